# Optimizing an MI355X kernel written in HIP

```python
import jax, jax.numpy as jnp
from jax import lax
import numpy as np

D_MODEL = 1024
BATCH = 8
SEQ = 4096
DEPTH = 1

PLE_DIM = 256
ATTN_HEADS = 8
HEAD_DIM = 64
ATTN_WIDTH = ATTN_HEADS * HEAD_DIM
IDX_HEADS = 4
IDX_DIM = 64
TOPK_MAX = 256
Q_BLOCK = 128
CONV_WIDTH = D_MODEL // 2
CONV_KERNEL = 31
MIX_WIDTH = ATTN_WIDTH + CONV_WIDTH
IN_SIZES = (ATTN_WIDTH, HEAD_DIM, HEAD_DIM, IDX_HEADS * IDX_DIM, IDX_DIM, IDX_HEADS, 2 * CONV_WIDTH)
IN_WIDTH = sum(IN_SIZES)
IN_SPLITS = tuple(int(s) for s in np.cumsum(IN_SIZES)[:-1])
N_EXPERTS = 32
TOP_K = 4
D_EXPERT = D_MODEL
SWIGLU_LIMIT = 7.0
SWIGLU_ALPHA = 1.702
MOE_BLOCK = 256
ROPE_THETA = 10000.0
EPS = 1e-6

kernel_name = 'hybrid_dsa_conformer_moe_block'


def rms_norm(x, g):
    xf = x.astype(jnp.float32)
    y = xf * lax.rsqrt(jnp.mean(xf * xf, axis=-1, keepdims=True) + EPS)
    return (y * g.astype(jnp.float32)).astype(x.dtype)


def layer_norm(x, g, b):
    xf = x.astype(jnp.float32)
    mu = jnp.mean(xf, axis=-1, keepdims=True)
    var = jnp.mean(jnp.square(xf - mu), axis=-1, keepdims=True)
    y = (xf - mu) * lax.rsqrt(var + EPS)
    return (y * g.astype(jnp.float32) + b.astype(jnp.float32)).astype(x.dtype)


def rope_tables(seq, dim):
    inv = ROPE_THETA ** (-jnp.arange(0, dim, 2, dtype=jnp.float32) / dim)
    ang = jnp.arange(seq, dtype=jnp.float32)[:, None] * inv[None, :]
    return jnp.cos(ang), jnp.sin(ang)


def apply_rope(x, cos, sin):
    extra = x.ndim - 3
    c = cos.reshape((cos.shape[0],) + (1,) * extra + (cos.shape[1],))
    s = sin.reshape((sin.shape[0],) + (1,) * extra + (sin.shape[1],))
    x1, x2 = jnp.split(x.astype(jnp.float32), 2, axis=-1)
    return jnp.concatenate([x1 * c - x2 * s, x2 * c + x1 * s], axis=-1).astype(x.dtype)


def dsa_attention(q, k, v, q_idx, k_idx, w_idx):
    B, S = q.shape[0], q.shape[1]
    n_sel = min(TOPK_MAX, S // 4)
    nb = S // Q_BLOCK
    key_pos = jnp.arange(S, dtype=jnp.int32)
    k_idx_f = k_idx.astype(jnp.float32)

    def to_blocks(a):
        return a.reshape((B, nb, Q_BLOCK) + a.shape[2:]).swapaxes(0, 1)

    def one_block(args):
        qb, qib, wb, tb = args
        s = jnp.einsum('bqhd,bsd->bqhs', qib.astype(jnp.float32), k_idx_f) * (IDX_DIM ** -0.5)
        score = jnp.einsum('bqhs,bqh->bqs', jax.nn.relu(s), wb.astype(jnp.float32)) * (IDX_HEADS ** -0.5)
        causal = key_pos[None, :] <= tb[:, None]
        score = jnp.where(causal[None], score, -jnp.inf)
        _, idx = lax.top_k(score, n_sel)
        valid = idx <= tb[None, :, None]
        k_sel = jax.vmap(lambda kb, ib: kb[ib])(k, idx)
        v_sel = jax.vmap(lambda vb, ib: vb[ib])(v, idx)
        logits = jnp.einsum('bqhd,bqkd->bqhk', qb, k_sel).astype(jnp.float32) * (HEAD_DIM ** -0.5)
        logits = jnp.where(valid[:, :, None, :], logits, -jnp.inf)
        probs = jax.nn.softmax(logits, axis=-1).astype(v.dtype)
        return jnp.einsum('bqhk,bqkd->bqhd', probs, v_sel)

    pos_blocks = key_pos.reshape(nb, Q_BLOCK)
    out = lax.map(one_block, (to_blocks(q), to_blocks(q_idx), to_blocks(w_idx), pos_blocks))
    return out.swapaxes(0, 1).reshape(B, S, ATTN_HEADS * HEAD_DIM)


def conformer_conv(u, glu_b, dw_w, dw_b, ln_g, ln_b):
    a, g = jnp.split(u + glu_b, 2, axis=-1)
    h = a * jax.nn.sigmoid(g)
    h = lax.conv_general_dilated(
        h, dw_w[:, None, :].astype(h.dtype), window_strides=(1,),
        padding=[(CONV_KERNEL - 1, 0)], dimension_numbers=('NWC', 'WIO', 'NWC'),
        feature_group_count=CONV_WIDTH) + dw_b
    h = layer_norm(h, ln_g, ln_b)
    return jax.nn.silu(h)


def moe(x, w_router, b_router, w_up, b_up, w_down, b_down):
    N = x.shape[0]
    logits = (x @ w_router).astype(jnp.float32) + b_router.astype(jnp.float32)
    top_v, top_e = lax.top_k(logits, TOP_K)
    gates = jax.nn.softmax(top_v, axis=-1)
    A = N * TOP_K
    e_flat = top_e.reshape(A)
    tok_flat = jnp.arange(A, dtype=jnp.int32) // TOP_K
    gate_flat = gates.reshape(A)
    order = jnp.argsort(e_flat)
    e_sorted = e_flat[order]
    counts = jnp.bincount(e_flat, length=N_EXPERTS)
    padded = (counts + MOE_BLOCK - 1) // MOE_BLOCK * MOE_BLOCK
    start = jnp.cumsum(counts) - counts
    cum_padded = jnp.cumsum(padded)
    pstart = cum_padded - padded
    dest = pstart[e_sorted] + jnp.arange(A, dtype=jnp.int32) - start[e_sorted]
    n_blocks = (A + N_EXPERTS * (MOE_BLOCK - 1) + MOE_BLOCK - 1) // MOE_BLOCK
    P = n_blocks * MOE_BLOCK
    row_tok = jnp.zeros((P,), jnp.int32).at[dest].set(tok_flat[order])
    row_gate = jnp.zeros((P,), jnp.float32).at[dest].set(gate_flat[order])
    block_start = jnp.arange(n_blocks, dtype=jnp.int32) * MOE_BLOCK
    block_exp = jnp.minimum(jnp.searchsorted(cum_padded, block_start, side='right'), N_EXPERTS - 1)

    def expert_block(args):
        e, toks = args
        h = x[toks] @ w_up[e] + b_up[e]
        gt, lin = jnp.split(h, 2, axis=-1)
        gt = jnp.minimum(gt, SWIGLU_LIMIT)
        lin = jnp.clip(lin, -SWIGLU_LIMIT, SWIGLU_LIMIT)
        act = gt * jax.nn.sigmoid(SWIGLU_ALPHA * gt) * (lin + 1.0)
        return act @ w_down[e] + b_down[e]

    y_rows = lax.map(expert_block, (block_exp, row_tok.reshape(n_blocks, MOE_BLOCK)))
    y_rows = y_rows.reshape(P, x.shape[1]).astype(jnp.float32) * row_gate[:, None]
    return jax.ops.segment_sum(y_rows, row_tok, num_segments=N).astype(x.dtype)


def setup_inputs(seed: int = 0) -> dict:
    key = jax.random.key(seed)
    ks = jax.random.split(key, 21)
    f32 = jnp.float32

    def nrm(k, shape, scale):
        return jax.random.normal(k, shape, f32) * scale

    def gain(k, shape):
        return 1.0 + 0.05 * jax.random.normal(k, shape, f32)

    return {
        'x': nrm(ks[0], (BATCH, SEQ, D_MODEL), 1.0),
        'p': nrm(ks[1], (DEPTH, BATCH, SEQ, PLE_DIM), 1.0),
        'w_in': nrm(ks[2], (DEPTH, D_MODEL, IN_WIDTH), D_MODEL ** -0.5),
        'w_out': nrm(ks[3], (DEPTH, MIX_WIDTH, D_MODEL), MIX_WIDTH ** -0.5),
        'g_mix': gain(ks[4], (DEPTH, D_MODEL)),
        'g_ffn': gain(ks[5], (DEPTH, D_MODEL)),
        'conv_glu_b': nrm(ks[6], (DEPTH, 2 * CONV_WIDTH), 0.02),
        'conv_dw_w': nrm(ks[7], (DEPTH, CONV_KERNEL, CONV_WIDTH), CONV_KERNEL ** -0.5),
        'conv_dw_b': nrm(ks[8], (DEPTH, CONV_WIDTH), 0.02),
        'conv_ln_g': gain(ks[9], (DEPTH, CONV_WIDTH)),
        'conv_ln_b': nrm(ks[10], (DEPTH, CONV_WIDTH), 0.02),
        'w_router': nrm(ks[11], (DEPTH, D_MODEL, N_EXPERTS), D_MODEL ** -0.5),
        'b_router': nrm(ks[12], (DEPTH, N_EXPERTS), 0.01),
        'w_up': nrm(ks[13], (DEPTH, N_EXPERTS, D_MODEL, 2 * D_EXPERT), D_MODEL ** -0.5),
        'b_up': nrm(ks[14], (DEPTH, N_EXPERTS, 2 * D_EXPERT), 0.02),
        'w_down': nrm(ks[15], (DEPTH, N_EXPERTS, D_EXPERT, D_MODEL), D_EXPERT ** -0.5),
        'b_down': nrm(ks[16], (DEPTH, N_EXPERTS, D_MODEL), 0.02),
        'w_ple_proj': nrm(ks[17], (DEPTH, PLE_DIM, D_MODEL), PLE_DIM ** -0.5),
        'w_ple_gate': nrm(ks[18], (DEPTH, D_MODEL, D_MODEL), D_MODEL ** -0.5),
        'g_ple': gain(ks[19], (DEPTH, D_MODEL)),
        'g_final': gain(ks[20], (D_MODEL,)),
    }


def reference(x, p, w_in, w_out, g_mix, g_ffn, conv_glu_b, conv_dw_w, conv_dw_b, conv_ln_g,
              conv_ln_b, w_router, b_router, w_up, b_up, w_down, b_down, w_ple_proj,
              w_ple_gate, g_ple, g_final):
    B, S, D = x.shape
    cos_a, sin_a = rope_tables(S, HEAD_DIM)
    cos_i, sin_i = rope_tables(S, IDX_DIM)
    h = x
    for i in range(DEPTH):
        u = rms_norm(h, g_mix[i]) @ w_in[i]
        q, k, v, qi, ki, wi, cu = jnp.split(u, IN_SPLITS, axis=-1)
        q = apply_rope(q.reshape(B, S, ATTN_HEADS, HEAD_DIM), cos_a, sin_a)
        k = apply_rope(k, cos_a, sin_a)
        qi = apply_rope(qi.reshape(B, S, IDX_HEADS, IDX_DIM), cos_i, sin_i)
        ki = apply_rope(ki, cos_i, sin_i)
        attn = dsa_attention(q, k, v, qi, ki, wi)
        conv = conformer_conv(cu, conv_glu_b[i], conv_dw_w[i], conv_dw_b[i],
                              conv_ln_g[i], conv_ln_b[i])
        h = h + jnp.concatenate([attn, conv], axis=-1) @ w_out[i]
        y = moe(rms_norm(h, g_ffn[i]).reshape(B * S, D), w_router[i], b_router[i],
                w_up[i], b_up[i], w_down[i], b_down[i])
        h = h + y.reshape(B, S, D)
        gate = jax.nn.sigmoid((rms_norm(h, g_ple[i]) @ w_ple_gate[i]).astype(jnp.float32))
        h = h + ((p[i] @ w_ple_proj[i]).astype(jnp.float32) * gate).astype(h.dtype)
    return rms_norm(h, g_final)
```

```cpp
#include <hip/hip_runtime.h>
#include <hip/hip_cooperative_groups.h>
#include <cstdio>
#include <cstdint>
namespace cg = cooperative_groups;

#define LAS __attribute__((address_space(3)))
#define GAS __attribute__((address_space(1)))
typedef unsigned short bf16_t;
typedef short bf16x8 __attribute__((ext_vector_type(8)));
typedef short s16x4 __attribute__((ext_vector_type(4)));
typedef float f32x4 __attribute__((ext_vector_type(4)));
typedef float f32x2 __attribute__((ext_vector_type(2)));
typedef float f32x16 __attribute__((ext_vector_type(16)));
typedef unsigned u32x4 __attribute__((ext_vector_type(4)));
typedef unsigned u32x2 __attribute__((ext_vector_type(2)));

constexpr int NB = 8, SEQ = 4096, DM = 1024, NTOK = NB * SEQ;
constexpr int NE = 32, TOPK = 4, NSLOT = NTOK * TOPK;
constexpr int INW = 1988;
constexpr int NSEL = 256;
constexpr float EPS = 1e-6f;
constexpr int NWAVES = 8, NTHR = 512;

constexpr size_t MiB = 1u << 20;
constexpr size_t WS_CTL = 0, CTL_BYTES = 64 * 1024;
constexpr size_t WS_ROPE = 1 * MiB;
constexpr size_t WS_WIN = 2 * MiB;
constexpr size_t WS_WOUT = 6 * MiB;
constexpr size_t WS_WG = 8 * MiB;
constexpr size_t WS_WP = 10 * MiB;
constexpr size_t WS_WRG = 10 * MiB + 512 * 1024;
constexpr size_t WS_RS1 = 11 * MiB;
constexpr size_t WS_RS3 = 11 * MiB + 512 * 1024;
constexpr size_t WS_WI = 12 * MiB;
constexpr size_t WS_LIST = 13 * MiB;
constexpr size_t WS_LSCALE = 17 * MiB;
constexpr size_t WS_LGATE = 21 * MiB;
constexpr size_t WS_PB = 25 * MiB;
constexpr size_t WS_WUP = 42 * MiB;
constexpr size_t WS_WDOWN = 170 * MiB;
constexpr size_t WS_H1 = 234 * MiB;
constexpr size_t WS_H1B = 362 * MiB;
constexpr size_t WS_PJ = 426 * MiB;
constexpr size_t WS_XB = 490 * MiB;
constexpr size_t WS_Q = 554 * MiB;
constexpr size_t WS_K = 586 * MiB;
constexpr size_t WS_V = 590 * MiB;
constexpr size_t WS_QI = 594 * MiB;
constexpr size_t WS_KI = 610 * MiB;
constexpr size_t WS_HGLU = 614 * MiB;
constexpr size_t WS_MIX = 646 * MiB;
constexpr size_t WS_ACT = 490 * MiB;
constexpr size_t WS_Y = 762 * MiB;
constexpr size_t WS_END = 1018 * MiB;
static_assert(WS_MIX + (size_t)NTOK * 1024 * 2 <= WS_ACT + (size_t)139264 * 2048 && WS_ACT + (size_t)139264 * 2048 <= WS_Y, "ws map");
constexpr int CW_CNT = 1024;

constexpr int LDS_STAGE = 131072;
constexpr int LDS_MISC = LDS_STAGE;
constexpr int LDS_BYTES = 147456;

__device__ __forceinline__ unsigned f2bf(float f) { unsigned u = __builtin_bit_cast(unsigned, f); return (u + 0x7fffu + ((u >> 16) & 1u)) >> 16; }
__device__ __forceinline__ unsigned pk2(float lo, float hi) { return f2bf(lo) | (f2bf(hi) << 16); }
__device__ __forceinline__ float bf_lo(unsigned w) { return __builtin_bit_cast(float, w << 16); }
__device__ __forceinline__ float bf_hi(unsigned w) { return __builtin_bit_cast(float, w & 0xffff0000u); }
__device__ __forceinline__ float wave_sum(float v) {
#pragma unroll
    for (int o = 1; o < 64; o <<= 1) v += __shfl_xor(v, o);
    return v;
}
__device__ __forceinline__ float sigmoidf_(float x) { return 1.0f / (1.0f + __expf(-x)); }
#define LDS_WAIT() asm volatile("s_waitcnt lgkmcnt(0)" ::: "memory")

struct Params {
    const float* x; const float* p; const float* w_in; const float* w_out; const float* g_mix; const float* g_ffn;
    const float* glu_b; const float* dw_w; const float* dw_b; const float* ln_g; const float* ln_b;
    const float* w_router; const float* b_router; const float* w_up; const float* b_up; const float* w_down; const float* b_down;
    const float* w_ple_proj; const float* w_ple_gate; const float* g_ple; const float* g_final;
    float* out; unsigned char* ws;
    int ph_lo, ph_hi;
};

namespace pg8 {
constexpr int BM = 256, BK = 64, HALF = 128, HTB = HALF * BK * 2, STAGE_BYTES = 8 * HTB, NXCD = 8, WGM = 8;
__host__ __device__ __forceinline__ int lds_byte(int r, int c) { const int st = (r >> 4) * 2 + (c >> 5), rr = r & 15, cc = c & 31, ob = rr * 64 + cc * 2; return st * 1024 + (ob ^ (((ob >> 9) & 1) << 5)); }
__host__ __device__ __forceinline__ void stage_rc(int b, int& R, int& C) { const int st = b / 1024, sb = b % 1024, swz = sb ^ (((sb >> 9) & 1) << 5); R = (st >> 1) * 16 + swz / 64; C = (st & 1) * 32 + (swz % 64) / 2; }
__host__ __device__ __forceinline__ int perm32(int rho) { const int n = rho >> 4, i = rho & 15; return 8 * (i >> 2) + 4 * n + (i & 3); }

struct Unit { int pm, pn, e, rows; };

__device__ __forceinline__ unsigned cvt_pk_bf16(float lo, float hi) { unsigned r; asm volatile("v_cvt_pk_bf16_f32 %0, %1, %2" : "=v"(r) : "v"(lo), "v"(hi)); return r; }

struct DenseSched {
    const bf16_t* A; const bf16_t* Bt; int K;
    int nM, nN, nwg, G, c;
    __device__ void init(const bf16_t* A_, const bf16_t* Bt_, int M, int N, int K_, int G_, int c_) { A = A_; Bt = Bt_; K = K_; nM = M / BM; nN = N / BM; nwg = nM * nN; G = G_; c = c_; }
    __device__ bool next(int i, Unit& u) const {
        const long L = (long)i * G + c; if (L >= nwg) return false;
        int wgid = (int)L; { const int q = nwg / NXCD, r = nwg % NXCD, xcd = wgid % NXCD, off = wgid / NXCD; wgid = (xcd < r ? xcd * (q + 1) : r * (q + 1) + (xcd - r) * q) + off; }
        const int nig = WGM * nN, gid = wgid / nig, fm = gid * WGM, gsz = (nM - fm) < WGM ? (nM - fm) : WGM;
        u.pm = fm + ((wgid % nig) % gsz); u.pn = (wgid % nig) / gsz; u.e = 0; u.rows = BM; return true;
    }
    __device__ __forceinline__ const char* a_ptr(const Unit& u) const { return (const char*)A + (size_t)u.pm * BM * K * 2; }
    __device__ __forceinline__ const char* b_ptr(const Unit& u) const { return (const char*)Bt + (size_t)u.pn * BM * K * 2; }
    __device__ __forceinline__ int a_row(const Unit&, int) const { return 0; }
};

struct MoeSched {
    const bf16_t* A; const bf16_t* Bt; int K; size_t b_estride;
    const LAS int* tb;
    const LAS int* cnt;
    const int* list;
    int nN, nwg, G, c; bool gather;
    __device__ bool next(int i, Unit& u) const {
        const long L = (long)i * G + c; if (L >= nwg) return false;
        int wgid = (int)L; { const int q = nwg / NXCD, r = nwg % NXCD, xcd = wgid % NXCD, off = wgid / NXCD; wgid = (xcd < r ? xcd * (q + 1) : r * (q + 1) + (xcd - r) * q) + off; }
        int e = 0;
#pragma unroll 1
        for (; e < NE - 1; ++e) { if (wgid < tb[e + 1] * nN) break; }
        const int local = wgid - tb[e] * nN, nM = tb[e + 1] - tb[e];
        const int nig = WGM * nN, gid = local / nig, fm = gid * WGM, gsz = (nM - fm) < WGM ? (nM - fm) : WGM;
        const int rt = fm + ((local % nig) % gsz);
        u.pm = tb[e] + rt; u.pn = (local % nig) / gsz; u.e = e;
        const int left = cnt[e] - rt * BM; u.rows = left < BM ? left : BM; return true;
    }
    __device__ __forceinline__ const char* a_ptr(const Unit& u) const { return gather ? (const char*)A : (const char*)A + (size_t)u.pm * BM * K * 2; }
    __device__ __forceinline__ const char* b_ptr(const Unit& u) const { return (const char*)Bt + (size_t)u.e * b_estride + (size_t)u.pn * BM * K * 2; }
    __device__ __forceinline__ int a_row(const Unit& u, int r) const {
        const int rt = u.pm - tb[u.e];
        return r < u.rows ? (list[u.e * NTOK + rt * BM + r] >> 2) : 0;
    }
};

template <class Epi, class Sched, bool GATHER>
__device__ __forceinline__ void gemm_phase(LAS unsigned char* lds, const Sched& S, const Epi& E) {
    const int tid = threadIdx.x, wid = __builtin_amdgcn_readfirstlane(tid >> 6), lane = tid & 63, wr = wid >> 2, wc = wid & 3, fr = lane & 15, fq = lane >> 4;
    const int K = S.K, nt = K / BK;
    unsigned voffA[2], voffB[2]; int RA[2], CA[2];
#pragma unroll
    for (int i = 0; i < 2; ++i) { int R, C; stage_rc(tid * 16 + i * 8192, R, C); const int Rb = Epi::PERM ? ((R & ~31) + perm32(R & 31)) : R;
        voffA[i] = (unsigned)(R * K + C) * 2u; voffB[i] = (unsigned)(Rb * K + C) * 2u; RA[i] = R; CA[i] = C; }
    const size_t kstep = (size_t)(BK * 2);
    const size_t hstep = (size_t)HALF * K * 2;
    const unsigned ldsw = (unsigned)wid * 1024u;
    const int aoff = lds_byte(wr * 64 + fr, fq * 8), boff = lds_byte(wc * 32 + fr, fq * 8);
    unsigned gC[2][2], gN[2][2];
#define PG8_SA(b, h) (((b) * 2 + (h)) * HTB)
#define PG8_SB(b, h) ((4 + (b) * 2 + (h)) * HTB)
#define PG8_STAGE(bufoff, gbase, voff) do { _Pragma("unroll") for (int _i = 0; _i < 2; ++_i) \
        __builtin_amdgcn_global_load_lds((const unsigned*)((const char*)(gbase) + (voff)[_i]), (LAS unsigned*)(lds + (bufoff) + ldsw + _i * 8192), 16, 0, 0); } while (0)
#define PG8_STAGE_A(bufoff, kp, h) do { if constexpr (GATHER) { PG8_STAGE(bufoff, kp, gC[h]); } else { PG8_STAGE(bufoff, (kp) + (h) * hstep, voffA); } } while (0)
#define PG8_LDA(dst, b, h) do { _Pragma("unroll") for (int m = 0; m < 4; ++m) _Pragma("unroll") for (int k = 0; k < 2; ++k) dst[m][k] = *(const LAS bf16x8*)(lds + PG8_SA(b, h) + aoff + m * 2048 + k * 1024); } while (0)
#define PG8_LDB(dst, b, h) do { _Pragma("unroll") for (int n = 0; n < 2; ++n) _Pragma("unroll") for (int k = 0; k < 2; ++k) dst[n][k] = *(const LAS bf16x8*)(lds + PG8_SB(b, h) + boff + n * 2048 + k * 1024); } while (0)
#define PG8_MMA(ai, bj, At, Bt) do { __builtin_amdgcn_s_setprio(1); _Pragma("unroll") for (int m = 0; m < 4; ++m) _Pragma("unroll") for (int n = 0; n < 2; ++n) _Pragma("unroll") for (int k = 0; k < 2; ++k) \
        acc[ai][bj][m][n] = __builtin_amdgcn_mfma_f32_16x16x32_bf16(Bt[n][k], At[m][k], acc[ai][bj][m][n], 0, 0, 0); __builtin_amdgcn_s_setprio(0); } while (0)
#define PG8_WAIT_V(n) asm volatile("s_waitcnt vmcnt(" #n ")" ::: "memory")
#define PG8_WAIT_L(n) asm volatile("s_waitcnt lgkmcnt(" #n ")" ::: "memory")
#define PG8_BAR __builtin_amdgcn_s_barrier()
#define PG8_SCHED __builtin_amdgcn_sched_barrier(0)
#define PG8_GOFF(dst, u) do { _Pragma("unroll") for (int _h = 0; _h < 2; ++_h) _Pragma("unroll") for (int _i = 0; _i < 2; ++_i) \
        dst[_h][_i] = (unsigned)(S.a_row(u, _h * HALF + RA[_i]) * K + CA[_i]) * 2u; } while (0)
    Unit cur, nxt, nn; int ui = 0;
    if (!S.next(0, cur)) return;
    bool has_next = S.next(1, nxt);
    if constexpr (GATHER) { PG8_GOFF(gC, cur); if (has_next) { PG8_GOFF(gN, nxt); } else { PG8_GOFF(gN, cur); } }
    f32x4 acc[2][2][4][2];
#pragma unroll
    for (int a = 0; a < 2; ++a)
#pragma unroll
        for (int b = 0; b < 2; ++b)
#pragma unroll
            for (int m = 0; m < 4; ++m)
#pragma unroll
                for (int n = 0; n < 2; ++n) acc[a][b][m][n] = (f32x4){0.f, 0.f, 0.f, 0.f};
    bf16x8 At[4][2], B0[2][2], B1[2][2];
    const char* cA = S.a_ptr(cur); const char* cB = S.b_ptr(cur);
    PG8_STAGE(PG8_SB(0, 0), cB, voffB); PG8_STAGE(PG8_SB(0, 1), cB + hstep, voffB); PG8_STAGE_A(PG8_SA(0, 0), cA, 0); PG8_STAGE_A(PG8_SA(0, 1), cA, 1);
    if (wr == 1) PG8_BAR;
    PG8_WAIT_V(2); PG8_BAR;
    PG8_STAGE(PG8_SB(1, 0), cB + kstep, voffB); PG8_STAGE_A(PG8_SA(1, 0), cA + kstep, 0); PG8_STAGE(PG8_SB(1, 1), cB + hstep + kstep, voffB);
    PG8_WAIT_V(6); PG8_BAR;
    for (;;) {
        const char* nA = has_next ? S.a_ptr(nxt) : cA; const char* nB = has_next ? S.b_ptr(nxt) : cB;
        for (int t = 0; t < nt; t += 2) {
            const bool last = (t == nt - 2);
            const char* a1 = cA + (size_t)(t + 1) * kstep;
            const char* a2 = last ? nA : cA + (size_t)(t + 2) * kstep; const char* b2 = last ? nB : cB + (size_t)(t + 2) * kstep;
            const char* a3 = a2 + kstep; const char* b3 = b2 + kstep;
            PG8_LDB(B0, 0, 0); PG8_LDB(B1, 0, 1); PG8_SCHED; PG8_LDA(At, 0, 0); PG8_STAGE_A(PG8_SA(1, 1), a1, 1);
            if constexpr (GATHER) { if (last) {
#pragma unroll
                for (int h = 0; h < 2; ++h)
#pragma unroll
                    for (int i = 0; i < 2; ++i) gC[h][i] = gN[h][i]; } }
            PG8_WAIT_V(8); PG8_WAIT_L(0); PG8_BAR; PG8_MMA(0, 0, At, B0); PG8_MMA(0, 1, At, B1); PG8_BAR; PG8_SCHED;
            PG8_LDA(At, 0, 1); PG8_STAGE(PG8_SB(0, 0), b2, voffB); PG8_STAGE(PG8_SB(0, 1), b2 + hstep, voffB); PG8_STAGE_A(PG8_SA(0, 0), a2, 0);
            PG8_WAIT_V(8); PG8_WAIT_L(0); PG8_BAR; PG8_MMA(1, 0, At, B0); PG8_MMA(1, 1, At, B1); PG8_BAR; PG8_SCHED;
            PG8_LDB(B0, 1, 0); PG8_LDB(B1, 1, 1); PG8_SCHED; PG8_LDA(At, 1, 0); PG8_STAGE_A(PG8_SA(0, 1), a2, 1);
            PG8_WAIT_V(8); PG8_WAIT_L(0); PG8_BAR; PG8_MMA(0, 0, At, B0); PG8_MMA(0, 1, At, B1); PG8_BAR; PG8_SCHED;
            PG8_LDA(At, 1, 1); PG8_STAGE(PG8_SB(1, 0), b3, voffB); PG8_STAGE(PG8_SB(1, 1), b3 + hstep, voffB); PG8_STAGE_A(PG8_SA(1, 0), a3, 0);
            PG8_WAIT_V(8); PG8_WAIT_L(0); PG8_BAR; PG8_MMA(1, 0, At, B0); PG8_MMA(1, 1, At, B1); PG8_BAR; PG8_SCHED;
        }
        if (wr == 0) PG8_BAR;
        bool has_nn = false;
        if constexpr (GATHER) { if (has_next) { has_nn = S.next(ui + 2, nn); if (has_nn) { PG8_GOFF(gN, nn); } } }
        else { if (has_next) has_nn = S.next(ui + 2, nn); }
        E(acc, cur, wr, wc, fr, fq);
        if (!has_next) break;
#pragma unroll
        for (int a = 0; a < 2; ++a)
#pragma unroll
            for (int b = 0; b < 2; ++b)
#pragma unroll
                for (int m = 0; m < 4; ++m)
#pragma unroll
                    for (int n = 0; n < 2; ++n) acc[a][b][m][n] = (f32x4){0.f, 0.f, 0.f, 0.f};
        cur = nxt; cA = nA; cB = nB; ++ui; nxt = nn; has_next = has_nn;
        if (wr == 1) PG8_BAR;
    }
    PG8_WAIT_V(0);
    PG8_BAR;
#undef PG8_SA
#undef PG8_SB
#undef PG8_STAGE
#undef PG8_STAGE_A
#undef PG8_LDA
#undef PG8_LDB
#undef PG8_MMA
#undef PG8_WAIT_V
#undef PG8_WAIT_L
#undef PG8_BAR
#undef PG8_SCHED
#undef PG8_GOFF
}
}

using pg8::Unit; using pg8::cvt_pk_bf16;
constexpr int BM = 256, HALF = 128;

struct EpiInProj {
    static constexpr bool PERM = true;
    const float* rs1; const f32x2* rope; const float* glu_b;
    bf16_t *q, *k, *v, *qi, *ki, *hglu; float* wi;
    __device__ __forceinline__ void operator()(const f32x4 (&acc)[2][2][4][2], const Unit& u, int wr, int wc, int fr, int fq) const {
        const int row0 = u.pm * BM + wr * 64 + fr;
        if (u.pn >= 4) {
            const int ch = 128 * (u.pn - 4) + 32 * wc + 8 * fq;
            f32x4 ba[2], bg[2];
#pragma unroll
            for (int n = 0; n < 2; ++n) { ba[n] = *(const f32x4*)(glu_b + ch + 4 * n); bg[n] = *(const f32x4*)(glu_b + 512 + ch + 4 * n); }
#pragma unroll
            for (int ai = 0; ai < 2; ++ai)
#pragma unroll
                for (int m = 0; m < 4; ++m) { const int row = row0 + ai * HALF + m * 16; const float rs = rs1[row];
                    float o[8];
#pragma unroll
                    for (int n = 0; n < 2; ++n)
#pragma unroll
                        for (int e = 0; e < 4; ++e) { const float a = acc[ai][0][m][n][e] * rs + ba[n][e], g = acc[ai][1][m][n][e] * rs + bg[n][e]; o[4 * n + e] = a * sigmoidf_(g); }
                    u32x4 w; w.x = cvt_pk_bf16(o[0], o[1]); w.y = cvt_pk_bf16(o[2], o[3]); w.z = cvt_pk_bf16(o[4], o[5]); w.w = cvt_pk_bf16(o[6], o[7]);
                    *(u32x4*)(hglu + (size_t)row * 512 + ch) = w; }
            return;
        }
        bf16_t* dst; int ld, col; bool do_rope = true, is_wi = false;
        if (u.pn < 2) { dst = q; ld = 512; col = (4 * u.pn + wc) * 64; }
        else if (u.pn == 2) { dst = qi; ld = 256; col = wc * 64; }
        else { ld = 64; col = 0; if (wc == 0) dst = k; else if (wc == 1) dst = ki; else if (wc == 2) { dst = v; do_rope = false; } else { dst = v; is_wi = true; do_rope = false; } }
        if (is_wi) {
            if (fq == 0) {
#pragma unroll
                for (int ai = 0; ai < 2; ++ai)
#pragma unroll
                    for (int m = 0; m < 4; ++m) { const int row = row0 + ai * HALF + m * 16; const float rs = rs1[row];
                        *(f32x4*)(wi + (size_t)row * 4) = acc[ai][0][m][0] * rs; }
            }
            return;
        }
        const int d0 = 8 * fq;
#pragma unroll
        for (int ai = 0; ai < 2; ++ai)
#pragma unroll
            for (int m = 0; m < 4; ++m) { const int row = row0 + ai * HALF + m * 16; const float rs = rs1[row];
                float o1[8], o2[8];
                if (do_rope) {
                    const f32x2* rp = rope + (size_t)(row & (SEQ - 1)) * 32 + d0;
#pragma unroll
                    for (int n = 0; n < 2; ++n)
#pragma unroll
                        for (int e = 0; e < 4; ++e) { const f32x2 cs = rp[4 * n + e]; const float x1 = acc[ai][0][m][n][e] * rs, x2 = acc[ai][1][m][n][e] * rs;
                            o1[4 * n + e] = x1 * cs.x - x2 * cs.y; o2[4 * n + e] = x2 * cs.x + x1 * cs.y; }
                } else {
#pragma unroll
                    for (int n = 0; n < 2; ++n)
#pragma unroll
                        for (int e = 0; e < 4; ++e) { o1[4 * n + e] = acc[ai][0][m][n][e] * rs; o2[4 * n + e] = acc[ai][1][m][n][e] * rs; }
                }
                u32x4 w1, w2; w1.x = cvt_pk_bf16(o1[0], o1[1]); w1.y = cvt_pk_bf16(o1[2], o1[3]); w1.z = cvt_pk_bf16(o1[4], o1[5]); w1.w = cvt_pk_bf16(o1[6], o1[7]);
                w2.x = cvt_pk_bf16(o2[0], o2[1]); w2.y = cvt_pk_bf16(o2[2], o2[3]); w2.z = cvt_pk_bf16(o2[4], o2[5]); w2.w = cvt_pk_bf16(o2[6], o2[7]);
                bf16_t* rp2 = dst + (size_t)row * ld + col + d0;
                *(u32x4*)(rp2) = w1; *(u32x4*)(rp2 + 32) = w2; }
    }
};

struct EpiBf16Plain {
    static constexpr bool PERM = true;
    bf16_t* O; int ldc;
    __device__ __forceinline__ void operator()(const f32x4 (&acc)[2][2][4][2], const Unit& u, int wr, int wc, int fr, int fq) const {
        const int row0 = u.pm * BM + wr * 64 + fr, col0 = u.pn * BM + wc * 32 + 8 * fq;
#pragma unroll
        for (int ai = 0; ai < 2; ++ai)
#pragma unroll
            for (int m = 0; m < 4; ++m) { bf16_t* rowp = O + (size_t)(row0 + ai * HALF + m * 16) * ldc + col0;
#pragma unroll
                for (int bj = 0; bj < 2; ++bj) { const f32x4 v0 = acc[ai][bj][m][0], v1 = acc[ai][bj][m][1];
                    u32x4 w; w.x = cvt_pk_bf16(v0[0], v0[1]); w.y = cvt_pk_bf16(v0[2], v0[3]); w.z = cvt_pk_bf16(v1[0], v1[1]); w.w = cvt_pk_bf16(v1[2], v1[3]);
                    *(u32x4*)(rowp + bj * HALF) = w; } }
    }
};

struct EpiOutProj {
    static constexpr bool PERM = false;
    const float* x; float* h1; bf16_t* h1b;
    __device__ __forceinline__ void operator()(const f32x4 (&acc)[2][2][4][2], const Unit& u, int wr, int wc, int fr, int fq) const {
        const int row0 = u.pm * BM + wr * 64 + fr, col0 = u.pn * BM + wc * 32 + 4 * fq;
#pragma unroll
        for (int ai = 0; ai < 2; ++ai)
#pragma unroll
            for (int m = 0; m < 4; ++m) { const size_t off = (size_t)(row0 + ai * HALF + m * 16) * DM + col0;
#pragma unroll
                for (int bj = 0; bj < 2; ++bj)
#pragma unroll
                    for (int n = 0; n < 2; ++n) { const size_t o = off + bj * HALF + n * 16; const f32x4 r = *(const f32x4*)(x + o) + acc[ai][bj][m][n];
                        *(f32x4*)(h1 + o) = r; u32x2 w; w.x = cvt_pk_bf16(r[0], r[1]); w.y = cvt_pk_bf16(r[2], r[3]); *(u32x2*)(h1b + o) = w; } }
    }
};

struct EpiUp {
    static constexpr bool PERM = true;
    const float* lscale; const float* b_up; bf16_t* act; const LAS int* tb;
    __device__ __forceinline__ void operator()(const f32x4 (&acc)[2][2][4][2], const Unit& u, int wr, int wc, int fr, int fq) const {
        const int r0 = wr * 64 + fr, ch = 128 * u.pn + 32 * wc + 8 * fq, rt = u.pm - tb[u.e];
        const float* bu = b_up + (size_t)u.e * 2048;
        f32x4 bg[2], bl[2];
#pragma unroll
        for (int n = 0; n < 2; ++n) { bg[n] = *(const f32x4*)(bu + ch + 4 * n); bl[n] = *(const f32x4*)(bu + 1024 + ch + 4 * n); }
#pragma unroll
        for (int ai = 0; ai < 2; ++ai)
#pragma unroll
            for (int m = 0; m < 4; ++m) { const int r = r0 + ai * HALF + m * 16;
                const float rs = (r < u.rows) ? lscale[u.e * NTOK + rt * BM + r] : 0.f;
                float o[8];
#pragma unroll
                for (int n = 0; n < 2; ++n)
#pragma unroll
                    for (int e = 0; e < 4; ++e) { float g = acc[ai][0][m][n][e] * rs + bg[n][e], l = acc[ai][1][m][n][e] * rs + bl[n][e];
                        g = fminf(g, 7.0f); l = fminf(fmaxf(l, -7.0f), 7.0f); o[4 * n + e] = g * sigmoidf_(1.702f * g) * (l + 1.0f); }
                u32x4 w; w.x = cvt_pk_bf16(o[0], o[1]); w.y = cvt_pk_bf16(o[2], o[3]); w.z = cvt_pk_bf16(o[4], o[5]); w.w = cvt_pk_bf16(o[6], o[7]);
                *(u32x4*)(act + (size_t)(u.pm * BM + r) * 1024 + ch) = w; }
    }
};

struct EpiDown {
    static constexpr bool PERM = true;
    const int* list; const float* lgate; const float* b_down; bf16_t* y; const LAS int* tb;
    __device__ __forceinline__ void operator()(const f32x4 (&acc)[2][2][4][2], const Unit& u, int wr, int wc, int fr, int fq) const {
        const int r0 = wr * 64 + fr, col0 = u.pn * BM + wc * 32 + 8 * fq, rt = u.pm - tb[u.e];
        const float* bd = b_down + (size_t)u.e * 1024;
        f32x4 bv[2][2];
#pragma unroll
        for (int bj = 0; bj < 2; ++bj)
#pragma unroll
            for (int n = 0; n < 2; ++n) bv[bj][n] = *(const f32x4*)(bd + col0 + bj * HALF + 4 * n);
#pragma unroll
        for (int ai = 0; ai < 2; ++ai)
#pragma unroll
            for (int m = 0; m < 4; ++m) { const int r = r0 + ai * HALF + m * 16;
                if (r < u.rows) { const int li = u.e * NTOK + rt * BM + r; const int slot = list[li]; const float g = lgate[li];
                    bf16_t* rowp = y + (size_t)slot * 1024 + col0;
#pragma unroll
                    for (int bj = 0; bj < 2; ++bj) { const f32x4 v0 = (acc[ai][bj][m][0] + bv[bj][0]) * g, v1 = (acc[ai][bj][m][1] + bv[bj][1]) * g;
                        u32x4 w; w.x = cvt_pk_bf16(v0[0], v0[1]); w.y = cvt_pk_bf16(v0[2], v0[3]); w.z = cvt_pk_bf16(v1[0], v1[1]); w.w = cvt_pk_bf16(v1[2], v1[3]);
                        *(u32x4*)(rowp + bj * HALF) = w; } } }
    }
};

struct EpiPle {
    static constexpr bool PERM = false;
    const float* h2; const bf16_t* pj; const float* rs3; float* out;
    __device__ __forceinline__ void operator()(const f32x4 (&acc)[2][2][4][2], const Unit& u, int wr, int wc, int fr, int fq) const {
        const int row0 = u.pm * BM + wr * 64 + fr, col0 = u.pn * BM + wc * 32 + 4 * fq;
#pragma unroll
        for (int ai = 0; ai < 2; ++ai)
#pragma unroll
            for (int m = 0; m < 4; ++m) { const int row = row0 + ai * HALF + m * 16; const size_t off = (size_t)row * DM + col0; const float rs = rs3[row];
#pragma unroll
                for (int bj = 0; bj < 2; ++bj)
#pragma unroll
                    for (int n = 0; n < 2; ++n) { const size_t o = off + bj * HALF + n * 16; const f32x4 hv = *(const f32x4*)(h2 + o); const u32x2 pw = *(const u32x2*)(pj + o);
                        const f32x4 a = acc[ai][bj][m][n]; f32x4 r;
                        r[0] = hv[0] + bf_lo(pw.x) * sigmoidf_(a[0] * rs); r[1] = hv[1] + bf_hi(pw.x) * sigmoidf_(a[1] * rs);
                        r[2] = hv[2] + bf_lo(pw.y) * sigmoidf_(a[2] * rs); r[3] = hv[3] + bf_hi(pw.y) * sigmoidf_(a[3] * rs);
                        *(f32x4*)(out + o) = r; } }
    }
};

__device__ __forceinline__ void p0_transpose_item(const float* W, int ldw, bf16_t* WT, int Kdim, const float* gain, LAS float* scr, int kb, int n0, int src0, int nvalid, int lane) {
    const int k0 = 64 * kb;
#pragma unroll 8
    for (int i = 0; i < 32; ++i) { const int kk = 2 * i + (lane >> 5), j = lane & 31;
        float v = 0.f; if (j < nvalid) { v = W[(size_t)(k0 + kk) * ldw + src0 + j]; if (gain) v *= gain[k0 + kk]; }
        scr[kk * 33 + j] = v; }
    LDS_WAIT(); asm volatile("" ::: "memory");
    const int c = lane & 7;
#pragma unroll
    for (int j = 0; j < 4; ++j) { const int n = (lane >> 3) + 8 * j; const LAS float* s = scr + (8 * c) * 33 + n;
        u32x4 o; o.x = pk2(s[0 * 33], s[1 * 33]); o.y = pk2(s[2 * 33], s[3 * 33]); o.z = pk2(s[4 * 33], s[5 * 33]); o.w = pk2(s[6 * 33], s[7 * 33]);
        *(u32x4*)(WT + (size_t)(n0 + n) * Kdim + k0 + 8 * c) = o; }
    LDS_WAIT(); asm volatile("" ::: "memory");
}
__device__ __forceinline__ void win_colmap(int nb, int& src0, int& nvalid) {
    const int pn = nb >> 3, j = (nb & 7) * 32, bj = j >> 7, slot = (j & 127) >> 5;
    nvalid = 32;
    if (pn < 2) src0 = (4 * pn + slot) * 64 + 32 * bj;
    else if (pn == 2) src0 = 640 + slot * 64 + 32 * bj;
    else if (pn == 3) { if (slot == 0) src0 = 512 + 32 * bj; else if (slot == 1) src0 = 896 + 32 * bj; else if (slot == 2) src0 = 576 + 32 * bj; else { src0 = 960; nvalid = bj == 0 ? 4 : 0; } }
    else src0 = 964 + 512 * bj + 128 * (pn - 4) + 32 * slot;
}
__device__ __forceinline__ void p0_prologue(const Params& P, LAS unsigned char* lds, int vcu, int G, int wave, int lane) {
    unsigned char* ws = P.ws;
    LAS float* scr = (LAS float*)(lds + wave * 16384);
    const int gw = vcu * NWAVES + wave, NGW = G * NWAVES;
    constexpr int I_IN = 16 * 64, I_OUT = 16 * 32, I_G = 16 * 32, I_P = 4 * 32, I_UP = 32 * 16 * 64, I_DN = 32 * 16 * 32;
    constexpr int NITEMS = I_IN + I_OUT + I_G + I_P + I_UP + I_DN;
    for (int it = gw; it < NITEMS; it += NGW) {
        int r = it;
        if (r < I_IN) { const int kb = r / 64, nb = r % 64; int s0, nv; win_colmap(nb, s0, nv); p0_transpose_item(P.w_in, INW, (bf16_t*)(ws + WS_WIN), 1024, P.g_mix, scr, kb, nb * 32, s0, nv, lane); continue; } r -= I_IN;
        if (r < I_OUT) { const int kb = r / 32, nb = r % 32; p0_transpose_item(P.w_out, 1024, (bf16_t*)(ws + WS_WOUT), 1024, nullptr, scr, kb, nb * 32, nb * 32, 32, lane); continue; } r -= I_OUT;
        if (r < I_G) { const int kb = r / 32, nb = r % 32; p0_transpose_item(P.w_ple_gate, 1024, (bf16_t*)(ws + WS_WG), 1024, P.g_ple, scr, kb, nb * 32, nb * 32, 32, lane); continue; } r -= I_G;
        if (r < I_P) { const int kb = r / 32, nb = r % 32; p0_transpose_item(P.w_ple_proj, 1024, (bf16_t*)(ws + WS_WP), 256, nullptr, scr, kb, nb * 32, nb * 32, 32, lane); continue; } r -= I_P;
        if (r < I_UP) { const int e = r / 1024, rr = r % 1024, kb = rr / 64, nb = rr % 64;
            const int pn = nb >> 3, j = (nb & 7) * 32, bj = j >> 7, jj = j & 127;
            p0_transpose_item(P.w_up + (size_t)e * 1024 * 2048, 2048, (bf16_t*)(ws + WS_WUP) + (size_t)e * 2048 * 1024, 1024, P.g_ffn, scr, kb, nb * 32, 1024 * bj + 128 * pn + jj, 32, lane); continue; } r -= I_UP;
        { const int e = r / 512, rr = r % 512, kb = rr / 32, nb = rr % 32;
            p0_transpose_item(P.w_down + (size_t)e * 1024 * 1024, 1024, (bf16_t*)(ws + WS_WDOWN) + (size_t)e * 1024 * 1024, 1024, nullptr, scr, kb, nb * 32, nb * 32, 32, lane); }
    }
    float* rs1 = (float*)(ws + WS_RS1); bf16_t* xb = (bf16_t*)(ws + WS_XB);
    for (int m = gw; m < NTOK; m += NGW) {
        const f32x4* xr = (const f32x4*)(P.x + (size_t)m * DM) + lane; f32x4 v[4]; float s = 0.f;
#pragma unroll
        for (int j = 0; j < 4; ++j) { v[j] = xr[64 * j]; s += (v[j].x * v[j].x + v[j].y * v[j].y) + (v[j].z * v[j].z + v[j].w * v[j].w); }
        s = wave_sum(s);
        u32x2* o8 = (u32x2*)(xb + (size_t)m * DM) + lane;
#pragma unroll
        for (int j = 0; j < 4; ++j) { u32x2 w; w.x = pk2(v[j].x, v[j].y); w.y = pk2(v[j].z, v[j].w); o8[64 * j] = w; }
        if (lane == 0) rs1[m] = 1.0f / sqrtf(s * (1.0f / DM) + EPS);
    }
    bf16_t* pb = (bf16_t*)(ws + WS_PB);
    for (int m = gw; m < NTOK; m += NGW) { const f32x4 v = *((const f32x4*)(P.p + (size_t)m * 256) + lane); u32x2 w; w.x = pk2(v.x, v.y); w.y = pk2(v.z, v.w); *((u32x2*)(pb + (size_t)m * 256) + lane) = w; }
    f32x2* rope = (f32x2*)(ws + WS_ROPE);
    for (int idx = gw * 64 + lane; idx < SEQ * 32; idx += NGW * 64) { const int t = idx >> 5, i = idx & 31;
        const float inv = exp2f(-(float)i * (13.287712379549449f / 32.0f));
        const float ang = (float)t * inv;
        const double rev = (double)ang * 0.15915494309189535; const float fr = (float)(rev - __builtin_floor(rev));
        rope[idx] = (f32x2){__builtin_amdgcn_cosf(fr), __builtin_amdgcn_sinf(fr)}; }
    float* wrg = (float*)(ws + WS_WRG);
    for (int idx = gw * 64 + lane; idx < 1024 * 32; idx += NGW * 64) wrg[idx] = P.w_router[idx] * P.g_ffn[idx >> 5];
}

__device__ __forceinline__ unsigned fkey(float f) { unsigned u = __builtin_bit_cast(unsigned, f); if (u == 0x80000000u) u = 0u; return u ^ ((unsigned)((int)u >> 31) | 0x80000000u); }
__device__ __forceinline__ int mbcnt64(unsigned long long m) { return __builtin_amdgcn_mbcnt_hi((unsigned)(m >> 32), __builtin_amdgcn_mbcnt_lo((unsigned)m, 0u)); }

template <int NR>
__device__ __forceinline__ void select_topk(const LAS float* row, int n, LAS unsigned* list, int lane) {
    unsigned v[NR];
#pragma unroll
    for (int r = 0; r < NR; ++r) { const int idx = r * 64 + lane; v[r] = idx < n ? fkey(row[idx]) : 0u; }
    unsigned prefix = 0u;
#pragma unroll 1
    for (int bit = 31; bit >= 0; --bit) {
        const unsigned cand = prefix | (1u << bit); int cnt = 0;
#pragma unroll
        for (int r = 0; r < NR; ++r) cnt += __builtin_popcountll(__ballot(v[r] >= cand));
        if (cnt >= NSEL) prefix = cand;
    }
    const unsigned T = prefix; int cgt = 0;
#pragma unroll
    for (int r = 0; r < NR; ++r) cgt += __builtin_popcountll(__ballot(v[r] > T));
    const int need = NSEL - cgt; int base = 0, ties = 0;
#pragma unroll
    for (int r = 0; r < NR; ++r) { const bool gt = v[r] > T, eq = v[r] == T; const unsigned long long em = __ballot(eq);
        const bool sel = gt || (eq && (ties + mbcnt64(em)) < need); const unsigned long long sm = __ballot(sel);
        if (sel) list[base + mbcnt64(sm)] = (unsigned)(r * 64 + lane);
        base += __builtin_popcountll(sm); ties += __builtin_popcountll(em); }
}

typedef short v4i16 __attribute__((ext_vector_type(4)));
constexpr int VROW = 144;

__device__ __forceinline__ void attn_tile(const Params& P, LAS unsigned char* lds, int b, int t0, int wave, int lane) {
    unsigned char* ws = P.ws;
    const bf16_t* QI = (const bf16_t*)(ws + WS_QI); const bf16_t* KI = (const bf16_t*)(ws + WS_KI);
    const bf16_t* Q = (const bf16_t*)(ws + WS_Q); const bf16_t* Kp = (const bf16_t*)(ws + WS_K); const bf16_t* Vp = (const bf16_t*)(ws + WS_V);
    const float* WI = (const float*)(ws + WS_WI); bf16_t* MIX = (bf16_t*)(ws + WS_MIX);
    LAS float* SC = (LAS float*)lds;
    LAS unsigned* list = (LAS unsigned*)(lds + LDS_MISC + 1024) + wave * 256;
    const int tokbase = b * SEQ;
    const bool need_sel = t0 >= 256;
    if (need_sel) {
        const int nkt = (t0 + 8 + 31) >> 5;
        bf16x8 a[4]; f32x4 w[4];
        { const bf16_t* src = QI + (size_t)(tokbase + t0 + ((lane & 31) >> 2)) * 256 + (lane & 3) * 64 + 8 * (lane >> 5);
#pragma unroll
          for (int ks = 0; ks < 4; ++ks) a[ks] = *(const bf16x8*)(src + 16 * ks); }
#pragma unroll
        for (int g = 0; g < 4; ++g) w[g] = *(const f32x4*)(WI + (size_t)(tokbase + t0 + 2 * g + (lane >> 5)) * 4);
        for (int kt = wave; kt < nkt; kt += NWAVES) {
            const int key = kt * 32 + (lane & 31);
            const bf16_t* ksrc = KI + (size_t)(tokbase + key) * 64 + 8 * (lane >> 5);
            bf16x8 bf[4];
#pragma unroll
            for (int ks = 0; ks < 4; ++ks) bf[ks] = *(const bf16x8*)(ksrc + 16 * ks);
            f32x16 acc;
#pragma unroll
            for (int i = 0; i < 16; ++i) acc[i] = 0.f;
#pragma unroll
            for (int ks = 0; ks < 4; ++ks) acc = __builtin_amdgcn_mfma_f32_32x32x16_bf16(a[ks], bf[ks], acc, 0, 0, 0);
#pragma unroll
            for (int g = 0; g < 4; ++g) { float s = 0.f;
#pragma unroll
                for (int h = 0; h < 4; ++h) s = fmaf(fmaxf(acc[4 * g + h], 0.f), w[g][h], s);
                const int ql = 2 * g + (lane >> 5);
                if (key > t0 + ql) s = -INFINITY;
                SC[ql * 4096 + key] = s; }
        }
    }
    __syncthreads();
    const int t = t0 + wave, tok = tokbase + t;
    if (need_sel) {
        const LAS float* row = SC + wave * 4096; const int n = t + 1;
        if (n <= 1024) select_topk<16>(row, n, list, lane);
        else if (n <= 2048) select_topk<32>(row, n, list, lane);
        else if (n <= 3072) select_topk<48>(row, n, list, lane);
        else select_topk<64>(row, n, list, lane);
    } else {
#pragma unroll
        for (int i = 0; i < 4; ++i) list[i * 64 + lane] = (unsigned)(i * 64 + lane);
    }
    __syncthreads();
    const int nvalid = need_sel ? NSEL : (t + 1);
    const int hd = lane & 15, g = lane >> 4;
    bf16x8 qf0, qf1;
#pragma unroll
    for (int i = 0; i < 8; ++i) { qf0[i] = 0; qf1[i] = 0; }
    if (hd < 8) { const bf16_t* qs = Q + (size_t)tok * 512 + hd * 64 + 8 * g; qf0 = *(const bf16x8*)qs; qf1 = *(const bf16x8*)(qs + 32); }
    float lg[8][2][4];
#pragma unroll
    for (int grp = 0; grp < 8; ++grp) {
        const unsigned ia = list[grp * 32 + hd], ib = list[grp * 32 + 16 + hd];
        const bf16_t* ka = Kp + (size_t)(tokbase + ia) * 64 + 8 * g; const bf16_t* kb = Kp + (size_t)(tokbase + ib) * 64 + 8 * g;
        const bf16x8 ka0 = *(const bf16x8*)ka, ka1 = *(const bf16x8*)(ka + 32), kb0 = *(const bf16x8*)kb, kb1 = *(const bf16x8*)(kb + 32);
        f32x4 sa = {0.f, 0.f, 0.f, 0.f}, sb = {0.f, 0.f, 0.f, 0.f};
        sa = __builtin_amdgcn_mfma_f32_16x16x32_bf16(ka0, qf0, sa, 0, 0, 0); sa = __builtin_amdgcn_mfma_f32_16x16x32_bf16(ka1, qf1, sa, 0, 0, 0);
        sb = __builtin_amdgcn_mfma_f32_16x16x32_bf16(kb0, qf0, sb, 0, 0, 0); sb = __builtin_amdgcn_mfma_f32_16x16x32_bf16(kb1, qf1, sb, 0, 0, 0);
#pragma unroll
        for (int r = 0; r < 4; ++r) { const int sl = grp * 32 + 4 * g + r;
            lg[grp][0][r] = sl < nvalid ? sa[r] * 0.125f : -INFINITY; lg[grp][1][r] = (sl + 16) < nvalid ? sb[r] * 0.125f : -INFINITY; }
    }
    float mx = -INFINITY;
#pragma unroll
    for (int grp = 0; grp < 8; ++grp)
#pragma unroll
        for (int tl = 0; tl < 2; ++tl)
#pragma unroll
            for (int r = 0; r < 4; ++r) mx = fmaxf(mx, lg[grp][tl][r]);
    mx = fmaxf(mx, __shfl_xor(mx, 16)); mx = fmaxf(mx, __shfl_xor(mx, 32));
    float sum = 0.f;
#pragma unroll
    for (int grp = 0; grp < 8; ++grp)
#pragma unroll
        for (int tl = 0; tl < 2; ++tl)
#pragma unroll
            for (int r = 0; r < 4; ++r) { const float pv = __expf(lg[grp][tl][r] - mx); lg[grp][tl][r] = pv; sum += pv; }
    sum += __shfl_xor(sum, 16); sum += __shfl_xor(sum, 32);
    const float inv = 1.0f / sum;
    f32x4 o[4];
#pragma unroll
    for (int dt = 0; dt < 4; ++dt) o[dt] = (f32x4){0.f, 0.f, 0.f, 0.f};
    LAS unsigned char* vreg = lds + wave * 16384;
    u32x4 vv[4];
#pragma unroll
    for (int i = 0; i < 4; ++i) { const unsigned idx = list[(lane >> 3) + 8 * i]; vv[i] = *(const u32x4*)(Vp + (size_t)(tokbase + idx) * 64 + 8 * (lane & 7)); }
#pragma unroll
    for (int grp = 0; grp < 8; ++grp) {
        LAS unsigned char* vbuf = vreg + (grp & 1) * 8192;
#pragma unroll
        for (int i = 0; i < 4; ++i) *(LAS u32x4*)(vbuf + ((lane >> 3) + 8 * i) * VROW + (lane & 7) * 16) = vv[i];
        if (grp < 7) {
#pragma unroll
            for (int i = 0; i < 4; ++i) { const unsigned idx = list[(grp + 1) * 32 + (lane >> 3) + 8 * i]; vv[i] = *(const u32x4*)(Vp + (size_t)(tokbase + idx) * 64 + 8 * (lane & 7)); }
        }
        bf16x8 pf;
        { const unsigned p0 = cvt_pk_bf16(lg[grp][0][0] * inv, lg[grp][0][1] * inv), p1 = cvt_pk_bf16(lg[grp][0][2] * inv, lg[grp][0][3] * inv);
          const unsigned p2 = cvt_pk_bf16(lg[grp][1][0] * inv, lg[grp][1][1] * inv), p3 = cvt_pk_bf16(lg[grp][1][2] * inv, lg[grp][1][3] * inv);
          const u32x4 pw = {p0, p1, p2, p3}; pf = __builtin_bit_cast(bf16x8, pw); }
        LAS unsigned char* ta = vbuf + (4 * g + (hd >> 2)) * VROW + (hd & 3) * 8;
#pragma unroll
        for (int dt = 0; dt < 4; ++dt) {
            const v4i16 lo = __builtin_amdgcn_ds_read_tr16_b64_v4i16((LAS v4i16*)(ta + dt * 32));
            const v4i16 hi = __builtin_amdgcn_ds_read_tr16_b64_v4i16((LAS v4i16*)(ta + 16 * VROW + dt * 32));
            bf16x8 bfv; bfv[0] = lo[0]; bfv[1] = lo[1]; bfv[2] = lo[2]; bfv[3] = lo[3]; bfv[4] = hi[0]; bfv[5] = hi[1]; bfv[6] = hi[2]; bfv[7] = hi[3];
            o[dt] = __builtin_amdgcn_mfma_f32_16x16x32_bf16(pf, bfv, o[dt], 0, 0, 0);
        }
    }
    if (g < 2) {
        bf16_t* op = MIX + (size_t)tok * 1024 + hd;
#pragma unroll
        for (int dt = 0; dt < 4; ++dt)
#pragma unroll
            for (int r = 0; r < 4; ++r) op[(4 * g + r) * 64 + 16 * dt] = (bf16_t)f2bf(o[dt][r]);
    }
    __syncthreads();
}

__device__ __forceinline__ void conv_tile(const Params& P, LAS unsigned char* lds, int tile, int tid, int wave, int lane) {
    unsigned char* ws = P.ws;
    const bf16_t* HG = (const bf16_t*)(ws + WS_HGLU); bf16_t* MIX = (bf16_t*)(ws + WS_MIX);
    LAS f32x2* part = (LAS f32x2*)(lds + LDS_MISC + 1024);
    LAS f32x2* stat = part + 256;
    const int tok0 = tile * 32, t0 = tok0 & (SEQ - 1), c = tid;
    float in[62];
#pragma unroll
    for (int r = 0; r < 62; ++r) { const int tt = t0 - 30 + r; in[r] = tt >= 0 ? __builtin_bit_cast(float, (unsigned)HG[(size_t)(tok0 - 30 + r) * 512 + c] << 16) : 0.f; }
    float out[32];
    const float bias = P.dw_b[c];
#pragma unroll
    for (int i = 0; i < 32; ++i) out[i] = bias;
#pragma unroll
    for (int j = 0; j < 31; ++j) { const float wj = P.dw_w[j * 512 + c];
#pragma unroll
        for (int i = 0; i < 32; ++i) out[i] = fmaf(in[i + j], wj, out[i]); }
#pragma unroll
    for (int i = 0; i < 32; ++i) { const float s1 = wave_sum(out[i]), s2 = wave_sum(out[i] * out[i]); if (lane == 0) part[i * 8 + wave] = (f32x2){s1, s2}; }
    __syncthreads();
    if (tid < 32) { float s1 = 0.f, s2 = 0.f;
#pragma unroll
        for (int w = 0; w < 8; ++w) { const f32x2 pp = part[tid * 8 + w]; s1 += pp.x; s2 += pp.y; }
        const float mean = s1 * (1.0f / 512.0f), var = fmaxf(s2 * (1.0f / 512.0f) - mean * mean, 0.f);
        stat[tid] = (f32x2){mean, 1.0f / sqrtf(var + EPS)}; }
    __syncthreads();
    const float lgc = P.ln_g[c], lbc = P.ln_b[c];
#pragma unroll
    for (int i = 0; i < 32; ++i) { const f32x2 st = stat[i]; const float y = (out[i] - st.x) * st.y * lgc + lbc; const float sl = y * sigmoidf_(y);
        MIX[(size_t)(tok0 + i) * 1024 + 512 + c] = (bf16_t)f2bf(sl); }
    __syncthreads();
}

__device__ __forceinline__ void router_phase(const Params& P, LAS unsigned char* lds, int blk, int G, int tid, int wave, int lane) {
    unsigned char* ws = P.ws;
    const float* h1 = (const float*)(ws + WS_H1); const float* wrg = (const float*)(ws + WS_WRG);
    int* list = (int*)(ws + WS_LIST); float* lscale = (float*)(ws + WS_LSCALE); float* lgate = (float*)(ws + WS_LGATE);
    unsigned* cntg = (unsigned*)(ws + WS_CTL) + CW_CNT;
    LAS float* WL = (LAS float*)lds;
    LAS int* lcnt = (LAS int*)(lds + LDS_MISC + 1024);
    LAS int* gbase = lcnt + 32;
    LAS int* rec_e = gbase + 32;
    LAS int* rec_p = rec_e + 512;
    LAS float* rec_g = (LAS float*)(rec_p + 512);
    LAS float* rec_s = rec_g + 512;
    for (int i = tid; i < 8192; i += NTHR) ((LAS f32x4*)WL)[i] = ((const f32x4*)wrg)[i];
    __syncthreads();
    const int e = lane & 31, kh = lane >> 5;
    const float be = P.b_router[e];
    for (int chunk = blk; chunk < NTOK / 128; chunk += G) {
        if (tid < 32) lcnt[tid] = 0;
        __syncthreads();
#pragma unroll 1
        for (int gi = 0; gi < 2; ++gi) {
            const int tl0 = wave * 16 + gi * 8, tok0 = chunk * 128 + tl0;
            float acc[8], ss[8];
#pragma unroll
            for (int tk = 0; tk < 8; ++tk) { acc[tk] = 0.f; ss[tk] = 0.f; }
#pragma unroll 2
            for (int k4 = 0; k4 < 128; ++k4) {
                const int k = kh * 512 + k4 * 4;
                const float w0 = WL[(k + 0) * 32 + e], w1 = WL[(k + 1) * 32 + e], w2 = WL[(k + 2) * 32 + e], w3 = WL[(k + 3) * 32 + e];
#pragma unroll
                for (int tk = 0; tk < 8; ++tk) { const f32x4 hv = *(const f32x4*)(h1 + (size_t)(tok0 + tk) * DM + k);
                    acc[tk] = fmaf(hv.x, w0, fmaf(hv.y, w1, fmaf(hv.z, w2, fmaf(hv.w, w3, acc[tk]))));
                    ss[tk] = fmaf(hv.x, hv.x, fmaf(hv.y, hv.y, fmaf(hv.z, hv.z, fmaf(hv.w, hv.w, ss[tk])))); }
            }
#pragma unroll
            for (int tk = 0; tk < 8; ++tk) {
                const float a = acc[tk] + __shfl_xor(acc[tk], 32), s = ss[tk] + __shfl_xor(ss[tk], 32);
                const float rs = 1.0f / sqrtf(s * (1.0f / DM) + EPS);
                float val = a * rs + be;
                float tv[4]; int te[4];
#pragma unroll
                for (int r = 0; r < 4; ++r) { float bv = val; int bi = e;
#pragma unroll
                    for (int off = 16; off >= 1; off >>= 1) { const float ov = __shfl_xor(bv, off); const int oi = __shfl_xor(bi, off); if (ov > bv || (ov == bv && oi < bi)) { bv = ov; bi = oi; } }
                    tv[r] = bv; te[r] = bi; if (e == bi) val = -INFINITY; }
                const float e0 = 1.0f, e1 = __expf(tv[1] - tv[0]), e2 = __expf(tv[2] - tv[0]), e3 = __expf(tv[3] - tv[0]);
                const float is = 1.0f / (e0 + e1 + e2 + e3);
                if (lane < 4) { const int myE = lane == 0 ? te[0] : lane == 1 ? te[1] : lane == 2 ? te[2] : te[3];
                    const float myG = (lane == 0 ? e0 : lane == 1 ? e1 : lane == 2 ? e2 : e3) * is;
                    const int lp = atomicAdd((int*)&lcnt[myE], 1);
                    const int si = (tl0 + tk) * 4 + lane; rec_e[si] = myE; rec_p[si] = lp; rec_g[si] = myG; if (lane == 0) rec_s[tl0 + tk] = rs; }
            }
        }
        __syncthreads();
        if (tid < 32) gbase[tid] = (int)atomicAdd(cntg + 64 * tid, (unsigned)lcnt[tid]);
        __syncthreads();
        { const int si = tid, ee = rec_e[si], pos = gbase[ee] + rec_p[si], li = ee * NTOK + pos;
          list[li] = (chunk * 128) * 4 + si; lscale[li] = rec_s[si >> 2]; lgate[li] = rec_g[si]; }
        __syncthreads();
    }
}

__device__ __forceinline__ void combine_phase(const Params& P, int gw, int NGW, int lane) {
    unsigned char* ws = P.ws;
    float* h1 = (float*)(ws + WS_H1); bf16_t* h1b = (bf16_t*)(ws + WS_H1B); const bf16_t* y = (const bf16_t*)(ws + WS_Y); float* rs3 = (float*)(ws + WS_RS3);
    for (int m = gw; m < NTOK; m += NGW) {
        f32x4* hr = (f32x4*)(h1 + (size_t)m * DM) + lane; f32x4 v[4]; float s = 0.f;
#pragma unroll
        for (int j = 0; j < 4; ++j) v[j] = hr[64 * j];
#pragma unroll
        for (int k = 0; k < 4; ++k) { const u32x2* yr = (const u32x2*)(y + (size_t)(m * 4 + k) * DM) + lane;
#pragma unroll
            for (int j = 0; j < 4; ++j) { const u32x2 w = yr[64 * j]; v[j].x += bf_lo(w.x); v[j].y += bf_hi(w.x); v[j].z += bf_lo(w.y); v[j].w += bf_hi(w.y); } }
        u32x2* o8 = (u32x2*)(h1b + (size_t)m * DM) + lane;
#pragma unroll
        for (int j = 0; j < 4; ++j) { hr[64 * j] = v[j]; u32x2 w; w.x = pk2(v[j].x, v[j].y); w.y = pk2(v[j].z, v[j].w); o8[64 * j] = w;
            s += (v[j].x * v[j].x + v[j].y * v[j].y) + (v[j].z * v[j].z + v[j].w * v[j].w); }
        s = wave_sum(s);
        if (lane == 0) rs3[m] = 1.0f / sqrtf(s * (1.0f / DM) + EPS);
    }
}

__device__ __forceinline__ void final_phase(const Params& P, int gw, int NGW, int lane) {
    f32x4 gv[4];
#pragma unroll
    for (int j = 0; j < 4; ++j) gv[j] = *((const f32x4*)P.g_final + lane + 64 * j);
    for (int m = gw; m < NTOK; m += NGW) {
        f32x4* orow = (f32x4*)(P.out + (size_t)m * DM) + lane; f32x4 v[4]; float s = 0.f;
#pragma unroll
        for (int j = 0; j < 4; ++j) { v[j] = orow[64 * j]; s += (v[j].x * v[j].x + v[j].y * v[j].y) + (v[j].z * v[j].z + v[j].w * v[j].w); }
        s = wave_sum(s); const float rs = 1.0f / sqrtf(s * (1.0f / DM) + EPS);
#pragma unroll
        for (int j = 0; j < 4; ++j) orow[64 * j] = v[j] * rs * gv[j];
    }
}

constexpr int NPHASE = 10;
__global__ void __launch_bounds__(NTHR, 2) fwd_kernel(Params P) {
    extern __shared__ __attribute__((aligned(16))) unsigned char lds_raw[];
    LAS unsigned char* lds = (LAS unsigned char*)lds_raw;
    cg::grid_group grid = cg::this_grid();
    const int tid = threadIdx.x, lane = tid & 63, wave = __builtin_amdgcn_readfirstlane(tid >> 6);
    const int G = gridDim.x, bx = blockIdx.x;
    const int vcu = (G % 8 == 0) ? (bx % 8) * (G / 8) + bx / 8 : bx;
    const int gw = vcu * NWAVES + wave, NGW = G * NWAVES;
    unsigned char* ws = P.ws;
    const int lo = P.ph_lo, hi = P.ph_hi;
#define IN(k) (lo <= (k) && (k) < hi)
#define SYNC(k) do { if (IN(k) && IN((k) + 1)) grid.sync(); } while (0)

    if (IN(0)) p0_prologue(P, lds, vcu, G, wave, lane);
    SYNC(0);
    if (IN(1)) {
        { pg8::DenseSched S; S.init((const bf16_t*)(ws + WS_XB), (const bf16_t*)(ws + WS_WIN), NTOK, 2048, 1024, G, bx);
          EpiInProj E{(const float*)(ws + WS_RS1), (const f32x2*)(ws + WS_ROPE), P.glu_b, (bf16_t*)(ws + WS_Q), (bf16_t*)(ws + WS_K), (bf16_t*)(ws + WS_V), (bf16_t*)(ws + WS_QI), (bf16_t*)(ws + WS_KI), (bf16_t*)(ws + WS_HGLU), (float*)(ws + WS_WI)};
          pg8::gemm_phase<EpiInProj, pg8::DenseSched, false>(lds, S, E); }
        { pg8::DenseSched S; S.init((const bf16_t*)(ws + WS_PB), (const bf16_t*)(ws + WS_WP), NTOK, 1024, 256, G, bx);
          EpiBf16Plain E{(bf16_t*)(ws + WS_PJ), 1024};
          pg8::gemm_phase<EpiBf16Plain, pg8::DenseSched, false>(lds, S, E); }
    }
    SYNC(1);
    if (IN(2)) {
        if (G % 8 == 0) { const int b = bx % 8, jb = bx / 8, nbb = G / 8;
            for (int i = 0;; ++i) { const int k = i * nbb + ((i & 1) ? nbb - 1 - jb : jb); if (k >= 512) break; attn_tile(P, lds, b, (511 - k) * 8, wave, lane); } }
        else { for (int tl = bx; tl < 4096; tl += G) attn_tile(P, lds, tl & 7, (511 - (tl >> 3)) * 8, wave, lane); }
        for (int tl = vcu; tl < NTOK / 32; tl += G) conv_tile(P, lds, tl, tid, wave, lane);
    }
    SYNC(2);
    if (IN(3)) {
        pg8::DenseSched S; S.init((const bf16_t*)(ws + WS_MIX), (const bf16_t*)(ws + WS_WOUT), NTOK, 1024, 1024, G, bx);
        EpiOutProj E{P.x, (float*)(ws + WS_H1), (bf16_t*)(ws + WS_H1B)};
        pg8::gemm_phase<EpiOutProj, pg8::DenseSched, false>(lds, S, E);
    }
    SYNC(3);
    if (IN(4)) router_phase(P, lds, vcu, G, tid, wave, lane);
    SYNC(4);
    if (IN(5) || IN(6)) {
        LAS int* tb = (LAS int*)(lds + LDS_MISC); LAS int* cn = tb + 64;
        if (tid == 0) { const unsigned* cntg = (const unsigned*)(ws + WS_CTL) + CW_CNT; int acc = 0;
            for (int e = 0; e < NE; ++e) { const int c = (int)__hip_atomic_load(cntg + 64 * e, __ATOMIC_RELAXED, __HIP_MEMORY_SCOPE_AGENT); tb[e] = acc; cn[e] = c; acc += (c + BM - 1) / BM; }
            tb[NE] = acc; }
        __syncthreads();
        if (IN(5)) {
            pg8::MoeSched S; S.A = (const bf16_t*)(ws + WS_H1B); S.Bt = (const bf16_t*)(ws + WS_WUP); S.K = 1024; S.b_estride = (size_t)2048 * 1024 * 2; S.tb = tb; S.cnt = cn; S.list = (const int*)(ws + WS_LIST);
            S.nN = 8; S.nwg = tb[NE] * 8; S.G = G; S.c = bx; S.gather = true;
            EpiUp E{(const float*)(ws + WS_LSCALE), P.b_up, (bf16_t*)(ws + WS_ACT), tb};
            pg8::gemm_phase<EpiUp, pg8::MoeSched, true>(lds, S, E);
        }
        SYNC(5);
        if (IN(6)) {
            pg8::MoeSched S; S.A = (const bf16_t*)(ws + WS_ACT); S.Bt = (const bf16_t*)(ws + WS_WDOWN); S.K = 1024; S.b_estride = (size_t)1024 * 1024 * 2; S.tb = tb; S.cnt = cn; S.list = (const int*)(ws + WS_LIST);
            S.nN = 4; S.nwg = tb[NE] * 4; S.G = G; S.c = bx; S.gather = false;
            EpiDown E{(const int*)(ws + WS_LIST), (const float*)(ws + WS_LGATE), P.b_down, (bf16_t*)(ws + WS_Y), tb};
            pg8::gemm_phase<EpiDown, pg8::MoeSched, false>(lds, S, E);
        }
    }
    SYNC(6);
    if (IN(7)) combine_phase(P, gw, NGW, lane);
    SYNC(7);
    if (IN(8)) {
        pg8::DenseSched S; S.init((const bf16_t*)(ws + WS_H1B), (const bf16_t*)(ws + WS_WG), NTOK, 1024, 1024, G, bx);
        EpiPle E{(const float*)(ws + WS_H1), (const bf16_t*)(ws + WS_PJ), (const float*)(ws + WS_RS3), P.out};
        pg8::gemm_phase<EpiPle, pg8::DenseSched, false>(lds, S, E);
    }
    SYNC(8);
    if (IN(9)) final_phase(P, gw, NGW, lane);
#undef IN
#undef SYNC
}

#ifndef N_LAUNCH_MODE
#define N_LAUNCH_MODE 0
#endif
extern "C" void kernel_launch(void* const* d_in, const int* in_sizes, int n_in, void* d_out, int out_size, void* d_ws, size_t ws_size, hipStream_t stream) {
    static int grid = 0;
    if (grid == 0) {
        if (n_in != 21 || out_size != NTOK * DM || ws_size < WS_END) { fprintf(stderr, "kernel_launch: unexpected shapes (n_in %d out %d ws %zu)\n", n_in, out_size, ws_size); grid = -1; return; }
        int dev = 0, cus = 0, per_cu = 0;
        (void)hipGetDevice(&dev); (void)hipDeviceGetAttribute(&cus, hipDeviceAttributeMultiprocessorCount, dev);
        (void)hipFuncSetAttribute((const void*)fwd_kernel, hipFuncAttributeMaxDynamicSharedMemorySize, LDS_BYTES);
        if (hipOccupancyMaxActiveBlocksPerMultiprocessor(&per_cu, (const void*)fwd_kernel, NTHR, LDS_BYTES) != hipSuccess || per_cu < 1) { fprintf(stderr, "kernel_launch: occupancy query failed (%d)\n", per_cu); (void)hipGetLastError(); grid = -1; return; }
        grid = cus;
    }
    if (grid < 0) return;
    (void)hipMemsetAsync((char*)d_ws + WS_CTL, 0, CTL_BYTES, stream);
    Params p{};
    p.x = (const float*)d_in[0]; p.p = (const float*)d_in[1]; p.w_in = (const float*)d_in[2]; p.w_out = (const float*)d_in[3]; p.g_mix = (const float*)d_in[4]; p.g_ffn = (const float*)d_in[5];
    p.glu_b = (const float*)d_in[6]; p.dw_w = (const float*)d_in[7]; p.dw_b = (const float*)d_in[8]; p.ln_g = (const float*)d_in[9]; p.ln_b = (const float*)d_in[10];
    p.w_router = (const float*)d_in[11]; p.b_router = (const float*)d_in[12]; p.w_up = (const float*)d_in[13]; p.b_up = (const float*)d_in[14]; p.w_down = (const float*)d_in[15]; p.b_down = (const float*)d_in[16];
    p.w_ple_proj = (const float*)d_in[17]; p.w_ple_gate = (const float*)d_in[18]; p.g_ple = (const float*)d_in[19]; p.g_final = (const float*)d_in[20];
    p.out = (float*)d_out; p.ws = (unsigned char*)d_ws;
#if N_LAUNCH_MODE == 1
    p.ph_lo = 0; p.ph_hi = NPHASE;
    void* args[] = {&p};
    hipError_t e = hipLaunchCooperativeKernel((const void*)fwd_kernel, dim3(grid), dim3(NTHR), args, LDS_BYTES, stream);
    if (e != hipSuccess) fprintf(stderr, "cooperative launch failed: %s (grid %d)\n", hipGetErrorString(e), grid);
#else
    for (int ph = 0; ph < NPHASE; ++ph) {
        p.ph_lo = ph; p.ph_hi = ph + 1;
        void* args[] = {&p};
        hipError_t e = hipLaunchCooperativeKernel((const void*)fwd_kernel, dim3(grid), dim3(NTHR), args, LDS_BYTES, stream);
        if (e != hipSuccess) { fprintf(stderr, "launch %d failed: %s (grid %d)\n", ph, hipGetErrorString(e), grid); break; }
    }
#endif
}
```

```cpp
#include <hip/hip_runtime.h>
#include <hip/hip_cooperative_groups.h>
#include <cstdio>
#include <cstdint>
namespace cg = cooperative_groups;

#define LAS __attribute__((address_space(3)))
#define GAS __attribute__((address_space(1)))
typedef unsigned short bf16_t;
typedef short bf16x8 __attribute__((ext_vector_type(8)));
typedef short s16x4 __attribute__((ext_vector_type(4)));
typedef float f32x4 __attribute__((ext_vector_type(4)));
typedef float f32x2 __attribute__((ext_vector_type(2)));
typedef float f32x16 __attribute__((ext_vector_type(16)));
typedef unsigned u32x4 __attribute__((ext_vector_type(4)));
typedef unsigned u32x2 __attribute__((ext_vector_type(2)));

constexpr int NB = 8, SEQ = 4096, DM = 1024, NTOK = NB * SEQ;
constexpr int NE = 32, TOPK = 4, NSLOT = NTOK * TOPK;
constexpr int INW = 1988;
constexpr int NSEL = 256;
constexpr float EPS = 1e-6f;
constexpr int NWAVES = 8, NTHR = 512;

constexpr size_t MiB = 1u << 20;
constexpr size_t WS_CTL = 0, CTL_BYTES = 64 * 1024;
constexpr size_t WS_ROPE = 1 * MiB;
constexpr size_t WS_WIN = 2 * MiB;
constexpr size_t WS_WOUT = 6 * MiB;
constexpr size_t WS_WG = 8 * MiB;
constexpr size_t WS_WP = 10 * MiB;
constexpr size_t WS_WRG = 10 * MiB + 512 * 1024;
constexpr size_t WS_RS1 = 11 * MiB;
constexpr size_t WS_RS3 = 11 * MiB + 512 * 1024;
constexpr size_t WS_WI = 12 * MiB;
constexpr size_t WS_LIST = 13 * MiB;
constexpr size_t WS_LSCALE = 17 * MiB;
constexpr size_t WS_LGATE = 21 * MiB;
constexpr size_t WS_PB = 25 * MiB;
constexpr size_t WS_WUP = 42 * MiB;
constexpr size_t WS_WDOWN = 170 * MiB;
constexpr size_t WS_H1 = 234 * MiB;
constexpr size_t WS_H1B = 362 * MiB;
constexpr size_t WS_PJ = 426 * MiB;
constexpr size_t WS_XB = 490 * MiB;
constexpr size_t WS_Q = 554 * MiB;
constexpr size_t WS_K = 586 * MiB;
constexpr size_t WS_V = 590 * MiB;
constexpr size_t WS_QI = 594 * MiB;
constexpr size_t WS_KI = 610 * MiB;
constexpr size_t WS_HGLU = 614 * MiB;
constexpr size_t WS_MIX = 646 * MiB;
constexpr size_t WS_ACT = 490 * MiB;
constexpr size_t WS_Y = 762 * MiB;
constexpr size_t WS_END = 1018 * MiB;
static_assert(WS_MIX + (size_t)NTOK * 1024 * 2 <= WS_ACT + (size_t)139264 * 2048 && WS_ACT + (size_t)139264 * 2048 <= WS_Y, "ws map");
constexpr int CW_CNT = 1024;

constexpr int LDS_STAGE = 131072;
constexpr int LDS_MISC = LDS_STAGE;
constexpr int LDS_BYTES = 147456;

__device__ __forceinline__ unsigned f2bf(float f) { unsigned u = __builtin_bit_cast(unsigned, f); return (u + 0x7fffu + ((u >> 16) & 1u)) >> 16; }
__device__ __forceinline__ unsigned pk2(float lo, float hi) { return f2bf(lo) | (f2bf(hi) << 16); }
__device__ __forceinline__ float bf_lo(unsigned w) { return __builtin_bit_cast(float, w << 16); }
__device__ __forceinline__ float bf_hi(unsigned w) { return __builtin_bit_cast(float, w & 0xffff0000u); }
__device__ __forceinline__ float wave_sum(float v) {
#pragma unroll
    for (int o = 1; o < 64; o <<= 1) v += __shfl_xor(v, o);
    return v;
}
__device__ __forceinline__ float sigmoidf_(float x) { return 1.0f / (1.0f + __expf(-x)); }
#define LDS_WAIT() asm volatile("s_waitcnt lgkmcnt(0)" ::: "memory")

struct Params {
    const float* x; const float* p; const float* w_in; const float* w_out; const float* g_mix; const float* g_ffn;
    const float* glu_b; const float* dw_w; const float* dw_b; const float* ln_g; const float* ln_b;
    const float* w_router; const float* b_router; const float* w_up; const float* b_up; const float* w_down; const float* b_down;
    const float* w_ple_proj; const float* w_ple_gate; const float* g_ple; const float* g_final;
    float* out; unsigned char* ws;
    int ph_lo, ph_hi;
};

namespace pg8 {
constexpr int BM = 256, BK = 64, HALF = 128, HTB = HALF * BK * 2, STAGE_BYTES = 8 * HTB, NXCD = 8, WGM = 8;
__host__ __device__ __forceinline__ int lds_byte(int r, int c) { const int st = (r >> 4) * 2 + (c >> 5), rr = r & 15, cc = c & 31, ob = rr * 64 + cc * 2; return st * 1024 + (ob ^ (((ob >> 9) & 1) << 5)); }
__host__ __device__ __forceinline__ void stage_rc(int b, int& R, int& C) { const int st = b / 1024, sb = b % 1024, swz = sb ^ (((sb >> 9) & 1) << 5); R = (st >> 1) * 16 + swz / 64; C = (st & 1) * 32 + (swz % 64) / 2; }
__host__ __device__ __forceinline__ int perm32(int rho) { const int n = rho >> 4, i = rho & 15; return 8 * (i >> 2) + 4 * n + (i & 3); }

struct Unit { int pm, pn, e, rows; };

__device__ __forceinline__ unsigned cvt_pk_bf16(float lo, float hi) { unsigned r; asm volatile("v_cvt_pk_bf16_f32 %0, %1, %2" : "=v"(r) : "v"(lo), "v"(hi)); return r; }

struct DenseSched {
    const bf16_t* A; const bf16_t* Bt; int K;
    int nM, nN, nwg, G, c;
    __device__ void init(const bf16_t* A_, const bf16_t* Bt_, int M, int N, int K_, int G_, int c_) { A = A_; Bt = Bt_; K = K_; nM = M / BM; nN = N / BM; nwg = nM * nN; G = G_; c = c_; }
    __device__ bool next(int i, Unit& u) const {
        const long L = (long)i * G + c; if (L >= nwg) return false;
        int wgid = (int)L; { const int q = nwg / NXCD, r = nwg % NXCD, xcd = wgid % NXCD, off = wgid / NXCD; wgid = (xcd < r ? xcd * (q + 1) : r * (q + 1) + (xcd - r) * q) + off; }
        const int nig = WGM * nN, gid = wgid / nig, fm = gid * WGM, gsz = (nM - fm) < WGM ? (nM - fm) : WGM;
        u.pm = fm + ((wgid % nig) % gsz); u.pn = (wgid % nig) / gsz; u.e = 0; u.rows = BM; return true;
    }
    __device__ __forceinline__ const char* a_ptr(const Unit& u) const { return (const char*)A + (size_t)u.pm * BM * K * 2; }
    __device__ __forceinline__ const char* b_ptr(const Unit& u) const { return (const char*)Bt + (size_t)u.pn * BM * K * 2; }
    __device__ __forceinline__ int a_row(const Unit&, int) const { return 0; }
};

struct MoeSched {
    const bf16_t* A; const bf16_t* Bt; int K; size_t b_estride;
    const LAS int* tb;
    const LAS int* cnt;
    const int* list;
    int nN, nwg, G, c; bool gather;
    __device__ bool next(int i, Unit& u) const {
        const long L = (long)i * G + c; if (L >= nwg) return false;
        int wgid = (int)L; { const int q = nwg / NXCD, r = nwg % NXCD, xcd = wgid % NXCD, off = wgid / NXCD; wgid = (xcd < r ? xcd * (q + 1) : r * (q + 1) + (xcd - r) * q) + off; }
        int e = 0;
#pragma unroll 1
        for (; e < NE - 1; ++e) { if (wgid < tb[e + 1] * nN) break; }
        const int local = wgid - tb[e] * nN, nM = tb[e + 1] - tb[e];
        const int nig = WGM * nN, gid = local / nig, fm = gid * WGM, gsz = (nM - fm) < WGM ? (nM - fm) : WGM;
        const int rt = fm + ((local % nig) % gsz);
        u.pm = tb[e] + rt; u.pn = (local % nig) / gsz; u.e = e;
        const int left = cnt[e] - rt * BM; u.rows = left < BM ? left : BM; return true;
    }
    __device__ __forceinline__ const char* a_ptr(const Unit& u) const { return gather ? (const char*)A : (const char*)A + (size_t)u.pm * BM * K * 2; }
    __device__ __forceinline__ const char* b_ptr(const Unit& u) const { return (const char*)Bt + (size_t)u.e * b_estride + (size_t)u.pn * BM * K * 2; }
    __device__ __forceinline__ int a_row(const Unit& u, int r) const {
        const int rt = u.pm - tb[u.e];
        return r < u.rows ? (list[u.e * NTOK + rt * BM + r] >> 2) : 0;
    }
};

template <class Epi, class Sched, bool GATHER>
__device__ __forceinline__ void gemm_phase(LAS unsigned char* lds, const Sched& S, const Epi& E) {
    const int tid = threadIdx.x, wid = __builtin_amdgcn_readfirstlane(tid >> 6), lane = tid & 63, wr = wid >> 2, wc = wid & 3, fr = lane & 15, fq = lane >> 4;
    const int K = S.K, nt = K / BK;
    unsigned voffA[2], voffB[2]; int RA[2], CA[2];
#pragma unroll
    for (int i = 0; i < 2; ++i) { int R, C; stage_rc(tid * 16 + i * 8192, R, C); const int Rb = Epi::PERM ? ((R & ~31) + perm32(R & 31)) : R;
        voffA[i] = (unsigned)(R * K + C) * 2u; voffB[i] = (unsigned)(Rb * K + C) * 2u; RA[i] = R; CA[i] = C; }
    const size_t kstep = (size_t)(BK * 2);
    const size_t hstep = (size_t)HALF * K * 2;
    const unsigned ldsw = (unsigned)wid * 1024u;
    const int aoff = lds_byte(wr * 64 + fr, fq * 8), boff = lds_byte(wc * 32 + fr, fq * 8);
    unsigned gC[2][2], gN[2][2];
#define PG8_SA(b, h) (((b) * 2 + (h)) * HTB)
#define PG8_SB(b, h) ((4 + (b) * 2 + (h)) * HTB)
#define PG8_STAGE(bufoff, gbase, voff) do { _Pragma("unroll") for (int _i = 0; _i < 2; ++_i) \
        __builtin_amdgcn_global_load_lds((const unsigned*)((const char*)(gbase) + (voff)[_i]), (LAS unsigned*)(lds + (bufoff) + ldsw + _i * 8192), 16, 0, 0); } while (0)
#define PG8_STAGE_A(bufoff, kp, h) do { if constexpr (GATHER) { PG8_STAGE(bufoff, kp, gC[h]); } else { PG8_STAGE(bufoff, (kp) + (h) * hstep, voffA); } } while (0)
#define PG8_LDA(dst, b, h) do { _Pragma("unroll") for (int m = 0; m < 4; ++m) _Pragma("unroll") for (int k = 0; k < 2; ++k) dst[m][k] = *(const LAS bf16x8*)(lds + PG8_SA(b, h) + aoff + m * 2048 + k * 1024); } while (0)
#define PG8_LDB(dst, b, h) do { _Pragma("unroll") for (int n = 0; n < 2; ++n) _Pragma("unroll") for (int k = 0; k < 2; ++k) dst[n][k] = *(const LAS bf16x8*)(lds + PG8_SB(b, h) + boff + n * 2048 + k * 1024); } while (0)
#define PG8_MMA(ai, bj, At, Bt) do { __builtin_amdgcn_s_setprio(1); _Pragma("unroll") for (int m = 0; m < 4; ++m) _Pragma("unroll") for (int n = 0; n < 2; ++n) _Pragma("unroll") for (int k = 0; k < 2; ++k) \
        acc[ai][bj][m][n] = __builtin_amdgcn_mfma_f32_16x16x32_bf16(Bt[n][k], At[m][k], acc[ai][bj][m][n], 0, 0, 0); __builtin_amdgcn_s_setprio(0); } while (0)
#define PG8_WAIT_V(n) asm volatile("s_waitcnt vmcnt(" #n ")" ::: "memory")
#define PG8_WAIT_L(n) asm volatile("s_waitcnt lgkmcnt(" #n ")" ::: "memory")
#define PG8_BAR __builtin_amdgcn_s_barrier()
#define PG8_SCHED __builtin_amdgcn_sched_barrier(0)
#define PG8_GOFF(dst, u) do { _Pragma("unroll") for (int _h = 0; _h < 2; ++_h) _Pragma("unroll") for (int _i = 0; _i < 2; ++_i) \
        dst[_h][_i] = (unsigned)(S.a_row(u, _h * HALF + RA[_i]) * K + CA[_i]) * 2u; } while (0)
    Unit cur, nxt, nn; int ui = 0;
    if (!S.next(0, cur)) return;
    bool has_next = S.next(1, nxt);
    if constexpr (GATHER) { PG8_GOFF(gC, cur); if (has_next) { PG8_GOFF(gN, nxt); } else { PG8_GOFF(gN, cur); } }
    f32x4 acc[2][2][4][2];
#pragma unroll
    for (int a = 0; a < 2; ++a)
#pragma unroll
        for (int b = 0; b < 2; ++b)
#pragma unroll
            for (int m = 0; m < 4; ++m)
#pragma unroll
                for (int n = 0; n < 2; ++n) acc[a][b][m][n] = (f32x4){0.f, 0.f, 0.f, 0.f};
    bf16x8 At[4][2], B0[2][2], B1[2][2];
    const char* cA = S.a_ptr(cur); const char* cB = S.b_ptr(cur);
    PG8_STAGE(PG8_SB(0, 0), cB, voffB); PG8_STAGE(PG8_SB(0, 1), cB + hstep, voffB); PG8_STAGE_A(PG8_SA(0, 0), cA, 0); PG8_STAGE_A(PG8_SA(0, 1), cA, 1);
    if (wr == 1) PG8_BAR;
    PG8_WAIT_V(2); PG8_BAR;
    PG8_STAGE(PG8_SB(1, 0), cB + kstep, voffB); PG8_STAGE_A(PG8_SA(1, 0), cA + kstep, 0); PG8_STAGE(PG8_SB(1, 1), cB + hstep + kstep, voffB);
    PG8_WAIT_V(6); PG8_BAR;
    for (;;) {
        const char* nA = has_next ? S.a_ptr(nxt) : cA; const char* nB = has_next ? S.b_ptr(nxt) : cB;
        for (int t = 0; t < nt; t += 2) {
            const bool last = (t == nt - 2);
            const char* a1 = cA + (size_t)(t + 1) * kstep;
            const char* a2 = last ? nA : cA + (size_t)(t + 2) * kstep; const char* b2 = last ? nB : cB + (size_t)(t + 2) * kstep;
            const char* a3 = a2 + kstep; const char* b3 = b2 + kstep;
            PG8_LDB(B0, 0, 0); PG8_LDB(B1, 0, 1); PG8_SCHED; PG8_LDA(At, 0, 0); PG8_STAGE_A(PG8_SA(1, 1), a1, 1);
            if constexpr (GATHER) { if (last) {
#pragma unroll
                for (int h = 0; h < 2; ++h)
#pragma unroll
                    for (int i = 0; i < 2; ++i) gC[h][i] = gN[h][i]; } }
            PG8_WAIT_V(8); PG8_WAIT_L(0); PG8_BAR; PG8_MMA(0, 0, At, B0); PG8_MMA(0, 1, At, B1); PG8_BAR; PG8_SCHED;
            PG8_LDA(At, 0, 1); PG8_STAGE(PG8_SB(0, 0), b2, voffB); PG8_STAGE(PG8_SB(0, 1), b2 + hstep, voffB); PG8_STAGE_A(PG8_SA(0, 0), a2, 0);
            PG8_WAIT_V(8); PG8_WAIT_L(0); PG8_BAR; PG8_MMA(1, 0, At, B0); PG8_MMA(1, 1, At, B1); PG8_BAR; PG8_SCHED;
            PG8_LDB(B0, 1, 0); PG8_LDB(B1, 1, 1); PG8_SCHED; PG8_LDA(At, 1, 0); PG8_STAGE_A(PG8_SA(0, 1), a2, 1);
            PG8_WAIT_V(8); PG8_WAIT_L(0); PG8_BAR; PG8_MMA(0, 0, At, B0); PG8_MMA(0, 1, At, B1); PG8_BAR; PG8_SCHED;
            PG8_LDA(At, 1, 1); PG8_STAGE(PG8_SB(1, 0), b3, voffB); PG8_STAGE(PG8_SB(1, 1), b3 + hstep, voffB); PG8_STAGE_A(PG8_SA(1, 0), a3, 0);
            PG8_WAIT_V(8); PG8_WAIT_L(0); PG8_BAR; PG8_MMA(1, 0, At, B0); PG8_MMA(1, 1, At, B1); PG8_BAR; PG8_SCHED;
        }
        if (wr == 0) PG8_BAR;
        bool has_nn = false;
        if constexpr (GATHER) { if (has_next) { has_nn = S.next(ui + 2, nn); if (has_nn) { PG8_GOFF(gN, nn); } } }
        else { if (has_next) has_nn = S.next(ui + 2, nn); }
        E(acc, cur, wr, wc, fr, fq);
        if (!has_next) break;
#pragma unroll
        for (int a = 0; a < 2; ++a)
#pragma unroll
            for (int b = 0; b < 2; ++b)
#pragma unroll
                for (int m = 0; m < 4; ++m)
#pragma unroll
                    for (int n = 0; n < 2; ++n) acc[a][b][m][n] = (f32x4){0.f, 0.f, 0.f, 0.f};
        cur = nxt; cA = nA; cB = nB; ++ui; nxt = nn; has_next = has_nn;
        if (wr == 1) PG8_BAR;
    }
    PG8_WAIT_V(0);
    PG8_BAR;
#undef PG8_SA
#undef PG8_SB
#undef PG8_STAGE
#undef PG8_STAGE_A
#undef PG8_LDA
#undef PG8_LDB
#undef PG8_MMA
#undef PG8_WAIT_V
#undef PG8_WAIT_L
#undef PG8_BAR
#undef PG8_SCHED
#undef PG8_GOFF
}
}

using pg8::Unit; using pg8::cvt_pk_bf16;
constexpr int BM = 256, HALF = 128;

struct EpiInProj {
    static constexpr bool PERM = true;
    const float* rs1; const f32x2* rope; const float* glu_b;
    bf16_t *q, *k, *v, *qi, *ki, *hglu; float* wi;
    __device__ __forceinline__ void operator()(const f32x4 (&acc)[2][2][4][2], const Unit& u, int wr, int wc, int fr, int fq) const {
        const int row0 = u.pm * BM + wr * 64 + fr;
        if (u.pn >= 4) {
            const int ch = 128 * (u.pn - 4) + 32 * wc + 8 * fq;
            f32x4 ba[2], bg[2];
#pragma unroll
            for (int n = 0; n < 2; ++n) { ba[n] = *(const f32x4*)(glu_b + ch + 4 * n); bg[n] = *(const f32x4*)(glu_b + 512 + ch + 4 * n); }
#pragma unroll
            for (int ai = 0; ai < 2; ++ai)
#pragma unroll
                for (int m = 0; m < 4; ++m) { const int row = row0 + ai * HALF + m * 16; const float rs = rs1[row];
                    float o[8];
#pragma unroll
                    for (int n = 0; n < 2; ++n)
#pragma unroll
                        for (int e = 0; e < 4; ++e) { const float a = acc[ai][0][m][n][e] * rs + ba[n][e], g = acc[ai][1][m][n][e] * rs + bg[n][e]; o[4 * n + e] = a * sigmoidf_(g); }
                    u32x4 w; w.x = cvt_pk_bf16(o[0], o[1]); w.y = cvt_pk_bf16(o[2], o[3]); w.z = cvt_pk_bf16(o[4], o[5]); w.w = cvt_pk_bf16(o[6], o[7]);
                    *(u32x4*)(hglu + (size_t)row * 512 + ch) = w; }
            return;
        }
        bf16_t* dst; int ld, col; bool do_rope = true, is_wi = false;
        if (u.pn < 2) { dst = q; ld = 512; col = (4 * u.pn + wc) * 64; }
        else if (u.pn == 2) { dst = qi; ld = 256; col = wc * 64; }
        else { ld = 64; col = 0; if (wc == 0) dst = k; else if (wc == 1) dst = ki; else if (wc == 2) { dst = v; do_rope = false; } else { dst = v; is_wi = true; do_rope = false; } }
        if (is_wi) {
            if (fq == 0) {
#pragma unroll
                for (int ai = 0; ai < 2; ++ai)
#pragma unroll
                    for (int m = 0; m < 4; ++m) { const int row = row0 + ai * HALF + m * 16; const float rs = rs1[row];
                        *(f32x4*)(wi + (size_t)row * 4) = acc[ai][0][m][0] * rs; }
            }
            return;
        }
        const int d0 = 8 * fq;
#pragma unroll
        for (int ai = 0; ai < 2; ++ai)
#pragma unroll
            for (int m = 0; m < 4; ++m) { const int row = row0 + ai * HALF + m * 16; const float rs = rs1[row];
                float o1[8], o2[8];
                if (do_rope) {
                    const f32x2* rp = rope + (size_t)(row & (SEQ - 1)) * 32 + d0;
#pragma unroll
                    for (int n = 0; n < 2; ++n)
#pragma unroll
                        for (int e = 0; e < 4; ++e) { const f32x2 cs = rp[4 * n + e]; const float x1 = acc[ai][0][m][n][e] * rs, x2 = acc[ai][1][m][n][e] * rs;
                            o1[4 * n + e] = x1 * cs.x - x2 * cs.y; o2[4 * n + e] = x2 * cs.x + x1 * cs.y; }
                } else {
#pragma unroll
                    for (int n = 0; n < 2; ++n)
#pragma unroll
                        for (int e = 0; e < 4; ++e) { o1[4 * n + e] = acc[ai][0][m][n][e] * rs; o2[4 * n + e] = acc[ai][1][m][n][e] * rs; }
                }
                u32x4 w1, w2; w1.x = cvt_pk_bf16(o1[0], o1[1]); w1.y = cvt_pk_bf16(o1[2], o1[3]); w1.z = cvt_pk_bf16(o1[4], o1[5]); w1.w = cvt_pk_bf16(o1[6], o1[7]);
                w2.x = cvt_pk_bf16(o2[0], o2[1]); w2.y = cvt_pk_bf16(o2[2], o2[3]); w2.z = cvt_pk_bf16(o2[4], o2[5]); w2.w = cvt_pk_bf16(o2[6], o2[7]);
                bf16_t* rp2 = dst + (size_t)row * ld + col + d0;
                *(u32x4*)(rp2) = w1; *(u32x4*)(rp2 + 32) = w2; }
    }
};

struct EpiBf16Plain {
    static constexpr bool PERM = true;
    bf16_t* O; int ldc;
    __device__ __forceinline__ void operator()(const f32x4 (&acc)[2][2][4][2], const Unit& u, int wr, int wc, int fr, int fq) const {
        const int row0 = u.pm * BM + wr * 64 + fr, col0 = u.pn * BM + wc * 32 + 8 * fq;
#pragma unroll
        for (int ai = 0; ai < 2; ++ai)
#pragma unroll
            for (int m = 0; m < 4; ++m) { bf16_t* rowp = O + (size_t)(row0 + ai * HALF + m * 16) * ldc + col0;
#pragma unroll
                for (int bj = 0; bj < 2; ++bj) { const f32x4 v0 = acc[ai][bj][m][0], v1 = acc[ai][bj][m][1];
                    u32x4 w; w.x = cvt_pk_bf16(v0[0], v0[1]); w.y = cvt_pk_bf16(v0[2], v0[3]); w.z = cvt_pk_bf16(v1[0], v1[1]); w.w = cvt_pk_bf16(v1[2], v1[3]);
                    *(u32x4*)(rowp + bj * HALF) = w; } }
    }
};

struct EpiOutProj {
    static constexpr bool PERM = false;
    const float* x; float* h1; bf16_t* h1b;
    __device__ __forceinline__ void operator()(const f32x4 (&acc)[2][2][4][2], const Unit& u, int wr, int wc, int fr, int fq) const {
        const int row0 = u.pm * BM + wr * 64 + fr, col0 = u.pn * BM + wc * 32 + 4 * fq;
#pragma unroll
        for (int ai = 0; ai < 2; ++ai)
#pragma unroll
            for (int m = 0; m < 4; ++m) { const size_t off = (size_t)(row0 + ai * HALF + m * 16) * DM + col0;
#pragma unroll
                for (int bj = 0; bj < 2; ++bj)
#pragma unroll
                    for (int n = 0; n < 2; ++n) { const size_t o = off + bj * HALF + n * 16; const f32x4 r = *(const f32x4*)(x + o) + acc[ai][bj][m][n];
                        *(f32x4*)(h1 + o) = r; u32x2 w; w.x = cvt_pk_bf16(r[0], r[1]); w.y = cvt_pk_bf16(r[2], r[3]); *(u32x2*)(h1b + o) = w; } }
    }
};

struct EpiUp {
    static constexpr bool PERM = true;
    const float* lscale; const float* b_up; bf16_t* act; const LAS int* tb;
    __device__ __forceinline__ void operator()(const f32x4 (&acc)[2][2][4][2], const Unit& u, int wr, int wc, int fr, int fq) const {
        const int r0 = wr * 64 + fr, ch = 128 * u.pn + 32 * wc + 8 * fq, rt = u.pm - tb[u.e];
        const float* bu = b_up + (size_t)u.e * 2048;
        f32x4 bg[2], bl[2];
#pragma unroll
        for (int n = 0; n < 2; ++n) { bg[n] = *(const f32x4*)(bu + ch + 4 * n); bl[n] = *(const f32x4*)(bu + 1024 + ch + 4 * n); }
#pragma unroll
        for (int ai = 0; ai < 2; ++ai)
#pragma unroll
            for (int m = 0; m < 4; ++m) { const int r = r0 + ai * HALF + m * 16;
                const float rs = (r < u.rows) ? lscale[u.e * NTOK + rt * BM + r] : 0.f;
                float o[8];
#pragma unroll
                for (int n = 0; n < 2; ++n)
#pragma unroll
                    for (int e = 0; e < 4; ++e) { float g = acc[ai][0][m][n][e] * rs + bg[n][e], l = acc[ai][1][m][n][e] * rs + bl[n][e];
                        g = fminf(g, 7.0f); l = fminf(fmaxf(l, -7.0f), 7.0f); o[4 * n + e] = g * sigmoidf_(1.702f * g) * (l + 1.0f); }
                u32x4 w; w.x = cvt_pk_bf16(o[0], o[1]); w.y = cvt_pk_bf16(o[2], o[3]); w.z = cvt_pk_bf16(o[4], o[5]); w.w = cvt_pk_bf16(o[6], o[7]);
                *(u32x4*)(act + (size_t)(u.pm * BM + r) * 1024 + ch) = w; }
    }
};

struct EpiDown {
    static constexpr bool PERM = true;
    const int* list; const float* lgate; const float* b_down; bf16_t* y; const LAS int* tb;
    __device__ __forceinline__ void operator()(const f32x4 (&acc)[2][2][4][2], const Unit& u, int wr, int wc, int fr, int fq) const {
        const int r0 = wr * 64 + fr, col0 = u.pn * BM + wc * 32 + 8 * fq, rt = u.pm - tb[u.e];
        const float* bd = b_down + (size_t)u.e * 1024;
        f32x4 bv[2][2];
#pragma unroll
        for (int bj = 0; bj < 2; ++bj)
#pragma unroll
            for (int n = 0; n < 2; ++n) bv[bj][n] = *(const f32x4*)(bd + col0 + bj * HALF + 4 * n);
#pragma unroll
        for (int ai = 0; ai < 2; ++ai)
#pragma unroll
            for (int m = 0; m < 4; ++m) { const int r = r0 + ai * HALF + m * 16;
                if (r < u.rows) { const int li = u.e * NTOK + rt * BM + r; const int slot = list[li]; const float g = lgate[li];
                    bf16_t* rowp = y + (size_t)slot * 1024 + col0;
#pragma unroll
                    for (int bj = 0; bj < 2; ++bj) { const f32x4 v0 = (acc[ai][bj][m][0] + bv[bj][0]) * g, v1 = (acc[ai][bj][m][1] + bv[bj][1]) * g;
                        u32x4 w; w.x = cvt_pk_bf16(v0[0], v0[1]); w.y = cvt_pk_bf16(v0[2], v0[3]); w.z = cvt_pk_bf16(v1[0], v1[1]); w.w = cvt_pk_bf16(v1[2], v1[3]);
                        *(u32x4*)(rowp + bj * HALF) = w; } } }
    }
};

struct EpiPle {
    static constexpr bool PERM = false;
    const float* h2; const bf16_t* pj; const float* rs3; float* out;
    __device__ __forceinline__ void operator()(const f32x4 (&acc)[2][2][4][2], const Unit& u, int wr, int wc, int fr, int fq) const {
        const int row0 = u.pm * BM + wr * 64 + fr, col0 = u.pn * BM + wc * 32 + 4 * fq;
#pragma unroll
        for (int ai = 0; ai < 2; ++ai)
#pragma unroll
            for (int m = 0; m < 4; ++m) { const int row = row0 + ai * HALF + m * 16; const size_t off = (size_t)row * DM + col0; const float rs = rs3[row];
#pragma unroll
                for (int bj = 0; bj < 2; ++bj)
#pragma unroll
                    for (int n = 0; n < 2; ++n) { const size_t o = off + bj * HALF + n * 16; const f32x4 hv = *(const f32x4*)(h2 + o); const u32x2 pw = *(const u32x2*)(pj + o);
                        const f32x4 a = acc[ai][bj][m][n]; f32x4 r;
                        r[0] = hv[0] + bf_lo(pw.x) * sigmoidf_(a[0] * rs); r[1] = hv[1] + bf_hi(pw.x) * sigmoidf_(a[1] * rs);
                        r[2] = hv[2] + bf_lo(pw.y) * sigmoidf_(a[2] * rs); r[3] = hv[3] + bf_hi(pw.y) * sigmoidf_(a[3] * rs);
                        *(f32x4*)(out + o) = r; } }
    }
};

__device__ __forceinline__ void p0_transpose_item(const float* W, int ldw, bf16_t* WT, int Kdim, const float* gain, LAS float* scr, int kb, int n0, int src0, int nvalid, int lane) {
    const int k0 = 64 * kb;
#pragma unroll 8
    for (int i = 0; i < 32; ++i) { const int kk = 2 * i + (lane >> 5), j = lane & 31;
        float v = 0.f; if (j < nvalid) { v = W[(size_t)(k0 + kk) * ldw + src0 + j]; if (gain) v *= gain[k0 + kk]; }
        scr[kk * 33 + j] = v; }
    LDS_WAIT(); asm volatile("" ::: "memory");
    const int c = lane & 7;
#pragma unroll
    for (int j = 0; j < 4; ++j) { const int n = (lane >> 3) + 8 * j; const LAS float* s = scr + (8 * c) * 33 + n;
        u32x4 o; o.x = pk2(s[0 * 33], s[1 * 33]); o.y = pk2(s[2 * 33], s[3 * 33]); o.z = pk2(s[4 * 33], s[5 * 33]); o.w = pk2(s[6 * 33], s[7 * 33]);
        *(u32x4*)(WT + (size_t)(n0 + n) * Kdim + k0 + 8 * c) = o; }
    LDS_WAIT(); asm volatile("" ::: "memory");
}
__device__ __forceinline__ void win_colmap(int nb, int& src0, int& nvalid) {
    const int pn = nb >> 3, j = (nb & 7) * 32, bj = j >> 7, slot = (j & 127) >> 5;
    nvalid = 32;
    if (pn < 2) src0 = (4 * pn + slot) * 64 + 32 * bj;
    else if (pn == 2) src0 = 640 + slot * 64 + 32 * bj;
    else if (pn == 3) { if (slot == 0) src0 = 512 + 32 * bj; else if (slot == 1) src0 = 896 + 32 * bj; else if (slot == 2) src0 = 576 + 32 * bj; else { src0 = 960; nvalid = bj == 0 ? 4 : 0; } }
    else src0 = 964 + 512 * bj + 128 * (pn - 4) + 32 * slot;
}
__device__ __forceinline__ void p0_prologue(const Params& P, LAS unsigned char* lds, int vcu, int G, int wave, int lane) {
    unsigned char* ws = P.ws;
    LAS float* scr = (LAS float*)(lds + wave * 16384);
    const int gw = vcu * NWAVES + wave, NGW = G * NWAVES;
    constexpr int I_IN = 16 * 64, I_OUT = 16 * 32, I_G = 16 * 32, I_P = 4 * 32, I_UP = 32 * 16 * 64, I_DN = 32 * 16 * 32;
    constexpr int NITEMS = I_IN + I_OUT + I_G + I_P + I_UP + I_DN;
    for (int it = gw; it < NITEMS; it += NGW) {
        int r = it;
        if (r < I_IN) { const int kb = r / 64, nb = r % 64; int s0, nv; win_colmap(nb, s0, nv); p0_transpose_item(P.w_in, INW, (bf16_t*)(ws + WS_WIN), 1024, P.g_mix, scr, kb, nb * 32, s0, nv, lane); continue; } r -= I_IN;
        if (r < I_OUT) { const int kb = r / 32, nb = r % 32; p0_transpose_item(P.w_out, 1024, (bf16_t*)(ws + WS_WOUT), 1024, nullptr, scr, kb, nb * 32, nb * 32, 32, lane); continue; } r -= I_OUT;
        if (r < I_G) { const int kb = r / 32, nb = r % 32; p0_transpose_item(P.w_ple_gate, 1024, (bf16_t*)(ws + WS_WG), 1024, P.g_ple, scr, kb, nb * 32, nb * 32, 32, lane); continue; } r -= I_G;
        if (r < I_P) { const int kb = r / 32, nb = r % 32; p0_transpose_item(P.w_ple_proj, 1024, (bf16_t*)(ws + WS_WP), 256, nullptr, scr, kb, nb * 32, nb * 32, 32, lane); continue; } r -= I_P;
        if (r < I_UP) { const int e = r / 1024, rr = r % 1024, kb = rr / 64, nb = rr % 64;
            const int pn = nb >> 3, j = (nb & 7) * 32, bj = j >> 7, jj = j & 127;
            p0_transpose_item(P.w_up + (size_t)e * 1024 * 2048, 2048, (bf16_t*)(ws + WS_WUP) + (size_t)e * 2048 * 1024, 1024, P.g_ffn, scr, kb, nb * 32, 1024 * bj + 128 * pn + jj, 32, lane); continue; } r -= I_UP;
        { const int e = r / 512, rr = r % 512, kb = rr / 32, nb = rr % 32;
            p0_transpose_item(P.w_down + (size_t)e * 1024 * 1024, 1024, (bf16_t*)(ws + WS_WDOWN) + (size_t)e * 1024 * 1024, 1024, nullptr, scr, kb, nb * 32, nb * 32, 32, lane); }
    }
    float* rs1 = (float*)(ws + WS_RS1); bf16_t* xb = (bf16_t*)(ws + WS_XB);
    for (int m = gw; m < NTOK; m += NGW) {
        const f32x4* xr = (const f32x4*)(P.x + (size_t)m * DM) + lane; f32x4 v[4]; float s = 0.f;
#pragma unroll
        for (int j = 0; j < 4; ++j) { v[j] = xr[64 * j]; s += (v[j].x * v[j].x + v[j].y * v[j].y) + (v[j].z * v[j].z + v[j].w * v[j].w); }
        s = wave_sum(s);
        u32x2* o8 = (u32x2*)(xb + (size_t)m * DM) + lane;
#pragma unroll
        for (int j = 0; j < 4; ++j) { u32x2 w; w.x = pk2(v[j].x, v[j].y); w.y = pk2(v[j].z, v[j].w); o8[64 * j] = w; }
        if (lane == 0) rs1[m] = 1.0f / sqrtf(s * (1.0f / DM) + EPS);
    }
    bf16_t* pb = (bf16_t*)(ws + WS_PB);
    for (int m = gw; m < NTOK; m += NGW) { const f32x4 v = *((const f32x4*)(P.p + (size_t)m * 256) + lane); u32x2 w; w.x = pk2(v.x, v.y); w.y = pk2(v.z, v.w); *((u32x2*)(pb + (size_t)m * 256) + lane) = w; }
    f32x2* rope = (f32x2*)(ws + WS_ROPE);
    for (int idx = gw * 64 + lane; idx < SEQ * 32; idx += NGW * 64) { const int t = idx >> 5, i = idx & 31;
        const float inv = exp2f(-(float)i * (13.287712379549449f / 32.0f));
        const float ang = (float)t * inv;
        const double rev = (double)ang * 0.15915494309189535; const float fr = (float)(rev - __builtin_floor(rev));
        rope[idx] = (f32x2){__builtin_amdgcn_cosf(fr), __builtin_amdgcn_sinf(fr)}; }
    float* wrg = (float*)(ws + WS_WRG);
    for (int idx = gw * 64 + lane; idx < 1024 * 32; idx += NGW * 64) wrg[idx] = P.w_router[idx] * P.g_ffn[idx >> 5];
}

__device__ __forceinline__ unsigned fkey(float f) { unsigned u = __builtin_bit_cast(unsigned, f); if (u == 0x80000000u) u = 0u; return u ^ ((unsigned)((int)u >> 31) | 0x80000000u); }
__device__ __forceinline__ int mbcnt64(unsigned long long m) { return __builtin_amdgcn_mbcnt_hi((unsigned)(m >> 32), __builtin_amdgcn_mbcnt_lo((unsigned)m, 0u)); }

template <int NR>
__device__ __forceinline__ void select_topk(const LAS float* row, int n, LAS unsigned* list, int lane) {
    unsigned v[NR];
#pragma unroll
    for (int r = 0; r < NR; ++r) { const int idx = r * 64 + lane; v[r] = idx < n ? fkey(row[idx]) : 0u; }
    unsigned prefix = 0u;
#pragma unroll 1
    for (int bit = 31; bit >= 0; --bit) {
        const unsigned cand = prefix | (1u << bit); int cnt = 0;
#pragma unroll
        for (int r = 0; r < NR; ++r) cnt += __builtin_popcountll(__ballot(v[r] >= cand));
        if (cnt >= NSEL) prefix = cand;
    }
    const unsigned T = prefix; int cgt = 0;
#pragma unroll
    for (int r = 0; r < NR; ++r) cgt += __builtin_popcountll(__ballot(v[r] > T));
    const int need = NSEL - cgt; int base = 0, ties = 0;
#pragma unroll
    for (int r = 0; r < NR; ++r) { const bool gt = v[r] > T, eq = v[r] == T; const unsigned long long em = __ballot(eq);
        const bool sel = gt || (eq && (ties + mbcnt64(em)) < need); const unsigned long long sm = __ballot(sel);
        if (sel) list[base + mbcnt64(sm)] = (unsigned)(r * 64 + lane);
        base += __builtin_popcountll(sm); ties += __builtin_popcountll(em); }
}

typedef short v4i16 __attribute__((ext_vector_type(4)));
constexpr int VROW = 144;

__device__ __forceinline__ void attn_tile(const Params& P, LAS unsigned char* lds, int b, int t0, int wave, int lane) {
    unsigned char* ws = P.ws;
    const bf16_t* QI = (const bf16_t*)(ws + WS_QI); const bf16_t* KI = (const bf16_t*)(ws + WS_KI);
    const bf16_t* Q = (const bf16_t*)(ws + WS_Q); const bf16_t* Kp = (const bf16_t*)(ws + WS_K); const bf16_t* Vp = (const bf16_t*)(ws + WS_V);
    const float* WI = (const float*)(ws + WS_WI); bf16_t* MIX = (bf16_t*)(ws + WS_MIX);
    LAS float* SC = (LAS float*)lds;
    LAS unsigned* list = (LAS unsigned*)(lds + LDS_MISC + 1024) + wave * 256;
    const int tokbase = b * SEQ;
    const bool need_sel = t0 >= 256;
    if (need_sel) {
        const int nkt = (t0 + 8 + 31) >> 5;
        bf16x8 a[4]; f32x4 w[4];
        { const bf16_t* src = QI + (size_t)(tokbase + t0 + ((lane & 31) >> 2)) * 256 + (lane & 3) * 64 + 8 * (lane >> 5);
#pragma unroll
          for (int ks = 0; ks < 4; ++ks) a[ks] = *(const bf16x8*)(src + 16 * ks); }
#pragma unroll
        for (int g = 0; g < 4; ++g) w[g] = *(const f32x4*)(WI + (size_t)(tokbase + t0 + 2 * g + (lane >> 5)) * 4);
        for (int kt = wave; kt < nkt; kt += NWAVES) {
            const int key = kt * 32 + (lane & 31);
            const bf16_t* ksrc = KI + (size_t)(tokbase + key) * 64 + 8 * (lane >> 5);
            bf16x8 bf[4];
#pragma unroll
            for (int ks = 0; ks < 4; ++ks) bf[ks] = *(const bf16x8*)(ksrc + 16 * ks);
            f32x16 acc;
#pragma unroll
            for (int i = 0; i < 16; ++i) acc[i] = 0.f;
#pragma unroll
            for (int ks = 0; ks < 4; ++ks) acc = __builtin_amdgcn_mfma_f32_32x32x16_bf16(a[ks], bf[ks], acc, 0, 0, 0);
#pragma unroll
            for (int g = 0; g < 4; ++g) { float s = 0.f;
#pragma unroll
                for (int h = 0; h < 4; ++h) s = fmaf(fmaxf(acc[4 * g + h], 0.f), w[g][h], s);
                const int ql = 2 * g + (lane >> 5);
                if (key > t0 + ql) s = -INFINITY;
                SC[ql * 4096 + key] = s; }
        }
    }
    __syncthreads();
    const int t = t0 + wave, tok = tokbase + t;
    if (need_sel) {
        const LAS float* row = SC + wave * 4096; const int n = t + 1;
        if (n <= 1024) select_topk<16>(row, n, list, lane);
        else if (n <= 2048) select_topk<32>(row, n, list, lane);
        else if (n <= 3072) select_topk<48>(row, n, list, lane);
        else select_topk<64>(row, n, list, lane);
    } else {
#pragma unroll
        for (int i = 0; i < 4; ++i) list[i * 64 + lane] = (unsigned)(i * 64 + lane);
    }
    __syncthreads();
    const int nvalid = need_sel ? NSEL : (t + 1);
    const int hd = lane & 15, g = lane >> 4;
    bf16x8 qf0, qf1;
#pragma unroll
    for (int i = 0; i < 8; ++i) { qf0[i] = 0; qf1[i] = 0; }
    if (hd < 8) { const bf16_t* qs = Q + (size_t)tok * 512 + hd * 64 + 8 * g; qf0 = *(const bf16x8*)qs; qf1 = *(const bf16x8*)(qs + 32); }
    float lg[8][2][4];
#pragma unroll
    for (int grp = 0; grp < 8; ++grp) {
        const unsigned ia = list[grp * 32 + hd], ib = list[grp * 32 + 16 + hd];
        const bf16_t* ka = Kp + (size_t)(tokbase + ia) * 64 + 8 * g; const bf16_t* kb = Kp + (size_t)(tokbase + ib) * 64 + 8 * g;
        const bf16x8 ka0 = *(const bf16x8*)ka, ka1 = *(const bf16x8*)(ka + 32), kb0 = *(const bf16x8*)kb, kb1 = *(const bf16x8*)(kb + 32);
        f32x4 sa = {0.f, 0.f, 0.f, 0.f}, sb = {0.f, 0.f, 0.f, 0.f};
        sa = __builtin_amdgcn_mfma_f32_16x16x32_bf16(ka0, qf0, sa, 0, 0, 0); sa = __builtin_amdgcn_mfma_f32_16x16x32_bf16(ka1, qf1, sa, 0, 0, 0);
        sb = __builtin_amdgcn_mfma_f32_16x16x32_bf16(kb0, qf0, sb, 0, 0, 0); sb = __builtin_amdgcn_mfma_f32_16x16x32_bf16(kb1, qf1, sb, 0, 0, 0);
#pragma unroll
        for (int r = 0; r < 4; ++r) { const int sl = grp * 32 + 4 * g + r;
            lg[grp][0][r] = sl < nvalid ? sa[r] * 0.125f : -INFINITY; lg[grp][1][r] = (sl + 16) < nvalid ? sb[r] * 0.125f : -INFINITY; }
    }
    float mx = -INFINITY;
#pragma unroll
    for (int grp = 0; grp < 8; ++grp)
#pragma unroll
        for (int tl = 0; tl < 2; ++tl)
#pragma unroll
            for (int r = 0; r < 4; ++r) mx = fmaxf(mx, lg[grp][tl][r]);
    mx = fmaxf(mx, __shfl_xor(mx, 16)); mx = fmaxf(mx, __shfl_xor(mx, 32));
    float sum = 0.f;
#pragma unroll
    for (int grp = 0; grp < 8; ++grp)
#pragma unroll
        for (int tl = 0; tl < 2; ++tl)
#pragma unroll
            for (int r = 0; r < 4; ++r) { const float pv = __expf(lg[grp][tl][r] - mx); lg[grp][tl][r] = pv; sum += pv; }
    sum += __shfl_xor(sum, 16); sum += __shfl_xor(sum, 32);
    const float inv = 1.0f / sum;
    f32x4 o[4];
#pragma unroll
    for (int dt = 0; dt < 4; ++dt) o[dt] = (f32x4){0.f, 0.f, 0.f, 0.f};
    LAS unsigned char* vreg = lds + wave * 16384;
    u32x4 vv[4];
#pragma unroll
    for (int i = 0; i < 4; ++i) { const unsigned idx = list[(lane >> 3) + 8 * i]; vv[i] = *(const u32x4*)(Vp + (size_t)(tokbase + idx) * 64 + 8 * (lane & 7)); }
#pragma unroll
    for (int grp = 0; grp < 8; ++grp) {
        LAS unsigned char* vbuf = vreg + (grp & 1) * 8192;
#pragma unroll
        for (int i = 0; i < 4; ++i) *(LAS u32x4*)(vbuf + ((lane >> 3) + 8 * i) * VROW + (lane & 7) * 16) = vv[i];
        if (grp < 7) {
#pragma unroll
            for (int i = 0; i < 4; ++i) { const unsigned idx = list[(grp + 1) * 32 + (lane >> 3) + 8 * i]; vv[i] = *(const u32x4*)(Vp + (size_t)(tokbase + idx) * 64 + 8 * (lane & 7)); }
        }
        bf16x8 pf;
        { const unsigned p0 = cvt_pk_bf16(lg[grp][0][0] * inv, lg[grp][0][1] * inv), p1 = cvt_pk_bf16(lg[grp][0][2] * inv, lg[grp][0][3] * inv);
          const unsigned p2 = cvt_pk_bf16(lg[grp][1][0] * inv, lg[grp][1][1] * inv), p3 = cvt_pk_bf16(lg[grp][1][2] * inv, lg[grp][1][3] * inv);
          const u32x4 pw = {p0, p1, p2, p3}; pf = __builtin_bit_cast(bf16x8, pw); }
        LAS unsigned char* ta = vbuf + (4 * g + (hd >> 2)) * VROW + (hd & 3) * 8;
#pragma unroll
        for (int dt = 0; dt < 4; ++dt) {
            const v4i16 lo = __builtin_amdgcn_ds_read_tr16_b64_v4i16((LAS v4i16*)(ta + dt * 32));
            const v4i16 hi = __builtin_amdgcn_ds_read_tr16_b64_v4i16((LAS v4i16*)(ta + 16 * VROW + dt * 32));
            bf16x8 bfv; bfv[0] = lo[0]; bfv[1] = lo[1]; bfv[2] = lo[2]; bfv[3] = lo[3]; bfv[4] = hi[0]; bfv[5] = hi[1]; bfv[6] = hi[2]; bfv[7] = hi[3];
            o[dt] = __builtin_amdgcn_mfma_f32_16x16x32_bf16(pf, bfv, o[dt], 0, 0, 0);
        }
    }
    if (g < 2) {
        bf16_t* op = MIX + (size_t)tok * 1024 + hd;
#pragma unroll
        for (int dt = 0; dt < 4; ++dt)
#pragma unroll
            for (int r = 0; r < 4; ++r) op[(4 * g + r) * 64 + 16 * dt] = (bf16_t)f2bf(o[dt][r]);
    }
    __syncthreads();
}

__device__ __forceinline__ void conv_tile(const Params& P, LAS unsigned char* lds, int tile, int tid, int wave, int lane) {
    unsigned char* ws = P.ws;
    const bf16_t* HG = (const bf16_t*)(ws + WS_HGLU); bf16_t* MIX = (bf16_t*)(ws + WS_MIX);
    LAS f32x2* part = (LAS f32x2*)(lds + LDS_MISC + 1024);
    LAS f32x2* stat = part + 256;
    const int tok0 = tile * 32, t0 = tok0 & (SEQ - 1), c = tid;
    float in[62];
#pragma unroll
    for (int r = 0; r < 62; ++r) { const int tt = t0 - 30 + r; in[r] = tt >= 0 ? __builtin_bit_cast(float, (unsigned)HG[(size_t)(tok0 - 30 + r) * 512 + c] << 16) : 0.f; }
    float out[32];
    const float bias = P.dw_b[c];
#pragma unroll
    for (int i = 0; i < 32; ++i) out[i] = bias;
#pragma unroll
    for (int j = 0; j < 31; ++j) { const float wj = P.dw_w[j * 512 + c];
#pragma unroll
        for (int i = 0; i < 32; ++i) out[i] = fmaf(in[i + j], wj, out[i]); }
#pragma unroll
    for (int i = 0; i < 32; ++i) { const float s1 = wave_sum(out[i]), s2 = wave_sum(out[i] * out[i]); if (lane == 0) part[i * 8 + wave] = (f32x2){s1, s2}; }
    __syncthreads();
    if (tid < 32) { float s1 = 0.f, s2 = 0.f;
#pragma unroll
        for (int w = 0; w < 8; ++w) { const f32x2 pp = part[tid * 8 + w]; s1 += pp.x; s2 += pp.y; }
        const float mean = s1 * (1.0f / 512.0f), var = fmaxf(s2 * (1.0f / 512.0f) - mean * mean, 0.f);
        stat[tid] = (f32x2){mean, 1.0f / sqrtf(var + EPS)}; }
    __syncthreads();
    const float lgc = P.ln_g[c], lbc = P.ln_b[c];
#pragma unroll
    for (int i = 0; i < 32; ++i) { const f32x2 st = stat[i]; const float y = (out[i] - st.x) * st.y * lgc + lbc; const float sl = y * sigmoidf_(y);
        MIX[(size_t)(tok0 + i) * 1024 + 512 + c] = (bf16_t)f2bf(sl); }
    __syncthreads();
}

__device__ __forceinline__ void router_phase(const Params& P, LAS unsigned char* lds, int blk, int G, int tid, int wave, int lane) {
    unsigned char* ws = P.ws;
    const float* h1 = (const float*)(ws + WS_H1); const float* wrg = (const float*)(ws + WS_WRG);
    int* list = (int*)(ws + WS_LIST); float* lscale = (float*)(ws + WS_LSCALE); float* lgate = (float*)(ws + WS_LGATE);
    unsigned* cntg = (unsigned*)(ws + WS_CTL) + CW_CNT;
    LAS float* WL = (LAS float*)lds;
    LAS int* lcnt = (LAS int*)(lds + LDS_MISC + 1024);
    LAS int* gbase = lcnt + 32;
    LAS int* rec_e = gbase + 32;
    LAS int* rec_p = rec_e + 512;
    LAS float* rec_g = (LAS float*)(rec_p + 512);
    LAS float* rec_s = rec_g + 512;
    for (int i = tid; i < 8192; i += NTHR) ((LAS f32x4*)WL)[i] = ((const f32x4*)wrg)[i];
    __syncthreads();
    const int e = lane & 31, kh = lane >> 5;
    const float be = P.b_router[e];
    for (int chunk = blk; chunk < NTOK / 128; chunk += G) {
        if (tid < 32) lcnt[tid] = 0;
        __syncthreads();
#pragma unroll 1
        for (int gi = 0; gi < 2; ++gi) {
            const int tl0 = wave * 16 + gi * 8, tok0 = chunk * 128 + tl0;
            float acc[8], ss[8];
#pragma unroll
            for (int tk = 0; tk < 8; ++tk) { acc[tk] = 0.f; ss[tk] = 0.f; }
#pragma unroll 2
            for (int k4 = 0; k4 < 128; ++k4) {
                const int k = kh * 512 + k4 * 4;
                const float w0 = WL[(k + 0) * 32 + e], w1 = WL[(k + 1) * 32 + e], w2 = WL[(k + 2) * 32 + e], w3 = WL[(k + 3) * 32 + e];
#pragma unroll
                for (int tk = 0; tk < 8; ++tk) { const f32x4 hv = *(const f32x4*)(h1 + (size_t)(tok0 + tk) * DM + k);
                    acc[tk] = fmaf(hv.x, w0, fmaf(hv.y, w1, fmaf(hv.z, w2, fmaf(hv.w, w3, acc[tk]))));
                    ss[tk] = fmaf(hv.x, hv.x, fmaf(hv.y, hv.y, fmaf(hv.z, hv.z, fmaf(hv.w, hv.w, ss[tk])))); }
            }
#pragma unroll
            for (int tk = 0; tk < 8; ++tk) {
                const float a = acc[tk] + __shfl_xor(acc[tk], 32), s = ss[tk] + __shfl_xor(ss[tk], 32);
                const float rs = 1.0f / sqrtf(s * (1.0f / DM) + EPS);
                float val = a * rs + be;
                float tv[4]; int te[4];
#pragma unroll
                for (int r = 0; r < 4; ++r) { float bv = val; int bi = e;
#pragma unroll
                    for (int off = 16; off >= 1; off >>= 1) { const float ov = __shfl_xor(bv, off); const int oi = __shfl_xor(bi, off); if (ov > bv || (ov == bv && oi < bi)) { bv = ov; bi = oi; } }
                    tv[r] = bv; te[r] = bi; if (e == bi) val = -INFINITY; }
                const float e0 = 1.0f, e1 = __expf(tv[1] - tv[0]), e2 = __expf(tv[2] - tv[0]), e3 = __expf(tv[3] - tv[0]);
                const float is = 1.0f / (e0 + e1 + e2 + e3);
                if (lane < 4) { const int myE = lane == 0 ? te[0] : lane == 1 ? te[1] : lane == 2 ? te[2] : te[3];
                    const float myG = (lane == 0 ? e0 : lane == 1 ? e1 : lane == 2 ? e2 : e3) * is;
                    const int lp = atomicAdd((int*)&lcnt[myE], 1);
                    const int si = (tl0 + tk) * 4 + lane; rec_e[si] = myE; rec_p[si] = lp; rec_g[si] = myG; if (lane == 0) rec_s[tl0 + tk] = rs; }
            }
        }
        __syncthreads();
        if (tid < 32) gbase[tid] = (int)atomicAdd(cntg + 64 * tid, (unsigned)lcnt[tid]);
        __syncthreads();
        { const int si = tid, ee = rec_e[si], pos = gbase[ee] + rec_p[si], li = ee * NTOK + pos;
          list[li] = (chunk * 128) * 4 + si; lscale[li] = rec_s[si >> 2]; lgate[li] = rec_g[si]; }
        __syncthreads();
    }
}

__device__ __forceinline__ void combine_phase(const Params& P, int gw, int NGW, int lane) {
    unsigned char* ws = P.ws;
    float* h1 = (float*)(ws + WS_H1); bf16_t* h1b = (bf16_t*)(ws + WS_H1B); const bf16_t* y = (const bf16_t*)(ws + WS_Y); float* rs3 = (float*)(ws + WS_RS3);
    for (int m = gw; m < NTOK; m += NGW) {
        f32x4* hr = (f32x4*)(h1 + (size_t)m * DM) + lane; f32x4 v[4]; float s = 0.f;
#pragma unroll
        for (int j = 0; j < 4; ++j) v[j] = hr[64 * j];
#pragma unroll
        for (int k = 0; k < 4; ++k) { const u32x2* yr = (const u32x2*)(y + (size_t)(m * 4 + k) * DM) + lane;
#pragma unroll
            for (int j = 0; j < 4; ++j) { const u32x2 w = yr[64 * j]; v[j].x += bf_lo(w.x); v[j].y += bf_hi(w.x); v[j].z += bf_lo(w.y); v[j].w += bf_hi(w.y); } }
        u32x2* o8 = (u32x2*)(h1b + (size_t)m * DM) + lane;
#pragma unroll
        for (int j = 0; j < 4; ++j) { hr[64 * j] = v[j]; u32x2 w; w.x = pk2(v[j].x, v[j].y); w.y = pk2(v[j].z, v[j].w); o8[64 * j] = w;
            s += (v[j].x * v[j].x + v[j].y * v[j].y) + (v[j].z * v[j].z + v[j].w * v[j].w); }
        s = wave_sum(s);
        if (lane == 0) rs3[m] = 1.0f / sqrtf(s * (1.0f / DM) + EPS);
    }
}

__device__ __forceinline__ void final_phase(const Params& P, int gw, int NGW, int lane) {
    f32x4 gv[4];
#pragma unroll
    for (int j = 0; j < 4; ++j) gv[j] = *((const f32x4*)P.g_final + lane + 64 * j);
    for (int m = gw; m < NTOK; m += NGW) {
        f32x4* orow = (f32x4*)(P.out + (size_t)m * DM) + lane; f32x4 v[4]; float s = 0.f;
#pragma unroll
        for (int j = 0; j < 4; ++j) { v[j] = orow[64 * j]; s += (v[j].x * v[j].x + v[j].y * v[j].y) + (v[j].z * v[j].z + v[j].w * v[j].w); }
        s = wave_sum(s); const float rs = 1.0f / sqrtf(s * (1.0f / DM) + EPS);
#pragma unroll
        for (int j = 0; j < 4; ++j) orow[64 * j] = v[j] * rs * gv[j];
    }
}

constexpr int NPHASE = 10;
__global__ void __launch_bounds__(NTHR, 2) fwd_kernel(Params P) {
    extern __shared__ __attribute__((aligned(16))) unsigned char lds_raw[];
    LAS unsigned char* lds = (LAS unsigned char*)lds_raw;
    cg::grid_group grid = cg::this_grid();
    const int tid = threadIdx.x, lane = tid & 63, wave = __builtin_amdgcn_readfirstlane(tid >> 6);
    const int G = gridDim.x, bx = blockIdx.x;
    const int vcu = (G % 8 == 0) ? (bx % 8) * (G / 8) + bx / 8 : bx;
    const int gw = vcu * NWAVES + wave, NGW = G * NWAVES;
    unsigned char* ws = P.ws;
    const int lo = P.ph_lo, hi = P.ph_hi;
#define IN(k) (lo <= (k) && (k) < hi)
#define SYNC(k) do { if (IN(k) && IN((k) + 1)) grid.sync(); } while (0)

    if (IN(0)) p0_prologue(P, lds, vcu, G, wave, lane);
    SYNC(0);
    if (IN(1)) {
        { pg8::DenseSched S; S.init((const bf16_t*)(ws + WS_XB), (const bf16_t*)(ws + WS_WIN), NTOK, 2048, 1024, G, bx);
          EpiInProj E{(const float*)(ws + WS_RS1), (const f32x2*)(ws + WS_ROPE), P.glu_b, (bf16_t*)(ws + WS_Q), (bf16_t*)(ws + WS_K), (bf16_t*)(ws + WS_V), (bf16_t*)(ws + WS_QI), (bf16_t*)(ws + WS_KI), (bf16_t*)(ws + WS_HGLU), (float*)(ws + WS_WI)};
          pg8::gemm_phase<EpiInProj, pg8::DenseSched, false>(lds, S, E); }
        { pg8::DenseSched S; S.init((const bf16_t*)(ws + WS_PB), (const bf16_t*)(ws + WS_WP), NTOK, 1024, 256, G, bx);
          EpiBf16Plain E{(bf16_t*)(ws + WS_PJ), 1024};
          pg8::gemm_phase<EpiBf16Plain, pg8::DenseSched, false>(lds, S, E); }
    }
    SYNC(1);
    if (IN(2)) {
        if (G % 8 == 0) { const int b = bx % 8, jb = bx / 8, nbb = G / 8;
            for (int i = 0;; ++i) { const int k = i * nbb + ((i & 1) ? nbb - 1 - jb : jb); if (k >= 512) break; attn_tile(P, lds, b, (511 - k) * 8, wave, lane); } }
        else { for (int tl = bx; tl < 4096; tl += G) attn_tile(P, lds, tl & 7, (511 - (tl >> 3)) * 8, wave, lane); }
        for (int tl = vcu; tl < NTOK / 32; tl += G) conv_tile(P, lds, tl, tid, wave, lane);
    }
    SYNC(2);
    if (IN(3)) {
        pg8::DenseSched S; S.init((const bf16_t*)(ws + WS_MIX), (const bf16_t*)(ws + WS_WOUT), NTOK, 1024, 1024, G, bx);
        EpiOutProj E{P.x, (float*)(ws + WS_H1), (bf16_t*)(ws + WS_H1B)};
        pg8::gemm_phase<EpiOutProj, pg8::DenseSched, false>(lds, S, E);
    }
    SYNC(3);
    if (IN(4)) router_phase(P, lds, vcu, G, tid, wave, lane);
    SYNC(4);
    if (IN(5) || IN(6)) {
        LAS int* tb = (LAS int*)(lds + LDS_MISC); LAS int* cn = tb + 64;
        if (tid == 0) { const unsigned* cntg = (const unsigned*)(ws + WS_CTL) + CW_CNT; int acc = 0;
            for (int e = 0; e < NE; ++e) { const int c = (int)__hip_atomic_load(cntg + 64 * e, __ATOMIC_RELAXED, __HIP_MEMORY_SCOPE_AGENT); tb[e] = acc; cn[e] = c; acc += (c + BM - 1) / BM; }
            tb[NE] = acc; }
        __syncthreads();
        if (IN(5)) {
            pg8::MoeSched S; S.A = (const bf16_t*)(ws + WS_H1B); S.Bt = (const bf16_t*)(ws + WS_WUP); S.K = 1024; S.b_estride = (size_t)2048 * 1024 * 2; S.tb = tb; S.cnt = cn; S.list = (const int*)(ws + WS_LIST);
            S.nN = 8; S.nwg = tb[NE] * 8; S.G = G; S.c = bx; S.gather = true;
            EpiUp E{(const float*)(ws + WS_LSCALE), P.b_up, (bf16_t*)(ws + WS_ACT), tb};
            pg8::gemm_phase<EpiUp, pg8::MoeSched, true>(lds, S, E);
        }
        SYNC(5);
        if (IN(6)) {
            pg8::MoeSched S; S.A = (const bf16_t*)(ws + WS_ACT); S.Bt = (const bf16_t*)(ws + WS_WDOWN); S.K = 1024; S.b_estride = (size_t)1024 * 1024 * 2; S.tb = tb; S.cnt = cn; S.list = (const int*)(ws + WS_LIST);
            S.nN = 4; S.nwg = tb[NE] * 4; S.G = G; S.c = bx; S.gather = false;
            EpiDown E{(const int*)(ws + WS_LIST), (const float*)(ws + WS_LGATE), P.b_down, (bf16_t*)(ws + WS_Y), tb};
            pg8::gemm_phase<EpiDown, pg8::MoeSched, false>(lds, S, E);
        }
    }
    SYNC(6);
    if (IN(7)) combine_phase(P, gw, NGW, lane);
    SYNC(7);
    if (IN(8)) {
        pg8::DenseSched S; S.init((const bf16_t*)(ws + WS_H1B), (const bf16_t*)(ws + WS_WG), NTOK, 1024, 1024, G, bx);
        EpiPle E{(const float*)(ws + WS_H1), (const bf16_t*)(ws + WS_PJ), (const float*)(ws + WS_RS3), P.out};
        pg8::gemm_phase<EpiPle, pg8::DenseSched, false>(lds, S, E);
    }
    SYNC(8);
    if (IN(9)) final_phase(P, gw, NGW, lane);
#undef IN
#undef SYNC
}

#ifndef N_LAUNCH_MODE
#define N_LAUNCH_MODE 1
#endif
extern "C" void kernel_launch(void* const* d_in, const int* in_sizes, int n_in, void* d_out, int out_size, void* d_ws, size_t ws_size, hipStream_t stream) {
    static int grid = 0;
    if (grid == 0) {
        if (n_in != 21 || out_size != NTOK * DM || ws_size < WS_END) { fprintf(stderr, "kernel_launch: unexpected shapes (n_in %d out %d ws %zu)\n", n_in, out_size, ws_size); grid = -1; return; }
        int dev = 0, cus = 0, per_cu = 0;
        (void)hipGetDevice(&dev); (void)hipDeviceGetAttribute(&cus, hipDeviceAttributeMultiprocessorCount, dev);
        (void)hipFuncSetAttribute((const void*)fwd_kernel, hipFuncAttributeMaxDynamicSharedMemorySize, LDS_BYTES);
        if (hipOccupancyMaxActiveBlocksPerMultiprocessor(&per_cu, (const void*)fwd_kernel, NTHR, LDS_BYTES) != hipSuccess || per_cu < 1) { fprintf(stderr, "kernel_launch: occupancy query failed (%d)\n", per_cu); (void)hipGetLastError(); grid = -1; return; }
        grid = cus;
    }
    if (grid < 0) return;
    (void)hipMemsetAsync((char*)d_ws + WS_CTL, 0, CTL_BYTES, stream);
    Params p{};
    p.x = (const float*)d_in[0]; p.p = (const float*)d_in[1]; p.w_in = (const float*)d_in[2]; p.w_out = (const float*)d_in[3]; p.g_mix = (const float*)d_in[4]; p.g_ffn = (const float*)d_in[5];
    p.glu_b = (const float*)d_in[6]; p.dw_w = (const float*)d_in[7]; p.dw_b = (const float*)d_in[8]; p.ln_g = (const float*)d_in[9]; p.ln_b = (const float*)d_in[10];
    p.w_router = (const float*)d_in[11]; p.b_router = (const float*)d_in[12]; p.w_up = (const float*)d_in[13]; p.b_up = (const float*)d_in[14]; p.w_down = (const float*)d_in[15]; p.b_down = (const float*)d_in[16];
    p.w_ple_proj = (const float*)d_in[17]; p.w_ple_gate = (const float*)d_in[18]; p.g_ple = (const float*)d_in[19]; p.g_final = (const float*)d_in[20];
    p.out = (float*)d_out; p.ws = (unsigned char*)d_ws;
#if N_LAUNCH_MODE == 1
    p.ph_lo = 0; p.ph_hi = NPHASE;
    void* args[] = {&p};
    hipError_t e = hipLaunchCooperativeKernel((const void*)fwd_kernel, dim3(grid), dim3(NTHR), args, LDS_BYTES, stream);
    if (e != hipSuccess) fprintf(stderr, "cooperative launch failed: %s (grid %d)\n", hipGetErrorString(e), grid);
#else
    for (int ph = 0; ph < NPHASE; ++ph) {
        p.ph_lo = ph; p.ph_hi = ph + 1;
        void* args[] = {&p};
        hipError_t e = hipLaunchCooperativeKernel((const void*)fwd_kernel, dim3(grid), dim3(NTHR), args, LDS_BYTES, stream);
        if (e != hipSuccess) { fprintf(stderr, "launch %d failed: %s (grid %d)\n", ph, hipGetErrorString(e), grid); break; }
    }
#endif
}
```

```cpp
#include <hip/hip_runtime.h>
#include <hip/hip_cooperative_groups.h>
#include <cstdio>
#include <cstdint>
namespace cg = cooperative_groups;

#define LAS __attribute__((address_space(3)))
#define GAS __attribute__((address_space(1)))
typedef unsigned short bf16_t;
typedef short bf16x8 __attribute__((ext_vector_type(8)));
typedef short s16x4 __attribute__((ext_vector_type(4)));
typedef float f32x4 __attribute__((ext_vector_type(4)));
typedef float f32x2 __attribute__((ext_vector_type(2)));
typedef float f32x16 __attribute__((ext_vector_type(16)));
typedef unsigned u32x4 __attribute__((ext_vector_type(4)));
typedef unsigned u32x2 __attribute__((ext_vector_type(2)));

constexpr int NB = 8, SEQ = 4096, DM = 1024, NTOK = NB * SEQ;
constexpr int NE = 32, TOPK = 4, NSLOT = NTOK * TOPK;
constexpr int INW = 1988;
constexpr int NSEL = 256;
constexpr float EPS = 1e-6f;
constexpr int NWAVES = 8, NTHR = 512;

constexpr size_t MiB = 1u << 20;
constexpr size_t WS_CTL = 0, CTL_BYTES = 64 * 1024;
constexpr size_t WS_ROPE = 1 * MiB;
constexpr size_t WS_WIN = 2 * MiB;
constexpr size_t WS_WOUT = 6 * MiB;
constexpr size_t WS_WG = 8 * MiB;
constexpr size_t WS_WP = 10 * MiB;
constexpr size_t WS_WRG = 10 * MiB + 512 * 1024;
constexpr size_t WS_RS1 = 11 * MiB;
constexpr size_t WS_RS3 = 11 * MiB + 512 * 1024;
constexpr size_t WS_WI = 12 * MiB;
constexpr size_t WS_LIST = 13 * MiB;
constexpr size_t WS_LSCALE = 17 * MiB;
constexpr size_t WS_LGATE = 21 * MiB;
constexpr size_t WS_PB = 25 * MiB;
constexpr size_t WS_WUP = 42 * MiB;
constexpr size_t WS_WDOWN = 170 * MiB;
constexpr size_t WS_H1 = 234 * MiB;
constexpr size_t WS_H1B = 362 * MiB;
constexpr size_t WS_PJ = 426 * MiB;
constexpr size_t WS_XB = 490 * MiB;
constexpr size_t WS_Q = 554 * MiB;
constexpr size_t WS_K = 586 * MiB;
constexpr size_t WS_V = 590 * MiB;
constexpr size_t WS_QI = 594 * MiB;
constexpr size_t WS_KI = 610 * MiB;
constexpr size_t WS_HGLU = 614 * MiB;
constexpr size_t WS_MIX = 646 * MiB;
constexpr size_t WS_ACT = 490 * MiB;
constexpr size_t WS_Y = 762 * MiB;
constexpr size_t WS_END = 1018 * MiB;
static_assert(WS_MIX + (size_t)NTOK * 1024 * 2 <= WS_ACT + (size_t)139264 * 2048 && WS_ACT + (size_t)139264 * 2048 <= WS_Y, "ws map");
constexpr int CW_CNT = 1024;

constexpr int LDS_STAGE = 131072;
constexpr int LDS_MISC = LDS_STAGE;
constexpr int LDS_BYTES = 147456;

__device__ __forceinline__ unsigned f2bf(float f) { unsigned u = __builtin_bit_cast(unsigned, f); return (u + 0x7fffu + ((u >> 16) & 1u)) >> 16; }
__device__ __forceinline__ unsigned pk2(float lo, float hi) { return f2bf(lo) | (f2bf(hi) << 16); }
__device__ __forceinline__ float bf_lo(unsigned w) { return __builtin_bit_cast(float, w << 16); }
__device__ __forceinline__ float bf_hi(unsigned w) { return __builtin_bit_cast(float, w & 0xffff0000u); }
__device__ __forceinline__ float wave_sum(float v) {
#pragma unroll
    for (int o = 1; o < 64; o <<= 1) v += __shfl_xor(v, o);
    return v;
}
__device__ __forceinline__ float sigmoidf_(float x) { return 1.0f / (1.0f + __expf(-x)); }
#define LDS_WAIT() asm volatile("s_waitcnt lgkmcnt(0)" ::: "memory")

struct Params {
    const float* x; const float* p; const float* w_in; const float* w_out; const float* g_mix; const float* g_ffn;
    const float* glu_b; const float* dw_w; const float* dw_b; const float* ln_g; const float* ln_b;
    const float* w_router; const float* b_router; const float* w_up; const float* b_up; const float* w_down; const float* b_down;
    const float* w_ple_proj; const float* w_ple_gate; const float* g_ple; const float* g_final;
    float* out; unsigned char* ws;
    int ph_lo, ph_hi, rep, pad;
};

namespace pg8 {
constexpr int BM = 256, BK = 64, HALF = 128, HTB = HALF * BK * 2, STAGE_BYTES = 8 * HTB, NXCD = 8, WGM = 8;
__host__ __device__ __forceinline__ int lds_byte(int r, int c) { const int st = (r >> 4) * 2 + (c >> 5), rr = r & 15, cc = c & 31, ob = rr * 64 + cc * 2; return st * 1024 + (ob ^ (((ob >> 9) & 1) << 5)); }
__host__ __device__ __forceinline__ void stage_rc(int b, int& R, int& C) { const int st = b / 1024, sb = b % 1024, swz = sb ^ (((sb >> 9) & 1) << 5); R = (st >> 1) * 16 + swz / 64; C = (st & 1) * 32 + (swz % 64) / 2; }
__host__ __device__ __forceinline__ int perm32(int rho) { const int n = rho >> 4, i = rho & 15; return 8 * (i >> 2) + 4 * n + (i & 3); }

struct Unit { int pm, pn, e, rows; };

__device__ __forceinline__ unsigned cvt_pk_bf16(float lo, float hi) { unsigned r; asm volatile("v_cvt_pk_bf16_f32 %0, %1, %2" : "=v"(r) : "v"(lo), "v"(hi)); return r; }

struct DenseSched {
    const bf16_t* A; const bf16_t* Bt; int K;
    int nM, nN, nwg, G, c;
    __device__ void init(const bf16_t* A_, const bf16_t* Bt_, int M, int N, int K_, int G_, int c_) { A = A_; Bt = Bt_; K = K_; nM = M / BM; nN = N / BM; nwg = nM * nN; G = G_; c = c_; }
    __device__ bool next(int i, Unit& u) const {
        const long L = (long)i * G + c; if (L >= nwg) return false;
        int wgid = (int)L; { const int q = nwg / NXCD, r = nwg % NXCD, xcd = wgid % NXCD, off = wgid / NXCD; wgid = (xcd < r ? xcd * (q + 1) : r * (q + 1) + (xcd - r) * q) + off; }
        const int nig = WGM * nN, gid = wgid / nig, fm = gid * WGM, gsz = (nM - fm) < WGM ? (nM - fm) : WGM;
        u.pm = fm + ((wgid % nig) % gsz); u.pn = (wgid % nig) / gsz; u.e = 0; u.rows = BM; return true;
    }
    __device__ __forceinline__ const char* a_ptr(const Unit& u) const { return (const char*)A + (size_t)u.pm * BM * K * 2; }
    __device__ __forceinline__ const char* b_ptr(const Unit& u) const { return (const char*)Bt + (size_t)u.pn * BM * K * 2; }
    __device__ __forceinline__ int a_row(const Unit&, int) const { return 0; }
};

struct MoeSched {
    const bf16_t* A; const bf16_t* Bt; int K; size_t b_estride;
    const LAS int* tb;
    const LAS int* cnt;
    const int* list;
    int nN, nwg, G, c; bool gather;
    __device__ bool next(int i, Unit& u) const {
        const long L = (long)i * G + c; if (L >= nwg) return false;
        int wgid = (int)L; { const int q = nwg / NXCD, r = nwg % NXCD, xcd = wgid % NXCD, off = wgid / NXCD; wgid = (xcd < r ? xcd * (q + 1) : r * (q + 1) + (xcd - r) * q) + off; }
        int e = 0;
#pragma unroll 1
        for (; e < NE - 1; ++e) { if (wgid < tb[e + 1] * nN) break; }
        const int local = wgid - tb[e] * nN, nM = tb[e + 1] - tb[e];
        const int nig = WGM * nN, gid = local / nig, fm = gid * WGM, gsz = (nM - fm) < WGM ? (nM - fm) : WGM;
        const int rt = fm + ((local % nig) % gsz);
        u.pm = tb[e] + rt; u.pn = (local % nig) / gsz; u.e = e;
        const int left = cnt[e] - rt * BM; u.rows = left < BM ? left : BM; return true;
    }
    __device__ __forceinline__ const char* a_ptr(const Unit& u) const { return gather ? (const char*)A : (const char*)A + (size_t)u.pm * BM * K * 2; }
    __device__ __forceinline__ const char* b_ptr(const Unit& u) const { return (const char*)Bt + (size_t)u.e * b_estride + (size_t)u.pn * BM * K * 2; }
    __device__ __forceinline__ int a_row(const Unit& u, int r) const {
        const int rt = u.pm - tb[u.e];
        return r < u.rows ? (list[u.e * NTOK + rt * BM + r] >> 2) : 0;
    }
};

template <class Epi, class Sched, bool GATHER>
__device__ __forceinline__ void gemm_phase(LAS unsigned char* lds, const Sched& S, const Epi& E) {
    const int tid = threadIdx.x, wid = __builtin_amdgcn_readfirstlane(tid >> 6), lane = tid & 63, wr = wid >> 2, wc = wid & 3, fr = lane & 15, fq = lane >> 4;
    const int K = S.K, nt = K / BK;
    unsigned voffA[2], voffB[2]; int RA[2], CA[2];
#pragma unroll
    for (int i = 0; i < 2; ++i) { int R, C; stage_rc(tid * 16 + i * 8192, R, C); const int Rb = Epi::PERM ? ((R & ~31) + perm32(R & 31)) : R;
        voffA[i] = (unsigned)(R * K + C) * 2u; voffB[i] = (unsigned)(Rb * K + C) * 2u; RA[i] = R; CA[i] = C; }
    const size_t kstep = (size_t)(BK * 2);
    const size_t hstep = (size_t)HALF * K * 2;
    const unsigned ldsw = (unsigned)wid * 1024u;
    const int aoff = lds_byte(wr * 64 + fr, fq * 8), boff = lds_byte(wc * 32 + fr, fq * 8);
    unsigned gC[2][2], gN[2][2];
#define PG8_SA(b, h) (((b) * 2 + (h)) * HTB)
#define PG8_SB(b, h) ((4 + (b) * 2 + (h)) * HTB)
#define PG8_STAGE(bufoff, gbase, voff) do { _Pragma("unroll") for (int _i = 0; _i < 2; ++_i) \
        __builtin_amdgcn_global_load_lds((const unsigned*)((const char*)(gbase) + (voff)[_i]), (LAS unsigned*)(lds + (bufoff) + ldsw + _i * 8192), 16, 0, 0); } while (0)
#define PG8_STAGE_A(bufoff, kp, h) do { if constexpr (GATHER) { PG8_STAGE(bufoff, kp, gC[h]); } else { PG8_STAGE(bufoff, (kp) + (h) * hstep, voffA); } } while (0)
#define PG8_LDA(dst, b, h) do { _Pragma("unroll") for (int m = 0; m < 4; ++m) _Pragma("unroll") for (int k = 0; k < 2; ++k) dst[m][k] = *(const LAS bf16x8*)(lds + PG8_SA(b, h) + aoff + m * 2048 + k * 1024); } while (0)
#define PG8_LDB(dst, b, h) do { _Pragma("unroll") for (int n = 0; n < 2; ++n) _Pragma("unroll") for (int k = 0; k < 2; ++k) dst[n][k] = *(const LAS bf16x8*)(lds + PG8_SB(b, h) + boff + n * 2048 + k * 1024); } while (0)
#define PG8_MMA(ai, bj, At, Bt) do { __builtin_amdgcn_s_setprio(1); _Pragma("unroll") for (int m = 0; m < 4; ++m) _Pragma("unroll") for (int n = 0; n < 2; ++n) _Pragma("unroll") for (int k = 0; k < 2; ++k) \
        acc[ai][bj][m][n] = __builtin_amdgcn_mfma_f32_16x16x32_bf16(Bt[n][k], At[m][k], acc[ai][bj][m][n], 0, 0, 0); __builtin_amdgcn_s_setprio(0); } while (0)
#define PG8_WAIT_V(n) asm volatile("s_waitcnt vmcnt(" #n ")" ::: "memory")
#define PG8_WAIT_L(n) asm volatile("s_waitcnt lgkmcnt(" #n ")" ::: "memory")
#define PG8_BAR __builtin_amdgcn_s_barrier()
#define PG8_SCHED __builtin_amdgcn_sched_barrier(0)
#define PG8_GOFF(dst, u) do { _Pragma("unroll") for (int _h = 0; _h < 2; ++_h) _Pragma("unroll") for (int _i = 0; _i < 2; ++_i) \
        dst[_h][_i] = (unsigned)(S.a_row(u, _h * HALF + RA[_i]) * K + CA[_i]) * 2u; } while (0)
    Unit cur, nxt, nn; int ui = 0;
    if (!S.next(0, cur)) return;
    bool has_next = S.next(1, nxt);
    if constexpr (GATHER) { PG8_GOFF(gC, cur); if (has_next) { PG8_GOFF(gN, nxt); } else { PG8_GOFF(gN, cur); } }
    f32x4 acc[2][2][4][2];
#pragma unroll
    for (int a = 0; a < 2; ++a)
#pragma unroll
        for (int b = 0; b < 2; ++b)
#pragma unroll
            for (int m = 0; m < 4; ++m)
#pragma unroll
                for (int n = 0; n < 2; ++n) acc[a][b][m][n] = (f32x4){0.f, 0.f, 0.f, 0.f};
    bf16x8 At[4][2], B0[2][2], B1[2][2];
    const char* cA = S.a_ptr(cur); const char* cB = S.b_ptr(cur);
    PG8_STAGE(PG8_SB(0, 0), cB, voffB); PG8_STAGE(PG8_SB(0, 1), cB + hstep, voffB); PG8_STAGE_A(PG8_SA(0, 0), cA, 0); PG8_STAGE_A(PG8_SA(0, 1), cA, 1);
    if (wr == 1) PG8_BAR;
    PG8_WAIT_V(2); PG8_BAR;
    PG8_STAGE(PG8_SB(1, 0), cB + kstep, voffB); PG8_STAGE_A(PG8_SA(1, 0), cA + kstep, 0); PG8_STAGE(PG8_SB(1, 1), cB + hstep + kstep, voffB);
    PG8_WAIT_V(6); PG8_BAR;
    for (;;) {
        const char* nA = has_next ? S.a_ptr(nxt) : cA; const char* nB = has_next ? S.b_ptr(nxt) : cB;
        for (int t = 0; t < nt; t += 2) {
            const bool last = (t == nt - 2);
            const char* a1 = cA + (size_t)(t + 1) * kstep;
            const char* a2 = last ? nA : cA + (size_t)(t + 2) * kstep; const char* b2 = last ? nB : cB + (size_t)(t + 2) * kstep;
            const char* a3 = a2 + kstep; const char* b3 = b2 + kstep;
            PG8_LDB(B0, 0, 0); PG8_LDB(B1, 0, 1); PG8_SCHED; PG8_LDA(At, 0, 0); PG8_STAGE_A(PG8_SA(1, 1), a1, 1);
            if constexpr (GATHER) { if (last) {
#pragma unroll
                for (int h = 0; h < 2; ++h)
#pragma unroll
                    for (int i = 0; i < 2; ++i) gC[h][i] = gN[h][i]; } }
            PG8_WAIT_V(8); PG8_WAIT_L(0); PG8_BAR; PG8_MMA(0, 0, At, B0); PG8_MMA(0, 1, At, B1); PG8_BAR; PG8_SCHED;
            PG8_LDA(At, 0, 1); PG8_STAGE(PG8_SB(0, 0), b2, voffB); PG8_STAGE(PG8_SB(0, 1), b2 + hstep, voffB); PG8_STAGE_A(PG8_SA(0, 0), a2, 0);
            PG8_WAIT_V(8); PG8_WAIT_L(0); PG8_BAR; PG8_MMA(1, 0, At, B0); PG8_MMA(1, 1, At, B1); PG8_BAR; PG8_SCHED;
            PG8_LDB(B0, 1, 0); PG8_LDB(B1, 1, 1); PG8_SCHED; PG8_LDA(At, 1, 0); PG8_STAGE_A(PG8_SA(0, 1), a2, 1);
            PG8_WAIT_V(8); PG8_WAIT_L(0); PG8_BAR; PG8_MMA(0, 0, At, B0); PG8_MMA(0, 1, At, B1); PG8_BAR; PG8_SCHED;
            PG8_LDA(At, 1, 1); PG8_STAGE(PG8_SB(1, 0), b3, voffB); PG8_STAGE(PG8_SB(1, 1), b3 + hstep, voffB); PG8_STAGE_A(PG8_SA(1, 0), a3, 0);
            PG8_WAIT_V(8); PG8_WAIT_L(0); PG8_BAR; PG8_MMA(1, 0, At, B0); PG8_MMA(1, 1, At, B1); PG8_BAR; PG8_SCHED;
        }
        if (wr == 0) PG8_BAR;
        bool has_nn = false;
        if constexpr (GATHER) { if (has_next) { has_nn = S.next(ui + 2, nn); if (has_nn) { PG8_GOFF(gN, nn); } } }
        else { if (has_next) has_nn = S.next(ui + 2, nn); }
        E(acc, cur, wr, wc, fr, fq);
        if (!has_next) break;
#pragma unroll
        for (int a = 0; a < 2; ++a)
#pragma unroll
            for (int b = 0; b < 2; ++b)
#pragma unroll
                for (int m = 0; m < 4; ++m)
#pragma unroll
                    for (int n = 0; n < 2; ++n) acc[a][b][m][n] = (f32x4){0.f, 0.f, 0.f, 0.f};
        cur = nxt; cA = nA; cB = nB; ++ui; nxt = nn; has_next = has_nn;
        if (wr == 1) PG8_BAR;
    }
    PG8_WAIT_V(0);
    PG8_BAR;
#undef PG8_SA
#undef PG8_SB
#undef PG8_STAGE
#undef PG8_STAGE_A
#undef PG8_LDA
#undef PG8_LDB
#undef PG8_MMA
#undef PG8_WAIT_V
#undef PG8_WAIT_L
#undef PG8_BAR
#undef PG8_SCHED
#undef PG8_GOFF
}
}

using pg8::Unit; using pg8::cvt_pk_bf16;
constexpr int BM = 256, HALF = 128;

struct EpiInProj {
    static constexpr bool PERM = true;
    const float* rs1; const f32x2* rope; const float* glu_b;
    bf16_t *q, *k, *v, *qi, *ki, *hglu; float* wi;
    __device__ __forceinline__ void operator()(const f32x4 (&acc)[2][2][4][2], const Unit& u, int wr, int wc, int fr, int fq) const {
        const int row0 = u.pm * BM + wr * 64 + fr;
        if (u.pn >= 4) {
            const int ch = 128 * (u.pn - 4) + 32 * wc + 8 * fq;
            f32x4 ba[2], bg[2];
#pragma unroll
            for (int n = 0; n < 2; ++n) { ba[n] = *(const f32x4*)(glu_b + ch + 4 * n); bg[n] = *(const f32x4*)(glu_b + 512 + ch + 4 * n); }
#pragma unroll
            for (int ai = 0; ai < 2; ++ai)
#pragma unroll
                for (int m = 0; m < 4; ++m) { const int row = row0 + ai * HALF + m * 16; const float rs = rs1[row];
                    float o[8];
#pragma unroll
                    for (int n = 0; n < 2; ++n)
#pragma unroll
                        for (int e = 0; e < 4; ++e) { const float a = acc[ai][0][m][n][e] * rs + ba[n][e], g = acc[ai][1][m][n][e] * rs + bg[n][e]; o[4 * n + e] = a * sigmoidf_(g); }
                    u32x4 w; w.x = cvt_pk_bf16(o[0], o[1]); w.y = cvt_pk_bf16(o[2], o[3]); w.z = cvt_pk_bf16(o[4], o[5]); w.w = cvt_pk_bf16(o[6], o[7]);
                    *(u32x4*)(hglu + (size_t)row * 512 + ch) = w; }
            return;
        }
        bf16_t* dst; int ld, col; bool do_rope = true, is_wi = false;
        if (u.pn < 2) { dst = q; ld = 512; col = (4 * u.pn + wc) * 64; }
        else if (u.pn == 2) { dst = qi; ld = 256; col = wc * 64; }
        else { ld = 64; col = 0; if (wc == 0) dst = k; else if (wc == 1) dst = ki; else if (wc == 2) { dst = v; do_rope = false; } else { dst = v; is_wi = true; do_rope = false; } }
        if (is_wi) {
            if (fq == 0) {
#pragma unroll
                for (int ai = 0; ai < 2; ++ai)
#pragma unroll
                    for (int m = 0; m < 4; ++m) { const int row = row0 + ai * HALF + m * 16; const float rs = rs1[row];
                        *(f32x4*)(wi + (size_t)row * 4) = acc[ai][0][m][0] * rs; }
            }
            return;
        }
        const int d0 = 8 * fq;
#pragma unroll
        for (int ai = 0; ai < 2; ++ai)
#pragma unroll
            for (int m = 0; m < 4; ++m) { const int row = row0 + ai * HALF + m * 16; const float rs = rs1[row];
                float o1[8], o2[8];
                if (do_rope) {
                    const f32x2* rp = rope + (size_t)(row & (SEQ - 1)) * 32 + d0;
#pragma unroll
                    for (int n = 0; n < 2; ++n)
#pragma unroll
                        for (int e = 0; e < 4; ++e) { const f32x2 cs = rp[4 * n + e]; const float x1 = acc[ai][0][m][n][e] * rs, x2 = acc[ai][1][m][n][e] * rs;
                            o1[4 * n + e] = x1 * cs.x - x2 * cs.y; o2[4 * n + e] = x2 * cs.x + x1 * cs.y; }
                } else {
#pragma unroll
                    for (int n = 0; n < 2; ++n)
#pragma unroll
                        for (int e = 0; e < 4; ++e) { o1[4 * n + e] = acc[ai][0][m][n][e] * rs; o2[4 * n + e] = acc[ai][1][m][n][e] * rs; }
                }
                u32x4 w1, w2; w1.x = cvt_pk_bf16(o1[0], o1[1]); w1.y = cvt_pk_bf16(o1[2], o1[3]); w1.z = cvt_pk_bf16(o1[4], o1[5]); w1.w = cvt_pk_bf16(o1[6], o1[7]);
                w2.x = cvt_pk_bf16(o2[0], o2[1]); w2.y = cvt_pk_bf16(o2[2], o2[3]); w2.z = cvt_pk_bf16(o2[4], o2[5]); w2.w = cvt_pk_bf16(o2[6], o2[7]);
                bf16_t* rp2 = dst + (size_t)row * ld + col + d0;
                *(u32x4*)(rp2) = w1; *(u32x4*)(rp2 + 32) = w2; }
    }
};

struct EpiBf16Plain {
    static constexpr bool PERM = true;
    bf16_t* O; int ldc;
    __device__ __forceinline__ void operator()(const f32x4 (&acc)[2][2][4][2], const Unit& u, int wr, int wc, int fr, int fq) const {
        const int row0 = u.pm * BM + wr * 64 + fr, col0 = u.pn * BM + wc * 32 + 8 * fq;
#pragma unroll
        for (int ai = 0; ai < 2; ++ai)
#pragma unroll
            for (int m = 0; m < 4; ++m) { bf16_t* rowp = O + (size_t)(row0 + ai * HALF + m * 16) * ldc + col0;
#pragma unroll
                for (int bj = 0; bj < 2; ++bj) { const f32x4 v0 = acc[ai][bj][m][0], v1 = acc[ai][bj][m][1];
                    u32x4 w; w.x = cvt_pk_bf16(v0[0], v0[1]); w.y = cvt_pk_bf16(v0[2], v0[3]); w.z = cvt_pk_bf16(v1[0], v1[1]); w.w = cvt_pk_bf16(v1[2], v1[3]);
                    *(u32x4*)(rowp + bj * HALF) = w; } }
    }
};

struct EpiOutProj {
    static constexpr bool PERM = false;
    const float* x; float* h1; bf16_t* h1b;
    __device__ __forceinline__ void operator()(const f32x4 (&acc)[2][2][4][2], const Unit& u, int wr, int wc, int fr, int fq) const {
        const int row0 = u.pm * BM + wr * 64 + fr, col0 = u.pn * BM + wc * 32 + 4 * fq;
#pragma unroll
        for (int ai = 0; ai < 2; ++ai)
#pragma unroll
            for (int m = 0; m < 4; ++m) { const size_t off = (size_t)(row0 + ai * HALF + m * 16) * DM + col0;
#pragma unroll
                for (int bj = 0; bj < 2; ++bj)
#pragma unroll
                    for (int n = 0; n < 2; ++n) { const size_t o = off + bj * HALF + n * 16; const f32x4 r = *(const f32x4*)(x + o) + acc[ai][bj][m][n];
                        *(f32x4*)(h1 + o) = r; u32x2 w; w.x = cvt_pk_bf16(r[0], r[1]); w.y = cvt_pk_bf16(r[2], r[3]); *(u32x2*)(h1b + o) = w; } }
    }
};

struct EpiUp {
    static constexpr bool PERM = true;
    const float* lscale; const float* b_up; bf16_t* act; const LAS int* tb;
    __device__ __forceinline__ void operator()(const f32x4 (&acc)[2][2][4][2], const Unit& u, int wr, int wc, int fr, int fq) const {
        const int r0 = wr * 64 + fr, ch = 128 * u.pn + 32 * wc + 8 * fq, rt = u.pm - tb[u.e];
        const float* bu = b_up + (size_t)u.e * 2048;
        f32x4 bg[2], bl[2];
#pragma unroll
        for (int n = 0; n < 2; ++n) { bg[n] = *(const f32x4*)(bu + ch + 4 * n); bl[n] = *(const f32x4*)(bu + 1024 + ch + 4 * n); }
#pragma unroll
        for (int ai = 0; ai < 2; ++ai)
#pragma unroll
            for (int m = 0; m < 4; ++m) { const int r = r0 + ai * HALF + m * 16;
                const float rs = (r < u.rows) ? lscale[u.e * NTOK + rt * BM + r] : 0.f;
                float o[8];
#pragma unroll
                for (int n = 0; n < 2; ++n)
#pragma unroll
                    for (int e = 0; e < 4; ++e) { float g = acc[ai][0][m][n][e] * rs + bg[n][e], l = acc[ai][1][m][n][e] * rs + bl[n][e];
                        g = fminf(g, 7.0f); l = fminf(fmaxf(l, -7.0f), 7.0f); o[4 * n + e] = g * sigmoidf_(1.702f * g) * (l + 1.0f); }
                u32x4 w; w.x = cvt_pk_bf16(o[0], o[1]); w.y = cvt_pk_bf16(o[2], o[3]); w.z = cvt_pk_bf16(o[4], o[5]); w.w = cvt_pk_bf16(o[6], o[7]);
                *(u32x4*)(act + (size_t)(u.pm * BM + r) * 1024 + ch) = w; }
    }
};

struct EpiDown {
    static constexpr bool PERM = true;
    const int* list; const float* lgate; const float* b_down; bf16_t* y; const LAS int* tb;
    __device__ __forceinline__ void operator()(const f32x4 (&acc)[2][2][4][2], const Unit& u, int wr, int wc, int fr, int fq) const {
        const int r0 = wr * 64 + fr, col0 = u.pn * BM + wc * 32 + 8 * fq, rt = u.pm - tb[u.e];
        const float* bd = b_down + (size_t)u.e * 1024;
        f32x4 bv[2][2];
#pragma unroll
        for (int bj = 0; bj < 2; ++bj)
#pragma unroll
            for (int n = 0; n < 2; ++n) bv[bj][n] = *(const f32x4*)(bd + col0 + bj * HALF + 4 * n);
#pragma unroll
        for (int ai = 0; ai < 2; ++ai)
#pragma unroll
            for (int m = 0; m < 4; ++m) { const int r = r0 + ai * HALF + m * 16;
                if (r < u.rows) { const int li = u.e * NTOK + rt * BM + r; const int slot = list[li]; const float g = lgate[li];
                    bf16_t* rowp = y + (size_t)slot * 1024 + col0;
#pragma unroll
                    for (int bj = 0; bj < 2; ++bj) { const f32x4 v0 = (acc[ai][bj][m][0] + bv[bj][0]) * g, v1 = (acc[ai][bj][m][1] + bv[bj][1]) * g;
                        u32x4 w; w.x = cvt_pk_bf16(v0[0], v0[1]); w.y = cvt_pk_bf16(v0[2], v0[3]); w.z = cvt_pk_bf16(v1[0], v1[1]); w.w = cvt_pk_bf16(v1[2], v1[3]);
                        *(u32x4*)(rowp + bj * HALF) = w; } } }
    }
};

struct EpiPle {
    static constexpr bool PERM = false;
    const float* h2; const bf16_t* pj; const float* rs3; float* out;
    __device__ __forceinline__ void operator()(const f32x4 (&acc)[2][2][4][2], const Unit& u, int wr, int wc, int fr, int fq) const {
        const int row0 = u.pm * BM + wr * 64 + fr, col0 = u.pn * BM + wc * 32 + 4 * fq;
#pragma unroll
        for (int ai = 0; ai < 2; ++ai)
#pragma unroll
            for (int m = 0; m < 4; ++m) { const int row = row0 + ai * HALF + m * 16; const size_t off = (size_t)row * DM + col0; const float rs = rs3[row];
#pragma unroll
                for (int bj = 0; bj < 2; ++bj)
#pragma unroll
                    for (int n = 0; n < 2; ++n) { const size_t o = off + bj * HALF + n * 16; const f32x4 hv = *(const f32x4*)(h2 + o); const u32x2 pw = *(const u32x2*)(pj + o);
                        const f32x4 a = acc[ai][bj][m][n]; f32x4 r;
                        r[0] = hv[0] + bf_lo(pw.x) * sigmoidf_(a[0] * rs); r[1] = hv[1] + bf_hi(pw.x) * sigmoidf_(a[1] * rs);
                        r[2] = hv[2] + bf_lo(pw.y) * sigmoidf_(a[2] * rs); r[3] = hv[3] + bf_hi(pw.y) * sigmoidf_(a[3] * rs);
                        *(f32x4*)(out + o) = r; } }
    }
};

__device__ __forceinline__ void p0_transpose_item(const float* W, int ldw, bf16_t* WT, int Kdim, const float* gain, LAS float* scr, int kb, int n0, int src0, int nvalid, int lane) {
    const int k0 = 64 * kb;
    f32x4 ld4[8];
#pragma unroll
    for (int i = 0; i < 8; ++i) { const int kk = 8 * i + (lane >> 3), j = (lane & 7) * 4;
        ld4[i] = (f32x4){0.f, 0.f, 0.f, 0.f}; if (j < nvalid) ld4[i] = *(const f32x4*)(W + (size_t)(k0 + kk) * ldw + src0 + j); }
#pragma unroll
    for (int i = 0; i < 8; ++i) { const int kk = 8 * i + (lane >> 3), j = (lane & 7) * 4; const float gk = gain ? gain[k0 + kk] : 1.0f;
        LAS float* d = scr + kk * 33 + j; d[0] = ld4[i].x * gk; d[1] = ld4[i].y * gk; d[2] = ld4[i].z * gk; d[3] = ld4[i].w * gk; }
    LDS_WAIT(); asm volatile("" ::: "memory");
    const int c = lane & 7;
#pragma unroll
    for (int j = 0; j < 4; ++j) { const int n = (lane >> 3) + 8 * j; const LAS float* s = scr + (8 * c) * 33 + n;
        u32x4 o; o.x = pk2(s[0 * 33], s[1 * 33]); o.y = pk2(s[2 * 33], s[3 * 33]); o.z = pk2(s[4 * 33], s[5 * 33]); o.w = pk2(s[6 * 33], s[7 * 33]);
        *(u32x4*)(WT + (size_t)(n0 + n) * Kdim + k0 + 8 * c) = o; }
    LDS_WAIT(); asm volatile("" ::: "memory");
}
__device__ __forceinline__ void win_colmap(int nb, int& src0, int& nvalid) {
    const int pn = nb >> 3, j = (nb & 7) * 32, bj = j >> 7, slot = (j & 127) >> 5;
    nvalid = 32;
    if (pn < 2) src0 = (4 * pn + slot) * 64 + 32 * bj;
    else if (pn == 2) src0 = 640 + slot * 64 + 32 * bj;
    else if (pn == 3) { if (slot == 0) src0 = 512 + 32 * bj; else if (slot == 1) src0 = 896 + 32 * bj; else if (slot == 2) src0 = 576 + 32 * bj; else { src0 = 960; nvalid = bj == 0 ? 4 : 0; } }
    else src0 = 964 + 512 * bj + 128 * (pn - 4) + 32 * slot;
}
__device__ __forceinline__ void p0_prologue(const Params& P, LAS unsigned char* lds, int vcu, int G, int wave, int lane) {
    unsigned char* ws = P.ws;
    LAS float* scr = (LAS float*)(lds + wave * 16384);
    const int gw = vcu * NWAVES + wave, NGW = G * NWAVES;
    constexpr int I_IN = 16 * 64, I_OUT = 16 * 32, I_G = 16 * 32, I_P = 4 * 32, I_UP = 32 * 16 * 64, I_DN = 32 * 16 * 32;
    constexpr int NITEMS = I_IN + I_OUT + I_G + I_P + I_UP + I_DN;
    for (int it = gw; it < NITEMS; it += NGW) {
        int r = it;
        if (r < I_IN) { const int kb = r / 64, nb = r % 64; int s0, nv; win_colmap(nb, s0, nv); p0_transpose_item(P.w_in, INW, (bf16_t*)(ws + WS_WIN), 1024, P.g_mix, scr, kb, nb * 32, s0, nv, lane); continue; } r -= I_IN;
        if (r < I_OUT) { const int kb = r / 32, nb = r % 32; p0_transpose_item(P.w_out, 1024, (bf16_t*)(ws + WS_WOUT), 1024, nullptr, scr, kb, nb * 32, nb * 32, 32, lane); continue; } r -= I_OUT;
        if (r < I_G) { const int kb = r / 32, nb = r % 32; p0_transpose_item(P.w_ple_gate, 1024, (bf16_t*)(ws + WS_WG), 1024, P.g_ple, scr, kb, nb * 32, nb * 32, 32, lane); continue; } r -= I_G;
        if (r < I_P) { const int kb = r / 32, nb = r % 32; p0_transpose_item(P.w_ple_proj, 1024, (bf16_t*)(ws + WS_WP), 256, nullptr, scr, kb, nb * 32, nb * 32, 32, lane); continue; } r -= I_P;
        if (r < I_UP) { const int e = r / 1024, rr = r % 1024, kb = rr / 64, nb = rr % 64;
            const int pn = nb >> 3, j = (nb & 7) * 32, bj = j >> 7, jj = j & 127;
            p0_transpose_item(P.w_up + (size_t)e * 1024 * 2048, 2048, (bf16_t*)(ws + WS_WUP) + (size_t)e * 2048 * 1024, 1024, P.g_ffn, scr, kb, nb * 32, 1024 * bj + 128 * pn + jj, 32, lane); continue; } r -= I_UP;
        { const int e = r / 512, rr = r % 512, kb = rr / 32, nb = rr % 32;
            p0_transpose_item(P.w_down + (size_t)e * 1024 * 1024, 1024, (bf16_t*)(ws + WS_WDOWN) + (size_t)e * 1024 * 1024, 1024, nullptr, scr, kb, nb * 32, nb * 32, 32, lane); }
    }
    float* rs1 = (float*)(ws + WS_RS1); bf16_t* xb = (bf16_t*)(ws + WS_XB);
    for (int m = gw; m < NTOK; m += NGW) {
        const f32x4* xr = (const f32x4*)(P.x + (size_t)m * DM) + lane; f32x4 v[4]; float s = 0.f;
#pragma unroll
        for (int j = 0; j < 4; ++j) { v[j] = xr[64 * j]; s += (v[j].x * v[j].x + v[j].y * v[j].y) + (v[j].z * v[j].z + v[j].w * v[j].w); }
        s = wave_sum(s);
        u32x2* o8 = (u32x2*)(xb + (size_t)m * DM) + lane;
#pragma unroll
        for (int j = 0; j < 4; ++j) { u32x2 w; w.x = pk2(v[j].x, v[j].y); w.y = pk2(v[j].z, v[j].w); o8[64 * j] = w; }
        if (lane == 0) rs1[m] = 1.0f / sqrtf(s * (1.0f / DM) + EPS);
    }
    bf16_t* pb = (bf16_t*)(ws + WS_PB);
    for (int m = gw; m < NTOK; m += NGW) { const f32x4 v = *((const f32x4*)(P.p + (size_t)m * 256) + lane); u32x2 w; w.x = pk2(v.x, v.y); w.y = pk2(v.z, v.w); *((u32x2*)(pb + (size_t)m * 256) + lane) = w; }
    f32x2* rope = (f32x2*)(ws + WS_ROPE);
    for (int idx = gw * 64 + lane; idx < SEQ * 32; idx += NGW * 64) { const int t = idx >> 5, i = idx & 31;
        const float inv = exp2f(-(float)i * (13.287712379549449f / 32.0f));
        const float ang = (float)t * inv;
        const double rev = (double)ang * 0.15915494309189535; const float fr = (float)(rev - __builtin_floor(rev));
        rope[idx] = (f32x2){__builtin_amdgcn_cosf(fr), __builtin_amdgcn_sinf(fr)}; }
    float* wrg = (float*)(ws + WS_WRG);
    for (int idx = gw * 64 + lane; idx < 1024 * 32; idx += NGW * 64) wrg[idx] = P.w_router[idx] * P.g_ffn[idx >> 5];
}

__device__ __forceinline__ unsigned fkey(float f) { unsigned u = __builtin_bit_cast(unsigned, f); if (u == 0x80000000u) u = 0u; return u ^ ((unsigned)((int)u >> 31) | 0x80000000u); }
__device__ __forceinline__ int mbcnt64(unsigned long long m) { return __builtin_amdgcn_mbcnt_hi((unsigned)(m >> 32), __builtin_amdgcn_mbcnt_lo((unsigned)m, 0u)); }

template <int NR>
__device__ __forceinline__ void select_topk(const LAS float* row, LAS unsigned* list, int lane) {
    unsigned v[NR];
#pragma unroll
    for (int r = 0; r < NR; ++r) v[r] = fkey(row[r * 64 + lane]);
    unsigned prefix = 0u; bool exact = false;
#pragma unroll 1
    for (int bit = 31; bit >= 0; --bit) {
        const unsigned cand = prefix | (1u << bit); int cnt = 0;
#pragma unroll
        for (int r = 0; r < NR; ++r) { cnt += __builtin_popcountll(__ballot(v[r] >= cand)); if ((r & 7) == 7) __builtin_amdgcn_sched_barrier(0); }
        if (cnt >= NSEL) prefix = cand;
        if (cnt == NSEL) { exact = true; break; }
    }
    const unsigned T = exact ? prefix - 1u : prefix; int cgt = NSEL;
    if (!exact) { cgt = 0;
#pragma unroll
        for (int r = 0; r < NR; ++r) { cgt += __builtin_popcountll(__ballot(v[r] > T)); if ((r & 7) == 7) __builtin_amdgcn_sched_barrier(0); } }
    const int need = NSEL - cgt; int base = 0, ties = 0;
#pragma unroll
    for (int r = 0; r < NR; ++r) { const bool gt = v[r] > T, eq = v[r] == T; const unsigned long long em = __ballot(eq);
        const bool sel = gt || (eq && (ties + mbcnt64(em)) < need); const unsigned long long sm = __ballot(sel);
        list[sel ? base + mbcnt64(sm) : NSEL + lane] = (unsigned)(r * 64 + lane);
        base += __builtin_popcountll(sm); ties += __builtin_popcountll(em);
        if ((r & 3) == 3) __builtin_amdgcn_sched_barrier(0); }
}

typedef short v4i16 __attribute__((ext_vector_type(4)));
constexpr int VROW = 144;

__device__ __forceinline__ void attn_tile(const Params& P, LAS unsigned char* lds, int b, int t0, int wave, int lane) {
    unsigned char* ws = P.ws;
    const bf16_t* QI = (const bf16_t*)(ws + WS_QI); const bf16_t* KI = (const bf16_t*)(ws + WS_KI);
    const bf16_t* Q = (const bf16_t*)(ws + WS_Q); const bf16_t* Kp = (const bf16_t*)(ws + WS_K); const bf16_t* Vp = (const bf16_t*)(ws + WS_V);
    const float* WI = (const float*)(ws + WS_WI); bf16_t* MIX = (bf16_t*)(ws + WS_MIX);
    LAS float* SC = (LAS float*)lds;
    LAS unsigned* list = (LAS unsigned*)(lds + LDS_MISC + 1024) + wave * 384;
    const int tokbase = b * SEQ;
    const bool need_sel = t0 >= 256;
    if (need_sel) {
        const int nkt = (t0 + 8 + 31) >> 5;
        bf16x8 a[4]; f32x4 w[4];
        { const bf16_t* src = QI + (size_t)(tokbase + t0 + ((lane & 31) >> 2)) * 256 + (lane & 3) * 64 + 8 * (lane >> 5);
#pragma unroll
          for (int ks = 0; ks < 4; ++ks) a[ks] = *(const bf16x8*)(src + 16 * ks); }
#pragma unroll
        for (int g = 0; g < 4; ++g) w[g] = *(const f32x4*)(WI + (size_t)(tokbase + t0 + 2 * g + (lane >> 5)) * 4);
        for (int rp = 0; rp <= (P.rep & 1); ++rp)
        for (int kt = wave; kt < nkt; kt += NWAVES) {
            const int key = kt * 32 + (lane & 31);
            const bf16_t* ksrc = KI + (size_t)(tokbase + key) * 64 + 8 * (lane >> 5);
            bf16x8 bf[4];
#pragma unroll
            for (int ks = 0; ks < 4; ++ks) bf[ks] = *(const bf16x8*)(ksrc + 16 * ks);
            f32x16 acc;
#pragma unroll
            for (int i = 0; i < 16; ++i) acc[i] = 0.f;
#pragma unroll
            for (int ks = 0; ks < 4; ++ks) acc = __builtin_amdgcn_mfma_f32_32x32x16_bf16(a[ks], bf[ks], acc, 0, 0, 0);
#pragma unroll
            for (int g = 0; g < 4; ++g) { float s = 0.f;
#pragma unroll
                for (int h = 0; h < 4; ++h) s = fmaf(fmaxf(acc[4 * g + h], 0.f), w[g][h], s);
                const int ql = 2 * g + (lane >> 5);
                if (key > t0 + ql) s = -INFINITY;
                SC[ql * 4096 + key] = s; }
        }
        { const int npad = ((t0 + 8 + 1023) >> 10) << 10;
          for (int i = nkt * 32 + (int)threadIdx.x; i < npad; i += NTHR) {
#pragma unroll
              for (int q = 0; q < 8; ++q) SC[q * 4096 + i] = -INFINITY; } }
    }
    __syncthreads();
    const int t = t0 + wave, tok = tokbase + t;
    for (int rp = 0; rp <= ((P.rep >> 1) & 1); ++rp)
    if (need_sel) {
        const LAS float* row = SC + wave * 4096; const int n = t + 1;
        if (n <= 1024) select_topk<16>(row, list, lane);
        else if (n <= 2048) select_topk<32>(row, list, lane);
        else if (n <= 3072) select_topk<48>(row, list, lane);
        else select_topk<64>(row, list, lane);
    } else {
#pragma unroll
        for (int i = 0; i < 4; ++i) list[i * 64 + lane] = (unsigned)(i * 64 + lane);
    }
    __syncthreads();
    const int nvalid = need_sel ? NSEL : (t + 1);
    const int ngrp = (nvalid + 31) >> 5;
    const int hd = lane & 15, g = lane >> 4;
    bf16x8 qf0, qf1;
#pragma unroll
    for (int i = 0; i < 8; ++i) { qf0[i] = 0; qf1[i] = 0; }
    if (hd < 8) { const bf16_t* qs = Q + (size_t)tok * 512 + hd * 64 + 8 * g; qf0 = *(const bf16x8*)qs; qf1 = *(const bf16x8*)(qs + 32); }
    float m = -INFINITY, ssum = 0.f;
    f32x4 o[4];
#pragma unroll
    for (int dt = 0; dt < 4; ++dt) o[dt] = (f32x4){0.f, 0.f, 0.f, 0.f};
    LAS unsigned char* vreg = lds + wave * 16384;
    bf16x8 kf[4]; u32x4 vv[4];
    { const unsigned ia = list[hd], ib = list[16 + hd];
      const bf16_t* ka = Kp + (size_t)(tokbase + ia) * 64 + 8 * g; const bf16_t* kb = Kp + (size_t)(tokbase + ib) * 64 + 8 * g;
      kf[0] = *(const bf16x8*)ka; kf[1] = *(const bf16x8*)(ka + 32); kf[2] = *(const bf16x8*)kb; kf[3] = *(const bf16x8*)(kb + 32);
#pragma unroll
      for (int i = 0; i < 4; ++i) { const unsigned idx = list[(lane >> 3) + 8 * i]; vv[i] = *(const u32x4*)(Vp + (size_t)(tokbase + idx) * 64 + 8 * (lane & 7)); } }
#pragma unroll 1
    for (int grp = 0; grp < ngrp; ++grp) {
        LAS unsigned char* vbuf = vreg + (grp & 1) * 8192;
#pragma unroll
        for (int i = 0; i < 4; ++i) *(LAS u32x4*)(vbuf + ((lane >> 3) + 8 * i) * VROW + (lane & 7) * 16) = vv[i];
        f32x4 sa = {0.f, 0.f, 0.f, 0.f}, sb = {0.f, 0.f, 0.f, 0.f};
        sa = __builtin_amdgcn_mfma_f32_16x16x32_bf16(kf[0], qf0, sa, 0, 0, 0); sa = __builtin_amdgcn_mfma_f32_16x16x32_bf16(kf[1], qf1, sa, 0, 0, 0);
        sb = __builtin_amdgcn_mfma_f32_16x16x32_bf16(kf[2], qf0, sb, 0, 0, 0); sb = __builtin_amdgcn_mfma_f32_16x16x32_bf16(kf[3], qf1, sb, 0, 0, 0);
        if (grp + 1 < ngrp) {
            const int nb = (grp + 1) * 32; const unsigned ia = list[nb + hd], ib = list[nb + 16 + hd];
            const bf16_t* ka = Kp + (size_t)(tokbase + ia) * 64 + 8 * g; const bf16_t* kb = Kp + (size_t)(tokbase + ib) * 64 + 8 * g;
            kf[0] = *(const bf16x8*)ka; kf[1] = *(const bf16x8*)(ka + 32); kf[2] = *(const bf16x8*)kb; kf[3] = *(const bf16x8*)(kb + 32);
#pragma unroll
            for (int i = 0; i < 4; ++i) { const unsigned idx = list[nb + (lane >> 3) + 8 * i]; vv[i] = *(const u32x4*)(Vp + (size_t)(tokbase + idx) * 64 + 8 * (lane & 7)); }
        }
        float l[8]; float mloc = -INFINITY;
#pragma unroll
        for (int r = 0; r < 4; ++r) { const int sl = grp * 32 + 4 * g + r;
            l[r] = sl < nvalid ? sa[r] * 0.125f : -INFINITY; l[4 + r] = (sl + 16) < nvalid ? sb[r] * 0.125f : -INFINITY;
            mloc = fmaxf(mloc, fmaxf(l[r], l[4 + r])); }
        mloc = fmaxf(mloc, __shfl_xor(mloc, 16)); mloc = fmaxf(mloc, __shfl_xor(mloc, 32));
        const float mnew = fmaxf(m, mloc), alpha = __expf(m - mnew); m = mnew;
        float ps = 0.f;
#pragma unroll
        for (int r = 0; r < 8; ++r) { l[r] = __expf(l[r] - mnew); ps += l[r]; }
        ssum = ssum * alpha + ps;
        bf16x8 pf;
        { const u32x4 pw = {cvt_pk_bf16(l[0], l[1]), cvt_pk_bf16(l[2], l[3]), cvt_pk_bf16(l[4], l[5]), cvt_pk_bf16(l[6], l[7])}; pf = __builtin_bit_cast(bf16x8, pw); }
        LAS unsigned char* ta = vbuf + (4 * g + (hd >> 2)) * VROW + (hd & 3) * 8;
#pragma unroll
        for (int dt = 0; dt < 4; ++dt) {
            const v4i16 lo = __builtin_amdgcn_ds_read_tr16_b64_v4i16((LAS v4i16*)(ta + dt * 32));
            const v4i16 hi = __builtin_amdgcn_ds_read_tr16_b64_v4i16((LAS v4i16*)(ta + 16 * VROW + dt * 32));
            bf16x8 vf; vf[0] = lo[0]; vf[1] = lo[1]; vf[2] = lo[2]; vf[3] = lo[3]; vf[4] = hi[0]; vf[5] = hi[1]; vf[6] = hi[2]; vf[7] = hi[3];
            o[dt] = __builtin_amdgcn_mfma_f32_16x16x32_bf16(vf, pf, o[dt] * alpha, 0, 0, 0);
        }
    }
    ssum += __shfl_xor(ssum, 16); ssum += __shfl_xor(ssum, 32);
    const float inv = 1.0f / ssum;
    if (hd < 8) {
        bf16_t* op = MIX + (size_t)tok * 1024 + hd * 64 + 4 * g;
#pragma unroll
        for (int dt = 0; dt < 4; ++dt) { u32x2 w; w.x = cvt_pk_bf16(o[dt][0] * inv, o[dt][1] * inv); w.y = cvt_pk_bf16(o[dt][2] * inv, o[dt][3] * inv); *(u32x2*)(op + 16 * dt) = w; }
    }
    __syncthreads();
}

__device__ __forceinline__ void conv_tile(const Params& P, LAS unsigned char* lds, int tile, int tid, int wave, int lane) {
    unsigned char* ws = P.ws;
    const bf16_t* HG = (const bf16_t*)(ws + WS_HGLU); bf16_t* MIX = (bf16_t*)(ws + WS_MIX);
    LAS f32x2* part = (LAS f32x2*)(lds + LDS_MISC + 1024);
    LAS f32x2* stat = part + 256;
    const int tok0 = tile * 32, t0 = tok0 & (SEQ - 1), c = tid;
    float in[62];
#pragma unroll
    for (int r = 0; r < 62; ++r) { const int tt = t0 - 30 + r; in[r] = tt >= 0 ? __builtin_bit_cast(float, (unsigned)HG[(size_t)(tok0 - 30 + r) * 512 + c] << 16) : 0.f; }
    float out[32];
    const float bias = P.dw_b[c];
#pragma unroll
    for (int i = 0; i < 32; ++i) out[i] = bias;
#pragma unroll
    for (int j = 0; j < 31; ++j) { const float wj = P.dw_w[j * 512 + c];
#pragma unroll
        for (int i = 0; i < 32; ++i) out[i] = fmaf(in[i + j], wj, out[i]); }
#pragma unroll
    for (int i = 0; i < 32; ++i) { const float s1 = wave_sum(out[i]), s2 = wave_sum(out[i] * out[i]); if (lane == 0) part[i * 8 + wave] = (f32x2){s1, s2}; }
    __syncthreads();
    if (tid < 32) { float s1 = 0.f, s2 = 0.f;
#pragma unroll
        for (int w = 0; w < 8; ++w) { const f32x2 pp = part[tid * 8 + w]; s1 += pp.x; s2 += pp.y; }
        const float mean = s1 * (1.0f / 512.0f), var = fmaxf(s2 * (1.0f / 512.0f) - mean * mean, 0.f);
        stat[tid] = (f32x2){mean, 1.0f / sqrtf(var + EPS)}; }
    __syncthreads();
    const float lgc = P.ln_g[c], lbc = P.ln_b[c];
#pragma unroll
    for (int i = 0; i < 32; ++i) { const f32x2 st = stat[i]; const float y = (out[i] - st.x) * st.y * lgc + lbc; const float sl = y * sigmoidf_(y);
        MIX[(size_t)(tok0 + i) * 1024 + 512 + c] = (bf16_t)f2bf(sl); }
    __syncthreads();
}

__device__ __forceinline__ void router_phase(const Params& P, LAS unsigned char* lds, int blk, int G, int tid, int wave, int lane) {
    unsigned char* ws = P.ws;
    const float* h1 = (const float*)(ws + WS_H1); const float* wrg = (const float*)(ws + WS_WRG);
    int* list = (int*)(ws + WS_LIST); float* lscale = (float*)(ws + WS_LSCALE); float* lgate = (float*)(ws + WS_LGATE);
    unsigned* cntg = (unsigned*)(ws + WS_CTL) + CW_CNT;
    LAS float* WL = (LAS float*)lds;
    LAS int* lcnt = (LAS int*)(lds + LDS_MISC + 1024);
    LAS int* gbase = lcnt + 32;
    LAS int* rec_e = gbase + 32;
    LAS int* rec_p = rec_e + 512;
    LAS float* rec_g = (LAS float*)(rec_p + 512);
    LAS float* rec_s = rec_g + 512;
    for (int i = tid; i < 8192; i += NTHR) ((LAS f32x4*)WL)[i] = ((const f32x4*)wrg)[i];
    __syncthreads();
    const int e = lane & 31, kh = lane >> 5;
    const float be = P.b_router[e];
    for (int chunk = blk; chunk < NTOK / 128; chunk += G) {
        if (tid < 32) lcnt[tid] = 0;
        __syncthreads();
#pragma unroll 1
        for (int gi = 0; gi < 2; ++gi) {
            const int tl0 = wave * 16 + gi * 8, tok0 = chunk * 128 + tl0;
            float acc[8], ss[8];
#pragma unroll
            for (int tk = 0; tk < 8; ++tk) { acc[tk] = 0.f; ss[tk] = 0.f; }
#pragma unroll 2
            for (int k4 = 0; k4 < 128; ++k4) {
                const int k = kh * 512 + k4 * 4;
                const float w0 = WL[(k + 0) * 32 + e], w1 = WL[(k + 1) * 32 + e], w2 = WL[(k + 2) * 32 + e], w3 = WL[(k + 3) * 32 + e];
#pragma unroll
                for (int tk = 0; tk < 8; ++tk) { const f32x4 hv = *(const f32x4*)(h1 + (size_t)(tok0 + tk) * DM + k);
                    acc[tk] = fmaf(hv.x, w0, fmaf(hv.y, w1, fmaf(hv.z, w2, fmaf(hv.w, w3, acc[tk]))));
                    ss[tk] = fmaf(hv.x, hv.x, fmaf(hv.y, hv.y, fmaf(hv.z, hv.z, fmaf(hv.w, hv.w, ss[tk])))); }
            }
#pragma unroll
            for (int tk = 0; tk < 8; ++tk) {
                const float a = acc[tk] + __shfl_xor(acc[tk], 32), s = ss[tk] + __shfl_xor(ss[tk], 32);
                const float rs = 1.0f / sqrtf(s * (1.0f / DM) + EPS);
                float val = a * rs + be;
                float tv[4]; int te[4];
#pragma unroll
                for (int r = 0; r < 4; ++r) { float bv = val; int bi = e;
#pragma unroll
                    for (int off = 16; off >= 1; off >>= 1) { const float ov = __shfl_xor(bv, off); const int oi = __shfl_xor(bi, off); if (ov > bv || (ov == bv && oi < bi)) { bv = ov; bi = oi; } }
                    tv[r] = bv; te[r] = bi; if (e == bi) val = -INFINITY; }
                const float e0 = 1.0f, e1 = __expf(tv[1] - tv[0]), e2 = __expf(tv[2] - tv[0]), e3 = __expf(tv[3] - tv[0]);
                const float is = 1.0f / (e0 + e1 + e2 + e3);
                if (lane < 4) { const int myE = lane == 0 ? te[0] : lane == 1 ? te[1] : lane == 2 ? te[2] : te[3];
                    const float myG = (lane == 0 ? e0 : lane == 1 ? e1 : lane == 2 ? e2 : e3) * is;
                    const int lp = atomicAdd((int*)&lcnt[myE], 1);
                    const int si = (tl0 + tk) * 4 + lane; rec_e[si] = myE; rec_p[si] = lp; rec_g[si] = myG; if (lane == 0) rec_s[tl0 + tk] = rs; }
            }
        }
        __syncthreads();
        if (tid < 32) gbase[tid] = (int)atomicAdd(cntg + 64 * tid, (unsigned)lcnt[tid]);
        __syncthreads();
        { const int si = tid, ee = rec_e[si], pos = gbase[ee] + rec_p[si], li = ee * NTOK + pos;
          list[li] = (chunk * 128) * 4 + si; lscale[li] = rec_s[si >> 2]; lgate[li] = rec_g[si]; }
        __syncthreads();
    }
}

__device__ __forceinline__ void combine_phase(const Params& P, int gw, int NGW, int lane) {
    unsigned char* ws = P.ws;
    float* h1 = (float*)(ws + WS_H1); bf16_t* h1b = (bf16_t*)(ws + WS_H1B); const bf16_t* y = (const bf16_t*)(ws + WS_Y); float* rs3 = (float*)(ws + WS_RS3);
    for (int m = gw; m < NTOK; m += NGW) {
        f32x4* hr = (f32x4*)(h1 + (size_t)m * DM) + lane; f32x4 v[4]; float s = 0.f;
#pragma unroll
        for (int j = 0; j < 4; ++j) v[j] = hr[64 * j];
#pragma unroll
        for (int k = 0; k < 4; ++k) { const u32x2* yr = (const u32x2*)(y + (size_t)(m * 4 + k) * DM) + lane;
#pragma unroll
            for (int j = 0; j < 4; ++j) { const u32x2 w = yr[64 * j]; v[j].x += bf_lo(w.x); v[j].y += bf_hi(w.x); v[j].z += bf_lo(w.y); v[j].w += bf_hi(w.y); } }
        u32x2* o8 = (u32x2*)(h1b + (size_t)m * DM) + lane;
#pragma unroll
        for (int j = 0; j < 4; ++j) { hr[64 * j] = v[j]; u32x2 w; w.x = pk2(v[j].x, v[j].y); w.y = pk2(v[j].z, v[j].w); o8[64 * j] = w;
            s += (v[j].x * v[j].x + v[j].y * v[j].y) + (v[j].z * v[j].z + v[j].w * v[j].w); }
        s = wave_sum(s);
        if (lane == 0) rs3[m] = 1.0f / sqrtf(s * (1.0f / DM) + EPS);
    }
}

__device__ __forceinline__ void final_phase(const Params& P, int gw, int NGW, int lane) {
    f32x4 gv[4];
#pragma unroll
    for (int j = 0; j < 4; ++j) gv[j] = *((const f32x4*)P.g_final + lane + 64 * j);
    for (int m = gw; m < NTOK; m += NGW) {
        f32x4* orow = (f32x4*)(P.out + (size_t)m * DM) + lane; f32x4 v[4]; float s = 0.f;
#pragma unroll
        for (int j = 0; j < 4; ++j) { v[j] = orow[64 * j]; s += (v[j].x * v[j].x + v[j].y * v[j].y) + (v[j].z * v[j].z + v[j].w * v[j].w); }
        s = wave_sum(s); const float rs = 1.0f / sqrtf(s * (1.0f / DM) + EPS);
#pragma unroll
        for (int j = 0; j < 4; ++j) orow[64 * j] = v[j] * rs * gv[j];
    }
}

constexpr int NPHASE = 10;
__global__ void __launch_bounds__(NTHR, 2) fwd_kernel(Params P) {
    extern __shared__ __attribute__((aligned(16))) unsigned char lds_raw[];
    LAS unsigned char* lds = (LAS unsigned char*)lds_raw;
    cg::grid_group grid = cg::this_grid();
    const int tid = threadIdx.x, lane = tid & 63, wave = __builtin_amdgcn_readfirstlane(tid >> 6);
    const int G = gridDim.x, bx = blockIdx.x;
    const int vcu = (G % 8 == 0) ? (bx % 8) * (G / 8) + bx / 8 : bx;
    const int gw = vcu * NWAVES + wave, NGW = G * NWAVES;
    unsigned char* ws = P.ws;
    const int lo = P.ph_lo, hi = P.ph_hi;
#ifndef PH_MASK
#define PH_MASK 0x3ff
#endif
#define IN(k) ((((PH_MASK) >> (k)) & 1) && lo <= (k) && (k) < hi)
#define SYNC(k) do { if (IN(k) && IN((k) + 1)) grid.sync(); } while (0)

    if (IN(0)) p0_prologue(P, lds, vcu, G, wave, lane);
    SYNC(0);
    if (IN(1)) {
        { pg8::DenseSched S; S.init((const bf16_t*)(ws + WS_XB), (const bf16_t*)(ws + WS_WIN), NTOK, 2048, 1024, G, bx);
          EpiInProj E{(const float*)(ws + WS_RS1), (const f32x2*)(ws + WS_ROPE), P.glu_b, (bf16_t*)(ws + WS_Q), (bf16_t*)(ws + WS_K), (bf16_t*)(ws + WS_V), (bf16_t*)(ws + WS_QI), (bf16_t*)(ws + WS_KI), (bf16_t*)(ws + WS_HGLU), (float*)(ws + WS_WI)};
          pg8::gemm_phase<EpiInProj, pg8::DenseSched, false>(lds, S, E); }
        { pg8::DenseSched S; S.init((const bf16_t*)(ws + WS_PB), (const bf16_t*)(ws + WS_WP), NTOK, 1024, 256, G, bx);
          EpiBf16Plain E{(bf16_t*)(ws + WS_PJ), 1024};
          pg8::gemm_phase<EpiBf16Plain, pg8::DenseSched, false>(lds, S, E); }
    }
    SYNC(1);
    if (IN(2)) {
        if (G % 8 == 0) { const int b = bx % 8, jb = bx / 8, nbb = G / 8;
            for (int i = 0;; ++i) { const int k = i * nbb + ((i & 1) ? nbb - 1 - jb : jb); if (k >= 512) break; attn_tile(P, lds, b, (511 - k) * 8, wave, lane); } }
        else { for (int tl = bx; tl < 4096; tl += G) attn_tile(P, lds, tl & 7, (511 - (tl >> 3)) * 8, wave, lane); }
        for (int rp = 0; rp <= ((P.rep >> 3) & 1); ++rp)
        for (int tl = vcu; tl < NTOK / 32; tl += G) conv_tile(P, lds, tl, tid, wave, lane);
    }
    SYNC(2);
    if (IN(3)) {
        pg8::DenseSched S; S.init((const bf16_t*)(ws + WS_MIX), (const bf16_t*)(ws + WS_WOUT), NTOK, 1024, 1024, G, bx);
        EpiOutProj E{P.x, (float*)(ws + WS_H1), (bf16_t*)(ws + WS_H1B)};
        pg8::gemm_phase<EpiOutProj, pg8::DenseSched, false>(lds, S, E);
    }
    SYNC(3);
    if (IN(4)) router_phase(P, lds, vcu, G, tid, wave, lane);
    SYNC(4);
    if (IN(5) || IN(6)) {
        LAS int* tb = (LAS int*)(lds + LDS_MISC); LAS int* cn = tb + 64;
        if (tid == 0) { const unsigned* cntg = (const unsigned*)(ws + WS_CTL) + CW_CNT; int acc = 0;
            for (int e = 0; e < NE; ++e) { const int c = (int)__hip_atomic_load(cntg + 64 * e, __ATOMIC_RELAXED, __HIP_MEMORY_SCOPE_AGENT); tb[e] = acc; cn[e] = c; acc += (c + BM - 1) / BM; }
            tb[NE] = acc; }
        __syncthreads();
        if (IN(5)) {
            pg8::MoeSched S; S.A = (const bf16_t*)(ws + WS_H1B); S.Bt = (const bf16_t*)(ws + WS_WUP); S.K = 1024; S.b_estride = (size_t)2048 * 1024 * 2; S.tb = tb; S.cnt = cn; S.list = (const int*)(ws + WS_LIST);
            S.nN = 8; S.nwg = tb[NE] * 8; S.G = G; S.c = bx; S.gather = true;
            EpiUp E{(const float*)(ws + WS_LSCALE), P.b_up, (bf16_t*)(ws + WS_ACT), tb};
            pg8::gemm_phase<EpiUp, pg8::MoeSched, true>(lds, S, E);
        }
        SYNC(5);
        if (IN(6)) {
            pg8::MoeSched S; S.A = (const bf16_t*)(ws + WS_ACT); S.Bt = (const bf16_t*)(ws + WS_WDOWN); S.K = 1024; S.b_estride = (size_t)1024 * 1024 * 2; S.tb = tb; S.cnt = cn; S.list = (const int*)(ws + WS_LIST);
            S.nN = 4; S.nwg = tb[NE] * 4; S.G = G; S.c = bx; S.gather = false;
            EpiDown E{(const int*)(ws + WS_LIST), (const float*)(ws + WS_LGATE), P.b_down, (bf16_t*)(ws + WS_Y), tb};
            pg8::gemm_phase<EpiDown, pg8::MoeSched, false>(lds, S, E);
        }
    }
    SYNC(6);
    if (IN(7)) combine_phase(P, gw, NGW, lane);
    SYNC(7);
    if (IN(8)) {
        pg8::DenseSched S; S.init((const bf16_t*)(ws + WS_H1B), (const bf16_t*)(ws + WS_WG), NTOK, 1024, 1024, G, bx);
        EpiPle E{(const float*)(ws + WS_H1), (const bf16_t*)(ws + WS_PJ), (const float*)(ws + WS_RS3), P.out};
        pg8::gemm_phase<EpiPle, pg8::DenseSched, false>(lds, S, E);
    }
    SYNC(8);
    if (IN(9)) final_phase(P, gw, NGW, lane);
#undef IN
#undef SYNC
}

#ifndef N_LAUNCH_MODE
#define N_LAUNCH_MODE 1
#endif
extern "C" void kernel_launch(void* const* d_in, const int* in_sizes, int n_in, void* d_out, int out_size, void* d_ws, size_t ws_size, hipStream_t stream) {
    static int grid = 0;
    if (grid == 0) {
        if (n_in != 21 || out_size != NTOK * DM || ws_size < WS_END) { fprintf(stderr, "kernel_launch: unexpected shapes (n_in %d out %d ws %zu)\n", n_in, out_size, ws_size); grid = -1; return; }
        int dev = 0, cus = 0, per_cu = 0;
        (void)hipGetDevice(&dev); (void)hipDeviceGetAttribute(&cus, hipDeviceAttributeMultiprocessorCount, dev);
        (void)hipFuncSetAttribute((const void*)fwd_kernel, hipFuncAttributeMaxDynamicSharedMemorySize, LDS_BYTES);
        if (hipOccupancyMaxActiveBlocksPerMultiprocessor(&per_cu, (const void*)fwd_kernel, NTHR, LDS_BYTES) != hipSuccess || per_cu < 1) { fprintf(stderr, "kernel_launch: occupancy query failed (%d)\n", per_cu); (void)hipGetLastError(); grid = -1; return; }
        grid = cus;
    }
    if (grid < 0) return;
    (void)hipMemsetAsync((char*)d_ws + WS_CTL, 0, CTL_BYTES, stream);
    Params p{};
    p.x = (const float*)d_in[0]; p.p = (const float*)d_in[1]; p.w_in = (const float*)d_in[2]; p.w_out = (const float*)d_in[3]; p.g_mix = (const float*)d_in[4]; p.g_ffn = (const float*)d_in[5];
    p.glu_b = (const float*)d_in[6]; p.dw_w = (const float*)d_in[7]; p.dw_b = (const float*)d_in[8]; p.ln_g = (const float*)d_in[9]; p.ln_b = (const float*)d_in[10];
    p.w_router = (const float*)d_in[11]; p.b_router = (const float*)d_in[12]; p.w_up = (const float*)d_in[13]; p.b_up = (const float*)d_in[14]; p.w_down = (const float*)d_in[15]; p.b_down = (const float*)d_in[16];
    p.w_ple_proj = (const float*)d_in[17]; p.w_ple_gate = (const float*)d_in[18]; p.g_ple = (const float*)d_in[19]; p.g_final = (const float*)d_in[20];
    p.out = (float*)d_out; p.ws = (unsigned char*)d_ws;
#ifndef PROBE_REPMASK
#define PROBE_REPMASK 0
#endif
    p.rep = PROBE_REPMASK;
#if N_LAUNCH_MODE == 1
    p.ph_lo = 0; p.ph_hi = NPHASE;
    void* args[] = {&p};
    hipError_t e = hipLaunchCooperativeKernel((const void*)fwd_kernel, dim3(grid), dim3(NTHR), args, LDS_BYTES, stream);
    if (e != hipSuccess) fprintf(stderr, "cooperative launch failed: %s (grid %d)\n", hipGetErrorString(e), grid);
#else
    for (int ph = 0; ph < NPHASE; ++ph) {
        p.ph_lo = ph; p.ph_hi = ph + 1;
        void* args[] = {&p};
        hipError_t e = hipLaunchCooperativeKernel((const void*)fwd_kernel, dim3(grid), dim3(NTHR), args, LDS_BYTES, stream);
        if (e != hipSuccess) { fprintf(stderr, "launch %d failed: %s (grid %d)\n", ph, hipGetErrorString(e), grid); break; }
    }
#endif
}
```

```cpp
#include <hip/hip_runtime.h>
#include <hip/hip_cooperative_groups.h>
#include <cstdio>
#include <cstdint>
namespace cg = cooperative_groups;

#define LAS __attribute__((address_space(3)))
#define GAS __attribute__((address_space(1)))
typedef unsigned short bf16_t;
typedef short bf16x8 __attribute__((ext_vector_type(8)));
typedef short s16x4 __attribute__((ext_vector_type(4)));
typedef float f32x4 __attribute__((ext_vector_type(4)));
typedef float f32x2 __attribute__((ext_vector_type(2)));
typedef float f32x16 __attribute__((ext_vector_type(16)));
typedef unsigned u32x4 __attribute__((ext_vector_type(4)));
typedef unsigned u32x2 __attribute__((ext_vector_type(2)));

constexpr int NB = 8, SEQ = 4096, DM = 1024, NTOK = NB * SEQ;
constexpr int NE = 32, TOPK = 4, NSLOT = NTOK * TOPK;
constexpr int INW = 1988;
constexpr int NSEL = 256;
constexpr float EPS = 1e-6f;
constexpr int NWAVES = 8, NTHR = 512;

constexpr size_t MiB = 1u << 20;
constexpr size_t WS_CTL = 0, CTL_BYTES = 64 * 1024;
constexpr size_t WS_ROPE = 1 * MiB;
constexpr size_t WS_WIN = 2 * MiB;
constexpr size_t WS_WOUT = 6 * MiB;
constexpr size_t WS_WG = 8 * MiB;
constexpr size_t WS_WP = 10 * MiB;
constexpr size_t WS_WRG = 10 * MiB + 512 * 1024;
constexpr size_t WS_RS1 = 11 * MiB;
constexpr size_t WS_RS3 = 11 * MiB + 512 * 1024;
constexpr size_t WS_WI = 12 * MiB;
constexpr size_t WS_LIST = 13 * MiB;
constexpr size_t WS_LSCALE = 17 * MiB;
constexpr size_t WS_LGATE = 21 * MiB;
constexpr size_t WS_PB = 25 * MiB;
constexpr size_t WS_WUP = 42 * MiB;
constexpr size_t WS_WDOWN = 170 * MiB;
constexpr size_t WS_H1 = 234 * MiB;
constexpr size_t WS_H1B = 362 * MiB;
constexpr size_t WS_PJ = 426 * MiB;
constexpr size_t WS_XB = 490 * MiB;
constexpr size_t WS_Q = 554 * MiB;
constexpr size_t WS_K = 586 * MiB;
constexpr size_t WS_V = 590 * MiB;
constexpr size_t WS_QI = 594 * MiB;
constexpr size_t WS_KI = 610 * MiB;
constexpr size_t WS_HGLU = 614 * MiB;
constexpr size_t WS_MIX = 646 * MiB;
constexpr size_t WS_ACT = 490 * MiB;
constexpr size_t WS_Y = 762 * MiB;
constexpr size_t WS_END = 1018 * MiB;
static_assert(WS_MIX + (size_t)NTOK * 1024 * 2 <= WS_ACT + (size_t)139264 * 2048 && WS_ACT + (size_t)139264 * 2048 <= WS_Y, "ws map");
constexpr int CW_CNT = 1024;

constexpr int LDS_STAGE = 131072;
constexpr int LDS_MISC = LDS_STAGE;
constexpr int LDS_BYTES = 147456;

__device__ __forceinline__ unsigned f2bf(float f) { unsigned u = __builtin_bit_cast(unsigned, f); return (u + 0x7fffu + ((u >> 16) & 1u)) >> 16; }
__device__ __forceinline__ unsigned pk2(float lo, float hi) { return f2bf(lo) | (f2bf(hi) << 16); }
__device__ __forceinline__ float bf_lo(unsigned w) { return __builtin_bit_cast(float, w << 16); }
__device__ __forceinline__ float bf_hi(unsigned w) { return __builtin_bit_cast(float, w & 0xffff0000u); }
__device__ __forceinline__ float wave_sum(float v) {
#pragma unroll
    for (int o = 1; o < 64; o <<= 1) v += __shfl_xor(v, o);
    return v;
}
__device__ __forceinline__ float sigmoidf_(float x) { return 1.0f / (1.0f + __expf(-x)); }
#define LDS_WAIT() asm volatile("s_waitcnt lgkmcnt(0)" ::: "memory")

struct Params {
    const float* x; const float* p; const float* w_in; const float* w_out; const float* g_mix; const float* g_ffn;
    const float* glu_b; const float* dw_w; const float* dw_b; const float* ln_g; const float* ln_b;
    const float* w_router; const float* b_router; const float* w_up; const float* b_up; const float* w_down; const float* b_down;
    const float* w_ple_proj; const float* w_ple_gate; const float* g_ple; const float* g_final;
    float* out; unsigned char* ws;
    int ph_lo, ph_hi, rep, pad;
};

namespace pg8 {
constexpr int BM = 256, BK = 64, HALF = 128, HTB = HALF * BK * 2, STAGE_BYTES = 8 * HTB, NXCD = 8, WGM = 8;
__host__ __device__ __forceinline__ int lds_byte(int r, int c) { const int st = (r >> 4) * 2 + (c >> 5), rr = r & 15, cc = c & 31, ob = rr * 64 + cc * 2; return st * 1024 + (ob ^ (((ob >> 9) & 1) << 5)); }
__host__ __device__ __forceinline__ void stage_rc(int b, int& R, int& C) { const int st = b / 1024, sb = b % 1024, swz = sb ^ (((sb >> 9) & 1) << 5); R = (st >> 1) * 16 + swz / 64; C = (st & 1) * 32 + (swz % 64) / 2; }
__host__ __device__ __forceinline__ int perm32(int rho) { const int n = rho >> 4, i = rho & 15; return 8 * (i >> 2) + 4 * n + (i & 3); }

struct Unit { int pm, pn, e, rows; };

__device__ __forceinline__ unsigned cvt_pk_bf16(float lo, float hi) { unsigned r; asm volatile("v_cvt_pk_bf16_f32 %0, %1, %2" : "=v"(r) : "v"(lo), "v"(hi)); return r; }

struct DenseSched {
    const bf16_t* A; const bf16_t* Bt; int K;
    int nM, nN, nwg, G, c;
    __device__ void init(const bf16_t* A_, const bf16_t* Bt_, int M, int N, int K_, int G_, int c_) { A = A_; Bt = Bt_; K = K_; nM = M / BM; nN = N / BM; nwg = nM * nN; G = G_; c = c_; }
    __device__ bool next(int i, Unit& u) const {
        const long L = (long)i * G + c; if (L >= nwg) return false;
        int wgid = (int)L; { const int q = nwg / NXCD, r = nwg % NXCD, xcd = wgid % NXCD, off = wgid / NXCD; wgid = (xcd < r ? xcd * (q + 1) : r * (q + 1) + (xcd - r) * q) + off; }
        const int nig = WGM * nN, gid = wgid / nig, fm = gid * WGM, gsz = (nM - fm) < WGM ? (nM - fm) : WGM;
        u.pm = fm + ((wgid % nig) % gsz); u.pn = (wgid % nig) / gsz; u.e = 0; u.rows = BM; return true;
    }
    __device__ __forceinline__ const char* a_ptr(const Unit& u) const { return (const char*)A + (size_t)u.pm * BM * K * 2; }
    __device__ __forceinline__ const char* b_ptr(const Unit& u) const { return (const char*)Bt + (size_t)u.pn * BM * K * 2; }
    __device__ __forceinline__ int a_row(const Unit&, int) const { return 0; }
};

struct MoeSched {
    const bf16_t* A; const bf16_t* Bt; int K; size_t b_estride;
    const LAS int* tb;
    const LAS int* cnt;
    const int* list;
    int nN, nwg, G, c; bool gather;
    __device__ bool next(int i, Unit& u) const {
        const long L = (long)i * G + c; if (L >= nwg) return false;
        int wgid = (int)L; { const int q = nwg / NXCD, r = nwg % NXCD, xcd = wgid % NXCD, off = wgid / NXCD; wgid = (xcd < r ? xcd * (q + 1) : r * (q + 1) + (xcd - r) * q) + off; }
        int e = 0;
#pragma unroll 1
        for (; e < NE - 1; ++e) { if (wgid < tb[e + 1] * nN) break; }
        const int local = wgid - tb[e] * nN, nM = tb[e + 1] - tb[e];
        const int nig = WGM * nN, gid = local / nig, fm = gid * WGM, gsz = (nM - fm) < WGM ? (nM - fm) : WGM;
        const int rt = fm + ((local % nig) % gsz);
        u.pm = tb[e] + rt; u.pn = (local % nig) / gsz; u.e = e;
        const int left = cnt[e] - rt * BM; u.rows = left < BM ? left : BM; return true;
    }
    __device__ __forceinline__ const char* a_ptr(const Unit& u) const { return gather ? (const char*)A : (const char*)A + (size_t)u.pm * BM * K * 2; }
    __device__ __forceinline__ const char* b_ptr(const Unit& u) const { return (const char*)Bt + (size_t)u.e * b_estride + (size_t)u.pn * BM * K * 2; }
    __device__ __forceinline__ int a_row(const Unit& u, int r) const {
        const int rt = u.pm - tb[u.e];
        return r < u.rows ? (list[u.e * NTOK + rt * BM + r] >> 2) : 0;
    }
};

template <class Epi, class Sched, bool GATHER>
__device__ __forceinline__ void gemm_phase(LAS unsigned char* lds, const Sched& S, const Epi& E) {
    const int tid = threadIdx.x, wid = __builtin_amdgcn_readfirstlane(tid >> 6), lane = tid & 63, wr = wid >> 2, wc = wid & 3, fr = lane & 15, fq = lane >> 4;
    const int K = S.K, nt = K / BK;
    unsigned voffA[2], voffB[2]; int RA[2], CA[2];
#pragma unroll
    for (int i = 0; i < 2; ++i) { int R, C; stage_rc(tid * 16 + i * 8192, R, C); const int Rb = Epi::PERM ? ((R & ~31) + perm32(R & 31)) : R;
        voffA[i] = (unsigned)(R * K + C) * 2u; voffB[i] = (unsigned)(Rb * K + C) * 2u; RA[i] = R; CA[i] = C; }
    const size_t kstep = (size_t)(BK * 2);
    const size_t hstep = (size_t)HALF * K * 2;
    const unsigned ldsw = (unsigned)wid * 1024u;
    const int aoff = lds_byte(wr * 64 + fr, fq * 8), boff = lds_byte(wc * 32 + fr, fq * 8);
    unsigned gC[2][2], gN[2][2];
#define PG8_SA(b, h) (((b) * 2 + (h)) * HTB)
#define PG8_SB(b, h) ((4 + (b) * 2 + (h)) * HTB)
#define PG8_STAGE(bufoff, gbase, voff) do { _Pragma("unroll") for (int _i = 0; _i < 2; ++_i) \
        __builtin_amdgcn_global_load_lds((const unsigned*)((const char*)(gbase) + (voff)[_i]), (LAS unsigned*)(lds + (bufoff) + ldsw + _i * 8192), 16, 0, 0); } while (0)
#define PG8_STAGE_A(bufoff, kp, h) do { if constexpr (GATHER) { PG8_STAGE(bufoff, kp, gC[h]); } else { PG8_STAGE(bufoff, (kp) + (h) * hstep, voffA); } } while (0)
#define PG8_LDA(dst, b, h) do { _Pragma("unroll") for (int m = 0; m < 4; ++m) _Pragma("unroll") for (int k = 0; k < 2; ++k) dst[m][k] = *(const LAS bf16x8*)(lds + PG8_SA(b, h) + aoff + m * 2048 + k * 1024); } while (0)
#define PG8_LDB(dst, b, h) do { _Pragma("unroll") for (int n = 0; n < 2; ++n) _Pragma("unroll") for (int k = 0; k < 2; ++k) dst[n][k] = *(const LAS bf16x8*)(lds + PG8_SB(b, h) + boff + n * 2048 + k * 1024); } while (0)
#define PG8_MMA(ai, bj, At, Bt) do { __builtin_amdgcn_s_setprio(1); _Pragma("unroll") for (int m = 0; m < 4; ++m) _Pragma("unroll") for (int n = 0; n < 2; ++n) _Pragma("unroll") for (int k = 0; k < 2; ++k) \
        acc[ai][bj][m][n] = __builtin_amdgcn_mfma_f32_16x16x32_bf16(Bt[n][k], At[m][k], acc[ai][bj][m][n], 0, 0, 0); __builtin_amdgcn_s_setprio(0); } while (0)
#define PG8_WAIT_V(n) asm volatile("s_waitcnt vmcnt(" #n ")" ::: "memory")
#define PG8_WAIT_L(n) asm volatile("s_waitcnt lgkmcnt(" #n ")" ::: "memory")
#define PG8_BAR __builtin_amdgcn_s_barrier()
#define PG8_SCHED __builtin_amdgcn_sched_barrier(0)
#define PG8_GOFF(dst, u) do { _Pragma("unroll") for (int _h = 0; _h < 2; ++_h) _Pragma("unroll") for (int _i = 0; _i < 2; ++_i) \
        dst[_h][_i] = (unsigned)(S.a_row(u, _h * HALF + RA[_i]) * K + CA[_i]) * 2u; } while (0)
    Unit cur, nxt, nn; int ui = 0;
    if (!S.next(0, cur)) return;
    bool has_next = S.next(1, nxt);
    if constexpr (GATHER) { PG8_GOFF(gC, cur); if (has_next) { PG8_GOFF(gN, nxt); } else { PG8_GOFF(gN, cur); } }
    f32x4 acc[2][2][4][2];
#pragma unroll
    for (int a = 0; a < 2; ++a)
#pragma unroll
        for (int b = 0; b < 2; ++b)
#pragma unroll
            for (int m = 0; m < 4; ++m)
#pragma unroll
                for (int n = 0; n < 2; ++n) acc[a][b][m][n] = (f32x4){0.f, 0.f, 0.f, 0.f};
    bf16x8 At[4][2], B0[2][2], B1[2][2];
    const char* cA = S.a_ptr(cur); const char* cB = S.b_ptr(cur);
    PG8_STAGE(PG8_SB(0, 0), cB, voffB); PG8_STAGE(PG8_SB(0, 1), cB + hstep, voffB); PG8_STAGE_A(PG8_SA(0, 0), cA, 0); PG8_STAGE_A(PG8_SA(0, 1), cA, 1);
    if (wr == 1) PG8_BAR;
    PG8_WAIT_V(2); PG8_BAR;
    PG8_STAGE(PG8_SB(1, 0), cB + kstep, voffB); PG8_STAGE_A(PG8_SA(1, 0), cA + kstep, 0); PG8_STAGE(PG8_SB(1, 1), cB + hstep + kstep, voffB);
    PG8_WAIT_V(6); PG8_BAR;
    for (;;) {
        const char* nA = has_next ? S.a_ptr(nxt) : cA; const char* nB = has_next ? S.b_ptr(nxt) : cB;
        for (int t = 0; t < nt; t += 2) {
            const bool last = (t == nt - 2);
            const char* a1 = cA + (size_t)(t + 1) * kstep;
            const char* a2 = last ? nA : cA + (size_t)(t + 2) * kstep; const char* b2 = last ? nB : cB + (size_t)(t + 2) * kstep;
            const char* a3 = a2 + kstep; const char* b3 = b2 + kstep;
            PG8_LDB(B0, 0, 0); PG8_LDB(B1, 0, 1); PG8_SCHED; PG8_LDA(At, 0, 0); PG8_STAGE_A(PG8_SA(1, 1), a1, 1);
            if constexpr (GATHER) { if (last) {
#pragma unroll
                for (int h = 0; h < 2; ++h)
#pragma unroll
                    for (int i = 0; i < 2; ++i) gC[h][i] = gN[h][i]; } }
            PG8_WAIT_V(8); PG8_WAIT_L(0); PG8_BAR; PG8_MMA(0, 0, At, B0); PG8_MMA(0, 1, At, B1); PG8_BAR; PG8_SCHED;
            PG8_LDA(At, 0, 1); PG8_STAGE(PG8_SB(0, 0), b2, voffB); PG8_STAGE(PG8_SB(0, 1), b2 + hstep, voffB); PG8_STAGE_A(PG8_SA(0, 0), a2, 0);
            PG8_WAIT_V(8); PG8_WAIT_L(0); PG8_BAR; PG8_MMA(1, 0, At, B0); PG8_MMA(1, 1, At, B1); PG8_BAR; PG8_SCHED;
            PG8_LDB(B0, 1, 0); PG8_LDB(B1, 1, 1); PG8_SCHED; PG8_LDA(At, 1, 0); PG8_STAGE_A(PG8_SA(0, 1), a2, 1);
            PG8_WAIT_V(8); PG8_WAIT_L(0); PG8_BAR; PG8_MMA(0, 0, At, B0); PG8_MMA(0, 1, At, B1); PG8_BAR; PG8_SCHED;
            PG8_LDA(At, 1, 1); PG8_STAGE(PG8_SB(1, 0), b3, voffB); PG8_STAGE(PG8_SB(1, 1), b3 + hstep, voffB); PG8_STAGE_A(PG8_SA(1, 0), a3, 0);
            PG8_WAIT_V(8); PG8_WAIT_L(0); PG8_BAR; PG8_MMA(1, 0, At, B0); PG8_MMA(1, 1, At, B1); PG8_BAR; PG8_SCHED;
        }
        if (wr == 0) PG8_BAR;
        bool has_nn = false;
        if constexpr (GATHER) { if (has_next) { has_nn = S.next(ui + 2, nn); if (has_nn) { PG8_GOFF(gN, nn); } } }
        else { if (has_next) has_nn = S.next(ui + 2, nn); }
        E(acc, cur, wr, wc, fr, fq);
        if (!has_next) break;
#pragma unroll
        for (int a = 0; a < 2; ++a)
#pragma unroll
            for (int b = 0; b < 2; ++b)
#pragma unroll
                for (int m = 0; m < 4; ++m)
#pragma unroll
                    for (int n = 0; n < 2; ++n) acc[a][b][m][n] = (f32x4){0.f, 0.f, 0.f, 0.f};
        cur = nxt; cA = nA; cB = nB; ++ui; nxt = nn; has_next = has_nn;
        if (wr == 1) PG8_BAR;
    }
    PG8_WAIT_V(0);
    PG8_BAR;
#undef PG8_SA
#undef PG8_SB
#undef PG8_STAGE
#undef PG8_STAGE_A
#undef PG8_LDA
#undef PG8_LDB
#undef PG8_MMA
#undef PG8_WAIT_V
#undef PG8_WAIT_L
#undef PG8_BAR
#undef PG8_SCHED
#undef PG8_GOFF
}
}

using pg8::Unit; using pg8::cvt_pk_bf16;
constexpr int BM = 256, HALF = 128;

struct EpiInProj {
    static constexpr bool PERM = true;
    const float* rs1; const f32x2* rope; const float* glu_b;
    bf16_t *q, *k, *v, *qi, *ki, *hglu; float* wi;
    __device__ __forceinline__ void operator()(const f32x4 (&acc)[2][2][4][2], const Unit& u, int wr, int wc, int fr, int fq) const {
        const int row0 = u.pm * BM + wr * 64 + fr;
        if (u.pn >= 4) {
            const int ch = 128 * (u.pn - 4) + 32 * wc + 8 * fq;
            f32x4 ba[2], bg[2];
#pragma unroll
            for (int n = 0; n < 2; ++n) { ba[n] = *(const f32x4*)(glu_b + ch + 4 * n); bg[n] = *(const f32x4*)(glu_b + 512 + ch + 4 * n); }
#pragma unroll
            for (int ai = 0; ai < 2; ++ai)
#pragma unroll
                for (int m = 0; m < 4; ++m) { const int row = row0 + ai * HALF + m * 16; const float rs = rs1[row];
                    float o[8];
#pragma unroll
                    for (int n = 0; n < 2; ++n)
#pragma unroll
                        for (int e = 0; e < 4; ++e) { const float a = acc[ai][0][m][n][e] * rs + ba[n][e], g = acc[ai][1][m][n][e] * rs + bg[n][e]; o[4 * n + e] = a * sigmoidf_(g); }
                    u32x4 w; w.x = cvt_pk_bf16(o[0], o[1]); w.y = cvt_pk_bf16(o[2], o[3]); w.z = cvt_pk_bf16(o[4], o[5]); w.w = cvt_pk_bf16(o[6], o[7]);
                    *(u32x4*)(hglu + (size_t)row * 512 + ch) = w; }
            return;
        }
        bf16_t* dst; int ld, col; bool do_rope = true, is_wi = false;
        if (u.pn < 2) { dst = q; ld = 512; col = (4 * u.pn + wc) * 64; }
        else if (u.pn == 2) { dst = qi; ld = 256; col = wc * 64; }
        else { ld = 64; col = 0; if (wc == 0) dst = k; else if (wc == 1) dst = ki; else if (wc == 2) { dst = v; do_rope = false; } else { dst = v; is_wi = true; do_rope = false; } }
        if (is_wi) {
            if (fq == 0) {
#pragma unroll
                for (int ai = 0; ai < 2; ++ai)
#pragma unroll
                    for (int m = 0; m < 4; ++m) { const int row = row0 + ai * HALF + m * 16; const float rs = rs1[row];
                        *(f32x4*)(wi + (size_t)row * 4) = acc[ai][0][m][0] * rs; }
            }
            return;
        }
        const int d0 = 8 * fq;
#pragma unroll
        for (int ai = 0; ai < 2; ++ai)
#pragma unroll
            for (int m = 0; m < 4; ++m) { const int row = row0 + ai * HALF + m * 16; const float rs = rs1[row];
                float o1[8], o2[8];
                if (do_rope) {
                    const f32x2* rp = rope + (size_t)(row & (SEQ - 1)) * 32 + d0;
#pragma unroll
                    for (int n = 0; n < 2; ++n)
#pragma unroll
                        for (int e = 0; e < 4; ++e) { const f32x2 cs = rp[4 * n + e]; const float x1 = acc[ai][0][m][n][e] * rs, x2 = acc[ai][1][m][n][e] * rs;
                            o1[4 * n + e] = x1 * cs.x - x2 * cs.y; o2[4 * n + e] = x2 * cs.x + x1 * cs.y; }
                } else {
#pragma unroll
                    for (int n = 0; n < 2; ++n)
#pragma unroll
                        for (int e = 0; e < 4; ++e) { o1[4 * n + e] = acc[ai][0][m][n][e] * rs; o2[4 * n + e] = acc[ai][1][m][n][e] * rs; }
                }
                u32x4 w1, w2; w1.x = cvt_pk_bf16(o1[0], o1[1]); w1.y = cvt_pk_bf16(o1[2], o1[3]); w1.z = cvt_pk_bf16(o1[4], o1[5]); w1.w = cvt_pk_bf16(o1[6], o1[7]);
                w2.x = cvt_pk_bf16(o2[0], o2[1]); w2.y = cvt_pk_bf16(o2[2], o2[3]); w2.z = cvt_pk_bf16(o2[4], o2[5]); w2.w = cvt_pk_bf16(o2[6], o2[7]);
                bf16_t* rp2 = dst + (size_t)row * ld + col + d0;
                *(u32x4*)(rp2) = w1; *(u32x4*)(rp2 + 32) = w2; }
    }
};

struct EpiBf16Plain {
    static constexpr bool PERM = true;
    bf16_t* O; int ldc;
    __device__ __forceinline__ void operator()(const f32x4 (&acc)[2][2][4][2], const Unit& u, int wr, int wc, int fr, int fq) const {
        const int row0 = u.pm * BM + wr * 64 + fr, col0 = u.pn * BM + wc * 32 + 8 * fq;
#pragma unroll
        for (int ai = 0; ai < 2; ++ai)
#pragma unroll
            for (int m = 0; m < 4; ++m) { bf16_t* rowp = O + (size_t)(row0 + ai * HALF + m * 16) * ldc + col0;
#pragma unroll
                for (int bj = 0; bj < 2; ++bj) { const f32x4 v0 = acc[ai][bj][m][0], v1 = acc[ai][bj][m][1];
                    u32x4 w; w.x = cvt_pk_bf16(v0[0], v0[1]); w.y = cvt_pk_bf16(v0[2], v0[3]); w.z = cvt_pk_bf16(v1[0], v1[1]); w.w = cvt_pk_bf16(v1[2], v1[3]);
                    *(u32x4*)(rowp + bj * HALF) = w; } }
    }
};

struct EpiOutProj {
    static constexpr bool PERM = false;
    const float* x; float* h1; bf16_t* h1b;
    __device__ __forceinline__ void operator()(const f32x4 (&acc)[2][2][4][2], const Unit& u, int wr, int wc, int fr, int fq) const {
        const int row0 = u.pm * BM + wr * 64 + fr, col0 = u.pn * BM + wc * 32 + 4 * fq;
#pragma unroll
        for (int ai = 0; ai < 2; ++ai)
#pragma unroll
            for (int m = 0; m < 4; ++m) { const size_t off = (size_t)(row0 + ai * HALF + m * 16) * DM + col0;
#pragma unroll
                for (int bj = 0; bj < 2; ++bj)
#pragma unroll
                    for (int n = 0; n < 2; ++n) { const size_t o = off + bj * HALF + n * 16; const f32x4 r = *(const f32x4*)(x + o) + acc[ai][bj][m][n];
                        *(f32x4*)(h1 + o) = r; u32x2 w; w.x = cvt_pk_bf16(r[0], r[1]); w.y = cvt_pk_bf16(r[2], r[3]); *(u32x2*)(h1b + o) = w; } }
    }
};

struct EpiUp {
    static constexpr bool PERM = true;
    const float* lscale; const float* b_up; bf16_t* act; const LAS int* tb;
    __device__ __forceinline__ void operator()(const f32x4 (&acc)[2][2][4][2], const Unit& u, int wr, int wc, int fr, int fq) const {
        const int r0 = wr * 64 + fr, ch = 128 * u.pn + 32 * wc + 8 * fq, rt = u.pm - tb[u.e];
        const float* bu = b_up + (size_t)u.e * 2048;
        f32x4 bg[2], bl[2];
#pragma unroll
        for (int n = 0; n < 2; ++n) { bg[n] = *(const f32x4*)(bu + ch + 4 * n); bl[n] = *(const f32x4*)(bu + 1024 + ch + 4 * n); }
#pragma unroll
        for (int ai = 0; ai < 2; ++ai)
#pragma unroll
            for (int m = 0; m < 4; ++m) { const int r = r0 + ai * HALF + m * 16;
                const float rs = (r < u.rows) ? lscale[u.e * NTOK + rt * BM + r] : 0.f;
                float o[8];
#pragma unroll
                for (int n = 0; n < 2; ++n)
#pragma unroll
                    for (int e = 0; e < 4; ++e) { float g = acc[ai][0][m][n][e] * rs + bg[n][e], l = acc[ai][1][m][n][e] * rs + bl[n][e];
                        g = fminf(g, 7.0f); l = fminf(fmaxf(l, -7.0f), 7.0f); o[4 * n + e] = g * sigmoidf_(1.702f * g) * (l + 1.0f); }
                u32x4 w; w.x = cvt_pk_bf16(o[0], o[1]); w.y = cvt_pk_bf16(o[2], o[3]); w.z = cvt_pk_bf16(o[4], o[5]); w.w = cvt_pk_bf16(o[6], o[7]);
                *(u32x4*)(act + (size_t)(u.pm * BM + r) * 1024 + ch) = w; }
    }
};

struct EpiDown {
    static constexpr bool PERM = true;
    const int* list; const float* lgate; const float* b_down; bf16_t* y; const LAS int* tb;
    __device__ __forceinline__ void operator()(const f32x4 (&acc)[2][2][4][2], const Unit& u, int wr, int wc, int fr, int fq) const {
        const int r0 = wr * 64 + fr, col0 = u.pn * BM + wc * 32 + 8 * fq, rt = u.pm - tb[u.e];
        const float* bd = b_down + (size_t)u.e * 1024;
        f32x4 bv[2][2];
#pragma unroll
        for (int bj = 0; bj < 2; ++bj)
#pragma unroll
            for (int n = 0; n < 2; ++n) bv[bj][n] = *(const f32x4*)(bd + col0 + bj * HALF + 4 * n);
#pragma unroll
        for (int ai = 0; ai < 2; ++ai)
#pragma unroll
            for (int m = 0; m < 4; ++m) { const int r = r0 + ai * HALF + m * 16;
                if (r < u.rows) { const int li = u.e * NTOK + rt * BM + r; const int slot = list[li]; const float g = lgate[li];
                    bf16_t* rowp = y + (size_t)slot * 1024 + col0;
#pragma unroll
                    for (int bj = 0; bj < 2; ++bj) { const f32x4 v0 = (acc[ai][bj][m][0] + bv[bj][0]) * g, v1 = (acc[ai][bj][m][1] + bv[bj][1]) * g;
                        u32x4 w; w.x = cvt_pk_bf16(v0[0], v0[1]); w.y = cvt_pk_bf16(v0[2], v0[3]); w.z = cvt_pk_bf16(v1[0], v1[1]); w.w = cvt_pk_bf16(v1[2], v1[3]);
                        *(u32x4*)(rowp + bj * HALF) = w; } } }
    }
};

struct EpiPle {
    static constexpr bool PERM = false;
    const float* h2; const bf16_t* pj; const float* rs3; float* out;
    __device__ __forceinline__ void operator()(const f32x4 (&acc)[2][2][4][2], const Unit& u, int wr, int wc, int fr, int fq) const {
        const int row0 = u.pm * BM + wr * 64 + fr, col0 = u.pn * BM + wc * 32 + 4 * fq;
#pragma unroll
        for (int ai = 0; ai < 2; ++ai)
#pragma unroll
            for (int m = 0; m < 4; ++m) { const int row = row0 + ai * HALF + m * 16; const size_t off = (size_t)row * DM + col0; const float rs = rs3[row];
#pragma unroll
                for (int bj = 0; bj < 2; ++bj)
#pragma unroll
                    for (int n = 0; n < 2; ++n) { const size_t o = off + bj * HALF + n * 16; const f32x4 hv = *(const f32x4*)(h2 + o); const u32x2 pw = *(const u32x2*)(pj + o);
                        const f32x4 a = acc[ai][bj][m][n]; f32x4 r;
                        r[0] = hv[0] + bf_lo(pw.x) * sigmoidf_(a[0] * rs); r[1] = hv[1] + bf_hi(pw.x) * sigmoidf_(a[1] * rs);
                        r[2] = hv[2] + bf_lo(pw.y) * sigmoidf_(a[2] * rs); r[3] = hv[3] + bf_hi(pw.y) * sigmoidf_(a[3] * rs);
                        *(f32x4*)(out + o) = r; } }
    }
};

__device__ __forceinline__ void p0_transpose_item(const float* W, int ldw, bf16_t* WT, int Kdim, const float* gain, LAS float* scr, int kb, int n0, int src0, int nvalid, int lane) {
    const int k0 = 64 * kb;
    f32x4 ld4[8];
#pragma unroll
    for (int i = 0; i < 8; ++i) { const int kk = 8 * i + (lane >> 3), j = (lane & 7) * 4;
        ld4[i] = (f32x4){0.f, 0.f, 0.f, 0.f}; if (j < nvalid) ld4[i] = *(const f32x4*)(W + (size_t)(k0 + kk) * ldw + src0 + j); }
#pragma unroll
    for (int i = 0; i < 8; ++i) { const int kk = 8 * i + (lane >> 3), j = (lane & 7) * 4; const float gk = gain ? gain[k0 + kk] : 1.0f;
        LAS float* d = scr + kk * 33 + j; d[0] = ld4[i].x * gk; d[1] = ld4[i].y * gk; d[2] = ld4[i].z * gk; d[3] = ld4[i].w * gk; }
    LDS_WAIT(); asm volatile("" ::: "memory");
    const int c = lane & 7;
#pragma unroll
    for (int j = 0; j < 4; ++j) { const int n = (lane >> 3) + 8 * j; const LAS float* s = scr + (8 * c) * 33 + n;
        u32x4 o; o.x = pk2(s[0 * 33], s[1 * 33]); o.y = pk2(s[2 * 33], s[3 * 33]); o.z = pk2(s[4 * 33], s[5 * 33]); o.w = pk2(s[6 * 33], s[7 * 33]);
        *(u32x4*)(WT + (size_t)(n0 + n) * Kdim + k0 + 8 * c) = o; }
    LDS_WAIT(); asm volatile("" ::: "memory");
}
__device__ __forceinline__ void win_colmap(int nb, int& src0, int& nvalid) {
    const int pn = nb >> 3, j = (nb & 7) * 32, bj = j >> 7, slot = (j & 127) >> 5;
    nvalid = 32;
    if (pn < 2) src0 = (4 * pn + slot) * 64 + 32 * bj;
    else if (pn == 2) src0 = 640 + slot * 64 + 32 * bj;
    else if (pn == 3) { if (slot == 0) src0 = 512 + 32 * bj; else if (slot == 1) src0 = 896 + 32 * bj; else if (slot == 2) src0 = 576 + 32 * bj; else { src0 = 960; nvalid = bj == 0 ? 4 : 0; } }
    else src0 = 964 + 512 * bj + 128 * (pn - 4) + 32 * slot;
}
__device__ __forceinline__ void p0_prologue(const Params& P, LAS unsigned char* lds, int vcu, int G, int wave, int lane) {
    unsigned char* ws = P.ws;
    LAS float* scr = (LAS float*)(lds + wave * 16384);
    const int gw = vcu * NWAVES + wave, NGW = G * NWAVES;
    constexpr int I_IN = 16 * 64, I_OUT = 16 * 32, I_G = 16 * 32, I_P = 4 * 32, I_UP = 32 * 16 * 64, I_DN = 32 * 16 * 32;
    constexpr int NITEMS = I_IN + I_OUT + I_G + I_P + I_UP + I_DN;
    for (int it = gw; it < NITEMS; it += NGW) {
        int r = it;
        if (r < I_IN) { const int kb = r / 64, nb = r % 64; int s0, nv; win_colmap(nb, s0, nv); p0_transpose_item(P.w_in, INW, (bf16_t*)(ws + WS_WIN), 1024, P.g_mix, scr, kb, nb * 32, s0, nv, lane); continue; } r -= I_IN;
        if (r < I_OUT) { const int kb = r / 32, nb = r % 32; p0_transpose_item(P.w_out, 1024, (bf16_t*)(ws + WS_WOUT), 1024, nullptr, scr, kb, nb * 32, nb * 32, 32, lane); continue; } r -= I_OUT;
        if (r < I_G) { const int kb = r / 32, nb = r % 32; p0_transpose_item(P.w_ple_gate, 1024, (bf16_t*)(ws + WS_WG), 1024, P.g_ple, scr, kb, nb * 32, nb * 32, 32, lane); continue; } r -= I_G;
        if (r < I_P) { const int kb = r / 32, nb = r % 32; p0_transpose_item(P.w_ple_proj, 1024, (bf16_t*)(ws + WS_WP), 256, nullptr, scr, kb, nb * 32, nb * 32, 32, lane); continue; } r -= I_P;
        if (r < I_UP) { const int e = r / 1024, rr = r % 1024, kb = rr / 64, nb = rr % 64;
            const int pn = nb >> 3, j = (nb & 7) * 32, bj = j >> 7, jj = j & 127;
            p0_transpose_item(P.w_up + (size_t)e * 1024 * 2048, 2048, (bf16_t*)(ws + WS_WUP) + (size_t)e * 2048 * 1024, 1024, P.g_ffn, scr, kb, nb * 32, 1024 * bj + 128 * pn + jj, 32, lane); continue; } r -= I_UP;
        { const int e = r / 512, rr = r % 512, kb = rr / 32, nb = rr % 32;
            p0_transpose_item(P.w_down + (size_t)e * 1024 * 1024, 1024, (bf16_t*)(ws + WS_WDOWN) + (size_t)e * 1024 * 1024, 1024, nullptr, scr, kb, nb * 32, nb * 32, 32, lane); }
    }
    float* rs1 = (float*)(ws + WS_RS1); bf16_t* xb = (bf16_t*)(ws + WS_XB);
    for (int m = gw; m < NTOK; m += NGW) {
        const f32x4* xr = (const f32x4*)(P.x + (size_t)m * DM) + lane; f32x4 v[4]; float s = 0.f;
#pragma unroll
        for (int j = 0; j < 4; ++j) { v[j] = xr[64 * j]; s += (v[j].x * v[j].x + v[j].y * v[j].y) + (v[j].z * v[j].z + v[j].w * v[j].w); }
        s = wave_sum(s);
        u32x2* o8 = (u32x2*)(xb + (size_t)m * DM) + lane;
#pragma unroll
        for (int j = 0; j < 4; ++j) { u32x2 w; w.x = pk2(v[j].x, v[j].y); w.y = pk2(v[j].z, v[j].w); o8[64 * j] = w; }
        if (lane == 0) rs1[m] = 1.0f / sqrtf(s * (1.0f / DM) + EPS);
    }
    bf16_t* pb = (bf16_t*)(ws + WS_PB);
    for (int m = gw; m < NTOK; m += NGW) { const f32x4 v = *((const f32x4*)(P.p + (size_t)m * 256) + lane); u32x2 w; w.x = pk2(v.x, v.y); w.y = pk2(v.z, v.w); *((u32x2*)(pb + (size_t)m * 256) + lane) = w; }
    f32x2* rope = (f32x2*)(ws + WS_ROPE);
    for (int idx = gw * 64 + lane; idx < SEQ * 32; idx += NGW * 64) { const int t = idx >> 5, i = idx & 31;
        const float inv = exp2f(-(float)i * (13.287712379549449f / 32.0f));
        const float ang = (float)t * inv;
        const double rev = (double)ang * 0.15915494309189535; const float fr = (float)(rev - __builtin_floor(rev));
        rope[idx] = (f32x2){__builtin_amdgcn_cosf(fr), __builtin_amdgcn_sinf(fr)}; }
    float* wrg = (float*)(ws + WS_WRG);
    for (int idx = gw * 64 + lane; idx < 1024 * 32; idx += NGW * 64) wrg[idx] = P.w_router[idx] * P.g_ffn[idx >> 5];
}

__device__ __forceinline__ unsigned fkey(float f) { unsigned u = __builtin_bit_cast(unsigned, f); if (u == 0x80000000u) u = 0u; return u ^ ((unsigned)((int)u >> 31) | 0x80000000u); }
__device__ __forceinline__ int mbcnt64(unsigned long long m) { return __builtin_amdgcn_mbcnt_hi((unsigned)(m >> 32), __builtin_amdgcn_mbcnt_lo((unsigned)m, 0u)); }

template <int NR>
__device__ __forceinline__ unsigned bisect_thr(const unsigned (&v)[NR], unsigned prefix, int startbit) {
    bool exact = false;
#pragma unroll 1
    for (int bit = startbit; bit >= 0; --bit) {
        const unsigned cand = prefix | (1u << bit); int cnt = 0;
#pragma unroll
        for (int r = 0; r < NR; ++r) { cnt += __builtin_popcountll(__ballot(v[r] >= cand)); if ((r & 7) == 7) __builtin_amdgcn_sched_barrier(0); }
        if (cnt >= NSEL) prefix = cand;
        if (cnt == NSEL) { exact = true; break; }
    }
    return exact ? prefix - 1u : prefix;
}
template <int NR, bool EXPL>
__device__ __forceinline__ void compact_sel(const unsigned (&v)[NR], const unsigned (&ci)[NR], unsigned T, LAS unsigned* list, int lane) {
    int cgt = 0;
#pragma unroll
    for (int r = 0; r < NR; ++r) { cgt += __builtin_popcountll(__ballot(v[r] > T)); if ((r & 7) == 7) __builtin_amdgcn_sched_barrier(0); }
    const int need = NSEL - cgt; int base = 0, ties = 0;
#pragma unroll
    for (int r = 0; r < NR; ++r) { const bool gt = v[r] > T, eq = v[r] == T; const unsigned long long em = __ballot(eq);
        const bool sel = gt || (eq && (ties + mbcnt64(em)) < need); const unsigned long long sm = __ballot(sel);
        list[sel ? base + mbcnt64(sm) : NSEL + lane] = EXPL ? ci[r] : (unsigned)(r * 64 + lane);
        base += __builtin_popcountll(sm); ties += __builtin_popcountll(em);
        if ((r & 3) == 3) __builtin_amdgcn_sched_barrier(0); }
}
constexpr int SEL_CAP = 1024;
template <int NR>
__device__ __forceinline__ void select_topk(LAS float* row, LAS unsigned* H, LAS unsigned* list, int lane, bool zero_h) {
    unsigned v[NR];
#pragma unroll
    for (int r = 0; r < NR; ++r) v[r] = fkey(row[r * 64 + lane]);
    LAS u32x4* H4 = (LAS u32x4*)H;
    const u32x4 h0 = H4[2 * lane], h1 = H4[2 * lane + 1];
    if (zero_h) { H4[2 * lane] = (u32x4){0u, 0u, 0u, 0u}; H4[2 * lane + 1] = (u32x4){0u, 0u, 0u, 0u}; }
    const unsigned hw[8] = {h0.x, h0.y, h0.z, h0.w, h1.x, h1.y, h1.z, h1.w};
    unsigned c[16];
#pragma unroll
    for (int i = 0; i < 8; ++i) { c[2 * i] = hw[i] & 0xffffu; c[2 * i + 1] = hw[i] >> 16; }
    unsigned s = 0u;
#pragma unroll
    for (int i = 0; i < 16; ++i) s += c[i];
    unsigned S = s;
#pragma unroll
    for (int off = 1; off < 64; off <<= 1) { const unsigned o = __shfl_down(S, off); if (lane + off < 64) S += o; }
    const unsigned long long okm = __ballot(S >= (unsigned)NSEL);
    bool fast = okm != 0ull; unsigned floorkey = 0u; int C = 0;
    if (fast) {
        const int Ls = 63 - __builtin_clzll(okm);
        unsigned acc = S - s; int bl = -1; unsigned accb = 0u;
#pragma unroll
        for (int b = 15; b >= 0; --b) { acc += c[b]; if (bl < 0 && acc >= (unsigned)NSEL) { bl = b; accb = acc; } }
        const int bstar = __shfl(bl, Ls) + 16 * Ls; C = (int)__shfl(accb, Ls);
        floorkey = (unsigned)bstar << 22;
        fast = (bstar > 1) && (C <= SEL_CAP);
    }
    if (!fast) {
        const unsigned T = bisect_thr<NR>(v, 0u, 31);
        compact_sel<NR, false>(v, v, T, list, lane);
        return;
    }
    LAS unsigned* ckl = (LAS unsigned*)row; LAS unsigned* cil = ckl + 1152;
    { int base = 0;
#pragma unroll
      for (int r = 0; r < NR; ++r) { const bool cnd = v[r] >= floorkey; const unsigned long long m = __ballot(cnd);
          const int pos = cnd ? base + mbcnt64(m) : SEL_CAP + lane;
          ckl[pos] = v[r]; cil[pos] = (unsigned)(r * 64 + lane); base += __builtin_popcountll(m);
          if ((r & 3) == 3) __builtin_amdgcn_sched_barrier(0); } }
    if (C <= 512) {
        unsigned ck[8], ci[8];
#pragma unroll
        for (int j = 0; j < 8; ++j) { const int i = j * 64 + lane; ck[j] = i < C ? ckl[i] : 0u; ci[j] = cil[i]; }
        const unsigned T = (C == NSEL) ? floorkey - 1u : bisect_thr<8>(ck, floorkey, 21);
        compact_sel<8, true>(ck, ci, T, list, lane);
    } else {
        unsigned ck[16], ci[16];
#pragma unroll
        for (int j = 0; j < 16; ++j) { const int i = j * 64 + lane; ck[j] = i < C ? ckl[i] : 0u; ci[j] = cil[i]; }
        const unsigned T = bisect_thr<16>(ck, floorkey, 21);
        compact_sel<16, true>(ck, ci, T, list, lane);
    }
}

typedef short v4i16 __attribute__((ext_vector_type(4)));
constexpr int VROW = 144;

__device__ __forceinline__ void attn_tile(const Params& P, LAS unsigned char* lds, int b, int t0, int wave, int lane) {
    unsigned char* ws = P.ws;
    const bf16_t* QI = (const bf16_t*)(ws + WS_QI); const bf16_t* KI = (const bf16_t*)(ws + WS_KI);
    const bf16_t* Q = (const bf16_t*)(ws + WS_Q); const bf16_t* Kp = (const bf16_t*)(ws + WS_K); const bf16_t* Vp = (const bf16_t*)(ws + WS_V);
    const float* WI = (const float*)(ws + WS_WI); bf16_t* MIX = (bf16_t*)(ws + WS_MIX);
    LAS float* SC = (LAS float*)lds;
    LAS unsigned* list = (LAS unsigned*)(lds + wave * 16384 + 14336);
    LAS unsigned* HIST = (LAS unsigned*)(lds + LDS_MISC);
    const int tokbase = b * SEQ;
    const bool need_sel = t0 >= 256;
    if (need_sel) {
        const int nkt = (t0 + 8 + 31) >> 5;
        bf16x8 a[4]; f32x4 w[4];
        { const bf16_t* src = QI + (size_t)(tokbase + t0 + ((lane & 31) >> 2)) * 256 + (lane & 3) * 64 + 8 * (lane >> 5);
#pragma unroll
          for (int ks = 0; ks < 4; ++ks) a[ks] = *(const bf16x8*)(src + 16 * ks); }
#pragma unroll
        for (int g = 0; g < 4; ++g) w[g] = *(const f32x4*)(WI + (size_t)(tokbase + t0 + 2 * g + (lane >> 5)) * 4);
        for (int kt0 = wave; kt0 < nkt; kt0 += 4 * NWAVES) {
            bf16x8 bf[4][4];
#pragma unroll
            for (int u = 0; u < 4; ++u) { const int kt = kt0 + u * NWAVES;
                if (kt < nkt) { const bf16_t* ksrc = KI + (size_t)(tokbase + kt * 32 + (lane & 31)) * 64 + 8 * (lane >> 5);
#pragma unroll
                    for (int ks = 0; ks < 4; ++ks) bf[u][ks] = *(const bf16x8*)(ksrc + 16 * ks); } }
#pragma unroll
            for (int u = 0; u < 4; ++u) { const int kt = kt0 + u * NWAVES;
                if (kt < nkt) {
                    const int key = kt * 32 + (lane & 31);
                    f32x16 acc;
#pragma unroll
                    for (int i = 0; i < 16; ++i) acc[i] = 0.f;
#pragma unroll
                    for (int ks = 0; ks < 4; ++ks) acc = __builtin_amdgcn_mfma_f32_32x32x16_bf16(a[ks], bf[u][ks], acc, 0, 0, 0);
#pragma unroll
                    for (int g = 0; g < 4; ++g) { float sc = 0.f;
#pragma unroll
                        for (int h = 0; h < 4; ++h) sc = fmaf(fmaxf(acc[4 * g + h], 0.f), w[g][h], sc);
                        const int ql = 2 * g + (lane >> 5);
                        if (key > t0 + ql) sc = -INFINITY;
                        SC[ql * 4096 + key] = sc;
                        if (key <= t0 + ql) { const unsigned ub = __builtin_bit_cast(unsigned, sc);
                            const unsigned bin = (ub >> 22) ^ (((unsigned)((int)ub >> 31) & 0x1ffu) | 0x200u);
                            __hip_atomic_fetch_add(HIST + ql * 512 + (bin >> 1), 1u << ((bin & 1u) << 4), __ATOMIC_RELAXED, __HIP_MEMORY_SCOPE_WORKGROUP); } }
                } }
        }
        { const int npad = ((t0 + 8 + 1023) >> 10) << 10;
          for (int i = nkt * 32 + (int)threadIdx.x; i < npad; i += NTHR) {
#pragma unroll
              for (int q = 0; q < 8; ++q) SC[q * 4096 + i] = -INFINITY; } }
    }
    __syncthreads();
    const int t = t0 + wave, tok = tokbase + t;
    if (need_sel) {
        LAS float* row = SC + wave * 4096; LAS unsigned* H = HIST + wave * 512; const int n = t + 1;
        if (n <= 1024) select_topk<16>(row, H, list, lane, true);
        else if (n <= 2048) select_topk<32>(row, H, list, lane, true);
        else if (n <= 3072) select_topk<48>(row, H, list, lane, true);
        else select_topk<64>(row, H, list, lane, true);
    } else {
#pragma unroll
        for (int i = 0; i < 4; ++i) list[i * 64 + lane] = (unsigned)(i * 64 + lane);
    }
    const int nvalid = need_sel ? NSEL : (t + 1);
    const int ngrp = (nvalid + 31) >> 5;
    const int hd = lane & 15, g = lane >> 4;
    bf16x8 qf0, qf1;
#pragma unroll
    for (int i = 0; i < 8; ++i) { qf0[i] = 0; qf1[i] = 0; }
    if (hd < 8) { const bf16_t* qs = Q + (size_t)tok * 512 + hd * 64 + 8 * g; qf0 = *(const bf16x8*)qs; qf1 = *(const bf16x8*)(qs + 32); }
    float m = -INFINITY, ssum = 0.f;
    f32x4 o[4];
#pragma unroll
    for (int dt = 0; dt < 4; ++dt) o[dt] = (f32x4){0.f, 0.f, 0.f, 0.f};
    LAS unsigned char* vreg = lds + wave * 16384;
    bf16x8 kf[4]; u32x4 vv[4];
    { const unsigned ia = list[hd], ib = list[16 + hd];
      const bf16_t* ka = Kp + (size_t)(tokbase + ia) * 64 + 8 * g; const bf16_t* kb = Kp + (size_t)(tokbase + ib) * 64 + 8 * g;
      kf[0] = *(const bf16x8*)ka; kf[1] = *(const bf16x8*)(ka + 32); kf[2] = *(const bf16x8*)kb; kf[3] = *(const bf16x8*)(kb + 32);
#pragma unroll
      for (int i = 0; i < 4; ++i) { const unsigned idx = list[(lane >> 3) + 8 * i]; vv[i] = *(const u32x4*)(Vp + (size_t)(tokbase + idx) * 64 + 8 * (lane & 7)); } }
#pragma unroll 1
    for (int grp = 0; grp < ngrp; ++grp) {
        LAS unsigned char* vbuf = vreg + (grp & 1) * 8192;
#pragma unroll
        for (int i = 0; i < 4; ++i) *(LAS u32x4*)(vbuf + ((lane >> 3) + 8 * i) * VROW + (lane & 7) * 16) = vv[i];
        f32x4 sa = {0.f, 0.f, 0.f, 0.f}, sb = {0.f, 0.f, 0.f, 0.f};
        sa = __builtin_amdgcn_mfma_f32_16x16x32_bf16(kf[0], qf0, sa, 0, 0, 0); sa = __builtin_amdgcn_mfma_f32_16x16x32_bf16(kf[1], qf1, sa, 0, 0, 0);
        sb = __builtin_amdgcn_mfma_f32_16x16x32_bf16(kf[2], qf0, sb, 0, 0, 0); sb = __builtin_amdgcn_mfma_f32_16x16x32_bf16(kf[3], qf1, sb, 0, 0, 0);
        if (grp + 1 < ngrp) {
            const int nb = (grp + 1) * 32; const unsigned ia = list[nb + hd], ib = list[nb + 16 + hd];
            const bf16_t* ka = Kp + (size_t)(tokbase + ia) * 64 + 8 * g; const bf16_t* kb = Kp + (size_t)(tokbase + ib) * 64 + 8 * g;
            kf[0] = *(const bf16x8*)ka; kf[1] = *(const bf16x8*)(ka + 32); kf[2] = *(const bf16x8*)kb; kf[3] = *(const bf16x8*)(kb + 32);
#pragma unroll
            for (int i = 0; i < 4; ++i) { const unsigned idx = list[nb + (lane >> 3) + 8 * i]; vv[i] = *(const u32x4*)(Vp + (size_t)(tokbase + idx) * 64 + 8 * (lane & 7)); }
        }
        float l[8]; float mloc = -INFINITY;
#pragma unroll
        for (int r = 0; r < 4; ++r) { const int sl = grp * 32 + 4 * g + r;
            l[r] = sl < nvalid ? sa[r] * 0.125f : -INFINITY; l[4 + r] = (sl + 16) < nvalid ? sb[r] * 0.125f : -INFINITY;
            mloc = fmaxf(mloc, fmaxf(l[r], l[4 + r])); }
        mloc = fmaxf(mloc, __shfl_xor(mloc, 16)); mloc = fmaxf(mloc, __shfl_xor(mloc, 32));
        const float mnew = fmaxf(m, mloc), alpha = __expf(m - mnew); m = mnew;
        float ps = 0.f;
#pragma unroll
        for (int r = 0; r < 8; ++r) { l[r] = __expf(l[r] - mnew); ps += l[r]; }
        ssum = ssum * alpha + ps;
        bf16x8 pf;
        { const u32x4 pw = {cvt_pk_bf16(l[0], l[1]), cvt_pk_bf16(l[2], l[3]), cvt_pk_bf16(l[4], l[5]), cvt_pk_bf16(l[6], l[7])}; pf = __builtin_bit_cast(bf16x8, pw); }
        LAS unsigned char* ta = vbuf + (4 * g + (hd >> 2)) * VROW + (hd & 3) * 8;
#pragma unroll
        for (int dt = 0; dt < 4; ++dt) {
            const v4i16 lo = __builtin_amdgcn_ds_read_tr16_b64_v4i16((LAS v4i16*)(ta + dt * 32));
            const v4i16 hi = __builtin_amdgcn_ds_read_tr16_b64_v4i16((LAS v4i16*)(ta + 16 * VROW + dt * 32));
            bf16x8 vf; vf[0] = lo[0]; vf[1] = lo[1]; vf[2] = lo[2]; vf[3] = lo[3]; vf[4] = hi[0]; vf[5] = hi[1]; vf[6] = hi[2]; vf[7] = hi[3];
            o[dt] = __builtin_amdgcn_mfma_f32_16x16x32_bf16(vf, pf, o[dt] * alpha, 0, 0, 0);
        }
    }
    ssum += __shfl_xor(ssum, 16); ssum += __shfl_xor(ssum, 32);
    const float inv = 1.0f / ssum;
    if (hd < 8) {
        bf16_t* op = MIX + (size_t)tok * 1024 + hd * 64 + 4 * g;
#pragma unroll
        for (int dt = 0; dt < 4; ++dt) { u32x2 w; w.x = cvt_pk_bf16(o[dt][0] * inv, o[dt][1] * inv); w.y = cvt_pk_bf16(o[dt][2] * inv, o[dt][3] * inv); *(u32x2*)(op + 16 * dt) = w; }
    }
    __syncthreads();
}

__device__ __forceinline__ void conv_tile(const Params& P, LAS unsigned char* lds, int tile, int tid, int wave, int lane) {
    unsigned char* ws = P.ws;
    const bf16_t* HG = (const bf16_t*)(ws + WS_HGLU); bf16_t* MIX = (bf16_t*)(ws + WS_MIX);
    LAS f32x2* part = (LAS f32x2*)(lds + LDS_MISC + 1024);
    LAS f32x2* stat = part + 256;
    const int tok0 = tile * 32, t0 = tok0 & (SEQ - 1), c = tid;
    float in[62];
#pragma unroll
    for (int r = 0; r < 62; ++r) { const int tt = t0 - 30 + r; in[r] = tt >= 0 ? __builtin_bit_cast(float, (unsigned)HG[(size_t)(tok0 - 30 + r) * 512 + c] << 16) : 0.f; }
    float out[32];
    const float bias = P.dw_b[c];
#pragma unroll
    for (int i = 0; i < 32; ++i) out[i] = bias;
#pragma unroll
    for (int j = 0; j < 31; ++j) { const float wj = P.dw_w[j * 512 + c];
#pragma unroll
        for (int i = 0; i < 32; ++i) out[i] = fmaf(in[i + j], wj, out[i]); }
#pragma unroll
    for (int i = 0; i < 32; ++i) { const float s1 = wave_sum(out[i]), s2 = wave_sum(out[i] * out[i]); if (lane == 0) part[i * 8 + wave] = (f32x2){s1, s2}; }
    __syncthreads();
    if (tid < 32) { float s1 = 0.f, s2 = 0.f;
#pragma unroll
        for (int w = 0; w < 8; ++w) { const f32x2 pp = part[tid * 8 + w]; s1 += pp.x; s2 += pp.y; }
        const float mean = s1 * (1.0f / 512.0f), var = fmaxf(s2 * (1.0f / 512.0f) - mean * mean, 0.f);
        stat[tid] = (f32x2){mean, 1.0f / sqrtf(var + EPS)}; }
    __syncthreads();
    const float lgc = P.ln_g[c], lbc = P.ln_b[c];
#pragma unroll
    for (int i = 0; i < 32; ++i) { const f32x2 st = stat[i]; const float y = (out[i] - st.x) * st.y * lgc + lbc; const float sl = y * sigmoidf_(y);
        MIX[(size_t)(tok0 + i) * 1024 + 512 + c] = (bf16_t)f2bf(sl); }
    __syncthreads();
}

__device__ __forceinline__ void router_phase(const Params& P, LAS unsigned char* lds, int blk, int G, int tid, int wave, int lane) {
    unsigned char* ws = P.ws;
    const float* h1 = (const float*)(ws + WS_H1); const float* wrg = (const float*)(ws + WS_WRG);
    int* list = (int*)(ws + WS_LIST); float* lscale = (float*)(ws + WS_LSCALE); float* lgate = (float*)(ws + WS_LGATE);
    unsigned* cntg = (unsigned*)(ws + WS_CTL) + CW_CNT;
    LAS float* WL = (LAS float*)lds;
    LAS int* lcnt = (LAS int*)(lds + LDS_MISC + 1024);
    LAS int* gbase = lcnt + 32;
    LAS int* rec_e = gbase + 32;
    LAS int* rec_p = rec_e + 512;
    LAS float* rec_g = (LAS float*)(rec_p + 512);
    LAS float* rec_s = rec_g + 512;
    for (int i = tid; i < 8192; i += NTHR) ((LAS f32x4*)WL)[i] = ((const f32x4*)wrg)[i];
    __syncthreads();
    const int e = lane & 31, kh = lane >> 5;
    const float be = P.b_router[e];
    for (int chunk = blk; chunk < NTOK / 128; chunk += G) {
        if (tid < 32) lcnt[tid] = 0;
        __syncthreads();
#pragma unroll 1
        for (int gi = 0; gi < 2; ++gi) {
            const int tl0 = wave * 16 + gi * 8, tok0 = chunk * 128 + tl0;
            float acc[8], ss[8];
#pragma unroll
            for (int tk = 0; tk < 8; ++tk) { acc[tk] = 0.f; ss[tk] = 0.f; }
#pragma unroll 2
            for (int k4 = 0; k4 < 128; ++k4) {
                const int k = kh * 512 + k4 * 4;
                const float w0 = WL[(k + 0) * 32 + e], w1 = WL[(k + 1) * 32 + e], w2 = WL[(k + 2) * 32 + e], w3 = WL[(k + 3) * 32 + e];
#pragma unroll
                for (int tk = 0; tk < 8; ++tk) { const f32x4 hv = *(const f32x4*)(h1 + (size_t)(tok0 + tk) * DM + k);
                    acc[tk] = fmaf(hv.x, w0, fmaf(hv.y, w1, fmaf(hv.z, w2, fmaf(hv.w, w3, acc[tk]))));
                    ss[tk] = fmaf(hv.x, hv.x, fmaf(hv.y, hv.y, fmaf(hv.z, hv.z, fmaf(hv.w, hv.w, ss[tk])))); }
            }
#pragma unroll
            for (int tk = 0; tk < 8; ++tk) {
                const float a = acc[tk] + __shfl_xor(acc[tk], 32), s = ss[tk] + __shfl_xor(ss[tk], 32);
                const float rs = 1.0f / sqrtf(s * (1.0f / DM) + EPS);
                float val = a * rs + be;
                float tv[4]; int te[4];
#pragma unroll
                for (int r = 0; r < 4; ++r) { float bv = val; int bi = e;
#pragma unroll
                    for (int off = 16; off >= 1; off >>= 1) { const float ov = __shfl_xor(bv, off); const int oi = __shfl_xor(bi, off); if (ov > bv || (ov == bv && oi < bi)) { bv = ov; bi = oi; } }
                    tv[r] = bv; te[r] = bi; if (e == bi) val = -INFINITY; }
                const float e0 = 1.0f, e1 = __expf(tv[1] - tv[0]), e2 = __expf(tv[2] - tv[0]), e3 = __expf(tv[3] - tv[0]);
                const float is = 1.0f / (e0 + e1 + e2 + e3);
                if (lane < 4) { const int myE = lane == 0 ? te[0] : lane == 1 ? te[1] : lane == 2 ? te[2] : te[3];
                    const float myG = (lane == 0 ? e0 : lane == 1 ? e1 : lane == 2 ? e2 : e3) * is;
                    const int lp = atomicAdd((int*)&lcnt[myE], 1);
                    const int si = (tl0 + tk) * 4 + lane; rec_e[si] = myE; rec_p[si] = lp; rec_g[si] = myG; if (lane == 0) rec_s[tl0 + tk] = rs; }
            }
        }
        __syncthreads();
        if (tid < 32) gbase[tid] = (int)atomicAdd(cntg + 64 * tid, (unsigned)lcnt[tid]);
        __syncthreads();
        { const int si = tid, ee = rec_e[si], pos = gbase[ee] + rec_p[si], li = ee * NTOK + pos;
          list[li] = (chunk * 128) * 4 + si; lscale[li] = rec_s[si >> 2]; lgate[li] = rec_g[si]; }
        __syncthreads();
    }
}

__device__ __forceinline__ void combine_phase(const Params& P, int gw, int NGW, int lane) {
    unsigned char* ws = P.ws;
    float* h1 = (float*)(ws + WS_H1); bf16_t* h1b = (bf16_t*)(ws + WS_H1B); const bf16_t* y = (const bf16_t*)(ws + WS_Y); float* rs3 = (float*)(ws + WS_RS3);
    for (int m = gw; m < NTOK; m += NGW) {
        f32x4* hr = (f32x4*)(h1 + (size_t)m * DM) + lane; f32x4 v[4]; float s = 0.f;
#pragma unroll
        for (int j = 0; j < 4; ++j) v[j] = hr[64 * j];
#pragma unroll
        for (int k = 0; k < 4; ++k) { const u32x2* yr = (const u32x2*)(y + (size_t)(m * 4 + k) * DM) + lane;
#pragma unroll
            for (int j = 0; j < 4; ++j) { const u32x2 w = yr[64 * j]; v[j].x += bf_lo(w.x); v[j].y += bf_hi(w.x); v[j].z += bf_lo(w.y); v[j].w += bf_hi(w.y); } }
        u32x2* o8 = (u32x2*)(h1b + (size_t)m * DM) + lane;
#pragma unroll
        for (int j = 0; j < 4; ++j) { hr[64 * j] = v[j]; u32x2 w; w.x = pk2(v[j].x, v[j].y); w.y = pk2(v[j].z, v[j].w); o8[64 * j] = w;
            s += (v[j].x * v[j].x + v[j].y * v[j].y) + (v[j].z * v[j].z + v[j].w * v[j].w); }
        s = wave_sum(s);
        if (lane == 0) rs3[m] = 1.0f / sqrtf(s * (1.0f / DM) + EPS);
    }
}

__device__ __forceinline__ void final_phase(const Params& P, int gw, int NGW, int lane) {
    f32x4 gv[4];
#pragma unroll
    for (int j = 0; j < 4; ++j) gv[j] = *((const f32x4*)P.g_final + lane + 64 * j);
    for (int m = gw; m < NTOK; m += NGW) {
        f32x4* orow = (f32x4*)(P.out + (size_t)m * DM) + lane; f32x4 v[4]; float s = 0.f;
#pragma unroll
        for (int j = 0; j < 4; ++j) { v[j] = orow[64 * j]; s += (v[j].x * v[j].x + v[j].y * v[j].y) + (v[j].z * v[j].z + v[j].w * v[j].w); }
        s = wave_sum(s); const float rs = 1.0f / sqrtf(s * (1.0f / DM) + EPS);
#pragma unroll
        for (int j = 0; j < 4; ++j) orow[64 * j] = v[j] * rs * gv[j];
    }
}

constexpr int NPHASE = 10;
__global__ void __launch_bounds__(NTHR, 2) fwd_kernel(Params P) {
    extern __shared__ __attribute__((aligned(16))) unsigned char lds_raw[];
    LAS unsigned char* lds = (LAS unsigned char*)lds_raw;
    cg::grid_group grid = cg::this_grid();
    const int tid = threadIdx.x, lane = tid & 63, wave = __builtin_amdgcn_readfirstlane(tid >> 6);
    const int G = gridDim.x, bx = blockIdx.x;
    const int vcu = (G % 8 == 0) ? (bx % 8) * (G / 8) + bx / 8 : bx;
    const int gw = vcu * NWAVES + wave, NGW = G * NWAVES;
    unsigned char* ws = P.ws;
    const int lo = P.ph_lo, hi = P.ph_hi;
#ifndef PH_MASK
#define PH_MASK 0x3ff
#endif
#define IN(k) ((((PH_MASK) >> (k)) & 1) && lo <= (k) && (k) < hi)
#define SYNC(k) do { if (IN(k) && IN((k) + 1)) grid.sync(); } while (0)

    if (IN(0)) p0_prologue(P, lds, vcu, G, wave, lane);
    SYNC(0);
    if (IN(1)) {
        { pg8::DenseSched S; S.init((const bf16_t*)(ws + WS_XB), (const bf16_t*)(ws + WS_WIN), NTOK, 2048, 1024, G, bx);
          EpiInProj E{(const float*)(ws + WS_RS1), (const f32x2*)(ws + WS_ROPE), P.glu_b, (bf16_t*)(ws + WS_Q), (bf16_t*)(ws + WS_K), (bf16_t*)(ws + WS_V), (bf16_t*)(ws + WS_QI), (bf16_t*)(ws + WS_KI), (bf16_t*)(ws + WS_HGLU), (float*)(ws + WS_WI)};
          pg8::gemm_phase<EpiInProj, pg8::DenseSched, false>(lds, S, E); }
        { pg8::DenseSched S; S.init((const bf16_t*)(ws + WS_PB), (const bf16_t*)(ws + WS_WP), NTOK, 1024, 256, G, bx);
          EpiBf16Plain E{(bf16_t*)(ws + WS_PJ), 1024};
          pg8::gemm_phase<EpiBf16Plain, pg8::DenseSched, false>(lds, S, E); }
    }
    SYNC(1);
    if (IN(2)) {
        for (int i = tid; i < 4096; i += NTHR) ((LAS unsigned*)(lds + LDS_MISC))[i] = 0u;
        __syncthreads();
        if (G % 8 == 0) { const int b = bx % 8, jb = bx / 8, nbb = G / 8;
            for (int i = 0;; ++i) { const int k = i * nbb + ((i & 1) ? nbb - 1 - jb : jb); if (k >= 512) break; attn_tile(P, lds, b, (511 - k) * 8, wave, lane); } }
        else { for (int tl = bx; tl < 4096; tl += G) attn_tile(P, lds, tl & 7, (511 - (tl >> 3)) * 8, wave, lane); }
        for (int rp = 0; rp <= ((P.rep >> 3) & 1); ++rp)
        for (int tl = vcu; tl < NTOK / 32; tl += G) conv_tile(P, lds, tl, tid, wave, lane);
    }
    SYNC(2);
    if (IN(3)) {
        pg8::DenseSched S; S.init((const bf16_t*)(ws + WS_MIX), (const bf16_t*)(ws + WS_WOUT), NTOK, 1024, 1024, G, bx);
        EpiOutProj E{P.x, (float*)(ws + WS_H1), (bf16_t*)(ws + WS_H1B)};
        pg8::gemm_phase<EpiOutProj, pg8::DenseSched, false>(lds, S, E);
    }
    SYNC(3);
    if (IN(4)) router_phase(P, lds, vcu, G, tid, wave, lane);
    SYNC(4);
    if (IN(5) || IN(6)) {
        LAS int* tb = (LAS int*)(lds + LDS_MISC); LAS int* cn = tb + 64;
        if (tid == 0) { const unsigned* cntg = (const unsigned*)(ws + WS_CTL) + CW_CNT; int acc = 0;
            for (int e = 0; e < NE; ++e) { const int c = (int)__hip_atomic_load(cntg + 64 * e, __ATOMIC_RELAXED, __HIP_MEMORY_SCOPE_AGENT); tb[e] = acc; cn[e] = c; acc += (c + BM - 1) / BM; }
            tb[NE] = acc; }
        __syncthreads();
        if (IN(5)) {
            pg8::MoeSched S; S.A = (const bf16_t*)(ws + WS_H1B); S.Bt = (const bf16_t*)(ws + WS_WUP); S.K = 1024; S.b_estride = (size_t)2048 * 1024 * 2; S.tb = tb; S.cnt = cn; S.list = (const int*)(ws + WS_LIST);
            S.nN = 8; S.nwg = tb[NE] * 8; S.G = G; S.c = bx; S.gather = true;
            EpiUp E{(const float*)(ws + WS_LSCALE), P.b_up, (bf16_t*)(ws + WS_ACT), tb};
            pg8::gemm_phase<EpiUp, pg8::MoeSched, true>(lds, S, E);
        }
        SYNC(5);
        if (IN(6)) {
            pg8::MoeSched S; S.A = (const bf16_t*)(ws + WS_ACT); S.Bt = (const bf16_t*)(ws + WS_WDOWN); S.K = 1024; S.b_estride = (size_t)1024 * 1024 * 2; S.tb = tb; S.cnt = cn; S.list = (const int*)(ws + WS_LIST);
            S.nN = 4; S.nwg = tb[NE] * 4; S.G = G; S.c = bx; S.gather = false;
            EpiDown E{(const int*)(ws + WS_LIST), (const float*)(ws + WS_LGATE), P.b_down, (bf16_t*)(ws + WS_Y), tb};
            pg8::gemm_phase<EpiDown, pg8::MoeSched, false>(lds, S, E);
        }
    }
    SYNC(6);
    if (IN(7)) combine_phase(P, gw, NGW, lane);
    SYNC(7);
    if (IN(8)) {
        pg8::DenseSched S; S.init((const bf16_t*)(ws + WS_H1B), (const bf16_t*)(ws + WS_WG), NTOK, 1024, 1024, G, bx);
        EpiPle E{(const float*)(ws + WS_H1), (const bf16_t*)(ws + WS_PJ), (const float*)(ws + WS_RS3), P.out};
        pg8::gemm_phase<EpiPle, pg8::DenseSched, false>(lds, S, E);
    }
    SYNC(8);
    if (IN(9)) final_phase(P, gw, NGW, lane);
#undef IN
#undef SYNC
}

#ifndef N_LAUNCH_MODE
#define N_LAUNCH_MODE 1
#endif
extern "C" void kernel_launch(void* const* d_in, const int* in_sizes, int n_in, void* d_out, int out_size, void* d_ws, size_t ws_size, hipStream_t stream) {
    static int grid = 0;
    if (grid == 0) {
        if (n_in != 21 || out_size != NTOK * DM || ws_size < WS_END) { fprintf(stderr, "kernel_launch: unexpected shapes (n_in %d out %d ws %zu)\n", n_in, out_size, ws_size); grid = -1; return; }
        int dev = 0, cus = 0, per_cu = 0;
        (void)hipGetDevice(&dev); (void)hipDeviceGetAttribute(&cus, hipDeviceAttributeMultiprocessorCount, dev);
        (void)hipFuncSetAttribute((const void*)fwd_kernel, hipFuncAttributeMaxDynamicSharedMemorySize, LDS_BYTES);
        if (hipOccupancyMaxActiveBlocksPerMultiprocessor(&per_cu, (const void*)fwd_kernel, NTHR, LDS_BYTES) != hipSuccess || per_cu < 1) { fprintf(stderr, "kernel_launch: occupancy query failed (%d)\n", per_cu); (void)hipGetLastError(); grid = -1; return; }
        grid = cus;
    }
    if (grid < 0) return;
    (void)hipMemsetAsync((char*)d_ws + WS_CTL, 0, CTL_BYTES, stream);
    Params p{};
    p.x = (const float*)d_in[0]; p.p = (const float*)d_in[1]; p.w_in = (const float*)d_in[2]; p.w_out = (const float*)d_in[3]; p.g_mix = (const float*)d_in[4]; p.g_ffn = (const float*)d_in[5];
    p.glu_b = (const float*)d_in[6]; p.dw_w = (const float*)d_in[7]; p.dw_b = (const float*)d_in[8]; p.ln_g = (const float*)d_in[9]; p.ln_b = (const float*)d_in[10];
    p.w_router = (const float*)d_in[11]; p.b_router = (const float*)d_in[12]; p.w_up = (const float*)d_in[13]; p.b_up = (const float*)d_in[14]; p.w_down = (const float*)d_in[15]; p.b_down = (const float*)d_in[16];
    p.w_ple_proj = (const float*)d_in[17]; p.w_ple_gate = (const float*)d_in[18]; p.g_ple = (const float*)d_in[19]; p.g_final = (const float*)d_in[20];
    p.out = (float*)d_out; p.ws = (unsigned char*)d_ws;
#ifndef PROBE_REPMASK
#define PROBE_REPMASK 0
#endif
    p.rep = PROBE_REPMASK;
#if N_LAUNCH_MODE == 1
    p.ph_lo = 0; p.ph_hi = NPHASE;
    void* args[] = {&p};
    hipError_t e = hipLaunchCooperativeKernel((const void*)fwd_kernel, dim3(grid), dim3(NTHR), args, LDS_BYTES, stream);
    if (e != hipSuccess) fprintf(stderr, "cooperative launch failed: %s (grid %d)\n", hipGetErrorString(e), grid);
#else
    for (int ph = 0; ph < NPHASE; ++ph) {
        p.ph_lo = ph; p.ph_hi = ph + 1;
        void* args[] = {&p};
        hipError_t e = hipLaunchCooperativeKernel((const void*)fwd_kernel, dim3(grid), dim3(NTHR), args, LDS_BYTES, stream);
        if (e != hipSuccess) { fprintf(stderr, "launch %d failed: %s (grid %d)\n", ph, hipGetErrorString(e), grid); break; }
    }
#endif
}
```

```cpp
#include <hip/hip_runtime.h>
#include <hip/hip_cooperative_groups.h>
#include <cstdio>
#include <cstdint>
namespace cg = cooperative_groups;

#define LAS __attribute__((address_space(3)))
#define GAS __attribute__((address_space(1)))
typedef unsigned short bf16_t;
typedef short bf16x8 __attribute__((ext_vector_type(8)));
typedef short s16x4 __attribute__((ext_vector_type(4)));
typedef float f32x4 __attribute__((ext_vector_type(4)));
typedef float f32x2 __attribute__((ext_vector_type(2)));
typedef float f32x16 __attribute__((ext_vector_type(16)));
typedef unsigned u32x4 __attribute__((ext_vector_type(4)));
typedef unsigned u32x2 __attribute__((ext_vector_type(2)));

constexpr int NB = 8, SEQ = 4096, DM = 1024, NTOK = NB * SEQ;
constexpr int NE = 32, TOPK = 4, NSLOT = NTOK * TOPK;
constexpr int INW = 1988;
constexpr int NSEL = 256;
constexpr float EPS = 1e-6f;
constexpr int NWAVES = 8, NTHR = 512;

constexpr size_t MiB = 1u << 20;
constexpr size_t WS_CTL = 0, CTL_BYTES = 64 * 1024;
constexpr size_t WS_ROPE = 1 * MiB;
constexpr size_t WS_WIN = 2 * MiB;
constexpr size_t WS_WOUT = 6 * MiB;
constexpr size_t WS_WG = 8 * MiB;
constexpr size_t WS_WP = 10 * MiB;
constexpr size_t WS_WRG = 10 * MiB + 512 * 1024;
constexpr size_t WS_RS1 = 11 * MiB;
constexpr size_t WS_RS3 = 11 * MiB + 512 * 1024;
constexpr size_t WS_WI = 12 * MiB;
constexpr size_t WS_LIST = 13 * MiB;
constexpr size_t WS_LSCALE = 17 * MiB;
constexpr size_t WS_LGATE = 21 * MiB;
constexpr size_t WS_PB = 25 * MiB;
constexpr size_t WS_WUP = 42 * MiB;
constexpr size_t WS_WDOWN = 170 * MiB;
constexpr size_t WS_H1 = 234 * MiB;
constexpr size_t WS_H1B = 362 * MiB;
constexpr size_t WS_PJ = 426 * MiB;
constexpr size_t WS_XB = 490 * MiB;
constexpr size_t WS_Q = 554 * MiB;
constexpr size_t WS_K = 586 * MiB;
constexpr size_t WS_V = 590 * MiB;
constexpr size_t WS_QI = 594 * MiB;
constexpr size_t WS_KI = 610 * MiB;
constexpr size_t WS_HGLU = 614 * MiB;
constexpr size_t WS_MIX = 646 * MiB;
constexpr size_t WS_ACT = 490 * MiB;
constexpr size_t WS_Y = 762 * MiB;
constexpr size_t WS_END = 1018 * MiB;
static_assert(WS_MIX + (size_t)NTOK * 1024 * 2 <= WS_ACT + (size_t)139264 * 2048 && WS_ACT + (size_t)139264 * 2048 <= WS_Y, "ws map");
constexpr int CW_CNT = 1024;
constexpr int CW_BAR = 8192;

constexpr int LDS_STAGE = 131072;
constexpr int LDS_MISC = LDS_STAGE;
constexpr int LDS_XB = 147456;
constexpr int LDS_BYTES = 147456 + 256;

__device__ __forceinline__ unsigned f2bf(float f) { unsigned u = __builtin_bit_cast(unsigned, f); return (u + 0x7fffu + ((u >> 16) & 1u)) >> 16; }
__device__ __forceinline__ unsigned pk2(float lo, float hi) { return f2bf(lo) | (f2bf(hi) << 16); }
__device__ __forceinline__ float bf_lo(unsigned w) { return __builtin_bit_cast(float, w << 16); }
__device__ __forceinline__ float bf_hi(unsigned w) { return __builtin_bit_cast(float, w & 0xffff0000u); }
__device__ __forceinline__ float wave_sum(float v) {
#pragma unroll
    for (int o = 1; o < 64; o <<= 1) v += __shfl_xor(v, o);
    return v;
}
__device__ __forceinline__ float sigmoidf_(float x) { return 1.0f / (1.0f + __expf(-x)); }
#define LDS_WAIT() asm volatile("s_waitcnt lgkmcnt(0)" ::: "memory")

struct Params {
    const float* x; const float* p; const float* w_in; const float* w_out; const float* g_mix; const float* g_ffn;
    const float* glu_b; const float* dw_w; const float* dw_b; const float* ln_g; const float* ln_b;
    const float* w_router; const float* b_router; const float* w_up; const float* b_up; const float* w_down; const float* b_down;
    const float* w_ple_proj; const float* w_ple_gate; const float* g_ple; const float* g_final;
    float* out; unsigned char* ws;
    int ph_lo, ph_hi, rep, pad;
};

namespace pg8 {
constexpr int BM = 256, BK = 64, HALF = 128, HTB = HALF * BK * 2, STAGE_BYTES = 8 * HTB, NXCD = 8, WGM = 8;
__host__ __device__ __forceinline__ int lds_byte(int r, int c) { const int st = (r >> 4) * 2 + (c >> 5), rr = r & 15, cc = c & 31, ob = rr * 64 + cc * 2; return st * 1024 + (ob ^ (((ob >> 9) & 1) << 5)); }
__host__ __device__ __forceinline__ void stage_rc(int b, int& R, int& C) { const int st = b / 1024, sb = b % 1024, swz = sb ^ (((sb >> 9) & 1) << 5); R = (st >> 1) * 16 + swz / 64; C = (st & 1) * 32 + (swz % 64) / 2; }
__host__ __device__ __forceinline__ int perm32(int rho) { const int n = rho >> 4, i = rho & 15; return 8 * (i >> 2) + 4 * n + (i & 3); }

struct Unit { int pm, pn, e, rows; };

__device__ __forceinline__ unsigned cvt_pk_bf16(float lo, float hi) { unsigned r; asm volatile("v_cvt_pk_bf16_f32 %0, %1, %2" : "=v"(r) : "v"(lo), "v"(hi)); return r; }

struct DenseSched {
    const bf16_t* A; const bf16_t* Bt; int K;
    int nM, nN, nwg, G, c;
    __device__ void init(const bf16_t* A_, const bf16_t* Bt_, int M, int N, int K_, int G_, int c_) { A = A_; Bt = Bt_; K = K_; nM = M / BM; nN = N / BM; nwg = nM * nN; G = G_; c = c_; }
    __device__ bool next(int i, Unit& u) const {
        const long L = (long)i * G + c; if (L >= nwg) return false;
        int wgid = (int)L; { const int q = nwg / NXCD, r = nwg % NXCD, xcd = wgid % NXCD, off = wgid / NXCD; wgid = (xcd < r ? xcd * (q + 1) : r * (q + 1) + (xcd - r) * q) + off; }
        const int nig = WGM * nN, gid = wgid / nig, fm = gid * WGM, gsz = (nM - fm) < WGM ? (nM - fm) : WGM;
        u.pm = fm + ((wgid % nig) % gsz); u.pn = (wgid % nig) / gsz; u.e = 0; u.rows = BM; return true;
    }
    __device__ __forceinline__ const char* a_ptr(const Unit& u) const { return (const char*)A + (size_t)u.pm * BM * K * 2; }
    __device__ __forceinline__ const char* b_ptr(const Unit& u) const { return (const char*)Bt + (size_t)u.pn * BM * K * 2; }
    __device__ __forceinline__ int a_row(const Unit&, int) const { return 0; }
};

struct MoeSched {
    const bf16_t* A; const bf16_t* Bt; int K; size_t b_estride;
    const LAS int* tb;
    const LAS int* cnt;
    const int* list;
    int nN, nwg, G, c; bool gather;
    __device__ bool next(int i, Unit& u) const {
        const long L = (long)i * G + c; if (L >= nwg) return false;
        int wgid = (int)L; { const int q = nwg / NXCD, r = nwg % NXCD, xcd = wgid % NXCD, off = wgid / NXCD; wgid = (xcd < r ? xcd * (q + 1) : r * (q + 1) + (xcd - r) * q) + off; }
        int e = 0;
#pragma unroll 1
        for (; e < NE - 1; ++e) { if (wgid < tb[e + 1] * nN) break; }
        const int local = wgid - tb[e] * nN, nM = tb[e + 1] - tb[e];
        const int nig = WGM * nN, gid = local / nig, fm = gid * WGM, gsz = (nM - fm) < WGM ? (nM - fm) : WGM;
        const int rt = fm + ((local % nig) % gsz);
        u.pm = tb[e] + rt; u.pn = (local % nig) / gsz; u.e = e;
        const int left = cnt[e] - rt * BM; u.rows = left < BM ? left : BM; return true;
    }
    __device__ __forceinline__ const char* a_ptr(const Unit& u) const { return gather ? (const char*)A : (const char*)A + (size_t)u.pm * BM * K * 2; }
    __device__ __forceinline__ const char* b_ptr(const Unit& u) const { return (const char*)Bt + (size_t)u.e * b_estride + (size_t)u.pn * BM * K * 2; }
    __device__ __forceinline__ int a_row(const Unit& u, int r) const {
        const int rt = u.pm - tb[u.e];
        return r < u.rows ? (list[u.e * NTOK + rt * BM + r] >> 2) : 0;
    }
};

template <class Epi, class Sched, bool GATHER>
__device__ __forceinline__ void gemm_phase(LAS unsigned char* lds, const Sched& S, const Epi& E) {
    const int tid = threadIdx.x, wid = __builtin_amdgcn_readfirstlane(tid >> 6), lane = tid & 63, wr = wid >> 2, wc = wid & 3, fr = lane & 15, fq = lane >> 4;
    const int K = S.K, nt = K / BK;
    unsigned voffA[2], voffB[2]; int RA[2], CA[2];
#pragma unroll
    for (int i = 0; i < 2; ++i) { int R, C; stage_rc(tid * 16 + i * 8192, R, C); const int Rb = Epi::PERM ? ((R & ~31) + perm32(R & 31)) : R;
        voffA[i] = (unsigned)(R * K + C) * 2u; voffB[i] = (unsigned)(Rb * K + C) * 2u; RA[i] = R; CA[i] = C; }
    const size_t kstep = (size_t)(BK * 2);
    const size_t hstep = (size_t)HALF * K * 2;
    const unsigned ldsw = (unsigned)wid * 1024u;
    const int aoff = lds_byte(wr * 64 + fr, fq * 8), boff = lds_byte(wc * 32 + fr, fq * 8);
    unsigned gC[2][2], gN[2][2];
#define PG8_SA(b, h) (((b) * 2 + (h)) * HTB)
#define PG8_SB(b, h) ((4 + (b) * 2 + (h)) * HTB)
#define PG8_STAGE(bufoff, gbase, voff) do { _Pragma("unroll") for (int _i = 0; _i < 2; ++_i) \
        __builtin_amdgcn_global_load_lds((const unsigned*)((const char*)(gbase) + (voff)[_i]), (LAS unsigned*)(lds + (bufoff) + ldsw + _i * 8192), 16, 0, 0); } while (0)
#define PG8_STAGE_A(bufoff, kp, h) do { if constexpr (GATHER) { PG8_STAGE(bufoff, kp, gC[h]); } else { PG8_STAGE(bufoff, (kp) + (h) * hstep, voffA); } } while (0)
#define PG8_LDA(dst, b, h) do { _Pragma("unroll") for (int m = 0; m < 4; ++m) _Pragma("unroll") for (int k = 0; k < 2; ++k) dst[m][k] = *(const LAS bf16x8*)(lds + PG8_SA(b, h) + aoff + m * 2048 + k * 1024); } while (0)
#define PG8_LDB(dst, b, h) do { _Pragma("unroll") for (int n = 0; n < 2; ++n) _Pragma("unroll") for (int k = 0; k < 2; ++k) dst[n][k] = *(const LAS bf16x8*)(lds + PG8_SB(b, h) + boff + n * 2048 + k * 1024); } while (0)
#define PG8_MMA(ai, bj, At, Bt) do { __builtin_amdgcn_s_setprio(1); _Pragma("unroll") for (int m = 0; m < 4; ++m) _Pragma("unroll") for (int n = 0; n < 2; ++n) _Pragma("unroll") for (int k = 0; k < 2; ++k) \
        acc[ai][bj][m][n] = __builtin_amdgcn_mfma_f32_16x16x32_bf16(Bt[n][k], At[m][k], acc[ai][bj][m][n], 0, 0, 0); __builtin_amdgcn_s_setprio(0); } while (0)
#define PG8_WAIT_V(n) asm volatile("s_waitcnt vmcnt(" #n ")" ::: "memory")
#define PG8_WAIT_L(n) asm volatile("s_waitcnt lgkmcnt(" #n ")" ::: "memory")
#define PG8_BAR __builtin_amdgcn_s_barrier()
#define PG8_SCHED __builtin_amdgcn_sched_barrier(0)
#define PG8_GOFF(dst, u) do { _Pragma("unroll") for (int _h = 0; _h < 2; ++_h) _Pragma("unroll") for (int _i = 0; _i < 2; ++_i) \
        dst[_h][_i] = (unsigned)(S.a_row(u, _h * HALF + RA[_i]) * K + CA[_i]) * 2u; } while (0)
    Unit cur, nxt, nn; int ui = 0;
    if (!S.next(0, cur)) return;
    bool has_next = S.next(1, nxt);
    if constexpr (GATHER) { PG8_GOFF(gC, cur); if (has_next) { PG8_GOFF(gN, nxt); } else { PG8_GOFF(gN, cur); } }
    f32x4 acc[2][2][4][2];
#pragma unroll
    for (int a = 0; a < 2; ++a)
#pragma unroll
        for (int b = 0; b < 2; ++b)
#pragma unroll
            for (int m = 0; m < 4; ++m)
#pragma unroll
                for (int n = 0; n < 2; ++n) acc[a][b][m][n] = (f32x4){0.f, 0.f, 0.f, 0.f};
    bf16x8 At[4][2], B0[2][2], B1[2][2];
    const char* cA = S.a_ptr(cur); const char* cB = S.b_ptr(cur);
    PG8_STAGE(PG8_SB(0, 0), cB, voffB); PG8_STAGE(PG8_SB(0, 1), cB + hstep, voffB); PG8_STAGE_A(PG8_SA(0, 0), cA, 0); PG8_STAGE_A(PG8_SA(0, 1), cA, 1);
    if (wr == 1) PG8_BAR;
    PG8_WAIT_V(2); PG8_BAR;
    PG8_STAGE(PG8_SB(1, 0), cB + kstep, voffB); PG8_STAGE_A(PG8_SA(1, 0), cA + kstep, 0); PG8_STAGE(PG8_SB(1, 1), cB + hstep + kstep, voffB);
    PG8_WAIT_V(6); PG8_BAR;
    for (;;) {
        const char* nA = has_next ? S.a_ptr(nxt) : cA; const char* nB = has_next ? S.b_ptr(nxt) : cB;
        for (int t = 0; t < nt; t += 2) {
            const bool last = (t == nt - 2);
            const char* a1 = cA + (size_t)(t + 1) * kstep;
            const char* a2 = last ? nA : cA + (size_t)(t + 2) * kstep; const char* b2 = last ? nB : cB + (size_t)(t + 2) * kstep;
            const char* a3 = a2 + kstep; const char* b3 = b2 + kstep;
            PG8_LDB(B0, 0, 0); PG8_LDB(B1, 0, 1); PG8_SCHED; PG8_LDA(At, 0, 0); PG8_STAGE_A(PG8_SA(1, 1), a1, 1);
            if constexpr (GATHER) { if (last) {
#pragma unroll
                for (int h = 0; h < 2; ++h)
#pragma unroll
                    for (int i = 0; i < 2; ++i) gC[h][i] = gN[h][i]; } }
            PG8_WAIT_V(8); PG8_WAIT_L(0); PG8_BAR; PG8_MMA(0, 0, At, B0); PG8_MMA(0, 1, At, B1); PG8_BAR; PG8_SCHED;
            PG8_LDA(At, 0, 1); PG8_STAGE(PG8_SB(0, 0), b2, voffB); PG8_STAGE(PG8_SB(0, 1), b2 + hstep, voffB); PG8_STAGE_A(PG8_SA(0, 0), a2, 0);
            PG8_WAIT_V(8); PG8_WAIT_L(0); PG8_BAR; PG8_MMA(1, 0, At, B0); PG8_MMA(1, 1, At, B1); PG8_BAR; PG8_SCHED;
            PG8_LDB(B0, 1, 0); PG8_LDB(B1, 1, 1); PG8_SCHED; PG8_LDA(At, 1, 0); PG8_STAGE_A(PG8_SA(0, 1), a2, 1);
            PG8_WAIT_V(8); PG8_WAIT_L(0); PG8_BAR; PG8_MMA(0, 0, At, B0); PG8_MMA(0, 1, At, B1); PG8_BAR; PG8_SCHED;
            PG8_LDA(At, 1, 1); PG8_STAGE(PG8_SB(1, 0), b3, voffB); PG8_STAGE(PG8_SB(1, 1), b3 + hstep, voffB); PG8_STAGE_A(PG8_SA(1, 0), a3, 0);
            PG8_WAIT_V(8); PG8_WAIT_L(0); PG8_BAR; PG8_MMA(1, 0, At, B0); PG8_MMA(1, 1, At, B1); PG8_BAR; PG8_SCHED;
        }
        if (wr == 0) PG8_BAR;
        bool has_nn = false;
        if constexpr (GATHER) { if (has_next) { has_nn = S.next(ui + 2, nn); if (has_nn) { PG8_GOFF(gN, nn); } } }
        else { if (has_next) has_nn = S.next(ui + 2, nn); }
        E(acc, cur, wr, wc, fr, fq);
        if (!has_next) break;
#pragma unroll
        for (int a = 0; a < 2; ++a)
#pragma unroll
            for (int b = 0; b < 2; ++b)
#pragma unroll
                for (int m = 0; m < 4; ++m)
#pragma unroll
                    for (int n = 0; n < 2; ++n) acc[a][b][m][n] = (f32x4){0.f, 0.f, 0.f, 0.f};
        cur = nxt; cA = nA; cB = nB; ++ui; nxt = nn; has_next = has_nn;
        if (wr == 1) PG8_BAR;
    }
    PG8_WAIT_V(0);
    PG8_BAR;
#undef PG8_SA
#undef PG8_SB
#undef PG8_STAGE
#undef PG8_STAGE_A
#undef PG8_LDA
#undef PG8_LDB
#undef PG8_MMA
#undef PG8_WAIT_V
#undef PG8_WAIT_L
#undef PG8_BAR
#undef PG8_SCHED
#undef PG8_GOFF
}
}

using pg8::Unit; using pg8::cvt_pk_bf16;
constexpr int BM = 256, HALF = 128;

struct EpiInProj {
    static constexpr bool PERM = true;
    const float* rs1; const f32x2* rope; const float* glu_b;
    bf16_t *q, *k, *v, *qi, *ki, *hglu; float* wi;
    __device__ __forceinline__ void operator()(const f32x4 (&acc)[2][2][4][2], const Unit& u, int wr, int wc, int fr, int fq) const {
        const int row0 = u.pm * BM + wr * 64 + fr;
        if (u.pn >= 4) {
            const int ch = 128 * (u.pn - 4) + 32 * wc + 8 * fq;
            f32x4 ba[2], bg[2];
#pragma unroll
            for (int n = 0; n < 2; ++n) { ba[n] = *(const f32x4*)(glu_b + ch + 4 * n); bg[n] = *(const f32x4*)(glu_b + 512 + ch + 4 * n); }
#pragma unroll
            for (int ai = 0; ai < 2; ++ai)
#pragma unroll
                for (int m = 0; m < 4; ++m) { const int row = row0 + ai * HALF + m * 16; const float rs = rs1[row];
                    float o[8];
#pragma unroll
                    for (int n = 0; n < 2; ++n)
#pragma unroll
                        for (int e = 0; e < 4; ++e) { const float a = acc[ai][0][m][n][e] * rs + ba[n][e], g = acc[ai][1][m][n][e] * rs + bg[n][e]; o[4 * n + e] = a * sigmoidf_(g); }
                    u32x4 w; w.x = cvt_pk_bf16(o[0], o[1]); w.y = cvt_pk_bf16(o[2], o[3]); w.z = cvt_pk_bf16(o[4], o[5]); w.w = cvt_pk_bf16(o[6], o[7]);
                    *(u32x4*)(hglu + (size_t)row * 512 + ch) = w; }
            return;
        }
        bf16_t* dst; int ld, col; bool do_rope = true, is_wi = false;
        if (u.pn < 2) { dst = q; ld = 512; col = (4 * u.pn + wc) * 64; }
        else if (u.pn == 2) { dst = qi; ld = 256; col = wc * 64; }
        else { ld = 64; col = 0; if (wc == 0) dst = k; else if (wc == 1) dst = ki; else if (wc == 2) { dst = v; do_rope = false; } else { dst = v; is_wi = true; do_rope = false; } }
        if (is_wi) {
            if (fq == 0) {
#pragma unroll
                for (int ai = 0; ai < 2; ++ai)
#pragma unroll
                    for (int m = 0; m < 4; ++m) { const int row = row0 + ai * HALF + m * 16; const float rs = rs1[row];
                        *(f32x4*)(wi + (size_t)row * 4) = acc[ai][0][m][0] * rs; }
            }
            return;
        }
        const int d0 = 8 * fq;
#pragma unroll
        for (int ai = 0; ai < 2; ++ai)
#pragma unroll
            for (int m = 0; m < 4; ++m) { const int row = row0 + ai * HALF + m * 16; const float rs = rs1[row];
                float o1[8], o2[8];
                if (do_rope) {
                    const f32x2* rp = rope + (size_t)(row & (SEQ - 1)) * 32 + d0;
#pragma unroll
                    for (int n = 0; n < 2; ++n)
#pragma unroll
                        for (int e = 0; e < 4; ++e) { const f32x2 cs = rp[4 * n + e]; const float x1 = acc[ai][0][m][n][e] * rs, x2 = acc[ai][1][m][n][e] * rs;
                            o1[4 * n + e] = x1 * cs.x - x2 * cs.y; o2[4 * n + e] = x2 * cs.x + x1 * cs.y; }
                } else {
#pragma unroll
                    for (int n = 0; n < 2; ++n)
#pragma unroll
                        for (int e = 0; e < 4; ++e) { o1[4 * n + e] = acc[ai][0][m][n][e] * rs; o2[4 * n + e] = acc[ai][1][m][n][e] * rs; }
                }
                u32x4 w1, w2; w1.x = cvt_pk_bf16(o1[0], o1[1]); w1.y = cvt_pk_bf16(o1[2], o1[3]); w1.z = cvt_pk_bf16(o1[4], o1[5]); w1.w = cvt_pk_bf16(o1[6], o1[7]);
                w2.x = cvt_pk_bf16(o2[0], o2[1]); w2.y = cvt_pk_bf16(o2[2], o2[3]); w2.z = cvt_pk_bf16(o2[4], o2[5]); w2.w = cvt_pk_bf16(o2[6], o2[7]);
                bf16_t* rp2 = dst + (size_t)row * ld + col + d0;
                *(u32x4*)(rp2) = w1; *(u32x4*)(rp2 + 32) = w2; }
    }
};

struct EpiBf16Plain {
    static constexpr bool PERM = true;
    bf16_t* O; int ldc;
    __device__ __forceinline__ void operator()(const f32x4 (&acc)[2][2][4][2], const Unit& u, int wr, int wc, int fr, int fq) const {
        const int row0 = u.pm * BM + wr * 64 + fr, col0 = u.pn * BM + wc * 32 + 8 * fq;
#pragma unroll
        for (int ai = 0; ai < 2; ++ai)
#pragma unroll
            for (int m = 0; m < 4; ++m) { bf16_t* rowp = O + (size_t)(row0 + ai * HALF + m * 16) * ldc + col0;
#pragma unroll
                for (int bj = 0; bj < 2; ++bj) { const f32x4 v0 = acc[ai][bj][m][0], v1 = acc[ai][bj][m][1];
                    u32x4 w; w.x = cvt_pk_bf16(v0[0], v0[1]); w.y = cvt_pk_bf16(v0[2], v0[3]); w.z = cvt_pk_bf16(v1[0], v1[1]); w.w = cvt_pk_bf16(v1[2], v1[3]);
                    *(u32x4*)(rowp + bj * HALF) = w; } }
    }
};

struct EpiOutProj {
    static constexpr bool PERM = false;
    const float* x; float* h1; bf16_t* h1b;
    __device__ __forceinline__ void operator()(const f32x4 (&acc)[2][2][4][2], const Unit& u, int wr, int wc, int fr, int fq) const {
        const int row0 = u.pm * BM + wr * 64 + fr, col0 = u.pn * BM + wc * 32 + 4 * fq;
#pragma unroll
        for (int ai = 0; ai < 2; ++ai)
#pragma unroll
            for (int m = 0; m < 4; ++m) { const size_t off = (size_t)(row0 + ai * HALF + m * 16) * DM + col0;
#pragma unroll
                for (int bj = 0; bj < 2; ++bj)
#pragma unroll
                    for (int n = 0; n < 2; ++n) { const size_t o = off + bj * HALF + n * 16; const f32x4 r = *(const f32x4*)(x + o) + acc[ai][bj][m][n];
                        *(f32x4*)(h1 + o) = r; u32x2 w; w.x = cvt_pk_bf16(r[0], r[1]); w.y = cvt_pk_bf16(r[2], r[3]); *(u32x2*)(h1b + o) = w; } }
    }
};

struct EpiUp {
    static constexpr bool PERM = true;
    const float* lscale; const float* b_up; bf16_t* act; const LAS int* tb;
    __device__ __forceinline__ void operator()(const f32x4 (&acc)[2][2][4][2], const Unit& u, int wr, int wc, int fr, int fq) const {
        const int r0 = wr * 64 + fr, ch = 128 * u.pn + 32 * wc + 8 * fq, rt = u.pm - tb[u.e];
        const float* bu = b_up + (size_t)u.e * 2048;
        f32x4 bg[2], bl[2];
#pragma unroll
        for (int n = 0; n < 2; ++n) { bg[n] = *(const f32x4*)(bu + ch + 4 * n); bl[n] = *(const f32x4*)(bu + 1024 + ch + 4 * n); }
#pragma unroll
        for (int ai = 0; ai < 2; ++ai)
#pragma unroll
            for (int m = 0; m < 4; ++m) { const int r = r0 + ai * HALF + m * 16;
                const float rs = (r < u.rows) ? lscale[u.e * NTOK + rt * BM + r] : 0.f;
                float o[8];
#pragma unroll
                for (int n = 0; n < 2; ++n)
#pragma unroll
                    for (int e = 0; e < 4; ++e) { float g = acc[ai][0][m][n][e] * rs + bg[n][e], l = acc[ai][1][m][n][e] * rs + bl[n][e];
                        g = fminf(g, 7.0f); l = fminf(fmaxf(l, -7.0f), 7.0f); o[4 * n + e] = g * sigmoidf_(1.702f * g) * (l + 1.0f); }
                u32x4 w; w.x = cvt_pk_bf16(o[0], o[1]); w.y = cvt_pk_bf16(o[2], o[3]); w.z = cvt_pk_bf16(o[4], o[5]); w.w = cvt_pk_bf16(o[6], o[7]);
                *(u32x4*)(act + (size_t)(u.pm * BM + r) * 1024 + ch) = w; }
    }
};

struct EpiDown {
    static constexpr bool PERM = true;
    const int* list; const float* lgate; const float* b_down; bf16_t* y; const LAS int* tb;
    __device__ __forceinline__ void operator()(const f32x4 (&acc)[2][2][4][2], const Unit& u, int wr, int wc, int fr, int fq) const {
        const int r0 = wr * 64 + fr, col0 = u.pn * BM + wc * 32 + 8 * fq, rt = u.pm - tb[u.e];
        const float* bd = b_down + (size_t)u.e * 1024;
        f32x4 bv[2][2];
#pragma unroll
        for (int bj = 0; bj < 2; ++bj)
#pragma unroll
            for (int n = 0; n < 2; ++n) bv[bj][n] = *(const f32x4*)(bd + col0 + bj * HALF + 4 * n);
#pragma unroll
        for (int ai = 0; ai < 2; ++ai)
#pragma unroll
            for (int m = 0; m < 4; ++m) { const int r = r0 + ai * HALF + m * 16;
                if (r < u.rows) { const int li = u.e * NTOK + rt * BM + r; const int slot = list[li]; const float g = lgate[li];
                    bf16_t* rowp = y + (size_t)slot * 1024 + col0;
#pragma unroll
                    for (int bj = 0; bj < 2; ++bj) { const f32x4 v0 = (acc[ai][bj][m][0] + bv[bj][0]) * g, v1 = (acc[ai][bj][m][1] + bv[bj][1]) * g;
                        u32x4 w; w.x = cvt_pk_bf16(v0[0], v0[1]); w.y = cvt_pk_bf16(v0[2], v0[3]); w.z = cvt_pk_bf16(v1[0], v1[1]); w.w = cvt_pk_bf16(v1[2], v1[3]);
                        *(u32x4*)(rowp + bj * HALF) = w; } } }
    }
};

struct EpiPle {
    static constexpr bool PERM = false;
    const float* h2; const bf16_t* pj; const float* rs3; float* out;
    __device__ __forceinline__ void operator()(const f32x4 (&acc)[2][2][4][2], const Unit& u, int wr, int wc, int fr, int fq) const {
        const int row0 = u.pm * BM + wr * 64 + fr, col0 = u.pn * BM + wc * 32 + 4 * fq;
#pragma unroll
        for (int ai = 0; ai < 2; ++ai)
#pragma unroll
            for (int m = 0; m < 4; ++m) { const int row = row0 + ai * HALF + m * 16; const size_t off = (size_t)row * DM + col0; const float rs = rs3[row];
#pragma unroll
                for (int bj = 0; bj < 2; ++bj)
#pragma unroll
                    for (int n = 0; n < 2; ++n) { const size_t o = off + bj * HALF + n * 16; const f32x4 hv = *(const f32x4*)(h2 + o); const u32x2 pw = *(const u32x2*)(pj + o);
                        const f32x4 a = acc[ai][bj][m][n]; f32x4 r;
                        r[0] = hv[0] + bf_lo(pw.x) * sigmoidf_(a[0] * rs); r[1] = hv[1] + bf_hi(pw.x) * sigmoidf_(a[1] * rs);
                        r[2] = hv[2] + bf_lo(pw.y) * sigmoidf_(a[2] * rs); r[3] = hv[3] + bf_hi(pw.y) * sigmoidf_(a[3] * rs);
                        *(f32x4*)(out + o) = r; } }
    }
};

__device__ __forceinline__ void p0_transpose_item(const float* W, int ldw, bf16_t* WT, int Kdim, const float* gain, LAS float* scr, int kb, int n0, int src0, int nvalid, int lane) {
    const int k0 = 64 * kb;
    f32x4 ld4[8];
#pragma unroll
    for (int i = 0; i < 8; ++i) { const int kk = 8 * i + (lane >> 3), j = (lane & 7) * 4;
        ld4[i] = (f32x4){0.f, 0.f, 0.f, 0.f}; if (j < nvalid) ld4[i] = *(const f32x4*)(W + (size_t)(k0 + kk) * ldw + src0 + j); }
#pragma unroll
    for (int i = 0; i < 8; ++i) { const int kk = 8 * i + (lane >> 3), j = (lane & 7) * 4; const float gk = gain ? gain[k0 + kk] : 1.0f;
        LAS float* d = scr + kk * 33 + j; d[0] = ld4[i].x * gk; d[1] = ld4[i].y * gk; d[2] = ld4[i].z * gk; d[3] = ld4[i].w * gk; }
    LDS_WAIT(); asm volatile("" ::: "memory");
    const int c = lane & 7;
#pragma unroll
    for (int j = 0; j < 4; ++j) { const int n = (lane >> 3) + 8 * j; const LAS float* s = scr + (8 * c) * 33 + n;
        u32x4 o; o.x = pk2(s[0 * 33], s[1 * 33]); o.y = pk2(s[2 * 33], s[3 * 33]); o.z = pk2(s[4 * 33], s[5 * 33]); o.w = pk2(s[6 * 33], s[7 * 33]);
        *(u32x4*)(WT + (size_t)(n0 + n) * Kdim + k0 + 8 * c) = o; }
    LDS_WAIT(); asm volatile("" ::: "memory");
}
__device__ __forceinline__ void win_colmap(int nb, int& src0, int& nvalid) {
    const int pn = nb >> 3, j = (nb & 7) * 32, bj = j >> 7, slot = (j & 127) >> 5;
    nvalid = 32;
    if (pn < 2) src0 = (4 * pn + slot) * 64 + 32 * bj;
    else if (pn == 2) src0 = 640 + slot * 64 + 32 * bj;
    else if (pn == 3) { if (slot == 0) src0 = 512 + 32 * bj; else if (slot == 1) src0 = 896 + 32 * bj; else if (slot == 2) src0 = 576 + 32 * bj; else { src0 = 960; nvalid = bj == 0 ? 4 : 0; } }
    else src0 = 964 + 512 * bj + 128 * (pn - 4) + 32 * slot;
}
__device__ __forceinline__ void p0_prologue(const Params& P, LAS unsigned char* lds, int vcu, int G, int wave, int lane) {
    unsigned char* ws = P.ws;
    LAS float* scr = (LAS float*)(lds + wave * 16384);
    const int gw = vcu * NWAVES + wave, NGW = G * NWAVES;
    constexpr int I_IN = 16 * 64, I_OUT = 16 * 32, I_G = 16 * 32, I_P = 4 * 32, I_UP = 32 * 16 * 64, I_DN = 32 * 16 * 32;
    constexpr int NITEMS = I_IN + I_OUT + I_G + I_P + I_UP + I_DN;
    for (int it = gw; it < NITEMS; it += NGW) {
        int r = it;
        if (r < I_IN) { const int kb = r / 64, nb = r % 64; int s0, nv; win_colmap(nb, s0, nv); p0_transpose_item(P.w_in, INW, (bf16_t*)(ws + WS_WIN), 1024, P.g_mix, scr, kb, nb * 32, s0, nv, lane); continue; } r -= I_IN;
        if (r < I_OUT) { const int kb = r / 32, nb = r % 32; p0_transpose_item(P.w_out, 1024, (bf16_t*)(ws + WS_WOUT), 1024, nullptr, scr, kb, nb * 32, nb * 32, 32, lane); continue; } r -= I_OUT;
        if (r < I_G) { const int kb = r / 32, nb = r % 32; p0_transpose_item(P.w_ple_gate, 1024, (bf16_t*)(ws + WS_WG), 1024, P.g_ple, scr, kb, nb * 32, nb * 32, 32, lane); continue; } r -= I_G;
        if (r < I_P) { const int kb = r / 32, nb = r % 32; p0_transpose_item(P.w_ple_proj, 1024, (bf16_t*)(ws + WS_WP), 256, nullptr, scr, kb, nb * 32, nb * 32, 32, lane); continue; } r -= I_P;
        if (r < I_UP) { const int e = r / 1024, rr = r % 1024, kb = rr / 64, nb = rr % 64;
            const int pn = nb >> 3, j = (nb & 7) * 32, bj = j >> 7, jj = j & 127;
            p0_transpose_item(P.w_up + (size_t)e * 1024 * 2048, 2048, (bf16_t*)(ws + WS_WUP) + (size_t)e * 2048 * 1024, 1024, P.g_ffn, scr, kb, nb * 32, 1024 * bj + 128 * pn + jj, 32, lane); continue; } r -= I_UP;
        { const int e = r / 512, rr = r % 512, kb = rr / 32, nb = rr % 32;
            p0_transpose_item(P.w_down + (size_t)e * 1024 * 1024, 1024, (bf16_t*)(ws + WS_WDOWN) + (size_t)e * 1024 * 1024, 1024, nullptr, scr, kb, nb * 32, nb * 32, 32, lane); }
    }
    float* rs1 = (float*)(ws + WS_RS1); bf16_t* xb = (bf16_t*)(ws + WS_XB);
    for (int m = gw; m < NTOK; m += NGW) {
        const f32x4* xr = (const f32x4*)(P.x + (size_t)m * DM) + lane; f32x4 v[4]; float s = 0.f;
#pragma unroll
        for (int j = 0; j < 4; ++j) { v[j] = xr[64 * j]; s += (v[j].x * v[j].x + v[j].y * v[j].y) + (v[j].z * v[j].z + v[j].w * v[j].w); }
        s = wave_sum(s);
        u32x2* o8 = (u32x2*)(xb + (size_t)m * DM) + lane;
#pragma unroll
        for (int j = 0; j < 4; ++j) { u32x2 w; w.x = pk2(v[j].x, v[j].y); w.y = pk2(v[j].z, v[j].w); o8[64 * j] = w; }
        if (lane == 0) rs1[m] = 1.0f / sqrtf(s * (1.0f / DM) + EPS);
    }
    bf16_t* pb = (bf16_t*)(ws + WS_PB);
    for (int m = gw; m < NTOK; m += NGW) { const f32x4 v = *((const f32x4*)(P.p + (size_t)m * 256) + lane); u32x2 w; w.x = pk2(v.x, v.y); w.y = pk2(v.z, v.w); *((u32x2*)(pb + (size_t)m * 256) + lane) = w; }
    f32x2* rope = (f32x2*)(ws + WS_ROPE);
    for (int idx = gw * 64 + lane; idx < SEQ * 32; idx += NGW * 64) { const int t = idx >> 5, i = idx & 31;
        const float inv = exp2f(-(float)i * (13.287712379549449f / 32.0f));
        const float ang = (float)t * inv;
        const double rev = (double)ang * 0.15915494309189535; const float fr = (float)(rev - __builtin_floor(rev));
        rope[idx] = (f32x2){__builtin_amdgcn_cosf(fr), __builtin_amdgcn_sinf(fr)}; }
    float* wrg = (float*)(ws + WS_WRG);
    for (int idx = gw * 64 + lane; idx < 1024 * 32; idx += NGW * 64) wrg[idx] = P.w_router[idx] * P.g_ffn[idx >> 5];
}

__device__ __forceinline__ unsigned fkey(float f) { unsigned u = __builtin_bit_cast(unsigned, f); if (u == 0x80000000u) u = 0u; return u ^ ((unsigned)((int)u >> 31) | 0x80000000u); }
__device__ __forceinline__ int mbcnt64(unsigned long long m) { return __builtin_amdgcn_mbcnt_hi((unsigned)(m >> 32), __builtin_amdgcn_mbcnt_lo((unsigned)m, 0u)); }

template <int NR>
__device__ __forceinline__ unsigned bisect_thr(const unsigned (&v)[NR], unsigned prefix, int startbit) {
    bool exact = false;
#pragma unroll 1
    for (int bit = startbit; bit >= 0; --bit) {
        const unsigned cand = prefix | (1u << bit); int cnt = 0;
#pragma unroll
        for (int r = 0; r < NR; ++r) { cnt += __builtin_popcountll(__ballot(v[r] >= cand)); if ((r & 7) == 7) __builtin_amdgcn_sched_barrier(0); }
        if (cnt >= NSEL) prefix = cand;
        if (cnt == NSEL) { exact = true; break; }
    }
    return exact ? prefix - 1u : prefix;
}
template <int NR, bool EXPL>
__device__ __forceinline__ void compact_sel(const unsigned (&v)[NR], const unsigned (&ci)[NR], unsigned T, LAS unsigned* list, int lane) {
    int cgt = 0;
#pragma unroll
    for (int r = 0; r < NR; ++r) { cgt += __builtin_popcountll(__ballot(v[r] > T)); if ((r & 7) == 7) __builtin_amdgcn_sched_barrier(0); }
    const int need = NSEL - cgt; int base = 0, ties = 0;
#pragma unroll
    for (int r = 0; r < NR; ++r) { const bool gt = v[r] > T, eq = v[r] == T; const unsigned long long em = __ballot(eq);
        const bool sel = gt || (eq && (ties + mbcnt64(em)) < need); const unsigned long long sm = __ballot(sel);
        list[sel ? base + mbcnt64(sm) : NSEL + lane] = EXPL ? ci[r] : (unsigned)(r * 64 + lane);
        base += __builtin_popcountll(sm); ties += __builtin_popcountll(em);
        if ((r & 3) == 3) __builtin_amdgcn_sched_barrier(0); }
}
constexpr int SEL_CAP = 1024;
template <int NR>
__device__ __forceinline__ void select_topk(LAS float* row, LAS unsigned* H, LAS unsigned* list, int lane, bool zero_h) {
    unsigned v[NR];
#pragma unroll
    for (int r = 0; r < NR; ++r) v[r] = fkey(row[r * 64 + lane]);
    LAS u32x4* H4 = (LAS u32x4*)H;
    const u32x4 h0 = H4[2 * lane], h1 = H4[2 * lane + 1];
    if (zero_h) { H4[2 * lane] = (u32x4){0u, 0u, 0u, 0u}; H4[2 * lane + 1] = (u32x4){0u, 0u, 0u, 0u}; }
    const unsigned hw[8] = {h0.x, h0.y, h0.z, h0.w, h1.x, h1.y, h1.z, h1.w};
    unsigned c[16];
#pragma unroll
    for (int i = 0; i < 8; ++i) { c[2 * i] = hw[i] & 0xffffu; c[2 * i + 1] = hw[i] >> 16; }
    unsigned s = 0u;
#pragma unroll
    for (int i = 0; i < 16; ++i) s += c[i];
    unsigned S = s;
#pragma unroll
    for (int off = 1; off < 64; off <<= 1) { const unsigned o = __shfl_down(S, off); if (lane + off < 64) S += o; }
    const unsigned long long okm = __ballot(S >= (unsigned)NSEL);
    bool fast = okm != 0ull; unsigned floorkey = 0u; int C = 0;
    if (fast) {
        const int Ls = 63 - __builtin_clzll(okm);
        unsigned acc = S - s; int bl = -1; unsigned accb = 0u;
#pragma unroll
        for (int b = 15; b >= 0; --b) { acc += c[b]; if (bl < 0 && acc >= (unsigned)NSEL) { bl = b; accb = acc; } }
        const int bstar = __shfl(bl, Ls) + 16 * Ls; C = (int)__shfl(accb, Ls);
        floorkey = (unsigned)bstar << 22;
        fast = (bstar > 1) && (C <= SEL_CAP);
    }
    if (!fast) {
        const unsigned T = bisect_thr<NR>(v, 0u, 31);
        compact_sel<NR, false>(v, v, T, list, lane);
        return;
    }
    LAS unsigned* ckl = (LAS unsigned*)row; LAS unsigned* cil = ckl + 1152;
    { int base = 0;
#pragma unroll
      for (int r = 0; r < NR; ++r) { const bool cnd = v[r] >= floorkey; const unsigned long long m = __ballot(cnd);
          const int pos = cnd ? base + mbcnt64(m) : SEL_CAP + lane;
          ckl[pos] = v[r]; cil[pos] = (unsigned)(r * 64 + lane); base += __builtin_popcountll(m);
          if ((r & 3) == 3) __builtin_amdgcn_sched_barrier(0); } }
    if (C <= 512) {
        unsigned ck[8], ci[8];
#pragma unroll
        for (int j = 0; j < 8; ++j) { const int i = j * 64 + lane; ck[j] = i < C ? ckl[i] : 0u; ci[j] = cil[i]; }
        const unsigned T = (C == NSEL) ? floorkey - 1u : bisect_thr<8>(ck, floorkey, 21);
        compact_sel<8, true>(ck, ci, T, list, lane);
    } else {
        unsigned ck[16], ci[16];
#pragma unroll
        for (int j = 0; j < 16; ++j) { const int i = j * 64 + lane; ck[j] = i < C ? ckl[i] : 0u; ci[j] = cil[i]; }
        const unsigned T = bisect_thr<16>(ck, floorkey, 21);
        compact_sel<16, true>(ck, ci, T, list, lane);
    }
}

typedef short v4i16 __attribute__((ext_vector_type(4)));
constexpr int VROW = 144;

__device__ __forceinline__ void attn_tile(const Params& P, LAS unsigned char* lds, int b, int t0, int wave, int lane) {
    unsigned char* ws = P.ws;
    const bf16_t* QI = (const bf16_t*)(ws + WS_QI); const bf16_t* KI = (const bf16_t*)(ws + WS_KI);
    const bf16_t* Q = (const bf16_t*)(ws + WS_Q); const bf16_t* Kp = (const bf16_t*)(ws + WS_K); const bf16_t* Vp = (const bf16_t*)(ws + WS_V);
    const float* WI = (const float*)(ws + WS_WI); bf16_t* MIX = (bf16_t*)(ws + WS_MIX);
    LAS float* SC = (LAS float*)lds;
    LAS unsigned* list = (LAS unsigned*)(lds + wave * 16384 + 14336);
    LAS unsigned* HIST = (LAS unsigned*)(lds + LDS_MISC);
    const int tokbase = b * SEQ;
    const bool need_sel = t0 >= 256;
    if (need_sel) {
        const int nkt = (t0 + 8 + 31) >> 5;
        bf16x8 a[4]; f32x4 w[4];
        { const bf16_t* src = QI + (size_t)(tokbase + t0 + ((lane & 31) >> 2)) * 256 + (lane & 3) * 64 + 8 * (lane >> 5);
#pragma unroll
          for (int ks = 0; ks < 4; ++ks) a[ks] = *(const bf16x8*)(src + 16 * ks); }
#pragma unroll
        for (int g = 0; g < 4; ++g) w[g] = *(const f32x4*)(WI + (size_t)(tokbase + t0 + 2 * g + (lane >> 5)) * 4);
        for (int kt0 = wave; kt0 < nkt; kt0 += 4 * NWAVES) {
            bf16x8 bf[4][4];
#pragma unroll
            for (int u = 0; u < 4; ++u) { const int kt = kt0 + u * NWAVES;
                if (kt < nkt) { const bf16_t* ksrc = KI + (size_t)(tokbase + kt * 32 + (lane & 31)) * 64 + 8 * (lane >> 5);
#pragma unroll
                    for (int ks = 0; ks < 4; ++ks) bf[u][ks] = *(const bf16x8*)(ksrc + 16 * ks); } }
#pragma unroll
            for (int u = 0; u < 4; ++u) { const int kt = kt0 + u * NWAVES;
                if (kt < nkt) {
                    const int key = kt * 32 + (lane & 31);
                    f32x16 acc;
#pragma unroll
                    for (int i = 0; i < 16; ++i) acc[i] = 0.f;
#pragma unroll
                    for (int ks = 0; ks < 4; ++ks) acc = __builtin_amdgcn_mfma_f32_32x32x16_bf16(a[ks], bf[u][ks], acc, 0, 0, 0);
#pragma unroll
                    for (int g = 0; g < 4; ++g) { float sc = 0.f;
#pragma unroll
                        for (int h = 0; h < 4; ++h) sc = fmaf(fmaxf(acc[4 * g + h], 0.f), w[g][h], sc);
                        const int ql = 2 * g + (lane >> 5);
                        if (key > t0 + ql) sc = -INFINITY;
                        SC[ql * 4096 + key] = sc;
                        if (key <= t0 + ql) { const unsigned ub = __builtin_bit_cast(unsigned, sc);
                            const unsigned bin = (ub >> 22) ^ (((unsigned)((int)ub >> 31) & 0x1ffu) | 0x200u);
                            __hip_atomic_fetch_add(HIST + ql * 512 + (bin >> 1), 1u << ((bin & 1u) << 4), __ATOMIC_RELAXED, __HIP_MEMORY_SCOPE_WORKGROUP); } }
                } }
        }
        { const int npad = ((t0 + 8 + 1023) >> 10) << 10;
          for (int i = nkt * 32 + (int)threadIdx.x; i < npad; i += NTHR) {
#pragma unroll
              for (int q = 0; q < 8; ++q) SC[q * 4096 + i] = -INFINITY; } }
    }
    __syncthreads();
    const int t = t0 + wave, tok = tokbase + t;
    if (need_sel) {
        LAS float* row = SC + wave * 4096; LAS unsigned* H = HIST + wave * 512; const int n = t + 1;
        if (n <= 1024) select_topk<16>(row, H, list, lane, true);
        else if (n <= 2048) select_topk<32>(row, H, list, lane, true);
        else if (n <= 3072) select_topk<48>(row, H, list, lane, true);
        else select_topk<64>(row, H, list, lane, true);
    } else {
#pragma unroll
        for (int i = 0; i < 4; ++i) list[i * 64 + lane] = (unsigned)(i * 64 + lane);
    }
    const int nvalid = need_sel ? NSEL : (t + 1);
    const int ngrp = (nvalid + 31) >> 5;
    const int hd = lane & 15, g = lane >> 4;
    bf16x8 qf0, qf1;
#pragma unroll
    for (int i = 0; i < 8; ++i) { qf0[i] = 0; qf1[i] = 0; }
    if (hd < 8) { const bf16_t* qs = Q + (size_t)tok * 512 + hd * 64 + 8 * g; qf0 = *(const bf16x8*)qs; qf1 = *(const bf16x8*)(qs + 32); }
    float m = -INFINITY, ssum = 0.f;
    f32x4 o[4];
#pragma unroll
    for (int dt = 0; dt < 4; ++dt) o[dt] = (f32x4){0.f, 0.f, 0.f, 0.f};
    LAS unsigned char* vreg = lds + wave * 16384;
    bf16x8 kf[4]; u32x4 vv[4];
    { const unsigned ia = list[hd], ib = list[16 + hd];
      const bf16_t* ka = Kp + (size_t)(tokbase + ia) * 64 + 8 * g; const bf16_t* kb = Kp + (size_t)(tokbase + ib) * 64 + 8 * g;
      kf[0] = *(const bf16x8*)ka; kf[1] = *(const bf16x8*)(ka + 32); kf[2] = *(const bf16x8*)kb; kf[3] = *(const bf16x8*)(kb + 32);
#pragma unroll
      for (int i = 0; i < 4; ++i) { const unsigned idx = list[(lane >> 3) + 8 * i]; vv[i] = *(const u32x4*)(Vp + (size_t)(tokbase + idx) * 64 + 8 * (lane & 7)); } }
#pragma unroll 1
    for (int grp = 0; grp < ngrp; ++grp) {
        LAS unsigned char* vbuf = vreg + (grp & 1) * 8192;
#pragma unroll
        for (int i = 0; i < 4; ++i) *(LAS u32x4*)(vbuf + ((lane >> 3) + 8 * i) * VROW + (lane & 7) * 16) = vv[i];
        f32x4 sa = {0.f, 0.f, 0.f, 0.f}, sb = {0.f, 0.f, 0.f, 0.f};
        sa = __builtin_amdgcn_mfma_f32_16x16x32_bf16(kf[0], qf0, sa, 0, 0, 0); sa = __builtin_amdgcn_mfma_f32_16x16x32_bf16(kf[1], qf1, sa, 0, 0, 0);
        sb = __builtin_amdgcn_mfma_f32_16x16x32_bf16(kf[2], qf0, sb, 0, 0, 0); sb = __builtin_amdgcn_mfma_f32_16x16x32_bf16(kf[3], qf1, sb, 0, 0, 0);
        if (grp + 1 < ngrp) {
            const int nb = (grp + 1) * 32; const unsigned ia = list[nb + hd], ib = list[nb + 16 + hd];
            const bf16_t* ka = Kp + (size_t)(tokbase + ia) * 64 + 8 * g; const bf16_t* kb = Kp + (size_t)(tokbase + ib) * 64 + 8 * g;
            kf[0] = *(const bf16x8*)ka; kf[1] = *(const bf16x8*)(ka + 32); kf[2] = *(const bf16x8*)kb; kf[3] = *(const bf16x8*)(kb + 32);
#pragma unroll
            for (int i = 0; i < 4; ++i) { const unsigned idx = list[nb + (lane >> 3) + 8 * i]; vv[i] = *(const u32x4*)(Vp + (size_t)(tokbase + idx) * 64 + 8 * (lane & 7)); }
        }
        float l[8]; float mloc = -INFINITY;
#pragma unroll
        for (int r = 0; r < 4; ++r) { const int sl = grp * 32 + 4 * g + r;
            l[r] = sl < nvalid ? sa[r] * 0.125f : -INFINITY; l[4 + r] = (sl + 16) < nvalid ? sb[r] * 0.125f : -INFINITY;
            mloc = fmaxf(mloc, fmaxf(l[r], l[4 + r])); }
        mloc = fmaxf(mloc, __shfl_xor(mloc, 16)); mloc = fmaxf(mloc, __shfl_xor(mloc, 32));
        const float mnew = fmaxf(m, mloc), alpha = __expf(m - mnew); m = mnew;
        float ps = 0.f;
#pragma unroll
        for (int r = 0; r < 8; ++r) { l[r] = __expf(l[r] - mnew); ps += l[r]; }
        ssum = ssum * alpha + ps;
        bf16x8 pf;
        { const u32x4 pw = {cvt_pk_bf16(l[0], l[1]), cvt_pk_bf16(l[2], l[3]), cvt_pk_bf16(l[4], l[5]), cvt_pk_bf16(l[6], l[7])}; pf = __builtin_bit_cast(bf16x8, pw); }
        LAS unsigned char* ta = vbuf + (4 * g + (hd >> 2)) * VROW + (hd & 3) * 8;
#pragma unroll
        for (int dt = 0; dt < 4; ++dt) {
            const v4i16 lo = __builtin_amdgcn_ds_read_tr16_b64_v4i16((LAS v4i16*)(ta + dt * 32));
            const v4i16 hi = __builtin_amdgcn_ds_read_tr16_b64_v4i16((LAS v4i16*)(ta + 16 * VROW + dt * 32));
            bf16x8 vf; vf[0] = lo[0]; vf[1] = lo[1]; vf[2] = lo[2]; vf[3] = lo[3]; vf[4] = hi[0]; vf[5] = hi[1]; vf[6] = hi[2]; vf[7] = hi[3];
            o[dt] = __builtin_amdgcn_mfma_f32_16x16x32_bf16(vf, pf, o[dt] * alpha, 0, 0, 0);
        }
    }
    ssum += __shfl_xor(ssum, 16); ssum += __shfl_xor(ssum, 32);
    const float inv = 1.0f / ssum;
    if (hd < 8) {
        bf16_t* op = MIX + (size_t)tok * 1024 + hd * 64 + 4 * g;
#pragma unroll
        for (int dt = 0; dt < 4; ++dt) { u32x2 w; w.x = cvt_pk_bf16(o[dt][0] * inv, o[dt][1] * inv); w.y = cvt_pk_bf16(o[dt][2] * inv, o[dt][3] * inv); *(u32x2*)(op + 16 * dt) = w; }
    }
    __syncthreads();
}

__device__ __forceinline__ void conv_tile(const Params& P, LAS unsigned char* lds, int tile, int tid, int wave, int lane) {
    unsigned char* ws = P.ws;
    const bf16_t* HG = (const bf16_t*)(ws + WS_HGLU); bf16_t* MIX = (bf16_t*)(ws + WS_MIX);
    LAS f32x2* part = (LAS f32x2*)(lds + LDS_MISC + 1024);
    LAS f32x2* stat = part + 256;
    const int tok0 = tile * 32, t0 = tok0 & (SEQ - 1), c = tid;
    float in[62];
#pragma unroll
    for (int r = 0; r < 62; ++r) { const int tt = t0 - 30 + r; in[r] = tt >= 0 ? __builtin_bit_cast(float, (unsigned)HG[(size_t)(tok0 - 30 + r) * 512 + c] << 16) : 0.f; }
    float out[32];
    const float bias = P.dw_b[c];
#pragma unroll
    for (int i = 0; i < 32; ++i) out[i] = bias;
#pragma unroll
    for (int j = 0; j < 31; ++j) { const float wj = P.dw_w[j * 512 + c];
#pragma unroll
        for (int i = 0; i < 32; ++i) out[i] = fmaf(in[i + j], wj, out[i]); }
#pragma unroll
    for (int i = 0; i < 32; ++i) { const float s1 = wave_sum(out[i]), s2 = wave_sum(out[i] * out[i]); if (lane == 0) part[i * 8 + wave] = (f32x2){s1, s2}; }
    __syncthreads();
    if (tid < 32) { float s1 = 0.f, s2 = 0.f;
#pragma unroll
        for (int w = 0; w < 8; ++w) { const f32x2 pp = part[tid * 8 + w]; s1 += pp.x; s2 += pp.y; }
        const float mean = s1 * (1.0f / 512.0f), var = fmaxf(s2 * (1.0f / 512.0f) - mean * mean, 0.f);
        stat[tid] = (f32x2){mean, 1.0f / sqrtf(var + EPS)}; }
    __syncthreads();
    const float lgc = P.ln_g[c], lbc = P.ln_b[c];
#pragma unroll
    for (int i = 0; i < 32; ++i) { const f32x2 st = stat[i]; const float y = (out[i] - st.x) * st.y * lgc + lbc; const float sl = y * sigmoidf_(y);
        MIX[(size_t)(tok0 + i) * 1024 + 512 + c] = (bf16_t)f2bf(sl); }
    __syncthreads();
}

__device__ __forceinline__ void router_phase(const Params& P, LAS unsigned char* lds, int blk, int G, int tid, int wave, int lane) {
    unsigned char* ws = P.ws;
    const float* h1 = (const float*)(ws + WS_H1); const float* wrg = (const float*)(ws + WS_WRG);
    int* list = (int*)(ws + WS_LIST); float* lscale = (float*)(ws + WS_LSCALE); float* lgate = (float*)(ws + WS_LGATE);
    unsigned* cntg = (unsigned*)(ws + WS_CTL) + CW_CNT;
    LAS float* WL = (LAS float*)lds;
    LAS int* lcnt = (LAS int*)(lds + LDS_MISC + 1024);
    LAS int* gbase = lcnt + 32;
    LAS int* rec_e = gbase + 32;
    LAS int* rec_p = rec_e + 512;
    LAS float* rec_g = (LAS float*)(rec_p + 512);
    LAS float* rec_s = rec_g + 512;
    for (int i = tid; i < 8192; i += NTHR) ((LAS f32x4*)WL)[i] = ((const f32x4*)wrg)[i];
    __syncthreads();
    const int tl = lane & 31, half = lane >> 5;
    for (int chunk = blk; chunk < NTOK / 128; chunk += G) {
        if (tid < 32) lcnt[tid] = 0;
        __syncthreads();
        if (wave < 4) {
            const int tloc = wave * 32 + tl, tok = chunk * 128 + tloc;
            const float* hrow = h1 + (size_t)tok * DM + 4 * half;
            f32x16 acc;
#pragma unroll
            for (int i = 0; i < 16; ++i) acc[i] = 0.f;
            float ss = 0.f;
#pragma unroll 1
            for (int k0 = 0; k0 < DM; k0 += 32) {
                f32x4 hv[4];
#pragma unroll
                for (int i = 0; i < 4; ++i) hv[i] = *(const f32x4*)(hrow + k0 + 8 * i);
#pragma unroll
                for (int i = 0; i < 4; ++i) {
                    ss = fmaf(hv[i].x, hv[i].x, fmaf(hv[i].y, hv[i].y, fmaf(hv[i].z, hv[i].z, fmaf(hv[i].w, hv[i].w, ss))));
#pragma unroll
                    for (int j = 0; j < 4; ++j) { const float wv = WL[(k0 + 8 * i + 4 * half + j) * 32 + tl];
                        acc = __builtin_amdgcn_mfma_f32_32x32x2f32(wv, hv[i][j], acc, 0, 0, 0); }
                }
            }
            ss += __shfl_xor(ss, 32);
            const float rs = 1.0f / sqrtf(ss * (1.0f / DM) + EPS);
            float v[16];
#pragma unroll
            for (int r = 0; r < 16; ++r) v[r] = acc[r] * rs + P.b_router[(r & 3) + 8 * (r >> 2) + 4 * half];
            float tv[4]; int te[4];
#pragma unroll
            for (int q = 0; q < 4; ++q) { float bv = -INFINITY; int be = 64;
#pragma unroll
                for (int r = 0; r < 16; ++r) { const int e = (r & 3) + 8 * (r >> 2) + 4 * half; if (v[r] > bv || (v[r] == bv && e < be)) { bv = v[r]; be = e; } }
#pragma unroll
                for (int r = 0; r < 16; ++r) { const int e = (r & 3) + 8 * (r >> 2) + 4 * half; if (e == be) v[r] = -INFINITY; }
                tv[q] = bv; te[q] = be; }
            float cv[8]; int ce[8];
#pragma unroll
            for (int q = 0; q < 4; ++q) { cv[q] = tv[q]; ce[q] = te[q]; cv[4 + q] = __shfl_xor(tv[q], 32); ce[4 + q] = __shfl_xor(te[q], 32); }
#pragma unroll
            for (int q = 0; q < 4; ++q) { float bv = -INFINITY; int be = 64;
#pragma unroll
                for (int r = 0; r < 8; ++r) if (cv[r] > bv || (cv[r] == bv && ce[r] < be)) { bv = cv[r]; be = ce[r]; }
#pragma unroll
                for (int r = 0; r < 8; ++r) if (ce[r] == be) cv[r] = -INFINITY;
                tv[q] = bv; te[q] = be; }
            const float e1 = __expf(tv[1] - tv[0]), e2 = __expf(tv[2] - tv[0]), e3 = __expf(tv[3] - tv[0]);
            const float is = 1.0f / (1.0f + e1 + e2 + e3);
            if (half == 0) {
                const float gq[4] = {is, e1 * is, e2 * is, e3 * is};
#pragma unroll
                for (int q = 0; q < 4; ++q) { const int lp = atomicAdd((int*)&lcnt[te[q]], 1); const int si = tloc * 4 + q; rec_e[si] = te[q]; rec_p[si] = lp; rec_g[si] = gq[q]; }
                rec_s[tloc] = rs;
            }
        }
        __syncthreads();
        if (tid < 32) gbase[tid] = (int)atomicAdd(cntg + 64 * tid, (unsigned)lcnt[tid]);
        __syncthreads();
        { const int si = tid, ee = rec_e[si], pos = gbase[ee] + rec_p[si], li = ee * NTOK + pos;
          list[li] = (chunk * 128) * 4 + si; lscale[li] = rec_s[si >> 2]; lgate[li] = rec_g[si]; }
        __syncthreads();
    }
}

__device__ __forceinline__ void combine_phase(const Params& P, int gw, int NGW, int lane) {
    unsigned char* ws = P.ws;
    float* h1 = (float*)(ws + WS_H1); bf16_t* h1b = (bf16_t*)(ws + WS_H1B); const bf16_t* y = (const bf16_t*)(ws + WS_Y); float* rs3 = (float*)(ws + WS_RS3);
    for (int m = gw; m < NTOK; m += NGW) {
        f32x4* hr = (f32x4*)(h1 + (size_t)m * DM) + lane; f32x4 v[4]; float s = 0.f;
#pragma unroll
        for (int j = 0; j < 4; ++j) v[j] = hr[64 * j];
#pragma unroll
        for (int k = 0; k < 4; ++k) { const u32x2* yr = (const u32x2*)(y + (size_t)(m * 4 + k) * DM) + lane;
#pragma unroll
            for (int j = 0; j < 4; ++j) { const u32x2 w = yr[64 * j]; v[j].x += bf_lo(w.x); v[j].y += bf_hi(w.x); v[j].z += bf_lo(w.y); v[j].w += bf_hi(w.y); } }
        u32x2* o8 = (u32x2*)(h1b + (size_t)m * DM) + lane;
#pragma unroll
        for (int j = 0; j < 4; ++j) { hr[64 * j] = v[j]; u32x2 w; w.x = pk2(v[j].x, v[j].y); w.y = pk2(v[j].z, v[j].w); o8[64 * j] = w;
            s += (v[j].x * v[j].x + v[j].y * v[j].y) + (v[j].z * v[j].z + v[j].w * v[j].w); }
        s = wave_sum(s);
        if (lane == 0) rs3[m] = 1.0f / sqrtf(s * (1.0f / DM) + EPS);
    }
}

__device__ __forceinline__ void final_phase(const Params& P, int gw, int NGW, int lane) {
    f32x4 gv[4];
#pragma unroll
    for (int j = 0; j < 4; ++j) gv[j] = *((const f32x4*)P.g_final + lane + 64 * j);
    for (int m = gw; m < NTOK; m += NGW) {
        f32x4* orow = (f32x4*)(P.out + (size_t)m * DM) + lane; f32x4 v[4]; float s = 0.f;
#pragma unroll
        for (int j = 0; j < 4; ++j) { v[j] = orow[64 * j]; s += (v[j].x * v[j].x + v[j].y * v[j].y) + (v[j].z * v[j].z + v[j].w * v[j].w); }
        s = wave_sum(s); const float rs = 1.0f / sqrtf(s * (1.0f / DM) + EPS);
#pragma unroll
        for (int j = 0; j < 4; ++j) orow[64 * j] = v[j] * rs * gv[j];
    }
}

#define XB_TMO      128
#define XB_XCNT(j)  (256  + 64 * (j))
#define XB_XSUB(j)  (1280 + 64 * (j))
#define XB_XGEN(j)  (2304 + 64 * (j))
#define XB_TOP      3328
#define XB_TOPGEN   3392
#define XCD_BAR_WORDS 3456
#define XB_SPIN_CAP (1u << 18)
__device__ __forceinline__ unsigned xb_ld(unsigned* p)              { return __hip_atomic_load(p, __ATOMIC_RELAXED, __HIP_MEMORY_SCOPE_AGENT); }
__device__ __forceinline__ unsigned xb_add(unsigned* p, unsigned v) { return __hip_atomic_fetch_add(p, v, __ATOMIC_RELAXED, __HIP_MEMORY_SCOPE_AGENT); }
__device__ __forceinline__ unsigned xb_xcc_id() { return (unsigned)__builtin_amdgcn_s_getreg((3 << 11) | 20) & 0xFu; }
#define XB_SPIN(cond, bar) do { unsigned _sp = 0; while (cond) { __builtin_amdgcn_s_sleep(1); \
    if ((++_sp & 255u) == 0u) { if (xb_ld(&(bar)[XB_TMO])) break; if (_sp > XB_SPIN_CAP) { atomicAdd(&(bar)[XB_TMO], 1u); break; } } } } while (0)
struct XcdBarrier { unsigned* bar; unsigned x; volatile LAS unsigned* st; };
__device__ __forceinline__ XcdBarrier xcd_barrier_post(unsigned* bar, volatile LAS unsigned* st) {
    XcdBarrier b; b.bar = bar; b.x = xb_xcc_id(); b.st = st;
    if (threadIdx.x == 0) (void)xb_add(&bar[XB_XCNT(b.x)], 1u);
    return b;
}
__device__ __forceinline__ void xcd_barrier_complete(unsigned* bar, unsigned x, unsigned& nloc, unsigned& nx) {
    const unsigned G = gridDim.x * gridDim.y * gridDim.z;
    unsigned sum, cnt, mine, sp = 0u;
    for (;;) {
        sum = 0u; cnt = 0u; mine = 0u;
#pragma unroll
        for (unsigned j = 0; j < 16; ++j) { const unsigned c = xb_ld(&bar[XB_XCNT(j)]); sum += c; cnt += (c > 0u) ? 1u : 0u; mine = (j == x) ? c : mine; }
        if (sum == G) break;
        __builtin_amdgcn_s_sleep(1);
        if ((++sp & 255u) == 0u) { if (xb_ld(&bar[XB_TMO])) break; if (sp > XB_SPIN_CAP) { atomicAdd(&bar[XB_TMO], 1u); break; } }
    }
    nloc = mine > 0u ? mine : 1u; nx = cnt > 0u ? cnt : 1u;
}
__device__ __forceinline__ void xcd_barrier(const XcdBarrier& b) {
    asm volatile("s_waitcnt vmcnt(0)" ::: "memory");
    __syncthreads();
    if (threadIdx.x == 0) {
        unsigned* bar = b.bar;
        __builtin_amdgcn_s_waitcnt(0);
        unsigned nloc = b.st[0], nx = b.st[1];
        if (nloc == 0u) { xcd_barrier_complete(bar, b.x, nloc, nx); b.st[0] = nloc; b.st[1] = nx; }
        const unsigned old = xb_add(&bar[XB_XSUB(b.x)], 1u);
        const unsigned gen = old / nloc;
        if (old + 1u == (gen + 1u) * nloc) {
            __builtin_amdgcn_fence(__ATOMIC_RELEASE, "agent");
            asm volatile("s_waitcnt vmcnt(0)" ::: "memory");
            const unsigned og = xb_add(&bar[XB_TOP], 1u);
            const unsigned tg = og / nx;
            if (og + 1u == (tg + 1u) * nx) xb_add(&bar[XB_TOPGEN], 1u);
            else XB_SPIN(xb_ld(&bar[XB_TOPGEN]) == tg, bar);
            __builtin_amdgcn_fence(__ATOMIC_ACQUIRE, "agent");
            xb_add(&bar[XB_XGEN(b.x)], 1u);
            asm volatile("s_waitcnt vmcnt(0)" ::: "memory");
        } else {
            XB_SPIN(xb_ld(&bar[XB_XGEN(b.x)]) == gen, bar);
            __builtin_amdgcn_fence(__ATOMIC_ACQUIRE, "agent");
            asm volatile("s_waitcnt vmcnt(0)" ::: "memory");
        }
    }
    __syncthreads();
}

constexpr int NPHASE = 10;
__global__ void __launch_bounds__(NTHR, 2) fwd_kernel(Params P) {
    extern __shared__ __attribute__((aligned(16))) unsigned char lds_raw[];
    LAS unsigned char* lds = (LAS unsigned char*)lds_raw;
    cg::grid_group grid = cg::this_grid();
    const int tid = threadIdx.x, lane = tid & 63, wave = __builtin_amdgcn_readfirstlane(tid >> 6);
    const int G = gridDim.x, bx = blockIdx.x;
    const int vcu = (G % 8 == 0) ? (bx % 8) * (G / 8) + bx / 8 : bx;
    const int gw = vcu * NWAVES + wave, NGW = G * NWAVES;
    unsigned char* ws = P.ws;
    const int lo = P.ph_lo, hi = P.ph_hi;
#ifndef PH_MASK
#define PH_MASK 0x3ff
#endif
#define IN(k) ((((PH_MASK) >> (k)) & 1) && lo <= (k) && (k) < hi)
    volatile LAS unsigned* xst = (volatile LAS unsigned*)(lds + LDS_XB);
    if (tid < 2) xst[tid] = 0u;
    __syncthreads();
    const XcdBarrier xbar = xcd_barrier_post((unsigned*)(ws + WS_CTL) + CW_BAR, xst);
#define SYNC(k) do { if (IN(k) && IN((k) + 1)) { if ((k) == 0) grid.sync(); else xcd_barrier(xbar); } } while (0)

    if (IN(0)) p0_prologue(P, lds, vcu, G, wave, lane);
    SYNC(0);
    if (IN(1)) {
        { pg8::DenseSched S; S.init((const bf16_t*)(ws + WS_XB), (const bf16_t*)(ws + WS_WIN), NTOK, 2048, 1024, G, bx);
          EpiInProj E{(const float*)(ws + WS_RS1), (const f32x2*)(ws + WS_ROPE), P.glu_b, (bf16_t*)(ws + WS_Q), (bf16_t*)(ws + WS_K), (bf16_t*)(ws + WS_V), (bf16_t*)(ws + WS_QI), (bf16_t*)(ws + WS_KI), (bf16_t*)(ws + WS_HGLU), (float*)(ws + WS_WI)};
          pg8::gemm_phase<EpiInProj, pg8::DenseSched, false>(lds, S, E); }
        { pg8::DenseSched S; S.init((const bf16_t*)(ws + WS_PB), (const bf16_t*)(ws + WS_WP), NTOK, 1024, 256, G, bx);
          EpiBf16Plain E{(bf16_t*)(ws + WS_PJ), 1024};
          pg8::gemm_phase<EpiBf16Plain, pg8::DenseSched, false>(lds, S, E); }
    }
    SYNC(1);
    if (IN(2)) {
        for (int i = tid; i < 4096; i += NTHR) ((LAS unsigned*)(lds + LDS_MISC))[i] = 0u;
        __syncthreads();
        if (G % 8 == 0) { const int b = bx % 8, jb = bx / 8, nbb = G / 8;
            for (int i = 0;; ++i) { const int k = i * nbb + ((i & 1) ? nbb - 1 - jb : jb); if (k >= 512) break; attn_tile(P, lds, b, (511 - k) * 8, wave, lane); } }
        else { for (int tl = bx; tl < 4096; tl += G) attn_tile(P, lds, tl & 7, (511 - (tl >> 3)) * 8, wave, lane); }
        for (int rp = 0; rp <= ((P.rep >> 3) & 1); ++rp)
        for (int tl = vcu; tl < NTOK / 32; tl += G) conv_tile(P, lds, tl, tid, wave, lane);
    }
    SYNC(2);
    if (IN(3)) {
        pg8::DenseSched S; S.init((const bf16_t*)(ws + WS_MIX), (const bf16_t*)(ws + WS_WOUT), NTOK, 1024, 1024, G, bx);
        EpiOutProj E{P.x, (float*)(ws + WS_H1), (bf16_t*)(ws + WS_H1B)};
        pg8::gemm_phase<EpiOutProj, pg8::DenseSched, false>(lds, S, E);
    }
    SYNC(3);
    if (IN(4)) router_phase(P, lds, vcu, G, tid, wave, lane);
    SYNC(4);
    if (IN(5) || IN(6)) {
        LAS int* tb = (LAS int*)(lds + LDS_MISC); LAS int* cn = tb + 64;
        if (tid == 0) { const unsigned* cntg = (const unsigned*)(ws + WS_CTL) + CW_CNT; int acc = 0;
            for (int e = 0; e < NE; ++e) { const int c = (int)__hip_atomic_load(cntg + 64 * e, __ATOMIC_RELAXED, __HIP_MEMORY_SCOPE_AGENT); tb[e] = acc; cn[e] = c; acc += (c + BM - 1) / BM; }
            tb[NE] = acc; }
        __syncthreads();
        if (IN(5)) {
            pg8::MoeSched S; S.A = (const bf16_t*)(ws + WS_H1B); S.Bt = (const bf16_t*)(ws + WS_WUP); S.K = 1024; S.b_estride = (size_t)2048 * 1024 * 2; S.tb = tb; S.cnt = cn; S.list = (const int*)(ws + WS_LIST);
            S.nN = 8; S.nwg = tb[NE] * 8; S.G = G; S.c = bx; S.gather = true;
            EpiUp E{(const float*)(ws + WS_LSCALE), P.b_up, (bf16_t*)(ws + WS_ACT), tb};
            pg8::gemm_phase<EpiUp, pg8::MoeSched, true>(lds, S, E);
        }
        SYNC(5);
        if (IN(6)) {
            pg8::MoeSched S; S.A = (const bf16_t*)(ws + WS_ACT); S.Bt = (const bf16_t*)(ws + WS_WDOWN); S.K = 1024; S.b_estride = (size_t)1024 * 1024 * 2; S.tb = tb; S.cnt = cn; S.list = (const int*)(ws + WS_LIST);
            S.nN = 4; S.nwg = tb[NE] * 4; S.G = G; S.c = bx; S.gather = false;
            EpiDown E{(const int*)(ws + WS_LIST), (const float*)(ws + WS_LGATE), P.b_down, (bf16_t*)(ws + WS_Y), tb};
            pg8::gemm_phase<EpiDown, pg8::MoeSched, false>(lds, S, E);
        }
    }
    SYNC(6);
    if (IN(7)) combine_phase(P, gw, NGW, lane);
    SYNC(7);
    if (IN(8)) {
        pg8::DenseSched S; S.init((const bf16_t*)(ws + WS_H1B), (const bf16_t*)(ws + WS_WG), NTOK, 1024, 1024, G, bx);
        EpiPle E{(const float*)(ws + WS_H1), (const bf16_t*)(ws + WS_PJ), (const float*)(ws + WS_RS3), P.out};
        pg8::gemm_phase<EpiPle, pg8::DenseSched, false>(lds, S, E);
    }
    SYNC(8);
    if (IN(9)) final_phase(P, gw, NGW, lane);
#undef IN
#undef SYNC
}

#ifndef N_LAUNCH_MODE
#define N_LAUNCH_MODE 1
#endif
extern "C" void kernel_launch(void* const* d_in, const int* in_sizes, int n_in, void* d_out, int out_size, void* d_ws, size_t ws_size, hipStream_t stream) {
    static int grid = 0;
    if (grid == 0) {
        if (n_in != 21 || out_size != NTOK * DM || ws_size < WS_END) { fprintf(stderr, "kernel_launch: unexpected shapes (n_in %d out %d ws %zu)\n", n_in, out_size, ws_size); grid = -1; return; }
        int dev = 0, cus = 0, per_cu = 0;
        (void)hipGetDevice(&dev); (void)hipDeviceGetAttribute(&cus, hipDeviceAttributeMultiprocessorCount, dev);
        (void)hipFuncSetAttribute((const void*)fwd_kernel, hipFuncAttributeMaxDynamicSharedMemorySize, LDS_BYTES);
        if (hipOccupancyMaxActiveBlocksPerMultiprocessor(&per_cu, (const void*)fwd_kernel, NTHR, LDS_BYTES) != hipSuccess || per_cu < 1) { fprintf(stderr, "kernel_launch: occupancy query failed (%d)\n", per_cu); (void)hipGetLastError(); grid = -1; return; }
        grid = cus;
    }
    if (grid < 0) return;
    (void)hipMemsetAsync((char*)d_ws + WS_CTL, 0, CTL_BYTES, stream);
    Params p{};
    p.x = (const float*)d_in[0]; p.p = (const float*)d_in[1]; p.w_in = (const float*)d_in[2]; p.w_out = (const float*)d_in[3]; p.g_mix = (const float*)d_in[4]; p.g_ffn = (const float*)d_in[5];
    p.glu_b = (const float*)d_in[6]; p.dw_w = (const float*)d_in[7]; p.dw_b = (const float*)d_in[8]; p.ln_g = (const float*)d_in[9]; p.ln_b = (const float*)d_in[10];
    p.w_router = (const float*)d_in[11]; p.b_router = (const float*)d_in[12]; p.w_up = (const float*)d_in[13]; p.b_up = (const float*)d_in[14]; p.w_down = (const float*)d_in[15]; p.b_down = (const float*)d_in[16];
    p.w_ple_proj = (const float*)d_in[17]; p.w_ple_gate = (const float*)d_in[18]; p.g_ple = (const float*)d_in[19]; p.g_final = (const float*)d_in[20];
    p.out = (float*)d_out; p.ws = (unsigned char*)d_ws;
#ifndef PROBE_REPMASK
#define PROBE_REPMASK 0
#endif
    p.rep = PROBE_REPMASK;
#if N_LAUNCH_MODE == 1
    p.ph_lo = 0; p.ph_hi = NPHASE;
    void* args[] = {&p};
    hipError_t e = hipLaunchCooperativeKernel((const void*)fwd_kernel, dim3(grid), dim3(NTHR), args, LDS_BYTES, stream);
    if (e != hipSuccess) fprintf(stderr, "cooperative launch failed: %s (grid %d)\n", hipGetErrorString(e), grid);
#else
    for (int ph = 0; ph < NPHASE; ++ph) {
        p.ph_lo = ph; p.ph_hi = ph + 1;
        void* args[] = {&p};
        hipError_t e = hipLaunchCooperativeKernel((const void*)fwd_kernel, dim3(grid), dim3(NTHR), args, LDS_BYTES, stream);
        if (e != hipSuccess) { fprintf(stderr, "launch %d failed: %s (grid %d)\n", ph, hipGetErrorString(e), grid); break; }
    }
#endif
}
```

```cpp
#include <hip/hip_runtime.h>
#include <hip/hip_cooperative_groups.h>
#include <cstdio>
#include <cstdint>
namespace cg = cooperative_groups;

#define LAS __attribute__((address_space(3)))
#define GAS __attribute__((address_space(1)))
typedef unsigned short bf16_t;
typedef short bf16x8 __attribute__((ext_vector_type(8)));
typedef short s16x4 __attribute__((ext_vector_type(4)));
typedef float f32x4 __attribute__((ext_vector_type(4)));
typedef float f32x2 __attribute__((ext_vector_type(2)));
typedef float f32x16 __attribute__((ext_vector_type(16)));
typedef unsigned u32x4 __attribute__((ext_vector_type(4)));
typedef unsigned u32x2 __attribute__((ext_vector_type(2)));

constexpr int NB = 8, SEQ = 4096, DM = 1024, NTOK = NB * SEQ;
constexpr int NE = 32, TOPK = 4, NSLOT = NTOK * TOPK;
constexpr int INW = 1988;
constexpr int NSEL = 256;
constexpr float EPS = 1e-6f;
constexpr int NWAVES = 8, NTHR = 512;

constexpr size_t MiB = 1u << 20;
constexpr size_t WS_CTL = 0, CTL_BYTES = 64 * 1024;
constexpr size_t WS_ROPE = 1 * MiB;
constexpr size_t WS_WIN = 2 * MiB;
constexpr size_t WS_WOUT = 6 * MiB;
constexpr size_t WS_WG = 8 * MiB;
constexpr size_t WS_WP = 10 * MiB;
constexpr size_t WS_WRG = 10 * MiB + 512 * 1024;
constexpr size_t WS_RS1 = 11 * MiB;
constexpr size_t WS_RS3 = 11 * MiB + 512 * 1024;
constexpr size_t WS_WI = 12 * MiB;
constexpr size_t WS_LIST = 13 * MiB;
constexpr size_t WS_LSCALE = 17 * MiB;
constexpr size_t WS_LGATE = 21 * MiB;
constexpr size_t WS_PB = 25 * MiB;
constexpr size_t WS_WUP = 42 * MiB;
constexpr size_t WS_WDOWN = 170 * MiB;
constexpr size_t WS_H1 = 234 * MiB;
constexpr size_t WS_H1B = 362 * MiB;
constexpr size_t WS_PJ = 426 * MiB;
constexpr size_t WS_XB = 490 * MiB;
constexpr size_t WS_Q = 554 * MiB;
constexpr size_t WS_K = 586 * MiB;
constexpr size_t WS_V = 590 * MiB;
constexpr size_t WS_QI = 594 * MiB;
constexpr size_t WS_KI = 610 * MiB;
constexpr size_t WS_HGLU = 614 * MiB;
constexpr size_t WS_MIX = 646 * MiB;
constexpr size_t WS_H1F8 = 490 * MiB;
constexpr size_t WS_ACT = 522 * MiB;
constexpr size_t WS_Y = 762 * MiB;
constexpr size_t WS_END = 1018 * MiB;
static_assert(WS_H1F8 + (size_t)NTOK * 1024 <= WS_ACT && WS_ACT + (size_t)139264 * 1024 <= WS_Y, "ws map");
constexpr int CW_CNT = 1024;
constexpr int CW_BAR = 8192;

constexpr int LDS_STAGE = 131072;
constexpr int LDS_MISC = LDS_STAGE;
constexpr int LDS_XB = 147456;
constexpr int LDS_BYTES = 147456 + 256;

__device__ __forceinline__ unsigned f2bf(float f) { unsigned u = __builtin_bit_cast(unsigned, f); return (u + 0x7fffu + ((u >> 16) & 1u)) >> 16; }
__device__ __forceinline__ unsigned pk2(float lo, float hi) { return f2bf(lo) | (f2bf(hi) << 16); }
__device__ __forceinline__ float bf_lo(unsigned w) { return __builtin_bit_cast(float, w << 16); }
__device__ __forceinline__ float bf_hi(unsigned w) { return __builtin_bit_cast(float, w & 0xffff0000u); }
__device__ __forceinline__ float wave_sum(float v) {
#pragma unroll
    for (int o = 1; o < 64; o <<= 1) v += __shfl_xor(v, o);
    return v;
}
__device__ __forceinline__ unsigned pk4_fp8(float a, float b, float c, float d) { int r = __builtin_amdgcn_cvt_pk_fp8_f32(a, b, 0, false); r = __builtin_amdgcn_cvt_pk_fp8_f32(c, d, r, true); return (unsigned)r; }
__device__ __forceinline__ float sigmoidf_(float x) { return 1.0f / (1.0f + __expf(-x)); }
#define LDS_WAIT() asm volatile("s_waitcnt lgkmcnt(0)" ::: "memory")

struct Params {
    const float* x; const float* p; const float* w_in; const float* w_out; const float* g_mix; const float* g_ffn;
    const float* glu_b; const float* dw_w; const float* dw_b; const float* ln_g; const float* ln_b;
    const float* w_router; const float* b_router; const float* w_up; const float* b_up; const float* w_down; const float* b_down;
    const float* w_ple_proj; const float* w_ple_gate; const float* g_ple; const float* g_final;
    float* out; unsigned char* ws;
    int ph_lo, ph_hi, rep, pad;
};

namespace pg8 {
constexpr int BM = 256, BK = 64, HALF = 128, HTB = HALF * BK * 2, STAGE_BYTES = 8 * HTB, NXCD = 8, WGM = 8;
__host__ __device__ __forceinline__ int lds_byte(int r, int c) { const int st = (r >> 4) * 2 + (c >> 5), rr = r & 15, cc = c & 31, ob = rr * 64 + cc * 2; return st * 1024 + (ob ^ (((ob >> 9) & 1) << 5)); }
__host__ __device__ __forceinline__ void stage_rc(int b, int& R, int& C) { const int st = b / 1024, sb = b % 1024, swz = sb ^ (((sb >> 9) & 1) << 5); R = (st >> 1) * 16 + swz / 64; C = (st & 1) * 32 + (swz % 64) / 2; }
__host__ __device__ __forceinline__ int perm32(int rho) { const int n = rho >> 4, i = rho & 15; return 8 * (i >> 2) + 4 * n + (i & 3); }

struct Unit { int pm, pn, e, rows; };

__device__ __forceinline__ unsigned cvt_pk_bf16(float lo, float hi) { unsigned r; asm volatile("v_cvt_pk_bf16_f32 %0, %1, %2" : "=v"(r) : "v"(lo), "v"(hi)); return r; }

struct DenseSched {
    const void* A; const void* Bt; int rp;
    int nM, nN, nwg, G, c;
    __device__ void init(const void* A_, const void* Bt_, int M, int N, int K_, int G_, int c_) { A = A_; Bt = Bt_; rp = K_ * 2; nM = M / BM; nN = N / BM; nwg = nM * nN; G = G_; c = c_; }
    __device__ bool next(int i, Unit& u) const {
        const long L = (long)i * G + c; if (L >= nwg) return false;
        int wgid = (int)L; { const int q = nwg / NXCD, r = nwg % NXCD, xcd = wgid % NXCD, off = wgid / NXCD; wgid = (xcd < r ? xcd * (q + 1) : r * (q + 1) + (xcd - r) * q) + off; }
        const int nig = WGM * nN, gid = wgid / nig, fm = gid * WGM, gsz = (nM - fm) < WGM ? (nM - fm) : WGM;
        u.pm = fm + ((wgid % nig) % gsz); u.pn = (wgid % nig) / gsz; u.e = 0; u.rows = BM; return true;
    }
    __device__ __forceinline__ const char* a_ptr(const Unit& u) const { return (const char*)A + (size_t)u.pm * BM * rp; }
    __device__ __forceinline__ const char* b_ptr(const Unit& u) const { return (const char*)Bt + (size_t)u.pn * BM * rp; }
    __device__ __forceinline__ int a_row(const Unit&, int) const { return 0; }
};

struct MoeSched {
    const void* A; const void* Bt; int rp; size_t b_estride;
    const LAS int* tb;
    const LAS int* cnt;
    const int* list;
    int nN, nwg, G, c; bool gather;
    __device__ bool next(int i, Unit& u) const {
        const long L = (long)i * G + c; if (L >= nwg) return false;
        int wgid = (int)L; { const int q = nwg / NXCD, r = nwg % NXCD, xcd = wgid % NXCD, off = wgid / NXCD; wgid = (xcd < r ? xcd * (q + 1) : r * (q + 1) + (xcd - r) * q) + off; }
        int e = 0;
#pragma unroll 1
        for (; e < NE - 1; ++e) { if (wgid < tb[e + 1] * nN) break; }
        const int local = wgid - tb[e] * nN, nM = tb[e + 1] - tb[e];
        const int nig = WGM * nN, gid = local / nig, fm = gid * WGM, gsz = (nM - fm) < WGM ? (nM - fm) : WGM;
        const int rt = fm + ((local % nig) % gsz);
        u.pm = tb[e] + rt; u.pn = (local % nig) / gsz; u.e = e;
        const int left = cnt[e] - rt * BM; u.rows = left < BM ? left : BM; return true;
    }
    __device__ __forceinline__ const char* a_ptr(const Unit& u) const { return (const char*)A; }
    __device__ __forceinline__ const char* b_ptr(const Unit& u) const { return (const char*)Bt + (size_t)u.e * b_estride + (size_t)u.pn * BM * rp; }
    __device__ __forceinline__ int a_row(const Unit& u, int r) const {
        if (!gather) return u.pm * BM + r;
        const int rt = u.pm - tb[u.e];
        return r < u.rows ? (list[u.e * NTOK + rt * BM + r] >> 2) : 0;
    }
};

typedef int v8i32 __attribute__((ext_vector_type(8)));
template <class Epi, class Sched, bool GATHER, bool F8 = false>
__device__ __forceinline__ void gemm_phase(LAS unsigned char* lds, const Sched& S, const Epi& E) {
    const int tid = threadIdx.x, wid = __builtin_amdgcn_readfirstlane(tid >> 6), lane = tid & 63, wr = wid >> 2, wc = wid & 3, fr = lane & 15, fq = lane >> 4;
    const int RP = S.rp, nt = RP / (BK * 2);
    unsigned voffA[2], voffB[2]; int RA[2], CA[2];
#pragma unroll
    for (int i = 0; i < 2; ++i) { int R, C; stage_rc(tid * 16 + i * 8192, R, C); const int Rb = Epi::PERM ? ((R & ~31) + perm32(R & 31)) : R;
        voffA[i] = (unsigned)(R * RP + C * 2); voffB[i] = (unsigned)(Rb * RP + C * 2); RA[i] = R; CA[i] = C; }
    const size_t kstep = (size_t)(BK * 2);
    const size_t hstep = (size_t)HALF * RP;
    const unsigned ldsw = (unsigned)wid * 1024u;
    const int aoff = lds_byte(wr * 64 + fr, fq * 8), boff = lds_byte(wc * 32 + fr, fq * 8);
    unsigned gC[2][2], gN[2][2];
#define PG8_SA(b, h) (((b) * 2 + (h)) * HTB)
#define PG8_SB(b, h) ((4 + (b) * 2 + (h)) * HTB)
#define PG8_STAGE(bufoff, gbase, voff) do { _Pragma("unroll") for (int _i = 0; _i < 2; ++_i) \
        __builtin_amdgcn_global_load_lds((const unsigned*)((const char*)(gbase) + (voff)[_i]), (LAS unsigned*)(lds + (bufoff) + ldsw + _i * 8192), 16, 0, 0); } while (0)
#define PG8_STAGE_A(bufoff, kp, h) do { if constexpr (GATHER) { PG8_STAGE(bufoff, kp, gC[h]); } else { PG8_STAGE(bufoff, (kp) + (h) * hstep, voffA); } } while (0)
#define PG8_LD16(p) (*(const LAS bf16x8*)(p))
#define PG8_CAT(lo, hi) __builtin_bit_cast(v8i32, __builtin_shufflevector(lo, hi, 0, 1, 2, 3, 4, 5, 6, 7, 8, 9, 10, 11, 12, 13, 14, 15))
#define PG8_LDA(dst, b, h) do { _Pragma("unroll") for (int m = 0; m < 4; ++m) { if constexpr (F8) { dst##8[m] = PG8_CAT(PG8_LD16(lds + PG8_SA(b, h) + aoff + m * 2048), PG8_LD16(lds + PG8_SA(b, h) + aoff + m * 2048 + 1024)); } \
        else { _Pragma("unroll") for (int k = 0; k < 2; ++k) dst[m][k] = PG8_LD16(lds + PG8_SA(b, h) + aoff + m * 2048 + k * 1024); } } } while (0)
#define PG8_LDB(dst, b, h) do { _Pragma("unroll") for (int n = 0; n < 2; ++n) { if constexpr (F8) { dst##8[n] = PG8_CAT(PG8_LD16(lds + PG8_SB(b, h) + boff + n * 2048), PG8_LD16(lds + PG8_SB(b, h) + boff + n * 2048 + 1024)); } \
        else { _Pragma("unroll") for (int k = 0; k < 2; ++k) dst[n][k] = PG8_LD16(lds + PG8_SB(b, h) + boff + n * 2048 + k * 1024); } } } while (0)
#define PG8_MMA(ai, bj, At, Bt) do { __builtin_amdgcn_s_setprio(1); _Pragma("unroll") for (int m = 0; m < 4; ++m) _Pragma("unroll") for (int n = 0; n < 2; ++n) { \
        if constexpr (F8) { acc[ai][bj][m][n] = __builtin_amdgcn_mfma_scale_f32_16x16x128_f8f6f4(Bt##8[n], At##8[m], acc[ai][bj][m][n], 0, 0, 0, 0x7f7f7f7f, 0, 0x7f7f7f7f); } \
        else { _Pragma("unroll") for (int k = 0; k < 2; ++k) acc[ai][bj][m][n] = __builtin_amdgcn_mfma_f32_16x16x32_bf16(Bt[n][k], At[m][k], acc[ai][bj][m][n], 0, 0, 0); } } \
        __builtin_amdgcn_s_setprio(0); } while (0)
#define PG8_WAIT_V(n) asm volatile("s_waitcnt vmcnt(" #n ")" ::: "memory")
#define PG8_WAIT_L(n) asm volatile("s_waitcnt lgkmcnt(" #n ")" ::: "memory")
#define PG8_BAR __builtin_amdgcn_s_barrier()
#define PG8_SCHED __builtin_amdgcn_sched_barrier(0)
#define PG8_GOFF(dst, u) do { _Pragma("unroll") for (int _h = 0; _h < 2; ++_h) _Pragma("unroll") for (int _i = 0; _i < 2; ++_i) \
        dst[_h][_i] = (unsigned)(S.a_row(u, _h * HALF + RA[_i]) * RP + CA[_i] * 2); } while (0)
    Unit cur, nxt, nn; int ui = 0;
    if (!S.next(0, cur)) return;
    bool has_next = S.next(1, nxt);
    if constexpr (GATHER) { PG8_GOFF(gC, cur); if (has_next) { PG8_GOFF(gN, nxt); } else { PG8_GOFF(gN, cur); } }
    f32x4 acc[2][2][4][2];
#pragma unroll
    for (int a = 0; a < 2; ++a)
#pragma unroll
        for (int b = 0; b < 2; ++b)
#pragma unroll
            for (int m = 0; m < 4; ++m)
#pragma unroll
                for (int n = 0; n < 2; ++n) acc[a][b][m][n] = (f32x4){0.f, 0.f, 0.f, 0.f};
    bf16x8 At[4][2], B0[2][2], B1[2][2]; v8i32 At8[4], B08[2], B18[2];
    const char* cA = S.a_ptr(cur); const char* cB = S.b_ptr(cur);
    PG8_STAGE(PG8_SB(0, 0), cB, voffB); PG8_STAGE(PG8_SB(0, 1), cB + hstep, voffB); PG8_STAGE_A(PG8_SA(0, 0), cA, 0); PG8_STAGE_A(PG8_SA(0, 1), cA, 1);
    if (wr == 1) PG8_BAR;
    PG8_WAIT_V(2); PG8_BAR;
    PG8_STAGE(PG8_SB(1, 0), cB + kstep, voffB); PG8_STAGE_A(PG8_SA(1, 0), cA + kstep, 0); PG8_STAGE(PG8_SB(1, 1), cB + hstep + kstep, voffB);
    PG8_WAIT_V(6); PG8_BAR;
    for (;;) {
        const char* nA = has_next ? S.a_ptr(nxt) : cA; const char* nB = has_next ? S.b_ptr(nxt) : cB;
        for (int t = 0; t < nt; t += 2) {
            const bool last = (t == nt - 2);
            const char* a1 = cA + (size_t)(t + 1) * kstep;
            const char* a2 = last ? nA : cA + (size_t)(t + 2) * kstep; const char* b2 = last ? nB : cB + (size_t)(t + 2) * kstep;
            const char* a3 = a2 + kstep; const char* b3 = b2 + kstep;
            PG8_LDB(B0, 0, 0); PG8_LDB(B1, 0, 1); PG8_SCHED; PG8_LDA(At, 0, 0); PG8_STAGE_A(PG8_SA(1, 1), a1, 1);
            if constexpr (GATHER) { if (last) {
#pragma unroll
                for (int h = 0; h < 2; ++h)
#pragma unroll
                    for (int i = 0; i < 2; ++i) gC[h][i] = gN[h][i]; } }
            PG8_WAIT_V(8); PG8_WAIT_L(0); PG8_BAR; PG8_MMA(0, 0, At, B0); PG8_MMA(0, 1, At, B1); PG8_BAR; PG8_SCHED;
            PG8_LDA(At, 0, 1); PG8_STAGE(PG8_SB(0, 0), b2, voffB); PG8_STAGE(PG8_SB(0, 1), b2 + hstep, voffB); PG8_STAGE_A(PG8_SA(0, 0), a2, 0);
            PG8_WAIT_V(8); PG8_WAIT_L(0); PG8_BAR; PG8_MMA(1, 0, At, B0); PG8_MMA(1, 1, At, B1); PG8_BAR; PG8_SCHED;
            PG8_LDB(B0, 1, 0); PG8_LDB(B1, 1, 1); PG8_SCHED; PG8_LDA(At, 1, 0); PG8_STAGE_A(PG8_SA(0, 1), a2, 1);
            PG8_WAIT_V(8); PG8_WAIT_L(0); PG8_BAR; PG8_MMA(0, 0, At, B0); PG8_MMA(0, 1, At, B1); PG8_BAR; PG8_SCHED;
            PG8_LDA(At, 1, 1); PG8_STAGE(PG8_SB(1, 0), b3, voffB); PG8_STAGE(PG8_SB(1, 1), b3 + hstep, voffB); PG8_STAGE_A(PG8_SA(1, 0), a3, 0);
            PG8_WAIT_V(8); PG8_WAIT_L(0); PG8_BAR; PG8_MMA(1, 0, At, B0); PG8_MMA(1, 1, At, B1); PG8_BAR; PG8_SCHED;
        }
        if (wr == 0) PG8_BAR;
        bool has_nn = false;
        if constexpr (GATHER) { if (has_next) { has_nn = S.next(ui + 2, nn); if (has_nn) { PG8_GOFF(gN, nn); } } }
        else { if (has_next) has_nn = S.next(ui + 2, nn); }
        { int fr_ = fr, fq_ = fq; asm volatile("" : "+v"(fr_), "+v"(fq_));
          E(acc, cur, wr, wc, fr_, fq_); }
        if (!has_next) break;
#pragma unroll
        for (int a = 0; a < 2; ++a)
#pragma unroll
            for (int b = 0; b < 2; ++b)
#pragma unroll
                for (int m = 0; m < 4; ++m)
#pragma unroll
                    for (int n = 0; n < 2; ++n) acc[a][b][m][n] = (f32x4){0.f, 0.f, 0.f, 0.f};
        cur = nxt; cA = nA; cB = nB; ++ui; nxt = nn; has_next = has_nn;
        if (wr == 1) PG8_BAR;
    }
    PG8_WAIT_V(0);
    PG8_BAR;
#undef PG8_SA
#undef PG8_SB
#undef PG8_STAGE
#undef PG8_STAGE_A
#undef PG8_LDA
#undef PG8_LDB
#undef PG8_MMA
#undef PG8_LD16
#undef PG8_CAT
#undef PG8_WAIT_V
#undef PG8_WAIT_L
#undef PG8_BAR
#undef PG8_SCHED
#undef PG8_GOFF
}
}

using pg8::Unit; using pg8::cvt_pk_bf16;
constexpr int BM = 256, HALF = 128;

struct EpiInProj {
    static constexpr bool PERM = true;
    const float* rs1; const f32x2* rope; const float* glu_b;
    bf16_t *q, *k, *v, *qi, *ki, *hglu; float* wi;
    __device__ __forceinline__ void operator()(const f32x4 (&acc)[2][2][4][2], const Unit& u, int wr, int wc, int fr, int fq) const {
        const int row0 = u.pm * BM + wr * 64 + fr;
        if (u.pn >= 4) {
            const int ch = 128 * (u.pn - 4) + 32 * wc + 8 * fq;
            f32x4 ba[2], bg[2];
#pragma unroll
            for (int n = 0; n < 2; ++n) { ba[n] = *(const f32x4*)(glu_b + ch + 4 * n); bg[n] = *(const f32x4*)(glu_b + 512 + ch + 4 * n); }
#pragma unroll
            for (int ai = 0; ai < 2; ++ai)
#pragma unroll
                for (int m = 0; m < 4; ++m) { const int row = row0 + ai * HALF + m * 16; const float rs = rs1[row];
                    float o[8];
#pragma unroll
                    for (int n = 0; n < 2; ++n)
#pragma unroll
                        for (int e = 0; e < 4; ++e) { const float a = acc[ai][0][m][n][e] * rs + ba[n][e], g = acc[ai][1][m][n][e] * rs + bg[n][e]; o[4 * n + e] = a * sigmoidf_(g); }
                    u32x4 w; w.x = cvt_pk_bf16(o[0], o[1]); w.y = cvt_pk_bf16(o[2], o[3]); w.z = cvt_pk_bf16(o[4], o[5]); w.w = cvt_pk_bf16(o[6], o[7]);
                    *(u32x4*)(hglu + (size_t)row * 512 + ch) = w; }
            return;
        }
        bf16_t* dst; int ld, col; bool do_rope = true, is_wi = false;
        if (u.pn < 2) { dst = q; ld = 512; col = (4 * u.pn + wc) * 64; }
        else if (u.pn == 2) { dst = qi; ld = 256; col = wc * 64; }
        else { ld = 64; col = 0; if (wc == 0) dst = k; else if (wc == 1) dst = ki; else if (wc == 2) { dst = v; do_rope = false; } else { dst = v; is_wi = true; do_rope = false; } }
        if (is_wi) {
            if (fq == 0) {
#pragma unroll
                for (int ai = 0; ai < 2; ++ai)
#pragma unroll
                    for (int m = 0; m < 4; ++m) { const int row = row0 + ai * HALF + m * 16; const float rs = rs1[row];
                        *(f32x4*)(wi + (size_t)row * 4) = acc[ai][0][m][0] * rs; }
            }
            return;
        }
        const int d0 = 8 * fq;
#pragma unroll
        for (int ai = 0; ai < 2; ++ai)
#pragma unroll
            for (int m = 0; m < 4; ++m) { const int row = row0 + ai * HALF + m * 16; const float rs = rs1[row];
                float o1[8], o2[8];
                if (do_rope) {
                    const f32x2* rp = rope + (size_t)(row & (SEQ - 1)) * 32 + d0;
#pragma unroll
                    for (int n = 0; n < 2; ++n)
#pragma unroll
                        for (int e = 0; e < 4; ++e) { const f32x2 cs = rp[4 * n + e]; const float x1 = acc[ai][0][m][n][e] * rs, x2 = acc[ai][1][m][n][e] * rs;
                            o1[4 * n + e] = x1 * cs.x - x2 * cs.y; o2[4 * n + e] = x2 * cs.x + x1 * cs.y; }
                } else {
#pragma unroll
                    for (int n = 0; n < 2; ++n)
#pragma unroll
                        for (int e = 0; e < 4; ++e) { o1[4 * n + e] = acc[ai][0][m][n][e] * rs; o2[4 * n + e] = acc[ai][1][m][n][e] * rs; }
                }
                u32x4 w1, w2; w1.x = cvt_pk_bf16(o1[0], o1[1]); w1.y = cvt_pk_bf16(o1[2], o1[3]); w1.z = cvt_pk_bf16(o1[4], o1[5]); w1.w = cvt_pk_bf16(o1[6], o1[7]);
                w2.x = cvt_pk_bf16(o2[0], o2[1]); w2.y = cvt_pk_bf16(o2[2], o2[3]); w2.z = cvt_pk_bf16(o2[4], o2[5]); w2.w = cvt_pk_bf16(o2[6], o2[7]);
                bf16_t* rp2 = dst + (size_t)row * ld + col + d0;
                *(u32x4*)(rp2) = w1; *(u32x4*)(rp2 + 32) = w2; }
    }
};

struct EpiBf16Plain {
    static constexpr bool PERM = true;
    bf16_t* O; int ldc;
    __device__ __forceinline__ void operator()(const f32x4 (&acc)[2][2][4][2], const Unit& u, int wr, int wc, int fr, int fq) const {
        const int row0 = u.pm * BM + wr * 64 + fr, col0 = u.pn * BM + wc * 32 + 8 * fq;
#pragma unroll
        for (int ai = 0; ai < 2; ++ai)
#pragma unroll
            for (int m = 0; m < 4; ++m) { bf16_t* rowp = O + (size_t)(row0 + ai * HALF + m * 16) * ldc + col0;
#pragma unroll
                for (int bj = 0; bj < 2; ++bj) { const f32x4 v0 = acc[ai][bj][m][0], v1 = acc[ai][bj][m][1];
                    u32x4 w; w.x = cvt_pk_bf16(v0[0], v0[1]); w.y = cvt_pk_bf16(v0[2], v0[3]); w.z = cvt_pk_bf16(v1[0], v1[1]); w.w = cvt_pk_bf16(v1[2], v1[3]);
                    *(u32x4*)(rowp + bj * HALF) = w; } }
    }
};

struct EpiOutProj {
    static constexpr bool PERM = false;
    const float* x; float* h1; unsigned char* h1f8;
    __device__ __forceinline__ void operator()(const f32x4 (&acc)[2][2][4][2], const Unit& u, int wr, int wc, int fr, int fq) const {
        const int row0 = u.pm * BM + wr * 64 + fr, col0 = u.pn * BM + wc * 32 + 4 * fq;
#pragma unroll
        for (int ai = 0; ai < 2; ++ai)
#pragma unroll
            for (int m = 0; m < 4; ++m) { const size_t off = (size_t)(row0 + ai * HALF + m * 16) * DM + col0;
#pragma unroll
                for (int bj = 0; bj < 2; ++bj)
#pragma unroll
                    for (int n = 0; n < 2; ++n) { const size_t o = off + bj * HALF + n * 16; const f32x4 r = *(const f32x4*)(x + o) + acc[ai][bj][m][n];
                        *(f32x4*)(h1 + o) = r; *(unsigned*)(h1f8 + o) = pk4_fp8(r[0], r[1], r[2], r[3]); } }
    }
};

struct EpiUp {
    static constexpr bool PERM = true;
    const float* lscale; const float* b_up; unsigned char* act; const LAS int* tb;
    __device__ __forceinline__ void operator()(const f32x4 (&acc)[2][2][4][2], const Unit& u, int wr, int wc, int fr, int fq) const {
        const int r0 = wr * 64 + fr, ch = 128 * u.pn + 32 * wc + 8 * fq, rt = u.pm - tb[u.e];
        const float* bu = b_up + (size_t)u.e * 2048;
        f32x4 bg[2], bl[2];
#pragma unroll
        for (int n = 0; n < 2; ++n) { bg[n] = *(const f32x4*)(bu + ch + 4 * n); bl[n] = *(const f32x4*)(bu + 1024 + ch + 4 * n); }
#pragma unroll
        for (int ai = 0; ai < 2; ++ai)
#pragma unroll
            for (int m = 0; m < 4; ++m) { const int r = r0 + ai * HALF + m * 16;
                const float rs = (r < u.rows) ? lscale[u.e * NTOK + rt * BM + r] * 0.03125f : 0.f;
                float o[8];
#pragma unroll
                for (int n = 0; n < 2; ++n)
#pragma unroll
                    for (int e = 0; e < 4; ++e) { float g = acc[ai][0][m][n][e] * rs + bg[n][e], l = acc[ai][1][m][n][e] * rs + bl[n][e];
                        g = fminf(g, 7.0f); l = fminf(fmaxf(l, -7.0f), 7.0f); o[4 * n + e] = g * sigmoidf_(1.702f * g) * (l + 1.0f); }
                u32x2 w; w.x = pk4_fp8(o[0], o[1], o[2], o[3]); w.y = pk4_fp8(o[4], o[5], o[6], o[7]);
                *(u32x2*)(act + (size_t)(u.pm * BM + r) * 1024 + ch) = w; }
    }
};

struct EpiDown {
    static constexpr bool PERM = true;
    const int* list; const float* lgate; const float* b_down; bf16_t* y; const LAS int* tb;
    __device__ __forceinline__ void operator()(f32x4 (&acc)[2][2][4][2], const Unit& u, int wr, int wc, int fr, int fq) const {
        const int r0 = wr * 64 + fr, col0 = u.pn * BM + wc * 32 + 8 * fq, rt = u.pm - tb[u.e];
        const float* bd = b_down + (size_t)u.e * 1024;
#pragma unroll
        for (int bj = 0; bj < 2; ++bj)
#pragma unroll
            for (int n = 0; n < 2; ++n) { const f32x4 bv = *(const f32x4*)(bd + col0 + bj * HALF + 4 * n);
#pragma unroll
                for (int ai = 0; ai < 2; ++ai)
#pragma unroll
                    for (int m = 0; m < 4; ++m) acc[ai][bj][m][n] = acc[ai][bj][m][n] * 0.03125f + bv; }
#pragma unroll
        for (int ai = 0; ai < 2; ++ai)
#pragma unroll
            for (int m = 0; m < 4; ++m) { const int r = r0 + ai * HALF + m * 16;
                if (r < u.rows) { const int li = u.e * NTOK + rt * BM + r; const int slot = list[li]; const float g = lgate[li];
                    bf16_t* rowp = y + (size_t)slot * 1024 + col0;
#pragma unroll
                    for (int bj = 0; bj < 2; ++bj) { const f32x4 v0 = acc[ai][bj][m][0] * g, v1 = acc[ai][bj][m][1] * g;
                        u32x4 w; w.x = cvt_pk_bf16(v0[0], v0[1]); w.y = cvt_pk_bf16(v0[2], v0[3]); w.z = cvt_pk_bf16(v1[0], v1[1]); w.w = cvt_pk_bf16(v1[2], v1[3]);
                        *(u32x4*)(rowp + bj * HALF) = w; } } }
    }
};

struct EpiPle {
    static constexpr bool PERM = false;
    const float* h2; const bf16_t* pj; const float* rs3; float* out;
    __device__ __forceinline__ void operator()(const f32x4 (&acc)[2][2][4][2], const Unit& u, int wr, int wc, int fr, int fq) const {
        const int row0 = u.pm * BM + wr * 64 + fr, col0 = u.pn * BM + wc * 32 + 4 * fq;
#pragma unroll
        for (int ai = 0; ai < 2; ++ai)
#pragma unroll
            for (int m = 0; m < 4; ++m) { const int row = row0 + ai * HALF + m * 16; const size_t off = (size_t)row * DM + col0; const float rs = rs3[row];
#pragma unroll
                for (int bj = 0; bj < 2; ++bj)
#pragma unroll
                    for (int n = 0; n < 2; ++n) { const size_t o = off + bj * HALF + n * 16; const f32x4 hv = *(const f32x4*)(h2 + o); const u32x2 pw = *(const u32x2*)(pj + o);
                        const f32x4 a = acc[ai][bj][m][n]; f32x4 r;
                        r[0] = hv[0] + bf_lo(pw.x) * sigmoidf_(a[0] * rs); r[1] = hv[1] + bf_hi(pw.x) * sigmoidf_(a[1] * rs);
                        r[2] = hv[2] + bf_lo(pw.y) * sigmoidf_(a[2] * rs); r[3] = hv[3] + bf_hi(pw.y) * sigmoidf_(a[3] * rs);
                        *(f32x4*)(out + o) = r; } }
    }
};

template <bool F8>
__device__ __forceinline__ void p0_transpose_item(const float* W, int ldw, void* WTv, int Kdim, const float* gain, LAS float* scr, int kb, int n0, int src0, int nvalid, int lane) {
    bf16_t* WT = (bf16_t*)WTv;
    const int k0 = 64 * kb;
    f32x4 ld4[8];
#pragma unroll
    for (int i = 0; i < 8; ++i) { const int kk = 8 * i + (lane >> 3), j = (lane & 7) * 4;
        ld4[i] = (f32x4){0.f, 0.f, 0.f, 0.f}; if (j < nvalid) ld4[i] = *(const f32x4*)(W + (size_t)(k0 + kk) * ldw + src0 + j); }
#pragma unroll
    for (int i = 0; i < 8; ++i) { const int kk = 8 * i + (lane >> 3), j = (lane & 7) * 4; const float gk = (gain ? gain[k0 + kk] : 1.0f) * (F8 ? 32.0f : 1.0f);
        LAS float* d = scr + kk * 33 + j; d[0] = ld4[i].x * gk; d[1] = ld4[i].y * gk; d[2] = ld4[i].z * gk; d[3] = ld4[i].w * gk; }
    LDS_WAIT(); asm volatile("" ::: "memory");
    const int c = lane & 7;
#pragma unroll
    for (int j = 0; j < 4; ++j) { const int n = (lane >> 3) + 8 * j; const LAS float* s = scr + (8 * c) * 33 + n;
        if constexpr (F8) { u32x2 o; o.x = pk4_fp8(s[0 * 33], s[1 * 33], s[2 * 33], s[3 * 33]); o.y = pk4_fp8(s[4 * 33], s[5 * 33], s[6 * 33], s[7 * 33]);
            *(u32x2*)((unsigned char*)WTv + (size_t)(n0 + n) * Kdim + k0 + 8 * c) = o; }
        else { u32x4 o; o.x = pk2(s[0 * 33], s[1 * 33]); o.y = pk2(s[2 * 33], s[3 * 33]); o.z = pk2(s[4 * 33], s[5 * 33]); o.w = pk2(s[6 * 33], s[7 * 33]);
            *(u32x4*)(WT + (size_t)(n0 + n) * Kdim + k0 + 8 * c) = o; } }
    LDS_WAIT(); asm volatile("" ::: "memory");
}
__device__ __forceinline__ void win_colmap(int nb, int& src0, int& nvalid) {
    const int pn = nb >> 3, j = (nb & 7) * 32, bj = j >> 7, slot = (j & 127) >> 5;
    nvalid = 32;
    if (pn < 2) src0 = (4 * pn + slot) * 64 + 32 * bj;
    else if (pn == 2) src0 = 640 + slot * 64 + 32 * bj;
    else if (pn == 3) { if (slot == 0) src0 = 512 + 32 * bj; else if (slot == 1) src0 = 896 + 32 * bj; else if (slot == 2) src0 = 576 + 32 * bj; else { src0 = 960; nvalid = bj == 0 ? 4 : 0; } }
    else src0 = 964 + 512 * bj + 128 * (pn - 4) + 32 * slot;
}
__device__ __forceinline__ void p0_prologue(const Params& P, LAS unsigned char* lds, int vcu, int G, int wave, int lane) {
    unsigned char* ws = P.ws;
    LAS float* scr = (LAS float*)(lds + wave * 16384);
    const int gw = vcu * NWAVES + wave, NGW = G * NWAVES;
    constexpr int I_IN = 16 * 64, I_OUT = 16 * 32, I_G = 16 * 32, I_P = 4 * 32, I_UP = 32 * 16 * 64, I_DN = 32 * 16 * 32;
    constexpr int NITEMS = I_IN + I_OUT + I_G + I_P + I_UP + I_DN;
    for (int it = gw; it < NITEMS; it += NGW) {
        int r = it;
        if (r < I_IN) { const int kb = r / 64, nb = r % 64; int s0, nv; win_colmap(nb, s0, nv); p0_transpose_item<false>(P.w_in, INW, (bf16_t*)(ws + WS_WIN), 1024, P.g_mix, scr, kb, nb * 32, s0, nv, lane); continue; } r -= I_IN;
        if (r < I_OUT) { const int kb = r / 32, nb = r % 32; p0_transpose_item<false>(P.w_out, 1024, (bf16_t*)(ws + WS_WOUT), 1024, nullptr, scr, kb, nb * 32, nb * 32, 32, lane); continue; } r -= I_OUT;
        if (r < I_G) { const int kb = r / 32, nb = r % 32; p0_transpose_item<false>(P.w_ple_gate, 1024, (bf16_t*)(ws + WS_WG), 1024, P.g_ple, scr, kb, nb * 32, nb * 32, 32, lane); continue; } r -= I_G;
        if (r < I_P) { const int kb = r / 32, nb = r % 32; p0_transpose_item<false>(P.w_ple_proj, 1024, (bf16_t*)(ws + WS_WP), 256, nullptr, scr, kb, nb * 32, nb * 32, 32, lane); continue; } r -= I_P;
        if (r < I_UP) { const int e = r / 1024, rr = r % 1024, kb = rr / 64, nb = rr % 64;
            const int pn = nb >> 3, j = (nb & 7) * 32, bj = j >> 7, jj = j & 127;
            p0_transpose_item<true>(P.w_up + (size_t)e * 1024 * 2048, 2048, (unsigned char*)(ws + WS_WUP) + (size_t)e * 2048 * 1024, 1024, P.g_ffn, scr, kb, nb * 32, 1024 * bj + 128 * pn + jj, 32, lane); continue; } r -= I_UP;
        { const int e = r / 512, rr = r % 512, kb = rr / 32, nb = rr % 32;
            p0_transpose_item<true>(P.w_down + (size_t)e * 1024 * 1024, 1024, (unsigned char*)(ws + WS_WDOWN) + (size_t)e * 1024 * 1024, 1024, nullptr, scr, kb, nb * 32, nb * 32, 32, lane); }
    }
    float* rs1 = (float*)(ws + WS_RS1); bf16_t* xb = (bf16_t*)(ws + WS_XB);
    for (int m = gw; m < NTOK; m += NGW) {
        const f32x4* xr = (const f32x4*)(P.x + (size_t)m * DM) + lane; f32x4 v[4]; float s = 0.f;
#pragma unroll
        for (int j = 0; j < 4; ++j) { v[j] = xr[64 * j]; s += (v[j].x * v[j].x + v[j].y * v[j].y) + (v[j].z * v[j].z + v[j].w * v[j].w); }
        s = wave_sum(s);
        u32x2* o8 = (u32x2*)(xb + (size_t)m * DM) + lane;
#pragma unroll
        for (int j = 0; j < 4; ++j) { u32x2 w; w.x = pk2(v[j].x, v[j].y); w.y = pk2(v[j].z, v[j].w); o8[64 * j] = w; }
        if (lane == 0) rs1[m] = 1.0f / sqrtf(s * (1.0f / DM) + EPS);
    }
    bf16_t* pb = (bf16_t*)(ws + WS_PB);
    for (int m = gw; m < NTOK; m += NGW) { const f32x4 v = *((const f32x4*)(P.p + (size_t)m * 256) + lane); u32x2 w; w.x = pk2(v.x, v.y); w.y = pk2(v.z, v.w); *((u32x2*)(pb + (size_t)m * 256) + lane) = w; }
    f32x2* rope = (f32x2*)(ws + WS_ROPE);
    for (int idx = gw * 64 + lane; idx < SEQ * 32; idx += NGW * 64) { const int t = idx >> 5, i = idx & 31;
        const float inv = exp2f(-(float)i * (13.287712379549449f / 32.0f));
        const float ang = (float)t * inv;
        const double rev = (double)ang * 0.15915494309189535; const float fr = (float)(rev - __builtin_floor(rev));
        rope[idx] = (f32x2){__builtin_amdgcn_cosf(fr), __builtin_amdgcn_sinf(fr)}; }
    float* wrg = (float*)(ws + WS_WRG);
    for (int idx = gw * 64 + lane; idx < 1024 * 32; idx += NGW * 64) wrg[idx] = P.w_router[idx] * P.g_ffn[idx >> 5];
}

__device__ __forceinline__ unsigned fkey(float f) { unsigned u = __builtin_bit_cast(unsigned, f); if (u == 0x80000000u) u = 0u; return u ^ ((unsigned)((int)u >> 31) | 0x80000000u); }
__device__ __forceinline__ int mbcnt64(unsigned long long m) { return __builtin_amdgcn_mbcnt_hi((unsigned)(m >> 32), __builtin_amdgcn_mbcnt_lo((unsigned)m, 0u)); }

template <int NR>
__device__ __forceinline__ unsigned bisect_thr(const unsigned (&v)[NR], unsigned prefix, int startbit) {
    bool exact = false;
#pragma unroll 1
    for (int bit = startbit; bit >= 0; --bit) {
        const unsigned cand = prefix | (1u << bit); int cnt = 0;
#pragma unroll
        for (int r = 0; r < NR; ++r) { cnt += __builtin_popcountll(__ballot(v[r] >= cand)); if ((r & 7) == 7) __builtin_amdgcn_sched_barrier(0); }
        if (cnt >= NSEL) prefix = cand;
        if (cnt == NSEL) { exact = true; break; }
    }
    return exact ? prefix - 1u : prefix;
}
template <int NR, bool EXPL>
__device__ __forceinline__ void compact_sel(const unsigned (&v)[NR], const unsigned (&ci)[NR], unsigned T, LAS unsigned* list, int lane) {
    int cgt = 0;
#pragma unroll
    for (int r = 0; r < NR; ++r) { cgt += __builtin_popcountll(__ballot(v[r] > T)); if ((r & 7) == 7) __builtin_amdgcn_sched_barrier(0); }
    const int need = NSEL - cgt; int base = 0, ties = 0;
#pragma unroll
    for (int r = 0; r < NR; ++r) { const bool gt = v[r] > T, eq = v[r] == T; const unsigned long long em = __ballot(eq);
        const bool sel = gt || (eq && (ties + mbcnt64(em)) < need); const unsigned long long sm = __ballot(sel);
        list[sel ? base + mbcnt64(sm) : NSEL + lane] = EXPL ? ci[r] : (unsigned)(r * 64 + lane);
        base += __builtin_popcountll(sm); ties += __builtin_popcountll(em);
        if ((r & 3) == 3) __builtin_amdgcn_sched_barrier(0); }
}
constexpr int SEL_CAP = 1024;
template <int NR>
__device__ __forceinline__ void select_topk(LAS float* row, LAS unsigned* H, LAS unsigned* list, int lane, bool zero_h) {
    unsigned v[NR];
#pragma unroll
    for (int r = 0; r < NR; ++r) v[r] = fkey(row[r * 64 + lane]);
    LAS u32x4* H4 = (LAS u32x4*)H;
    const u32x4 h0 = H4[2 * lane], h1 = H4[2 * lane + 1];
    if (zero_h) { H4[2 * lane] = (u32x4){0u, 0u, 0u, 0u}; H4[2 * lane + 1] = (u32x4){0u, 0u, 0u, 0u}; }
    const unsigned hw[8] = {h0.x, h0.y, h0.z, h0.w, h1.x, h1.y, h1.z, h1.w};
    unsigned c[16];
#pragma unroll
    for (int i = 0; i < 8; ++i) { c[2 * i] = hw[i] & 0xffffu; c[2 * i + 1] = hw[i] >> 16; }
    unsigned s = 0u;
#pragma unroll
    for (int i = 0; i < 16; ++i) s += c[i];
    unsigned S = s;
#pragma unroll
    for (int off = 1; off < 64; off <<= 1) { const unsigned o = __shfl_down(S, off); if (lane + off < 64) S += o; }
    const unsigned long long okm = __ballot(S >= (unsigned)NSEL);
    bool fast = okm != 0ull; unsigned floorkey = 0u; int C = 0;
    if (fast) {
        const int Ls = 63 - __builtin_clzll(okm);
        unsigned acc = S - s; int bl = -1; unsigned accb = 0u;
#pragma unroll
        for (int b = 15; b >= 0; --b) { acc += c[b]; if (bl < 0 && acc >= (unsigned)NSEL) { bl = b; accb = acc; } }
        const int bstar = __shfl(bl, Ls) + 16 * Ls; C = (int)__shfl(accb, Ls);
        floorkey = (unsigned)bstar << 22;
        fast = (bstar > 1) && (C <= SEL_CAP);
    }
    if (!fast) {
        const unsigned T = bisect_thr<NR>(v, 0u, 31);
        compact_sel<NR, false>(v, v, T, list, lane);
        return;
    }
    LAS unsigned* ckl = (LAS unsigned*)row; LAS unsigned* cil = ckl + 1152;
    { int base = 0;
#pragma unroll
      for (int r = 0; r < NR; ++r) { const bool cnd = v[r] >= floorkey; const unsigned long long m = __ballot(cnd);
          const int pos = cnd ? base + mbcnt64(m) : SEL_CAP + lane;
          ckl[pos] = v[r]; cil[pos] = (unsigned)(r * 64 + lane); base += __builtin_popcountll(m);
          if ((r & 3) == 3) __builtin_amdgcn_sched_barrier(0); } }
    if (C <= 512) {
        unsigned ck[8], ci[8];
#pragma unroll
        for (int j = 0; j < 8; ++j) { const int i = j * 64 + lane; ck[j] = i < C ? ckl[i] : 0u; ci[j] = cil[i]; }
        const unsigned T = (C == NSEL) ? floorkey - 1u : bisect_thr<8>(ck, floorkey, 21);
        compact_sel<8, true>(ck, ci, T, list, lane);
    } else {
        unsigned ck[16], ci[16];
#pragma unroll
        for (int j = 0; j < 16; ++j) { const int i = j * 64 + lane; ck[j] = i < C ? ckl[i] : 0u; ci[j] = cil[i]; }
        const unsigned T = bisect_thr<16>(ck, floorkey, 21);
        compact_sel<16, true>(ck, ci, T, list, lane);
    }
}

typedef short v4i16 __attribute__((ext_vector_type(4)));
constexpr int VROW = 144;

__device__ __forceinline__ void attn_tile(const Params& P, LAS unsigned char* lds, int b, int t0, int wave, int lane) {
    unsigned char* ws = P.ws;
    const bf16_t* QI = (const bf16_t*)(ws + WS_QI); const bf16_t* KI = (const bf16_t*)(ws + WS_KI);
    const bf16_t* Q = (const bf16_t*)(ws + WS_Q); const bf16_t* Kp = (const bf16_t*)(ws + WS_K); const bf16_t* Vp = (const bf16_t*)(ws + WS_V);
    const float* WI = (const float*)(ws + WS_WI); bf16_t* MIX = (bf16_t*)(ws + WS_MIX);
    LAS float* SC = (LAS float*)lds;
    LAS unsigned* list = (LAS unsigned*)(lds + wave * 16384 + 14336);
    LAS unsigned* HIST = (LAS unsigned*)(lds + LDS_MISC);
    const int tokbase = b * SEQ;
    const bool need_sel = t0 >= 256;
    if (need_sel) {
        const int nkt = (t0 + 8 + 31) >> 5;
        bf16x8 a[4]; f32x4 w[4];
        { const bf16_t* src = QI + (size_t)(tokbase + t0 + ((lane & 31) >> 2)) * 256 + (lane & 3) * 64 + 8 * (lane >> 5);
#pragma unroll
          for (int ks = 0; ks < 4; ++ks) a[ks] = *(const bf16x8*)(src + 16 * ks); }
#pragma unroll
        for (int g = 0; g < 4; ++g) w[g] = *(const f32x4*)(WI + (size_t)(tokbase + t0 + 2 * g + (lane >> 5)) * 4);
        for (int kt0 = wave; kt0 < nkt; kt0 += 4 * NWAVES) {
            bf16x8 bf[4][4];
#pragma unroll
            for (int u = 0; u < 4; ++u) { const int kt = kt0 + u * NWAVES;
                if (kt < nkt) { const bf16_t* ksrc = KI + (size_t)(tokbase + kt * 32 + (lane & 31)) * 64 + 8 * (lane >> 5);
#pragma unroll
                    for (int ks = 0; ks < 4; ++ks) bf[u][ks] = *(const bf16x8*)(ksrc + 16 * ks); } }
#pragma unroll
            for (int u = 0; u < 4; ++u) { const int kt = kt0 + u * NWAVES;
                if (kt < nkt) {
                    const int key = kt * 32 + (lane & 31);
                    f32x16 acc;
#pragma unroll
                    for (int i = 0; i < 16; ++i) acc[i] = 0.f;
#pragma unroll
                    for (int ks = 0; ks < 4; ++ks) acc = __builtin_amdgcn_mfma_f32_32x32x16_bf16(a[ks], bf[u][ks], acc, 0, 0, 0);
#pragma unroll
                    for (int g = 0; g < 4; ++g) { float sc = 0.f;
#pragma unroll
                        for (int h = 0; h < 4; ++h) sc = fmaf(fmaxf(acc[4 * g + h], 0.f), w[g][h], sc);
                        const int ql = 2 * g + (lane >> 5);
                        if (key > t0 + ql) sc = -INFINITY;
                        SC[ql * 4096 + key] = sc;
                        if (key <= t0 + ql) { const unsigned ub = __builtin_bit_cast(unsigned, sc);
                            const unsigned bin = (ub >> 22) ^ (((unsigned)((int)ub >> 31) & 0x1ffu) | 0x200u);
                            __hip_atomic_fetch_add(HIST + ql * 512 + (bin >> 1), 1u << ((bin & 1u) << 4), __ATOMIC_RELAXED, __HIP_MEMORY_SCOPE_WORKGROUP); } }
                } }
        }
        { const int npad = ((t0 + 8 + 1023) >> 10) << 10;
          for (int i = nkt * 32 + (int)threadIdx.x; i < npad; i += NTHR) {
#pragma unroll
              for (int q = 0; q < 8; ++q) SC[q * 4096 + i] = -INFINITY; } }
    }
    __syncthreads();
    const int t = t0 + wave, tok = tokbase + t;
    if (need_sel) {
        LAS float* row = SC + wave * 4096; LAS unsigned* H = HIST + wave * 512; const int n = t + 1;
        if (n <= 1024) select_topk<16>(row, H, list, lane, true);
        else if (n <= 2048) select_topk<32>(row, H, list, lane, true);
        else if (n <= 3072) select_topk<48>(row, H, list, lane, true);
        else select_topk<64>(row, H, list, lane, true);
    } else {
#pragma unroll
        for (int i = 0; i < 4; ++i) list[i * 64 + lane] = (unsigned)(i * 64 + lane);
    }
    const int nvalid = need_sel ? NSEL : (t + 1);
    const int ngrp = (nvalid + 31) >> 5;
    const int hd = lane & 15, g = lane >> 4;
    bf16x8 qf0, qf1;
#pragma unroll
    for (int i = 0; i < 8; ++i) { qf0[i] = 0; qf1[i] = 0; }
    if (hd < 8) { const bf16_t* qs = Q + (size_t)tok * 512 + hd * 64 + 8 * g; qf0 = *(const bf16x8*)qs; qf1 = *(const bf16x8*)(qs + 32); }
    float m = -INFINITY, ssum = 0.f;
    f32x4 o[4];
#pragma unroll
    for (int dt = 0; dt < 4; ++dt) o[dt] = (f32x4){0.f, 0.f, 0.f, 0.f};
    LAS unsigned char* vreg = lds + wave * 16384;
    bf16x8 kf[4]; u32x4 vv[4];
    { const unsigned ia = list[hd], ib = list[16 + hd];
      const bf16_t* ka = Kp + (size_t)(tokbase + ia) * 64 + 8 * g; const bf16_t* kb = Kp + (size_t)(tokbase + ib) * 64 + 8 * g;
      kf[0] = *(const bf16x8*)ka; kf[1] = *(const bf16x8*)(ka + 32); kf[2] = *(const bf16x8*)kb; kf[3] = *(const bf16x8*)(kb + 32);
#pragma unroll
      for (int i = 0; i < 4; ++i) { const unsigned idx = list[(lane >> 3) + 8 * i]; vv[i] = *(const u32x4*)(Vp + (size_t)(tokbase + idx) * 64 + 8 * (lane & 7)); } }
#pragma unroll 1
    for (int grp = 0; grp < ngrp; ++grp) {
        LAS unsigned char* vbuf = vreg + (grp & 1) * 8192;
#pragma unroll
        for (int i = 0; i < 4; ++i) *(LAS u32x4*)(vbuf + ((lane >> 3) + 8 * i) * VROW + (lane & 7) * 16) = vv[i];
        f32x4 sa = {0.f, 0.f, 0.f, 0.f}, sb = {0.f, 0.f, 0.f, 0.f};
        sa = __builtin_amdgcn_mfma_f32_16x16x32_bf16(kf[0], qf0, sa, 0, 0, 0); sa = __builtin_amdgcn_mfma_f32_16x16x32_bf16(kf[1], qf1, sa, 0, 0, 0);
        sb = __builtin_amdgcn_mfma_f32_16x16x32_bf16(kf[2], qf0, sb, 0, 0, 0); sb = __builtin_amdgcn_mfma_f32_16x16x32_bf16(kf[3], qf1, sb, 0, 0, 0);
        if (grp + 1 < ngrp) {
            const int nb = (grp + 1) * 32; const unsigned ia = list[nb + hd], ib = list[nb + 16 + hd];
            const bf16_t* ka = Kp + (size_t)(tokbase + ia) * 64 + 8 * g; const bf16_t* kb = Kp + (size_t)(tokbase + ib) * 64 + 8 * g;
            kf[0] = *(const bf16x8*)ka; kf[1] = *(const bf16x8*)(ka + 32); kf[2] = *(const bf16x8*)kb; kf[3] = *(const bf16x8*)(kb + 32);
#pragma unroll
            for (int i = 0; i < 4; ++i) { const unsigned idx = list[nb + (lane >> 3) + 8 * i]; vv[i] = *(const u32x4*)(Vp + (size_t)(tokbase + idx) * 64 + 8 * (lane & 7)); }
        }
        float l[8]; float mloc = -INFINITY;
#pragma unroll
        for (int r = 0; r < 4; ++r) { const int sl = grp * 32 + 4 * g + r;
            l[r] = sl < nvalid ? sa[r] * 0.125f : -INFINITY; l[4 + r] = (sl + 16) < nvalid ? sb[r] * 0.125f : -INFINITY;
            mloc = fmaxf(mloc, fmaxf(l[r], l[4 + r])); }
        mloc = fmaxf(mloc, __shfl_xor(mloc, 16)); mloc = fmaxf(mloc, __shfl_xor(mloc, 32));
        const float mnew = fmaxf(m, mloc), alpha = __expf(m - mnew); m = mnew;
        float ps = 0.f;
#pragma unroll
        for (int r = 0; r < 8; ++r) { l[r] = __expf(l[r] - mnew); ps += l[r]; }
        ssum = ssum * alpha + ps;
        bf16x8 pf;
        { const u32x4 pw = {cvt_pk_bf16(l[0], l[1]), cvt_pk_bf16(l[2], l[3]), cvt_pk_bf16(l[4], l[5]), cvt_pk_bf16(l[6], l[7])}; pf = __builtin_bit_cast(bf16x8, pw); }
        LAS unsigned char* ta = vbuf + (4 * g + (hd >> 2)) * VROW + (hd & 3) * 8;
#pragma unroll
        for (int dt = 0; dt < 4; ++dt) {
            const v4i16 lo = __builtin_amdgcn_ds_read_tr16_b64_v4i16((LAS v4i16*)(ta + dt * 32));
            const v4i16 hi = __builtin_amdgcn_ds_read_tr16_b64_v4i16((LAS v4i16*)(ta + 16 * VROW + dt * 32));
            bf16x8 vf; vf[0] = lo[0]; vf[1] = lo[1]; vf[2] = lo[2]; vf[3] = lo[3]; vf[4] = hi[0]; vf[5] = hi[1]; vf[6] = hi[2]; vf[7] = hi[3];
            o[dt] = __builtin_amdgcn_mfma_f32_16x16x32_bf16(vf, pf, o[dt] * alpha, 0, 0, 0);
        }
    }
    ssum += __shfl_xor(ssum, 16); ssum += __shfl_xor(ssum, 32);
    const float inv = 1.0f / ssum;
    if (hd < 8) {
        bf16_t* op = MIX + (size_t)tok * 1024 + hd * 64 + 4 * g;
#pragma unroll
        for (int dt = 0; dt < 4; ++dt) { u32x2 w; w.x = cvt_pk_bf16(o[dt][0] * inv, o[dt][1] * inv); w.y = cvt_pk_bf16(o[dt][2] * inv, o[dt][3] * inv); *(u32x2*)(op + 16 * dt) = w; }
    }
    __syncthreads();
}

__device__ __forceinline__ void conv_tile(const Params& P, LAS unsigned char* lds, int tile, int tid, int wave, int lane) {
    unsigned char* ws = P.ws;
    const bf16_t* HG = (const bf16_t*)(ws + WS_HGLU); bf16_t* MIX = (bf16_t*)(ws + WS_MIX);
    LAS f32x2* part = (LAS f32x2*)(lds + LDS_MISC + 1024);
    LAS f32x2* stat = part + 256;
    const int tok0 = tile * 32, t0 = tok0 & (SEQ - 1), c = tid;
    float in[62];
#pragma unroll
    for (int r = 0; r < 62; ++r) { const int tt = t0 - 30 + r; in[r] = tt >= 0 ? __builtin_bit_cast(float, (unsigned)HG[(size_t)(tok0 - 30 + r) * 512 + c] << 16) : 0.f; }
    float out[32];
    const float bias = P.dw_b[c];
#pragma unroll
    for (int i = 0; i < 32; ++i) out[i] = bias;
#pragma unroll
    for (int j = 0; j < 31; ++j) { const float wj = P.dw_w[j * 512 + c];
#pragma unroll
        for (int i = 0; i < 32; ++i) out[i] = fmaf(in[i + j], wj, out[i]); }
#pragma unroll
    for (int i = 0; i < 32; ++i) { const float s1 = wave_sum(out[i]), s2 = wave_sum(out[i] * out[i]); if (lane == 0) part[i * 8 + wave] = (f32x2){s1, s2}; }
    __syncthreads();
    if (tid < 32) { float s1 = 0.f, s2 = 0.f;
#pragma unroll
        for (int w = 0; w < 8; ++w) { const f32x2 pp = part[tid * 8 + w]; s1 += pp.x; s2 += pp.y; }
        const float mean = s1 * (1.0f / 512.0f), var = fmaxf(s2 * (1.0f / 512.0f) - mean * mean, 0.f);
        stat[tid] = (f32x2){mean, 1.0f / sqrtf(var + EPS)}; }
    __syncthreads();
    const float lgc = P.ln_g[c], lbc = P.ln_b[c];
#pragma unroll
    for (int i = 0; i < 32; ++i) { const f32x2 st = stat[i]; const float y = (out[i] - st.x) * st.y * lgc + lbc; const float sl = y * sigmoidf_(y);
        MIX[(size_t)(tok0 + i) * 1024 + 512 + c] = (bf16_t)f2bf(sl); }
    __syncthreads();
}

__device__ __forceinline__ void router_phase(const Params& P, LAS unsigned char* lds, int blk, int G, int tid, int wave, int lane) {
    unsigned char* ws = P.ws;
    const float* h1 = (const float*)(ws + WS_H1); const float* wrg = (const float*)(ws + WS_WRG);
    int* list = (int*)(ws + WS_LIST); float* lscale = (float*)(ws + WS_LSCALE); float* lgate = (float*)(ws + WS_LGATE);
    unsigned* cntg = (unsigned*)(ws + WS_CTL) + CW_CNT;
    LAS float* WL = (LAS float*)lds;
    LAS int* lcnt = (LAS int*)(lds + LDS_MISC + 1024);
    LAS int* gbase = lcnt + 32;
    LAS int* rec_e = gbase + 32;
    LAS int* rec_p = rec_e + 512;
    LAS float* rec_g = (LAS float*)(rec_p + 512);
    LAS float* rec_s = rec_g + 512;
    for (int i = tid; i < 8192; i += NTHR) ((LAS f32x4*)WL)[i] = ((const f32x4*)wrg)[i];
    __syncthreads();
    const int tl = lane & 31, half = lane >> 5;
    for (int chunk = blk; chunk < NTOK / 128; chunk += G) {
        if (tid < 32) lcnt[tid] = 0;
        __syncthreads();
        if (wave < 4) {
            const int tloc = wave * 32 + tl, tok = chunk * 128 + tloc;
            const float* hrow = h1 + (size_t)tok * DM + 4 * half;
            f32x16 acc;
#pragma unroll
            for (int i = 0; i < 16; ++i) acc[i] = 0.f;
            float ss = 0.f;
#pragma unroll 1
            for (int k0 = 0; k0 < DM; k0 += 32) {
                f32x4 hv[4];
#pragma unroll
                for (int i = 0; i < 4; ++i) hv[i] = *(const f32x4*)(hrow + k0 + 8 * i);
#pragma unroll
                for (int i = 0; i < 4; ++i) {
                    ss = fmaf(hv[i].x, hv[i].x, fmaf(hv[i].y, hv[i].y, fmaf(hv[i].z, hv[i].z, fmaf(hv[i].w, hv[i].w, ss))));
#pragma unroll
                    for (int j = 0; j < 4; ++j) { const float wv = WL[(k0 + 8 * i + 4 * half + j) * 32 + tl];
                        acc = __builtin_amdgcn_mfma_f32_32x32x2f32(wv, hv[i][j], acc, 0, 0, 0); }
                }
            }
            ss += __shfl_xor(ss, 32);
            const float rs = 1.0f / sqrtf(ss * (1.0f / DM) + EPS);
            float v[16];
#pragma unroll
            for (int r = 0; r < 16; ++r) v[r] = acc[r] * rs + P.b_router[(r & 3) + 8 * (r >> 2) + 4 * half];
            float tv[4]; int te[4];
#pragma unroll
            for (int q = 0; q < 4; ++q) { float bv = -INFINITY; int be = 64;
#pragma unroll
                for (int r = 0; r < 16; ++r) { const int e = (r & 3) + 8 * (r >> 2) + 4 * half; if (v[r] > bv || (v[r] == bv && e < be)) { bv = v[r]; be = e; } }
#pragma unroll
                for (int r = 0; r < 16; ++r) { const int e = (r & 3) + 8 * (r >> 2) + 4 * half; if (e == be) v[r] = -INFINITY; }
                tv[q] = bv; te[q] = be; }
            float cv[8]; int ce[8];
#pragma unroll
            for (int q = 0; q < 4; ++q) { cv[q] = tv[q]; ce[q] = te[q]; cv[4 + q] = __shfl_xor(tv[q], 32); ce[4 + q] = __shfl_xor(te[q], 32); }
#pragma unroll
            for (int q = 0; q < 4; ++q) { float bv = -INFINITY; int be = 64;
#pragma unroll
                for (int r = 0; r < 8; ++r) if (cv[r] > bv || (cv[r] == bv && ce[r] < be)) { bv = cv[r]; be = ce[r]; }
#pragma unroll
                for (int r = 0; r < 8; ++r) if (ce[r] == be) cv[r] = -INFINITY;
                tv[q] = bv; te[q] = be; }
            const float e1 = __expf(tv[1] - tv[0]), e2 = __expf(tv[2] - tv[0]), e3 = __expf(tv[3] - tv[0]);
            const float is = 1.0f / (1.0f + e1 + e2 + e3);
            if (half == 0) {
                const float gq[4] = {is, e1 * is, e2 * is, e3 * is};
#pragma unroll
                for (int q = 0; q < 4; ++q) { const int lp = atomicAdd((int*)&lcnt[te[q]], 1); const int si = tloc * 4 + q; rec_e[si] = te[q]; rec_p[si] = lp; rec_g[si] = gq[q]; }
                rec_s[tloc] = rs;
            }
        }
        __syncthreads();
        if (tid < 32) gbase[tid] = (int)atomicAdd(cntg + 64 * tid, (unsigned)lcnt[tid]);
        __syncthreads();
        { const int si = tid, ee = rec_e[si], pos = gbase[ee] + rec_p[si], li = ee * NTOK + pos;
          list[li] = (chunk * 128) * 4 + si; lscale[li] = rec_s[si >> 2]; lgate[li] = rec_g[si]; }
        __syncthreads();
    }
}

__device__ __forceinline__ void combine_phase(const Params& P, int gw, int NGW, int lane) {
    unsigned char* ws = P.ws;
    float* h1 = (float*)(ws + WS_H1); bf16_t* h1b = (bf16_t*)(ws + WS_H1B); const bf16_t* y = (const bf16_t*)(ws + WS_Y); float* rs3 = (float*)(ws + WS_RS3);
    for (int m = gw; m < NTOK; m += NGW) {
        f32x4* hr = (f32x4*)(h1 + (size_t)m * DM) + lane; f32x4 v[4]; float s = 0.f;
#pragma unroll
        for (int j = 0; j < 4; ++j) v[j] = hr[64 * j];
#pragma unroll
        for (int k = 0; k < 4; ++k) { const u32x2* yr = (const u32x2*)(y + (size_t)(m * 4 + k) * DM) + lane;
#pragma unroll
            for (int j = 0; j < 4; ++j) { const u32x2 w = yr[64 * j]; v[j].x += bf_lo(w.x); v[j].y += bf_hi(w.x); v[j].z += bf_lo(w.y); v[j].w += bf_hi(w.y); } }
        u32x2* o8 = (u32x2*)(h1b + (size_t)m * DM) + lane;
#pragma unroll
        for (int j = 0; j < 4; ++j) { hr[64 * j] = v[j]; u32x2 w; w.x = pk2(v[j].x, v[j].y); w.y = pk2(v[j].z, v[j].w); o8[64 * j] = w;
            s += (v[j].x * v[j].x + v[j].y * v[j].y) + (v[j].z * v[j].z + v[j].w * v[j].w); }
        s = wave_sum(s);
        if (lane == 0) rs3[m] = 1.0f / sqrtf(s * (1.0f / DM) + EPS);
    }
}

__device__ __forceinline__ void final_phase(const Params& P, int gw, int NGW, int lane) {
    f32x4 gv[4];
#pragma unroll
    for (int j = 0; j < 4; ++j) gv[j] = *((const f32x4*)P.g_final + lane + 64 * j);
    for (int m = gw; m < NTOK; m += NGW) {
        f32x4* orow = (f32x4*)(P.out + (size_t)m * DM) + lane; f32x4 v[4]; float s = 0.f;
#pragma unroll
        for (int j = 0; j < 4; ++j) { v[j] = orow[64 * j]; s += (v[j].x * v[j].x + v[j].y * v[j].y) + (v[j].z * v[j].z + v[j].w * v[j].w); }
        s = wave_sum(s); const float rs = 1.0f / sqrtf(s * (1.0f / DM) + EPS);
#pragma unroll
        for (int j = 0; j < 4; ++j) orow[64 * j] = v[j] * rs * gv[j];
    }
}

#define XB_TMO      128
#define XB_XCNT(j)  (256  + 64 * (j))
#define XB_XSUB(j)  (1280 + 64 * (j))
#define XB_XGEN(j)  (2304 + 64 * (j))
#define XB_TOP      3328
#define XB_TOPGEN   3392
#define XCD_BAR_WORDS 3456
#define XB_SPIN_CAP (1u << 18)
__device__ __forceinline__ unsigned xb_ld(unsigned* p)              { return __hip_atomic_load(p, __ATOMIC_RELAXED, __HIP_MEMORY_SCOPE_AGENT); }
__device__ __forceinline__ unsigned xb_add(unsigned* p, unsigned v) { return __hip_atomic_fetch_add(p, v, __ATOMIC_RELAXED, __HIP_MEMORY_SCOPE_AGENT); }
__device__ __forceinline__ unsigned xb_xcc_id() { return (unsigned)__builtin_amdgcn_s_getreg((3 << 11) | 20) & 0xFu; }
#define XB_SPIN(cond, bar) do { unsigned _sp = 0; while (cond) { __builtin_amdgcn_s_sleep(1); \
    if ((++_sp & 255u) == 0u) { if (xb_ld(&(bar)[XB_TMO])) break; if (_sp > XB_SPIN_CAP) { atomicAdd(&(bar)[XB_TMO], 1u); break; } } } } while (0)
struct XcdBarrier { unsigned* bar; unsigned x; volatile LAS unsigned* st; };
__device__ __forceinline__ XcdBarrier xcd_barrier_post(unsigned* bar, volatile LAS unsigned* st) {
    XcdBarrier b; b.bar = bar; b.x = xb_xcc_id(); b.st = st;
    if (threadIdx.x == 0) (void)xb_add(&bar[XB_XCNT(b.x)], 1u);
    return b;
}
__device__ __forceinline__ void xcd_barrier_complete(unsigned* bar, unsigned x, unsigned& nloc, unsigned& nx) {
    const unsigned G = gridDim.x * gridDim.y * gridDim.z;
    unsigned sum, cnt, mine, sp = 0u;
    for (;;) {
        sum = 0u; cnt = 0u; mine = 0u;
#pragma unroll
        for (unsigned j = 0; j < 16; ++j) { const unsigned c = xb_ld(&bar[XB_XCNT(j)]); sum += c; cnt += (c > 0u) ? 1u : 0u; mine = (j == x) ? c : mine; }
        if (sum == G) break;
        __builtin_amdgcn_s_sleep(1);
        if ((++sp & 255u) == 0u) { if (xb_ld(&bar[XB_TMO])) break; if (sp > XB_SPIN_CAP) { atomicAdd(&bar[XB_TMO], 1u); break; } }
    }
    nloc = mine > 0u ? mine : 1u; nx = cnt > 0u ? cnt : 1u;
}
__device__ __forceinline__ void xcd_barrier(const XcdBarrier& b) {
    asm volatile("s_waitcnt vmcnt(0)" ::: "memory");
    __syncthreads();
    if (threadIdx.x == 0) {
        unsigned* bar = b.bar;
        __builtin_amdgcn_s_waitcnt(0);
        unsigned nloc = b.st[0], nx = b.st[1];
        if (nloc == 0u) { xcd_barrier_complete(bar, b.x, nloc, nx); b.st[0] = nloc; b.st[1] = nx; }
        const unsigned old = xb_add(&bar[XB_XSUB(b.x)], 1u);
        const unsigned gen = old / nloc;
        if (old + 1u == (gen + 1u) * nloc) {
            __builtin_amdgcn_fence(__ATOMIC_RELEASE, "agent");
            asm volatile("s_waitcnt vmcnt(0)" ::: "memory");
            const unsigned og = xb_add(&bar[XB_TOP], 1u);
            const unsigned tg = og / nx;
            if (og + 1u == (tg + 1u) * nx) xb_add(&bar[XB_TOPGEN], 1u);
            else XB_SPIN(xb_ld(&bar[XB_TOPGEN]) == tg, bar);
            __builtin_amdgcn_fence(__ATOMIC_ACQUIRE, "agent");
            xb_add(&bar[XB_XGEN(b.x)], 1u);
            asm volatile("s_waitcnt vmcnt(0)" ::: "memory");
        } else {
            XB_SPIN(xb_ld(&bar[XB_XGEN(b.x)]) == gen, bar);
            __builtin_amdgcn_fence(__ATOMIC_ACQUIRE, "agent");
            asm volatile("s_waitcnt vmcnt(0)" ::: "memory");
        }
    }
    __syncthreads();
}

constexpr int NPHASE = 10;
__global__ void __launch_bounds__(NTHR, 2) fwd_kernel(Params P) {
    extern __shared__ __attribute__((aligned(16))) unsigned char lds_raw[];
    LAS unsigned char* lds = (LAS unsigned char*)lds_raw;
    cg::grid_group grid = cg::this_grid();
    const int tid = threadIdx.x, lane = tid & 63, wave = __builtin_amdgcn_readfirstlane(tid >> 6);
    const int G = gridDim.x, bx = blockIdx.x;
    const int vcu = (G % 8 == 0) ? (bx % 8) * (G / 8) + bx / 8 : bx;
    const int gw = vcu * NWAVES + wave, NGW = G * NWAVES;
    unsigned char* ws = P.ws;
    const int lo = P.ph_lo, hi = P.ph_hi;
#ifndef PH_MASK
#define PH_MASK 0x3ff
#endif
#define IN(k) ((((PH_MASK) >> (k)) & 1) && lo <= (k) && (k) < hi)
    volatile LAS unsigned* xst = (volatile LAS unsigned*)(lds + LDS_XB);
    if (tid < 2) xst[tid] = 0u;
    __syncthreads();
    const XcdBarrier xbar = xcd_barrier_post((unsigned*)(ws + WS_CTL) + CW_BAR, xst);
#define SYNC(k) do { if (IN(k) && IN((k) + 1)) { if ((k) == 0) grid.sync(); else xcd_barrier(xbar); } } while (0)

    if (IN(0)) p0_prologue(P, lds, vcu, G, wave, lane);
    SYNC(0);
    if (IN(1)) {
        { pg8::DenseSched S; S.init((const bf16_t*)(ws + WS_XB), (const bf16_t*)(ws + WS_WIN), NTOK, 2048, 1024, G, bx);
          EpiInProj E{(const float*)(ws + WS_RS1), (const f32x2*)(ws + WS_ROPE), P.glu_b, (bf16_t*)(ws + WS_Q), (bf16_t*)(ws + WS_K), (bf16_t*)(ws + WS_V), (bf16_t*)(ws + WS_QI), (bf16_t*)(ws + WS_KI), (bf16_t*)(ws + WS_HGLU), (float*)(ws + WS_WI)};
          pg8::gemm_phase<EpiInProj, pg8::DenseSched, false>(lds, S, E); }
        { pg8::DenseSched S; S.init((const bf16_t*)(ws + WS_PB), (const bf16_t*)(ws + WS_WP), NTOK, 1024, 256, G, bx);
          EpiBf16Plain E{(bf16_t*)(ws + WS_PJ), 1024};
          pg8::gemm_phase<EpiBf16Plain, pg8::DenseSched, false>(lds, S, E); }
    }
    SYNC(1);
    if (IN(2)) {
        for (int i = tid; i < 4096; i += NTHR) ((LAS unsigned*)(lds + LDS_MISC))[i] = 0u;
        __syncthreads();
        if (G % 8 == 0) { const int b = bx % 8, jb = bx / 8, nbb = G / 8;
            for (int i = 0;; ++i) { const int k = i * nbb + ((i & 1) ? nbb - 1 - jb : jb); if (k >= 512) break; attn_tile(P, lds, b, (511 - k) * 8, wave, lane); } }
        else { for (int tl = bx; tl < 4096; tl += G) attn_tile(P, lds, tl & 7, (511 - (tl >> 3)) * 8, wave, lane); }
        for (int rp = 0; rp <= ((P.rep >> 3) & 1); ++rp)
        for (int tl = vcu; tl < NTOK / 32; tl += G) conv_tile(P, lds, tl, tid, wave, lane);
    }
    SYNC(2);
    if (IN(3)) {
        pg8::DenseSched S; S.init((const bf16_t*)(ws + WS_MIX), (const bf16_t*)(ws + WS_WOUT), NTOK, 1024, 1024, G, bx);
        EpiOutProj E{P.x, (float*)(ws + WS_H1), (unsigned char*)(ws + WS_H1F8)};
        pg8::gemm_phase<EpiOutProj, pg8::DenseSched, false>(lds, S, E);
    }
    SYNC(3);
    if (IN(4)) router_phase(P, lds, vcu, G, tid, wave, lane);
    SYNC(4);
    if (IN(5) || IN(6)) {
        LAS int* tb = (LAS int*)(lds + LDS_MISC); LAS int* cn = tb + 64;
        if (tid == 0) { const unsigned* cntg = (const unsigned*)(ws + WS_CTL) + CW_CNT; int acc = 0;
            for (int e = 0; e < NE; ++e) { const int c = (int)__hip_atomic_load(cntg + 64 * e, __ATOMIC_RELAXED, __HIP_MEMORY_SCOPE_AGENT); tb[e] = acc; cn[e] = c; acc += (c + BM - 1) / BM; }
            tb[NE] = acc; }
        __syncthreads();
        if (IN(5)) {
            pg8::MoeSched S; S.A = ws + WS_H1F8; S.Bt = ws + WS_WUP; S.rp = 1024; S.b_estride = (size_t)2048 * 1024; S.tb = tb; S.cnt = cn; S.list = (const int*)(ws + WS_LIST);
            S.nN = 8; S.nwg = tb[NE] * 8; S.G = G; S.c = bx; S.gather = true;
            EpiUp E{(const float*)(ws + WS_LSCALE), P.b_up, (unsigned char*)(ws + WS_ACT), tb};
            pg8::gemm_phase<EpiUp, pg8::MoeSched, true, true>(lds, S, E);
        }
        SYNC(5);
        if (IN(6)) {
            pg8::MoeSched S; S.A = ws + WS_ACT; S.Bt = ws + WS_WDOWN; S.rp = 1024; S.b_estride = (size_t)1024 * 1024; S.tb = tb; S.cnt = cn; S.list = (const int*)(ws + WS_LIST);
            S.nN = 4; S.nwg = tb[NE] * 4; S.G = G; S.c = bx; S.gather = false;
            EpiDown E{(const int*)(ws + WS_LIST), (const float*)(ws + WS_LGATE), P.b_down, (bf16_t*)(ws + WS_Y), tb};
            pg8::gemm_phase<EpiDown, pg8::MoeSched, true, true>(lds, S, E);
        }
    }
    SYNC(6);
    if (IN(7)) combine_phase(P, gw, NGW, lane);
    SYNC(7);
    if (IN(8)) {
        pg8::DenseSched S; S.init((const bf16_t*)(ws + WS_H1B), (const bf16_t*)(ws + WS_WG), NTOK, 1024, 1024, G, bx);
        EpiPle E{(const float*)(ws + WS_H1), (const bf16_t*)(ws + WS_PJ), (const float*)(ws + WS_RS3), P.out};
        pg8::gemm_phase<EpiPle, pg8::DenseSched, false>(lds, S, E);
    }
    SYNC(8);
    if (IN(9)) final_phase(P, gw, NGW, lane);
#undef IN
#undef SYNC
}

#ifndef N_LAUNCH_MODE
#define N_LAUNCH_MODE 1
#endif
extern "C" void kernel_launch(void* const* d_in, const int* in_sizes, int n_in, void* d_out, int out_size, void* d_ws, size_t ws_size, hipStream_t stream) {
    static int grid = 0;
    if (grid == 0) {
        if (n_in != 21 || out_size != NTOK * DM || ws_size < WS_END) { fprintf(stderr, "kernel_launch: unexpected shapes (n_in %d out %d ws %zu)\n", n_in, out_size, ws_size); grid = -1; return; }
        int dev = 0, cus = 0, per_cu = 0;
        (void)hipGetDevice(&dev); (void)hipDeviceGetAttribute(&cus, hipDeviceAttributeMultiprocessorCount, dev);
        (void)hipFuncSetAttribute((const void*)fwd_kernel, hipFuncAttributeMaxDynamicSharedMemorySize, LDS_BYTES);
        if (hipOccupancyMaxActiveBlocksPerMultiprocessor(&per_cu, (const void*)fwd_kernel, NTHR, LDS_BYTES) != hipSuccess || per_cu < 1) { fprintf(stderr, "kernel_launch: occupancy query failed (%d)\n", per_cu); (void)hipGetLastError(); grid = -1; return; }
        grid = cus;
    }
    if (grid < 0) return;
    (void)hipMemsetAsync((char*)d_ws + WS_CTL, 0, CTL_BYTES, stream);
    Params p{};
    p.x = (const float*)d_in[0]; p.p = (const float*)d_in[1]; p.w_in = (const float*)d_in[2]; p.w_out = (const float*)d_in[3]; p.g_mix = (const float*)d_in[4]; p.g_ffn = (const float*)d_in[5];
    p.glu_b = (const float*)d_in[6]; p.dw_w = (const float*)d_in[7]; p.dw_b = (const float*)d_in[8]; p.ln_g = (const float*)d_in[9]; p.ln_b = (const float*)d_in[10];
    p.w_router = (const float*)d_in[11]; p.b_router = (const float*)d_in[12]; p.w_up = (const float*)d_in[13]; p.b_up = (const float*)d_in[14]; p.w_down = (const float*)d_in[15]; p.b_down = (const float*)d_in[16];
    p.w_ple_proj = (const float*)d_in[17]; p.w_ple_gate = (const float*)d_in[18]; p.g_ple = (const float*)d_in[19]; p.g_final = (const float*)d_in[20];
    p.out = (float*)d_out; p.ws = (unsigned char*)d_ws;
#ifndef PROBE_REPMASK
#define PROBE_REPMASK 0
#endif
    p.rep = PROBE_REPMASK;
#if N_LAUNCH_MODE == 1
    p.ph_lo = 0; p.ph_hi = NPHASE;
    void* args[] = {&p};
    hipError_t e = hipLaunchCooperativeKernel((const void*)fwd_kernel, dim3(grid), dim3(NTHR), args, LDS_BYTES, stream);
    if (e != hipSuccess) fprintf(stderr, "cooperative launch failed: %s (grid %d)\n", hipGetErrorString(e), grid);
#else
    for (int ph = 0; ph < NPHASE; ++ph) {
        p.ph_lo = ph; p.ph_hi = ph + 1;
        void* args[] = {&p};
        hipError_t e = hipLaunchCooperativeKernel((const void*)fwd_kernel, dim3(grid), dim3(NTHR), args, LDS_BYTES, stream);
        if (e != hipSuccess) { fprintf(stderr, "launch %d failed: %s (grid %d)\n", ph, hipGetErrorString(e), grid); break; }
    }
#endif
}
```

```cpp
#include <hip/hip_runtime.h>
#include <hip/hip_cooperative_groups.h>
#include <cstdio>
#include <cstdint>
namespace cg = cooperative_groups;

#define LAS __attribute__((address_space(3)))
#define GAS __attribute__((address_space(1)))
typedef unsigned short bf16_t;
typedef short bf16x8 __attribute__((ext_vector_type(8)));
typedef short s16x4 __attribute__((ext_vector_type(4)));
typedef float f32x4 __attribute__((ext_vector_type(4)));
typedef float f32x2 __attribute__((ext_vector_type(2)));
typedef float f32x16 __attribute__((ext_vector_type(16)));
typedef unsigned u32x4 __attribute__((ext_vector_type(4)));
typedef unsigned u32x2 __attribute__((ext_vector_type(2)));

constexpr int NB = 8, SEQ = 4096, DM = 1024, NTOK = NB * SEQ;
constexpr int NE = 32, TOPK = 4, NSLOT = NTOK * TOPK;
constexpr int INW = 1988;
constexpr int NSEL = 256;
constexpr float EPS = 1e-6f;
constexpr int NWAVES = 8, NTHR = 512;

constexpr size_t MiB = 1u << 20;
constexpr size_t WS_CTL = 0, CTL_BYTES = 64 * 1024;
constexpr size_t WS_ROPE = 1 * MiB;
constexpr size_t WS_WIN = 2 * MiB;
constexpr size_t WS_WOUT = 6 * MiB;
constexpr size_t WS_WG = 8 * MiB;
constexpr size_t WS_WP = 10 * MiB;
constexpr size_t WS_WRG = 10 * MiB + 512 * 1024;
constexpr size_t WS_RS1 = 11 * MiB;
constexpr size_t WS_RS3 = 11 * MiB + 512 * 1024;
constexpr size_t WS_WI = 12 * MiB;
constexpr size_t WS_LIST = 13 * MiB;
constexpr size_t WS_LSCALE = 17 * MiB;
constexpr size_t WS_LGATE = 21 * MiB;
constexpr size_t WS_PB = 25 * MiB;
constexpr size_t WS_WUP = 42 * MiB;
constexpr size_t WS_WDOWN = 170 * MiB;
constexpr size_t WS_H1 = 234 * MiB;
constexpr size_t WS_H1B = 362 * MiB;
constexpr size_t WS_PJ = 426 * MiB;
constexpr size_t WS_XB = 490 * MiB;
constexpr size_t WS_Q = 554 * MiB;
constexpr size_t WS_K = 586 * MiB;
constexpr size_t WS_V = 590 * MiB;
constexpr size_t WS_QI = 594 * MiB;
constexpr size_t WS_KI = 610 * MiB;
constexpr size_t WS_HGLU = 614 * MiB;
constexpr size_t WS_MIX = 646 * MiB;
constexpr size_t WS_H1F8 = 490 * MiB;
constexpr size_t WS_ACT = 522 * MiB;
constexpr size_t WS_Y = 762 * MiB;
constexpr size_t WS_END = 1018 * MiB;
static_assert(WS_H1F8 + (size_t)NTOK * 1024 <= WS_ACT && WS_ACT + (size_t)139264 * 1024 <= WS_Y, "ws map");
constexpr int CW_CNT = 1024;
constexpr int CW_BAR = 8192;

constexpr int LDS_STAGE = 131072;
constexpr int LDS_MISC = LDS_STAGE;
constexpr int LDS_XB = 147456;
constexpr int LDS_BYTES = 147456 + 256;

__device__ __forceinline__ unsigned f2bf(float f) { unsigned u = __builtin_bit_cast(unsigned, f); return (u + 0x7fffu + ((u >> 16) & 1u)) >> 16; }
__device__ __forceinline__ unsigned pk2(float lo, float hi) { return f2bf(lo) | (f2bf(hi) << 16); }
__device__ __forceinline__ float bf_lo(unsigned w) { return __builtin_bit_cast(float, w << 16); }
__device__ __forceinline__ float bf_hi(unsigned w) { return __builtin_bit_cast(float, w & 0xffff0000u); }
__device__ __forceinline__ float wave_sum(float v) {
    v += __builtin_bit_cast(float, __builtin_amdgcn_update_dpp(0, __builtin_bit_cast(int, v), 0xB1, 0xF, 0xF, true));
    v += __builtin_bit_cast(float, __builtin_amdgcn_update_dpp(0, __builtin_bit_cast(int, v), 0x4E, 0xF, 0xF, true));
    v += __builtin_bit_cast(float, __builtin_amdgcn_update_dpp(0, __builtin_bit_cast(int, v), 0x141, 0xF, 0xF, true));
    v += __builtin_bit_cast(float, __builtin_amdgcn_update_dpp(0, __builtin_bit_cast(int, v), 0x140, 0xF, 0xF, true));
    const int vi = __builtin_bit_cast(int, v);
    const float r0 = __builtin_bit_cast(float, __builtin_amdgcn_readlane(vi, 0)), r1 = __builtin_bit_cast(float, __builtin_amdgcn_readlane(vi, 16));
    const float r2 = __builtin_bit_cast(float, __builtin_amdgcn_readlane(vi, 32)), r3 = __builtin_bit_cast(float, __builtin_amdgcn_readlane(vi, 48));
    return (r0 + r1) + (r2 + r3);
}
__device__ __forceinline__ unsigned pk4_fp8(float a, float b, float c, float d) { int r = __builtin_amdgcn_cvt_pk_fp8_f32(a, b, 0, false); r = __builtin_amdgcn_cvt_pk_fp8_f32(c, d, r, true); return (unsigned)r; }
__device__ __forceinline__ float sigmoidf_(float x) { return 1.0f / (1.0f + __expf(-x)); }
#define LDS_WAIT() asm volatile("s_waitcnt lgkmcnt(0)" ::: "memory")

struct Params {
    const float* x; const float* p; const float* w_in; const float* w_out; const float* g_mix; const float* g_ffn;
    const float* glu_b; const float* dw_w; const float* dw_b; const float* ln_g; const float* ln_b;
    const float* w_router; const float* b_router; const float* w_up; const float* b_up; const float* w_down; const float* b_down;
    const float* w_ple_proj; const float* w_ple_gate; const float* g_ple; const float* g_final;
    float* out; unsigned char* ws;
    int ph_lo, ph_hi, rep, pad;
};

namespace pg8 {
constexpr int BM = 256, BK = 64, HALF = 128, HTB = HALF * BK * 2, STAGE_BYTES = 8 * HTB, NXCD = 8, WGM = 8;
__host__ __device__ __forceinline__ int lds_byte(int r, int c) { const int st = (r >> 4) * 2 + (c >> 5), rr = r & 15, cc = c & 31, ob = rr * 64 + cc * 2; return st * 1024 + (ob ^ (((ob >> 9) & 1) << 5)); }
__host__ __device__ __forceinline__ void stage_rc(int b, int& R, int& C) { const int st = b / 1024, sb = b % 1024, swz = sb ^ (((sb >> 9) & 1) << 5); R = (st >> 1) * 16 + swz / 64; C = (st & 1) * 32 + (swz % 64) / 2; }
__host__ __device__ __forceinline__ int perm32(int rho) { const int n = rho >> 4, i = rho & 15; return 8 * (i >> 2) + 4 * n + (i & 3); }

struct Unit { int pm, pn, e, rows; };

__device__ __forceinline__ unsigned cvt_pk_bf16(float lo, float hi) { unsigned r; asm volatile("v_cvt_pk_bf16_f32 %0, %1, %2" : "=v"(r) : "v"(lo), "v"(hi)); return r; }

struct DenseSched {
    const void* A; const void* Bt; int rp;
    int nM, nN, nwg, G, c;
    __device__ void init(const void* A_, const void* Bt_, int M, int N, int K_, int G_, int c_) { A = A_; Bt = Bt_; rp = K_ * 2; nM = M / BM; nN = N / BM; nwg = nM * nN; G = G_; c = c_; }
    __device__ bool next(int i, Unit& u) const {
        const long L = (long)i * G + c; if (L >= nwg) return false;
        int wgid = (int)L; { const int q = nwg / NXCD, r = nwg % NXCD, xcd = wgid % NXCD, off = wgid / NXCD; wgid = (xcd < r ? xcd * (q + 1) : r * (q + 1) + (xcd - r) * q) + off; }
        const int nig = WGM * nN, gid = wgid / nig, fm = gid * WGM, gsz = (nM - fm) < WGM ? (nM - fm) : WGM;
        u.pm = fm + ((wgid % nig) % gsz); u.pn = (wgid % nig) / gsz; u.e = 0; u.rows = BM; return true;
    }
    __device__ __forceinline__ const char* a_ptr(const Unit& u) const { return (const char*)A + (size_t)u.pm * BM * rp; }
    __device__ __forceinline__ const char* b_ptr(const Unit& u) const { return (const char*)Bt + (size_t)u.pn * BM * rp; }
    __device__ __forceinline__ int a_row(const Unit&, int) const { return 0; }
};

struct MoeSched {
    const void* A; const void* Bt; int rp; size_t b_estride;
    const LAS int* tb;
    const LAS int* cnt;
    const int* list;
    int nN, nwg, G, c; bool gather;
    __device__ bool next(int i, Unit& u) const {
        const long L = (long)i * G + c; if (L >= nwg) return false;
        int wgid = (int)L; { const int q = nwg / NXCD, r = nwg % NXCD, xcd = wgid % NXCD, off = wgid / NXCD; wgid = (xcd < r ? xcd * (q + 1) : r * (q + 1) + (xcd - r) * q) + off; }
        int e = 0;
#pragma unroll 1
        for (; e < NE - 1; ++e) { if (wgid < tb[e + 1] * nN) break; }
        const int local = wgid - tb[e] * nN, nM = tb[e + 1] - tb[e];
        const int nig = WGM * nN, gid = local / nig, fm = gid * WGM, gsz = (nM - fm) < WGM ? (nM - fm) : WGM;
        const int rt = fm + ((local % nig) % gsz);
        u.pm = tb[e] + rt; u.pn = (local % nig) / gsz; u.e = e;
        const int left = cnt[e] - rt * BM; u.rows = left < BM ? left : BM; return true;
    }
    __device__ __forceinline__ const char* a_ptr(const Unit& u) const { return (const char*)A; }
    __device__ __forceinline__ const char* b_ptr(const Unit& u) const { return (const char*)Bt + (size_t)u.e * b_estride + (size_t)u.pn * BM * rp; }
    __device__ __forceinline__ int a_row(const Unit& u, int r) const {
        if (!gather) return u.pm * BM + r;
        const int rt = u.pm - tb[u.e];
        return r < u.rows ? (list[u.e * NTOK + rt * BM + r] >> 2) : 0;
    }
};

typedef int v8i32 __attribute__((ext_vector_type(8)));
template <class Epi, class Sched, bool GATHER, bool F8 = false>
__device__ __forceinline__ void gemm_phase(LAS unsigned char* lds, const Sched& S, const Epi& E) {
    const int tid = threadIdx.x, wid = __builtin_amdgcn_readfirstlane(tid >> 6), lane = tid & 63, wr = wid >> 2, wc = wid & 3, fr = lane & 15, fq = lane >> 4;
    const int RP = S.rp, nt = RP / (BK * 2);
    unsigned voffA[2], voffB[2]; int RA[2], CA[2];
#pragma unroll
    for (int i = 0; i < 2; ++i) { int R, C; stage_rc(tid * 16 + i * 8192, R, C); const int Rb = Epi::PERM ? ((R & ~31) + perm32(R & 31)) : R;
        voffA[i] = (unsigned)(R * RP + C * 2); voffB[i] = (unsigned)(Rb * RP + C * 2); RA[i] = R; CA[i] = C; }
    const size_t kstep = (size_t)(BK * 2);
    const size_t hstep = (size_t)HALF * RP;
    const unsigned ldsw = (unsigned)wid * 1024u;
    const int aoff = lds_byte(wr * 64 + fr, fq * 8), boff = lds_byte(wc * 32 + fr, fq * 8);
    unsigned gC[2][2], gN[2][2];
#define PG8_SA(b, h) (((b) * 2 + (h)) * HTB)
#define PG8_SB(b, h) ((4 + (b) * 2 + (h)) * HTB)
#define PG8_STAGE(bufoff, gbase, voff) do { _Pragma("unroll") for (int _i = 0; _i < 2; ++_i) \
        __builtin_amdgcn_global_load_lds((const unsigned*)((const char*)(gbase) + (voff)[_i]), (LAS unsigned*)(lds + (bufoff) + ldsw + _i * 8192), 16, 0, 0); } while (0)
#define PG8_STAGE_A(bufoff, kp, h) do { if constexpr (GATHER) { PG8_STAGE(bufoff, kp, gC[h]); } else { PG8_STAGE(bufoff, (kp) + (h) * hstep, voffA); } } while (0)
#define PG8_LD16(p) (*(const LAS bf16x8*)(p))
#define PG8_CAT(lo, hi) __builtin_bit_cast(v8i32, __builtin_shufflevector(lo, hi, 0, 1, 2, 3, 4, 5, 6, 7, 8, 9, 10, 11, 12, 13, 14, 15))
#define PG8_LDA(dst, b, h) do { _Pragma("unroll") for (int m = 0; m < 4; ++m) { if constexpr (F8) { dst##8[m] = PG8_CAT(PG8_LD16(lds + PG8_SA(b, h) + aoff + m * 2048), PG8_LD16(lds + PG8_SA(b, h) + aoff + m * 2048 + 1024)); } \
        else { _Pragma("unroll") for (int k = 0; k < 2; ++k) dst[m][k] = PG8_LD16(lds + PG8_SA(b, h) + aoff + m * 2048 + k * 1024); } } } while (0)
#define PG8_LDB(dst, b, h) do { _Pragma("unroll") for (int n = 0; n < 2; ++n) { if constexpr (F8) { dst##8[n] = PG8_CAT(PG8_LD16(lds + PG8_SB(b, h) + boff + n * 2048), PG8_LD16(lds + PG8_SB(b, h) + boff + n * 2048 + 1024)); } \
        else { _Pragma("unroll") for (int k = 0; k < 2; ++k) dst[n][k] = PG8_LD16(lds + PG8_SB(b, h) + boff + n * 2048 + k * 1024); } } } while (0)
#define PG8_MMA(ai, bj, At, Bt) do { __builtin_amdgcn_s_setprio(1); _Pragma("unroll") for (int m = 0; m < 4; ++m) _Pragma("unroll") for (int n = 0; n < 2; ++n) { \
        if constexpr (F8) { acc[ai][bj][m][n] = __builtin_amdgcn_mfma_scale_f32_16x16x128_f8f6f4(Bt##8[n], At##8[m], acc[ai][bj][m][n], 0, 0, 0, 0x7f7f7f7f, 0, 0x7f7f7f7f); } \
        else { _Pragma("unroll") for (int k = 0; k < 2; ++k) acc[ai][bj][m][n] = __builtin_amdgcn_mfma_f32_16x16x32_bf16(Bt[n][k], At[m][k], acc[ai][bj][m][n], 0, 0, 0); } } \
        __builtin_amdgcn_s_setprio(0); } while (0)
#define PG8_WAIT_V(n) asm volatile("s_waitcnt vmcnt(" #n ")" ::: "memory")
#define PG8_WAIT_L(n) asm volatile("s_waitcnt lgkmcnt(" #n ")" ::: "memory")
#define PG8_BAR __builtin_amdgcn_s_barrier()
#define PG8_SCHED __builtin_amdgcn_sched_barrier(0)
#define PG8_GOFF(dst, u) do { _Pragma("unroll") for (int _h = 0; _h < 2; ++_h) _Pragma("unroll") for (int _i = 0; _i < 2; ++_i) \
        dst[_h][_i] = (unsigned)(S.a_row(u, _h * HALF + RA[_i]) * RP + CA[_i] * 2); } while (0)
    Unit cur, nxt, nn; int ui = 0;
    if (!S.next(0, cur)) return;
    bool has_next = S.next(1, nxt);
    if constexpr (GATHER) { PG8_GOFF(gC, cur); if (has_next) { PG8_GOFF(gN, nxt); } else { PG8_GOFF(gN, cur); } }
    f32x4 acc[2][2][4][2];
#pragma unroll
    for (int a = 0; a < 2; ++a)
#pragma unroll
        for (int b = 0; b < 2; ++b)
#pragma unroll
            for (int m = 0; m < 4; ++m)
#pragma unroll
                for (int n = 0; n < 2; ++n) acc[a][b][m][n] = (f32x4){0.f, 0.f, 0.f, 0.f};
    bf16x8 At[4][2], B0[2][2], B1[2][2]; v8i32 At8[4], B08[2], B18[2];
    const char* cA = S.a_ptr(cur); const char* cB = S.b_ptr(cur);
    PG8_STAGE(PG8_SB(0, 0), cB, voffB); PG8_STAGE(PG8_SB(0, 1), cB + hstep, voffB); PG8_STAGE_A(PG8_SA(0, 0), cA, 0); PG8_STAGE_A(PG8_SA(0, 1), cA, 1);
    if (wr == 1) PG8_BAR;
    PG8_WAIT_V(2); PG8_BAR;
    PG8_STAGE(PG8_SB(1, 0), cB + kstep, voffB); PG8_STAGE_A(PG8_SA(1, 0), cA + kstep, 0); PG8_STAGE(PG8_SB(1, 1), cB + hstep + kstep, voffB);
    PG8_WAIT_V(6); PG8_BAR;
    for (;;) {
        const char* nA = has_next ? S.a_ptr(nxt) : cA; const char* nB = has_next ? S.b_ptr(nxt) : cB;
        for (int t = 0; t < nt; t += 2) {
            const bool last = (t == nt - 2);
            const char* a1 = cA + (size_t)(t + 1) * kstep;
            const char* a2 = last ? nA : cA + (size_t)(t + 2) * kstep; const char* b2 = last ? nB : cB + (size_t)(t + 2) * kstep;
            const char* a3 = a2 + kstep; const char* b3 = b2 + kstep;
            PG8_LDB(B0, 0, 0); PG8_LDB(B1, 0, 1); PG8_SCHED; PG8_LDA(At, 0, 0); PG8_STAGE_A(PG8_SA(1, 1), a1, 1);
            if constexpr (GATHER) { if (last) {
#pragma unroll
                for (int h = 0; h < 2; ++h)
#pragma unroll
                    for (int i = 0; i < 2; ++i) gC[h][i] = gN[h][i]; } }
            PG8_WAIT_V(8); PG8_WAIT_L(0); PG8_BAR; PG8_MMA(0, 0, At, B0); PG8_MMA(0, 1, At, B1); PG8_BAR; PG8_SCHED;
            PG8_LDA(At, 0, 1); PG8_STAGE(PG8_SB(0, 0), b2, voffB); PG8_STAGE(PG8_SB(0, 1), b2 + hstep, voffB); PG8_STAGE_A(PG8_SA(0, 0), a2, 0);
            PG8_WAIT_V(8); PG8_WAIT_L(0); PG8_BAR; PG8_MMA(1, 0, At, B0); PG8_MMA(1, 1, At, B1); PG8_BAR; PG8_SCHED;
            PG8_LDB(B0, 1, 0); PG8_LDB(B1, 1, 1); PG8_SCHED; PG8_LDA(At, 1, 0); PG8_STAGE_A(PG8_SA(0, 1), a2, 1);
            PG8_WAIT_V(8); PG8_WAIT_L(0); PG8_BAR; PG8_MMA(0, 0, At, B0); PG8_MMA(0, 1, At, B1); PG8_BAR; PG8_SCHED;
            PG8_LDA(At, 1, 1); PG8_STAGE(PG8_SB(1, 0), b3, voffB); PG8_STAGE(PG8_SB(1, 1), b3 + hstep, voffB); PG8_STAGE_A(PG8_SA(1, 0), a3, 0);
            PG8_WAIT_V(8); PG8_WAIT_L(0); PG8_BAR; PG8_MMA(1, 0, At, B0); PG8_MMA(1, 1, At, B1); PG8_BAR; PG8_SCHED;
        }
        if (wr == 0) PG8_BAR;
        bool has_nn = false;
        if constexpr (GATHER) { if (has_next) { has_nn = S.next(ui + 2, nn); if (has_nn) { PG8_GOFF(gN, nn); } } }
        else { if (has_next) has_nn = S.next(ui + 2, nn); }
        { int fr_ = fr, fq_ = fq; asm volatile("" : "+v"(fr_), "+v"(fq_));
          E(acc, cur, wr, wc, fr_, fq_); }
        if (!has_next) break;
#pragma unroll
        for (int a = 0; a < 2; ++a)
#pragma unroll
            for (int b = 0; b < 2; ++b)
#pragma unroll
                for (int m = 0; m < 4; ++m)
#pragma unroll
                    for (int n = 0; n < 2; ++n) acc[a][b][m][n] = (f32x4){0.f, 0.f, 0.f, 0.f};
        cur = nxt; cA = nA; cB = nB; ++ui; nxt = nn; has_next = has_nn;
        if (wr == 1) PG8_BAR;
    }
    PG8_WAIT_V(0);
    PG8_BAR;
#undef PG8_SA
#undef PG8_SB
#undef PG8_STAGE
#undef PG8_STAGE_A
#undef PG8_LDA
#undef PG8_LDB
#undef PG8_MMA
#undef PG8_LD16
#undef PG8_CAT
#undef PG8_WAIT_V
#undef PG8_WAIT_L
#undef PG8_BAR
#undef PG8_SCHED
#undef PG8_GOFF
}
}

using pg8::Unit; using pg8::cvt_pk_bf16;
constexpr int BM = 256, HALF = 128;

struct EpiInProj {
    static constexpr bool PERM = true;
    const float* rs1; const f32x2* rope; const float* glu_b;
    bf16_t *q, *k, *v, *qi, *ki, *hglu; float* wi;
    __device__ __forceinline__ void operator()(const f32x4 (&acc)[2][2][4][2], const Unit& u, int wr, int wc, int fr, int fq) const {
        const int row0 = u.pm * BM + wr * 64 + fr;
        if (u.pn >= 4) {
            const int ch = 128 * (u.pn - 4) + 32 * wc + 8 * fq;
            f32x4 ba[2], bg[2];
#pragma unroll
            for (int n = 0; n < 2; ++n) { ba[n] = *(const f32x4*)(glu_b + ch + 4 * n); bg[n] = *(const f32x4*)(glu_b + 512 + ch + 4 * n); }
#pragma unroll
            for (int ai = 0; ai < 2; ++ai)
#pragma unroll
                for (int m = 0; m < 4; ++m) { const int row = row0 + ai * HALF + m * 16; const float rs = rs1[row];
                    float o[8];
#pragma unroll
                    for (int n = 0; n < 2; ++n)
#pragma unroll
                        for (int e = 0; e < 4; ++e) { const float a = acc[ai][0][m][n][e] * rs + ba[n][e], g = acc[ai][1][m][n][e] * rs + bg[n][e]; o[4 * n + e] = a * sigmoidf_(g); }
                    u32x4 w; w.x = cvt_pk_bf16(o[0], o[1]); w.y = cvt_pk_bf16(o[2], o[3]); w.z = cvt_pk_bf16(o[4], o[5]); w.w = cvt_pk_bf16(o[6], o[7]);
                    *(u32x4*)(hglu + (size_t)row * 512 + ch) = w; }
            return;
        }
        bf16_t* dst; int ld, col; bool do_rope = true, is_wi = false;
        if (u.pn < 2) { dst = q; ld = 512; col = (4 * u.pn + wc) * 64; }
        else if (u.pn == 2) { dst = qi; ld = 256; col = wc * 64; }
        else { ld = 64; col = 0; if (wc == 0) dst = k; else if (wc == 1) dst = ki; else if (wc == 2) { dst = v; do_rope = false; } else { dst = v; is_wi = true; do_rope = false; } }
        if (is_wi) {
            if (fq == 0) {
#pragma unroll
                for (int ai = 0; ai < 2; ++ai)
#pragma unroll
                    for (int m = 0; m < 4; ++m) { const int row = row0 + ai * HALF + m * 16; const float rs = rs1[row];
                        *(f32x4*)(wi + (size_t)row * 4) = acc[ai][0][m][0] * rs; }
            }
            return;
        }
        const int d0 = 8 * fq;
#pragma unroll
        for (int ai = 0; ai < 2; ++ai)
#pragma unroll
            for (int m = 0; m < 4; ++m) { const int row = row0 + ai * HALF + m * 16; const float rs = rs1[row];
                float o1[8], o2[8];
                if (do_rope) {
                    const f32x2* rp = rope + (size_t)(row & (SEQ - 1)) * 32 + d0;
#pragma unroll
                    for (int n = 0; n < 2; ++n)
#pragma unroll
                        for (int e = 0; e < 4; ++e) { const f32x2 cs = rp[4 * n + e]; const float x1 = acc[ai][0][m][n][e] * rs, x2 = acc[ai][1][m][n][e] * rs;
                            o1[4 * n + e] = x1 * cs.x - x2 * cs.y; o2[4 * n + e] = x2 * cs.x + x1 * cs.y; }
                } else {
#pragma unroll
                    for (int n = 0; n < 2; ++n)
#pragma unroll
                        for (int e = 0; e < 4; ++e) { o1[4 * n + e] = acc[ai][0][m][n][e] * rs; o2[4 * n + e] = acc[ai][1][m][n][e] * rs; }
                }
                u32x4 w1, w2; w1.x = cvt_pk_bf16(o1[0], o1[1]); w1.y = cvt_pk_bf16(o1[2], o1[3]); w1.z = cvt_pk_bf16(o1[4], o1[5]); w1.w = cvt_pk_bf16(o1[6], o1[7]);
                w2.x = cvt_pk_bf16(o2[0], o2[1]); w2.y = cvt_pk_bf16(o2[2], o2[3]); w2.z = cvt_pk_bf16(o2[4], o2[5]); w2.w = cvt_pk_bf16(o2[6], o2[7]);
                bf16_t* rp2 = dst + (size_t)row * ld + col + d0;
                *(u32x4*)(rp2) = w1; *(u32x4*)(rp2 + 32) = w2; }
    }
};

struct EpiBf16Plain {
    static constexpr bool PERM = true;
    bf16_t* O; int ldc;
    __device__ __forceinline__ void operator()(const f32x4 (&acc)[2][2][4][2], const Unit& u, int wr, int wc, int fr, int fq) const {
        const int row0 = u.pm * BM + wr * 64 + fr, col0 = u.pn * BM + wc * 32 + 8 * fq;
#pragma unroll
        for (int ai = 0; ai < 2; ++ai)
#pragma unroll
            for (int m = 0; m < 4; ++m) { bf16_t* rowp = O + (size_t)(row0 + ai * HALF + m * 16) * ldc + col0;
#pragma unroll
                for (int bj = 0; bj < 2; ++bj) { const f32x4 v0 = acc[ai][bj][m][0], v1 = acc[ai][bj][m][1];
                    u32x4 w; w.x = cvt_pk_bf16(v0[0], v0[1]); w.y = cvt_pk_bf16(v0[2], v0[3]); w.z = cvt_pk_bf16(v1[0], v1[1]); w.w = cvt_pk_bf16(v1[2], v1[3]);
                    *(u32x4*)(rowp + bj * HALF) = w; } }
    }
};

struct EpiOutProj {
    static constexpr bool PERM = false;
    const float* x; float* h1; unsigned char* h1f8;
    __device__ __forceinline__ void operator()(const f32x4 (&acc)[2][2][4][2], const Unit& u, int wr, int wc, int fr, int fq) const {
        const int row0 = u.pm * BM + wr * 64 + fr, col0 = u.pn * BM + wc * 32 + 4 * fq;
#pragma unroll
        for (int ai = 0; ai < 2; ++ai)
#pragma unroll
            for (int m = 0; m < 4; ++m) { const size_t off = (size_t)(row0 + ai * HALF + m * 16) * DM + col0;
#pragma unroll
                for (int bj = 0; bj < 2; ++bj)
#pragma unroll
                    for (int n = 0; n < 2; ++n) { const size_t o = off + bj * HALF + n * 16; const f32x4 r = *(const f32x4*)(x + o) + acc[ai][bj][m][n];
                        *(f32x4*)(h1 + o) = r; *(unsigned*)(h1f8 + o) = pk4_fp8(r[0], r[1], r[2], r[3]); } }
    }
};

struct EpiUp {
    static constexpr bool PERM = true;
    const float* lscale; const float* b_up; unsigned char* act; const LAS int* tb;
    __device__ __forceinline__ void operator()(const f32x4 (&acc)[2][2][4][2], const Unit& u, int wr, int wc, int fr, int fq) const {
        const int r0 = wr * 64 + fr, ch = 128 * u.pn + 32 * wc + 8 * fq, rt = u.pm - tb[u.e];
        const float* bu = b_up + (size_t)u.e * 2048;
        f32x4 bg[2], bl[2];
#pragma unroll
        for (int n = 0; n < 2; ++n) { bg[n] = *(const f32x4*)(bu + ch + 4 * n); bl[n] = *(const f32x4*)(bu + 1024 + ch + 4 * n); }
#pragma unroll
        for (int ai = 0; ai < 2; ++ai)
#pragma unroll
            for (int m = 0; m < 4; ++m) { const int r = r0 + ai * HALF + m * 16;
                const float rs = (r < u.rows) ? lscale[u.e * NTOK + rt * BM + r] * 0.03125f : 0.f;
                float o[8];
#pragma unroll
                for (int n = 0; n < 2; ++n)
#pragma unroll
                    for (int e = 0; e < 4; ++e) { float g = acc[ai][0][m][n][e] * rs + bg[n][e], l = acc[ai][1][m][n][e] * rs + bl[n][e];
                        g = fminf(g, 7.0f); l = fminf(fmaxf(l, -7.0f), 7.0f); o[4 * n + e] = g * sigmoidf_(1.702f * g) * (l + 1.0f); }
                u32x2 w; w.x = pk4_fp8(o[0], o[1], o[2], o[3]); w.y = pk4_fp8(o[4], o[5], o[6], o[7]);
                *(u32x2*)(act + (size_t)(u.pm * BM + r) * 1024 + ch) = w; }
    }
};

struct EpiDown {
    static constexpr bool PERM = true;
    const int* list; const float* lgate; const float* b_down; bf16_t* y; const LAS int* tb;
    __device__ __forceinline__ void operator()(f32x4 (&acc)[2][2][4][2], const Unit& u, int wr, int wc, int fr, int fq) const {
        const int r0 = wr * 64 + fr, col0 = u.pn * BM + wc * 32 + 8 * fq, rt = u.pm - tb[u.e];
        const float* bd = b_down + (size_t)u.e * 1024;
#pragma unroll
        for (int bj = 0; bj < 2; ++bj)
#pragma unroll
            for (int n = 0; n < 2; ++n) { const f32x4 bv = *(const f32x4*)(bd + col0 + bj * HALF + 4 * n);
#pragma unroll
                for (int ai = 0; ai < 2; ++ai)
#pragma unroll
                    for (int m = 0; m < 4; ++m) acc[ai][bj][m][n] = acc[ai][bj][m][n] * 0.03125f + bv; }
#pragma unroll
        for (int ai = 0; ai < 2; ++ai)
#pragma unroll
            for (int m = 0; m < 4; ++m) { const int r = r0 + ai * HALF + m * 16;
                if (r < u.rows) { const int li = u.e * NTOK + rt * BM + r; const int slot = list[li]; const float g = lgate[li];
                    bf16_t* rowp = y + (size_t)slot * 1024 + col0;
#pragma unroll
                    for (int bj = 0; bj < 2; ++bj) { const f32x4 v0 = acc[ai][bj][m][0] * g, v1 = acc[ai][bj][m][1] * g;
                        u32x4 w; w.x = cvt_pk_bf16(v0[0], v0[1]); w.y = cvt_pk_bf16(v0[2], v0[3]); w.z = cvt_pk_bf16(v1[0], v1[1]); w.w = cvt_pk_bf16(v1[2], v1[3]);
                        *(u32x4*)(rowp + bj * HALF) = w; } } }
    }
};

struct EpiPle {
    static constexpr bool PERM = false;
    const bf16_t* h2b; const bf16_t* pj; const float* rs3; float* out;
    __device__ __forceinline__ void operator()(const f32x4 (&acc)[2][2][4][2], const Unit& u, int wr, int wc, int fr, int fq) const {
        const int row0 = u.pm * BM + wr * 64 + fr, col0 = u.pn * BM + wc * 32 + 4 * fq;
#pragma unroll
        for (int ai = 0; ai < 2; ++ai)
#pragma unroll
            for (int m = 0; m < 4; ++m) { const int row = row0 + ai * HALF + m * 16; const size_t off = (size_t)row * DM + col0; const float rs = rs3[row];
#pragma unroll
                for (int bj = 0; bj < 2; ++bj)
#pragma unroll
                    for (int n = 0; n < 2; ++n) { const size_t o = off + bj * HALF + n * 16; const u32x2 hw = *(const u32x2*)(h2b + o); const f32x4 hv = {bf_lo(hw.x), bf_hi(hw.x), bf_lo(hw.y), bf_hi(hw.y)}; const u32x2 pw = *(const u32x2*)(pj + o);
                        const f32x4 a = acc[ai][bj][m][n]; f32x4 r;
                        r[0] = hv[0] + bf_lo(pw.x) * sigmoidf_(a[0] * rs); r[1] = hv[1] + bf_hi(pw.x) * sigmoidf_(a[1] * rs);
                        r[2] = hv[2] + bf_lo(pw.y) * sigmoidf_(a[2] * rs); r[3] = hv[3] + bf_hi(pw.y) * sigmoidf_(a[3] * rs);
                        *(f32x4*)(out + o) = r; } }
    }
};

template <bool F8>
__device__ __forceinline__ void p0_transpose_item(const float* W, int ldw, void* WTv, int Kdim, const float* gain, LAS float* scr, int kb, int n0, int src0, int nvalid, int lane) {
    bf16_t* WT = (bf16_t*)WTv;
    const int k0 = 64 * kb;
    f32x4 ld4[8];
#pragma unroll
    for (int i = 0; i < 8; ++i) { const int kk = 8 * i + (lane >> 3), j = (lane & 7) * 4;
        ld4[i] = (f32x4){0.f, 0.f, 0.f, 0.f}; if (j < nvalid) ld4[i] = *(const f32x4*)(W + (size_t)(k0 + kk) * ldw + src0 + j); }
#pragma unroll
    for (int i = 0; i < 8; ++i) { const int kk = 8 * i + (lane >> 3), j = (lane & 7) * 4; const float gk = (gain ? gain[k0 + kk] : 1.0f) * (F8 ? 32.0f : 1.0f);
        LAS float* d = scr + kk * 33 + j; d[0] = ld4[i].x * gk; d[1] = ld4[i].y * gk; d[2] = ld4[i].z * gk; d[3] = ld4[i].w * gk; }
    LDS_WAIT(); asm volatile("" ::: "memory");
    const int c = lane & 7;
#pragma unroll
    for (int j = 0; j < 4; ++j) { const int n = (lane >> 3) + 8 * j; const LAS float* s = scr + (8 * c) * 33 + n;
        if constexpr (F8) { u32x2 o; o.x = pk4_fp8(s[0 * 33], s[1 * 33], s[2 * 33], s[3 * 33]); o.y = pk4_fp8(s[4 * 33], s[5 * 33], s[6 * 33], s[7 * 33]);
            *(u32x2*)((unsigned char*)WTv + (size_t)(n0 + n) * Kdim + k0 + 8 * c) = o; }
        else { u32x4 o; o.x = pk2(s[0 * 33], s[1 * 33]); o.y = pk2(s[2 * 33], s[3 * 33]); o.z = pk2(s[4 * 33], s[5 * 33]); o.w = pk2(s[6 * 33], s[7 * 33]);
            *(u32x4*)(WT + (size_t)(n0 + n) * Kdim + k0 + 8 * c) = o; } }
    LDS_WAIT(); asm volatile("" ::: "memory");
}
__device__ __forceinline__ void win_colmap(int nb, int& src0, int& nvalid) {
    const int pn = nb >> 3, j = (nb & 7) * 32, bj = j >> 7, slot = (j & 127) >> 5;
    nvalid = 32;
    if (pn < 2) src0 = (4 * pn + slot) * 64 + 32 * bj;
    else if (pn == 2) src0 = 640 + slot * 64 + 32 * bj;
    else if (pn == 3) { if (slot == 0) src0 = 512 + 32 * bj; else if (slot == 1) src0 = 896 + 32 * bj; else if (slot == 2) src0 = 576 + 32 * bj; else { src0 = 960; nvalid = bj == 0 ? 4 : 0; } }
    else src0 = 964 + 512 * bj + 128 * (pn - 4) + 32 * slot;
}
__device__ __forceinline__ void p0_prologue(const Params& P, LAS unsigned char* lds, int vcu, int G, int wave, int lane) {
    unsigned char* ws = P.ws;
    LAS float* scr = (LAS float*)(lds + wave * 16384);
    const int gw = vcu * NWAVES + wave, NGW = G * NWAVES;
    constexpr int I_IN = 16 * 64, I_OUT = 16 * 32, I_G = 16 * 32, I_P = 4 * 32, I_UP = 32 * 16 * 64, I_DN = 32 * 16 * 32;
    constexpr int NITEMS = I_IN + I_OUT + I_G + I_P + I_UP + I_DN;
    for (int it = gw; it < NITEMS; it += NGW) {
        int r = it;
        if (r < I_IN) { const int kb = r / 64, nb = r % 64; int s0, nv; win_colmap(nb, s0, nv); p0_transpose_item<false>(P.w_in, INW, (bf16_t*)(ws + WS_WIN), 1024, P.g_mix, scr, kb, nb * 32, s0, nv, lane); continue; } r -= I_IN;
        if (r < I_OUT) { const int kb = r / 32, nb = r % 32; p0_transpose_item<false>(P.w_out, 1024, (bf16_t*)(ws + WS_WOUT), 1024, nullptr, scr, kb, nb * 32, nb * 32, 32, lane); continue; } r -= I_OUT;
        if (r < I_G) { const int kb = r / 32, nb = r % 32; p0_transpose_item<false>(P.w_ple_gate, 1024, (bf16_t*)(ws + WS_WG), 1024, P.g_ple, scr, kb, nb * 32, nb * 32, 32, lane); continue; } r -= I_G;
        if (r < I_P) { const int kb = r / 32, nb = r % 32; p0_transpose_item<false>(P.w_ple_proj, 1024, (bf16_t*)(ws + WS_WP), 256, nullptr, scr, kb, nb * 32, nb * 32, 32, lane); continue; } r -= I_P;
        if (r < I_UP) { const int e = r / 1024, rr = r % 1024, kb = rr / 64, nb = rr % 64;
            const int pn = nb >> 3, j = (nb & 7) * 32, bj = j >> 7, jj = j & 127;
            p0_transpose_item<true>(P.w_up + (size_t)e * 1024 * 2048, 2048, (unsigned char*)(ws + WS_WUP) + (size_t)e * 2048 * 1024, 1024, P.g_ffn, scr, kb, nb * 32, 1024 * bj + 128 * pn + jj, 32, lane); continue; } r -= I_UP;
        { const int e = r / 512, rr = r % 512, kb = rr / 32, nb = rr % 32;
            p0_transpose_item<true>(P.w_down + (size_t)e * 1024 * 1024, 1024, (unsigned char*)(ws + WS_WDOWN) + (size_t)e * 1024 * 1024, 1024, nullptr, scr, kb, nb * 32, nb * 32, 32, lane); }
    }
    float* rs1 = (float*)(ws + WS_RS1); bf16_t* xb = (bf16_t*)(ws + WS_XB);
    for (int m = gw; m < NTOK; m += NGW) {
        const f32x4* xr = (const f32x4*)(P.x + (size_t)m * DM) + lane; f32x4 v[4]; float s = 0.f;
#pragma unroll
        for (int j = 0; j < 4; ++j) { v[j] = xr[64 * j]; s += (v[j].x * v[j].x + v[j].y * v[j].y) + (v[j].z * v[j].z + v[j].w * v[j].w); }
        s = wave_sum(s);
        u32x2* o8 = (u32x2*)(xb + (size_t)m * DM) + lane;
#pragma unroll
        for (int j = 0; j < 4; ++j) { u32x2 w; w.x = pk2(v[j].x, v[j].y); w.y = pk2(v[j].z, v[j].w); o8[64 * j] = w; }
        if (lane == 0) rs1[m] = 1.0f / sqrtf(s * (1.0f / DM) + EPS);
    }
    bf16_t* pb = (bf16_t*)(ws + WS_PB);
    for (int m = gw; m < NTOK; m += NGW) { const f32x4 v = *((const f32x4*)(P.p + (size_t)m * 256) + lane); u32x2 w; w.x = pk2(v.x, v.y); w.y = pk2(v.z, v.w); *((u32x2*)(pb + (size_t)m * 256) + lane) = w; }
    f32x2* rope = (f32x2*)(ws + WS_ROPE);
    for (int idx = gw * 64 + lane; idx < SEQ * 32; idx += NGW * 64) { const int t = idx >> 5, i = idx & 31;
        const float inv = exp2f(-(float)i * (13.287712379549449f / 32.0f));
        const float ang = (float)t * inv;
        const double rev = (double)ang * 0.15915494309189535; const float fr = (float)(rev - __builtin_floor(rev));
        rope[idx] = (f32x2){__builtin_amdgcn_cosf(fr), __builtin_amdgcn_sinf(fr)}; }
    float* wrg = (float*)(ws + WS_WRG);
    for (int idx = gw * 64 + lane; idx < 1024 * 32; idx += NGW * 64) wrg[idx] = P.w_router[idx] * P.g_ffn[idx >> 5];
}

__device__ __forceinline__ unsigned fkey(float f) { unsigned u = __builtin_bit_cast(unsigned, f); if (u == 0x80000000u) u = 0u; return u ^ ((unsigned)((int)u >> 31) | 0x80000000u); }
__device__ __forceinline__ int mbcnt64(unsigned long long m) { return __builtin_amdgcn_mbcnt_hi((unsigned)(m >> 32), __builtin_amdgcn_mbcnt_lo((unsigned)m, 0u)); }

template <int NR>
__device__ __forceinline__ unsigned bisect_thr(const unsigned (&v)[NR], unsigned prefix, int startbit) {
    bool exact = false;
#pragma unroll 1
    for (int bit = startbit; bit >= 0; --bit) {
        const unsigned cand = prefix | (1u << bit); int cnt = 0;
#pragma unroll
        for (int r = 0; r < NR; ++r) { cnt += __builtin_popcountll(__ballot(v[r] >= cand)); if ((r & 7) == 7) __builtin_amdgcn_sched_barrier(0); }
        if (cnt >= NSEL) prefix = cand;
        if (cnt == NSEL) { exact = true; break; }
    }
    return exact ? prefix - 1u : prefix;
}
template <int NR, bool EXPL>
__device__ __forceinline__ void compact_sel(const unsigned (&v)[NR], const unsigned (&ci)[NR], unsigned T, LAS unsigned* list, int lane) {
    int cgt = 0;
#pragma unroll
    for (int r = 0; r < NR; ++r) { cgt += __builtin_popcountll(__ballot(v[r] > T)); if ((r & 7) == 7) __builtin_amdgcn_sched_barrier(0); }
    const int need = NSEL - cgt; int base = 0, ties = 0;
#pragma unroll
    for (int r = 0; r < NR; ++r) { const bool gt = v[r] > T, eq = v[r] == T; const unsigned long long em = __ballot(eq);
        const bool sel = gt || (eq && (ties + mbcnt64(em)) < need); const unsigned long long sm = __ballot(sel);
        list[sel ? base + mbcnt64(sm) : NSEL + lane] = EXPL ? ci[r] : (unsigned)(r * 64 + lane);
        base += __builtin_popcountll(sm); ties += __builtin_popcountll(em);
        if ((r & 3) == 3) __builtin_amdgcn_sched_barrier(0); }
}
constexpr int SEL_CAP = 1024;
template <int NR>
__device__ __forceinline__ void select_topk(LAS float* row, LAS unsigned* H, LAS unsigned* list, int lane, bool zero_h) {
    unsigned v[NR];
#pragma unroll
    for (int r = 0; r < NR; ++r) v[r] = fkey(row[r * 64 + lane]);
    LAS u32x4* H4 = (LAS u32x4*)H;
    const u32x4 h0 = H4[2 * lane], h1 = H4[2 * lane + 1];
    if (zero_h) { H4[2 * lane] = (u32x4){0u, 0u, 0u, 0u}; H4[2 * lane + 1] = (u32x4){0u, 0u, 0u, 0u}; }
    const unsigned hw[8] = {h0.x, h0.y, h0.z, h0.w, h1.x, h1.y, h1.z, h1.w};
    unsigned c[16];
#pragma unroll
    for (int i = 0; i < 8; ++i) { c[2 * i] = hw[i] & 0xffffu; c[2 * i + 1] = hw[i] >> 16; }
    unsigned s = 0u;
#pragma unroll
    for (int i = 0; i < 16; ++i) s += c[i];
    unsigned S = s;
#pragma unroll
    for (int off = 1; off < 64; off <<= 1) { const unsigned o = __shfl_down(S, off); if (lane + off < 64) S += o; }
    const unsigned long long okm = __ballot(S >= (unsigned)NSEL);
    bool fast = okm != 0ull; unsigned floorkey = 0u; int C = 0;
    if (fast) {
        const int Ls = 63 - __builtin_clzll(okm);
        unsigned acc = S - s; int bl = -1; unsigned accb = 0u;
#pragma unroll
        for (int b = 15; b >= 0; --b) { acc += c[b]; if (bl < 0 && acc >= (unsigned)NSEL) { bl = b; accb = acc; } }
        const int bstar = __shfl(bl, Ls) + 16 * Ls; C = (int)__shfl(accb, Ls);
        floorkey = (unsigned)bstar << 22;
        fast = (bstar > 1) && (C <= SEL_CAP);
    }
    if (!fast) {
        const unsigned T = bisect_thr<NR>(v, 0u, 31);
        compact_sel<NR, false>(v, v, T, list, lane);
        return;
    }
    LAS unsigned* ckl = (LAS unsigned*)row; LAS unsigned* cil = ckl + 1152;
    { int base = 0;
#pragma unroll
      for (int r = 0; r < NR; ++r) { const bool cnd = v[r] >= floorkey; const unsigned long long m = __ballot(cnd);
          const int pos = cnd ? base + mbcnt64(m) : SEL_CAP + lane;
          ckl[pos] = v[r]; cil[pos] = (unsigned)(r * 64 + lane); base += __builtin_popcountll(m);
          if ((r & 3) == 3) __builtin_amdgcn_sched_barrier(0); } }
    if (C <= 512) {
        unsigned ck[8], ci[8];
#pragma unroll
        for (int j = 0; j < 8; ++j) { const int i = j * 64 + lane; ck[j] = i < C ? ckl[i] : 0u; ci[j] = cil[i]; }
        const unsigned T = (C == NSEL) ? floorkey - 1u : bisect_thr<8>(ck, floorkey, 21);
        compact_sel<8, true>(ck, ci, T, list, lane);
    } else {
        unsigned ck[16], ci[16];
#pragma unroll
        for (int j = 0; j < 16; ++j) { const int i = j * 64 + lane; ck[j] = i < C ? ckl[i] : 0u; ci[j] = cil[i]; }
        const unsigned T = bisect_thr<16>(ck, floorkey, 21);
        compact_sel<16, true>(ck, ci, T, list, lane);
    }
}

typedef short v4i16 __attribute__((ext_vector_type(4)));
constexpr int VROW = 144;

__device__ __forceinline__ void attn_tile(const Params& P, LAS unsigned char* lds, int b, int t0, int wave, int lane) {
    unsigned char* ws = P.ws;
    const bf16_t* QI = (const bf16_t*)(ws + WS_QI); const bf16_t* KI = (const bf16_t*)(ws + WS_KI);
    const bf16_t* Q = (const bf16_t*)(ws + WS_Q); const bf16_t* Kp = (const bf16_t*)(ws + WS_K); const bf16_t* Vp = (const bf16_t*)(ws + WS_V);
    const float* WI = (const float*)(ws + WS_WI); bf16_t* MIX = (bf16_t*)(ws + WS_MIX);
    LAS float* SC = (LAS float*)lds;
    LAS unsigned* list = (LAS unsigned*)(lds + wave * 16384 + 14336);
    LAS unsigned* HIST = (LAS unsigned*)(lds + LDS_MISC);
    const int tokbase = b * SEQ;
    const bool need_sel = t0 >= 256;
    if (need_sel) {
        const int nkt = (t0 + 8 + 31) >> 5;
        bf16x8 a[4]; f32x4 w[4];
        { const bf16_t* src = QI + (size_t)(tokbase + t0 + ((lane & 31) >> 2)) * 256 + (lane & 3) * 64 + 8 * (lane >> 5);
#pragma unroll
          for (int ks = 0; ks < 4; ++ks) a[ks] = *(const bf16x8*)(src + 16 * ks); }
#pragma unroll
        for (int g = 0; g < 4; ++g) w[g] = *(const f32x4*)(WI + (size_t)(tokbase + t0 + 2 * g + (lane >> 5)) * 4);
        for (int kt0 = wave; kt0 < nkt; kt0 += 4 * NWAVES) {
            bf16x8 bf[4][4];
#pragma unroll
            for (int u = 0; u < 4; ++u) { const int kt = kt0 + u * NWAVES;
                if (kt < nkt) { const bf16_t* ksrc = KI + (size_t)(tokbase + kt * 32 + (lane & 31)) * 64 + 8 * (lane >> 5);
#pragma unroll
                    for (int ks = 0; ks < 4; ++ks) bf[u][ks] = *(const bf16x8*)(ksrc + 16 * ks); } }
#pragma unroll
            for (int u = 0; u < 4; ++u) { const int kt = kt0 + u * NWAVES;
                if (kt < nkt) {
                    const int key = kt * 32 + (lane & 31);
                    f32x16 acc;
#pragma unroll
                    for (int i = 0; i < 16; ++i) acc[i] = 0.f;
#pragma unroll
                    for (int ks = 0; ks < 4; ++ks) acc = __builtin_amdgcn_mfma_f32_32x32x16_bf16(a[ks], bf[u][ks], acc, 0, 0, 0);
#pragma unroll
                    for (int g = 0; g < 4; ++g) { float sc = 0.f;
#pragma unroll
                        for (int h = 0; h < 4; ++h) sc = fmaf(fmaxf(acc[4 * g + h], 0.f), w[g][h], sc);
                        const int ql = 2 * g + (lane >> 5);
                        if (key > t0 + ql) sc = -INFINITY;
                        SC[ql * 4096 + key] = sc;
                        if (key <= t0 + ql) { const unsigned ub = __builtin_bit_cast(unsigned, sc);
                            const unsigned bin = (ub >> 22) ^ (((unsigned)((int)ub >> 31) & 0x1ffu) | 0x200u);
                            __hip_atomic_fetch_add(HIST + ql * 512 + (bin >> 1), 1u << ((bin & 1u) << 4), __ATOMIC_RELAXED, __HIP_MEMORY_SCOPE_WORKGROUP); } }
                } }
        }
        { const int npad = ((t0 + 8 + 1023) >> 10) << 10;
          for (int i = nkt * 32 + (int)threadIdx.x; i < npad; i += NTHR) {
#pragma unroll
              for (int q = 0; q < 8; ++q) SC[q * 4096 + i] = -INFINITY; } }
    }
    __syncthreads();
    const int t = t0 + wave, tok = tokbase + t;
    if (need_sel) {
        LAS float* row = SC + wave * 4096; LAS unsigned* H = HIST + wave * 512; const int n = t + 1;
        if (n <= 1024) select_topk<16>(row, H, list, lane, true);
        else if (n <= 2048) select_topk<32>(row, H, list, lane, true);
        else if (n <= 3072) select_topk<48>(row, H, list, lane, true);
        else select_topk<64>(row, H, list, lane, true);
    } else {
#pragma unroll
        for (int i = 0; i < 4; ++i) list[i * 64 + lane] = (unsigned)(i * 64 + lane);
    }
    const int nvalid = need_sel ? NSEL : (t + 1);
    const int ngrp = (nvalid + 31) >> 5;
    const int hd = lane & 15, g = lane >> 4;
    bf16x8 qf0, qf1;
#pragma unroll
    for (int i = 0; i < 8; ++i) { qf0[i] = 0; qf1[i] = 0; }
    if (hd < 8) { const bf16_t* qs = Q + (size_t)tok * 512 + hd * 64 + 8 * g; qf0 = *(const bf16x8*)qs; qf1 = *(const bf16x8*)(qs + 32); }
    float m = -INFINITY, ssum = 0.f;
    f32x4 o[4];
#pragma unroll
    for (int dt = 0; dt < 4; ++dt) o[dt] = (f32x4){0.f, 0.f, 0.f, 0.f};
    LAS unsigned char* vreg = lds + wave * 16384;
    bf16x8 kf[4]; u32x4 vv[4];
    { const unsigned ia = list[hd], ib = list[16 + hd];
      const bf16_t* ka = Kp + (size_t)(tokbase + ia) * 64 + 8 * g; const bf16_t* kb = Kp + (size_t)(tokbase + ib) * 64 + 8 * g;
      kf[0] = *(const bf16x8*)ka; kf[1] = *(const bf16x8*)(ka + 32); kf[2] = *(const bf16x8*)kb; kf[3] = *(const bf16x8*)(kb + 32);
#pragma unroll
      for (int i = 0; i < 4; ++i) { const unsigned idx = list[(lane >> 3) + 8 * i]; vv[i] = *(const u32x4*)(Vp + (size_t)(tokbase + idx) * 64 + 8 * (lane & 7)); } }
#pragma unroll 1
    for (int grp = 0; grp < ngrp; ++grp) {
        LAS unsigned char* vbuf = vreg + (grp & 1) * 8192;
#pragma unroll
        for (int i = 0; i < 4; ++i) *(LAS u32x4*)(vbuf + ((lane >> 3) + 8 * i) * VROW + (lane & 7) * 16) = vv[i];
        f32x4 sa = {0.f, 0.f, 0.f, 0.f}, sb = {0.f, 0.f, 0.f, 0.f};
        sa = __builtin_amdgcn_mfma_f32_16x16x32_bf16(kf[0], qf0, sa, 0, 0, 0); sa = __builtin_amdgcn_mfma_f32_16x16x32_bf16(kf[1], qf1, sa, 0, 0, 0);
        sb = __builtin_amdgcn_mfma_f32_16x16x32_bf16(kf[2], qf0, sb, 0, 0, 0); sb = __builtin_amdgcn_mfma_f32_16x16x32_bf16(kf[3], qf1, sb, 0, 0, 0);
        if (grp + 1 < ngrp) {
            const int nb = (grp + 1) * 32; const unsigned ia = list[nb + hd], ib = list[nb + 16 + hd];
            const bf16_t* ka = Kp + (size_t)(tokbase + ia) * 64 + 8 * g; const bf16_t* kb = Kp + (size_t)(tokbase + ib) * 64 + 8 * g;
            kf[0] = *(const bf16x8*)ka; kf[1] = *(const bf16x8*)(ka + 32); kf[2] = *(const bf16x8*)kb; kf[3] = *(const bf16x8*)(kb + 32);
#pragma unroll
            for (int i = 0; i < 4; ++i) { const unsigned idx = list[nb + (lane >> 3) + 8 * i]; vv[i] = *(const u32x4*)(Vp + (size_t)(tokbase + idx) * 64 + 8 * (lane & 7)); }
        }
        float l[8]; float mloc = -INFINITY;
#pragma unroll
        for (int r = 0; r < 4; ++r) { const int sl = grp * 32 + 4 * g + r;
            l[r] = sl < nvalid ? sa[r] * 0.125f : -INFINITY; l[4 + r] = (sl + 16) < nvalid ? sb[r] * 0.125f : -INFINITY;
            mloc = fmaxf(mloc, fmaxf(l[r], l[4 + r])); }
        mloc = fmaxf(mloc, __shfl_xor(mloc, 16)); mloc = fmaxf(mloc, __shfl_xor(mloc, 32));
        const float mnew = fmaxf(m, mloc), alpha = __expf(m - mnew); m = mnew;
        float ps = 0.f;
#pragma unroll
        for (int r = 0; r < 8; ++r) { l[r] = __expf(l[r] - mnew); ps += l[r]; }
        ssum = ssum * alpha + ps;
        bf16x8 pf;
        { const u32x4 pw = {cvt_pk_bf16(l[0], l[1]), cvt_pk_bf16(l[2], l[3]), cvt_pk_bf16(l[4], l[5]), cvt_pk_bf16(l[6], l[7])}; pf = __builtin_bit_cast(bf16x8, pw); }
        LAS unsigned char* ta = vbuf + (4 * g + (hd >> 2)) * VROW + (hd & 3) * 8;
#pragma unroll
        for (int dt = 0; dt < 4; ++dt) {
            const v4i16 lo = __builtin_amdgcn_ds_read_tr16_b64_v4i16((LAS v4i16*)(ta + dt * 32));
            const v4i16 hi = __builtin_amdgcn_ds_read_tr16_b64_v4i16((LAS v4i16*)(ta + 16 * VROW + dt * 32));
            bf16x8 vf; vf[0] = lo[0]; vf[1] = lo[1]; vf[2] = lo[2]; vf[3] = lo[3]; vf[4] = hi[0]; vf[5] = hi[1]; vf[6] = hi[2]; vf[7] = hi[3];
            o[dt] = __builtin_amdgcn_mfma_f32_16x16x32_bf16(vf, pf, o[dt] * alpha, 0, 0, 0);
        }
    }
    ssum += __shfl_xor(ssum, 16); ssum += __shfl_xor(ssum, 32);
    const float inv = 1.0f / ssum;
    if (hd < 8) {
        bf16_t* op = MIX + (size_t)tok * 1024 + hd * 64 + 4 * g;
#pragma unroll
        for (int dt = 0; dt < 4; ++dt) { u32x2 w; w.x = cvt_pk_bf16(o[dt][0] * inv, o[dt][1] * inv); w.y = cvt_pk_bf16(o[dt][2] * inv, o[dt][3] * inv); *(u32x2*)(op + 16 * dt) = w; }
    }
    __syncthreads();
}

__device__ __forceinline__ void conv_tile(const Params& P, LAS unsigned char* lds, int tile, int tid, int wave, int lane) {
    unsigned char* ws = P.ws;
    const bf16_t* HG = (const bf16_t*)(ws + WS_HGLU); bf16_t* MIX = (bf16_t*)(ws + WS_MIX);
    LAS f32x2* part = (LAS f32x2*)(lds + LDS_MISC + 1024);
    LAS f32x2* stat = part + 256;
    LAS bf16_t* Lin = (LAS bf16_t*)lds;
    LAS bf16_t* Lout = (LAS bf16_t*)(lds + 65536);
    const int tok0 = tile * 32, t0 = tok0 & (SEQ - 1), c = tid;
    for (int ch = tid; ch < 62 * 64; ch += NTHR) { const int r = ch >> 6, cc = ch & 63; const int tt = t0 - 30 + r;
        u32x4 v = {0u, 0u, 0u, 0u}; if (tt >= 0) v = *(const u32x4*)(HG + (size_t)(tok0 - 30 + r) * 512 + cc * 8);
        *(LAS u32x4*)(Lin + r * 512 + cc * 8) = v; }
    __syncthreads();
    float in[62];
#pragma unroll
    for (int r = 0; r < 62; ++r) in[r] = __builtin_bit_cast(float, (unsigned)Lin[r * 512 + c] << 16);
    float out[32];
    const float bias = P.dw_b[c];
#pragma unroll
    for (int i = 0; i < 32; ++i) out[i] = bias;
#pragma unroll
    for (int j = 0; j < 31; ++j) { const float wj = P.dw_w[j * 512 + c];
#pragma unroll
        for (int i = 0; i < 32; ++i) out[i] = fmaf(in[i + j], wj, out[i]); }
#pragma unroll
    for (int i = 0; i < 32; ++i) { const float s1 = wave_sum(out[i]), s2 = wave_sum(out[i] * out[i]); if (lane == 0) part[i * 8 + wave] = (f32x2){s1, s2}; }
    __syncthreads();
    if (tid < 32) { float s1 = 0.f, s2 = 0.f;
#pragma unroll
        for (int w = 0; w < 8; ++w) { const f32x2 pp = part[tid * 8 + w]; s1 += pp.x; s2 += pp.y; }
        const float mean = s1 * (1.0f / 512.0f), var = fmaxf(s2 * (1.0f / 512.0f) - mean * mean, 0.f);
        stat[tid] = (f32x2){mean, 1.0f / sqrtf(var + EPS)}; }
    __syncthreads();
    const float lgc = P.ln_g[c], lbc = P.ln_b[c];
#pragma unroll
    for (int i = 0; i < 32; ++i) { const f32x2 st = stat[i]; const float y = (out[i] - st.x) * st.y * lgc + lbc; const float sl = y * sigmoidf_(y);
        Lout[i * 512 + c] = (bf16_t)f2bf(sl); }
    __syncthreads();
    for (int ch = tid; ch < 32 * 64; ch += NTHR) { const int r = ch >> 6, cc = ch & 63;
        *(u32x4*)(MIX + (size_t)(tok0 + r) * 1024 + 512 + cc * 8) = *(const LAS u32x4*)(Lout + r * 512 + cc * 8); }
    __syncthreads();
}

__device__ __forceinline__ void router_phase(const Params& P, LAS unsigned char* lds, int blk, int G, int tid, int wave, int lane) {
    unsigned char* ws = P.ws;
    const float* h1 = (const float*)(ws + WS_H1); const float* wrg = (const float*)(ws + WS_WRG);
    int* list = (int*)(ws + WS_LIST); float* lscale = (float*)(ws + WS_LSCALE); float* lgate = (float*)(ws + WS_LGATE);
    unsigned* cntg = (unsigned*)(ws + WS_CTL) + CW_CNT;
    LAS float* WL = (LAS float*)lds;
    LAS int* lcnt = (LAS int*)(lds + LDS_MISC + 1024);
    LAS int* gbase = lcnt + 32;
    LAS int* rec_e = gbase + 32;
    LAS int* rec_p = rec_e + 512;
    LAS float* rec_g = (LAS float*)(rec_p + 512);
    LAS float* rec_s = rec_g + 512;
    for (int i = tid; i < 8192; i += NTHR) ((LAS f32x4*)WL)[i] = ((const f32x4*)wrg)[i];
    __syncthreads();
    const int tl = lane & 31, half = lane >> 5;
    for (int chunk = blk; chunk < NTOK / 128; chunk += G) {
        if (tid < 32) lcnt[tid] = 0;
        __syncthreads();
        if (wave < 4) {
            const int tloc = wave * 32 + tl, tok = chunk * 128 + tloc;
            const float* hrow = h1 + (size_t)tok * DM + 4 * half;
            f32x16 acc;
#pragma unroll
            for (int i = 0; i < 16; ++i) acc[i] = 0.f;
            float ss = 0.f;
#pragma unroll 1
            for (int k0 = 0; k0 < DM; k0 += 32) {
                f32x4 hv[4];
#pragma unroll
                for (int i = 0; i < 4; ++i) hv[i] = *(const f32x4*)(hrow + k0 + 8 * i);
#pragma unroll
                for (int i = 0; i < 4; ++i) {
                    ss = fmaf(hv[i].x, hv[i].x, fmaf(hv[i].y, hv[i].y, fmaf(hv[i].z, hv[i].z, fmaf(hv[i].w, hv[i].w, ss))));
#pragma unroll
                    for (int j = 0; j < 4; ++j) { const float wv = WL[(k0 + 8 * i + 4 * half + j) * 32 + tl];
                        acc = __builtin_amdgcn_mfma_f32_32x32x2f32(wv, hv[i][j], acc, 0, 0, 0); }
                }
            }
            ss += __shfl_xor(ss, 32);
            const float rs = 1.0f / sqrtf(ss * (1.0f / DM) + EPS);
            float v[16];
#pragma unroll
            for (int r = 0; r < 16; ++r) v[r] = acc[r] * rs + P.b_router[(r & 3) + 8 * (r >> 2) + 4 * half];
            float tv[4]; int te[4];
#pragma unroll
            for (int q = 0; q < 4; ++q) { float bv = -INFINITY; int be = 64;
#pragma unroll
                for (int r = 0; r < 16; ++r) { const int e = (r & 3) + 8 * (r >> 2) + 4 * half; if (v[r] > bv || (v[r] == bv && e < be)) { bv = v[r]; be = e; } }
#pragma unroll
                for (int r = 0; r < 16; ++r) { const int e = (r & 3) + 8 * (r >> 2) + 4 * half; if (e == be) v[r] = -INFINITY; }
                tv[q] = bv; te[q] = be; }
            float cv[8]; int ce[8];
#pragma unroll
            for (int q = 0; q < 4; ++q) { cv[q] = tv[q]; ce[q] = te[q]; cv[4 + q] = __shfl_xor(tv[q], 32); ce[4 + q] = __shfl_xor(te[q], 32); }
#pragma unroll
            for (int q = 0; q < 4; ++q) { float bv = -INFINITY; int be = 64;
#pragma unroll
                for (int r = 0; r < 8; ++r) if (cv[r] > bv || (cv[r] == bv && ce[r] < be)) { bv = cv[r]; be = ce[r]; }
#pragma unroll
                for (int r = 0; r < 8; ++r) if (ce[r] == be) cv[r] = -INFINITY;
                tv[q] = bv; te[q] = be; }
            const float e1 = __expf(tv[1] - tv[0]), e2 = __expf(tv[2] - tv[0]), e3 = __expf(tv[3] - tv[0]);
            const float is = 1.0f / (1.0f + e1 + e2 + e3);
            if (half == 0) {
                const float gq[4] = {is, e1 * is, e2 * is, e3 * is};
#pragma unroll
                for (int q = 0; q < 4; ++q) { const int lp = atomicAdd((int*)&lcnt[te[q]], 1); const int si = tloc * 4 + q; rec_e[si] = te[q]; rec_p[si] = lp; rec_g[si] = gq[q]; }
                rec_s[tloc] = rs;
            }
        }
        __syncthreads();
        if (tid < 32) gbase[tid] = (int)atomicAdd(cntg + 64 * tid, (unsigned)lcnt[tid]);
        __syncthreads();
        { const int si = tid, ee = rec_e[si], pos = gbase[ee] + rec_p[si], li = ee * NTOK + pos;
          list[li] = (chunk * 128) * 4 + si; lscale[li] = rec_s[si >> 2]; lgate[li] = rec_g[si]; }
        __syncthreads();
    }
}

__device__ __forceinline__ void combine_phase(const Params& P, int gw, int NGW, int lane) {
    unsigned char* ws = P.ws;
    float* h1 = (float*)(ws + WS_H1); bf16_t* h1b = (bf16_t*)(ws + WS_H1B); const bf16_t* y = (const bf16_t*)(ws + WS_Y); float* rs3 = (float*)(ws + WS_RS3);
    for (int m = gw; m < NTOK; m += NGW) {
        const f32x4* hr = (const f32x4*)(h1 + (size_t)m * DM) + lane; f32x4 v[4]; float s = 0.f;
#pragma unroll
        for (int j = 0; j < 4; ++j) v[j] = hr[64 * j];
#pragma unroll
        for (int k = 0; k < 4; ++k) { const u32x2* yr = (const u32x2*)(y + (size_t)(m * 4 + k) * DM) + lane;
#pragma unroll
            for (int j = 0; j < 4; ++j) { const u32x2 w = yr[64 * j]; v[j].x += bf_lo(w.x); v[j].y += bf_hi(w.x); v[j].z += bf_lo(w.y); v[j].w += bf_hi(w.y); } }
        u32x2* o8 = (u32x2*)(h1b + (size_t)m * DM) + lane;
#pragma unroll
        for (int j = 0; j < 4; ++j) { u32x2 w; w.x = pk2(v[j].x, v[j].y); w.y = pk2(v[j].z, v[j].w); o8[64 * j] = w;
            s += (v[j].x * v[j].x + v[j].y * v[j].y) + (v[j].z * v[j].z + v[j].w * v[j].w); }
        s = wave_sum(s);
        if (lane == 0) rs3[m] = 1.0f / sqrtf(s * (1.0f / DM) + EPS);
    }
}

__device__ __forceinline__ void final_phase(const Params& P, int gw, int NGW, int lane) {
    f32x4 gv[4];
#pragma unroll
    for (int j = 0; j < 4; ++j) gv[j] = *((const f32x4*)P.g_final + lane + 64 * j);
    for (int m = gw; m < NTOK; m += NGW) {
        f32x4* orow = (f32x4*)(P.out + (size_t)m * DM) + lane; f32x4 v[4]; float s = 0.f;
#pragma unroll
        for (int j = 0; j < 4; ++j) { v[j] = orow[64 * j]; s += (v[j].x * v[j].x + v[j].y * v[j].y) + (v[j].z * v[j].z + v[j].w * v[j].w); }
        s = wave_sum(s); const float rs = 1.0f / sqrtf(s * (1.0f / DM) + EPS);
#pragma unroll
        for (int j = 0; j < 4; ++j) orow[64 * j] = v[j] * rs * gv[j];
    }
}

#define XB_TMO      128
#define XB_XCNT(j)  (256  + 64 * (j))
#define XB_XSUB(j)  (1280 + 64 * (j))
#define XB_XGEN(j)  (2304 + 64 * (j))
#define XB_TOP      3328
#define XB_TOPGEN   3392
#define XCD_BAR_WORDS 3456
#define XB_SPIN_CAP (1u << 18)
__device__ __forceinline__ unsigned xb_ld(unsigned* p)              { return __hip_atomic_load(p, __ATOMIC_RELAXED, __HIP_MEMORY_SCOPE_AGENT); }
__device__ __forceinline__ unsigned xb_add(unsigned* p, unsigned v) { return __hip_atomic_fetch_add(p, v, __ATOMIC_RELAXED, __HIP_MEMORY_SCOPE_AGENT); }
__device__ __forceinline__ unsigned xb_xcc_id() { return (unsigned)__builtin_amdgcn_s_getreg((3 << 11) | 20) & 0xFu; }
#define XB_SPIN(cond, bar) do { unsigned _sp = 0; while (cond) { __builtin_amdgcn_s_sleep(1); \
    if ((++_sp & 255u) == 0u) { if (xb_ld(&(bar)[XB_TMO])) break; if (_sp > XB_SPIN_CAP) { atomicAdd(&(bar)[XB_TMO], 1u); break; } } } } while (0)
struct XcdBarrier { unsigned* bar; unsigned x; volatile LAS unsigned* st; };
__device__ __forceinline__ XcdBarrier xcd_barrier_post(unsigned* bar, volatile LAS unsigned* st) {
    XcdBarrier b; b.bar = bar; b.x = xb_xcc_id(); b.st = st;
    if (threadIdx.x == 0) (void)xb_add(&bar[XB_XCNT(b.x)], 1u);
    return b;
}
__device__ __forceinline__ void xcd_barrier_complete(unsigned* bar, unsigned x, unsigned& nloc, unsigned& nx) {
    const unsigned G = gridDim.x * gridDim.y * gridDim.z;
    unsigned sum, cnt, mine, sp = 0u;
    for (;;) {
        sum = 0u; cnt = 0u; mine = 0u;
#pragma unroll
        for (unsigned j = 0; j < 16; ++j) { const unsigned c = xb_ld(&bar[XB_XCNT(j)]); sum += c; cnt += (c > 0u) ? 1u : 0u; mine = (j == x) ? c : mine; }
        if (sum == G) break;
        __builtin_amdgcn_s_sleep(1);
        if ((++sp & 255u) == 0u) { if (xb_ld(&bar[XB_TMO])) break; if (sp > XB_SPIN_CAP) { atomicAdd(&bar[XB_TMO], 1u); break; } }
    }
    nloc = mine > 0u ? mine : 1u; nx = cnt > 0u ? cnt : 1u;
}
__device__ __forceinline__ void xcd_barrier(const XcdBarrier& b) {
    asm volatile("s_waitcnt vmcnt(0)" ::: "memory");
    __syncthreads();
    if (threadIdx.x == 0) {
        unsigned* bar = b.bar;
        __builtin_amdgcn_s_waitcnt(0);
        unsigned nloc = b.st[0], nx = b.st[1];
        if (nloc == 0u) { xcd_barrier_complete(bar, b.x, nloc, nx); b.st[0] = nloc; b.st[1] = nx; }
        const unsigned old = xb_add(&bar[XB_XSUB(b.x)], 1u);
        const unsigned gen = old / nloc;
        if (old + 1u == (gen + 1u) * nloc) {
            __builtin_amdgcn_fence(__ATOMIC_RELEASE, "agent");
            asm volatile("s_waitcnt vmcnt(0)" ::: "memory");
            const unsigned og = xb_add(&bar[XB_TOP], 1u);
            const unsigned tg = og / nx;
            if (og + 1u == (tg + 1u) * nx) xb_add(&bar[XB_TOPGEN], 1u);
            else XB_SPIN(xb_ld(&bar[XB_TOPGEN]) == tg, bar);
            __builtin_amdgcn_fence(__ATOMIC_ACQUIRE, "agent");
            xb_add(&bar[XB_XGEN(b.x)], 1u);
            asm volatile("s_waitcnt vmcnt(0)" ::: "memory");
        } else {
            XB_SPIN(xb_ld(&bar[XB_XGEN(b.x)]) == gen, bar);
            __builtin_amdgcn_fence(__ATOMIC_ACQUIRE, "agent");
            asm volatile("s_waitcnt vmcnt(0)" ::: "memory");
        }
    }
    __syncthreads();
}

constexpr int NPHASE = 10;
__global__ void __launch_bounds__(NTHR, 2) fwd_kernel(Params P) {
    extern __shared__ __attribute__((aligned(16))) unsigned char lds_raw[];
    LAS unsigned char* lds = (LAS unsigned char*)lds_raw;
    cg::grid_group grid = cg::this_grid();
    const int tid = threadIdx.x, lane = tid & 63, wave = __builtin_amdgcn_readfirstlane(tid >> 6);
    const int G = gridDim.x, bx = blockIdx.x;
    const int vcu = (G % 8 == 0) ? (bx % 8) * (G / 8) + bx / 8 : bx;
    const int gw = vcu * NWAVES + wave, NGW = G * NWAVES;
    unsigned char* ws = P.ws;
    const int lo = P.ph_lo, hi = P.ph_hi;
#ifndef PH_MASK
#define PH_MASK 0x3ff
#endif
#define IN(k) ((((PH_MASK) >> (k)) & 1) && lo <= (k) && (k) < hi)
    volatile LAS unsigned* xst = (volatile LAS unsigned*)(lds + LDS_XB);
    if (tid < 2) xst[tid] = 0u;
    __syncthreads();
    const XcdBarrier xbar = xcd_barrier_post((unsigned*)(ws + WS_CTL) + CW_BAR, xst);
#define SYNC(k) do { if (IN(k) && IN((k) + 1)) { if ((k) == 0) grid.sync(); else xcd_barrier(xbar); } } while (0)

    if (IN(0)) p0_prologue(P, lds, vcu, G, wave, lane);
    SYNC(0);
    if (IN(1)) {
        { pg8::DenseSched S; S.init((const bf16_t*)(ws + WS_XB), (const bf16_t*)(ws + WS_WIN), NTOK, 2048, 1024, G, bx);
          EpiInProj E{(const float*)(ws + WS_RS1), (const f32x2*)(ws + WS_ROPE), P.glu_b, (bf16_t*)(ws + WS_Q), (bf16_t*)(ws + WS_K), (bf16_t*)(ws + WS_V), (bf16_t*)(ws + WS_QI), (bf16_t*)(ws + WS_KI), (bf16_t*)(ws + WS_HGLU), (float*)(ws + WS_WI)};
          pg8::gemm_phase<EpiInProj, pg8::DenseSched, false>(lds, S, E); }
        { pg8::DenseSched S; S.init((const bf16_t*)(ws + WS_PB), (const bf16_t*)(ws + WS_WP), NTOK, 1024, 256, G, bx);
          EpiBf16Plain E{(bf16_t*)(ws + WS_PJ), 1024};
          pg8::gemm_phase<EpiBf16Plain, pg8::DenseSched, false>(lds, S, E); }
    }
    SYNC(1);
    if (IN(2)) {
        for (int i = tid; i < 4096; i += NTHR) ((LAS unsigned*)(lds + LDS_MISC))[i] = 0u;
        __syncthreads();
        if (G % 8 == 0) { const int b = bx % 8, jb = bx / 8, nbb = G / 8;
            for (int i = 0;; ++i) { const int k = i * nbb + ((i & 1) ? nbb - 1 - jb : jb); if (k >= 512) break; attn_tile(P, lds, b, (511 - k) * 8, wave, lane); } }
        else { for (int tl = bx; tl < 4096; tl += G) attn_tile(P, lds, tl & 7, (511 - (tl >> 3)) * 8, wave, lane); }
        for (int rp = 0; rp <= ((P.rep >> 3) & 1); ++rp)
        for (int tl = vcu; tl < NTOK / 32; tl += G) conv_tile(P, lds, tl, tid, wave, lane);
    }
    SYNC(2);
    if (IN(3)) {
        pg8::DenseSched S; S.init((const bf16_t*)(ws + WS_MIX), (const bf16_t*)(ws + WS_WOUT), NTOK, 1024, 1024, G, bx);
        EpiOutProj E{P.x, (float*)(ws + WS_H1), (unsigned char*)(ws + WS_H1F8)};
        pg8::gemm_phase<EpiOutProj, pg8::DenseSched, false>(lds, S, E);
    }
    SYNC(3);
    if (IN(4)) router_phase(P, lds, vcu, G, tid, wave, lane);
    SYNC(4);
    if (IN(5) || IN(6)) {
        LAS int* tb = (LAS int*)(lds + LDS_MISC); LAS int* cn = tb + 64;
        if (tid == 0) { const unsigned* cntg = (const unsigned*)(ws + WS_CTL) + CW_CNT; int acc = 0;
            for (int e = 0; e < NE; ++e) { const int c = (int)__hip_atomic_load(cntg + 64 * e, __ATOMIC_RELAXED, __HIP_MEMORY_SCOPE_AGENT); tb[e] = acc; cn[e] = c; acc += (c + BM - 1) / BM; }
            tb[NE] = acc; }
        __syncthreads();
        if (IN(5)) {
            pg8::MoeSched S; S.A = ws + WS_H1F8; S.Bt = ws + WS_WUP; S.rp = 1024; S.b_estride = (size_t)2048 * 1024; S.tb = tb; S.cnt = cn; S.list = (const int*)(ws + WS_LIST);
            S.nN = 8; S.nwg = tb[NE] * 8; S.G = G; S.c = bx; S.gather = true;
            EpiUp E{(const float*)(ws + WS_LSCALE), P.b_up, (unsigned char*)(ws + WS_ACT), tb};
            pg8::gemm_phase<EpiUp, pg8::MoeSched, true, true>(lds, S, E);
        }
        SYNC(5);
        if (IN(6)) {
            pg8::MoeSched S; S.A = ws + WS_ACT; S.Bt = ws + WS_WDOWN; S.rp = 1024; S.b_estride = (size_t)1024 * 1024; S.tb = tb; S.cnt = cn; S.list = (const int*)(ws + WS_LIST);
            S.nN = 4; S.nwg = tb[NE] * 4; S.G = G; S.c = bx; S.gather = false;
            EpiDown E{(const int*)(ws + WS_LIST), (const float*)(ws + WS_LGATE), P.b_down, (bf16_t*)(ws + WS_Y), tb};
            pg8::gemm_phase<EpiDown, pg8::MoeSched, true, true>(lds, S, E);
        }
    }
    SYNC(6);
    if (IN(7)) combine_phase(P, gw, NGW, lane);
    SYNC(7);
    if (IN(8)) {
        pg8::DenseSched S; S.init((const bf16_t*)(ws + WS_H1B), (const bf16_t*)(ws + WS_WG), NTOK, 1024, 1024, G, bx);
        EpiPle E{(const bf16_t*)(ws + WS_H1B), (const bf16_t*)(ws + WS_PJ), (const float*)(ws + WS_RS3), P.out};
        pg8::gemm_phase<EpiPle, pg8::DenseSched, false>(lds, S, E);
    }
    SYNC(8);
    if (IN(9)) final_phase(P, gw, NGW, lane);
#undef IN
#undef SYNC
}

#ifndef N_LAUNCH_MODE
#define N_LAUNCH_MODE 1
#endif
extern "C" void kernel_launch(void* const* d_in, const int* in_sizes, int n_in, void* d_out, int out_size, void* d_ws, size_t ws_size, hipStream_t stream) {
    static int grid = 0;
    if (grid == 0) {
        if (n_in != 21 || out_size != NTOK * DM || ws_size < WS_END) { fprintf(stderr, "kernel_launch: unexpected shapes (n_in %d out %d ws %zu)\n", n_in, out_size, ws_size); grid = -1; return; }
        int dev = 0, cus = 0, per_cu = 0;
        (void)hipGetDevice(&dev); (void)hipDeviceGetAttribute(&cus, hipDeviceAttributeMultiprocessorCount, dev);
        (void)hipFuncSetAttribute((const void*)fwd_kernel, hipFuncAttributeMaxDynamicSharedMemorySize, LDS_BYTES);
        if (hipOccupancyMaxActiveBlocksPerMultiprocessor(&per_cu, (const void*)fwd_kernel, NTHR, LDS_BYTES) != hipSuccess || per_cu < 1) { fprintf(stderr, "kernel_launch: occupancy query failed (%d)\n", per_cu); (void)hipGetLastError(); grid = -1; return; }
        grid = cus;
    }
    if (grid < 0) return;
    (void)hipMemsetAsync((char*)d_ws + WS_CTL, 0, CTL_BYTES, stream);
    Params p{};
    p.x = (const float*)d_in[0]; p.p = (const float*)d_in[1]; p.w_in = (const float*)d_in[2]; p.w_out = (const float*)d_in[3]; p.g_mix = (const float*)d_in[4]; p.g_ffn = (const float*)d_in[5];
    p.glu_b = (const float*)d_in[6]; p.dw_w = (const float*)d_in[7]; p.dw_b = (const float*)d_in[8]; p.ln_g = (const float*)d_in[9]; p.ln_b = (const float*)d_in[10];
    p.w_router = (const float*)d_in[11]; p.b_router = (const float*)d_in[12]; p.w_up = (const float*)d_in[13]; p.b_up = (const float*)d_in[14]; p.w_down = (const float*)d_in[15]; p.b_down = (const float*)d_in[16];
    p.w_ple_proj = (const float*)d_in[17]; p.w_ple_gate = (const float*)d_in[18]; p.g_ple = (const float*)d_in[19]; p.g_final = (const float*)d_in[20];
    p.out = (float*)d_out; p.ws = (unsigned char*)d_ws;
#ifndef PROBE_REPMASK
#define PROBE_REPMASK 0
#endif
    p.rep = PROBE_REPMASK;
#if N_LAUNCH_MODE == 1
    p.ph_lo = 0; p.ph_hi = NPHASE;
    void* args[] = {&p};
    hipError_t e = hipLaunchCooperativeKernel((const void*)fwd_kernel, dim3(grid), dim3(NTHR), args, LDS_BYTES, stream);
    if (e != hipSuccess) fprintf(stderr, "cooperative launch failed: %s (grid %d)\n", hipGetErrorString(e), grid);
#else
    for (int ph = 0; ph < NPHASE; ++ph) {
        p.ph_lo = ph; p.ph_hi = ph + 1;
        void* args[] = {&p};
        hipError_t e = hipLaunchCooperativeKernel((const void*)fwd_kernel, dim3(grid), dim3(NTHR), args, LDS_BYTES, stream);
        if (e != hipSuccess) { fprintf(stderr, "launch %d failed: %s (grid %d)\n", ph, hipGetErrorString(e), grid); break; }
    }
#endif
}
```

```cpp
#include <hip/hip_runtime.h>
#include <hip/hip_cooperative_groups.h>
#include <cstdio>
#include <cstdint>
namespace cg = cooperative_groups;

#define LAS __attribute__((address_space(3)))
#define GAS __attribute__((address_space(1)))
typedef unsigned short bf16_t;
typedef short bf16x8 __attribute__((ext_vector_type(8)));
typedef short s16x4 __attribute__((ext_vector_type(4)));
typedef float f32x4 __attribute__((ext_vector_type(4)));
typedef float f32x2 __attribute__((ext_vector_type(2)));
typedef float f32x16 __attribute__((ext_vector_type(16)));
typedef unsigned u32x4 __attribute__((ext_vector_type(4)));
typedef unsigned u32x2 __attribute__((ext_vector_type(2)));

constexpr int NB = 8, SEQ = 4096, DM = 1024, NTOK = NB * SEQ;
constexpr int NE = 32, TOPK = 4, NSLOT = NTOK * TOPK;
constexpr int INW = 1988;
constexpr int NSEL = 256;
constexpr float EPS = 1e-6f;
constexpr int NWAVES = 8, NTHR = 512;

constexpr size_t MiB = 1u << 20;
constexpr size_t WS_CTL = 0, CTL_BYTES = 64 * 1024;
constexpr size_t WS_ROPE = 1 * MiB;
constexpr size_t WS_WIN = 2 * MiB;
constexpr size_t WS_WOUT = 6 * MiB;
constexpr size_t WS_WG = 8 * MiB;
constexpr size_t WS_WP = 10 * MiB;
constexpr size_t WS_WRG = 10 * MiB + 512 * 1024;
constexpr size_t WS_RS1 = 11 * MiB;
constexpr size_t WS_RS3 = 11 * MiB + 512 * 1024;
constexpr size_t WS_WI = 12 * MiB;
constexpr size_t WS_LIST = 13 * MiB;
constexpr size_t WS_LSCALE = 17 * MiB;
constexpr size_t WS_LGATE = 21 * MiB;
constexpr size_t WS_PB = 25 * MiB;
constexpr size_t WS_WUP = 42 * MiB;
constexpr size_t WS_WDOWN = 170 * MiB;
constexpr size_t WS_H1 = 234 * MiB;
constexpr size_t WS_H1B = 362 * MiB;
constexpr size_t WS_PJ = 426 * MiB;
constexpr size_t WS_XB = 490 * MiB;
constexpr size_t WS_Q = 554 * MiB;
constexpr size_t WS_K = 586 * MiB;
constexpr size_t WS_V = 590 * MiB;
constexpr size_t WS_QI = 594 * MiB;
constexpr size_t WS_KI = 610 * MiB;
constexpr size_t WS_HGLU = 614 * MiB;
constexpr size_t WS_MIX = 646 * MiB;
constexpr size_t WS_H1F8 = 490 * MiB;
constexpr size_t WS_ACT = 522 * MiB;
constexpr size_t WS_Y = 762 * MiB;
constexpr size_t WS_G = 762 * MiB;
constexpr size_t WS_END = 1018 * MiB;
static_assert(WS_H1F8 + (size_t)NTOK * 1024 <= WS_ACT && WS_ACT + (size_t)139264 * 1024 <= WS_Y, "ws map");
constexpr int CW_CNT = 1024;
constexpr int CW_BAR = 8192;

constexpr int LDS_STAGE = 131072;
constexpr int LDS_MISC = LDS_STAGE;
constexpr int LDS_META = LDS_MISC + 4096;
constexpr int LDS_XB = 147456;
constexpr int LDS_BYTES = 147456 + 256;

__device__ __forceinline__ unsigned f2bf(float f) { unsigned u = __builtin_bit_cast(unsigned, f); return (u + 0x7fffu + ((u >> 16) & 1u)) >> 16; }
__device__ __forceinline__ unsigned pk2(float lo, float hi) { return f2bf(lo) | (f2bf(hi) << 16); }
__device__ __forceinline__ float bf_lo(unsigned w) { return __builtin_bit_cast(float, w << 16); }
__device__ __forceinline__ float bf_hi(unsigned w) { return __builtin_bit_cast(float, w & 0xffff0000u); }
__device__ __forceinline__ float wave_sum(float v) {
    v += __builtin_bit_cast(float, __builtin_amdgcn_update_dpp(0, __builtin_bit_cast(int, v), 0xB1, 0xF, 0xF, true));
    v += __builtin_bit_cast(float, __builtin_amdgcn_update_dpp(0, __builtin_bit_cast(int, v), 0x4E, 0xF, 0xF, true));
    v += __builtin_bit_cast(float, __builtin_amdgcn_update_dpp(0, __builtin_bit_cast(int, v), 0x141, 0xF, 0xF, true));
    v += __builtin_bit_cast(float, __builtin_amdgcn_update_dpp(0, __builtin_bit_cast(int, v), 0x140, 0xF, 0xF, true));
    const int vi = __builtin_bit_cast(int, v);
    const float r0 = __builtin_bit_cast(float, __builtin_amdgcn_readlane(vi, 0)), r1 = __builtin_bit_cast(float, __builtin_amdgcn_readlane(vi, 16));
    const float r2 = __builtin_bit_cast(float, __builtin_amdgcn_readlane(vi, 32)), r3 = __builtin_bit_cast(float, __builtin_amdgcn_readlane(vi, 48));
    return (r0 + r1) + (r2 + r3);
}
__device__ __forceinline__ unsigned pk4_fp8(float a, float b, float c, float d) { int r = __builtin_amdgcn_cvt_pk_fp8_f32(a, b, 0, false); r = __builtin_amdgcn_cvt_pk_fp8_f32(c, d, r, true); return (unsigned)r; }
__device__ __forceinline__ float sigmoidf_(float x) { return 1.0f / (1.0f + __expf(-x)); }
#define LDS_WAIT() asm volatile("s_waitcnt lgkmcnt(0)" ::: "memory")

struct Params {
    const float* x; const float* p; const float* w_in; const float* w_out; const float* g_mix; const float* g_ffn;
    const float* glu_b; const float* dw_w; const float* dw_b; const float* ln_g; const float* ln_b;
    const float* w_router; const float* b_router; const float* w_up; const float* b_up; const float* w_down; const float* b_down;
    const float* w_ple_proj; const float* w_ple_gate; const float* g_ple; const float* g_final;
    float* out; unsigned char* ws;
    int ph_lo, ph_hi, rep, pad;
};

namespace pg8 {
constexpr int BM = 256, BK = 64, HALF = 128, HTB = HALF * BK * 2, STAGE_BYTES = 8 * HTB, NXCD = 8, WGM = 8;
__host__ __device__ __forceinline__ int lds_byte(int r, int c) { const int st = (r >> 4) * 2 + (c >> 5), rr = r & 15, cc = c & 31, ob = rr * 64 + cc * 2; return st * 1024 + (ob ^ (((ob >> 9) & 1) << 5)); }
__host__ __device__ __forceinline__ void stage_rc(int b, int& R, int& C) { const int st = b / 1024, sb = b % 1024, swz = sb ^ (((sb >> 9) & 1) << 5); R = (st >> 1) * 16 + swz / 64; C = (st & 1) * 32 + (swz % 64) / 2; }
__host__ __device__ __forceinline__ int perm32(int rho) { const int n = rho >> 4, i = rho & 15; return 8 * (i >> 2) + 4 * n + (i & 3); }

struct Unit { int pm, pn, e, rows; };

__device__ __forceinline__ unsigned cvt_pk_bf16(float lo, float hi) { unsigned r; asm volatile("v_cvt_pk_bf16_f32 %0, %1, %2" : "=v"(r) : "v"(lo), "v"(hi)); return r; }

struct DenseSched {
    const void* A; const void* Bt; int rp;
    int nM, nN, nwg, G, c;
    __device__ void init(const void* A_, const void* Bt_, int M, int N, int K_, int G_, int c_) { A = A_; Bt = Bt_; rp = K_ * 2; nM = M / BM; nN = N / BM; nwg = nM * nN; G = G_; c = c_; }
    __device__ bool next(int i, Unit& u) const {
        const long L = (long)i * G + c; if (L >= nwg) return false;
        int wgid = (int)L; { const int q = nwg / NXCD, r = nwg % NXCD, xcd = wgid % NXCD, off = wgid / NXCD; wgid = (xcd < r ? xcd * (q + 1) : r * (q + 1) + (xcd - r) * q) + off; }
        const int nig = WGM * nN, gid = wgid / nig, fm = gid * WGM, gsz = (nM - fm) < WGM ? (nM - fm) : WGM;
        u.pm = fm + ((wgid % nig) % gsz); u.pn = (wgid % nig) / gsz; u.e = 0; u.rows = BM; return true;
    }
    __device__ __forceinline__ const char* a_ptr(const Unit& u) const { return (const char*)A + (size_t)u.pm * BM * rp; }
    __device__ __forceinline__ const char* b_ptr(const Unit& u) const { return (const char*)Bt + (size_t)u.pn * BM * rp; }
    __device__ __forceinline__ int a_row(const Unit&, int) const { return 0; }
    __device__ __forceinline__ void meta(const Unit&, LAS unsigned char*, int, int) const {}
};

struct MoeSched {
    const void* A; const void* Bt; int rp; size_t b_estride;
    const LAS int* tb;
    const LAS int* cnt;
    const int* list;
    int nN, nwg, G, c; bool gather;
    __device__ bool next(int i, Unit& u) const {
        const long L = (long)i * G + c; if (L >= nwg) return false;
        int wgid = (int)L; { const int q = nwg / NXCD, r = nwg % NXCD, xcd = wgid % NXCD, off = wgid / NXCD; wgid = (xcd < r ? xcd * (q + 1) : r * (q + 1) + (xcd - r) * q) + off; }
        int e = 0;
#pragma unroll 1
        for (; e < NE - 1; ++e) { if (wgid < tb[e + 1] * nN) break; }
        const int local = wgid - tb[e] * nN, nM = tb[e + 1] - tb[e];
        const int nig = WGM * nN, gid = local / nig, fm = gid * WGM, gsz = (nM - fm) < WGM ? (nM - fm) : WGM;
        const int rt = fm + ((local % nig) % gsz);
        u.pm = tb[e] + rt; u.pn = (local % nig) / gsz; u.e = e;
        const int left = cnt[e] - rt * BM; u.rows = left < BM ? left : BM; return true;
    }
    __device__ __forceinline__ const char* a_ptr(const Unit& u) const { return (const char*)A; }
    __device__ __forceinline__ const char* b_ptr(const Unit& u) const { return (const char*)Bt + (size_t)u.e * b_estride + (size_t)u.pn * BM * rp; }
    __device__ __forceinline__ int a_row(const Unit& u, int r) const {
        if (!gather) return u.pm * BM + r;
        const int rt = u.pm - tb[u.e];
        return r < u.rows ? (list[u.e * NTOK + rt * BM + r] >> 2) : 0;
    }
    const float* m_scale; const float* m_gate; const float* m_bias;
    __device__ __forceinline__ void meta(const Unit& u, LAS unsigned char* tbl, int wid, int lane) const {
        const int rt = u.pm - tb[u.e]; const size_t li = (size_t)u.e * NTOK + rt * BM + (wid & 3) * 64 + lane;
        if (gather) {
            if (wid < 4) __builtin_amdgcn_global_load_lds((const unsigned*)(m_scale + li), (LAS unsigned*)(tbl + (wid & 3) * 256), 4, 0, 0);
            else { const int j = (wid & 3) * 64 + lane; const float* src = m_bias + (size_t)u.e * 2048 + (j < 128 ? 128 * u.pn + j : 1024 + 128 * u.pn + (j - 128));
                __builtin_amdgcn_global_load_lds((const unsigned*)src, (LAS unsigned*)(tbl + 2048 + (wid & 3) * 256), 4, 0, 0); }
        } else {
            if (wid < 4) { __builtin_amdgcn_global_load_lds((const unsigned*)(list + li), (LAS unsigned*)(tbl + (wid & 3) * 256), 4, 0, 0);
                __builtin_amdgcn_global_load_lds((const unsigned*)(m_bias + (size_t)u.e * 1024 + u.pn * BM + (wid & 3) * 64 + lane), (LAS unsigned*)(tbl + 2048 + (wid & 3) * 256), 4, 0, 0); }
            else __builtin_amdgcn_global_load_lds((const unsigned*)(m_gate + li), (LAS unsigned*)(tbl + 1024 + (wid & 3) * 256), 4, 0, 0);
        }
    }
};

typedef int v8i32 __attribute__((ext_vector_type(8)));
template <class Epi, class Sched, bool GATHER, bool F8 = false>
__device__ __forceinline__ void gemm_phase(LAS unsigned char* lds, const Sched& S, const Epi& E) {
    const int tid = threadIdx.x, wid = __builtin_amdgcn_readfirstlane(tid >> 6), lane = tid & 63, wr = wid >> 2, wc = wid & 3, fr = lane & 15, fq = lane >> 4;
    const int RP = S.rp, nt = RP / (BK * 2);
    unsigned voffA[2], voffB[2]; int RA[2], CA[2];
#pragma unroll
    for (int i = 0; i < 2; ++i) { int R, C; stage_rc(tid * 16 + i * 8192, R, C); const int Rb = Epi::PERM ? ((R & ~31) + perm32(R & 31)) : R;
        voffA[i] = (unsigned)(R * RP + C * 2); voffB[i] = (unsigned)(Rb * RP + C * 2); RA[i] = R; CA[i] = C; }
    const size_t kstep = (size_t)(BK * 2);
    const size_t hstep = (size_t)HALF * RP;
    const unsigned ldsw = (unsigned)wid * 1024u;
    const int aoff = lds_byte(wr * 64 + fr, fq * 8), boff = lds_byte(wc * 32 + fr, fq * 8);
    unsigned gC[2][2], gN[2][2];
#define PG8_SA(b, h) (((b) * 2 + (h)) * HTB)
#define PG8_SB(b, h) ((4 + (b) * 2 + (h)) * HTB)
#define PG8_STAGE(bufoff, gbase, voff) do { _Pragma("unroll") for (int _i = 0; _i < 2; ++_i) \
        __builtin_amdgcn_global_load_lds((const unsigned*)((const char*)(gbase) + (voff)[_i]), (LAS unsigned*)(lds + (bufoff) + ldsw + _i * 8192), 16, 0, 0); } while (0)
#define PG8_STAGE_A(bufoff, kp, h) do { if constexpr (GATHER) { PG8_STAGE(bufoff, kp, gC[h]); } else { PG8_STAGE(bufoff, (kp) + (h) * hstep, voffA); } } while (0)
#define PG8_LD16(p) (*(const LAS bf16x8*)(p))
#define PG8_CAT(lo, hi) __builtin_bit_cast(v8i32, __builtin_shufflevector(lo, hi, 0, 1, 2, 3, 4, 5, 6, 7, 8, 9, 10, 11, 12, 13, 14, 15))
#define PG8_LDA(dst, b, h) do { _Pragma("unroll") for (int m = 0; m < 4; ++m) { if constexpr (F8) { dst##8[m] = PG8_CAT(PG8_LD16(lds + PG8_SA(b, h) + aoff + m * 2048), PG8_LD16(lds + PG8_SA(b, h) + aoff + m * 2048 + 1024)); } \
        else { _Pragma("unroll") for (int k = 0; k < 2; ++k) dst[m][k] = PG8_LD16(lds + PG8_SA(b, h) + aoff + m * 2048 + k * 1024); } } } while (0)
#define PG8_LDB(dst, b, h) do { _Pragma("unroll") for (int n = 0; n < 2; ++n) { if constexpr (F8) { dst##8[n] = PG8_CAT(PG8_LD16(lds + PG8_SB(b, h) + boff + n * 2048), PG8_LD16(lds + PG8_SB(b, h) + boff + n * 2048 + 1024)); } \
        else { _Pragma("unroll") for (int k = 0; k < 2; ++k) dst[n][k] = PG8_LD16(lds + PG8_SB(b, h) + boff + n * 2048 + k * 1024); } } } while (0)
#define PG8_MMA(ai, bj, At, Bt) do { __builtin_amdgcn_s_setprio(1); _Pragma("unroll") for (int m = 0; m < 4; ++m) _Pragma("unroll") for (int n = 0; n < 2; ++n) { \
        if constexpr (F8) { acc[ai][bj][m][n] = __builtin_amdgcn_mfma_scale_f32_16x16x128_f8f6f4(Bt##8[n], At##8[m], acc[ai][bj][m][n], 0, 0, 0, 0x7f7f7f7f, 0, 0x7f7f7f7f); } \
        else { _Pragma("unroll") for (int k = 0; k < 2; ++k) acc[ai][bj][m][n] = __builtin_amdgcn_mfma_f32_16x16x32_bf16(Bt[n][k], At[m][k], acc[ai][bj][m][n], 0, 0, 0); } } \
        __builtin_amdgcn_s_setprio(0); } while (0)
#define PG8_WAIT_V(n) asm volatile("s_waitcnt vmcnt(" #n ")" ::: "memory")
#define PG8_WAIT_L(n) asm volatile("s_waitcnt lgkmcnt(" #n ")" ::: "memory")
#define PG8_BAR __builtin_amdgcn_s_barrier()
#define PG8_SCHED __builtin_amdgcn_sched_barrier(0)
#define PG8_GOFF(dst, u) do { _Pragma("unroll") for (int _h = 0; _h < 2; ++_h) _Pragma("unroll") for (int _i = 0; _i < 2; ++_i) \
        dst[_h][_i] = (unsigned)(S.a_row(u, _h * HALF + RA[_i]) * RP + CA[_i] * 2); } while (0)
    Unit cur, nxt, nn; int ui = 0;
    if (!S.next(0, cur)) return;
    bool has_next = S.next(1, nxt);
    if constexpr (GATHER) { PG8_GOFF(gC, cur); if (has_next) { PG8_GOFF(gN, nxt); } else { PG8_GOFF(gN, cur); } }
    f32x4 acc[2][2][4][2];
#pragma unroll
    for (int a = 0; a < 2; ++a)
#pragma unroll
        for (int b = 0; b < 2; ++b)
#pragma unroll
            for (int m = 0; m < 4; ++m)
#pragma unroll
                for (int n = 0; n < 2; ++n) acc[a][b][m][n] = (f32x4){0.f, 0.f, 0.f, 0.f};
    bf16x8 At[4][2], B0[2][2], B1[2][2]; v8i32 At8[4], B08[2], B18[2];
    const char* cA = S.a_ptr(cur); const char* cB = S.b_ptr(cur);
    PG8_STAGE(PG8_SB(0, 0), cB, voffB); PG8_STAGE(PG8_SB(0, 1), cB + hstep, voffB); PG8_STAGE_A(PG8_SA(0, 0), cA, 0); PG8_STAGE_A(PG8_SA(0, 1), cA, 1);
    if (wr == 1) PG8_BAR;
    PG8_WAIT_V(2); PG8_BAR;
    PG8_STAGE(PG8_SB(1, 0), cB + kstep, voffB); PG8_STAGE_A(PG8_SA(1, 0), cA + kstep, 0); PG8_STAGE(PG8_SB(1, 1), cB + hstep + kstep, voffB);
    PG8_WAIT_V(6); PG8_BAR;
    for (;;) {
        const char* nA = has_next ? S.a_ptr(nxt) : cA; const char* nB = has_next ? S.b_ptr(nxt) : cB;
        S.meta(cur, lds + (LDS_META - 0) + (ui & 1) * 4096, wid, lane);
        for (int t = 0; t < nt; t += 2) {
            const bool last = (t == nt - 2);
            const char* a1 = cA + (size_t)(t + 1) * kstep;
            const char* a2 = last ? nA : cA + (size_t)(t + 2) * kstep; const char* b2 = last ? nB : cB + (size_t)(t + 2) * kstep;
            const char* a3 = a2 + kstep; const char* b3 = b2 + kstep;
            PG8_LDB(B0, 0, 0); PG8_LDB(B1, 0, 1); PG8_SCHED; PG8_LDA(At, 0, 0); PG8_STAGE_A(PG8_SA(1, 1), a1, 1);
            if constexpr (GATHER) { if (last) {
#pragma unroll
                for (int h = 0; h < 2; ++h)
#pragma unroll
                    for (int i = 0; i < 2; ++i) gC[h][i] = gN[h][i]; } }
            PG8_WAIT_V(8); PG8_WAIT_L(0); PG8_BAR; PG8_MMA(0, 0, At, B0); PG8_MMA(0, 1, At, B1); PG8_BAR; PG8_SCHED;
            PG8_LDA(At, 0, 1); PG8_STAGE(PG8_SB(0, 0), b2, voffB); PG8_STAGE(PG8_SB(0, 1), b2 + hstep, voffB); PG8_STAGE_A(PG8_SA(0, 0), a2, 0);
            PG8_WAIT_V(8); PG8_WAIT_L(0); PG8_BAR; PG8_MMA(1, 0, At, B0); PG8_MMA(1, 1, At, B1); PG8_BAR; PG8_SCHED;
            PG8_LDB(B0, 1, 0); PG8_LDB(B1, 1, 1); PG8_SCHED; PG8_LDA(At, 1, 0); PG8_STAGE_A(PG8_SA(0, 1), a2, 1);
            PG8_WAIT_V(8); PG8_WAIT_L(0); PG8_BAR; PG8_MMA(0, 0, At, B0); PG8_MMA(0, 1, At, B1); PG8_BAR; PG8_SCHED;
            PG8_LDA(At, 1, 1); PG8_STAGE(PG8_SB(1, 0), b3, voffB); PG8_STAGE(PG8_SB(1, 1), b3 + hstep, voffB); PG8_STAGE_A(PG8_SA(1, 0), a3, 0);
            PG8_WAIT_V(8); PG8_WAIT_L(0); PG8_BAR; PG8_MMA(1, 0, At, B0); PG8_MMA(1, 1, At, B1); PG8_BAR; PG8_SCHED;
        }
        if (wr == 0) PG8_BAR;
        bool has_nn = false;
        if constexpr (GATHER) { if (has_next) { has_nn = S.next(ui + 2, nn); if (has_nn) { PG8_GOFF(gN, nn); } } }
        else { if (has_next) has_nn = S.next(ui + 2, nn); }
        { int fr_ = fr, fq_ = fq; asm volatile("" : "+v"(fr_), "+v"(fq_));
          E(acc, cur, wr, wc, fr_, fq_, lds + LDS_META + (ui & 1) * 4096); }
        if (!has_next) break;
#pragma unroll
        for (int a = 0; a < 2; ++a)
#pragma unroll
            for (int b = 0; b < 2; ++b)
#pragma unroll
                for (int m = 0; m < 4; ++m)
#pragma unroll
                    for (int n = 0; n < 2; ++n) acc[a][b][m][n] = (f32x4){0.f, 0.f, 0.f, 0.f};
        cur = nxt; cA = nA; cB = nB; ++ui; nxt = nn; has_next = has_nn;
        if (wr == 1) PG8_BAR;
    }
    PG8_WAIT_V(0);
    PG8_BAR;
#undef PG8_SA
#undef PG8_SB
#undef PG8_STAGE
#undef PG8_STAGE_A
#undef PG8_LDA
#undef PG8_LDB
#undef PG8_MMA
#undef PG8_LD16
#undef PG8_CAT
#undef PG8_WAIT_V
#undef PG8_WAIT_L
#undef PG8_BAR
#undef PG8_SCHED
#undef PG8_GOFF
}
}

using pg8::Unit; using pg8::cvt_pk_bf16;
constexpr int BM = 256, HALF = 128;

struct EpiInProj {
    static constexpr bool PERM = true;
    const float* rs1; const f32x2* rope; const float* glu_b;
    bf16_t *q, *k, *v, *qi, *ki, *hglu; float* wi;
    __device__ __forceinline__ void operator()(const f32x4 (&acc)[2][2][4][2], const Unit& u, int wr, int wc, int fr, int fq, const LAS unsigned char* mt) const {
        const int row0 = u.pm * BM + wr * 64 + fr;
        if (u.pn >= 4) {
            const int ch = 128 * (u.pn - 4) + 32 * wc + 8 * fq;
            f32x4 ba[2], bg[2];
#pragma unroll
            for (int n = 0; n < 2; ++n) { ba[n] = *(const f32x4*)(glu_b + ch + 4 * n); bg[n] = *(const f32x4*)(glu_b + 512 + ch + 4 * n); }
#pragma unroll
            for (int ai = 0; ai < 2; ++ai)
#pragma unroll
                for (int m = 0; m < 4; ++m) { const int row = row0 + ai * HALF + m * 16; const float rs = rs1[row];
                    float o[8];
#pragma unroll
                    for (int n = 0; n < 2; ++n)
#pragma unroll
                        for (int e = 0; e < 4; ++e) { const float a = acc[ai][0][m][n][e] * rs + ba[n][e], g = acc[ai][1][m][n][e] * rs + bg[n][e]; o[4 * n + e] = a * sigmoidf_(g); }
                    u32x4 w; w.x = cvt_pk_bf16(o[0], o[1]); w.y = cvt_pk_bf16(o[2], o[3]); w.z = cvt_pk_bf16(o[4], o[5]); w.w = cvt_pk_bf16(o[6], o[7]);
                    *(u32x4*)(hglu + (size_t)row * 512 + ch) = w; }
            return;
        }
        bf16_t* dst; int ld, col; bool do_rope = true, is_wi = false;
        if (u.pn < 2) { dst = q; ld = 512; col = (4 * u.pn + wc) * 64; }
        else if (u.pn == 2) { dst = qi; ld = 256; col = wc * 64; }
        else { ld = 64; col = 0; if (wc == 0) dst = k; else if (wc == 1) dst = ki; else if (wc == 2) { dst = v; do_rope = false; } else { dst = v; is_wi = true; do_rope = false; } }
        if (is_wi) {
            if (fq == 0) {
#pragma unroll
                for (int ai = 0; ai < 2; ++ai)
#pragma unroll
                    for (int m = 0; m < 4; ++m) { const int row = row0 + ai * HALF + m * 16; const float rs = rs1[row];
                        *(f32x4*)(wi + (size_t)row * 4) = acc[ai][0][m][0] * rs; }
            }
            return;
        }
        const int d0 = 8 * fq;
#pragma unroll
        for (int ai = 0; ai < 2; ++ai)
#pragma unroll
            for (int m = 0; m < 4; ++m) { const int row = row0 + ai * HALF + m * 16; const float rs = rs1[row];
                float o1[8], o2[8];
                if (do_rope) {
                    const f32x2* rp = rope + (size_t)(row & (SEQ - 1)) * 32 + d0;
#pragma unroll
                    for (int n = 0; n < 2; ++n)
#pragma unroll
                        for (int e = 0; e < 4; ++e) { const f32x2 cs = rp[4 * n + e]; const float x1 = acc[ai][0][m][n][e] * rs, x2 = acc[ai][1][m][n][e] * rs;
                            o1[4 * n + e] = x1 * cs.x - x2 * cs.y; o2[4 * n + e] = x2 * cs.x + x1 * cs.y; }
                } else {
#pragma unroll
                    for (int n = 0; n < 2; ++n)
#pragma unroll
                        for (int e = 0; e < 4; ++e) { o1[4 * n + e] = acc[ai][0][m][n][e] * rs; o2[4 * n + e] = acc[ai][1][m][n][e] * rs; }
                }
                u32x4 w1, w2; w1.x = cvt_pk_bf16(o1[0], o1[1]); w1.y = cvt_pk_bf16(o1[2], o1[3]); w1.z = cvt_pk_bf16(o1[4], o1[5]); w1.w = cvt_pk_bf16(o1[6], o1[7]);
                w2.x = cvt_pk_bf16(o2[0], o2[1]); w2.y = cvt_pk_bf16(o2[2], o2[3]); w2.z = cvt_pk_bf16(o2[4], o2[5]); w2.w = cvt_pk_bf16(o2[6], o2[7]);
                bf16_t* rp2 = dst + (size_t)row * ld + col + d0;
                *(u32x4*)(rp2) = w1; *(u32x4*)(rp2 + 32) = w2; }
    }
};

struct EpiBf16Plain {
    static constexpr bool PERM = true;
    bf16_t* O; int ldc;
    __device__ __forceinline__ void operator()(const f32x4 (&acc)[2][2][4][2], const Unit& u, int wr, int wc, int fr, int fq, const LAS unsigned char* mt) const {
        const int row0 = u.pm * BM + wr * 64 + fr, col0 = u.pn * BM + wc * 32 + 8 * fq;
#pragma unroll
        for (int ai = 0; ai < 2; ++ai)
#pragma unroll
            for (int m = 0; m < 4; ++m) { bf16_t* rowp = O + (size_t)(row0 + ai * HALF + m * 16) * ldc + col0;
#pragma unroll
                for (int bj = 0; bj < 2; ++bj) { const f32x4 v0 = acc[ai][bj][m][0], v1 = acc[ai][bj][m][1];
                    u32x4 w; w.x = cvt_pk_bf16(v0[0], v0[1]); w.y = cvt_pk_bf16(v0[2], v0[3]); w.z = cvt_pk_bf16(v1[0], v1[1]); w.w = cvt_pk_bf16(v1[2], v1[3]);
                    *(u32x4*)(rowp + bj * HALF) = w; } }
    }
};

struct EpiOutProj {
    static constexpr bool PERM = false;
    const float* x; float* h1; unsigned char* h1f8;
    __device__ __forceinline__ void operator()(const f32x4 (&acc)[2][2][4][2], const Unit& u, int wr, int wc, int fr, int fq, const LAS unsigned char* mt) const {
        const int row0 = u.pm * BM + wr * 64 + fr, col0 = u.pn * BM + wc * 32 + 4 * fq;
#pragma unroll
        for (int ai = 0; ai < 2; ++ai)
#pragma unroll
            for (int m = 0; m < 4; ++m) { const size_t off = (size_t)(row0 + ai * HALF + m * 16) * DM + col0;
#pragma unroll
                for (int bj = 0; bj < 2; ++bj)
#pragma unroll
                    for (int n = 0; n < 2; ++n) { const size_t o = off + bj * HALF + n * 16; const f32x4 r = *(const f32x4*)(x + o) + acc[ai][bj][m][n];
                        *(f32x4*)(h1 + o) = r; *(unsigned*)(h1f8 + o) = pk4_fp8(r[0], r[1], r[2], r[3]); } }
    }
};

struct EpiUp {
    static constexpr bool PERM = true;
    unsigned char* act;
    __device__ __forceinline__ void operator()(const f32x4 (&acc)[2][2][4][2], const Unit& u, int wr, int wc, int fr, int fq, const LAS unsigned char* mt) const {
        const int r0 = wr * 64 + fr, cl = 32 * wc + 8 * fq, ch = 128 * u.pn + cl;
        const LAS float* rowA = (const LAS float*)mt; const LAS float* bias = (const LAS float*)(mt + 2048);
        f32x4 bg[2], bl[2];
#pragma unroll
        for (int n = 0; n < 2; ++n) { bg[n] = *(const LAS f32x4*)(bias + cl + 4 * n); bl[n] = *(const LAS f32x4*)(bias + 128 + cl + 4 * n); }
#pragma unroll
        for (int ai = 0; ai < 2; ++ai)
#pragma unroll
            for (int m = 0; m < 4; ++m) { const int r = r0 + ai * HALF + m * 16;
                const float rs = (r < u.rows) ? rowA[r] * 0.03125f : 0.f;
                float o[8];
#pragma unroll
                for (int n = 0; n < 2; ++n)
#pragma unroll
                    for (int e = 0; e < 4; ++e) { float g = acc[ai][0][m][n][e] * rs + bg[n][e], l = acc[ai][1][m][n][e] * rs + bl[n][e];
                        g = fminf(g, 7.0f); l = fminf(fmaxf(l, -7.0f), 7.0f); o[4 * n + e] = g * sigmoidf_(1.702f * g) * (l + 1.0f); }
                u32x2 w; w.x = pk4_fp8(o[0], o[1], o[2], o[3]); w.y = pk4_fp8(o[4], o[5], o[6], o[7]);
                *(u32x2*)(act + (size_t)(u.pm * BM + r) * 1024 + ch) = w; }
    }
};

struct EpiDown {
    static constexpr bool PERM = true;
    bf16_t* y;
    __device__ __forceinline__ void operator()(f32x4 (&acc)[2][2][4][2], const Unit& u, int wr, int wc, int fr, int fq, const LAS unsigned char* mt) const {
        const int r0 = wr * 64 + fr, cl = wc * 32 + 8 * fq, col0 = u.pn * BM + cl;
        const LAS int* slotT = (const LAS int*)mt; const LAS float* gateT = (const LAS float*)(mt + 1024); const LAS float* bias = (const LAS float*)(mt + 2048);
#pragma unroll
        for (int bj = 0; bj < 2; ++bj)
#pragma unroll
            for (int n = 0; n < 2; ++n) { const f32x4 bv = *(const LAS f32x4*)(bias + cl + bj * HALF + 4 * n);
#pragma unroll
                for (int ai = 0; ai < 2; ++ai)
#pragma unroll
                    for (int m = 0; m < 4; ++m) acc[ai][bj][m][n] = acc[ai][bj][m][n] * 0.03125f + bv; }
#pragma unroll
        for (int ai = 0; ai < 2; ++ai)
#pragma unroll
            for (int m = 0; m < 4; ++m) { const int r = r0 + ai * HALF + m * 16;
                if (r < u.rows) { const int slot = slotT[r]; const float g = gateT[r];
                    bf16_t* rowp = y + (size_t)slot * 1024 + col0;
#pragma unroll
                    for (int bj = 0; bj < 2; ++bj) { const f32x4 v0 = acc[ai][bj][m][0] * g, v1 = acc[ai][bj][m][1] * g;
                        u32x4 w; w.x = cvt_pk_bf16(v0[0], v0[1]); w.y = cvt_pk_bf16(v0[2], v0[3]); w.z = cvt_pk_bf16(v1[0], v1[1]); w.w = cvt_pk_bf16(v1[2], v1[3]);
                        *(u32x4*)(rowp + bj * HALF) = w; } } }
    }
};

struct EpiPle {
    static constexpr bool PERM = false;
    const bf16_t* h2b; const bf16_t* pj; const float* rs3; float* out;
    __device__ __forceinline__ void operator()(const f32x4 (&acc)[2][2][4][2], const Unit& u, int wr, int wc, int fr, int fq, const LAS unsigned char* mt) const {
        const int row0 = u.pm * BM + wr * 64 + fr, col0 = u.pn * BM + wc * 32 + 4 * fq;
#pragma unroll
        for (int ai = 0; ai < 2; ++ai)
#pragma unroll
            for (int m = 0; m < 4; ++m) { const int row = row0 + ai * HALF + m * 16; const size_t off = (size_t)row * DM + col0; const float rs = rs3[row];
#pragma unroll
                for (int bj = 0; bj < 2; ++bj)
#pragma unroll
                    for (int n = 0; n < 2; ++n) { const size_t o = off + bj * HALF + n * 16; const u32x2 hw = *(const u32x2*)(h2b + o); const f32x4 hv = {bf_lo(hw.x), bf_hi(hw.x), bf_lo(hw.y), bf_hi(hw.y)}; const u32x2 pw = *(const u32x2*)(pj + o);
                        const f32x4 a = acc[ai][bj][m][n]; f32x4 r;
                        r[0] = hv[0] + bf_lo(pw.x) * sigmoidf_(a[0] * rs); r[1] = hv[1] + bf_hi(pw.x) * sigmoidf_(a[1] * rs);
                        r[2] = hv[2] + bf_lo(pw.y) * sigmoidf_(a[2] * rs); r[3] = hv[3] + bf_hi(pw.y) * sigmoidf_(a[3] * rs);
                        *(f32x4*)(out + o) = r; } }
    }
};

template <bool F8>
__device__ __forceinline__ void p0_transpose_item(const float* W, int ldw, void* WTv, int Kdim, const float* gain, LAS float* scr, int kb, int n0, int src0, int nvalid, int lane) {
    bf16_t* WT = (bf16_t*)WTv;
    const int k0 = 64 * kb;
    f32x4 ld4[8];
#pragma unroll
    for (int i = 0; i < 8; ++i) { const int kk = 8 * i + (lane >> 3), j = (lane & 7) * 4;
        ld4[i] = (f32x4){0.f, 0.f, 0.f, 0.f}; if (j < nvalid) ld4[i] = *(const f32x4*)(W + (size_t)(k0 + kk) * ldw + src0 + j); }
#pragma unroll
    for (int i = 0; i < 8; ++i) { const int kk = 8 * i + (lane >> 3), j = (lane & 7) * 4; const float gk = (gain ? gain[k0 + kk] : 1.0f) * (F8 ? 32.0f : 1.0f);
        LAS float* d = scr + kk * 33 + j; d[0] = ld4[i].x * gk; d[1] = ld4[i].y * gk; d[2] = ld4[i].z * gk; d[3] = ld4[i].w * gk; }
    LDS_WAIT(); asm volatile("" ::: "memory");
    const int c = lane & 7;
#pragma unroll
    for (int j = 0; j < 4; ++j) { const int n = (lane >> 3) + 8 * j; const LAS float* s = scr + (8 * c) * 33 + n;
        if constexpr (F8) { u32x2 o; o.x = pk4_fp8(s[0 * 33], s[1 * 33], s[2 * 33], s[3 * 33]); o.y = pk4_fp8(s[4 * 33], s[5 * 33], s[6 * 33], s[7 * 33]);
            *(u32x2*)((unsigned char*)WTv + (size_t)(n0 + n) * Kdim + k0 + 8 * c) = o; }
        else { u32x4 o; o.x = pk2(s[0 * 33], s[1 * 33]); o.y = pk2(s[2 * 33], s[3 * 33]); o.z = pk2(s[4 * 33], s[5 * 33]); o.w = pk2(s[6 * 33], s[7 * 33]);
            *(u32x4*)(WT + (size_t)(n0 + n) * Kdim + k0 + 8 * c) = o; } }
    LDS_WAIT(); asm volatile("" ::: "memory");
}
__device__ __forceinline__ void win_colmap(int nb, int& src0, int& nvalid) {
    const int pn = nb >> 3, j = (nb & 7) * 32, bj = j >> 7, slot = (j & 127) >> 5;
    nvalid = 32;
    if (pn < 2) src0 = (4 * pn + slot) * 64 + 32 * bj;
    else if (pn == 2) src0 = 640 + slot * 64 + 32 * bj;
    else if (pn == 3) { if (slot == 0) src0 = 512 + 32 * bj; else if (slot == 1) src0 = 896 + 32 * bj; else if (slot == 2) src0 = 576 + 32 * bj; else { src0 = 960; nvalid = bj == 0 ? 4 : 0; } }
    else src0 = 964 + 512 * bj + 128 * (pn - 4) + 32 * slot;
}
__device__ __forceinline__ void p0_prologue(const Params& P, LAS unsigned char* lds, int vcu, int G, int wave, int lane) {
    unsigned char* ws = P.ws;
    LAS float* scr = (LAS float*)(lds + wave * 16384);
    const int gw = vcu * NWAVES + wave, NGW = G * NWAVES;
    constexpr int I_IN = 16 * 64, I_OUT = 16 * 32, I_G = 16 * 32, I_P = 4 * 32, I_UP = 32 * 16 * 64, I_DN = 32 * 16 * 32;
    constexpr int NITEMS = I_IN + I_OUT + I_G + I_P + I_UP + I_DN;
    for (int it = gw; it < NITEMS; it += NGW) {
        int r = it;
        if (r < I_IN) { const int kb = r / 64, nb = r % 64; int s0, nv; win_colmap(nb, s0, nv); p0_transpose_item<false>(P.w_in, INW, (bf16_t*)(ws + WS_WIN), 1024, P.g_mix, scr, kb, nb * 32, s0, nv, lane); continue; } r -= I_IN;
        if (r < I_OUT) { const int kb = r / 32, nb = r % 32; p0_transpose_item<false>(P.w_out, 1024, (bf16_t*)(ws + WS_WOUT), 1024, nullptr, scr, kb, nb * 32, nb * 32, 32, lane); continue; } r -= I_OUT;
        if (r < I_G) { const int kb = r / 32, nb = r % 32; p0_transpose_item<false>(P.w_ple_gate, 1024, (bf16_t*)(ws + WS_WG), 1024, P.g_ple, scr, kb, nb * 32, nb * 32, 32, lane); continue; } r -= I_G;
        if (r < I_P) { const int kb = r / 32, nb = r % 32; p0_transpose_item<false>(P.w_ple_proj, 1024, (bf16_t*)(ws + WS_WP), 256, nullptr, scr, kb, nb * 32, nb * 32, 32, lane); continue; } r -= I_P;
        if (r < I_UP) { const int e = r / 1024, rr = r % 1024, kb = rr / 64, nb = rr % 64;
            const int pn = nb >> 3, j = (nb & 7) * 32, bj = j >> 7, jj = j & 127;
            p0_transpose_item<true>(P.w_up + (size_t)e * 1024 * 2048, 2048, (unsigned char*)(ws + WS_WUP) + (size_t)e * 2048 * 1024, 1024, P.g_ffn, scr, kb, nb * 32, 1024 * bj + 128 * pn + jj, 32, lane); continue; } r -= I_UP;
        { const int e = r / 512, rr = r % 512, kb = rr / 32, nb = rr % 32;
            p0_transpose_item<true>(P.w_down + (size_t)e * 1024 * 1024, 1024, (unsigned char*)(ws + WS_WDOWN) + (size_t)e * 1024 * 1024, 1024, nullptr, scr, kb, nb * 32, nb * 32, 32, lane); }
    }
    float* rs1 = (float*)(ws + WS_RS1); bf16_t* xb = (bf16_t*)(ws + WS_XB);
    for (int m = gw; m < NTOK; m += NGW) {
        const f32x4* xr = (const f32x4*)(P.x + (size_t)m * DM) + lane; f32x4 v[4]; float s = 0.f;
#pragma unroll
        for (int j = 0; j < 4; ++j) { v[j] = xr[64 * j]; s += (v[j].x * v[j].x + v[j].y * v[j].y) + (v[j].z * v[j].z + v[j].w * v[j].w); }
        s = wave_sum(s);
        u32x2* o8 = (u32x2*)(xb + (size_t)m * DM) + lane;
#pragma unroll
        for (int j = 0; j < 4; ++j) { u32x2 w; w.x = pk2(v[j].x, v[j].y); w.y = pk2(v[j].z, v[j].w); o8[64 * j] = w; }
        if (lane == 0) rs1[m] = 1.0f / sqrtf(s * (1.0f / DM) + EPS);
    }
    bf16_t* pb = (bf16_t*)(ws + WS_PB);
    for (int m = gw; m < NTOK; m += NGW) { const f32x4 v = *((const f32x4*)(P.p + (size_t)m * 256) + lane); u32x2 w; w.x = pk2(v.x, v.y); w.y = pk2(v.z, v.w); *((u32x2*)(pb + (size_t)m * 256) + lane) = w; }
    f32x2* rope = (f32x2*)(ws + WS_ROPE);
    for (int idx = gw * 64 + lane; idx < SEQ * 32; idx += NGW * 64) { const int t = idx >> 5, i = idx & 31;
        const float inv = exp2f(-(float)i * (13.287712379549449f / 32.0f));
        const float ang = (float)t * inv;
        const double rev = (double)ang * 0.15915494309189535; const float fr = (float)(rev - __builtin_floor(rev));
        rope[idx] = (f32x2){__builtin_amdgcn_cosf(fr), __builtin_amdgcn_sinf(fr)}; }
    float* wrg = (float*)(ws + WS_WRG);
    for (int idx = gw * 64 + lane; idx < 1024 * 32; idx += NGW * 64) wrg[idx] = P.w_router[idx] * P.g_ffn[idx >> 5];
}

__device__ __forceinline__ unsigned fkey(float f) { unsigned u = __builtin_bit_cast(unsigned, f); if (u == 0x80000000u) u = 0u; return u ^ ((unsigned)((int)u >> 31) | 0x80000000u); }
__device__ __forceinline__ int mbcnt64(unsigned long long m) { return __builtin_amdgcn_mbcnt_hi((unsigned)(m >> 32), __builtin_amdgcn_mbcnt_lo((unsigned)m, 0u)); }

template <int NR>
__device__ __forceinline__ unsigned bisect_thr(const unsigned (&v)[NR], unsigned prefix, int startbit) {
    bool exact = false;
#pragma unroll 1
    for (int bit = startbit; bit >= 0; --bit) {
        const unsigned cand = prefix | (1u << bit); int cnt = 0;
#pragma unroll
        for (int r = 0; r < NR; ++r) { cnt += __builtin_popcountll(__ballot(v[r] >= cand)); if ((r & 7) == 7) __builtin_amdgcn_sched_barrier(0); }
        if (cnt >= NSEL) prefix = cand;
        if (cnt == NSEL) { exact = true; break; }
    }
    return exact ? prefix - 1u : prefix;
}
template <int NR, bool EXPL>
__device__ __forceinline__ void compact_sel(const unsigned (&v)[NR], const unsigned (&ci)[NR], unsigned T, LAS unsigned* list, int lane) {
    int cgt = 0;
#pragma unroll
    for (int r = 0; r < NR; ++r) { cgt += __builtin_popcountll(__ballot(v[r] > T)); if ((r & 7) == 7) __builtin_amdgcn_sched_barrier(0); }
    const int need = NSEL - cgt; int base = 0, ties = 0;
#pragma unroll
    for (int r = 0; r < NR; ++r) { const bool gt = v[r] > T, eq = v[r] == T; const unsigned long long em = __ballot(eq);
        const bool sel = gt || (eq && (ties + mbcnt64(em)) < need); const unsigned long long sm = __ballot(sel);
        list[sel ? base + mbcnt64(sm) : NSEL + lane] = EXPL ? ci[r] : (unsigned)(r * 64 + lane);
        base += __builtin_popcountll(sm); ties += __builtin_popcountll(em);
        if ((r & 3) == 3) __builtin_amdgcn_sched_barrier(0); }
}
constexpr int SEL_CAP = 1024;
template <int NR>
__device__ __forceinline__ void select_topk(LAS float* row, LAS unsigned* H, LAS unsigned* list, int lane, bool zero_h) {
    unsigned v[NR];
#pragma unroll
    for (int r = 0; r < NR; ++r) v[r] = fkey(row[r * 64 + lane]);
    LAS u32x4* H4 = (LAS u32x4*)H;
    const u32x4 h0 = H4[2 * lane], h1 = H4[2 * lane + 1];
    if (zero_h) { H4[2 * lane] = (u32x4){0u, 0u, 0u, 0u}; H4[2 * lane + 1] = (u32x4){0u, 0u, 0u, 0u}; }
    const unsigned hw[8] = {h0.x, h0.y, h0.z, h0.w, h1.x, h1.y, h1.z, h1.w};
    unsigned c[16];
#pragma unroll
    for (int i = 0; i < 8; ++i) { c[2 * i] = hw[i] & 0xffffu; c[2 * i + 1] = hw[i] >> 16; }
    unsigned s = 0u;
#pragma unroll
    for (int i = 0; i < 16; ++i) s += c[i];
    unsigned S = s;
#pragma unroll
    for (int off = 1; off < 64; off <<= 1) { const unsigned o = __shfl_down(S, off); if (lane + off < 64) S += o; }
    const unsigned long long okm = __ballot(S >= (unsigned)NSEL);
    bool fast = okm != 0ull; unsigned floorkey = 0u; int C = 0;
    if (fast) {
        const int Ls = 63 - __builtin_clzll(okm);
        unsigned acc = S - s; int bl = -1; unsigned accb = 0u;
#pragma unroll
        for (int b = 15; b >= 0; --b) { acc += c[b]; if (bl < 0 && acc >= (unsigned)NSEL) { bl = b; accb = acc; } }
        const int bstar = __shfl(bl, Ls) + 16 * Ls; C = (int)__shfl(accb, Ls);
        floorkey = (unsigned)bstar << 22;
        fast = (bstar > 1) && (C <= SEL_CAP);
    }
    if (!fast) {
        const unsigned T = bisect_thr<NR>(v, 0u, 31);
        compact_sel<NR, false>(v, v, T, list, lane);
        return;
    }
    LAS unsigned* ckl = (LAS unsigned*)row; LAS unsigned* cil = ckl + 1152;
    { int base = 0;
#pragma unroll
      for (int r = 0; r < NR; ++r) { const bool cnd = v[r] >= floorkey; const unsigned long long m = __ballot(cnd);
          const int pos = cnd ? base + mbcnt64(m) : SEL_CAP + lane;
          ckl[pos] = v[r]; cil[pos] = (unsigned)(r * 64 + lane); base += __builtin_popcountll(m);
          if ((r & 3) == 3) __builtin_amdgcn_sched_barrier(0); } }
    if (C <= 512) {
        unsigned ck[8], ci[8];
#pragma unroll
        for (int j = 0; j < 8; ++j) { const int i = j * 64 + lane; ck[j] = i < C ? ckl[i] : 0u; ci[j] = cil[i]; }
        const unsigned T = (C == NSEL) ? floorkey - 1u : bisect_thr<8>(ck, floorkey, 21);
        compact_sel<8, true>(ck, ci, T, list, lane);
    } else {
        unsigned ck[16], ci[16];
#pragma unroll
        for (int j = 0; j < 16; ++j) { const int i = j * 64 + lane; ck[j] = i < C ? ckl[i] : 0u; ci[j] = cil[i]; }
        const unsigned T = bisect_thr<16>(ck, floorkey, 21);
        compact_sel<16, true>(ck, ci, T, list, lane);
    }
}

typedef short v4i16 __attribute__((ext_vector_type(4)));
constexpr int VROW = 144;

__device__ __forceinline__ void attn_tile(const Params& P, LAS unsigned char* lds, int b, int t0, int wave, int lane) {
    unsigned char* ws = P.ws;
    const bf16_t* QI = (const bf16_t*)(ws + WS_QI); const bf16_t* KI = (const bf16_t*)(ws + WS_KI);
    const bf16_t* Q = (const bf16_t*)(ws + WS_Q); const bf16_t* Kp = (const bf16_t*)(ws + WS_K); const bf16_t* Vp = (const bf16_t*)(ws + WS_V);
    const float* WI = (const float*)(ws + WS_WI); bf16_t* MIX = (bf16_t*)(ws + WS_MIX);
    LAS float* SC = (LAS float*)lds;
    LAS unsigned* list = (LAS unsigned*)(lds + wave * 16384 + 14336);
    LAS unsigned* HIST = (LAS unsigned*)(lds + LDS_MISC);
    const int tokbase = b * SEQ;
    const bool need_sel = t0 >= 256;
    if (need_sel) {
        const int nkt = (t0 + 8 + 31) >> 5;
        bf16x8 a[4]; f32x4 w[4];
        { const bf16_t* src = QI + (size_t)(tokbase + t0 + ((lane & 31) >> 2)) * 256 + (lane & 3) * 64 + 8 * (lane >> 5);
#pragma unroll
          for (int ks = 0; ks < 4; ++ks) a[ks] = *(const bf16x8*)(src + 16 * ks); }
#pragma unroll
        for (int g = 0; g < 4; ++g) w[g] = *(const f32x4*)(WI + (size_t)(tokbase + t0 + 2 * g + (lane >> 5)) * 4);
        for (int kt0 = wave; kt0 < nkt; kt0 += 4 * NWAVES) {
            bf16x8 bf[4][4];
#pragma unroll
            for (int u = 0; u < 4; ++u) { const int kt = kt0 + u * NWAVES;
                if (kt < nkt) { const bf16_t* ksrc = KI + (size_t)(tokbase + kt * 32 + (lane & 31)) * 64 + 8 * (lane >> 5);
#pragma unroll
                    for (int ks = 0; ks < 4; ++ks) bf[u][ks] = *(const bf16x8*)(ksrc + 16 * ks); } }
#pragma unroll
            for (int u = 0; u < 4; ++u) { const int kt = kt0 + u * NWAVES;
                if (kt < nkt) {
                    const int key = kt * 32 + (lane & 31);
                    f32x16 acc;
#pragma unroll
                    for (int i = 0; i < 16; ++i) acc[i] = 0.f;
#pragma unroll
                    for (int ks = 0; ks < 4; ++ks) acc = __builtin_amdgcn_mfma_f32_32x32x16_bf16(a[ks], bf[u][ks], acc, 0, 0, 0);
#pragma unroll
                    for (int g = 0; g < 4; ++g) { float sc = 0.f;
#pragma unroll
                        for (int h = 0; h < 4; ++h) sc = fmaf(fmaxf(acc[4 * g + h], 0.f), w[g][h], sc);
                        const int ql = 2 * g + (lane >> 5);
                        if (key > t0 + ql) sc = -INFINITY;
                        SC[ql * 4096 + key] = sc;
                        if (key <= t0 + ql) { const unsigned ub = __builtin_bit_cast(unsigned, sc);
                            const unsigned bin = (ub >> 22) ^ (((unsigned)((int)ub >> 31) & 0x1ffu) | 0x200u);
                            __hip_atomic_fetch_add(HIST + ql * 512 + (bin >> 1), 1u << ((bin & 1u) << 4), __ATOMIC_RELAXED, __HIP_MEMORY_SCOPE_WORKGROUP); } }
                } }
        }
        { const int npad = ((t0 + 8 + 1023) >> 10) << 10;
          for (int i = nkt * 32 + (int)threadIdx.x; i < npad; i += NTHR) {
#pragma unroll
              for (int q = 0; q < 8; ++q) SC[q * 4096 + i] = -INFINITY; } }
    }
    __syncthreads();
    const int t = t0 + wave, tok = tokbase + t;
    if (need_sel) {
        LAS float* row = SC + wave * 4096; LAS unsigned* H = HIST + wave * 512; const int n = t + 1;
        if (n <= 1024) select_topk<16>(row, H, list, lane, true);
        else if (n <= 2048) select_topk<32>(row, H, list, lane, true);
        else if (n <= 3072) select_topk<48>(row, H, list, lane, true);
        else select_topk<64>(row, H, list, lane, true);
    } else {
#pragma unroll
        for (int i = 0; i < 4; ++i) list[i * 64 + lane] = (unsigned)(i * 64 + lane);
    }
    const int nvalid = need_sel ? NSEL : (t + 1);
    const int ngrp = (nvalid + 31) >> 5;
    const int hd = lane & 15, g = lane >> 4;
    bf16x8 qf0, qf1;
#pragma unroll
    for (int i = 0; i < 8; ++i) { qf0[i] = 0; qf1[i] = 0; }
    if (hd < 8) { const bf16_t* qs = Q + (size_t)tok * 512 + hd * 64 + 8 * g; qf0 = *(const bf16x8*)qs; qf1 = *(const bf16x8*)(qs + 32); }
    float m = -INFINITY, ssum = 0.f;
    f32x4 o[4];
#pragma unroll
    for (int dt = 0; dt < 4; ++dt) o[dt] = (f32x4){0.f, 0.f, 0.f, 0.f};
    LAS unsigned char* vreg = lds + wave * 16384;
    bf16x8 kfA[4], kfB[4]; u32x4 vvA[4], vvB[4];
#define ATT_LOAD(KF, VV, G_) do { const int nb_ = (G_) * 32; const unsigned ia_ = list[nb_ + hd], ib_ = list[nb_ + 16 + hd]; \
        const bf16_t* ka_ = Kp + (size_t)(tokbase + ia_) * 64 + 8 * g; const bf16_t* kb_ = Kp + (size_t)(tokbase + ib_) * 64 + 8 * g; \
        KF[0] = *(const bf16x8*)ka_; KF[1] = *(const bf16x8*)(ka_ + 32); KF[2] = *(const bf16x8*)kb_; KF[3] = *(const bf16x8*)(kb_ + 32); \
        _Pragma("unroll") for (int i_ = 0; i_ < 4; ++i_) { const unsigned idx_ = list[nb_ + (lane >> 3) + 8 * i_]; VV[i_] = *(const u32x4*)(Vp + (size_t)(tokbase + idx_) * 64 + 8 * (lane & 7)); } } while (0)
#define ATT_GROUP(KF, VV, G_, VBUF) do { \
        LAS unsigned char* vbuf_ = (VBUF); \
        f32x4 sa_ = {0.f, 0.f, 0.f, 0.f}, sb_ = {0.f, 0.f, 0.f, 0.f}; \
        sa_ = __builtin_amdgcn_mfma_f32_16x16x32_bf16(KF[0], qf0, sa_, 0, 0, 0); sa_ = __builtin_amdgcn_mfma_f32_16x16x32_bf16(KF[1], qf1, sa_, 0, 0, 0); \
        sb_ = __builtin_amdgcn_mfma_f32_16x16x32_bf16(KF[2], qf0, sb_, 0, 0, 0); sb_ = __builtin_amdgcn_mfma_f32_16x16x32_bf16(KF[3], qf1, sb_, 0, 0, 0); \
        _Pragma("unroll") for (int i_ = 0; i_ < 4; ++i_) *(LAS u32x4*)(vbuf_ + ((lane >> 3) + 8 * i_) * VROW + (lane & 7) * 16) = VV[i_]; \
        if ((G_) + 2 < ngrp) ATT_LOAD(KF, VV, (G_) + 2); \
        float l_[8]; float mloc_ = -INFINITY; \
        _Pragma("unroll") for (int r_ = 0; r_ < 4; ++r_) { const int sl_ = (G_) * 32 + 4 * g + r_; \
            l_[r_] = sl_ < nvalid ? sa_[r_] * 0.125f : -INFINITY; l_[4 + r_] = (sl_ + 16) < nvalid ? sb_[r_] * 0.125f : -INFINITY; \
            mloc_ = fmaxf(mloc_, fmaxf(l_[r_], l_[4 + r_])); } \
        mloc_ = fmaxf(mloc_, __shfl_xor(mloc_, 16)); mloc_ = fmaxf(mloc_, __shfl_xor(mloc_, 32)); \
        const float mnew_ = fmaxf(m, mloc_), alpha_ = __expf(m - mnew_); m = mnew_; \
        float ps_ = 0.f; \
        _Pragma("unroll") for (int r_ = 0; r_ < 8; ++r_) { l_[r_] = __expf(l_[r_] - mnew_); ps_ += l_[r_]; } \
        ssum = ssum * alpha_ + ps_; \
        bf16x8 pf_; \
        { const u32x4 pw_ = {cvt_pk_bf16(l_[0], l_[1]), cvt_pk_bf16(l_[2], l_[3]), cvt_pk_bf16(l_[4], l_[5]), cvt_pk_bf16(l_[6], l_[7])}; pf_ = __builtin_bit_cast(bf16x8, pw_); } \
        LAS unsigned char* ta_ = vbuf_ + (4 * g + (hd >> 2)) * VROW + (hd & 3) * 8; \
        _Pragma("unroll") for (int dt_ = 0; dt_ < 4; ++dt_) { \
            const v4i16 lo_ = __builtin_amdgcn_ds_read_tr16_b64_v4i16((LAS v4i16*)(ta_ + dt_ * 32)); \
            const v4i16 hi_ = __builtin_amdgcn_ds_read_tr16_b64_v4i16((LAS v4i16*)(ta_ + 16 * VROW + dt_ * 32)); \
            bf16x8 vf_; vf_[0] = lo_[0]; vf_[1] = lo_[1]; vf_[2] = lo_[2]; vf_[3] = lo_[3]; vf_[4] = hi_[0]; vf_[5] = hi_[1]; vf_[6] = hi_[2]; vf_[7] = hi_[3]; \
            o[dt_] = __builtin_amdgcn_mfma_f32_16x16x32_bf16(vf_, pf_, o[dt_] * alpha_, 0, 0, 0); } } while (0)
    ATT_LOAD(kfA, vvA, 0);
    if (ngrp > 1) ATT_LOAD(kfB, vvB, 1);
#pragma unroll 1
    for (int grp = 0; grp < ngrp; grp += 2) {
        ATT_GROUP(kfA, vvA, grp, vreg);
        if (grp + 1 < ngrp) ATT_GROUP(kfB, vvB, grp + 1, vreg + 8192);
    }
#undef ATT_LOAD
#undef ATT_GROUP
    ssum += __shfl_xor(ssum, 16); ssum += __shfl_xor(ssum, 32);
    const float inv = 1.0f / ssum;
    if (hd < 8) {
        bf16_t* op = MIX + (size_t)tok * 1024 + hd * 64 + 4 * g;
#pragma unroll
        for (int dt = 0; dt < 4; ++dt) { u32x2 w; w.x = cvt_pk_bf16(o[dt][0] * inv, o[dt][1] * inv); w.y = cvt_pk_bf16(o[dt][2] * inv, o[dt][3] * inv); *(u32x2*)(op + 16 * dt) = w; }
    }
    __syncthreads();
}

__device__ __forceinline__ void conv_tile(const Params& P, LAS unsigned char* lds, int tile, int tid, int wave, int lane) {
    unsigned char* ws = P.ws;
    const bf16_t* HG = (const bf16_t*)(ws + WS_HGLU); bf16_t* MIX = (bf16_t*)(ws + WS_MIX);
    LAS f32x2* part = (LAS f32x2*)(lds + LDS_MISC + 1024);
    LAS f32x2* stat = part + 256;
    LAS bf16_t* Lin = (LAS bf16_t*)lds;
    LAS bf16_t* Lout = (LAS bf16_t*)(lds + 65536);
    const int tok0 = tile * 32, t0 = tok0 & (SEQ - 1), c = tid;
    for (int ch = tid; ch < 62 * 64; ch += NTHR) { const int r = ch >> 6, cc = ch & 63; const int tt = t0 - 30 + r;
        u32x4 v = {0u, 0u, 0u, 0u}; if (tt >= 0) v = *(const u32x4*)(HG + (size_t)(tok0 - 30 + r) * 512 + cc * 8);
        *(LAS u32x4*)(Lin + r * 512 + cc * 8) = v; }
    __syncthreads();
    float in[62];
#pragma unroll
    for (int r = 0; r < 62; ++r) in[r] = __builtin_bit_cast(float, (unsigned)Lin[r * 512 + c] << 16);
    float out[32];
    const float bias = P.dw_b[c];
#pragma unroll
    for (int i = 0; i < 32; ++i) out[i] = bias;
#pragma unroll
    for (int j = 0; j < 31; ++j) { const float wj = P.dw_w[j * 512 + c];
#pragma unroll
        for (int i = 0; i < 32; ++i) out[i] = fmaf(in[i + j], wj, out[i]); }
#pragma unroll
    for (int i = 0; i < 32; ++i) { const float s1 = wave_sum(out[i]), s2 = wave_sum(out[i] * out[i]); if (lane == 0) part[i * 8 + wave] = (f32x2){s1, s2}; }
    __syncthreads();
    if (tid < 32) { float s1 = 0.f, s2 = 0.f;
#pragma unroll
        for (int w = 0; w < 8; ++w) { const f32x2 pp = part[tid * 8 + w]; s1 += pp.x; s2 += pp.y; }
        const float mean = s1 * (1.0f / 512.0f), var = fmaxf(s2 * (1.0f / 512.0f) - mean * mean, 0.f);
        stat[tid] = (f32x2){mean, 1.0f / sqrtf(var + EPS)}; }
    __syncthreads();
    const float lgc = P.ln_g[c], lbc = P.ln_b[c];
#pragma unroll
    for (int i = 0; i < 32; ++i) { const f32x2 st = stat[i]; const float y = (out[i] - st.x) * st.y * lgc + lbc; const float sl = y * sigmoidf_(y);
        Lout[i * 512 + c] = (bf16_t)f2bf(sl); }
    __syncthreads();
    for (int ch = tid; ch < 32 * 64; ch += NTHR) { const int r = ch >> 6, cc = ch & 63;
        *(u32x4*)(MIX + (size_t)(tok0 + r) * 1024 + 512 + cc * 8) = *(const LAS u32x4*)(Lout + r * 512 + cc * 8); }
    __syncthreads();
}

__device__ __forceinline__ void router_phase(const Params& P, LAS unsigned char* lds, int blk, int G, int tid, int wave, int lane) {
    unsigned char* ws = P.ws;
    const float* h1 = (const float*)(ws + WS_H1); const float* wrg = (const float*)(ws + WS_WRG);
    int* list = (int*)(ws + WS_LIST); float* lscale = (float*)(ws + WS_LSCALE); float* lgate = (float*)(ws + WS_LGATE);
    unsigned* cntg = (unsigned*)(ws + WS_CTL) + CW_CNT;
    LAS float* WL = (LAS float*)lds;
    LAS int* lcnt = (LAS int*)(lds + LDS_MISC + 1024);
    LAS int* gbase = lcnt + 32;
    LAS int* rec_e = gbase + 32;
    LAS int* rec_p = rec_e + 512;
    LAS float* rec_g = (LAS float*)(rec_p + 512);
    LAS float* rec_s = rec_g + 512;
    for (int i = tid; i < 8192; i += NTHR) ((LAS f32x4*)WL)[i] = ((const f32x4*)wrg)[i];
    __syncthreads();
    const int tl = lane & 31, half = lane >> 5;
    for (int chunk = blk; chunk < NTOK / 128; chunk += G) {
        if (tid < 32) lcnt[tid] = 0;
        __syncthreads();
        if (wave < 4) {
            const int tloc = wave * 32 + tl, tok = chunk * 128 + tloc;
            const float* hrow = h1 + (size_t)tok * DM + 4 * half;
            f32x16 acc;
#pragma unroll
            for (int i = 0; i < 16; ++i) acc[i] = 0.f;
            float ss = 0.f;
#pragma unroll 1
            for (int k0 = 0; k0 < DM; k0 += 32) {
                f32x4 hv[4];
#pragma unroll
                for (int i = 0; i < 4; ++i) hv[i] = *(const f32x4*)(hrow + k0 + 8 * i);
#pragma unroll
                for (int i = 0; i < 4; ++i) {
                    ss = fmaf(hv[i].x, hv[i].x, fmaf(hv[i].y, hv[i].y, fmaf(hv[i].z, hv[i].z, fmaf(hv[i].w, hv[i].w, ss))));
#pragma unroll
                    for (int j = 0; j < 4; ++j) { const float wv = WL[(k0 + 8 * i + 4 * half + j) * 32 + tl];
                        acc = __builtin_amdgcn_mfma_f32_32x32x2f32(wv, hv[i][j], acc, 0, 0, 0); }
                }
            }
            ss += __shfl_xor(ss, 32);
            const float rs = 1.0f / sqrtf(ss * (1.0f / DM) + EPS);
            float v[16];
#pragma unroll
            for (int r = 0; r < 16; ++r) v[r] = acc[r] * rs + P.b_router[(r & 3) + 8 * (r >> 2) + 4 * half];
            float tv[4]; int te[4];
#pragma unroll
            for (int q = 0; q < 4; ++q) { float bv = -INFINITY; int be = 64;
#pragma unroll
                for (int r = 0; r < 16; ++r) { const int e = (r & 3) + 8 * (r >> 2) + 4 * half; if (v[r] > bv || (v[r] == bv && e < be)) { bv = v[r]; be = e; } }
#pragma unroll
                for (int r = 0; r < 16; ++r) { const int e = (r & 3) + 8 * (r >> 2) + 4 * half; if (e == be) v[r] = -INFINITY; }
                tv[q] = bv; te[q] = be; }
            float cv[8]; int ce[8];
#pragma unroll
            for (int q = 0; q < 4; ++q) { cv[q] = tv[q]; ce[q] = te[q]; cv[4 + q] = __shfl_xor(tv[q], 32); ce[4 + q] = __shfl_xor(te[q], 32); }
#pragma unroll
            for (int q = 0; q < 4; ++q) { float bv = -INFINITY; int be = 64;
#pragma unroll
                for (int r = 0; r < 8; ++r) if (cv[r] > bv || (cv[r] == bv && ce[r] < be)) { bv = cv[r]; be = ce[r]; }
#pragma unroll
                for (int r = 0; r < 8; ++r) if (ce[r] == be) cv[r] = -INFINITY;
                tv[q] = bv; te[q] = be; }
            const float e1 = __expf(tv[1] - tv[0]), e2 = __expf(tv[2] - tv[0]), e3 = __expf(tv[3] - tv[0]);
            const float is = 1.0f / (1.0f + e1 + e2 + e3);
            if (half == 0) {
                const float gq[4] = {is, e1 * is, e2 * is, e3 * is};
#pragma unroll
                for (int q = 0; q < 4; ++q) { const int lp = atomicAdd((int*)&lcnt[te[q]], 1); const int si = tloc * 4 + q; rec_e[si] = te[q]; rec_p[si] = lp; rec_g[si] = gq[q]; }
                rec_s[tloc] = rs;
            }
        }
        __syncthreads();
        if (tid < 32) gbase[tid] = (int)atomicAdd(cntg + 64 * tid, (unsigned)lcnt[tid]);
        __syncthreads();
        { const int si = tid, ee = rec_e[si], pos = gbase[ee] + rec_p[si], li = ee * NTOK + pos;
          list[li] = (chunk * 128) * 4 + si; lscale[li] = rec_s[si >> 2]; lgate[li] = rec_g[si]; }
        __syncthreads();
    }
}

__device__ __forceinline__ void combine_phase(const Params& P, int gw, int NGW, int lane) {
    unsigned char* ws = P.ws;
    float* h1 = (float*)(ws + WS_H1); bf16_t* h1b = (bf16_t*)(ws + WS_H1B); const bf16_t* y = (const bf16_t*)(ws + WS_Y); float* rs3 = (float*)(ws + WS_RS3);
    for (int m = gw; m < NTOK; m += NGW) {
        const f32x4* hr = (const f32x4*)(h1 + (size_t)m * DM) + lane; f32x4 v[4]; float s = 0.f;
#pragma unroll
        for (int j = 0; j < 4; ++j) v[j] = hr[64 * j];
#pragma unroll
        for (int k = 0; k < 4; ++k) { const u32x2* yr = (const u32x2*)(y + (size_t)(m * 4 + k) * DM) + lane;
#pragma unroll
            for (int j = 0; j < 4; ++j) { const u32x2 w = yr[64 * j]; v[j].x += bf_lo(w.x); v[j].y += bf_hi(w.x); v[j].z += bf_lo(w.y); v[j].w += bf_hi(w.y); } }
        u32x2* o8 = (u32x2*)(h1b + (size_t)m * DM) + lane;
#pragma unroll
        for (int j = 0; j < 4; ++j) { u32x2 w; w.x = pk2(v[j].x, v[j].y); w.y = pk2(v[j].z, v[j].w); o8[64 * j] = w;
            s += (v[j].x * v[j].x + v[j].y * v[j].y) + (v[j].z * v[j].z + v[j].w * v[j].w); }
        s = wave_sum(s);
        if (lane == 0) rs3[m] = 1.0f / sqrtf(s * (1.0f / DM) + EPS);
    }
}

__device__ __forceinline__ void final_phase(const Params& P, int gw, int NGW, int lane) {
    unsigned char* ws = P.ws;
    const bf16_t* h2b = (const bf16_t*)(ws + WS_H1B); const bf16_t* pj = (const bf16_t*)(ws + WS_PJ); const bf16_t* G = (const bf16_t*)(ws + WS_G); const float* rs3 = (const float*)(ws + WS_RS3);
    f32x4 gv[4];
#pragma unroll
    for (int j = 0; j < 4; ++j) gv[j] = *((const f32x4*)P.g_final + lane + 64 * j);
    for (int m = gw; m < NTOK; m += NGW) {
        const u32x2* hr = (const u32x2*)(h2b + (size_t)m * DM) + lane; const u32x2* pr = (const u32x2*)(pj + (size_t)m * DM) + lane; const u32x2* gr = (const u32x2*)(G + (size_t)m * DM) + lane;
        const float r3 = rs3[m]; f32x4 v[4]; float s = 0.f;
#pragma unroll
        for (int j = 0; j < 4; ++j) { const u32x2 hw = hr[64 * j], pw = pr[64 * j], gw2 = gr[64 * j];
            v[j].x = bf_lo(hw.x) + bf_lo(pw.x) * sigmoidf_(bf_lo(gw2.x) * r3); v[j].y = bf_hi(hw.x) + bf_hi(pw.x) * sigmoidf_(bf_hi(gw2.x) * r3);
            v[j].z = bf_lo(hw.y) + bf_lo(pw.y) * sigmoidf_(bf_lo(gw2.y) * r3); v[j].w = bf_hi(hw.y) + bf_hi(pw.y) * sigmoidf_(bf_hi(gw2.y) * r3);
            s += (v[j].x * v[j].x + v[j].y * v[j].y) + (v[j].z * v[j].z + v[j].w * v[j].w); }
        s = wave_sum(s); const float rs = 1.0f / sqrtf(s * (1.0f / DM) + EPS);
        f32x4* orow = (f32x4*)(P.out + (size_t)m * DM) + lane;
#pragma unroll
        for (int j = 0; j < 4; ++j) orow[64 * j] = v[j] * rs * gv[j];
    }
}

#define XB_TMO      128
#define XB_XCNT(j)  (256  + 64 * (j))
#define XB_XSUB(j)  (1280 + 64 * (j))
#define XB_XGEN(j)  (2304 + 64 * (j))
#define XB_TOP      3328
#define XB_TOPGEN   3392
#define XCD_BAR_WORDS 3456
#define XB_SPIN_CAP (1u << 18)
__device__ __forceinline__ unsigned xb_ld(unsigned* p)              { return __hip_atomic_load(p, __ATOMIC_RELAXED, __HIP_MEMORY_SCOPE_AGENT); }
__device__ __forceinline__ unsigned xb_add(unsigned* p, unsigned v) { return __hip_atomic_fetch_add(p, v, __ATOMIC_RELAXED, __HIP_MEMORY_SCOPE_AGENT); }
__device__ __forceinline__ unsigned xb_xcc_id() { return (unsigned)__builtin_amdgcn_s_getreg((3 << 11) | 20) & 0xFu; }
#define XB_SPIN(cond, bar) do { unsigned _sp = 0; while (cond) { __builtin_amdgcn_s_sleep(1); \
    if ((++_sp & 255u) == 0u) { if (xb_ld(&(bar)[XB_TMO])) break; if (_sp > XB_SPIN_CAP) { atomicAdd(&(bar)[XB_TMO], 1u); break; } } } } while (0)
struct XcdBarrier { unsigned* bar; unsigned x; volatile LAS unsigned* st; };
__device__ __forceinline__ XcdBarrier xcd_barrier_post(unsigned* bar, volatile LAS unsigned* st) {
    XcdBarrier b; b.bar = bar; b.x = xb_xcc_id(); b.st = st;
    if (threadIdx.x == 0) (void)xb_add(&bar[XB_XCNT(b.x)], 1u);
    return b;
}
__device__ __forceinline__ void xcd_barrier_complete(unsigned* bar, unsigned x, unsigned& nloc, unsigned& nx) {
    const unsigned G = gridDim.x * gridDim.y * gridDim.z;
    unsigned sum, cnt, mine, sp = 0u;
    for (;;) {
        sum = 0u; cnt = 0u; mine = 0u;
#pragma unroll
        for (unsigned j = 0; j < 16; ++j) { const unsigned c = xb_ld(&bar[XB_XCNT(j)]); sum += c; cnt += (c > 0u) ? 1u : 0u; mine = (j == x) ? c : mine; }
        if (sum == G) break;
        __builtin_amdgcn_s_sleep(1);
        if ((++sp & 255u) == 0u) { if (xb_ld(&bar[XB_TMO])) break; if (sp > XB_SPIN_CAP) { atomicAdd(&bar[XB_TMO], 1u); break; } }
    }
    nloc = mine > 0u ? mine : 1u; nx = cnt > 0u ? cnt : 1u;
}
__device__ __forceinline__ void xcd_barrier(const XcdBarrier& b) {
    asm volatile("s_waitcnt vmcnt(0)" ::: "memory");
    __syncthreads();
    if (threadIdx.x == 0) {
        unsigned* bar = b.bar;
        __builtin_amdgcn_s_waitcnt(0);
        unsigned nloc = b.st[0], nx = b.st[1];
        if (nloc == 0u) { xcd_barrier_complete(bar, b.x, nloc, nx); b.st[0] = nloc; b.st[1] = nx; }
        const unsigned old = xb_add(&bar[XB_XSUB(b.x)], 1u);
        const unsigned gen = old / nloc;
        if (old + 1u == (gen + 1u) * nloc) {
            __builtin_amdgcn_fence(__ATOMIC_RELEASE, "agent");
            asm volatile("s_waitcnt vmcnt(0)" ::: "memory");
            const unsigned og = xb_add(&bar[XB_TOP], 1u);
            const unsigned tg = og / nx;
            if (og + 1u == (tg + 1u) * nx) xb_add(&bar[XB_TOPGEN], 1u);
            else XB_SPIN(xb_ld(&bar[XB_TOPGEN]) == tg, bar);
            __builtin_amdgcn_fence(__ATOMIC_ACQUIRE, "agent");
            xb_add(&bar[XB_XGEN(b.x)], 1u);
            asm volatile("s_waitcnt vmcnt(0)" ::: "memory");
        } else {
            XB_SPIN(xb_ld(&bar[XB_XGEN(b.x)]) == gen, bar);
            __builtin_amdgcn_fence(__ATOMIC_ACQUIRE, "agent");
            asm volatile("s_waitcnt vmcnt(0)" ::: "memory");
        }
    }
    __syncthreads();
}

constexpr int NPHASE = 10;
__global__ void __launch_bounds__(NTHR, 2) fwd_kernel(Params P) {
    extern __shared__ __attribute__((aligned(16))) unsigned char lds_raw[];
    LAS unsigned char* lds = (LAS unsigned char*)lds_raw;
    cg::grid_group grid = cg::this_grid();
    const int tid = threadIdx.x, lane = tid & 63, wave = __builtin_amdgcn_readfirstlane(tid >> 6);
    const int G = gridDim.x, bx = blockIdx.x;
    const int vcu = (G % 8 == 0) ? (bx % 8) * (G / 8) + bx / 8 : bx;
    const int gw = vcu * NWAVES + wave, NGW = G * NWAVES;
    unsigned char* ws = P.ws;
    const int lo = P.ph_lo, hi = P.ph_hi;
#ifndef PH_MASK
#define PH_MASK 0x3ff
#endif
#define IN(k) ((((PH_MASK) >> (k)) & 1) && lo <= (k) && (k) < hi)
    volatile LAS unsigned* xst = (volatile LAS unsigned*)(lds + LDS_XB);
    if (tid < 2) xst[tid] = 0u;
    __syncthreads();
    const XcdBarrier xbar = xcd_barrier_post((unsigned*)(ws + WS_CTL) + CW_BAR, xst);
#define SYNC(k) do { if (IN(k) && IN((k) + 1)) { if ((k) == 0) grid.sync(); else xcd_barrier(xbar); } } while (0)

    if (IN(0)) p0_prologue(P, lds, vcu, G, wave, lane);
    SYNC(0);
    if (IN(1)) {
        { pg8::DenseSched S; S.init((const bf16_t*)(ws + WS_XB), (const bf16_t*)(ws + WS_WIN), NTOK, 2048, 1024, G, bx);
          EpiInProj E{(const float*)(ws + WS_RS1), (const f32x2*)(ws + WS_ROPE), P.glu_b, (bf16_t*)(ws + WS_Q), (bf16_t*)(ws + WS_K), (bf16_t*)(ws + WS_V), (bf16_t*)(ws + WS_QI), (bf16_t*)(ws + WS_KI), (bf16_t*)(ws + WS_HGLU), (float*)(ws + WS_WI)};
          pg8::gemm_phase<EpiInProj, pg8::DenseSched, false>(lds, S, E); }
        { pg8::DenseSched S; S.init((const bf16_t*)(ws + WS_PB), (const bf16_t*)(ws + WS_WP), NTOK, 1024, 256, G, bx);
          EpiBf16Plain E{(bf16_t*)(ws + WS_PJ), 1024};
          pg8::gemm_phase<EpiBf16Plain, pg8::DenseSched, false>(lds, S, E); }
    }
    SYNC(1);
    if (IN(2)) {
        for (int i = tid; i < 4096; i += NTHR) ((LAS unsigned*)(lds + LDS_MISC))[i] = 0u;
        __syncthreads();
        if (G % 8 == 0) { const int b = bx % 8, jb = bx / 8, nbb = G / 8;
            for (int i = 0;; ++i) { const int k = i * nbb + ((i & 1) ? nbb - 1 - jb : jb); if (k >= 512) break; attn_tile(P, lds, b, (511 - k) * 8, wave, lane); } }
        else { for (int tl = bx; tl < 4096; tl += G) attn_tile(P, lds, tl & 7, (511 - (tl >> 3)) * 8, wave, lane); }
        for (int rp = 0; rp <= ((P.rep >> 3) & 1); ++rp)
        for (int tl = vcu; tl < NTOK / 32; tl += G) conv_tile(P, lds, tl, tid, wave, lane);
    }
    SYNC(2);
    if (IN(3)) {
        pg8::DenseSched S; S.init((const bf16_t*)(ws + WS_MIX), (const bf16_t*)(ws + WS_WOUT), NTOK, 1024, 1024, G, bx);
        EpiOutProj E{P.x, (float*)(ws + WS_H1), (unsigned char*)(ws + WS_H1F8)};
        pg8::gemm_phase<EpiOutProj, pg8::DenseSched, false>(lds, S, E);
    }
    SYNC(3);
    if (IN(4)) router_phase(P, lds, vcu, G, tid, wave, lane);
    SYNC(4);
    if (IN(5) || IN(6)) {
        LAS int* tb = (LAS int*)(lds + LDS_MISC); LAS int* cn = tb + 64;
        if (tid == 0) { const unsigned* cntg = (const unsigned*)(ws + WS_CTL) + CW_CNT; int acc = 0;
            for (int e = 0; e < NE; ++e) { const int c = (int)__hip_atomic_load(cntg + 64 * e, __ATOMIC_RELAXED, __HIP_MEMORY_SCOPE_AGENT); tb[e] = acc; cn[e] = c; acc += (c + BM - 1) / BM; }
            tb[NE] = acc; }
        __syncthreads();
        if (IN(5)) {
            pg8::MoeSched S; S.A = ws + WS_H1F8; S.Bt = ws + WS_WUP; S.rp = 1024; S.b_estride = (size_t)2048 * 1024; S.tb = tb; S.cnt = cn; S.list = (const int*)(ws + WS_LIST);
            S.nN = 8; S.nwg = tb[NE] * 8; S.G = G; S.c = bx; S.gather = true;
            S.m_scale = (const float*)(ws + WS_LSCALE); S.m_gate = nullptr; S.m_bias = P.b_up;
            EpiUp E{(unsigned char*)(ws + WS_ACT)};
            pg8::gemm_phase<EpiUp, pg8::MoeSched, true, true>(lds, S, E);
        }
        SYNC(5);
        if (IN(6)) {
            pg8::MoeSched S; S.A = ws + WS_ACT; S.Bt = ws + WS_WDOWN; S.rp = 1024; S.b_estride = (size_t)1024 * 1024; S.tb = tb; S.cnt = cn; S.list = (const int*)(ws + WS_LIST);
            S.nN = 4; S.nwg = tb[NE] * 4; S.G = G; S.c = bx; S.gather = false;
            S.m_scale = nullptr; S.m_gate = (const float*)(ws + WS_LGATE); S.m_bias = P.b_down;
            EpiDown E{(bf16_t*)(ws + WS_Y)};
            pg8::gemm_phase<EpiDown, pg8::MoeSched, true, true>(lds, S, E);
        }
    }
    SYNC(6);
    if (IN(7)) combine_phase(P, gw, NGW, lane);
    SYNC(7);
    if (IN(8)) {
        pg8::DenseSched S; S.init((const bf16_t*)(ws + WS_H1B), (const bf16_t*)(ws + WS_WG), NTOK, 1024, 1024, G, bx);
        EpiBf16Plain E{(bf16_t*)(ws + WS_G), 1024};
        pg8::gemm_phase<EpiBf16Plain, pg8::DenseSched, false>(lds, S, E);
    }
    SYNC(8);
    if (IN(9)) final_phase(P, gw, NGW, lane);
#undef IN
#undef SYNC
}

#ifndef N_LAUNCH_MODE
#define N_LAUNCH_MODE 1
#endif
extern "C" void kernel_launch(void* const* d_in, const int* in_sizes, int n_in, void* d_out, int out_size, void* d_ws, size_t ws_size, hipStream_t stream) {
    static int grid = 0;
    if (grid == 0) {
        if (n_in != 21 || out_size != NTOK * DM || ws_size < WS_END) { fprintf(stderr, "kernel_launch: unexpected shapes (n_in %d out %d ws %zu)\n", n_in, out_size, ws_size); grid = -1; return; }
        int dev = 0, cus = 0, per_cu = 0;
        (void)hipGetDevice(&dev); (void)hipDeviceGetAttribute(&cus, hipDeviceAttributeMultiprocessorCount, dev);
        (void)hipFuncSetAttribute((const void*)fwd_kernel, hipFuncAttributeMaxDynamicSharedMemorySize, LDS_BYTES);
        if (hipOccupancyMaxActiveBlocksPerMultiprocessor(&per_cu, (const void*)fwd_kernel, NTHR, LDS_BYTES) != hipSuccess || per_cu < 1) { fprintf(stderr, "kernel_launch: occupancy query failed (%d)\n", per_cu); (void)hipGetLastError(); grid = -1; return; }
        grid = cus;
    }
    if (grid < 0) return;
    (void)hipMemsetAsync((char*)d_ws + WS_CTL, 0, CTL_BYTES, stream);
    Params p{};
    p.x = (const float*)d_in[0]; p.p = (const float*)d_in[1]; p.w_in = (const float*)d_in[2]; p.w_out = (const float*)d_in[3]; p.g_mix = (const float*)d_in[4]; p.g_ffn = (const float*)d_in[5];
    p.glu_b = (const float*)d_in[6]; p.dw_w = (const float*)d_in[7]; p.dw_b = (const float*)d_in[8]; p.ln_g = (const float*)d_in[9]; p.ln_b = (const float*)d_in[10];
    p.w_router = (const float*)d_in[11]; p.b_router = (const float*)d_in[12]; p.w_up = (const float*)d_in[13]; p.b_up = (const float*)d_in[14]; p.w_down = (const float*)d_in[15]; p.b_down = (const float*)d_in[16];
    p.w_ple_proj = (const float*)d_in[17]; p.w_ple_gate = (const float*)d_in[18]; p.g_ple = (const float*)d_in[19]; p.g_final = (const float*)d_in[20];
    p.out = (float*)d_out; p.ws = (unsigned char*)d_ws;
#ifndef PROBE_REPMASK
#define PROBE_REPMASK 0
#endif
    p.rep = PROBE_REPMASK;
#if N_LAUNCH_MODE == 1
    p.ph_lo = 0; p.ph_hi = NPHASE;
    void* args[] = {&p};
    hipError_t e = hipLaunchCooperativeKernel((const void*)fwd_kernel, dim3(grid), dim3(NTHR), args, LDS_BYTES, stream);
    if (e != hipSuccess) fprintf(stderr, "cooperative launch failed: %s (grid %d)\n", hipGetErrorString(e), grid);
#else
    for (int ph = 0; ph < NPHASE; ++ph) {
        p.ph_lo = ph; p.ph_hi = ph + 1;
        void* args[] = {&p};
        hipError_t e = hipLaunchCooperativeKernel((const void*)fwd_kernel, dim3(grid), dim3(NTHR), args, LDS_BYTES, stream);
        if (e != hipSuccess) { fprintf(stderr, "launch %d failed: %s (grid %d)\n", ph, hipGetErrorString(e), grid); break; }
    }
#endif
}
```

```cpp
#include <hip/hip_runtime.h>
#include <hip/hip_cooperative_groups.h>
#include <cstdio>
#include <cstdint>
namespace cg = cooperative_groups;

#define LAS __attribute__((address_space(3)))
#define GAS __attribute__((address_space(1)))
typedef unsigned short bf16_t;
typedef short bf16x8 __attribute__((ext_vector_type(8)));
typedef short s16x4 __attribute__((ext_vector_type(4)));
typedef float f32x4 __attribute__((ext_vector_type(4)));
typedef float f32x2 __attribute__((ext_vector_type(2)));
typedef float f32x16 __attribute__((ext_vector_type(16)));
typedef unsigned u32x4 __attribute__((ext_vector_type(4)));
typedef unsigned u32x2 __attribute__((ext_vector_type(2)));

constexpr int NB = 8, SEQ = 4096, DM = 1024, NTOK = NB * SEQ;
constexpr int NE = 32, TOPK = 4, NSLOT = NTOK * TOPK;
constexpr int INW = 1988;
constexpr int NSEL = 256;
constexpr float EPS = 1e-6f;
constexpr int NWAVES = 8, NTHR = 512;

constexpr size_t MiB = 1u << 20;
constexpr size_t WS_CTL = 0, CTL_BYTES = 64 * 1024;
constexpr size_t WS_ROPE = 1 * MiB;
constexpr size_t WS_WIN = 2 * MiB;
constexpr size_t WS_WOUT = 6 * MiB;
constexpr size_t WS_WG = 8 * MiB;
constexpr size_t WS_WP = 10 * MiB;
constexpr size_t WS_WRG = 10 * MiB + 512 * 1024;
constexpr size_t WS_RS1 = 11 * MiB;
constexpr size_t WS_RS3 = 11 * MiB + 512 * 1024;
constexpr size_t WS_WI = 12 * MiB;
constexpr size_t WS_LIST = 13 * MiB;
constexpr size_t WS_LSCALE = 17 * MiB;
constexpr size_t WS_LGATE = 21 * MiB;
constexpr size_t WS_PB = 25 * MiB;
constexpr size_t WS_WUP = 42 * MiB;
constexpr size_t WS_WDOWN = 170 * MiB;
constexpr size_t WS_H1 = 234 * MiB;
constexpr size_t WS_H1B = 362 * MiB;
constexpr size_t WS_PJ = 426 * MiB;
constexpr size_t WS_XB = 490 * MiB;
constexpr size_t WS_Q = 554 * MiB;
constexpr size_t WS_K = 586 * MiB;
constexpr size_t WS_V = 590 * MiB;
constexpr size_t WS_QI = 594 * MiB;
constexpr size_t WS_KI = 610 * MiB;
constexpr size_t WS_HGLU = 614 * MiB;
constexpr size_t WS_MIX = 646 * MiB;
constexpr size_t WS_H1F8 = 490 * MiB;
constexpr size_t WS_ACT = 522 * MiB;
constexpr size_t WS_Y = 762 * MiB;
constexpr size_t WS_G = 762 * MiB;
constexpr size_t WS_END = 1018 * MiB;
static_assert(WS_H1F8 + (size_t)NTOK * 1024 <= WS_ACT && WS_ACT + (size_t)139264 * 1024 <= WS_Y, "ws map");
constexpr int CW_CNT = 1024;
constexpr int CW_BAR = 8192;

constexpr int LDS_STAGE = 131072;
constexpr int LDS_MISC = LDS_STAGE;
constexpr int LDS_META = LDS_MISC + 4096;
constexpr int LDS_XB = 147456;
constexpr int LDS_BYTES = 147456 + 256;

__device__ __forceinline__ unsigned f2bf(float f) { unsigned u = __builtin_bit_cast(unsigned, f); return (u + 0x7fffu + ((u >> 16) & 1u)) >> 16; }
__device__ __forceinline__ unsigned pk2(float lo, float hi) { return f2bf(lo) | (f2bf(hi) << 16); }
__device__ __forceinline__ float bf_lo(unsigned w) { return __builtin_bit_cast(float, w << 16); }
__device__ __forceinline__ float bf_hi(unsigned w) { return __builtin_bit_cast(float, w & 0xffff0000u); }
__device__ __forceinline__ float wave_sum(float v) {
    v += __builtin_bit_cast(float, __builtin_amdgcn_update_dpp(0, __builtin_bit_cast(int, v), 0xB1, 0xF, 0xF, true));
    v += __builtin_bit_cast(float, __builtin_amdgcn_update_dpp(0, __builtin_bit_cast(int, v), 0x4E, 0xF, 0xF, true));
    v += __builtin_bit_cast(float, __builtin_amdgcn_update_dpp(0, __builtin_bit_cast(int, v), 0x141, 0xF, 0xF, true));
    v += __builtin_bit_cast(float, __builtin_amdgcn_update_dpp(0, __builtin_bit_cast(int, v), 0x140, 0xF, 0xF, true));
    const int vi = __builtin_bit_cast(int, v);
    const float r0 = __builtin_bit_cast(float, __builtin_amdgcn_readlane(vi, 0)), r1 = __builtin_bit_cast(float, __builtin_amdgcn_readlane(vi, 16));
    const float r2 = __builtin_bit_cast(float, __builtin_amdgcn_readlane(vi, 32)), r3 = __builtin_bit_cast(float, __builtin_amdgcn_readlane(vi, 48));
    return (r0 + r1) + (r2 + r3);
}
__device__ __forceinline__ unsigned pk4_fp8(float a, float b, float c, float d) { int r = __builtin_amdgcn_cvt_pk_fp8_f32(a, b, 0, false); r = __builtin_amdgcn_cvt_pk_fp8_f32(c, d, r, true); return (unsigned)r; }
__device__ __forceinline__ float sigmoidf_(float x) { return 1.0f / (1.0f + __expf(-x)); }
#define LDS_WAIT() asm volatile("s_waitcnt lgkmcnt(0)" ::: "memory")

struct Params {
    const float* x; const float* p; const float* w_in; const float* w_out; const float* g_mix; const float* g_ffn;
    const float* glu_b; const float* dw_w; const float* dw_b; const float* ln_g; const float* ln_b;
    const float* w_router; const float* b_router; const float* w_up; const float* b_up; const float* w_down; const float* b_down;
    const float* w_ple_proj; const float* w_ple_gate; const float* g_ple; const float* g_final;
    float* out; unsigned char* ws;
    int ph_lo, ph_hi, rep, pad;
};

namespace pg8 {
constexpr int BM = 256, BK = 64, HALF = 128, HTB = HALF * BK * 2, STAGE_BYTES = 8 * HTB, NXCD = 8, WGM = 8;
__host__ __device__ __forceinline__ int lds_byte(int r, int c) { const int st = (r >> 4) * 2 + (c >> 5), rr = r & 15, cc = c & 31, ob = rr * 64 + cc * 2; return st * 1024 + (ob ^ (((ob >> 9) & 1) << 5)); }
__host__ __device__ __forceinline__ void stage_rc(int b, int& R, int& C) { const int st = b / 1024, sb = b % 1024, swz = sb ^ (((sb >> 9) & 1) << 5); R = (st >> 1) * 16 + swz / 64; C = (st & 1) * 32 + (swz % 64) / 2; }
__host__ __device__ __forceinline__ int perm32(int rho) { const int n = rho >> 4, i = rho & 15; return 8 * (i >> 2) + 4 * n + (i & 3); }

struct Unit { int pm, pn, e, rows; };

__device__ __forceinline__ unsigned cvt_pk_bf16(float lo, float hi) { unsigned r; asm volatile("v_cvt_pk_bf16_f32 %0, %1, %2" : "=v"(r) : "v"(lo), "v"(hi)); return r; }

struct DenseSched {
    const void* A; const void* Bt; int rp;
    int nM, nN, nwg, G, c;
    __device__ void init(const void* A_, const void* Bt_, int M, int N, int K_, int G_, int c_) { A = A_; Bt = Bt_; rp = K_ * 2; nM = M / BM; nN = N / BM; nwg = nM * nN; G = G_; c = c_; }
    __device__ bool next(int i, Unit& u) const {
        const long L = (long)i * G + c; if (L >= nwg) return false;
        int wgid = (int)L; { const int q = nwg / NXCD, r = nwg % NXCD, xcd = wgid % NXCD, off = wgid / NXCD; wgid = (xcd < r ? xcd * (q + 1) : r * (q + 1) + (xcd - r) * q) + off; }
        const int nig = WGM * nN, gid = wgid / nig, fm = gid * WGM, gsz = (nM - fm) < WGM ? (nM - fm) : WGM;
        u.pm = fm + ((wgid % nig) % gsz); u.pn = (wgid % nig) / gsz; u.e = 0; u.rows = BM; return true;
    }
    __device__ __forceinline__ const char* a_ptr(const Unit& u) const { return (const char*)A + (size_t)u.pm * BM * rp; }
    __device__ __forceinline__ const char* b_ptr(const Unit& u) const { return (const char*)Bt + (size_t)u.pn * BM * rp; }
    __device__ __forceinline__ int a_row(const Unit&, int) const { return 0; }
    __device__ __forceinline__ void meta(const Unit&, LAS unsigned char*, int, int) const {}
};

struct MoeSched {
    const void* A; const void* Bt; int rp; size_t b_estride;
    const LAS int* tb;
    const LAS int* cnt;
    const int* list;
    int nN, nwg, G, c; bool gather;
    __device__ bool next(int i, Unit& u) const {
        const long L = (long)i * G + c; if (L >= nwg) return false;
        int wgid = (int)L; { const int q = nwg / NXCD, r = nwg % NXCD, xcd = wgid % NXCD, off = wgid / NXCD; wgid = (xcd < r ? xcd * (q + 1) : r * (q + 1) + (xcd - r) * q) + off; }
        int e = 0;
#pragma unroll 1
        for (; e < NE - 1; ++e) { if (wgid < tb[e + 1] * nN) break; }
        const int local = wgid - tb[e] * nN, nM = tb[e + 1] - tb[e];
        const int nig = WGM * nN, gid = local / nig, fm = gid * WGM, gsz = (nM - fm) < WGM ? (nM - fm) : WGM;
        const int rt = fm + ((local % nig) % gsz);
        u.pm = tb[e] + rt; u.pn = (local % nig) / gsz; u.e = e;
        const int left = cnt[e] - rt * BM; u.rows = left < BM ? left : BM; return true;
    }
    __device__ __forceinline__ const char* a_ptr(const Unit& u) const { return (const char*)A; }
    __device__ __forceinline__ const char* b_ptr(const Unit& u) const { return (const char*)Bt + (size_t)u.e * b_estride + (size_t)u.pn * BM * rp; }
    __device__ __forceinline__ int a_row(const Unit& u, int r) const {
        if (!gather) return u.pm * BM + r;
        const int rt = u.pm - tb[u.e];
        return r < u.rows ? (list[u.e * NTOK + rt * BM + r] >> 2) : 0;
    }
    const float* m_scale; const float* m_gate; const float* m_bias;
    __device__ __forceinline__ void meta(const Unit& u, LAS unsigned char* tbl, int wid, int lane) const {
        const int rt = u.pm - tb[u.e]; const size_t li = (size_t)u.e * NTOK + rt * BM + (wid & 3) * 64 + lane;
        if (gather) {
            if (wid < 4) __builtin_amdgcn_global_load_lds((const unsigned*)(m_scale + li), (LAS unsigned*)(tbl + (wid & 3) * 256), 4, 0, 0);
            else { const int j = (wid & 3) * 64 + lane; const float* src = m_bias + (size_t)u.e * 2048 + (j < 128 ? 128 * u.pn + j : 1024 + 128 * u.pn + (j - 128));
                __builtin_amdgcn_global_load_lds((const unsigned*)src, (LAS unsigned*)(tbl + 2048 + (wid & 3) * 256), 4, 0, 0); }
        } else {
            if (wid < 4) { __builtin_amdgcn_global_load_lds((const unsigned*)(list + li), (LAS unsigned*)(tbl + (wid & 3) * 256), 4, 0, 0);
                __builtin_amdgcn_global_load_lds((const unsigned*)(m_bias + (size_t)u.e * 1024 + u.pn * BM + (wid & 3) * 64 + lane), (LAS unsigned*)(tbl + 2048 + (wid & 3) * 256), 4, 0, 0); }
            else __builtin_amdgcn_global_load_lds((const unsigned*)(m_gate + li), (LAS unsigned*)(tbl + 1024 + (wid & 3) * 256), 4, 0, 0);
        }
    }
};

typedef int v8i32 __attribute__((ext_vector_type(8)));
template <class Epi, class Sched, bool GATHER, bool F8 = false, bool WARMTRIP = false>
__device__ __forceinline__ void gemm_phase(LAS unsigned char* lds, const Sched& S, const Epi& E) {
    const int tid = threadIdx.x, wid = __builtin_amdgcn_readfirstlane(tid >> 6), lane = tid & 63, wr = wid >> 2, wc = wid & 3, fr = lane & 15, fq = lane >> 4;
    const int RP = S.rp, nt = RP / (BK * 2);
    unsigned voffA[2], voffB[2]; int RA[2], CA[2];
#pragma unroll
    for (int i = 0; i < 2; ++i) { int R, C; stage_rc(tid * 16 + i * 8192, R, C); const int Rb = Epi::PERM ? ((R & ~31) + perm32(R & 31)) : R;
        voffA[i] = (unsigned)(R * RP + C * 2); voffB[i] = (unsigned)(Rb * RP + C * 2); RA[i] = R; CA[i] = C; }
    const size_t kstep = (size_t)(BK * 2);
    const size_t hstep = (size_t)HALF * RP;
    const unsigned ldsw = (unsigned)wid * 1024u;
    const int aoff = lds_byte(wr * 64 + fr, fq * 8), boff = lds_byte(wc * 32 + fr, fq * 8);
    unsigned gC[2][2], gN[2][2];
#define PG8_SA(b, h) (((b) * 2 + (h)) * HTB)
#define PG8_SB(b, h) ((4 + (b) * 2 + (h)) * HTB)
#define PG8_STAGE(bufoff, gbase, voff) do { _Pragma("unroll") for (int _i = 0; _i < 2; ++_i) \
        __builtin_amdgcn_global_load_lds((const unsigned*)((const char*)(gbase) + (voff)[_i]), (LAS unsigned*)(lds + (bufoff) + ldsw + _i * 8192), 16, 0, 0); } while (0)
#define PG8_STAGE_A(bufoff, kp, h) do { if constexpr (GATHER) { PG8_STAGE(bufoff, kp, gC[h]); } else { PG8_STAGE(bufoff, (kp) + (h) * hstep, voffA); } } while (0)
#define PG8_LD16(p) (*(const LAS bf16x8*)(p))
#define PG8_CAT(lo, hi) __builtin_bit_cast(v8i32, __builtin_shufflevector(lo, hi, 0, 1, 2, 3, 4, 5, 6, 7, 8, 9, 10, 11, 12, 13, 14, 15))
#define PG8_LDA(dst, b, h) do { _Pragma("unroll") for (int m = 0; m < 4; ++m) { if constexpr (F8) { dst##8[m] = PG8_CAT(PG8_LD16(lds + PG8_SA(b, h) + aoff + m * 2048), PG8_LD16(lds + PG8_SA(b, h) + aoff + m * 2048 + 1024)); } \
        else { _Pragma("unroll") for (int k = 0; k < 2; ++k) dst[m][k] = PG8_LD16(lds + PG8_SA(b, h) + aoff + m * 2048 + k * 1024); } } } while (0)
#define PG8_LDB(dst, b, h) do { _Pragma("unroll") for (int n = 0; n < 2; ++n) { if constexpr (F8) { dst##8[n] = PG8_CAT(PG8_LD16(lds + PG8_SB(b, h) + boff + n * 2048), PG8_LD16(lds + PG8_SB(b, h) + boff + n * 2048 + 1024)); } \
        else { _Pragma("unroll") for (int k = 0; k < 2; ++k) dst[n][k] = PG8_LD16(lds + PG8_SB(b, h) + boff + n * 2048 + k * 1024); } } } while (0)
#define PG8_MMA(ai, bj, At, Bt) do { __builtin_amdgcn_s_setprio(1); _Pragma("unroll") for (int m = 0; m < 4; ++m) _Pragma("unroll") for (int n = 0; n < 2; ++n) { \
        if constexpr (F8) { acc[ai][bj][m][n] = __builtin_amdgcn_mfma_scale_f32_16x16x128_f8f6f4(Bt##8[n], At##8[m], acc[ai][bj][m][n], 0, 0, 0, 0x7f7f7f7f, 0, 0x7f7f7f7f); } \
        else { _Pragma("unroll") for (int k = 0; k < 2; ++k) acc[ai][bj][m][n] = __builtin_amdgcn_mfma_f32_16x16x32_bf16(Bt[n][k], At[m][k], acc[ai][bj][m][n], 0, 0, 0); } } \
        __builtin_amdgcn_s_setprio(0); } while (0)
#define PG8_WAIT_V(n) asm volatile("s_waitcnt vmcnt(" #n ")" ::: "memory")
#define PG8_WAIT_L(n) asm volatile("s_waitcnt lgkmcnt(" #n ")" ::: "memory")
#define PG8_BAR __builtin_amdgcn_s_barrier()
#define PG8_SCHED __builtin_amdgcn_sched_barrier(0)
#define PG8_GOFF(dst, u) do { _Pragma("unroll") for (int _h = 0; _h < 2; ++_h) _Pragma("unroll") for (int _i = 0; _i < 2; ++_i) \
        dst[_h][_i] = (unsigned)(S.a_row(u, _h * HALF + RA[_i]) * RP + CA[_i] * 2); } while (0)
    Unit cur, nxt, nn; int ui = 0;
    if (!S.next(0, cur)) return;
    bool has_next = S.next(1, nxt);
    if constexpr (GATHER) { PG8_GOFF(gC, cur); if (has_next) { PG8_GOFF(gN, nxt); } else { PG8_GOFF(gN, cur); } }
    f32x4 acc[2][2][4][2];
#pragma unroll
    for (int a = 0; a < 2; ++a)
#pragma unroll
        for (int b = 0; b < 2; ++b)
#pragma unroll
            for (int m = 0; m < 4; ++m)
#pragma unroll
                for (int n = 0; n < 2; ++n) acc[a][b][m][n] = (f32x4){0.f, 0.f, 0.f, 0.f};
    bf16x8 At[4][2], B0[2][2], B1[2][2]; v8i32 At8[4], B08[2], B18[2];
    const char* cA = S.a_ptr(cur); const char* cB = S.b_ptr(cur);
    PG8_STAGE(PG8_SB(0, 0), cB, voffB); PG8_STAGE(PG8_SB(0, 1), cB + hstep, voffB); PG8_STAGE_A(PG8_SA(0, 0), cA, 0); PG8_STAGE_A(PG8_SA(0, 1), cA, 1);
    if (wr == 1) PG8_BAR;
    PG8_WAIT_V(2); PG8_BAR;
    PG8_STAGE(PG8_SB(1, 0), cB + kstep, voffB); PG8_STAGE_A(PG8_SA(1, 0), cA + kstep, 0); PG8_STAGE(PG8_SB(1, 1), cB + hstep + kstep, voffB);
    PG8_WAIT_V(6); PG8_BAR;
    for (;;) {
        const char* nA = has_next ? S.a_ptr(nxt) : cA; const char* nB = has_next ? S.b_ptr(nxt) : cB;
        S.meta(cur, lds + (LDS_META - 0) + (ui & 1) * 4096, wid, lane);
#define PG8_TRIP(WARM, t) do { \
            const bool last = ((t) == nt - 2); \
            const char* a1 = cA + (size_t)((t) + 1) * kstep; \
            const char* a2 = last ? nA : cA + (size_t)((t) + 2) * kstep; const char* b2 = last ? nB : cB + (size_t)((t) + 2) * kstep; \
            const char* a3 = a2 + kstep; const char* b3 = b2 + kstep; \
              \
            PG8_LDB(B0, 0, 0); PG8_LDB(B1, 0, 1); PG8_SCHED; PG8_LDA(At, 0, 0); if constexpr (!(WARM)) { PG8_STAGE_A(PG8_SA(1, 1), a1, 1); } \
            if constexpr (GATHER) { if (last) { _Pragma("unroll") for (int h = 0; h < 2; ++h) _Pragma("unroll") for (int i = 0; i < 2; ++i) gC[h][i] = gN[h][i]; } } \
            if constexpr (!(WARM)) { PG8_WAIT_V(8); } PG8_WAIT_L(0); PG8_BAR; PG8_MMA(0, 0, At, B0); PG8_MMA(0, 1, At, B1); PG8_BAR; PG8_SCHED; \
              \
            PG8_LDA(At, 0, 1); PG8_STAGE(PG8_SB(0, 0), b2, voffB); PG8_STAGE(PG8_SB(0, 1), b2 + hstep, voffB); PG8_STAGE_A(PG8_SA(0, 0), a2, 0); \
            if constexpr (!(WARM)) { PG8_WAIT_V(8); } PG8_WAIT_L(0); PG8_BAR; PG8_MMA(1, 0, At, B0); PG8_MMA(1, 1, At, B1); PG8_BAR; PG8_SCHED; \
              \
            PG8_LDB(B0, 1, 0); PG8_LDB(B1, 1, 1); PG8_SCHED; PG8_LDA(At, 1, 0); PG8_STAGE_A(PG8_SA(0, 1), a2, 1); \
            if constexpr (!(WARM)) { PG8_WAIT_V(8); } PG8_WAIT_L(0); PG8_BAR; PG8_MMA(0, 0, At, B0); PG8_MMA(0, 1, At, B1); PG8_BAR; PG8_SCHED; \
              \
            PG8_LDA(At, 1, 1); PG8_STAGE(PG8_SB(1, 0), b3, voffB); PG8_STAGE(PG8_SB(1, 1), b3 + hstep, voffB); PG8_STAGE_A(PG8_SA(1, 0), a3, 0); \
            PG8_WAIT_V(8); PG8_WAIT_L(0); PG8_BAR; PG8_MMA(1, 0, At, B0); PG8_MMA(1, 1, At, B1); PG8_BAR; PG8_SCHED; \
        } while (0)
        int t0_ = 0;
        if constexpr (WARMTRIP) { if (ui > 0) { PG8_TRIP(true, 0); t0_ = 2; } }
        for (int t = t0_; t < nt; t += 2) { PG8_TRIP(false, t); }
#undef PG8_TRIP
        if (wr == 0) PG8_BAR;
        if constexpr (WARMTRIP) { PG8_STAGE_A(PG8_SA(1, 1), nA + kstep, 1); }
        bool has_nn = false;
        if constexpr (GATHER) { if (has_next) { has_nn = S.next(ui + 2, nn); if (has_nn) { PG8_GOFF(gN, nn); } } }
        else { if (has_next) has_nn = S.next(ui + 2, nn); }
        { int fr_ = fr, fq_ = fq; asm volatile("" : "+v"(fr_), "+v"(fq_));
          const LAS unsigned char* mt = lds + LDS_META + (ui & 1) * 4096;
          if constexpr (WARMTRIP) {
              E.pre(acc, cur, wr, wc, fr_, fq_, mt);
              if constexpr (GATHER) asm volatile("" : "+v"(gN[0][0]), "+v"(gN[0][1]), "+v"(gN[1][0]), "+v"(gN[1][1]));
              PG8_WAIT_V(0);
              E.post(acc, cur, wr, wc, fr_, fq_, mt);
          } else { E.run(acc, cur, wr, wc, fr_, fq_, mt); } }
        if (!has_next) break;
#pragma unroll
        for (int a = 0; a < 2; ++a)
#pragma unroll
            for (int b = 0; b < 2; ++b)
#pragma unroll
                for (int m = 0; m < 4; ++m)
#pragma unroll
                    for (int n = 0; n < 2; ++n) acc[a][b][m][n] = (f32x4){0.f, 0.f, 0.f, 0.f};
        cur = nxt; cA = nA; cB = nB; ++ui; nxt = nn; has_next = has_nn;
        if (wr == 1) PG8_BAR;
    }
    PG8_WAIT_V(0);
    PG8_BAR;
#undef PG8_SA
#undef PG8_SB
#undef PG8_STAGE
#undef PG8_STAGE_A
#undef PG8_LDA
#undef PG8_LDB
#undef PG8_MMA
#undef PG8_LD16
#undef PG8_CAT
#undef PG8_WAIT_V
#undef PG8_WAIT_L
#undef PG8_BAR
#undef PG8_SCHED
#undef PG8_GOFF
}
}

using pg8::Unit; using pg8::cvt_pk_bf16;
constexpr int BM = 256, HALF = 128;

typedef f32x4 (&AccRef)[2][2][4][2];
__device__ __forceinline__ void pack8_bf16(f32x4& lo, const f32x4& hi) {
    const unsigned w0 = cvt_pk_bf16(lo[0], lo[1]), w1 = cvt_pk_bf16(lo[2], lo[3]), w2 = cvt_pk_bf16(hi[0], hi[1]), w3 = cvt_pk_bf16(hi[2], hi[3]);
    lo[0] = __builtin_bit_cast(float, w0); lo[1] = __builtin_bit_cast(float, w1); lo[2] = __builtin_bit_cast(float, w2); lo[3] = __builtin_bit_cast(float, w3);
}
#define AS_U4(v) __builtin_bit_cast(u32x4, v)

struct EpiInProj {
    static constexpr bool PERM = true;
    const float* rs1; const f32x2* rope; const float* glu_b;
    bf16_t *q, *k, *v, *qi, *ki, *hglu; float* wi;
    __device__ __forceinline__ void pre(AccRef acc, const Unit& u, int wr, int wc, int fr, int fq, const LAS unsigned char* mt) const {
        const int row0 = u.pm * BM + wr * 64 + fr;
        if (u.pn >= 4) {
            const int ch = 128 * (u.pn - 4) + 32 * wc + 8 * fq;
            f32x4 ba[2], bg[2];
#pragma unroll
            for (int n = 0; n < 2; ++n) { ba[n] = *(const f32x4*)(glu_b + ch + 4 * n); bg[n] = *(const f32x4*)(glu_b + 512 + ch + 4 * n); }
#pragma unroll
            for (int ai = 0; ai < 2; ++ai)
#pragma unroll
                for (int m = 0; m < 4; ++m) { const float rs = rs1[row0 + ai * HALF + m * 16];
#pragma unroll
                    for (int n = 0; n < 2; ++n)
#pragma unroll
                        for (int e = 0; e < 4; ++e) { const float a = acc[ai][0][m][n][e] * rs + ba[n][e], g = acc[ai][1][m][n][e] * rs + bg[n][e]; acc[ai][0][m][n][e] = a * sigmoidf_(g); }
                    pack8_bf16(acc[ai][0][m][0], acc[ai][0][m][1]); }
            return;
        }
        const bool do_rope = !(u.pn == 3 && wc >= 2), is_wi = (u.pn == 3 && wc == 3);
        const int d0 = 8 * fq;
#pragma unroll
        for (int ai = 0; ai < 2; ++ai)
#pragma unroll
            for (int m = 0; m < 4; ++m) { const int row = row0 + ai * HALF + m * 16; const float rs = rs1[row];
                if (do_rope) {
                    const f32x2* rp = rope + (size_t)(row & (SEQ - 1)) * 32 + d0;
#pragma unroll
                    for (int n = 0; n < 2; ++n)
#pragma unroll
                        for (int e = 0; e < 4; ++e) { const f32x2 cs = rp[4 * n + e]; const float x1 = acc[ai][0][m][n][e] * rs, x2 = acc[ai][1][m][n][e] * rs;
                            acc[ai][0][m][n][e] = x1 * cs.x - x2 * cs.y; acc[ai][1][m][n][e] = x2 * cs.x + x1 * cs.y; }
                } else {
#pragma unroll
                    for (int n = 0; n < 2; ++n) { acc[ai][0][m][n] = acc[ai][0][m][n] * rs; acc[ai][1][m][n] = acc[ai][1][m][n] * rs; }
                }
                if (!is_wi) { pack8_bf16(acc[ai][0][m][0], acc[ai][0][m][1]); pack8_bf16(acc[ai][1][m][0], acc[ai][1][m][1]); }
                if (m & 1) __builtin_amdgcn_sched_barrier(0); }
    }
    __device__ __forceinline__ void post(AccRef acc, const Unit& u, int wr, int wc, int fr, int fq, const LAS unsigned char* mt) const {
        const int row0 = u.pm * BM + wr * 64 + fr;
        if (u.pn >= 4) {
            const int ch = 128 * (u.pn - 4) + 32 * wc + 8 * fq;
#pragma unroll
            for (int ai = 0; ai < 2; ++ai)
#pragma unroll
                for (int m = 0; m < 4; ++m) *(u32x4*)(hglu + (size_t)(row0 + ai * HALF + m * 16) * 512 + ch) = AS_U4(acc[ai][0][m][0]);
            return;
        }
        bf16_t* dst; int ld, col; bool is_wi = false;
        if (u.pn < 2) { dst = q; ld = 512; col = (4 * u.pn + wc) * 64; }
        else if (u.pn == 2) { dst = qi; ld = 256; col = wc * 64; }
        else { ld = 64; col = 0; if (wc == 0) dst = k; else if (wc == 1) dst = ki; else if (wc == 2) dst = v; else { dst = v; is_wi = true; } }
        if (is_wi) {
            if (fq == 0) {
#pragma unroll
                for (int ai = 0; ai < 2; ++ai)
#pragma unroll
                    for (int m = 0; m < 4; ++m) *(f32x4*)(wi + (size_t)(row0 + ai * HALF + m * 16) * 4) = acc[ai][0][m][0];
            }
            return;
        }
#pragma unroll
        for (int ai = 0; ai < 2; ++ai)
#pragma unroll
            for (int m = 0; m < 4; ++m) { bf16_t* rp2 = dst + (size_t)(row0 + ai * HALF + m * 16) * ld + col + 8 * fq;
                *(u32x4*)(rp2) = AS_U4(acc[ai][0][m][0]); *(u32x4*)(rp2 + 32) = AS_U4(acc[ai][1][m][0]); }
    }
    __device__ __forceinline__ void run(const f32x4 (&acc)[2][2][4][2], const Unit& u, int wr, int wc, int fr, int fq, const LAS unsigned char* mt) const {
        const int row0 = u.pm * BM + wr * 64 + fr;
        if (u.pn >= 4) {
            const int ch = 128 * (u.pn - 4) + 32 * wc + 8 * fq;
            f32x4 ba[2], bg[2];
#pragma unroll
            for (int n = 0; n < 2; ++n) { ba[n] = *(const f32x4*)(glu_b + ch + 4 * n); bg[n] = *(const f32x4*)(glu_b + 512 + ch + 4 * n); }
#pragma unroll
            for (int ai = 0; ai < 2; ++ai)
#pragma unroll
                for (int m = 0; m < 4; ++m) { const int row = row0 + ai * HALF + m * 16; const float rs = rs1[row];
                    float o[8];
#pragma unroll
                    for (int n = 0; n < 2; ++n)
#pragma unroll
                        for (int e = 0; e < 4; ++e) { const float a = acc[ai][0][m][n][e] * rs + ba[n][e], g = acc[ai][1][m][n][e] * rs + bg[n][e]; o[4 * n + e] = a * sigmoidf_(g); }
                    u32x4 w; w.x = cvt_pk_bf16(o[0], o[1]); w.y = cvt_pk_bf16(o[2], o[3]); w.z = cvt_pk_bf16(o[4], o[5]); w.w = cvt_pk_bf16(o[6], o[7]);
                    *(u32x4*)(hglu + (size_t)row * 512 + ch) = w; }
            return;
        }
        bf16_t* dst; int ld, col; bool do_rope = true, is_wi = false;
        if (u.pn < 2) { dst = q; ld = 512; col = (4 * u.pn + wc) * 64; }
        else if (u.pn == 2) { dst = qi; ld = 256; col = wc * 64; }
        else { ld = 64; col = 0; if (wc == 0) dst = k; else if (wc == 1) dst = ki; else if (wc == 2) { dst = v; do_rope = false; } else { dst = v; is_wi = true; do_rope = false; } }
        if (is_wi) {
            if (fq == 0) {
#pragma unroll
                for (int ai = 0; ai < 2; ++ai)
#pragma unroll
                    for (int m = 0; m < 4; ++m) { const int row = row0 + ai * HALF + m * 16; const float rs = rs1[row];
                        *(f32x4*)(wi + (size_t)row * 4) = acc[ai][0][m][0] * rs; }
            }
            return;
        }
        const int d0 = 8 * fq;
#pragma unroll
        for (int ai = 0; ai < 2; ++ai)
#pragma unroll
            for (int m = 0; m < 4; ++m) { const int row = row0 + ai * HALF + m * 16; const float rs = rs1[row];
                float o1[8], o2[8];
                if (do_rope) {
                    const f32x2* rp = rope + (size_t)(row & (SEQ - 1)) * 32 + d0;
#pragma unroll
                    for (int n = 0; n < 2; ++n)
#pragma unroll
                        for (int e = 0; e < 4; ++e) { const f32x2 cs = rp[4 * n + e]; const float x1 = acc[ai][0][m][n][e] * rs, x2 = acc[ai][1][m][n][e] * rs;
                            o1[4 * n + e] = x1 * cs.x - x2 * cs.y; o2[4 * n + e] = x2 * cs.x + x1 * cs.y; }
                } else {
#pragma unroll
                    for (int n = 0; n < 2; ++n)
#pragma unroll
                        for (int e = 0; e < 4; ++e) { o1[4 * n + e] = acc[ai][0][m][n][e] * rs; o2[4 * n + e] = acc[ai][1][m][n][e] * rs; }
                }
                u32x4 w1, w2; w1.x = cvt_pk_bf16(o1[0], o1[1]); w1.y = cvt_pk_bf16(o1[2], o1[3]); w1.z = cvt_pk_bf16(o1[4], o1[5]); w1.w = cvt_pk_bf16(o1[6], o1[7]);
                w2.x = cvt_pk_bf16(o2[0], o2[1]); w2.y = cvt_pk_bf16(o2[2], o2[3]); w2.z = cvt_pk_bf16(o2[4], o2[5]); w2.w = cvt_pk_bf16(o2[6], o2[7]);
                bf16_t* rp2 = dst + (size_t)row * ld + col + d0;
                *(u32x4*)(rp2) = w1; *(u32x4*)(rp2 + 32) = w2; }
    }
};

struct EpiBf16Plain {
    static constexpr bool PERM = true;
    bf16_t* O; int ldc;
    __device__ __forceinline__ void pre(AccRef acc, const Unit&, int, int, int, int, const LAS unsigned char*) const {
#pragma unroll
        for (int ai = 0; ai < 2; ++ai)
#pragma unroll
            for (int bj = 0; bj < 2; ++bj)
#pragma unroll
                for (int m = 0; m < 4; ++m) pack8_bf16(acc[ai][bj][m][0], acc[ai][bj][m][1]);
    }
    __device__ __forceinline__ void post(AccRef acc, const Unit& u, int wr, int wc, int fr, int fq, const LAS unsigned char* mt) const {
        const int row0 = u.pm * BM + wr * 64 + fr, col0 = u.pn * BM + wc * 32 + 8 * fq;
#pragma unroll
        for (int ai = 0; ai < 2; ++ai)
#pragma unroll
            for (int m = 0; m < 4; ++m) { bf16_t* rowp = O + (size_t)(row0 + ai * HALF + m * 16) * ldc + col0;
#pragma unroll
                for (int bj = 0; bj < 2; ++bj) *(u32x4*)(rowp + bj * HALF) = AS_U4(acc[ai][bj][m][0]); }
    }
    __device__ __forceinline__ void run(const f32x4 (&acc)[2][2][4][2], const Unit& u, int wr, int wc, int fr, int fq, const LAS unsigned char* mt) const {
        const int row0 = u.pm * BM + wr * 64 + fr, col0 = u.pn * BM + wc * 32 + 8 * fq;
#pragma unroll
        for (int ai = 0; ai < 2; ++ai)
#pragma unroll
            for (int m = 0; m < 4; ++m) { bf16_t* rowp = O + (size_t)(row0 + ai * HALF + m * 16) * ldc + col0;
#pragma unroll
                for (int bj = 0; bj < 2; ++bj) { const f32x4 v0 = acc[ai][bj][m][0], v1 = acc[ai][bj][m][1];
                    u32x4 w; w.x = cvt_pk_bf16(v0[0], v0[1]); w.y = cvt_pk_bf16(v0[2], v0[3]); w.z = cvt_pk_bf16(v1[0], v1[1]); w.w = cvt_pk_bf16(v1[2], v1[3]);
                    *(u32x4*)(rowp + bj * HALF) = w; } }
    }
};

struct EpiOutProj {
    static constexpr bool PERM = false;
    const float* x; float* h1; unsigned char* h1f8;
    __device__ __forceinline__ void pre(AccRef acc, const Unit& u, int wr, int wc, int fr, int fq, const LAS unsigned char* mt) const {
        const int row0 = u.pm * BM + wr * 64 + fr, col0 = u.pn * BM + wc * 32 + 4 * fq;
#pragma unroll
        for (int ai = 0; ai < 2; ++ai)
#pragma unroll
            for (int m = 0; m < 4; ++m) { const size_t off = (size_t)(row0 + ai * HALF + m * 16) * DM + col0;
#pragma unroll
                for (int bj = 0; bj < 2; ++bj)
#pragma unroll
                    for (int n = 0; n < 2; ++n) acc[ai][bj][m][n] += *(const f32x4*)(x + off + bj * HALF + n * 16);
                if (m & 1) __builtin_amdgcn_sched_barrier(0); }
    }
    __device__ __forceinline__ void post(AccRef acc, const Unit& u, int wr, int wc, int fr, int fq, const LAS unsigned char* mt) const {
        const int row0 = u.pm * BM + wr * 64 + fr, col0 = u.pn * BM + wc * 32 + 4 * fq;
#pragma unroll
        for (int ai = 0; ai < 2; ++ai)
#pragma unroll
            for (int m = 0; m < 4; ++m) { const size_t off = (size_t)(row0 + ai * HALF + m * 16) * DM + col0;
#pragma unroll
                for (int bj = 0; bj < 2; ++bj)
#pragma unroll
                    for (int n = 0; n < 2; ++n) { const size_t o = off + bj * HALF + n * 16; const f32x4 r = acc[ai][bj][m][n];
                        *(f32x4*)(h1 + o) = r; *(unsigned*)(h1f8 + o) = pk4_fp8(r[0], r[1], r[2], r[3]); } }
    }
    __device__ __forceinline__ void run(AccRef acc, const Unit& u, int wr, int wc, int fr, int fq, const LAS unsigned char* mt) const { pre(acc, u, wr, wc, fr, fq, mt); post(acc, u, wr, wc, fr, fq, mt); }
};

struct EpiUp {
    static constexpr bool PERM = true;
    unsigned char* act;
    __device__ __forceinline__ void pre(AccRef acc, const Unit& u, int wr, int wc, int fr, int fq, const LAS unsigned char* mt) const {
        const int r0 = wr * 64 + fr, cl = 32 * wc + 8 * fq;
        const LAS float* rowA = (const LAS float*)mt; const LAS float* bias = (const LAS float*)(mt + 2048);
        f32x4 bg[2], bl[2];
#pragma unroll
        for (int n = 0; n < 2; ++n) { bg[n] = *(const LAS f32x4*)(bias + cl + 4 * n); bl[n] = *(const LAS f32x4*)(bias + 128 + cl + 4 * n); }
#pragma unroll
        for (int ai = 0; ai < 2; ++ai)
#pragma unroll
            for (int m = 0; m < 4; ++m) { const int r = r0 + ai * HALF + m * 16;
                const float rs = (r < u.rows) ? rowA[r] * 0.03125f : 0.f;
                float o[8];
#pragma unroll
                for (int n = 0; n < 2; ++n)
#pragma unroll
                    for (int e = 0; e < 4; ++e) { float g = acc[ai][0][m][n][e] * rs + bg[n][e], l = acc[ai][1][m][n][e] * rs + bl[n][e];
                        g = fminf(g, 7.0f); l = fminf(fmaxf(l, -7.0f), 7.0f); o[4 * n + e] = g * sigmoidf_(1.702f * g) * (l + 1.0f); }
                acc[ai][0][m][0][0] = __builtin_bit_cast(float, pk4_fp8(o[0], o[1], o[2], o[3])); acc[ai][0][m][0][1] = __builtin_bit_cast(float, pk4_fp8(o[4], o[5], o[6], o[7])); }
    }
    __device__ __forceinline__ void post(AccRef acc, const Unit& u, int wr, int wc, int fr, int fq, const LAS unsigned char* mt) const {
        const int r0 = wr * 64 + fr, ch = 128 * u.pn + 32 * wc + 8 * fq;
#pragma unroll
        for (int ai = 0; ai < 2; ++ai)
#pragma unroll
            for (int m = 0; m < 4; ++m) { const int r = r0 + ai * HALF + m * 16;
                u32x2 w; w.x = __builtin_bit_cast(unsigned, acc[ai][0][m][0][0]); w.y = __builtin_bit_cast(unsigned, acc[ai][0][m][0][1]);
                *(u32x2*)(act + (size_t)(u.pm * BM + r) * 1024 + ch) = w; }
    }
    __device__ __forceinline__ void run(const f32x4 (&acc)[2][2][4][2], const Unit& u, int wr, int wc, int fr, int fq, const LAS unsigned char* mt) const {
        const int r0 = wr * 64 + fr, cl = 32 * wc + 8 * fq, ch = 128 * u.pn + cl;
        const LAS float* rowA = (const LAS float*)mt; const LAS float* bias = (const LAS float*)(mt + 2048);
        f32x4 bg[2], bl[2];
#pragma unroll
        for (int n = 0; n < 2; ++n) { bg[n] = *(const LAS f32x4*)(bias + cl + 4 * n); bl[n] = *(const LAS f32x4*)(bias + 128 + cl + 4 * n); }
#pragma unroll
        for (int ai = 0; ai < 2; ++ai)
#pragma unroll
            for (int m = 0; m < 4; ++m) { const int r = r0 + ai * HALF + m * 16;
                const float rs = (r < u.rows) ? rowA[r] * 0.03125f : 0.f;
                float o[8];
#pragma unroll
                for (int n = 0; n < 2; ++n)
#pragma unroll
                    for (int e = 0; e < 4; ++e) { float g = acc[ai][0][m][n][e] * rs + bg[n][e], l = acc[ai][1][m][n][e] * rs + bl[n][e];
                        g = fminf(g, 7.0f); l = fminf(fmaxf(l, -7.0f), 7.0f); o[4 * n + e] = g * sigmoidf_(1.702f * g) * (l + 1.0f); }
                u32x2 w; w.x = pk4_fp8(o[0], o[1], o[2], o[3]); w.y = pk4_fp8(o[4], o[5], o[6], o[7]);
                *(u32x2*)(act + (size_t)(u.pm * BM + r) * 1024 + ch) = w; }
    }
};

struct EpiDown {
    static constexpr bool PERM = true;
    bf16_t* y;
    __device__ __forceinline__ void pre(AccRef acc, const Unit& u, int wr, int wc, int fr, int fq, const LAS unsigned char* mt) const {
        const int r0 = wr * 64 + fr, cl = wc * 32 + 8 * fq;
        const LAS float* gateT = (const LAS float*)(mt + 1024); const LAS float* bias = (const LAS float*)(mt + 2048);
        float gt[2][4];
#pragma unroll
        for (int ai = 0; ai < 2; ++ai)
#pragma unroll
            for (int m = 0; m < 4; ++m) gt[ai][m] = gateT[r0 + ai * HALF + m * 16];
#pragma unroll
        for (int bj = 0; bj < 2; ++bj) { const f32x4 bv0 = *(const LAS f32x4*)(bias + cl + bj * HALF), bv1 = *(const LAS f32x4*)(bias + cl + bj * HALF + 4);
#pragma unroll
            for (int ai = 0; ai < 2; ++ai)
#pragma unroll
                for (int m = 0; m < 4; ++m) { acc[ai][bj][m][0] = (acc[ai][bj][m][0] * 0.03125f + bv0) * gt[ai][m]; acc[ai][bj][m][1] = (acc[ai][bj][m][1] * 0.03125f + bv1) * gt[ai][m];
                    pack8_bf16(acc[ai][bj][m][0], acc[ai][bj][m][1]); } }
    }
    __device__ __forceinline__ void post(AccRef acc, const Unit& u, int wr, int wc, int fr, int fq, const LAS unsigned char* mt) const {
        const int r0 = wr * 64 + fr, col0 = u.pn * BM + wc * 32 + 8 * fq;
        const LAS int* slotT = (const LAS int*)mt;
#pragma unroll
        for (int ai = 0; ai < 2; ++ai)
#pragma unroll
            for (int m = 0; m < 4; ++m) { const int r = r0 + ai * HALF + m * 16;
                if (r < u.rows) { bf16_t* rowp = y + (size_t)slotT[r] * 1024 + col0;
#pragma unroll
                    for (int bj = 0; bj < 2; ++bj) *(u32x4*)(rowp + bj * HALF) = AS_U4(acc[ai][bj][m][0]); } }
    }
    __device__ __forceinline__ void run(AccRef acc, const Unit& u, int wr, int wc, int fr, int fq, const LAS unsigned char* mt) const { pre(acc, u, wr, wc, fr, fq, mt); post(acc, u, wr, wc, fr, fq, mt); }
};

template <bool F8>
__device__ __forceinline__ void p0_transpose_item(const float* W, int ldw, void* WTv, int Kdim, const float* gain, LAS float* scr, int kb, int n0, int src0, int nvalid, int lane) {
    bf16_t* WT = (bf16_t*)WTv;
    const int k0 = 64 * kb;
    f32x4 ld4[8];
#pragma unroll
    for (int i = 0; i < 8; ++i) { const int kk = 8 * i + (lane >> 3), j = (lane & 7) * 4;
        ld4[i] = (f32x4){0.f, 0.f, 0.f, 0.f}; if (j < nvalid) ld4[i] = *(const f32x4*)(W + (size_t)(k0 + kk) * ldw + src0 + j); }
#pragma unroll
    for (int i = 0; i < 8; ++i) { const int kk = 8 * i + (lane >> 3), j = (lane & 7) * 4; const float gk = (gain ? gain[k0 + kk] : 1.0f) * (F8 ? 32.0f : 1.0f);
        LAS float* d = scr + kk * 33 + j; d[0] = ld4[i].x * gk; d[1] = ld4[i].y * gk; d[2] = ld4[i].z * gk; d[3] = ld4[i].w * gk; }
    LDS_WAIT(); asm volatile("" ::: "memory");
    const int c = lane & 7;
#pragma unroll
    for (int j = 0; j < 4; ++j) { const int n = (lane >> 3) + 8 * j; const LAS float* s = scr + (8 * c) * 33 + n;
        if constexpr (F8) { u32x2 o; o.x = pk4_fp8(s[0 * 33], s[1 * 33], s[2 * 33], s[3 * 33]); o.y = pk4_fp8(s[4 * 33], s[5 * 33], s[6 * 33], s[7 * 33]);
            *(u32x2*)((unsigned char*)WTv + (size_t)(n0 + n) * Kdim + k0 + 8 * c) = o; }
        else { u32x4 o; o.x = pk2(s[0 * 33], s[1 * 33]); o.y = pk2(s[2 * 33], s[3 * 33]); o.z = pk2(s[4 * 33], s[5 * 33]); o.w = pk2(s[6 * 33], s[7 * 33]);
            *(u32x4*)(WT + (size_t)(n0 + n) * Kdim + k0 + 8 * c) = o; } }
    LDS_WAIT(); asm volatile("" ::: "memory");
}
__device__ __forceinline__ void win_colmap(int nb, int& src0, int& nvalid) {
    const int pn = nb >> 3, j = (nb & 7) * 32, bj = j >> 7, slot = (j & 127) >> 5;
    nvalid = 32;
    if (pn < 2) src0 = (4 * pn + slot) * 64 + 32 * bj;
    else if (pn == 2) src0 = 640 + slot * 64 + 32 * bj;
    else if (pn == 3) { if (slot == 0) src0 = 512 + 32 * bj; else if (slot == 1) src0 = 896 + 32 * bj; else if (slot == 2) src0 = 576 + 32 * bj; else { src0 = 960; nvalid = bj == 0 ? 4 : 0; } }
    else src0 = 964 + 512 * bj + 128 * (pn - 4) + 32 * slot;
}
__device__ __forceinline__ void p0_prologue(const Params& P, LAS unsigned char* lds, int vcu, int G, int wave, int lane) {
    unsigned char* ws = P.ws;
    LAS float* scr = (LAS float*)(lds + wave * 16384);
    const int gw = vcu * NWAVES + wave, NGW = G * NWAVES;
    constexpr int I_IN = 16 * 64, I_OUT = 16 * 32, I_G = 16 * 32, I_P = 4 * 32, I_UP = 32 * 16 * 64, I_DN = 32 * 16 * 32;
    constexpr int NITEMS = I_IN + I_OUT + I_G + I_P + I_UP + I_DN;
    for (int it = gw; it < NITEMS; it += NGW) {
        int r = it;
        if (r < I_IN) { const int kb = r / 64, nb = r % 64; int s0, nv; win_colmap(nb, s0, nv); p0_transpose_item<false>(P.w_in, INW, (bf16_t*)(ws + WS_WIN), 1024, P.g_mix, scr, kb, nb * 32, s0, nv, lane); continue; } r -= I_IN;
        if (r < I_OUT) { const int kb = r / 32, nb = r % 32; p0_transpose_item<false>(P.w_out, 1024, (bf16_t*)(ws + WS_WOUT), 1024, nullptr, scr, kb, nb * 32, nb * 32, 32, lane); continue; } r -= I_OUT;
        if (r < I_G) { const int kb = r / 32, nb = r % 32; p0_transpose_item<false>(P.w_ple_gate, 1024, (bf16_t*)(ws + WS_WG), 1024, P.g_ple, scr, kb, nb * 32, nb * 32, 32, lane); continue; } r -= I_G;
        if (r < I_P) { const int kb = r / 32, nb = r % 32; p0_transpose_item<false>(P.w_ple_proj, 1024, (bf16_t*)(ws + WS_WP), 256, nullptr, scr, kb, nb * 32, nb * 32, 32, lane); continue; } r -= I_P;
        if (r < I_UP) { const int e = r / 1024, rr = r % 1024, kb = rr / 64, nb = rr % 64;
            const int pn = nb >> 3, j = (nb & 7) * 32, bj = j >> 7, jj = j & 127;
            p0_transpose_item<true>(P.w_up + (size_t)e * 1024 * 2048, 2048, (unsigned char*)(ws + WS_WUP) + (size_t)e * 2048 * 1024, 1024, P.g_ffn, scr, kb, nb * 32, 1024 * bj + 128 * pn + jj, 32, lane); continue; } r -= I_UP;
        { const int e = r / 512, rr = r % 512, kb = rr / 32, nb = rr % 32;
            p0_transpose_item<true>(P.w_down + (size_t)e * 1024 * 1024, 1024, (unsigned char*)(ws + WS_WDOWN) + (size_t)e * 1024 * 1024, 1024, nullptr, scr, kb, nb * 32, nb * 32, 32, lane); }
    }
    float* rs1 = (float*)(ws + WS_RS1); bf16_t* xb = (bf16_t*)(ws + WS_XB);
    for (int m = gw; m < NTOK; m += NGW) {
        const f32x4* xr = (const f32x4*)(P.x + (size_t)m * DM) + lane; f32x4 v[4]; float s = 0.f;
#pragma unroll
        for (int j = 0; j < 4; ++j) { v[j] = xr[64 * j]; s += (v[j].x * v[j].x + v[j].y * v[j].y) + (v[j].z * v[j].z + v[j].w * v[j].w); }
        s = wave_sum(s);
        u32x2* o8 = (u32x2*)(xb + (size_t)m * DM) + lane;
#pragma unroll
        for (int j = 0; j < 4; ++j) { u32x2 w; w.x = pk2(v[j].x, v[j].y); w.y = pk2(v[j].z, v[j].w); o8[64 * j] = w; }
        if (lane == 0) rs1[m] = 1.0f / sqrtf(s * (1.0f / DM) + EPS);
    }
    bf16_t* pb = (bf16_t*)(ws + WS_PB);
    for (int m = gw; m < NTOK; m += NGW) { const f32x4 v = *((const f32x4*)(P.p + (size_t)m * 256) + lane); u32x2 w; w.x = pk2(v.x, v.y); w.y = pk2(v.z, v.w); *((u32x2*)(pb + (size_t)m * 256) + lane) = w; }
    f32x2* rope = (f32x2*)(ws + WS_ROPE);
    for (int idx = gw * 64 + lane; idx < SEQ * 32; idx += NGW * 64) { const int t = idx >> 5, i = idx & 31;
        const float inv = exp2f(-(float)i * (13.287712379549449f / 32.0f));
        const float ang = (float)t * inv;
        const double rev = (double)ang * 0.15915494309189535; const float fr = (float)(rev - __builtin_floor(rev));
        rope[idx] = (f32x2){__builtin_amdgcn_cosf(fr), __builtin_amdgcn_sinf(fr)}; }
    float* wrg = (float*)(ws + WS_WRG);
    for (int idx = gw * 64 + lane; idx < 1024 * 32; idx += NGW * 64) wrg[idx] = P.w_router[idx] * P.g_ffn[idx >> 5];
}

__device__ __forceinline__ unsigned fkey(float f) { unsigned u = __builtin_bit_cast(unsigned, f); if (u == 0x80000000u) u = 0u; return u ^ ((unsigned)((int)u >> 31) | 0x80000000u); }
__device__ __forceinline__ int mbcnt64(unsigned long long m) { return __builtin_amdgcn_mbcnt_hi((unsigned)(m >> 32), __builtin_amdgcn_mbcnt_lo((unsigned)m, 0u)); }

template <int NR>
__device__ __forceinline__ unsigned bisect_thr(const unsigned (&v)[NR], unsigned prefix, int startbit) {
    bool exact = false;
#pragma unroll 1
    for (int bit = startbit; bit >= 0; --bit) {
        const unsigned cand = prefix | (1u << bit); int cnt = 0;
#pragma unroll
        for (int r = 0; r < NR; ++r) { cnt += __builtin_popcountll(__ballot(v[r] >= cand)); if ((r & 7) == 7) __builtin_amdgcn_sched_barrier(0); }
        if (cnt >= NSEL) prefix = cand;
        if (cnt == NSEL) { exact = true; break; }
    }
    return exact ? prefix - 1u : prefix;
}
template <int NR, bool EXPL>
__device__ __forceinline__ void compact_sel(const unsigned (&v)[NR], const unsigned (&ci)[NR], unsigned T, LAS unsigned* list, int lane) {
    int cgt = 0;
#pragma unroll
    for (int r = 0; r < NR; ++r) { cgt += __builtin_popcountll(__ballot(v[r] > T)); if ((r & 7) == 7) __builtin_amdgcn_sched_barrier(0); }
    const int need = NSEL - cgt; int base = 0, ties = 0;
#pragma unroll
    for (int r = 0; r < NR; ++r) { const bool gt = v[r] > T, eq = v[r] == T; const unsigned long long em = __ballot(eq);
        const bool sel = gt || (eq && (ties + mbcnt64(em)) < need); const unsigned long long sm = __ballot(sel);
        list[sel ? base + mbcnt64(sm) : NSEL + lane] = EXPL ? ci[r] : (unsigned)(r * 64 + lane);
        base += __builtin_popcountll(sm); ties += __builtin_popcountll(em);
        if ((r & 3) == 3) __builtin_amdgcn_sched_barrier(0); }
}
constexpr int SEL_CAP = 1024;
template <int NR>
__device__ __forceinline__ void select_topk(LAS float* row, LAS unsigned* H, LAS unsigned* list, int lane, bool zero_h) {
    unsigned v[NR];
#pragma unroll
    for (int r = 0; r < NR; ++r) v[r] = fkey(row[r * 64 + lane]);
    LAS u32x4* H4 = (LAS u32x4*)H;
    const u32x4 h0 = H4[2 * lane], h1 = H4[2 * lane + 1];
    if (zero_h) { H4[2 * lane] = (u32x4){0u, 0u, 0u, 0u}; H4[2 * lane + 1] = (u32x4){0u, 0u, 0u, 0u}; }
    const unsigned hw[8] = {h0.x, h0.y, h0.z, h0.w, h1.x, h1.y, h1.z, h1.w};
    unsigned c[16];
#pragma unroll
    for (int i = 0; i < 8; ++i) { c[2 * i] = hw[i] & 0xffffu; c[2 * i + 1] = hw[i] >> 16; }
    unsigned s = 0u;
#pragma unroll
    for (int i = 0; i < 16; ++i) s += c[i];
    unsigned S = s;
#pragma unroll
    for (int off = 1; off < 64; off <<= 1) { const unsigned o = __shfl_down(S, off); if (lane + off < 64) S += o; }
    const unsigned long long okm = __ballot(S >= (unsigned)NSEL);
    bool fast = okm != 0ull; unsigned floorkey = 0u; int C = 0;
    if (fast) {
        const int Ls = 63 - __builtin_clzll(okm);
        unsigned acc = S - s; int bl = -1; unsigned accb = 0u;
#pragma unroll
        for (int b = 15; b >= 0; --b) { acc += c[b]; if (bl < 0 && acc >= (unsigned)NSEL) { bl = b; accb = acc; } }
        const int bstar = __shfl(bl, Ls) + 16 * Ls; C = (int)__shfl(accb, Ls);
        floorkey = (unsigned)bstar << 22;
        fast = (bstar > 1) && (C <= SEL_CAP);
    }
    if (!fast) {
        const unsigned T = bisect_thr<NR>(v, 0u, 31);
        compact_sel<NR, false>(v, v, T, list, lane);
        return;
    }
    LAS unsigned* ckl = (LAS unsigned*)row; LAS unsigned* cil = ckl + 1152;
    { int base = 0;
#pragma unroll
      for (int r = 0; r < NR; ++r) { const bool cnd = v[r] >= floorkey; const unsigned long long m = __ballot(cnd);
          const int pos = cnd ? base + mbcnt64(m) : SEL_CAP + lane;
          ckl[pos] = v[r]; cil[pos] = (unsigned)(r * 64 + lane); base += __builtin_popcountll(m);
          if ((r & 3) == 3) __builtin_amdgcn_sched_barrier(0); } }
    if (C <= 512) {
        unsigned ck[8], ci[8];
#pragma unroll
        for (int j = 0; j < 8; ++j) { const int i = j * 64 + lane; ck[j] = i < C ? ckl[i] : 0u; ci[j] = cil[i]; }
        const unsigned T = (C == NSEL) ? floorkey - 1u : bisect_thr<8>(ck, floorkey, 21);
        compact_sel<8, true>(ck, ci, T, list, lane);
    } else {
        unsigned ck[16], ci[16];
#pragma unroll
        for (int j = 0; j < 16; ++j) { const int i = j * 64 + lane; ck[j] = i < C ? ckl[i] : 0u; ci[j] = cil[i]; }
        const unsigned T = bisect_thr<16>(ck, floorkey, 21);
        compact_sel<16, true>(ck, ci, T, list, lane);
    }
}

typedef short v4i16 __attribute__((ext_vector_type(4)));
constexpr int VROW = 144;

__device__ __forceinline__ void attn_tile(const Params& P, LAS unsigned char* lds, int b, int t0, int wave, int lane) {
    unsigned char* ws = P.ws;
    const bf16_t* QI = (const bf16_t*)(ws + WS_QI); const bf16_t* KI = (const bf16_t*)(ws + WS_KI);
    const bf16_t* Q = (const bf16_t*)(ws + WS_Q); const bf16_t* Kp = (const bf16_t*)(ws + WS_K); const bf16_t* Vp = (const bf16_t*)(ws + WS_V);
    const float* WI = (const float*)(ws + WS_WI); bf16_t* MIX = (bf16_t*)(ws + WS_MIX);
    LAS float* SC = (LAS float*)lds;
    LAS unsigned* list = (LAS unsigned*)(lds + wave * 16384 + 14336);
    LAS unsigned* HIST = (LAS unsigned*)(lds + LDS_MISC);
    const int tokbase = b * SEQ;
    const bool need_sel = t0 >= 256;
    if (need_sel) {
        const int nkt = (t0 + 8 + 31) >> 5;
        bf16x8 a[4]; f32x4 w[4];
        { const bf16_t* src = QI + (size_t)(tokbase + t0 + ((lane & 31) >> 2)) * 256 + (lane & 3) * 64 + 8 * (lane >> 5);
#pragma unroll
          for (int ks = 0; ks < 4; ++ks) a[ks] = *(const bf16x8*)(src + 16 * ks); }
#pragma unroll
        for (int g = 0; g < 4; ++g) w[g] = *(const f32x4*)(WI + (size_t)(tokbase + t0 + 2 * g + (lane >> 5)) * 4);
        for (int kt0 = wave; kt0 < nkt; kt0 += 4 * NWAVES) {
            bf16x8 bf[4][4];
#pragma unroll
            for (int u = 0; u < 4; ++u) { const int kt = kt0 + u * NWAVES;
                if (kt < nkt) { const bf16_t* ksrc = KI + (size_t)(tokbase + kt * 32 + (lane & 31)) * 64 + 8 * (lane >> 5);
#pragma unroll
                    for (int ks = 0; ks < 4; ++ks) bf[u][ks] = *(const bf16x8*)(ksrc + 16 * ks); } }
#pragma unroll
            for (int u = 0; u < 4; ++u) { const int kt = kt0 + u * NWAVES;
                if (kt < nkt) {
                    const int key = kt * 32 + (lane & 31);
                    f32x16 acc;
#pragma unroll
                    for (int i = 0; i < 16; ++i) acc[i] = 0.f;
#pragma unroll
                    for (int ks = 0; ks < 4; ++ks) acc = __builtin_amdgcn_mfma_f32_32x32x16_bf16(a[ks], bf[u][ks], acc, 0, 0, 0);
#pragma unroll
                    for (int g = 0; g < 4; ++g) { float sc = 0.f;
#pragma unroll
                        for (int h = 0; h < 4; ++h) sc = fmaf(fmaxf(acc[4 * g + h], 0.f), w[g][h], sc);
                        const int ql = 2 * g + (lane >> 5);
                        if (key > t0 + ql) sc = -INFINITY;
                        SC[ql * 4096 + key] = sc;
                        if (key <= t0 + ql) { const unsigned ub = __builtin_bit_cast(unsigned, sc);
                            const unsigned bin = (ub >> 22) ^ (((unsigned)((int)ub >> 31) & 0x1ffu) | 0x200u);
                            __hip_atomic_fetch_add(HIST + ql * 512 + (bin >> 1), 1u << ((bin & 1u) << 4), __ATOMIC_RELAXED, __HIP_MEMORY_SCOPE_WORKGROUP); } }
                } }
        }
        { const int npad = ((t0 + 8 + 1023) >> 10) << 10;
          for (int i = nkt * 32 + (int)threadIdx.x; i < npad; i += NTHR) {
#pragma unroll
              for (int q = 0; q < 8; ++q) SC[q * 4096 + i] = -INFINITY; } }
    }
    __syncthreads();
    const int t = t0 + wave, tok = tokbase + t;
    if (need_sel) {
        LAS float* row = SC + wave * 4096; LAS unsigned* H = HIST + wave * 512; const int n = t + 1;
        if (n <= 1024) select_topk<16>(row, H, list, lane, true);
        else if (n <= 2048) select_topk<32>(row, H, list, lane, true);
        else if (n <= 3072) select_topk<48>(row, H, list, lane, true);
        else select_topk<64>(row, H, list, lane, true);
    } else {
#pragma unroll
        for (int i = 0; i < 4; ++i) list[i * 64 + lane] = (unsigned)(i * 64 + lane);
    }
    const int nvalid = need_sel ? NSEL : (t + 1);
    const int ngrp = (nvalid + 31) >> 5;
    const int hd = lane & 15, g = lane >> 4;
    bf16x8 qf0, qf1;
#pragma unroll
    for (int i = 0; i < 8; ++i) { qf0[i] = 0; qf1[i] = 0; }
    if (hd < 8) { const bf16_t* qs = Q + (size_t)tok * 512 + hd * 64 + 8 * g; qf0 = *(const bf16x8*)qs; qf1 = *(const bf16x8*)(qs + 32); }
    float m = -INFINITY, ssum = 0.f;
    f32x4 o[4];
#pragma unroll
    for (int dt = 0; dt < 4; ++dt) o[dt] = (f32x4){0.f, 0.f, 0.f, 0.f};
    LAS unsigned char* vreg = lds + wave * 16384;
    bf16x8 kfA[4], kfB[4]; u32x4 vvA[4], vvB[4];
#define ATT_LOAD(KF, VV, G_) do { const int nb_ = (G_) * 32; const unsigned ia_ = list[nb_ + hd], ib_ = list[nb_ + 16 + hd]; \
        const bf16_t* ka_ = Kp + (size_t)(tokbase + ia_) * 64 + 8 * g; const bf16_t* kb_ = Kp + (size_t)(tokbase + ib_) * 64 + 8 * g; \
        KF[0] = *(const bf16x8*)ka_; KF[1] = *(const bf16x8*)(ka_ + 32); KF[2] = *(const bf16x8*)kb_; KF[3] = *(const bf16x8*)(kb_ + 32); \
        _Pragma("unroll") for (int i_ = 0; i_ < 4; ++i_) { const unsigned idx_ = list[nb_ + (lane >> 3) + 8 * i_]; VV[i_] = *(const u32x4*)(Vp + (size_t)(tokbase + idx_) * 64 + 8 * (lane & 7)); } } while (0)
#define ATT_GROUP(KF, VV, G_, VBUF) do { \
        LAS unsigned char* vbuf_ = (VBUF); \
        f32x4 sa_ = {0.f, 0.f, 0.f, 0.f}, sb_ = {0.f, 0.f, 0.f, 0.f}; \
        sa_ = __builtin_amdgcn_mfma_f32_16x16x32_bf16(KF[0], qf0, sa_, 0, 0, 0); sa_ = __builtin_amdgcn_mfma_f32_16x16x32_bf16(KF[1], qf1, sa_, 0, 0, 0); \
        sb_ = __builtin_amdgcn_mfma_f32_16x16x32_bf16(KF[2], qf0, sb_, 0, 0, 0); sb_ = __builtin_amdgcn_mfma_f32_16x16x32_bf16(KF[3], qf1, sb_, 0, 0, 0); \
        _Pragma("unroll") for (int i_ = 0; i_ < 4; ++i_) *(LAS u32x4*)(vbuf_ + ((lane >> 3) + 8 * i_) * VROW + (lane & 7) * 16) = VV[i_]; \
        if ((G_) + 2 < ngrp) ATT_LOAD(KF, VV, (G_) + 2); \
        float l_[8]; float mloc_ = -INFINITY; \
        _Pragma("unroll") for (int r_ = 0; r_ < 4; ++r_) { const int sl_ = (G_) * 32 + 4 * g + r_; \
            l_[r_] = sl_ < nvalid ? sa_[r_] * 0.125f : -INFINITY; l_[4 + r_] = (sl_ + 16) < nvalid ? sb_[r_] * 0.125f : -INFINITY; \
            mloc_ = fmaxf(mloc_, fmaxf(l_[r_], l_[4 + r_])); } \
        mloc_ = fmaxf(mloc_, __shfl_xor(mloc_, 16)); mloc_ = fmaxf(mloc_, __shfl_xor(mloc_, 32)); \
        const float mnew_ = fmaxf(m, mloc_), alpha_ = __expf(m - mnew_); m = mnew_; \
        float ps_ = 0.f; \
        _Pragma("unroll") for (int r_ = 0; r_ < 8; ++r_) { l_[r_] = __expf(l_[r_] - mnew_); ps_ += l_[r_]; } \
        ssum = ssum * alpha_ + ps_; \
        bf16x8 pf_; \
        { const u32x4 pw_ = {cvt_pk_bf16(l_[0], l_[1]), cvt_pk_bf16(l_[2], l_[3]), cvt_pk_bf16(l_[4], l_[5]), cvt_pk_bf16(l_[6], l_[7])}; pf_ = __builtin_bit_cast(bf16x8, pw_); } \
        LAS unsigned char* ta_ = vbuf_ + (4 * g + (hd >> 2)) * VROW + (hd & 3) * 8; \
        _Pragma("unroll") for (int dt_ = 0; dt_ < 4; ++dt_) { \
            const v4i16 lo_ = __builtin_amdgcn_ds_read_tr16_b64_v4i16((LAS v4i16*)(ta_ + dt_ * 32)); \
            const v4i16 hi_ = __builtin_amdgcn_ds_read_tr16_b64_v4i16((LAS v4i16*)(ta_ + 16 * VROW + dt_ * 32)); \
            bf16x8 vf_; vf_[0] = lo_[0]; vf_[1] = lo_[1]; vf_[2] = lo_[2]; vf_[3] = lo_[3]; vf_[4] = hi_[0]; vf_[5] = hi_[1]; vf_[6] = hi_[2]; vf_[7] = hi_[3]; \
            o[dt_] = __builtin_amdgcn_mfma_f32_16x16x32_bf16(vf_, pf_, o[dt_] * alpha_, 0, 0, 0); } } while (0)
    ATT_LOAD(kfA, vvA, 0);
    if (ngrp > 1) ATT_LOAD(kfB, vvB, 1);
#pragma unroll 1
    for (int grp = 0; grp < ngrp; grp += 2) {
        ATT_GROUP(kfA, vvA, grp, vreg);
        if (grp + 1 < ngrp) ATT_GROUP(kfB, vvB, grp + 1, vreg + 8192);
    }
#undef ATT_LOAD
#undef ATT_GROUP
    ssum += __shfl_xor(ssum, 16); ssum += __shfl_xor(ssum, 32);
    const float inv = 1.0f / ssum;
    if (hd < 8) {
        bf16_t* op = MIX + (size_t)tok * 1024 + hd * 64 + 4 * g;
#pragma unroll
        for (int dt = 0; dt < 4; ++dt) { u32x2 w; w.x = cvt_pk_bf16(o[dt][0] * inv, o[dt][1] * inv); w.y = cvt_pk_bf16(o[dt][2] * inv, o[dt][3] * inv); *(u32x2*)(op + 16 * dt) = w; }
    }
    __syncthreads();
}

__device__ __forceinline__ void conv_tile(const Params& P, LAS unsigned char* lds, int tile, int tid, int wave, int lane) {
    unsigned char* ws = P.ws;
    const bf16_t* HG = (const bf16_t*)(ws + WS_HGLU); bf16_t* MIX = (bf16_t*)(ws + WS_MIX);
    LAS f32x2* part = (LAS f32x2*)(lds + LDS_MISC + 1024);
    LAS f32x2* stat = part + 256;
    LAS bf16_t* Lin = (LAS bf16_t*)lds;
    LAS bf16_t* Lout = (LAS bf16_t*)(lds + 65536);
    const int tok0 = tile * 32, t0 = tok0 & (SEQ - 1), c = tid;
    for (int ch = tid; ch < 62 * 64; ch += NTHR) { const int r = ch >> 6, cc = ch & 63; const int tt = t0 - 30 + r;
        u32x4 v = {0u, 0u, 0u, 0u}; if (tt >= 0) v = *(const u32x4*)(HG + (size_t)(tok0 - 30 + r) * 512 + cc * 8);
        *(LAS u32x4*)(Lin + r * 512 + cc * 8) = v; }
    __syncthreads();
    float in[62];
#pragma unroll
    for (int r = 0; r < 62; ++r) in[r] = __builtin_bit_cast(float, (unsigned)Lin[r * 512 + c] << 16);
    float out[32];
    const float bias = P.dw_b[c];
#pragma unroll
    for (int i = 0; i < 32; ++i) out[i] = bias;
#pragma unroll
    for (int j = 0; j < 31; ++j) { const float wj = P.dw_w[j * 512 + c];
#pragma unroll
        for (int i = 0; i < 32; ++i) out[i] = fmaf(in[i + j], wj, out[i]); }
#pragma unroll
    for (int i = 0; i < 32; ++i) { const float s1 = wave_sum(out[i]), s2 = wave_sum(out[i] * out[i]); if (lane == 0) part[i * 8 + wave] = (f32x2){s1, s2}; }
    __syncthreads();
    if (tid < 32) { float s1 = 0.f, s2 = 0.f;
#pragma unroll
        for (int w = 0; w < 8; ++w) { const f32x2 pp = part[tid * 8 + w]; s1 += pp.x; s2 += pp.y; }
        const float mean = s1 * (1.0f / 512.0f), var = fmaxf(s2 * (1.0f / 512.0f) - mean * mean, 0.f);
        stat[tid] = (f32x2){mean, 1.0f / sqrtf(var + EPS)}; }
    __syncthreads();
    const float lgc = P.ln_g[c], lbc = P.ln_b[c];
#pragma unroll
    for (int i = 0; i < 32; ++i) { const f32x2 st = stat[i]; const float y = (out[i] - st.x) * st.y * lgc + lbc; const float sl = y * sigmoidf_(y);
        Lout[i * 512 + c] = (bf16_t)f2bf(sl); }
    __syncthreads();
    for (int ch = tid; ch < 32 * 64; ch += NTHR) { const int r = ch >> 6, cc = ch & 63;
        *(u32x4*)(MIX + (size_t)(tok0 + r) * 1024 + 512 + cc * 8) = *(const LAS u32x4*)(Lout + r * 512 + cc * 8); }
    __syncthreads();
}

__device__ __forceinline__ void router_phase(const Params& P, LAS unsigned char* lds, int blk, int G, int tid, int wave, int lane) {
    unsigned char* ws = P.ws;
    const float* h1 = (const float*)(ws + WS_H1); const float* wrg = (const float*)(ws + WS_WRG);
    int* list = (int*)(ws + WS_LIST); float* lscale = (float*)(ws + WS_LSCALE); float* lgate = (float*)(ws + WS_LGATE);
    unsigned* cntg = (unsigned*)(ws + WS_CTL) + CW_CNT;
    LAS float* WL = (LAS float*)lds;
    LAS int* lcnt = (LAS int*)(lds + LDS_MISC + 1024);
    LAS int* gbase = lcnt + 32;
    LAS int* rec_e = gbase + 32;
    LAS int* rec_p = rec_e + 512;
    LAS float* rec_g = (LAS float*)(rec_p + 512);
    LAS float* rec_s = rec_g + 512;
    for (int i = tid; i < 8192; i += NTHR) ((LAS f32x4*)WL)[i] = ((const f32x4*)wrg)[i];
    __syncthreads();
    const int tl = lane & 31, half = lane >> 5;
    for (int chunk = blk; chunk < NTOK / 128; chunk += G) {
        if (tid < 32) lcnt[tid] = 0;
        __syncthreads();
        if (wave < 4) {
            const int tloc = wave * 32 + tl, tok = chunk * 128 + tloc;
            const float* hrow = h1 + (size_t)tok * DM + 4 * half;
            f32x16 acc;
#pragma unroll
            for (int i = 0; i < 16; ++i) acc[i] = 0.f;
            float ss = 0.f;
#pragma unroll 1
            for (int k0 = 0; k0 < DM; k0 += 32) {
                f32x4 hv[4];
#pragma unroll
                for (int i = 0; i < 4; ++i) hv[i] = *(const f32x4*)(hrow + k0 + 8 * i);
#pragma unroll
                for (int i = 0; i < 4; ++i) {
                    ss = fmaf(hv[i].x, hv[i].x, fmaf(hv[i].y, hv[i].y, fmaf(hv[i].z, hv[i].z, fmaf(hv[i].w, hv[i].w, ss))));
#pragma unroll
                    for (int j = 0; j < 4; ++j) { const float wv = WL[(k0 + 8 * i + 4 * half + j) * 32 + tl];
                        acc = __builtin_amdgcn_mfma_f32_32x32x2f32(wv, hv[i][j], acc, 0, 0, 0); }
                }
            }
            ss += __shfl_xor(ss, 32);
            const float rs = 1.0f / sqrtf(ss * (1.0f / DM) + EPS);
            float v[16];
#pragma unroll
            for (int r = 0; r < 16; ++r) v[r] = acc[r] * rs + P.b_router[(r & 3) + 8 * (r >> 2) + 4 * half];
            float tv[4]; int te[4];
#pragma unroll
            for (int q = 0; q < 4; ++q) { float bv = -INFINITY; int be = 64;
#pragma unroll
                for (int r = 0; r < 16; ++r) { const int e = (r & 3) + 8 * (r >> 2) + 4 * half; if (v[r] > bv || (v[r] == bv && e < be)) { bv = v[r]; be = e; } }
#pragma unroll
                for (int r = 0; r < 16; ++r) { const int e = (r & 3) + 8 * (r >> 2) + 4 * half; if (e == be) v[r] = -INFINITY; }
                tv[q] = bv; te[q] = be; }
            float cv[8]; int ce[8];
#pragma unroll
            for (int q = 0; q < 4; ++q) { cv[q] = tv[q]; ce[q] = te[q]; cv[4 + q] = __shfl_xor(tv[q], 32); ce[4 + q] = __shfl_xor(te[q], 32); }
#pragma unroll
            for (int q = 0; q < 4; ++q) { float bv = -INFINITY; int be = 64;
#pragma unroll
                for (int r = 0; r < 8; ++r) if (cv[r] > bv || (cv[r] == bv && ce[r] < be)) { bv = cv[r]; be = ce[r]; }
#pragma unroll
                for (int r = 0; r < 8; ++r) if (ce[r] == be) cv[r] = -INFINITY;
                tv[q] = bv; te[q] = be; }
            const float e1 = __expf(tv[1] - tv[0]), e2 = __expf(tv[2] - tv[0]), e3 = __expf(tv[3] - tv[0]);
            const float is = 1.0f / (1.0f + e1 + e2 + e3);
            if (half == 0) {
                const float gq[4] = {is, e1 * is, e2 * is, e3 * is};
#pragma unroll
                for (int q = 0; q < 4; ++q) { const int lp = atomicAdd((int*)&lcnt[te[q]], 1); const int si = tloc * 4 + q; rec_e[si] = te[q]; rec_p[si] = lp; rec_g[si] = gq[q]; }
                rec_s[tloc] = rs;
            }
        }
        __syncthreads();
        if (tid < 32) gbase[tid] = (int)atomicAdd(cntg + 64 * tid, (unsigned)lcnt[tid]);
        __syncthreads();
        { const int si = tid, ee = rec_e[si], pos = gbase[ee] + rec_p[si], li = ee * NTOK + pos;
          list[li] = (chunk * 128) * 4 + si; lscale[li] = rec_s[si >> 2]; lgate[li] = rec_g[si]; }
        __syncthreads();
    }
}

__device__ __forceinline__ void combine_phase(const Params& P, int gw, int NGW, int lane) {
    unsigned char* ws = P.ws;
    float* h1 = (float*)(ws + WS_H1); bf16_t* h1b = (bf16_t*)(ws + WS_H1B); const bf16_t* y = (const bf16_t*)(ws + WS_Y); float* rs3 = (float*)(ws + WS_RS3);
    for (int m = gw; m < NTOK; m += NGW) {
        const f32x4* hr = (const f32x4*)(h1 + (size_t)m * DM) + lane; f32x4 v[4]; float s = 0.f;
#pragma unroll
        for (int j = 0; j < 4; ++j) v[j] = hr[64 * j];
#pragma unroll
        for (int k = 0; k < 4; ++k) { const u32x2* yr = (const u32x2*)(y + (size_t)(m * 4 + k) * DM) + lane;
#pragma unroll
            for (int j = 0; j < 4; ++j) { const u32x2 w = yr[64 * j]; v[j].x += bf_lo(w.x); v[j].y += bf_hi(w.x); v[j].z += bf_lo(w.y); v[j].w += bf_hi(w.y); } }
        u32x2* o8 = (u32x2*)(h1b + (size_t)m * DM) + lane;
#pragma unroll
        for (int j = 0; j < 4; ++j) { u32x2 w; w.x = pk2(v[j].x, v[j].y); w.y = pk2(v[j].z, v[j].w); o8[64 * j] = w;
            s += (v[j].x * v[j].x + v[j].y * v[j].y) + (v[j].z * v[j].z + v[j].w * v[j].w); }
        s = wave_sum(s);
        if (lane == 0) rs3[m] = 1.0f / sqrtf(s * (1.0f / DM) + EPS);
    }
}

__device__ __forceinline__ void final_phase(const Params& P, int gw, int NGW, int lane) {
    unsigned char* ws = P.ws;
    const bf16_t* h2b = (const bf16_t*)(ws + WS_H1B); const bf16_t* pj = (const bf16_t*)(ws + WS_PJ); const bf16_t* G = (const bf16_t*)(ws + WS_G); const float* rs3 = (const float*)(ws + WS_RS3);
    f32x4 gv[4];
#pragma unroll
    for (int j = 0; j < 4; ++j) gv[j] = *((const f32x4*)P.g_final + lane + 64 * j);
    for (int m = gw; m < NTOK; m += NGW) {
        const u32x2* hr = (const u32x2*)(h2b + (size_t)m * DM) + lane; const u32x2* pr = (const u32x2*)(pj + (size_t)m * DM) + lane; const u32x2* gr = (const u32x2*)(G + (size_t)m * DM) + lane;
        const float r3 = rs3[m]; f32x4 v[4]; float s = 0.f;
#pragma unroll
        for (int j = 0; j < 4; ++j) { const u32x2 hw = hr[64 * j], pw = pr[64 * j], gw2 = gr[64 * j];
            v[j].x = bf_lo(hw.x) + bf_lo(pw.x) * sigmoidf_(bf_lo(gw2.x) * r3); v[j].y = bf_hi(hw.x) + bf_hi(pw.x) * sigmoidf_(bf_hi(gw2.x) * r3);
            v[j].z = bf_lo(hw.y) + bf_lo(pw.y) * sigmoidf_(bf_lo(gw2.y) * r3); v[j].w = bf_hi(hw.y) + bf_hi(pw.y) * sigmoidf_(bf_hi(gw2.y) * r3);
            s += (v[j].x * v[j].x + v[j].y * v[j].y) + (v[j].z * v[j].z + v[j].w * v[j].w); }
        s = wave_sum(s); const float rs = 1.0f / sqrtf(s * (1.0f / DM) + EPS);
        f32x4* orow = (f32x4*)(P.out + (size_t)m * DM) + lane;
#pragma unroll
        for (int j = 0; j < 4; ++j) orow[64 * j] = v[j] * rs * gv[j];
    }
}

#define XB_TMO      128
#define XB_XCNT(j)  (256  + 64 * (j))
#define XB_XSUB(j)  (1280 + 64 * (j))
#define XB_XGEN(j)  (2304 + 64 * (j))
#define XB_TOP      3328
#define XB_TOPGEN   3392
#define XCD_BAR_WORDS 3456
#define XB_SPIN_CAP (1u << 18)
__device__ __forceinline__ unsigned xb_ld(unsigned* p)              { return __hip_atomic_load(p, __ATOMIC_RELAXED, __HIP_MEMORY_SCOPE_AGENT); }
__device__ __forceinline__ unsigned xb_add(unsigned* p, unsigned v) { return __hip_atomic_fetch_add(p, v, __ATOMIC_RELAXED, __HIP_MEMORY_SCOPE_AGENT); }
__device__ __forceinline__ unsigned xb_xcc_id() { return (unsigned)__builtin_amdgcn_s_getreg((3 << 11) | 20) & 0xFu; }
#define XB_SPIN(cond, bar) do { unsigned _sp = 0; while (cond) { __builtin_amdgcn_s_sleep(1); \
    if ((++_sp & 255u) == 0u) { if (xb_ld(&(bar)[XB_TMO])) break; if (_sp > XB_SPIN_CAP) { atomicAdd(&(bar)[XB_TMO], 1u); break; } } } } while (0)
struct XcdBarrier { unsigned* bar; unsigned x; volatile LAS unsigned* st; };
__device__ __forceinline__ XcdBarrier xcd_barrier_post(unsigned* bar, volatile LAS unsigned* st) {
    XcdBarrier b; b.bar = bar; b.x = xb_xcc_id(); b.st = st;
    if (threadIdx.x == 0) (void)xb_add(&bar[XB_XCNT(b.x)], 1u);
    return b;
}
__device__ __forceinline__ void xcd_barrier_complete(unsigned* bar, unsigned x, unsigned& nloc, unsigned& nx) {
    const unsigned G = gridDim.x * gridDim.y * gridDim.z;
    unsigned sum, cnt, mine, sp = 0u;
    for (;;) {
        sum = 0u; cnt = 0u; mine = 0u;
#pragma unroll
        for (unsigned j = 0; j < 16; ++j) { const unsigned c = xb_ld(&bar[XB_XCNT(j)]); sum += c; cnt += (c > 0u) ? 1u : 0u; mine = (j == x) ? c : mine; }
        if (sum == G) break;
        __builtin_amdgcn_s_sleep(1);
        if ((++sp & 255u) == 0u) { if (xb_ld(&bar[XB_TMO])) break; if (sp > XB_SPIN_CAP) { atomicAdd(&bar[XB_TMO], 1u); break; } }
    }
    nloc = mine > 0u ? mine : 1u; nx = cnt > 0u ? cnt : 1u;
}
__device__ __forceinline__ void xcd_barrier(const XcdBarrier& b) {
    asm volatile("s_waitcnt vmcnt(0)" ::: "memory");
    __syncthreads();
    if (threadIdx.x == 0) {
        unsigned* bar = b.bar;
        __builtin_amdgcn_s_waitcnt(0);
        unsigned nloc = b.st[0], nx = b.st[1];
        if (nloc == 0u) { xcd_barrier_complete(bar, b.x, nloc, nx); b.st[0] = nloc; b.st[1] = nx; }
        const unsigned old = xb_add(&bar[XB_XSUB(b.x)], 1u);
        const unsigned gen = old / nloc;
        if (old + 1u == (gen + 1u) * nloc) {
            __builtin_amdgcn_fence(__ATOMIC_RELEASE, "agent");
            asm volatile("s_waitcnt vmcnt(0)" ::: "memory");
            const unsigned og = xb_add(&bar[XB_TOP], 1u);
            const unsigned tg = og / nx;
            if (og + 1u == (tg + 1u) * nx) xb_add(&bar[XB_TOPGEN], 1u);
            else XB_SPIN(xb_ld(&bar[XB_TOPGEN]) == tg, bar);
            __builtin_amdgcn_fence(__ATOMIC_ACQUIRE, "agent");
            xb_add(&bar[XB_XGEN(b.x)], 1u);
            asm volatile("s_waitcnt vmcnt(0)" ::: "memory");
        } else {
            XB_SPIN(xb_ld(&bar[XB_XGEN(b.x)]) == gen, bar);
            __builtin_amdgcn_fence(__ATOMIC_ACQUIRE, "agent");
            asm volatile("s_waitcnt vmcnt(0)" ::: "memory");
        }
    }
    __syncthreads();
}

constexpr int NPHASE = 10;
__global__ void __launch_bounds__(NTHR, 2) fwd_kernel(Params P) {
    extern __shared__ __attribute__((aligned(16))) unsigned char lds_raw[];
    LAS unsigned char* lds = (LAS unsigned char*)lds_raw;
    cg::grid_group grid = cg::this_grid();
    const int tid = threadIdx.x, wave = __builtin_amdgcn_readfirstlane(tid >> 6);
    const int G = gridDim.x, bx = blockIdx.x;
#define FRESH_LANE(name) int name = (int)__builtin_amdgcn_mbcnt_hi(~0u, __builtin_amdgcn_mbcnt_lo(~0u, 0u)); asm volatile("" : "+v"(name))
    const int vcu = (G % 8 == 0) ? (bx % 8) * (G / 8) + bx / 8 : bx;
    const int NGW = G * NWAVES;
    unsigned char* ws = P.ws;
    const int lo = P.ph_lo, hi = P.ph_hi;
#ifndef PH_MASK
#define PH_MASK 0x3ff
#endif
#define IN(k) ((((PH_MASK) >> (k)) & 1) && lo <= (k) && (k) < hi)
    volatile LAS unsigned* xst = (volatile LAS unsigned*)(lds + LDS_XB);
    if (tid < 2) xst[tid] = 0u;
    __syncthreads();
    const XcdBarrier xbar = xcd_barrier_post((unsigned*)(ws + WS_CTL) + CW_BAR, xst);
#define SYNC(k) do { if (IN(k) && IN((k) + 1)) { if ((k) == 0) grid.sync(); else xcd_barrier(xbar); } } while (0)

    if (IN(0)) { FRESH_LANE(lane); p0_prologue(P, lds, vcu, G, wave, lane); }
    SYNC(0);
    if (IN(1)) {
        { pg8::DenseSched S; S.init((const bf16_t*)(ws + WS_XB), (const bf16_t*)(ws + WS_WIN), NTOK, 2048, 1024, G, bx);
          EpiInProj E{(const float*)(ws + WS_RS1), (const f32x2*)(ws + WS_ROPE), P.glu_b, (bf16_t*)(ws + WS_Q), (bf16_t*)(ws + WS_K), (bf16_t*)(ws + WS_V), (bf16_t*)(ws + WS_QI), (bf16_t*)(ws + WS_KI), (bf16_t*)(ws + WS_HGLU), (float*)(ws + WS_WI)};
          pg8::gemm_phase<EpiInProj, pg8::DenseSched, false>(lds, S, E); }
        { pg8::DenseSched S; S.init((const bf16_t*)(ws + WS_PB), (const bf16_t*)(ws + WS_WP), NTOK, 1024, 256, G, bx);
          EpiBf16Plain E{(bf16_t*)(ws + WS_PJ), 1024};
          pg8::gemm_phase<EpiBf16Plain, pg8::DenseSched, false>(lds, S, E); }
    }
    SYNC(1);
    if (IN(2)) {
        FRESH_LANE(lane);
        for (int i = tid; i < 4096; i += NTHR) ((LAS unsigned*)(lds + LDS_MISC))[i] = 0u;
        __syncthreads();
        if (G % 8 == 0) { const int b = bx % 8, jb = bx / 8, nbb = G / 8;
            for (int i = 0;; ++i) { const int k = i * nbb + ((i & 1) ? nbb - 1 - jb : jb); if (k >= 512) break; attn_tile(P, lds, b, (511 - k) * 8, wave, lane); } }
        else { for (int tl = bx; tl < 4096; tl += G) attn_tile(P, lds, tl & 7, (511 - (tl >> 3)) * 8, wave, lane); }
        for (int rp = 0; rp <= ((P.rep >> 3) & 1); ++rp)
        for (int tl = vcu; tl < NTOK / 32; tl += G) conv_tile(P, lds, tl, tid, wave, lane);
    }
    SYNC(2);
    if (IN(3)) {
        pg8::DenseSched S; S.init((const bf16_t*)(ws + WS_MIX), (const bf16_t*)(ws + WS_WOUT), NTOK, 1024, 1024, G, bx);
        EpiOutProj E{P.x, (float*)(ws + WS_H1), (unsigned char*)(ws + WS_H1F8)};
        pg8::gemm_phase<EpiOutProj, pg8::DenseSched, false, false, true>(lds, S, E);
    }
    SYNC(3);
    if (IN(4)) { FRESH_LANE(lane); router_phase(P, lds, vcu, G, tid, wave, lane); }
    SYNC(4);
    if (IN(5) || IN(6)) {
        LAS int* tb = (LAS int*)(lds + LDS_MISC); LAS int* cn = tb + 64;
        if (tid == 0) { const unsigned* cntg = (const unsigned*)(ws + WS_CTL) + CW_CNT; int acc = 0;
            for (int e = 0; e < NE; ++e) { const int c = (int)__hip_atomic_load(cntg + 64 * e, __ATOMIC_RELAXED, __HIP_MEMORY_SCOPE_AGENT); tb[e] = acc; cn[e] = c; acc += (c + BM - 1) / BM; }
            tb[NE] = acc; }
        __syncthreads();
        if (IN(5)) {
            pg8::MoeSched S; S.A = ws + WS_H1F8; S.Bt = ws + WS_WUP; S.rp = 1024; S.b_estride = (size_t)2048 * 1024; S.tb = tb; S.cnt = cn; S.list = (const int*)(ws + WS_LIST);
            S.nN = 8; S.nwg = tb[NE] * 8; S.G = G; S.c = bx; S.gather = true;
            S.m_scale = (const float*)(ws + WS_LSCALE); S.m_gate = nullptr; S.m_bias = P.b_up;
            EpiUp E{(unsigned char*)(ws + WS_ACT)};
            pg8::gemm_phase<EpiUp, pg8::MoeSched, true, true>(lds, S, E);
        }
        SYNC(5);
        if (IN(6)) {
            pg8::MoeSched S; S.A = ws + WS_ACT; S.Bt = ws + WS_WDOWN; S.rp = 1024; S.b_estride = (size_t)1024 * 1024; S.tb = tb; S.cnt = cn; S.list = (const int*)(ws + WS_LIST);
            S.nN = 4; S.nwg = tb[NE] * 4; S.G = G; S.c = bx; S.gather = false;
            S.m_scale = nullptr; S.m_gate = (const float*)(ws + WS_LGATE); S.m_bias = P.b_down;
            EpiDown E{(bf16_t*)(ws + WS_Y)};
            pg8::gemm_phase<EpiDown, pg8::MoeSched, true, true, true>(lds, S, E);
        }
    }
    SYNC(6);
    if (IN(7)) { FRESH_LANE(l7); const int g7 = vcu * NWAVES + wave;
        combine_phase(P, g7, NGW, l7); }
    SYNC(7);
    if (IN(8)) {
        pg8::DenseSched S; S.init((const bf16_t*)(ws + WS_H1B), (const bf16_t*)(ws + WS_WG), NTOK, 1024, 1024, G, bx);
        EpiBf16Plain E{(bf16_t*)(ws + WS_G), 1024};
        pg8::gemm_phase<EpiBf16Plain, pg8::DenseSched, false>(lds, S, E);
    }
    SYNC(8);
    if (IN(9)) { FRESH_LANE(l9); const int g9 = vcu * NWAVES + wave;
        final_phase(P, g9, NGW, l9); }
#undef IN
#undef SYNC
}

#ifndef N_LAUNCH_MODE
#define N_LAUNCH_MODE 1
#endif
extern "C" void kernel_launch(void* const* d_in, const int* in_sizes, int n_in, void* d_out, int out_size, void* d_ws, size_t ws_size, hipStream_t stream) {
    static int grid = 0;
    if (grid == 0) {
        if (n_in != 21 || out_size != NTOK * DM || ws_size < WS_END) { fprintf(stderr, "kernel_launch: unexpected shapes (n_in %d out %d ws %zu)\n", n_in, out_size, ws_size); grid = -1; return; }
        int dev = 0, cus = 0, per_cu = 0;
        (void)hipGetDevice(&dev); (void)hipDeviceGetAttribute(&cus, hipDeviceAttributeMultiprocessorCount, dev);
        (void)hipFuncSetAttribute((const void*)fwd_kernel, hipFuncAttributeMaxDynamicSharedMemorySize, LDS_BYTES);
        if (hipOccupancyMaxActiveBlocksPerMultiprocessor(&per_cu, (const void*)fwd_kernel, NTHR, LDS_BYTES) != hipSuccess || per_cu < 1) { fprintf(stderr, "kernel_launch: occupancy query failed (%d)\n", per_cu); (void)hipGetLastError(); grid = -1; return; }
        grid = cus;
    }
    if (grid < 0) return;
    (void)hipMemsetAsync((char*)d_ws + WS_CTL, 0, CTL_BYTES, stream);
    Params p{};
    p.x = (const float*)d_in[0]; p.p = (const float*)d_in[1]; p.w_in = (const float*)d_in[2]; p.w_out = (const float*)d_in[3]; p.g_mix = (const float*)d_in[4]; p.g_ffn = (const float*)d_in[5];
    p.glu_b = (const float*)d_in[6]; p.dw_w = (const float*)d_in[7]; p.dw_b = (const float*)d_in[8]; p.ln_g = (const float*)d_in[9]; p.ln_b = (const float*)d_in[10];
    p.w_router = (const float*)d_in[11]; p.b_router = (const float*)d_in[12]; p.w_up = (const float*)d_in[13]; p.b_up = (const float*)d_in[14]; p.w_down = (const float*)d_in[15]; p.b_down = (const float*)d_in[16];
    p.w_ple_proj = (const float*)d_in[17]; p.w_ple_gate = (const float*)d_in[18]; p.g_ple = (const float*)d_in[19]; p.g_final = (const float*)d_in[20];
    p.out = (float*)d_out; p.ws = (unsigned char*)d_ws;
#ifndef PROBE_REPMASK
#define PROBE_REPMASK 0
#endif
    p.rep = PROBE_REPMASK;
#if N_LAUNCH_MODE == 1
    p.ph_lo = 0; p.ph_hi = NPHASE;
    void* args[] = {&p};
    hipError_t e = hipLaunchCooperativeKernel((const void*)fwd_kernel, dim3(grid), dim3(NTHR), args, LDS_BYTES, stream);
    if (e != hipSuccess) fprintf(stderr, "cooperative launch failed: %s (grid %d)\n", hipGetErrorString(e), grid);
#else
    for (int ph = 0; ph < NPHASE; ++ph) {
        p.ph_lo = ph; p.ph_hi = ph + 1;
        void* args[] = {&p};
        hipError_t e = hipLaunchCooperativeKernel((const void*)fwd_kernel, dim3(grid), dim3(NTHR), args, LDS_BYTES, stream);
        if (e != hipSuccess) { fprintf(stderr, "launch %d failed: %s (grid %d)\n", ph, hipGetErrorString(e), grid); break; }
    }
#endif
}
```

```cpp
#include <hip/hip_runtime.h>
#include <hip/hip_cooperative_groups.h>
#include <cstdio>
#include <cstdint>
namespace cg = cooperative_groups;

#define LAS __attribute__((address_space(3)))
#define GAS __attribute__((address_space(1)))
typedef unsigned short bf16_t;
typedef short bf16x8 __attribute__((ext_vector_type(8)));
typedef short s16x4 __attribute__((ext_vector_type(4)));
typedef float f32x4 __attribute__((ext_vector_type(4)));
typedef float f32x2 __attribute__((ext_vector_type(2)));
typedef float f32x16 __attribute__((ext_vector_type(16)));
typedef unsigned u32x4 __attribute__((ext_vector_type(4)));
typedef unsigned u32x2 __attribute__((ext_vector_type(2)));

constexpr int NB = 8, SEQ = 4096, DM = 1024, NTOK = NB * SEQ;
constexpr int NE = 32, TOPK = 4, NSLOT = NTOK * TOPK;
constexpr int INW = 1988;
constexpr int NSEL = 256;
constexpr float EPS = 1e-6f;
constexpr int NWAVES = 8, NTHR = 512;

constexpr size_t MiB = 1u << 20;
constexpr size_t WS_CTL = 0, CTL_BYTES = 64 * 1024;
constexpr size_t WS_ROPE = 1 * MiB;
constexpr size_t WS_WIN = 2 * MiB;
constexpr size_t WS_WOUT = 6 * MiB;
constexpr size_t WS_WG = 8 * MiB;
constexpr size_t WS_WP = 10 * MiB;
constexpr size_t WS_WRG = 10 * MiB + 512 * 1024;
constexpr size_t WS_RS1 = 11 * MiB;
constexpr size_t WS_RS3 = 11 * MiB + 512 * 1024;
constexpr size_t WS_WI = 12 * MiB;
constexpr size_t WS_LIST = 13 * MiB;
constexpr size_t WS_LSCALE = 17 * MiB;
constexpr size_t WS_LGATE = 21 * MiB;
constexpr size_t WS_PB = 25 * MiB;
constexpr size_t WS_WUP = 42 * MiB;
constexpr size_t WS_WDOWN = 170 * MiB;
constexpr size_t WS_H1 = 234 * MiB;
constexpr size_t WS_H1B = 362 * MiB;
constexpr size_t WS_PJ = 426 * MiB;
constexpr size_t WS_XB = 490 * MiB;
constexpr size_t WS_Q = 554 * MiB;
constexpr size_t WS_K = 586 * MiB;
constexpr size_t WS_V = 590 * MiB;
constexpr size_t WS_QI = 594 * MiB;
constexpr size_t WS_KI = 610 * MiB;
constexpr size_t WS_HGLU = 614 * MiB;
constexpr size_t WS_MIX = 646 * MiB;
constexpr size_t WS_H1F8 = 490 * MiB;
constexpr size_t WS_ACT = 522 * MiB;
constexpr size_t WS_Y = 762 * MiB;
constexpr size_t WS_G = 762 * MiB;
constexpr size_t WS_END = 1018 * MiB;
static_assert(WS_H1F8 + (size_t)NTOK * 1024 <= WS_ACT && WS_ACT + (size_t)139264 * 1024 <= WS_Y, "ws map");
constexpr int CW_CNT = 1024;
constexpr int CW_BAR = 8192;

constexpr int LDS_STAGE = 131072;
constexpr int LDS_MISC = LDS_STAGE;
constexpr int LDS_META = LDS_MISC + 4096;
constexpr int LDS_XB = 147456;
constexpr int LDS_BYTES = 147456 + 256;

__device__ __forceinline__ unsigned f2bf(float f) { unsigned u = __builtin_bit_cast(unsigned, f); return (u + 0x7fffu + ((u >> 16) & 1u)) >> 16; }
__device__ __forceinline__ unsigned pk2(float lo, float hi) { return f2bf(lo) | (f2bf(hi) << 16); }
__device__ __forceinline__ float bf_lo(unsigned w) { return __builtin_bit_cast(float, w << 16); }
__device__ __forceinline__ float bf_hi(unsigned w) { return __builtin_bit_cast(float, w & 0xffff0000u); }
__device__ __forceinline__ float wave_sum(float v) {
    v += __builtin_bit_cast(float, __builtin_amdgcn_update_dpp(0, __builtin_bit_cast(int, v), 0xB1, 0xF, 0xF, true));
    v += __builtin_bit_cast(float, __builtin_amdgcn_update_dpp(0, __builtin_bit_cast(int, v), 0x4E, 0xF, 0xF, true));
    v += __builtin_bit_cast(float, __builtin_amdgcn_update_dpp(0, __builtin_bit_cast(int, v), 0x141, 0xF, 0xF, true));
    v += __builtin_bit_cast(float, __builtin_amdgcn_update_dpp(0, __builtin_bit_cast(int, v), 0x140, 0xF, 0xF, true));
    const int vi = __builtin_bit_cast(int, v);
    const float r0 = __builtin_bit_cast(float, __builtin_amdgcn_readlane(vi, 0)), r1 = __builtin_bit_cast(float, __builtin_amdgcn_readlane(vi, 16));
    const float r2 = __builtin_bit_cast(float, __builtin_amdgcn_readlane(vi, 32)), r3 = __builtin_bit_cast(float, __builtin_amdgcn_readlane(vi, 48));
    return (r0 + r1) + (r2 + r3);
}
__device__ __forceinline__ unsigned pk4_fp8(float a, float b, float c, float d) { int r = __builtin_amdgcn_cvt_pk_fp8_f32(a, b, 0, false); r = __builtin_amdgcn_cvt_pk_fp8_f32(c, d, r, true); return (unsigned)r; }
__device__ __forceinline__ float sigmoidf_(float x) { return __builtin_amdgcn_rcpf(1.0f + __builtin_amdgcn_exp2f(x * -1.4426950408889634f)); }
#define LDS_WAIT() asm volatile("s_waitcnt lgkmcnt(0)" ::: "memory")

struct Params {
    const float* x; const float* p; const float* w_in; const float* w_out; const float* g_mix; const float* g_ffn;
    const float* glu_b; const float* dw_w; const float* dw_b; const float* ln_g; const float* ln_b;
    const float* w_router; const float* b_router; const float* w_up; const float* b_up; const float* w_down; const float* b_down;
    const float* w_ple_proj; const float* w_ple_gate; const float* g_ple; const float* g_final;
    float* out; unsigned char* ws;
    int ph_lo, ph_hi, rep, pad;
};

namespace pg8 {
constexpr int BM = 256, BK = 64, HALF = 128, HTB = HALF * BK * 2, STAGE_BYTES = 8 * HTB, NXCD = 8, WGM = 8;
__host__ __device__ __forceinline__ int lds_byte(int r, int c) { const int st = (r >> 4) * 2 + (c >> 5), rr = r & 15, cc = c & 31, ob = rr * 64 + cc * 2; return st * 1024 + (ob ^ (((ob >> 9) & 1) << 5)); }
__host__ __device__ __forceinline__ void stage_rc(int b, int& R, int& C) { const int st = b / 1024, sb = b % 1024, swz = sb ^ (((sb >> 9) & 1) << 5); R = (st >> 1) * 16 + swz / 64; C = (st & 1) * 32 + (swz % 64) / 2; }
__host__ __device__ __forceinline__ int perm32(int rho) { const int n = rho >> 4, i = rho & 15; return 8 * (i >> 2) + 4 * n + (i & 3); }

struct Unit { int pm, pn, e, rows; };

__device__ __forceinline__ unsigned cvt_pk_bf16(float lo, float hi) { unsigned r; asm volatile("v_cvt_pk_bf16_f32 %0, %1, %2" : "=v"(r) : "v"(lo), "v"(hi)); return r; }

struct DenseSched {
    const void* A; const void* Bt; int rp;
    int nM, nN, nwg, G, c;
    __device__ void init(const void* A_, const void* Bt_, int M, int N, int K_, int G_, int c_) { A = A_; Bt = Bt_; rp = K_ * 2; nM = M / BM; nN = N / BM; nwg = nM * nN; G = G_; c = c_; }
    __device__ bool next(int i, Unit& u) const {
        const long L = (long)i * G + c; if (L >= nwg) return false;
        int wgid = (int)L; { const int q = nwg / NXCD, r = nwg % NXCD, xcd = wgid % NXCD, off = wgid / NXCD; wgid = (xcd < r ? xcd * (q + 1) : r * (q + 1) + (xcd - r) * q) + off; }
        const int nig = WGM * nN, gid = wgid / nig, fm = gid * WGM, gsz = (nM - fm) < WGM ? (nM - fm) : WGM;
        u.pm = fm + ((wgid % nig) % gsz); u.pn = (wgid % nig) / gsz; u.e = 0; u.rows = BM; return true;
    }
    __device__ __forceinline__ const char* a_ptr(const Unit& u) const { return (const char*)A + (size_t)u.pm * BM * rp; }
    __device__ __forceinline__ const char* b_ptr(const Unit& u) const { return (const char*)Bt + (size_t)u.pn * BM * rp; }
    __device__ __forceinline__ int a_row(const Unit&, int) const { return 0; }
    __device__ __forceinline__ void meta(const Unit&, LAS unsigned char*, int, int) const {}
};

struct MoeSched {
    const void* A; const void* Bt; int rp; size_t b_estride;
    const LAS int* tb;
    const LAS int* cnt;
    const int* list;
    int nN, nwg, G, c; bool gather;
    __device__ bool next(int i, Unit& u) const {
        const long L = (long)i * G + c; if (L >= nwg) return false;
        int wgid = (int)L; { const int q = nwg / NXCD, r = nwg % NXCD, xcd = wgid % NXCD, off = wgid / NXCD; wgid = (xcd < r ? xcd * (q + 1) : r * (q + 1) + (xcd - r) * q) + off; }
        int e = 0;
#pragma unroll 1
        for (; e < NE - 1; ++e) { if (wgid < tb[e + 1] * nN) break; }
        const int local = wgid - tb[e] * nN, nM = tb[e + 1] - tb[e];
        const int nig = WGM * nN, gid = local / nig, fm = gid * WGM, gsz = (nM - fm) < WGM ? (nM - fm) : WGM;
        const int rt = fm + ((local % nig) % gsz);
        u.pm = tb[e] + rt; u.pn = (local % nig) / gsz; u.e = e;
        const int left = cnt[e] - rt * BM; u.rows = left < BM ? left : BM; return true;
    }
    __device__ __forceinline__ const char* a_ptr(const Unit& u) const { return (const char*)A; }
    __device__ __forceinline__ const char* b_ptr(const Unit& u) const { return (const char*)Bt + (size_t)u.e * b_estride + (size_t)u.pn * BM * rp; }
    __device__ __forceinline__ int a_row(const Unit& u, int r) const {
        if (!gather) return u.pm * BM + r;
        const int rt = u.pm - tb[u.e];
        return r < u.rows ? (list[u.e * NTOK + rt * BM + r] >> 2) : 0;
    }
    const float* m_scale; const float* m_gate; const float* m_bias;
    __device__ __forceinline__ void meta(const Unit& u, LAS unsigned char* tbl, int wid, int lane) const {
        const int rt = u.pm - tb[u.e]; const size_t li = (size_t)u.e * NTOK + rt * BM + (wid & 3) * 64 + lane;
        if (gather) {
            if (wid < 4) __builtin_amdgcn_global_load_lds((const unsigned*)(m_scale + li), (LAS unsigned*)(tbl + (wid & 3) * 256), 4, 0, 0);
            else { const int j = (wid & 3) * 64 + lane; const float* src = m_bias + (size_t)u.e * 2048 + (j < 128 ? 128 * u.pn + j : 1024 + 128 * u.pn + (j - 128));
                __builtin_amdgcn_global_load_lds((const unsigned*)src, (LAS unsigned*)(tbl + 2048 + (wid & 3) * 256), 4, 0, 0); }
        } else {
            if (wid < 4) { __builtin_amdgcn_global_load_lds((const unsigned*)(list + li), (LAS unsigned*)(tbl + (wid & 3) * 256), 4, 0, 0);
                __builtin_amdgcn_global_load_lds((const unsigned*)(m_bias + (size_t)u.e * 1024 + u.pn * BM + (wid & 3) * 64 + lane), (LAS unsigned*)(tbl + 2048 + (wid & 3) * 256), 4, 0, 0); }
            else __builtin_amdgcn_global_load_lds((const unsigned*)(m_gate + li), (LAS unsigned*)(tbl + 1024 + (wid & 3) * 256), 4, 0, 0);
        }
    }
};

typedef int v8i32 __attribute__((ext_vector_type(8)));
template <class Epi, class Sched, bool GATHER, bool F8 = false, bool WARMTRIP = false>
__device__ __forceinline__ void gemm_phase(LAS unsigned char* lds, const Sched& S, const Epi& E) {
    const int tid = threadIdx.x, wid = __builtin_amdgcn_readfirstlane(tid >> 6), lane = tid & 63, wr = wid >> 2, wc = wid & 3, fr = lane & 15, fq = lane >> 4;
    const int RP = S.rp, nt = RP / (BK * 2);
    unsigned voffA[2], voffB[2]; int RA[2], CA[2];
#pragma unroll
    for (int i = 0; i < 2; ++i) { int R, C; stage_rc(tid * 16 + i * 8192, R, C); const int Rb = Epi::PERM ? ((R & ~31) + perm32(R & 31)) : R;
        voffA[i] = (unsigned)(R * RP + C * 2); voffB[i] = (unsigned)(Rb * RP + C * 2); RA[i] = R; CA[i] = C; }
    const size_t kstep = (size_t)(BK * 2);
    const size_t hstep = (size_t)HALF * RP;
    const unsigned ldsw = (unsigned)wid * 1024u;
    const int aoff = lds_byte(wr * 64 + fr, fq * 8), boff = lds_byte(wc * 32 + fr, fq * 8);
    unsigned gC[2][2], gN[2][2];
#define PG8_SA(b, h) (((b) * 2 + (h)) * HTB)
#define PG8_SB(b, h) ((4 + (b) * 2 + (h)) * HTB)
#define PG8_STAGE(bufoff, gbase, voff) do { _Pragma("unroll") for (int _i = 0; _i < 2; ++_i) \
        __builtin_amdgcn_global_load_lds((const unsigned*)((const char*)(gbase) + (voff)[_i]), (LAS unsigned*)(lds + (bufoff) + ldsw + _i * 8192), 16, 0, 0); } while (0)
#define PG8_STAGE_A(bufoff, kp, h) do { if constexpr (GATHER) { PG8_STAGE(bufoff, kp, gC[h]); } else { PG8_STAGE(bufoff, (kp) + (h) * hstep, voffA); } } while (0)
#define PG8_LD16(p) (*(const LAS bf16x8*)(p))
#define PG8_CAT(lo, hi) __builtin_bit_cast(v8i32, __builtin_shufflevector(lo, hi, 0, 1, 2, 3, 4, 5, 6, 7, 8, 9, 10, 11, 12, 13, 14, 15))
#define PG8_LDA(dst, b, h) do { _Pragma("unroll") for (int m = 0; m < 4; ++m) { if constexpr (F8) { dst##8[m] = PG8_CAT(PG8_LD16(lds + PG8_SA(b, h) + aoff + m * 2048), PG8_LD16(lds + PG8_SA(b, h) + aoff + m * 2048 + 1024)); } \
        else { _Pragma("unroll") for (int k = 0; k < 2; ++k) dst[m][k] = PG8_LD16(lds + PG8_SA(b, h) + aoff + m * 2048 + k * 1024); } } } while (0)
#define PG8_LDB(dst, b, h) do { _Pragma("unroll") for (int n = 0; n < 2; ++n) { if constexpr (F8) { dst##8[n] = PG8_CAT(PG8_LD16(lds + PG8_SB(b, h) + boff + n * 2048), PG8_LD16(lds + PG8_SB(b, h) + boff + n * 2048 + 1024)); } \
        else { _Pragma("unroll") for (int k = 0; k < 2; ++k) dst[n][k] = PG8_LD16(lds + PG8_SB(b, h) + boff + n * 2048 + k * 1024); } } } while (0)
#define PG8_MMA(ai, bj, At, Bt) do { __builtin_amdgcn_s_setprio(1); _Pragma("unroll") for (int m = 0; m < 4; ++m) _Pragma("unroll") for (int n = 0; n < 2; ++n) { \
        if constexpr (F8) { acc[ai][bj][m][n] = __builtin_amdgcn_mfma_scale_f32_16x16x128_f8f6f4(Bt##8[n], At##8[m], acc[ai][bj][m][n], 0, 0, 0, 0x7f7f7f7f, 0, 0x7f7f7f7f); } \
        else { _Pragma("unroll") for (int k = 0; k < 2; ++k) acc[ai][bj][m][n] = __builtin_amdgcn_mfma_f32_16x16x32_bf16(Bt[n][k], At[m][k], acc[ai][bj][m][n], 0, 0, 0); } } \
        __builtin_amdgcn_s_setprio(0); } while (0)
#define PG8_WAIT_V(n) asm volatile("s_waitcnt vmcnt(" #n ")" ::: "memory")
#define PG8_WAIT_L(n) asm volatile("s_waitcnt lgkmcnt(" #n ")" ::: "memory")
#define PG8_BAR __builtin_amdgcn_s_barrier()
#define PG8_SCHED __builtin_amdgcn_sched_barrier(0)
#define PG8_GOFF(dst, u) do { _Pragma("unroll") for (int _h = 0; _h < 2; ++_h) _Pragma("unroll") for (int _i = 0; _i < 2; ++_i) \
        dst[_h][_i] = (unsigned)(S.a_row(u, _h * HALF + RA[_i]) * RP + CA[_i] * 2); } while (0)
    Unit cur, nxt, nn; int ui = 0;
    if (!S.next(0, cur)) return;
    bool has_next = S.next(1, nxt);
    if constexpr (GATHER) { PG8_GOFF(gC, cur); if (has_next) { PG8_GOFF(gN, nxt); } else { PG8_GOFF(gN, cur); } }
    f32x4 acc[2][2][4][2];
#pragma unroll
    for (int a = 0; a < 2; ++a)
#pragma unroll
        for (int b = 0; b < 2; ++b)
#pragma unroll
            for (int m = 0; m < 4; ++m)
#pragma unroll
                for (int n = 0; n < 2; ++n) acc[a][b][m][n] = (f32x4){0.f, 0.f, 0.f, 0.f};
    bf16x8 At[4][2], B0[2][2], B1[2][2]; v8i32 At8[4], B08[2], B18[2];
    const char* cA = S.a_ptr(cur); const char* cB = S.b_ptr(cur);
    PG8_STAGE(PG8_SB(0, 0), cB, voffB); PG8_STAGE(PG8_SB(0, 1), cB + hstep, voffB); PG8_STAGE_A(PG8_SA(0, 0), cA, 0); PG8_STAGE_A(PG8_SA(0, 1), cA, 1);
    if (wr == 1) PG8_BAR;
    PG8_WAIT_V(2); PG8_BAR;
    PG8_STAGE(PG8_SB(1, 0), cB + kstep, voffB); PG8_STAGE_A(PG8_SA(1, 0), cA + kstep, 0); PG8_STAGE(PG8_SB(1, 1), cB + hstep + kstep, voffB);
    PG8_WAIT_V(6); PG8_BAR;
    for (;;) {
        const char* nA = has_next ? S.a_ptr(nxt) : cA; const char* nB = has_next ? S.b_ptr(nxt) : cB;
        S.meta(cur, lds + (LDS_META - 0) + (ui & 1) * 4096, wid, lane);
#define PG8_TRIP(WARM, t) do { \
            const bool last = ((t) == nt - 2); \
            const char* a1 = cA + (size_t)((t) + 1) * kstep; \
            const char* a2 = last ? nA : cA + (size_t)((t) + 2) * kstep; const char* b2 = last ? nB : cB + (size_t)((t) + 2) * kstep; \
            const char* a3 = a2 + kstep; const char* b3 = b2 + kstep; \
              \
            PG8_LDB(B0, 0, 0); PG8_LDB(B1, 0, 1); PG8_SCHED; PG8_LDA(At, 0, 0); if constexpr (!(WARM)) { PG8_STAGE_A(PG8_SA(1, 1), a1, 1); } \
            if constexpr (GATHER) { if (last) { _Pragma("unroll") for (int h = 0; h < 2; ++h) _Pragma("unroll") for (int i = 0; i < 2; ++i) gC[h][i] = gN[h][i]; } } \
            if constexpr (!(WARM)) { PG8_WAIT_V(8); } PG8_WAIT_L(0); PG8_BAR; PG8_MMA(0, 0, At, B0); PG8_MMA(0, 1, At, B1); PG8_BAR; PG8_SCHED; \
              \
            PG8_LDA(At, 0, 1); PG8_STAGE(PG8_SB(0, 0), b2, voffB); PG8_STAGE(PG8_SB(0, 1), b2 + hstep, voffB); PG8_STAGE_A(PG8_SA(0, 0), a2, 0); \
            if constexpr (!(WARM)) { PG8_WAIT_V(8); } PG8_WAIT_L(0); PG8_BAR; PG8_MMA(1, 0, At, B0); PG8_MMA(1, 1, At, B1); PG8_BAR; PG8_SCHED; \
              \
            PG8_LDB(B0, 1, 0); PG8_LDB(B1, 1, 1); PG8_SCHED; PG8_LDA(At, 1, 0); PG8_STAGE_A(PG8_SA(0, 1), a2, 1); \
            if constexpr (!(WARM)) { PG8_WAIT_V(8); } PG8_WAIT_L(0); PG8_BAR; PG8_MMA(0, 0, At, B0); PG8_MMA(0, 1, At, B1); PG8_BAR; PG8_SCHED; \
              \
            PG8_LDA(At, 1, 1); PG8_STAGE(PG8_SB(1, 0), b3, voffB); PG8_STAGE(PG8_SB(1, 1), b3 + hstep, voffB); PG8_STAGE_A(PG8_SA(1, 0), a3, 0); \
            PG8_WAIT_V(8); PG8_WAIT_L(0); PG8_BAR; PG8_MMA(1, 0, At, B0); PG8_MMA(1, 1, At, B1); PG8_BAR; PG8_SCHED; \
        } while (0)
        int t0_ = 0;
        if constexpr (WARMTRIP) { if (ui > 0) { PG8_TRIP(true, 0); t0_ = 2; } }
        for (int t = t0_; t < nt; t += 2) { PG8_TRIP(false, t); }
#undef PG8_TRIP
        if (wr == 0) PG8_BAR;
        if constexpr (WARMTRIP) { PG8_STAGE_A(PG8_SA(1, 1), nA + kstep, 1); }
        bool has_nn = false;
        if constexpr (GATHER) { if (has_next) { has_nn = S.next(ui + 2, nn); if (has_nn) { PG8_GOFF(gN, nn); } } }
        else { if (has_next) has_nn = S.next(ui + 2, nn); }
        { int fr_ = fr, fq_ = fq; asm volatile("" : "+v"(fr_), "+v"(fq_));
          const LAS unsigned char* mt = lds + LDS_META + (ui & 1) * 4096;
          if constexpr (WARMTRIP) {
              E.pre(acc, cur, wr, wc, fr_, fq_, mt);
              if constexpr (GATHER) asm volatile("" : "+v"(gN[0][0]), "+v"(gN[0][1]), "+v"(gN[1][0]), "+v"(gN[1][1]));
              PG8_WAIT_V(0);
              E.post(acc, cur, wr, wc, fr_, fq_, mt);
          } else { E.run(acc, cur, wr, wc, fr_, fq_, mt); } }
        if (!has_next) break;
#pragma unroll
        for (int a = 0; a < 2; ++a)
#pragma unroll
            for (int b = 0; b < 2; ++b)
#pragma unroll
                for (int m = 0; m < 4; ++m)
#pragma unroll
                    for (int n = 0; n < 2; ++n) acc[a][b][m][n] = (f32x4){0.f, 0.f, 0.f, 0.f};
        cur = nxt; cA = nA; cB = nB; ++ui; nxt = nn; has_next = has_nn;
        if (wr == 1) PG8_BAR;
    }
    PG8_WAIT_V(0);
    PG8_BAR;
#undef PG8_SA
#undef PG8_SB
#undef PG8_STAGE
#undef PG8_STAGE_A
#undef PG8_LDA
#undef PG8_LDB
#undef PG8_MMA
#undef PG8_LD16
#undef PG8_CAT
#undef PG8_WAIT_V
#undef PG8_WAIT_L
#undef PG8_BAR
#undef PG8_SCHED
#undef PG8_GOFF
}
}

using pg8::Unit; using pg8::cvt_pk_bf16;
constexpr int BM = 256, HALF = 128;

typedef f32x4 (&AccRef)[2][2][4][2];
__device__ __forceinline__ void pack8_bf16(f32x4& lo, const f32x4& hi) {
    const unsigned w0 = cvt_pk_bf16(lo[0], lo[1]), w1 = cvt_pk_bf16(lo[2], lo[3]), w2 = cvt_pk_bf16(hi[0], hi[1]), w3 = cvt_pk_bf16(hi[2], hi[3]);
    lo[0] = __builtin_bit_cast(float, w0); lo[1] = __builtin_bit_cast(float, w1); lo[2] = __builtin_bit_cast(float, w2); lo[3] = __builtin_bit_cast(float, w3);
}
#define AS_U4(v) __builtin_bit_cast(u32x4, v)

struct EpiInProj {
    static constexpr bool PERM = true;
    const float* rs1; const f32x2* rope; const float* glu_b;
    bf16_t *q, *k, *v, *qi, *ki, *hglu; float* wi;
    __device__ __forceinline__ void pre(AccRef acc, const Unit& u, int wr, int wc, int fr, int fq, const LAS unsigned char* mt) const {
        const int row0 = u.pm * BM + wr * 64 + fr;
        if (u.pn >= 4) {
            const int ch = 128 * (u.pn - 4) + 32 * wc + 8 * fq;
            f32x4 ba[2], bg[2];
#pragma unroll
            for (int n = 0; n < 2; ++n) { ba[n] = *(const f32x4*)(glu_b + ch + 4 * n); bg[n] = *(const f32x4*)(glu_b + 512 + ch + 4 * n); }
#pragma unroll
            for (int ai = 0; ai < 2; ++ai)
#pragma unroll
                for (int m = 0; m < 4; ++m) { const float rs = rs1[row0 + ai * HALF + m * 16];
#pragma unroll
                    for (int n = 0; n < 2; ++n)
#pragma unroll
                        for (int e = 0; e < 4; ++e) { const float a = acc[ai][0][m][n][e] * rs + ba[n][e], g = acc[ai][1][m][n][e] * rs + bg[n][e]; acc[ai][0][m][n][e] = a * sigmoidf_(g); }
                    pack8_bf16(acc[ai][0][m][0], acc[ai][0][m][1]); }
            return;
        }
        const bool do_rope = !(u.pn == 3 && wc >= 2), is_wi = (u.pn == 3 && wc == 3);
        const int d0 = 8 * fq;
#pragma unroll
        for (int ai = 0; ai < 2; ++ai)
#pragma unroll
            for (int m = 0; m < 4; ++m) { const int row = row0 + ai * HALF + m * 16; const float rs = rs1[row];
                if (do_rope) {
                    const f32x2* rp = rope + (size_t)(row & (SEQ - 1)) * 32 + d0;
#pragma unroll
                    for (int n = 0; n < 2; ++n)
#pragma unroll
                        for (int e = 0; e < 4; ++e) { const f32x2 cs = rp[4 * n + e]; const float x1 = acc[ai][0][m][n][e] * rs, x2 = acc[ai][1][m][n][e] * rs;
                            acc[ai][0][m][n][e] = x1 * cs.x - x2 * cs.y; acc[ai][1][m][n][e] = x2 * cs.x + x1 * cs.y; }
                } else {
#pragma unroll
                    for (int n = 0; n < 2; ++n) { acc[ai][0][m][n] = acc[ai][0][m][n] * rs; acc[ai][1][m][n] = acc[ai][1][m][n] * rs; }
                }
                if (!is_wi) { pack8_bf16(acc[ai][0][m][0], acc[ai][0][m][1]); pack8_bf16(acc[ai][1][m][0], acc[ai][1][m][1]); }
                if (m & 1) __builtin_amdgcn_sched_barrier(0); }
    }
    __device__ __forceinline__ void post(AccRef acc, const Unit& u, int wr, int wc, int fr, int fq, const LAS unsigned char* mt) const {
        const int row0 = u.pm * BM + wr * 64 + fr;
        if (u.pn >= 4) {
            const int ch = 128 * (u.pn - 4) + 32 * wc + 8 * fq;
#pragma unroll
            for (int ai = 0; ai < 2; ++ai)
#pragma unroll
                for (int m = 0; m < 4; ++m) *(u32x4*)(hglu + (size_t)(row0 + ai * HALF + m * 16) * 512 + ch) = AS_U4(acc[ai][0][m][0]);
            return;
        }
        bf16_t* dst; int ld, col; bool is_wi = false;
        if (u.pn < 2) { dst = q; ld = 512; col = (4 * u.pn + wc) * 64; }
        else if (u.pn == 2) { dst = qi; ld = 256; col = wc * 64; }
        else { ld = 64; col = 0; if (wc == 0) dst = k; else if (wc == 1) dst = ki; else if (wc == 2) dst = v; else { dst = v; is_wi = true; } }
        if (is_wi) {
            if (fq == 0) {
#pragma unroll
                for (int ai = 0; ai < 2; ++ai)
#pragma unroll
                    for (int m = 0; m < 4; ++m) *(f32x4*)(wi + (size_t)(row0 + ai * HALF + m * 16) * 4) = acc[ai][0][m][0];
            }
            return;
        }
#pragma unroll
        for (int ai = 0; ai < 2; ++ai)
#pragma unroll
            for (int m = 0; m < 4; ++m) { bf16_t* rp2 = dst + (size_t)(row0 + ai * HALF + m * 16) * ld + col + 8 * fq;
                *(u32x4*)(rp2) = AS_U4(acc[ai][0][m][0]); *(u32x4*)(rp2 + 32) = AS_U4(acc[ai][1][m][0]); }
    }
    __device__ __forceinline__ void run(const f32x4 (&acc)[2][2][4][2], const Unit& u, int wr, int wc, int fr, int fq, const LAS unsigned char* mt) const {
        const int row0 = u.pm * BM + wr * 64 + fr;
        if (u.pn >= 4) {
            const int ch = 128 * (u.pn - 4) + 32 * wc + 8 * fq;
            f32x4 ba[2], bg[2];
#pragma unroll
            for (int n = 0; n < 2; ++n) { ba[n] = *(const f32x4*)(glu_b + ch + 4 * n); bg[n] = *(const f32x4*)(glu_b + 512 + ch + 4 * n); }
#pragma unroll
            for (int ai = 0; ai < 2; ++ai)
#pragma unroll
                for (int m = 0; m < 4; ++m) { const int row = row0 + ai * HALF + m * 16; const float rs = rs1[row];
                    float o[8];
#pragma unroll
                    for (int n = 0; n < 2; ++n)
#pragma unroll
                        for (int e = 0; e < 4; ++e) { const float a = acc[ai][0][m][n][e] * rs + ba[n][e], g = acc[ai][1][m][n][e] * rs + bg[n][e]; o[4 * n + e] = a * sigmoidf_(g); }
                    u32x4 w; w.x = cvt_pk_bf16(o[0], o[1]); w.y = cvt_pk_bf16(o[2], o[3]); w.z = cvt_pk_bf16(o[4], o[5]); w.w = cvt_pk_bf16(o[6], o[7]);
                    *(u32x4*)(hglu + (size_t)row * 512 + ch) = w; }
            return;
        }
        bf16_t* dst; int ld, col; bool do_rope = true, is_wi = false;
        if (u.pn < 2) { dst = q; ld = 512; col = (4 * u.pn + wc) * 64; }
        else if (u.pn == 2) { dst = qi; ld = 256; col = wc * 64; }
        else { ld = 64; col = 0; if (wc == 0) dst = k; else if (wc == 1) dst = ki; else if (wc == 2) { dst = v; do_rope = false; } else { dst = v; is_wi = true; do_rope = false; } }
        if (is_wi) {
            if (fq == 0) {
#pragma unroll
                for (int ai = 0; ai < 2; ++ai)
#pragma unroll
                    for (int m = 0; m < 4; ++m) { const int row = row0 + ai * HALF + m * 16; const float rs = rs1[row];
                        *(f32x4*)(wi + (size_t)row * 4) = acc[ai][0][m][0] * rs; }
            }
            return;
        }
        const int d0 = 8 * fq;
#pragma unroll
        for (int ai = 0; ai < 2; ++ai)
#pragma unroll
            for (int m = 0; m < 4; ++m) { const int row = row0 + ai * HALF + m * 16; const float rs = rs1[row];
                float o1[8], o2[8];
                if (do_rope) {
                    const f32x2* rp = rope + (size_t)(row & (SEQ - 1)) * 32 + d0;
#pragma unroll
                    for (int n = 0; n < 2; ++n)
#pragma unroll
                        for (int e = 0; e < 4; ++e) { const f32x2 cs = rp[4 * n + e]; const float x1 = acc[ai][0][m][n][e] * rs, x2 = acc[ai][1][m][n][e] * rs;
                            o1[4 * n + e] = x1 * cs.x - x2 * cs.y; o2[4 * n + e] = x2 * cs.x + x1 * cs.y; }
                } else {
#pragma unroll
                    for (int n = 0; n < 2; ++n)
#pragma unroll
                        for (int e = 0; e < 4; ++e) { o1[4 * n + e] = acc[ai][0][m][n][e] * rs; o2[4 * n + e] = acc[ai][1][m][n][e] * rs; }
                }
                u32x4 w1, w2; w1.x = cvt_pk_bf16(o1[0], o1[1]); w1.y = cvt_pk_bf16(o1[2], o1[3]); w1.z = cvt_pk_bf16(o1[4], o1[5]); w1.w = cvt_pk_bf16(o1[6], o1[7]);
                w2.x = cvt_pk_bf16(o2[0], o2[1]); w2.y = cvt_pk_bf16(o2[2], o2[3]); w2.z = cvt_pk_bf16(o2[4], o2[5]); w2.w = cvt_pk_bf16(o2[6], o2[7]);
                bf16_t* rp2 = dst + (size_t)row * ld + col + d0;
                *(u32x4*)(rp2) = w1; *(u32x4*)(rp2 + 32) = w2; }
    }
};

struct EpiBf16Plain {
    static constexpr bool PERM = true;
    bf16_t* O; int ldc;
    __device__ __forceinline__ void pre(AccRef acc, const Unit&, int, int, int, int, const LAS unsigned char*) const {
#pragma unroll
        for (int ai = 0; ai < 2; ++ai)
#pragma unroll
            for (int bj = 0; bj < 2; ++bj)
#pragma unroll
                for (int m = 0; m < 4; ++m) pack8_bf16(acc[ai][bj][m][0], acc[ai][bj][m][1]);
    }
    __device__ __forceinline__ void post(AccRef acc, const Unit& u, int wr, int wc, int fr, int fq, const LAS unsigned char* mt) const {
        const int row0 = u.pm * BM + wr * 64 + fr, col0 = u.pn * BM + wc * 32 + 8 * fq;
#pragma unroll
        for (int ai = 0; ai < 2; ++ai)
#pragma unroll
            for (int m = 0; m < 4; ++m) { bf16_t* rowp = O + (size_t)(row0 + ai * HALF + m * 16) * ldc + col0;
#pragma unroll
                for (int bj = 0; bj < 2; ++bj) *(u32x4*)(rowp + bj * HALF) = AS_U4(acc[ai][bj][m][0]); }
    }
    __device__ __forceinline__ void run(const f32x4 (&acc)[2][2][4][2], const Unit& u, int wr, int wc, int fr, int fq, const LAS unsigned char* mt) const {
        const int row0 = u.pm * BM + wr * 64 + fr, col0 = u.pn * BM + wc * 32 + 8 * fq;
#pragma unroll
        for (int ai = 0; ai < 2; ++ai)
#pragma unroll
            for (int m = 0; m < 4; ++m) { bf16_t* rowp = O + (size_t)(row0 + ai * HALF + m * 16) * ldc + col0;
#pragma unroll
                for (int bj = 0; bj < 2; ++bj) { const f32x4 v0 = acc[ai][bj][m][0], v1 = acc[ai][bj][m][1];
                    u32x4 w; w.x = cvt_pk_bf16(v0[0], v0[1]); w.y = cvt_pk_bf16(v0[2], v0[3]); w.z = cvt_pk_bf16(v1[0], v1[1]); w.w = cvt_pk_bf16(v1[2], v1[3]);
                    *(u32x4*)(rowp + bj * HALF) = w; } }
    }
};

struct EpiOutProj {
    static constexpr bool PERM = false;
    const float* x; float* h1; unsigned char* h1f8;
    __device__ __forceinline__ void pre(AccRef acc, const Unit& u, int wr, int wc, int fr, int fq, const LAS unsigned char* mt) const {
        const int row0 = u.pm * BM + wr * 64 + fr, col0 = u.pn * BM + wc * 32 + 4 * fq;
#pragma unroll
        for (int ai = 0; ai < 2; ++ai)
#pragma unroll
            for (int m = 0; m < 4; ++m) { const size_t off = (size_t)(row0 + ai * HALF + m * 16) * DM + col0;
#pragma unroll
                for (int bj = 0; bj < 2; ++bj)
#pragma unroll
                    for (int n = 0; n < 2; ++n) acc[ai][bj][m][n] += *(const f32x4*)(x + off + bj * HALF + n * 16);
                if (m & 1) __builtin_amdgcn_sched_barrier(0); }
    }
    __device__ __forceinline__ void post(AccRef acc, const Unit& u, int wr, int wc, int fr, int fq, const LAS unsigned char* mt) const {
        const int row0 = u.pm * BM + wr * 64 + fr, col0 = u.pn * BM + wc * 32 + 4 * fq;
#pragma unroll
        for (int ai = 0; ai < 2; ++ai)
#pragma unroll
            for (int m = 0; m < 4; ++m) { const size_t off = (size_t)(row0 + ai * HALF + m * 16) * DM + col0;
#pragma unroll
                for (int bj = 0; bj < 2; ++bj)
#pragma unroll
                    for (int n = 0; n < 2; ++n) { const size_t o = off + bj * HALF + n * 16; const f32x4 r = acc[ai][bj][m][n];
                        *(f32x4*)(h1 + o) = r; *(unsigned*)(h1f8 + o) = pk4_fp8(r[0], r[1], r[2], r[3]); } }
    }
    __device__ __forceinline__ void run(AccRef acc, const Unit& u, int wr, int wc, int fr, int fq, const LAS unsigned char* mt) const { pre(acc, u, wr, wc, fr, fq, mt); post(acc, u, wr, wc, fr, fq, mt); }
};

struct EpiUp {
    static constexpr bool PERM = true;
    unsigned char* act;
    __device__ __forceinline__ void pre(AccRef acc, const Unit& u, int wr, int wc, int fr, int fq, const LAS unsigned char* mt) const {
        const int r0 = wr * 64 + fr, cl = 32 * wc + 8 * fq;
        const LAS float* rowA = (const LAS float*)mt; const LAS float* bias = (const LAS float*)(mt + 2048);
        f32x4 bg[2], bl[2];
#pragma unroll
        for (int n = 0; n < 2; ++n) { bg[n] = *(const LAS f32x4*)(bias + cl + 4 * n); bl[n] = *(const LAS f32x4*)(bias + 128 + cl + 4 * n); }
#pragma unroll
        for (int ai = 0; ai < 2; ++ai)
#pragma unroll
            for (int m = 0; m < 4; ++m) { const int r = r0 + ai * HALF + m * 16;
                const float rs = (r < u.rows) ? rowA[r] * 0.03125f : 0.f;
                float o[8];
#pragma unroll
                for (int n = 0; n < 2; ++n)
#pragma unroll
                    for (int e = 0; e < 4; ++e) { float g = acc[ai][0][m][n][e] * rs + bg[n][e], l = acc[ai][1][m][n][e] * rs + bl[n][e];
                        g = fminf(g, 7.0f); l = fminf(fmaxf(l, -7.0f), 7.0f); o[4 * n + e] = g * sigmoidf_(1.702f * g) * (l + 1.0f); }
                acc[ai][0][m][0][0] = __builtin_bit_cast(float, pk4_fp8(o[0], o[1], o[2], o[3])); acc[ai][0][m][0][1] = __builtin_bit_cast(float, pk4_fp8(o[4], o[5], o[6], o[7])); }
    }
    __device__ __forceinline__ void post(AccRef acc, const Unit& u, int wr, int wc, int fr, int fq, const LAS unsigned char* mt) const {
        const int r0 = wr * 64 + fr, ch = 128 * u.pn + 32 * wc + 8 * fq;
#pragma unroll
        for (int ai = 0; ai < 2; ++ai)
#pragma unroll
            for (int m = 0; m < 4; ++m) { const int r = r0 + ai * HALF + m * 16;
                u32x2 w; w.x = __builtin_bit_cast(unsigned, acc[ai][0][m][0][0]); w.y = __builtin_bit_cast(unsigned, acc[ai][0][m][0][1]);
                *(u32x2*)(act + (size_t)(u.pm * BM + r) * 1024 + ch) = w; }
    }
    __device__ __forceinline__ void run(const f32x4 (&acc)[2][2][4][2], const Unit& u, int wr, int wc, int fr, int fq, const LAS unsigned char* mt) const {
        const int r0 = wr * 64 + fr, cl = 32 * wc + 8 * fq, ch = 128 * u.pn + cl;
        const LAS float* rowA = (const LAS float*)mt; const LAS float* bias = (const LAS float*)(mt + 2048);
        f32x4 bg[2], bl[2];
#pragma unroll
        for (int n = 0; n < 2; ++n) { bg[n] = *(const LAS f32x4*)(bias + cl + 4 * n); bl[n] = *(const LAS f32x4*)(bias + 128 + cl + 4 * n); }
#pragma unroll
        for (int ai = 0; ai < 2; ++ai)
#pragma unroll
            for (int m = 0; m < 4; ++m) { const int r = r0 + ai * HALF + m * 16;
                const float rs = (r < u.rows) ? rowA[r] * 0.03125f : 0.f;
                float o[8];
#pragma unroll
                for (int n = 0; n < 2; ++n)
#pragma unroll
                    for (int e = 0; e < 4; ++e) { float g = acc[ai][0][m][n][e] * rs + bg[n][e], l = acc[ai][1][m][n][e] * rs + bl[n][e];
                        g = fminf(g, 7.0f); l = fminf(fmaxf(l, -7.0f), 7.0f); o[4 * n + e] = g * sigmoidf_(1.702f * g) * (l + 1.0f); }
                u32x2 w; w.x = pk4_fp8(o[0], o[1], o[2], o[3]); w.y = pk4_fp8(o[4], o[5], o[6], o[7]);
                *(u32x2*)(act + (size_t)(u.pm * BM + r) * 1024 + ch) = w; }
    }
};

struct EpiDown {
    static constexpr bool PERM = true;
    bf16_t* y;
    __device__ __forceinline__ void pre(AccRef acc, const Unit& u, int wr, int wc, int fr, int fq, const LAS unsigned char* mt) const {
        const int r0 = wr * 64 + fr, cl = wc * 32 + 8 * fq;
        const LAS float* gateT = (const LAS float*)(mt + 1024); const LAS float* bias = (const LAS float*)(mt + 2048);
        float gt[2][4];
#pragma unroll
        for (int ai = 0; ai < 2; ++ai)
#pragma unroll
            for (int m = 0; m < 4; ++m) gt[ai][m] = gateT[r0 + ai * HALF + m * 16];
#pragma unroll
        for (int bj = 0; bj < 2; ++bj) { const f32x4 bv0 = *(const LAS f32x4*)(bias + cl + bj * HALF), bv1 = *(const LAS f32x4*)(bias + cl + bj * HALF + 4);
#pragma unroll
            for (int ai = 0; ai < 2; ++ai)
#pragma unroll
                for (int m = 0; m < 4; ++m) { acc[ai][bj][m][0] = (acc[ai][bj][m][0] * 0.03125f + bv0) * gt[ai][m]; acc[ai][bj][m][1] = (acc[ai][bj][m][1] * 0.03125f + bv1) * gt[ai][m];
                    pack8_bf16(acc[ai][bj][m][0], acc[ai][bj][m][1]); } }
    }
    __device__ __forceinline__ void post(AccRef acc, const Unit& u, int wr, int wc, int fr, int fq, const LAS unsigned char* mt) const {
        const int r0 = wr * 64 + fr, col0 = u.pn * BM + wc * 32 + 8 * fq;
        const LAS int* slotT = (const LAS int*)mt;
#pragma unroll
        for (int ai = 0; ai < 2; ++ai)
#pragma unroll
            for (int m = 0; m < 4; ++m) { const int r = r0 + ai * HALF + m * 16;
                if (r < u.rows) { bf16_t* rowp = y + (size_t)slotT[r] * 1024 + col0;
#pragma unroll
                    for (int bj = 0; bj < 2; ++bj) *(u32x4*)(rowp + bj * HALF) = AS_U4(acc[ai][bj][m][0]); } }
    }
    __device__ __forceinline__ void run(AccRef acc, const Unit& u, int wr, int wc, int fr, int fq, const LAS unsigned char* mt) const { pre(acc, u, wr, wc, fr, fq, mt); post(acc, u, wr, wc, fr, fq, mt); }
};

template <bool F8>
__device__ __forceinline__ void p0_transpose_item(const float* W, int ldw, void* WTv, int Kdim, const float* gain, LAS float* scr, int kb, int n0, int src0, int nvalid, int lane) {
    bf16_t* WT = (bf16_t*)WTv;
    const int k0 = 64 * kb;
    f32x4 ld4[8];
#pragma unroll
    for (int i = 0; i < 8; ++i) { const int kk = 8 * i + (lane >> 3), j = (lane & 7) * 4;
        ld4[i] = (f32x4){0.f, 0.f, 0.f, 0.f}; if (j < nvalid) ld4[i] = *(const f32x4*)(W + (size_t)(k0 + kk) * ldw + src0 + j); }
#pragma unroll
    for (int i = 0; i < 8; ++i) { const int kk = 8 * i + (lane >> 3), j = (lane & 7) * 4; const float gk = (gain ? gain[k0 + kk] : 1.0f) * (F8 ? 32.0f : 1.0f);
        LAS float* d = scr + kk * 33 + j; d[0] = ld4[i].x * gk; d[1] = ld4[i].y * gk; d[2] = ld4[i].z * gk; d[3] = ld4[i].w * gk; }
    LDS_WAIT(); asm volatile("" ::: "memory");
    const int c = lane & 7;
#pragma unroll
    for (int j = 0; j < 4; ++j) { const int n = (lane >> 3) + 8 * j; const LAS float* s = scr + (8 * c) * 33 + n;
        if constexpr (F8) { u32x2 o; o.x = pk4_fp8(s[0 * 33], s[1 * 33], s[2 * 33], s[3 * 33]); o.y = pk4_fp8(s[4 * 33], s[5 * 33], s[6 * 33], s[7 * 33]);
            *(u32x2*)((unsigned char*)WTv + (size_t)(n0 + n) * Kdim + k0 + 8 * c) = o; }
        else { u32x4 o; o.x = pk2(s[0 * 33], s[1 * 33]); o.y = pk2(s[2 * 33], s[3 * 33]); o.z = pk2(s[4 * 33], s[5 * 33]); o.w = pk2(s[6 * 33], s[7 * 33]);
            *(u32x4*)(WT + (size_t)(n0 + n) * Kdim + k0 + 8 * c) = o; } }
    LDS_WAIT(); asm volatile("" ::: "memory");
}
__device__ __forceinline__ void win_colmap(int nb, int& src0, int& nvalid) {
    const int pn = nb >> 3, j = (nb & 7) * 32, bj = j >> 7, slot = (j & 127) >> 5;
    nvalid = 32;
    if (pn < 2) src0 = (4 * pn + slot) * 64 + 32 * bj;
    else if (pn == 2) src0 = 640 + slot * 64 + 32 * bj;
    else if (pn == 3) { if (slot == 0) src0 = 512 + 32 * bj; else if (slot == 1) src0 = 896 + 32 * bj; else if (slot == 2) src0 = 576 + 32 * bj; else { src0 = 960; nvalid = bj == 0 ? 4 : 0; } }
    else src0 = 964 + 512 * bj + 128 * (pn - 4) + 32 * slot;
}
__device__ __forceinline__ void p0_prologue(const Params& P, LAS unsigned char* lds, int vcu, int G, int wave, int lane) {
    unsigned char* ws = P.ws;
    LAS float* scr = (LAS float*)(lds + wave * 16384);
    const int gw = vcu * NWAVES + wave, NGW = G * NWAVES;
    constexpr int I_IN = 16 * 64, I_OUT = 16 * 32, I_G = 16 * 32, I_P = 4 * 32, I_UP = 32 * 16 * 64, I_DN = 32 * 16 * 32;
    constexpr int NITEMS = I_IN + I_OUT + I_G + I_P + I_UP + I_DN;
    for (int it = gw; it < NITEMS; it += NGW) {
        int r = it;
        if (r < I_IN) { const int kb = r / 64, nb = r % 64; int s0, nv; win_colmap(nb, s0, nv); p0_transpose_item<false>(P.w_in, INW, (bf16_t*)(ws + WS_WIN), 1024, P.g_mix, scr, kb, nb * 32, s0, nv, lane); continue; } r -= I_IN;
        if (r < I_OUT) { const int kb = r / 32, nb = r % 32; p0_transpose_item<false>(P.w_out, 1024, (bf16_t*)(ws + WS_WOUT), 1024, nullptr, scr, kb, nb * 32, nb * 32, 32, lane); continue; } r -= I_OUT;
        if (r < I_G) { const int kb = r / 32, nb = r % 32; p0_transpose_item<false>(P.w_ple_gate, 1024, (bf16_t*)(ws + WS_WG), 1024, P.g_ple, scr, kb, nb * 32, nb * 32, 32, lane); continue; } r -= I_G;
        if (r < I_P) { const int kb = r / 32, nb = r % 32; p0_transpose_item<false>(P.w_ple_proj, 1024, (bf16_t*)(ws + WS_WP), 256, nullptr, scr, kb, nb * 32, nb * 32, 32, lane); continue; } r -= I_P;
        if (r < I_UP) { const int e = r / 1024, rr = r % 1024, kb = rr / 64, nb = rr % 64;
            const int pn = nb >> 3, j = (nb & 7) * 32, bj = j >> 7, jj = j & 127;
            p0_transpose_item<true>(P.w_up + (size_t)e * 1024 * 2048, 2048, (unsigned char*)(ws + WS_WUP) + (size_t)e * 2048 * 1024, 1024, P.g_ffn, scr, kb, nb * 32, 1024 * bj + 128 * pn + jj, 32, lane); continue; } r -= I_UP;
        { const int e = r / 512, rr = r % 512, kb = rr / 32, nb = rr % 32;
            p0_transpose_item<true>(P.w_down + (size_t)e * 1024 * 1024, 1024, (unsigned char*)(ws + WS_WDOWN) + (size_t)e * 1024 * 1024, 1024, nullptr, scr, kb, nb * 32, nb * 32, 32, lane); }
    }
    float* rs1 = (float*)(ws + WS_RS1); bf16_t* xb = (bf16_t*)(ws + WS_XB);
    for (int m = gw; m < NTOK; m += NGW) {
        const f32x4* xr = (const f32x4*)(P.x + (size_t)m * DM) + lane; f32x4 v[4]; float s = 0.f;
#pragma unroll
        for (int j = 0; j < 4; ++j) { v[j] = xr[64 * j]; s += (v[j].x * v[j].x + v[j].y * v[j].y) + (v[j].z * v[j].z + v[j].w * v[j].w); }
        s = wave_sum(s);
        u32x2* o8 = (u32x2*)(xb + (size_t)m * DM) + lane;
#pragma unroll
        for (int j = 0; j < 4; ++j) { u32x2 w; w.x = pk2(v[j].x, v[j].y); w.y = pk2(v[j].z, v[j].w); o8[64 * j] = w; }
        if (lane == 0) rs1[m] = 1.0f / sqrtf(s * (1.0f / DM) + EPS);
    }
    bf16_t* pb = (bf16_t*)(ws + WS_PB);
    for (int m = gw; m < NTOK; m += NGW) { const f32x4 v = *((const f32x4*)(P.p + (size_t)m * 256) + lane); u32x2 w; w.x = pk2(v.x, v.y); w.y = pk2(v.z, v.w); *((u32x2*)(pb + (size_t)m * 256) + lane) = w; }
    f32x2* rope = (f32x2*)(ws + WS_ROPE);
    for (int idx = gw * 64 + lane; idx < SEQ * 32; idx += NGW * 64) { const int t = idx >> 5, i = idx & 31;
        const float inv = exp2f(-(float)i * (13.287712379549449f / 32.0f));
        const float ang = (float)t * inv;
        const double rev = (double)ang * 0.15915494309189535; const float fr = (float)(rev - __builtin_floor(rev));
        rope[idx] = (f32x2){__builtin_amdgcn_cosf(fr), __builtin_amdgcn_sinf(fr)}; }
    float* wrg = (float*)(ws + WS_WRG);
    for (int idx = gw * 64 + lane; idx < 1024 * 32; idx += NGW * 64) wrg[idx] = P.w_router[idx] * P.g_ffn[idx >> 5];
}

__device__ __forceinline__ unsigned fkey(float f) { unsigned u = __builtin_bit_cast(unsigned, f); if (u == 0x80000000u) u = 0u; return u ^ ((unsigned)((int)u >> 31) | 0x80000000u); }
__device__ __forceinline__ int mbcnt64(unsigned long long m) { return __builtin_amdgcn_mbcnt_hi((unsigned)(m >> 32), __builtin_amdgcn_mbcnt_lo((unsigned)m, 0u)); }

template <int NR>
__device__ __forceinline__ unsigned bisect_thr(const unsigned (&v)[NR], unsigned prefix, int startbit) {
    bool exact = false;
#pragma unroll 1
    for (int bit = startbit; bit >= 0; --bit) {
        const unsigned cand = prefix | (1u << bit); int cnt = 0;
#pragma unroll
        for (int r = 0; r < NR; ++r) { cnt += __builtin_popcountll(__ballot(v[r] >= cand)); if ((r & 7) == 7) __builtin_amdgcn_sched_barrier(0); }
        if (cnt >= NSEL) prefix = cand;
        if (cnt == NSEL) { exact = true; break; }
    }
    return exact ? prefix - 1u : prefix;
}
template <int NR, bool EXPL>
__device__ __forceinline__ void compact_sel(const unsigned (&v)[NR], const unsigned (&ci)[NR], unsigned T, LAS unsigned* list, int lane) {
    int cgt = 0;
#pragma unroll
    for (int r = 0; r < NR; ++r) { cgt += __builtin_popcountll(__ballot(v[r] > T)); if ((r & 7) == 7) __builtin_amdgcn_sched_barrier(0); }
    const int need = NSEL - cgt; int base = 0, ties = 0;
#pragma unroll
    for (int r = 0; r < NR; ++r) { const bool gt = v[r] > T, eq = v[r] == T; const unsigned long long em = __ballot(eq);
        const bool sel = gt || (eq && (ties + mbcnt64(em)) < need); const unsigned long long sm = __ballot(sel);
        list[sel ? base + mbcnt64(sm) : NSEL + lane] = EXPL ? ci[r] : (unsigned)(r * 64 + lane);
        base += __builtin_popcountll(sm); ties += __builtin_popcountll(em);
        if ((r & 3) == 3) __builtin_amdgcn_sched_barrier(0); }
}
constexpr int SEL_CAP = 1024;
template <int NR>
__device__ __forceinline__ void select_topk(LAS float* row, LAS unsigned* H, LAS unsigned* list, int lane, bool zero_h) {
    unsigned v[NR];
#pragma unroll
    for (int r = 0; r < NR; ++r) v[r] = fkey(row[r * 64 + lane]);
    LAS u32x4* H4 = (LAS u32x4*)H;
    const u32x4 h0 = H4[2 * lane], h1 = H4[2 * lane + 1];
    if (zero_h) { H4[2 * lane] = (u32x4){0u, 0u, 0u, 0u}; H4[2 * lane + 1] = (u32x4){0u, 0u, 0u, 0u}; }
    const unsigned hw[8] = {h0.x, h0.y, h0.z, h0.w, h1.x, h1.y, h1.z, h1.w};
    unsigned c[16];
#pragma unroll
    for (int i = 0; i < 8; ++i) { c[2 * i] = hw[i] & 0xffffu; c[2 * i + 1] = hw[i] >> 16; }
    unsigned s = 0u;
#pragma unroll
    for (int i = 0; i < 16; ++i) s += c[i];
    unsigned S = s;
#pragma unroll
    for (int off = 1; off < 64; off <<= 1) { const unsigned o = __shfl_down(S, off); if (lane + off < 64) S += o; }
    const unsigned long long okm = __ballot(S >= (unsigned)NSEL);
    bool fast = okm != 0ull; unsigned floorkey = 0u; int C = 0;
    if (fast) {
        const int Ls = 63 - __builtin_clzll(okm);
        unsigned acc = S - s; int bl = -1; unsigned accb = 0u;
#pragma unroll
        for (int b = 15; b >= 0; --b) { acc += c[b]; if (bl < 0 && acc >= (unsigned)NSEL) { bl = b; accb = acc; } }
        const int bstar = __shfl(bl, Ls) + 16 * Ls; C = (int)__shfl(accb, Ls);
        floorkey = (unsigned)bstar << 22;
        fast = (bstar > 1) && (C <= SEL_CAP);
    }
    if (!fast) {
        const unsigned T = bisect_thr<NR>(v, 0u, 31);
        compact_sel<NR, false>(v, v, T, list, lane);
        return;
    }
    LAS unsigned* ckl = (LAS unsigned*)row; LAS unsigned* cil = ckl + 1152;
    { int base = 0;
#pragma unroll
      for (int r = 0; r < NR; ++r) { const bool cnd = v[r] >= floorkey; const unsigned long long m = __ballot(cnd);
          const int pos = cnd ? base + mbcnt64(m) : SEL_CAP + lane;
          ckl[pos] = v[r]; cil[pos] = (unsigned)(r * 64 + lane); base += __builtin_popcountll(m);
          if ((r & 3) == 3) __builtin_amdgcn_sched_barrier(0); } }
    if (C <= 512) {
        unsigned ck[8], ci[8];
#pragma unroll
        for (int j = 0; j < 8; ++j) { const int i = j * 64 + lane; ck[j] = i < C ? ckl[i] : 0u; ci[j] = cil[i]; }
        const unsigned T = (C == NSEL) ? floorkey - 1u : bisect_thr<8>(ck, floorkey, 21);
        compact_sel<8, true>(ck, ci, T, list, lane);
    } else {
        unsigned ck[16], ci[16];
#pragma unroll
        for (int j = 0; j < 16; ++j) { const int i = j * 64 + lane; ck[j] = i < C ? ckl[i] : 0u; ci[j] = cil[i]; }
        const unsigned T = bisect_thr<16>(ck, floorkey, 21);
        compact_sel<16, true>(ck, ci, T, list, lane);
    }
}

typedef short v4i16 __attribute__((ext_vector_type(4)));
constexpr int VROW = 144;

__device__ __forceinline__ void attn_tile(const Params& P, LAS unsigned char* lds, int b, int t0, int wave, int lane) {
    unsigned char* ws = P.ws;
    const bf16_t* QI = (const bf16_t*)(ws + WS_QI); const bf16_t* KI = (const bf16_t*)(ws + WS_KI);
    const bf16_t* Q = (const bf16_t*)(ws + WS_Q); const bf16_t* Kp = (const bf16_t*)(ws + WS_K); const bf16_t* Vp = (const bf16_t*)(ws + WS_V);
    const float* WI = (const float*)(ws + WS_WI); bf16_t* MIX = (bf16_t*)(ws + WS_MIX);
    LAS float* SC = (LAS float*)lds;
    LAS unsigned* list = (LAS unsigned*)(lds + wave * 16384 + 14336);
    LAS unsigned* HIST = (LAS unsigned*)(lds + LDS_MISC);
    const int tokbase = b * SEQ;
    const bool need_sel = t0 >= 256;
    if (need_sel) {
        const int nkt = (t0 + 8 + 31) >> 5;
        bf16x8 a[4]; f32x4 w[4];
        { const bf16_t* src = QI + (size_t)(tokbase + t0 + ((lane & 31) >> 2)) * 256 + (lane & 3) * 64 + 8 * (lane >> 5);
#pragma unroll
          for (int ks = 0; ks < 4; ++ks) a[ks] = *(const bf16x8*)(src + 16 * ks); }
#pragma unroll
        for (int g = 0; g < 4; ++g) w[g] = *(const f32x4*)(WI + (size_t)(tokbase + t0 + 2 * g + (lane >> 5)) * 4);
        for (int kt0 = wave; kt0 < nkt; kt0 += 4 * NWAVES) {
            bf16x8 bf[4][4];
#pragma unroll
            for (int u = 0; u < 4; ++u) { const int kt = kt0 + u * NWAVES;
                if (kt < nkt) { const bf16_t* ksrc = KI + (size_t)(tokbase + kt * 32 + (lane & 31)) * 64 + 8 * (lane >> 5);
#pragma unroll
                    for (int ks = 0; ks < 4; ++ks) bf[u][ks] = *(const bf16x8*)(ksrc + 16 * ks); } }
#pragma unroll
            for (int u = 0; u < 4; ++u) { const int kt = kt0 + u * NWAVES;
                if (kt < nkt) {
                    const int key = kt * 32 + (lane & 31);
                    f32x16 acc;
#pragma unroll
                    for (int i = 0; i < 16; ++i) acc[i] = 0.f;
#pragma unroll
                    for (int ks = 0; ks < 4; ++ks) acc = __builtin_amdgcn_mfma_f32_32x32x16_bf16(a[ks], bf[u][ks], acc, 0, 0, 0);
#pragma unroll
                    for (int g = 0; g < 4; ++g) { float sc = 0.f;
#pragma unroll
                        for (int h = 0; h < 4; ++h) sc = fmaf(fmaxf(acc[4 * g + h], 0.f), w[g][h], sc);
                        const int ql = 2 * g + (lane >> 5);
                        if (key > t0 + ql) sc = -INFINITY;
                        SC[ql * 4096 + key] = sc;
                        if (key <= t0 + ql) { const unsigned ub = __builtin_bit_cast(unsigned, sc);
                            const unsigned bin = (ub >> 22) ^ (((unsigned)((int)ub >> 31) & 0x1ffu) | 0x200u);
                            __hip_atomic_fetch_add(HIST + ql * 512 + (bin >> 1), 1u << ((bin & 1u) << 4), __ATOMIC_RELAXED, __HIP_MEMORY_SCOPE_WORKGROUP); } }
                } }
        }
        { const int npad = ((t0 + 8 + 1023) >> 10) << 10;
          for (int i = nkt * 32 + (int)threadIdx.x; i < npad; i += NTHR) {
#pragma unroll
              for (int q = 0; q < 8; ++q) SC[q * 4096 + i] = -INFINITY; } }
    }
    __syncthreads();
    const int t = t0 + wave, tok = tokbase + t;
    if (need_sel) {
        LAS float* row = SC + wave * 4096; LAS unsigned* H = HIST + wave * 512; const int n = t + 1;
        if (n <= 1024) select_topk<16>(row, H, list, lane, true);
        else if (n <= 2048) select_topk<32>(row, H, list, lane, true);
        else if (n <= 3072) select_topk<48>(row, H, list, lane, true);
        else select_topk<64>(row, H, list, lane, true);
    } else {
#pragma unroll
        for (int i = 0; i < 4; ++i) list[i * 64 + lane] = (unsigned)(i * 64 + lane);
    }
    const int nvalid = need_sel ? NSEL : (t + 1);
    const int ngrp = (nvalid + 31) >> 5;
    const int hd = lane & 15, g = lane >> 4;
    bf16x8 qf0, qf1;
#pragma unroll
    for (int i = 0; i < 8; ++i) { qf0[i] = 0; qf1[i] = 0; }
    if (hd < 8) { const bf16_t* qs = Q + (size_t)tok * 512 + hd * 64 + 8 * g; qf0 = *(const bf16x8*)qs; qf1 = *(const bf16x8*)(qs + 32); }
    float m = -INFINITY, ssum = 0.f;
    f32x4 o[4];
#pragma unroll
    for (int dt = 0; dt < 4; ++dt) o[dt] = (f32x4){0.f, 0.f, 0.f, 0.f};
    LAS unsigned char* vreg = lds + wave * 16384;
    bf16x8 kfA[4], kfB[4]; u32x4 vvA[4], vvB[4];
#define ATT_LOAD(KF, VV, G_) do { const int nb_ = (G_) * 32; const unsigned ia_ = list[nb_ + hd], ib_ = list[nb_ + 16 + hd]; \
        const bf16_t* ka_ = Kp + (size_t)(tokbase + ia_) * 64 + 8 * g; const bf16_t* kb_ = Kp + (size_t)(tokbase + ib_) * 64 + 8 * g; \
        KF[0] = *(const bf16x8*)ka_; KF[1] = *(const bf16x8*)(ka_ + 32); KF[2] = *(const bf16x8*)kb_; KF[3] = *(const bf16x8*)(kb_ + 32); \
        _Pragma("unroll") for (int i_ = 0; i_ < 4; ++i_) { const unsigned idx_ = list[nb_ + (lane >> 3) + 8 * i_]; VV[i_] = *(const u32x4*)(Vp + (size_t)(tokbase + idx_) * 64 + 8 * (lane & 7)); } } while (0)
#define ATT_GROUP(KF, VV, G_, VBUF) do { \
        LAS unsigned char* vbuf_ = (VBUF); \
        f32x4 sa_ = {0.f, 0.f, 0.f, 0.f}, sb_ = {0.f, 0.f, 0.f, 0.f}; \
        sa_ = __builtin_amdgcn_mfma_f32_16x16x32_bf16(KF[0], qf0, sa_, 0, 0, 0); sa_ = __builtin_amdgcn_mfma_f32_16x16x32_bf16(KF[1], qf1, sa_, 0, 0, 0); \
        sb_ = __builtin_amdgcn_mfma_f32_16x16x32_bf16(KF[2], qf0, sb_, 0, 0, 0); sb_ = __builtin_amdgcn_mfma_f32_16x16x32_bf16(KF[3], qf1, sb_, 0, 0, 0); \
        _Pragma("unroll") for (int i_ = 0; i_ < 4; ++i_) *(LAS u32x4*)(vbuf_ + ((lane >> 3) + 8 * i_) * VROW + (lane & 7) * 16) = VV[i_]; \
        if ((G_) + 2 < ngrp) ATT_LOAD(KF, VV, (G_) + 2); \
        float l_[8]; float mloc_ = -INFINITY; \
        _Pragma("unroll") for (int r_ = 0; r_ < 4; ++r_) { const int sl_ = (G_) * 32 + 4 * g + r_; \
            l_[r_] = sl_ < nvalid ? sa_[r_] * 0.125f : -INFINITY; l_[4 + r_] = (sl_ + 16) < nvalid ? sb_[r_] * 0.125f : -INFINITY; \
            mloc_ = fmaxf(mloc_, fmaxf(l_[r_], l_[4 + r_])); } \
        mloc_ = fmaxf(mloc_, __shfl_xor(mloc_, 16)); mloc_ = fmaxf(mloc_, __shfl_xor(mloc_, 32)); \
        const float mnew_ = fmaxf(m, mloc_), alpha_ = __expf(m - mnew_); m = mnew_; \
        float ps_ = 0.f; \
        _Pragma("unroll") for (int r_ = 0; r_ < 8; ++r_) { l_[r_] = __expf(l_[r_] - mnew_); ps_ += l_[r_]; } \
        ssum = ssum * alpha_ + ps_; \
        bf16x8 pf_; \
        { const u32x4 pw_ = {cvt_pk_bf16(l_[0], l_[1]), cvt_pk_bf16(l_[2], l_[3]), cvt_pk_bf16(l_[4], l_[5]), cvt_pk_bf16(l_[6], l_[7])}; pf_ = __builtin_bit_cast(bf16x8, pw_); } \
        LAS unsigned char* ta_ = vbuf_ + (4 * g + (hd >> 2)) * VROW + (hd & 3) * 8; \
        _Pragma("unroll") for (int dt_ = 0; dt_ < 4; ++dt_) { \
            const v4i16 lo_ = __builtin_amdgcn_ds_read_tr16_b64_v4i16((LAS v4i16*)(ta_ + dt_ * 32)); \
            const v4i16 hi_ = __builtin_amdgcn_ds_read_tr16_b64_v4i16((LAS v4i16*)(ta_ + 16 * VROW + dt_ * 32)); \
            bf16x8 vf_; vf_[0] = lo_[0]; vf_[1] = lo_[1]; vf_[2] = lo_[2]; vf_[3] = lo_[3]; vf_[4] = hi_[0]; vf_[5] = hi_[1]; vf_[6] = hi_[2]; vf_[7] = hi_[3]; \
            o[dt_] = __builtin_amdgcn_mfma_f32_16x16x32_bf16(vf_, pf_, o[dt_] * alpha_, 0, 0, 0); } } while (0)
    ATT_LOAD(kfA, vvA, 0);
    if (ngrp > 1) ATT_LOAD(kfB, vvB, 1);
#pragma unroll 1
    for (int grp = 0; grp < ngrp; grp += 2) {
        ATT_GROUP(kfA, vvA, grp, vreg);
        if (grp + 1 < ngrp) ATT_GROUP(kfB, vvB, grp + 1, vreg + 8192);
    }
#undef ATT_LOAD
#undef ATT_GROUP
    ssum += __shfl_xor(ssum, 16); ssum += __shfl_xor(ssum, 32);
    const float inv = 1.0f / ssum;
    if (hd < 8) {
        bf16_t* op = MIX + (size_t)tok * 1024 + hd * 64 + 4 * g;
#pragma unroll
        for (int dt = 0; dt < 4; ++dt) { u32x2 w; w.x = cvt_pk_bf16(o[dt][0] * inv, o[dt][1] * inv); w.y = cvt_pk_bf16(o[dt][2] * inv, o[dt][3] * inv); *(u32x2*)(op + 16 * dt) = w; }
    }
    __syncthreads();
}

__device__ __forceinline__ void conv_tile(const Params& P, LAS unsigned char* lds, int tile, int tid, int wave, int lane) {
    unsigned char* ws = P.ws;
    const bf16_t* HG = (const bf16_t*)(ws + WS_HGLU); bf16_t* MIX = (bf16_t*)(ws + WS_MIX);
    LAS f32x2* part = (LAS f32x2*)(lds + LDS_MISC + 1024);
    LAS f32x2* stat = part + 256;
    LAS bf16_t* Lin = (LAS bf16_t*)lds;
    LAS bf16_t* Lout = (LAS bf16_t*)(lds + 65536);
    const int tok0 = tile * 32, t0 = tok0 & (SEQ - 1), c = tid;
    for (int ch = tid; ch < 62 * 64; ch += NTHR) { const int r = ch >> 6, cc = ch & 63; const int tt = t0 - 30 + r;
        u32x4 v = {0u, 0u, 0u, 0u}; if (tt >= 0) v = *(const u32x4*)(HG + (size_t)(tok0 - 30 + r) * 512 + cc * 8);
        *(LAS u32x4*)(Lin + r * 512 + cc * 8) = v; }
    __syncthreads();
    float in[62];
#pragma unroll
    for (int r = 0; r < 62; ++r) in[r] = __builtin_bit_cast(float, (unsigned)Lin[r * 512 + c] << 16);
    float out[32];
    const float bias = P.dw_b[c];
#pragma unroll
    for (int i = 0; i < 32; ++i) out[i] = bias;
#pragma unroll
    for (int j = 0; j < 31; ++j) { const float wj = P.dw_w[j * 512 + c];
#pragma unroll
        for (int i = 0; i < 32; ++i) out[i] = fmaf(in[i + j], wj, out[i]); }
#pragma unroll
    for (int i = 0; i < 32; ++i) { const float s1 = wave_sum(out[i]), s2 = wave_sum(out[i] * out[i]); if (lane == 0) part[i * 8 + wave] = (f32x2){s1, s2}; }
    __syncthreads();
    if (tid < 32) { float s1 = 0.f, s2 = 0.f;
#pragma unroll
        for (int w = 0; w < 8; ++w) { const f32x2 pp = part[tid * 8 + w]; s1 += pp.x; s2 += pp.y; }
        const float mean = s1 * (1.0f / 512.0f), var = fmaxf(s2 * (1.0f / 512.0f) - mean * mean, 0.f);
        stat[tid] = (f32x2){mean, 1.0f / sqrtf(var + EPS)}; }
    __syncthreads();
    const float lgc = P.ln_g[c], lbc = P.ln_b[c];
#pragma unroll
    for (int i = 0; i < 32; ++i) { const f32x2 st = stat[i]; const float y = (out[i] - st.x) * st.y * lgc + lbc; const float sl = y * sigmoidf_(y);
        Lout[i * 512 + c] = (bf16_t)f2bf(sl); }
    __syncthreads();
    for (int ch = tid; ch < 32 * 64; ch += NTHR) { const int r = ch >> 6, cc = ch & 63;
        *(u32x4*)(MIX + (size_t)(tok0 + r) * 1024 + 512 + cc * 8) = *(const LAS u32x4*)(Lout + r * 512 + cc * 8); }
    __syncthreads();
}

__device__ __forceinline__ void router_phase(const Params& P, LAS unsigned char* lds, int blk, int G, int tid, int wave, int lane) {
    unsigned char* ws = P.ws;
    const float* h1 = (const float*)(ws + WS_H1); const float* wrg = (const float*)(ws + WS_WRG);
    int* list = (int*)(ws + WS_LIST); float* lscale = (float*)(ws + WS_LSCALE); float* lgate = (float*)(ws + WS_LGATE);
    unsigned* cntg = (unsigned*)(ws + WS_CTL) + CW_CNT;
    LAS float* WL = (LAS float*)lds;
    LAS int* lcnt = (LAS int*)(lds + LDS_MISC + 1024);
    LAS int* gbase = lcnt + 32;
    LAS int* rec_e = gbase + 32;
    LAS int* rec_p = rec_e + 512;
    LAS float* rec_g = (LAS float*)(rec_p + 512);
    LAS float* rec_s = rec_g + 512;
    for (int i = tid; i < 8192; i += NTHR) ((LAS f32x4*)WL)[i] = ((const f32x4*)wrg)[i];
    __syncthreads();
    const int tl = lane & 31, half = lane >> 5;
    for (int chunk = blk; chunk < NTOK / 128; chunk += G) {
        if (tid < 32) lcnt[tid] = 0;
        __syncthreads();
        if (wave < 4) {
            const int tloc = wave * 32 + tl, tok = chunk * 128 + tloc;
            const float* hrow = h1 + (size_t)tok * DM + 4 * half;
            f32x16 acc;
#pragma unroll
            for (int i = 0; i < 16; ++i) acc[i] = 0.f;
            float ss = 0.f;
#pragma unroll 1
            for (int k0 = 0; k0 < DM; k0 += 32) {
                f32x4 hv[4];
#pragma unroll
                for (int i = 0; i < 4; ++i) hv[i] = *(const f32x4*)(hrow + k0 + 8 * i);
#pragma unroll
                for (int i = 0; i < 4; ++i) {
                    ss = fmaf(hv[i].x, hv[i].x, fmaf(hv[i].y, hv[i].y, fmaf(hv[i].z, hv[i].z, fmaf(hv[i].w, hv[i].w, ss))));
#pragma unroll
                    for (int j = 0; j < 4; ++j) { const float wv = WL[(k0 + 8 * i + 4 * half + j) * 32 + tl];
                        acc = __builtin_amdgcn_mfma_f32_32x32x2f32(wv, hv[i][j], acc, 0, 0, 0); }
                }
            }
            ss += __shfl_xor(ss, 32);
            const float rs = 1.0f / sqrtf(ss * (1.0f / DM) + EPS);
            float v[16];
#pragma unroll
            for (int r = 0; r < 16; ++r) v[r] = acc[r] * rs + P.b_router[(r & 3) + 8 * (r >> 2) + 4 * half];
            float tv[4]; int te[4];
#pragma unroll
            for (int q = 0; q < 4; ++q) { float bv = -INFINITY; int be = 64;
#pragma unroll
                for (int r = 0; r < 16; ++r) { const int e = (r & 3) + 8 * (r >> 2) + 4 * half; if (v[r] > bv || (v[r] == bv && e < be)) { bv = v[r]; be = e; } }
#pragma unroll
                for (int r = 0; r < 16; ++r) { const int e = (r & 3) + 8 * (r >> 2) + 4 * half; if (e == be) v[r] = -INFINITY; }
                tv[q] = bv; te[q] = be; }
            float cv[8]; int ce[8];
#pragma unroll
            for (int q = 0; q < 4; ++q) { cv[q] = tv[q]; ce[q] = te[q]; cv[4 + q] = __shfl_xor(tv[q], 32); ce[4 + q] = __shfl_xor(te[q], 32); }
#pragma unroll
            for (int q = 0; q < 4; ++q) { float bv = -INFINITY; int be = 64;
#pragma unroll
                for (int r = 0; r < 8; ++r) if (cv[r] > bv || (cv[r] == bv && ce[r] < be)) { bv = cv[r]; be = ce[r]; }
#pragma unroll
                for (int r = 0; r < 8; ++r) if (ce[r] == be) cv[r] = -INFINITY;
                tv[q] = bv; te[q] = be; }
            const float e1 = __expf(tv[1] - tv[0]), e2 = __expf(tv[2] - tv[0]), e3 = __expf(tv[3] - tv[0]);
            const float is = 1.0f / (1.0f + e1 + e2 + e3);
            if (half == 0) {
                const float gq[4] = {is, e1 * is, e2 * is, e3 * is};
#pragma unroll
                for (int q = 0; q < 4; ++q) { const int lp = atomicAdd((int*)&lcnt[te[q]], 1); const int si = tloc * 4 + q; rec_e[si] = te[q]; rec_p[si] = lp; rec_g[si] = gq[q]; }
                rec_s[tloc] = rs;
            }
        }
        __syncthreads();
        if (tid < 32) gbase[tid] = (int)atomicAdd(cntg + 64 * tid, (unsigned)lcnt[tid]);
        __syncthreads();
        { const int si = tid, ee = rec_e[si], pos = gbase[ee] + rec_p[si], li = ee * NTOK + pos;
          list[li] = (chunk * 128) * 4 + si; lscale[li] = rec_s[si >> 2]; lgate[li] = rec_g[si]; }
        __syncthreads();
    }
}

__device__ __forceinline__ void combine_phase(const Params& P, int gw, int NGW, int lane) {
    unsigned char* ws = P.ws;
    float* h1 = (float*)(ws + WS_H1); bf16_t* h1b = (bf16_t*)(ws + WS_H1B); const bf16_t* y = (const bf16_t*)(ws + WS_Y); float* rs3 = (float*)(ws + WS_RS3);
    for (int m = gw; m < NTOK; m += NGW) {
        const f32x4* hr = (const f32x4*)(h1 + (size_t)m * DM) + lane; f32x4 v[4]; float s = 0.f;
#pragma unroll
        for (int j = 0; j < 4; ++j) v[j] = hr[64 * j];
#pragma unroll
        for (int k = 0; k < 4; ++k) { const u32x2* yr = (const u32x2*)(y + (size_t)(m * 4 + k) * DM) + lane;
#pragma unroll
            for (int j = 0; j < 4; ++j) { const u32x2 w = yr[64 * j]; v[j].x += bf_lo(w.x); v[j].y += bf_hi(w.x); v[j].z += bf_lo(w.y); v[j].w += bf_hi(w.y); } }
        u32x2* o8 = (u32x2*)(h1b + (size_t)m * DM) + lane;
#pragma unroll
        for (int j = 0; j < 4; ++j) { u32x2 w; w.x = pk2(v[j].x, v[j].y); w.y = pk2(v[j].z, v[j].w); o8[64 * j] = w;
            s += (v[j].x * v[j].x + v[j].y * v[j].y) + (v[j].z * v[j].z + v[j].w * v[j].w); }
        s = wave_sum(s);
        if (lane == 0) rs3[m] = 1.0f / sqrtf(s * (1.0f / DM) + EPS);
    }
}

__device__ __forceinline__ void final_phase(const Params& P, int gw, int NGW, int lane) {
    unsigned char* ws = P.ws;
    const bf16_t* h2b = (const bf16_t*)(ws + WS_H1B); const bf16_t* pj = (const bf16_t*)(ws + WS_PJ); const bf16_t* G = (const bf16_t*)(ws + WS_G); const float* rs3 = (const float*)(ws + WS_RS3);
    f32x4 gv[4];
#pragma unroll
    for (int j = 0; j < 4; ++j) gv[j] = *((const f32x4*)P.g_final + lane + 64 * j);
    for (int m = gw; m < NTOK; m += NGW) {
        const u32x2* hr = (const u32x2*)(h2b + (size_t)m * DM) + lane; const u32x2* pr = (const u32x2*)(pj + (size_t)m * DM) + lane; const u32x2* gr = (const u32x2*)(G + (size_t)m * DM) + lane;
        const float r3 = rs3[m]; f32x4 v[4]; float s = 0.f;
#pragma unroll
        for (int j = 0; j < 4; ++j) { const u32x2 hw = hr[64 * j], pw = pr[64 * j], gw2 = gr[64 * j];
            v[j].x = bf_lo(hw.x) + bf_lo(pw.x) * sigmoidf_(bf_lo(gw2.x) * r3); v[j].y = bf_hi(hw.x) + bf_hi(pw.x) * sigmoidf_(bf_hi(gw2.x) * r3);
            v[j].z = bf_lo(hw.y) + bf_lo(pw.y) * sigmoidf_(bf_lo(gw2.y) * r3); v[j].w = bf_hi(hw.y) + bf_hi(pw.y) * sigmoidf_(bf_hi(gw2.y) * r3);
            s += (v[j].x * v[j].x + v[j].y * v[j].y) + (v[j].z * v[j].z + v[j].w * v[j].w); }
        s = wave_sum(s); const float rs = 1.0f / sqrtf(s * (1.0f / DM) + EPS);
        f32x4* orow = (f32x4*)(P.out + (size_t)m * DM) + lane;
#pragma unroll
        for (int j = 0; j < 4; ++j) orow[64 * j] = v[j] * rs * gv[j];
    }
}

#define XB_TMO      128
#define XB_XCNT(j)  (256  + 64 * (j))
#define XB_XSUB(j)  (1280 + 64 * (j))
#define XB_XGEN(j)  (2304 + 64 * (j))
#define XB_TOP      3328
#define XB_TOPGEN   3392
#define XCD_BAR_WORDS 3456
#define XB_SPIN_CAP (1u << 18)
__device__ __forceinline__ unsigned xb_ld(unsigned* p)              { return __hip_atomic_load(p, __ATOMIC_RELAXED, __HIP_MEMORY_SCOPE_AGENT); }
__device__ __forceinline__ unsigned xb_add(unsigned* p, unsigned v) { return __hip_atomic_fetch_add(p, v, __ATOMIC_RELAXED, __HIP_MEMORY_SCOPE_AGENT); }
__device__ __forceinline__ unsigned xb_xcc_id() { return (unsigned)__builtin_amdgcn_s_getreg((3 << 11) | 20) & 0xFu; }
#define XB_SPIN(cond, bar) do { unsigned _sp = 0; while (cond) { __builtin_amdgcn_s_sleep(1); \
    if ((++_sp & 255u) == 0u) { if (xb_ld(&(bar)[XB_TMO])) break; if (_sp > XB_SPIN_CAP) { atomicAdd(&(bar)[XB_TMO], 1u); break; } } } } while (0)
struct XcdBarrier { unsigned* bar; unsigned x; volatile LAS unsigned* st; };
__device__ __forceinline__ XcdBarrier xcd_barrier_post(unsigned* bar, volatile LAS unsigned* st) {
    XcdBarrier b; b.bar = bar; b.x = xb_xcc_id(); b.st = st;
    if (threadIdx.x == 0) (void)xb_add(&bar[XB_XCNT(b.x)], 1u);
    return b;
}
__device__ __forceinline__ void xcd_barrier_complete(unsigned* bar, unsigned x, unsigned& nloc, unsigned& nx) {
    const unsigned G = gridDim.x * gridDim.y * gridDim.z;
    unsigned sum, cnt, mine, sp = 0u;
    for (;;) {
        sum = 0u; cnt = 0u; mine = 0u;
#pragma unroll
        for (unsigned j = 0; j < 16; ++j) { const unsigned c = xb_ld(&bar[XB_XCNT(j)]); sum += c; cnt += (c > 0u) ? 1u : 0u; mine = (j == x) ? c : mine; }
        if (sum == G) break;
        __builtin_amdgcn_s_sleep(1);
        if ((++sp & 255u) == 0u) { if (xb_ld(&bar[XB_TMO])) break; if (sp > XB_SPIN_CAP) { atomicAdd(&bar[XB_TMO], 1u); break; } }
    }
    nloc = mine > 0u ? mine : 1u; nx = cnt > 0u ? cnt : 1u;
}
__device__ __forceinline__ void xcd_barrier(const XcdBarrier& b) {
    asm volatile("s_waitcnt vmcnt(0)" ::: "memory");
    __syncthreads();
    if (threadIdx.x == 0) {
        unsigned* bar = b.bar;
        __builtin_amdgcn_s_waitcnt(0);
        unsigned nloc = b.st[0], nx = b.st[1];
        if (nloc == 0u) { xcd_barrier_complete(bar, b.x, nloc, nx); b.st[0] = nloc; b.st[1] = nx; }
        const unsigned old = xb_add(&bar[XB_XSUB(b.x)], 1u);
        const unsigned gen = old / nloc;
        if (old + 1u == (gen + 1u) * nloc) {
            __builtin_amdgcn_fence(__ATOMIC_RELEASE, "agent");
            asm volatile("s_waitcnt vmcnt(0)" ::: "memory");
            const unsigned og = xb_add(&bar[XB_TOP], 1u);
            const unsigned tg = og / nx;
            if (og + 1u == (tg + 1u) * nx) xb_add(&bar[XB_TOPGEN], 1u);
            else XB_SPIN(xb_ld(&bar[XB_TOPGEN]) == tg, bar);
            __builtin_amdgcn_fence(__ATOMIC_ACQUIRE, "agent");
            xb_add(&bar[XB_XGEN(b.x)], 1u);
            asm volatile("s_waitcnt vmcnt(0)" ::: "memory");
        } else {
            XB_SPIN(xb_ld(&bar[XB_XGEN(b.x)]) == gen, bar);
            __builtin_amdgcn_fence(__ATOMIC_ACQUIRE, "agent");
            asm volatile("s_waitcnt vmcnt(0)" ::: "memory");
        }
    }
    __syncthreads();
}

constexpr int NPHASE = 10;
__global__ void __launch_bounds__(NTHR, 2) fwd_kernel(Params P) {
    extern __shared__ __attribute__((aligned(16))) unsigned char lds_raw[];
    LAS unsigned char* lds = (LAS unsigned char*)lds_raw;
    cg::grid_group grid = cg::this_grid();
    const int tid = threadIdx.x, wave = __builtin_amdgcn_readfirstlane(tid >> 6);
    const int G = gridDim.x, bx = blockIdx.x;
#define FRESH_LANE(name) int name = (int)__builtin_amdgcn_mbcnt_hi(~0u, __builtin_amdgcn_mbcnt_lo(~0u, 0u)); asm volatile("" : "+v"(name))
    const int vcu = (G % 8 == 0) ? (bx % 8) * (G / 8) + bx / 8 : bx;
    const int NGW = G * NWAVES;
    unsigned char* ws = P.ws;
    const int lo = P.ph_lo, hi = P.ph_hi;
#ifndef PH_MASK
#define PH_MASK 0x3ff
#endif
#define IN(k) ((((PH_MASK) >> (k)) & 1) && lo <= (k) && (k) < hi)
    volatile LAS unsigned* xst = (volatile LAS unsigned*)(lds + LDS_XB);
    if (tid < 2) xst[tid] = 0u;
    __syncthreads();
    const XcdBarrier xbar = xcd_barrier_post((unsigned*)(ws + WS_CTL) + CW_BAR, xst);
#define SYNC(k) do { if (IN(k) && IN((k) + 1)) { if ((k) == 0) grid.sync(); else xcd_barrier(xbar); } } while (0)

    if (IN(0)) { FRESH_LANE(lane); p0_prologue(P, lds, vcu, G, wave, lane); }
    SYNC(0);
    if (IN(1)) {
        { pg8::DenseSched S; S.init((const bf16_t*)(ws + WS_XB), (const bf16_t*)(ws + WS_WIN), NTOK, 2048, 1024, G, bx);
          EpiInProj E{(const float*)(ws + WS_RS1), (const f32x2*)(ws + WS_ROPE), P.glu_b, (bf16_t*)(ws + WS_Q), (bf16_t*)(ws + WS_K), (bf16_t*)(ws + WS_V), (bf16_t*)(ws + WS_QI), (bf16_t*)(ws + WS_KI), (bf16_t*)(ws + WS_HGLU), (float*)(ws + WS_WI)};
          pg8::gemm_phase<EpiInProj, pg8::DenseSched, false>(lds, S, E); }
        { pg8::DenseSched S; S.init((const bf16_t*)(ws + WS_PB), (const bf16_t*)(ws + WS_WP), NTOK, 1024, 256, G, bx);
          EpiBf16Plain E{(bf16_t*)(ws + WS_PJ), 1024};
          pg8::gemm_phase<EpiBf16Plain, pg8::DenseSched, false>(lds, S, E); }
    }
    SYNC(1);
    if (IN(2)) {
        FRESH_LANE(lane);
        for (int i = tid; i < 4096; i += NTHR) ((LAS unsigned*)(lds + LDS_MISC))[i] = 0u;
        __syncthreads();
        if (G % 8 == 0) { const int b = bx % 8, jb = bx / 8, nbb = G / 8;
            for (int i = 0;; ++i) { const int k = i * nbb + ((i & 1) ? nbb - 1 - jb : jb); if (k >= 512) break; attn_tile(P, lds, b, (511 - k) * 8, wave, lane); } }
        else { for (int tl = bx; tl < 4096; tl += G) attn_tile(P, lds, tl & 7, (511 - (tl >> 3)) * 8, wave, lane); }
        for (int rp = 0; rp <= ((P.rep >> 3) & 1); ++rp)
        for (int tl = vcu; tl < NTOK / 32; tl += G) conv_tile(P, lds, tl, tid, wave, lane);
    }
    SYNC(2);
    if (IN(3)) {
        pg8::DenseSched S; S.init((const bf16_t*)(ws + WS_MIX), (const bf16_t*)(ws + WS_WOUT), NTOK, 1024, 1024, G, bx);
        EpiOutProj E{P.x, (float*)(ws + WS_H1), (unsigned char*)(ws + WS_H1F8)};
        pg8::gemm_phase<EpiOutProj, pg8::DenseSched, false, false, true>(lds, S, E);
    }
    SYNC(3);
    if (IN(4)) { FRESH_LANE(lane); router_phase(P, lds, vcu, G, tid, wave, lane); }
    SYNC(4);
    if (IN(5) || IN(6)) {
        LAS int* tb = (LAS int*)(lds + LDS_MISC); LAS int* cn = tb + 64;
        if (tid == 0) { const unsigned* cntg = (const unsigned*)(ws + WS_CTL) + CW_CNT; int acc = 0;
            for (int e = 0; e < NE; ++e) { const int c = (int)__hip_atomic_load(cntg + 64 * e, __ATOMIC_RELAXED, __HIP_MEMORY_SCOPE_AGENT); tb[e] = acc; cn[e] = c; acc += (c + BM - 1) / BM; }
            tb[NE] = acc; }
        __syncthreads();
        if (IN(5)) {
            pg8::MoeSched S; S.A = ws + WS_H1F8; S.Bt = ws + WS_WUP; S.rp = 1024; S.b_estride = (size_t)2048 * 1024; S.tb = tb; S.cnt = cn; S.list = (const int*)(ws + WS_LIST);
            S.nN = 8; S.nwg = tb[NE] * 8; S.G = G; S.c = bx; S.gather = true;
            S.m_scale = (const float*)(ws + WS_LSCALE); S.m_gate = nullptr; S.m_bias = P.b_up;
            EpiUp E{(unsigned char*)(ws + WS_ACT)};
            pg8::gemm_phase<EpiUp, pg8::MoeSched, true, true>(lds, S, E);
        }
        SYNC(5);
        if (IN(6)) {
            pg8::MoeSched S; S.A = ws + WS_ACT; S.Bt = ws + WS_WDOWN; S.rp = 1024; S.b_estride = (size_t)1024 * 1024; S.tb = tb; S.cnt = cn; S.list = (const int*)(ws + WS_LIST);
            S.nN = 4; S.nwg = tb[NE] * 4; S.G = G; S.c = bx; S.gather = false;
            S.m_scale = nullptr; S.m_gate = (const float*)(ws + WS_LGATE); S.m_bias = P.b_down;
            EpiDown E{(bf16_t*)(ws + WS_Y)};
            pg8::gemm_phase<EpiDown, pg8::MoeSched, true, true, true>(lds, S, E);
        }
    }
    SYNC(6);
    if (IN(7)) { FRESH_LANE(l7); const int g7 = vcu * NWAVES + wave;
        combine_phase(P, g7, NGW, l7); }
    SYNC(7);
    if (IN(8)) {
        pg8::DenseSched S; S.init((const bf16_t*)(ws + WS_H1B), (const bf16_t*)(ws + WS_WG), NTOK, 1024, 1024, G, bx);
        EpiBf16Plain E{(bf16_t*)(ws + WS_G), 1024};
        pg8::gemm_phase<EpiBf16Plain, pg8::DenseSched, false>(lds, S, E);
    }
    SYNC(8);
    if (IN(9)) { FRESH_LANE(l9); const int g9 = vcu * NWAVES + wave;
        final_phase(P, g9, NGW, l9); }
#undef IN
#undef SYNC
}

#ifndef N_LAUNCH_MODE
#define N_LAUNCH_MODE 1
#endif
extern "C" void kernel_launch(void* const* d_in, const int* in_sizes, int n_in, void* d_out, int out_size, void* d_ws, size_t ws_size, hipStream_t stream) {
    static int grid = 0;
    if (grid == 0) {
        if (n_in != 21 || out_size != NTOK * DM || ws_size < WS_END) { fprintf(stderr, "kernel_launch: unexpected shapes (n_in %d out %d ws %zu)\n", n_in, out_size, ws_size); grid = -1; return; }
        int dev = 0, cus = 0, per_cu = 0;
        (void)hipGetDevice(&dev); (void)hipDeviceGetAttribute(&cus, hipDeviceAttributeMultiprocessorCount, dev);
        (void)hipFuncSetAttribute((const void*)fwd_kernel, hipFuncAttributeMaxDynamicSharedMemorySize, LDS_BYTES);
        if (hipOccupancyMaxActiveBlocksPerMultiprocessor(&per_cu, (const void*)fwd_kernel, NTHR, LDS_BYTES) != hipSuccess || per_cu < 1) { fprintf(stderr, "kernel_launch: occupancy query failed (%d)\n", per_cu); (void)hipGetLastError(); grid = -1; return; }
        grid = cus;
    }
    if (grid < 0) return;
    (void)hipMemsetAsync((char*)d_ws + WS_CTL, 0, CTL_BYTES, stream);
    Params p{};
    p.x = (const float*)d_in[0]; p.p = (const float*)d_in[1]; p.w_in = (const float*)d_in[2]; p.w_out = (const float*)d_in[3]; p.g_mix = (const float*)d_in[4]; p.g_ffn = (const float*)d_in[5];
    p.glu_b = (const float*)d_in[6]; p.dw_w = (const float*)d_in[7]; p.dw_b = (const float*)d_in[8]; p.ln_g = (const float*)d_in[9]; p.ln_b = (const float*)d_in[10];
    p.w_router = (const float*)d_in[11]; p.b_router = (const float*)d_in[12]; p.w_up = (const float*)d_in[13]; p.b_up = (const float*)d_in[14]; p.w_down = (const float*)d_in[15]; p.b_down = (const float*)d_in[16];
    p.w_ple_proj = (const float*)d_in[17]; p.w_ple_gate = (const float*)d_in[18]; p.g_ple = (const float*)d_in[19]; p.g_final = (const float*)d_in[20];
    p.out = (float*)d_out; p.ws = (unsigned char*)d_ws;
#ifndef PROBE_REPMASK
#define PROBE_REPMASK 0
#endif
    p.rep = PROBE_REPMASK;
#if N_LAUNCH_MODE == 1
    p.ph_lo = 0; p.ph_hi = NPHASE;
    void* args[] = {&p};
    hipError_t e = hipLaunchCooperativeKernel((const void*)fwd_kernel, dim3(grid), dim3(NTHR), args, LDS_BYTES, stream);
    if (e != hipSuccess) fprintf(stderr, "cooperative launch failed: %s (grid %d)\n", hipGetErrorString(e), grid);
#else
    for (int ph = 0; ph < NPHASE; ++ph) {
        p.ph_lo = ph; p.ph_hi = ph + 1;
        void* args[] = {&p};
        hipError_t e = hipLaunchCooperativeKernel((const void*)fwd_kernel, dim3(grid), dim3(NTHR), args, LDS_BYTES, stream);
        if (e != hipSuccess) { fprintf(stderr, "launch %d failed: %s (grid %d)\n", ph, hipGetErrorString(e), grid); break; }
    }
#endif
}
```

```cpp
#include <hip/hip_runtime.h>
#include <hip/hip_cooperative_groups.h>
#include <cstdio>
#include <cstdint>
namespace cg = cooperative_groups;

#define LAS __attribute__((address_space(3)))
#define GAS __attribute__((address_space(1)))
typedef unsigned short bf16_t;
typedef short bf16x8 __attribute__((ext_vector_type(8)));
typedef short s16x4 __attribute__((ext_vector_type(4)));
typedef float f32x4 __attribute__((ext_vector_type(4)));
typedef float f32x2 __attribute__((ext_vector_type(2)));
typedef float f32x16 __attribute__((ext_vector_type(16)));
typedef unsigned u32x4 __attribute__((ext_vector_type(4)));
typedef unsigned u32x2 __attribute__((ext_vector_type(2)));

constexpr int NB = 8, SEQ = 4096, DM = 1024, NTOK = NB * SEQ;
constexpr int NE = 32, TOPK = 4, NSLOT = NTOK * TOPK;
constexpr int INW = 1988;
constexpr int NSEL = 256;
constexpr float EPS = 1e-6f;
constexpr int NWAVES = 8, NTHR = 512;

constexpr size_t MiB = 1u << 20;
constexpr size_t WS_CTL = 0, CTL_BYTES = 64 * 1024;
constexpr size_t WS_ROPE = 1 * MiB;
constexpr size_t WS_WIN = 2 * MiB;
constexpr size_t WS_WOUT = 6 * MiB;
constexpr size_t WS_WG = 8 * MiB;
constexpr size_t WS_WP = 10 * MiB;
constexpr size_t WS_WRG = 10 * MiB + 512 * 1024;
constexpr size_t WS_RS1 = 11 * MiB;
constexpr size_t WS_RS3 = 11 * MiB + 512 * 1024;
constexpr size_t WS_WI = 12 * MiB;
constexpr size_t WS_LIST = 13 * MiB;
constexpr size_t WS_LSCALE = 17 * MiB;
constexpr size_t WS_LGATE = 21 * MiB;
constexpr size_t WS_PB = 25 * MiB;
constexpr size_t WS_WUP = 42 * MiB;
constexpr size_t WS_WDOWN = 170 * MiB;
constexpr size_t WS_H1 = 234 * MiB;
constexpr size_t WS_H1B = 362 * MiB;
constexpr size_t WS_PJ = 426 * MiB;
constexpr size_t WS_XB = 490 * MiB;
constexpr size_t WS_Q = 554 * MiB;
constexpr size_t WS_K = 586 * MiB;
constexpr size_t WS_V = 590 * MiB;
constexpr size_t WS_QI = 594 * MiB;
constexpr size_t WS_KI = 610 * MiB;
constexpr size_t WS_HGLU = 614 * MiB;
constexpr size_t WS_MIX = 646 * MiB;
constexpr size_t WS_H1F8 = 490 * MiB;
constexpr size_t WS_ACT = 522 * MiB;
constexpr size_t WS_Y = 762 * MiB;
constexpr size_t WS_G = 762 * MiB;
constexpr size_t WS_END = 1018 * MiB;
static_assert(WS_H1F8 + (size_t)NTOK * 1024 <= WS_ACT && WS_ACT + (size_t)139264 * 1024 <= WS_Y, "ws map");
constexpr int CW_CNT = 1024;
constexpr int CW_BAR = 8192;

constexpr int LDS_STAGE = 131072;
constexpr int LDS_MISC = LDS_STAGE;
constexpr int LDS_META = LDS_MISC + 4096;
constexpr int LDS_XB = 147456;
constexpr int LDS_BYTES = 147456 + 256;

__device__ __forceinline__ unsigned f2bf(float f) { unsigned u = __builtin_bit_cast(unsigned, f); return (u + 0x7fffu + ((u >> 16) & 1u)) >> 16; }
__device__ __forceinline__ unsigned pk2(float lo, float hi) { return f2bf(lo) | (f2bf(hi) << 16); }
__device__ __forceinline__ float bf_lo(unsigned w) { return __builtin_bit_cast(float, w << 16); }
__device__ __forceinline__ float bf_hi(unsigned w) { return __builtin_bit_cast(float, w & 0xffff0000u); }
__device__ __forceinline__ float wave_sum(float v) {
    v += __builtin_bit_cast(float, __builtin_amdgcn_update_dpp(0, __builtin_bit_cast(int, v), 0xB1, 0xF, 0xF, true));
    v += __builtin_bit_cast(float, __builtin_amdgcn_update_dpp(0, __builtin_bit_cast(int, v), 0x4E, 0xF, 0xF, true));
    v += __builtin_bit_cast(float, __builtin_amdgcn_update_dpp(0, __builtin_bit_cast(int, v), 0x141, 0xF, 0xF, true));
    v += __builtin_bit_cast(float, __builtin_amdgcn_update_dpp(0, __builtin_bit_cast(int, v), 0x140, 0xF, 0xF, true));
    const int vi = __builtin_bit_cast(int, v);
    const float r0 = __builtin_bit_cast(float, __builtin_amdgcn_readlane(vi, 0)), r1 = __builtin_bit_cast(float, __builtin_amdgcn_readlane(vi, 16));
    const float r2 = __builtin_bit_cast(float, __builtin_amdgcn_readlane(vi, 32)), r3 = __builtin_bit_cast(float, __builtin_amdgcn_readlane(vi, 48));
    return (r0 + r1) + (r2 + r3);
}
__device__ __forceinline__ unsigned pk4_fp8(float a, float b, float c, float d) { int r = __builtin_amdgcn_cvt_pk_fp8_f32(a, b, 0, false); r = __builtin_amdgcn_cvt_pk_fp8_f32(c, d, r, true); return (unsigned)r; }
__device__ __forceinline__ float sigmoidf_(float x) { return __builtin_amdgcn_rcpf(1.0f + __builtin_amdgcn_exp2f(x * -1.4426950408889634f)); }
#define LDS_WAIT() asm volatile("s_waitcnt lgkmcnt(0)" ::: "memory")

struct Params {
    const float* x; const float* p; const float* w_in; const float* w_out; const float* g_mix; const float* g_ffn;
    const float* glu_b; const float* dw_w; const float* dw_b; const float* ln_g; const float* ln_b;
    const float* w_router; const float* b_router; const float* w_up; const float* b_up; const float* w_down; const float* b_down;
    const float* w_ple_proj; const float* w_ple_gate; const float* g_ple; const float* g_final;
    float* out; unsigned char* ws;
    int ph_lo, ph_hi, rep, pad;
};

namespace pg8 {
constexpr int BM = 256, BK = 64, HALF = 128, HTB = HALF * BK * 2, STAGE_BYTES = 8 * HTB, NXCD = 8, WGM = 8;
__host__ __device__ __forceinline__ int lds_byte(int r, int c) { const int st = (r >> 4) * 2 + (c >> 5), rr = r & 15, cc = c & 31, ob = rr * 64 + cc * 2; return st * 1024 + (ob ^ (((ob >> 9) & 1) << 5)); }
__host__ __device__ __forceinline__ void stage_rc(int b, int& R, int& C) { const int st = b / 1024, sb = b % 1024, swz = sb ^ (((sb >> 9) & 1) << 5); R = (st >> 1) * 16 + swz / 64; C = (st & 1) * 32 + (swz % 64) / 2; }
__host__ __device__ __forceinline__ int perm32(int rho) { const int n = rho >> 4, i = rho & 15; return 8 * (i >> 2) + 4 * n + (i & 3); }

struct Unit { int pm, pn, e, rows; };

__device__ __forceinline__ unsigned cvt_pk_bf16(float lo, float hi) { unsigned r; asm volatile("v_cvt_pk_bf16_f32 %0, %1, %2" : "=v"(r) : "v"(lo), "v"(hi)); return r; }

struct DenseSched {
    const void* A; const void* Bt; int rp;
    int nM, nN, nwg, G, c;
    __device__ void init(const void* A_, const void* Bt_, int M, int N, int K_, int G_, int c_) { A = A_; Bt = Bt_; rp = K_ * 2; nM = M / BM; nN = N / BM; nwg = nM * nN; G = G_; c = c_; }
    __device__ bool next(int i, Unit& u) const {
        const long L = (long)i * G + c; if (L >= nwg) return false;
        int wgid = (int)L; { const int q = nwg / NXCD, r = nwg % NXCD, xcd = wgid % NXCD, off = wgid / NXCD; wgid = (xcd < r ? xcd * (q + 1) : r * (q + 1) + (xcd - r) * q) + off; }
        const int nig = WGM * nN, gid = wgid / nig, fm = gid * WGM, gsz = (nM - fm) < WGM ? (nM - fm) : WGM;
        u.pm = fm + ((wgid % nig) % gsz); u.pn = (wgid % nig) / gsz; u.e = 0; u.rows = BM; return true;
    }
    __device__ __forceinline__ const char* a_ptr(const Unit& u) const { return (const char*)A + (size_t)u.pm * BM * rp; }
    __device__ __forceinline__ const char* b_ptr(const Unit& u) const { return (const char*)Bt + (size_t)u.pn * BM * rp; }
    __device__ __forceinline__ int a_row(const Unit&, int) const { return 0; }
    __device__ __forceinline__ void meta(const Unit&, LAS unsigned char*, int, int) const {}
};

struct MoeSched {
    const void* A; const void* Bt; int rp; size_t b_estride;
    const LAS int* tb;
    const LAS int* cnt;
    const int* list;
    int nN, nwg, G, c; bool gather;
    const LAS int* utab;
    __device__ __forceinline__ bool next(int i, Unit& u) const {
        if (i >= 32) return false;
        const LAS int* p = utab + 4 * i; const int rows = p[3]; if (rows < 0) return false;
        u.pm = p[0]; u.pn = p[1]; u.e = p[2]; u.rows = rows; return true;
    }
    __device__ __forceinline__ void build_table(LAS int* tab, int tid) const {
        if (tid < 32) { Unit u; const bool ok = decode(tid, u); tab[4 * tid] = u.pm; tab[4 * tid + 1] = u.pn; tab[4 * tid + 2] = u.e; tab[4 * tid + 3] = ok ? u.rows : -1; }
    }
    __device__ __forceinline__ bool decode(int i, Unit& u) const {
        u.pm = 0; u.pn = 0; u.e = 0; u.rows = 0;
        const long L = (long)i * G + c; if (L >= nwg) return false;
        int wgid = (int)L; { const int q = nwg / NXCD, r = nwg % NXCD, xcd = wgid % NXCD, off = wgid / NXCD; wgid = (xcd < r ? xcd * (q + 1) : r * (q + 1) + (xcd - r) * q) + off; }
        int e = 0;
#pragma unroll 1
        for (; e < NE - 1; ++e) { if (wgid < tb[e + 1] * nN) break; }
        const int local = wgid - tb[e] * nN, nM = tb[e + 1] - tb[e];
        const int nig = WGM * nN, gid = local / nig, fm = gid * WGM, gsz = (nM - fm) < WGM ? (nM - fm) : WGM;
        const int rt = fm + ((local % nig) % gsz);
        u.pm = tb[e] + rt; u.pn = (local % nig) / gsz; u.e = e;
        const int left = cnt[e] - rt * BM; u.rows = left < BM ? left : BM; return true;
    }
    __device__ __forceinline__ const char* a_ptr(const Unit& u) const { return (const char*)A; }
    __device__ __forceinline__ const char* b_ptr(const Unit& u) const { return (const char*)Bt + (size_t)u.e * b_estride + (size_t)u.pn * BM * rp; }
    __device__ __forceinline__ int a_row(const Unit& u, int r) const {
        if (!gather) return u.pm * BM + r;
        const int rt = u.pm - tb[u.e];
        return r < u.rows ? (list[u.e * NTOK + rt * BM + r] >> 2) : 0;
    }
    const float* m_scale; const float* m_gate; const float* m_bias;
    __device__ __forceinline__ void meta(const Unit& u, LAS unsigned char* tbl, int wid, int lane) const {
        const int rt = u.pm - tb[u.e]; const size_t li = (size_t)u.e * NTOK + rt * BM + (wid & 3) * 64 + lane;
        if (gather) {
            if (wid < 4) __builtin_amdgcn_global_load_lds((const unsigned*)(m_scale + li), (LAS unsigned*)(tbl + (wid & 3) * 256), 4, 0, 0);
            else { const int j = (wid & 3) * 64 + lane; const float* src = m_bias + (size_t)u.e * 2048 + (j < 128 ? 128 * u.pn + j : 1024 + 128 * u.pn + (j - 128));
                __builtin_amdgcn_global_load_lds((const unsigned*)src, (LAS unsigned*)(tbl + 2048 + (wid & 3) * 256), 4, 0, 0); }
        } else {
            if (wid < 4) { __builtin_amdgcn_global_load_lds((const unsigned*)(list + li), (LAS unsigned*)(tbl + (wid & 3) * 256), 4, 0, 0);
                __builtin_amdgcn_global_load_lds((const unsigned*)(m_bias + (size_t)u.e * 1024 + u.pn * BM + (wid & 3) * 64 + lane), (LAS unsigned*)(tbl + 2048 + (wid & 3) * 256), 4, 0, 0); }
            else __builtin_amdgcn_global_load_lds((const unsigned*)(m_gate + li), (LAS unsigned*)(tbl + 1024 + (wid & 3) * 256), 4, 0, 0);
        }
    }
};

typedef int v8i32 __attribute__((ext_vector_type(8)));
template <class Epi, class Sched, bool GATHER, bool F8 = false, bool WARMTRIP = false>
__device__ __forceinline__ void gemm_phase(LAS unsigned char* lds, const Sched& S, const Epi& E) {
    const int tid = threadIdx.x, wid = __builtin_amdgcn_readfirstlane(tid >> 6), lane = tid & 63, wr = wid >> 2, wc = wid & 3, fr = lane & 15, fq = lane >> 4;
    const int RP = S.rp, nt = RP / (BK * 2);
    unsigned voffA[2], voffB[2]; int RA[2], CA[2];
#pragma unroll
    for (int i = 0; i < 2; ++i) { int R, C; stage_rc(tid * 16 + i * 8192, R, C); const int Rb = Epi::PERM ? ((R & ~31) + perm32(R & 31)) : R;
        voffA[i] = (unsigned)(R * RP + C * 2); voffB[i] = (unsigned)(Rb * RP + C * 2); RA[i] = R; CA[i] = C; }
    const size_t kstep = (size_t)(BK * 2);
    const size_t hstep = (size_t)HALF * RP;
    const unsigned ldsw = (unsigned)wid * 1024u;
    const int aoff = lds_byte(wr * 64 + fr, fq * 8), boff = lds_byte(wc * 32 + fr, fq * 8);
    unsigned gC[2][2], gN[2][2];
#define PG8_SA(b, h) (((b) * 2 + (h)) * HTB)
#define PG8_SB(b, h) ((4 + (b) * 2 + (h)) * HTB)
#define PG8_STAGE(bufoff, gbase, voff) do { _Pragma("unroll") for (int _i = 0; _i < 2; ++_i) \
        __builtin_amdgcn_global_load_lds((const unsigned*)((const char*)(gbase) + (voff)[_i]), (LAS unsigned*)(lds + (bufoff) + ldsw + _i * 8192), 16, 0, 0); } while (0)
#define PG8_STAGE_A(bufoff, kp, h) do { if constexpr (GATHER) { PG8_STAGE(bufoff, kp, gC[h]); } else { PG8_STAGE(bufoff, (kp) + (h) * hstep, voffA); } } while (0)
#define PG8_LD16(p) (*(const LAS bf16x8*)(p))
#define PG8_CAT(lo, hi) __builtin_bit_cast(v8i32, __builtin_shufflevector(lo, hi, 0, 1, 2, 3, 4, 5, 6, 7, 8, 9, 10, 11, 12, 13, 14, 15))
#define PG8_LDA(dst, b, h) do { _Pragma("unroll") for (int m = 0; m < 4; ++m) { if constexpr (F8) { dst##8[m] = PG8_CAT(PG8_LD16(lds + PG8_SA(b, h) + aoff + m * 2048), PG8_LD16(lds + PG8_SA(b, h) + aoff + m * 2048 + 1024)); } \
        else { _Pragma("unroll") for (int k = 0; k < 2; ++k) dst[m][k] = PG8_LD16(lds + PG8_SA(b, h) + aoff + m * 2048 + k * 1024); } } } while (0)
#define PG8_LDB(dst, b, h) do { _Pragma("unroll") for (int n = 0; n < 2; ++n) { if constexpr (F8) { dst##8[n] = PG8_CAT(PG8_LD16(lds + PG8_SB(b, h) + boff + n * 2048), PG8_LD16(lds + PG8_SB(b, h) + boff + n * 2048 + 1024)); } \
        else { _Pragma("unroll") for (int k = 0; k < 2; ++k) dst[n][k] = PG8_LD16(lds + PG8_SB(b, h) + boff + n * 2048 + k * 1024); } } } while (0)
#define PG8_MMA(ai, bj, At, Bt) do { __builtin_amdgcn_s_setprio(1); _Pragma("unroll") for (int m = 0; m < 4; ++m) _Pragma("unroll") for (int n = 0; n < 2; ++n) { \
        if constexpr (F8) { acc[ai][bj][m][n] = __builtin_amdgcn_mfma_scale_f32_16x16x128_f8f6f4(Bt##8[n], At##8[m], acc[ai][bj][m][n], 0, 0, 0, 0x7f7f7f7f, 0, 0x7f7f7f7f); } \
        else { _Pragma("unroll") for (int k = 0; k < 2; ++k) acc[ai][bj][m][n] = __builtin_amdgcn_mfma_f32_16x16x32_bf16(Bt[n][k], At[m][k], acc[ai][bj][m][n], 0, 0, 0); } } \
        __builtin_amdgcn_s_setprio(0); } while (0)
#define PG8_WAIT_V(n) asm volatile("s_waitcnt vmcnt(" #n ")" ::: "memory")
#define PG8_WAIT_L(n) asm volatile("s_waitcnt lgkmcnt(" #n ")" ::: "memory")
#define PG8_BAR __builtin_amdgcn_s_barrier()
#define PG8_SCHED __builtin_amdgcn_sched_barrier(0)
#define PG8_GOFF(dst, u) do { _Pragma("unroll") for (int _h = 0; _h < 2; ++_h) _Pragma("unroll") for (int _i = 0; _i < 2; ++_i) \
        dst[_h][_i] = (unsigned)(S.a_row(u, _h * HALF + RA[_i]) * RP + CA[_i] * 2); } while (0)
    Unit cur, nxt, nn; int ui = 0;
    if (!S.next(0, cur)) return;
    bool has_next = S.next(1, nxt);
    if constexpr (GATHER) { PG8_GOFF(gC, cur); if (has_next) { PG8_GOFF(gN, nxt); } else { PG8_GOFF(gN, cur); } }
    f32x4 acc[2][2][4][2];
#pragma unroll
    for (int a = 0; a < 2; ++a)
#pragma unroll
        for (int b = 0; b < 2; ++b)
#pragma unroll
            for (int m = 0; m < 4; ++m)
#pragma unroll
                for (int n = 0; n < 2; ++n) acc[a][b][m][n] = (f32x4){0.f, 0.f, 0.f, 0.f};
    bf16x8 At[4][2], B0[2][2], B1[2][2]; v8i32 At8[4], B08[2], B18[2];
    const char* cA = S.a_ptr(cur); const char* cB = S.b_ptr(cur);
    PG8_STAGE(PG8_SB(0, 0), cB, voffB); PG8_STAGE(PG8_SB(0, 1), cB + hstep, voffB); PG8_STAGE_A(PG8_SA(0, 0), cA, 0); PG8_STAGE_A(PG8_SA(0, 1), cA, 1);
    if (wr == 1) PG8_BAR;
    PG8_WAIT_V(2); PG8_BAR;
    PG8_STAGE(PG8_SB(1, 0), cB + kstep, voffB); PG8_STAGE_A(PG8_SA(1, 0), cA + kstep, 0); PG8_STAGE(PG8_SB(1, 1), cB + hstep + kstep, voffB);
    PG8_WAIT_V(6); PG8_BAR;
    for (;;) {
        const char* nA = has_next ? S.a_ptr(nxt) : cA; const char* nB = has_next ? S.b_ptr(nxt) : cB;
        S.meta(cur, lds + (LDS_META - 0) + (ui & 1) * 4096, wid, lane);
#define PG8_TRIP(WARM, t) do { \
            const bool last = ((t) == nt - 2); \
            const char* a1 = cA + (size_t)((t) + 1) * kstep; \
            const char* a2 = last ? nA : cA + (size_t)((t) + 2) * kstep; const char* b2 = last ? nB : cB + (size_t)((t) + 2) * kstep; \
            const char* a3 = a2 + kstep; const char* b3 = b2 + kstep; \
              \
            PG8_LDB(B0, 0, 0); PG8_LDB(B1, 0, 1); PG8_SCHED; PG8_LDA(At, 0, 0); if constexpr (!(WARM)) { PG8_STAGE_A(PG8_SA(1, 1), a1, 1); } \
            if constexpr (GATHER) { if (last) { _Pragma("unroll") for (int h = 0; h < 2; ++h) _Pragma("unroll") for (int i = 0; i < 2; ++i) gC[h][i] = gN[h][i]; } } \
            if constexpr (!(WARM)) { PG8_WAIT_V(8); } PG8_WAIT_L(0); PG8_BAR; PG8_MMA(0, 0, At, B0); PG8_MMA(0, 1, At, B1); PG8_BAR; PG8_SCHED; \
              \
            PG8_LDA(At, 0, 1); PG8_STAGE(PG8_SB(0, 0), b2, voffB); PG8_STAGE(PG8_SB(0, 1), b2 + hstep, voffB); PG8_STAGE_A(PG8_SA(0, 0), a2, 0); \
            if constexpr (!(WARM)) { PG8_WAIT_V(8); } PG8_WAIT_L(0); PG8_BAR; PG8_MMA(1, 0, At, B0); PG8_MMA(1, 1, At, B1); PG8_BAR; PG8_SCHED; \
              \
            PG8_LDB(B0, 1, 0); PG8_LDB(B1, 1, 1); PG8_SCHED; PG8_LDA(At, 1, 0); PG8_STAGE_A(PG8_SA(0, 1), a2, 1); \
            if constexpr (!(WARM)) { PG8_WAIT_V(8); } PG8_WAIT_L(0); PG8_BAR; PG8_MMA(0, 0, At, B0); PG8_MMA(0, 1, At, B1); PG8_BAR; PG8_SCHED; \
              \
            PG8_LDA(At, 1, 1); PG8_STAGE(PG8_SB(1, 0), b3, voffB); PG8_STAGE(PG8_SB(1, 1), b3 + hstep, voffB); PG8_STAGE_A(PG8_SA(1, 0), a3, 0); \
            PG8_WAIT_V(8); PG8_WAIT_L(0); PG8_BAR; PG8_MMA(1, 0, At, B0); PG8_MMA(1, 1, At, B1); PG8_BAR; PG8_SCHED; \
        } while (0)
        int t0_ = 0;
        if constexpr (WARMTRIP) { if (ui > 0) { PG8_TRIP(true, 0); t0_ = 2; } }
        for (int t = t0_; t < nt; t += 2) { PG8_TRIP(false, t); }
#undef PG8_TRIP
        if (wr == 0) PG8_BAR;
        if constexpr (WARMTRIP) { PG8_STAGE_A(PG8_SA(1, 1), nA + kstep, 1); }
        bool has_nn = false;
        if constexpr (GATHER) { if (has_next) { has_nn = S.next(ui + 2, nn); if (has_nn) { PG8_GOFF(gN, nn); } } }
        else { if (has_next) has_nn = S.next(ui + 2, nn); }
        { int fr_ = fr, fq_ = fq; asm volatile("" : "+v"(fr_), "+v"(fq_));
          const LAS unsigned char* mt = lds + LDS_META + (ui & 1) * 4096;
          if constexpr (WARMTRIP) {
              E.pre(acc, cur, wr, wc, fr_, fq_, mt);
              if constexpr (GATHER) asm volatile("" : "+v"(gN[0][0]), "+v"(gN[0][1]), "+v"(gN[1][0]), "+v"(gN[1][1]));
              PG8_WAIT_V(0);
              E.post(acc, cur, wr, wc, fr_, fq_, mt);
          } else { E.run(acc, cur, wr, wc, fr_, fq_, mt); } }
        if (!has_next) break;
#pragma unroll
        for (int a = 0; a < 2; ++a)
#pragma unroll
            for (int b = 0; b < 2; ++b)
#pragma unroll
                for (int m = 0; m < 4; ++m)
#pragma unroll
                    for (int n = 0; n < 2; ++n) acc[a][b][m][n] = (f32x4){0.f, 0.f, 0.f, 0.f};
        cur = nxt; cA = nA; cB = nB; ++ui; nxt = nn; has_next = has_nn;
        if (wr == 1) PG8_BAR;
    }
    PG8_WAIT_V(0);
    PG8_BAR;
#undef PG8_SA
#undef PG8_SB
#undef PG8_STAGE
#undef PG8_STAGE_A
#undef PG8_LDA
#undef PG8_LDB
#undef PG8_MMA
#undef PG8_LD16
#undef PG8_CAT
#undef PG8_WAIT_V
#undef PG8_WAIT_L
#undef PG8_BAR
#undef PG8_SCHED
#undef PG8_GOFF
}
}

using pg8::Unit; using pg8::cvt_pk_bf16;
constexpr int BM = 256, HALF = 128;

typedef f32x4 (&AccRef)[2][2][4][2];
__device__ __forceinline__ void pack8_bf16(f32x4& lo, const f32x4& hi) {
    const unsigned w0 = cvt_pk_bf16(lo[0], lo[1]), w1 = cvt_pk_bf16(lo[2], lo[3]), w2 = cvt_pk_bf16(hi[0], hi[1]), w3 = cvt_pk_bf16(hi[2], hi[3]);
    lo[0] = __builtin_bit_cast(float, w0); lo[1] = __builtin_bit_cast(float, w1); lo[2] = __builtin_bit_cast(float, w2); lo[3] = __builtin_bit_cast(float, w3);
}
#define AS_U4(v) __builtin_bit_cast(u32x4, v)

struct EpiInProj {
    static constexpr bool PERM = true;
    const float* rs1; const f32x2* rope; const float* glu_b;
    bf16_t *q, *k, *v, *qi, *ki, *hglu; float* wi;
    __device__ __forceinline__ void pre(AccRef acc, const Unit& u, int wr, int wc, int fr, int fq, const LAS unsigned char* mt) const {
        const int row0 = u.pm * BM + wr * 64 + fr;
        if (u.pn >= 4) {
            const int ch = 128 * (u.pn - 4) + 32 * wc + 8 * fq;
            f32x4 ba[2], bg[2];
#pragma unroll
            for (int n = 0; n < 2; ++n) { ba[n] = *(const f32x4*)(glu_b + ch + 4 * n); bg[n] = *(const f32x4*)(glu_b + 512 + ch + 4 * n); }
#pragma unroll
            for (int ai = 0; ai < 2; ++ai)
#pragma unroll
                for (int m = 0; m < 4; ++m) { const float rs = rs1[row0 + ai * HALF + m * 16];
#pragma unroll
                    for (int n = 0; n < 2; ++n)
#pragma unroll
                        for (int e = 0; e < 4; ++e) { const float a = acc[ai][0][m][n][e] * rs + ba[n][e], g = acc[ai][1][m][n][e] * rs + bg[n][e]; acc[ai][0][m][n][e] = a * sigmoidf_(g); }
                    pack8_bf16(acc[ai][0][m][0], acc[ai][0][m][1]); }
            return;
        }
        const bool do_rope = !(u.pn == 3 && wc >= 2), is_wi = (u.pn == 3 && wc == 3);
        const int d0 = 8 * fq;
#pragma unroll
        for (int ai = 0; ai < 2; ++ai)
#pragma unroll
            for (int m = 0; m < 4; ++m) { const int row = row0 + ai * HALF + m * 16; const float rs = rs1[row];
                if (do_rope) {
                    const f32x2* rp = rope + (size_t)(row & (SEQ - 1)) * 32 + d0;
#pragma unroll
                    for (int n = 0; n < 2; ++n)
#pragma unroll
                        for (int e = 0; e < 4; ++e) { const f32x2 cs = rp[4 * n + e]; const float x1 = acc[ai][0][m][n][e] * rs, x2 = acc[ai][1][m][n][e] * rs;
                            acc[ai][0][m][n][e] = x1 * cs.x - x2 * cs.y; acc[ai][1][m][n][e] = x2 * cs.x + x1 * cs.y; }
                } else {
#pragma unroll
                    for (int n = 0; n < 2; ++n) { acc[ai][0][m][n] = acc[ai][0][m][n] * rs; acc[ai][1][m][n] = acc[ai][1][m][n] * rs; }
                }
                if (!is_wi) { pack8_bf16(acc[ai][0][m][0], acc[ai][0][m][1]); pack8_bf16(acc[ai][1][m][0], acc[ai][1][m][1]); }
                if (m & 1) __builtin_amdgcn_sched_barrier(0); }
    }
    __device__ __forceinline__ void post(AccRef acc, const Unit& u, int wr, int wc, int fr, int fq, const LAS unsigned char* mt) const {
        const int row0 = u.pm * BM + wr * 64 + fr;
        if (u.pn >= 4) {
            const int ch = 128 * (u.pn - 4) + 32 * wc + 8 * fq;
#pragma unroll
            for (int ai = 0; ai < 2; ++ai)
#pragma unroll
                for (int m = 0; m < 4; ++m) *(u32x4*)(hglu + (size_t)(row0 + ai * HALF + m * 16) * 512 + ch) = AS_U4(acc[ai][0][m][0]);
            return;
        }
        bf16_t* dst; int ld, col; bool is_wi = false;
        if (u.pn < 2) { dst = q; ld = 512; col = (4 * u.pn + wc) * 64; }
        else if (u.pn == 2) { dst = qi; ld = 256; col = wc * 64; }
        else { ld = 64; col = 0; if (wc == 0) dst = k; else if (wc == 1) dst = ki; else if (wc == 2) dst = v; else { dst = v; is_wi = true; } }
        if (is_wi) {
            if (fq == 0) {
#pragma unroll
                for (int ai = 0; ai < 2; ++ai)
#pragma unroll
                    for (int m = 0; m < 4; ++m) *(f32x4*)(wi + (size_t)(row0 + ai * HALF + m * 16) * 4) = acc[ai][0][m][0];
            }
            return;
        }
#pragma unroll
        for (int ai = 0; ai < 2; ++ai)
#pragma unroll
            for (int m = 0; m < 4; ++m) { bf16_t* rp2 = dst + (size_t)(row0 + ai * HALF + m * 16) * ld + col + 8 * fq;
                *(u32x4*)(rp2) = AS_U4(acc[ai][0][m][0]); *(u32x4*)(rp2 + 32) = AS_U4(acc[ai][1][m][0]); }
    }
    __device__ __forceinline__ void run(const f32x4 (&acc)[2][2][4][2], const Unit& u, int wr, int wc, int fr, int fq, const LAS unsigned char* mt) const {
        const int row0 = u.pm * BM + wr * 64 + fr;
        if (u.pn >= 4) {
            const int ch = 128 * (u.pn - 4) + 32 * wc + 8 * fq;
            f32x4 ba[2], bg[2];
#pragma unroll
            for (int n = 0; n < 2; ++n) { ba[n] = *(const f32x4*)(glu_b + ch + 4 * n); bg[n] = *(const f32x4*)(glu_b + 512 + ch + 4 * n); }
#pragma unroll
            for (int ai = 0; ai < 2; ++ai)
#pragma unroll
                for (int m = 0; m < 4; ++m) { const int row = row0 + ai * HALF + m * 16; const float rs = rs1[row];
                    float o[8];
#pragma unroll
                    for (int n = 0; n < 2; ++n)
#pragma unroll
                        for (int e = 0; e < 4; ++e) { const float a = acc[ai][0][m][n][e] * rs + ba[n][e], g = acc[ai][1][m][n][e] * rs + bg[n][e]; o[4 * n + e] = a * sigmoidf_(g); }
                    u32x4 w; w.x = cvt_pk_bf16(o[0], o[1]); w.y = cvt_pk_bf16(o[2], o[3]); w.z = cvt_pk_bf16(o[4], o[5]); w.w = cvt_pk_bf16(o[6], o[7]);
                    *(u32x4*)(hglu + (size_t)row * 512 + ch) = w; }
            return;
        }
        bf16_t* dst; int ld, col; bool do_rope = true, is_wi = false;
        if (u.pn < 2) { dst = q; ld = 512; col = (4 * u.pn + wc) * 64; }
        else if (u.pn == 2) { dst = qi; ld = 256; col = wc * 64; }
        else { ld = 64; col = 0; if (wc == 0) dst = k; else if (wc == 1) dst = ki; else if (wc == 2) { dst = v; do_rope = false; } else { dst = v; is_wi = true; do_rope = false; } }
        if (is_wi) {
            if (fq == 0) {
#pragma unroll
                for (int ai = 0; ai < 2; ++ai)
#pragma unroll
                    for (int m = 0; m < 4; ++m) { const int row = row0 + ai * HALF + m * 16; const float rs = rs1[row];
                        *(f32x4*)(wi + (size_t)row * 4) = acc[ai][0][m][0] * rs; }
            }
            return;
        }
        const int d0 = 8 * fq;
#pragma unroll
        for (int ai = 0; ai < 2; ++ai)
#pragma unroll
            for (int m = 0; m < 4; ++m) { const int row = row0 + ai * HALF + m * 16; const float rs = rs1[row];
                float o1[8], o2[8];
                if (do_rope) {
                    const f32x2* rp = rope + (size_t)(row & (SEQ - 1)) * 32 + d0;
#pragma unroll
                    for (int n = 0; n < 2; ++n)
#pragma unroll
                        for (int e = 0; e < 4; ++e) { const f32x2 cs = rp[4 * n + e]; const float x1 = acc[ai][0][m][n][e] * rs, x2 = acc[ai][1][m][n][e] * rs;
                            o1[4 * n + e] = x1 * cs.x - x2 * cs.y; o2[4 * n + e] = x2 * cs.x + x1 * cs.y; }
                } else {
#pragma unroll
                    for (int n = 0; n < 2; ++n)
#pragma unroll
                        for (int e = 0; e < 4; ++e) { o1[4 * n + e] = acc[ai][0][m][n][e] * rs; o2[4 * n + e] = acc[ai][1][m][n][e] * rs; }
                }
                u32x4 w1, w2; w1.x = cvt_pk_bf16(o1[0], o1[1]); w1.y = cvt_pk_bf16(o1[2], o1[3]); w1.z = cvt_pk_bf16(o1[4], o1[5]); w1.w = cvt_pk_bf16(o1[6], o1[7]);
                w2.x = cvt_pk_bf16(o2[0], o2[1]); w2.y = cvt_pk_bf16(o2[2], o2[3]); w2.z = cvt_pk_bf16(o2[4], o2[5]); w2.w = cvt_pk_bf16(o2[6], o2[7]);
                bf16_t* rp2 = dst + (size_t)row * ld + col + d0;
                *(u32x4*)(rp2) = w1; *(u32x4*)(rp2 + 32) = w2; }
    }
};

struct EpiBf16Plain {
    static constexpr bool PERM = true;
    bf16_t* O; int ldc;
    __device__ __forceinline__ void pre(AccRef acc, const Unit&, int, int, int, int, const LAS unsigned char*) const {
#pragma unroll
        for (int ai = 0; ai < 2; ++ai)
#pragma unroll
            for (int bj = 0; bj < 2; ++bj)
#pragma unroll
                for (int m = 0; m < 4; ++m) pack8_bf16(acc[ai][bj][m][0], acc[ai][bj][m][1]);
    }
    __device__ __forceinline__ void post(AccRef acc, const Unit& u, int wr, int wc, int fr, int fq, const LAS unsigned char* mt) const {
        const int row0 = u.pm * BM + wr * 64 + fr, col0 = u.pn * BM + wc * 32 + 8 * fq;
#pragma unroll
        for (int ai = 0; ai < 2; ++ai)
#pragma unroll
            for (int m = 0; m < 4; ++m) { bf16_t* rowp = O + (size_t)(row0 + ai * HALF + m * 16) * ldc + col0;
#pragma unroll
                for (int bj = 0; bj < 2; ++bj) *(u32x4*)(rowp + bj * HALF) = AS_U4(acc[ai][bj][m][0]); }
    }
    __device__ __forceinline__ void run(const f32x4 (&acc)[2][2][4][2], const Unit& u, int wr, int wc, int fr, int fq, const LAS unsigned char* mt) const {
        const int row0 = u.pm * BM + wr * 64 + fr, col0 = u.pn * BM + wc * 32 + 8 * fq;
#pragma unroll
        for (int ai = 0; ai < 2; ++ai)
#pragma unroll
            for (int m = 0; m < 4; ++m) { bf16_t* rowp = O + (size_t)(row0 + ai * HALF + m * 16) * ldc + col0;
#pragma unroll
                for (int bj = 0; bj < 2; ++bj) { const f32x4 v0 = acc[ai][bj][m][0], v1 = acc[ai][bj][m][1];
                    u32x4 w; w.x = cvt_pk_bf16(v0[0], v0[1]); w.y = cvt_pk_bf16(v0[2], v0[3]); w.z = cvt_pk_bf16(v1[0], v1[1]); w.w = cvt_pk_bf16(v1[2], v1[3]);
                    *(u32x4*)(rowp + bj * HALF) = w; } }
    }
};

struct EpiOutProj {
    static constexpr bool PERM = false;
    const float* x; float* h1; unsigned char* h1f8;
    __device__ __forceinline__ void pre(AccRef acc, const Unit& u, int wr, int wc, int fr, int fq, const LAS unsigned char* mt) const {
        const int row0 = u.pm * BM + wr * 64 + fr, col0 = u.pn * BM + wc * 32 + 4 * fq;
#pragma unroll
        for (int ai = 0; ai < 2; ++ai)
#pragma unroll
            for (int m = 0; m < 4; ++m) { const size_t off = (size_t)(row0 + ai * HALF + m * 16) * DM + col0;
#pragma unroll
                for (int bj = 0; bj < 2; ++bj)
#pragma unroll
                    for (int n = 0; n < 2; ++n) acc[ai][bj][m][n] += *(const f32x4*)(x + off + bj * HALF + n * 16);
                if (m & 1) __builtin_amdgcn_sched_barrier(0); }
    }
    __device__ __forceinline__ void post(AccRef acc, const Unit& u, int wr, int wc, int fr, int fq, const LAS unsigned char* mt) const {
        const int row0 = u.pm * BM + wr * 64 + fr, col0 = u.pn * BM + wc * 32 + 4 * fq;
#pragma unroll
        for (int ai = 0; ai < 2; ++ai)
#pragma unroll
            for (int m = 0; m < 4; ++m) { const size_t off = (size_t)(row0 + ai * HALF + m * 16) * DM + col0;
#pragma unroll
                for (int bj = 0; bj < 2; ++bj)
#pragma unroll
                    for (int n = 0; n < 2; ++n) { const size_t o = off + bj * HALF + n * 16; const f32x4 r = acc[ai][bj][m][n];
                        *(f32x4*)(h1 + o) = r; *(unsigned*)(h1f8 + o) = pk4_fp8(r[0], r[1], r[2], r[3]); } }
    }
    __device__ __forceinline__ void run(AccRef acc, const Unit& u, int wr, int wc, int fr, int fq, const LAS unsigned char* mt) const { pre(acc, u, wr, wc, fr, fq, mt); post(acc, u, wr, wc, fr, fq, mt); }
};

struct EpiUp {
    static constexpr bool PERM = true;
    unsigned char* act;
    __device__ __forceinline__ void pre(AccRef acc, const Unit& u, int wr, int wc, int fr, int fq, const LAS unsigned char* mt) const {
        const int r0 = wr * 64 + fr, cl = 32 * wc + 8 * fq;
        const LAS float* rowA = (const LAS float*)mt; const LAS float* bias = (const LAS float*)(mt + 2048);
        f32x4 bg[2], bl[2];
#pragma unroll
        for (int n = 0; n < 2; ++n) { bg[n] = *(const LAS f32x4*)(bias + cl + 4 * n); bl[n] = *(const LAS f32x4*)(bias + 128 + cl + 4 * n); }
#pragma unroll
        for (int ai = 0; ai < 2; ++ai)
#pragma unroll
            for (int m = 0; m < 4; ++m) { const int r = r0 + ai * HALF + m * 16;
                const float rs = (r < u.rows) ? rowA[r] * 0.03125f : 0.f;
#pragma unroll
                for (int n = 0; n < 2; ++n)
#pragma unroll
                    for (int e = 0; e < 4; ++e) { float g = acc[ai][0][m][n][e] * rs + bg[n][e], l = acc[ai][1][m][n][e] * rs + bl[n][e];
                        g = fminf(g, 7.0f); l = fminf(fmaxf(l, -7.0f), 7.0f); acc[ai][0][m][n][e] = g * sigmoidf_(1.702f * g) * (l + 1.0f); } }
    }
    __device__ __forceinline__ void post(AccRef acc, const Unit& u, int wr, int wc, int fr, int fq, const LAS unsigned char* mt) const {
        const int r0 = wr * 64 + fr, ch = 128 * u.pn + 32 * wc + 8 * fq;
#pragma unroll
        for (int ai = 0; ai < 2; ++ai)
#pragma unroll
            for (int m = 0; m < 4; ++m) { const int r = r0 + ai * HALF + m * 16;
                const f32x4 v0 = acc[ai][0][m][0], v1 = acc[ai][0][m][1];
                u32x2 w; w.x = pk4_fp8(v0[0], v0[1], v0[2], v0[3]); w.y = pk4_fp8(v1[0], v1[1], v1[2], v1[3]);
                *(u32x2*)(act + (size_t)(u.pm * BM + r) * 1024 + ch) = w; }
    }
    __device__ __forceinline__ void run(const f32x4 (&acc)[2][2][4][2], const Unit& u, int wr, int wc, int fr, int fq, const LAS unsigned char* mt) const {
        const int r0 = wr * 64 + fr, cl = 32 * wc + 8 * fq, ch = 128 * u.pn + cl;
        const LAS float* rowA = (const LAS float*)mt; const LAS float* bias = (const LAS float*)(mt + 2048);
        f32x4 bg[2], bl[2];
#pragma unroll
        for (int n = 0; n < 2; ++n) { bg[n] = *(const LAS f32x4*)(bias + cl + 4 * n); bl[n] = *(const LAS f32x4*)(bias + 128 + cl + 4 * n); }
#pragma unroll
        for (int ai = 0; ai < 2; ++ai)
#pragma unroll
            for (int m = 0; m < 4; ++m) { const int r = r0 + ai * HALF + m * 16;
                const float rs = (r < u.rows) ? rowA[r] * 0.03125f : 0.f;
                float o[8];
#pragma unroll
                for (int n = 0; n < 2; ++n)
#pragma unroll
                    for (int e = 0; e < 4; ++e) { float g = acc[ai][0][m][n][e] * rs + bg[n][e], l = acc[ai][1][m][n][e] * rs + bl[n][e];
                        g = fminf(g, 7.0f); l = fminf(fmaxf(l, -7.0f), 7.0f); o[4 * n + e] = g * sigmoidf_(1.702f * g) * (l + 1.0f); }
                u32x2 w; w.x = pk4_fp8(o[0], o[1], o[2], o[3]); w.y = pk4_fp8(o[4], o[5], o[6], o[7]);
                *(u32x2*)(act + (size_t)(u.pm * BM + r) * 1024 + ch) = w; }
    }
};

struct EpiDown {
    static constexpr bool PERM = true;
    bf16_t* y;
    __device__ __forceinline__ void pre(AccRef acc, const Unit& u, int wr, int wc, int fr, int fq, const LAS unsigned char* mt) const {
        const int r0 = wr * 64 + fr, cl = wc * 32 + 8 * fq;
        const LAS float* gateT = (const LAS float*)(mt + 1024); const LAS float* bias = (const LAS float*)(mt + 2048);
        float gt[2][4];
#pragma unroll
        for (int ai = 0; ai < 2; ++ai)
#pragma unroll
            for (int m = 0; m < 4; ++m) gt[ai][m] = gateT[r0 + ai * HALF + m * 16];
#pragma unroll
        for (int bj = 0; bj < 2; ++bj) { const f32x4 bv0 = *(const LAS f32x4*)(bias + cl + bj * HALF), bv1 = *(const LAS f32x4*)(bias + cl + bj * HALF + 4);
#pragma unroll
            for (int ai = 0; ai < 2; ++ai)
#pragma unroll
                for (int m = 0; m < 4; ++m) { acc[ai][bj][m][0] = (acc[ai][bj][m][0] * 0.03125f + bv0) * gt[ai][m]; acc[ai][bj][m][1] = (acc[ai][bj][m][1] * 0.03125f + bv1) * gt[ai][m];
                    pack8_bf16(acc[ai][bj][m][0], acc[ai][bj][m][1]); } }
    }
    __device__ __forceinline__ void post(AccRef acc, const Unit& u, int wr, int wc, int fr, int fq, const LAS unsigned char* mt) const {
        const int r0 = wr * 64 + fr, col0 = u.pn * BM + wc * 32 + 8 * fq;
        const LAS int* slotT = (const LAS int*)mt;
#pragma unroll
        for (int ai = 0; ai < 2; ++ai)
#pragma unroll
            for (int m = 0; m < 4; ++m) { const int r = r0 + ai * HALF + m * 16;
                if (r < u.rows) { bf16_t* rowp = y + (size_t)slotT[r] * 1024 + col0;
#pragma unroll
                    for (int bj = 0; bj < 2; ++bj) *(u32x4*)(rowp + bj * HALF) = AS_U4(acc[ai][bj][m][0]); } }
    }
    __device__ __forceinline__ void run(AccRef acc, const Unit& u, int wr, int wc, int fr, int fq, const LAS unsigned char* mt) const { pre(acc, u, wr, wc, fr, fq, mt); post(acc, u, wr, wc, fr, fq, mt); }
};

template <bool F8>
__device__ __forceinline__ void p0_transpose_item(const float* W, int ldw, void* WTv, int Kdim, const float* gain, LAS float* scr, int kb, int n0, int src0, int nvalid, int lane) {
    bf16_t* WT = (bf16_t*)WTv;
    const int k0 = 64 * kb;
    f32x4 ld4[8];
#pragma unroll
    for (int i = 0; i < 8; ++i) { const int kk = 8 * i + (lane >> 3), j = (lane & 7) * 4;
        ld4[i] = (f32x4){0.f, 0.f, 0.f, 0.f}; if (j < nvalid) ld4[i] = *(const f32x4*)(W + (size_t)(k0 + kk) * ldw + src0 + j); }
#pragma unroll
    for (int i = 0; i < 8; ++i) { const int kk = 8 * i + (lane >> 3), j = (lane & 7) * 4; const float gk = (gain ? gain[k0 + kk] : 1.0f) * (F8 ? 32.0f : 1.0f);
        LAS float* d = scr + kk * 33 + j; d[0] = ld4[i].x * gk; d[1] = ld4[i].y * gk; d[2] = ld4[i].z * gk; d[3] = ld4[i].w * gk; }
    LDS_WAIT(); asm volatile("" ::: "memory");
    const int c = lane & 7;
#pragma unroll
    for (int j = 0; j < 4; ++j) { const int n = (lane >> 3) + 8 * j; const LAS float* s = scr + (8 * c) * 33 + n;
        if constexpr (F8) { u32x2 o; o.x = pk4_fp8(s[0 * 33], s[1 * 33], s[2 * 33], s[3 * 33]); o.y = pk4_fp8(s[4 * 33], s[5 * 33], s[6 * 33], s[7 * 33]);
            *(u32x2*)((unsigned char*)WTv + (size_t)(n0 + n) * Kdim + k0 + 8 * c) = o; }
        else { u32x4 o; o.x = pk2(s[0 * 33], s[1 * 33]); o.y = pk2(s[2 * 33], s[3 * 33]); o.z = pk2(s[4 * 33], s[5 * 33]); o.w = pk2(s[6 * 33], s[7 * 33]);
            *(u32x4*)(WT + (size_t)(n0 + n) * Kdim + k0 + 8 * c) = o; } }
    LDS_WAIT(); asm volatile("" ::: "memory");
}
__device__ __forceinline__ void win_colmap(int nb, int& src0, int& nvalid) {
    const int pn = nb >> 3, j = (nb & 7) * 32, bj = j >> 7, slot = (j & 127) >> 5;
    nvalid = 32;
    if (pn < 2) src0 = (4 * pn + slot) * 64 + 32 * bj;
    else if (pn == 2) src0 = 640 + slot * 64 + 32 * bj;
    else if (pn == 3) { if (slot == 0) src0 = 512 + 32 * bj; else if (slot == 1) src0 = 896 + 32 * bj; else if (slot == 2) src0 = 576 + 32 * bj; else { src0 = 960; nvalid = bj == 0 ? 4 : 0; } }
    else src0 = 964 + 512 * bj + 128 * (pn - 4) + 32 * slot;
}
__device__ __forceinline__ void p0_prologue(const Params& P, LAS unsigned char* lds, int vcu, int G, int wave, int lane) {
    unsigned char* ws = P.ws;
    LAS float* scr = (LAS float*)(lds + wave * 16384);
    const int gw = vcu * NWAVES + wave, NGW = G * NWAVES;
    constexpr int I_IN = 16 * 64, I_OUT = 16 * 32, I_G = 16 * 32, I_P = 4 * 32, I_UP = 32 * 16 * 64, I_DN = 32 * 16 * 32;
    constexpr int NITEMS = I_IN + I_OUT + I_G + I_P + I_UP + I_DN;
    for (int it = gw; it < NITEMS; it += NGW) {
        int r = it;
        if (r < I_IN) { const int kb = r / 64, nb = r % 64; int s0, nv; win_colmap(nb, s0, nv); p0_transpose_item<false>(P.w_in, INW, (bf16_t*)(ws + WS_WIN), 1024, P.g_mix, scr, kb, nb * 32, s0, nv, lane); continue; } r -= I_IN;
        if (r < I_OUT) { const int kb = r / 32, nb = r % 32; p0_transpose_item<false>(P.w_out, 1024, (bf16_t*)(ws + WS_WOUT), 1024, nullptr, scr, kb, nb * 32, nb * 32, 32, lane); continue; } r -= I_OUT;
        if (r < I_G) { const int kb = r / 32, nb = r % 32; p0_transpose_item<false>(P.w_ple_gate, 1024, (bf16_t*)(ws + WS_WG), 1024, P.g_ple, scr, kb, nb * 32, nb * 32, 32, lane); continue; } r -= I_G;
        if (r < I_P) { const int kb = r / 32, nb = r % 32; p0_transpose_item<false>(P.w_ple_proj, 1024, (bf16_t*)(ws + WS_WP), 256, nullptr, scr, kb, nb * 32, nb * 32, 32, lane); continue; } r -= I_P;
        if (r < I_UP) { const int e = r / 1024, rr = r % 1024, kb = rr / 64, nb = rr % 64;
            const int pn = nb >> 3, j = (nb & 7) * 32, bj = j >> 7, jj = j & 127;
            p0_transpose_item<true>(P.w_up + (size_t)e * 1024 * 2048, 2048, (unsigned char*)(ws + WS_WUP) + (size_t)e * 2048 * 1024, 1024, P.g_ffn, scr, kb, nb * 32, 1024 * bj + 128 * pn + jj, 32, lane); continue; } r -= I_UP;
        { const int e = r / 512, rr = r % 512, kb = rr / 32, nb = rr % 32;
            p0_transpose_item<true>(P.w_down + (size_t)e * 1024 * 1024, 1024, (unsigned char*)(ws + WS_WDOWN) + (size_t)e * 1024 * 1024, 1024, nullptr, scr, kb, nb * 32, nb * 32, 32, lane); }
    }
    float* rs1 = (float*)(ws + WS_RS1); bf16_t* xb = (bf16_t*)(ws + WS_XB);
    for (int m = gw; m < NTOK; m += NGW) {
        const f32x4* xr = (const f32x4*)(P.x + (size_t)m * DM) + lane; f32x4 v[4]; float s = 0.f;
#pragma unroll
        for (int j = 0; j < 4; ++j) { v[j] = xr[64 * j]; s += (v[j].x * v[j].x + v[j].y * v[j].y) + (v[j].z * v[j].z + v[j].w * v[j].w); }
        s = wave_sum(s);
        u32x2* o8 = (u32x2*)(xb + (size_t)m * DM) + lane;
#pragma unroll
        for (int j = 0; j < 4; ++j) { u32x2 w; w.x = pk2(v[j].x, v[j].y); w.y = pk2(v[j].z, v[j].w); o8[64 * j] = w; }
        if (lane == 0) rs1[m] = 1.0f / sqrtf(s * (1.0f / DM) + EPS);
    }
    bf16_t* pb = (bf16_t*)(ws + WS_PB);
    for (int m = gw; m < NTOK; m += NGW) { const f32x4 v = *((const f32x4*)(P.p + (size_t)m * 256) + lane); u32x2 w; w.x = pk2(v.x, v.y); w.y = pk2(v.z, v.w); *((u32x2*)(pb + (size_t)m * 256) + lane) = w; }
    f32x2* rope = (f32x2*)(ws + WS_ROPE);
    for (int idx = gw * 64 + lane; idx < SEQ * 32; idx += NGW * 64) { const int t = idx >> 5, i = idx & 31;
        const float inv = exp2f(-(float)i * (13.287712379549449f / 32.0f));
        const float ang = (float)t * inv;
        const double rev = (double)ang * 0.15915494309189535; const float fr = (float)(rev - __builtin_floor(rev));
        rope[idx] = (f32x2){__builtin_amdgcn_cosf(fr), __builtin_amdgcn_sinf(fr)}; }
    float* wrg = (float*)(ws + WS_WRG);
    for (int idx = gw * 64 + lane; idx < 1024 * 32; idx += NGW * 64) wrg[idx] = P.w_router[idx] * P.g_ffn[idx >> 5];
}

__device__ __forceinline__ unsigned fkey(float f) { unsigned u = __builtin_bit_cast(unsigned, f); if (u == 0x80000000u) u = 0u; return u ^ ((unsigned)((int)u >> 31) | 0x80000000u); }
__device__ __forceinline__ int mbcnt64(unsigned long long m) { return __builtin_amdgcn_mbcnt_hi((unsigned)(m >> 32), __builtin_amdgcn_mbcnt_lo((unsigned)m, 0u)); }

template <int NR>
__device__ __forceinline__ unsigned bisect_thr(const unsigned (&v)[NR], unsigned prefix, int startbit) {
    bool exact = false;
#pragma unroll 1
    for (int bit = startbit; bit >= 0; --bit) {
        const unsigned cand = prefix | (1u << bit); int cnt = 0;
#pragma unroll
        for (int r = 0; r < NR; ++r) { cnt += __builtin_popcountll(__ballot(v[r] >= cand)); if ((r & 7) == 7) __builtin_amdgcn_sched_barrier(0); }
        if (cnt >= NSEL) prefix = cand;
        if (cnt == NSEL) { exact = true; break; }
    }
    return exact ? prefix - 1u : prefix;
}
template <int NR, bool EXPL>
__device__ __forceinline__ void compact_sel(const unsigned (&v)[NR], const unsigned (&ci)[NR], unsigned T, LAS unsigned* list, int lane) {
    int cgt = 0;
#pragma unroll
    for (int r = 0; r < NR; ++r) { cgt += __builtin_popcountll(__ballot(v[r] > T)); if ((r & 7) == 7) __builtin_amdgcn_sched_barrier(0); }
    const int need = NSEL - cgt; int base = 0, ties = 0;
#pragma unroll
    for (int r = 0; r < NR; ++r) { const bool gt = v[r] > T, eq = v[r] == T; const unsigned long long em = __ballot(eq);
        const bool sel = gt || (eq && (ties + mbcnt64(em)) < need); const unsigned long long sm = __ballot(sel);
        list[sel ? base + mbcnt64(sm) : NSEL + lane] = EXPL ? ci[r] : (unsigned)(r * 64 + lane);
        base += __builtin_popcountll(sm); ties += __builtin_popcountll(em);
        if ((r & 3) == 3) __builtin_amdgcn_sched_barrier(0); }
}
constexpr int SEL_CAP = 1024;
template <int NR>
__device__ __forceinline__ void select_topk(LAS float* row, LAS unsigned* H, LAS unsigned* list, int lane, bool zero_h) {
    unsigned v[NR];
#pragma unroll
    for (int r = 0; r < NR; ++r) v[r] = fkey(row[r * 64 + lane]);
    LAS u32x4* H4 = (LAS u32x4*)H;
    const u32x4 h0 = H4[2 * lane], h1 = H4[2 * lane + 1];
    if (zero_h) { H4[2 * lane] = (u32x4){0u, 0u, 0u, 0u}; H4[2 * lane + 1] = (u32x4){0u, 0u, 0u, 0u}; }
    const unsigned hw[8] = {h0.x, h0.y, h0.z, h0.w, h1.x, h1.y, h1.z, h1.w};
    unsigned c[16];
#pragma unroll
    for (int i = 0; i < 8; ++i) { c[2 * i] = hw[i] & 0xffffu; c[2 * i + 1] = hw[i] >> 16; }
    unsigned s = 0u;
#pragma unroll
    for (int i = 0; i < 16; ++i) s += c[i];
    unsigned S = s;
#pragma unroll
    for (int off = 1; off < 64; off <<= 1) { const unsigned o = __shfl_down(S, off); if (lane + off < 64) S += o; }
    const unsigned long long okm = __ballot(S >= (unsigned)NSEL);
    bool fast = okm != 0ull; unsigned floorkey = 0u; int C = 0;
    if (fast) {
        const int Ls = 63 - __builtin_clzll(okm);
        unsigned acc = S - s; int bl = -1; unsigned accb = 0u;
#pragma unroll
        for (int b = 15; b >= 0; --b) { acc += c[b]; if (bl < 0 && acc >= (unsigned)NSEL) { bl = b; accb = acc; } }
        const int bstar = __shfl(bl, Ls) + 16 * Ls; C = (int)__shfl(accb, Ls);
        floorkey = (unsigned)bstar << 22;
        fast = (bstar > 1) && (C <= SEL_CAP);
    }
    if (!fast) {
        const unsigned T = bisect_thr<NR>(v, 0u, 31);
        compact_sel<NR, false>(v, v, T, list, lane);
        return;
    }
    LAS unsigned* ckl = (LAS unsigned*)row; LAS unsigned* cil = ckl + 1152;
    { int base = 0;
#pragma unroll
      for (int r = 0; r < NR; ++r) { const bool cnd = v[r] >= floorkey; const unsigned long long m = __ballot(cnd);
          const int pos = cnd ? base + mbcnt64(m) : SEL_CAP + lane;
          ckl[pos] = v[r]; cil[pos] = (unsigned)(r * 64 + lane); base += __builtin_popcountll(m);
          if ((r & 3) == 3) __builtin_amdgcn_sched_barrier(0); } }
    if (C <= 512) {
        unsigned ck[8], ci[8];
#pragma unroll
        for (int j = 0; j < 8; ++j) { const int i = j * 64 + lane; ck[j] = i < C ? ckl[i] : 0u; ci[j] = cil[i]; }
        const unsigned T = (C == NSEL) ? floorkey - 1u : bisect_thr<8>(ck, floorkey, 21);
        compact_sel<8, true>(ck, ci, T, list, lane);
    } else {
        unsigned ck[16], ci[16];
#pragma unroll
        for (int j = 0; j < 16; ++j) { const int i = j * 64 + lane; ck[j] = i < C ? ckl[i] : 0u; ci[j] = cil[i]; }
        const unsigned T = bisect_thr<16>(ck, floorkey, 21);
        compact_sel<16, true>(ck, ci, T, list, lane);
    }
}

typedef short v4i16 __attribute__((ext_vector_type(4)));
constexpr int VROW = 144;

__device__ __forceinline__ void attn_tile(const Params& P, LAS unsigned char* lds, int b, int t0, int wave, int lane) {
    unsigned char* ws = P.ws;
    const bf16_t* QI = (const bf16_t*)(ws + WS_QI); const bf16_t* KI = (const bf16_t*)(ws + WS_KI);
    const bf16_t* Q = (const bf16_t*)(ws + WS_Q); const bf16_t* Kp = (const bf16_t*)(ws + WS_K); const bf16_t* Vp = (const bf16_t*)(ws + WS_V);
    const float* WI = (const float*)(ws + WS_WI); bf16_t* MIX = (bf16_t*)(ws + WS_MIX);
    LAS float* SC = (LAS float*)lds;
    LAS unsigned* list = (LAS unsigned*)(lds + wave * 16384 + 14336);
    LAS unsigned* HIST = (LAS unsigned*)(lds + LDS_MISC);
    const int tokbase = b * SEQ;
    const bool need_sel = t0 >= 256;
    if (need_sel) {
        const int nkt = (t0 + 8 + 31) >> 5;
        bf16x8 a[4]; f32x4 w[4];
        { const bf16_t* src = QI + (size_t)(tokbase + t0 + ((lane & 31) >> 2)) * 256 + (lane & 3) * 64 + 8 * (lane >> 5);
#pragma unroll
          for (int ks = 0; ks < 4; ++ks) a[ks] = *(const bf16x8*)(src + 16 * ks); }
#pragma unroll
        for (int g = 0; g < 4; ++g) w[g] = *(const f32x4*)(WI + (size_t)(tokbase + t0 + 2 * g + (lane >> 5)) * 4);
        for (int kt0 = wave; kt0 < nkt; kt0 += 4 * NWAVES) {
            bf16x8 bf[4][4];
#pragma unroll
            for (int u = 0; u < 4; ++u) { const int kt = kt0 + u * NWAVES;
                if (kt < nkt) { const bf16_t* ksrc = KI + (size_t)(tokbase + kt * 32 + (lane & 31)) * 64 + 8 * (lane >> 5);
#pragma unroll
                    for (int ks = 0; ks < 4; ++ks) bf[u][ks] = *(const bf16x8*)(ksrc + 16 * ks); } }
#pragma unroll
            for (int u = 0; u < 4; ++u) { const int kt = kt0 + u * NWAVES;
                if (kt < nkt) {
                    const int key = kt * 32 + (lane & 31);
                    f32x16 acc;
#pragma unroll
                    for (int i = 0; i < 16; ++i) acc[i] = 0.f;
#pragma unroll
                    for (int ks = 0; ks < 4; ++ks) acc = __builtin_amdgcn_mfma_f32_32x32x16_bf16(a[ks], bf[u][ks], acc, 0, 0, 0);
#pragma unroll
                    for (int g = 0; g < 4; ++g) { float sc = 0.f;
#pragma unroll
                        for (int h = 0; h < 4; ++h) sc = fmaf(fmaxf(acc[4 * g + h], 0.f), w[g][h], sc);
                        const int ql = 2 * g + (lane >> 5);
                        if (key > t0 + ql) sc = -INFINITY;
                        SC[ql * 4096 + key] = sc;
                        if (key <= t0 + ql) { const unsigned ub = __builtin_bit_cast(unsigned, sc);
                            const unsigned bin = (ub >> 22) ^ (((unsigned)((int)ub >> 31) & 0x1ffu) | 0x200u);
                            __hip_atomic_fetch_add(HIST + ql * 512 + (bin >> 1), 1u << ((bin & 1u) << 4), __ATOMIC_RELAXED, __HIP_MEMORY_SCOPE_WORKGROUP); } }
                } }
        }
        { const int npad = ((t0 + 8 + 1023) >> 10) << 10;
          for (int i = nkt * 32 + (int)threadIdx.x; i < npad; i += NTHR) {
#pragma unroll
              for (int q = 0; q < 8; ++q) SC[q * 4096 + i] = -INFINITY; } }
    }
    __syncthreads();
    const int t = t0 + wave, tok = tokbase + t;
    if (need_sel) {
        LAS float* row = SC + wave * 4096; LAS unsigned* H = HIST + wave * 512; const int n = t + 1;
        if (n <= 1024) select_topk<16>(row, H, list, lane, true);
        else if (n <= 2048) select_topk<32>(row, H, list, lane, true);
        else if (n <= 3072) select_topk<48>(row, H, list, lane, true);
        else select_topk<64>(row, H, list, lane, true);
    } else {
#pragma unroll
        for (int i = 0; i < 4; ++i) list[i * 64 + lane] = (unsigned)(i * 64 + lane);
    }
    const int nvalid = need_sel ? NSEL : (t + 1);
    const int ngrp = (nvalid + 31) >> 5;
    const int hd = lane & 15, g = lane >> 4;
    bf16x8 qf0, qf1;
#pragma unroll
    for (int i = 0; i < 8; ++i) { qf0[i] = 0; qf1[i] = 0; }
    if (hd < 8) { const bf16_t* qs = Q + (size_t)tok * 512 + hd * 64 + 8 * g; qf0 = *(const bf16x8*)qs; qf1 = *(const bf16x8*)(qs + 32); }
    float m = -INFINITY, ssum = 0.f;
    f32x4 o[4];
#pragma unroll
    for (int dt = 0; dt < 4; ++dt) o[dt] = (f32x4){0.f, 0.f, 0.f, 0.f};
    LAS unsigned char* vreg = lds + wave * 16384;
    bf16x8 kfA[4], kfB[4]; u32x4 vvA[4], vvB[4];
#define ATT_LOAD(KF, VV, G_) do { const int nb_ = (G_) * 32; const unsigned ia_ = list[nb_ + hd], ib_ = list[nb_ + 16 + hd]; \
        const bf16_t* ka_ = Kp + (size_t)(tokbase + ia_) * 64 + 8 * g; const bf16_t* kb_ = Kp + (size_t)(tokbase + ib_) * 64 + 8 * g; \
        KF[0] = *(const bf16x8*)ka_; KF[1] = *(const bf16x8*)(ka_ + 32); KF[2] = *(const bf16x8*)kb_; KF[3] = *(const bf16x8*)(kb_ + 32); \
        _Pragma("unroll") for (int i_ = 0; i_ < 4; ++i_) { const unsigned idx_ = list[nb_ + (lane >> 3) + 8 * i_]; VV[i_] = *(const u32x4*)(Vp + (size_t)(tokbase + idx_) * 64 + 8 * (lane & 7)); } } while (0)
#define ATT_GROUP(KF, VV, G_, VBUF) do { \
        LAS unsigned char* vbuf_ = (VBUF); \
        f32x4 sa_ = {0.f, 0.f, 0.f, 0.f}, sb_ = {0.f, 0.f, 0.f, 0.f}; \
        sa_ = __builtin_amdgcn_mfma_f32_16x16x32_bf16(KF[0], qf0, sa_, 0, 0, 0); sa_ = __builtin_amdgcn_mfma_f32_16x16x32_bf16(KF[1], qf1, sa_, 0, 0, 0); \
        sb_ = __builtin_amdgcn_mfma_f32_16x16x32_bf16(KF[2], qf0, sb_, 0, 0, 0); sb_ = __builtin_amdgcn_mfma_f32_16x16x32_bf16(KF[3], qf1, sb_, 0, 0, 0); \
        _Pragma("unroll") for (int i_ = 0; i_ < 4; ++i_) *(LAS u32x4*)(vbuf_ + ((lane >> 3) + 8 * i_) * VROW + (lane & 7) * 16) = VV[i_]; \
        if ((G_) + 2 < ngrp) ATT_LOAD(KF, VV, (G_) + 2); \
        float l_[8]; float mloc_ = -INFINITY; \
        _Pragma("unroll") for (int r_ = 0; r_ < 4; ++r_) { const int sl_ = (G_) * 32 + 4 * g + r_; \
            l_[r_] = sl_ < nvalid ? sa_[r_] * 0.125f : -INFINITY; l_[4 + r_] = (sl_ + 16) < nvalid ? sb_[r_] * 0.125f : -INFINITY; \
            mloc_ = fmaxf(mloc_, fmaxf(l_[r_], l_[4 + r_])); } \
        mloc_ = fmaxf(mloc_, __shfl_xor(mloc_, 16)); mloc_ = fmaxf(mloc_, __shfl_xor(mloc_, 32)); \
        const float mnew_ = fmaxf(m, mloc_), alpha_ = __expf(m - mnew_); m = mnew_; \
        float ps_ = 0.f; \
        _Pragma("unroll") for (int r_ = 0; r_ < 8; ++r_) { l_[r_] = __expf(l_[r_] - mnew_); ps_ += l_[r_]; } \
        ssum = ssum * alpha_ + ps_; \
        bf16x8 pf_; \
        { const u32x4 pw_ = {cvt_pk_bf16(l_[0], l_[1]), cvt_pk_bf16(l_[2], l_[3]), cvt_pk_bf16(l_[4], l_[5]), cvt_pk_bf16(l_[6], l_[7])}; pf_ = __builtin_bit_cast(bf16x8, pw_); } \
        LAS unsigned char* ta_ = vbuf_ + (4 * g + (hd >> 2)) * VROW + (hd & 3) * 8; \
        _Pragma("unroll") for (int dt_ = 0; dt_ < 4; ++dt_) { \
            const v4i16 lo_ = __builtin_amdgcn_ds_read_tr16_b64_v4i16((LAS v4i16*)(ta_ + dt_ * 32)); \
            const v4i16 hi_ = __builtin_amdgcn_ds_read_tr16_b64_v4i16((LAS v4i16*)(ta_ + 16 * VROW + dt_ * 32)); \
            bf16x8 vf_; vf_[0] = lo_[0]; vf_[1] = lo_[1]; vf_[2] = lo_[2]; vf_[3] = lo_[3]; vf_[4] = hi_[0]; vf_[5] = hi_[1]; vf_[6] = hi_[2]; vf_[7] = hi_[3]; \
            o[dt_] = __builtin_amdgcn_mfma_f32_16x16x32_bf16(vf_, pf_, o[dt_] * alpha_, 0, 0, 0); } } while (0)
    ATT_LOAD(kfA, vvA, 0);
    if (ngrp > 1) ATT_LOAD(kfB, vvB, 1);
#pragma unroll 1
    for (int grp = 0; grp < ngrp; grp += 2) {
        ATT_GROUP(kfA, vvA, grp, vreg);
        if (grp + 1 < ngrp) ATT_GROUP(kfB, vvB, grp + 1, vreg + 8192);
    }
#undef ATT_LOAD
#undef ATT_GROUP
    ssum += __shfl_xor(ssum, 16); ssum += __shfl_xor(ssum, 32);
    const float inv = 1.0f / ssum;
    if (hd < 8) {
        bf16_t* op = MIX + (size_t)tok * 1024 + hd * 64 + 4 * g;
#pragma unroll
        for (int dt = 0; dt < 4; ++dt) { u32x2 w; w.x = cvt_pk_bf16(o[dt][0] * inv, o[dt][1] * inv); w.y = cvt_pk_bf16(o[dt][2] * inv, o[dt][3] * inv); *(u32x2*)(op + 16 * dt) = w; }
    }
    __syncthreads();
}

__device__ __forceinline__ void conv_tile(const Params& P, LAS unsigned char* lds, int tile, int tid, int wave, int lane) {
    unsigned char* ws = P.ws;
    const bf16_t* HG = (const bf16_t*)(ws + WS_HGLU); bf16_t* MIX = (bf16_t*)(ws + WS_MIX);
    LAS f32x2* part = (LAS f32x2*)(lds + LDS_MISC + 1024);
    LAS f32x2* stat = part + 256;
    LAS bf16_t* Lin = (LAS bf16_t*)lds;
    LAS bf16_t* Lout = (LAS bf16_t*)(lds + 65536);
    const int tok0 = tile * 32, t0 = tok0 & (SEQ - 1), c = tid;
    for (int ch = tid; ch < 62 * 64; ch += NTHR) { const int r = ch >> 6, cc = ch & 63; const int tt = t0 - 30 + r;
        u32x4 v = {0u, 0u, 0u, 0u}; if (tt >= 0) v = *(const u32x4*)(HG + (size_t)(tok0 - 30 + r) * 512 + cc * 8);
        *(LAS u32x4*)(Lin + r * 512 + cc * 8) = v; }
    __syncthreads();
    float in[62];
#pragma unroll
    for (int r = 0; r < 62; ++r) in[r] = __builtin_bit_cast(float, (unsigned)Lin[r * 512 + c] << 16);
    float out[32];
    const float bias = P.dw_b[c];
#pragma unroll
    for (int i = 0; i < 32; ++i) out[i] = bias;
#pragma unroll
    for (int j = 0; j < 31; ++j) { const float wj = P.dw_w[j * 512 + c];
#pragma unroll
        for (int i = 0; i < 32; ++i) out[i] = fmaf(in[i + j], wj, out[i]); }
#pragma unroll
    for (int i = 0; i < 32; ++i) { const float s1 = wave_sum(out[i]), s2 = wave_sum(out[i] * out[i]); if (lane == 0) part[i * 8 + wave] = (f32x2){s1, s2}; }
    __syncthreads();
    if (tid < 32) { float s1 = 0.f, s2 = 0.f;
#pragma unroll
        for (int w = 0; w < 8; ++w) { const f32x2 pp = part[tid * 8 + w]; s1 += pp.x; s2 += pp.y; }
        const float mean = s1 * (1.0f / 512.0f), var = fmaxf(s2 * (1.0f / 512.0f) - mean * mean, 0.f);
        stat[tid] = (f32x2){mean, 1.0f / sqrtf(var + EPS)}; }
    __syncthreads();
    const float lgc = P.ln_g[c], lbc = P.ln_b[c];
#pragma unroll
    for (int i = 0; i < 32; ++i) { const f32x2 st = stat[i]; const float y = (out[i] - st.x) * st.y * lgc + lbc; const float sl = y * sigmoidf_(y);
        Lout[i * 512 + c] = (bf16_t)f2bf(sl); }
    __syncthreads();
    for (int ch = tid; ch < 32 * 64; ch += NTHR) { const int r = ch >> 6, cc = ch & 63;
        *(u32x4*)(MIX + (size_t)(tok0 + r) * 1024 + 512 + cc * 8) = *(const LAS u32x4*)(Lout + r * 512 + cc * 8); }
    __syncthreads();
}

__device__ __forceinline__ void router_phase(const Params& P, LAS unsigned char* lds, int blk, int G, int tid, int wave, int lane) {
    unsigned char* ws = P.ws;
    const float* h1 = (const float*)(ws + WS_H1); const float* wrg = (const float*)(ws + WS_WRG);
    int* list = (int*)(ws + WS_LIST); float* lscale = (float*)(ws + WS_LSCALE); float* lgate = (float*)(ws + WS_LGATE);
    unsigned* cntg = (unsigned*)(ws + WS_CTL) + CW_CNT;
    LAS float* WL = (LAS float*)lds;
    LAS int* lcnt = (LAS int*)(lds + LDS_MISC + 1024);
    LAS int* gbase = lcnt + 32;
    LAS int* rec_e = gbase + 32;
    LAS int* rec_p = rec_e + 512;
    LAS float* rec_g = (LAS float*)(rec_p + 512);
    LAS float* rec_s = rec_g + 512;
    for (int i = tid; i < 8192; i += NTHR) ((LAS f32x4*)WL)[i] = ((const f32x4*)wrg)[i];
    __syncthreads();
    const int tl = lane & 31, half = lane >> 5;
    for (int chunk = blk; chunk < NTOK / 128; chunk += G) {
        if (tid < 32) lcnt[tid] = 0;
        __syncthreads();
        if (wave < 4) {
            const int tloc = wave * 32 + tl, tok = chunk * 128 + tloc;
            const float* hrow = h1 + (size_t)tok * DM + 4 * half;
            f32x16 acc;
#pragma unroll
            for (int i = 0; i < 16; ++i) acc[i] = 0.f;
            float ss = 0.f;
#pragma unroll 1
            for (int k0 = 0; k0 < DM; k0 += 32) {
                f32x4 hv[4];
#pragma unroll
                for (int i = 0; i < 4; ++i) hv[i] = *(const f32x4*)(hrow + k0 + 8 * i);
#pragma unroll
                for (int i = 0; i < 4; ++i) {
                    ss = fmaf(hv[i].x, hv[i].x, fmaf(hv[i].y, hv[i].y, fmaf(hv[i].z, hv[i].z, fmaf(hv[i].w, hv[i].w, ss))));
#pragma unroll
                    for (int j = 0; j < 4; ++j) { const float wv = WL[(k0 + 8 * i + 4 * half + j) * 32 + tl];
                        acc = __builtin_amdgcn_mfma_f32_32x32x2f32(wv, hv[i][j], acc, 0, 0, 0); }
                }
            }
            ss += __shfl_xor(ss, 32);
            const float rs = 1.0f / sqrtf(ss * (1.0f / DM) + EPS);
            float v[16];
#pragma unroll
            for (int r = 0; r < 16; ++r) v[r] = acc[r] * rs + P.b_router[(r & 3) + 8 * (r >> 2) + 4 * half];
            float tv[4]; int te[4];
#pragma unroll
            for (int q = 0; q < 4; ++q) { float bv = -INFINITY; int be = 64;
#pragma unroll
                for (int r = 0; r < 16; ++r) { const int e = (r & 3) + 8 * (r >> 2) + 4 * half; if (v[r] > bv || (v[r] == bv && e < be)) { bv = v[r]; be = e; } }
#pragma unroll
                for (int r = 0; r < 16; ++r) { const int e = (r & 3) + 8 * (r >> 2) + 4 * half; if (e == be) v[r] = -INFINITY; }
                tv[q] = bv; te[q] = be; }
            float cv[8]; int ce[8];
#pragma unroll
            for (int q = 0; q < 4; ++q) { cv[q] = tv[q]; ce[q] = te[q]; cv[4 + q] = __shfl_xor(tv[q], 32); ce[4 + q] = __shfl_xor(te[q], 32); }
#pragma unroll
            for (int q = 0; q < 4; ++q) { float bv = -INFINITY; int be = 64;
#pragma unroll
                for (int r = 0; r < 8; ++r) if (cv[r] > bv || (cv[r] == bv && ce[r] < be)) { bv = cv[r]; be = ce[r]; }
#pragma unroll
                for (int r = 0; r < 8; ++r) if (ce[r] == be) cv[r] = -INFINITY;
                tv[q] = bv; te[q] = be; }
            const float e1 = __expf(tv[1] - tv[0]), e2 = __expf(tv[2] - tv[0]), e3 = __expf(tv[3] - tv[0]);
            const float is = 1.0f / (1.0f + e1 + e2 + e3);
            if (half == 0) {
                const float gq[4] = {is, e1 * is, e2 * is, e3 * is};
#pragma unroll
                for (int q = 0; q < 4; ++q) { const int lp = atomicAdd((int*)&lcnt[te[q]], 1); const int si = tloc * 4 + q; rec_e[si] = te[q]; rec_p[si] = lp; rec_g[si] = gq[q]; }
                rec_s[tloc] = rs;
            }
        }
        __syncthreads();
        if (tid < 32) gbase[tid] = (int)atomicAdd(cntg + 64 * tid, (unsigned)lcnt[tid]);
        __syncthreads();
        { const int si = tid, ee = rec_e[si], pos = gbase[ee] + rec_p[si], li = ee * NTOK + pos;
          list[li] = (chunk * 128) * 4 + si; lscale[li] = rec_s[si >> 2]; lgate[li] = rec_g[si]; }
        __syncthreads();
    }
}

__device__ __forceinline__ void combine_phase(const Params& P, int gw, int NGW, int lane) {
    unsigned char* ws = P.ws;
    float* h1 = (float*)(ws + WS_H1); bf16_t* h1b = (bf16_t*)(ws + WS_H1B); const bf16_t* y = (const bf16_t*)(ws + WS_Y); float* rs3 = (float*)(ws + WS_RS3);
    for (int m = gw; m < NTOK; m += NGW) {
        const f32x4* hr = (const f32x4*)(h1 + (size_t)m * DM) + lane; f32x4 v[4]; float s = 0.f;
#pragma unroll
        for (int j = 0; j < 4; ++j) v[j] = hr[64 * j];
#pragma unroll
        for (int k = 0; k < 4; ++k) { const u32x2* yr = (const u32x2*)(y + (size_t)(m * 4 + k) * DM) + lane;
#pragma unroll
            for (int j = 0; j < 4; ++j) { const u32x2 w = yr[64 * j]; v[j].x += bf_lo(w.x); v[j].y += bf_hi(w.x); v[j].z += bf_lo(w.y); v[j].w += bf_hi(w.y); } }
        u32x2* o8 = (u32x2*)(h1b + (size_t)m * DM) + lane;
#pragma unroll
        for (int j = 0; j < 4; ++j) { u32x2 w; w.x = pk2(v[j].x, v[j].y); w.y = pk2(v[j].z, v[j].w); o8[64 * j] = w;
            s += (v[j].x * v[j].x + v[j].y * v[j].y) + (v[j].z * v[j].z + v[j].w * v[j].w); }
        s = wave_sum(s);
        if (lane == 0) rs3[m] = 1.0f / sqrtf(s * (1.0f / DM) + EPS);
    }
}

__device__ __forceinline__ void final_phase(const Params& P, int gw, int NGW, int lane) {
    unsigned char* ws = P.ws;
    const bf16_t* h2b = (const bf16_t*)(ws + WS_H1B); const bf16_t* pj = (const bf16_t*)(ws + WS_PJ); const bf16_t* G = (const bf16_t*)(ws + WS_G); const float* rs3 = (const float*)(ws + WS_RS3);
    f32x4 gv[4];
#pragma unroll
    for (int j = 0; j < 4; ++j) gv[j] = *((const f32x4*)P.g_final + lane + 64 * j);
    for (int m = gw; m < NTOK; m += NGW) {
        const u32x2* hr = (const u32x2*)(h2b + (size_t)m * DM) + lane; const u32x2* pr = (const u32x2*)(pj + (size_t)m * DM) + lane; const u32x2* gr = (const u32x2*)(G + (size_t)m * DM) + lane;
        const float r3 = rs3[m]; f32x4 v[4]; float s = 0.f;
#pragma unroll
        for (int j = 0; j < 4; ++j) { const u32x2 hw = hr[64 * j], pw = pr[64 * j], gw2 = gr[64 * j];
            v[j].x = bf_lo(hw.x) + bf_lo(pw.x) * sigmoidf_(bf_lo(gw2.x) * r3); v[j].y = bf_hi(hw.x) + bf_hi(pw.x) * sigmoidf_(bf_hi(gw2.x) * r3);
            v[j].z = bf_lo(hw.y) + bf_lo(pw.y) * sigmoidf_(bf_lo(gw2.y) * r3); v[j].w = bf_hi(hw.y) + bf_hi(pw.y) * sigmoidf_(bf_hi(gw2.y) * r3);
            s += (v[j].x * v[j].x + v[j].y * v[j].y) + (v[j].z * v[j].z + v[j].w * v[j].w); }
        s = wave_sum(s); const float rs = 1.0f / sqrtf(s * (1.0f / DM) + EPS);
        f32x4* orow = (f32x4*)(P.out + (size_t)m * DM) + lane;
#pragma unroll
        for (int j = 0; j < 4; ++j) orow[64 * j] = v[j] * rs * gv[j];
    }
}

#define XB_TMO      128
#define XB_XCNT(j)  (256  + 64 * (j))
#define XB_XSUB(j)  (1280 + 64 * (j))
#define XB_XGEN(j)  (2304 + 64 * (j))
#define XB_TOP      3328
#define XB_TOPGEN   3392
#define XCD_BAR_WORDS 3456
#define XB_SPIN_CAP (1u << 18)
__device__ __forceinline__ unsigned xb_ld(unsigned* p)              { return __hip_atomic_load(p, __ATOMIC_RELAXED, __HIP_MEMORY_SCOPE_AGENT); }
__device__ __forceinline__ unsigned xb_add(unsigned* p, unsigned v) { return __hip_atomic_fetch_add(p, v, __ATOMIC_RELAXED, __HIP_MEMORY_SCOPE_AGENT); }
__device__ __forceinline__ unsigned xb_xcc_id() { return (unsigned)__builtin_amdgcn_s_getreg((3 << 11) | 20) & 0xFu; }
#define XB_SPIN(cond, bar) do { unsigned _sp = 0; while (cond) { __builtin_amdgcn_s_sleep(1); \
    if ((++_sp & 255u) == 0u) { if (xb_ld(&(bar)[XB_TMO])) break; if (_sp > XB_SPIN_CAP) { atomicAdd(&(bar)[XB_TMO], 1u); break; } } } } while (0)
struct XcdBarrier { unsigned* bar; unsigned x; volatile LAS unsigned* st; };
__device__ __forceinline__ XcdBarrier xcd_barrier_post(unsigned* bar, volatile LAS unsigned* st) {
    XcdBarrier b; b.bar = bar; b.x = xb_xcc_id(); b.st = st;
    if (threadIdx.x == 0) (void)xb_add(&bar[XB_XCNT(b.x)], 1u);
    return b;
}
__device__ __forceinline__ void xcd_barrier_complete(unsigned* bar, unsigned x, unsigned& nloc, unsigned& nx) {
    const unsigned G = gridDim.x * gridDim.y * gridDim.z;
    unsigned sum, cnt, mine, sp = 0u;
    for (;;) {
        sum = 0u; cnt = 0u; mine = 0u;
#pragma unroll
        for (unsigned j = 0; j < 16; ++j) { const unsigned c = xb_ld(&bar[XB_XCNT(j)]); sum += c; cnt += (c > 0u) ? 1u : 0u; mine = (j == x) ? c : mine; }
        if (sum == G) break;
        __builtin_amdgcn_s_sleep(1);
        if ((++sp & 255u) == 0u) { if (xb_ld(&bar[XB_TMO])) break; if (sp > XB_SPIN_CAP) { atomicAdd(&bar[XB_TMO], 1u); break; } }
    }
    nloc = mine > 0u ? mine : 1u; nx = cnt > 0u ? cnt : 1u;
}
__device__ __forceinline__ void xcd_barrier(const XcdBarrier& b) {
    asm volatile("s_waitcnt vmcnt(0)" ::: "memory");
    __syncthreads();
    if (threadIdx.x == 0) {
        unsigned* bar = b.bar;
        __builtin_amdgcn_s_waitcnt(0);
        unsigned nloc = b.st[0], nx = b.st[1];
        if (nloc == 0u) { xcd_barrier_complete(bar, b.x, nloc, nx); b.st[0] = nloc; b.st[1] = nx; }
        const unsigned old = xb_add(&bar[XB_XSUB(b.x)], 1u);
        const unsigned gen = old / nloc;
        if (old + 1u == (gen + 1u) * nloc) {
            __builtin_amdgcn_fence(__ATOMIC_RELEASE, "agent");
            asm volatile("s_waitcnt vmcnt(0)" ::: "memory");
            const unsigned og = xb_add(&bar[XB_TOP], 1u);
            const unsigned tg = og / nx;
            if (og + 1u == (tg + 1u) * nx) xb_add(&bar[XB_TOPGEN], 1u);
            else XB_SPIN(xb_ld(&bar[XB_TOPGEN]) == tg, bar);
            __builtin_amdgcn_fence(__ATOMIC_ACQUIRE, "agent");
            xb_add(&bar[XB_XGEN(b.x)], 1u);
            asm volatile("s_waitcnt vmcnt(0)" ::: "memory");
        } else {
            XB_SPIN(xb_ld(&bar[XB_XGEN(b.x)]) == gen, bar);
            __builtin_amdgcn_fence(__ATOMIC_ACQUIRE, "agent");
            asm volatile("s_waitcnt vmcnt(0)" ::: "memory");
        }
    }
    __syncthreads();
}

constexpr int NPHASE = 10;
__global__ void __launch_bounds__(NTHR, 2) fwd_kernel(Params P) {
    extern __shared__ __attribute__((aligned(16))) unsigned char lds_raw[];
    LAS unsigned char* lds = (LAS unsigned char*)lds_raw;
    cg::grid_group grid = cg::this_grid();
    const int tid = threadIdx.x, wave = __builtin_amdgcn_readfirstlane(tid >> 6);
    const int G = gridDim.x, bx = blockIdx.x;
#define FRESH_LANE(name) int name = (int)__builtin_amdgcn_mbcnt_hi(~0u, __builtin_amdgcn_mbcnt_lo(~0u, 0u)); asm volatile("" : "+v"(name))
    const int vcu = (G % 8 == 0) ? (bx % 8) * (G / 8) + bx / 8 : bx;
    const int NGW = G * NWAVES;
    unsigned char* ws = P.ws;
    const int lo = P.ph_lo, hi = P.ph_hi;
#ifndef PH_MASK
#define PH_MASK 0x3ff
#endif
#define IN(k) ((((PH_MASK) >> (k)) & 1) && lo <= (k) && (k) < hi)
    volatile LAS unsigned* xst = (volatile LAS unsigned*)(lds + LDS_XB);
    if (tid < 2) xst[tid] = 0u;
    __syncthreads();
    const XcdBarrier xbar = xcd_barrier_post((unsigned*)(ws + WS_CTL) + CW_BAR, xst);
#define SYNC(k) do { if (IN(k) && IN((k) + 1)) { if ((k) == 0) grid.sync(); else xcd_barrier(xbar); } } while (0)

    if (IN(0)) { FRESH_LANE(lane); p0_prologue(P, lds, vcu, G, wave, lane); }
    SYNC(0);
    if (IN(1)) {
        { pg8::DenseSched S; S.init((const bf16_t*)(ws + WS_XB), (const bf16_t*)(ws + WS_WIN), NTOK, 2048, 1024, G, bx);
          EpiInProj E{(const float*)(ws + WS_RS1), (const f32x2*)(ws + WS_ROPE), P.glu_b, (bf16_t*)(ws + WS_Q), (bf16_t*)(ws + WS_K), (bf16_t*)(ws + WS_V), (bf16_t*)(ws + WS_QI), (bf16_t*)(ws + WS_KI), (bf16_t*)(ws + WS_HGLU), (float*)(ws + WS_WI)};
          pg8::gemm_phase<EpiInProj, pg8::DenseSched, false>(lds, S, E); }
        { pg8::DenseSched S; S.init((const bf16_t*)(ws + WS_PB), (const bf16_t*)(ws + WS_WP), NTOK, 1024, 256, G, bx);
          EpiBf16Plain E{(bf16_t*)(ws + WS_PJ), 1024};
          pg8::gemm_phase<EpiBf16Plain, pg8::DenseSched, false>(lds, S, E); }
    }
    SYNC(1);
    if (IN(2)) {
        FRESH_LANE(lane);
        for (int i = tid; i < 4096; i += NTHR) ((LAS unsigned*)(lds + LDS_MISC))[i] = 0u;
        __syncthreads();
        if (G % 8 == 0) { const int b = bx % 8, jb = bx / 8, nbb = G / 8;
            for (int i = 0;; ++i) { const int k = i * nbb + ((i & 1) ? nbb - 1 - jb : jb); if (k >= 512) break; attn_tile(P, lds, b, (511 - k) * 8, wave, lane); } }
        else { for (int tl = bx; tl < 4096; tl += G) attn_tile(P, lds, tl & 7, (511 - (tl >> 3)) * 8, wave, lane); }
        for (int rp = 0; rp <= ((P.rep >> 3) & 1); ++rp)
        for (int tl = vcu; tl < NTOK / 32; tl += G) conv_tile(P, lds, tl, tid, wave, lane);
    }
    SYNC(2);
    if (IN(3)) {
        pg8::DenseSched S; S.init((const bf16_t*)(ws + WS_MIX), (const bf16_t*)(ws + WS_WOUT), NTOK, 1024, 1024, G, bx);
        EpiOutProj E{P.x, (float*)(ws + WS_H1), (unsigned char*)(ws + WS_H1F8)};
        pg8::gemm_phase<EpiOutProj, pg8::DenseSched, false, false, true>(lds, S, E);
    }
    SYNC(3);
    if (IN(4)) { FRESH_LANE(lane); router_phase(P, lds, vcu, G, tid, wave, lane); }
    SYNC(4);
    if (IN(5) || IN(6)) {
        LAS int* tb = (LAS int*)(lds + LDS_MISC); LAS int* cn = tb + 64;
        if (tid == 0) { const unsigned* cntg = (const unsigned*)(ws + WS_CTL) + CW_CNT; int acc = 0;
            for (int e = 0; e < NE; ++e) { const int c = (int)__hip_atomic_load(cntg + 64 * e, __ATOMIC_RELAXED, __HIP_MEMORY_SCOPE_AGENT); tb[e] = acc; cn[e] = c; acc += (c + BM - 1) / BM; }
            tb[NE] = acc; }
        __syncthreads();
        if (IN(5)) {
            pg8::MoeSched S; S.A = ws + WS_H1F8; S.Bt = ws + WS_WUP; S.rp = 1024; S.b_estride = (size_t)2048 * 1024; S.tb = tb; S.cnt = cn; S.list = (const int*)(ws + WS_LIST);
            S.nN = 8; S.nwg = tb[NE] * 8; S.G = G; S.c = bx; S.gather = true;
            { LAS int* ut = (LAS int*)(lds + LDS_MISC + 512); S.utab = ut; S.build_table(ut, tid); __syncthreads(); }
            S.m_scale = (const float*)(ws + WS_LSCALE); S.m_gate = nullptr; S.m_bias = P.b_up;
            EpiUp E{(unsigned char*)(ws + WS_ACT)};
            pg8::gemm_phase<EpiUp, pg8::MoeSched, true, true, true>(lds, S, E);
        }
        SYNC(5);
        if (IN(6)) {
            pg8::MoeSched S; S.A = ws + WS_ACT; S.Bt = ws + WS_WDOWN; S.rp = 1024; S.b_estride = (size_t)1024 * 1024; S.tb = tb; S.cnt = cn; S.list = (const int*)(ws + WS_LIST);
            S.nN = 4; S.nwg = tb[NE] * 4; S.G = G; S.c = bx; S.gather = false;
            { LAS int* ut = (LAS int*)(lds + LDS_MISC + 512); S.utab = ut; S.build_table(ut, tid); __syncthreads(); }
            S.m_scale = nullptr; S.m_gate = (const float*)(ws + WS_LGATE); S.m_bias = P.b_down;
            EpiDown E{(bf16_t*)(ws + WS_Y)};
            pg8::gemm_phase<EpiDown, pg8::MoeSched, true, true, true>(lds, S, E);
        }
    }
    SYNC(6);
    if (IN(7)) { FRESH_LANE(l7); const int g7 = vcu * NWAVES + wave;
        combine_phase(P, g7, NGW, l7); }
    SYNC(7);
    if (IN(8)) {
        pg8::DenseSched S; S.init((const bf16_t*)(ws + WS_H1B), (const bf16_t*)(ws + WS_WG), NTOK, 1024, 1024, G, bx);
        EpiBf16Plain E{(bf16_t*)(ws + WS_G), 1024};
        pg8::gemm_phase<EpiBf16Plain, pg8::DenseSched, false>(lds, S, E);
    }
    SYNC(8);
    if (IN(9)) { FRESH_LANE(l9); const int g9 = vcu * NWAVES + wave;
        final_phase(P, g9, NGW, l9); }
#undef IN
#undef SYNC
}

#ifndef N_LAUNCH_MODE
#define N_LAUNCH_MODE 1
#endif
extern "C" void kernel_launch(void* const* d_in, const int* in_sizes, int n_in, void* d_out, int out_size, void* d_ws, size_t ws_size, hipStream_t stream) {
    static int grid = 0;
    if (grid == 0) {
        if (n_in != 21 || out_size != NTOK * DM || ws_size < WS_END) { fprintf(stderr, "kernel_launch: unexpected shapes (n_in %d out %d ws %zu)\n", n_in, out_size, ws_size); grid = -1; return; }
        int dev = 0, cus = 0, per_cu = 0;
        (void)hipGetDevice(&dev); (void)hipDeviceGetAttribute(&cus, hipDeviceAttributeMultiprocessorCount, dev);
        (void)hipFuncSetAttribute((const void*)fwd_kernel, hipFuncAttributeMaxDynamicSharedMemorySize, LDS_BYTES);
        if (hipOccupancyMaxActiveBlocksPerMultiprocessor(&per_cu, (const void*)fwd_kernel, NTHR, LDS_BYTES) != hipSuccess || per_cu < 1) { fprintf(stderr, "kernel_launch: occupancy query failed (%d)\n", per_cu); (void)hipGetLastError(); grid = -1; return; }
        grid = cus;
    }
    if (grid < 0) return;
    (void)hipMemsetAsync((char*)d_ws + WS_CTL, 0, CTL_BYTES, stream);
    Params p{};
    p.x = (const float*)d_in[0]; p.p = (const float*)d_in[1]; p.w_in = (const float*)d_in[2]; p.w_out = (const float*)d_in[3]; p.g_mix = (const float*)d_in[4]; p.g_ffn = (const float*)d_in[5];
    p.glu_b = (const float*)d_in[6]; p.dw_w = (const float*)d_in[7]; p.dw_b = (const float*)d_in[8]; p.ln_g = (const float*)d_in[9]; p.ln_b = (const float*)d_in[10];
    p.w_router = (const float*)d_in[11]; p.b_router = (const float*)d_in[12]; p.w_up = (const float*)d_in[13]; p.b_up = (const float*)d_in[14]; p.w_down = (const float*)d_in[15]; p.b_down = (const float*)d_in[16];
    p.w_ple_proj = (const float*)d_in[17]; p.w_ple_gate = (const float*)d_in[18]; p.g_ple = (const float*)d_in[19]; p.g_final = (const float*)d_in[20];
    p.out = (float*)d_out; p.ws = (unsigned char*)d_ws;
#ifndef PROBE_REPMASK
#define PROBE_REPMASK 0
#endif
    p.rep = PROBE_REPMASK;
#if N_LAUNCH_MODE == 1
    p.ph_lo = 0; p.ph_hi = NPHASE;
    void* args[] = {&p};
    hipError_t e = hipLaunchCooperativeKernel((const void*)fwd_kernel, dim3(grid), dim3(NTHR), args, LDS_BYTES, stream);
    if (e != hipSuccess) fprintf(stderr, "cooperative launch failed: %s (grid %d)\n", hipGetErrorString(e), grid);
#else
    for (int ph = 0; ph < NPHASE; ++ph) {
        p.ph_lo = ph; p.ph_hi = ph + 1;
        void* args[] = {&p};
        hipError_t e = hipLaunchCooperativeKernel((const void*)fwd_kernel, dim3(grid), dim3(NTHR), args, LDS_BYTES, stream);
        if (e != hipSuccess) { fprintf(stderr, "launch %d failed: %s (grid %d)\n", ph, hipGetErrorString(e), grid); break; }
    }
#endif
}
```

```cpp
#include <hip/hip_runtime.h>
#include <hip/hip_cooperative_groups.h>
#include <cstdio>
#include <cstdint>
namespace cg = cooperative_groups;

#define LAS __attribute__((address_space(3)))
#define GAS __attribute__((address_space(1)))
typedef unsigned short bf16_t;
typedef short bf16x8 __attribute__((ext_vector_type(8)));
typedef short s16x4 __attribute__((ext_vector_type(4)));
typedef float f32x4 __attribute__((ext_vector_type(4)));
typedef float f32x2 __attribute__((ext_vector_type(2)));
typedef float f32x16 __attribute__((ext_vector_type(16)));
typedef unsigned u32x4 __attribute__((ext_vector_type(4)));
typedef unsigned u32x2 __attribute__((ext_vector_type(2)));

constexpr int NB = 8, SEQ = 4096, DM = 1024, NTOK = NB * SEQ;
constexpr int NE = 32, TOPK = 4, NSLOT = NTOK * TOPK;
constexpr int INW = 1988;
constexpr int NSEL = 256;
constexpr float EPS = 1e-6f;
constexpr int NWAVES = 8, NTHR = 512;

constexpr size_t MiB = 1u << 20;
constexpr size_t WS_CTL = 0, CTL_BYTES = 64 * 1024;
constexpr size_t WS_ROPE = 1 * MiB;
constexpr size_t WS_WIN = 2 * MiB;
constexpr size_t WS_WOUT = 6 * MiB;
constexpr size_t WS_WG = 8 * MiB;
constexpr size_t WS_WP = 10 * MiB;
constexpr size_t WS_WRG = 10 * MiB + 512 * 1024;
constexpr size_t WS_RS1 = 11 * MiB;
constexpr size_t WS_RS3 = 11 * MiB + 512 * 1024;
constexpr size_t WS_WI = 12 * MiB;
constexpr size_t WS_LIST = 13 * MiB;
constexpr size_t WS_LSCALE = 17 * MiB;
constexpr size_t WS_LGATE = 21 * MiB;
constexpr size_t WS_PB = 25 * MiB;
constexpr size_t WS_WUP = 42 * MiB;
constexpr size_t WS_WDOWN = 170 * MiB;
constexpr size_t WS_H1 = 234 * MiB;
constexpr size_t WS_H1B = 362 * MiB;
constexpr size_t WS_PJ = 426 * MiB;
constexpr size_t WS_XB = 490 * MiB;
constexpr size_t WS_Q = 554 * MiB;
constexpr size_t WS_K = 586 * MiB;
constexpr size_t WS_V = 590 * MiB;
constexpr size_t WS_QI = 594 * MiB;
constexpr size_t WS_KI = 610 * MiB;
constexpr size_t WS_HGLU = 614 * MiB;
constexpr size_t WS_MIX = 646 * MiB;
constexpr size_t WS_H1F8 = 490 * MiB;
constexpr size_t WS_ACT = 522 * MiB;
constexpr size_t WS_Y = 762 * MiB;
constexpr size_t WS_G = 762 * MiB;
constexpr size_t WS_END = 1018 * MiB;
static_assert(WS_H1F8 + (size_t)NTOK * 1024 <= WS_ACT && WS_ACT + (size_t)139264 * 1024 <= WS_Y, "ws map");
constexpr int CW_CNT = 1024;
constexpr int CW_AQ = 4096;
constexpr int CW_CQ = 4096 + 64 * 8;
constexpr int CW_BAR = 8192;

constexpr int LDS_STAGE = 131072;
constexpr int LDS_MISC = LDS_STAGE;
constexpr int LDS_META = LDS_MISC + 4096;
constexpr int LDS_XB = 147456;
constexpr int LDS_BYTES = 147456 + 256;

__device__ __forceinline__ unsigned f2bf(float f) { unsigned u = __builtin_bit_cast(unsigned, f); return (u + 0x7fffu + ((u >> 16) & 1u)) >> 16; }
__device__ __forceinline__ unsigned pk2(float lo, float hi) { return f2bf(lo) | (f2bf(hi) << 16); }
__device__ __forceinline__ float bf_lo(unsigned w) { return __builtin_bit_cast(float, w << 16); }
__device__ __forceinline__ float bf_hi(unsigned w) { return __builtin_bit_cast(float, w & 0xffff0000u); }
__device__ __forceinline__ float wave_sum(float v) {
    v += __builtin_bit_cast(float, __builtin_amdgcn_update_dpp(0, __builtin_bit_cast(int, v), 0xB1, 0xF, 0xF, true));
    v += __builtin_bit_cast(float, __builtin_amdgcn_update_dpp(0, __builtin_bit_cast(int, v), 0x4E, 0xF, 0xF, true));
    v += __builtin_bit_cast(float, __builtin_amdgcn_update_dpp(0, __builtin_bit_cast(int, v), 0x141, 0xF, 0xF, true));
    v += __builtin_bit_cast(float, __builtin_amdgcn_update_dpp(0, __builtin_bit_cast(int, v), 0x140, 0xF, 0xF, true));
    const int vi = __builtin_bit_cast(int, v);
    const float r0 = __builtin_bit_cast(float, __builtin_amdgcn_readlane(vi, 0)), r1 = __builtin_bit_cast(float, __builtin_amdgcn_readlane(vi, 16));
    const float r2 = __builtin_bit_cast(float, __builtin_amdgcn_readlane(vi, 32)), r3 = __builtin_bit_cast(float, __builtin_amdgcn_readlane(vi, 48));
    return (r0 + r1) + (r2 + r3);
}
__device__ __forceinline__ unsigned pk4_fp8(float a, float b, float c, float d) { int r = __builtin_amdgcn_cvt_pk_fp8_f32(a, b, 0, false); r = __builtin_amdgcn_cvt_pk_fp8_f32(c, d, r, true); return (unsigned)r; }
__device__ __forceinline__ float sigmoidf_(float x) { return __builtin_amdgcn_rcpf(1.0f + __builtin_amdgcn_exp2f(x * -1.4426950408889634f)); }
#define LDS_WAIT() asm volatile("s_waitcnt lgkmcnt(0)" ::: "memory")

struct Params {
    const float* x; const float* p; const float* w_in; const float* w_out; const float* g_mix; const float* g_ffn;
    const float* glu_b; const float* dw_w; const float* dw_b; const float* ln_g; const float* ln_b;
    const float* w_router; const float* b_router; const float* w_up; const float* b_up; const float* w_down; const float* b_down;
    const float* w_ple_proj; const float* w_ple_gate; const float* g_ple; const float* g_final;
    float* out; unsigned char* ws;
    int ph_lo, ph_hi, rep, pad;
};

namespace pg8 {
constexpr int BM = 256, BK = 64, HALF = 128, HTB = HALF * BK * 2, STAGE_BYTES = 8 * HTB, NXCD = 8, WGM = 8;
__host__ __device__ __forceinline__ int lds_byte(int r, int c) { const int st = (r >> 4) * 2 + (c >> 5), rr = r & 15, cc = c & 31, ob = rr * 64 + cc * 2; return st * 1024 + (ob ^ (((ob >> 9) & 1) << 5)); }
__host__ __device__ __forceinline__ void stage_rc(int b, int& R, int& C) { const int st = b / 1024, sb = b % 1024, swz = sb ^ (((sb >> 9) & 1) << 5); R = (st >> 1) * 16 + swz / 64; C = (st & 1) * 32 + (swz % 64) / 2; }
__host__ __device__ __forceinline__ int perm32(int rho) { const int n = rho >> 4, i = rho & 15; return 8 * (i >> 2) + 4 * n + (i & 3); }

struct Unit { int pm, pn, e, rows; };

__device__ __forceinline__ unsigned cvt_pk_bf16(float lo, float hi) { unsigned r; asm volatile("v_cvt_pk_bf16_f32 %0, %1, %2" : "=v"(r) : "v"(lo), "v"(hi)); return r; }

struct DenseSched {
    const void* A; const void* Bt; int rp;
    int nM, nN, nwg, G, c;
    __device__ void init(const void* A_, const void* Bt_, int M, int N, int K_, int G_, int c_) { A = A_; Bt = Bt_; rp = K_ * 2; nM = M / BM; nN = N / BM; nwg = nM * nN; G = G_; c = c_; }
    __device__ bool next(int i, Unit& u) const {
        const long L = (long)i * G + c; if (L >= nwg) return false;
        int wgid = (int)L; { const int q = nwg / NXCD, r = nwg % NXCD, xcd = wgid % NXCD, off = wgid / NXCD; wgid = (xcd < r ? xcd * (q + 1) : r * (q + 1) + (xcd - r) * q) + off; }
        const int nig = WGM * nN, gid = wgid / nig, fm = gid * WGM, gsz = (nM - fm) < WGM ? (nM - fm) : WGM;
        u.pm = fm + ((wgid % nig) % gsz); u.pn = (wgid % nig) / gsz; u.e = 0; u.rows = BM; return true;
    }
    __device__ __forceinline__ const char* a_ptr(const Unit& u) const { return (const char*)A + (size_t)u.pm * BM * rp; }
    __device__ __forceinline__ const char* b_ptr(const Unit& u) const { return (const char*)Bt + (size_t)u.pn * BM * rp; }
    __device__ __forceinline__ int a_row(const Unit&, int) const { return 0; }
    __device__ __forceinline__ void meta(const Unit&, LAS unsigned char*, int, int) const {}
};

struct MoeSched {
    const void* A; const void* Bt; int rp; size_t b_estride;
    const LAS int* tb;
    const LAS int* cnt;
    const int* list;
    int nN, nwg, G, c; bool gather;
    const LAS int* utab;
    __device__ __forceinline__ bool next(int i, Unit& u) const {
        if (i >= 32) return false;
        const LAS int* p = utab + 4 * i; const int rows = p[3]; if (rows < 0) return false;
        u.pm = p[0]; u.pn = p[1]; u.e = p[2]; u.rows = rows; return true;
    }
    __device__ __forceinline__ void build_table(LAS int* tab, int tid) const {
        if (tid < 32) { Unit u; const bool ok = decode(tid, u); tab[4 * tid] = u.pm; tab[4 * tid + 1] = u.pn; tab[4 * tid + 2] = u.e; tab[4 * tid + 3] = ok ? u.rows : -1; }
    }
    __device__ __forceinline__ bool decode(int i, Unit& u) const {
        u.pm = 0; u.pn = 0; u.e = 0; u.rows = 0;
        const long L = (long)i * G + c; if (L >= nwg) return false;
        int wgid = (int)L; { const int q = nwg / NXCD, r = nwg % NXCD, xcd = wgid % NXCD, off = wgid / NXCD; wgid = (xcd < r ? xcd * (q + 1) : r * (q + 1) + (xcd - r) * q) + off; }
        int e = 0;
#pragma unroll 1
        for (; e < NE - 1; ++e) { if (wgid < tb[e + 1] * nN) break; }
        const int local = wgid - tb[e] * nN, nM = tb[e + 1] - tb[e];
        const int nig = WGM * nN, gid = local / nig, fm = gid * WGM, gsz = (nM - fm) < WGM ? (nM - fm) : WGM;
        const int rt = fm + ((local % nig) % gsz);
        u.pm = tb[e] + rt; u.pn = (local % nig) / gsz; u.e = e;
        const int left = cnt[e] - rt * BM; u.rows = left < BM ? left : BM; return true;
    }
    __device__ __forceinline__ const char* a_ptr(const Unit& u) const { return (const char*)A; }
    __device__ __forceinline__ const char* b_ptr(const Unit& u) const { return (const char*)Bt + (size_t)u.e * b_estride + (size_t)u.pn * BM * rp; }
    __device__ __forceinline__ int a_row(const Unit& u, int r) const {
        if (!gather) return u.pm * BM + r;
        const int rt = u.pm - tb[u.e];
        return r < u.rows ? (list[u.e * NTOK + rt * BM + r] >> 2) : 0;
    }
    const float* m_scale; const float* m_gate; const float* m_bias;
    __device__ __forceinline__ void meta(const Unit& u, LAS unsigned char* tbl, int wid, int lane) const {
        const int rt = u.pm - tb[u.e]; const size_t li = (size_t)u.e * NTOK + rt * BM + (wid & 3) * 64 + lane;
        if (gather) {
            if (wid < 4) __builtin_amdgcn_global_load_lds((const unsigned*)(m_scale + li), (LAS unsigned*)(tbl + (wid & 3) * 256), 4, 0, 0);
            else { const int j = (wid & 3) * 64 + lane; const float* src = m_bias + (size_t)u.e * 2048 + (j < 128 ? 128 * u.pn + j : 1024 + 128 * u.pn + (j - 128));
                __builtin_amdgcn_global_load_lds((const unsigned*)src, (LAS unsigned*)(tbl + 2048 + (wid & 3) * 256), 4, 0, 0); }
        } else {
            if (wid < 4) { __builtin_amdgcn_global_load_lds((const unsigned*)(list + li), (LAS unsigned*)(tbl + (wid & 3) * 256), 4, 0, 0);
                __builtin_amdgcn_global_load_lds((const unsigned*)(m_bias + (size_t)u.e * 1024 + u.pn * BM + (wid & 3) * 64 + lane), (LAS unsigned*)(tbl + 2048 + (wid & 3) * 256), 4, 0, 0); }
            else __builtin_amdgcn_global_load_lds((const unsigned*)(m_gate + li), (LAS unsigned*)(tbl + 1024 + (wid & 3) * 256), 4, 0, 0);
        }
    }
};

typedef int v8i32 __attribute__((ext_vector_type(8)));
template <class Epi, class Sched, bool GATHER, bool F8 = false, bool WARMTRIP = false>
__device__ __forceinline__ void gemm_phase(LAS unsigned char* lds, const Sched& S, const Epi& E) {
    const int tid = threadIdx.x, wid = __builtin_amdgcn_readfirstlane(tid >> 6), lane = tid & 63, wr = wid >> 2, wc = wid & 3, fr = lane & 15, fq = lane >> 4;
    const int RP = S.rp, nt = RP / (BK * 2);
    unsigned voffA[2], voffB[2]; int RA[2], CA[2];
#pragma unroll
    for (int i = 0; i < 2; ++i) { int R, C; stage_rc(tid * 16 + i * 8192, R, C); const int Rb = Epi::PERM ? ((R & ~31) + perm32(R & 31)) : R;
        voffA[i] = (unsigned)(R * RP + C * 2); voffB[i] = (unsigned)(Rb * RP + C * 2); RA[i] = R; CA[i] = C; }
    const size_t kstep = (size_t)(BK * 2);
    const size_t hstep = (size_t)HALF * RP;
    const unsigned ldsw = (unsigned)wid * 1024u;
    const int aoff = lds_byte(wr * 64 + fr, fq * 8), boff = lds_byte(wc * 32 + fr, fq * 8);
    unsigned gC[2][2], gN[2][2];
#define PG8_SA(b, h) (((b) * 2 + (h)) * HTB)
#define PG8_SB(b, h) ((4 + (b) * 2 + (h)) * HTB)
#define PG8_STAGE(bufoff, gbase, voff) do { _Pragma("unroll") for (int _i = 0; _i < 2; ++_i) \
        __builtin_amdgcn_global_load_lds((const unsigned*)((const char*)(gbase) + (voff)[_i]), (LAS unsigned*)(lds + (bufoff) + ldsw + _i * 8192), 16, 0, 0); } while (0)
#define PG8_STAGE_A(bufoff, kp, h) do { if constexpr (GATHER) { PG8_STAGE(bufoff, kp, gC[h]); } else { PG8_STAGE(bufoff, (kp) + (h) * hstep, voffA); } } while (0)
#define PG8_LD16(p) (*(const LAS bf16x8*)(p))
#define PG8_CAT(lo, hi) __builtin_bit_cast(v8i32, __builtin_shufflevector(lo, hi, 0, 1, 2, 3, 4, 5, 6, 7, 8, 9, 10, 11, 12, 13, 14, 15))
#define PG8_LDA(dst, b, h) do { _Pragma("unroll") for (int m = 0; m < 4; ++m) { if constexpr (F8) { dst##8[m] = PG8_CAT(PG8_LD16(lds + PG8_SA(b, h) + aoff + m * 2048), PG8_LD16(lds + PG8_SA(b, h) + aoff + m * 2048 + 1024)); } \
        else { _Pragma("unroll") for (int k = 0; k < 2; ++k) dst[m][k] = PG8_LD16(lds + PG8_SA(b, h) + aoff + m * 2048 + k * 1024); } } } while (0)
#define PG8_LDB(dst, b, h) do { _Pragma("unroll") for (int n = 0; n < 2; ++n) { if constexpr (F8) { dst##8[n] = PG8_CAT(PG8_LD16(lds + PG8_SB(b, h) + boff + n * 2048), PG8_LD16(lds + PG8_SB(b, h) + boff + n * 2048 + 1024)); } \
        else { _Pragma("unroll") for (int k = 0; k < 2; ++k) dst[n][k] = PG8_LD16(lds + PG8_SB(b, h) + boff + n * 2048 + k * 1024); } } } while (0)
#define PG8_MMA(ai, bj, At, Bt) do { __builtin_amdgcn_s_setprio(1); _Pragma("unroll") for (int m = 0; m < 4; ++m) _Pragma("unroll") for (int n = 0; n < 2; ++n) { \
        if constexpr (F8) { acc[ai][bj][m][n] = __builtin_amdgcn_mfma_scale_f32_16x16x128_f8f6f4(Bt##8[n], At##8[m], acc[ai][bj][m][n], 0, 0, 0, 0x7f7f7f7f, 0, 0x7f7f7f7f); } \
        else { _Pragma("unroll") for (int k = 0; k < 2; ++k) acc[ai][bj][m][n] = __builtin_amdgcn_mfma_f32_16x16x32_bf16(Bt[n][k], At[m][k], acc[ai][bj][m][n], 0, 0, 0); } } \
        __builtin_amdgcn_s_setprio(0); } while (0)
#define PG8_WAIT_V(n) asm volatile("s_waitcnt vmcnt(" #n ")" ::: "memory")
#define PG8_WAIT_L(n) asm volatile("s_waitcnt lgkmcnt(" #n ")" ::: "memory")
#define PG8_BAR __builtin_amdgcn_s_barrier()
#define PG8_SCHED __builtin_amdgcn_sched_barrier(0)
#define PG8_GOFF(dst, u) do { _Pragma("unroll") for (int _h = 0; _h < 2; ++_h) _Pragma("unroll") for (int _i = 0; _i < 2; ++_i) \
        dst[_h][_i] = (unsigned)(S.a_row(u, _h * HALF + RA[_i]) * RP + CA[_i] * 2); } while (0)
    Unit cur, nxt, nn; int ui = 0;
    if (!S.next(0, cur)) return;
    bool has_next = S.next(1, nxt);
    if constexpr (GATHER) { PG8_GOFF(gC, cur); if (has_next) { PG8_GOFF(gN, nxt); } else { PG8_GOFF(gN, cur); } }
    f32x4 acc[2][2][4][2];
#pragma unroll
    for (int a = 0; a < 2; ++a)
#pragma unroll
        for (int b = 0; b < 2; ++b)
#pragma unroll
            for (int m = 0; m < 4; ++m)
#pragma unroll
                for (int n = 0; n < 2; ++n) acc[a][b][m][n] = (f32x4){0.f, 0.f, 0.f, 0.f};
    bf16x8 At[4][2], B0[2][2], B1[2][2]; v8i32 At8[4], B08[2], B18[2];
    const char* cA = S.a_ptr(cur); const char* cB = S.b_ptr(cur);
    PG8_STAGE(PG8_SB(0, 0), cB, voffB); PG8_STAGE(PG8_SB(0, 1), cB + hstep, voffB); PG8_STAGE_A(PG8_SA(0, 0), cA, 0); PG8_STAGE_A(PG8_SA(0, 1), cA, 1);
    if (wr == 1) PG8_BAR;
    PG8_WAIT_V(2); PG8_BAR;
    PG8_STAGE(PG8_SB(1, 0), cB + kstep, voffB); PG8_STAGE_A(PG8_SA(1, 0), cA + kstep, 0); PG8_STAGE(PG8_SB(1, 1), cB + hstep + kstep, voffB);
    PG8_WAIT_V(6); PG8_BAR;
    for (;;) {
        const char* nA = has_next ? S.a_ptr(nxt) : cA; const char* nB = has_next ? S.b_ptr(nxt) : cB;
        S.meta(cur, lds + (LDS_META - 0) + (ui & 1) * 4096, wid, lane);
#define PG8_TRIP(WARM, t) do { \
            const bool last = ((t) == nt - 2); \
            const char* a1 = cA + (size_t)((t) + 1) * kstep; \
            const char* a2 = last ? nA : cA + (size_t)((t) + 2) * kstep; const char* b2 = last ? nB : cB + (size_t)((t) + 2) * kstep; \
            const char* a3 = a2 + kstep; const char* b3 = b2 + kstep; \
              \
            PG8_LDB(B0, 0, 0); PG8_LDB(B1, 0, 1); PG8_SCHED; PG8_LDA(At, 0, 0); if constexpr (!(WARM)) { PG8_STAGE_A(PG8_SA(1, 1), a1, 1); } \
            if constexpr (GATHER) { if (last) { _Pragma("unroll") for (int h = 0; h < 2; ++h) _Pragma("unroll") for (int i = 0; i < 2; ++i) gC[h][i] = gN[h][i]; } } \
            if constexpr (!(WARM)) { PG8_WAIT_V(8); } PG8_WAIT_L(0); PG8_BAR; PG8_MMA(0, 0, At, B0); PG8_MMA(0, 1, At, B1); PG8_BAR; PG8_SCHED; \
              \
            PG8_LDA(At, 0, 1); PG8_STAGE(PG8_SB(0, 0), b2, voffB); PG8_STAGE(PG8_SB(0, 1), b2 + hstep, voffB); PG8_STAGE_A(PG8_SA(0, 0), a2, 0); \
            if constexpr (!(WARM)) { PG8_WAIT_V(8); } PG8_WAIT_L(0); PG8_BAR; PG8_MMA(1, 0, At, B0); PG8_MMA(1, 1, At, B1); PG8_BAR; PG8_SCHED; \
              \
            PG8_LDB(B0, 1, 0); PG8_LDB(B1, 1, 1); PG8_SCHED; PG8_LDA(At, 1, 0); PG8_STAGE_A(PG8_SA(0, 1), a2, 1); \
            if constexpr (!(WARM)) { PG8_WAIT_V(8); } PG8_WAIT_L(0); PG8_BAR; PG8_MMA(0, 0, At, B0); PG8_MMA(0, 1, At, B1); PG8_BAR; PG8_SCHED; \
              \
            PG8_LDA(At, 1, 1); PG8_STAGE(PG8_SB(1, 0), b3, voffB); PG8_STAGE(PG8_SB(1, 1), b3 + hstep, voffB); PG8_STAGE_A(PG8_SA(1, 0), a3, 0); \
            PG8_WAIT_V(8); PG8_WAIT_L(0); PG8_BAR; PG8_MMA(1, 0, At, B0); PG8_MMA(1, 1, At, B1); PG8_BAR; PG8_SCHED; \
        } while (0)
        int t0_ = 0;
        if constexpr (WARMTRIP) { if (ui > 0) { PG8_TRIP(true, 0); t0_ = 2; } }
        for (int t = t0_; t < nt; t += 2) { PG8_TRIP(false, t); }
#undef PG8_TRIP
        if (wr == 0) PG8_BAR;
        if constexpr (WARMTRIP) { PG8_STAGE_A(PG8_SA(1, 1), nA + kstep, 1); }
        bool has_nn = false;
        if constexpr (GATHER) { if (has_next) { has_nn = S.next(ui + 2, nn); if (has_nn) { PG8_GOFF(gN, nn); } } }
        else { if (has_next) has_nn = S.next(ui + 2, nn); }
        { int fr_ = fr, fq_ = fq; asm volatile("" : "+v"(fr_), "+v"(fq_));
          const LAS unsigned char* mt = lds + LDS_META + (ui & 1) * 4096;
          if constexpr (WARMTRIP) {
              E.pre(acc, cur, wr, wc, fr_, fq_, mt);
              if constexpr (GATHER) asm volatile("" : "+v"(gN[0][0]), "+v"(gN[0][1]), "+v"(gN[1][0]), "+v"(gN[1][1]));
              PG8_WAIT_V(0);
              E.post(acc, cur, wr, wc, fr_, fq_, mt);
          } else { E.run(acc, cur, wr, wc, fr_, fq_, mt); } }
        if (!has_next) break;
#pragma unroll
        for (int a = 0; a < 2; ++a)
#pragma unroll
            for (int b = 0; b < 2; ++b)
#pragma unroll
                for (int m = 0; m < 4; ++m)
#pragma unroll
                    for (int n = 0; n < 2; ++n) acc[a][b][m][n] = (f32x4){0.f, 0.f, 0.f, 0.f};
        cur = nxt; cA = nA; cB = nB; ++ui; nxt = nn; has_next = has_nn;
        if (wr == 1) PG8_BAR;
    }
    PG8_WAIT_V(0);
    PG8_BAR;
#undef PG8_SA
#undef PG8_SB
#undef PG8_STAGE
#undef PG8_STAGE_A
#undef PG8_LDA
#undef PG8_LDB
#undef PG8_MMA
#undef PG8_LD16
#undef PG8_CAT
#undef PG8_WAIT_V
#undef PG8_WAIT_L
#undef PG8_BAR
#undef PG8_SCHED
#undef PG8_GOFF
}
}

using pg8::Unit; using pg8::cvt_pk_bf16;
constexpr int BM = 256, HALF = 128;

typedef f32x4 (&AccRef)[2][2][4][2];
__device__ __forceinline__ void pack8_bf16(f32x4& lo, const f32x4& hi) {
    const unsigned w0 = cvt_pk_bf16(lo[0], lo[1]), w1 = cvt_pk_bf16(lo[2], lo[3]), w2 = cvt_pk_bf16(hi[0], hi[1]), w3 = cvt_pk_bf16(hi[2], hi[3]);
    lo[0] = __builtin_bit_cast(float, w0); lo[1] = __builtin_bit_cast(float, w1); lo[2] = __builtin_bit_cast(float, w2); lo[3] = __builtin_bit_cast(float, w3);
}
#define AS_U4(v) __builtin_bit_cast(u32x4, v)

struct EpiInProj {
    static constexpr bool PERM = true;
    const float* rs1; const f32x2* rope; const float* glu_b;
    bf16_t *q, *k, *v, *qi, *ki, *hglu; float* wi;
    __device__ __forceinline__ void pre(AccRef acc, const Unit& u, int wr, int wc, int fr, int fq, const LAS unsigned char* mt) const {
        const int row0 = u.pm * BM + wr * 64 + fr;
        if (u.pn >= 4) {
            const int ch = 128 * (u.pn - 4) + 32 * wc + 8 * fq;
            f32x4 ba[2], bg[2];
#pragma unroll
            for (int n = 0; n < 2; ++n) { ba[n] = *(const f32x4*)(glu_b + ch + 4 * n); bg[n] = *(const f32x4*)(glu_b + 512 + ch + 4 * n); }
#pragma unroll
            for (int ai = 0; ai < 2; ++ai)
#pragma unroll
                for (int m = 0; m < 4; ++m) { const float rs = rs1[row0 + ai * HALF + m * 16];
#pragma unroll
                    for (int n = 0; n < 2; ++n)
#pragma unroll
                        for (int e = 0; e < 4; ++e) { const float a = acc[ai][0][m][n][e] * rs + ba[n][e], g = acc[ai][1][m][n][e] * rs + bg[n][e]; acc[ai][0][m][n][e] = a * sigmoidf_(g); }
                    pack8_bf16(acc[ai][0][m][0], acc[ai][0][m][1]); }
            return;
        }
        const bool do_rope = !(u.pn == 3 && wc >= 2), is_wi = (u.pn == 3 && wc == 3);
        const int d0 = 8 * fq;
#pragma unroll
        for (int ai = 0; ai < 2; ++ai)
#pragma unroll
            for (int m = 0; m < 4; ++m) { const int row = row0 + ai * HALF + m * 16; const float rs = rs1[row];
                if (do_rope) {
                    const f32x2* rp = rope + (size_t)(row & (SEQ - 1)) * 32 + d0;
#pragma unroll
                    for (int n = 0; n < 2; ++n)
#pragma unroll
                        for (int e = 0; e < 4; ++e) { const f32x2 cs = rp[4 * n + e]; const float x1 = acc[ai][0][m][n][e] * rs, x2 = acc[ai][1][m][n][e] * rs;
                            acc[ai][0][m][n][e] = x1 * cs.x - x2 * cs.y; acc[ai][1][m][n][e] = x2 * cs.x + x1 * cs.y; }
                } else {
#pragma unroll
                    for (int n = 0; n < 2; ++n) { acc[ai][0][m][n] = acc[ai][0][m][n] * rs; acc[ai][1][m][n] = acc[ai][1][m][n] * rs; }
                }
                if (!is_wi) { pack8_bf16(acc[ai][0][m][0], acc[ai][0][m][1]); pack8_bf16(acc[ai][1][m][0], acc[ai][1][m][1]); }
                if (m & 1) __builtin_amdgcn_sched_barrier(0); }
    }
    __device__ __forceinline__ void post(AccRef acc, const Unit& u, int wr, int wc, int fr, int fq, const LAS unsigned char* mt) const {
        const int row0 = u.pm * BM + wr * 64 + fr;
        if (u.pn >= 4) {
            const int ch = 128 * (u.pn - 4) + 32 * wc + 8 * fq;
#pragma unroll
            for (int ai = 0; ai < 2; ++ai)
#pragma unroll
                for (int m = 0; m < 4; ++m) *(u32x4*)(hglu + (size_t)(row0 + ai * HALF + m * 16) * 512 + ch) = AS_U4(acc[ai][0][m][0]);
            return;
        }
        bf16_t* dst; int ld, col; bool is_wi = false;
        if (u.pn < 2) { dst = q; ld = 512; col = (4 * u.pn + wc) * 64; }
        else if (u.pn == 2) { dst = qi; ld = 256; col = wc * 64; }
        else { ld = 64; col = 0; if (wc == 0) dst = k; else if (wc == 1) dst = ki; else if (wc == 2) dst = v; else { dst = v; is_wi = true; } }
        if (is_wi) {
            if (fq == 0) {
#pragma unroll
                for (int ai = 0; ai < 2; ++ai)
#pragma unroll
                    for (int m = 0; m < 4; ++m) *(f32x4*)(wi + (size_t)(row0 + ai * HALF + m * 16) * 4) = acc[ai][0][m][0];
            }
            return;
        }
#pragma unroll
        for (int ai = 0; ai < 2; ++ai)
#pragma unroll
            for (int m = 0; m < 4; ++m) { bf16_t* rp2 = dst + (size_t)(row0 + ai * HALF + m * 16) * ld + col + 8 * fq;
                *(u32x4*)(rp2) = AS_U4(acc[ai][0][m][0]); *(u32x4*)(rp2 + 32) = AS_U4(acc[ai][1][m][0]); }
    }
    __device__ __forceinline__ void run(const f32x4 (&acc)[2][2][4][2], const Unit& u, int wr, int wc, int fr, int fq, const LAS unsigned char* mt) const {
        const int row0 = u.pm * BM + wr * 64 + fr;
        if (u.pn >= 4) {
            const int ch = 128 * (u.pn - 4) + 32 * wc + 8 * fq;
            f32x4 ba[2], bg[2];
#pragma unroll
            for (int n = 0; n < 2; ++n) { ba[n] = *(const f32x4*)(glu_b + ch + 4 * n); bg[n] = *(const f32x4*)(glu_b + 512 + ch + 4 * n); }
#pragma unroll
            for (int ai = 0; ai < 2; ++ai)
#pragma unroll
                for (int m = 0; m < 4; ++m) { const int row = row0 + ai * HALF + m * 16; const float rs = rs1[row];
                    float o[8];
#pragma unroll
                    for (int n = 0; n < 2; ++n)
#pragma unroll
                        for (int e = 0; e < 4; ++e) { const float a = acc[ai][0][m][n][e] * rs + ba[n][e], g = acc[ai][1][m][n][e] * rs + bg[n][e]; o[4 * n + e] = a * sigmoidf_(g); }
                    u32x4 w; w.x = cvt_pk_bf16(o[0], o[1]); w.y = cvt_pk_bf16(o[2], o[3]); w.z = cvt_pk_bf16(o[4], o[5]); w.w = cvt_pk_bf16(o[6], o[7]);
                    *(u32x4*)(hglu + (size_t)row * 512 + ch) = w; }
            return;
        }
        bf16_t* dst; int ld, col; bool do_rope = true, is_wi = false;
        if (u.pn < 2) { dst = q; ld = 512; col = (4 * u.pn + wc) * 64; }
        else if (u.pn == 2) { dst = qi; ld = 256; col = wc * 64; }
        else { ld = 64; col = 0; if (wc == 0) dst = k; else if (wc == 1) dst = ki; else if (wc == 2) { dst = v; do_rope = false; } else { dst = v; is_wi = true; do_rope = false; } }
        if (is_wi) {
            if (fq == 0) {
#pragma unroll
                for (int ai = 0; ai < 2; ++ai)
#pragma unroll
                    for (int m = 0; m < 4; ++m) { const int row = row0 + ai * HALF + m * 16; const float rs = rs1[row];
                        *(f32x4*)(wi + (size_t)row * 4) = acc[ai][0][m][0] * rs; }
            }
            return;
        }
        const int d0 = 8 * fq;
#pragma unroll
        for (int ai = 0; ai < 2; ++ai)
#pragma unroll
            for (int m = 0; m < 4; ++m) { const int row = row0 + ai * HALF + m * 16; const float rs = rs1[row];
                float o1[8], o2[8];
                if (do_rope) {
                    const f32x2* rp = rope + (size_t)(row & (SEQ - 1)) * 32 + d0;
#pragma unroll
                    for (int n = 0; n < 2; ++n)
#pragma unroll
                        for (int e = 0; e < 4; ++e) { const f32x2 cs = rp[4 * n + e]; const float x1 = acc[ai][0][m][n][e] * rs, x2 = acc[ai][1][m][n][e] * rs;
                            o1[4 * n + e] = x1 * cs.x - x2 * cs.y; o2[4 * n + e] = x2 * cs.x + x1 * cs.y; }
                } else {
#pragma unroll
                    for (int n = 0; n < 2; ++n)
#pragma unroll
                        for (int e = 0; e < 4; ++e) { o1[4 * n + e] = acc[ai][0][m][n][e] * rs; o2[4 * n + e] = acc[ai][1][m][n][e] * rs; }
                }
                u32x4 w1, w2; w1.x = cvt_pk_bf16(o1[0], o1[1]); w1.y = cvt_pk_bf16(o1[2], o1[3]); w1.z = cvt_pk_bf16(o1[4], o1[5]); w1.w = cvt_pk_bf16(o1[6], o1[7]);
                w2.x = cvt_pk_bf16(o2[0], o2[1]); w2.y = cvt_pk_bf16(o2[2], o2[3]); w2.z = cvt_pk_bf16(o2[4], o2[5]); w2.w = cvt_pk_bf16(o2[6], o2[7]);
                bf16_t* rp2 = dst + (size_t)row * ld + col + d0;
                *(u32x4*)(rp2) = w1; *(u32x4*)(rp2 + 32) = w2; }
    }
};

struct EpiBf16Plain {
    static constexpr bool PERM = true;
    bf16_t* O; int ldc;
    __device__ __forceinline__ void pre(AccRef acc, const Unit&, int, int, int, int, const LAS unsigned char*) const {
#pragma unroll
        for (int ai = 0; ai < 2; ++ai)
#pragma unroll
            for (int bj = 0; bj < 2; ++bj)
#pragma unroll
                for (int m = 0; m < 4; ++m) pack8_bf16(acc[ai][bj][m][0], acc[ai][bj][m][1]);
    }
    __device__ __forceinline__ void post(AccRef acc, const Unit& u, int wr, int wc, int fr, int fq, const LAS unsigned char* mt) const {
        const int row0 = u.pm * BM + wr * 64 + fr, col0 = u.pn * BM + wc * 32 + 8 * fq;
#pragma unroll
        for (int ai = 0; ai < 2; ++ai)
#pragma unroll
            for (int m = 0; m < 4; ++m) { bf16_t* rowp = O + (size_t)(row0 + ai * HALF + m * 16) * ldc + col0;
#pragma unroll
                for (int bj = 0; bj < 2; ++bj) *(u32x4*)(rowp + bj * HALF) = AS_U4(acc[ai][bj][m][0]); }
    }
    __device__ __forceinline__ void run(const f32x4 (&acc)[2][2][4][2], const Unit& u, int wr, int wc, int fr, int fq, const LAS unsigned char* mt) const {
        const int row0 = u.pm * BM + wr * 64 + fr, col0 = u.pn * BM + wc * 32 + 8 * fq;
#pragma unroll
        for (int ai = 0; ai < 2; ++ai)
#pragma unroll
            for (int m = 0; m < 4; ++m) { bf16_t* rowp = O + (size_t)(row0 + ai * HALF + m * 16) * ldc + col0;
#pragma unroll
                for (int bj = 0; bj < 2; ++bj) { const f32x4 v0 = acc[ai][bj][m][0], v1 = acc[ai][bj][m][1];
                    u32x4 w; w.x = cvt_pk_bf16(v0[0], v0[1]); w.y = cvt_pk_bf16(v0[2], v0[3]); w.z = cvt_pk_bf16(v1[0], v1[1]); w.w = cvt_pk_bf16(v1[2], v1[3]);
                    *(u32x4*)(rowp + bj * HALF) = w; } }
    }
};

struct EpiOutProj {
    static constexpr bool PERM = false;
    const float* x; float* h1; unsigned char* h1f8;
    __device__ __forceinline__ void pre(AccRef acc, const Unit& u, int wr, int wc, int fr, int fq, const LAS unsigned char* mt) const {
        const int row0 = u.pm * BM + wr * 64 + fr, col0 = u.pn * BM + wc * 32 + 4 * fq;
#pragma unroll
        for (int ai = 0; ai < 2; ++ai)
#pragma unroll
            for (int m = 0; m < 4; ++m) { const size_t off = (size_t)(row0 + ai * HALF + m * 16) * DM + col0;
#pragma unroll
                for (int bj = 0; bj < 2; ++bj)
#pragma unroll
                    for (int n = 0; n < 2; ++n) acc[ai][bj][m][n] += *(const f32x4*)(x + off + bj * HALF + n * 16);
                if (m & 1) __builtin_amdgcn_sched_barrier(0); }
    }
    __device__ __forceinline__ void post(AccRef acc, const Unit& u, int wr, int wc, int fr, int fq, const LAS unsigned char* mt) const {
        const int row0 = u.pm * BM + wr * 64 + fr, col0 = u.pn * BM + wc * 32 + 4 * fq;
#pragma unroll
        for (int ai = 0; ai < 2; ++ai)
#pragma unroll
            for (int m = 0; m < 4; ++m) { const size_t off = (size_t)(row0 + ai * HALF + m * 16) * DM + col0;
#pragma unroll
                for (int bj = 0; bj < 2; ++bj)
#pragma unroll
                    for (int n = 0; n < 2; ++n) { const size_t o = off + bj * HALF + n * 16; const f32x4 r = acc[ai][bj][m][n];
                        *(f32x4*)(h1 + o) = r; *(unsigned*)(h1f8 + o) = pk4_fp8(r[0], r[1], r[2], r[3]); } }
    }
    __device__ __forceinline__ void run(AccRef acc, const Unit& u, int wr, int wc, int fr, int fq, const LAS unsigned char* mt) const { pre(acc, u, wr, wc, fr, fq, mt); post(acc, u, wr, wc, fr, fq, mt); }
};

struct EpiUp {
    static constexpr bool PERM = true;
    unsigned char* act;
    __device__ __forceinline__ void pre(AccRef acc, const Unit& u, int wr, int wc, int fr, int fq, const LAS unsigned char* mt) const {
        const int r0 = wr * 64 + fr, cl = 32 * wc + 8 * fq;
        const LAS float* rowA = (const LAS float*)mt; const LAS float* bias = (const LAS float*)(mt + 2048);
        f32x4 bg[2], bl[2];
#pragma unroll
        for (int n = 0; n < 2; ++n) { bg[n] = *(const LAS f32x4*)(bias + cl + 4 * n); bl[n] = *(const LAS f32x4*)(bias + 128 + cl + 4 * n); }
#pragma unroll
        for (int ai = 0; ai < 2; ++ai)
#pragma unroll
            for (int m = 0; m < 4; ++m) { const int r = r0 + ai * HALF + m * 16;
                const float rs = (r < u.rows) ? rowA[r] * 0.03125f : 0.f;
#pragma unroll
                for (int n = 0; n < 2; ++n)
#pragma unroll
                    for (int e = 0; e < 4; ++e) { float g = acc[ai][0][m][n][e] * rs + bg[n][e], l = acc[ai][1][m][n][e] * rs + bl[n][e];
                        g = fminf(g, 7.0f); l = fminf(fmaxf(l, -7.0f), 7.0f); acc[ai][0][m][n][e] = g * sigmoidf_(1.702f * g) * (l + 1.0f); } }
    }
    __device__ __forceinline__ void post(AccRef acc, const Unit& u, int wr, int wc, int fr, int fq, const LAS unsigned char* mt) const {
        const int r0 = wr * 64 + fr, ch = 128 * u.pn + 32 * wc + 8 * fq;
#pragma unroll
        for (int ai = 0; ai < 2; ++ai)
#pragma unroll
            for (int m = 0; m < 4; ++m) { const int r = r0 + ai * HALF + m * 16;
                const f32x4 v0 = acc[ai][0][m][0], v1 = acc[ai][0][m][1];
                u32x2 w; w.x = pk4_fp8(v0[0], v0[1], v0[2], v0[3]); w.y = pk4_fp8(v1[0], v1[1], v1[2], v1[3]);
                *(u32x2*)(act + (size_t)(u.pm * BM + r) * 1024 + ch) = w; }
    }
    __device__ __forceinline__ void run(const f32x4 (&acc)[2][2][4][2], const Unit& u, int wr, int wc, int fr, int fq, const LAS unsigned char* mt) const {
        const int r0 = wr * 64 + fr, cl = 32 * wc + 8 * fq, ch = 128 * u.pn + cl;
        const LAS float* rowA = (const LAS float*)mt; const LAS float* bias = (const LAS float*)(mt + 2048);
        f32x4 bg[2], bl[2];
#pragma unroll
        for (int n = 0; n < 2; ++n) { bg[n] = *(const LAS f32x4*)(bias + cl + 4 * n); bl[n] = *(const LAS f32x4*)(bias + 128 + cl + 4 * n); }
#pragma unroll
        for (int ai = 0; ai < 2; ++ai)
#pragma unroll
            for (int m = 0; m < 4; ++m) { const int r = r0 + ai * HALF + m * 16;
                const float rs = (r < u.rows) ? rowA[r] * 0.03125f : 0.f;
                float o[8];
#pragma unroll
                for (int n = 0; n < 2; ++n)
#pragma unroll
                    for (int e = 0; e < 4; ++e) { float g = acc[ai][0][m][n][e] * rs + bg[n][e], l = acc[ai][1][m][n][e] * rs + bl[n][e];
                        g = fminf(g, 7.0f); l = fminf(fmaxf(l, -7.0f), 7.0f); o[4 * n + e] = g * sigmoidf_(1.702f * g) * (l + 1.0f); }
                u32x2 w; w.x = pk4_fp8(o[0], o[1], o[2], o[3]); w.y = pk4_fp8(o[4], o[5], o[6], o[7]);
                *(u32x2*)(act + (size_t)(u.pm * BM + r) * 1024 + ch) = w; }
    }
};

struct EpiDown {
    static constexpr bool PERM = true;
    bf16_t* y;
    __device__ __forceinline__ void pre(AccRef acc, const Unit& u, int wr, int wc, int fr, int fq, const LAS unsigned char* mt) const {
        const int r0 = wr * 64 + fr, cl = wc * 32 + 8 * fq;
        const LAS float* gateT = (const LAS float*)(mt + 1024); const LAS float* bias = (const LAS float*)(mt + 2048);
        float gt[2][4];
#pragma unroll
        for (int ai = 0; ai < 2; ++ai)
#pragma unroll
            for (int m = 0; m < 4; ++m) gt[ai][m] = gateT[r0 + ai * HALF + m * 16];
#pragma unroll
        for (int bj = 0; bj < 2; ++bj) { const f32x4 bv0 = *(const LAS f32x4*)(bias + cl + bj * HALF), bv1 = *(const LAS f32x4*)(bias + cl + bj * HALF + 4);
#pragma unroll
            for (int ai = 0; ai < 2; ++ai)
#pragma unroll
                for (int m = 0; m < 4; ++m) { acc[ai][bj][m][0] = (acc[ai][bj][m][0] * 0.03125f + bv0) * gt[ai][m]; acc[ai][bj][m][1] = (acc[ai][bj][m][1] * 0.03125f + bv1) * gt[ai][m];
                    pack8_bf16(acc[ai][bj][m][0], acc[ai][bj][m][1]); } }
    }
    __device__ __forceinline__ void post(AccRef acc, const Unit& u, int wr, int wc, int fr, int fq, const LAS unsigned char* mt) const {
        const int r0 = wr * 64 + fr, col0 = u.pn * BM + wc * 32 + 8 * fq;
        const LAS int* slotT = (const LAS int*)mt;
#pragma unroll
        for (int ai = 0; ai < 2; ++ai)
#pragma unroll
            for (int m = 0; m < 4; ++m) { const int r = r0 + ai * HALF + m * 16;
                if (r < u.rows) { bf16_t* rowp = y + (size_t)slotT[r] * 1024 + col0;
#pragma unroll
                    for (int bj = 0; bj < 2; ++bj) *(u32x4*)(rowp + bj * HALF) = AS_U4(acc[ai][bj][m][0]); } }
    }
    __device__ __forceinline__ void run(AccRef acc, const Unit& u, int wr, int wc, int fr, int fq, const LAS unsigned char* mt) const { pre(acc, u, wr, wc, fr, fq, mt); post(acc, u, wr, wc, fr, fq, mt); }
};

template <bool F8>
__device__ __forceinline__ void p0_transpose_item(const float* W, int ldw, void* WTv, int Kdim, const float* gain, LAS float* scr, int kb, int n0, int src0, int nvalid, int lane) {
    bf16_t* WT = (bf16_t*)WTv;
    const int k0 = 64 * kb;
    f32x4 ld4[8];
#pragma unroll
    for (int i = 0; i < 8; ++i) { const int kk = 8 * i + (lane >> 3), j = (lane & 7) * 4;
        ld4[i] = (f32x4){0.f, 0.f, 0.f, 0.f}; if (j < nvalid) ld4[i] = *(const f32x4*)(W + (size_t)(k0 + kk) * ldw + src0 + j); }
#pragma unroll
    for (int i = 0; i < 8; ++i) { const int kk = 8 * i + (lane >> 3), j = (lane & 7) * 4; const float gk = (gain ? gain[k0 + kk] : 1.0f) * (F8 ? 32.0f : 1.0f);
        LAS float* d = scr + kk * 33 + j; d[0] = ld4[i].x * gk; d[1] = ld4[i].y * gk; d[2] = ld4[i].z * gk; d[3] = ld4[i].w * gk; }
    LDS_WAIT(); asm volatile("" ::: "memory");
    const int c = lane & 7;
#pragma unroll
    for (int j = 0; j < 4; ++j) { const int n = (lane >> 3) + 8 * j; const LAS float* s = scr + (8 * c) * 33 + n;
        if constexpr (F8) { u32x2 o; o.x = pk4_fp8(s[0 * 33], s[1 * 33], s[2 * 33], s[3 * 33]); o.y = pk4_fp8(s[4 * 33], s[5 * 33], s[6 * 33], s[7 * 33]);
            *(u32x2*)((unsigned char*)WTv + (size_t)(n0 + n) * Kdim + k0 + 8 * c) = o; }
        else { u32x4 o; o.x = pk2(s[0 * 33], s[1 * 33]); o.y = pk2(s[2 * 33], s[3 * 33]); o.z = pk2(s[4 * 33], s[5 * 33]); o.w = pk2(s[6 * 33], s[7 * 33]);
            *(u32x4*)(WT + (size_t)(n0 + n) * Kdim + k0 + 8 * c) = o; } }
    LDS_WAIT(); asm volatile("" ::: "memory");
}
__device__ __forceinline__ void win_colmap(int nb, int& src0, int& nvalid) {
    const int pn = nb >> 3, j = (nb & 7) * 32, bj = j >> 7, slot = (j & 127) >> 5;
    nvalid = 32;
    if (pn < 2) src0 = (4 * pn + slot) * 64 + 32 * bj;
    else if (pn == 2) src0 = 640 + slot * 64 + 32 * bj;
    else if (pn == 3) { if (slot == 0) src0 = 512 + 32 * bj; else if (slot == 1) src0 = 896 + 32 * bj; else if (slot == 2) src0 = 576 + 32 * bj; else { src0 = 960; nvalid = bj == 0 ? 4 : 0; } }
    else src0 = 964 + 512 * bj + 128 * (pn - 4) + 32 * slot;
}
__device__ __forceinline__ void p0_prologue(const Params& P, LAS unsigned char* lds, int vcu, int G, int wave, int lane) {
    unsigned char* ws = P.ws;
    LAS float* scr = (LAS float*)(lds + wave * 16384);
    const int gw = vcu * NWAVES + wave, NGW = G * NWAVES;
    constexpr int I_IN = 16 * 64, I_OUT = 16 * 32, I_G = 16 * 32, I_P = 4 * 32;
    constexpr int NITEMS = I_IN + I_OUT + I_G + I_P;
    for (int it = gw; it < NITEMS; it += NGW) {
        int r = it;
        if (r < I_IN) { const int kb = r / 64, nb = r % 64; int s0, nv; win_colmap(nb, s0, nv); p0_transpose_item<false>(P.w_in, INW, (bf16_t*)(ws + WS_WIN), 1024, P.g_mix, scr, kb, nb * 32, s0, nv, lane); continue; } r -= I_IN;
        if (r < I_OUT) { const int kb = r / 32, nb = r % 32; p0_transpose_item<false>(P.w_out, 1024, (bf16_t*)(ws + WS_WOUT), 1024, nullptr, scr, kb, nb * 32, nb * 32, 32, lane); continue; } r -= I_OUT;
        if (r < I_G) { const int kb = r / 32, nb = r % 32; p0_transpose_item<false>(P.w_ple_gate, 1024, (bf16_t*)(ws + WS_WG), 1024, P.g_ple, scr, kb, nb * 32, nb * 32, 32, lane); continue; } r -= I_G;
        { const int kb = r / 32, nb = r % 32; p0_transpose_item<false>(P.w_ple_proj, 1024, (bf16_t*)(ws + WS_WP), 256, nullptr, scr, kb, nb * 32, nb * 32, 32, lane); }
    }
    float* rs1 = (float*)(ws + WS_RS1); bf16_t* xb = (bf16_t*)(ws + WS_XB);
    for (int m = gw; m < NTOK; m += NGW) {
        const f32x4* xr = (const f32x4*)(P.x + (size_t)m * DM) + lane; f32x4 v[4]; float s = 0.f;
#pragma unroll
        for (int j = 0; j < 4; ++j) { v[j] = xr[64 * j]; s += (v[j].x * v[j].x + v[j].y * v[j].y) + (v[j].z * v[j].z + v[j].w * v[j].w); }
        s = wave_sum(s);
        u32x2* o8 = (u32x2*)(xb + (size_t)m * DM) + lane;
#pragma unroll
        for (int j = 0; j < 4; ++j) { u32x2 w; w.x = pk2(v[j].x, v[j].y); w.y = pk2(v[j].z, v[j].w); o8[64 * j] = w; }
        if (lane == 0) rs1[m] = 1.0f / sqrtf(s * (1.0f / DM) + EPS);
    }
    bf16_t* pb = (bf16_t*)(ws + WS_PB);
    for (int m = gw; m < NTOK; m += NGW) { const f32x4 v = *((const f32x4*)(P.p + (size_t)m * 256) + lane); u32x2 w; w.x = pk2(v.x, v.y); w.y = pk2(v.z, v.w); *((u32x2*)(pb + (size_t)m * 256) + lane) = w; }
    f32x2* rope = (f32x2*)(ws + WS_ROPE);
    for (int idx = gw * 64 + lane; idx < SEQ * 32; idx += NGW * 64) { const int t = idx >> 5, i = idx & 31;
        const float inv = exp2f(-(float)i * (13.287712379549449f / 32.0f));
        const float ang = (float)t * inv;
        const double rev = (double)ang * 0.15915494309189535; const float fr = (float)(rev - __builtin_floor(rev));
        rope[idx] = (f32x2){__builtin_amdgcn_cosf(fr), __builtin_amdgcn_sinf(fr)}; }
    float* wrg = (float*)(ws + WS_WRG);
    for (int idx = gw * 64 + lane; idx < 1024 * 32; idx += NGW * 64) wrg[idx] = P.w_router[idx] * P.g_ffn[idx >> 5];
}

__device__ __forceinline__ unsigned fkey(float f) { unsigned u = __builtin_bit_cast(unsigned, f); if (u == 0x80000000u) u = 0u; return u ^ ((unsigned)((int)u >> 31) | 0x80000000u); }
__device__ __forceinline__ int mbcnt64(unsigned long long m) { return __builtin_amdgcn_mbcnt_hi((unsigned)(m >> 32), __builtin_amdgcn_mbcnt_lo((unsigned)m, 0u)); }

template <int NR>
__device__ __forceinline__ unsigned bisect_thr(const unsigned (&v)[NR], unsigned prefix, int startbit) {
    bool exact = false;
#pragma unroll 1
    for (int bit = startbit; bit >= 0; --bit) {
        const unsigned cand = prefix | (1u << bit); int cnt = 0;
#pragma unroll
        for (int r = 0; r < NR; ++r) { cnt += __builtin_popcountll(__ballot(v[r] >= cand)); if ((r & 7) == 7) __builtin_amdgcn_sched_barrier(0); }
        if (cnt >= NSEL) prefix = cand;
        if (cnt == NSEL) { exact = true; break; }
    }
    return exact ? prefix - 1u : prefix;
}
template <int NR, bool EXPL>
__device__ __forceinline__ void compact_sel(const unsigned (&v)[NR], const unsigned (&ci)[NR], unsigned T, LAS unsigned* list, int lane) {
    int cgt = 0;
#pragma unroll
    for (int r = 0; r < NR; ++r) { cgt += __builtin_popcountll(__ballot(v[r] > T)); if ((r & 7) == 7) __builtin_amdgcn_sched_barrier(0); }
    const int need = NSEL - cgt; int base = 0, ties = 0;
#pragma unroll
    for (int r = 0; r < NR; ++r) { const bool gt = v[r] > T, eq = v[r] == T; const unsigned long long em = __ballot(eq);
        const bool sel = gt || (eq && (ties + mbcnt64(em)) < need); const unsigned long long sm = __ballot(sel);
        list[sel ? base + mbcnt64(sm) : NSEL + lane] = EXPL ? ci[r] : (unsigned)(r * 64 + lane);
        base += __builtin_popcountll(sm); ties += __builtin_popcountll(em);
        if ((r & 3) == 3) __builtin_amdgcn_sched_barrier(0); }
}
constexpr int SEL_CAP = 1024;
template <int NR>
__device__ __forceinline__ void select_topk(LAS float* row, LAS unsigned* H, LAS unsigned* list, int lane, bool zero_h) {
    unsigned v[NR];
#pragma unroll
    for (int r = 0; r < NR; ++r) v[r] = fkey(row[r * 64 + lane]);
    LAS u32x4* H4 = (LAS u32x4*)H;
    const u32x4 h0 = H4[2 * lane], h1 = H4[2 * lane + 1];
    if (zero_h) { H4[2 * lane] = (u32x4){0u, 0u, 0u, 0u}; H4[2 * lane + 1] = (u32x4){0u, 0u, 0u, 0u}; }
    const unsigned hw[8] = {h0.x, h0.y, h0.z, h0.w, h1.x, h1.y, h1.z, h1.w};
    unsigned c[16];
#pragma unroll
    for (int i = 0; i < 8; ++i) { c[2 * i] = hw[i] & 0xffffu; c[2 * i + 1] = hw[i] >> 16; }
    unsigned s = 0u;
#pragma unroll
    for (int i = 0; i < 16; ++i) s += c[i];
    unsigned S = s;
#pragma unroll
    for (int off = 1; off < 64; off <<= 1) { const unsigned o = __shfl_down(S, off); if (lane + off < 64) S += o; }
    const unsigned long long okm = __ballot(S >= (unsigned)NSEL);
    bool fast = okm != 0ull; unsigned floorkey = 0u; int C = 0;
    if (fast) {
        const int Ls = 63 - __builtin_clzll(okm);
        unsigned acc = S - s; int bl = -1; unsigned accb = 0u;
#pragma unroll
        for (int b = 15; b >= 0; --b) { acc += c[b]; if (bl < 0 && acc >= (unsigned)NSEL) { bl = b; accb = acc; } }
        const int bstar = __shfl(bl, Ls) + 16 * Ls; C = (int)__shfl(accb, Ls);
        floorkey = (unsigned)bstar << 22;
        fast = (bstar > 1) && (C <= SEL_CAP);
    }
    if (!fast) {
        const unsigned T = bisect_thr<NR>(v, 0u, 31);
        compact_sel<NR, false>(v, v, T, list, lane);
        return;
    }
    LAS unsigned* ckl = (LAS unsigned*)row; LAS unsigned* cil = ckl + 1152;
    { int base = 0;
#pragma unroll
      for (int r = 0; r < NR; ++r) { const bool cnd = v[r] >= floorkey; const unsigned long long m = __ballot(cnd);
          const int pos = cnd ? base + mbcnt64(m) : SEL_CAP + lane;
          ckl[pos] = v[r]; cil[pos] = (unsigned)(r * 64 + lane); base += __builtin_popcountll(m);
          if ((r & 3) == 3) __builtin_amdgcn_sched_barrier(0); } }
    if (C <= 512) {
        unsigned ck[8], ci[8];
#pragma unroll
        for (int j = 0; j < 8; ++j) { const int i = j * 64 + lane; ck[j] = i < C ? ckl[i] : 0u; ci[j] = cil[i]; }
        const unsigned T = (C == NSEL) ? floorkey - 1u : bisect_thr<8>(ck, floorkey, 21);
        compact_sel<8, true>(ck, ci, T, list, lane);
    } else {
        unsigned ck[16], ci[16];
#pragma unroll
        for (int j = 0; j < 16; ++j) { const int i = j * 64 + lane; ck[j] = i < C ? ckl[i] : 0u; ci[j] = cil[i]; }
        const unsigned T = bisect_thr<16>(ck, floorkey, 21);
        compact_sel<16, true>(ck, ci, T, list, lane);
    }
}

typedef short v4i16 __attribute__((ext_vector_type(4)));
constexpr int VROW = 144;

__device__ __forceinline__ void attn_tile(const Params& P, LAS unsigned char* lds, int b, int t0, int wave, int lane) {
    unsigned char* ws = P.ws;
    const bf16_t* QI = (const bf16_t*)(ws + WS_QI); const bf16_t* KI = (const bf16_t*)(ws + WS_KI);
    const bf16_t* Q = (const bf16_t*)(ws + WS_Q); const bf16_t* Kp = (const bf16_t*)(ws + WS_K); const bf16_t* Vp = (const bf16_t*)(ws + WS_V);
    const float* WI = (const float*)(ws + WS_WI); bf16_t* MIX = (bf16_t*)(ws + WS_MIX);
    LAS float* SC = (LAS float*)lds;
    LAS unsigned* list = (LAS unsigned*)(lds + wave * 16384 + 14336);
    LAS unsigned* HIST = (LAS unsigned*)(lds + LDS_MISC);
    const int tokbase = b * SEQ;
    const bool need_sel = t0 >= 256;
    if (need_sel) {
        const int nkt = (t0 + 8 + 31) >> 5;
        bf16x8 a[4]; f32x4 w[4];
        { const bf16_t* src = QI + (size_t)(tokbase + t0 + ((lane & 31) >> 2)) * 256 + (lane & 3) * 64 + 8 * (lane >> 5);
#pragma unroll
          for (int ks = 0; ks < 4; ++ks) a[ks] = *(const bf16x8*)(src + 16 * ks); }
#pragma unroll
        for (int g = 0; g < 4; ++g) w[g] = *(const f32x4*)(WI + (size_t)(tokbase + t0 + 2 * g + (lane >> 5)) * 4);
        for (int kt0 = wave; kt0 < nkt; kt0 += 4 * NWAVES) {
            bf16x8 bf[4][4];
#pragma unroll
            for (int u = 0; u < 4; ++u) { const int kt = kt0 + u * NWAVES;
                if (kt < nkt) { const bf16_t* ksrc = KI + (size_t)(tokbase + kt * 32 + (lane & 31)) * 64 + 8 * (lane >> 5);
#pragma unroll
                    for (int ks = 0; ks < 4; ++ks) bf[u][ks] = *(const bf16x8*)(ksrc + 16 * ks); } }
#pragma unroll
            for (int u = 0; u < 4; ++u) { const int kt = kt0 + u * NWAVES;
                if (kt < nkt) {
                    const int key = kt * 32 + (lane & 31);
                    f32x16 acc;
#pragma unroll
                    for (int i = 0; i < 16; ++i) acc[i] = 0.f;
#pragma unroll
                    for (int ks = 0; ks < 4; ++ks) acc = __builtin_amdgcn_mfma_f32_32x32x16_bf16(a[ks], bf[u][ks], acc, 0, 0, 0);
#pragma unroll
                    for (int g = 0; g < 4; ++g) { float sc = 0.f;
#pragma unroll
                        for (int h = 0; h < 4; ++h) sc = fmaf(fmaxf(acc[4 * g + h], 0.f), w[g][h], sc);
                        const int ql = 2 * g + (lane >> 5);
                        if (key > t0 + ql) sc = -INFINITY;
                        SC[ql * 4096 + key] = sc;
                        if (key <= t0 + ql) { const unsigned ub = __builtin_bit_cast(unsigned, sc);
                            const unsigned bin = (ub >> 22) ^ (((unsigned)((int)ub >> 31) & 0x1ffu) | 0x200u);
                            __hip_atomic_fetch_add(HIST + ql * 512 + (bin >> 1), 1u << ((bin & 1u) << 4), __ATOMIC_RELAXED, __HIP_MEMORY_SCOPE_WORKGROUP); } }
                } }
        }
        { const int npad = ((t0 + 8 + 1023) >> 10) << 10;
          for (int i = nkt * 32 + (int)threadIdx.x; i < npad; i += NTHR) {
#pragma unroll
              for (int q = 0; q < 8; ++q) SC[q * 4096 + i] = -INFINITY; } }
    }
    __syncthreads();
    const int t = t0 + wave, tok = tokbase + t;
    if (need_sel) {
        LAS float* row = SC + wave * 4096; LAS unsigned* H = HIST + wave * 512; const int n = t + 1;
        if (n <= 1024) select_topk<16>(row, H, list, lane, true);
        else if (n <= 2048) select_topk<32>(row, H, list, lane, true);
        else if (n <= 3072) select_topk<48>(row, H, list, lane, true);
        else select_topk<64>(row, H, list, lane, true);
    } else {
#pragma unroll
        for (int i = 0; i < 4; ++i) list[i * 64 + lane] = (unsigned)(i * 64 + lane);
    }
    const int nvalid = need_sel ? NSEL : (t + 1);
    const int ngrp = (nvalid + 31) >> 5;
    const int hd = lane & 15, g = lane >> 4;
    bf16x8 qf0, qf1;
#pragma unroll
    for (int i = 0; i < 8; ++i) { qf0[i] = 0; qf1[i] = 0; }
    if (hd < 8) { const bf16_t* qs = Q + (size_t)tok * 512 + hd * 64 + 8 * g; qf0 = *(const bf16x8*)qs; qf1 = *(const bf16x8*)(qs + 32); }
    float m = -INFINITY, ssum = 0.f;
    f32x4 o[4];
#pragma unroll
    for (int dt = 0; dt < 4; ++dt) o[dt] = (f32x4){0.f, 0.f, 0.f, 0.f};
    LAS unsigned char* vreg = lds + wave * 16384;
    bf16x8 kfA[4], kfB[4]; u32x4 vvA[4], vvB[4];
#define ATT_LOAD(KF, VV, G_) do { const int nb_ = (G_) * 32; const unsigned ia_ = list[nb_ + hd], ib_ = list[nb_ + 16 + hd]; \
        const bf16_t* ka_ = Kp + (size_t)(tokbase + ia_) * 64 + 8 * g; const bf16_t* kb_ = Kp + (size_t)(tokbase + ib_) * 64 + 8 * g; \
        KF[0] = *(const bf16x8*)ka_; KF[1] = *(const bf16x8*)(ka_ + 32); KF[2] = *(const bf16x8*)kb_; KF[3] = *(const bf16x8*)(kb_ + 32); \
        _Pragma("unroll") for (int i_ = 0; i_ < 4; ++i_) { const unsigned idx_ = list[nb_ + (lane >> 3) + 8 * i_]; VV[i_] = *(const u32x4*)(Vp + (size_t)(tokbase + idx_) * 64 + 8 * (lane & 7)); } } while (0)
#define ATT_GROUP(KF, VV, G_, VBUF) do { \
        LAS unsigned char* vbuf_ = (VBUF); \
        f32x4 sa_ = {0.f, 0.f, 0.f, 0.f}, sb_ = {0.f, 0.f, 0.f, 0.f}; \
        sa_ = __builtin_amdgcn_mfma_f32_16x16x32_bf16(KF[0], qf0, sa_, 0, 0, 0); sa_ = __builtin_amdgcn_mfma_f32_16x16x32_bf16(KF[1], qf1, sa_, 0, 0, 0); \
        sb_ = __builtin_amdgcn_mfma_f32_16x16x32_bf16(KF[2], qf0, sb_, 0, 0, 0); sb_ = __builtin_amdgcn_mfma_f32_16x16x32_bf16(KF[3], qf1, sb_, 0, 0, 0); \
        _Pragma("unroll") for (int i_ = 0; i_ < 4; ++i_) *(LAS u32x4*)(vbuf_ + ((lane >> 3) + 8 * i_) * VROW + (lane & 7) * 16) = VV[i_]; \
        if ((G_) + 2 < ngrp) ATT_LOAD(KF, VV, (G_) + 2); \
        float l_[8]; float mloc_ = -INFINITY; \
        _Pragma("unroll") for (int r_ = 0; r_ < 4; ++r_) { const int sl_ = (G_) * 32 + 4 * g + r_; \
            l_[r_] = sl_ < nvalid ? sa_[r_] * 0.125f : -INFINITY; l_[4 + r_] = (sl_ + 16) < nvalid ? sb_[r_] * 0.125f : -INFINITY; \
            mloc_ = fmaxf(mloc_, fmaxf(l_[r_], l_[4 + r_])); } \
        mloc_ = fmaxf(mloc_, __shfl_xor(mloc_, 16)); mloc_ = fmaxf(mloc_, __shfl_xor(mloc_, 32)); \
        const float mnew_ = fmaxf(m, mloc_), alpha_ = __expf(m - mnew_); m = mnew_; \
        float ps_ = 0.f; \
        _Pragma("unroll") for (int r_ = 0; r_ < 8; ++r_) { l_[r_] = __expf(l_[r_] - mnew_); ps_ += l_[r_]; } \
        ssum = ssum * alpha_ + ps_; \
        bf16x8 pf_; \
        { const u32x4 pw_ = {cvt_pk_bf16(l_[0], l_[1]), cvt_pk_bf16(l_[2], l_[3]), cvt_pk_bf16(l_[4], l_[5]), cvt_pk_bf16(l_[6], l_[7])}; pf_ = __builtin_bit_cast(bf16x8, pw_); } \
        LAS unsigned char* ta_ = vbuf_ + (4 * g + (hd >> 2)) * VROW + (hd & 3) * 8; \
        _Pragma("unroll") for (int dt_ = 0; dt_ < 4; ++dt_) { \
            const v4i16 lo_ = __builtin_amdgcn_ds_read_tr16_b64_v4i16((LAS v4i16*)(ta_ + dt_ * 32)); \
            const v4i16 hi_ = __builtin_amdgcn_ds_read_tr16_b64_v4i16((LAS v4i16*)(ta_ + 16 * VROW + dt_ * 32)); \
            bf16x8 vf_; vf_[0] = lo_[0]; vf_[1] = lo_[1]; vf_[2] = lo_[2]; vf_[3] = lo_[3]; vf_[4] = hi_[0]; vf_[5] = hi_[1]; vf_[6] = hi_[2]; vf_[7] = hi_[3]; \
            o[dt_] = __builtin_amdgcn_mfma_f32_16x16x32_bf16(vf_, pf_, o[dt_] * alpha_, 0, 0, 0); } } while (0)
    ATT_LOAD(kfA, vvA, 0);
    if (ngrp > 1) ATT_LOAD(kfB, vvB, 1);
#pragma unroll 1
    for (int grp = 0; grp < ngrp; grp += 2) {
        ATT_GROUP(kfA, vvA, grp, vreg);
        if (grp + 1 < ngrp) ATT_GROUP(kfB, vvB, grp + 1, vreg + 8192);
    }
#undef ATT_LOAD
#undef ATT_GROUP
    ssum += __shfl_xor(ssum, 16); ssum += __shfl_xor(ssum, 32);
    const float inv = 1.0f / ssum;
    if (hd < 8) {
        bf16_t* op = MIX + (size_t)tok * 1024 + hd * 64 + 4 * g;
#pragma unroll
        for (int dt = 0; dt < 4; ++dt) { u32x2 w; w.x = cvt_pk_bf16(o[dt][0] * inv, o[dt][1] * inv); w.y = cvt_pk_bf16(o[dt][2] * inv, o[dt][3] * inv); *(u32x2*)(op + 16 * dt) = w; }
    }
    __syncthreads();
}

__device__ __forceinline__ void conv_tile(const Params& P, LAS unsigned char* lds, int tile, int tid, int wave, int lane) {
    unsigned char* ws = P.ws;
    const bf16_t* HG = (const bf16_t*)(ws + WS_HGLU); bf16_t* MIX = (bf16_t*)(ws + WS_MIX);
    LAS f32x2* part = (LAS f32x2*)(lds + LDS_MISC + 1024);
    LAS f32x2* stat = part + 256;
    LAS bf16_t* Lin = (LAS bf16_t*)lds;
    LAS bf16_t* Lout = (LAS bf16_t*)(lds + 65536);
    const int tok0 = tile * 32, t0 = tok0 & (SEQ - 1), c = tid;
    for (int ch = tid; ch < 62 * 64; ch += NTHR) { const int r = ch >> 6, cc = ch & 63; const int tt = t0 - 30 + r;
        u32x4 v = {0u, 0u, 0u, 0u}; if (tt >= 0) v = *(const u32x4*)(HG + (size_t)(tok0 - 30 + r) * 512 + cc * 8);
        *(LAS u32x4*)(Lin + r * 512 + cc * 8) = v; }
    __syncthreads();
    float in[62];
#pragma unroll
    for (int r = 0; r < 62; ++r) in[r] = __builtin_bit_cast(float, (unsigned)Lin[r * 512 + c] << 16);
    float out[32];
    const float bias = P.dw_b[c];
#pragma unroll
    for (int i = 0; i < 32; ++i) out[i] = bias;
#pragma unroll
    for (int j = 0; j < 31; ++j) { const float wj = P.dw_w[j * 512 + c];
#pragma unroll
        for (int i = 0; i < 32; ++i) out[i] = fmaf(in[i + j], wj, out[i]); }
#pragma unroll
    for (int i = 0; i < 32; ++i) { const float s1 = wave_sum(out[i]), s2 = wave_sum(out[i] * out[i]); if (lane == 0) part[i * 8 + wave] = (f32x2){s1, s2}; }
    __syncthreads();
    if (tid < 32) { float s1 = 0.f, s2 = 0.f;
#pragma unroll
        for (int w = 0; w < 8; ++w) { const f32x2 pp = part[tid * 8 + w]; s1 += pp.x; s2 += pp.y; }
        const float mean = s1 * (1.0f / 512.0f), var = fmaxf(s2 * (1.0f / 512.0f) - mean * mean, 0.f);
        stat[tid] = (f32x2){mean, 1.0f / sqrtf(var + EPS)}; }
    __syncthreads();
    const float lgc = P.ln_g[c], lbc = P.ln_b[c];
#pragma unroll
    for (int i = 0; i < 32; ++i) { const f32x2 st = stat[i]; const float y = (out[i] - st.x) * st.y * lgc + lbc; const float sl = y * sigmoidf_(y);
        Lout[i * 512 + c] = (bf16_t)f2bf(sl); }
    __syncthreads();
    for (int ch = tid; ch < 32 * 64; ch += NTHR) { const int r = ch >> 6, cc = ch & 63;
        *(u32x4*)(MIX + (size_t)(tok0 + r) * 1024 + 512 + cc * 8) = *(const LAS u32x4*)(Lout + r * 512 + cc * 8); }
    __syncthreads();
}

constexpr int MW_UP = 32 * 16 * 64, MW_DN = 32 * 16 * 32, MW_ITEMS = MW_UP + MW_DN;
__device__ __forceinline__ void mw_decode(const Params& P, int it, const float*& src, int& ldw, unsigned char*& dst, const float*& gain) {
    unsigned char* ws = P.ws;
    if (it < MW_UP) { const int e = it >> 10, rr = it & 1023, kb = rr >> 6, nb = rr & 63, pn = nb >> 3, j = (nb & 7) * 32, bj = j >> 7, jj = j & 127;
        src = P.w_up + (size_t)e * 1024 * 2048 + (size_t)(kb * 64) * 2048 + 1024 * bj + 128 * pn + jj; ldw = 2048;
        dst = ws + WS_WUP + (size_t)e * 2048 * 1024 + (size_t)(nb * 32) * 1024 + kb * 64; gain = P.g_ffn + kb * 64; }
    else { const int r = it - MW_UP, e = r >> 9, rr = r & 511, kb = rr >> 5, nb = rr & 31;
        src = P.w_down + (size_t)e * 1024 * 1024 + (size_t)(kb * 64) * 1024 + nb * 32; ldw = 1024;
        dst = ws + WS_WDOWN + (size_t)e * 1024 * 1024 + (size_t)(nb * 32) * 1024 + kb * 64; gain = nullptr; }
}
#define MW_LOAD(LD, it_) do { if ((it_) < MW_ITEMS) { const float* src_; int ldw_; unsigned char* dst_; const float* gain_; mw_decode(P, (it_), src_, ldw_, dst_, gain_); \
        _Pragma("unroll") for (int i_ = 0; i_ < 8; ++i_) LD[i_] = *(const f32x4*)(src_ + (size_t)(8 * i_ + (lane >> 3)) * ldw_ + (lane & 7) * 4); } } while (0)
#define MW_FINISH(LD, it_) do { if ((it_) < MW_ITEMS) { const float* src_; int ldw_; unsigned char* dst_; const float* gain_; mw_decode(P, (it_), src_, ldw_, dst_, gain_); \
        _Pragma("unroll") for (int i_ = 0; i_ < 8; ++i_) { const int kk_ = 8 * i_ + (lane >> 3), j_ = (lane & 7) * 4; const float gk_ = (gain_ ? gain_[kk_] : 1.0f) * 32.0f; \
            LAS float* d_ = scr + kk_ * 33 + j_; d_[0] = LD[i_].x * gk_; d_[1] = LD[i_].y * gk_; d_[2] = LD[i_].z * gk_; d_[3] = LD[i_].w * gk_; } \
        LDS_WAIT(); asm volatile("" ::: "memory"); \
        const int c_ = lane & 7; \
        _Pragma("unroll") for (int j_ = 0; j_ < 4; ++j_) { const int n_ = (lane >> 3) + 8 * j_; const LAS float* sp_ = scr + (8 * c_) * 33 + n_; \
            u32x2 o_; o_.x = pk4_fp8(sp_[0 * 33], sp_[1 * 33], sp_[2 * 33], sp_[3 * 33]); o_.y = pk4_fp8(sp_[4 * 33], sp_[5 * 33], sp_[6 * 33], sp_[7 * 33]); \
            *(u32x2*)(dst_ + (size_t)n_ * 1024 + 8 * c_) = o_; } \
        LDS_WAIT(); asm volatile("" ::: "memory"); } } while (0)
__device__ __forceinline__ void moe_weight_convert(const Params& P, LAS float* scr, int cw, int ncw, int lane) {
    f32x4 l0[8], l1[8], l2[8], l3[8];
    MW_LOAD(l0, cw); MW_LOAD(l1, cw + ncw); MW_LOAD(l2, cw + 2 * ncw);
    for (int base = cw; base < MW_ITEMS; base += 4 * ncw) {
        MW_LOAD(l3, base + 3 * ncw); MW_FINISH(l0, base);
        MW_LOAD(l0, base + 4 * ncw); MW_FINISH(l1, base + ncw);
        MW_LOAD(l1, base + 5 * ncw); MW_FINISH(l2, base + 2 * ncw);
        MW_LOAD(l2, base + 6 * ncw); MW_FINISH(l3, base + 3 * ncw);
    }
}
#undef MW_LOAD
#undef MW_FINISH

__device__ __forceinline__ void router_phase(const Params& P, LAS unsigned char* lds, int blk, int G, int tid, int wave, int lane) {
    unsigned char* ws = P.ws;
    const float* h1 = (const float*)(ws + WS_H1); const float* wrg = (const float*)(ws + WS_WRG);
    int* list = (int*)(ws + WS_LIST); float* lscale = (float*)(ws + WS_LSCALE); float* lgate = (float*)(ws + WS_LGATE);
    unsigned* cntg = (unsigned*)(ws + WS_CTL) + CW_CNT;
    LAS float* WL = (LAS float*)lds;
    LAS int* lcnt = (LAS int*)(lds + LDS_MISC + 1024);
    LAS int* gbase = lcnt + 32;
    LAS int* rec_e = gbase + 32;
    LAS int* rec_p = rec_e + 512;
    LAS float* rec_g = (LAS float*)(rec_p + 512);
    LAS float* rec_s = rec_g + 512;
    for (int i = tid; i < 8192; i += NTHR) ((LAS f32x4*)WL)[i] = ((const f32x4*)wrg)[i];
    __syncthreads();
    const int tl = lane & 31, half = lane >> 5;
    for (int chunk = blk; chunk < NTOK / 128; chunk += G) {
        if (tid < 32) lcnt[tid] = 0;
        __syncthreads();
        if (wave < 4) {
            const int tloc = wave * 32 + tl, tok = chunk * 128 + tloc;
            const float* hrow = h1 + (size_t)tok * DM + 4 * half;
            f32x16 acc;
#pragma unroll
            for (int i = 0; i < 16; ++i) acc[i] = 0.f;
            float ss = 0.f;
#pragma unroll 1
            for (int k0 = 0; k0 < DM; k0 += 32) {
                f32x4 hv[4];
#pragma unroll
                for (int i = 0; i < 4; ++i) hv[i] = *(const f32x4*)(hrow + k0 + 8 * i);
#pragma unroll
                for (int i = 0; i < 4; ++i) {
                    ss = fmaf(hv[i].x, hv[i].x, fmaf(hv[i].y, hv[i].y, fmaf(hv[i].z, hv[i].z, fmaf(hv[i].w, hv[i].w, ss))));
#pragma unroll
                    for (int j = 0; j < 4; ++j) { const float wv = WL[(k0 + 8 * i + 4 * half + j) * 32 + tl];
                        acc = __builtin_amdgcn_mfma_f32_32x32x2f32(wv, hv[i][j], acc, 0, 0, 0); }
                }
            }
            ss += __shfl_xor(ss, 32);
            const float rs = 1.0f / sqrtf(ss * (1.0f / DM) + EPS);
            float v[16];
#pragma unroll
            for (int r = 0; r < 16; ++r) v[r] = acc[r] * rs + P.b_router[(r & 3) + 8 * (r >> 2) + 4 * half];
            float tv[4]; int te[4];
#pragma unroll
            for (int q = 0; q < 4; ++q) { float bv = -INFINITY; int be = 64;
#pragma unroll
                for (int r = 0; r < 16; ++r) { const int e = (r & 3) + 8 * (r >> 2) + 4 * half; if (v[r] > bv || (v[r] == bv && e < be)) { bv = v[r]; be = e; } }
#pragma unroll
                for (int r = 0; r < 16; ++r) { const int e = (r & 3) + 8 * (r >> 2) + 4 * half; if (e == be) v[r] = -INFINITY; }
                tv[q] = bv; te[q] = be; }
            float cv[8]; int ce[8];
#pragma unroll
            for (int q = 0; q < 4; ++q) { cv[q] = tv[q]; ce[q] = te[q]; cv[4 + q] = __shfl_xor(tv[q], 32); ce[4 + q] = __shfl_xor(te[q], 32); }
#pragma unroll
            for (int q = 0; q < 4; ++q) { float bv = -INFINITY; int be = 64;
#pragma unroll
                for (int r = 0; r < 8; ++r) if (cv[r] > bv || (cv[r] == bv && ce[r] < be)) { bv = cv[r]; be = ce[r]; }
#pragma unroll
                for (int r = 0; r < 8; ++r) if (ce[r] == be) cv[r] = -INFINITY;
                tv[q] = bv; te[q] = be; }
            const float e1 = __expf(tv[1] - tv[0]), e2 = __expf(tv[2] - tv[0]), e3 = __expf(tv[3] - tv[0]);
            const float is = 1.0f / (1.0f + e1 + e2 + e3);
            if (half == 0) {
                const float gq[4] = {is, e1 * is, e2 * is, e3 * is};
#pragma unroll
                for (int q = 0; q < 4; ++q) { const int lp = atomicAdd((int*)&lcnt[te[q]], 1); const int si = tloc * 4 + q; rec_e[si] = te[q]; rec_p[si] = lp; rec_g[si] = gq[q]; }
                rec_s[tloc] = rs;
            }
        }
        __syncthreads();
        if (tid < 32) gbase[tid] = (int)atomicAdd(cntg + 64 * tid, (unsigned)lcnt[tid]);
        __syncthreads();
        { const int si = tid, ee = rec_e[si], pos = gbase[ee] + rec_p[si], li = ee * NTOK + pos;
          list[li] = (chunk * 128) * 4 + si; lscale[li] = rec_s[si >> 2]; lgate[li] = rec_g[si]; }
        __syncthreads();
    }
}

__device__ __forceinline__ void combine_phase(const Params& P, int gw, int NGW, int lane) {
    unsigned char* ws = P.ws;
    float* h1 = (float*)(ws + WS_H1); bf16_t* h1b = (bf16_t*)(ws + WS_H1B); const bf16_t* y = (const bf16_t*)(ws + WS_Y); float* rs3 = (float*)(ws + WS_RS3);
    for (int m = gw; m < NTOK; m += NGW) {
        const f32x4* hr = (const f32x4*)(h1 + (size_t)m * DM) + lane; f32x4 v[4]; float s = 0.f;
#pragma unroll
        for (int j = 0; j < 4; ++j) v[j] = hr[64 * j];
#pragma unroll
        for (int k = 0; k < 4; ++k) { const u32x2* yr = (const u32x2*)(y + (size_t)(m * 4 + k) * DM) + lane;
#pragma unroll
            for (int j = 0; j < 4; ++j) { const u32x2 w = yr[64 * j]; v[j].x += bf_lo(w.x); v[j].y += bf_hi(w.x); v[j].z += bf_lo(w.y); v[j].w += bf_hi(w.y); } }
        u32x2* o8 = (u32x2*)(h1b + (size_t)m * DM) + lane;
#pragma unroll
        for (int j = 0; j < 4; ++j) { u32x2 w; w.x = pk2(v[j].x, v[j].y); w.y = pk2(v[j].z, v[j].w); o8[64 * j] = w;
            s += (v[j].x * v[j].x + v[j].y * v[j].y) + (v[j].z * v[j].z + v[j].w * v[j].w); }
        s = wave_sum(s);
        if (lane == 0) rs3[m] = 1.0f / sqrtf(s * (1.0f / DM) + EPS);
    }
}

__device__ __forceinline__ void final_phase(const Params& P, int gw, int NGW, int lane) {
    unsigned char* ws = P.ws;
    const bf16_t* h2b = (const bf16_t*)(ws + WS_H1B); const bf16_t* pj = (const bf16_t*)(ws + WS_PJ); const bf16_t* G = (const bf16_t*)(ws + WS_G); const float* rs3 = (const float*)(ws + WS_RS3);
    f32x4 gv[4];
#pragma unroll
    for (int j = 0; j < 4; ++j) gv[j] = *((const f32x4*)P.g_final + lane + 64 * j);
    for (int m = gw; m < NTOK; m += NGW) {
        const u32x2* hr = (const u32x2*)(h2b + (size_t)m * DM) + lane; const u32x2* pr = (const u32x2*)(pj + (size_t)m * DM) + lane; const u32x2* gr = (const u32x2*)(G + (size_t)m * DM) + lane;
        const float r3 = rs3[m]; f32x4 v[4]; float s = 0.f;
#pragma unroll
        for (int j = 0; j < 4; ++j) { const u32x2 hw = hr[64 * j], pw = pr[64 * j], gw2 = gr[64 * j];
            v[j].x = bf_lo(hw.x) + bf_lo(pw.x) * sigmoidf_(bf_lo(gw2.x) * r3); v[j].y = bf_hi(hw.x) + bf_hi(pw.x) * sigmoidf_(bf_hi(gw2.x) * r3);
            v[j].z = bf_lo(hw.y) + bf_lo(pw.y) * sigmoidf_(bf_lo(gw2.y) * r3); v[j].w = bf_hi(hw.y) + bf_hi(pw.y) * sigmoidf_(bf_hi(gw2.y) * r3);
            s += (v[j].x * v[j].x + v[j].y * v[j].y) + (v[j].z * v[j].z + v[j].w * v[j].w); }
        s = wave_sum(s); const float rs = 1.0f / sqrtf(s * (1.0f / DM) + EPS);
        f32x4* orow = (f32x4*)(P.out + (size_t)m * DM) + lane;
#pragma unroll
        for (int j = 0; j < 4; ++j) orow[64 * j] = v[j] * rs * gv[j];
    }
}

#define XB_TMO      128
#define XB_XCNT(j)  (256  + 64 * (j))
#define XB_XSUB(j)  (1280 + 64 * (j))
#define XB_XGEN(j)  (2304 + 64 * (j))
#define XB_TOP      3328
#define XB_TOPGEN   3392
#define XCD_BAR_WORDS 3456
#define XB_SPIN_CAP (1u << 18)
__device__ __forceinline__ unsigned xb_ld(unsigned* p)              { return __hip_atomic_load(p, __ATOMIC_RELAXED, __HIP_MEMORY_SCOPE_AGENT); }
__device__ __forceinline__ unsigned xb_add(unsigned* p, unsigned v) { return __hip_atomic_fetch_add(p, v, __ATOMIC_RELAXED, __HIP_MEMORY_SCOPE_AGENT); }
__device__ __forceinline__ unsigned xb_xcc_id() { return (unsigned)__builtin_amdgcn_s_getreg((3 << 11) | 20) & 0xFu; }
#define XB_SPIN(cond, bar) do { unsigned _sp = 0; while (cond) { __builtin_amdgcn_s_sleep(1); \
    if ((++_sp & 255u) == 0u) { if (xb_ld(&(bar)[XB_TMO])) break; if (_sp > XB_SPIN_CAP) { atomicAdd(&(bar)[XB_TMO], 1u); break; } } } } while (0)
struct XcdBarrier { unsigned* bar; unsigned x; volatile LAS unsigned* st; };
__device__ __forceinline__ XcdBarrier xcd_barrier_post(unsigned* bar, volatile LAS unsigned* st) {
    XcdBarrier b; b.bar = bar; b.x = xb_xcc_id(); b.st = st;
    if (threadIdx.x == 0) (void)xb_add(&bar[XB_XCNT(b.x)], 1u);
    return b;
}
__device__ __forceinline__ void xcd_barrier_complete(unsigned* bar, unsigned x, unsigned& nloc, unsigned& nx) {
    const unsigned G = gridDim.x * gridDim.y * gridDim.z;
    unsigned sum, cnt, mine, sp = 0u;
    for (;;) {
        sum = 0u; cnt = 0u; mine = 0u;
#pragma unroll
        for (unsigned j = 0; j < 16; ++j) { const unsigned c = xb_ld(&bar[XB_XCNT(j)]); sum += c; cnt += (c > 0u) ? 1u : 0u; mine = (j == x) ? c : mine; }
        if (sum == G) break;
        __builtin_amdgcn_s_sleep(1);
        if ((++sp & 255u) == 0u) { if (xb_ld(&bar[XB_TMO])) break; if (sp > XB_SPIN_CAP) { atomicAdd(&bar[XB_TMO], 1u); break; } }
    }
    nloc = mine > 0u ? mine : 1u; nx = cnt > 0u ? cnt : 1u;
}
__device__ __forceinline__ void xcd_barrier(const XcdBarrier& b) {
    asm volatile("s_waitcnt vmcnt(0)" ::: "memory");
    __syncthreads();
    if (threadIdx.x == 0) {
        unsigned* bar = b.bar;
        __builtin_amdgcn_s_waitcnt(0);
        unsigned nloc = b.st[0], nx = b.st[1];
        if (nloc == 0u) { xcd_barrier_complete(bar, b.x, nloc, nx); b.st[0] = nloc; b.st[1] = nx; }
        const unsigned old = xb_add(&bar[XB_XSUB(b.x)], 1u);
        const unsigned gen = old / nloc;
        if (old + 1u == (gen + 1u) * nloc) {
            __builtin_amdgcn_fence(__ATOMIC_RELEASE, "agent");
            asm volatile("s_waitcnt vmcnt(0)" ::: "memory");
            const unsigned og = xb_add(&bar[XB_TOP], 1u);
            const unsigned tg = og / nx;
            if (og + 1u == (tg + 1u) * nx) xb_add(&bar[XB_TOPGEN], 1u);
            else XB_SPIN(xb_ld(&bar[XB_TOPGEN]) == tg, bar);
            __builtin_amdgcn_fence(__ATOMIC_ACQUIRE, "agent");
            xb_add(&bar[XB_XGEN(b.x)], 1u);
            asm volatile("s_waitcnt vmcnt(0)" ::: "memory");
        } else {
            XB_SPIN(xb_ld(&bar[XB_XGEN(b.x)]) == gen, bar);
            __builtin_amdgcn_fence(__ATOMIC_ACQUIRE, "agent");
            asm volatile("s_waitcnt vmcnt(0)" ::: "memory");
        }
    }
    __syncthreads();
}

constexpr int NPHASE = 10;
__global__ void __launch_bounds__(NTHR, 2) fwd_kernel(Params P) {
    extern __shared__ __attribute__((aligned(16))) unsigned char lds_raw[];
    LAS unsigned char* lds = (LAS unsigned char*)lds_raw;
    cg::grid_group grid = cg::this_grid();
    const int tid = threadIdx.x, wave = __builtin_amdgcn_readfirstlane(tid >> 6);
    const int G = gridDim.x, bx = blockIdx.x;
#define FRESH_LANE(name) int name = (int)__builtin_amdgcn_mbcnt_hi(~0u, __builtin_amdgcn_mbcnt_lo(~0u, 0u)); asm volatile("" : "+v"(name))
    const int vcu = (G % 8 == 0) ? (bx % 8) * (G / 8) + bx / 8 : bx;
    const int NGW = G * NWAVES;
    unsigned char* ws = P.ws;
    const int lo = P.ph_lo, hi = P.ph_hi;
#ifndef PH_MASK
#define PH_MASK 0x3ff
#endif
#define IN(k) ((((PH_MASK) >> (k)) & 1) && lo <= (k) && (k) < hi)
    volatile LAS unsigned* xst = (volatile LAS unsigned*)(lds + LDS_XB);
    if (tid < 2) xst[tid] = 0u;
    __syncthreads();
    const XcdBarrier xbar = xcd_barrier_post((unsigned*)(ws + WS_CTL) + CW_BAR, xst);
#define SYNC(k) do { if (IN(k) && IN((k) + 1)) { if ((k) == 0) grid.sync(); else xcd_barrier(xbar); } } while (0)

    if (IN(0)) { FRESH_LANE(lane); p0_prologue(P, lds, vcu, G, wave, lane); }
    SYNC(0);
    if (IN(1)) {
        { pg8::DenseSched S; S.init((const bf16_t*)(ws + WS_XB), (const bf16_t*)(ws + WS_WIN), NTOK, 2048, 1024, G, bx);
          EpiInProj E{(const float*)(ws + WS_RS1), (const f32x2*)(ws + WS_ROPE), P.glu_b, (bf16_t*)(ws + WS_Q), (bf16_t*)(ws + WS_K), (bf16_t*)(ws + WS_V), (bf16_t*)(ws + WS_QI), (bf16_t*)(ws + WS_KI), (bf16_t*)(ws + WS_HGLU), (float*)(ws + WS_WI)};
          pg8::gemm_phase<EpiInProj, pg8::DenseSched, false>(lds, S, E); }
        { pg8::DenseSched S; S.init((const bf16_t*)(ws + WS_PB), (const bf16_t*)(ws + WS_WP), NTOK, 1024, 256, G, bx);
          EpiBf16Plain E{(bf16_t*)(ws + WS_PJ), 1024};
          pg8::gemm_phase<EpiBf16Plain, pg8::DenseSched, false>(lds, S, E); }
    }
    SYNC(1);
    if (IN(2)) {
        FRESH_LANE(lane);
        for (int i = tid; i < 4096; i += NTHR) ((LAS unsigned*)(lds + LDS_MISC))[i] = 0u;
        __syncthreads();
        unsigned* ctl = (unsigned*)(ws + WS_CTL);
        volatile LAS int* qw = (volatile LAS int*)(lds + LDS_XB + 32);
        if (G % 8 == 0 && G >= 128) { const int ncv = 8; if ((bx >> 3) < ncv) moe_weight_convert(P, (LAS float*)(lds + wave * 16384), (bx * NWAVES) + wave, ncv * 8 * NWAVES, lane); }
        else { moe_weight_convert(P, (LAS float*)(lds + wave * 16384), bx * NWAVES + wave, G * NWAVES, lane); }
        __syncthreads();
        for (int db = 0; db < NB; ++db) { const int b = (bx + db) & 7;
            for (;;) {
                if (tid == 0) qw[0] = (int)atomicAdd(ctl + CW_AQ + 64 * b, 1u);
                __syncthreads();
                const int k = qw[0];
                if (k >= 512) break;
                attn_tile(P, lds, b, (511 - k) * 8, wave, lane);
            }
            __syncthreads(); }
        for (;;) {
            if (tid == 0) qw[0] = (int)atomicAdd(ctl + CW_CQ, 1u);
            __syncthreads();
            const int tl = qw[0];
            if (tl >= NTOK / 32) break;
            conv_tile(P, lds, tl, tid, wave, lane);
        }
    }
    SYNC(2);
    if (IN(3)) {
        pg8::DenseSched S; S.init((const bf16_t*)(ws + WS_MIX), (const bf16_t*)(ws + WS_WOUT), NTOK, 1024, 1024, G, bx);
        EpiOutProj E{P.x, (float*)(ws + WS_H1), (unsigned char*)(ws + WS_H1F8)};
        pg8::gemm_phase<EpiOutProj, pg8::DenseSched, false, false, true>(lds, S, E);
    }
    SYNC(3);
    if (IN(4)) { FRESH_LANE(lane); router_phase(P, lds, vcu, G, tid, wave, lane); }
    SYNC(4);
    if (IN(5) || IN(6)) {
        LAS int* tb = (LAS int*)(lds + LDS_MISC); LAS int* cn = tb + 64;
        if (tid == 0) { const unsigned* cntg = (const unsigned*)(ws + WS_CTL) + CW_CNT; int acc = 0;
            for (int e = 0; e < NE; ++e) { const int c = (int)__hip_atomic_load(cntg + 64 * e, __ATOMIC_RELAXED, __HIP_MEMORY_SCOPE_AGENT); tb[e] = acc; cn[e] = c; acc += (c + BM - 1) / BM; }
            tb[NE] = acc; }
        __syncthreads();
        if (IN(5)) {
            pg8::MoeSched S; S.A = ws + WS_H1F8; S.Bt = ws + WS_WUP; S.rp = 1024; S.b_estride = (size_t)2048 * 1024; S.tb = tb; S.cnt = cn; S.list = (const int*)(ws + WS_LIST);
            S.nN = 8; S.nwg = tb[NE] * 8; S.G = G; S.c = bx; S.gather = true;
            { LAS int* ut = (LAS int*)(lds + LDS_MISC + 512); S.utab = ut; S.build_table(ut, tid); __syncthreads(); }
            S.m_scale = (const float*)(ws + WS_LSCALE); S.m_gate = nullptr; S.m_bias = P.b_up;
            EpiUp E{(unsigned char*)(ws + WS_ACT)};
            pg8::gemm_phase<EpiUp, pg8::MoeSched, true, true, true>(lds, S, E);
        }
        SYNC(5);
        if (IN(6)) {
            pg8::MoeSched S; S.A = ws + WS_ACT; S.Bt = ws + WS_WDOWN; S.rp = 1024; S.b_estride = (size_t)1024 * 1024; S.tb = tb; S.cnt = cn; S.list = (const int*)(ws + WS_LIST);
            S.nN = 4; S.nwg = tb[NE] * 4; S.G = G; S.c = bx; S.gather = false;
            { LAS int* ut = (LAS int*)(lds + LDS_MISC + 512); S.utab = ut; S.build_table(ut, tid); __syncthreads(); }
            S.m_scale = nullptr; S.m_gate = (const float*)(ws + WS_LGATE); S.m_bias = P.b_down;
            EpiDown E{(bf16_t*)(ws + WS_Y)};
            pg8::gemm_phase<EpiDown, pg8::MoeSched, true, true, true>(lds, S, E);
        }
    }
    SYNC(6);
    if (IN(7)) { FRESH_LANE(l7); const int g7 = vcu * NWAVES + wave;
        combine_phase(P, g7, NGW, l7); }
    SYNC(7);
    if (IN(8)) {
        pg8::DenseSched S; S.init((const bf16_t*)(ws + WS_H1B), (const bf16_t*)(ws + WS_WG), NTOK, 1024, 1024, G, bx);
        EpiBf16Plain E{(bf16_t*)(ws + WS_G), 1024};
        pg8::gemm_phase<EpiBf16Plain, pg8::DenseSched, false>(lds, S, E);
    }
    SYNC(8);
    if (IN(9)) { FRESH_LANE(l9); const int g9 = vcu * NWAVES + wave;
        final_phase(P, g9, NGW, l9); }
#undef IN
#undef SYNC
}

#ifndef N_LAUNCH_MODE
#define N_LAUNCH_MODE 1
#endif
extern "C" void kernel_launch(void* const* d_in, const int* in_sizes, int n_in, void* d_out, int out_size, void* d_ws, size_t ws_size, hipStream_t stream) {
    static int grid = 0;
    if (grid == 0) {
        if (n_in != 21 || out_size != NTOK * DM || ws_size < WS_END) { fprintf(stderr, "kernel_launch: unexpected shapes (n_in %d out %d ws %zu)\n", n_in, out_size, ws_size); grid = -1; return; }
        int dev = 0, cus = 0, per_cu = 0;
        (void)hipGetDevice(&dev); (void)hipDeviceGetAttribute(&cus, hipDeviceAttributeMultiprocessorCount, dev);
        (void)hipFuncSetAttribute((const void*)fwd_kernel, hipFuncAttributeMaxDynamicSharedMemorySize, LDS_BYTES);
        if (hipOccupancyMaxActiveBlocksPerMultiprocessor(&per_cu, (const void*)fwd_kernel, NTHR, LDS_BYTES) != hipSuccess || per_cu < 1) { fprintf(stderr, "kernel_launch: occupancy query failed (%d)\n", per_cu); (void)hipGetLastError(); grid = -1; return; }
        grid = cus;
    }
    if (grid < 0) return;
    (void)hipMemsetAsync((char*)d_ws + WS_CTL, 0, CTL_BYTES, stream);
    Params p{};
    p.x = (const float*)d_in[0]; p.p = (const float*)d_in[1]; p.w_in = (const float*)d_in[2]; p.w_out = (const float*)d_in[3]; p.g_mix = (const float*)d_in[4]; p.g_ffn = (const float*)d_in[5];
    p.glu_b = (const float*)d_in[6]; p.dw_w = (const float*)d_in[7]; p.dw_b = (const float*)d_in[8]; p.ln_g = (const float*)d_in[9]; p.ln_b = (const float*)d_in[10];
    p.w_router = (const float*)d_in[11]; p.b_router = (const float*)d_in[12]; p.w_up = (const float*)d_in[13]; p.b_up = (const float*)d_in[14]; p.w_down = (const float*)d_in[15]; p.b_down = (const float*)d_in[16];
    p.w_ple_proj = (const float*)d_in[17]; p.w_ple_gate = (const float*)d_in[18]; p.g_ple = (const float*)d_in[19]; p.g_final = (const float*)d_in[20];
    p.out = (float*)d_out; p.ws = (unsigned char*)d_ws;
#ifndef PROBE_REPMASK
#define PROBE_REPMASK 0
#endif
    p.rep = PROBE_REPMASK;
#if N_LAUNCH_MODE == 1
    p.ph_lo = 0; p.ph_hi = NPHASE;
    void* args[] = {&p};
    hipError_t e = hipLaunchCooperativeKernel((const void*)fwd_kernel, dim3(grid), dim3(NTHR), args, LDS_BYTES, stream);
    if (e != hipSuccess) fprintf(stderr, "cooperative launch failed: %s (grid %d)\n", hipGetErrorString(e), grid);
#else
    for (int ph = 0; ph < NPHASE; ++ph) {
        p.ph_lo = ph; p.ph_hi = ph + 1;
        void* args[] = {&p};
        hipError_t e = hipLaunchCooperativeKernel((const void*)fwd_kernel, dim3(grid), dim3(NTHR), args, LDS_BYTES, stream);
        if (e != hipSuccess) { fprintf(stderr, "launch %d failed: %s (grid %d)\n", ph, hipGetErrorString(e), grid); break; }
    }
#endif
}
```

```cpp
#include <hip/hip_runtime.h>
#include <hip/hip_cooperative_groups.h>
#include <cstdio>
#include <cstdint>
namespace cg = cooperative_groups;

#define LAS __attribute__((address_space(3)))
#define GAS __attribute__((address_space(1)))
typedef unsigned short bf16_t;
typedef short bf16x8 __attribute__((ext_vector_type(8)));
typedef short s16x4 __attribute__((ext_vector_type(4)));
typedef float f32x4 __attribute__((ext_vector_type(4)));
typedef float f32x2 __attribute__((ext_vector_type(2)));
typedef float f32x16 __attribute__((ext_vector_type(16)));
typedef unsigned u32x4 __attribute__((ext_vector_type(4)));
typedef unsigned u32x2 __attribute__((ext_vector_type(2)));

constexpr int NB = 8, SEQ = 4096, DM = 1024, NTOK = NB * SEQ;
constexpr int NE = 32, TOPK = 4, NSLOT = NTOK * TOPK;
constexpr int INW = 1988;
constexpr int NSEL = 256;
constexpr float EPS = 1e-6f;
constexpr int NWAVES = 8, NTHR = 512;

constexpr size_t MiB = 1u << 20;
constexpr size_t WS_CTL = 0, CTL_BYTES = 64 * 1024;
constexpr size_t WS_ROPE = 1 * MiB;
constexpr size_t WS_WIN = 2 * MiB;
constexpr size_t WS_WOUT = 6 * MiB;
constexpr size_t WS_WG = 8 * MiB;
constexpr size_t WS_WP = 10 * MiB;
constexpr size_t WS_WRG = 10 * MiB + 512 * 1024;
constexpr size_t WS_RS1 = 11 * MiB;
constexpr size_t WS_RS3 = 11 * MiB + 512 * 1024;
constexpr size_t WS_WI = 12 * MiB;
constexpr size_t WS_LIST = 13 * MiB;
constexpr size_t WS_LSCALE = 17 * MiB;
constexpr size_t WS_LGATE = 21 * MiB;
constexpr size_t WS_PB = 25 * MiB;
constexpr size_t WS_WUP = 42 * MiB;
constexpr size_t WS_WDOWN = 170 * MiB;
constexpr size_t WS_H1 = 234 * MiB;
constexpr size_t WS_H1B = 362 * MiB;
constexpr size_t WS_PJ = 426 * MiB;
constexpr size_t WS_XB = 490 * MiB;
constexpr size_t WS_Q = 554 * MiB;
constexpr size_t WS_K = 586 * MiB;
constexpr size_t WS_V = 590 * MiB;
constexpr size_t WS_QI = 594 * MiB;
constexpr size_t WS_KI = 610 * MiB;
constexpr size_t WS_HGLU = 614 * MiB;
constexpr size_t WS_MIX = 646 * MiB;
constexpr size_t WS_H1F8 = 490 * MiB;
constexpr size_t WS_ACT = 522 * MiB;
constexpr size_t WS_Y = 762 * MiB;
constexpr size_t WS_G = 762 * MiB;
constexpr size_t WS_END = 1018 * MiB;
static_assert(WS_H1F8 + (size_t)NTOK * 1024 <= WS_ACT && WS_ACT + (size_t)139264 * 1024 <= WS_Y, "ws map");
constexpr int CW_CNT = 1024;
constexpr int CW_AQ = 4096;
constexpr int CW_CQ = 4096 + 64 * 8;
constexpr int CW_BAR = 8192;

constexpr int LDS_STAGE = 131072;
constexpr int LDS_MISC = LDS_STAGE;
constexpr int LDS_META = LDS_MISC + 4096;
constexpr int LDS_XB = 147456;
constexpr int LDS_BYTES = 147456 + 256;

__device__ __forceinline__ unsigned f2bf(float f) { unsigned u = __builtin_bit_cast(unsigned, f); return (u + 0x7fffu + ((u >> 16) & 1u)) >> 16; }
__device__ __forceinline__ unsigned pk2(float lo, float hi) { return f2bf(lo) | (f2bf(hi) << 16); }
__device__ __forceinline__ float bf_lo(unsigned w) { return __builtin_bit_cast(float, w << 16); }
__device__ __forceinline__ float bf_hi(unsigned w) { return __builtin_bit_cast(float, w & 0xffff0000u); }
__device__ __forceinline__ float wave_sum(float v) {
    v += __builtin_bit_cast(float, __builtin_amdgcn_update_dpp(0, __builtin_bit_cast(int, v), 0xB1, 0xF, 0xF, true));
    v += __builtin_bit_cast(float, __builtin_amdgcn_update_dpp(0, __builtin_bit_cast(int, v), 0x4E, 0xF, 0xF, true));
    v += __builtin_bit_cast(float, __builtin_amdgcn_update_dpp(0, __builtin_bit_cast(int, v), 0x141, 0xF, 0xF, true));
    v += __builtin_bit_cast(float, __builtin_amdgcn_update_dpp(0, __builtin_bit_cast(int, v), 0x140, 0xF, 0xF, true));
    const int vi = __builtin_bit_cast(int, v);
    const float r0 = __builtin_bit_cast(float, __builtin_amdgcn_readlane(vi, 0)), r1 = __builtin_bit_cast(float, __builtin_amdgcn_readlane(vi, 16));
    const float r2 = __builtin_bit_cast(float, __builtin_amdgcn_readlane(vi, 32)), r3 = __builtin_bit_cast(float, __builtin_amdgcn_readlane(vi, 48));
    return (r0 + r1) + (r2 + r3);
}
__device__ __forceinline__ unsigned pk4_fp8(float a, float b, float c, float d) { int r = __builtin_amdgcn_cvt_pk_fp8_f32(a, b, 0, false); r = __builtin_amdgcn_cvt_pk_fp8_f32(c, d, r, true); return (unsigned)r; }
__device__ __forceinline__ float sigmoidf_(float x) { return __builtin_amdgcn_rcpf(1.0f + __builtin_amdgcn_exp2f(x * -1.4426950408889634f)); }
#define LDS_WAIT() asm volatile("s_waitcnt lgkmcnt(0)" ::: "memory")

struct Params {
    const float* x; const float* p; const float* w_in; const float* w_out; const float* g_mix; const float* g_ffn;
    const float* glu_b; const float* dw_w; const float* dw_b; const float* ln_g; const float* ln_b;
    const float* w_router; const float* b_router; const float* w_up; const float* b_up; const float* w_down; const float* b_down;
    const float* w_ple_proj; const float* w_ple_gate; const float* g_ple; const float* g_final;
    float* out; unsigned char* ws;
    int ph_lo, ph_hi;
};

namespace pg8 {
constexpr int BM = 256, BK = 64, HALF = 128, HTB = HALF * BK * 2, STAGE_BYTES = 8 * HTB, NXCD = 8, WGM = 8;
__host__ __device__ __forceinline__ int lds_byte(int r, int c) { const int st = (r >> 4) * 2 + (c >> 5), rr = r & 15, cc = c & 31, ob = rr * 64 + cc * 2; return st * 1024 + (ob ^ (((ob >> 9) & 1) << 5)); }
__host__ __device__ __forceinline__ void stage_rc(int b, int& R, int& C) { const int st = b / 1024, sb = b % 1024, swz = sb ^ (((sb >> 9) & 1) << 5); R = (st >> 1) * 16 + swz / 64; C = (st & 1) * 32 + (swz % 64) / 2; }
__host__ __device__ __forceinline__ int perm32(int rho) { const int n = rho >> 4, i = rho & 15; return 8 * (i >> 2) + 4 * n + (i & 3); }

struct Unit { int pm, pn, e, rows; };

__device__ __forceinline__ unsigned cvt_pk_bf16(float lo, float hi) { unsigned r; asm volatile("v_cvt_pk_bf16_f32 %0, %1, %2" : "=v"(r) : "v"(lo), "v"(hi)); return r; }

struct DenseSched {
    const void* A; const void* Bt; int rp;
    int nM, nN, nwg, G, c;
    __device__ void init(const void* A_, const void* Bt_, int M, int N, int K_, int G_, int c_) { A = A_; Bt = Bt_; rp = K_ * 2; nM = M / BM; nN = N / BM; nwg = nM * nN; G = G_; c = c_; }
    __device__ bool next(int i, Unit& u) const {
        const long L = (long)i * G + c; if (L >= nwg) return false;
        int wgid = (int)L; { const int q = nwg / NXCD, r = nwg % NXCD, xcd = wgid % NXCD, off = wgid / NXCD; wgid = (xcd < r ? xcd * (q + 1) : r * (q + 1) + (xcd - r) * q) + off; }
        const int nig = WGM * nN, gid = wgid / nig, fm = gid * WGM, gsz = (nM - fm) < WGM ? (nM - fm) : WGM;
        u.pm = fm + ((wgid % nig) % gsz); u.pn = (wgid % nig) / gsz; u.e = 0; u.rows = BM; return true;
    }
    bool idg = false;
    __device__ __forceinline__ const char* a_ptr(const Unit& u) const { return idg ? (const char*)A : (const char*)A + (size_t)u.pm * BM * rp; }
    __device__ __forceinline__ const char* b_ptr(const Unit& u) const { return (const char*)Bt + (size_t)u.pn * BM * rp; }
    __device__ __forceinline__ int a_row(const Unit& u, int r) const { return u.pm * BM + r; }
    __device__ __forceinline__ void meta(const Unit&, LAS unsigned char*, int, int) const {}
};

struct MoeSched {
    const void* A; const void* Bt; int rp; size_t b_estride;
    const LAS int* tb;
    const LAS int* cnt;
    const int* list;
    int nN, nwg, G, c; bool gather;
    const LAS int* utab;
    __device__ __forceinline__ bool next(int i, Unit& u) const {
        if (i >= 32) return false;
        const LAS int* p = utab + 4 * i; const int rows = p[3]; if (rows < 0) return false;
        u.pm = p[0]; u.pn = p[1]; u.e = p[2]; u.rows = rows; return true;
    }
    __device__ __forceinline__ void build_table(LAS int* tab, int tid) const {
        if (tid < 32) { Unit u; const bool ok = decode(tid, u); tab[4 * tid] = u.pm; tab[4 * tid + 1] = u.pn; tab[4 * tid + 2] = u.e; tab[4 * tid + 3] = ok ? u.rows : -1; }
    }
    __device__ __forceinline__ bool decode(int i, Unit& u) const {
        u.pm = 0; u.pn = 0; u.e = 0; u.rows = 0;
        const long L = (long)i * G + c; if (L >= nwg) return false;
        int wgid = (int)L; { const int q = nwg / NXCD, r = nwg % NXCD, xcd = wgid % NXCD, off = wgid / NXCD; wgid = (xcd < r ? xcd * (q + 1) : r * (q + 1) + (xcd - r) * q) + off; }
        int e = 0;
#pragma unroll 1
        for (; e < NE - 1; ++e) { if (wgid < tb[e + 1] * nN) break; }
        const int local = wgid - tb[e] * nN, nM = tb[e + 1] - tb[e];
        const int nig = WGM * nN, gid = local / nig, fm = gid * WGM, gsz = (nM - fm) < WGM ? (nM - fm) : WGM;
        const int rt = fm + ((local % nig) % gsz);
        u.pm = tb[e] + rt; u.pn = (local % nig) / gsz; u.e = e;
        const int left = cnt[e] - rt * BM; u.rows = left < BM ? left : BM; return true;
    }
    __device__ __forceinline__ const char* a_ptr(const Unit& u) const { return (const char*)A; }
    __device__ __forceinline__ const char* b_ptr(const Unit& u) const { return (const char*)Bt + (size_t)u.e * b_estride + (size_t)u.pn * BM * rp; }
    __device__ __forceinline__ int a_row(const Unit& u, int r) const {
        if (!gather) return u.pm * BM + r;
        const int rt = u.pm - tb[u.e];
        return r < u.rows ? (list[u.e * NTOK + rt * BM + r] >> 2) : 0;
    }
    const float* m_scale; const float* m_gate; const float* m_bias;
    __device__ __forceinline__ void meta(const Unit& u, LAS unsigned char* tbl, int wid, int lane) const {
        const int rt = u.pm - tb[u.e]; const size_t li = (size_t)u.e * NTOK + rt * BM + (wid & 3) * 64 + lane;
        if (gather) {
            if (wid < 4) __builtin_amdgcn_global_load_lds((const unsigned*)(m_scale + li), (LAS unsigned*)(tbl + (wid & 3) * 256), 4, 0, 0);
            else { const int j = (wid & 3) * 64 + lane; const float* src = m_bias + (size_t)u.e * 2048 + (j < 128 ? 128 * u.pn + j : 1024 + 128 * u.pn + (j - 128));
                __builtin_amdgcn_global_load_lds((const unsigned*)src, (LAS unsigned*)(tbl + 2048 + (wid & 3) * 256), 4, 0, 0); }
        } else {
            if (wid < 4) { __builtin_amdgcn_global_load_lds((const unsigned*)(list + li), (LAS unsigned*)(tbl + (wid & 3) * 256), 4, 0, 0);
                __builtin_amdgcn_global_load_lds((const unsigned*)(m_bias + (size_t)u.e * 1024 + u.pn * BM + (wid & 3) * 64 + lane), (LAS unsigned*)(tbl + 2048 + (wid & 3) * 256), 4, 0, 0); }
            else __builtin_amdgcn_global_load_lds((const unsigned*)(m_gate + li), (LAS unsigned*)(tbl + 1024 + (wid & 3) * 256), 4, 0, 0);
        }
    }
};

typedef int v8i32 __attribute__((ext_vector_type(8)));
template <class Epi, class Sched, bool GATHER, bool F8 = false, bool WARMTRIP = false>
__device__ __forceinline__ void gemm_phase(LAS unsigned char* lds, const Sched& S, const Epi& E) {
    const int tid = threadIdx.x, wid = __builtin_amdgcn_readfirstlane(tid >> 6), lane = tid & 63, wr = wid >> 2, wc = wid & 3, fr = lane & 15, fq = lane >> 4;
    const int RP = S.rp, nt = RP / (BK * 2);
    unsigned voffA[2], voffB[2]; int RA[2], CA[2];
#pragma unroll
    for (int i = 0; i < 2; ++i) { int R, C; stage_rc(tid * 16 + i * 8192, R, C); const int Rb = Epi::PERM ? ((R & ~31) + perm32(R & 31)) : R;
        voffA[i] = (unsigned)(R * RP + C * 2); voffB[i] = (unsigned)(Rb * RP + C * 2); RA[i] = R; CA[i] = C; }
    const size_t kstep = (size_t)(BK * 2);
    const size_t hstep = (size_t)HALF * RP;
    const unsigned ldsw = (unsigned)wid * 1024u;
    const int aoff = lds_byte(wr * 64 + fr, fq * 8), boff = lds_byte(wc * 32 + fr, fq * 8);
    unsigned gC[2][2], gN[2][2];
#define PG8_SA(b, h) (((b) * 2 + (h)) * HTB)
#define PG8_SB(b, h) ((4 + (b) * 2 + (h)) * HTB)
#define PG8_STAGE(bufoff, gbase, voff) do { _Pragma("unroll") for (int _i = 0; _i < 2; ++_i) \
        __builtin_amdgcn_global_load_lds((const unsigned*)((const char*)(gbase) + (voff)[_i]), (LAS unsigned*)(lds + (bufoff) + ldsw + _i * 8192), 16, 0, 0); } while (0)
#define PG8_STAGE_A(bufoff, kp, h) do { if constexpr (GATHER) { PG8_STAGE(bufoff, kp, gC[h]); } else { PG8_STAGE(bufoff, (kp) + (h) * hstep, voffA); } } while (0)
#define PG8_LD16(p) (*(const LAS bf16x8*)(p))
#define PG8_CAT(lo, hi) __builtin_bit_cast(v8i32, __builtin_shufflevector(lo, hi, 0, 1, 2, 3, 4, 5, 6, 7, 8, 9, 10, 11, 12, 13, 14, 15))
#define PG8_LDA(dst, b, h) do { _Pragma("unroll") for (int m = 0; m < 4; ++m) { if constexpr (F8) { dst##8[m] = PG8_CAT(PG8_LD16(lds + PG8_SA(b, h) + aoff + m * 2048), PG8_LD16(lds + PG8_SA(b, h) + aoff + m * 2048 + 1024)); } \
        else { _Pragma("unroll") for (int k = 0; k < 2; ++k) dst[m][k] = PG8_LD16(lds + PG8_SA(b, h) + aoff + m * 2048 + k * 1024); } } } while (0)
#define PG8_LDB(dst, b, h) do { _Pragma("unroll") for (int n = 0; n < 2; ++n) { if constexpr (F8) { dst##8[n] = PG8_CAT(PG8_LD16(lds + PG8_SB(b, h) + boff + n * 2048), PG8_LD16(lds + PG8_SB(b, h) + boff + n * 2048 + 1024)); } \
        else { _Pragma("unroll") for (int k = 0; k < 2; ++k) dst[n][k] = PG8_LD16(lds + PG8_SB(b, h) + boff + n * 2048 + k * 1024); } } } while (0)
#define PG8_MMA(ai, bj, At, Bt) do { __builtin_amdgcn_s_setprio(1); _Pragma("unroll") for (int m = 0; m < 4; ++m) _Pragma("unroll") for (int n = 0; n < 2; ++n) { \
        if constexpr (F8) { acc[ai][bj][m][n] = __builtin_amdgcn_mfma_scale_f32_16x16x128_f8f6f4(Bt##8[n], At##8[m], acc[ai][bj][m][n], 0, 0, 0, 0x7f7f7f7f, 0, 0x7f7f7f7f); } \
        else { _Pragma("unroll") for (int k = 0; k < 2; ++k) acc[ai][bj][m][n] = __builtin_amdgcn_mfma_f32_16x16x32_bf16(Bt[n][k], At[m][k], acc[ai][bj][m][n], 0, 0, 0); } } \
        __builtin_amdgcn_s_setprio(0); } while (0)
#define PG8_WAIT_V(n) asm volatile("s_waitcnt vmcnt(" #n ")" ::: "memory")
#define PG8_WAIT_L(n) asm volatile("s_waitcnt lgkmcnt(" #n ")" ::: "memory")
#define PG8_BAR __builtin_amdgcn_s_barrier()
#define PG8_SCHED __builtin_amdgcn_sched_barrier(0)
#define PG8_GOFF(dst, u) do { _Pragma("unroll") for (int _h = 0; _h < 2; ++_h) _Pragma("unroll") for (int _i = 0; _i < 2; ++_i) \
        dst[_h][_i] = (unsigned)(S.a_row(u, _h * HALF + RA[_i]) * RP + CA[_i] * 2); } while (0)
    Unit cur, nxt, nn; int ui = 0;
    if (!S.next(0, cur)) return;
    bool has_next = S.next(1, nxt);
    if constexpr (GATHER) { PG8_GOFF(gC, cur); if (has_next) { PG8_GOFF(gN, nxt); } else { PG8_GOFF(gN, cur); } }
    f32x4 acc[2][2][4][2];
#pragma unroll
    for (int a = 0; a < 2; ++a)
#pragma unroll
        for (int b = 0; b < 2; ++b)
#pragma unroll
            for (int m = 0; m < 4; ++m)
#pragma unroll
                for (int n = 0; n < 2; ++n) acc[a][b][m][n] = (f32x4){0.f, 0.f, 0.f, 0.f};
    bf16x8 At[4][2], B0[2][2], B1[2][2]; v8i32 At8[4], B08[2], B18[2];
    const char* cA = S.a_ptr(cur); const char* cB = S.b_ptr(cur);
    PG8_STAGE(PG8_SB(0, 0), cB, voffB); PG8_STAGE(PG8_SB(0, 1), cB + hstep, voffB); PG8_STAGE_A(PG8_SA(0, 0), cA, 0); PG8_STAGE_A(PG8_SA(0, 1), cA, 1);
    if (wr == 1) PG8_BAR;
    PG8_WAIT_V(2); PG8_BAR;
    PG8_STAGE(PG8_SB(1, 0), cB + kstep, voffB); PG8_STAGE_A(PG8_SA(1, 0), cA + kstep, 0); PG8_STAGE(PG8_SB(1, 1), cB + hstep + kstep, voffB);
    PG8_WAIT_V(6); PG8_BAR;
    for (;;) {
        const char* nA = has_next ? S.a_ptr(nxt) : cA; const char* nB = has_next ? S.b_ptr(nxt) : cB;
        S.meta(cur, lds + (LDS_META - 0) + (ui & 1) * 4096, wid, lane);
#define PG8_TRIP(WARM, t) do { \
            const bool last = ((t) == nt - 2); \
            const char* a1 = cA + (size_t)((t) + 1) * kstep; \
            const char* a2 = last ? nA : cA + (size_t)((t) + 2) * kstep; const char* b2 = last ? nB : cB + (size_t)((t) + 2) * kstep; \
            const char* a3 = a2 + kstep; const char* b3 = b2 + kstep; \
              \
            PG8_LDB(B0, 0, 0); PG8_LDB(B1, 0, 1); PG8_SCHED; PG8_LDA(At, 0, 0); if constexpr (!(WARM)) { PG8_STAGE_A(PG8_SA(1, 1), a1, 1); } \
            if constexpr (GATHER) { if (last) { _Pragma("unroll") for (int h = 0; h < 2; ++h) _Pragma("unroll") for (int i = 0; i < 2; ++i) gC[h][i] = gN[h][i]; } } \
            if constexpr (!(WARM)) { PG8_WAIT_V(8); } PG8_WAIT_L(0); PG8_BAR; PG8_MMA(0, 0, At, B0); PG8_MMA(0, 1, At, B1); PG8_BAR; PG8_SCHED; \
              \
            PG8_LDA(At, 0, 1); PG8_STAGE(PG8_SB(0, 0), b2, voffB); PG8_STAGE(PG8_SB(0, 1), b2 + hstep, voffB); PG8_STAGE_A(PG8_SA(0, 0), a2, 0); \
            if constexpr (!(WARM)) { PG8_WAIT_V(8); } PG8_WAIT_L(0); PG8_BAR; PG8_MMA(1, 0, At, B0); PG8_MMA(1, 1, At, B1); PG8_BAR; PG8_SCHED; \
              \
            PG8_LDB(B0, 1, 0); PG8_LDB(B1, 1, 1); PG8_SCHED; PG8_LDA(At, 1, 0); PG8_STAGE_A(PG8_SA(0, 1), a2, 1); \
            if constexpr (!(WARM)) { PG8_WAIT_V(8); } PG8_WAIT_L(0); PG8_BAR; PG8_MMA(0, 0, At, B0); PG8_MMA(0, 1, At, B1); PG8_BAR; PG8_SCHED; \
              \
            PG8_LDA(At, 1, 1); PG8_STAGE(PG8_SB(1, 0), b3, voffB); PG8_STAGE(PG8_SB(1, 1), b3 + hstep, voffB); PG8_STAGE_A(PG8_SA(1, 0), a3, 0); \
            PG8_WAIT_V(8); PG8_WAIT_L(0); PG8_BAR; PG8_MMA(1, 0, At, B0); PG8_MMA(1, 1, At, B1); PG8_BAR; PG8_SCHED; \
        } while (0)
        int t0_ = 0;
        if constexpr (WARMTRIP) { if (ui > 0) { PG8_TRIP(true, 0); t0_ = 2; } }
        for (int t = t0_; t < nt; t += 2) { PG8_TRIP(false, t); }
#undef PG8_TRIP
        if (wr == 0) PG8_BAR;
        if constexpr (WARMTRIP) { PG8_STAGE_A(PG8_SA(1, 1), nA + kstep, 1); }
        bool has_nn = false;
        if constexpr (GATHER) { if (has_next) { has_nn = S.next(ui + 2, nn); if (has_nn) { PG8_GOFF(gN, nn); } } }
        else { if (has_next) has_nn = S.next(ui + 2, nn); }
        { int fr_ = fr, fq_ = fq; asm volatile("" : "+v"(fr_), "+v"(fq_));
          const LAS unsigned char* mt = lds + LDS_META + (ui & 1) * 4096;
          if constexpr (WARMTRIP) {
              E.pre(acc, cur, wr, wc, fr_, fq_, mt);
              if constexpr (GATHER) asm volatile("" : "+v"(gN[0][0]), "+v"(gN[0][1]), "+v"(gN[1][0]), "+v"(gN[1][1]));
              PG8_WAIT_V(0);
              E.post(acc, cur, wr, wc, fr_, fq_, mt);
          } else { E.run(acc, cur, wr, wc, fr_, fq_, mt); } }
        if (!has_next) break;
#pragma unroll
        for (int a = 0; a < 2; ++a)
#pragma unroll
            for (int b = 0; b < 2; ++b)
#pragma unroll
                for (int m = 0; m < 4; ++m)
#pragma unroll
                    for (int n = 0; n < 2; ++n) acc[a][b][m][n] = (f32x4){0.f, 0.f, 0.f, 0.f};
        cur = nxt; cA = nA; cB = nB; ++ui; nxt = nn; has_next = has_nn;
        if (wr == 1) PG8_BAR;
    }
    PG8_WAIT_V(0);
    PG8_BAR;
#undef PG8_SA
#undef PG8_SB
#undef PG8_STAGE
#undef PG8_STAGE_A
#undef PG8_LDA
#undef PG8_LDB
#undef PG8_MMA
#undef PG8_LD16
#undef PG8_CAT
#undef PG8_WAIT_V
#undef PG8_WAIT_L
#undef PG8_BAR
#undef PG8_SCHED
#undef PG8_GOFF
}
}

using pg8::Unit; using pg8::cvt_pk_bf16;
constexpr int BM = 256, HALF = 128;

typedef f32x4 (&AccRef)[2][2][4][2];
__device__ __forceinline__ void pack8_bf16(f32x4& lo, const f32x4& hi) {
    const unsigned w0 = cvt_pk_bf16(lo[0], lo[1]), w1 = cvt_pk_bf16(lo[2], lo[3]), w2 = cvt_pk_bf16(hi[0], hi[1]), w3 = cvt_pk_bf16(hi[2], hi[3]);
    lo[0] = __builtin_bit_cast(float, w0); lo[1] = __builtin_bit_cast(float, w1); lo[2] = __builtin_bit_cast(float, w2); lo[3] = __builtin_bit_cast(float, w3);
}
#define AS_U4(v) __builtin_bit_cast(u32x4, v)

struct EpiInProj {
    static constexpr bool PERM = true;
    const float* rs1; const f32x2* rope; const float* glu_b;
    bf16_t *q, *k, *v, *qi, *ki, *hglu; float* wi;
    __device__ __forceinline__ void pre(AccRef acc, const Unit& u, int wr, int wc, int fr, int fq, const LAS unsigned char* mt) const {
        const int row0 = u.pm * BM + wr * 64 + fr;
        if (u.pn >= 4) {
            const int ch = 128 * (u.pn - 4) + 32 * wc + 8 * fq;
            f32x4 ba[2], bg[2];
#pragma unroll
            for (int n = 0; n < 2; ++n) { ba[n] = *(const f32x4*)(glu_b + ch + 4 * n); bg[n] = *(const f32x4*)(glu_b + 512 + ch + 4 * n); }
#pragma unroll
            for (int ai = 0; ai < 2; ++ai)
#pragma unroll
                for (int m = 0; m < 4; ++m) { const float rs = rs1[row0 + ai * HALF + m * 16];
#pragma unroll
                    for (int n = 0; n < 2; ++n)
#pragma unroll
                        for (int e = 0; e < 4; ++e) { const float a = acc[ai][0][m][n][e] * rs + ba[n][e], g = acc[ai][1][m][n][e] * rs + bg[n][e]; acc[ai][0][m][n][e] = a * sigmoidf_(g); }
                    pack8_bf16(acc[ai][0][m][0], acc[ai][0][m][1]); }
            return;
        }
        const bool do_rope = !(u.pn == 3 && wc >= 2), is_wi = (u.pn == 3 && wc == 3);
        const int d0 = 8 * fq;
#pragma unroll
        for (int ai = 0; ai < 2; ++ai)
#pragma unroll
            for (int m = 0; m < 4; ++m) { const int row = row0 + ai * HALF + m * 16; const float rs = rs1[row];
                if (do_rope) {
                    const f32x2* rp = rope + (size_t)(row & (SEQ - 1)) * 32 + d0;
#pragma unroll
                    for (int n = 0; n < 2; ++n)
#pragma unroll
                        for (int e = 0; e < 4; ++e) { const f32x2 cs = rp[4 * n + e]; const float x1 = acc[ai][0][m][n][e] * rs, x2 = acc[ai][1][m][n][e] * rs;
                            acc[ai][0][m][n][e] = x1 * cs.x - x2 * cs.y; acc[ai][1][m][n][e] = x2 * cs.x + x1 * cs.y; }
                } else {
#pragma unroll
                    for (int n = 0; n < 2; ++n) { acc[ai][0][m][n] = acc[ai][0][m][n] * rs; acc[ai][1][m][n] = acc[ai][1][m][n] * rs; }
                }
                if (!is_wi) { pack8_bf16(acc[ai][0][m][0], acc[ai][0][m][1]); pack8_bf16(acc[ai][1][m][0], acc[ai][1][m][1]); }
                if (m & 1) __builtin_amdgcn_sched_barrier(0); }
    }
    __device__ __forceinline__ void post(AccRef acc, const Unit& u, int wr, int wc, int fr, int fq, const LAS unsigned char* mt) const {
        const int row0 = u.pm * BM + wr * 64 + fr;
        if (u.pn >= 4) {
            const int ch = 128 * (u.pn - 4) + 32 * wc + 8 * fq;
#pragma unroll
            for (int ai = 0; ai < 2; ++ai)
#pragma unroll
                for (int m = 0; m < 4; ++m) *(u32x4*)(hglu + (size_t)(row0 + ai * HALF + m * 16) * 512 + ch) = AS_U4(acc[ai][0][m][0]);
            return;
        }
        bf16_t* dst; int ld, col; bool is_wi = false;
        if (u.pn < 2) { dst = q; ld = 512; col = (4 * u.pn + wc) * 64; }
        else if (u.pn == 2) { dst = qi; ld = 256; col = wc * 64; }
        else { ld = 64; col = 0; if (wc == 0) dst = k; else if (wc == 1) dst = ki; else if (wc == 2) dst = v; else { dst = v; is_wi = true; } }
        if (is_wi) {
            if (fq == 0) {
#pragma unroll
                for (int ai = 0; ai < 2; ++ai)
#pragma unroll
                    for (int m = 0; m < 4; ++m) *(f32x4*)(wi + (size_t)(row0 + ai * HALF + m * 16) * 4) = acc[ai][0][m][0];
            }
            return;
        }
#pragma unroll
        for (int ai = 0; ai < 2; ++ai)
#pragma unroll
            for (int m = 0; m < 4; ++m) { bf16_t* rp2 = dst + (size_t)(row0 + ai * HALF + m * 16) * ld + col + 8 * fq;
                *(u32x4*)(rp2) = AS_U4(acc[ai][0][m][0]); *(u32x4*)(rp2 + 32) = AS_U4(acc[ai][1][m][0]); }
    }
    __device__ __forceinline__ void run(const f32x4 (&acc)[2][2][4][2], const Unit& u, int wr, int wc, int fr, int fq, const LAS unsigned char* mt) const {
        const int row0 = u.pm * BM + wr * 64 + fr;
        if (u.pn >= 4) {
            const int ch = 128 * (u.pn - 4) + 32 * wc + 8 * fq;
            f32x4 ba[2], bg[2];
#pragma unroll
            for (int n = 0; n < 2; ++n) { ba[n] = *(const f32x4*)(glu_b + ch + 4 * n); bg[n] = *(const f32x4*)(glu_b + 512 + ch + 4 * n); }
#pragma unroll
            for (int ai = 0; ai < 2; ++ai)
#pragma unroll
                for (int m = 0; m < 4; ++m) { const int row = row0 + ai * HALF + m * 16; const float rs = rs1[row];
                    float o[8];
#pragma unroll
                    for (int n = 0; n < 2; ++n)
#pragma unroll
                        for (int e = 0; e < 4; ++e) { const float a = acc[ai][0][m][n][e] * rs + ba[n][e], g = acc[ai][1][m][n][e] * rs + bg[n][e]; o[4 * n + e] = a * sigmoidf_(g); }
                    u32x4 w; w.x = cvt_pk_bf16(o[0], o[1]); w.y = cvt_pk_bf16(o[2], o[3]); w.z = cvt_pk_bf16(o[4], o[5]); w.w = cvt_pk_bf16(o[6], o[7]);
                    *(u32x4*)(hglu + (size_t)row * 512 + ch) = w; }
            return;
        }
        bf16_t* dst; int ld, col; bool do_rope = true, is_wi = false;
        if (u.pn < 2) { dst = q; ld = 512; col = (4 * u.pn + wc) * 64; }
        else if (u.pn == 2) { dst = qi; ld = 256; col = wc * 64; }
        else { ld = 64; col = 0; if (wc == 0) dst = k; else if (wc == 1) dst = ki; else if (wc == 2) { dst = v; do_rope = false; } else { dst = v; is_wi = true; do_rope = false; } }
        if (is_wi) {
            if (fq == 0) {
#pragma unroll
                for (int ai = 0; ai < 2; ++ai)
#pragma unroll
                    for (int m = 0; m < 4; ++m) { const int row = row0 + ai * HALF + m * 16; const float rs = rs1[row];
                        *(f32x4*)(wi + (size_t)row * 4) = acc[ai][0][m][0] * rs; }
            }
            return;
        }
        const int d0 = 8 * fq;
#pragma unroll
        for (int ai = 0; ai < 2; ++ai)
#pragma unroll
            for (int m = 0; m < 4; ++m) { const int row = row0 + ai * HALF + m * 16; const float rs = rs1[row];
                float o1[8], o2[8];
                if (do_rope) {
                    const f32x2* rp = rope + (size_t)(row & (SEQ - 1)) * 32 + d0;
#pragma unroll
                    for (int n = 0; n < 2; ++n)
#pragma unroll
                        for (int e = 0; e < 4; ++e) { const f32x2 cs = rp[4 * n + e]; const float x1 = acc[ai][0][m][n][e] * rs, x2 = acc[ai][1][m][n][e] * rs;
                            o1[4 * n + e] = x1 * cs.x - x2 * cs.y; o2[4 * n + e] = x2 * cs.x + x1 * cs.y; }
                } else {
#pragma unroll
                    for (int n = 0; n < 2; ++n)
#pragma unroll
                        for (int e = 0; e < 4; ++e) { o1[4 * n + e] = acc[ai][0][m][n][e] * rs; o2[4 * n + e] = acc[ai][1][m][n][e] * rs; }
                }
                u32x4 w1, w2; w1.x = cvt_pk_bf16(o1[0], o1[1]); w1.y = cvt_pk_bf16(o1[2], o1[3]); w1.z = cvt_pk_bf16(o1[4], o1[5]); w1.w = cvt_pk_bf16(o1[6], o1[7]);
                w2.x = cvt_pk_bf16(o2[0], o2[1]); w2.y = cvt_pk_bf16(o2[2], o2[3]); w2.z = cvt_pk_bf16(o2[4], o2[5]); w2.w = cvt_pk_bf16(o2[6], o2[7]);
                bf16_t* rp2 = dst + (size_t)row * ld + col + d0;
                *(u32x4*)(rp2) = w1; *(u32x4*)(rp2 + 32) = w2; }
    }
};

struct EpiBf16Plain {
    static constexpr bool PERM = true;
    bf16_t* O; int ldc; float scale;
    __device__ __forceinline__ void pre(AccRef acc, const Unit&, int, int, int, int, const LAS unsigned char*) const {
#pragma unroll
        for (int ai = 0; ai < 2; ++ai)
#pragma unroll
            for (int bj = 0; bj < 2; ++bj)
#pragma unroll
                for (int m = 0; m < 4; ++m) { acc[ai][bj][m][0] = acc[ai][bj][m][0] * scale; acc[ai][bj][m][1] = acc[ai][bj][m][1] * scale; pack8_bf16(acc[ai][bj][m][0], acc[ai][bj][m][1]); }
    }
    __device__ __forceinline__ void post(AccRef acc, const Unit& u, int wr, int wc, int fr, int fq, const LAS unsigned char* mt) const {
        const int row0 = u.pm * BM + wr * 64 + fr, col0 = u.pn * BM + wc * 32 + 8 * fq;
#pragma unroll
        for (int ai = 0; ai < 2; ++ai)
#pragma unroll
            for (int m = 0; m < 4; ++m) { bf16_t* rowp = O + (size_t)(row0 + ai * HALF + m * 16) * ldc + col0;
#pragma unroll
                for (int bj = 0; bj < 2; ++bj) *(u32x4*)(rowp + bj * HALF) = AS_U4(acc[ai][bj][m][0]); }
    }
    __device__ __forceinline__ void run(const f32x4 (&acc)[2][2][4][2], const Unit& u, int wr, int wc, int fr, int fq, const LAS unsigned char* mt) const {
        const int row0 = u.pm * BM + wr * 64 + fr, col0 = u.pn * BM + wc * 32 + 8 * fq;
#pragma unroll
        for (int ai = 0; ai < 2; ++ai)
#pragma unroll
            for (int m = 0; m < 4; ++m) { bf16_t* rowp = O + (size_t)(row0 + ai * HALF + m * 16) * ldc + col0;
#pragma unroll
                for (int bj = 0; bj < 2; ++bj) { const f32x4 v0 = acc[ai][bj][m][0] * scale, v1 = acc[ai][bj][m][1] * scale;
                    u32x4 w; w.x = cvt_pk_bf16(v0[0], v0[1]); w.y = cvt_pk_bf16(v0[2], v0[3]); w.z = cvt_pk_bf16(v1[0], v1[1]); w.w = cvt_pk_bf16(v1[2], v1[3]);
                    *(u32x4*)(rowp + bj * HALF) = w; } }
    }
};

struct EpiOutProj {
    static constexpr bool PERM = false;
    const float* x; float* h1; unsigned char* h1f8;
    __device__ __forceinline__ void pre(AccRef acc, const Unit& u, int wr, int wc, int fr, int fq, const LAS unsigned char* mt) const {
        const int row0 = u.pm * BM + wr * 64 + fr, col0 = u.pn * BM + wc * 32 + 4 * fq;
#pragma unroll
        for (int ai = 0; ai < 2; ++ai)
#pragma unroll
            for (int m = 0; m < 4; ++m) { const size_t off = (size_t)(row0 + ai * HALF + m * 16) * DM + col0;
#pragma unroll
                for (int bj = 0; bj < 2; ++bj)
#pragma unroll
                    for (int n = 0; n < 2; ++n) acc[ai][bj][m][n] += *(const f32x4*)(x + off + bj * HALF + n * 16);
                if (m & 1) __builtin_amdgcn_sched_barrier(0); }
    }
    __device__ __forceinline__ void post(AccRef acc, const Unit& u, int wr, int wc, int fr, int fq, const LAS unsigned char* mt) const {
        const int row0 = u.pm * BM + wr * 64 + fr, col0 = u.pn * BM + wc * 32 + 4 * fq;
#pragma unroll
        for (int ai = 0; ai < 2; ++ai)
#pragma unroll
            for (int m = 0; m < 4; ++m) { const size_t off = (size_t)(row0 + ai * HALF + m * 16) * DM + col0;
#pragma unroll
                for (int bj = 0; bj < 2; ++bj)
#pragma unroll
                    for (int n = 0; n < 2; ++n) { const size_t o = off + bj * HALF + n * 16; const f32x4 r = acc[ai][bj][m][n];
                        *(f32x4*)(h1 + o) = r; *(unsigned*)(h1f8 + o) = pk4_fp8(r[0], r[1], r[2], r[3]); } }
    }
    __device__ __forceinline__ void run(AccRef acc, const Unit& u, int wr, int wc, int fr, int fq, const LAS unsigned char* mt) const { pre(acc, u, wr, wc, fr, fq, mt); post(acc, u, wr, wc, fr, fq, mt); }
};

struct EpiUp {
    static constexpr bool PERM = true;
    unsigned char* act;
    __device__ __forceinline__ void pre(AccRef acc, const Unit& u, int wr, int wc, int fr, int fq, const LAS unsigned char* mt) const {
        const int r0 = wr * 64 + fr, cl = 32 * wc + 8 * fq;
        const LAS float* rowA = (const LAS float*)mt; const LAS float* bias = (const LAS float*)(mt + 2048);
        f32x4 bg[2], bl[2];
#pragma unroll
        for (int n = 0; n < 2; ++n) { bg[n] = *(const LAS f32x4*)(bias + cl + 4 * n); bl[n] = *(const LAS f32x4*)(bias + 128 + cl + 4 * n); }
#pragma unroll
        for (int ai = 0; ai < 2; ++ai)
#pragma unroll
            for (int m = 0; m < 4; ++m) { const int r = r0 + ai * HALF + m * 16;
                const float rs = (r < u.rows) ? rowA[r] * 0.03125f : 0.f;
#pragma unroll
                for (int n = 0; n < 2; ++n)
#pragma unroll
                    for (int e = 0; e < 4; ++e) { float g = acc[ai][0][m][n][e] * rs + bg[n][e], l = acc[ai][1][m][n][e] * rs + bl[n][e];
                        g = fminf(g, 7.0f); l = fminf(fmaxf(l, -7.0f), 7.0f); acc[ai][0][m][n][e] = g * sigmoidf_(1.702f * g) * (l + 1.0f); } }
    }
    __device__ __forceinline__ void post(AccRef acc, const Unit& u, int wr, int wc, int fr, int fq, const LAS unsigned char* mt) const {
        const int r0 = wr * 64 + fr, ch = 128 * u.pn + 32 * wc + 8 * fq;
#pragma unroll
        for (int ai = 0; ai < 2; ++ai)
#pragma unroll
            for (int m = 0; m < 4; ++m) { const int r = r0 + ai * HALF + m * 16;
                const f32x4 v0 = acc[ai][0][m][0], v1 = acc[ai][0][m][1];
                u32x2 w; w.x = pk4_fp8(v0[0], v0[1], v0[2], v0[3]); w.y = pk4_fp8(v1[0], v1[1], v1[2], v1[3]);
                *(u32x2*)(act + (size_t)(u.pm * BM + r) * 1024 + ch) = w; }
    }
    __device__ __forceinline__ void run(const f32x4 (&acc)[2][2][4][2], const Unit& u, int wr, int wc, int fr, int fq, const LAS unsigned char* mt) const {
        const int r0 = wr * 64 + fr, cl = 32 * wc + 8 * fq, ch = 128 * u.pn + cl;
        const LAS float* rowA = (const LAS float*)mt; const LAS float* bias = (const LAS float*)(mt + 2048);
        f32x4 bg[2], bl[2];
#pragma unroll
        for (int n = 0; n < 2; ++n) { bg[n] = *(const LAS f32x4*)(bias + cl + 4 * n); bl[n] = *(const LAS f32x4*)(bias + 128 + cl + 4 * n); }
#pragma unroll
        for (int ai = 0; ai < 2; ++ai)
#pragma unroll
            for (int m = 0; m < 4; ++m) { const int r = r0 + ai * HALF + m * 16;
                const float rs = (r < u.rows) ? rowA[r] * 0.03125f : 0.f;
                float o[8];
#pragma unroll
                for (int n = 0; n < 2; ++n)
#pragma unroll
                    for (int e = 0; e < 4; ++e) { float g = acc[ai][0][m][n][e] * rs + bg[n][e], l = acc[ai][1][m][n][e] * rs + bl[n][e];
                        g = fminf(g, 7.0f); l = fminf(fmaxf(l, -7.0f), 7.0f); o[4 * n + e] = g * sigmoidf_(1.702f * g) * (l + 1.0f); }
                u32x2 w; w.x = pk4_fp8(o[0], o[1], o[2], o[3]); w.y = pk4_fp8(o[4], o[5], o[6], o[7]);
                *(u32x2*)(act + (size_t)(u.pm * BM + r) * 1024 + ch) = w; }
    }
};

struct EpiDown {
    static constexpr bool PERM = true;
    bf16_t* y;
    __device__ __forceinline__ void pre(AccRef acc, const Unit& u, int wr, int wc, int fr, int fq, const LAS unsigned char* mt) const {
        const int r0 = wr * 64 + fr, cl = wc * 32 + 8 * fq;
        const LAS float* gateT = (const LAS float*)(mt + 1024); const LAS float* bias = (const LAS float*)(mt + 2048);
        float gt[2][4];
#pragma unroll
        for (int ai = 0; ai < 2; ++ai)
#pragma unroll
            for (int m = 0; m < 4; ++m) gt[ai][m] = gateT[r0 + ai * HALF + m * 16];
#pragma unroll
        for (int bj = 0; bj < 2; ++bj) { const f32x4 bv0 = *(const LAS f32x4*)(bias + cl + bj * HALF), bv1 = *(const LAS f32x4*)(bias + cl + bj * HALF + 4);
#pragma unroll
            for (int ai = 0; ai < 2; ++ai)
#pragma unroll
                for (int m = 0; m < 4; ++m) { acc[ai][bj][m][0] = (acc[ai][bj][m][0] * 0.03125f + bv0) * gt[ai][m]; acc[ai][bj][m][1] = (acc[ai][bj][m][1] * 0.03125f + bv1) * gt[ai][m];
                    pack8_bf16(acc[ai][bj][m][0], acc[ai][bj][m][1]); } }
    }
    __device__ __forceinline__ void post(AccRef acc, const Unit& u, int wr, int wc, int fr, int fq, const LAS unsigned char* mt) const {
        const int r0 = wr * 64 + fr, col0 = u.pn * BM + wc * 32 + 8 * fq;
        const LAS int* slotT = (const LAS int*)mt;
#pragma unroll
        for (int ai = 0; ai < 2; ++ai)
#pragma unroll
            for (int m = 0; m < 4; ++m) { const int r = r0 + ai * HALF + m * 16;
                if (r < u.rows) { bf16_t* rowp = y + (size_t)slotT[r] * 1024 + col0;
#pragma unroll
                    for (int bj = 0; bj < 2; ++bj) *(u32x4*)(rowp + bj * HALF) = AS_U4(acc[ai][bj][m][0]); } }
    }
    __device__ __forceinline__ void run(AccRef acc, const Unit& u, int wr, int wc, int fr, int fq, const LAS unsigned char* mt) const { pre(acc, u, wr, wc, fr, fq, mt); post(acc, u, wr, wc, fr, fq, mt); }
};

template <bool F8>
__device__ __forceinline__ void p0_transpose_item(const float* W, int ldw, void* WTv, int Kdim, const float* gain, LAS float* scr, int kb, int n0, int src0, int nvalid, int lane) {
    bf16_t* WT = (bf16_t*)WTv;
    const int k0 = 64 * kb;
    f32x4 ld4[8];
#pragma unroll
    for (int i = 0; i < 8; ++i) { const int kk = 8 * i + (lane >> 3), j = (lane & 7) * 4;
        ld4[i] = (f32x4){0.f, 0.f, 0.f, 0.f}; if (j < nvalid) ld4[i] = *(const f32x4*)(W + (size_t)(k0 + kk) * ldw + src0 + j); }
#pragma unroll
    for (int i = 0; i < 8; ++i) { const int kk = 8 * i + (lane >> 3), j = (lane & 7) * 4; const float gk = (gain ? gain[k0 + kk] : 1.0f) * (F8 ? 32.0f : 1.0f);
        LAS float* d = scr + kk * 33 + j; d[0] = ld4[i].x * gk; d[1] = ld4[i].y * gk; d[2] = ld4[i].z * gk; d[3] = ld4[i].w * gk; }
    LDS_WAIT(); asm volatile("" ::: "memory");
    const int c = lane & 7;
#pragma unroll
    for (int j = 0; j < 4; ++j) { const int n = (lane >> 3) + 8 * j; const LAS float* s = scr + (8 * c) * 33 + n;
        if constexpr (F8) { u32x2 o; o.x = pk4_fp8(s[0 * 33], s[1 * 33], s[2 * 33], s[3 * 33]); o.y = pk4_fp8(s[4 * 33], s[5 * 33], s[6 * 33], s[7 * 33]);
            *(u32x2*)((unsigned char*)WTv + (size_t)(n0 + n) * Kdim + k0 + 8 * c) = o; }
        else { u32x4 o; o.x = pk2(s[0 * 33], s[1 * 33]); o.y = pk2(s[2 * 33], s[3 * 33]); o.z = pk2(s[4 * 33], s[5 * 33]); o.w = pk2(s[6 * 33], s[7 * 33]);
            *(u32x4*)(WT + (size_t)(n0 + n) * Kdim + k0 + 8 * c) = o; } }
    LDS_WAIT(); asm volatile("" ::: "memory");
}
__device__ __forceinline__ void win_colmap(int nb, int& src0, int& nvalid) {
    const int pn = nb >> 3, j = (nb & 7) * 32, bj = j >> 7, slot = (j & 127) >> 5;
    nvalid = 32;
    if (pn < 2) src0 = (4 * pn + slot) * 64 + 32 * bj;
    else if (pn == 2) src0 = 640 + slot * 64 + 32 * bj;
    else if (pn == 3) { if (slot == 0) src0 = 512 + 32 * bj; else if (slot == 1) src0 = 896 + 32 * bj; else if (slot == 2) src0 = 576 + 32 * bj; else { src0 = 960; nvalid = bj == 0 ? 4 : 0; } }
    else src0 = 964 + 512 * bj + 128 * (pn - 4) + 32 * slot;
}
__device__ __forceinline__ void p0_prologue(const Params& P, LAS unsigned char* lds, int vcu, int G, int wave, int lane) {
    unsigned char* ws = P.ws;
    LAS float* scr = (LAS float*)(lds + wave * 16384);
    const int gw = vcu * NWAVES + wave, NGW = G * NWAVES;
    constexpr int I_IN = 16 * 64, I_OUT = 16 * 32, I_G = 16 * 32, I_P = 4 * 32;
    constexpr int NITEMS = I_IN + I_OUT + I_G + I_P;
    for (int it = gw; it < NITEMS; it += NGW) {
        int r = it;
        if (r < I_IN) { const int kb = r / 64, nb = r % 64; int s0, nv; win_colmap(nb, s0, nv); p0_transpose_item<false>(P.w_in, INW, (bf16_t*)(ws + WS_WIN), 1024, P.g_mix, scr, kb, nb * 32, s0, nv, lane); continue; } r -= I_IN;
        if (r < I_OUT) { const int kb = r / 32, nb = r % 32; p0_transpose_item<false>(P.w_out, 1024, (bf16_t*)(ws + WS_WOUT), 1024, nullptr, scr, kb, nb * 32, nb * 32, 32, lane); continue; } r -= I_OUT;
        if (r < I_G) { const int kb = r / 32, nb = r % 32; p0_transpose_item<true>(P.w_ple_gate, 1024, (unsigned char*)(ws + WS_WG), 1024, P.g_ple, scr, kb, nb * 32, nb * 32, 32, lane); continue; } r -= I_G;
        { const int kb = r / 32, nb = r % 32; p0_transpose_item<false>(P.w_ple_proj, 1024, (bf16_t*)(ws + WS_WP), 256, nullptr, scr, kb, nb * 32, nb * 32, 32, lane); }
    }
    float* rs1 = (float*)(ws + WS_RS1); bf16_t* xb = (bf16_t*)(ws + WS_XB);
    for (int m = gw; m < NTOK; m += NGW) {
        const f32x4* xr = (const f32x4*)(P.x + (size_t)m * DM) + lane; f32x4 v[4]; float s = 0.f;
#pragma unroll
        for (int j = 0; j < 4; ++j) { v[j] = xr[64 * j]; s += (v[j].x * v[j].x + v[j].y * v[j].y) + (v[j].z * v[j].z + v[j].w * v[j].w); }
        s = wave_sum(s);
        u32x2* o8 = (u32x2*)(xb + (size_t)m * DM) + lane;
#pragma unroll
        for (int j = 0; j < 4; ++j) { u32x2 w; w.x = pk2(v[j].x, v[j].y); w.y = pk2(v[j].z, v[j].w); o8[64 * j] = w; }
        if (lane == 0) rs1[m] = 1.0f / sqrtf(s * (1.0f / DM) + EPS);
    }
    bf16_t* pb = (bf16_t*)(ws + WS_PB);
    for (int m = gw; m < NTOK; m += NGW) { const f32x4 v = *((const f32x4*)(P.p + (size_t)m * 256) + lane); u32x2 w; w.x = pk2(v.x, v.y); w.y = pk2(v.z, v.w); *((u32x2*)(pb + (size_t)m * 256) + lane) = w; }
    f32x2* rope = (f32x2*)(ws + WS_ROPE);
    for (int idx = gw * 64 + lane; idx < SEQ * 32; idx += NGW * 64) { const int t = idx >> 5, i = idx & 31;
        const float inv = exp2f(-(float)i * (13.287712379549449f / 32.0f));
        const float ang = (float)t * inv;
        const double rev = (double)ang * 0.15915494309189535; const float fr = (float)(rev - __builtin_floor(rev));
        rope[idx] = (f32x2){__builtin_amdgcn_cosf(fr), __builtin_amdgcn_sinf(fr)}; }
    float* wrg = (float*)(ws + WS_WRG);
    for (int idx = gw * 64 + lane; idx < 1024 * 32; idx += NGW * 64) wrg[idx] = P.w_router[idx] * P.g_ffn[idx >> 5];
}

__device__ __forceinline__ unsigned fkey(float f) { unsigned u = __builtin_bit_cast(unsigned, f); if (u == 0x80000000u) u = 0u; return u ^ ((unsigned)((int)u >> 31) | 0x80000000u); }
__device__ __forceinline__ int mbcnt64(unsigned long long m) { return __builtin_amdgcn_mbcnt_hi((unsigned)(m >> 32), __builtin_amdgcn_mbcnt_lo((unsigned)m, 0u)); }

template <int NR>
__device__ __forceinline__ unsigned bisect_thr(const unsigned (&v)[NR], unsigned prefix, int startbit) {
    bool exact = false;
#pragma unroll 1
    for (int bit = startbit; bit >= 0; --bit) {
        const unsigned cand = prefix | (1u << bit); int cnt = 0;
#pragma unroll
        for (int r = 0; r < NR; ++r) { cnt += __builtin_popcountll(__ballot(v[r] >= cand)); if ((r & 7) == 7) __builtin_amdgcn_sched_barrier(0); }
        if (cnt >= NSEL) prefix = cand;
        if (cnt == NSEL) { exact = true; break; }
    }
    return exact ? prefix - 1u : prefix;
}
template <int NR, bool EXPL>
__device__ __forceinline__ void compact_sel(const unsigned (&v)[NR], const unsigned (&ci)[NR], unsigned T, LAS unsigned* list, int lane) {
    int cgt = 0;
#pragma unroll
    for (int r = 0; r < NR; ++r) { cgt += __builtin_popcountll(__ballot(v[r] > T)); if ((r & 7) == 7) __builtin_amdgcn_sched_barrier(0); }
    const int need = NSEL - cgt; int base = 0, ties = 0;
#pragma unroll
    for (int r = 0; r < NR; ++r) { const bool gt = v[r] > T, eq = v[r] == T; const unsigned long long em = __ballot(eq);
        const bool sel = gt || (eq && (ties + mbcnt64(em)) < need); const unsigned long long sm = __ballot(sel);
        list[sel ? base + mbcnt64(sm) : NSEL + lane] = EXPL ? ci[r] : (unsigned)(r * 64 + lane);
        base += __builtin_popcountll(sm); ties += __builtin_popcountll(em);
        if ((r & 3) == 3) __builtin_amdgcn_sched_barrier(0); }
}
constexpr int SEL_CAP = 1024;
template <int NR>
__device__ __forceinline__ void select_topk(LAS float* row, LAS unsigned* H, LAS unsigned* list, int lane, bool zero_h) {
    unsigned v[NR];
#pragma unroll
    for (int r = 0; r < NR; ++r) v[r] = fkey(row[r * 64 + lane]);
    LAS u32x4* H4 = (LAS u32x4*)H;
    const u32x4 h0 = H4[2 * lane], h1 = H4[2 * lane + 1];
    if (zero_h) { H4[2 * lane] = (u32x4){0u, 0u, 0u, 0u}; H4[2 * lane + 1] = (u32x4){0u, 0u, 0u, 0u}; }
    const unsigned hw[8] = {h0.x, h0.y, h0.z, h0.w, h1.x, h1.y, h1.z, h1.w};
    unsigned c[16];
#pragma unroll
    for (int i = 0; i < 8; ++i) { c[2 * i] = hw[i] & 0xffffu; c[2 * i + 1] = hw[i] >> 16; }
    unsigned s = 0u;
#pragma unroll
    for (int i = 0; i < 16; ++i) s += c[i];
    unsigned S = s;
#pragma unroll
    for (int off = 1; off < 64; off <<= 1) { const unsigned o = __shfl_down(S, off); if (lane + off < 64) S += o; }
    const unsigned long long okm = __ballot(S >= (unsigned)NSEL);
    bool fast = okm != 0ull; unsigned floorkey = 0u; int C = 0;
    if (fast) {
        const int Ls = 63 - __builtin_clzll(okm);
        unsigned acc = S - s; int bl = -1; unsigned accb = 0u;
#pragma unroll
        for (int b = 15; b >= 0; --b) { acc += c[b]; if (bl < 0 && acc >= (unsigned)NSEL) { bl = b; accb = acc; } }
        const int bstar = __shfl(bl, Ls) + 16 * Ls; C = (int)__shfl(accb, Ls);
        floorkey = (unsigned)bstar << 22;
        fast = (bstar > 1) && (C <= SEL_CAP);
    }
    if (!fast) {
        const unsigned T = bisect_thr<NR>(v, 0u, 31);
        compact_sel<NR, false>(v, v, T, list, lane);
        return;
    }
    LAS unsigned* ckl = (LAS unsigned*)row; LAS unsigned* cil = ckl + 1152;
    { int base = 0;
#pragma unroll
      for (int r = 0; r < NR; ++r) { const bool cnd = v[r] >= floorkey; const unsigned long long m = __ballot(cnd);
          const int pos = cnd ? base + mbcnt64(m) : SEL_CAP + lane;
          ckl[pos] = v[r]; cil[pos] = (unsigned)(r * 64 + lane); base += __builtin_popcountll(m);
          if ((r & 3) == 3) __builtin_amdgcn_sched_barrier(0); } }
    if (C <= 512) {
        unsigned ck[8], ci[8];
#pragma unroll
        for (int j = 0; j < 8; ++j) { const int i = j * 64 + lane; ck[j] = i < C ? ckl[i] : 0u; ci[j] = cil[i]; }
        const unsigned T = (C == NSEL) ? floorkey - 1u : bisect_thr<8>(ck, floorkey, 21);
        compact_sel<8, true>(ck, ci, T, list, lane);
    } else {
        unsigned ck[16], ci[16];
#pragma unroll
        for (int j = 0; j < 16; ++j) { const int i = j * 64 + lane; ck[j] = i < C ? ckl[i] : 0u; ci[j] = cil[i]; }
        const unsigned T = bisect_thr<16>(ck, floorkey, 21);
        compact_sel<16, true>(ck, ci, T, list, lane);
    }
}

typedef short v4i16 __attribute__((ext_vector_type(4)));
constexpr int VROW = 144;

__device__ __forceinline__ void attn_tile(const Params& P, LAS unsigned char* lds, int b, int t0, int wave, int lane) {
    unsigned char* ws = P.ws;
    const bf16_t* QI = (const bf16_t*)(ws + WS_QI); const bf16_t* KI = (const bf16_t*)(ws + WS_KI);
    const bf16_t* Q = (const bf16_t*)(ws + WS_Q); const bf16_t* Kp = (const bf16_t*)(ws + WS_K); const bf16_t* Vp = (const bf16_t*)(ws + WS_V);
    const float* WI = (const float*)(ws + WS_WI); bf16_t* MIX = (bf16_t*)(ws + WS_MIX);
    LAS float* SC = (LAS float*)lds;
    LAS unsigned* list = (LAS unsigned*)(lds + wave * 16384 + 14336);
    LAS unsigned* HIST = (LAS unsigned*)(lds + LDS_MISC);
    const int tokbase = b * SEQ;
    const bool need_sel = t0 >= 256;
    if (need_sel) {
        const int nkt = (t0 + 8 + 31) >> 5;
        bf16x8 a[4]; f32x4 w[4];
        { const bf16_t* src = QI + (size_t)(tokbase + t0 + ((lane & 31) >> 2)) * 256 + (lane & 3) * 64 + 8 * (lane >> 5);
#pragma unroll
          for (int ks = 0; ks < 4; ++ks) a[ks] = *(const bf16x8*)(src + 16 * ks); }
#pragma unroll
        for (int g = 0; g < 4; ++g) w[g] = *(const f32x4*)(WI + (size_t)(tokbase + t0 + 2 * g + (lane >> 5)) * 4);
        for (int kt0 = wave; kt0 < nkt; kt0 += 4 * NWAVES) {
            bf16x8 bf[4][4];
#pragma unroll
            for (int u = 0; u < 4; ++u) { const int kt = kt0 + u * NWAVES;
                if (kt < nkt) { const bf16_t* ksrc = KI + (size_t)(tokbase + kt * 32 + (lane & 31)) * 64 + 8 * (lane >> 5);
#pragma unroll
                    for (int ks = 0; ks < 4; ++ks) bf[u][ks] = *(const bf16x8*)(ksrc + 16 * ks); } }
#pragma unroll
            for (int u = 0; u < 4; ++u) { const int kt = kt0 + u * NWAVES;
                if (kt < nkt) {
                    const int key = kt * 32 + (lane & 31);
                    f32x16 acc;
#pragma unroll
                    for (int i = 0; i < 16; ++i) acc[i] = 0.f;
#pragma unroll
                    for (int ks = 0; ks < 4; ++ks) acc = __builtin_amdgcn_mfma_f32_32x32x16_bf16(a[ks], bf[u][ks], acc, 0, 0, 0);
#pragma unroll
                    for (int g = 0; g < 4; ++g) { float sc = 0.f;
#pragma unroll
                        for (int h = 0; h < 4; ++h) sc = fmaf(fmaxf(acc[4 * g + h], 0.f), w[g][h], sc);
                        const int ql = 2 * g + (lane >> 5);
                        if (key > t0 + ql) sc = -INFINITY;
                        SC[ql * 4096 + key] = sc;
                        if (key <= t0 + ql) { const unsigned ub = __builtin_bit_cast(unsigned, sc);
                            const unsigned bin = (ub >> 22) ^ (((unsigned)((int)ub >> 31) & 0x1ffu) | 0x200u);
                            __hip_atomic_fetch_add(HIST + ql * 512 + (bin >> 1), 1u << ((bin & 1u) << 4), __ATOMIC_RELAXED, __HIP_MEMORY_SCOPE_WORKGROUP); } }
                } }
        }
        { const int npad = ((t0 + 8 + 1023) >> 10) << 10;
          for (int i = nkt * 32 + (int)threadIdx.x; i < npad; i += NTHR) {
#pragma unroll
              for (int q = 0; q < 8; ++q) SC[q * 4096 + i] = -INFINITY; } }
    }
    __syncthreads();
    const int t = t0 + wave, tok = tokbase + t;
    if (need_sel) {
        LAS float* row = SC + wave * 4096; LAS unsigned* H = HIST + wave * 512; const int n = t + 1;
        if (n <= 1024) select_topk<16>(row, H, list, lane, true);
        else if (n <= 2048) select_topk<32>(row, H, list, lane, true);
        else if (n <= 3072) select_topk<48>(row, H, list, lane, true);
        else select_topk<64>(row, H, list, lane, true);
    } else {
#pragma unroll
        for (int i = 0; i < 4; ++i) list[i * 64 + lane] = (unsigned)(i * 64 + lane);
    }
    const int nvalid = need_sel ? NSEL : (t + 1);
    const int ngrp = (nvalid + 31) >> 5;
    const int hd = lane & 15, g = lane >> 4;
    bf16x8 qf0, qf1;
#pragma unroll
    for (int i = 0; i < 8; ++i) { qf0[i] = 0; qf1[i] = 0; }
    if (hd < 8) { const bf16_t* qs = Q + (size_t)tok * 512 + hd * 64 + 8 * g; qf0 = *(const bf16x8*)qs; qf1 = *(const bf16x8*)(qs + 32); }
    float m = -INFINITY, ssum = 0.f;
    f32x4 o[4];
#pragma unroll
    for (int dt = 0; dt < 4; ++dt) o[dt] = (f32x4){0.f, 0.f, 0.f, 0.f};
    LAS unsigned char* vreg = lds + wave * 16384;
    bf16x8 kfA[4], kfB[4]; u32x4 vvA[4], vvB[4];
#define ATT_LOAD(KF, VV, G_) do { const int nb_ = (G_) * 32; const unsigned ia_ = list[nb_ + hd], ib_ = list[nb_ + 16 + hd]; \
        const bf16_t* ka_ = Kp + (size_t)(tokbase + ia_) * 64 + 8 * g; const bf16_t* kb_ = Kp + (size_t)(tokbase + ib_) * 64 + 8 * g; \
        KF[0] = *(const bf16x8*)ka_; KF[1] = *(const bf16x8*)(ka_ + 32); KF[2] = *(const bf16x8*)kb_; KF[3] = *(const bf16x8*)(kb_ + 32); \
        _Pragma("unroll") for (int i_ = 0; i_ < 4; ++i_) { const unsigned idx_ = list[nb_ + (lane >> 3) + 8 * i_]; VV[i_] = *(const u32x4*)(Vp + (size_t)(tokbase + idx_) * 64 + 8 * (lane & 7)); } } while (0)
#define ATT_GROUP(KF, VV, G_, VBUF) do { \
        LAS unsigned char* vbuf_ = (VBUF); \
        f32x4 sa_ = {0.f, 0.f, 0.f, 0.f}, sb_ = {0.f, 0.f, 0.f, 0.f}; \
        sa_ = __builtin_amdgcn_mfma_f32_16x16x32_bf16(KF[0], qf0, sa_, 0, 0, 0); sa_ = __builtin_amdgcn_mfma_f32_16x16x32_bf16(KF[1], qf1, sa_, 0, 0, 0); \
        sb_ = __builtin_amdgcn_mfma_f32_16x16x32_bf16(KF[2], qf0, sb_, 0, 0, 0); sb_ = __builtin_amdgcn_mfma_f32_16x16x32_bf16(KF[3], qf1, sb_, 0, 0, 0); \
        _Pragma("unroll") for (int i_ = 0; i_ < 4; ++i_) *(LAS u32x4*)(vbuf_ + ((lane >> 3) + 8 * i_) * VROW + (lane & 7) * 16) = VV[i_]; \
        if ((G_) + 2 < ngrp) ATT_LOAD(KF, VV, (G_) + 2); \
        float l_[8]; float mloc_ = -INFINITY; \
        _Pragma("unroll") for (int r_ = 0; r_ < 4; ++r_) { const int sl_ = (G_) * 32 + 4 * g + r_; \
            l_[r_] = sl_ < nvalid ? sa_[r_] * 0.125f : -INFINITY; l_[4 + r_] = (sl_ + 16) < nvalid ? sb_[r_] * 0.125f : -INFINITY; \
            mloc_ = fmaxf(mloc_, fmaxf(l_[r_], l_[4 + r_])); } \
        mloc_ = fmaxf(mloc_, __shfl_xor(mloc_, 16)); mloc_ = fmaxf(mloc_, __shfl_xor(mloc_, 32)); \
        const float mnew_ = fmaxf(m, mloc_), alpha_ = __expf(m - mnew_); m = mnew_; \
        float ps_ = 0.f; \
        _Pragma("unroll") for (int r_ = 0; r_ < 8; ++r_) { l_[r_] = __expf(l_[r_] - mnew_); ps_ += l_[r_]; } \
        ssum = ssum * alpha_ + ps_; \
        bf16x8 pf_; \
        { const u32x4 pw_ = {cvt_pk_bf16(l_[0], l_[1]), cvt_pk_bf16(l_[2], l_[3]), cvt_pk_bf16(l_[4], l_[5]), cvt_pk_bf16(l_[6], l_[7])}; pf_ = __builtin_bit_cast(bf16x8, pw_); } \
        LAS unsigned char* ta_ = vbuf_ + (4 * g + (hd >> 2)) * VROW + (hd & 3) * 8; \
        _Pragma("unroll") for (int dt_ = 0; dt_ < 4; ++dt_) { \
            const v4i16 lo_ = __builtin_amdgcn_ds_read_tr16_b64_v4i16((LAS v4i16*)(ta_ + dt_ * 32)); \
            const v4i16 hi_ = __builtin_amdgcn_ds_read_tr16_b64_v4i16((LAS v4i16*)(ta_ + 16 * VROW + dt_ * 32)); \
            bf16x8 vf_; vf_[0] = lo_[0]; vf_[1] = lo_[1]; vf_[2] = lo_[2]; vf_[3] = lo_[3]; vf_[4] = hi_[0]; vf_[5] = hi_[1]; vf_[6] = hi_[2]; vf_[7] = hi_[3]; \
            o[dt_] = __builtin_amdgcn_mfma_f32_16x16x32_bf16(vf_, pf_, o[dt_] * alpha_, 0, 0, 0); } } while (0)
    ATT_LOAD(kfA, vvA, 0);
    if (ngrp > 1) ATT_LOAD(kfB, vvB, 1);
#pragma unroll 1
    for (int grp = 0; grp < ngrp; grp += 2) {
        ATT_GROUP(kfA, vvA, grp, vreg);
        if (grp + 1 < ngrp) ATT_GROUP(kfB, vvB, grp + 1, vreg + 8192);
    }
#undef ATT_LOAD
#undef ATT_GROUP
    ssum += __shfl_xor(ssum, 16); ssum += __shfl_xor(ssum, 32);
    const float inv = 1.0f / ssum;
    if (hd < 8) {
        bf16_t* op = MIX + (size_t)tok * 1024 + hd * 64 + 4 * g;
#pragma unroll
        for (int dt = 0; dt < 4; ++dt) { u32x2 w; w.x = cvt_pk_bf16(o[dt][0] * inv, o[dt][1] * inv); w.y = cvt_pk_bf16(o[dt][2] * inv, o[dt][3] * inv); *(u32x2*)(op + 16 * dt) = w; }
    }
    __syncthreads();
}

__device__ __forceinline__ void conv_tile(const Params& P, LAS unsigned char* lds, int tile, int tid, int wave, int lane) {
    unsigned char* ws = P.ws;
    const bf16_t* HG = (const bf16_t*)(ws + WS_HGLU); bf16_t* MIX = (bf16_t*)(ws + WS_MIX);
    LAS f32x2* part = (LAS f32x2*)(lds + LDS_MISC + 1024);
    LAS f32x2* stat = part + 256;
    LAS bf16_t* Lin = (LAS bf16_t*)lds;
    LAS bf16_t* Lout = (LAS bf16_t*)(lds + 65536);
    const int tok0 = tile * 32, t0 = tok0 & (SEQ - 1), c = tid;
    for (int ch = tid; ch < 62 * 64; ch += NTHR) { const int r = ch >> 6, cc = ch & 63; const int tt = t0 - 30 + r;
        u32x4 v = {0u, 0u, 0u, 0u}; if (tt >= 0) v = *(const u32x4*)(HG + (size_t)(tok0 - 30 + r) * 512 + cc * 8);
        *(LAS u32x4*)(Lin + r * 512 + cc * 8) = v; }
    __syncthreads();
    float in[62];
#pragma unroll
    for (int r = 0; r < 62; ++r) in[r] = __builtin_bit_cast(float, (unsigned)Lin[r * 512 + c] << 16);
    float out[32];
    const float bias = P.dw_b[c];
#pragma unroll
    for (int i = 0; i < 32; ++i) out[i] = bias;
#pragma unroll
    for (int j = 0; j < 31; ++j) { const float wj = P.dw_w[j * 512 + c];
#pragma unroll
        for (int i = 0; i < 32; ++i) out[i] = fmaf(in[i + j], wj, out[i]); }
#pragma unroll
    for (int i = 0; i < 32; ++i) { const float s1 = wave_sum(out[i]), s2 = wave_sum(out[i] * out[i]); if (lane == 0) part[i * 8 + wave] = (f32x2){s1, s2}; }
    __syncthreads();
    if (tid < 32) { float s1 = 0.f, s2 = 0.f;
#pragma unroll
        for (int w = 0; w < 8; ++w) { const f32x2 pp = part[tid * 8 + w]; s1 += pp.x; s2 += pp.y; }
        const float mean = s1 * (1.0f / 512.0f), var = fmaxf(s2 * (1.0f / 512.0f) - mean * mean, 0.f);
        stat[tid] = (f32x2){mean, 1.0f / sqrtf(var + EPS)}; }
    __syncthreads();
    const float lgc = P.ln_g[c], lbc = P.ln_b[c];
#pragma unroll
    for (int i = 0; i < 32; ++i) { const f32x2 st = stat[i]; const float y = (out[i] - st.x) * st.y * lgc + lbc; const float sl = y * sigmoidf_(y);
        Lout[i * 512 + c] = (bf16_t)f2bf(sl); }
    __syncthreads();
    for (int ch = tid; ch < 32 * 64; ch += NTHR) { const int r = ch >> 6, cc = ch & 63;
        *(u32x4*)(MIX + (size_t)(tok0 + r) * 1024 + 512 + cc * 8) = *(const LAS u32x4*)(Lout + r * 512 + cc * 8); }
    __syncthreads();
}

constexpr int MW_UP = 32 * 16 * 64, MW_DN = 32 * 16 * 32, MW_ITEMS = MW_UP + MW_DN;
__device__ __forceinline__ void mw_decode(const Params& P, int it, const float*& src, int& ldw, unsigned char*& dst, const float*& gain) {
    unsigned char* ws = P.ws;
    if (it < MW_UP) { const int e = it >> 10, rr = it & 1023, kb = rr >> 6, nb = rr & 63, pn = nb >> 3, j = (nb & 7) * 32, bj = j >> 7, jj = j & 127;
        src = P.w_up + (size_t)e * 1024 * 2048 + (size_t)(kb * 64) * 2048 + 1024 * bj + 128 * pn + jj; ldw = 2048;
        dst = ws + WS_WUP + (size_t)e * 2048 * 1024 + (size_t)(nb * 32) * 1024 + kb * 64; gain = P.g_ffn + kb * 64; }
    else { const int r = it - MW_UP, e = r >> 9, rr = r & 511, kb = rr >> 5, nb = rr & 31;
        src = P.w_down + (size_t)e * 1024 * 1024 + (size_t)(kb * 64) * 1024 + nb * 32; ldw = 1024;
        dst = ws + WS_WDOWN + (size_t)e * 1024 * 1024 + (size_t)(nb * 32) * 1024 + kb * 64; gain = nullptr; }
}
#define MW_LOAD(LD, it_) do { if ((it_) < MW_ITEMS) { const float* src_; int ldw_; unsigned char* dst_; const float* gain_; mw_decode(P, (it_), src_, ldw_, dst_, gain_); \
        _Pragma("unroll") for (int i_ = 0; i_ < 8; ++i_) LD[i_] = *(const f32x4*)(src_ + (size_t)(8 * i_ + (lane >> 3)) * ldw_ + (lane & 7) * 4); } } while (0)
#define MW_FINISH(LD, it_) do { if ((it_) < MW_ITEMS) { const float* src_; int ldw_; unsigned char* dst_; const float* gain_; mw_decode(P, (it_), src_, ldw_, dst_, gain_); \
        _Pragma("unroll") for (int i_ = 0; i_ < 8; ++i_) { const int kk_ = 8 * i_ + (lane >> 3), j_ = (lane & 7) * 4; const float gk_ = (gain_ ? gain_[kk_] : 1.0f) * 32.0f; \
            LAS float* d_ = scr + kk_ * 33 + j_; d_[0] = LD[i_].x * gk_; d_[1] = LD[i_].y * gk_; d_[2] = LD[i_].z * gk_; d_[3] = LD[i_].w * gk_; } \
        LDS_WAIT(); asm volatile("" ::: "memory"); \
        const int c_ = lane & 7; \
        _Pragma("unroll") for (int j_ = 0; j_ < 4; ++j_) { const int n_ = (lane >> 3) + 8 * j_; const LAS float* sp_ = scr + (8 * c_) * 33 + n_; \
            u32x2 o_; o_.x = pk4_fp8(sp_[0 * 33], sp_[1 * 33], sp_[2 * 33], sp_[3 * 33]); o_.y = pk4_fp8(sp_[4 * 33], sp_[5 * 33], sp_[6 * 33], sp_[7 * 33]); \
            *(u32x2*)(dst_ + (size_t)n_ * 1024 + 8 * c_) = o_; } \
        LDS_WAIT(); asm volatile("" ::: "memory"); } } while (0)
__device__ __forceinline__ void moe_weight_convert(const Params& P, LAS float* scr, int cw, int ncw, int lane) {
    f32x4 l0[8], l1[8], l2[8], l3[8];
    MW_LOAD(l0, cw); MW_LOAD(l1, cw + ncw); MW_LOAD(l2, cw + 2 * ncw);
    for (int base = cw; base < MW_ITEMS; base += 4 * ncw) {
        MW_LOAD(l3, base + 3 * ncw); MW_FINISH(l0, base);
        MW_LOAD(l0, base + 4 * ncw); MW_FINISH(l1, base + ncw);
        MW_LOAD(l1, base + 5 * ncw); MW_FINISH(l2, base + 2 * ncw);
        MW_LOAD(l2, base + 6 * ncw); MW_FINISH(l3, base + 3 * ncw);
    }
}
#undef MW_LOAD
#undef MW_FINISH

__device__ __forceinline__ void router_phase(const Params& P, LAS unsigned char* lds, int blk, int G, int tid, int wave, int lane) {
    unsigned char* ws = P.ws;
    const float* h1 = (const float*)(ws + WS_H1); const float* wrg = (const float*)(ws + WS_WRG);
    int* list = (int*)(ws + WS_LIST); float* lscale = (float*)(ws + WS_LSCALE); float* lgate = (float*)(ws + WS_LGATE);
    unsigned* cntg = (unsigned*)(ws + WS_CTL) + CW_CNT;
    LAS float* WL = (LAS float*)lds;
    LAS int* lcnt = (LAS int*)(lds + LDS_MISC + 1024);
    LAS int* gbase = lcnt + 32;
    LAS int* rec_e = gbase + 32;
    LAS int* rec_p = rec_e + 512;
    LAS float* rec_g = (LAS float*)(rec_p + 512);
    LAS float* rec_s = rec_g + 512;
    for (int i = tid; i < 8192; i += NTHR) ((LAS f32x4*)WL)[i] = ((const f32x4*)wrg)[i];
    __syncthreads();
    const int tl = lane & 31, half = lane >> 5;
    for (int chunk = blk; chunk < NTOK / 128; chunk += G) {
        if (tid < 32) lcnt[tid] = 0;
        __syncthreads();
        if (wave < 4) {
            const int tloc = wave * 32 + tl, tok = chunk * 128 + tloc;
            const float* hrow = h1 + (size_t)tok * DM + 4 * half;
            f32x16 acc;
#pragma unroll
            for (int i = 0; i < 16; ++i) acc[i] = 0.f;
            float ss = 0.f;
#pragma unroll 1
            for (int k0 = 0; k0 < DM; k0 += 32) {
                f32x4 hv[4];
#pragma unroll
                for (int i = 0; i < 4; ++i) hv[i] = *(const f32x4*)(hrow + k0 + 8 * i);
#pragma unroll
                for (int i = 0; i < 4; ++i) {
                    ss = fmaf(hv[i].x, hv[i].x, fmaf(hv[i].y, hv[i].y, fmaf(hv[i].z, hv[i].z, fmaf(hv[i].w, hv[i].w, ss))));
#pragma unroll
                    for (int j = 0; j < 4; ++j) { const float wv = WL[(k0 + 8 * i + 4 * half + j) * 32 + tl];
                        acc = __builtin_amdgcn_mfma_f32_32x32x2f32(wv, hv[i][j], acc, 0, 0, 0); }
                }
            }
            ss += __shfl_xor(ss, 32);
            const float rs = 1.0f / sqrtf(ss * (1.0f / DM) + EPS);
            float v[16];
#pragma unroll
            for (int r = 0; r < 16; ++r) v[r] = acc[r] * rs + P.b_router[(r & 3) + 8 * (r >> 2) + 4 * half];
            float tv[4]; int te[4];
#pragma unroll
            for (int q = 0; q < 4; ++q) { float bv = -INFINITY; int be = 64;
#pragma unroll
                for (int r = 0; r < 16; ++r) { const int e = (r & 3) + 8 * (r >> 2) + 4 * half; if (v[r] > bv || (v[r] == bv && e < be)) { bv = v[r]; be = e; } }
#pragma unroll
                for (int r = 0; r < 16; ++r) { const int e = (r & 3) + 8 * (r >> 2) + 4 * half; if (e == be) v[r] = -INFINITY; }
                tv[q] = bv; te[q] = be; }
            float cv[8]; int ce[8];
#pragma unroll
            for (int q = 0; q < 4; ++q) { cv[q] = tv[q]; ce[q] = te[q]; cv[4 + q] = __shfl_xor(tv[q], 32); ce[4 + q] = __shfl_xor(te[q], 32); }
#pragma unroll
            for (int q = 0; q < 4; ++q) { float bv = -INFINITY; int be = 64;
#pragma unroll
                for (int r = 0; r < 8; ++r) if (cv[r] > bv || (cv[r] == bv && ce[r] < be)) { bv = cv[r]; be = ce[r]; }
#pragma unroll
                for (int r = 0; r < 8; ++r) if (ce[r] == be) cv[r] = -INFINITY;
                tv[q] = bv; te[q] = be; }
            const float e1 = __expf(tv[1] - tv[0]), e2 = __expf(tv[2] - tv[0]), e3 = __expf(tv[3] - tv[0]);
            const float is = 1.0f / (1.0f + e1 + e2 + e3);
            if (half == 0) {
                const float gq[4] = {is, e1 * is, e2 * is, e3 * is};
#pragma unroll
                for (int q = 0; q < 4; ++q) { const int lp = atomicAdd((int*)&lcnt[te[q]], 1); const int si = tloc * 4 + q; rec_e[si] = te[q]; rec_p[si] = lp; rec_g[si] = gq[q]; }
                rec_s[tloc] = rs;
            }
        }
        __syncthreads();
        if (tid < 32) gbase[tid] = (int)atomicAdd(cntg + 64 * tid, (unsigned)lcnt[tid]);
        __syncthreads();
        { const int si = tid, ee = rec_e[si], pos = gbase[ee] + rec_p[si], li = ee * NTOK + pos;
          list[li] = (chunk * 128) * 4 + si; lscale[li] = rec_s[si >> 2]; lgate[li] = rec_g[si]; }
        __syncthreads();
    }
}

__device__ __forceinline__ void combine_phase(const Params& P, int gw, int NGW, int lane) {
    unsigned char* ws = P.ws;
    float* h1 = (float*)(ws + WS_H1); bf16_t* h1b = (bf16_t*)(ws + WS_H1B); const bf16_t* y = (const bf16_t*)(ws + WS_Y); float* rs3 = (float*)(ws + WS_RS3);
    for (int m = gw; m < NTOK; m += NGW) {
        const f32x4* hr = (const f32x4*)(h1 + (size_t)m * DM) + lane; f32x4 v[4]; float s = 0.f;
#pragma unroll
        for (int j = 0; j < 4; ++j) v[j] = hr[64 * j];
#pragma unroll
        for (int k = 0; k < 4; ++k) { const u32x2* yr = (const u32x2*)(y + (size_t)(m * 4 + k) * DM) + lane;
#pragma unroll
            for (int j = 0; j < 4; ++j) { const u32x2 w = yr[64 * j]; v[j].x += bf_lo(w.x); v[j].y += bf_hi(w.x); v[j].z += bf_lo(w.y); v[j].w += bf_hi(w.y); } }
        u32x2* o8 = (u32x2*)(h1b + (size_t)m * DM) + lane; unsigned* o4 = (unsigned*)(ws + WS_H1F8 + (size_t)m * DM) + lane;
#pragma unroll
        for (int j = 0; j < 4; ++j) { u32x2 w; w.x = pk2(v[j].x, v[j].y); w.y = pk2(v[j].z, v[j].w); o8[64 * j] = w; o4[64 * j] = pk4_fp8(v[j].x, v[j].y, v[j].z, v[j].w);
            s += (v[j].x * v[j].x + v[j].y * v[j].y) + (v[j].z * v[j].z + v[j].w * v[j].w); }
        s = wave_sum(s);
        if (lane == 0) rs3[m] = 1.0f / sqrtf(s * (1.0f / DM) + EPS);
    }
}

__device__ __forceinline__ void final_phase(const Params& P, int gw, int NGW, int lane) {
    unsigned char* ws = P.ws;
    const bf16_t* h2b = (const bf16_t*)(ws + WS_H1B); const bf16_t* pj = (const bf16_t*)(ws + WS_PJ); const bf16_t* G = (const bf16_t*)(ws + WS_G); const float* rs3 = (const float*)(ws + WS_RS3);
    f32x4 gv[4];
#pragma unroll
    for (int j = 0; j < 4; ++j) gv[j] = *((const f32x4*)P.g_final + lane + 64 * j);
    for (int m = gw; m < NTOK; m += NGW) {
        const u32x2* hr = (const u32x2*)(h2b + (size_t)m * DM) + lane; const u32x2* pr = (const u32x2*)(pj + (size_t)m * DM) + lane; const u32x2* gr = (const u32x2*)(G + (size_t)m * DM) + lane;
        const float r3 = rs3[m]; f32x4 v[4]; float s = 0.f;
#pragma unroll
        for (int j = 0; j < 4; ++j) { const u32x2 hw = hr[64 * j], pw = pr[64 * j], gw2 = gr[64 * j];
            v[j].x = bf_lo(hw.x) + bf_lo(pw.x) * sigmoidf_(bf_lo(gw2.x) * r3); v[j].y = bf_hi(hw.x) + bf_hi(pw.x) * sigmoidf_(bf_hi(gw2.x) * r3);
            v[j].z = bf_lo(hw.y) + bf_lo(pw.y) * sigmoidf_(bf_lo(gw2.y) * r3); v[j].w = bf_hi(hw.y) + bf_hi(pw.y) * sigmoidf_(bf_hi(gw2.y) * r3);
            s += (v[j].x * v[j].x + v[j].y * v[j].y) + (v[j].z * v[j].z + v[j].w * v[j].w); }
        s = wave_sum(s); const float rs = 1.0f / sqrtf(s * (1.0f / DM) + EPS);
        f32x4* orow = (f32x4*)(P.out + (size_t)m * DM) + lane;
#pragma unroll
        for (int j = 0; j < 4; ++j) orow[64 * j] = v[j] * rs * gv[j];
    }
}

#define XB_TMO      128
#define XB_XCNT(j)  (256  + 64 * (j))
#define XB_XSUB(j)  (1280 + 64 * (j))
#define XB_XGEN(j)  (2304 + 64 * (j))
#define XB_TOP      3328
#define XB_TOPGEN   3392
#define XCD_BAR_WORDS 3456
#define XB_SPIN_CAP (1u << 18)
__device__ __forceinline__ unsigned xb_ld(unsigned* p)              { return __hip_atomic_load(p, __ATOMIC_RELAXED, __HIP_MEMORY_SCOPE_AGENT); }
__device__ __forceinline__ unsigned xb_add(unsigned* p, unsigned v) { return __hip_atomic_fetch_add(p, v, __ATOMIC_RELAXED, __HIP_MEMORY_SCOPE_AGENT); }
__device__ __forceinline__ unsigned xb_xcc_id() { return (unsigned)__builtin_amdgcn_s_getreg((3 << 11) | 20) & 0xFu; }
#define XB_SPIN(cond, bar) do { unsigned _sp = 0; while (cond) { __builtin_amdgcn_s_sleep(1); \
    if ((++_sp & 255u) == 0u) { if (xb_ld(&(bar)[XB_TMO])) break; if (_sp > XB_SPIN_CAP) { atomicAdd(&(bar)[XB_TMO], 1u); break; } } } } while (0)
struct XcdBarrier { unsigned* bar; unsigned x; volatile LAS unsigned* st; };
__device__ __forceinline__ XcdBarrier xcd_barrier_post(unsigned* bar, volatile LAS unsigned* st) {
    XcdBarrier b; b.bar = bar; b.x = xb_xcc_id(); b.st = st;
    if (threadIdx.x == 0) (void)xb_add(&bar[XB_XCNT(b.x)], 1u);
    return b;
}
__device__ __forceinline__ void xcd_barrier_complete(unsigned* bar, unsigned x, unsigned& nloc, unsigned& nx) {
    const unsigned G = gridDim.x * gridDim.y * gridDim.z;
    unsigned sum, cnt, mine, sp = 0u;
    for (;;) {
        sum = 0u; cnt = 0u; mine = 0u;
#pragma unroll
        for (unsigned j = 0; j < 16; ++j) { const unsigned c = xb_ld(&bar[XB_XCNT(j)]); sum += c; cnt += (c > 0u) ? 1u : 0u; mine = (j == x) ? c : mine; }
        if (sum == G) break;
        __builtin_amdgcn_s_sleep(1);
        if ((++sp & 255u) == 0u) { if (xb_ld(&bar[XB_TMO])) break; if (sp > XB_SPIN_CAP) { atomicAdd(&bar[XB_TMO], 1u); break; } }
    }
    nloc = mine > 0u ? mine : 1u; nx = cnt > 0u ? cnt : 1u;
}
__device__ __forceinline__ void xcd_barrier(const XcdBarrier& b) {
    asm volatile("s_waitcnt vmcnt(0)" ::: "memory");
    __syncthreads();
    if (threadIdx.x == 0) {
        unsigned* bar = b.bar;
        __builtin_amdgcn_s_waitcnt(0);
        unsigned nloc = b.st[0], nx = b.st[1];
        if (nloc == 0u) { xcd_barrier_complete(bar, b.x, nloc, nx); b.st[0] = nloc; b.st[1] = nx; }
        const unsigned old = xb_add(&bar[XB_XSUB(b.x)], 1u);
        const unsigned gen = old / nloc;
        if (old + 1u == (gen + 1u) * nloc) {
            __builtin_amdgcn_fence(__ATOMIC_RELEASE, "agent");
            asm volatile("s_waitcnt vmcnt(0)" ::: "memory");
            const unsigned og = xb_add(&bar[XB_TOP], 1u);
            const unsigned tg = og / nx;
            if (og + 1u == (tg + 1u) * nx) xb_add(&bar[XB_TOPGEN], 1u);
            else XB_SPIN(xb_ld(&bar[XB_TOPGEN]) == tg, bar);
            __builtin_amdgcn_fence(__ATOMIC_ACQUIRE, "agent");
            xb_add(&bar[XB_XGEN(b.x)], 1u);
            asm volatile("s_waitcnt vmcnt(0)" ::: "memory");
        } else {
            XB_SPIN(xb_ld(&bar[XB_XGEN(b.x)]) == gen, bar);
            __builtin_amdgcn_fence(__ATOMIC_ACQUIRE, "agent");
            asm volatile("s_waitcnt vmcnt(0)" ::: "memory");
        }
    }
    __syncthreads();
}

constexpr int NPHASE = 10;
__global__ void __launch_bounds__(NTHR, 2) fwd_kernel(Params P) {
    extern __shared__ __attribute__((aligned(16))) unsigned char lds_raw[];
    LAS unsigned char* lds = (LAS unsigned char*)lds_raw;
    cg::grid_group grid = cg::this_grid();
    const int tid = threadIdx.x, wave = __builtin_amdgcn_readfirstlane(tid >> 6);
    const int G = gridDim.x, bx = blockIdx.x;
#define FRESH_LANE(name) int name = (int)__builtin_amdgcn_mbcnt_hi(~0u, __builtin_amdgcn_mbcnt_lo(~0u, 0u)); asm volatile("" : "+v"(name))
    const int vcu = (G % 8 == 0) ? (bx % 8) * (G / 8) + bx / 8 : bx;
    const int NGW = G * NWAVES;
    unsigned char* ws = P.ws;
    const int lo = P.ph_lo, hi = P.ph_hi;
#define IN(k) (lo <= (k) && (k) < hi)
    volatile LAS unsigned* xst = (volatile LAS unsigned*)(lds + LDS_XB);
    if (tid < 2) xst[tid] = 0u;
    __syncthreads();
    const XcdBarrier xbar = xcd_barrier_post((unsigned*)(ws + WS_CTL) + CW_BAR, xst);
#define SYNC(k) do { if (IN(k) && IN((k) + 1)) { if ((k) == 0) grid.sync(); else xcd_barrier(xbar); } } while (0)

    if (IN(0)) { FRESH_LANE(lane); p0_prologue(P, lds, vcu, G, wave, lane); }
    SYNC(0);
    if (IN(1)) {
        { pg8::DenseSched S; S.init((const bf16_t*)(ws + WS_XB), (const bf16_t*)(ws + WS_WIN), NTOK, 2048, 1024, G, bx);
          EpiInProj E{(const float*)(ws + WS_RS1), (const f32x2*)(ws + WS_ROPE), P.glu_b, (bf16_t*)(ws + WS_Q), (bf16_t*)(ws + WS_K), (bf16_t*)(ws + WS_V), (bf16_t*)(ws + WS_QI), (bf16_t*)(ws + WS_KI), (bf16_t*)(ws + WS_HGLU), (float*)(ws + WS_WI)};
          pg8::gemm_phase<EpiInProj, pg8::DenseSched, false>(lds, S, E); }
        { pg8::DenseSched S; S.init((const bf16_t*)(ws + WS_PB), (const bf16_t*)(ws + WS_WP), NTOK, 1024, 256, G, bx);
          EpiBf16Plain E{(bf16_t*)(ws + WS_PJ), 1024, 1.0f};
          pg8::gemm_phase<EpiBf16Plain, pg8::DenseSched, false>(lds, S, E); }
    }
    SYNC(1);
    if (IN(2)) {
        FRESH_LANE(lane);
        for (int i = tid; i < 4096; i += NTHR) ((LAS unsigned*)(lds + LDS_MISC))[i] = 0u;
        __syncthreads();
        unsigned* ctl = (unsigned*)(ws + WS_CTL);
        volatile LAS int* qw = (volatile LAS int*)(lds + LDS_XB + 32);
        if (G % 8 == 0 && G >= 128) { const int ncv = 8; if ((bx >> 3) < ncv) moe_weight_convert(P, (LAS float*)(lds + wave * 16384), (bx * NWAVES) + wave, ncv * 8 * NWAVES, lane); }
        else { moe_weight_convert(P, (LAS float*)(lds + wave * 16384), bx * NWAVES + wave, G * NWAVES, lane); }
        __syncthreads();
        for (int db = 0; db < NB; ++db) { const int b = (bx + db) & 7;
            for (;;) {
                if (tid == 0) qw[0] = (int)atomicAdd(ctl + CW_AQ + 64 * b, 1u);
                __syncthreads();
                const int k = qw[0];
                if (k >= 512) break;
                attn_tile(P, lds, b, (511 - k) * 8, wave, lane);
            }
            __syncthreads(); }
        for (;;) {
            if (tid == 0) qw[0] = (int)atomicAdd(ctl + CW_CQ, 1u);
            __syncthreads();
            const int tl = qw[0];
            if (tl >= NTOK / 32) break;
            conv_tile(P, lds, tl, tid, wave, lane);
        }
    }
    SYNC(2);
    if (IN(3)) {
        pg8::DenseSched S; S.init((const bf16_t*)(ws + WS_MIX), (const bf16_t*)(ws + WS_WOUT), NTOK, 1024, 1024, G, bx);
        EpiOutProj E{P.x, (float*)(ws + WS_H1), (unsigned char*)(ws + WS_H1F8)};
        pg8::gemm_phase<EpiOutProj, pg8::DenseSched, false, false, true>(lds, S, E);
    }
    SYNC(3);
    if (IN(4)) { FRESH_LANE(lane); router_phase(P, lds, vcu, G, tid, wave, lane); }
    SYNC(4);
    if (IN(5) || IN(6)) {
        LAS int* tb = (LAS int*)(lds + LDS_MISC); LAS int* cn = tb + 64;
        if (tid == 0) { const unsigned* cntg = (const unsigned*)(ws + WS_CTL) + CW_CNT; int acc = 0;
            for (int e = 0; e < NE; ++e) { const int c = (int)__hip_atomic_load(cntg + 64 * e, __ATOMIC_RELAXED, __HIP_MEMORY_SCOPE_AGENT); tb[e] = acc; cn[e] = c; acc += (c + BM - 1) / BM; }
            tb[NE] = acc; }
        __syncthreads();
        if (IN(5)) {
            pg8::MoeSched S; S.A = ws + WS_H1F8; S.Bt = ws + WS_WUP; S.rp = 1024; S.b_estride = (size_t)2048 * 1024; S.tb = tb; S.cnt = cn; S.list = (const int*)(ws + WS_LIST);
            S.nN = 8; S.nwg = tb[NE] * 8; S.G = G; S.c = bx; S.gather = true;
            { LAS int* ut = (LAS int*)(lds + LDS_MISC + 512); S.utab = ut; S.build_table(ut, tid); __syncthreads(); }
            S.m_scale = (const float*)(ws + WS_LSCALE); S.m_gate = nullptr; S.m_bias = P.b_up;
            EpiUp E{(unsigned char*)(ws + WS_ACT)};
            pg8::gemm_phase<EpiUp, pg8::MoeSched, true, true, true>(lds, S, E);
        }
        SYNC(5);
        if (IN(6)) {
            pg8::MoeSched S; S.A = ws + WS_ACT; S.Bt = ws + WS_WDOWN; S.rp = 1024; S.b_estride = (size_t)1024 * 1024; S.tb = tb; S.cnt = cn; S.list = (const int*)(ws + WS_LIST);
            S.nN = 4; S.nwg = tb[NE] * 4; S.G = G; S.c = bx; S.gather = false;
            { LAS int* ut = (LAS int*)(lds + LDS_MISC + 512); S.utab = ut; S.build_table(ut, tid); __syncthreads(); }
            S.m_scale = nullptr; S.m_gate = (const float*)(ws + WS_LGATE); S.m_bias = P.b_down;
            EpiDown E{(bf16_t*)(ws + WS_Y)};
            pg8::gemm_phase<EpiDown, pg8::MoeSched, true, true, true>(lds, S, E);
        }
    }
    SYNC(6);
    if (IN(7)) { FRESH_LANE(l7); const int g7 = vcu * NWAVES + wave;
        combine_phase(P, g7, NGW, l7); }
    SYNC(7);
    if (IN(8)) {
        pg8::DenseSched S; S.init(ws + WS_H1F8, ws + WS_WG, NTOK, 1024, 1024, G, bx); S.rp = 1024; S.idg = true;
        EpiBf16Plain E{(bf16_t*)(ws + WS_G), 1024, 0.03125f};
        pg8::gemm_phase<EpiBf16Plain, pg8::DenseSched, true, true>(lds, S, E);
    }
    SYNC(8);
    if (IN(9)) { FRESH_LANE(l9); const int g9 = vcu * NWAVES + wave;
        final_phase(P, g9, NGW, l9); }
#undef IN
#undef SYNC
}

#ifndef N_LAUNCH_MODE
#define N_LAUNCH_MODE 1
#endif
extern "C" void kernel_launch(void* const* d_in, const int* in_sizes, int n_in, void* d_out, int out_size, void* d_ws, size_t ws_size, hipStream_t stream) {
    static int grid = 0;
    if (grid == 0) {
        if (n_in != 21 || out_size != NTOK * DM || ws_size < WS_END) { fprintf(stderr, "kernel_launch: unexpected shapes (n_in %d out %d ws %zu)\n", n_in, out_size, ws_size); grid = -1; return; }
        int dev = 0, cus = 0, per_cu = 0;
        (void)hipGetDevice(&dev); (void)hipDeviceGetAttribute(&cus, hipDeviceAttributeMultiprocessorCount, dev);
        (void)hipFuncSetAttribute((const void*)fwd_kernel, hipFuncAttributeMaxDynamicSharedMemorySize, LDS_BYTES);
        if (hipOccupancyMaxActiveBlocksPerMultiprocessor(&per_cu, (const void*)fwd_kernel, NTHR, LDS_BYTES) != hipSuccess || per_cu < 1) { fprintf(stderr, "kernel_launch: occupancy query failed (%d)\n", per_cu); (void)hipGetLastError(); grid = -1; return; }
        grid = cus;
    }
    if (grid < 0) return;
    (void)hipMemsetAsync((char*)d_ws + WS_CTL, 0, CTL_BYTES, stream);
    Params p{};
    p.x = (const float*)d_in[0]; p.p = (const float*)d_in[1]; p.w_in = (const float*)d_in[2]; p.w_out = (const float*)d_in[3]; p.g_mix = (const float*)d_in[4]; p.g_ffn = (const float*)d_in[5];
    p.glu_b = (const float*)d_in[6]; p.dw_w = (const float*)d_in[7]; p.dw_b = (const float*)d_in[8]; p.ln_g = (const float*)d_in[9]; p.ln_b = (const float*)d_in[10];
    p.w_router = (const float*)d_in[11]; p.b_router = (const float*)d_in[12]; p.w_up = (const float*)d_in[13]; p.b_up = (const float*)d_in[14]; p.w_down = (const float*)d_in[15]; p.b_down = (const float*)d_in[16];
    p.w_ple_proj = (const float*)d_in[17]; p.w_ple_gate = (const float*)d_in[18]; p.g_ple = (const float*)d_in[19]; p.g_final = (const float*)d_in[20];
    p.out = (float*)d_out; p.ws = (unsigned char*)d_ws;
#if N_LAUNCH_MODE == 1
    p.ph_lo = 0; p.ph_hi = NPHASE;
    void* args[] = {&p};
    hipError_t e = hipLaunchCooperativeKernel((const void*)fwd_kernel, dim3(grid), dim3(NTHR), args, LDS_BYTES, stream);
    if (e != hipSuccess) fprintf(stderr, "cooperative launch failed: %s (grid %d)\n", hipGetErrorString(e), grid);
#else
    for (int ph = 0; ph < NPHASE; ++ph) {
        p.ph_lo = ph; p.ph_hi = ph + 1;
        void* args[] = {&p};
        hipError_t e = hipLaunchCooperativeKernel((const void*)fwd_kernel, dim3(grid), dim3(NTHR), args, LDS_BYTES, stream);
        if (e != hipSuccess) { fprintf(stderr, "launch %d failed: %s (grid %d)\n", ph, hipGetErrorString(e), grid); break; }
    }
#endif
}
```

```cpp
#include <hip/hip_runtime.h>
#include <hip/hip_cooperative_groups.h>
#include <cstdio>
#include <cstdint>
namespace cg = cooperative_groups;

#define LAS __attribute__((address_space(3)))
#define GAS __attribute__((address_space(1)))
typedef unsigned short bf16_t;
typedef short bf16x8 __attribute__((ext_vector_type(8)));
typedef short s16x4 __attribute__((ext_vector_type(4)));
typedef float f32x4 __attribute__((ext_vector_type(4)));
typedef float f32x2 __attribute__((ext_vector_type(2)));
typedef float f32x16 __attribute__((ext_vector_type(16)));
typedef unsigned u32x4 __attribute__((ext_vector_type(4)));
typedef unsigned u32x2 __attribute__((ext_vector_type(2)));

constexpr int NB = 8, SEQ = 4096, DM = 1024, NTOK = NB * SEQ;
constexpr int NE = 32, TOPK = 4, NSLOT = NTOK * TOPK;
constexpr int INW = 1988;
constexpr int NSEL = 256;
constexpr float EPS = 1e-6f;
constexpr int NWAVES = 8, NTHR = 512;

constexpr size_t MiB = 1u << 20;
constexpr size_t WS_CTL = 0, CTL_BYTES = 64 * 1024;
constexpr size_t WS_ROPE = 1 * MiB;
constexpr size_t WS_WIN = 2 * MiB;
constexpr size_t WS_WOUT = 6 * MiB;
constexpr size_t WS_WG = 8 * MiB;
constexpr size_t WS_WP = 10 * MiB;
constexpr size_t WS_WRG = 10 * MiB + 512 * 1024;
constexpr size_t WS_RS1 = 11 * MiB;
constexpr size_t WS_RS3 = 11 * MiB + 512 * 1024;
constexpr size_t WS_WI = 12 * MiB;
constexpr size_t WS_LIST = 13 * MiB;
constexpr size_t WS_LSCALE = 17 * MiB;
constexpr size_t WS_LGATE = 21 * MiB;
constexpr size_t WS_PB = 25 * MiB;
constexpr size_t WS_WUP = 42 * MiB;
constexpr size_t WS_WDOWN = 170 * MiB;
constexpr size_t WS_H1 = 234 * MiB;
constexpr size_t WS_H1B = 362 * MiB;
constexpr size_t WS_PJ = 426 * MiB;
constexpr size_t WS_XB = 490 * MiB;
constexpr size_t WS_Q = 554 * MiB;
constexpr size_t WS_K = 586 * MiB;
constexpr size_t WS_V = 590 * MiB;
constexpr size_t WS_QI = 594 * MiB;
constexpr size_t WS_KI = 610 * MiB;
constexpr size_t WS_HGLU = 614 * MiB;
constexpr size_t WS_MIX = 646 * MiB;
constexpr size_t WS_H1F8 = 490 * MiB;
constexpr size_t WS_ACT = 522 * MiB;
constexpr size_t WS_Y = 762 * MiB;
constexpr size_t WS_G = 762 * MiB;
constexpr size_t WS_END = 1018 * MiB;
static_assert(WS_H1F8 + (size_t)NTOK * 1024 <= WS_ACT && WS_ACT + (size_t)139264 * 1024 <= WS_Y, "ws map");
constexpr int CW_CNT = 1024;
constexpr int CW_AQ = 4096;
constexpr int CW_CQ = 4096 + 64 * 8;
constexpr int CW_BAR = 8192;

constexpr int LDS_STAGE = 131072;
constexpr int LDS_MISC = LDS_STAGE;
constexpr int LDS_META = LDS_MISC + 4096;
constexpr int LDS_XB = 147456;
constexpr int LDS_BYTES = 147456 + 256;

__device__ __forceinline__ unsigned f2bf(float f) { unsigned u = __builtin_bit_cast(unsigned, f); return (u + 0x7fffu + ((u >> 16) & 1u)) >> 16; }
__device__ __forceinline__ unsigned pk2(float lo, float hi) { return f2bf(lo) | (f2bf(hi) << 16); }
__device__ __forceinline__ float bf_lo(unsigned w) { return __builtin_bit_cast(float, w << 16); }
__device__ __forceinline__ float bf_hi(unsigned w) { return __builtin_bit_cast(float, w & 0xffff0000u); }
__device__ __forceinline__ float wave_sum(float v) {
    v += __builtin_bit_cast(float, __builtin_amdgcn_update_dpp(0, __builtin_bit_cast(int, v), 0xB1, 0xF, 0xF, true));
    v += __builtin_bit_cast(float, __builtin_amdgcn_update_dpp(0, __builtin_bit_cast(int, v), 0x4E, 0xF, 0xF, true));
    v += __builtin_bit_cast(float, __builtin_amdgcn_update_dpp(0, __builtin_bit_cast(int, v), 0x141, 0xF, 0xF, true));
    v += __builtin_bit_cast(float, __builtin_amdgcn_update_dpp(0, __builtin_bit_cast(int, v), 0x140, 0xF, 0xF, true));
    const int vi = __builtin_bit_cast(int, v);
    const float r0 = __builtin_bit_cast(float, __builtin_amdgcn_readlane(vi, 0)), r1 = __builtin_bit_cast(float, __builtin_amdgcn_readlane(vi, 16));
    const float r2 = __builtin_bit_cast(float, __builtin_amdgcn_readlane(vi, 32)), r3 = __builtin_bit_cast(float, __builtin_amdgcn_readlane(vi, 48));
    return (r0 + r1) + (r2 + r3);
}
__device__ __forceinline__ unsigned pk4_fp8(float a, float b, float c, float d) { int r = __builtin_amdgcn_cvt_pk_fp8_f32(a, b, 0, false); r = __builtin_amdgcn_cvt_pk_fp8_f32(c, d, r, true); return (unsigned)r; }
__device__ __forceinline__ float sigmoidf_(float x) { return __builtin_amdgcn_rcpf(1.0f + __builtin_amdgcn_exp2f(x * -1.4426950408889634f)); }
#define LDS_WAIT() asm volatile("s_waitcnt lgkmcnt(0)" ::: "memory")

struct Params {
    const float* x; const float* p; const float* w_in; const float* w_out; const float* g_mix; const float* g_ffn;
    const float* glu_b; const float* dw_w; const float* dw_b; const float* ln_g; const float* ln_b;
    const float* w_router; const float* b_router; const float* w_up; const float* b_up; const float* w_down; const float* b_down;
    const float* w_ple_proj; const float* w_ple_gate; const float* g_ple; const float* g_final;
    float* out; unsigned char* ws;
    int ph_lo, ph_hi;
};

namespace pg8 {
constexpr int BM = 256, BK = 64, HALF = 128, HTB = HALF * BK * 2, STAGE_BYTES = 8 * HTB, NXCD = 8, WGM = 8;
__host__ __device__ __forceinline__ int lds_byte(int r, int c) { const int st = (r >> 4) * 2 + (c >> 5), rr = r & 15, cc = c & 31, ob = rr * 64 + cc * 2; return st * 1024 + (ob ^ (((ob >> 9) & 1) << 5)); }
__host__ __device__ __forceinline__ void stage_rc(int b, int& R, int& C) { const int st = b / 1024, sb = b % 1024, swz = sb ^ (((sb >> 9) & 1) << 5); R = (st >> 1) * 16 + swz / 64; C = (st & 1) * 32 + (swz % 64) / 2; }
__host__ __device__ __forceinline__ int perm32(int rho) { const int n = rho >> 4, i = rho & 15; return 8 * (i >> 2) + 4 * n + (i & 3); }

struct Unit { int pm, pn, e, rows; };

__device__ __forceinline__ unsigned cvt_pk_bf16(float lo, float hi) { unsigned r; asm volatile("v_cvt_pk_bf16_f32 %0, %1, %2" : "=v"(r) : "v"(lo), "v"(hi)); return r; }

struct DenseSched {
    const void* A; const void* Bt; int rp;
    int nM, nN, nwg, G, c;
    __device__ void init(const void* A_, const void* Bt_, int M, int N, int K_, int G_, int c_) { A = A_; Bt = Bt_; rp = K_ * 2; nM = M / BM; nN = N / BM; nwg = nM * nN; G = G_; c = c_; }
    __device__ bool next(int i, Unit& u) const {
        const long L = (long)i * G + c; if (L >= nwg) return false;
        int wgid = (int)L; { const int q = nwg / NXCD, r = nwg % NXCD, xcd = wgid % NXCD, off = wgid / NXCD; wgid = (xcd < r ? xcd * (q + 1) : r * (q + 1) + (xcd - r) * q) + off; }
        const int nig = WGM * nN, gid = wgid / nig, fm = gid * WGM, gsz = (nM - fm) < WGM ? (nM - fm) : WGM;
        u.pm = fm + ((wgid % nig) % gsz); u.pn = (wgid % nig) / gsz; u.e = 0; u.rows = BM; return true;
    }
    bool idg = false;
    __device__ __forceinline__ const char* a_ptr(const Unit& u) const { return idg ? (const char*)A : (const char*)A + (size_t)u.pm * BM * rp; }
    __device__ __forceinline__ const char* b_ptr(const Unit& u) const { return (const char*)Bt + (size_t)u.pn * BM * rp; }
    __device__ __forceinline__ int a_row(const Unit& u, int r) const { return u.pm * BM + r; }
    __device__ __forceinline__ void meta(const Unit&, LAS unsigned char*, int, int) const {}
};

struct MoeSched {
    const void* A; const void* Bt; int rp; size_t b_estride;
    const LAS int* tb;
    const LAS int* cnt;
    const int* list;
    int nN, nwg, G, c; bool gather;
    const LAS int* utab;
    __device__ __forceinline__ bool next(int i, Unit& u) const {
        if (i >= 32) return false;
        const LAS int* p = utab + 4 * i; const int rows = p[3]; if (rows < 0) return false;
        u.pm = p[0]; u.pn = p[1]; u.e = p[2]; u.rows = rows; return true;
    }
    __device__ __forceinline__ void build_table(LAS int* tab, int tid) const {
        if (tid < 32) { Unit u; const bool ok = decode(tid, u); tab[4 * tid] = u.pm; tab[4 * tid + 1] = u.pn; tab[4 * tid + 2] = u.e; tab[4 * tid + 3] = ok ? u.rows : -1; }
    }
    __device__ __forceinline__ bool decode(int i, Unit& u) const {
        u.pm = 0; u.pn = 0; u.e = 0; u.rows = 0;
        const long L = (long)i * G + c; if (L >= nwg) return false;
        int wgid = (int)L; { const int q = nwg / NXCD, r = nwg % NXCD, xcd = wgid % NXCD, off = wgid / NXCD; wgid = (xcd < r ? xcd * (q + 1) : r * (q + 1) + (xcd - r) * q) + off; }
        int e = 0;
#pragma unroll 1
        for (; e < NE - 1; ++e) { if (wgid < tb[e + 1] * nN) break; }
        const int local = wgid - tb[e] * nN, nM = tb[e + 1] - tb[e];
        const int nig = WGM * nN, gid = local / nig, fm = gid * WGM, gsz = (nM - fm) < WGM ? (nM - fm) : WGM;
        const int rt = fm + ((local % nig) % gsz);
        u.pm = tb[e] + rt; u.pn = (local % nig) / gsz; u.e = e;
        const int left = cnt[e] - rt * BM; u.rows = left < BM ? left : BM; return true;
    }
    __device__ __forceinline__ const char* a_ptr(const Unit& u) const { return (const char*)A; }
    __device__ __forceinline__ const char* b_ptr(const Unit& u) const { return (const char*)Bt + (size_t)u.e * b_estride + (size_t)u.pn * BM * rp; }
    __device__ __forceinline__ int a_row(const Unit& u, int r) const {
        if (!gather) return u.pm * BM + r;
        const int rt = u.pm - tb[u.e];
        return r < u.rows ? (list[u.e * NTOK + rt * BM + r] >> 2) : 0;
    }
    const float* m_scale; const float* m_gate; const float* m_bias;
    __device__ __forceinline__ void meta(const Unit& u, LAS unsigned char* tbl, int wid, int lane) const {
        const int rt = u.pm - tb[u.e]; const size_t li = (size_t)u.e * NTOK + rt * BM + (wid & 3) * 64 + lane;
        if (gather) {
            if (wid < 4) __builtin_amdgcn_global_load_lds((const unsigned*)(m_scale + li), (LAS unsigned*)(tbl + (wid & 3) * 256), 4, 0, 0);
            else { const int j = (wid & 3) * 64 + lane; const float* src = m_bias + (size_t)u.e * 2048 + (j < 128 ? 128 * u.pn + j : 1024 + 128 * u.pn + (j - 128));
                __builtin_amdgcn_global_load_lds((const unsigned*)src, (LAS unsigned*)(tbl + 2048 + (wid & 3) * 256), 4, 0, 0); }
        } else {
            if (wid < 4) { __builtin_amdgcn_global_load_lds((const unsigned*)(list + li), (LAS unsigned*)(tbl + (wid & 3) * 256), 4, 0, 0);
                __builtin_amdgcn_global_load_lds((const unsigned*)(m_bias + (size_t)u.e * 1024 + u.pn * BM + (wid & 3) * 64 + lane), (LAS unsigned*)(tbl + 2048 + (wid & 3) * 256), 4, 0, 0); }
            else __builtin_amdgcn_global_load_lds((const unsigned*)(m_gate + li), (LAS unsigned*)(tbl + 1024 + (wid & 3) * 256), 4, 0, 0);
        }
    }
};

typedef int v8i32 __attribute__((ext_vector_type(8)));
template <class Epi, class Sched, bool GATHER, bool F8 = false, bool WARMTRIP = false>
__device__ __forceinline__ void gemm_phase(LAS unsigned char* lds, const Sched& S, const Epi& E) {
    const int tid = threadIdx.x, wid = __builtin_amdgcn_readfirstlane(tid >> 6), lane = tid & 63, wr = wid >> 2, wc = wid & 3, fr = lane & 15, fq = lane >> 4;
    const int RP = S.rp, nt = RP / (BK * 2);
    unsigned voffA[2], voffB[2]; int RA[2], CA[2];
#pragma unroll
    for (int i = 0; i < 2; ++i) { int R, C; stage_rc(tid * 16 + i * 8192, R, C); const int Rb = Epi::PERM ? ((R & ~31) + perm32(R & 31)) : R;
        voffA[i] = (unsigned)(R * RP + C * 2); voffB[i] = (unsigned)(Rb * RP + C * 2); RA[i] = R; CA[i] = C; }
    const size_t kstep = (size_t)(BK * 2);
    const size_t hstep = (size_t)HALF * RP;
    const unsigned ldsw = (unsigned)wid * 1024u;
    const int aoff = lds_byte(wr * 64 + fr, fq * 8), boff = lds_byte(wc * 32 + fr, fq * 8);
    unsigned gC[2][2], gN[2][2];
#define PG8_SA(b, h) (((b) * 2 + (h)) * HTB)
#define PG8_SB(b, h) ((4 + (b) * 2 + (h)) * HTB)
#define PG8_STAGE(bufoff, gbase, voff) do { _Pragma("unroll") for (int _i = 0; _i < 2; ++_i) \
        __builtin_amdgcn_global_load_lds((const unsigned*)((const char*)(gbase) + (voff)[_i]), (LAS unsigned*)(lds + (bufoff) + ldsw + _i * 8192), 16, 0, 0); } while (0)
#define PG8_STAGE_A(bufoff, kp, h) do { if constexpr (GATHER) { PG8_STAGE(bufoff, kp, gC[h]); } else { PG8_STAGE(bufoff, (kp) + (h) * hstep, voffA); } } while (0)
#define PG8_LD16(p) (*(const LAS bf16x8*)(p))
#define PG8_CAT(lo, hi) __builtin_bit_cast(v8i32, __builtin_shufflevector(lo, hi, 0, 1, 2, 3, 4, 5, 6, 7, 8, 9, 10, 11, 12, 13, 14, 15))
#define PG8_LDA(dst, b, h) do { _Pragma("unroll") for (int m = 0; m < 4; ++m) { if constexpr (F8) { dst##8[m] = PG8_CAT(PG8_LD16(lds + PG8_SA(b, h) + aoff + m * 2048), PG8_LD16(lds + PG8_SA(b, h) + aoff + m * 2048 + 1024)); } \
        else { _Pragma("unroll") for (int k = 0; k < 2; ++k) dst[m][k] = PG8_LD16(lds + PG8_SA(b, h) + aoff + m * 2048 + k * 1024); } } } while (0)
#define PG8_LDB(dst, b, h) do { _Pragma("unroll") for (int n = 0; n < 2; ++n) { if constexpr (F8) { dst##8[n] = PG8_CAT(PG8_LD16(lds + PG8_SB(b, h) + boff + n * 2048), PG8_LD16(lds + PG8_SB(b, h) + boff + n * 2048 + 1024)); } \
        else { _Pragma("unroll") for (int k = 0; k < 2; ++k) dst[n][k] = PG8_LD16(lds + PG8_SB(b, h) + boff + n * 2048 + k * 1024); } } } while (0)
#define PG8_MMA(ai, bj, At, Bt) do { __builtin_amdgcn_s_setprio(1); _Pragma("unroll") for (int m = 0; m < 4; ++m) _Pragma("unroll") for (int n = 0; n < 2; ++n) { \
        if constexpr (F8) { acc[ai][bj][m][n] = __builtin_amdgcn_mfma_scale_f32_16x16x128_f8f6f4(Bt##8[n], At##8[m], acc[ai][bj][m][n], 0, 0, 0, 0x7f7f7f7f, 0, 0x7f7f7f7f); } \
        else { _Pragma("unroll") for (int k = 0; k < 2; ++k) acc[ai][bj][m][n] = __builtin_amdgcn_mfma_f32_16x16x32_bf16(Bt[n][k], At[m][k], acc[ai][bj][m][n], 0, 0, 0); } } \
        __builtin_amdgcn_s_setprio(0); } while (0)
#define PG8_WAIT_V(n) asm volatile("s_waitcnt vmcnt(" #n ")" ::: "memory")
#define PG8_WAIT_L(n) asm volatile("s_waitcnt lgkmcnt(" #n ")" ::: "memory")
#define PG8_BAR __builtin_amdgcn_s_barrier()
#define PG8_SCHED __builtin_amdgcn_sched_barrier(0)
#define PG8_GOFF(dst, u) do { _Pragma("unroll") for (int _h = 0; _h < 2; ++_h) _Pragma("unroll") for (int _i = 0; _i < 2; ++_i) \
        dst[_h][_i] = (unsigned)(S.a_row(u, _h * HALF + RA[_i]) * RP + CA[_i] * 2); } while (0)
    Unit cur, nxt, nn; int ui = 0;
    if (!S.next(0, cur)) return;
    bool has_next = S.next(1, nxt);
    if constexpr (GATHER) { PG8_GOFF(gC, cur); if (has_next) { PG8_GOFF(gN, nxt); } else { PG8_GOFF(gN, cur); } }
    f32x4 acc[2][2][4][2];
#pragma unroll
    for (int a = 0; a < 2; ++a)
#pragma unroll
        for (int b = 0; b < 2; ++b)
#pragma unroll
            for (int m = 0; m < 4; ++m)
#pragma unroll
                for (int n = 0; n < 2; ++n) acc[a][b][m][n] = (f32x4){0.f, 0.f, 0.f, 0.f};
    bf16x8 At[4][2], B0[2][2], B1[2][2]; v8i32 At8[4], B08[2], B18[2];
    const char* cA = S.a_ptr(cur); const char* cB = S.b_ptr(cur);
    PG8_STAGE(PG8_SB(0, 0), cB, voffB); PG8_STAGE(PG8_SB(0, 1), cB + hstep, voffB); PG8_STAGE_A(PG8_SA(0, 0), cA, 0); PG8_STAGE_A(PG8_SA(0, 1), cA, 1);
    if (wr == 1) PG8_BAR;
    PG8_WAIT_V(2); PG8_BAR;
    PG8_STAGE(PG8_SB(1, 0), cB + kstep, voffB); PG8_STAGE_A(PG8_SA(1, 0), cA + kstep, 0); PG8_STAGE(PG8_SB(1, 1), cB + hstep + kstep, voffB);
    PG8_WAIT_V(6); PG8_BAR;
    for (;;) {
        const char* nA = has_next ? S.a_ptr(nxt) : cA; const char* nB = has_next ? S.b_ptr(nxt) : cB;
        S.meta(cur, lds + (LDS_META - 0) + (ui & 1) * 4096, wid, lane);
#define PG8_TRIP(WARM, t) do { \
            const bool last = ((t) == nt - 2); \
            const char* a1 = cA + (size_t)((t) + 1) * kstep; \
            const char* a2 = last ? nA : cA + (size_t)((t) + 2) * kstep; const char* b2 = last ? nB : cB + (size_t)((t) + 2) * kstep; \
            const char* a3 = a2 + kstep; const char* b3 = b2 + kstep; \
              \
            PG8_LDB(B0, 0, 0); PG8_LDB(B1, 0, 1); PG8_SCHED; PG8_LDA(At, 0, 0); if constexpr (!(WARM)) { PG8_STAGE_A(PG8_SA(1, 1), a1, 1); } \
            if constexpr (GATHER) { if (last) { _Pragma("unroll") for (int h = 0; h < 2; ++h) _Pragma("unroll") for (int i = 0; i < 2; ++i) gC[h][i] = gN[h][i]; } } \
            if constexpr (!(WARM)) { PG8_WAIT_V(8); } PG8_WAIT_L(0); PG8_BAR; PG8_MMA(0, 0, At, B0); PG8_MMA(0, 1, At, B1); PG8_BAR; PG8_SCHED; \
              \
            PG8_LDA(At, 0, 1); PG8_STAGE(PG8_SB(0, 0), b2, voffB); PG8_STAGE(PG8_SB(0, 1), b2 + hstep, voffB); PG8_STAGE_A(PG8_SA(0, 0), a2, 0); \
            if constexpr (!(WARM)) { PG8_WAIT_V(8); } PG8_WAIT_L(0); PG8_BAR; PG8_MMA(1, 0, At, B0); PG8_MMA(1, 1, At, B1); PG8_BAR; PG8_SCHED; \
              \
            PG8_LDB(B0, 1, 0); PG8_LDB(B1, 1, 1); PG8_SCHED; PG8_LDA(At, 1, 0); PG8_STAGE_A(PG8_SA(0, 1), a2, 1); \
            if constexpr (!(WARM)) { PG8_WAIT_V(8); } PG8_WAIT_L(0); PG8_BAR; PG8_MMA(0, 0, At, B0); PG8_MMA(0, 1, At, B1); PG8_BAR; PG8_SCHED; \
              \
            PG8_LDA(At, 1, 1); PG8_STAGE(PG8_SB(1, 0), b3, voffB); PG8_STAGE(PG8_SB(1, 1), b3 + hstep, voffB); PG8_STAGE_A(PG8_SA(1, 0), a3, 0); \
            PG8_WAIT_V(8); PG8_WAIT_L(0); PG8_BAR; PG8_MMA(1, 0, At, B0); PG8_MMA(1, 1, At, B1); PG8_BAR; PG8_SCHED; \
        } while (0)
        int t0_ = 0;
        if constexpr (WARMTRIP) { if (ui > 0) { PG8_TRIP(true, 0); t0_ = 2; } }
        for (int t = t0_; t < nt; t += 2) { PG8_TRIP(false, t); }
#undef PG8_TRIP
        if (wr == 0) PG8_BAR;
        if constexpr (WARMTRIP) { PG8_STAGE_A(PG8_SA(1, 1), nA + kstep, 1); }
        bool has_nn = false;
        if constexpr (GATHER) { if (has_next) { has_nn = S.next(ui + 2, nn); if (has_nn) { PG8_GOFF(gN, nn); } } }
        else { if (has_next) has_nn = S.next(ui + 2, nn); }
        { int fr_ = fr, fq_ = fq; asm volatile("" : "+v"(fr_), "+v"(fq_));
          const LAS unsigned char* mt = lds + LDS_META + (ui & 1) * 4096;
          if constexpr (WARMTRIP) {
              E.pre(acc, cur, wr, wc, fr_, fq_, mt);
              if constexpr (GATHER) asm volatile("" : "+v"(gN[0][0]), "+v"(gN[0][1]), "+v"(gN[1][0]), "+v"(gN[1][1]));
              PG8_WAIT_V(0);
              E.post(acc, cur, wr, wc, fr_, fq_, mt);
          } else { E.run(acc, cur, wr, wc, fr_, fq_, mt); } }
        if (!has_next) break;
#pragma unroll
        for (int a = 0; a < 2; ++a)
#pragma unroll
            for (int b = 0; b < 2; ++b)
#pragma unroll
                for (int m = 0; m < 4; ++m)
#pragma unroll
                    for (int n = 0; n < 2; ++n) acc[a][b][m][n] = (f32x4){0.f, 0.f, 0.f, 0.f};
        cur = nxt; cA = nA; cB = nB; ++ui; nxt = nn; has_next = has_nn;
        if (wr == 1) PG8_BAR;
    }
    PG8_WAIT_V(0);
    PG8_BAR;
#undef PG8_SA
#undef PG8_SB
#undef PG8_STAGE
#undef PG8_STAGE_A
#undef PG8_LDA
#undef PG8_LDB
#undef PG8_MMA
#undef PG8_LD16
#undef PG8_CAT
#undef PG8_WAIT_V
#undef PG8_WAIT_L
#undef PG8_BAR
#undef PG8_SCHED
#undef PG8_GOFF
}
}

using pg8::Unit; using pg8::cvt_pk_bf16;
constexpr int BM = 256, HALF = 128;

typedef f32x4 (&AccRef)[2][2][4][2];
__device__ __forceinline__ void pack8_bf16(f32x4& lo, const f32x4& hi) {
    const unsigned w0 = cvt_pk_bf16(lo[0], lo[1]), w1 = cvt_pk_bf16(lo[2], lo[3]), w2 = cvt_pk_bf16(hi[0], hi[1]), w3 = cvt_pk_bf16(hi[2], hi[3]);
    lo[0] = __builtin_bit_cast(float, w0); lo[1] = __builtin_bit_cast(float, w1); lo[2] = __builtin_bit_cast(float, w2); lo[3] = __builtin_bit_cast(float, w3);
}
#define AS_U4(v) __builtin_bit_cast(u32x4, v)

struct EpiInProj {
    static constexpr bool PERM = true;
    const float* rs1; const f32x2* rope; const float* glu_b;
    bf16_t *q, *k, *v, *qi, *ki, *hglu; float* wi;
    __device__ __forceinline__ void pre(AccRef acc, const Unit& u, int wr, int wc, int fr, int fq, const LAS unsigned char* mt) const {
        const int row0 = u.pm * BM + wr * 64 + fr;
        if (u.pn >= 4) {
            const int ch = 128 * (u.pn - 4) + 32 * wc + 8 * fq;
            f32x4 ba[2], bg[2];
#pragma unroll
            for (int n = 0; n < 2; ++n) { ba[n] = *(const f32x4*)(glu_b + ch + 4 * n); bg[n] = *(const f32x4*)(glu_b + 512 + ch + 4 * n); }
#pragma unroll
            for (int ai = 0; ai < 2; ++ai)
#pragma unroll
                for (int m = 0; m < 4; ++m) { const float rs = rs1[row0 + ai * HALF + m * 16];
#pragma unroll
                    for (int n = 0; n < 2; ++n)
#pragma unroll
                        for (int e = 0; e < 4; ++e) { const float a = acc[ai][0][m][n][e] * rs + ba[n][e], g = acc[ai][1][m][n][e] * rs + bg[n][e]; acc[ai][0][m][n][e] = a * sigmoidf_(g); }
                    pack8_bf16(acc[ai][0][m][0], acc[ai][0][m][1]); }
            return;
        }
        const bool do_rope = !(u.pn == 3 && wc >= 2), is_wi = (u.pn == 3 && wc == 3);
        const int d0 = 8 * fq;
#pragma unroll
        for (int ai = 0; ai < 2; ++ai)
#pragma unroll
            for (int m = 0; m < 4; ++m) { const int row = row0 + ai * HALF + m * 16; const float rs = rs1[row];
                if (do_rope) {
                    const f32x2* rp = rope + (size_t)(row & (SEQ - 1)) * 32 + d0;
#pragma unroll
                    for (int n = 0; n < 2; ++n)
#pragma unroll
                        for (int e = 0; e < 4; ++e) { const f32x2 cs = rp[4 * n + e]; const float x1 = acc[ai][0][m][n][e] * rs, x2 = acc[ai][1][m][n][e] * rs;
                            acc[ai][0][m][n][e] = x1 * cs.x - x2 * cs.y; acc[ai][1][m][n][e] = x2 * cs.x + x1 * cs.y; }
                } else {
#pragma unroll
                    for (int n = 0; n < 2; ++n) { acc[ai][0][m][n] = acc[ai][0][m][n] * rs; acc[ai][1][m][n] = acc[ai][1][m][n] * rs; }
                }
                if (!is_wi) { pack8_bf16(acc[ai][0][m][0], acc[ai][0][m][1]); pack8_bf16(acc[ai][1][m][0], acc[ai][1][m][1]); }
                if (m & 1) __builtin_amdgcn_sched_barrier(0); }
    }
    __device__ __forceinline__ void post(AccRef acc, const Unit& u, int wr, int wc, int fr, int fq, const LAS unsigned char* mt) const {
        const int row0 = u.pm * BM + wr * 64 + fr;
        if (u.pn >= 4) {
            const int ch = 128 * (u.pn - 4) + 32 * wc + 8 * fq;
#pragma unroll
            for (int ai = 0; ai < 2; ++ai)
#pragma unroll
                for (int m = 0; m < 4; ++m) *(u32x4*)(hglu + (size_t)(row0 + ai * HALF + m * 16) * 512 + ch) = AS_U4(acc[ai][0][m][0]);
            return;
        }
        bf16_t* dst; int ld, col; bool is_wi = false;
        if (u.pn < 2) { dst = q; ld = 512; col = (4 * u.pn + wc) * 64; }
        else if (u.pn == 2) { dst = qi; ld = 256; col = wc * 64; }
        else { ld = 64; col = 0; if (wc == 0) dst = k; else if (wc == 1) dst = ki; else if (wc == 2) dst = v; else { dst = v; is_wi = true; } }
        if (is_wi) {
            if (fq == 0) {
#pragma unroll
                for (int ai = 0; ai < 2; ++ai)
#pragma unroll
                    for (int m = 0; m < 4; ++m) *(f32x4*)(wi + (size_t)(row0 + ai * HALF + m * 16) * 4) = acc[ai][0][m][0];
            }
            return;
        }
#pragma unroll
        for (int ai = 0; ai < 2; ++ai)
#pragma unroll
            for (int m = 0; m < 4; ++m) { bf16_t* rp2 = dst + (size_t)(row0 + ai * HALF + m * 16) * ld + col + 8 * fq;
                *(u32x4*)(rp2) = AS_U4(acc[ai][0][m][0]); *(u32x4*)(rp2 + 32) = AS_U4(acc[ai][1][m][0]); }
    }
    __device__ __forceinline__ void run(const f32x4 (&acc)[2][2][4][2], const Unit& u, int wr, int wc, int fr, int fq, const LAS unsigned char* mt) const {
        const int row0 = u.pm * BM + wr * 64 + fr;
        if (u.pn >= 4) {
            const int ch = 128 * (u.pn - 4) + 32 * wc + 8 * fq;
            f32x4 ba[2], bg[2];
#pragma unroll
            for (int n = 0; n < 2; ++n) { ba[n] = *(const f32x4*)(glu_b + ch + 4 * n); bg[n] = *(const f32x4*)(glu_b + 512 + ch + 4 * n); }
#pragma unroll
            for (int ai = 0; ai < 2; ++ai)
#pragma unroll
                for (int m = 0; m < 4; ++m) { const int row = row0 + ai * HALF + m * 16; const float rs = rs1[row];
                    float o[8];
#pragma unroll
                    for (int n = 0; n < 2; ++n)
#pragma unroll
                        for (int e = 0; e < 4; ++e) { const float a = acc[ai][0][m][n][e] * rs + ba[n][e], g = acc[ai][1][m][n][e] * rs + bg[n][e]; o[4 * n + e] = a * sigmoidf_(g); }
                    u32x4 w; w.x = cvt_pk_bf16(o[0], o[1]); w.y = cvt_pk_bf16(o[2], o[3]); w.z = cvt_pk_bf16(o[4], o[5]); w.w = cvt_pk_bf16(o[6], o[7]);
                    *(u32x4*)(hglu + (size_t)row * 512 + ch) = w; }
            return;
        }
        bf16_t* dst; int ld, col; bool do_rope = true, is_wi = false;
        if (u.pn < 2) { dst = q; ld = 512; col = (4 * u.pn + wc) * 64; }
        else if (u.pn == 2) { dst = qi; ld = 256; col = wc * 64; }
        else { ld = 64; col = 0; if (wc == 0) dst = k; else if (wc == 1) dst = ki; else if (wc == 2) { dst = v; do_rope = false; } else { dst = v; is_wi = true; do_rope = false; } }
        if (is_wi) {
            if (fq == 0) {
#pragma unroll
                for (int ai = 0; ai < 2; ++ai)
#pragma unroll
                    for (int m = 0; m < 4; ++m) { const int row = row0 + ai * HALF + m * 16; const float rs = rs1[row];
                        *(f32x4*)(wi + (size_t)row * 4) = acc[ai][0][m][0] * rs; }
            }
            return;
        }
        const int d0 = 8 * fq;
#pragma unroll
        for (int ai = 0; ai < 2; ++ai)
#pragma unroll
            for (int m = 0; m < 4; ++m) { const int row = row0 + ai * HALF + m * 16; const float rs = rs1[row];
                float o1[8], o2[8];
                if (do_rope) {
                    const f32x4* rp = (const f32x4*)(rope + (size_t)(row & (SEQ - 1)) * 32 + d0);
#pragma unroll
                    for (int n = 0; n < 2; ++n)
#pragma unroll
                        for (int e2 = 0; e2 < 2; ++e2) { const f32x4 cs = rp[2 * n + e2];
                            { const float x1 = acc[ai][0][m][n][2 * e2] * rs, x2 = acc[ai][1][m][n][2 * e2] * rs; o1[4 * n + 2 * e2] = x1 * cs.x - x2 * cs.y; o2[4 * n + 2 * e2] = x2 * cs.x + x1 * cs.y; }
                            { const float x1 = acc[ai][0][m][n][2 * e2 + 1] * rs, x2 = acc[ai][1][m][n][2 * e2 + 1] * rs; o1[4 * n + 2 * e2 + 1] = x1 * cs.z - x2 * cs.w; o2[4 * n + 2 * e2 + 1] = x2 * cs.z + x1 * cs.w; } }
                } else {
#pragma unroll
                    for (int n = 0; n < 2; ++n)
#pragma unroll
                        for (int e = 0; e < 4; ++e) { o1[4 * n + e] = acc[ai][0][m][n][e] * rs; o2[4 * n + e] = acc[ai][1][m][n][e] * rs; }
                }
                u32x4 w1, w2; w1.x = cvt_pk_bf16(o1[0], o1[1]); w1.y = cvt_pk_bf16(o1[2], o1[3]); w1.z = cvt_pk_bf16(o1[4], o1[5]); w1.w = cvt_pk_bf16(o1[6], o1[7]);
                w2.x = cvt_pk_bf16(o2[0], o2[1]); w2.y = cvt_pk_bf16(o2[2], o2[3]); w2.z = cvt_pk_bf16(o2[4], o2[5]); w2.w = cvt_pk_bf16(o2[6], o2[7]);
                if (u.pn == 3 && wc == 1) {
                    bf16_t* tp = ki + ((size_t)(row >> 5) * 256 + (row & 31) + 32 * (fq & 1)) * 8;
                    *(u32x4*)(tp + (size_t)(fq >> 1) * 512) = w1; *(u32x4*)(tp + (size_t)(2 + (fq >> 1)) * 512) = w2;
                } else {
                    bf16_t* rp2 = dst + (size_t)row * ld + col + d0;
                    *(u32x4*)(rp2) = w1; *(u32x4*)(rp2 + 32) = w2; } }
    }
};

struct EpiBf16Plain {
    static constexpr bool PERM = true;
    bf16_t* O; int ldc; float scale;
    __device__ __forceinline__ void pre(AccRef acc, const Unit&, int, int, int, int, const LAS unsigned char*) const {
#pragma unroll
        for (int ai = 0; ai < 2; ++ai)
#pragma unroll
            for (int bj = 0; bj < 2; ++bj)
#pragma unroll
                for (int m = 0; m < 4; ++m) { acc[ai][bj][m][0] = acc[ai][bj][m][0] * scale; acc[ai][bj][m][1] = acc[ai][bj][m][1] * scale; pack8_bf16(acc[ai][bj][m][0], acc[ai][bj][m][1]); }
    }
    __device__ __forceinline__ void post(AccRef acc, const Unit& u, int wr, int wc, int fr, int fq, const LAS unsigned char* mt) const {
        const int row0 = u.pm * BM + wr * 64 + fr, col0 = u.pn * BM + wc * 32 + 8 * fq;
#pragma unroll
        for (int ai = 0; ai < 2; ++ai)
#pragma unroll
            for (int m = 0; m < 4; ++m) { bf16_t* rowp = O + (size_t)(row0 + ai * HALF + m * 16) * ldc + col0;
#pragma unroll
                for (int bj = 0; bj < 2; ++bj) *(u32x4*)(rowp + bj * HALF) = AS_U4(acc[ai][bj][m][0]); }
    }
    __device__ __forceinline__ void run(const f32x4 (&acc)[2][2][4][2], const Unit& u, int wr, int wc, int fr, int fq, const LAS unsigned char* mt) const {
        const int row0 = u.pm * BM + wr * 64 + fr, col0 = u.pn * BM + wc * 32 + 8 * fq;
#pragma unroll
        for (int ai = 0; ai < 2; ++ai)
#pragma unroll
            for (int m = 0; m < 4; ++m) { bf16_t* rowp = O + (size_t)(row0 + ai * HALF + m * 16) * ldc + col0;
#pragma unroll
                for (int bj = 0; bj < 2; ++bj) { const f32x4 v0 = acc[ai][bj][m][0] * scale, v1 = acc[ai][bj][m][1] * scale;
                    u32x4 w; w.x = cvt_pk_bf16(v0[0], v0[1]); w.y = cvt_pk_bf16(v0[2], v0[3]); w.z = cvt_pk_bf16(v1[0], v1[1]); w.w = cvt_pk_bf16(v1[2], v1[3]);
                    *(u32x4*)(rowp + bj * HALF) = w; } }
    }
};

struct EpiOutProj {
    static constexpr bool PERM = false;
    const float* x; float* h1; unsigned char* h1f8;
    __device__ __forceinline__ void pre(AccRef acc, const Unit& u, int wr, int wc, int fr, int fq, const LAS unsigned char* mt) const {
        const int row0 = u.pm * BM + wr * 64 + fr, col0 = u.pn * BM + wc * 32 + 4 * fq;
#pragma unroll
        for (int ai = 0; ai < 2; ++ai)
#pragma unroll
            for (int m = 0; m < 4; ++m) { const size_t off = (size_t)(row0 + ai * HALF + m * 16) * DM + col0;
#pragma unroll
                for (int bj = 0; bj < 2; ++bj)
#pragma unroll
                    for (int n = 0; n < 2; ++n) acc[ai][bj][m][n] += *(const f32x4*)(x + off + bj * HALF + n * 16);
                if (m & 1) __builtin_amdgcn_sched_barrier(0); }
    }
    __device__ __forceinline__ void post(AccRef acc, const Unit& u, int wr, int wc, int fr, int fq, const LAS unsigned char* mt) const {
        const int row0 = u.pm * BM + wr * 64 + fr, col0 = u.pn * BM + wc * 32 + 4 * fq;
#pragma unroll
        for (int ai = 0; ai < 2; ++ai)
#pragma unroll
            for (int m = 0; m < 4; ++m) { const size_t off = (size_t)(row0 + ai * HALF + m * 16) * DM + col0;
#pragma unroll
                for (int bj = 0; bj < 2; ++bj)
#pragma unroll
                    for (int n = 0; n < 2; ++n) { const size_t o = off + bj * HALF + n * 16; const f32x4 r = acc[ai][bj][m][n];
                        *(f32x4*)(h1 + o) = r; *(unsigned*)(h1f8 + o) = pk4_fp8(r[0], r[1], r[2], r[3]); } }
    }
    __device__ __forceinline__ void run(AccRef acc, const Unit& u, int wr, int wc, int fr, int fq, const LAS unsigned char* mt) const { pre(acc, u, wr, wc, fr, fq, mt); post(acc, u, wr, wc, fr, fq, mt); }
};

struct EpiUp {
    static constexpr bool PERM = true;
    unsigned char* act;
    __device__ __forceinline__ void pre(AccRef acc, const Unit& u, int wr, int wc, int fr, int fq, const LAS unsigned char* mt) const {
        const int r0 = wr * 64 + fr, cl = 32 * wc + 8 * fq;
        const LAS float* rowA = (const LAS float*)mt; const LAS float* bias = (const LAS float*)(mt + 2048);
        f32x4 bg[2], bl[2];
#pragma unroll
        for (int n = 0; n < 2; ++n) { bg[n] = *(const LAS f32x4*)(bias + cl + 4 * n); bl[n] = *(const LAS f32x4*)(bias + 128 + cl + 4 * n); }
#pragma unroll
        for (int ai = 0; ai < 2; ++ai)
#pragma unroll
            for (int m = 0; m < 4; ++m) { const int r = r0 + ai * HALF + m * 16;
                const float rs = (r < u.rows) ? rowA[r] * 0.03125f : 0.f;
#pragma unroll
                for (int n = 0; n < 2; ++n)
#pragma unroll
                    for (int e = 0; e < 4; ++e) { float g = acc[ai][0][m][n][e] * rs + bg[n][e], l = acc[ai][1][m][n][e] * rs + bl[n][e];
                        g = fminf(g, 7.0f); l = fminf(fmaxf(l, -7.0f), 7.0f); acc[ai][0][m][n][e] = g * sigmoidf_(1.702f * g) * (l + 1.0f); } }
    }
    __device__ __forceinline__ void post(AccRef acc, const Unit& u, int wr, int wc, int fr, int fq, const LAS unsigned char* mt) const {
        const int r0 = wr * 64 + fr, ch = 128 * u.pn + 32 * wc + 8 * fq;
#pragma unroll
        for (int ai = 0; ai < 2; ++ai)
#pragma unroll
            for (int m = 0; m < 4; ++m) { const int r = r0 + ai * HALF + m * 16;
                const f32x4 v0 = acc[ai][0][m][0], v1 = acc[ai][0][m][1];
                u32x2 w; w.x = pk4_fp8(v0[0], v0[1], v0[2], v0[3]); w.y = pk4_fp8(v1[0], v1[1], v1[2], v1[3]);
                *(u32x2*)(act + (size_t)(u.pm * BM + r) * 1024 + ch) = w; }
    }
    __device__ __forceinline__ void run(const f32x4 (&acc)[2][2][4][2], const Unit& u, int wr, int wc, int fr, int fq, const LAS unsigned char* mt) const {
        const int r0 = wr * 64 + fr, cl = 32 * wc + 8 * fq, ch = 128 * u.pn + cl;
        const LAS float* rowA = (const LAS float*)mt; const LAS float* bias = (const LAS float*)(mt + 2048);
        f32x4 bg[2], bl[2];
#pragma unroll
        for (int n = 0; n < 2; ++n) { bg[n] = *(const LAS f32x4*)(bias + cl + 4 * n); bl[n] = *(const LAS f32x4*)(bias + 128 + cl + 4 * n); }
#pragma unroll
        for (int ai = 0; ai < 2; ++ai)
#pragma unroll
            for (int m = 0; m < 4; ++m) { const int r = r0 + ai * HALF + m * 16;
                const float rs = (r < u.rows) ? rowA[r] * 0.03125f : 0.f;
                float o[8];
#pragma unroll
                for (int n = 0; n < 2; ++n)
#pragma unroll
                    for (int e = 0; e < 4; ++e) { float g = acc[ai][0][m][n][e] * rs + bg[n][e], l = acc[ai][1][m][n][e] * rs + bl[n][e];
                        g = fminf(g, 7.0f); l = fminf(fmaxf(l, -7.0f), 7.0f); o[4 * n + e] = g * sigmoidf_(1.702f * g) * (l + 1.0f); }
                u32x2 w; w.x = pk4_fp8(o[0], o[1], o[2], o[3]); w.y = pk4_fp8(o[4], o[5], o[6], o[7]);
                *(u32x2*)(act + (size_t)(u.pm * BM + r) * 1024 + ch) = w; }
    }
};

struct EpiDown {
    static constexpr bool PERM = true;
    bf16_t* y;
    __device__ __forceinline__ void pre(AccRef acc, const Unit& u, int wr, int wc, int fr, int fq, const LAS unsigned char* mt) const {
        const int r0 = wr * 64 + fr, cl = wc * 32 + 8 * fq;
        const LAS float* gateT = (const LAS float*)(mt + 1024); const LAS float* bias = (const LAS float*)(mt + 2048);
        float gt[2][4];
#pragma unroll
        for (int ai = 0; ai < 2; ++ai)
#pragma unroll
            for (int m = 0; m < 4; ++m) gt[ai][m] = gateT[r0 + ai * HALF + m * 16];
#pragma unroll
        for (int bj = 0; bj < 2; ++bj) { const f32x4 bv0 = *(const LAS f32x4*)(bias + cl + bj * HALF), bv1 = *(const LAS f32x4*)(bias + cl + bj * HALF + 4);
#pragma unroll
            for (int ai = 0; ai < 2; ++ai)
#pragma unroll
                for (int m = 0; m < 4; ++m) { acc[ai][bj][m][0] = (acc[ai][bj][m][0] * 0.03125f + bv0) * gt[ai][m]; acc[ai][bj][m][1] = (acc[ai][bj][m][1] * 0.03125f + bv1) * gt[ai][m];
                    pack8_bf16(acc[ai][bj][m][0], acc[ai][bj][m][1]); } }
    }
    __device__ __forceinline__ void post(AccRef acc, const Unit& u, int wr, int wc, int fr, int fq, const LAS unsigned char* mt) const {
        const int r0 = wr * 64 + fr, col0 = u.pn * BM + wc * 32 + 8 * fq;
        const LAS int* slotT = (const LAS int*)mt;
#pragma unroll
        for (int ai = 0; ai < 2; ++ai)
#pragma unroll
            for (int m = 0; m < 4; ++m) { const int r = r0 + ai * HALF + m * 16;
                if (r < u.rows) { bf16_t* rowp = y + (size_t)slotT[r] * 1024 + col0;
#pragma unroll
                    for (int bj = 0; bj < 2; ++bj) *(u32x4*)(rowp + bj * HALF) = AS_U4(acc[ai][bj][m][0]); } }
    }
    __device__ __forceinline__ void run(AccRef acc, const Unit& u, int wr, int wc, int fr, int fq, const LAS unsigned char* mt) const { pre(acc, u, wr, wc, fr, fq, mt); post(acc, u, wr, wc, fr, fq, mt); }
};

template <bool F8>
__device__ __forceinline__ void p0_transpose_item(const float* W, int ldw, void* WTv, int Kdim, const float* gain, LAS float* scr, int kb, int n0, int src0, int nvalid, int lane) {
    bf16_t* WT = (bf16_t*)WTv;
    const int k0 = 64 * kb;
    f32x4 ld4[8];
#pragma unroll
    for (int i = 0; i < 8; ++i) { const int kk = 8 * i + (lane >> 3), j = (lane & 7) * 4;
        ld4[i] = (f32x4){0.f, 0.f, 0.f, 0.f}; if (j < nvalid) ld4[i] = *(const f32x4*)(W + (size_t)(k0 + kk) * ldw + src0 + j); }
#pragma unroll
    for (int i = 0; i < 8; ++i) { const int kk = 8 * i + (lane >> 3), j = (lane & 7) * 4; const float gk = (gain ? gain[k0 + kk] : 1.0f) * (F8 ? 32.0f : 1.0f);
        LAS float* d = scr + kk * 33 + j; d[0] = ld4[i].x * gk; d[1] = ld4[i].y * gk; d[2] = ld4[i].z * gk; d[3] = ld4[i].w * gk; }
    LDS_WAIT(); asm volatile("" ::: "memory");
    const int c = lane & 7;
#pragma unroll
    for (int j = 0; j < 4; ++j) { const int n = (lane >> 3) + 8 * j; const LAS float* s = scr + (8 * c) * 33 + n;
        if constexpr (F8) { u32x2 o; o.x = pk4_fp8(s[0 * 33], s[1 * 33], s[2 * 33], s[3 * 33]); o.y = pk4_fp8(s[4 * 33], s[5 * 33], s[6 * 33], s[7 * 33]);
            *(u32x2*)((unsigned char*)WTv + (size_t)(n0 + n) * Kdim + k0 + 8 * c) = o; }
        else { u32x4 o; o.x = pk2(s[0 * 33], s[1 * 33]); o.y = pk2(s[2 * 33], s[3 * 33]); o.z = pk2(s[4 * 33], s[5 * 33]); o.w = pk2(s[6 * 33], s[7 * 33]);
            *(u32x4*)(WT + (size_t)(n0 + n) * Kdim + k0 + 8 * c) = o; } }
    LDS_WAIT(); asm volatile("" ::: "memory");
}
__device__ __forceinline__ void win_colmap(int nb, int& src0, int& nvalid) {
    const int pn = nb >> 3, j = (nb & 7) * 32, bj = j >> 7, slot = (j & 127) >> 5;
    nvalid = 32;
    if (pn < 2) src0 = (4 * pn + slot) * 64 + 32 * bj;
    else if (pn == 2) src0 = 640 + slot * 64 + 32 * bj;
    else if (pn == 3) { if (slot == 0) src0 = 512 + 32 * bj; else if (slot == 1) src0 = 896 + 32 * bj; else if (slot == 2) src0 = 576 + 32 * bj; else { src0 = 960; nvalid = bj == 0 ? 4 : 0; } }
    else src0 = 964 + 512 * bj + 128 * (pn - 4) + 32 * slot;
}
__device__ __forceinline__ void p0_prologue(const Params& P, LAS unsigned char* lds, int vcu, int G, int wave, int lane) {
    unsigned char* ws = P.ws;
    LAS float* scr = (LAS float*)(lds + wave * 16384);
    const int gw = vcu * NWAVES + wave, NGW = G * NWAVES;
    constexpr int I_IN = 16 * 64, I_OUT = 16 * 32, I_G = 16 * 32, I_P = 4 * 32;
    constexpr int NITEMS = I_IN + I_OUT + I_G + I_P;
    for (int it = gw; it < NITEMS; it += NGW) {
        int r = it;
        if (r < I_IN) { const int kb = r / 64, nb = r % 64; int s0, nv; win_colmap(nb, s0, nv); p0_transpose_item<false>(P.w_in, INW, (bf16_t*)(ws + WS_WIN), 1024, P.g_mix, scr, kb, nb * 32, s0, nv, lane); continue; } r -= I_IN;
        if (r < I_OUT) { const int kb = r / 32, nb = r % 32; p0_transpose_item<false>(P.w_out, 1024, (bf16_t*)(ws + WS_WOUT), 1024, nullptr, scr, kb, nb * 32, nb * 32, 32, lane); continue; } r -= I_OUT;
        if (r < I_G) { const int kb = r / 32, nb = r % 32; p0_transpose_item<true>(P.w_ple_gate, 1024, (unsigned char*)(ws + WS_WG), 1024, P.g_ple, scr, kb, nb * 32, nb * 32, 32, lane); continue; } r -= I_G;
        { const int kb = r / 32, nb = r % 32; p0_transpose_item<false>(P.w_ple_proj, 1024, (bf16_t*)(ws + WS_WP), 256, nullptr, scr, kb, nb * 32, nb * 32, 32, lane); }
    }
    float* rs1 = (float*)(ws + WS_RS1); bf16_t* xb = (bf16_t*)(ws + WS_XB);
    for (int m = gw; m < NTOK; m += NGW) {
        const f32x4* xr = (const f32x4*)(P.x + (size_t)m * DM) + lane; f32x4 v[4]; float s = 0.f;
#pragma unroll
        for (int j = 0; j < 4; ++j) { v[j] = xr[64 * j]; s += (v[j].x * v[j].x + v[j].y * v[j].y) + (v[j].z * v[j].z + v[j].w * v[j].w); }
        s = wave_sum(s);
        u32x2* o8 = (u32x2*)(xb + (size_t)m * DM) + lane;
#pragma unroll
        for (int j = 0; j < 4; ++j) { u32x2 w; w.x = pk2(v[j].x, v[j].y); w.y = pk2(v[j].z, v[j].w); o8[64 * j] = w; }
        if (lane == 0) rs1[m] = 1.0f / sqrtf(s * (1.0f / DM) + EPS);
    }
    bf16_t* pb = (bf16_t*)(ws + WS_PB);
    for (int m = gw; m < NTOK; m += NGW) { const f32x4 v = *((const f32x4*)(P.p + (size_t)m * 256) + lane); u32x2 w; w.x = pk2(v.x, v.y); w.y = pk2(v.z, v.w); *((u32x2*)(pb + (size_t)m * 256) + lane) = w; }
    f32x2* rope = (f32x2*)(ws + WS_ROPE);
    for (int idx = gw * 64 + lane; idx < SEQ * 32; idx += NGW * 64) { const int t = idx >> 5, i = idx & 31;
        const float inv = exp2f(-(float)i * (13.287712379549449f / 32.0f));
        const float ang = (float)t * inv;
        const double rev = (double)ang * 0.15915494309189535; const float fr = (float)(rev - __builtin_floor(rev));
        rope[idx] = (f32x2){__builtin_amdgcn_cosf(fr), __builtin_amdgcn_sinf(fr)}; }
    float* wrg = (float*)(ws + WS_WRG);
    for (int idx = gw * 64 + lane; idx < 1024 * 32; idx += NGW * 64) wrg[idx] = P.w_router[idx] * P.g_ffn[idx >> 5];
}

__device__ __forceinline__ unsigned fkey(float f) { unsigned u = __builtin_bit_cast(unsigned, f); if (u == 0x80000000u) u = 0u; return u ^ ((unsigned)((int)u >> 31) | 0x80000000u); }
__device__ __forceinline__ int mbcnt64(unsigned long long m) { return __builtin_amdgcn_mbcnt_hi((unsigned)(m >> 32), __builtin_amdgcn_mbcnt_lo((unsigned)m, 0u)); }

template <int NR>
__device__ __forceinline__ unsigned bisect_thr(const unsigned (&v)[NR], unsigned prefix, int startbit) {
    bool exact = false;
#pragma unroll 1
    for (int bit = startbit; bit >= 0; --bit) {
        const unsigned cand = prefix | (1u << bit); int cnt = 0;
#pragma unroll
        for (int r = 0; r < NR; ++r) { cnt += __builtin_popcountll(__ballot(v[r] >= cand)); if ((r & 7) == 7) __builtin_amdgcn_sched_barrier(0); }
        if (cnt >= NSEL) prefix = cand;
        if (cnt == NSEL) { exact = true; break; }
    }
    return exact ? prefix - 1u : prefix;
}
template <int NR, bool EXPL>
__device__ __forceinline__ void compact_sel(const unsigned (&v)[NR], const unsigned (&ci)[NR], unsigned T, LAS unsigned* list, int lane) {
    int cgt = 0;
#pragma unroll
    for (int r = 0; r < NR; ++r) { cgt += __builtin_popcountll(__ballot(v[r] > T)); if ((r & 7) == 7) __builtin_amdgcn_sched_barrier(0); }
    const int need = NSEL - cgt; int base = 0, ties = 0;
#pragma unroll
    for (int r = 0; r < NR; ++r) { const bool gt = v[r] > T, eq = v[r] == T; const unsigned long long em = __ballot(eq);
        const bool sel = gt || (eq && (ties + mbcnt64(em)) < need); const unsigned long long sm = __ballot(sel);
        list[sel ? base + mbcnt64(sm) : NSEL + lane] = EXPL ? ci[r] : (unsigned)(r * 64 + lane);
        base += __builtin_popcountll(sm); ties += __builtin_popcountll(em);
        if ((r & 3) == 3) __builtin_amdgcn_sched_barrier(0); }
}
constexpr int SEL_CAP = 1024;
template <int NR>
__device__ __forceinline__ void select_topk(LAS float* row, LAS unsigned* H, LAS unsigned* list, int lane, bool zero_h) {
    unsigned v[NR];
#pragma unroll
    for (int r = 0; r < NR; ++r) v[r] = fkey(row[r * 64 + lane]);
    LAS u32x4* H4 = (LAS u32x4*)H;
    const u32x4 h0 = H4[2 * lane], h1 = H4[2 * lane + 1];
    if (zero_h) { H4[2 * lane] = (u32x4){0u, 0u, 0u, 0u}; H4[2 * lane + 1] = (u32x4){0u, 0u, 0u, 0u}; }
    const unsigned hw[8] = {h0.x, h0.y, h0.z, h0.w, h1.x, h1.y, h1.z, h1.w};
    unsigned c[16];
#pragma unroll
    for (int i = 0; i < 8; ++i) { c[2 * i] = hw[i] & 0xffffu; c[2 * i + 1] = hw[i] >> 16; }
    unsigned s = 0u;
#pragma unroll
    for (int i = 0; i < 16; ++i) s += c[i];
    unsigned S = s;
#pragma unroll
    for (int off = 1; off < 64; off <<= 1) { const unsigned o = __shfl_down(S, off); if (lane + off < 64) S += o; }
    const unsigned long long okm = __ballot(S >= (unsigned)NSEL);
    bool fast = okm != 0ull; unsigned floorkey = 0u; int C = 0;
    if (fast) {
        const int Ls = 63 - __builtin_clzll(okm);
        unsigned acc = S - s; int bl = -1; unsigned accb = 0u;
#pragma unroll
        for (int b = 15; b >= 0; --b) { acc += c[b]; if (bl < 0 && acc >= (unsigned)NSEL) { bl = b; accb = acc; } }
        const int bstar = __shfl(bl, Ls) + 16 * Ls; C = (int)__shfl(accb, Ls);
        floorkey = (unsigned)bstar << 22;
        fast = (bstar > 1) && (C <= SEL_CAP);
    }
    if (!fast) {
        const unsigned T = bisect_thr<NR>(v, 0u, 31);
        compact_sel<NR, false>(v, v, T, list, lane);
        return;
    }
    LAS unsigned* ckl = (LAS unsigned*)row; LAS unsigned* cil = ckl + 1152;
    { int base = 0;
#pragma unroll
      for (int r = 0; r < NR; ++r) { const bool cnd = v[r] >= floorkey; const unsigned long long m = __ballot(cnd);
          const int pos = cnd ? base + mbcnt64(m) : SEL_CAP + lane;
          ckl[pos] = v[r]; cil[pos] = (unsigned)(r * 64 + lane); base += __builtin_popcountll(m);
          if ((r & 3) == 3) __builtin_amdgcn_sched_barrier(0); } }
    if (C <= 512) {
        unsigned ck[8], ci[8];
#pragma unroll
        for (int j = 0; j < 8; ++j) { const int i = j * 64 + lane; ck[j] = i < C ? ckl[i] : 0u; ci[j] = cil[i]; }
        const unsigned T = (C == NSEL) ? floorkey - 1u : bisect_thr<8>(ck, floorkey, 21);
        compact_sel<8, true>(ck, ci, T, list, lane);
    } else {
        unsigned ck[16], ci[16];
#pragma unroll
        for (int j = 0; j < 16; ++j) { const int i = j * 64 + lane; ck[j] = i < C ? ckl[i] : 0u; ci[j] = cil[i]; }
        const unsigned T = bisect_thr<16>(ck, floorkey, 21);
        compact_sel<16, true>(ck, ci, T, list, lane);
    }
}

typedef short v4i16 __attribute__((ext_vector_type(4)));
constexpr int VROW = 144;

__device__ __forceinline__ void attn_tile(const Params& P, LAS unsigned char* lds, int b, int t0, int wave, int lane) {
    unsigned char* ws = P.ws;
    const bf16_t* QI = (const bf16_t*)(ws + WS_QI); const bf16_t* KI = (const bf16_t*)(ws + WS_KI);
    const bf16_t* Q = (const bf16_t*)(ws + WS_Q); const bf16_t* Kp = (const bf16_t*)(ws + WS_K); const bf16_t* Vp = (const bf16_t*)(ws + WS_V);
    const float* WI = (const float*)(ws + WS_WI); bf16_t* MIX = (bf16_t*)(ws + WS_MIX);
    LAS float* SC = (LAS float*)lds;
    LAS unsigned* list = (LAS unsigned*)(lds + wave * 16384 + 14336);
    LAS unsigned* HIST = (LAS unsigned*)(lds + LDS_MISC);
    const int tokbase = b * SEQ;
    const bool need_sel = t0 >= 256;
    if (need_sel) {
        const int nkt = (t0 + 8 + 31) >> 5;
        bf16x8 a[4]; f32x4 w[4];
        { const bf16_t* src = QI + (size_t)(tokbase + t0 + ((lane & 31) >> 2)) * 256 + (lane & 3) * 64 + 8 * (lane >> 5);
#pragma unroll
          for (int ks = 0; ks < 4; ++ks) a[ks] = *(const bf16x8*)(src + 16 * ks); }
#pragma unroll
        for (int g = 0; g < 4; ++g) w[g] = *(const f32x4*)(WI + (size_t)(tokbase + t0 + 2 * g + (lane >> 5)) * 4);
        for (int kt0 = wave; kt0 < nkt; kt0 += 4 * NWAVES) {
            bf16x8 bf[4][4];
#pragma unroll
            for (int u = 0; u < 4; ++u) { const int kt = kt0 + u * NWAVES;
                if (kt < nkt) { const bf16_t* ksrc = KI + ((size_t)((tokbase >> 5) + kt) * 256 + lane) * 8;
#pragma unroll
                    for (int ks = 0; ks < 4; ++ks) bf[u][ks] = *(const bf16x8*)(ksrc + 512 * ks); } }
#pragma unroll
            for (int u = 0; u < 4; ++u) { const int kt = kt0 + u * NWAVES;
                if (kt < nkt) {
                    const int key = kt * 32 + (lane & 31);
                    f32x16 acc;
#pragma unroll
                    for (int i = 0; i < 16; ++i) acc[i] = 0.f;
#pragma unroll
                    for (int ks = 0; ks < 4; ++ks) acc = __builtin_amdgcn_mfma_f32_32x32x16_bf16(a[ks], bf[u][ks], acc, 0, 0, 0);
#pragma unroll
                    for (int g = 0; g < 4; ++g) { float sc = 0.f;
#pragma unroll
                        for (int h = 0; h < 4; ++h) sc = fmaf(fmaxf(acc[4 * g + h], 0.f), w[g][h], sc);
                        const int ql = 2 * g + (lane >> 5);
                        if (key > t0 + ql) sc = -INFINITY;
                        SC[ql * 4096 + key] = sc;
                        if (key <= t0 + ql) { const unsigned ub = __builtin_bit_cast(unsigned, sc);
                            const unsigned bin = (ub >> 22) ^ (((unsigned)((int)ub >> 31) & 0x1ffu) | 0x200u);
                            __hip_atomic_fetch_add(HIST + ql * 512 + (bin >> 1), 1u << ((bin & 1u) << 4), __ATOMIC_RELAXED, __HIP_MEMORY_SCOPE_WORKGROUP); } }
                } }
        }
        { const int npad = ((t0 + 8 + 1023) >> 10) << 10;
          for (int i = nkt * 32 + (int)threadIdx.x; i < npad; i += NTHR) {
#pragma unroll
              for (int q = 0; q < 8; ++q) SC[q * 4096 + i] = -INFINITY; } }
    }
    __syncthreads();
    const int t = t0 + wave, tok = tokbase + t;
    if (need_sel) {
        LAS float* row = SC + wave * 4096; LAS unsigned* H = HIST + wave * 512; const int n = t + 1;
        if (n <= 1024) select_topk<16>(row, H, list, lane, true);
        else if (n <= 2048) select_topk<32>(row, H, list, lane, true);
        else if (n <= 3072) select_topk<48>(row, H, list, lane, true);
        else select_topk<64>(row, H, list, lane, true);
    } else {
#pragma unroll
        for (int i = 0; i < 4; ++i) list[i * 64 + lane] = (unsigned)(i * 64 + lane);
    }
    const int nvalid = need_sel ? NSEL : (t + 1);
    const int ngrp = (nvalid + 31) >> 5;
    const int hd = lane & 15, g = lane >> 4;
    bf16x8 qf0, qf1;
#pragma unroll
    for (int i = 0; i < 8; ++i) { qf0[i] = 0; qf1[i] = 0; }
    if (hd < 8) { const bf16_t* qs = Q + (size_t)tok * 512 + hd * 64 + 8 * g; qf0 = *(const bf16x8*)qs; qf1 = *(const bf16x8*)(qs + 32); }
    float m = -INFINITY, ssum = 0.f;
    f32x4 o[4];
#pragma unroll
    for (int dt = 0; dt < 4; ++dt) o[dt] = (f32x4){0.f, 0.f, 0.f, 0.f};
    LAS unsigned char* vreg = lds + wave * 16384;
    u32x4 kfA[4], kfB[4]; u32x4 vvA[4], vvB[4];
    LAS unsigned char* kbuf = vreg + 9216;
#define ATT_LOAD(KF, VV, G_) do { const int nb_ = (G_) * 32; \
        _Pragma("unroll") for (int i_ = 0; i_ < 4; ++i_) { const unsigned idx_ = list[nb_ + (lane >> 3) + 8 * i_]; const size_t ro_ = (size_t)(tokbase + idx_) * 64 + 8 * (lane & 7); \
            KF[i_] = *(const u32x4*)(Kp + ro_); VV[i_] = *(const u32x4*)(Vp + ro_); } } while (0)
#define ATT_GROUP(KF, VV, G_, VBUF) do { \
        LAS unsigned char* vbuf_ = (VBUF); \
        _Pragma("unroll") for (int i_ = 0; i_ < 4; ++i_) *(LAS u32x4*)(kbuf + ((lane >> 3) + 8 * i_) * VROW + (lane & 7) * 16) = KF[i_]; \
        const LAS unsigned char* kr_ = kbuf + hd * VROW + 16 * g; \
        const bf16x8 ka0_ = *(const LAS bf16x8*)kr_, ka1_ = *(const LAS bf16x8*)(kr_ + 64), kb0_ = *(const LAS bf16x8*)(kr_ + 16 * VROW), kb1_ = *(const LAS bf16x8*)(kr_ + 16 * VROW + 64); \
        f32x4 sa_ = {0.f, 0.f, 0.f, 0.f}, sb_ = {0.f, 0.f, 0.f, 0.f}; \
        sa_ = __builtin_amdgcn_mfma_f32_16x16x32_bf16(ka0_, qf0, sa_, 0, 0, 0); sa_ = __builtin_amdgcn_mfma_f32_16x16x32_bf16(ka1_, qf1, sa_, 0, 0, 0); \
        sb_ = __builtin_amdgcn_mfma_f32_16x16x32_bf16(kb0_, qf0, sb_, 0, 0, 0); sb_ = __builtin_amdgcn_mfma_f32_16x16x32_bf16(kb1_, qf1, sb_, 0, 0, 0); \
        _Pragma("unroll") for (int i_ = 0; i_ < 4; ++i_) *(LAS u32x4*)(vbuf_ + ((lane >> 3) + 8 * i_) * VROW + (lane & 7) * 16) = VV[i_]; \
        if ((G_) + 2 < ngrp) ATT_LOAD(KF, VV, (G_) + 2); \
        float l_[8]; float mloc_ = -INFINITY; \
        _Pragma("unroll") for (int r_ = 0; r_ < 4; ++r_) { const int sl_ = (G_) * 32 + 4 * g + r_; \
            l_[r_] = sl_ < nvalid ? sa_[r_] * 0.125f : -INFINITY; l_[4 + r_] = (sl_ + 16) < nvalid ? sb_[r_] * 0.125f : -INFINITY; \
            mloc_ = fmaxf(mloc_, fmaxf(l_[r_], l_[4 + r_])); } \
        mloc_ = fmaxf(mloc_, __shfl_xor(mloc_, 16)); mloc_ = fmaxf(mloc_, __shfl_xor(mloc_, 32)); \
        const float mnew_ = fmaxf(m, mloc_), alpha_ = __expf(m - mnew_); m = mnew_; \
        float ps_ = 0.f; \
        _Pragma("unroll") for (int r_ = 0; r_ < 8; ++r_) { l_[r_] = __expf(l_[r_] - mnew_); ps_ += l_[r_]; } \
        ssum = ssum * alpha_ + ps_; \
        bf16x8 pf_; \
        { const u32x4 pw_ = {cvt_pk_bf16(l_[0], l_[1]), cvt_pk_bf16(l_[2], l_[3]), cvt_pk_bf16(l_[4], l_[5]), cvt_pk_bf16(l_[6], l_[7])}; pf_ = __builtin_bit_cast(bf16x8, pw_); } \
        LAS unsigned char* ta_ = vbuf_ + (4 * g + (hd >> 2)) * VROW + (hd & 3) * 8; \
        _Pragma("unroll") for (int dt_ = 0; dt_ < 4; ++dt_) { \
            const v4i16 lo_ = __builtin_amdgcn_ds_read_tr16_b64_v4i16((LAS v4i16*)(ta_ + dt_ * 32)); \
            const v4i16 hi_ = __builtin_amdgcn_ds_read_tr16_b64_v4i16((LAS v4i16*)(ta_ + 16 * VROW + dt_ * 32)); \
            bf16x8 vf_; vf_[0] = lo_[0]; vf_[1] = lo_[1]; vf_[2] = lo_[2]; vf_[3] = lo_[3]; vf_[4] = hi_[0]; vf_[5] = hi_[1]; vf_[6] = hi_[2]; vf_[7] = hi_[3]; \
            o[dt_] = __builtin_amdgcn_mfma_f32_16x16x32_bf16(vf_, pf_, o[dt_] * alpha_, 0, 0, 0); } } while (0)
    ATT_LOAD(kfA, vvA, 0);
    if (ngrp > 1) ATT_LOAD(kfB, vvB, 1);
#pragma unroll 1
    for (int grp = 0; grp < ngrp; grp += 2) {
        ATT_GROUP(kfA, vvA, grp, vreg);
        if (grp + 1 < ngrp) ATT_GROUP(kfB, vvB, grp + 1, vreg + 4608);
    }
#undef ATT_LOAD
#undef ATT_GROUP
    ssum += __shfl_xor(ssum, 16); ssum += __shfl_xor(ssum, 32);
    const float inv = 1.0f / ssum;
    if (hd < 8) {
        bf16_t* op = MIX + (size_t)tok * 1024 + hd * 64 + 4 * g;
#pragma unroll
        for (int dt = 0; dt < 4; ++dt) { u32x2 w; w.x = cvt_pk_bf16(o[dt][0] * inv, o[dt][1] * inv); w.y = cvt_pk_bf16(o[dt][2] * inv, o[dt][3] * inv); *(u32x2*)(op + 16 * dt) = w; }
    }
    __syncthreads();
}

__device__ __forceinline__ void conv_tile(const Params& P, LAS unsigned char* lds, int tile, int tid, int wave, int lane) {
    unsigned char* ws = P.ws;
    const bf16_t* HG = (const bf16_t*)(ws + WS_HGLU); bf16_t* MIX = (bf16_t*)(ws + WS_MIX);
    LAS f32x2* part = (LAS f32x2*)(lds + LDS_MISC + 1024);
    LAS f32x2* stat = part + 256;
    LAS bf16_t* Lin = (LAS bf16_t*)lds;
    LAS bf16_t* Lout = (LAS bf16_t*)(lds + 65536);
    const int tok0 = tile * 32, t0 = tok0 & (SEQ - 1), c = tid;
    for (int ch = tid; ch < 62 * 64; ch += NTHR) { const int r = ch >> 6, cc = ch & 63; const int tt = t0 - 30 + r;
        u32x4 v = {0u, 0u, 0u, 0u}; if (tt >= 0) v = *(const u32x4*)(HG + (size_t)(tok0 - 30 + r) * 512 + cc * 8);
        *(LAS u32x4*)(Lin + r * 512 + cc * 8) = v; }
    __syncthreads();
    float in[62];
#pragma unroll
    for (int r = 0; r < 62; ++r) in[r] = __builtin_bit_cast(float, (unsigned)Lin[r * 512 + c] << 16);
    float out[32];
    const float bias = P.dw_b[c];
#pragma unroll
    for (int i = 0; i < 32; ++i) out[i] = bias;
#pragma unroll
    for (int j = 0; j < 31; ++j) { const float wj = P.dw_w[j * 512 + c];
#pragma unroll
        for (int i = 0; i < 32; ++i) out[i] = fmaf(in[i + j], wj, out[i]); }
#pragma unroll
    for (int i = 0; i < 32; ++i) { const float s1 = wave_sum(out[i]), s2 = wave_sum(out[i] * out[i]); if (lane == 0) part[i * 8 + wave] = (f32x2){s1, s2}; }
    __syncthreads();
    if (tid < 32) { float s1 = 0.f, s2 = 0.f;
#pragma unroll
        for (int w = 0; w < 8; ++w) { const f32x2 pp = part[tid * 8 + w]; s1 += pp.x; s2 += pp.y; }
        const float mean = s1 * (1.0f / 512.0f), var = fmaxf(s2 * (1.0f / 512.0f) - mean * mean, 0.f);
        stat[tid] = (f32x2){mean, 1.0f / sqrtf(var + EPS)}; }
    __syncthreads();
    const float lgc = P.ln_g[c], lbc = P.ln_b[c];
#pragma unroll
    for (int i = 0; i < 32; ++i) { const f32x2 st = stat[i]; const float y = (out[i] - st.x) * st.y * lgc + lbc; const float sl = y * sigmoidf_(y);
        Lout[i * 512 + c] = (bf16_t)f2bf(sl); }
    __syncthreads();
    for (int ch = tid; ch < 32 * 64; ch += NTHR) { const int r = ch >> 6, cc = ch & 63;
        *(u32x4*)(MIX + (size_t)(tok0 + r) * 1024 + 512 + cc * 8) = *(const LAS u32x4*)(Lout + r * 512 + cc * 8); }
    __syncthreads();
}

constexpr int MW_UP = 32 * 16 * 64, MW_DN = 32 * 16 * 32, MW_ITEMS = MW_UP + MW_DN;
__device__ __forceinline__ void mw_decode(const Params& P, int it, const float*& src, int& ldw, unsigned char*& dst, const float*& gain) {
    unsigned char* ws = P.ws;
    if (it < MW_UP) { const int e = it >> 10, rr = it & 1023, kb = rr >> 6, nb = rr & 63, pn = nb >> 3, j = (nb & 7) * 32, bj = j >> 7, jj = j & 127;
        src = P.w_up + (size_t)e * 1024 * 2048 + (size_t)(kb * 64) * 2048 + 1024 * bj + 128 * pn + jj; ldw = 2048;
        dst = ws + WS_WUP + (size_t)e * 2048 * 1024 + (size_t)(nb * 32) * 1024 + kb * 64; gain = P.g_ffn + kb * 64; }
    else { const int r = it - MW_UP, e = r >> 9, rr = r & 511, kb = rr >> 5, nb = rr & 31;
        src = P.w_down + (size_t)e * 1024 * 1024 + (size_t)(kb * 64) * 1024 + nb * 32; ldw = 1024;
        dst = ws + WS_WDOWN + (size_t)e * 1024 * 1024 + (size_t)(nb * 32) * 1024 + kb * 64; gain = nullptr; }
}
#define MW_LOAD(LD, it_) do { if ((it_) < MW_ITEMS) { const float* src_; int ldw_; unsigned char* dst_; const float* gain_; mw_decode(P, (it_), src_, ldw_, dst_, gain_); \
        _Pragma("unroll") for (int i_ = 0; i_ < 8; ++i_) LD[i_] = *(const f32x4*)(src_ + (size_t)(8 * i_ + (lane >> 3)) * ldw_ + (lane & 7) * 4); } } while (0)
#define MW_FINISH(LD, it_) do { if ((it_) < MW_ITEMS) { const float* src_; int ldw_; unsigned char* dst_; const float* gain_; mw_decode(P, (it_), src_, ldw_, dst_, gain_); \
        _Pragma("unroll") for (int i_ = 0; i_ < 8; ++i_) { const int kk_ = 8 * i_ + (lane >> 3), j_ = (lane & 7) * 4; const float gk_ = (gain_ ? gain_[kk_] : 1.0f) * 32.0f; \
            LAS float* d_ = scr + kk_ * 33 + j_; d_[0] = LD[i_].x * gk_; d_[1] = LD[i_].y * gk_; d_[2] = LD[i_].z * gk_; d_[3] = LD[i_].w * gk_; } \
        LDS_WAIT(); asm volatile("" ::: "memory"); \
        const int c_ = lane & 7; \
        _Pragma("unroll") for (int j_ = 0; j_ < 4; ++j_) { const int n_ = (lane >> 3) + 8 * j_; const LAS float* sp_ = scr + (8 * c_) * 33 + n_; \
            u32x2 o_; o_.x = pk4_fp8(sp_[0 * 33], sp_[1 * 33], sp_[2 * 33], sp_[3 * 33]); o_.y = pk4_fp8(sp_[4 * 33], sp_[5 * 33], sp_[6 * 33], sp_[7 * 33]); \
            *(u32x2*)(dst_ + (size_t)n_ * 1024 + 8 * c_) = o_; } \
        LDS_WAIT(); asm volatile("" ::: "memory"); } } while (0)
__device__ __forceinline__ void moe_weight_convert(const Params& P, LAS float* scr, int cw, int ncw, int lane) {
    f32x4 l0[8], l1[8], l2[8], l3[8];
    MW_LOAD(l0, cw); MW_LOAD(l1, cw + ncw); MW_LOAD(l2, cw + 2 * ncw);
    for (int base = cw; base < MW_ITEMS; base += 4 * ncw) {
        MW_LOAD(l3, base + 3 * ncw); MW_FINISH(l0, base);
        MW_LOAD(l0, base + 4 * ncw); MW_FINISH(l1, base + ncw);
        MW_LOAD(l1, base + 5 * ncw); MW_FINISH(l2, base + 2 * ncw);
        MW_LOAD(l2, base + 6 * ncw); MW_FINISH(l3, base + 3 * ncw);
    }
}
#undef MW_LOAD
#undef MW_FINISH

__device__ __forceinline__ void router_phase(const Params& P, LAS unsigned char* lds, int blk, int G, int tid, int wave, int lane) {
    unsigned char* ws = P.ws;
    const float* h1 = (const float*)(ws + WS_H1); const float* wrg = (const float*)(ws + WS_WRG);
    int* list = (int*)(ws + WS_LIST); float* lscale = (float*)(ws + WS_LSCALE); float* lgate = (float*)(ws + WS_LGATE);
    unsigned* cntg = (unsigned*)(ws + WS_CTL) + CW_CNT;
    LAS float* WL = (LAS float*)lds;
    LAS int* lcnt = (LAS int*)(lds + LDS_MISC + 1024);
    LAS int* gbase = lcnt + 32;
    LAS int* rec_e = gbase + 32;
    LAS int* rec_p = rec_e + 512;
    LAS float* rec_g = (LAS float*)(rec_p + 512);
    LAS float* rec_s = rec_g + 512;
    for (int i = tid; i < 8192; i += NTHR) ((LAS f32x4*)WL)[i] = ((const f32x4*)wrg)[i];
    __syncthreads();
    const int tl = lane & 31, half = lane >> 5;
    for (int chunk = blk; chunk < NTOK / 128; chunk += G) {
        if (tid < 32) lcnt[tid] = 0;
        __syncthreads();
        if (wave < 4) {
            const int tloc = wave * 32 + tl, tok = chunk * 128 + tloc;
            const float* hrow = h1 + (size_t)tok * DM + 4 * half;
            f32x16 acc;
#pragma unroll
            for (int i = 0; i < 16; ++i) acc[i] = 0.f;
            float ss = 0.f;
#pragma unroll 1
            for (int k0 = 0; k0 < DM; k0 += 32) {
                f32x4 hv[4];
#pragma unroll
                for (int i = 0; i < 4; ++i) hv[i] = *(const f32x4*)(hrow + k0 + 8 * i);
#pragma unroll
                for (int i = 0; i < 4; ++i) {
                    ss = fmaf(hv[i].x, hv[i].x, fmaf(hv[i].y, hv[i].y, fmaf(hv[i].z, hv[i].z, fmaf(hv[i].w, hv[i].w, ss))));
#pragma unroll
                    for (int j = 0; j < 4; ++j) { const float wv = WL[(k0 + 8 * i + 4 * half + j) * 32 + tl];
                        acc = __builtin_amdgcn_mfma_f32_32x32x2f32(wv, hv[i][j], acc, 0, 0, 0); }
                }
            }
            ss += __shfl_xor(ss, 32);
            const float rs = 1.0f / sqrtf(ss * (1.0f / DM) + EPS);
            float v[16];
#pragma unroll
            for (int r = 0; r < 16; ++r) v[r] = acc[r] * rs + P.b_router[(r & 3) + 8 * (r >> 2) + 4 * half];
            float tv[4]; int te[4];
#pragma unroll
            for (int q = 0; q < 4; ++q) { float bv = -INFINITY; int be = 64;
#pragma unroll
                for (int r = 0; r < 16; ++r) { const int e = (r & 3) + 8 * (r >> 2) + 4 * half; if (v[r] > bv || (v[r] == bv && e < be)) { bv = v[r]; be = e; } }
#pragma unroll
                for (int r = 0; r < 16; ++r) { const int e = (r & 3) + 8 * (r >> 2) + 4 * half; if (e == be) v[r] = -INFINITY; }
                tv[q] = bv; te[q] = be; }
            float cv[8]; int ce[8];
#pragma unroll
            for (int q = 0; q < 4; ++q) { cv[q] = tv[q]; ce[q] = te[q]; cv[4 + q] = __shfl_xor(tv[q], 32); ce[4 + q] = __shfl_xor(te[q], 32); }
#pragma unroll
            for (int q = 0; q < 4; ++q) { float bv = -INFINITY; int be = 64;
#pragma unroll
                for (int r = 0; r < 8; ++r) if (cv[r] > bv || (cv[r] == bv && ce[r] < be)) { bv = cv[r]; be = ce[r]; }
#pragma unroll
                for (int r = 0; r < 8; ++r) if (ce[r] == be) cv[r] = -INFINITY;
                tv[q] = bv; te[q] = be; }
            const float e1 = __expf(tv[1] - tv[0]), e2 = __expf(tv[2] - tv[0]), e3 = __expf(tv[3] - tv[0]);
            const float is = 1.0f / (1.0f + e1 + e2 + e3);
            if (half == 0) {
                const float gq[4] = {is, e1 * is, e2 * is, e3 * is};
#pragma unroll
                for (int q = 0; q < 4; ++q) { const int lp = atomicAdd((int*)&lcnt[te[q]], 1); const int si = tloc * 4 + q; rec_e[si] = te[q]; rec_p[si] = lp; rec_g[si] = gq[q]; }
                rec_s[tloc] = rs;
            }
        }
        __syncthreads();
        if (tid < 32) gbase[tid] = (int)atomicAdd(cntg + 64 * tid, (unsigned)lcnt[tid]);
        __syncthreads();
        { const int si = tid, ee = rec_e[si], pos = gbase[ee] + rec_p[si], li = ee * NTOK + pos;
          list[li] = (chunk * 128) * 4 + si; lscale[li] = rec_s[si >> 2]; lgate[li] = rec_g[si]; }
        __syncthreads();
    }
}

__device__ __forceinline__ void combine_phase(const Params& P, int gw, int NGW, int lane) {
    unsigned char* ws = P.ws;
    float* h1 = (float*)(ws + WS_H1); bf16_t* h1b = (bf16_t*)(ws + WS_H1B); const bf16_t* y = (const bf16_t*)(ws + WS_Y); float* rs3 = (float*)(ws + WS_RS3);
    for (int m = gw; m < NTOK; m += NGW) {
        const f32x4* hr = (const f32x4*)(h1 + (size_t)m * DM) + lane; f32x4 v[4]; float s = 0.f;
#pragma unroll
        for (int j = 0; j < 4; ++j) v[j] = hr[64 * j];
#pragma unroll
        for (int k = 0; k < 4; ++k) { const u32x2* yr = (const u32x2*)(y + (size_t)(m * 4 + k) * DM) + lane;
#pragma unroll
            for (int j = 0; j < 4; ++j) { const u32x2 w = yr[64 * j]; v[j].x += bf_lo(w.x); v[j].y += bf_hi(w.x); v[j].z += bf_lo(w.y); v[j].w += bf_hi(w.y); } }
        u32x2* o8 = (u32x2*)(h1b + (size_t)m * DM) + lane; unsigned* o4 = (unsigned*)(ws + WS_H1F8 + (size_t)m * DM) + lane;
#pragma unroll
        for (int j = 0; j < 4; ++j) { u32x2 w; w.x = pk2(v[j].x, v[j].y); w.y = pk2(v[j].z, v[j].w); o8[64 * j] = w; o4[64 * j] = pk4_fp8(v[j].x, v[j].y, v[j].z, v[j].w);
            s += (v[j].x * v[j].x + v[j].y * v[j].y) + (v[j].z * v[j].z + v[j].w * v[j].w); }
        s = wave_sum(s);
        if (lane == 0) rs3[m] = 1.0f / sqrtf(s * (1.0f / DM) + EPS);
    }
}

__device__ __forceinline__ void final_phase(const Params& P, int gw, int NGW, int lane) {
    unsigned char* ws = P.ws;
    const bf16_t* h2b = (const bf16_t*)(ws + WS_H1B); const bf16_t* pj = (const bf16_t*)(ws + WS_PJ); const bf16_t* G = (const bf16_t*)(ws + WS_G); const float* rs3 = (const float*)(ws + WS_RS3);
    f32x4 gv[4];
#pragma unroll
    for (int j = 0; j < 4; ++j) gv[j] = *((const f32x4*)P.g_final + lane + 64 * j);
    for (int m = gw; m < NTOK; m += NGW) {
        const u32x2* hr = (const u32x2*)(h2b + (size_t)m * DM) + lane; const u32x2* pr = (const u32x2*)(pj + (size_t)m * DM) + lane; const u32x2* gr = (const u32x2*)(G + (size_t)m * DM) + lane;
        const float r3 = rs3[m]; f32x4 v[4]; float s = 0.f;
#pragma unroll
        for (int j = 0; j < 4; ++j) { const u32x2 hw = hr[64 * j], pw = pr[64 * j], gw2 = gr[64 * j];
            v[j].x = bf_lo(hw.x) + bf_lo(pw.x) * sigmoidf_(bf_lo(gw2.x) * r3); v[j].y = bf_hi(hw.x) + bf_hi(pw.x) * sigmoidf_(bf_hi(gw2.x) * r3);
            v[j].z = bf_lo(hw.y) + bf_lo(pw.y) * sigmoidf_(bf_lo(gw2.y) * r3); v[j].w = bf_hi(hw.y) + bf_hi(pw.y) * sigmoidf_(bf_hi(gw2.y) * r3);
            s += (v[j].x * v[j].x + v[j].y * v[j].y) + (v[j].z * v[j].z + v[j].w * v[j].w); }
        s = wave_sum(s); const float rs = 1.0f / sqrtf(s * (1.0f / DM) + EPS);
        f32x4* orow = (f32x4*)(P.out + (size_t)m * DM) + lane;
#pragma unroll
        for (int j = 0; j < 4; ++j) orow[64 * j] = v[j] * rs * gv[j];
    }
}

#define XB_TMO      128
#define XB_XCNT(j)  (256  + 64 * (j))
#define XB_XSUB(j)  (1280 + 64 * (j))
#define XB_XGEN(j)  (2304 + 64 * (j))
#define XB_TOP      3328
#define XB_TOPGEN   3392
#define XCD_BAR_WORDS 3456
#define XB_SPIN_CAP (1u << 18)
__device__ __forceinline__ unsigned xb_ld(unsigned* p)              { return __hip_atomic_load(p, __ATOMIC_RELAXED, __HIP_MEMORY_SCOPE_AGENT); }
__device__ __forceinline__ unsigned xb_add(unsigned* p, unsigned v) { return __hip_atomic_fetch_add(p, v, __ATOMIC_RELAXED, __HIP_MEMORY_SCOPE_AGENT); }
__device__ __forceinline__ unsigned xb_xcc_id() { return (unsigned)__builtin_amdgcn_s_getreg((3 << 11) | 20) & 0xFu; }
#define XB_SPIN(cond, bar) do { unsigned _sp = 0; while (cond) { __builtin_amdgcn_s_sleep(1); \
    if ((++_sp & 255u) == 0u) { if (xb_ld(&(bar)[XB_TMO])) break; if (_sp > XB_SPIN_CAP) { atomicAdd(&(bar)[XB_TMO], 1u); break; } } } } while (0)
struct XcdBarrier { unsigned* bar; unsigned x; volatile LAS unsigned* st; };
__device__ __forceinline__ XcdBarrier xcd_barrier_post(unsigned* bar, volatile LAS unsigned* st) {
    XcdBarrier b; b.bar = bar; b.x = xb_xcc_id(); b.st = st;
    if (threadIdx.x == 0) (void)xb_add(&bar[XB_XCNT(b.x)], 1u);
    return b;
}
__device__ __forceinline__ void xcd_barrier_complete(unsigned* bar, unsigned x, unsigned& nloc, unsigned& nx) {
    const unsigned G = gridDim.x * gridDim.y * gridDim.z;
    unsigned sum, cnt, mine, sp = 0u;
    for (;;) {
        sum = 0u; cnt = 0u; mine = 0u;
#pragma unroll
        for (unsigned j = 0; j < 16; ++j) { const unsigned c = xb_ld(&bar[XB_XCNT(j)]); sum += c; cnt += (c > 0u) ? 1u : 0u; mine = (j == x) ? c : mine; }
        if (sum == G) break;
        __builtin_amdgcn_s_sleep(1);
        if ((++sp & 255u) == 0u) { if (xb_ld(&bar[XB_TMO])) break; if (sp > XB_SPIN_CAP) { atomicAdd(&bar[XB_TMO], 1u); break; } }
    }
    nloc = mine > 0u ? mine : 1u; nx = cnt > 0u ? cnt : 1u;
}
__device__ __forceinline__ void xcd_barrier(const XcdBarrier& b) {
    asm volatile("s_waitcnt vmcnt(0)" ::: "memory");
    __syncthreads();
    if (threadIdx.x == 0) {
        unsigned* bar = b.bar;
        __builtin_amdgcn_s_waitcnt(0);
        unsigned nloc = b.st[0], nx = b.st[1];
        if (nloc == 0u) { xcd_barrier_complete(bar, b.x, nloc, nx); b.st[0] = nloc; b.st[1] = nx; }
        const unsigned old = xb_add(&bar[XB_XSUB(b.x)], 1u);
        const unsigned gen = old / nloc;
        if (old + 1u == (gen + 1u) * nloc) {
            __builtin_amdgcn_fence(__ATOMIC_RELEASE, "agent");
            asm volatile("s_waitcnt vmcnt(0)" ::: "memory");
            const unsigned og = xb_add(&bar[XB_TOP], 1u);
            const unsigned tg = og / nx;
            if (og + 1u == (tg + 1u) * nx) xb_add(&bar[XB_TOPGEN], 1u);
            else XB_SPIN(xb_ld(&bar[XB_TOPGEN]) == tg, bar);
            __builtin_amdgcn_fence(__ATOMIC_ACQUIRE, "agent");
            xb_add(&bar[XB_XGEN(b.x)], 1u);
            asm volatile("s_waitcnt vmcnt(0)" ::: "memory");
        } else {
            XB_SPIN(xb_ld(&bar[XB_XGEN(b.x)]) == gen, bar);
            __builtin_amdgcn_fence(__ATOMIC_ACQUIRE, "agent");
            asm volatile("s_waitcnt vmcnt(0)" ::: "memory");
        }
    }
    __syncthreads();
}

constexpr int NPHASE = 10;
__global__ void __launch_bounds__(NTHR, 2) fwd_kernel(Params P) {
    extern __shared__ __attribute__((aligned(16))) unsigned char lds_raw[];
    LAS unsigned char* lds = (LAS unsigned char*)lds_raw;
    cg::grid_group grid = cg::this_grid();
    const int tid = threadIdx.x, wave = __builtin_amdgcn_readfirstlane(tid >> 6);
    const int G = gridDim.x, bx = blockIdx.x;
#define FRESH_LANE(name) int name = (int)__builtin_amdgcn_mbcnt_hi(~0u, __builtin_amdgcn_mbcnt_lo(~0u, 0u)); asm volatile("" : "+v"(name))
    const int vcu = (G % 8 == 0) ? (bx % 8) * (G / 8) + bx / 8 : bx;
    const int NGW = G * NWAVES;
    unsigned char* ws = P.ws;
    const int lo = P.ph_lo, hi = P.ph_hi;
#define IN(k) (lo <= (k) && (k) < hi)
    volatile LAS unsigned* xst = (volatile LAS unsigned*)(lds + LDS_XB);
    if (tid < 2) xst[tid] = 0u;
    __syncthreads();
    const XcdBarrier xbar = xcd_barrier_post((unsigned*)(ws + WS_CTL) + CW_BAR, xst);
#define SYNC(k) do { if (IN(k) && IN((k) + 1)) { if ((k) == 0) grid.sync(); else xcd_barrier(xbar); } } while (0)

    if (IN(0)) { FRESH_LANE(lane); p0_prologue(P, lds, vcu, G, wave, lane); }
    SYNC(0);
    if (IN(1)) {
        { pg8::DenseSched S; S.init((const bf16_t*)(ws + WS_XB), (const bf16_t*)(ws + WS_WIN), NTOK, 2048, 1024, G, bx);
          EpiInProj E{(const float*)(ws + WS_RS1), (const f32x2*)(ws + WS_ROPE), P.glu_b, (bf16_t*)(ws + WS_Q), (bf16_t*)(ws + WS_K), (bf16_t*)(ws + WS_V), (bf16_t*)(ws + WS_QI), (bf16_t*)(ws + WS_KI), (bf16_t*)(ws + WS_HGLU), (float*)(ws + WS_WI)};
          pg8::gemm_phase<EpiInProj, pg8::DenseSched, false>(lds, S, E); }
        { pg8::DenseSched S; S.init((const bf16_t*)(ws + WS_PB), (const bf16_t*)(ws + WS_WP), NTOK, 1024, 256, G, bx);
          EpiBf16Plain E{(bf16_t*)(ws + WS_PJ), 1024, 1.0f};
          pg8::gemm_phase<EpiBf16Plain, pg8::DenseSched, false>(lds, S, E); }
    }
    SYNC(1);
    if (IN(2)) {
        FRESH_LANE(lane);
        for (int i = tid; i < 4096; i += NTHR) ((LAS unsigned*)(lds + LDS_MISC))[i] = 0u;
        __syncthreads();
        unsigned* ctl = (unsigned*)(ws + WS_CTL);
        volatile LAS int* qw = (volatile LAS int*)(lds + LDS_XB + 32);
        if (G % 8 == 0 && G >= 128) { const int ncv = 8; if ((bx >> 3) < ncv) moe_weight_convert(P, (LAS float*)(lds + wave * 16384), (bx * NWAVES) + wave, ncv * 8 * NWAVES, lane); }
        else { moe_weight_convert(P, (LAS float*)(lds + wave * 16384), bx * NWAVES + wave, G * NWAVES, lane); }
        __syncthreads();
        for (int db = 0; db < NB; ++db) { const int b = (bx + db) & 7;
            for (;;) {
                if (tid == 0) qw[0] = (int)atomicAdd(ctl + CW_AQ + 64 * b, 1u);
                __syncthreads();
                const int k = qw[0];
                if (k >= 512) break;
                attn_tile(P, lds, b, (511 - k) * 8, wave, lane);
            }
            __syncthreads(); }
        for (;;) {
            if (tid == 0) qw[0] = (int)atomicAdd(ctl + CW_CQ, 1u);
            __syncthreads();
            const int tl = qw[0];
            if (tl >= NTOK / 32) break;
            conv_tile(P, lds, tl, tid, wave, lane);
        }
    }
    SYNC(2);
    if (IN(3)) {
        pg8::DenseSched S; S.init((const bf16_t*)(ws + WS_MIX), (const bf16_t*)(ws + WS_WOUT), NTOK, 1024, 1024, G, bx);
        EpiOutProj E{P.x, (float*)(ws + WS_H1), (unsigned char*)(ws + WS_H1F8)};
        pg8::gemm_phase<EpiOutProj, pg8::DenseSched, false, false, true>(lds, S, E);
    }
    SYNC(3);
    if (IN(4)) { FRESH_LANE(lane); router_phase(P, lds, vcu, G, tid, wave, lane); }
    SYNC(4);
    if (IN(5) || IN(6)) {
        LAS int* tb = (LAS int*)(lds + LDS_MISC); LAS int* cn = tb + 64;
        if (tid == 0) { const unsigned* cntg = (const unsigned*)(ws + WS_CTL) + CW_CNT; int acc = 0;
            for (int e = 0; e < NE; ++e) { const int c = (int)__hip_atomic_load(cntg + 64 * e, __ATOMIC_RELAXED, __HIP_MEMORY_SCOPE_AGENT); tb[e] = acc; cn[e] = c; acc += (c + BM - 1) / BM; }
            tb[NE] = acc; }
        __syncthreads();
        if (IN(5)) {
            pg8::MoeSched S; S.A = ws + WS_H1F8; S.Bt = ws + WS_WUP; S.rp = 1024; S.b_estride = (size_t)2048 * 1024; S.tb = tb; S.cnt = cn; S.list = (const int*)(ws + WS_LIST);
            S.nN = 8; S.nwg = tb[NE] * 8; S.G = G; S.c = bx; S.gather = true;
            { LAS int* ut = (LAS int*)(lds + LDS_MISC + 512); S.utab = ut; S.build_table(ut, tid); __syncthreads(); }
            S.m_scale = (const float*)(ws + WS_LSCALE); S.m_gate = nullptr; S.m_bias = P.b_up;
            EpiUp E{(unsigned char*)(ws + WS_ACT)};
            pg8::gemm_phase<EpiUp, pg8::MoeSched, true, true, true>(lds, S, E);
        }
        SYNC(5);
        if (IN(6)) {
            pg8::MoeSched S; S.A = ws + WS_ACT; S.Bt = ws + WS_WDOWN; S.rp = 1024; S.b_estride = (size_t)1024 * 1024; S.tb = tb; S.cnt = cn; S.list = (const int*)(ws + WS_LIST);
            S.nN = 4; S.nwg = tb[NE] * 4; S.G = G; S.c = bx; S.gather = false;
            { LAS int* ut = (LAS int*)(lds + LDS_MISC + 512); S.utab = ut; S.build_table(ut, tid); __syncthreads(); }
            S.m_scale = nullptr; S.m_gate = (const float*)(ws + WS_LGATE); S.m_bias = P.b_down;
            EpiDown E{(bf16_t*)(ws + WS_Y)};
            pg8::gemm_phase<EpiDown, pg8::MoeSched, true, true, true>(lds, S, E);
        }
    }
    SYNC(6);
    if (IN(7)) { FRESH_LANE(l7); const int g7 = vcu * NWAVES + wave;
        combine_phase(P, g7, NGW, l7); }
    SYNC(7);
    if (IN(8)) {
        pg8::DenseSched S; S.init(ws + WS_H1F8, ws + WS_WG, NTOK, 1024, 1024, G, bx); S.rp = 1024; S.idg = true;
        EpiBf16Plain E{(bf16_t*)(ws + WS_G), 1024, 0.03125f};
        pg8::gemm_phase<EpiBf16Plain, pg8::DenseSched, true, true>(lds, S, E);
    }
    SYNC(8);
    if (IN(9)) { FRESH_LANE(l9); const int g9 = vcu * NWAVES + wave;
        final_phase(P, g9, NGW, l9); }
#undef IN
#undef SYNC
}

#ifndef N_LAUNCH_MODE
#define N_LAUNCH_MODE 1
#endif
extern "C" void kernel_launch(void* const* d_in, const int* in_sizes, int n_in, void* d_out, int out_size, void* d_ws, size_t ws_size, hipStream_t stream) {
    static int grid = 0;
    if (grid == 0) {
        if (n_in != 21 || out_size != NTOK * DM || ws_size < WS_END) { fprintf(stderr, "kernel_launch: unexpected shapes (n_in %d out %d ws %zu)\n", n_in, out_size, ws_size); grid = -1; return; }
        int dev = 0, cus = 0, per_cu = 0;
        (void)hipGetDevice(&dev); (void)hipDeviceGetAttribute(&cus, hipDeviceAttributeMultiprocessorCount, dev);
        (void)hipFuncSetAttribute((const void*)fwd_kernel, hipFuncAttributeMaxDynamicSharedMemorySize, LDS_BYTES);
        if (hipOccupancyMaxActiveBlocksPerMultiprocessor(&per_cu, (const void*)fwd_kernel, NTHR, LDS_BYTES) != hipSuccess || per_cu < 1) { fprintf(stderr, "kernel_launch: occupancy query failed (%d)\n", per_cu); (void)hipGetLastError(); grid = -1; return; }
        grid = cus;
    }
    if (grid < 0) return;
    (void)hipMemsetAsync((char*)d_ws + WS_CTL, 0, CTL_BYTES, stream);
    Params p{};
    p.x = (const float*)d_in[0]; p.p = (const float*)d_in[1]; p.w_in = (const float*)d_in[2]; p.w_out = (const float*)d_in[3]; p.g_mix = (const float*)d_in[4]; p.g_ffn = (const float*)d_in[5];
    p.glu_b = (const float*)d_in[6]; p.dw_w = (const float*)d_in[7]; p.dw_b = (const float*)d_in[8]; p.ln_g = (const float*)d_in[9]; p.ln_b = (const float*)d_in[10];
    p.w_router = (const float*)d_in[11]; p.b_router = (const float*)d_in[12]; p.w_up = (const float*)d_in[13]; p.b_up = (const float*)d_in[14]; p.w_down = (const float*)d_in[15]; p.b_down = (const float*)d_in[16];
    p.w_ple_proj = (const float*)d_in[17]; p.w_ple_gate = (const float*)d_in[18]; p.g_ple = (const float*)d_in[19]; p.g_final = (const float*)d_in[20];
    p.out = (float*)d_out; p.ws = (unsigned char*)d_ws;
#if N_LAUNCH_MODE == 1
    p.ph_lo = 0; p.ph_hi = NPHASE;
    void* args[] = {&p};
    hipError_t e = hipLaunchCooperativeKernel((const void*)fwd_kernel, dim3(grid), dim3(NTHR), args, LDS_BYTES, stream);
    if (e != hipSuccess) fprintf(stderr, "cooperative launch failed: %s (grid %d)\n", hipGetErrorString(e), grid);
#else
    for (int ph = 0; ph < NPHASE; ++ph) {
        p.ph_lo = ph; p.ph_hi = ph + 1;
        void* args[] = {&p};
        hipError_t e = hipLaunchCooperativeKernel((const void*)fwd_kernel, dim3(grid), dim3(NTHR), args, LDS_BYTES, stream);
        if (e != hipSuccess) { fprintf(stderr, "launch %d failed: %s (grid %d)\n", ph, hipGetErrorString(e), grid); break; }
    }
#endif
}
```

```cpp
#include <hip/hip_runtime.h>
#include <hip/hip_cooperative_groups.h>
#include <cstdio>
#include <cstdint>
namespace cg = cooperative_groups;

#define LAS __attribute__((address_space(3)))
#define GAS __attribute__((address_space(1)))
typedef unsigned short bf16_t;
typedef short bf16x8 __attribute__((ext_vector_type(8)));
typedef short s16x4 __attribute__((ext_vector_type(4)));
typedef float f32x4 __attribute__((ext_vector_type(4)));
typedef float f32x2 __attribute__((ext_vector_type(2)));
typedef float f32x16 __attribute__((ext_vector_type(16)));
typedef unsigned u32x4 __attribute__((ext_vector_type(4)));
typedef unsigned u32x2 __attribute__((ext_vector_type(2)));

constexpr int NB = 8, SEQ = 4096, DM = 1024, NTOK = NB * SEQ;
constexpr int NE = 32, TOPK = 4, NSLOT = NTOK * TOPK;
constexpr int INW = 1988;
constexpr int NSEL = 256;
constexpr float EPS = 1e-6f;
constexpr int NWAVES = 8, NTHR = 512;

constexpr size_t MiB = 1u << 20;
constexpr size_t WS_CTL = 0, CTL_BYTES = 64 * 1024;
constexpr size_t WS_ROPE = 1 * MiB;
constexpr size_t WS_WIN = 2 * MiB;
constexpr size_t WS_WOUT = 6 * MiB;
constexpr size_t WS_WG = 8 * MiB;
constexpr size_t WS_WP = 10 * MiB;
constexpr size_t WS_WRG = 10 * MiB + 512 * 1024;
constexpr size_t WS_RS1 = 11 * MiB;
constexpr size_t WS_RS3 = 11 * MiB + 512 * 1024;
constexpr size_t WS_WI = 12 * MiB;
constexpr size_t WS_LIST = 13 * MiB;
constexpr size_t WS_LSCALE = 17 * MiB;
constexpr size_t WS_LGATE = 21 * MiB;
constexpr size_t WS_PB = 25 * MiB;
constexpr size_t WS_WUP = 42 * MiB;
constexpr size_t WS_WDOWN = 170 * MiB;
constexpr size_t WS_H1 = 234 * MiB;
constexpr size_t WS_H1B = 362 * MiB;
constexpr size_t WS_PJ = 426 * MiB;
constexpr size_t WS_XB = 490 * MiB;
constexpr size_t WS_Q = 554 * MiB;
constexpr size_t WS_K = 586 * MiB;
constexpr size_t WS_V = 590 * MiB;
constexpr size_t WS_QI = 594 * MiB;
constexpr size_t WS_KI = 610 * MiB;
constexpr size_t WS_HGLU = 614 * MiB;
constexpr size_t WS_MIX = 646 * MiB;
constexpr size_t WS_H1F8 = 490 * MiB;
constexpr size_t WS_ACT = 522 * MiB;
constexpr size_t WS_Y = 762 * MiB;
constexpr size_t WS_G = 762 * MiB;
constexpr size_t WS_END = 1018 * MiB;
static_assert(WS_H1F8 + (size_t)NTOK * 1024 <= WS_ACT && WS_ACT + (size_t)139264 * 1024 <= WS_Y, "ws map");
constexpr int CW_CNT = 1024;
constexpr int CW_AQ = 4096;
constexpr int CW_CQ = 4096 + 64 * 8;
constexpr int CW_BAR = 8192;

constexpr int LDS_STAGE = 131072;
constexpr int LDS_MISC = LDS_STAGE;
constexpr int LDS_META = LDS_MISC + 4096;
constexpr int LDS_XB = 147456;
constexpr int LDS_BYTES = 147456 + 256;

__device__ __forceinline__ unsigned f2bf(float f) { unsigned u = __builtin_bit_cast(unsigned, f); return (u + 0x7fffu + ((u >> 16) & 1u)) >> 16; }
__device__ __forceinline__ unsigned pk2(float lo, float hi) { return f2bf(lo) | (f2bf(hi) << 16); }
__device__ __forceinline__ float bf_lo(unsigned w) { return __builtin_bit_cast(float, w << 16); }
__device__ __forceinline__ float bf_hi(unsigned w) { return __builtin_bit_cast(float, w & 0xffff0000u); }
__device__ __forceinline__ float wave_sum(float v) {
    v += __builtin_bit_cast(float, __builtin_amdgcn_update_dpp(0, __builtin_bit_cast(int, v), 0xB1, 0xF, 0xF, true));
    v += __builtin_bit_cast(float, __builtin_amdgcn_update_dpp(0, __builtin_bit_cast(int, v), 0x4E, 0xF, 0xF, true));
    v += __builtin_bit_cast(float, __builtin_amdgcn_update_dpp(0, __builtin_bit_cast(int, v), 0x141, 0xF, 0xF, true));
    v += __builtin_bit_cast(float, __builtin_amdgcn_update_dpp(0, __builtin_bit_cast(int, v), 0x140, 0xF, 0xF, true));
    const int vi = __builtin_bit_cast(int, v);
    const float r0 = __builtin_bit_cast(float, __builtin_amdgcn_readlane(vi, 0)), r1 = __builtin_bit_cast(float, __builtin_amdgcn_readlane(vi, 16));
    const float r2 = __builtin_bit_cast(float, __builtin_amdgcn_readlane(vi, 32)), r3 = __builtin_bit_cast(float, __builtin_amdgcn_readlane(vi, 48));
    return (r0 + r1) + (r2 + r3);
}
__device__ __forceinline__ unsigned pk4_fp8(float a, float b, float c, float d) { int r = __builtin_amdgcn_cvt_pk_fp8_f32(a, b, 0, false); r = __builtin_amdgcn_cvt_pk_fp8_f32(c, d, r, true); return (unsigned)r; }
__device__ __forceinline__ float sigmoidf_(float x) { return __builtin_amdgcn_rcpf(1.0f + __builtin_amdgcn_exp2f(x * -1.4426950408889634f)); }
#define LDS_WAIT() asm volatile("s_waitcnt lgkmcnt(0)" ::: "memory")

struct Params {
    const float* x; const float* p; const float* w_in; const float* w_out; const float* g_mix; const float* g_ffn;
    const float* glu_b; const float* dw_w; const float* dw_b; const float* ln_g; const float* ln_b;
    const float* w_router; const float* b_router; const float* w_up; const float* b_up; const float* w_down; const float* b_down;
    const float* w_ple_proj; const float* w_ple_gate; const float* g_ple; const float* g_final;
    float* out; unsigned char* ws;
    int ph_lo, ph_hi;
};

namespace pg8 {
constexpr int BM = 256, BK = 64, HALF = 128, HTB = HALF * BK * 2, STAGE_BYTES = 8 * HTB, NXCD = 8, WGM = 8;
__host__ __device__ __forceinline__ int lds_byte(int r, int c) { const int st = (r >> 4) * 2 + (c >> 5), rr = r & 15, cc = c & 31, ob = rr * 64 + cc * 2; return st * 1024 + (ob ^ (((ob >> 9) & 1) << 5)); }
__host__ __device__ __forceinline__ void stage_rc(int b, int& R, int& C) { const int st = b / 1024, sb = b % 1024, swz = sb ^ (((sb >> 9) & 1) << 5); R = (st >> 1) * 16 + swz / 64; C = (st & 1) * 32 + (swz % 64) / 2; }
__host__ __device__ __forceinline__ int perm32(int rho) { const int n = rho >> 4, i = rho & 15; return 8 * (i >> 2) + 4 * n + (i & 3); }

struct Unit { int pm, pn, e, rows; };

__device__ __forceinline__ unsigned cvt_pk_bf16(float lo, float hi) { unsigned r; asm volatile("v_cvt_pk_bf16_f32 %0, %1, %2" : "=v"(r) : "v"(lo), "v"(hi)); return r; }

struct DenseSched {
    const void* A; const void* Bt; int rp;
    int nM, nN, nwg, G, c;
    __device__ void init(const void* A_, const void* Bt_, int M, int N, int K_, int G_, int c_) { A = A_; Bt = Bt_; rp = K_ * 2; nM = M / BM; nN = N / BM; nwg = nM * nN; G = G_; c = c_; }
    __device__ bool next(int i, Unit& u) const {
        const long L = (long)i * G + c; if (L >= nwg) return false;
        int wgid = (int)L; { const int q = nwg / NXCD, r = nwg % NXCD, xcd = wgid % NXCD, off = wgid / NXCD; wgid = (xcd < r ? xcd * (q + 1) : r * (q + 1) + (xcd - r) * q) + off; }
        const int nig = WGM * nN, gid = wgid / nig, fm = gid * WGM, gsz = (nM - fm) < WGM ? (nM - fm) : WGM;
        u.pm = fm + ((wgid % nig) % gsz); u.pn = (wgid % nig) / gsz; u.e = 0; u.rows = BM; return true;
    }
    bool idg = false;
    __device__ __forceinline__ const char* a_ptr(const Unit& u) const { return idg ? (const char*)A : (const char*)A + (size_t)u.pm * BM * rp; }
    __device__ __forceinline__ const char* b_ptr(const Unit& u) const { return (const char*)Bt + (size_t)u.pn * BM * rp; }
    __device__ __forceinline__ int a_row(const Unit& u, int r) const { return u.pm * BM + r; }
    __device__ __forceinline__ void meta(const Unit&, LAS unsigned char*, int, int) const {}
};

struct MoeSched {
    const void* A; const void* Bt; int rp; size_t b_estride;
    const LAS int* tb;
    const LAS int* cnt;
    const int* list;
    int nN, nwg, G, c; bool gather;
    const LAS int* utab;
    __device__ __forceinline__ bool next(int i, Unit& u) const {
        if (i >= 32) return false;
        const LAS int* p = utab + 4 * i; const int rows = p[3]; if (rows < 0) return false;
        u.pm = p[0]; u.pn = p[1]; u.e = p[2]; u.rows = rows; return true;
    }
    __device__ __forceinline__ void build_table(LAS int* tab, int tid) const {
        if (tid < 32) { Unit u; const bool ok = decode(tid, u); tab[4 * tid] = u.pm; tab[4 * tid + 1] = u.pn; tab[4 * tid + 2] = u.e; tab[4 * tid + 3] = ok ? u.rows : -1; }
    }
    __device__ __forceinline__ bool decode(int i, Unit& u) const {
        u.pm = 0; u.pn = 0; u.e = 0; u.rows = 0;
        const long L = (long)i * G + c; if (L >= nwg) return false;
        int wgid = (int)L; { const int q = nwg / NXCD, r = nwg % NXCD, xcd = wgid % NXCD, off = wgid / NXCD; wgid = (xcd < r ? xcd * (q + 1) : r * (q + 1) + (xcd - r) * q) + off; }
        int e = 0;
#pragma unroll 1
        for (; e < NE - 1; ++e) { if (wgid < tb[e + 1] * nN) break; }
        const int local = wgid - tb[e] * nN, nM = tb[e + 1] - tb[e];
        const int nig = WGM * nN, gid = local / nig, fm = gid * WGM, gsz = (nM - fm) < WGM ? (nM - fm) : WGM;
        const int rt = fm + ((local % nig) % gsz);
        u.pm = tb[e] + rt; u.pn = (local % nig) / gsz; u.e = e;
        const int left = cnt[e] - rt * BM; u.rows = left < BM ? left : BM; return true;
    }
    __device__ __forceinline__ const char* a_ptr(const Unit& u) const { return (const char*)A; }
    __device__ __forceinline__ const char* b_ptr(const Unit& u) const { return (const char*)Bt + (size_t)u.e * b_estride + (size_t)u.pn * BM * rp; }
    __device__ __forceinline__ int a_row(const Unit& u, int r) const {
        if (!gather) return u.pm * BM + r;
        const int rt = u.pm - tb[u.e];
        return r < u.rows ? (list[u.e * NTOK + rt * BM + r] >> 2) : 0;
    }
    const float* m_scale; const float* m_gate; const float* m_bias;
    __device__ __forceinline__ void meta(const Unit& u, LAS unsigned char* tbl, int wid, int lane) const {
        const int rt = u.pm - tb[u.e]; const size_t li = (size_t)u.e * NTOK + rt * BM + (wid & 3) * 64 + lane;
        if (gather) {
            if (wid < 4) __builtin_amdgcn_global_load_lds((const unsigned*)(m_scale + li), (LAS unsigned*)(tbl + (wid & 3) * 256), 4, 0, 0);
            else { const int j = (wid & 3) * 64 + lane; const float* src = m_bias + (size_t)u.e * 2048 + (j < 128 ? 128 * u.pn + j : 1024 + 128 * u.pn + (j - 128));
                __builtin_amdgcn_global_load_lds((const unsigned*)src, (LAS unsigned*)(tbl + 2048 + (wid & 3) * 256), 4, 0, 0); }
        } else {
            if (wid < 4) { __builtin_amdgcn_global_load_lds((const unsigned*)(list + li), (LAS unsigned*)(tbl + (wid & 3) * 256), 4, 0, 0);
                __builtin_amdgcn_global_load_lds((const unsigned*)(m_bias + (size_t)u.e * 1024 + u.pn * BM + (wid & 3) * 64 + lane), (LAS unsigned*)(tbl + 2048 + (wid & 3) * 256), 4, 0, 0); }
            else __builtin_amdgcn_global_load_lds((const unsigned*)(m_gate + li), (LAS unsigned*)(tbl + 1024 + (wid & 3) * 256), 4, 0, 0);
        }
    }
};

typedef int v8i32 __attribute__((ext_vector_type(8)));
template <class Epi, class Sched, bool GATHER, bool F8 = false, bool WARMTRIP = false>
__device__ __forceinline__ void gemm_phase(LAS unsigned char* lds, const Sched& S, const Epi& E) {
    const int tid = threadIdx.x, wid = __builtin_amdgcn_readfirstlane(tid >> 6), lane = tid & 63, wr = wid >> 2, wc = wid & 3, fr = lane & 15, fq = lane >> 4;
    const int RP = S.rp, nt = RP / (BK * 2);
    unsigned voffA[2], voffB[2]; int RA[2], CA[2];
#pragma unroll
    for (int i = 0; i < 2; ++i) { int R, C; stage_rc(tid * 16 + i * 8192, R, C); const int Rb = Epi::PERM ? ((R & ~31) + perm32(R & 31)) : R;
        voffA[i] = (unsigned)(R * RP + C * 2); voffB[i] = (unsigned)(Rb * RP + C * 2); RA[i] = R; CA[i] = C; }
    const size_t kstep = (size_t)(BK * 2);
    const size_t hstep = (size_t)HALF * RP;
    const unsigned ldsw = (unsigned)wid * 1024u;
    const int aoff = lds_byte(wr * 64 + fr, fq * 8), boff = lds_byte(wc * 32 + fr, fq * 8);
    unsigned gC[2][2], gN[2][2];
#define PG8_SA(b, h) (((b) * 2 + (h)) * HTB)
#define PG8_SB(b, h) ((4 + (b) * 2 + (h)) * HTB)
#define PG8_STAGE(bufoff, gbase, voff) do { _Pragma("unroll") for (int _i = 0; _i < 2; ++_i) \
        __builtin_amdgcn_global_load_lds((const unsigned*)((const char*)(gbase) + (voff)[_i]), (LAS unsigned*)(lds + (bufoff) + ldsw + _i * 8192), 16, 0, 0); } while (0)
#define PG8_STAGE_A(bufoff, kp, h) do { if constexpr (GATHER) { PG8_STAGE(bufoff, kp, gC[h]); } else { PG8_STAGE(bufoff, (kp) + (h) * hstep, voffA); } } while (0)
#define PG8_LD16(p) (*(const LAS bf16x8*)(p))
#define PG8_CAT(lo, hi) __builtin_bit_cast(v8i32, __builtin_shufflevector(lo, hi, 0, 1, 2, 3, 4, 5, 6, 7, 8, 9, 10, 11, 12, 13, 14, 15))
#define PG8_LDA(dst, b, h) do { _Pragma("unroll") for (int m = 0; m < 4; ++m) { if constexpr (F8) { dst##8[m] = PG8_CAT(PG8_LD16(lds + PG8_SA(b, h) + aoff + m * 2048), PG8_LD16(lds + PG8_SA(b, h) + aoff + m * 2048 + 1024)); } \
        else { _Pragma("unroll") for (int k = 0; k < 2; ++k) dst[m][k] = PG8_LD16(lds + PG8_SA(b, h) + aoff + m * 2048 + k * 1024); } } } while (0)
#define PG8_LDB(dst, b, h) do { _Pragma("unroll") for (int n = 0; n < 2; ++n) { if constexpr (F8) { dst##8[n] = PG8_CAT(PG8_LD16(lds + PG8_SB(b, h) + boff + n * 2048), PG8_LD16(lds + PG8_SB(b, h) + boff + n * 2048 + 1024)); } \
        else { _Pragma("unroll") for (int k = 0; k < 2; ++k) dst[n][k] = PG8_LD16(lds + PG8_SB(b, h) + boff + n * 2048 + k * 1024); } } } while (0)
#define PG8_MMA(ai, bj, At, Bt) do { __builtin_amdgcn_s_setprio(1); _Pragma("unroll") for (int m = 0; m < 4; ++m) _Pragma("unroll") for (int n = 0; n < 2; ++n) { \
        if constexpr (F8) { acc[ai][bj][m][n] = __builtin_amdgcn_mfma_scale_f32_16x16x128_f8f6f4(Bt##8[n], At##8[m], acc[ai][bj][m][n], 0, 0, 0, 0x7f7f7f7f, 0, 0x7f7f7f7f); } \
        else { _Pragma("unroll") for (int k = 0; k < 2; ++k) acc[ai][bj][m][n] = __builtin_amdgcn_mfma_f32_16x16x32_bf16(Bt[n][k], At[m][k], acc[ai][bj][m][n], 0, 0, 0); } } \
        __builtin_amdgcn_s_setprio(0); } while (0)
#define PG8_WAIT_V(n) asm volatile("s_waitcnt vmcnt(" #n ")" ::: "memory")
#define PG8_WAIT_L(n) asm volatile("s_waitcnt lgkmcnt(" #n ")" ::: "memory")
#define PG8_BAR __builtin_amdgcn_s_barrier()
#define PG8_SCHED __builtin_amdgcn_sched_barrier(0)
#define PG8_GOFF(dst, u) do { _Pragma("unroll") for (int _h = 0; _h < 2; ++_h) _Pragma("unroll") for (int _i = 0; _i < 2; ++_i) \
        dst[_h][_i] = (unsigned)(S.a_row(u, _h * HALF + RA[_i]) * RP + CA[_i] * 2); } while (0)
    Unit cur, nxt, nn; int ui = 0;
    if (!S.next(0, cur)) return;
    bool has_next = S.next(1, nxt);
    if constexpr (GATHER) { PG8_GOFF(gC, cur); if (has_next) { PG8_GOFF(gN, nxt); } else { PG8_GOFF(gN, cur); } }
    f32x4 acc[2][2][4][2];
#pragma unroll
    for (int a = 0; a < 2; ++a)
#pragma unroll
        for (int b = 0; b < 2; ++b)
#pragma unroll
            for (int m = 0; m < 4; ++m)
#pragma unroll
                for (int n = 0; n < 2; ++n) acc[a][b][m][n] = (f32x4){0.f, 0.f, 0.f, 0.f};
    bf16x8 At[4][2], B0[2][2], B1[2][2]; v8i32 At8[4], B08[2], B18[2];
    const char* cA = S.a_ptr(cur); const char* cB = S.b_ptr(cur);
    PG8_STAGE(PG8_SB(0, 0), cB, voffB); PG8_STAGE(PG8_SB(0, 1), cB + hstep, voffB); PG8_STAGE_A(PG8_SA(0, 0), cA, 0); PG8_STAGE_A(PG8_SA(0, 1), cA, 1);
    if (wr == 1) PG8_BAR;
    PG8_WAIT_V(2); PG8_BAR;
    PG8_STAGE(PG8_SB(1, 0), cB + kstep, voffB); PG8_STAGE_A(PG8_SA(1, 0), cA + kstep, 0); PG8_STAGE(PG8_SB(1, 1), cB + hstep + kstep, voffB);
    PG8_WAIT_V(6); PG8_BAR;
    for (;;) {
        const char* nA = has_next ? S.a_ptr(nxt) : cA; const char* nB = has_next ? S.b_ptr(nxt) : cB;
        S.meta(cur, lds + (LDS_META - 0) + (ui & 1) * 4096, wid, lane);
#define PG8_TRIP(WARM, t) do { \
            const bool last = ((t) == nt - 2); \
            const char* a1 = cA + (size_t)((t) + 1) * kstep; \
            const char* a2 = last ? nA : cA + (size_t)((t) + 2) * kstep; const char* b2 = last ? nB : cB + (size_t)((t) + 2) * kstep; \
            const char* a3 = a2 + kstep; const char* b3 = b2 + kstep; \
              \
            PG8_LDB(B0, 0, 0); PG8_LDB(B1, 0, 1); PG8_SCHED; PG8_LDA(At, 0, 0); if constexpr (!(WARM)) { PG8_STAGE_A(PG8_SA(1, 1), a1, 1); } \
            if constexpr (GATHER) { if (last) { _Pragma("unroll") for (int h = 0; h < 2; ++h) _Pragma("unroll") for (int i = 0; i < 2; ++i) gC[h][i] = gN[h][i]; } } \
            if constexpr (!(WARM)) { PG8_WAIT_V(8); } PG8_WAIT_L(0); PG8_BAR; PG8_MMA(0, 0, At, B0); PG8_MMA(0, 1, At, B1); PG8_BAR; PG8_SCHED; \
              \
            PG8_LDA(At, 0, 1); PG8_STAGE(PG8_SB(0, 0), b2, voffB); PG8_STAGE(PG8_SB(0, 1), b2 + hstep, voffB); PG8_STAGE_A(PG8_SA(0, 0), a2, 0); \
            if constexpr (!(WARM)) { PG8_WAIT_V(8); } PG8_WAIT_L(0); PG8_BAR; PG8_MMA(1, 0, At, B0); PG8_MMA(1, 1, At, B1); PG8_BAR; PG8_SCHED; \
              \
            PG8_LDB(B0, 1, 0); PG8_LDB(B1, 1, 1); PG8_SCHED; PG8_LDA(At, 1, 0); PG8_STAGE_A(PG8_SA(0, 1), a2, 1); \
            if constexpr (!(WARM)) { PG8_WAIT_V(8); } PG8_WAIT_L(0); PG8_BAR; PG8_MMA(0, 0, At, B0); PG8_MMA(0, 1, At, B1); PG8_BAR; PG8_SCHED; \
              \
            PG8_LDA(At, 1, 1); PG8_STAGE(PG8_SB(1, 0), b3, voffB); PG8_STAGE(PG8_SB(1, 1), b3 + hstep, voffB); PG8_STAGE_A(PG8_SA(1, 0), a3, 0); \
            PG8_WAIT_V(8); PG8_WAIT_L(0); PG8_BAR; PG8_MMA(1, 0, At, B0); PG8_MMA(1, 1, At, B1); PG8_BAR; PG8_SCHED; \
        } while (0)
        int t0_ = 0;
        if constexpr (WARMTRIP) { if (ui > 0) { PG8_TRIP(true, 0); t0_ = 2; } }
        for (int t = t0_; t < nt; t += 2) { PG8_TRIP(false, t); }
#undef PG8_TRIP
        if (wr == 0) PG8_BAR;
        if constexpr (WARMTRIP) { PG8_STAGE_A(PG8_SA(1, 1), nA + kstep, 1); }
        bool has_nn = false;
        if constexpr (GATHER) { if (has_next) { has_nn = S.next(ui + 2, nn); if (has_nn) { PG8_GOFF(gN, nn); } } }
        else { if (has_next) has_nn = S.next(ui + 2, nn); }
        { int fr_ = fr, fq_ = fq; asm volatile("" : "+v"(fr_), "+v"(fq_));
          const LAS unsigned char* mt = lds + LDS_META + (ui & 1) * 4096;
          if constexpr (WARMTRIP) {
              E.pre(acc, cur, wr, wc, fr_, fq_, mt);
              if constexpr (GATHER) asm volatile("" : "+v"(gN[0][0]), "+v"(gN[0][1]), "+v"(gN[1][0]), "+v"(gN[1][1]));
              PG8_WAIT_V(0);
              E.post(acc, cur, wr, wc, fr_, fq_, mt);
          } else { E.run(acc, cur, wr, wc, fr_, fq_, mt); } }
        if (!has_next) break;
#pragma unroll
        for (int a = 0; a < 2; ++a)
#pragma unroll
            for (int b = 0; b < 2; ++b)
#pragma unroll
                for (int m = 0; m < 4; ++m)
#pragma unroll
                    for (int n = 0; n < 2; ++n) acc[a][b][m][n] = (f32x4){0.f, 0.f, 0.f, 0.f};
        cur = nxt; cA = nA; cB = nB; ++ui; nxt = nn; has_next = has_nn;
        if (wr == 1) PG8_BAR;
    }
    PG8_WAIT_V(0);
    PG8_BAR;
#undef PG8_SA
#undef PG8_SB
#undef PG8_STAGE
#undef PG8_STAGE_A
#undef PG8_LDA
#undef PG8_LDB
#undef PG8_MMA
#undef PG8_LD16
#undef PG8_CAT
#undef PG8_WAIT_V
#undef PG8_WAIT_L
#undef PG8_BAR
#undef PG8_SCHED
#undef PG8_GOFF
}
}

using pg8::Unit; using pg8::cvt_pk_bf16;
constexpr int BM = 256, HALF = 128;

typedef f32x4 (&AccRef)[2][2][4][2];
__device__ __forceinline__ void pack8_bf16(f32x4& lo, const f32x4& hi) {
    const unsigned w0 = cvt_pk_bf16(lo[0], lo[1]), w1 = cvt_pk_bf16(lo[2], lo[3]), w2 = cvt_pk_bf16(hi[0], hi[1]), w3 = cvt_pk_bf16(hi[2], hi[3]);
    lo[0] = __builtin_bit_cast(float, w0); lo[1] = __builtin_bit_cast(float, w1); lo[2] = __builtin_bit_cast(float, w2); lo[3] = __builtin_bit_cast(float, w3);
}
#define AS_U4(v) __builtin_bit_cast(u32x4, v)

struct EpiInProj {
    static constexpr bool PERM = true;
    const float* rs1; const f32x2* rope; const float* glu_b;
    bf16_t *q, *k, *v, *qi, *ki, *hglu; float* wi;
    __device__ __forceinline__ void pre(AccRef acc, const Unit& u, int wr, int wc, int fr, int fq, const LAS unsigned char* mt) const {
        const int row0 = u.pm * BM + wr * 64 + fr;
        if (u.pn >= 4) {
            const int ch = 128 * (u.pn - 4) + 32 * wc + 8 * fq;
            f32x4 ba[2], bg[2];
#pragma unroll
            for (int n = 0; n < 2; ++n) { ba[n] = *(const f32x4*)(glu_b + ch + 4 * n); bg[n] = *(const f32x4*)(glu_b + 512 + ch + 4 * n); }
#pragma unroll
            for (int ai = 0; ai < 2; ++ai)
#pragma unroll
                for (int m = 0; m < 4; ++m) { const float rs = rs1[row0 + ai * HALF + m * 16];
#pragma unroll
                    for (int n = 0; n < 2; ++n)
#pragma unroll
                        for (int e = 0; e < 4; ++e) { const float a = acc[ai][0][m][n][e] * rs + ba[n][e], g = acc[ai][1][m][n][e] * rs + bg[n][e]; acc[ai][0][m][n][e] = a * sigmoidf_(g); }
                    pack8_bf16(acc[ai][0][m][0], acc[ai][0][m][1]); }
            return;
        }
        const bool do_rope = !(u.pn == 3 && wc >= 2), is_wi = (u.pn == 3 && wc == 3);
        const int d0 = 8 * fq;
#pragma unroll
        for (int ai = 0; ai < 2; ++ai)
#pragma unroll
            for (int m = 0; m < 4; ++m) { const int row = row0 + ai * HALF + m * 16; const float rs = rs1[row];
                if (do_rope) {
                    const f32x2* rp = rope + (size_t)(row & (SEQ - 1)) * 32 + d0;
#pragma unroll
                    for (int n = 0; n < 2; ++n)
#pragma unroll
                        for (int e = 0; e < 4; ++e) { const f32x2 cs = rp[4 * n + e]; const float x1 = acc[ai][0][m][n][e] * rs, x2 = acc[ai][1][m][n][e] * rs;
                            acc[ai][0][m][n][e] = x1 * cs.x - x2 * cs.y; acc[ai][1][m][n][e] = x2 * cs.x + x1 * cs.y; }
                } else {
#pragma unroll
                    for (int n = 0; n < 2; ++n) { acc[ai][0][m][n] = acc[ai][0][m][n] * rs; acc[ai][1][m][n] = acc[ai][1][m][n] * rs; }
                }
                if (!is_wi) { pack8_bf16(acc[ai][0][m][0], acc[ai][0][m][1]); pack8_bf16(acc[ai][1][m][0], acc[ai][1][m][1]); }
                if (m & 1) __builtin_amdgcn_sched_barrier(0); }
    }
    __device__ __forceinline__ void post(AccRef acc, const Unit& u, int wr, int wc, int fr, int fq, const LAS unsigned char* mt) const {
        const int row0 = u.pm * BM + wr * 64 + fr;
        if (u.pn >= 4) {
            const int ch = 128 * (u.pn - 4) + 32 * wc + 8 * fq;
#pragma unroll
            for (int ai = 0; ai < 2; ++ai)
#pragma unroll
                for (int m = 0; m < 4; ++m) *(u32x4*)(hglu + (size_t)(row0 + ai * HALF + m * 16) * 512 + ch) = AS_U4(acc[ai][0][m][0]);
            return;
        }
        bf16_t* dst; int ld, col; bool is_wi = false;
        if (u.pn < 2) { dst = q; ld = 512; col = (4 * u.pn + wc) * 64; }
        else if (u.pn == 2) { dst = qi; ld = 256; col = wc * 64; }
        else { ld = 64; col = 0; if (wc == 0) dst = k; else if (wc == 1) dst = ki; else if (wc == 2) dst = v; else { dst = v; is_wi = true; } }
        if (is_wi) {
            if (fq == 0) {
#pragma unroll
                for (int ai = 0; ai < 2; ++ai)
#pragma unroll
                    for (int m = 0; m < 4; ++m) *(f32x4*)(wi + (size_t)(row0 + ai * HALF + m * 16) * 4) = acc[ai][0][m][0];
            }
            return;
        }
#pragma unroll
        for (int ai = 0; ai < 2; ++ai)
#pragma unroll
            for (int m = 0; m < 4; ++m) { bf16_t* rp2 = dst + (size_t)(row0 + ai * HALF + m * 16) * ld + col + 8 * fq;
                *(u32x4*)(rp2) = AS_U4(acc[ai][0][m][0]); *(u32x4*)(rp2 + 32) = AS_U4(acc[ai][1][m][0]); }
    }
    __device__ __forceinline__ void run(const f32x4 (&acc)[2][2][4][2], const Unit& u, int wr, int wc, int fr, int fq, const LAS unsigned char* mt) const {
        const int row0 = u.pm * BM + wr * 64 + fr;
        if (u.pn >= 4) {
            const int ch = 128 * (u.pn - 4) + 32 * wc + 8 * fq;
            f32x4 ba[2], bg[2];
#pragma unroll
            for (int n = 0; n < 2; ++n) { ba[n] = *(const f32x4*)(glu_b + ch + 4 * n); bg[n] = *(const f32x4*)(glu_b + 512 + ch + 4 * n); }
#pragma unroll
            for (int ai = 0; ai < 2; ++ai)
#pragma unroll
                for (int m = 0; m < 4; ++m) { const int row = row0 + ai * HALF + m * 16; const float rs = rs1[row];
                    float o[8];
#pragma unroll
                    for (int n = 0; n < 2; ++n)
#pragma unroll
                        for (int e = 0; e < 4; ++e) { const float a = acc[ai][0][m][n][e] * rs + ba[n][e], g = acc[ai][1][m][n][e] * rs + bg[n][e]; o[4 * n + e] = a * sigmoidf_(g); }
                    u32x4 w; w.x = cvt_pk_bf16(o[0], o[1]); w.y = cvt_pk_bf16(o[2], o[3]); w.z = cvt_pk_bf16(o[4], o[5]); w.w = cvt_pk_bf16(o[6], o[7]);
                    *(u32x4*)(hglu + (size_t)row * 512 + ch) = w; }
            return;
        }
        bf16_t* dst; int ld, col; bool do_rope = true, is_wi = false;
        if (u.pn < 2) { dst = q; ld = 512; col = (4 * u.pn + wc) * 64; }
        else if (u.pn == 2) { dst = qi; ld = 256; col = wc * 64; }
        else { ld = 64; col = 0; if (wc == 0) dst = k; else if (wc == 1) dst = ki; else if (wc == 2) { dst = v; do_rope = false; } else { dst = v; is_wi = true; do_rope = false; } }
        if (is_wi) {
            if (fq == 0) {
#pragma unroll
                for (int ai = 0; ai < 2; ++ai)
#pragma unroll
                    for (int m = 0; m < 4; ++m) { const int row = row0 + ai * HALF + m * 16; const float rs = rs1[row];
                        *(f32x4*)(wi + (size_t)row * 4) = acc[ai][0][m][0] * rs; }
            }
            return;
        }
        const int d0 = 8 * fq;
#pragma unroll
        for (int ai = 0; ai < 2; ++ai)
#pragma unroll
            for (int m = 0; m < 4; ++m) { const int row = row0 + ai * HALF + m * 16; const float rs = rs1[row];
                float o1[8], o2[8];
                if (do_rope) {
                    const f32x4* rp = (const f32x4*)(rope + (size_t)(row & (SEQ - 1)) * 32 + d0);
#pragma unroll
                    for (int n = 0; n < 2; ++n)
#pragma unroll
                        for (int e2 = 0; e2 < 2; ++e2) { const f32x4 cs = rp[2 * n + e2];
                            { const float x1 = acc[ai][0][m][n][2 * e2] * rs, x2 = acc[ai][1][m][n][2 * e2] * rs; o1[4 * n + 2 * e2] = x1 * cs.x - x2 * cs.y; o2[4 * n + 2 * e2] = x2 * cs.x + x1 * cs.y; }
                            { const float x1 = acc[ai][0][m][n][2 * e2 + 1] * rs, x2 = acc[ai][1][m][n][2 * e2 + 1] * rs; o1[4 * n + 2 * e2 + 1] = x1 * cs.z - x2 * cs.w; o2[4 * n + 2 * e2 + 1] = x2 * cs.z + x1 * cs.w; } }
                } else {
#pragma unroll
                    for (int n = 0; n < 2; ++n)
#pragma unroll
                        for (int e = 0; e < 4; ++e) { o1[4 * n + e] = acc[ai][0][m][n][e] * rs; o2[4 * n + e] = acc[ai][1][m][n][e] * rs; }
                }
                u32x4 w1, w2; w1.x = cvt_pk_bf16(o1[0], o1[1]); w1.y = cvt_pk_bf16(o1[2], o1[3]); w1.z = cvt_pk_bf16(o1[4], o1[5]); w1.w = cvt_pk_bf16(o1[6], o1[7]);
                w2.x = cvt_pk_bf16(o2[0], o2[1]); w2.y = cvt_pk_bf16(o2[2], o2[3]); w2.z = cvt_pk_bf16(o2[4], o2[5]); w2.w = cvt_pk_bf16(o2[6], o2[7]);
                if (u.pn == 3 && wc == 1) {
                    bf16_t* tp = ki + ((size_t)(row >> 5) * 256 + (row & 31) + 32 * (fq & 1)) * 8;
                    *(u32x4*)(tp + (size_t)(fq >> 1) * 512) = w1; *(u32x4*)(tp + (size_t)(2 + (fq >> 1)) * 512) = w2;
                } else {
                    bf16_t* rp2 = dst + (size_t)row * ld + col + d0;
                    *(u32x4*)(rp2) = w1; *(u32x4*)(rp2 + 32) = w2; } }
    }
};

struct EpiBf16Plain {
    static constexpr bool PERM = true;
    bf16_t* O; int ldc; float scale;
    __device__ __forceinline__ void pre(AccRef acc, const Unit&, int, int, int, int, const LAS unsigned char*) const {
#pragma unroll
        for (int ai = 0; ai < 2; ++ai)
#pragma unroll
            for (int bj = 0; bj < 2; ++bj)
#pragma unroll
                for (int m = 0; m < 4; ++m) { acc[ai][bj][m][0] = acc[ai][bj][m][0] * scale; acc[ai][bj][m][1] = acc[ai][bj][m][1] * scale; pack8_bf16(acc[ai][bj][m][0], acc[ai][bj][m][1]); }
    }
    __device__ __forceinline__ void post(AccRef acc, const Unit& u, int wr, int wc, int fr, int fq, const LAS unsigned char* mt) const {
        const int row0 = u.pm * BM + wr * 64 + fr, col0 = u.pn * BM + wc * 32 + 8 * fq;
#pragma unroll
        for (int ai = 0; ai < 2; ++ai)
#pragma unroll
            for (int m = 0; m < 4; ++m) { bf16_t* rowp = O + (size_t)(row0 + ai * HALF + m * 16) * ldc + col0;
#pragma unroll
                for (int bj = 0; bj < 2; ++bj) *(u32x4*)(rowp + bj * HALF) = AS_U4(acc[ai][bj][m][0]); }
    }
    __device__ __forceinline__ void run(const f32x4 (&acc)[2][2][4][2], const Unit& u, int wr, int wc, int fr, int fq, const LAS unsigned char* mt) const {
        const int row0 = u.pm * BM + wr * 64 + fr, col0 = u.pn * BM + wc * 32 + 8 * fq;
#pragma unroll
        for (int ai = 0; ai < 2; ++ai)
#pragma unroll
            for (int m = 0; m < 4; ++m) { bf16_t* rowp = O + (size_t)(row0 + ai * HALF + m * 16) * ldc + col0;
#pragma unroll
                for (int bj = 0; bj < 2; ++bj) { const f32x4 v0 = acc[ai][bj][m][0] * scale, v1 = acc[ai][bj][m][1] * scale;
                    u32x4 w; w.x = cvt_pk_bf16(v0[0], v0[1]); w.y = cvt_pk_bf16(v0[2], v0[3]); w.z = cvt_pk_bf16(v1[0], v1[1]); w.w = cvt_pk_bf16(v1[2], v1[3]);
                    *(u32x4*)(rowp + bj * HALF) = w; } }
    }
};

struct EpiF8Plain {
    static constexpr bool PERM = true;
    unsigned char* O; int ldc; float scale;
    __device__ __forceinline__ void pre(AccRef acc, const Unit&, int, int, int, int, const LAS unsigned char*) const {}
    __device__ __forceinline__ void post(AccRef acc, const Unit& u, int wr, int wc, int fr, int fq, const LAS unsigned char* mt) const {
        const int row0 = u.pm * BM + wr * 64 + fr, col0 = u.pn * BM + wc * 32 + 8 * fq;
#pragma unroll
        for (int ai = 0; ai < 2; ++ai)
#pragma unroll
            for (int m = 0; m < 4; ++m) { unsigned char* rowp = O + (size_t)(row0 + ai * HALF + m * 16) * ldc + col0;
#pragma unroll
                for (int bj = 0; bj < 2; ++bj) { const f32x4 v0 = acc[ai][bj][m][0] * scale, v1 = acc[ai][bj][m][1] * scale;
                    u32x2 w; w.x = pk4_fp8(v0[0], v0[1], v0[2], v0[3]); w.y = pk4_fp8(v1[0], v1[1], v1[2], v1[3]);
                    *(u32x2*)(rowp + bj * HALF) = w; } }
    }
    __device__ __forceinline__ void run(AccRef acc, const Unit& u, int wr, int wc, int fr, int fq, const LAS unsigned char* mt) const { post(acc, u, wr, wc, fr, fq, mt); }
};

struct EpiOutProj {
    static constexpr bool PERM = false;
    const float* x; float* h1; unsigned char* h1f8;
    __device__ __forceinline__ void pre(AccRef acc, const Unit& u, int wr, int wc, int fr, int fq, const LAS unsigned char* mt) const {
        const int row0 = u.pm * BM + wr * 64 + fr, col0 = u.pn * BM + wc * 32 + 4 * fq;
#pragma unroll
        for (int ai = 0; ai < 2; ++ai)
#pragma unroll
            for (int m = 0; m < 4; ++m) { const size_t off = (size_t)(row0 + ai * HALF + m * 16) * DM + col0;
#pragma unroll
                for (int bj = 0; bj < 2; ++bj)
#pragma unroll
                    for (int n = 0; n < 2; ++n) acc[ai][bj][m][n] += *(const f32x4*)(x + off + bj * HALF + n * 16);
                if (m & 1) __builtin_amdgcn_sched_barrier(0); }
    }
    __device__ __forceinline__ void post(AccRef acc, const Unit& u, int wr, int wc, int fr, int fq, const LAS unsigned char* mt) const {
        const int row0 = u.pm * BM + wr * 64 + fr, col0 = u.pn * BM + wc * 32 + 4 * fq;
#pragma unroll
        for (int ai = 0; ai < 2; ++ai)
#pragma unroll
            for (int m = 0; m < 4; ++m) { const size_t off = (size_t)(row0 + ai * HALF + m * 16) * DM + col0;
#pragma unroll
                for (int bj = 0; bj < 2; ++bj)
#pragma unroll
                    for (int n = 0; n < 2; ++n) { const size_t o = off + bj * HALF + n * 16; const f32x4 r = acc[ai][bj][m][n];
                        *(f32x4*)(h1 + o) = r; *(unsigned*)(h1f8 + o) = pk4_fp8(r[0], r[1], r[2], r[3]); } }
    }
    __device__ __forceinline__ void run(AccRef acc, const Unit& u, int wr, int wc, int fr, int fq, const LAS unsigned char* mt) const { pre(acc, u, wr, wc, fr, fq, mt); post(acc, u, wr, wc, fr, fq, mt); }
};

struct EpiUp {
    static constexpr bool PERM = true;
    unsigned char* act;
    __device__ __forceinline__ void pre(AccRef acc, const Unit& u, int wr, int wc, int fr, int fq, const LAS unsigned char* mt) const {
        const int r0 = wr * 64 + fr, cl = 32 * wc + 8 * fq;
        const LAS float* rowA = (const LAS float*)mt; const LAS float* bias = (const LAS float*)(mt + 2048);
        f32x4 bg[2], bl[2];
#pragma unroll
        for (int n = 0; n < 2; ++n) { bg[n] = *(const LAS f32x4*)(bias + cl + 4 * n); bl[n] = *(const LAS f32x4*)(bias + 128 + cl + 4 * n); }
#pragma unroll
        for (int ai = 0; ai < 2; ++ai)
#pragma unroll
            for (int m = 0; m < 4; ++m) { const int r = r0 + ai * HALF + m * 16;
                const float rs = (r < u.rows) ? rowA[r] * 0.03125f : 0.f;
#pragma unroll
                for (int n = 0; n < 2; ++n)
#pragma unroll
                    for (int e = 0; e < 4; ++e) { float g = acc[ai][0][m][n][e] * rs + bg[n][e], l = acc[ai][1][m][n][e] * rs + bl[n][e];
                        g = fminf(g, 7.0f); l = fminf(fmaxf(l, -7.0f), 7.0f); acc[ai][0][m][n][e] = g * sigmoidf_(1.702f * g) * (l + 1.0f); } }
    }
    __device__ __forceinline__ void post(AccRef acc, const Unit& u, int wr, int wc, int fr, int fq, const LAS unsigned char* mt) const {
        const int r0 = wr * 64 + fr, ch = 128 * u.pn + 32 * wc + 8 * fq;
#pragma unroll
        for (int ai = 0; ai < 2; ++ai)
#pragma unroll
            for (int m = 0; m < 4; ++m) { const int r = r0 + ai * HALF + m * 16;
                const f32x4 v0 = acc[ai][0][m][0], v1 = acc[ai][0][m][1];
                u32x2 w; w.x = pk4_fp8(v0[0], v0[1], v0[2], v0[3]); w.y = pk4_fp8(v1[0], v1[1], v1[2], v1[3]);
                *(u32x2*)(act + (size_t)(u.pm * BM + r) * 1024 + ch) = w; }
    }
    __device__ __forceinline__ void run(const f32x4 (&acc)[2][2][4][2], const Unit& u, int wr, int wc, int fr, int fq, const LAS unsigned char* mt) const {
        const int r0 = wr * 64 + fr, cl = 32 * wc + 8 * fq, ch = 128 * u.pn + cl;
        const LAS float* rowA = (const LAS float*)mt; const LAS float* bias = (const LAS float*)(mt + 2048);
        f32x4 bg[2], bl[2];
#pragma unroll
        for (int n = 0; n < 2; ++n) { bg[n] = *(const LAS f32x4*)(bias + cl + 4 * n); bl[n] = *(const LAS f32x4*)(bias + 128 + cl + 4 * n); }
#pragma unroll
        for (int ai = 0; ai < 2; ++ai)
#pragma unroll
            for (int m = 0; m < 4; ++m) { const int r = r0 + ai * HALF + m * 16;
                const float rs = (r < u.rows) ? rowA[r] * 0.03125f : 0.f;
                float o[8];
#pragma unroll
                for (int n = 0; n < 2; ++n)
#pragma unroll
                    for (int e = 0; e < 4; ++e) { float g = acc[ai][0][m][n][e] * rs + bg[n][e], l = acc[ai][1][m][n][e] * rs + bl[n][e];
                        g = fminf(g, 7.0f); l = fminf(fmaxf(l, -7.0f), 7.0f); o[4 * n + e] = g * sigmoidf_(1.702f * g) * (l + 1.0f); }
                u32x2 w; w.x = pk4_fp8(o[0], o[1], o[2], o[3]); w.y = pk4_fp8(o[4], o[5], o[6], o[7]);
                *(u32x2*)(act + (size_t)(u.pm * BM + r) * 1024 + ch) = w; }
    }
};

struct EpiDown {
    static constexpr bool PERM = true;
    unsigned char* y;
    __device__ __forceinline__ void pre(AccRef acc, const Unit& u, int wr, int wc, int fr, int fq, const LAS unsigned char* mt) const {
        const int r0 = wr * 64 + fr, cl = wc * 32 + 8 * fq;
        const LAS float* gateT = (const LAS float*)(mt + 1024); const LAS float* bias = (const LAS float*)(mt + 2048);
        float gt[2][4];
#pragma unroll
        for (int ai = 0; ai < 2; ++ai)
#pragma unroll
            for (int m = 0; m < 4; ++m) gt[ai][m] = gateT[r0 + ai * HALF + m * 16] * 16.0f;
#pragma unroll
        for (int bj = 0; bj < 2; ++bj) { const f32x4 bv0 = *(const LAS f32x4*)(bias + cl + bj * HALF), bv1 = *(const LAS f32x4*)(bias + cl + bj * HALF + 4);
#pragma unroll
            for (int ai = 0; ai < 2; ++ai)
#pragma unroll
                for (int m = 0; m < 4; ++m) { acc[ai][bj][m][0] = (acc[ai][bj][m][0] * 0.03125f + bv0) * gt[ai][m]; acc[ai][bj][m][1] = (acc[ai][bj][m][1] * 0.03125f + bv1) * gt[ai][m]; } }
    }
    __device__ __forceinline__ void post(AccRef acc, const Unit& u, int wr, int wc, int fr, int fq, const LAS unsigned char* mt) const {
        const int r0 = wr * 64 + fr, col0 = u.pn * BM + wc * 32 + 8 * fq;
        const LAS int* slotT = (const LAS int*)mt;
#pragma unroll
        for (int ai = 0; ai < 2; ++ai)
#pragma unroll
            for (int m = 0; m < 4; ++m) { const int r = r0 + ai * HALF + m * 16;
                if (r < u.rows) { unsigned char* rowp = y + (size_t)slotT[r] * 1024 + col0;
#pragma unroll
                    for (int bj = 0; bj < 2; ++bj) { const f32x4 v0 = acc[ai][bj][m][0], v1 = acc[ai][bj][m][1];
                        u32x2 w; w.x = pk4_fp8(v0[0], v0[1], v0[2], v0[3]); w.y = pk4_fp8(v1[0], v1[1], v1[2], v1[3]);
                        *(u32x2*)(rowp + bj * HALF) = w; } } }
    }
    __device__ __forceinline__ void run(AccRef acc, const Unit& u, int wr, int wc, int fr, int fq, const LAS unsigned char* mt) const { pre(acc, u, wr, wc, fr, fq, mt); post(acc, u, wr, wc, fr, fq, mt); }
};

template <bool F8>
__device__ __forceinline__ void p0_transpose_item(const float* W, int ldw, void* WTv, int Kdim, const float* gain, LAS float* scr, int kb, int n0, int src0, int nvalid, int lane) {
    bf16_t* WT = (bf16_t*)WTv;
    const int k0 = 64 * kb;
    f32x4 ld4[8];
#pragma unroll
    for (int i = 0; i < 8; ++i) { const int kk = 8 * i + (lane >> 3), j = (lane & 7) * 4;
        ld4[i] = (f32x4){0.f, 0.f, 0.f, 0.f}; if (j < nvalid) ld4[i] = *(const f32x4*)(W + (size_t)(k0 + kk) * ldw + src0 + j); }
#pragma unroll
    for (int i = 0; i < 8; ++i) { const int kk = 8 * i + (lane >> 3), j = (lane & 7) * 4; const float gk = (gain ? gain[k0 + kk] : 1.0f) * (F8 ? 32.0f : 1.0f);
        LAS float* d = scr + kk * 33 + j; d[0] = ld4[i].x * gk; d[1] = ld4[i].y * gk; d[2] = ld4[i].z * gk; d[3] = ld4[i].w * gk; }
    LDS_WAIT(); asm volatile("" ::: "memory");
    const int c = lane & 7;
#pragma unroll
    for (int j = 0; j < 4; ++j) { const int n = (lane >> 3) + 8 * j; const LAS float* s = scr + (8 * c) * 33 + n;
        if constexpr (F8) { u32x2 o; o.x = pk4_fp8(s[0 * 33], s[1 * 33], s[2 * 33], s[3 * 33]); o.y = pk4_fp8(s[4 * 33], s[5 * 33], s[6 * 33], s[7 * 33]);
            *(u32x2*)((unsigned char*)WTv + (size_t)(n0 + n) * Kdim + k0 + 8 * c) = o; }
        else { u32x4 o; o.x = pk2(s[0 * 33], s[1 * 33]); o.y = pk2(s[2 * 33], s[3 * 33]); o.z = pk2(s[4 * 33], s[5 * 33]); o.w = pk2(s[6 * 33], s[7 * 33]);
            *(u32x4*)(WT + (size_t)(n0 + n) * Kdim + k0 + 8 * c) = o; } }
    LDS_WAIT(); asm volatile("" ::: "memory");
}
__device__ __forceinline__ void win_colmap(int nb, int& src0, int& nvalid) {
    const int pn = nb >> 3, j = (nb & 7) * 32, bj = j >> 7, slot = (j & 127) >> 5;
    nvalid = 32;
    if (pn < 2) src0 = (4 * pn + slot) * 64 + 32 * bj;
    else if (pn == 2) src0 = 640 + slot * 64 + 32 * bj;
    else if (pn == 3) { if (slot == 0) src0 = 512 + 32 * bj; else if (slot == 1) src0 = 896 + 32 * bj; else if (slot == 2) src0 = 576 + 32 * bj; else { src0 = 960; nvalid = bj == 0 ? 4 : 0; } }
    else src0 = 964 + 512 * bj + 128 * (pn - 4) + 32 * slot;
}
__device__ __forceinline__ void p0_prologue(const Params& P, LAS unsigned char* lds, int vcu, int G, int wave, int lane) {
    unsigned char* ws = P.ws;
    LAS float* scr = (LAS float*)(lds + wave * 16384);
    const int gw = vcu * NWAVES + wave, NGW = G * NWAVES;
    constexpr int I_IN = 16 * 64, I_OUT = 16 * 32, I_G = 16 * 32, I_P = 4 * 32;
    constexpr int NITEMS = I_IN + I_OUT + I_G + I_P;
    for (int it = gw; it < NITEMS; it += NGW) {
        int r = it;
        if (r < I_IN) { const int kb = r / 64, nb = r % 64; int s0, nv; win_colmap(nb, s0, nv); p0_transpose_item<false>(P.w_in, INW, (bf16_t*)(ws + WS_WIN), 1024, P.g_mix, scr, kb, nb * 32, s0, nv, lane); continue; } r -= I_IN;
        if (r < I_OUT) { const int kb = r / 32, nb = r % 32; p0_transpose_item<false>(P.w_out, 1024, (bf16_t*)(ws + WS_WOUT), 1024, nullptr, scr, kb, nb * 32, nb * 32, 32, lane); continue; } r -= I_OUT;
        if (r < I_G) { const int kb = r / 32, nb = r % 32; p0_transpose_item<true>(P.w_ple_gate, 1024, (unsigned char*)(ws + WS_WG), 1024, P.g_ple, scr, kb, nb * 32, nb * 32, 32, lane); continue; } r -= I_G;
        { const int kb = r / 32, nb = r % 32; p0_transpose_item<false>(P.w_ple_proj, 1024, (bf16_t*)(ws + WS_WP), 256, nullptr, scr, kb, nb * 32, nb * 32, 32, lane); }
    }
    float* rs1 = (float*)(ws + WS_RS1); bf16_t* xb = (bf16_t*)(ws + WS_XB);
    for (int m = gw; m < NTOK; m += NGW) {
        const f32x4* xr = (const f32x4*)(P.x + (size_t)m * DM) + lane; f32x4 v[4]; float s = 0.f;
#pragma unroll
        for (int j = 0; j < 4; ++j) { v[j] = xr[64 * j]; s += (v[j].x * v[j].x + v[j].y * v[j].y) + (v[j].z * v[j].z + v[j].w * v[j].w); }
        s = wave_sum(s);
        u32x2* o8 = (u32x2*)(xb + (size_t)m * DM) + lane;
#pragma unroll
        for (int j = 0; j < 4; ++j) { u32x2 w; w.x = pk2(v[j].x, v[j].y); w.y = pk2(v[j].z, v[j].w); o8[64 * j] = w; }
        if (lane == 0) rs1[m] = 1.0f / sqrtf(s * (1.0f / DM) + EPS);
    }
    bf16_t* pb = (bf16_t*)(ws + WS_PB);
    for (int m = gw; m < NTOK; m += NGW) { const f32x4 v = *((const f32x4*)(P.p + (size_t)m * 256) + lane); u32x2 w; w.x = pk2(v.x, v.y); w.y = pk2(v.z, v.w); *((u32x2*)(pb + (size_t)m * 256) + lane) = w; }
    f32x2* rope = (f32x2*)(ws + WS_ROPE);
    for (int idx = gw * 64 + lane; idx < SEQ * 32; idx += NGW * 64) { const int t = idx >> 5, i = idx & 31;
        const float inv = exp2f(-(float)i * (13.287712379549449f / 32.0f));
        const float ang = (float)t * inv;
        const double rev = (double)ang * 0.15915494309189535; const float fr = (float)(rev - __builtin_floor(rev));
        rope[idx] = (f32x2){__builtin_amdgcn_cosf(fr), __builtin_amdgcn_sinf(fr)}; }
    float* wrg = (float*)(ws + WS_WRG);
    for (int idx = gw * 64 + lane; idx < 1024 * 32; idx += NGW * 64) wrg[idx] = P.w_router[idx] * P.g_ffn[idx >> 5];
}

__device__ __forceinline__ unsigned fkey(float f) { unsigned u = __builtin_bit_cast(unsigned, f); if (u == 0x80000000u) u = 0u; return u ^ ((unsigned)((int)u >> 31) | 0x80000000u); }
__device__ __forceinline__ int mbcnt64(unsigned long long m) { return __builtin_amdgcn_mbcnt_hi((unsigned)(m >> 32), __builtin_amdgcn_mbcnt_lo((unsigned)m, 0u)); }

template <int NR>
__device__ __forceinline__ unsigned bisect_thr(const unsigned (&v)[NR], unsigned prefix, int startbit) {
    bool exact = false;
#pragma unroll 1
    for (int bit = startbit; bit >= 0; --bit) {
        const unsigned cand = prefix | (1u << bit); int cnt = 0;
#pragma unroll
        for (int r = 0; r < NR; ++r) { cnt += __builtin_popcountll(__ballot(v[r] >= cand)); if ((r & 7) == 7) __builtin_amdgcn_sched_barrier(0); }
        if (cnt >= NSEL) prefix = cand;
        if (cnt == NSEL) { exact = true; break; }
    }
    return exact ? prefix - 1u : prefix;
}
template <int NR, bool EXPL>
__device__ __forceinline__ void compact_sel(const unsigned (&v)[NR], const unsigned (&ci)[NR], unsigned T, LAS unsigned* list, int lane) {
    int cgt = 0;
#pragma unroll
    for (int r = 0; r < NR; ++r) { cgt += __builtin_popcountll(__ballot(v[r] > T)); if ((r & 7) == 7) __builtin_amdgcn_sched_barrier(0); }
    const int need = NSEL - cgt; int base = 0, ties = 0;
#pragma unroll
    for (int r = 0; r < NR; ++r) { const bool gt = v[r] > T, eq = v[r] == T; const unsigned long long em = __ballot(eq);
        const bool sel = gt || (eq && (ties + mbcnt64(em)) < need); const unsigned long long sm = __ballot(sel);
        list[sel ? base + mbcnt64(sm) : NSEL + lane] = EXPL ? ci[r] : (unsigned)(r * 64 + lane);
        base += __builtin_popcountll(sm); ties += __builtin_popcountll(em);
        if ((r & 3) == 3) __builtin_amdgcn_sched_barrier(0); }
}
constexpr int SEL_CAP = 1024;
template <int NR>
__device__ __forceinline__ void select_topk(LAS float* row, LAS unsigned* H, LAS unsigned* list, int lane, bool zero_h) {
    unsigned v[NR];
#pragma unroll
    for (int r = 0; r < NR; ++r) v[r] = fkey(row[r * 64 + lane]);
    LAS u32x4* H4 = (LAS u32x4*)H;
    const u32x4 h0 = H4[2 * lane], h1 = H4[2 * lane + 1];
    if (zero_h) { H4[2 * lane] = (u32x4){0u, 0u, 0u, 0u}; H4[2 * lane + 1] = (u32x4){0u, 0u, 0u, 0u}; }
    const unsigned hw[8] = {h0.x, h0.y, h0.z, h0.w, h1.x, h1.y, h1.z, h1.w};
    unsigned c[16];
#pragma unroll
    for (int i = 0; i < 8; ++i) { c[2 * i] = hw[i] & 0xffffu; c[2 * i + 1] = hw[i] >> 16; }
    unsigned s = 0u;
#pragma unroll
    for (int i = 0; i < 16; ++i) s += c[i];
    unsigned S = s;
#pragma unroll
    for (int off = 1; off < 64; off <<= 1) { const unsigned o = __shfl_down(S, off); if (lane + off < 64) S += o; }
    const unsigned long long okm = __ballot(S >= (unsigned)NSEL);
    bool fast = okm != 0ull; unsigned floorkey = 0u; int C = 0;
    if (fast) {
        const int Ls = 63 - __builtin_clzll(okm);
        unsigned acc = S - s; int bl = -1; unsigned accb = 0u;
#pragma unroll
        for (int b = 15; b >= 0; --b) { acc += c[b]; if (bl < 0 && acc >= (unsigned)NSEL) { bl = b; accb = acc; } }
        const int bstar = __shfl(bl, Ls) + 16 * Ls; C = (int)__shfl(accb, Ls);
        floorkey = (unsigned)bstar << 22;
        fast = (bstar > 1) && (C <= SEL_CAP);
    }
    if (!fast) {
        const unsigned T = bisect_thr<NR>(v, 0u, 31);
        compact_sel<NR, false>(v, v, T, list, lane);
        return;
    }
    LAS unsigned* ckl = (LAS unsigned*)row; LAS unsigned* cil = ckl + 1152;
    { int base = 0;
#pragma unroll
      for (int r = 0; r < NR; ++r) { const bool cnd = v[r] >= floorkey; const unsigned long long m = __ballot(cnd);
          const int pos = cnd ? base + mbcnt64(m) : SEL_CAP + lane;
          ckl[pos] = v[r]; cil[pos] = (unsigned)(r * 64 + lane); base += __builtin_popcountll(m);
          if ((r & 3) == 3) __builtin_amdgcn_sched_barrier(0); } }
    if (C <= 512) {
        unsigned ck[8], ci[8];
#pragma unroll
        for (int j = 0; j < 8; ++j) { const int i = j * 64 + lane; ck[j] = i < C ? ckl[i] : 0u; ci[j] = cil[i]; }
        const unsigned T = (C == NSEL) ? floorkey - 1u : bisect_thr<8>(ck, floorkey, 21);
        compact_sel<8, true>(ck, ci, T, list, lane);
    } else {
        unsigned ck[16], ci[16];
#pragma unroll
        for (int j = 0; j < 16; ++j) { const int i = j * 64 + lane; ck[j] = i < C ? ckl[i] : 0u; ci[j] = cil[i]; }
        const unsigned T = bisect_thr<16>(ck, floorkey, 21);
        compact_sel<16, true>(ck, ci, T, list, lane);
    }
}

typedef short v4i16 __attribute__((ext_vector_type(4)));
constexpr int VROW = 144;

__device__ __forceinline__ void attn_tile(const Params& P, LAS unsigned char* lds, int b, int t0, int wave, int lane) {
    unsigned char* ws = P.ws;
    const bf16_t* QI = (const bf16_t*)(ws + WS_QI); const bf16_t* KI = (const bf16_t*)(ws + WS_KI);
    const bf16_t* Q = (const bf16_t*)(ws + WS_Q); const bf16_t* Kp = (const bf16_t*)(ws + WS_K); const bf16_t* Vp = (const bf16_t*)(ws + WS_V);
    const float* WI = (const float*)(ws + WS_WI); bf16_t* MIX = (bf16_t*)(ws + WS_MIX);
    LAS float* SC = (LAS float*)lds;
    LAS unsigned* list = (LAS unsigned*)(lds + wave * 16384 + 14336);
    LAS unsigned* HIST = (LAS unsigned*)(lds + LDS_MISC);
    const int tokbase = b * SEQ;
    const bool need_sel = t0 >= 256;
    if (need_sel) {
        const int nkt = (t0 + 8 + 31) >> 5;
        bf16x8 a[4]; f32x4 w[4];
        { const bf16_t* src = QI + (size_t)(tokbase + t0 + ((lane & 31) >> 2)) * 256 + (lane & 3) * 64 + 8 * (lane >> 5);
#pragma unroll
          for (int ks = 0; ks < 4; ++ks) a[ks] = *(const bf16x8*)(src + 16 * ks); }
#pragma unroll
        for (int g = 0; g < 4; ++g) w[g] = *(const f32x4*)(WI + (size_t)(tokbase + t0 + 2 * g + (lane >> 5)) * 4);
        for (int kt0 = wave; kt0 < nkt; kt0 += 4 * NWAVES) {
            bf16x8 bf[4][4];
#pragma unroll
            for (int u = 0; u < 4; ++u) { const int kt = kt0 + u * NWAVES;
                if (kt < nkt) { const bf16_t* ksrc = KI + ((size_t)((tokbase >> 5) + kt) * 256 + lane) * 8;
#pragma unroll
                    for (int ks = 0; ks < 4; ++ks) bf[u][ks] = *(const bf16x8*)(ksrc + 512 * ks); } }
#pragma unroll
            for (int u = 0; u < 4; ++u) { const int kt = kt0 + u * NWAVES;
                if (kt < nkt) {
                    const int key = kt * 32 + (lane & 31);
                    f32x16 acc;
#pragma unroll
                    for (int i = 0; i < 16; ++i) acc[i] = 0.f;
#pragma unroll
                    for (int ks = 0; ks < 4; ++ks) acc = __builtin_amdgcn_mfma_f32_32x32x16_bf16(a[ks], bf[u][ks], acc, 0, 0, 0);
#pragma unroll
                    for (int g = 0; g < 4; ++g) { float sc = 0.f;
#pragma unroll
                        for (int h = 0; h < 4; ++h) sc = fmaf(fmaxf(acc[4 * g + h], 0.f), w[g][h], sc);
                        const int ql = 2 * g + (lane >> 5);
                        if (key > t0 + ql) sc = -INFINITY;
                        SC[ql * 4096 + key] = sc;
                        if (key <= t0 + ql) { const unsigned ub = __builtin_bit_cast(unsigned, sc);
                            const unsigned bin = (ub >> 22) ^ (((unsigned)((int)ub >> 31) & 0x1ffu) | 0x200u);
                            __hip_atomic_fetch_add(HIST + ql * 512 + (bin >> 1), 1u << ((bin & 1u) << 4), __ATOMIC_RELAXED, __HIP_MEMORY_SCOPE_WORKGROUP); } }
                } }
        }
        { const int npad = ((t0 + 8 + 1023) >> 10) << 10;
          for (int i = nkt * 32 + (int)threadIdx.x; i < npad; i += NTHR) {
#pragma unroll
              for (int q = 0; q < 8; ++q) SC[q * 4096 + i] = -INFINITY; } }
    }
    __syncthreads();
    const int t = t0 + wave, tok = tokbase + t;
    if (need_sel) {
        LAS float* row = SC + wave * 4096; LAS unsigned* H = HIST + wave * 512; const int n = t + 1;
        if (n <= 1024) select_topk<16>(row, H, list, lane, true);
        else if (n <= 2048) select_topk<32>(row, H, list, lane, true);
        else if (n <= 3072) select_topk<48>(row, H, list, lane, true);
        else select_topk<64>(row, H, list, lane, true);
    } else {
#pragma unroll
        for (int i = 0; i < 4; ++i) list[i * 64 + lane] = (unsigned)(i * 64 + lane);
    }
    const int nvalid = need_sel ? NSEL : (t + 1);
    const int ngrp = (nvalid + 31) >> 5;
    const int hd = lane & 15, g = lane >> 4;
    bf16x8 qf0, qf1;
#pragma unroll
    for (int i = 0; i < 8; ++i) { qf0[i] = 0; qf1[i] = 0; }
    if (hd < 8) { const bf16_t* qs = Q + (size_t)tok * 512 + hd * 64 + 8 * g; qf0 = *(const bf16x8*)qs; qf1 = *(const bf16x8*)(qs + 32); }
    float m = -INFINITY, ssum = 0.f;
    f32x4 o[4];
#pragma unroll
    for (int dt = 0; dt < 4; ++dt) o[dt] = (f32x4){0.f, 0.f, 0.f, 0.f};
    LAS unsigned char* vreg = lds + wave * 16384;
    u32x4 kfA[4], kfB[4]; u32x4 vvA[4], vvB[4];
    LAS unsigned char* kbuf = vreg + 9216;
#define ATT_LOAD(KF, VV, G_) do { const int nb_ = (G_) * 32; \
        _Pragma("unroll") for (int i_ = 0; i_ < 4; ++i_) { const unsigned idx_ = list[nb_ + (lane >> 3) + 8 * i_]; const size_t ro_ = (size_t)(tokbase + idx_) * 64 + 8 * (lane & 7); \
            KF[i_] = *(const u32x4*)(Kp + ro_); VV[i_] = *(const u32x4*)(Vp + ro_); } } while (0)
#define ATT_GROUP(KF, VV, G_, VBUF) do { \
        LAS unsigned char* vbuf_ = (VBUF); \
        _Pragma("unroll") for (int i_ = 0; i_ < 4; ++i_) *(LAS u32x4*)(kbuf + ((lane >> 3) + 8 * i_) * VROW + (lane & 7) * 16) = KF[i_]; \
        const LAS unsigned char* kr_ = kbuf + hd * VROW + 16 * g; \
        const bf16x8 ka0_ = *(const LAS bf16x8*)kr_, ka1_ = *(const LAS bf16x8*)(kr_ + 64), kb0_ = *(const LAS bf16x8*)(kr_ + 16 * VROW), kb1_ = *(const LAS bf16x8*)(kr_ + 16 * VROW + 64); \
        f32x4 sa_ = {0.f, 0.f, 0.f, 0.f}, sb_ = {0.f, 0.f, 0.f, 0.f}; \
        sa_ = __builtin_amdgcn_mfma_f32_16x16x32_bf16(ka0_, qf0, sa_, 0, 0, 0); sa_ = __builtin_amdgcn_mfma_f32_16x16x32_bf16(ka1_, qf1, sa_, 0, 0, 0); \
        sb_ = __builtin_amdgcn_mfma_f32_16x16x32_bf16(kb0_, qf0, sb_, 0, 0, 0); sb_ = __builtin_amdgcn_mfma_f32_16x16x32_bf16(kb1_, qf1, sb_, 0, 0, 0); \
        _Pragma("unroll") for (int i_ = 0; i_ < 4; ++i_) *(LAS u32x4*)(vbuf_ + ((lane >> 3) + 8 * i_) * VROW + (lane & 7) * 16) = VV[i_]; \
        if ((G_) + 2 < ngrp) ATT_LOAD(KF, VV, (G_) + 2); \
        float l_[8]; float mloc_ = -INFINITY; \
        _Pragma("unroll") for (int r_ = 0; r_ < 4; ++r_) { const int sl_ = (G_) * 32 + 4 * g + r_; \
            l_[r_] = sl_ < nvalid ? sa_[r_] * 0.125f : -INFINITY; l_[4 + r_] = (sl_ + 16) < nvalid ? sb_[r_] * 0.125f : -INFINITY; \
            mloc_ = fmaxf(mloc_, fmaxf(l_[r_], l_[4 + r_])); } \
        mloc_ = fmaxf(mloc_, __shfl_xor(mloc_, 16)); mloc_ = fmaxf(mloc_, __shfl_xor(mloc_, 32)); \
        const float mnew_ = fmaxf(m, mloc_), alpha_ = __expf(m - mnew_); m = mnew_; \
        float ps_ = 0.f; \
        _Pragma("unroll") for (int r_ = 0; r_ < 8; ++r_) { l_[r_] = __expf(l_[r_] - mnew_); ps_ += l_[r_]; } \
        ssum = ssum * alpha_ + ps_; \
        bf16x8 pf_; \
        { const u32x4 pw_ = {cvt_pk_bf16(l_[0], l_[1]), cvt_pk_bf16(l_[2], l_[3]), cvt_pk_bf16(l_[4], l_[5]), cvt_pk_bf16(l_[6], l_[7])}; pf_ = __builtin_bit_cast(bf16x8, pw_); } \
        LAS unsigned char* ta_ = vbuf_ + (4 * g + (hd >> 2)) * VROW + (hd & 3) * 8; \
        _Pragma("unroll") for (int dt_ = 0; dt_ < 4; ++dt_) { \
            const v4i16 lo_ = __builtin_amdgcn_ds_read_tr16_b64_v4i16((LAS v4i16*)(ta_ + dt_ * 32)); \
            const v4i16 hi_ = __builtin_amdgcn_ds_read_tr16_b64_v4i16((LAS v4i16*)(ta_ + 16 * VROW + dt_ * 32)); \
            bf16x8 vf_; vf_[0] = lo_[0]; vf_[1] = lo_[1]; vf_[2] = lo_[2]; vf_[3] = lo_[3]; vf_[4] = hi_[0]; vf_[5] = hi_[1]; vf_[6] = hi_[2]; vf_[7] = hi_[3]; \
            o[dt_] = __builtin_amdgcn_mfma_f32_16x16x32_bf16(vf_, pf_, o[dt_] * alpha_, 0, 0, 0); } } while (0)
    ATT_LOAD(kfA, vvA, 0);
    if (ngrp > 1) ATT_LOAD(kfB, vvB, 1);
#pragma unroll 1
    for (int grp = 0; grp < ngrp; grp += 2) {
        ATT_GROUP(kfA, vvA, grp, vreg);
        if (grp + 1 < ngrp) ATT_GROUP(kfB, vvB, grp + 1, vreg + 4608);
    }
#undef ATT_LOAD
#undef ATT_GROUP
    ssum += __shfl_xor(ssum, 16); ssum += __shfl_xor(ssum, 32);
    const float inv = 1.0f / ssum;
    if (hd < 8) {
        bf16_t* op = MIX + (size_t)tok * 1024 + hd * 64 + 4 * g;
#pragma unroll
        for (int dt = 0; dt < 4; ++dt) { u32x2 w; w.x = cvt_pk_bf16(o[dt][0] * inv, o[dt][1] * inv); w.y = cvt_pk_bf16(o[dt][2] * inv, o[dt][3] * inv); *(u32x2*)(op + 16 * dt) = w; }
    }
    __syncthreads();
}

__device__ __forceinline__ void conv_tile(const Params& P, LAS unsigned char* lds, int tile, int tid, int wave, int lane) {
    unsigned char* ws = P.ws;
    const bf16_t* HG = (const bf16_t*)(ws + WS_HGLU); bf16_t* MIX = (bf16_t*)(ws + WS_MIX);
    LAS f32x2* part = (LAS f32x2*)(lds + LDS_MISC + 1024);
    LAS f32x2* stat = part + 256;
    LAS bf16_t* Lin = (LAS bf16_t*)lds;
    LAS bf16_t* Lout = (LAS bf16_t*)(lds + 65536);
    const int tok0 = tile * 32, t0 = tok0 & (SEQ - 1), c = tid;
    for (int ch = tid; ch < 62 * 64; ch += NTHR) { const int r = ch >> 6, cc = ch & 63; const int tt = t0 - 30 + r;
        u32x4 v = {0u, 0u, 0u, 0u}; if (tt >= 0) v = *(const u32x4*)(HG + (size_t)(tok0 - 30 + r) * 512 + cc * 8);
        *(LAS u32x4*)(Lin + r * 512 + cc * 8) = v; }
    __syncthreads();
    float in[62];
#pragma unroll
    for (int r = 0; r < 62; ++r) in[r] = __builtin_bit_cast(float, (unsigned)Lin[r * 512 + c] << 16);
    float out[32];
    const float bias = P.dw_b[c];
#pragma unroll
    for (int i = 0; i < 32; ++i) out[i] = bias;
#pragma unroll
    for (int j = 0; j < 31; ++j) { const float wj = P.dw_w[j * 512 + c];
#pragma unroll
        for (int i = 0; i < 32; ++i) out[i] = fmaf(in[i + j], wj, out[i]); }
#pragma unroll
    for (int i = 0; i < 32; ++i) { const float s1 = wave_sum(out[i]), s2 = wave_sum(out[i] * out[i]); if (lane == 0) part[i * 8 + wave] = (f32x2){s1, s2}; }
    __syncthreads();
    if (tid < 32) { float s1 = 0.f, s2 = 0.f;
#pragma unroll
        for (int w = 0; w < 8; ++w) { const f32x2 pp = part[tid * 8 + w]; s1 += pp.x; s2 += pp.y; }
        const float mean = s1 * (1.0f / 512.0f), var = fmaxf(s2 * (1.0f / 512.0f) - mean * mean, 0.f);
        stat[tid] = (f32x2){mean, 1.0f / sqrtf(var + EPS)}; }
    __syncthreads();
    const float lgc = P.ln_g[c], lbc = P.ln_b[c];
#pragma unroll
    for (int i = 0; i < 32; ++i) { const f32x2 st = stat[i]; const float y = (out[i] - st.x) * st.y * lgc + lbc; const float sl = y * sigmoidf_(y);
        Lout[i * 512 + c] = (bf16_t)f2bf(sl); }
    __syncthreads();
    for (int ch = tid; ch < 32 * 64; ch += NTHR) { const int r = ch >> 6, cc = ch & 63;
        *(u32x4*)(MIX + (size_t)(tok0 + r) * 1024 + 512 + cc * 8) = *(const LAS u32x4*)(Lout + r * 512 + cc * 8); }
    __syncthreads();
}

constexpr int MW_UP = 32 * 16 * 64, MW_DN = 32 * 16 * 32, MW_ITEMS = MW_UP + MW_DN;
__device__ __forceinline__ void mw_decode(const Params& P, int it, const float*& src, int& ldw, unsigned char*& dst, const float*& gain) {
    unsigned char* ws = P.ws;
    if (it < MW_UP) { const int e = it >> 10, rr = it & 1023, kb = rr >> 6, nb = rr & 63, pn = nb >> 3, j = (nb & 7) * 32, bj = j >> 7, jj = j & 127;
        src = P.w_up + (size_t)e * 1024 * 2048 + (size_t)(kb * 64) * 2048 + 1024 * bj + 128 * pn + jj; ldw = 2048;
        dst = ws + WS_WUP + (size_t)e * 2048 * 1024 + (size_t)(nb * 32) * 1024 + kb * 64; gain = P.g_ffn + kb * 64; }
    else { const int r = it - MW_UP, e = r >> 9, rr = r & 511, kb = rr >> 5, nb = rr & 31;
        src = P.w_down + (size_t)e * 1024 * 1024 + (size_t)(kb * 64) * 1024 + nb * 32; ldw = 1024;
        dst = ws + WS_WDOWN + (size_t)e * 1024 * 1024 + (size_t)(nb * 32) * 1024 + kb * 64; gain = nullptr; }
}
#define MW_LOAD(LD, it_) do { if ((it_) < MW_ITEMS) { const float* src_; int ldw_; unsigned char* dst_; const float* gain_; mw_decode(P, (it_), src_, ldw_, dst_, gain_); \
        _Pragma("unroll") for (int i_ = 0; i_ < 8; ++i_) LD[i_] = *(const f32x4*)(src_ + (size_t)(8 * i_ + (lane >> 3)) * ldw_ + (lane & 7) * 4); } } while (0)
#define MW_FINISH(LD, it_) do { if ((it_) < MW_ITEMS) { const float* src_; int ldw_; unsigned char* dst_; const float* gain_; mw_decode(P, (it_), src_, ldw_, dst_, gain_); \
        _Pragma("unroll") for (int i_ = 0; i_ < 8; ++i_) { const int kk_ = 8 * i_ + (lane >> 3), j_ = (lane & 7) * 4; const float gk_ = (gain_ ? gain_[kk_] : 1.0f) * 32.0f; \
            LAS float* d_ = scr + kk_ * 33 + j_; d_[0] = LD[i_].x * gk_; d_[1] = LD[i_].y * gk_; d_[2] = LD[i_].z * gk_; d_[3] = LD[i_].w * gk_; } \
        LDS_WAIT(); asm volatile("" ::: "memory"); \
        const int c_ = lane & 7; \
        _Pragma("unroll") for (int j_ = 0; j_ < 4; ++j_) { const int n_ = (lane >> 3) + 8 * j_; const LAS float* sp_ = scr + (8 * c_) * 33 + n_; \
            u32x2 o_; o_.x = pk4_fp8(sp_[0 * 33], sp_[1 * 33], sp_[2 * 33], sp_[3 * 33]); o_.y = pk4_fp8(sp_[4 * 33], sp_[5 * 33], sp_[6 * 33], sp_[7 * 33]); \
            *(u32x2*)(dst_ + (size_t)n_ * 1024 + 8 * c_) = o_; } \
        LDS_WAIT(); asm volatile("" ::: "memory"); } } while (0)
__device__ __forceinline__ void moe_weight_convert(const Params& P, LAS float* scr, int cw, int ncw, int lane) {
    f32x4 l0[8], l1[8], l2[8], l3[8];
    MW_LOAD(l0, cw); MW_LOAD(l1, cw + ncw); MW_LOAD(l2, cw + 2 * ncw);
    for (int base = cw; base < MW_ITEMS; base += 4 * ncw) {
        MW_LOAD(l3, base + 3 * ncw); MW_FINISH(l0, base);
        MW_LOAD(l0, base + 4 * ncw); MW_FINISH(l1, base + ncw);
        MW_LOAD(l1, base + 5 * ncw); MW_FINISH(l2, base + 2 * ncw);
        MW_LOAD(l2, base + 6 * ncw); MW_FINISH(l3, base + 3 * ncw);
    }
}
#undef MW_LOAD
#undef MW_FINISH

__device__ __forceinline__ void router_phase(const Params& P, LAS unsigned char* lds, int blk, int G, int tid, int wave, int lane) {
    unsigned char* ws = P.ws;
    const float* h1 = (const float*)(ws + WS_H1); const float* wrg = (const float*)(ws + WS_WRG);
    int* list = (int*)(ws + WS_LIST); float* lscale = (float*)(ws + WS_LSCALE); float* lgate = (float*)(ws + WS_LGATE);
    unsigned* cntg = (unsigned*)(ws + WS_CTL) + CW_CNT;
    LAS float* WL = (LAS float*)lds;
    LAS int* lcnt = (LAS int*)(lds + LDS_MISC + 1024);
    LAS int* gbase = lcnt + 32;
    LAS int* rec_e = gbase + 32;
    LAS int* rec_p = rec_e + 512;
    LAS float* rec_g = (LAS float*)(rec_p + 512);
    LAS float* rec_s = rec_g + 512;
    for (int i = tid; i < 8192; i += NTHR) ((LAS f32x4*)WL)[i] = ((const f32x4*)wrg)[i];
    __syncthreads();
    const int tl = lane & 31, half = lane >> 5;
    for (int chunk = blk; chunk < NTOK / 128; chunk += G) {
        if (tid < 32) lcnt[tid] = 0;
        __syncthreads();
        if (wave < 4) {
            const int tloc = wave * 32 + tl, tok = chunk * 128 + tloc;
            const float* hrow = h1 + (size_t)tok * DM + 4 * half;
            f32x16 acc;
#pragma unroll
            for (int i = 0; i < 16; ++i) acc[i] = 0.f;
            float ss = 0.f;
#pragma unroll 1
            for (int k0 = 0; k0 < DM; k0 += 32) {
                f32x4 hv[4];
#pragma unroll
                for (int i = 0; i < 4; ++i) hv[i] = *(const f32x4*)(hrow + k0 + 8 * i);
#pragma unroll
                for (int i = 0; i < 4; ++i) {
                    ss = fmaf(hv[i].x, hv[i].x, fmaf(hv[i].y, hv[i].y, fmaf(hv[i].z, hv[i].z, fmaf(hv[i].w, hv[i].w, ss))));
#pragma unroll
                    for (int j = 0; j < 4; ++j) { const float wv = WL[(k0 + 8 * i + 4 * half + j) * 32 + tl];
                        acc = __builtin_amdgcn_mfma_f32_32x32x2f32(wv, hv[i][j], acc, 0, 0, 0); }
                }
            }
            ss += __shfl_xor(ss, 32);
            const float rs = 1.0f / sqrtf(ss * (1.0f / DM) + EPS);
            float v[16];
#pragma unroll
            for (int r = 0; r < 16; ++r) v[r] = acc[r] * rs + P.b_router[(r & 3) + 8 * (r >> 2) + 4 * half];
            float tv[4]; int te[4];
#pragma unroll
            for (int q = 0; q < 4; ++q) { float bv = -INFINITY; int be = 64;
#pragma unroll
                for (int r = 0; r < 16; ++r) { const int e = (r & 3) + 8 * (r >> 2) + 4 * half; if (v[r] > bv || (v[r] == bv && e < be)) { bv = v[r]; be = e; } }
#pragma unroll
                for (int r = 0; r < 16; ++r) { const int e = (r & 3) + 8 * (r >> 2) + 4 * half; if (e == be) v[r] = -INFINITY; }
                tv[q] = bv; te[q] = be; }
            float cv[8]; int ce[8];
#pragma unroll
            for (int q = 0; q < 4; ++q) { cv[q] = tv[q]; ce[q] = te[q]; cv[4 + q] = __shfl_xor(tv[q], 32); ce[4 + q] = __shfl_xor(te[q], 32); }
#pragma unroll
            for (int q = 0; q < 4; ++q) { float bv = -INFINITY; int be = 64;
#pragma unroll
                for (int r = 0; r < 8; ++r) if (cv[r] > bv || (cv[r] == bv && ce[r] < be)) { bv = cv[r]; be = ce[r]; }
#pragma unroll
                for (int r = 0; r < 8; ++r) if (ce[r] == be) cv[r] = -INFINITY;
                tv[q] = bv; te[q] = be; }
            const float e1 = __expf(tv[1] - tv[0]), e2 = __expf(tv[2] - tv[0]), e3 = __expf(tv[3] - tv[0]);
            const float is = 1.0f / (1.0f + e1 + e2 + e3);
            if (half == 0) {
                const float gq[4] = {is, e1 * is, e2 * is, e3 * is};
#pragma unroll
                for (int q = 0; q < 4; ++q) { const int lp = atomicAdd((int*)&lcnt[te[q]], 1); const int si = tloc * 4 + q; rec_e[si] = te[q]; rec_p[si] = lp; rec_g[si] = gq[q]; }
                rec_s[tloc] = rs;
            }
        }
        __syncthreads();
        if (tid < 32) gbase[tid] = (int)atomicAdd(cntg + 64 * tid, (unsigned)lcnt[tid]);
        __syncthreads();
        { const int si = tid, ee = rec_e[si], pos = gbase[ee] + rec_p[si], li = ee * NTOK + pos;
          list[li] = (chunk * 128) * 4 + si; lscale[li] = rec_s[si >> 2]; lgate[li] = rec_g[si]; }
        __syncthreads();
    }
}

__device__ __forceinline__ void combine_phase(const Params& P, int gw, int NGW, int lane) {
    unsigned char* ws = P.ws;
    float* h1 = (float*)(ws + WS_H1); bf16_t* h1b = (bf16_t*)(ws + WS_H1B); const unsigned char* y = ws + WS_Y; float* rs3 = (float*)(ws + WS_RS3);
    for (int m = gw; m < NTOK; m += NGW) {
        const f32x4* hr = (const f32x4*)(h1 + (size_t)m * DM) + lane; f32x4 v[4]; float s = 0.f;
#pragma unroll
        for (int j = 0; j < 4; ++j) v[j] = hr[64 * j];
#pragma unroll
        for (int k = 0; k < 4; ++k) { const unsigned* yr = (const unsigned*)(y + (size_t)(m * 4 + k) * DM) + lane;
#pragma unroll
            for (int j = 0; j < 4; ++j) { const unsigned w = yr[64 * j]; const f32x2 lo = __builtin_amdgcn_cvt_pk_f32_fp8((int)w, false), hi = __builtin_amdgcn_cvt_pk_f32_fp8((int)w, true);
                v[j].x += lo.x * 0.0625f; v[j].y += lo.y * 0.0625f; v[j].z += hi.x * 0.0625f; v[j].w += hi.y * 0.0625f; } }
        u32x2* o8 = (u32x2*)(h1b + (size_t)m * DM) + lane; unsigned* o4 = (unsigned*)(ws + WS_H1F8 + (size_t)m * DM) + lane;
#pragma unroll
        for (int j = 0; j < 4; ++j) { u32x2 w; w.x = pk2(v[j].x, v[j].y); w.y = pk2(v[j].z, v[j].w); o8[64 * j] = w; o4[64 * j] = pk4_fp8(v[j].x, v[j].y, v[j].z, v[j].w);
            s += (v[j].x * v[j].x + v[j].y * v[j].y) + (v[j].z * v[j].z + v[j].w * v[j].w); }
        s = wave_sum(s);
        if (lane == 0) rs3[m] = 1.0f / sqrtf(s * (1.0f / DM) + EPS);
    }
}

__device__ __forceinline__ void final_phase(const Params& P, int gw, int NGW, int lane) {
    unsigned char* ws = P.ws;
    const bf16_t* h2b = (const bf16_t*)(ws + WS_H1B); const bf16_t* pj = (const bf16_t*)(ws + WS_PJ); const unsigned char* G = ws + WS_G; const float* rs3 = (const float*)(ws + WS_RS3);
    f32x4 gv[4];
#pragma unroll
    for (int j = 0; j < 4; ++j) gv[j] = *((const f32x4*)P.g_final + lane + 64 * j);
    for (int m = gw; m < NTOK; m += NGW) {
        const u32x2* hr = (const u32x2*)(h2b + (size_t)m * DM) + lane; const u32x2* pr = (const u32x2*)(pj + (size_t)m * DM) + lane; const unsigned* gr = (const unsigned*)(G + (size_t)m * DM) + lane;
        const float r3 = rs3[m]; f32x4 v[4]; float s = 0.f;
#pragma unroll
        for (int j = 0; j < 4; ++j) { const u32x2 hw = hr[64 * j], pw = pr[64 * j]; const unsigned gw2 = gr[64 * j];
            const f32x2 glo = __builtin_amdgcn_cvt_pk_f32_fp8((int)gw2, false), ghi = __builtin_amdgcn_cvt_pk_f32_fp8((int)gw2, true);
            v[j].x = bf_lo(hw.x) + bf_lo(pw.x) * sigmoidf_(glo.x * r3); v[j].y = bf_hi(hw.x) + bf_hi(pw.x) * sigmoidf_(glo.y * r3);
            v[j].z = bf_lo(hw.y) + bf_lo(pw.y) * sigmoidf_(ghi.x * r3); v[j].w = bf_hi(hw.y) + bf_hi(pw.y) * sigmoidf_(ghi.y * r3);
            s += (v[j].x * v[j].x + v[j].y * v[j].y) + (v[j].z * v[j].z + v[j].w * v[j].w); }
        s = wave_sum(s); const float rs = 1.0f / sqrtf(s * (1.0f / DM) + EPS);
        f32x4* orow = (f32x4*)(P.out + (size_t)m * DM) + lane;
#pragma unroll
        for (int j = 0; j < 4; ++j) orow[64 * j] = v[j] * rs * gv[j];
    }
}

#define XB_TMO      128
#define XB_XCNT(j)  (256  + 64 * (j))
#define XB_XSUB(j)  (1280 + 64 * (j))
#define XB_XGEN(j)  (2304 + 64 * (j))
#define XB_TOP      3328
#define XB_TOPGEN   3392
#define XCD_BAR_WORDS 3456
#define XB_SPIN_CAP (1u << 18)
__device__ __forceinline__ unsigned xb_ld(unsigned* p)              { return __hip_atomic_load(p, __ATOMIC_RELAXED, __HIP_MEMORY_SCOPE_AGENT); }
__device__ __forceinline__ unsigned xb_add(unsigned* p, unsigned v) { return __hip_atomic_fetch_add(p, v, __ATOMIC_RELAXED, __HIP_MEMORY_SCOPE_AGENT); }
__device__ __forceinline__ unsigned xb_xcc_id() { return (unsigned)__builtin_amdgcn_s_getreg((3 << 11) | 20) & 0xFu; }
#define XB_SPIN(cond, bar) do { unsigned _sp = 0; while (cond) { __builtin_amdgcn_s_sleep(1); \
    if ((++_sp & 255u) == 0u) { if (xb_ld(&(bar)[XB_TMO])) break; if (_sp > XB_SPIN_CAP) { atomicAdd(&(bar)[XB_TMO], 1u); break; } } } } while (0)
struct XcdBarrier { unsigned* bar; unsigned x; volatile LAS unsigned* st; };
__device__ __forceinline__ XcdBarrier xcd_barrier_post(unsigned* bar, volatile LAS unsigned* st) {
    XcdBarrier b; b.bar = bar; b.x = xb_xcc_id(); b.st = st;
    if (threadIdx.x == 0) (void)xb_add(&bar[XB_XCNT(b.x)], 1u);
    return b;
}
__device__ __forceinline__ void xcd_barrier_complete(unsigned* bar, unsigned x, unsigned& nloc, unsigned& nx) {
    const unsigned G = gridDim.x * gridDim.y * gridDim.z;
    unsigned sum, cnt, mine, sp = 0u;
    for (;;) {
        sum = 0u; cnt = 0u; mine = 0u;
#pragma unroll
        for (unsigned j = 0; j < 16; ++j) { const unsigned c = xb_ld(&bar[XB_XCNT(j)]); sum += c; cnt += (c > 0u) ? 1u : 0u; mine = (j == x) ? c : mine; }
        if (sum == G) break;
        __builtin_amdgcn_s_sleep(1);
        if ((++sp & 255u) == 0u) { if (xb_ld(&bar[XB_TMO])) break; if (sp > XB_SPIN_CAP) { atomicAdd(&bar[XB_TMO], 1u); break; } }
    }
    nloc = mine > 0u ? mine : 1u; nx = cnt > 0u ? cnt : 1u;
}
__device__ __forceinline__ void xcd_barrier(const XcdBarrier& b) {
    asm volatile("s_waitcnt vmcnt(0)" ::: "memory");
    __syncthreads();
    if (threadIdx.x == 0) {
        unsigned* bar = b.bar;
        __builtin_amdgcn_s_waitcnt(0);
        unsigned nloc = b.st[0], nx = b.st[1];
        if (nloc == 0u) { xcd_barrier_complete(bar, b.x, nloc, nx); b.st[0] = nloc; b.st[1] = nx; }
        const unsigned old = xb_add(&bar[XB_XSUB(b.x)], 1u);
        const unsigned gen = old / nloc;
        if (old + 1u == (gen + 1u) * nloc) {
            __builtin_amdgcn_fence(__ATOMIC_RELEASE, "agent");
            asm volatile("s_waitcnt vmcnt(0)" ::: "memory");
            const unsigned og = xb_add(&bar[XB_TOP], 1u);
            const unsigned tg = og / nx;
            if (og + 1u == (tg + 1u) * nx) xb_add(&bar[XB_TOPGEN], 1u);
            else XB_SPIN(xb_ld(&bar[XB_TOPGEN]) == tg, bar);
            __builtin_amdgcn_fence(__ATOMIC_ACQUIRE, "agent");
            xb_add(&bar[XB_XGEN(b.x)], 1u);
            asm volatile("s_waitcnt vmcnt(0)" ::: "memory");
        } else {
            XB_SPIN(xb_ld(&bar[XB_XGEN(b.x)]) == gen, bar);
            __builtin_amdgcn_fence(__ATOMIC_ACQUIRE, "agent");
            asm volatile("s_waitcnt vmcnt(0)" ::: "memory");
        }
    }
    __syncthreads();
}

constexpr int NPHASE = 10;
__global__ void __launch_bounds__(NTHR, 2) fwd_kernel(Params P) {
    extern __shared__ __attribute__((aligned(16))) unsigned char lds_raw[];
    LAS unsigned char* lds = (LAS unsigned char*)lds_raw;
    cg::grid_group grid = cg::this_grid();
    const int tid = threadIdx.x, wave = __builtin_amdgcn_readfirstlane(tid >> 6);
    const int G = gridDim.x, bx = blockIdx.x;
#define FRESH_LANE(name) int name = (int)__builtin_amdgcn_mbcnt_hi(~0u, __builtin_amdgcn_mbcnt_lo(~0u, 0u)); asm volatile("" : "+v"(name))
    const int vcu = (G % 8 == 0) ? (bx % 8) * (G / 8) + bx / 8 : bx;
    const int NGW = G * NWAVES;
    unsigned char* ws = P.ws;
    const int lo = P.ph_lo, hi = P.ph_hi;
#define IN(k) (lo <= (k) && (k) < hi)
    volatile LAS unsigned* xst = (volatile LAS unsigned*)(lds + LDS_XB);
    if (tid < 2) xst[tid] = 0u;
    __syncthreads();
    const XcdBarrier xbar = xcd_barrier_post((unsigned*)(ws + WS_CTL) + CW_BAR, xst);
#define SYNC(k) do { if (IN(k) && IN((k) + 1)) { if ((k) == 0) grid.sync(); else xcd_barrier(xbar); } } while (0)

    if (IN(0)) { FRESH_LANE(lane); p0_prologue(P, lds, vcu, G, wave, lane); }
    SYNC(0);
    if (IN(1)) {
        { pg8::DenseSched S; S.init((const bf16_t*)(ws + WS_XB), (const bf16_t*)(ws + WS_WIN), NTOK, 2048, 1024, G, bx);
          EpiInProj E{(const float*)(ws + WS_RS1), (const f32x2*)(ws + WS_ROPE), P.glu_b, (bf16_t*)(ws + WS_Q), (bf16_t*)(ws + WS_K), (bf16_t*)(ws + WS_V), (bf16_t*)(ws + WS_QI), (bf16_t*)(ws + WS_KI), (bf16_t*)(ws + WS_HGLU), (float*)(ws + WS_WI)};
          pg8::gemm_phase<EpiInProj, pg8::DenseSched, false>(lds, S, E); }
        { pg8::DenseSched S; S.init((const bf16_t*)(ws + WS_PB), (const bf16_t*)(ws + WS_WP), NTOK, 1024, 256, G, bx);
          EpiBf16Plain E{(bf16_t*)(ws + WS_PJ), 1024, 1.0f};
          pg8::gemm_phase<EpiBf16Plain, pg8::DenseSched, false>(lds, S, E); }
    }
    SYNC(1);
    if (IN(2)) {
        FRESH_LANE(lane);
        for (int i = tid; i < 4096; i += NTHR) ((LAS unsigned*)(lds + LDS_MISC))[i] = 0u;
        __syncthreads();
        unsigned* ctl = (unsigned*)(ws + WS_CTL);
        volatile LAS int* qw = (volatile LAS int*)(lds + LDS_XB + 32);
        if (G % 8 == 0 && G >= 128) { const int ncv = 8; if ((bx >> 3) < ncv) moe_weight_convert(P, (LAS float*)(lds + wave * 16384), (bx * NWAVES) + wave, ncv * 8 * NWAVES, lane); }
        else { moe_weight_convert(P, (LAS float*)(lds + wave * 16384), bx * NWAVES + wave, G * NWAVES, lane); }
        __syncthreads();
        for (int db = 0; db < NB; ++db) { const int b = (bx + db) & 7;
            for (;;) {
                if (tid == 0) qw[0] = (int)atomicAdd(ctl + CW_AQ + 64 * b, 1u);
                __syncthreads();
                const int k = qw[0];
                if (k >= 512) break;
                attn_tile(P, lds, b, (511 - k) * 8, wave, lane);
            }
            __syncthreads(); }
        for (;;) {
            if (tid == 0) qw[0] = (int)atomicAdd(ctl + CW_CQ, 1u);
            __syncthreads();
            const int tl = qw[0];
            if (tl >= NTOK / 32) break;
            conv_tile(P, lds, tl, tid, wave, lane);
        }
    }
    SYNC(2);
    if (IN(3)) {
        pg8::DenseSched S; S.init((const bf16_t*)(ws + WS_MIX), (const bf16_t*)(ws + WS_WOUT), NTOK, 1024, 1024, G, bx);
        EpiOutProj E{P.x, (float*)(ws + WS_H1), (unsigned char*)(ws + WS_H1F8)};
        pg8::gemm_phase<EpiOutProj, pg8::DenseSched, false, false, true>(lds, S, E);
    }
    SYNC(3);
    if (IN(4)) { FRESH_LANE(lane); router_phase(P, lds, vcu, G, tid, wave, lane); }
    SYNC(4);
    if (IN(5) || IN(6)) {
        LAS int* tb = (LAS int*)(lds + LDS_MISC); LAS int* cn = tb + 64;
        if (tid == 0) { const unsigned* cntg = (const unsigned*)(ws + WS_CTL) + CW_CNT; int acc = 0;
            for (int e = 0; e < NE; ++e) { const int c = (int)__hip_atomic_load(cntg + 64 * e, __ATOMIC_RELAXED, __HIP_MEMORY_SCOPE_AGENT); tb[e] = acc; cn[e] = c; acc += (c + BM - 1) / BM; }
            tb[NE] = acc; }
        __syncthreads();
        if (IN(5)) {
            pg8::MoeSched S; S.A = ws + WS_H1F8; S.Bt = ws + WS_WUP; S.rp = 1024; S.b_estride = (size_t)2048 * 1024; S.tb = tb; S.cnt = cn; S.list = (const int*)(ws + WS_LIST);
            S.nN = 8; S.nwg = tb[NE] * 8; S.G = G; S.c = bx; S.gather = true;
            { LAS int* ut = (LAS int*)(lds + LDS_MISC + 512); S.utab = ut; S.build_table(ut, tid); __syncthreads(); }
            S.m_scale = (const float*)(ws + WS_LSCALE); S.m_gate = nullptr; S.m_bias = P.b_up;
            EpiUp E{(unsigned char*)(ws + WS_ACT)};
            pg8::gemm_phase<EpiUp, pg8::MoeSched, true, true, true>(lds, S, E);
        }
        SYNC(5);
        if (IN(6)) {
            pg8::MoeSched S; S.A = ws + WS_ACT; S.Bt = ws + WS_WDOWN; S.rp = 1024; S.b_estride = (size_t)1024 * 1024; S.tb = tb; S.cnt = cn; S.list = (const int*)(ws + WS_LIST);
            S.nN = 4; S.nwg = tb[NE] * 4; S.G = G; S.c = bx; S.gather = false;
            { LAS int* ut = (LAS int*)(lds + LDS_MISC + 512); S.utab = ut; S.build_table(ut, tid); __syncthreads(); }
            S.m_scale = nullptr; S.m_gate = (const float*)(ws + WS_LGATE); S.m_bias = P.b_down;
            EpiDown E{(unsigned char*)(ws + WS_Y)};
            pg8::gemm_phase<EpiDown, pg8::MoeSched, true, true, true>(lds, S, E);
        }
    }
    SYNC(6);
    if (IN(7)) { FRESH_LANE(l7); const int g7 = vcu * NWAVES + wave;
        combine_phase(P, g7, NGW, l7); }
    SYNC(7);
    if (IN(8)) {
        pg8::DenseSched S; S.init(ws + WS_H1F8, ws + WS_WG, NTOK, 1024, 1024, G, bx); S.rp = 1024; S.idg = true;
        EpiF8Plain E{(unsigned char*)(ws + WS_G), 1024, 0.03125f};
        pg8::gemm_phase<EpiF8Plain, pg8::DenseSched, true, true>(lds, S, E);
    }
    SYNC(8);
    if (IN(9)) { FRESH_LANE(l9); const int g9 = vcu * NWAVES + wave;
        final_phase(P, g9, NGW, l9); }
#undef IN
#undef SYNC
}

#ifndef N_LAUNCH_MODE
#define N_LAUNCH_MODE 1
#endif
extern "C" void kernel_launch(void* const* d_in, const int* in_sizes, int n_in, void* d_out, int out_size, void* d_ws, size_t ws_size, hipStream_t stream) {
    static int grid = 0;
    if (grid == 0) {
        if (n_in != 21 || out_size != NTOK * DM || ws_size < WS_END) { fprintf(stderr, "kernel_launch: unexpected shapes (n_in %d out %d ws %zu)\n", n_in, out_size, ws_size); grid = -1; return; }
        int dev = 0, cus = 0, per_cu = 0;
        (void)hipGetDevice(&dev); (void)hipDeviceGetAttribute(&cus, hipDeviceAttributeMultiprocessorCount, dev);
        (void)hipFuncSetAttribute((const void*)fwd_kernel, hipFuncAttributeMaxDynamicSharedMemorySize, LDS_BYTES);
        if (hipOccupancyMaxActiveBlocksPerMultiprocessor(&per_cu, (const void*)fwd_kernel, NTHR, LDS_BYTES) != hipSuccess || per_cu < 1) { fprintf(stderr, "kernel_launch: occupancy query failed (%d)\n", per_cu); (void)hipGetLastError(); grid = -1; return; }
        grid = cus;
    }
    if (grid < 0) return;
    (void)hipMemsetAsync((char*)d_ws + WS_CTL, 0, CTL_BYTES, stream);
    Params p{};
    p.x = (const float*)d_in[0]; p.p = (const float*)d_in[1]; p.w_in = (const float*)d_in[2]; p.w_out = (const float*)d_in[3]; p.g_mix = (const float*)d_in[4]; p.g_ffn = (const float*)d_in[5];
    p.glu_b = (const float*)d_in[6]; p.dw_w = (const float*)d_in[7]; p.dw_b = (const float*)d_in[8]; p.ln_g = (const float*)d_in[9]; p.ln_b = (const float*)d_in[10];
    p.w_router = (const float*)d_in[11]; p.b_router = (const float*)d_in[12]; p.w_up = (const float*)d_in[13]; p.b_up = (const float*)d_in[14]; p.w_down = (const float*)d_in[15]; p.b_down = (const float*)d_in[16];
    p.w_ple_proj = (const float*)d_in[17]; p.w_ple_gate = (const float*)d_in[18]; p.g_ple = (const float*)d_in[19]; p.g_final = (const float*)d_in[20];
    p.out = (float*)d_out; p.ws = (unsigned char*)d_ws;
#if N_LAUNCH_MODE == 1
    p.ph_lo = 0; p.ph_hi = NPHASE;
    void* args[] = {&p};
    hipError_t e = hipLaunchCooperativeKernel((const void*)fwd_kernel, dim3(grid), dim3(NTHR), args, LDS_BYTES, stream);
    if (e != hipSuccess) fprintf(stderr, "cooperative launch failed: %s (grid %d)\n", hipGetErrorString(e), grid);
#else
    for (int ph = 0; ph < NPHASE; ++ph) {
        p.ph_lo = ph; p.ph_hi = ph + 1;
        void* args[] = {&p};
        hipError_t e = hipLaunchCooperativeKernel((const void*)fwd_kernel, dim3(grid), dim3(NTHR), args, LDS_BYTES, stream);
        if (e != hipSuccess) { fprintf(stderr, "launch %d failed: %s (grid %d)\n", ph, hipGetErrorString(e), grid); break; }
    }
#endif
}
```

```cpp
#include <hip/hip_runtime.h>
#include <hip/hip_cooperative_groups.h>
#include <cstdio>
#include <cstdint>
namespace cg = cooperative_groups;

#define LAS __attribute__((address_space(3)))
#define GAS __attribute__((address_space(1)))
typedef unsigned short bf16_t;
typedef short bf16x8 __attribute__((ext_vector_type(8)));
typedef short s16x4 __attribute__((ext_vector_type(4)));
typedef float f32x4 __attribute__((ext_vector_type(4)));
typedef float f32x2 __attribute__((ext_vector_type(2)));
typedef float f32x16 __attribute__((ext_vector_type(16)));
typedef unsigned u32x4 __attribute__((ext_vector_type(4)));
typedef unsigned u32x2 __attribute__((ext_vector_type(2)));

constexpr int NB = 8, SEQ = 4096, DM = 1024, NTOK = NB * SEQ;
constexpr int NE = 32, TOPK = 4, NSLOT = NTOK * TOPK;
constexpr int INW = 1988;
constexpr int NSEL = 256;
constexpr float EPS = 1e-6f;
constexpr int NWAVES = 8, NTHR = 512;

constexpr size_t MiB = 1u << 20;
constexpr size_t WS_CTL = 0, CTL_BYTES = 64 * 1024;
constexpr size_t WS_ROPE = 1 * MiB;
constexpr size_t WS_WIN = 2 * MiB;
constexpr size_t WS_WOUT = 6 * MiB;
constexpr size_t WS_WG = 8 * MiB;
constexpr size_t WS_WP = 10 * MiB;
constexpr size_t WS_WRG = 10 * MiB + 512 * 1024;
constexpr size_t WS_RS1 = 11 * MiB;
constexpr size_t WS_RS3 = 11 * MiB + 512 * 1024;
constexpr size_t WS_WI = 12 * MiB;
constexpr size_t WS_LIST = 13 * MiB;
constexpr size_t WS_LSCALE = 17 * MiB;
constexpr size_t WS_LGATE = 21 * MiB;
constexpr size_t WS_PB = 25 * MiB;
constexpr size_t WS_WUP = 42 * MiB;
constexpr size_t WS_WDOWN = 170 * MiB;
constexpr size_t WS_H1 = 234 * MiB;
constexpr size_t WS_H1B = 362 * MiB;
constexpr size_t WS_PJ = 426 * MiB;
constexpr size_t WS_XB = 490 * MiB;
constexpr size_t WS_Q = 554 * MiB;
constexpr size_t WS_K = 586 * MiB;
constexpr size_t WS_V = 590 * MiB;
constexpr size_t WS_QI = 594 * MiB;
constexpr size_t WS_KI = 610 * MiB;
constexpr size_t WS_HGLU = 614 * MiB;
constexpr size_t WS_MIX = 646 * MiB;
constexpr size_t WS_H1F8 = 490 * MiB;
constexpr size_t WS_ACT = 522 * MiB;
constexpr size_t WS_Y = 762 * MiB;
constexpr size_t WS_G = 762 * MiB;
constexpr size_t WS_END = 1018 * MiB;
static_assert(WS_H1F8 + (size_t)NTOK * 1024 <= WS_ACT && WS_ACT + (size_t)139264 * 1024 <= WS_Y, "ws map");
constexpr int CW_CNT = 1024;
constexpr int CW_AQ = 4096;
constexpr int CW_CQ = 4096 + 64 * 8;
constexpr int CW_BAR = 8192;

constexpr int LDS_STAGE = 131072;
constexpr int LDS_MISC = LDS_STAGE;
constexpr int LDS_META = LDS_MISC + 4096;
constexpr int LDS_XB = 147456;
constexpr int LDS_BYTES = 147456 + 256;

__device__ __forceinline__ unsigned f2bf(float f) { unsigned u = __builtin_bit_cast(unsigned, f); return (u + 0x7fffu + ((u >> 16) & 1u)) >> 16; }
__device__ __forceinline__ unsigned pk2(float lo, float hi) { return f2bf(lo) | (f2bf(hi) << 16); }
__device__ __forceinline__ float bf_lo(unsigned w) { return __builtin_bit_cast(float, w << 16); }
__device__ __forceinline__ float bf_hi(unsigned w) { return __builtin_bit_cast(float, w & 0xffff0000u); }
__device__ __forceinline__ float wave_sum(float v) {
    v += __builtin_bit_cast(float, __builtin_amdgcn_update_dpp(0, __builtin_bit_cast(int, v), 0xB1, 0xF, 0xF, true));
    v += __builtin_bit_cast(float, __builtin_amdgcn_update_dpp(0, __builtin_bit_cast(int, v), 0x4E, 0xF, 0xF, true));
    v += __builtin_bit_cast(float, __builtin_amdgcn_update_dpp(0, __builtin_bit_cast(int, v), 0x141, 0xF, 0xF, true));
    v += __builtin_bit_cast(float, __builtin_amdgcn_update_dpp(0, __builtin_bit_cast(int, v), 0x140, 0xF, 0xF, true));
    const int vi = __builtin_bit_cast(int, v);
    const float r0 = __builtin_bit_cast(float, __builtin_amdgcn_readlane(vi, 0)), r1 = __builtin_bit_cast(float, __builtin_amdgcn_readlane(vi, 16));
    const float r2 = __builtin_bit_cast(float, __builtin_amdgcn_readlane(vi, 32)), r3 = __builtin_bit_cast(float, __builtin_amdgcn_readlane(vi, 48));
    return (r0 + r1) + (r2 + r3);
}
__device__ __forceinline__ unsigned pk4_fp8(float a, float b, float c, float d) { int r = __builtin_amdgcn_cvt_pk_fp8_f32(a, b, 0, false); r = __builtin_amdgcn_cvt_pk_fp8_f32(c, d, r, true); return (unsigned)r; }
__device__ __forceinline__ float sigmoidf_(float x) { return __builtin_amdgcn_rcpf(1.0f + __builtin_amdgcn_exp2f(x * -1.4426950408889634f)); }
#define LDS_WAIT() asm volatile("s_waitcnt lgkmcnt(0)" ::: "memory")
#define NT_LD(p) __builtin_nontemporal_load(p)
#define NT_ST(v, p) __builtin_nontemporal_store(v, p)

struct Params {
    const float* x; const float* p; const float* w_in; const float* w_out; const float* g_mix; const float* g_ffn;
    const float* glu_b; const float* dw_w; const float* dw_b; const float* ln_g; const float* ln_b;
    const float* w_router; const float* b_router; const float* w_up; const float* b_up; const float* w_down; const float* b_down;
    const float* w_ple_proj; const float* w_ple_gate; const float* g_ple; const float* g_final;
    float* out; unsigned char* ws;
    int ph_lo, ph_hi;
};

namespace pg8 {
constexpr int BM = 256, BK = 64, HALF = 128, HTB = HALF * BK * 2, STAGE_BYTES = 8 * HTB, NXCD = 8, WGM = 8;
__host__ __device__ __forceinline__ int lds_byte(int r, int c) { const int st = (r >> 4) * 2 + (c >> 5), rr = r & 15, cc = c & 31, ob = rr * 64 + cc * 2; return st * 1024 + (ob ^ (((ob >> 9) & 1) << 5)); }
__host__ __device__ __forceinline__ void stage_rc(int b, int& R, int& C) { const int st = b / 1024, sb = b % 1024, swz = sb ^ (((sb >> 9) & 1) << 5); R = (st >> 1) * 16 + swz / 64; C = (st & 1) * 32 + (swz % 64) / 2; }
__host__ __device__ __forceinline__ int perm32(int rho) { const int n = rho >> 4, i = rho & 15; return 8 * (i >> 2) + 4 * n + (i & 3); }

struct Unit { int pm, pn, e, rows; };

__device__ __forceinline__ unsigned cvt_pk_bf16(float lo, float hi) { unsigned r; asm volatile("v_cvt_pk_bf16_f32 %0, %1, %2" : "=v"(r) : "v"(lo), "v"(hi)); return r; }

struct DenseSched {
    const void* A; const void* Bt; int rp;
    int nM, nN, nwg, G, c;
    __device__ void init(const void* A_, const void* Bt_, int M, int N, int K_, int G_, int c_) { A = A_; Bt = Bt_; rp = K_ * 2; nM = M / BM; nN = N / BM; nwg = nM * nN; G = G_; c = c_; }
    __device__ bool next(int i, Unit& u) const {
        const long L = (long)i * G + c; if (L >= nwg) return false;
        int wgid = (int)L; { const int q = nwg / NXCD, r = nwg % NXCD, xcd = wgid % NXCD, off = wgid / NXCD; wgid = (xcd < r ? xcd * (q + 1) : r * (q + 1) + (xcd - r) * q) + off; }
        const int nig = WGM * nN, gid = wgid / nig, fm = gid * WGM, gsz = (nM - fm) < WGM ? (nM - fm) : WGM;
        u.pm = fm + ((wgid % nig) % gsz); u.pn = (wgid % nig) / gsz; u.e = 0; u.rows = BM; return true;
    }
    bool idg = false;
    __device__ __forceinline__ const char* a_ptr(const Unit& u) const { return idg ? (const char*)A : (const char*)A + (size_t)u.pm * BM * rp; }
    __device__ __forceinline__ const char* b_ptr(const Unit& u) const { return (const char*)Bt + (size_t)u.pn * BM * rp; }
    __device__ __forceinline__ int a_row(const Unit& u, int r) const { return u.pm * BM + r; }
    __device__ __forceinline__ void meta(const Unit&, LAS unsigned char*, int, int) const {}
};

struct MoeSched {
    const void* A; const void* Bt; int rp; size_t b_estride;
    const LAS int* tb;
    const LAS int* cnt;
    const int* list;
    int nN, nwg, G, c; bool gather;
    const LAS int* utab;
    __device__ __forceinline__ bool next(int i, Unit& u) const {
        if (i >= 32) return false;
        const LAS int* p = utab + 4 * i; const int rows = p[3]; if (rows < 0) return false;
        u.pm = p[0]; u.pn = p[1]; u.e = p[2]; u.rows = rows; return true;
    }
    __device__ __forceinline__ void build_table(LAS int* tab, int tid) const {
        if (tid < 32) { Unit u; const bool ok = decode(tid, u); tab[4 * tid] = u.pm; tab[4 * tid + 1] = u.pn; tab[4 * tid + 2] = u.e; tab[4 * tid + 3] = ok ? u.rows : -1; }
    }
    __device__ __forceinline__ bool decode(int i, Unit& u) const {
        u.pm = 0; u.pn = 0; u.e = 0; u.rows = 0;
        const long L = (long)i * G + c; if (L >= nwg) return false;
        int wgid = (int)L; { const int q = nwg / NXCD, r = nwg % NXCD, xcd = wgid % NXCD, off = wgid / NXCD; wgid = (xcd < r ? xcd * (q + 1) : r * (q + 1) + (xcd - r) * q) + off; }
        int e = 0;
#pragma unroll 1
        for (; e < NE - 1; ++e) { if (wgid < tb[e + 1] * nN) break; }
        const int local = wgid - tb[e] * nN, nM = tb[e + 1] - tb[e];
        const int nig = WGM * nN, gid = local / nig, fm = gid * WGM, gsz = (nM - fm) < WGM ? (nM - fm) : WGM;
        const int rt = fm + ((local % nig) % gsz);
        u.pm = tb[e] + rt; u.pn = (local % nig) / gsz; u.e = e;
        const int left = cnt[e] - rt * BM; u.rows = left < BM ? left : BM; return true;
    }
    __device__ __forceinline__ const char* a_ptr(const Unit& u) const { return (const char*)A; }
    __device__ __forceinline__ const char* b_ptr(const Unit& u) const { return (const char*)Bt + (size_t)u.e * b_estride + (size_t)u.pn * BM * rp; }
    __device__ __forceinline__ int a_row(const Unit& u, int r) const {
        if (!gather) return u.pm * BM + r;
        const int rt = u.pm - tb[u.e];
        return r < u.rows ? (list[u.e * NTOK + rt * BM + r] >> 2) : 0;
    }
    const float* m_scale; const float* m_gate; const float* m_bias;
    __device__ __forceinline__ void meta(const Unit& u, LAS unsigned char* tbl, int wid, int lane) const {
        const int rt = u.pm - tb[u.e]; const size_t li = (size_t)u.e * NTOK + rt * BM + (wid & 3) * 64 + lane;
        if (gather) {
            if (wid < 4) __builtin_amdgcn_global_load_lds((const unsigned*)(m_scale + li), (LAS unsigned*)(tbl + (wid & 3) * 256), 4, 0, 0);
            else { const int j = (wid & 3) * 64 + lane; const float* src = m_bias + (size_t)u.e * 2048 + (j < 128 ? 128 * u.pn + j : 1024 + 128 * u.pn + (j - 128));
                __builtin_amdgcn_global_load_lds((const unsigned*)src, (LAS unsigned*)(tbl + 2048 + (wid & 3) * 256), 4, 0, 0); }
        } else {
            if (wid < 4) { __builtin_amdgcn_global_load_lds((const unsigned*)(list + li), (LAS unsigned*)(tbl + (wid & 3) * 256), 4, 0, 0);
                __builtin_amdgcn_global_load_lds((const unsigned*)(m_bias + (size_t)u.e * 1024 + u.pn * BM + (wid & 3) * 64 + lane), (LAS unsigned*)(tbl + 2048 + (wid & 3) * 256), 4, 0, 0); }
            else __builtin_amdgcn_global_load_lds((const unsigned*)(m_gate + li), (LAS unsigned*)(tbl + 1024 + (wid & 3) * 256), 4, 0, 0);
        }
    }
};

typedef int v8i32 __attribute__((ext_vector_type(8)));
template <class Epi, class Sched, bool GATHER, bool F8 = false, bool WARMTRIP = false>
__device__ __forceinline__ void gemm_phase(LAS unsigned char* lds, const Sched& S, const Epi& E) {
    const int tid = threadIdx.x, wid = __builtin_amdgcn_readfirstlane(tid >> 6), lane = tid & 63, wr = wid >> 2, wc = wid & 3, fr = lane & 15, fq = lane >> 4;
    const int RP = S.rp, nt = RP / (BK * 2);
    unsigned voffA[2], voffB[2]; int RA[2], CA[2];
#pragma unroll
    for (int i = 0; i < 2; ++i) { int R, C; stage_rc(tid * 16 + i * 8192, R, C); const int Rb = Epi::PERM ? ((R & ~31) + perm32(R & 31)) : R;
        voffA[i] = (unsigned)(R * RP + C * 2); voffB[i] = (unsigned)(Rb * RP + C * 2); RA[i] = R; CA[i] = C; }
    const size_t kstep = (size_t)(BK * 2);
    const size_t hstep = (size_t)HALF * RP;
    const unsigned ldsw = (unsigned)wid * 1024u;
    const int aoff = lds_byte(wr * 64 + fr, fq * 8), boff = lds_byte(wc * 32 + fr, fq * 8);
    unsigned gC[2][2], gN[2][2];
#define PG8_SA(b, h) (((b) * 2 + (h)) * HTB)
#define PG8_SB(b, h) ((4 + (b) * 2 + (h)) * HTB)
#define PG8_STAGE(bufoff, gbase, voff) do { _Pragma("unroll") for (int _i = 0; _i < 2; ++_i) \
        __builtin_amdgcn_global_load_lds((const unsigned*)((const char*)(gbase) + (voff)[_i]), (LAS unsigned*)(lds + (bufoff) + ldsw + _i * 8192), 16, 0, 0); } while (0)
#define PG8_STAGE_A(bufoff, kp, h) do { if constexpr (GATHER) { PG8_STAGE(bufoff, kp, gC[h]); } else { PG8_STAGE(bufoff, (kp) + (h) * hstep, voffA); } } while (0)
#define PG8_LD16(p) (*(const LAS bf16x8*)(p))
#define PG8_CAT(lo, hi) __builtin_bit_cast(v8i32, __builtin_shufflevector(lo, hi, 0, 1, 2, 3, 4, 5, 6, 7, 8, 9, 10, 11, 12, 13, 14, 15))
#define PG8_LDA(dst, b, h) do { _Pragma("unroll") for (int m = 0; m < 4; ++m) { if constexpr (F8) { dst##8[m] = PG8_CAT(PG8_LD16(lds + PG8_SA(b, h) + aoff + m * 2048), PG8_LD16(lds + PG8_SA(b, h) + aoff + m * 2048 + 1024)); } \
        else { _Pragma("unroll") for (int k = 0; k < 2; ++k) dst[m][k] = PG8_LD16(lds + PG8_SA(b, h) + aoff + m * 2048 + k * 1024); } } } while (0)
#define PG8_LDB(dst, b, h) do { _Pragma("unroll") for (int n = 0; n < 2; ++n) { if constexpr (F8) { dst##8[n] = PG8_CAT(PG8_LD16(lds + PG8_SB(b, h) + boff + n * 2048), PG8_LD16(lds + PG8_SB(b, h) + boff + n * 2048 + 1024)); } \
        else { _Pragma("unroll") for (int k = 0; k < 2; ++k) dst[n][k] = PG8_LD16(lds + PG8_SB(b, h) + boff + n * 2048 + k * 1024); } } } while (0)
#define PG8_MMA(ai, bj, At, Bt) do { __builtin_amdgcn_s_setprio(1); _Pragma("unroll") for (int m = 0; m < 4; ++m) _Pragma("unroll") for (int n = 0; n < 2; ++n) { \
        if constexpr (F8) { acc[ai][bj][m][n] = __builtin_amdgcn_mfma_scale_f32_16x16x128_f8f6f4(Bt##8[n], At##8[m], acc[ai][bj][m][n], 0, 0, 0, 0x7f7f7f7f, 0, 0x7f7f7f7f); } \
        else { _Pragma("unroll") for (int k = 0; k < 2; ++k) acc[ai][bj][m][n] = __builtin_amdgcn_mfma_f32_16x16x32_bf16(Bt[n][k], At[m][k], acc[ai][bj][m][n], 0, 0, 0); } } \
        __builtin_amdgcn_s_setprio(0); } while (0)
#define PG8_WAIT_V(n) asm volatile("s_waitcnt vmcnt(" #n ")" ::: "memory")
#define PG8_WAIT_L(n) asm volatile("s_waitcnt lgkmcnt(" #n ")" ::: "memory")
#define PG8_BAR __builtin_amdgcn_s_barrier()
#define PG8_SCHED __builtin_amdgcn_sched_barrier(0)
#define PG8_GOFF(dst, u) do { _Pragma("unroll") for (int _h = 0; _h < 2; ++_h) _Pragma("unroll") for (int _i = 0; _i < 2; ++_i) \
        dst[_h][_i] = (unsigned)(S.a_row(u, _h * HALF + RA[_i]) * RP + CA[_i] * 2); } while (0)
    Unit cur, nxt, nn; int ui = 0;
    if (!S.next(0, cur)) return;
    bool has_next = S.next(1, nxt);
    if constexpr (GATHER) { PG8_GOFF(gC, cur); if (has_next) { PG8_GOFF(gN, nxt); } else { PG8_GOFF(gN, cur); } }
    f32x4 acc[2][2][4][2];
#pragma unroll
    for (int a = 0; a < 2; ++a)
#pragma unroll
        for (int b = 0; b < 2; ++b)
#pragma unroll
            for (int m = 0; m < 4; ++m)
#pragma unroll
                for (int n = 0; n < 2; ++n) acc[a][b][m][n] = (f32x4){0.f, 0.f, 0.f, 0.f};
    bf16x8 At[4][2], B0[2][2], B1[2][2]; v8i32 At8[4], B08[2], B18[2];
    const char* cA = S.a_ptr(cur); const char* cB = S.b_ptr(cur);
    PG8_STAGE(PG8_SB(0, 0), cB, voffB); PG8_STAGE(PG8_SB(0, 1), cB + hstep, voffB); PG8_STAGE_A(PG8_SA(0, 0), cA, 0); PG8_STAGE_A(PG8_SA(0, 1), cA, 1);
    if (wr == 1) PG8_BAR;
    PG8_WAIT_V(2); PG8_BAR;
    PG8_STAGE(PG8_SB(1, 0), cB + kstep, voffB); PG8_STAGE_A(PG8_SA(1, 0), cA + kstep, 0); PG8_STAGE(PG8_SB(1, 1), cB + hstep + kstep, voffB);
    PG8_WAIT_V(6); PG8_BAR;
    for (;;) {
        const char* nA = has_next ? S.a_ptr(nxt) : cA; const char* nB = has_next ? S.b_ptr(nxt) : cB;
        S.meta(cur, lds + (LDS_META - 0) + (ui & 1) * 4096, wid, lane);
#define PG8_TRIP(WARM, t) do { \
            const bool last = ((t) == nt - 2); \
            const char* a1 = cA + (size_t)((t) + 1) * kstep; \
            const char* a2 = last ? nA : cA + (size_t)((t) + 2) * kstep; const char* b2 = last ? nB : cB + (size_t)((t) + 2) * kstep; \
            const char* a3 = a2 + kstep; const char* b3 = b2 + kstep; \
              \
            PG8_LDB(B0, 0, 0); PG8_LDB(B1, 0, 1); PG8_SCHED; PG8_LDA(At, 0, 0); if constexpr (!(WARM)) { PG8_STAGE_A(PG8_SA(1, 1), a1, 1); } \
            if constexpr (GATHER) { if (last) { _Pragma("unroll") for (int h = 0; h < 2; ++h) _Pragma("unroll") for (int i = 0; i < 2; ++i) gC[h][i] = gN[h][i]; } } \
            if constexpr (!(WARM)) { PG8_WAIT_V(8); } PG8_WAIT_L(0); PG8_BAR; PG8_MMA(0, 0, At, B0); PG8_MMA(0, 1, At, B1); PG8_BAR; PG8_SCHED; \
              \
            PG8_LDA(At, 0, 1); PG8_STAGE(PG8_SB(0, 0), b2, voffB); PG8_STAGE(PG8_SB(0, 1), b2 + hstep, voffB); PG8_STAGE_A(PG8_SA(0, 0), a2, 0); \
            if constexpr (!(WARM)) { PG8_WAIT_V(8); } PG8_WAIT_L(0); PG8_BAR; PG8_MMA(1, 0, At, B0); PG8_MMA(1, 1, At, B1); PG8_BAR; PG8_SCHED; \
              \
            PG8_LDB(B0, 1, 0); PG8_LDB(B1, 1, 1); PG8_SCHED; PG8_LDA(At, 1, 0); PG8_STAGE_A(PG8_SA(0, 1), a2, 1); \
            if constexpr (!(WARM)) { PG8_WAIT_V(8); } PG8_WAIT_L(0); PG8_BAR; PG8_MMA(0, 0, At, B0); PG8_MMA(0, 1, At, B1); PG8_BAR; PG8_SCHED; \
              \
            PG8_LDA(At, 1, 1); PG8_STAGE(PG8_SB(1, 0), b3, voffB); PG8_STAGE(PG8_SB(1, 1), b3 + hstep, voffB); PG8_STAGE_A(PG8_SA(1, 0), a3, 0); \
            PG8_WAIT_V(8); PG8_WAIT_L(0); PG8_BAR; PG8_MMA(1, 0, At, B0); PG8_MMA(1, 1, At, B1); PG8_BAR; PG8_SCHED; \
        } while (0)
        int t0_ = 0;
        if constexpr (WARMTRIP) { if (ui > 0) { PG8_TRIP(true, 0); t0_ = 2; } }
        for (int t = t0_; t < nt; t += 2) { PG8_TRIP(false, t); }
#undef PG8_TRIP
        if (wr == 0) PG8_BAR;
        if constexpr (WARMTRIP) { PG8_STAGE_A(PG8_SA(1, 1), nA + kstep, 1); }
        bool has_nn = false;
        if constexpr (GATHER) { if (has_next) { has_nn = S.next(ui + 2, nn); if (has_nn) { PG8_GOFF(gN, nn); } } }
        else { if (has_next) has_nn = S.next(ui + 2, nn); }
        { int fr_ = fr, fq_ = fq; asm volatile("" : "+v"(fr_), "+v"(fq_));
          const LAS unsigned char* mt = lds + LDS_META + (ui & 1) * 4096;
          if constexpr (WARMTRIP) {
              E.pre(acc, cur, wr, wc, fr_, fq_, mt);
              if constexpr (GATHER) asm volatile("" : "+v"(gN[0][0]), "+v"(gN[0][1]), "+v"(gN[1][0]), "+v"(gN[1][1]));
              PG8_WAIT_V(0);
              E.post(acc, cur, wr, wc, fr_, fq_, mt);
          } else { E.run(acc, cur, wr, wc, fr_, fq_, mt); } }
        if (!has_next) break;
#pragma unroll
        for (int a = 0; a < 2; ++a)
#pragma unroll
            for (int b = 0; b < 2; ++b)
#pragma unroll
                for (int m = 0; m < 4; ++m)
#pragma unroll
                    for (int n = 0; n < 2; ++n) acc[a][b][m][n] = (f32x4){0.f, 0.f, 0.f, 0.f};
        cur = nxt; cA = nA; cB = nB; ++ui; nxt = nn; has_next = has_nn;
        if (wr == 1) PG8_BAR;
    }
    PG8_WAIT_V(0);
    PG8_BAR;
#undef PG8_SA
#undef PG8_SB
#undef PG8_STAGE
#undef PG8_STAGE_A
#undef PG8_LDA
#undef PG8_LDB
#undef PG8_MMA
#undef PG8_LD16
#undef PG8_CAT
#undef PG8_WAIT_V
#undef PG8_WAIT_L
#undef PG8_BAR
#undef PG8_SCHED
#undef PG8_GOFF
}
}

using pg8::Unit; using pg8::cvt_pk_bf16;
constexpr int BM = 256, HALF = 128;

typedef f32x4 (&AccRef)[2][2][4][2];
__device__ __forceinline__ void pack8_bf16(f32x4& lo, const f32x4& hi) {
    const unsigned w0 = cvt_pk_bf16(lo[0], lo[1]), w1 = cvt_pk_bf16(lo[2], lo[3]), w2 = cvt_pk_bf16(hi[0], hi[1]), w3 = cvt_pk_bf16(hi[2], hi[3]);
    lo[0] = __builtin_bit_cast(float, w0); lo[1] = __builtin_bit_cast(float, w1); lo[2] = __builtin_bit_cast(float, w2); lo[3] = __builtin_bit_cast(float, w3);
}
#define AS_U4(v) __builtin_bit_cast(u32x4, v)

struct EpiInProj {
    static constexpr bool PERM = true;
    const float* rs1; const f32x2* rope; const float* glu_b;
    bf16_t *q, *k, *v, *qi, *ki, *hglu; float* wi;
    __device__ __forceinline__ void pre(AccRef acc, const Unit& u, int wr, int wc, int fr, int fq, const LAS unsigned char* mt) const {
        const int row0 = u.pm * BM + wr * 64 + fr;
        if (u.pn >= 4) {
            const int ch = 128 * (u.pn - 4) + 32 * wc + 8 * fq;
            f32x4 ba[2], bg[2];
#pragma unroll
            for (int n = 0; n < 2; ++n) { ba[n] = *(const f32x4*)(glu_b + ch + 4 * n); bg[n] = *(const f32x4*)(glu_b + 512 + ch + 4 * n); }
#pragma unroll
            for (int ai = 0; ai < 2; ++ai)
#pragma unroll
                for (int m = 0; m < 4; ++m) { const float rs = rs1[row0 + ai * HALF + m * 16];
#pragma unroll
                    for (int n = 0; n < 2; ++n)
#pragma unroll
                        for (int e = 0; e < 4; ++e) { const float a = acc[ai][0][m][n][e] * rs + ba[n][e], g = acc[ai][1][m][n][e] * rs + bg[n][e]; acc[ai][0][m][n][e] = a * sigmoidf_(g); }
                    pack8_bf16(acc[ai][0][m][0], acc[ai][0][m][1]); }
            return;
        }
        const bool do_rope = !(u.pn == 3 && wc >= 2), is_wi = (u.pn == 3 && wc == 3);
        const int d0 = 8 * fq;
#pragma unroll
        for (int ai = 0; ai < 2; ++ai)
#pragma unroll
            for (int m = 0; m < 4; ++m) { const int row = row0 + ai * HALF + m * 16; const float rs = rs1[row];
                if (do_rope) {
                    const f32x2* rp = rope + (size_t)(row & (SEQ - 1)) * 32 + d0;
#pragma unroll
                    for (int n = 0; n < 2; ++n)
#pragma unroll
                        for (int e = 0; e < 4; ++e) { const f32x2 cs = rp[4 * n + e]; const float x1 = acc[ai][0][m][n][e] * rs, x2 = acc[ai][1][m][n][e] * rs;
                            acc[ai][0][m][n][e] = x1 * cs.x - x2 * cs.y; acc[ai][1][m][n][e] = x2 * cs.x + x1 * cs.y; }
                } else {
#pragma unroll
                    for (int n = 0; n < 2; ++n) { acc[ai][0][m][n] = acc[ai][0][m][n] * rs; acc[ai][1][m][n] = acc[ai][1][m][n] * rs; }
                }
                if (!is_wi) { pack8_bf16(acc[ai][0][m][0], acc[ai][0][m][1]); pack8_bf16(acc[ai][1][m][0], acc[ai][1][m][1]); }
                if (m & 1) __builtin_amdgcn_sched_barrier(0); }
    }
    __device__ __forceinline__ void post(AccRef acc, const Unit& u, int wr, int wc, int fr, int fq, const LAS unsigned char* mt) const {
        const int row0 = u.pm * BM + wr * 64 + fr;
        if (u.pn >= 4) {
            const int ch = 128 * (u.pn - 4) + 32 * wc + 8 * fq;
#pragma unroll
            for (int ai = 0; ai < 2; ++ai)
#pragma unroll
                for (int m = 0; m < 4; ++m) *(u32x4*)(hglu + (size_t)(row0 + ai * HALF + m * 16) * 512 + ch) = AS_U4(acc[ai][0][m][0]);
            return;
        }
        bf16_t* dst; int ld, col; bool is_wi = false;
        if (u.pn < 2) { dst = q; ld = 512; col = (4 * u.pn + wc) * 64; }
        else if (u.pn == 2) { dst = qi; ld = 256; col = wc * 64; }
        else { ld = 64; col = 0; if (wc == 0) dst = k; else if (wc == 1) dst = ki; else if (wc == 2) dst = v; else { dst = v; is_wi = true; } }
        if (is_wi) {
            if (fq == 0) {
#pragma unroll
                for (int ai = 0; ai < 2; ++ai)
#pragma unroll
                    for (int m = 0; m < 4; ++m) *(f32x4*)(wi + (size_t)(row0 + ai * HALF + m * 16) * 4) = acc[ai][0][m][0];
            }
            return;
        }
#pragma unroll
        for (int ai = 0; ai < 2; ++ai)
#pragma unroll
            for (int m = 0; m < 4; ++m) { bf16_t* rp2 = dst + (size_t)(row0 + ai * HALF + m * 16) * ld + col + 8 * fq;
                *(u32x4*)(rp2) = AS_U4(acc[ai][0][m][0]); *(u32x4*)(rp2 + 32) = AS_U4(acc[ai][1][m][0]); }
    }
    __device__ __forceinline__ void run(const f32x4 (&acc)[2][2][4][2], const Unit& u, int wr, int wc, int fr, int fq, const LAS unsigned char* mt) const {
        const int row0 = u.pm * BM + wr * 64 + fr;
        if (u.pn >= 4) {
            const int ch = 128 * (u.pn - 4) + 32 * wc + 8 * fq;
            f32x4 ba[2], bg[2];
#pragma unroll
            for (int n = 0; n < 2; ++n) { ba[n] = *(const f32x4*)(glu_b + ch + 4 * n); bg[n] = *(const f32x4*)(glu_b + 512 + ch + 4 * n); }
#pragma unroll
            for (int ai = 0; ai < 2; ++ai)
#pragma unroll
                for (int m = 0; m < 4; ++m) { const int row = row0 + ai * HALF + m * 16; const float rs = rs1[row];
                    float o[8];
#pragma unroll
                    for (int n = 0; n < 2; ++n)
#pragma unroll
                        for (int e = 0; e < 4; ++e) { const float a = acc[ai][0][m][n][e] * rs + ba[n][e], g = acc[ai][1][m][n][e] * rs + bg[n][e]; o[4 * n + e] = a * sigmoidf_(g); }
                    u32x4 w; w.x = cvt_pk_bf16(o[0], o[1]); w.y = cvt_pk_bf16(o[2], o[3]); w.z = cvt_pk_bf16(o[4], o[5]); w.w = cvt_pk_bf16(o[6], o[7]);
                    *(u32x4*)(hglu + (size_t)row * 512 + ch) = w; }
            return;
        }
        bf16_t* dst; int ld, col; bool do_rope = true, is_wi = false;
        if (u.pn < 2) { dst = q; ld = 512; col = (4 * u.pn + wc) * 64; }
        else if (u.pn == 2) { dst = qi; ld = 256; col = wc * 64; }
        else { ld = 64; col = 0; if (wc == 0) dst = k; else if (wc == 1) dst = ki; else if (wc == 2) { dst = v; do_rope = false; } else { dst = v; is_wi = true; do_rope = false; } }
        if (is_wi) {
            if (fq == 0) {
#pragma unroll
                for (int ai = 0; ai < 2; ++ai)
#pragma unroll
                    for (int m = 0; m < 4; ++m) { const int row = row0 + ai * HALF + m * 16; const float rs = rs1[row];
                        *(f32x4*)(wi + (size_t)row * 4) = acc[ai][0][m][0] * rs; }
            }
            return;
        }
        const int d0 = 8 * fq;
#pragma unroll
        for (int ai = 0; ai < 2; ++ai)
#pragma unroll
            for (int m = 0; m < 4; ++m) { const int row = row0 + ai * HALF + m * 16; const float rs = rs1[row];
                float o1[8], o2[8];
                if (do_rope) {
                    const f32x4* rp = (const f32x4*)(rope + (size_t)(row & (SEQ - 1)) * 32 + d0);
#pragma unroll
                    for (int n = 0; n < 2; ++n)
#pragma unroll
                        for (int e2 = 0; e2 < 2; ++e2) { const f32x4 cs = rp[2 * n + e2];
                            { const float x1 = acc[ai][0][m][n][2 * e2] * rs, x2 = acc[ai][1][m][n][2 * e2] * rs; o1[4 * n + 2 * e2] = x1 * cs.x - x2 * cs.y; o2[4 * n + 2 * e2] = x2 * cs.x + x1 * cs.y; }
                            { const float x1 = acc[ai][0][m][n][2 * e2 + 1] * rs, x2 = acc[ai][1][m][n][2 * e2 + 1] * rs; o1[4 * n + 2 * e2 + 1] = x1 * cs.z - x2 * cs.w; o2[4 * n + 2 * e2 + 1] = x2 * cs.z + x1 * cs.w; } }
                } else {
#pragma unroll
                    for (int n = 0; n < 2; ++n)
#pragma unroll
                        for (int e = 0; e < 4; ++e) { o1[4 * n + e] = acc[ai][0][m][n][e] * rs; o2[4 * n + e] = acc[ai][1][m][n][e] * rs; }
                }
                u32x4 w1, w2; w1.x = cvt_pk_bf16(o1[0], o1[1]); w1.y = cvt_pk_bf16(o1[2], o1[3]); w1.z = cvt_pk_bf16(o1[4], o1[5]); w1.w = cvt_pk_bf16(o1[6], o1[7]);
                w2.x = cvt_pk_bf16(o2[0], o2[1]); w2.y = cvt_pk_bf16(o2[2], o2[3]); w2.z = cvt_pk_bf16(o2[4], o2[5]); w2.w = cvt_pk_bf16(o2[6], o2[7]);
                if (u.pn == 3 && wc == 1) {
                    bf16_t* tp = ki + ((size_t)(row >> 5) * 256 + (row & 31) + 32 * (fq & 1)) * 8;
                    *(u32x4*)(tp + (size_t)(fq >> 1) * 512) = w1; *(u32x4*)(tp + (size_t)(2 + (fq >> 1)) * 512) = w2;
                } else {
                    bf16_t* rp2 = dst + (size_t)row * ld + col + d0;
                    *(u32x4*)(rp2) = w1; *(u32x4*)(rp2 + 32) = w2; } }
    }
};

struct EpiBf16Plain {
    static constexpr bool PERM = true;
    bf16_t* O; int ldc; float scale;
    __device__ __forceinline__ void pre(AccRef acc, const Unit&, int, int, int, int, const LAS unsigned char*) const {
#pragma unroll
        for (int ai = 0; ai < 2; ++ai)
#pragma unroll
            for (int bj = 0; bj < 2; ++bj)
#pragma unroll
                for (int m = 0; m < 4; ++m) { acc[ai][bj][m][0] = acc[ai][bj][m][0] * scale; acc[ai][bj][m][1] = acc[ai][bj][m][1] * scale; pack8_bf16(acc[ai][bj][m][0], acc[ai][bj][m][1]); }
    }
    __device__ __forceinline__ void post(AccRef acc, const Unit& u, int wr, int wc, int fr, int fq, const LAS unsigned char* mt) const {
        const int row0 = u.pm * BM + wr * 64 + fr, col0 = u.pn * BM + wc * 32 + 8 * fq;
#pragma unroll
        for (int ai = 0; ai < 2; ++ai)
#pragma unroll
            for (int m = 0; m < 4; ++m) { bf16_t* rowp = O + (size_t)(row0 + ai * HALF + m * 16) * ldc + col0;
#pragma unroll
                for (int bj = 0; bj < 2; ++bj) *(u32x4*)(rowp + bj * HALF) = AS_U4(acc[ai][bj][m][0]); }
    }
    __device__ __forceinline__ void run(const f32x4 (&acc)[2][2][4][2], const Unit& u, int wr, int wc, int fr, int fq, const LAS unsigned char* mt) const {
        const int row0 = u.pm * BM + wr * 64 + fr, col0 = u.pn * BM + wc * 32 + 8 * fq;
#pragma unroll
        for (int ai = 0; ai < 2; ++ai)
#pragma unroll
            for (int m = 0; m < 4; ++m) { bf16_t* rowp = O + (size_t)(row0 + ai * HALF + m * 16) * ldc + col0;
#pragma unroll
                for (int bj = 0; bj < 2; ++bj) { const f32x4 v0 = acc[ai][bj][m][0] * scale, v1 = acc[ai][bj][m][1] * scale;
                    u32x4 w; w.x = cvt_pk_bf16(v0[0], v0[1]); w.y = cvt_pk_bf16(v0[2], v0[3]); w.z = cvt_pk_bf16(v1[0], v1[1]); w.w = cvt_pk_bf16(v1[2], v1[3]);
                    *(u32x4*)(rowp + bj * HALF) = w; } }
    }
};

struct EpiF8Plain {
    static constexpr bool PERM = true;
    unsigned char* O; int ldc; float scale;
    __device__ __forceinline__ void pre(AccRef acc, const Unit&, int, int, int, int, const LAS unsigned char*) const {}
    __device__ __forceinline__ void post(AccRef acc, const Unit& u, int wr, int wc, int fr, int fq, const LAS unsigned char* mt) const {
        const int row0 = u.pm * BM + wr * 64 + fr, col0 = u.pn * BM + wc * 32 + 8 * fq;
#pragma unroll
        for (int ai = 0; ai < 2; ++ai)
#pragma unroll
            for (int m = 0; m < 4; ++m) { unsigned char* rowp = O + (size_t)(row0 + ai * HALF + m * 16) * ldc + col0;
#pragma unroll
                for (int bj = 0; bj < 2; ++bj) { const f32x4 v0 = acc[ai][bj][m][0] * scale, v1 = acc[ai][bj][m][1] * scale;
                    u32x2 w; w.x = pk4_fp8(v0[0], v0[1], v0[2], v0[3]); w.y = pk4_fp8(v1[0], v1[1], v1[2], v1[3]);
                    *(u32x2*)(rowp + bj * HALF) = w; } }
    }
    __device__ __forceinline__ void run(AccRef acc, const Unit& u, int wr, int wc, int fr, int fq, const LAS unsigned char* mt) const { post(acc, u, wr, wc, fr, fq, mt); }
};

struct EpiOutProj {
    static constexpr bool PERM = false;
    const float* x; float* h1; unsigned char* h1f8;
    __device__ __forceinline__ void pre(AccRef acc, const Unit& u, int wr, int wc, int fr, int fq, const LAS unsigned char* mt) const {
        const int row0 = u.pm * BM + wr * 64 + fr, col0 = u.pn * BM + wc * 32 + 4 * fq;
#pragma unroll
        for (int ai = 0; ai < 2; ++ai)
#pragma unroll
            for (int m = 0; m < 4; ++m) { const size_t off = (size_t)(row0 + ai * HALF + m * 16) * DM + col0;
#pragma unroll
                for (int bj = 0; bj < 2; ++bj)
#pragma unroll
                    for (int n = 0; n < 2; ++n) acc[ai][bj][m][n] += *(const f32x4*)(x + off + bj * HALF + n * 16);
                if (m & 1) __builtin_amdgcn_sched_barrier(0); }
    }
    __device__ __forceinline__ void post(AccRef acc, const Unit& u, int wr, int wc, int fr, int fq, const LAS unsigned char* mt) const {
        const int row0 = u.pm * BM + wr * 64 + fr, col0 = u.pn * BM + wc * 32 + 4 * fq;
#pragma unroll
        for (int ai = 0; ai < 2; ++ai)
#pragma unroll
            for (int m = 0; m < 4; ++m) { const size_t off = (size_t)(row0 + ai * HALF + m * 16) * DM + col0;
#pragma unroll
                for (int bj = 0; bj < 2; ++bj)
#pragma unroll
                    for (int n = 0; n < 2; ++n) { const size_t o = off + bj * HALF + n * 16; const f32x4 r = acc[ai][bj][m][n];
                        *(f32x4*)(h1 + o) = r; *(unsigned*)(h1f8 + o) = pk4_fp8(r[0], r[1], r[2], r[3]); } }
    }
    __device__ __forceinline__ void run(AccRef acc, const Unit& u, int wr, int wc, int fr, int fq, const LAS unsigned char* mt) const { pre(acc, u, wr, wc, fr, fq, mt); post(acc, u, wr, wc, fr, fq, mt); }
};

struct EpiUp {
    static constexpr bool PERM = true;
    unsigned char* act;
    __device__ __forceinline__ void pre(AccRef acc, const Unit& u, int wr, int wc, int fr, int fq, const LAS unsigned char* mt) const {
        const int r0 = wr * 64 + fr, cl = 32 * wc + 8 * fq;
        const LAS float* rowA = (const LAS float*)mt; const LAS float* bias = (const LAS float*)(mt + 2048);
        f32x4 bg[2], bl[2];
#pragma unroll
        for (int n = 0; n < 2; ++n) { bg[n] = *(const LAS f32x4*)(bias + cl + 4 * n); bl[n] = *(const LAS f32x4*)(bias + 128 + cl + 4 * n); }
#pragma unroll
        for (int ai = 0; ai < 2; ++ai)
#pragma unroll
            for (int m = 0; m < 4; ++m) { const int r = r0 + ai * HALF + m * 16;
                const float rs = (r < u.rows) ? rowA[r] * 0.03125f : 0.f;
#pragma unroll
                for (int n = 0; n < 2; ++n)
#pragma unroll
                    for (int e = 0; e < 4; ++e) { float g = acc[ai][0][m][n][e] * rs + bg[n][e], l = acc[ai][1][m][n][e] * rs + bl[n][e];
                        g = fminf(g, 7.0f); l = fminf(fmaxf(l, -7.0f), 7.0f); acc[ai][0][m][n][e] = g * sigmoidf_(1.702f * g) * (l + 1.0f); } }
    }
    __device__ __forceinline__ void post(AccRef acc, const Unit& u, int wr, int wc, int fr, int fq, const LAS unsigned char* mt) const {
        const int r0 = wr * 64 + fr, ch = 128 * u.pn + 32 * wc + 8 * fq;
#pragma unroll
        for (int ai = 0; ai < 2; ++ai)
#pragma unroll
            for (int m = 0; m < 4; ++m) { const int r = r0 + ai * HALF + m * 16;
                const f32x4 v0 = acc[ai][0][m][0], v1 = acc[ai][0][m][1];
                u32x2 w; w.x = pk4_fp8(v0[0], v0[1], v0[2], v0[3]); w.y = pk4_fp8(v1[0], v1[1], v1[2], v1[3]);
                *(u32x2*)(act + (size_t)(u.pm * BM + r) * 1024 + ch) = w; }
    }
    __device__ __forceinline__ void run(const f32x4 (&acc)[2][2][4][2], const Unit& u, int wr, int wc, int fr, int fq, const LAS unsigned char* mt) const {
        const int r0 = wr * 64 + fr, cl = 32 * wc + 8 * fq, ch = 128 * u.pn + cl;
        const LAS float* rowA = (const LAS float*)mt; const LAS float* bias = (const LAS float*)(mt + 2048);
        f32x4 bg[2], bl[2];
#pragma unroll
        for (int n = 0; n < 2; ++n) { bg[n] = *(const LAS f32x4*)(bias + cl + 4 * n); bl[n] = *(const LAS f32x4*)(bias + 128 + cl + 4 * n); }
#pragma unroll
        for (int ai = 0; ai < 2; ++ai)
#pragma unroll
            for (int m = 0; m < 4; ++m) { const int r = r0 + ai * HALF + m * 16;
                const float rs = (r < u.rows) ? rowA[r] * 0.03125f : 0.f;
                float o[8];
#pragma unroll
                for (int n = 0; n < 2; ++n)
#pragma unroll
                    for (int e = 0; e < 4; ++e) { float g = acc[ai][0][m][n][e] * rs + bg[n][e], l = acc[ai][1][m][n][e] * rs + bl[n][e];
                        g = fminf(g, 7.0f); l = fminf(fmaxf(l, -7.0f), 7.0f); o[4 * n + e] = g * sigmoidf_(1.702f * g) * (l + 1.0f); }
                u32x2 w; w.x = pk4_fp8(o[0], o[1], o[2], o[3]); w.y = pk4_fp8(o[4], o[5], o[6], o[7]);
                *(u32x2*)(act + (size_t)(u.pm * BM + r) * 1024 + ch) = w; }
    }
};

struct EpiDown {
    static constexpr bool PERM = true;
    unsigned char* y;
    __device__ __forceinline__ void pre(AccRef acc, const Unit& u, int wr, int wc, int fr, int fq, const LAS unsigned char* mt) const {
        const int r0 = wr * 64 + fr, cl = wc * 32 + 8 * fq;
        const LAS float* gateT = (const LAS float*)(mt + 1024); const LAS float* bias = (const LAS float*)(mt + 2048);
        float gt[2][4];
#pragma unroll
        for (int ai = 0; ai < 2; ++ai)
#pragma unroll
            for (int m = 0; m < 4; ++m) gt[ai][m] = gateT[r0 + ai * HALF + m * 16] * 16.0f;
#pragma unroll
        for (int bj = 0; bj < 2; ++bj) { const f32x4 bv0 = *(const LAS f32x4*)(bias + cl + bj * HALF), bv1 = *(const LAS f32x4*)(bias + cl + bj * HALF + 4);
#pragma unroll
            for (int ai = 0; ai < 2; ++ai)
#pragma unroll
                for (int m = 0; m < 4; ++m) { acc[ai][bj][m][0] = (acc[ai][bj][m][0] * 0.03125f + bv0) * gt[ai][m]; acc[ai][bj][m][1] = (acc[ai][bj][m][1] * 0.03125f + bv1) * gt[ai][m]; } }
    }
    __device__ __forceinline__ void post(AccRef acc, const Unit& u, int wr, int wc, int fr, int fq, const LAS unsigned char* mt) const {
        const int r0 = wr * 64 + fr, col0 = u.pn * BM + wc * 32 + 8 * fq;
        const LAS int* slotT = (const LAS int*)mt;
#pragma unroll
        for (int ai = 0; ai < 2; ++ai)
#pragma unroll
            for (int m = 0; m < 4; ++m) { const int r = r0 + ai * HALF + m * 16;
                if (r < u.rows) { unsigned char* rowp = y + (size_t)slotT[r] * 1024 + col0;
#pragma unroll
                    for (int bj = 0; bj < 2; ++bj) { const f32x4 v0 = acc[ai][bj][m][0], v1 = acc[ai][bj][m][1];
                        u32x2 w; w.x = pk4_fp8(v0[0], v0[1], v0[2], v0[3]); w.y = pk4_fp8(v1[0], v1[1], v1[2], v1[3]);
                        *(u32x2*)(rowp + bj * HALF) = w; } } }
    }
    __device__ __forceinline__ void run(AccRef acc, const Unit& u, int wr, int wc, int fr, int fq, const LAS unsigned char* mt) const { pre(acc, u, wr, wc, fr, fq, mt); post(acc, u, wr, wc, fr, fq, mt); }
};

template <bool F8>
__device__ __forceinline__ void p0_transpose_item(const float* W, int ldw, void* WTv, int Kdim, const float* gain, LAS float* scr, int kb, int n0, int src0, int nvalid, int lane) {
    bf16_t* WT = (bf16_t*)WTv;
    const int k0 = 64 * kb;
    f32x4 ld4[8];
#pragma unroll
    for (int i = 0; i < 8; ++i) { const int kk = 8 * i + (lane >> 3), j = (lane & 7) * 4;
        ld4[i] = (f32x4){0.f, 0.f, 0.f, 0.f}; if (j < nvalid) ld4[i] = NT_LD((const f32x4*)(W + (size_t)(k0 + kk) * ldw + src0 + j)); }
#pragma unroll
    for (int i = 0; i < 8; ++i) { const int kk = 8 * i + (lane >> 3), j = (lane & 7) * 4; const float gk = (gain ? gain[k0 + kk] : 1.0f) * (F8 ? 32.0f : 1.0f);
        LAS float* d = scr + kk * 33 + j; d[0] = ld4[i].x * gk; d[1] = ld4[i].y * gk; d[2] = ld4[i].z * gk; d[3] = ld4[i].w * gk; }
    LDS_WAIT(); asm volatile("" ::: "memory");
    const int c = lane & 7;
#pragma unroll
    for (int j = 0; j < 4; ++j) { const int n = (lane >> 3) + 8 * j; const LAS float* s = scr + (8 * c) * 33 + n;
        if constexpr (F8) { u32x2 o; o.x = pk4_fp8(s[0 * 33], s[1 * 33], s[2 * 33], s[3 * 33]); o.y = pk4_fp8(s[4 * 33], s[5 * 33], s[6 * 33], s[7 * 33]);
            *(u32x2*)((unsigned char*)WTv + (size_t)(n0 + n) * Kdim + k0 + 8 * c) = o; }
        else { u32x4 o; o.x = pk2(s[0 * 33], s[1 * 33]); o.y = pk2(s[2 * 33], s[3 * 33]); o.z = pk2(s[4 * 33], s[5 * 33]); o.w = pk2(s[6 * 33], s[7 * 33]);
            *(u32x4*)(WT + (size_t)(n0 + n) * Kdim + k0 + 8 * c) = o; } }
    LDS_WAIT(); asm volatile("" ::: "memory");
}
__device__ __forceinline__ void win_colmap(int nb, int& src0, int& nvalid) {
    const int pn = nb >> 3, j = (nb & 7) * 32, bj = j >> 7, slot = (j & 127) >> 5;
    nvalid = 32;
    if (pn < 2) src0 = (4 * pn + slot) * 64 + 32 * bj;
    else if (pn == 2) src0 = 640 + slot * 64 + 32 * bj;
    else if (pn == 3) { if (slot == 0) src0 = 512 + 32 * bj; else if (slot == 1) src0 = 896 + 32 * bj; else if (slot == 2) src0 = 576 + 32 * bj; else { src0 = 960; nvalid = bj == 0 ? 4 : 0; } }
    else src0 = 964 + 512 * bj + 128 * (pn - 4) + 32 * slot;
}
__device__ __forceinline__ void p0_prologue(const Params& P, LAS unsigned char* lds, int vcu, int G, int wave, int lane) {
    unsigned char* ws = P.ws;
    LAS float* scr = (LAS float*)(lds + wave * 16384);
    const int gw = vcu * NWAVES + wave, NGW = G * NWAVES;
    constexpr int I_IN = 16 * 64, I_OUT = 16 * 32, I_G = 16 * 32, I_P = 4 * 32;
    constexpr int NITEMS = I_IN + I_OUT + I_G + I_P;
    for (int it = gw; it < NITEMS; it += NGW) {
        int r = it;
        if (r < I_IN) { const int kb = r / 64, nb = r % 64; int s0, nv; win_colmap(nb, s0, nv); p0_transpose_item<false>(P.w_in, INW, (bf16_t*)(ws + WS_WIN), 1024, P.g_mix, scr, kb, nb * 32, s0, nv, lane); continue; } r -= I_IN;
        if (r < I_OUT) { const int kb = r / 32, nb = r % 32; p0_transpose_item<false>(P.w_out, 1024, (bf16_t*)(ws + WS_WOUT), 1024, nullptr, scr, kb, nb * 32, nb * 32, 32, lane); continue; } r -= I_OUT;
        if (r < I_G) { const int kb = r / 32, nb = r % 32; p0_transpose_item<true>(P.w_ple_gate, 1024, (unsigned char*)(ws + WS_WG), 1024, P.g_ple, scr, kb, nb * 32, nb * 32, 32, lane); continue; } r -= I_G;
        { const int kb = r / 32, nb = r % 32; p0_transpose_item<false>(P.w_ple_proj, 1024, (bf16_t*)(ws + WS_WP), 256, nullptr, scr, kb, nb * 32, nb * 32, 32, lane); }
    }
    float* rs1 = (float*)(ws + WS_RS1); bf16_t* xb = (bf16_t*)(ws + WS_XB);
    for (int m = gw; m < NTOK; m += NGW) {
        const f32x4* xr = (const f32x4*)(P.x + (size_t)m * DM) + lane; f32x4 v[4]; float s = 0.f;
#pragma unroll
        for (int j = 0; j < 4; ++j) { v[j] = NT_LD(xr + 64 * j); s += (v[j].x * v[j].x + v[j].y * v[j].y) + (v[j].z * v[j].z + v[j].w * v[j].w); }
        s = wave_sum(s);
        u32x2* o8 = (u32x2*)(xb + (size_t)m * DM) + lane;
#pragma unroll
        for (int j = 0; j < 4; ++j) { u32x2 w; w.x = pk2(v[j].x, v[j].y); w.y = pk2(v[j].z, v[j].w); o8[64 * j] = w; }
        if (lane == 0) rs1[m] = 1.0f / sqrtf(s * (1.0f / DM) + EPS);
    }
    bf16_t* pb = (bf16_t*)(ws + WS_PB);
    for (int m = gw; m < NTOK; m += NGW) { const f32x4 v = NT_LD((const f32x4*)(P.p + (size_t)m * 256) + lane); u32x2 w; w.x = pk2(v.x, v.y); w.y = pk2(v.z, v.w); *((u32x2*)(pb + (size_t)m * 256) + lane) = w; }
    f32x2* rope = (f32x2*)(ws + WS_ROPE);
    for (int idx = gw * 64 + lane; idx < SEQ * 32; idx += NGW * 64) { const int t = idx >> 5, i = idx & 31;
        const float inv = exp2f(-(float)i * (13.287712379549449f / 32.0f));
        const float ang = (float)t * inv;
        const double rev = (double)ang * 0.15915494309189535; const float fr = (float)(rev - __builtin_floor(rev));
        rope[idx] = (f32x2){__builtin_amdgcn_cosf(fr), __builtin_amdgcn_sinf(fr)}; }
    float* wrg = (float*)(ws + WS_WRG);
    for (int idx = gw * 64 + lane; idx < 1024 * 32; idx += NGW * 64) wrg[idx] = P.w_router[idx] * P.g_ffn[idx >> 5];
}

__device__ __forceinline__ unsigned fkey(float f) { unsigned u = __builtin_bit_cast(unsigned, f); if (u == 0x80000000u) u = 0u; return u ^ ((unsigned)((int)u >> 31) | 0x80000000u); }
__device__ __forceinline__ int mbcnt64(unsigned long long m) { return __builtin_amdgcn_mbcnt_hi((unsigned)(m >> 32), __builtin_amdgcn_mbcnt_lo((unsigned)m, 0u)); }

template <int NR>
__device__ __forceinline__ unsigned bisect_thr(const unsigned (&v)[NR], unsigned prefix, int startbit) {
    bool exact = false;
#pragma unroll 1
    for (int bit = startbit; bit >= 0; --bit) {
        const unsigned cand = prefix | (1u << bit); int cnt = 0;
#pragma unroll
        for (int r = 0; r < NR; ++r) { cnt += __builtin_popcountll(__ballot(v[r] >= cand)); if ((r & 7) == 7) __builtin_amdgcn_sched_barrier(0); }
        if (cnt >= NSEL) prefix = cand;
        if (cnt == NSEL) { exact = true; break; }
    }
    return exact ? prefix - 1u : prefix;
}
template <int NR, bool EXPL>
__device__ __forceinline__ void compact_sel(const unsigned (&v)[NR], const unsigned (&ci)[NR], unsigned T, LAS unsigned* list, int lane) {
    int cgt = 0;
#pragma unroll
    for (int r = 0; r < NR; ++r) { cgt += __builtin_popcountll(__ballot(v[r] > T)); if ((r & 7) == 7) __builtin_amdgcn_sched_barrier(0); }
    const int need = NSEL - cgt; int base = 0, ties = 0;
#pragma unroll
    for (int r = 0; r < NR; ++r) { const bool gt = v[r] > T, eq = v[r] == T; const unsigned long long em = __ballot(eq);
        const bool sel = gt || (eq && (ties + mbcnt64(em)) < need); const unsigned long long sm = __ballot(sel);
        list[sel ? base + mbcnt64(sm) : NSEL + lane] = EXPL ? ci[r] : (unsigned)(r * 64 + lane);
        base += __builtin_popcountll(sm); ties += __builtin_popcountll(em);
        if ((r & 3) == 3) __builtin_amdgcn_sched_barrier(0); }
}
constexpr int SEL_CAP = 1024;
template <int NR>
__device__ __forceinline__ void select_topk(LAS float* row, LAS unsigned* H, LAS unsigned* list, int lane, bool zero_h) {
    unsigned v[NR];
#pragma unroll
    for (int r = 0; r < NR; ++r) v[r] = fkey(row[r * 64 + lane]);
    LAS u32x4* H4 = (LAS u32x4*)H;
    const u32x4 h0 = H4[2 * lane], h1 = H4[2 * lane + 1];
    if (zero_h) { H4[2 * lane] = (u32x4){0u, 0u, 0u, 0u}; H4[2 * lane + 1] = (u32x4){0u, 0u, 0u, 0u}; }
    const unsigned hw[8] = {h0.x, h0.y, h0.z, h0.w, h1.x, h1.y, h1.z, h1.w};
    unsigned c[16];
#pragma unroll
    for (int i = 0; i < 8; ++i) { c[2 * i] = hw[i] & 0xffffu; c[2 * i + 1] = hw[i] >> 16; }
    unsigned s = 0u;
#pragma unroll
    for (int i = 0; i < 16; ++i) s += c[i];
    unsigned S = s;
#pragma unroll
    for (int off = 1; off < 64; off <<= 1) { const unsigned o = __shfl_down(S, off); if (lane + off < 64) S += o; }
    const unsigned long long okm = __ballot(S >= (unsigned)NSEL);
    bool fast = okm != 0ull; unsigned floorkey = 0u; int C = 0;
    if (fast) {
        const int Ls = 63 - __builtin_clzll(okm);
        unsigned acc = S - s; int bl = -1; unsigned accb = 0u;
#pragma unroll
        for (int b = 15; b >= 0; --b) { acc += c[b]; if (bl < 0 && acc >= (unsigned)NSEL) { bl = b; accb = acc; } }
        const int bstar = __shfl(bl, Ls) + 16 * Ls; C = (int)__shfl(accb, Ls);
        floorkey = (unsigned)bstar << 22;
        fast = (bstar > 1) && (C <= SEL_CAP);
    }
    if (!fast) {
        const unsigned T = bisect_thr<NR>(v, 0u, 31);
        compact_sel<NR, false>(v, v, T, list, lane);
        return;
    }
    LAS unsigned* ckl = (LAS unsigned*)row; LAS unsigned* cil = ckl + 1152;
    { int base = 0;
#pragma unroll
      for (int r = 0; r < NR; ++r) { const bool cnd = v[r] >= floorkey; const unsigned long long m = __ballot(cnd);
          const int pos = cnd ? base + mbcnt64(m) : SEL_CAP + lane;
          ckl[pos] = v[r]; cil[pos] = (unsigned)(r * 64 + lane); base += __builtin_popcountll(m);
          if ((r & 3) == 3) __builtin_amdgcn_sched_barrier(0); } }
    if (C <= 512) {
        unsigned ck[8], ci[8];
#pragma unroll
        for (int j = 0; j < 8; ++j) { const int i = j * 64 + lane; ck[j] = i < C ? ckl[i] : 0u; ci[j] = cil[i]; }
        const unsigned T = (C == NSEL) ? floorkey - 1u : bisect_thr<8>(ck, floorkey, 21);
        compact_sel<8, true>(ck, ci, T, list, lane);
    } else {
        unsigned ck[16], ci[16];
#pragma unroll
        for (int j = 0; j < 16; ++j) { const int i = j * 64 + lane; ck[j] = i < C ? ckl[i] : 0u; ci[j] = cil[i]; }
        const unsigned T = bisect_thr<16>(ck, floorkey, 21);
        compact_sel<16, true>(ck, ci, T, list, lane);
    }
}

typedef short v4i16 __attribute__((ext_vector_type(4)));
constexpr int VROW = 144;

__device__ __forceinline__ void attn_tile(const Params& P, LAS unsigned char* lds, int b, int t0, int wave, int lane) {
    unsigned char* ws = P.ws;
    const bf16_t* QI = (const bf16_t*)(ws + WS_QI); const bf16_t* KI = (const bf16_t*)(ws + WS_KI);
    const bf16_t* Q = (const bf16_t*)(ws + WS_Q); const bf16_t* Kp = (const bf16_t*)(ws + WS_K); const bf16_t* Vp = (const bf16_t*)(ws + WS_V);
    const float* WI = (const float*)(ws + WS_WI); bf16_t* MIX = (bf16_t*)(ws + WS_MIX);
    LAS float* SC = (LAS float*)lds;
    LAS unsigned* list = (LAS unsigned*)(lds + wave * 16384 + 14336);
    LAS unsigned* HIST = (LAS unsigned*)(lds + LDS_MISC);
    const int tokbase = b * SEQ;
    const bool need_sel = t0 >= 256;
    if (need_sel) {
        const int nkt = (t0 + 8 + 31) >> 5;
        bf16x8 a[4]; f32x4 w[4];
        { const bf16_t* src = QI + (size_t)(tokbase + t0 + ((lane & 31) >> 2)) * 256 + (lane & 3) * 64 + 8 * (lane >> 5);
#pragma unroll
          for (int ks = 0; ks < 4; ++ks) a[ks] = *(const bf16x8*)(src + 16 * ks); }
#pragma unroll
        for (int g = 0; g < 4; ++g) w[g] = *(const f32x4*)(WI + (size_t)(tokbase + t0 + 2 * g + (lane >> 5)) * 4);
        for (int kt0 = wave; kt0 < nkt; kt0 += 4 * NWAVES) {
            bf16x8 bf[4][4];
#pragma unroll
            for (int u = 0; u < 4; ++u) { const int kt = kt0 + u * NWAVES;
                if (kt < nkt) { const bf16_t* ksrc = KI + ((size_t)((tokbase >> 5) + kt) * 256 + lane) * 8;
#pragma unroll
                    for (int ks = 0; ks < 4; ++ks) bf[u][ks] = *(const bf16x8*)(ksrc + 512 * ks); } }
#pragma unroll
            for (int u = 0; u < 4; ++u) { const int kt = kt0 + u * NWAVES;
                if (kt < nkt) {
                    const int key = kt * 32 + (lane & 31);
                    f32x16 acc;
#pragma unroll
                    for (int i = 0; i < 16; ++i) acc[i] = 0.f;
#pragma unroll
                    for (int ks = 0; ks < 4; ++ks) acc = __builtin_amdgcn_mfma_f32_32x32x16_bf16(a[ks], bf[u][ks], acc, 0, 0, 0);
#pragma unroll
                    for (int g = 0; g < 4; ++g) { float sc = 0.f;
#pragma unroll
                        for (int h = 0; h < 4; ++h) sc = fmaf(fmaxf(acc[4 * g + h], 0.f), w[g][h], sc);
                        const int ql = 2 * g + (lane >> 5);
                        if (key > t0 + ql) sc = -INFINITY;
                        SC[ql * 4096 + key] = sc;
                        if (key <= t0 + ql) { const unsigned ub = __builtin_bit_cast(unsigned, sc);
                            const unsigned bin = (ub >> 22) ^ (((unsigned)((int)ub >> 31) & 0x1ffu) | 0x200u);
                            __hip_atomic_fetch_add(HIST + ql * 512 + (bin >> 1), 1u << ((bin & 1u) << 4), __ATOMIC_RELAXED, __HIP_MEMORY_SCOPE_WORKGROUP); } }
                } }
        }
        { const int npad = ((t0 + 8 + 1023) >> 10) << 10;
          for (int i = nkt * 32 + (int)threadIdx.x; i < npad; i += NTHR) {
#pragma unroll
              for (int q = 0; q < 8; ++q) SC[q * 4096 + i] = -INFINITY; } }
    }
    __syncthreads();
    const int t = t0 + wave, tok = tokbase + t;
    if (need_sel) {
        LAS float* row = SC + wave * 4096; LAS unsigned* H = HIST + wave * 512; const int n = t + 1;
        if (n <= 1024) select_topk<16>(row, H, list, lane, true);
        else if (n <= 2048) select_topk<32>(row, H, list, lane, true);
        else if (n <= 3072) select_topk<48>(row, H, list, lane, true);
        else select_topk<64>(row, H, list, lane, true);
    } else {
#pragma unroll
        for (int i = 0; i < 4; ++i) list[i * 64 + lane] = (unsigned)(i * 64 + lane);
    }
    const int nvalid = need_sel ? NSEL : (t + 1);
    const int ngrp = (nvalid + 31) >> 5;
    const int hd = lane & 15, g = lane >> 4;
    bf16x8 qf0, qf1;
#pragma unroll
    for (int i = 0; i < 8; ++i) { qf0[i] = 0; qf1[i] = 0; }
    if (hd < 8) { const bf16_t* qs = Q + (size_t)tok * 512 + hd * 64 + 8 * g; qf0 = *(const bf16x8*)qs; qf1 = *(const bf16x8*)(qs + 32); }
    float m = -INFINITY, ssum = 0.f;
    f32x4 o[4];
#pragma unroll
    for (int dt = 0; dt < 4; ++dt) o[dt] = (f32x4){0.f, 0.f, 0.f, 0.f};
    LAS unsigned char* vreg = lds + wave * 16384;
    u32x4 kfA[4], kfB[4]; u32x4 vvA[4], vvB[4];
    LAS unsigned char* kbuf = vreg + 9216;
#define ATT_LOAD(KF, VV, G_) do { const int nb_ = (G_) * 32; \
        _Pragma("unroll") for (int i_ = 0; i_ < 4; ++i_) { const unsigned idx_ = list[nb_ + (lane >> 3) + 8 * i_]; const size_t ro_ = (size_t)(tokbase + idx_) * 64 + 8 * (lane & 7); \
            KF[i_] = *(const u32x4*)(Kp + ro_); VV[i_] = *(const u32x4*)(Vp + ro_); } } while (0)
#define ATT_GROUP(KF, VV, G_, VBUF) do { \
        LAS unsigned char* vbuf_ = (VBUF); \
        _Pragma("unroll") for (int i_ = 0; i_ < 4; ++i_) *(LAS u32x4*)(kbuf + ((lane >> 3) + 8 * i_) * VROW + (lane & 7) * 16) = KF[i_]; \
        const LAS unsigned char* kr_ = kbuf + hd * VROW + 16 * g; \
        const bf16x8 ka0_ = *(const LAS bf16x8*)kr_, ka1_ = *(const LAS bf16x8*)(kr_ + 64), kb0_ = *(const LAS bf16x8*)(kr_ + 16 * VROW), kb1_ = *(const LAS bf16x8*)(kr_ + 16 * VROW + 64); \
        f32x4 sa_ = {0.f, 0.f, 0.f, 0.f}, sb_ = {0.f, 0.f, 0.f, 0.f}; \
        sa_ = __builtin_amdgcn_mfma_f32_16x16x32_bf16(ka0_, qf0, sa_, 0, 0, 0); sa_ = __builtin_amdgcn_mfma_f32_16x16x32_bf16(ka1_, qf1, sa_, 0, 0, 0); \
        sb_ = __builtin_amdgcn_mfma_f32_16x16x32_bf16(kb0_, qf0, sb_, 0, 0, 0); sb_ = __builtin_amdgcn_mfma_f32_16x16x32_bf16(kb1_, qf1, sb_, 0, 0, 0); \
        _Pragma("unroll") for (int i_ = 0; i_ < 4; ++i_) *(LAS u32x4*)(vbuf_ + ((lane >> 3) + 8 * i_) * VROW + (lane & 7) * 16) = VV[i_]; \
        if ((G_) + 2 < ngrp) ATT_LOAD(KF, VV, (G_) + 2); \
        float l_[8]; float mloc_ = -INFINITY; \
        _Pragma("unroll") for (int r_ = 0; r_ < 4; ++r_) { const int sl_ = (G_) * 32 + 4 * g + r_; \
            l_[r_] = sl_ < nvalid ? sa_[r_] * 0.125f : -INFINITY; l_[4 + r_] = (sl_ + 16) < nvalid ? sb_[r_] * 0.125f : -INFINITY; \
            mloc_ = fmaxf(mloc_, fmaxf(l_[r_], l_[4 + r_])); } \
        mloc_ = fmaxf(mloc_, __shfl_xor(mloc_, 16)); mloc_ = fmaxf(mloc_, __shfl_xor(mloc_, 32)); \
        const float mnew_ = fmaxf(m, mloc_), alpha_ = __expf(m - mnew_); m = mnew_; \
        float ps_ = 0.f; \
        _Pragma("unroll") for (int r_ = 0; r_ < 8; ++r_) { l_[r_] = __expf(l_[r_] - mnew_); ps_ += l_[r_]; } \
        ssum = ssum * alpha_ + ps_; \
        bf16x8 pf_; \
        { const u32x4 pw_ = {cvt_pk_bf16(l_[0], l_[1]), cvt_pk_bf16(l_[2], l_[3]), cvt_pk_bf16(l_[4], l_[5]), cvt_pk_bf16(l_[6], l_[7])}; pf_ = __builtin_bit_cast(bf16x8, pw_); } \
        LAS unsigned char* ta_ = vbuf_ + (4 * g + (hd >> 2)) * VROW + (hd & 3) * 8; \
        _Pragma("unroll") for (int dt_ = 0; dt_ < 4; ++dt_) { \
            const v4i16 lo_ = __builtin_amdgcn_ds_read_tr16_b64_v4i16((LAS v4i16*)(ta_ + dt_ * 32)); \
            const v4i16 hi_ = __builtin_amdgcn_ds_read_tr16_b64_v4i16((LAS v4i16*)(ta_ + 16 * VROW + dt_ * 32)); \
            bf16x8 vf_; vf_[0] = lo_[0]; vf_[1] = lo_[1]; vf_[2] = lo_[2]; vf_[3] = lo_[3]; vf_[4] = hi_[0]; vf_[5] = hi_[1]; vf_[6] = hi_[2]; vf_[7] = hi_[3]; \
            o[dt_] = __builtin_amdgcn_mfma_f32_16x16x32_bf16(vf_, pf_, o[dt_] * alpha_, 0, 0, 0); } } while (0)
    ATT_LOAD(kfA, vvA, 0);
    if (ngrp > 1) ATT_LOAD(kfB, vvB, 1);
#pragma unroll 1
    for (int grp = 0; grp < ngrp; grp += 2) {
        ATT_GROUP(kfA, vvA, grp, vreg);
        if (grp + 1 < ngrp) ATT_GROUP(kfB, vvB, grp + 1, vreg + 4608);
    }
#undef ATT_LOAD
#undef ATT_GROUP
    ssum += __shfl_xor(ssum, 16); ssum += __shfl_xor(ssum, 32);
    const float inv = 1.0f / ssum;
    if (hd < 8) {
        bf16_t* op = MIX + (size_t)tok * 1024 + hd * 64 + 4 * g;
#pragma unroll
        for (int dt = 0; dt < 4; ++dt) { u32x2 w; w.x = cvt_pk_bf16(o[dt][0] * inv, o[dt][1] * inv); w.y = cvt_pk_bf16(o[dt][2] * inv, o[dt][3] * inv); *(u32x2*)(op + 16 * dt) = w; }
    }
    __syncthreads();
}

__device__ __forceinline__ void conv_tile(const Params& P, LAS unsigned char* lds, int tile, int tid, int wave, int lane) {
    unsigned char* ws = P.ws;
    const bf16_t* HG = (const bf16_t*)(ws + WS_HGLU); bf16_t* MIX = (bf16_t*)(ws + WS_MIX);
    LAS f32x2* part = (LAS f32x2*)(lds + LDS_MISC + 1024);
    LAS f32x2* stat = part + 256;
    LAS bf16_t* Lin = (LAS bf16_t*)lds;
    LAS bf16_t* Lout = (LAS bf16_t*)(lds + 65536);
    const int tok0 = tile * 32, t0 = tok0 & (SEQ - 1), c = tid;
    for (int ch = tid; ch < 62 * 64; ch += NTHR) { const int r = ch >> 6, cc = ch & 63; const int tt = t0 - 30 + r;
        u32x4 v = {0u, 0u, 0u, 0u}; if (tt >= 0) v = *(const u32x4*)(HG + (size_t)(tok0 - 30 + r) * 512 + cc * 8);
        *(LAS u32x4*)(Lin + r * 512 + cc * 8) = v; }
    __syncthreads();
    float in[62];
#pragma unroll
    for (int r = 0; r < 62; ++r) in[r] = __builtin_bit_cast(float, (unsigned)Lin[r * 512 + c] << 16);
    float out[32];
    const float bias = P.dw_b[c];
#pragma unroll
    for (int i = 0; i < 32; ++i) out[i] = bias;
#pragma unroll
    for (int j = 0; j < 31; ++j) { const float wj = P.dw_w[j * 512 + c];
#pragma unroll
        for (int i = 0; i < 32; ++i) out[i] = fmaf(in[i + j], wj, out[i]); }
#pragma unroll
    for (int i = 0; i < 32; ++i) { const float s1 = wave_sum(out[i]), s2 = wave_sum(out[i] * out[i]); if (lane == 0) part[i * 8 + wave] = (f32x2){s1, s2}; }
    __syncthreads();
    if (tid < 32) { float s1 = 0.f, s2 = 0.f;
#pragma unroll
        for (int w = 0; w < 8; ++w) { const f32x2 pp = part[tid * 8 + w]; s1 += pp.x; s2 += pp.y; }
        const float mean = s1 * (1.0f / 512.0f), var = fmaxf(s2 * (1.0f / 512.0f) - mean * mean, 0.f);
        stat[tid] = (f32x2){mean, 1.0f / sqrtf(var + EPS)}; }
    __syncthreads();
    const float lgc = P.ln_g[c], lbc = P.ln_b[c];
#pragma unroll
    for (int i = 0; i < 32; ++i) { const f32x2 st = stat[i]; const float y = (out[i] - st.x) * st.y * lgc + lbc; const float sl = y * sigmoidf_(y);
        Lout[i * 512 + c] = (bf16_t)f2bf(sl); }
    __syncthreads();
    for (int ch = tid; ch < 32 * 64; ch += NTHR) { const int r = ch >> 6, cc = ch & 63;
        *(u32x4*)(MIX + (size_t)(tok0 + r) * 1024 + 512 + cc * 8) = *(const LAS u32x4*)(Lout + r * 512 + cc * 8); }
    __syncthreads();
}

constexpr int MW_UP = 32 * 16 * 64, MW_DN = 32 * 16 * 32, MW_ITEMS = MW_UP + MW_DN;
__device__ __forceinline__ void mw_decode(const Params& P, int it, const float*& src, int& ldw, unsigned char*& dst, const float*& gain) {
    unsigned char* ws = P.ws;
    if (it < MW_UP) { const int e = it >> 10, rr = it & 1023, kb = rr >> 6, nb = rr & 63, pn = nb >> 3, j = (nb & 7) * 32, bj = j >> 7, jj = j & 127;
        src = P.w_up + (size_t)e * 1024 * 2048 + (size_t)(kb * 64) * 2048 + 1024 * bj + 128 * pn + jj; ldw = 2048;
        dst = ws + WS_WUP + (size_t)e * 2048 * 1024 + (size_t)(nb * 32) * 1024 + kb * 64; gain = P.g_ffn + kb * 64; }
    else { const int r = it - MW_UP, e = r >> 9, rr = r & 511, kb = rr >> 5, nb = rr & 31;
        src = P.w_down + (size_t)e * 1024 * 1024 + (size_t)(kb * 64) * 1024 + nb * 32; ldw = 1024;
        dst = ws + WS_WDOWN + (size_t)e * 1024 * 1024 + (size_t)(nb * 32) * 1024 + kb * 64; gain = nullptr; }
}
#define MW_LOAD(LD, it_) do { if ((it_) < MW_ITEMS) { const float* src_; int ldw_; unsigned char* dst_; const float* gain_; mw_decode(P, (it_), src_, ldw_, dst_, gain_); \
        _Pragma("unroll") for (int i_ = 0; i_ < 8; ++i_) LD[i_] = NT_LD((const f32x4*)(src_ + (size_t)(8 * i_ + (lane >> 3)) * ldw_ + (lane & 7) * 4)); } } while (0)
#define MW_FINISH(LD, it_) do { if ((it_) < MW_ITEMS) { const float* src_; int ldw_; unsigned char* dst_; const float* gain_; mw_decode(P, (it_), src_, ldw_, dst_, gain_); \
        _Pragma("unroll") for (int i_ = 0; i_ < 8; ++i_) { const int kk_ = 8 * i_ + (lane >> 3), j_ = (lane & 7) * 4; const float gk_ = (gain_ ? gain_[kk_] : 1.0f) * 32.0f; \
            LAS float* d_ = scr + kk_ * 33 + j_; d_[0] = LD[i_].x * gk_; d_[1] = LD[i_].y * gk_; d_[2] = LD[i_].z * gk_; d_[3] = LD[i_].w * gk_; } \
        LDS_WAIT(); asm volatile("" ::: "memory"); \
        const int c_ = lane & 7; \
        _Pragma("unroll") for (int j_ = 0; j_ < 4; ++j_) { const int n_ = (lane >> 3) + 8 * j_; const LAS float* sp_ = scr + (8 * c_) * 33 + n_; \
            u32x2 o_; o_.x = pk4_fp8(sp_[0 * 33], sp_[1 * 33], sp_[2 * 33], sp_[3 * 33]); o_.y = pk4_fp8(sp_[4 * 33], sp_[5 * 33], sp_[6 * 33], sp_[7 * 33]); \
            *(u32x2*)(dst_ + (size_t)n_ * 1024 + 8 * c_) = o_; } \
        LDS_WAIT(); asm volatile("" ::: "memory"); } } while (0)
__device__ __forceinline__ void moe_weight_convert(const Params& P, LAS float* scr, int cw, int ncw, int lane) {
    f32x4 l0[8], l1[8], l2[8], l3[8];
    MW_LOAD(l0, cw); MW_LOAD(l1, cw + ncw); MW_LOAD(l2, cw + 2 * ncw);
    for (int base = cw; base < MW_ITEMS; base += 4 * ncw) {
        MW_LOAD(l3, base + 3 * ncw); MW_FINISH(l0, base);
        MW_LOAD(l0, base + 4 * ncw); MW_FINISH(l1, base + ncw);
        MW_LOAD(l1, base + 5 * ncw); MW_FINISH(l2, base + 2 * ncw);
        MW_LOAD(l2, base + 6 * ncw); MW_FINISH(l3, base + 3 * ncw);
    }
}
#undef MW_LOAD
#undef MW_FINISH

__device__ __forceinline__ void router_phase(const Params& P, LAS unsigned char* lds, int blk, int G, int tid, int wave, int lane) {
    unsigned char* ws = P.ws;
    const float* h1 = (const float*)(ws + WS_H1); const float* wrg = (const float*)(ws + WS_WRG);
    int* list = (int*)(ws + WS_LIST); float* lscale = (float*)(ws + WS_LSCALE); float* lgate = (float*)(ws + WS_LGATE);
    unsigned* cntg = (unsigned*)(ws + WS_CTL) + CW_CNT;
    LAS float* WL = (LAS float*)lds;
    LAS int* lcnt = (LAS int*)(lds + LDS_MISC + 1024);
    LAS int* gbase = lcnt + 32;
    LAS int* rec_e = gbase + 32;
    LAS int* rec_p = rec_e + 512;
    LAS float* rec_g = (LAS float*)(rec_p + 512);
    LAS float* rec_s = rec_g + 512;
    for (int i = tid; i < 8192; i += NTHR) ((LAS f32x4*)WL)[i] = ((const f32x4*)wrg)[i];
    __syncthreads();
    const int tl = lane & 31, half = lane >> 5;
    for (int chunk = blk; chunk < NTOK / 128; chunk += G) {
        if (tid < 32) lcnt[tid] = 0;
        __syncthreads();
        if (wave < 4) {
            const int tloc = wave * 32 + tl, tok = chunk * 128 + tloc;
            const float* hrow = h1 + (size_t)tok * DM + 4 * half;
            f32x16 acc;
#pragma unroll
            for (int i = 0; i < 16; ++i) acc[i] = 0.f;
            float ss = 0.f;
#pragma unroll 1
            for (int k0 = 0; k0 < DM; k0 += 32) {
                f32x4 hv[4];
#pragma unroll
                for (int i = 0; i < 4; ++i) hv[i] = *(const f32x4*)(hrow + k0 + 8 * i);
#pragma unroll
                for (int i = 0; i < 4; ++i) {
                    ss = fmaf(hv[i].x, hv[i].x, fmaf(hv[i].y, hv[i].y, fmaf(hv[i].z, hv[i].z, fmaf(hv[i].w, hv[i].w, ss))));
#pragma unroll
                    for (int j = 0; j < 4; ++j) { const float wv = WL[(k0 + 8 * i + 4 * half + j) * 32 + tl];
                        acc = __builtin_amdgcn_mfma_f32_32x32x2f32(wv, hv[i][j], acc, 0, 0, 0); }
                }
            }
            ss += __shfl_xor(ss, 32);
            const float rs = 1.0f / sqrtf(ss * (1.0f / DM) + EPS);
            float v[16];
#pragma unroll
            for (int r = 0; r < 16; ++r) v[r] = acc[r] * rs + P.b_router[(r & 3) + 8 * (r >> 2) + 4 * half];
            float tv[4]; int te[4];
#pragma unroll
            for (int q = 0; q < 4; ++q) { float bv = -INFINITY; int be = 64;
#pragma unroll
                for (int r = 0; r < 16; ++r) { const int e = (r & 3) + 8 * (r >> 2) + 4 * half; if (v[r] > bv || (v[r] == bv && e < be)) { bv = v[r]; be = e; } }
#pragma unroll
                for (int r = 0; r < 16; ++r) { const int e = (r & 3) + 8 * (r >> 2) + 4 * half; if (e == be) v[r] = -INFINITY; }
                tv[q] = bv; te[q] = be; }
            float cv[8]; int ce[8];
#pragma unroll
            for (int q = 0; q < 4; ++q) { cv[q] = tv[q]; ce[q] = te[q]; cv[4 + q] = __shfl_xor(tv[q], 32); ce[4 + q] = __shfl_xor(te[q], 32); }
#pragma unroll
            for (int q = 0; q < 4; ++q) { float bv = -INFINITY; int be = 64;
#pragma unroll
                for (int r = 0; r < 8; ++r) if (cv[r] > bv || (cv[r] == bv && ce[r] < be)) { bv = cv[r]; be = ce[r]; }
#pragma unroll
                for (int r = 0; r < 8; ++r) if (ce[r] == be) cv[r] = -INFINITY;
                tv[q] = bv; te[q] = be; }
            const float e1 = __expf(tv[1] - tv[0]), e2 = __expf(tv[2] - tv[0]), e3 = __expf(tv[3] - tv[0]);
            const float is = 1.0f / (1.0f + e1 + e2 + e3);
            if (half == 0) {
                const float gq[4] = {is, e1 * is, e2 * is, e3 * is};
#pragma unroll
                for (int q = 0; q < 4; ++q) { const int lp = atomicAdd((int*)&lcnt[te[q]], 1); const int si = tloc * 4 + q; rec_e[si] = te[q]; rec_p[si] = lp; rec_g[si] = gq[q]; }
                rec_s[tloc] = rs;
            }
        }
        __syncthreads();
        if (tid < 32) gbase[tid] = (int)atomicAdd(cntg + 64 * tid, (unsigned)lcnt[tid]);
        __syncthreads();
        { const int si = tid, ee = rec_e[si], pos = gbase[ee] + rec_p[si], li = ee * NTOK + pos;
          list[li] = (chunk * 128) * 4 + si; lscale[li] = rec_s[si >> 2]; lgate[li] = rec_g[si]; }
        __syncthreads();
    }
}

__device__ __forceinline__ void combine_phase(const Params& P, int gw, int NGW, int lane) {
    unsigned char* ws = P.ws;
    float* h1 = (float*)(ws + WS_H1); bf16_t* h1b = (bf16_t*)(ws + WS_H1B); const unsigned char* y = ws + WS_Y; float* rs3 = (float*)(ws + WS_RS3);
    for (int m = gw; m < NTOK; m += NGW) {
        const f32x4* hr = (const f32x4*)(h1 + (size_t)m * DM) + lane; f32x4 v[4]; float s = 0.f;
#pragma unroll
        for (int j = 0; j < 4; ++j) v[j] = NT_LD(hr + 64 * j);
#pragma unroll
        for (int k = 0; k < 4; ++k) { const unsigned* yr = (const unsigned*)(y + (size_t)(m * 4 + k) * DM) + lane;
#pragma unroll
            for (int j = 0; j < 4; ++j) { const unsigned w = NT_LD(yr + 64 * j); const f32x2 lo = __builtin_amdgcn_cvt_pk_f32_fp8((int)w, false), hi = __builtin_amdgcn_cvt_pk_f32_fp8((int)w, true);
                v[j].x += lo.x * 0.0625f; v[j].y += lo.y * 0.0625f; v[j].z += hi.x * 0.0625f; v[j].w += hi.y * 0.0625f; } }
        u32x2* o8 = (u32x2*)(h1b + (size_t)m * DM) + lane; unsigned* o4 = (unsigned*)(ws + WS_H1F8 + (size_t)m * DM) + lane;
#pragma unroll
        for (int j = 0; j < 4; ++j) { u32x2 w; w.x = pk2(v[j].x, v[j].y); w.y = pk2(v[j].z, v[j].w); o8[64 * j] = w; o4[64 * j] = pk4_fp8(v[j].x, v[j].y, v[j].z, v[j].w);
            s += (v[j].x * v[j].x + v[j].y * v[j].y) + (v[j].z * v[j].z + v[j].w * v[j].w); }
        s = wave_sum(s);
        if (lane == 0) rs3[m] = 1.0f / sqrtf(s * (1.0f / DM) + EPS);
    }
}

__device__ __forceinline__ void final_phase(const Params& P, int gw, int NGW, int lane) {
    unsigned char* ws = P.ws;
    const bf16_t* h2b = (const bf16_t*)(ws + WS_H1B); const bf16_t* pj = (const bf16_t*)(ws + WS_PJ); const unsigned char* G = ws + WS_G; const float* rs3 = (const float*)(ws + WS_RS3);
    f32x4 gv[4];
#pragma unroll
    for (int j = 0; j < 4; ++j) gv[j] = *((const f32x4*)P.g_final + lane + 64 * j);
    for (int m = gw; m < NTOK; m += NGW) {
        const u32x2* hr = (const u32x2*)(h2b + (size_t)m * DM) + lane; const u32x2* pr = (const u32x2*)(pj + (size_t)m * DM) + lane; const unsigned* gr = (const unsigned*)(G + (size_t)m * DM) + lane;
        const float r3 = rs3[m]; f32x4 v[4]; float s = 0.f;
#pragma unroll
        for (int j = 0; j < 4; ++j) { const u32x2 hw = NT_LD(hr + 64 * j), pw = NT_LD(pr + 64 * j); const unsigned gw2 = NT_LD(gr + 64 * j);
            const f32x2 glo = __builtin_amdgcn_cvt_pk_f32_fp8((int)gw2, false), ghi = __builtin_amdgcn_cvt_pk_f32_fp8((int)gw2, true);
            v[j].x = bf_lo(hw.x) + bf_lo(pw.x) * sigmoidf_(glo.x * r3); v[j].y = bf_hi(hw.x) + bf_hi(pw.x) * sigmoidf_(glo.y * r3);
            v[j].z = bf_lo(hw.y) + bf_lo(pw.y) * sigmoidf_(ghi.x * r3); v[j].w = bf_hi(hw.y) + bf_hi(pw.y) * sigmoidf_(ghi.y * r3);
            s += (v[j].x * v[j].x + v[j].y * v[j].y) + (v[j].z * v[j].z + v[j].w * v[j].w); }
        s = wave_sum(s); const float rs = 1.0f / sqrtf(s * (1.0f / DM) + EPS);
        f32x4* orow = (f32x4*)(P.out + (size_t)m * DM) + lane;
#pragma unroll
        for (int j = 0; j < 4; ++j) NT_ST(v[j] * rs * gv[j], orow + 64 * j);
    }
}

#define XB_TMO      128
#define XB_XCNT(j)  (256  + 64 * (j))
#define XB_XSUB(j)  (1280 + 64 * (j))
#define XB_XGEN(j)  (2304 + 64 * (j))
#define XB_TOP      3328
#define XB_TOPGEN   3392
#define XCD_BAR_WORDS 3456
#define XB_SPIN_CAP (1u << 18)
__device__ __forceinline__ unsigned xb_ld(unsigned* p)              { return __hip_atomic_load(p, __ATOMIC_RELAXED, __HIP_MEMORY_SCOPE_AGENT); }
__device__ __forceinline__ unsigned xb_add(unsigned* p, unsigned v) { return __hip_atomic_fetch_add(p, v, __ATOMIC_RELAXED, __HIP_MEMORY_SCOPE_AGENT); }
__device__ __forceinline__ unsigned xb_xcc_id() { return (unsigned)__builtin_amdgcn_s_getreg((3 << 11) | 20) & 0xFu; }
#define XB_SPIN(cond, bar) do { unsigned _sp = 0; while (cond) { __builtin_amdgcn_s_sleep(1); \
    if ((++_sp & 255u) == 0u) { if (xb_ld(&(bar)[XB_TMO])) break; if (_sp > XB_SPIN_CAP) { atomicAdd(&(bar)[XB_TMO], 1u); break; } } } } while (0)
struct XcdBarrier { unsigned* bar; unsigned x; volatile LAS unsigned* st; };
__device__ __forceinline__ XcdBarrier xcd_barrier_post(unsigned* bar, volatile LAS unsigned* st) {
    XcdBarrier b; b.bar = bar; b.x = xb_xcc_id(); b.st = st;
    if (threadIdx.x == 0) (void)xb_add(&bar[XB_XCNT(b.x)], 1u);
    return b;
}
__device__ __forceinline__ void xcd_barrier_complete(unsigned* bar, unsigned x, unsigned& nloc, unsigned& nx) {
    const unsigned G = gridDim.x * gridDim.y * gridDim.z;
    unsigned sum, cnt, mine, sp = 0u;
    for (;;) {
        sum = 0u; cnt = 0u; mine = 0u;
#pragma unroll
        for (unsigned j = 0; j < 16; ++j) { const unsigned c = xb_ld(&bar[XB_XCNT(j)]); sum += c; cnt += (c > 0u) ? 1u : 0u; mine = (j == x) ? c : mine; }
        if (sum == G) break;
        __builtin_amdgcn_s_sleep(1);
        if ((++sp & 255u) == 0u) { if (xb_ld(&bar[XB_TMO])) break; if (sp > XB_SPIN_CAP) { atomicAdd(&bar[XB_TMO], 1u); break; } }
    }
    nloc = mine > 0u ? mine : 1u; nx = cnt > 0u ? cnt : 1u;
}
__device__ __forceinline__ void xcd_barrier(const XcdBarrier& b) {
    asm volatile("s_waitcnt vmcnt(0)" ::: "memory");
    __syncthreads();
    if (threadIdx.x == 0) {
        unsigned* bar = b.bar;
        __builtin_amdgcn_s_waitcnt(0);
        unsigned nloc = b.st[0], nx = b.st[1];
        if (nloc == 0u) { xcd_barrier_complete(bar, b.x, nloc, nx); b.st[0] = nloc; b.st[1] = nx; }
        const unsigned old = xb_add(&bar[XB_XSUB(b.x)], 1u);
        const unsigned gen = old / nloc;
        if (old + 1u == (gen + 1u) * nloc) {
            __builtin_amdgcn_fence(__ATOMIC_RELEASE, "agent");
            asm volatile("s_waitcnt vmcnt(0)" ::: "memory");
            const unsigned og = xb_add(&bar[XB_TOP], 1u);
            const unsigned tg = og / nx;
            if (og + 1u == (tg + 1u) * nx) xb_add(&bar[XB_TOPGEN], 1u);
            else XB_SPIN(xb_ld(&bar[XB_TOPGEN]) == tg, bar);
            __builtin_amdgcn_fence(__ATOMIC_ACQUIRE, "agent");
            xb_add(&bar[XB_XGEN(b.x)], 1u);
            asm volatile("s_waitcnt vmcnt(0)" ::: "memory");
        } else {
            XB_SPIN(xb_ld(&bar[XB_XGEN(b.x)]) == gen, bar);
            __builtin_amdgcn_fence(__ATOMIC_ACQUIRE, "agent");
            asm volatile("s_waitcnt vmcnt(0)" ::: "memory");
        }
    }
    __syncthreads();
}

constexpr int NPHASE = 10;
__global__ void __launch_bounds__(NTHR, 2) fwd_kernel(Params P) {
    extern __shared__ __attribute__((aligned(16))) unsigned char lds_raw[];
    LAS unsigned char* lds = (LAS unsigned char*)lds_raw;
    cg::grid_group grid = cg::this_grid();
    const int tid = threadIdx.x, wave = __builtin_amdgcn_readfirstlane(tid >> 6);
    const int G = gridDim.x, bx = blockIdx.x;
#define FRESH_LANE(name) int name = (int)__builtin_amdgcn_mbcnt_hi(~0u, __builtin_amdgcn_mbcnt_lo(~0u, 0u)); asm volatile("" : "+v"(name))
    const int vcu = (G % 8 == 0) ? (bx % 8) * (G / 8) + bx / 8 : bx;
    const int NGW = G * NWAVES;
    unsigned char* ws = P.ws;
    const int lo = P.ph_lo, hi = P.ph_hi;
#define IN(k) (lo <= (k) && (k) < hi)
    volatile LAS unsigned* xst = (volatile LAS unsigned*)(lds + LDS_XB);
    if (tid < 2) xst[tid] = 0u;
    __syncthreads();
    const XcdBarrier xbar = xcd_barrier_post((unsigned*)(ws + WS_CTL) + CW_BAR, xst);
#define SYNC(k) do { if (IN(k) && IN((k) + 1)) { if ((k) == 0) grid.sync(); else xcd_barrier(xbar); } } while (0)

    if (IN(0)) { FRESH_LANE(lane); p0_prologue(P, lds, vcu, G, wave, lane); }
    SYNC(0);
    if (IN(1)) {
        { pg8::DenseSched S; S.init((const bf16_t*)(ws + WS_XB), (const bf16_t*)(ws + WS_WIN), NTOK, 2048, 1024, G, bx);
          EpiInProj E{(const float*)(ws + WS_RS1), (const f32x2*)(ws + WS_ROPE), P.glu_b, (bf16_t*)(ws + WS_Q), (bf16_t*)(ws + WS_K), (bf16_t*)(ws + WS_V), (bf16_t*)(ws + WS_QI), (bf16_t*)(ws + WS_KI), (bf16_t*)(ws + WS_HGLU), (float*)(ws + WS_WI)};
          pg8::gemm_phase<EpiInProj, pg8::DenseSched, false>(lds, S, E); }
        { pg8::DenseSched S; S.init((const bf16_t*)(ws + WS_PB), (const bf16_t*)(ws + WS_WP), NTOK, 1024, 256, G, bx);
          EpiBf16Plain E{(bf16_t*)(ws + WS_PJ), 1024, 1.0f};
          pg8::gemm_phase<EpiBf16Plain, pg8::DenseSched, false>(lds, S, E); }
    }
    SYNC(1);
    if (IN(2)) {
        FRESH_LANE(lane);
        for (int i = tid; i < 4096; i += NTHR) ((LAS unsigned*)(lds + LDS_MISC))[i] = 0u;
        __syncthreads();
        unsigned* ctl = (unsigned*)(ws + WS_CTL);
        volatile LAS int* qw = (volatile LAS int*)(lds + LDS_XB + 32);
        if (G % 8 == 0 && G >= 128) { const int ncv = 8; if ((bx >> 3) < ncv) moe_weight_convert(P, (LAS float*)(lds + wave * 16384), (bx * NWAVES) + wave, ncv * 8 * NWAVES, lane); }
        else { moe_weight_convert(P, (LAS float*)(lds + wave * 16384), bx * NWAVES + wave, G * NWAVES, lane); }
        __syncthreads();
        for (int db = 0; db < NB; ++db) { const int b = (bx + db) & 7;
            for (;;) {
                if (tid == 0) qw[0] = (int)atomicAdd(ctl + CW_AQ + 64 * b, 1u);
                __syncthreads();
                const int k = qw[0];
                if (k >= 512) break;
                attn_tile(P, lds, b, (511 - k) * 8, wave, lane);
            }
            __syncthreads(); }
        for (;;) {
            if (tid == 0) qw[0] = (int)atomicAdd(ctl + CW_CQ, 1u);
            __syncthreads();
            const int tl = qw[0];
            if (tl >= NTOK / 32) break;
            conv_tile(P, lds, tl, tid, wave, lane);
        }
    }
    SYNC(2);
    if (IN(3)) {
        pg8::DenseSched S; S.init((const bf16_t*)(ws + WS_MIX), (const bf16_t*)(ws + WS_WOUT), NTOK, 1024, 1024, G, bx);
        EpiOutProj E{P.x, (float*)(ws + WS_H1), (unsigned char*)(ws + WS_H1F8)};
        pg8::gemm_phase<EpiOutProj, pg8::DenseSched, false, false, true>(lds, S, E);
    }
    SYNC(3);
    if (IN(4)) { FRESH_LANE(lane); router_phase(P, lds, vcu, G, tid, wave, lane); }
    SYNC(4);
    if (IN(5) || IN(6)) {
        LAS int* tb = (LAS int*)(lds + LDS_MISC); LAS int* cn = tb + 64;
        if (tid == 0) { const unsigned* cntg = (const unsigned*)(ws + WS_CTL) + CW_CNT; int acc = 0;
            for (int e = 0; e < NE; ++e) { const int c = (int)__hip_atomic_load(cntg + 64 * e, __ATOMIC_RELAXED, __HIP_MEMORY_SCOPE_AGENT); tb[e] = acc; cn[e] = c; acc += (c + BM - 1) / BM; }
            tb[NE] = acc; }
        __syncthreads();
        if (IN(5)) {
            pg8::MoeSched S; S.A = ws + WS_H1F8; S.Bt = ws + WS_WUP; S.rp = 1024; S.b_estride = (size_t)2048 * 1024; S.tb = tb; S.cnt = cn; S.list = (const int*)(ws + WS_LIST);
            S.nN = 8; S.nwg = tb[NE] * 8; S.G = G; S.c = bx; S.gather = true;
            { LAS int* ut = (LAS int*)(lds + LDS_MISC + 512); S.utab = ut; S.build_table(ut, tid); __syncthreads(); }
            S.m_scale = (const float*)(ws + WS_LSCALE); S.m_gate = nullptr; S.m_bias = P.b_up;
            EpiUp E{(unsigned char*)(ws + WS_ACT)};
            pg8::gemm_phase<EpiUp, pg8::MoeSched, true, true, true>(lds, S, E);
        }
        SYNC(5);
        if (IN(6)) {
            pg8::MoeSched S; S.A = ws + WS_ACT; S.Bt = ws + WS_WDOWN; S.rp = 1024; S.b_estride = (size_t)1024 * 1024; S.tb = tb; S.cnt = cn; S.list = (const int*)(ws + WS_LIST);
            S.nN = 4; S.nwg = tb[NE] * 4; S.G = G; S.c = bx; S.gather = false;
            { LAS int* ut = (LAS int*)(lds + LDS_MISC + 512); S.utab = ut; S.build_table(ut, tid); __syncthreads(); }
            S.m_scale = nullptr; S.m_gate = (const float*)(ws + WS_LGATE); S.m_bias = P.b_down;
            EpiDown E{(unsigned char*)(ws + WS_Y)};
            pg8::gemm_phase<EpiDown, pg8::MoeSched, true, true, true>(lds, S, E);
        }
    }
    SYNC(6);
    if (IN(7)) { FRESH_LANE(l7); const int g7 = vcu * NWAVES + wave;
        combine_phase(P, g7, NGW, l7); }
    SYNC(7);
    if (IN(8)) {
        pg8::DenseSched S; S.init(ws + WS_H1F8, ws + WS_WG, NTOK, 1024, 1024, G, bx); S.rp = 1024; S.idg = true;
        EpiF8Plain E{(unsigned char*)(ws + WS_G), 1024, 0.03125f};
        pg8::gemm_phase<EpiF8Plain, pg8::DenseSched, true, true>(lds, S, E);
    }
    SYNC(8);
    if (IN(9)) { FRESH_LANE(l9); const int g9 = vcu * NWAVES + wave;
        final_phase(P, g9, NGW, l9); }
#undef IN
#undef SYNC
}

#ifndef N_LAUNCH_MODE
#define N_LAUNCH_MODE 1
#endif
extern "C" void kernel_launch(void* const* d_in, const int* in_sizes, int n_in, void* d_out, int out_size, void* d_ws, size_t ws_size, hipStream_t stream) {
    static int grid = 0;
    if (grid == 0) {
        if (n_in != 21 || out_size != NTOK * DM || ws_size < WS_END) { fprintf(stderr, "kernel_launch: unexpected shapes (n_in %d out %d ws %zu)\n", n_in, out_size, ws_size); grid = -1; return; }
        int dev = 0, cus = 0, per_cu = 0;
        (void)hipGetDevice(&dev); (void)hipDeviceGetAttribute(&cus, hipDeviceAttributeMultiprocessorCount, dev);
        (void)hipFuncSetAttribute((const void*)fwd_kernel, hipFuncAttributeMaxDynamicSharedMemorySize, LDS_BYTES);
        if (hipOccupancyMaxActiveBlocksPerMultiprocessor(&per_cu, (const void*)fwd_kernel, NTHR, LDS_BYTES) != hipSuccess || per_cu < 1) { fprintf(stderr, "kernel_launch: occupancy query failed (%d)\n", per_cu); (void)hipGetLastError(); grid = -1; return; }
        grid = cus;
    }
    if (grid < 0) return;
    (void)hipMemsetAsync((char*)d_ws + WS_CTL, 0, CTL_BYTES, stream);
    Params p{};
    p.x = (const float*)d_in[0]; p.p = (const float*)d_in[1]; p.w_in = (const float*)d_in[2]; p.w_out = (const float*)d_in[3]; p.g_mix = (const float*)d_in[4]; p.g_ffn = (const float*)d_in[5];
    p.glu_b = (const float*)d_in[6]; p.dw_w = (const float*)d_in[7]; p.dw_b = (const float*)d_in[8]; p.ln_g = (const float*)d_in[9]; p.ln_b = (const float*)d_in[10];
    p.w_router = (const float*)d_in[11]; p.b_router = (const float*)d_in[12]; p.w_up = (const float*)d_in[13]; p.b_up = (const float*)d_in[14]; p.w_down = (const float*)d_in[15]; p.b_down = (const float*)d_in[16];
    p.w_ple_proj = (const float*)d_in[17]; p.w_ple_gate = (const float*)d_in[18]; p.g_ple = (const float*)d_in[19]; p.g_final = (const float*)d_in[20];
    p.out = (float*)d_out; p.ws = (unsigned char*)d_ws;
#if N_LAUNCH_MODE == 1
    p.ph_lo = 0; p.ph_hi = NPHASE;
    void* args[] = {&p};
    hipError_t e = hipLaunchCooperativeKernel((const void*)fwd_kernel, dim3(grid), dim3(NTHR), args, LDS_BYTES, stream);
    if (e != hipSuccess) fprintf(stderr, "cooperative launch failed: %s (grid %d)\n", hipGetErrorString(e), grid);
#else
    for (int ph = 0; ph < NPHASE; ++ph) {
        p.ph_lo = ph; p.ph_hi = ph + 1;
        void* args[] = {&p};
        hipError_t e = hipLaunchCooperativeKernel((const void*)fwd_kernel, dim3(grid), dim3(NTHR), args, LDS_BYTES, stream);
        if (e != hipSuccess) { fprintf(stderr, "launch %d failed: %s (grid %d)\n", ph, hipGetErrorString(e), grid); break; }
    }
#endif
}
```

```cpp
#include <hip/hip_runtime.h>
#include <hip/hip_cooperative_groups.h>
#include <cstdio>
#include <cstdint>
namespace cg = cooperative_groups;

#define LAS __attribute__((address_space(3)))
#define GAS __attribute__((address_space(1)))
typedef unsigned short bf16_t;
typedef short bf16x8 __attribute__((ext_vector_type(8)));
typedef short s16x4 __attribute__((ext_vector_type(4)));
typedef float f32x4 __attribute__((ext_vector_type(4)));
typedef float f32x2 __attribute__((ext_vector_type(2)));
typedef float f32x16 __attribute__((ext_vector_type(16)));
typedef unsigned u32x4 __attribute__((ext_vector_type(4)));
typedef unsigned u32x2 __attribute__((ext_vector_type(2)));

constexpr int NB = 8, SEQ = 4096, DM = 1024, NTOK = NB * SEQ;
constexpr int NE = 32, TOPK = 4, NSLOT = NTOK * TOPK;
constexpr int INW = 1988;
constexpr int NSEL = 256;
constexpr float EPS = 1e-6f;
constexpr int NWAVES = 8, NTHR = 512;

constexpr size_t MiB = 1u << 20;
constexpr size_t WS_CTL = 0, CTL_BYTES = 64 * 1024;
constexpr size_t WS_ROPE = 1 * MiB;
constexpr size_t WS_WIN = 2 * MiB;
constexpr size_t WS_WOUT = 6 * MiB;
constexpr size_t WS_WG = 8 * MiB;
constexpr size_t WS_WP = 10 * MiB;
constexpr size_t WS_WRG = 10 * MiB + 512 * 1024;
constexpr size_t WS_RS1 = 11 * MiB;
constexpr size_t WS_RS3 = 11 * MiB + 512 * 1024;
constexpr size_t WS_WI = 12 * MiB;
constexpr size_t WS_LIST = 13 * MiB;
constexpr size_t WS_LSCALE = 17 * MiB;
constexpr size_t WS_LGATE = 21 * MiB;
constexpr size_t WS_PB = 25 * MiB;
constexpr size_t WS_WUP = 42 * MiB;
constexpr size_t WS_WDOWN = 170 * MiB;
constexpr size_t WS_H1 = 234 * MiB;
constexpr size_t WS_H1B = 362 * MiB;
constexpr size_t WS_PJ = 426 * MiB;
constexpr size_t WS_XB = 490 * MiB;
constexpr size_t WS_Q = 554 * MiB;
constexpr size_t WS_K = 586 * MiB;
constexpr size_t WS_V = 590 * MiB;
constexpr size_t WS_QI = 594 * MiB;
constexpr size_t WS_KI = 610 * MiB;
constexpr size_t WS_HGLU = 614 * MiB;
constexpr size_t WS_MIX = 646 * MiB;
constexpr size_t WS_H1F8 = 490 * MiB;
constexpr size_t WS_ACT = 522 * MiB;
constexpr size_t WS_Y = 762 * MiB;
constexpr size_t WS_G = 762 * MiB;
constexpr size_t WS_END = 1018 * MiB;
static_assert(WS_H1F8 + (size_t)NTOK * 1024 <= WS_ACT && WS_ACT + (size_t)139264 * 1024 <= WS_Y, "ws map");
constexpr int CW_CNT = 1024;
constexpr int CW_AQ = 4096;
constexpr int CW_CQ = 4096 + 64 * 8;
constexpr int CW_BAR = 8192;

constexpr int LDS_STAGE = 131072;
constexpr int LDS_MISC = LDS_STAGE;
constexpr int LDS_META = LDS_MISC + 4096;
constexpr int LDS_XB = 147456;
constexpr int LDS_BYTES = 147456 + 256;

__device__ __forceinline__ unsigned f2bf(float f) { unsigned u = __builtin_bit_cast(unsigned, f); return (u + 0x7fffu + ((u >> 16) & 1u)) >> 16; }
__device__ __forceinline__ unsigned pk2(float lo, float hi) { return f2bf(lo) | (f2bf(hi) << 16); }
__device__ __forceinline__ float bf_lo(unsigned w) { return __builtin_bit_cast(float, w << 16); }
__device__ __forceinline__ float bf_hi(unsigned w) { return __builtin_bit_cast(float, w & 0xffff0000u); }
__device__ __forceinline__ float wave_sum(float v) {
    v += __builtin_bit_cast(float, __builtin_amdgcn_update_dpp(0, __builtin_bit_cast(int, v), 0xB1, 0xF, 0xF, true));
    v += __builtin_bit_cast(float, __builtin_amdgcn_update_dpp(0, __builtin_bit_cast(int, v), 0x4E, 0xF, 0xF, true));
    v += __builtin_bit_cast(float, __builtin_amdgcn_update_dpp(0, __builtin_bit_cast(int, v), 0x141, 0xF, 0xF, true));
    v += __builtin_bit_cast(float, __builtin_amdgcn_update_dpp(0, __builtin_bit_cast(int, v), 0x140, 0xF, 0xF, true));
    const int vi = __builtin_bit_cast(int, v);
    const float r0 = __builtin_bit_cast(float, __builtin_amdgcn_readlane(vi, 0)), r1 = __builtin_bit_cast(float, __builtin_amdgcn_readlane(vi, 16));
    const float r2 = __builtin_bit_cast(float, __builtin_amdgcn_readlane(vi, 32)), r3 = __builtin_bit_cast(float, __builtin_amdgcn_readlane(vi, 48));
    return (r0 + r1) + (r2 + r3);
}
__device__ __forceinline__ unsigned pk4_fp8(float a, float b, float c, float d) { int r = __builtin_amdgcn_cvt_pk_fp8_f32(a, b, 0, false); r = __builtin_amdgcn_cvt_pk_fp8_f32(c, d, r, true); return (unsigned)r; }
__device__ __forceinline__ float sigmoidf_(float x) { return __builtin_amdgcn_rcpf(1.0f + __builtin_amdgcn_exp2f(x * -1.4426950408889634f)); }
#define LDS_WAIT() asm volatile("s_waitcnt lgkmcnt(0)" ::: "memory")
#define NT_LD(p) __builtin_nontemporal_load(p)
#define NT_ST(v, p) __builtin_nontemporal_store(v, p)

struct Params {
    const float* x; const float* p; const float* w_in; const float* w_out; const float* g_mix; const float* g_ffn;
    const float* glu_b; const float* dw_w; const float* dw_b; const float* ln_g; const float* ln_b;
    const float* w_router; const float* b_router; const float* w_up; const float* b_up; const float* w_down; const float* b_down;
    const float* w_ple_proj; const float* w_ple_gate; const float* g_ple; const float* g_final;
    float* out; unsigned char* ws;
    int ph_lo, ph_hi;
};

namespace pg8 {
constexpr int BM = 256, BK = 64, HALF = 128, HTB = HALF * BK * 2, STAGE_BYTES = 8 * HTB, NXCD = 8, WGM = 8;
__host__ __device__ __forceinline__ int lds_byte(int r, int c) { const int st = (r >> 4) * 2 + (c >> 5), rr = r & 15, cc = c & 31, ob = rr * 64 + cc * 2; return st * 1024 + (ob ^ (((ob >> 9) & 1) << 5)); }
__host__ __device__ __forceinline__ void stage_rc(int b, int& R, int& C) { const int st = b / 1024, sb = b % 1024, swz = sb ^ (((sb >> 9) & 1) << 5); R = (st >> 1) * 16 + swz / 64; C = (st & 1) * 32 + (swz % 64) / 2; }
__host__ __device__ __forceinline__ int perm32(int rho) { const int n = rho >> 4, i = rho & 15; return 8 * (i >> 2) + 4 * n + (i & 3); }

struct Unit { int pm, pn, e, rows; };

__device__ __forceinline__ unsigned cvt_pk_bf16(float lo, float hi) { unsigned r; asm volatile("v_cvt_pk_bf16_f32 %0, %1, %2" : "=v"(r) : "v"(lo), "v"(hi)); return r; }

struct DenseSched {
    const void* A; const void* Bt; int rp;
    int nM, nN, nwg, G, c;
    __device__ void init(const void* A_, const void* Bt_, int M, int N, int K_, int G_, int c_) { A = A_; Bt = Bt_; rp = K_ * 2; nM = M / BM; nN = N / BM; nwg = nM * nN; G = G_; c = c_; }
    __device__ bool next(int i, Unit& u) const {
        const long L = (long)i * G + c; if (L >= nwg) return false;
        int wgid = (int)L; { const int q = nwg / NXCD, r = nwg % NXCD, xcd = wgid % NXCD, off = wgid / NXCD; wgid = (xcd < r ? xcd * (q + 1) : r * (q + 1) + (xcd - r) * q) + off; }
        const int nig = WGM * nN, gid = wgid / nig, fm = gid * WGM, gsz = (nM - fm) < WGM ? (nM - fm) : WGM;
        u.pm = fm + ((wgid % nig) % gsz); u.pn = (wgid % nig) / gsz; u.e = 0; u.rows = BM; return true;
    }
    bool idg = false;
    __device__ __forceinline__ const char* a_ptr(const Unit& u) const { return idg ? (const char*)A : (const char*)A + (size_t)u.pm * BM * rp; }
    __device__ __forceinline__ const char* b_ptr(const Unit& u) const { return (const char*)Bt + (size_t)u.pn * BM * rp; }
    __device__ __forceinline__ int a_row(const Unit& u, int r) const { return u.pm * BM + r; }
    __device__ __forceinline__ void meta(const Unit&, LAS unsigned char*, int, int) const {}
};

struct MoeSched {
    const void* A; const void* Bt; int rp; size_t b_estride;
    const LAS int* tb;
    const LAS int* cnt;
    const int* list;
    int nN, nwg, G, c; bool gather;
    const LAS int* utab;
    __device__ __forceinline__ bool next(int i, Unit& u) const {
        if (i >= 32) return false;
        const LAS int* p = utab + 4 * i; const int rows = p[3]; if (rows < 0) return false;
        u.pm = p[0]; u.pn = p[1]; u.e = p[2]; u.rows = rows; return true;
    }
    __device__ __forceinline__ void build_table(LAS int* tab, int tid) const {
        if (tid < 32) { Unit u; const bool ok = decode(tid, u); tab[4 * tid] = u.pm; tab[4 * tid + 1] = u.pn; tab[4 * tid + 2] = u.e; tab[4 * tid + 3] = ok ? u.rows : -1; }
    }
    __device__ __forceinline__ bool decode(int i, Unit& u) const {
        u.pm = 0; u.pn = 0; u.e = 0; u.rows = 0;
        const long L = (long)i * G + c; if (L >= nwg) return false;
        int wgid = (int)L; { const int q = nwg / NXCD, r = nwg % NXCD, xcd = wgid % NXCD, off = wgid / NXCD; wgid = (xcd < r ? xcd * (q + 1) : r * (q + 1) + (xcd - r) * q) + off; }
        int e = 0;
#pragma unroll 1
        for (; e < NE - 1; ++e) { if (wgid < tb[e + 1] * nN) break; }
        const int local = wgid - tb[e] * nN, nM = tb[e + 1] - tb[e];
        const int nig = WGM * nN, gid = local / nig, fm = gid * WGM, gsz = (nM - fm) < WGM ? (nM - fm) : WGM;
        const int rt = fm + ((local % nig) % gsz);
        u.pm = tb[e] + rt; u.pn = (local % nig) / gsz; u.e = e;
        const int left = cnt[e] - rt * BM; u.rows = left < BM ? left : BM; return true;
    }
    __device__ __forceinline__ const char* a_ptr(const Unit& u) const { return (const char*)A; }
    __device__ __forceinline__ const char* b_ptr(const Unit& u) const { return (const char*)Bt + (size_t)u.e * b_estride + (size_t)u.pn * BM * rp; }
    __device__ __forceinline__ int a_row(const Unit& u, int r) const {
        if (!gather) return u.pm * BM + r;
        const int rt = u.pm - tb[u.e];
        return r < u.rows ? (list[u.e * NTOK + rt * BM + r] >> 2) : 0;
    }
    const float* m_scale; const float* m_gate; const float* m_bias;
    __device__ __forceinline__ void meta(const Unit& u, LAS unsigned char* tbl, int wid, int lane) const {
        const int rt = u.pm - tb[u.e]; const size_t li = (size_t)u.e * NTOK + rt * BM + (wid & 3) * 64 + lane;
        if (gather) {
            if (wid < 4) __builtin_amdgcn_global_load_lds((const unsigned*)(m_scale + li), (LAS unsigned*)(tbl + (wid & 3) * 256), 4, 0, 0);
            else { const int j = (wid & 3) * 64 + lane; const float* src = m_bias + (size_t)u.e * 2048 + (j < 128 ? 128 * u.pn + j : 1024 + 128 * u.pn + (j - 128));
                __builtin_amdgcn_global_load_lds((const unsigned*)src, (LAS unsigned*)(tbl + 2048 + (wid & 3) * 256), 4, 0, 0); }
        } else {
            if (wid < 4) { __builtin_amdgcn_global_load_lds((const unsigned*)(list + li), (LAS unsigned*)(tbl + (wid & 3) * 256), 4, 0, 0);
                __builtin_amdgcn_global_load_lds((const unsigned*)(m_bias + (size_t)u.e * 1024 + u.pn * BM + (wid & 3) * 64 + lane), (LAS unsigned*)(tbl + 2048 + (wid & 3) * 256), 4, 0, 0); }
            else __builtin_amdgcn_global_load_lds((const unsigned*)(m_gate + li), (LAS unsigned*)(tbl + 1024 + (wid & 3) * 256), 4, 0, 0);
        }
    }
};

typedef int v8i32 __attribute__((ext_vector_type(8)));
template <class Epi, class Sched, bool GATHER, bool F8 = false, bool WARMTRIP = false>
__device__ __forceinline__ void gemm_phase(LAS unsigned char* lds, const Sched& S, const Epi& E) {
    const int tid = threadIdx.x, wid = __builtin_amdgcn_readfirstlane(tid >> 6), lane = tid & 63, wr = wid >> 2, wc = wid & 3, fr = lane & 15, fq = lane >> 4;
    const int RP = S.rp, nt = RP / (BK * 2);
    unsigned voffA[2], voffB[2]; int RA[2], CA[2];
#pragma unroll
    for (int i = 0; i < 2; ++i) { int R, C; stage_rc(tid * 16 + i * 8192, R, C); const int Rb = Epi::PERM ? ((R & ~31) + perm32(R & 31)) : R;
        voffA[i] = (unsigned)(R * RP + C * 2); voffB[i] = (unsigned)(Rb * RP + C * 2); RA[i] = R; CA[i] = C; }
    const size_t kstep = (size_t)(BK * 2);
    const size_t hstep = (size_t)HALF * RP;
    const unsigned ldsw = (unsigned)wid * 1024u;
    const int aoff = lds_byte(wr * 64 + fr, fq * 8), boff = lds_byte(wc * 32 + fr, fq * 8);
    unsigned gC[2][2], gN[2][2];
#define PG8_SA(b, h) (((b) * 2 + (h)) * HTB)
#define PG8_SB(b, h) ((4 + (b) * 2 + (h)) * HTB)
#define PG8_STAGE(bufoff, gbase, voff) do { _Pragma("unroll") for (int _i = 0; _i < 2; ++_i) \
        __builtin_amdgcn_global_load_lds((const unsigned*)((const char*)(gbase) + (voff)[_i]), (LAS unsigned*)(lds + (bufoff) + ldsw + _i * 8192), 16, 0, 0); } while (0)
#define PG8_STAGE_A(bufoff, kp, h) do { if constexpr (GATHER) { PG8_STAGE(bufoff, kp, gC[h]); } else { PG8_STAGE(bufoff, (kp) + (h) * hstep, voffA); } } while (0)
#define PG8_LD16(p) (*(const LAS bf16x8*)(p))
#define PG8_CAT(lo, hi) __builtin_bit_cast(v8i32, __builtin_shufflevector(lo, hi, 0, 1, 2, 3, 4, 5, 6, 7, 8, 9, 10, 11, 12, 13, 14, 15))
#define PG8_LDA(dst, b, h) do { _Pragma("unroll") for (int m = 0; m < 4; ++m) { if constexpr (F8) { dst##8[m] = PG8_CAT(PG8_LD16(lds + PG8_SA(b, h) + aoff + m * 2048), PG8_LD16(lds + PG8_SA(b, h) + aoff + m * 2048 + 1024)); } \
        else { _Pragma("unroll") for (int k = 0; k < 2; ++k) dst[m][k] = PG8_LD16(lds + PG8_SA(b, h) + aoff + m * 2048 + k * 1024); } } } while (0)
#define PG8_LDB(dst, b, h) do { _Pragma("unroll") for (int n = 0; n < 2; ++n) { if constexpr (F8) { dst##8[n] = PG8_CAT(PG8_LD16(lds + PG8_SB(b, h) + boff + n * 2048), PG8_LD16(lds + PG8_SB(b, h) + boff + n * 2048 + 1024)); } \
        else { _Pragma("unroll") for (int k = 0; k < 2; ++k) dst[n][k] = PG8_LD16(lds + PG8_SB(b, h) + boff + n * 2048 + k * 1024); } } } while (0)
#define PG8_MMA(ai, bj, At, Bt) do { __builtin_amdgcn_s_setprio(1); _Pragma("unroll") for (int m = 0; m < 4; ++m) _Pragma("unroll") for (int n = 0; n < 2; ++n) { \
        if constexpr (F8) { acc[ai][bj][m][n] = __builtin_amdgcn_mfma_scale_f32_16x16x128_f8f6f4(Bt##8[n], At##8[m], acc[ai][bj][m][n], 0, 0, 0, 0x7f7f7f7f, 0, 0x7f7f7f7f); } \
        else { _Pragma("unroll") for (int k = 0; k < 2; ++k) acc[ai][bj][m][n] = __builtin_amdgcn_mfma_f32_16x16x32_bf16(Bt[n][k], At[m][k], acc[ai][bj][m][n], 0, 0, 0); } } \
        __builtin_amdgcn_s_setprio(0); } while (0)
#define PG8_WAIT_V(n) asm volatile("s_waitcnt vmcnt(" #n ")" ::: "memory")
#define PG8_WAIT_L(n) asm volatile("s_waitcnt lgkmcnt(" #n ")" ::: "memory")
#define PG8_BAR __builtin_amdgcn_s_barrier()
#define PG8_SCHED __builtin_amdgcn_sched_barrier(0)
#define PG8_GOFF(dst, u) do { _Pragma("unroll") for (int _h = 0; _h < 2; ++_h) _Pragma("unroll") for (int _i = 0; _i < 2; ++_i) \
        dst[_h][_i] = (unsigned)(S.a_row(u, _h * HALF + RA[_i]) * RP + CA[_i] * 2); } while (0)
    Unit cur, nxt, nn; int ui = 0;
    if (!S.next(0, cur)) return;
    bool has_next = S.next(1, nxt);
    if constexpr (GATHER) { PG8_GOFF(gC, cur); if (has_next) { PG8_GOFF(gN, nxt); } else { PG8_GOFF(gN, cur); } }
    f32x4 acc[2][2][4][2];
#pragma unroll
    for (int a = 0; a < 2; ++a)
#pragma unroll
        for (int b = 0; b < 2; ++b)
#pragma unroll
            for (int m = 0; m < 4; ++m)
#pragma unroll
                for (int n = 0; n < 2; ++n) acc[a][b][m][n] = (f32x4){0.f, 0.f, 0.f, 0.f};
    bf16x8 At[4][2], B0[2][2], B1[2][2]; v8i32 At8[4], B08[2], B18[2];
    const char* cA = S.a_ptr(cur); const char* cB = S.b_ptr(cur);
    PG8_STAGE(PG8_SB(0, 0), cB, voffB); PG8_STAGE(PG8_SB(0, 1), cB + hstep, voffB); PG8_STAGE_A(PG8_SA(0, 0), cA, 0); PG8_STAGE_A(PG8_SA(0, 1), cA, 1);
    if (wr == 1) PG8_BAR;
    PG8_WAIT_V(2); PG8_BAR;
    PG8_STAGE(PG8_SB(1, 0), cB + kstep, voffB); PG8_STAGE_A(PG8_SA(1, 0), cA + kstep, 0); PG8_STAGE(PG8_SB(1, 1), cB + hstep + kstep, voffB);
    PG8_WAIT_V(6); PG8_BAR;
    for (;;) {
        const char* nA = has_next ? S.a_ptr(nxt) : cA; const char* nB = has_next ? S.b_ptr(nxt) : cB;
        S.meta(cur, lds + (LDS_META - 0) + (ui & 1) * 4096, wid, lane);
#define PG8_TRIP(WARM, t) do { \
            const bool last = ((t) == nt - 2); \
            const char* a1 = cA + (size_t)((t) + 1) * kstep; \
            const char* a2 = last ? nA : cA + (size_t)((t) + 2) * kstep; const char* b2 = last ? nB : cB + (size_t)((t) + 2) * kstep; \
            const char* a3 = a2 + kstep; const char* b3 = b2 + kstep; \
              \
            PG8_LDB(B0, 0, 0); PG8_LDB(B1, 0, 1); PG8_SCHED; PG8_LDA(At, 0, 0); if constexpr (!(WARM)) { PG8_STAGE_A(PG8_SA(1, 1), a1, 1); } \
            if constexpr (GATHER) { if (last) { _Pragma("unroll") for (int h = 0; h < 2; ++h) _Pragma("unroll") for (int i = 0; i < 2; ++i) gC[h][i] = gN[h][i]; } } \
            if constexpr (!(WARM)) { PG8_WAIT_V(8); } PG8_WAIT_L(0); PG8_BAR; PG8_MMA(0, 0, At, B0); PG8_MMA(0, 1, At, B1); PG8_BAR; PG8_SCHED; \
              \
            PG8_LDA(At, 0, 1); PG8_STAGE(PG8_SB(0, 0), b2, voffB); PG8_STAGE(PG8_SB(0, 1), b2 + hstep, voffB); PG8_STAGE_A(PG8_SA(0, 0), a2, 0); \
            if constexpr (!(WARM)) { PG8_WAIT_V(8); } PG8_WAIT_L(0); PG8_BAR; PG8_MMA(1, 0, At, B0); PG8_MMA(1, 1, At, B1); PG8_BAR; PG8_SCHED; \
              \
            PG8_LDB(B0, 1, 0); PG8_LDB(B1, 1, 1); PG8_SCHED; PG8_LDA(At, 1, 0); PG8_STAGE_A(PG8_SA(0, 1), a2, 1); \
            if constexpr (!(WARM)) { PG8_WAIT_V(8); } PG8_WAIT_L(0); PG8_BAR; PG8_MMA(0, 0, At, B0); PG8_MMA(0, 1, At, B1); PG8_BAR; PG8_SCHED; \
              \
            PG8_LDA(At, 1, 1); PG8_STAGE(PG8_SB(1, 0), b3, voffB); PG8_STAGE(PG8_SB(1, 1), b3 + hstep, voffB); PG8_STAGE_A(PG8_SA(1, 0), a3, 0); \
            PG8_WAIT_V(8); PG8_WAIT_L(0); PG8_BAR; PG8_MMA(1, 0, At, B0); PG8_MMA(1, 1, At, B1); PG8_BAR; PG8_SCHED; \
        } while (0)
        int t0_ = 0;
        if constexpr (WARMTRIP) { if (ui > 0) { PG8_TRIP(true, 0); t0_ = 2; } }
        for (int t = t0_; t < nt; t += 2) { PG8_TRIP(false, t); }
#undef PG8_TRIP
        if (wr == 0) PG8_BAR;
        if constexpr (WARMTRIP) { PG8_STAGE_A(PG8_SA(1, 1), nA + kstep, 1); }
        bool has_nn = false;
        if constexpr (GATHER) { if (has_next) { has_nn = S.next(ui + 2, nn); if (has_nn) { PG8_GOFF(gN, nn); } } }
        else { if (has_next) has_nn = S.next(ui + 2, nn); }
        { int fr_ = fr, fq_ = fq; asm volatile("" : "+v"(fr_), "+v"(fq_));
          const LAS unsigned char* mt = lds + LDS_META + (ui & 1) * 4096;
          if constexpr (WARMTRIP) {
              E.pre(acc, cur, wr, wc, fr_, fq_, mt);
              if constexpr (GATHER) asm volatile("" : "+v"(gN[0][0]), "+v"(gN[0][1]), "+v"(gN[1][0]), "+v"(gN[1][1]));
              PG8_WAIT_V(0);
              E.post(acc, cur, wr, wc, fr_, fq_, mt);
          } else { E.run(acc, cur, wr, wc, fr_, fq_, mt); } }
        if (!has_next) break;
#pragma unroll
        for (int a = 0; a < 2; ++a)
#pragma unroll
            for (int b = 0; b < 2; ++b)
#pragma unroll
                for (int m = 0; m < 4; ++m)
#pragma unroll
                    for (int n = 0; n < 2; ++n) acc[a][b][m][n] = (f32x4){0.f, 0.f, 0.f, 0.f};
        cur = nxt; cA = nA; cB = nB; ++ui; nxt = nn; has_next = has_nn;
        if (wr == 1) PG8_BAR;
    }
    PG8_WAIT_V(0);
    PG8_BAR;
#undef PG8_SA
#undef PG8_SB
#undef PG8_STAGE
#undef PG8_STAGE_A
#undef PG8_LDA
#undef PG8_LDB
#undef PG8_MMA
#undef PG8_LD16
#undef PG8_CAT
#undef PG8_WAIT_V
#undef PG8_WAIT_L
#undef PG8_BAR
#undef PG8_SCHED
#undef PG8_GOFF
}
}

using pg8::Unit; using pg8::cvt_pk_bf16;
constexpr int BM = 256, HALF = 128;

typedef f32x4 (&AccRef)[2][2][4][2];
__device__ __forceinline__ void pack8_bf16(f32x4& lo, const f32x4& hi) {
    const unsigned w0 = cvt_pk_bf16(lo[0], lo[1]), w1 = cvt_pk_bf16(lo[2], lo[3]), w2 = cvt_pk_bf16(hi[0], hi[1]), w3 = cvt_pk_bf16(hi[2], hi[3]);
    lo[0] = __builtin_bit_cast(float, w0); lo[1] = __builtin_bit_cast(float, w1); lo[2] = __builtin_bit_cast(float, w2); lo[3] = __builtin_bit_cast(float, w3);
}
#define AS_U4(v) __builtin_bit_cast(u32x4, v)

struct EpiInProj {
    static constexpr bool PERM = true;
    const float* rs1; const f32x2* rope; const float* glu_b;
    bf16_t *q, *k, *v, *qi, *ki, *hglu; float* wi;
    __device__ __forceinline__ void pre(AccRef acc, const Unit& u, int wr, int wc, int fr, int fq, const LAS unsigned char* mt) const {
        const int row0 = u.pm * BM + wr * 64 + fr;
        if (u.pn >= 4) {
            const int ch = 128 * (u.pn - 4) + 32 * wc + 8 * fq;
            f32x4 ba[2], bg[2];
#pragma unroll
            for (int n = 0; n < 2; ++n) { ba[n] = *(const f32x4*)(glu_b + ch + 4 * n); bg[n] = *(const f32x4*)(glu_b + 512 + ch + 4 * n); }
#pragma unroll
            for (int ai = 0; ai < 2; ++ai)
#pragma unroll
                for (int m = 0; m < 4; ++m) { const float rs = rs1[row0 + ai * HALF + m * 16];
#pragma unroll
                    for (int n = 0; n < 2; ++n)
#pragma unroll
                        for (int e = 0; e < 4; ++e) { const float a = acc[ai][0][m][n][e] * rs + ba[n][e], g = acc[ai][1][m][n][e] * rs + bg[n][e]; acc[ai][0][m][n][e] = a * sigmoidf_(g); }
                    pack8_bf16(acc[ai][0][m][0], acc[ai][0][m][1]); }
            return;
        }
        const bool do_rope = !(u.pn == 3 && wc >= 2), is_wi = (u.pn == 3 && wc == 3);
        const int d0 = 8 * fq;
#pragma unroll
        for (int ai = 0; ai < 2; ++ai)
#pragma unroll
            for (int m = 0; m < 4; ++m) { const int row = row0 + ai * HALF + m * 16; const float rs = rs1[row];
                if (do_rope) {
                    const f32x2* rp = rope + (size_t)(row & (SEQ - 1)) * 32 + d0;
#pragma unroll
                    for (int n = 0; n < 2; ++n)
#pragma unroll
                        for (int e = 0; e < 4; ++e) { const f32x2 cs = rp[4 * n + e]; const float x1 = acc[ai][0][m][n][e] * rs, x2 = acc[ai][1][m][n][e] * rs;
                            acc[ai][0][m][n][e] = x1 * cs.x - x2 * cs.y; acc[ai][1][m][n][e] = x2 * cs.x + x1 * cs.y; }
                } else {
#pragma unroll
                    for (int n = 0; n < 2; ++n) { acc[ai][0][m][n] = acc[ai][0][m][n] * rs; acc[ai][1][m][n] = acc[ai][1][m][n] * rs; }
                }
                if (!is_wi) { pack8_bf16(acc[ai][0][m][0], acc[ai][0][m][1]); pack8_bf16(acc[ai][1][m][0], acc[ai][1][m][1]); }
                if (m & 1) __builtin_amdgcn_sched_barrier(0); }
    }
    __device__ __forceinline__ void post(AccRef acc, const Unit& u, int wr, int wc, int fr, int fq, const LAS unsigned char* mt) const {
        const int row0 = u.pm * BM + wr * 64 + fr;
        if (u.pn >= 4) {
            const int ch = 128 * (u.pn - 4) + 32 * wc + 8 * fq;
#pragma unroll
            for (int ai = 0; ai < 2; ++ai)
#pragma unroll
                for (int m = 0; m < 4; ++m) *(u32x4*)(hglu + (size_t)(row0 + ai * HALF + m * 16) * 512 + ch) = AS_U4(acc[ai][0][m][0]);
            return;
        }
        bf16_t* dst; int ld, col; bool is_wi = false;
        if (u.pn < 2) { dst = q; ld = 512; col = (4 * u.pn + wc) * 64; }
        else if (u.pn == 2) { dst = qi; ld = 256; col = wc * 64; }
        else { ld = 64; col = 0; if (wc == 0) dst = k; else if (wc == 1) dst = ki; else if (wc == 2) dst = v; else { dst = v; is_wi = true; } }
        if (is_wi) {
            if (fq == 0) {
#pragma unroll
                for (int ai = 0; ai < 2; ++ai)
#pragma unroll
                    for (int m = 0; m < 4; ++m) *(f32x4*)(wi + (size_t)(row0 + ai * HALF + m * 16) * 4) = acc[ai][0][m][0];
            }
            return;
        }
#pragma unroll
        for (int ai = 0; ai < 2; ++ai)
#pragma unroll
            for (int m = 0; m < 4; ++m) { bf16_t* rp2 = dst + (size_t)(row0 + ai * HALF + m * 16) * ld + col + 8 * fq;
                *(u32x4*)(rp2) = AS_U4(acc[ai][0][m][0]); *(u32x4*)(rp2 + 32) = AS_U4(acc[ai][1][m][0]); }
    }
    __device__ __forceinline__ void run(const f32x4 (&acc)[2][2][4][2], const Unit& u, int wr, int wc, int fr, int fq, const LAS unsigned char* mt) const {
        const int row0 = u.pm * BM + wr * 64 + fr;
        if (u.pn >= 4) {
            const int ch = 128 * (u.pn - 4) + 32 * wc + 8 * fq;
            f32x4 ba[2], bg[2];
#pragma unroll
            for (int n = 0; n < 2; ++n) { ba[n] = *(const f32x4*)(glu_b + ch + 4 * n); bg[n] = *(const f32x4*)(glu_b + 512 + ch + 4 * n); }
#pragma unroll
            for (int ai = 0; ai < 2; ++ai)
#pragma unroll
                for (int m = 0; m < 4; ++m) { const int row = row0 + ai * HALF + m * 16; const float rs = rs1[row];
                    float o[8];
#pragma unroll
                    for (int n = 0; n < 2; ++n)
#pragma unroll
                        for (int e = 0; e < 4; ++e) { const float a = acc[ai][0][m][n][e] * rs + ba[n][e], g = acc[ai][1][m][n][e] * rs + bg[n][e]; o[4 * n + e] = a * sigmoidf_(g); }
                    u32x4 w; w.x = cvt_pk_bf16(o[0], o[1]); w.y = cvt_pk_bf16(o[2], o[3]); w.z = cvt_pk_bf16(o[4], o[5]); w.w = cvt_pk_bf16(o[6], o[7]);
                    *(u32x4*)(hglu + (size_t)row * 512 + ch) = w; }
            return;
        }
        bf16_t* dst; int ld, col; bool do_rope = true, is_wi = false;
        if (u.pn < 2) { dst = q; ld = 512; col = (4 * u.pn + wc) * 64; }
        else if (u.pn == 2) { dst = qi; ld = 256; col = wc * 64; }
        else { ld = 64; col = 0; if (wc == 0) dst = k; else if (wc == 1) dst = ki; else if (wc == 2) { dst = v; do_rope = false; } else { dst = v; is_wi = true; do_rope = false; } }
        if (is_wi) {
            if (fq == 0) {
#pragma unroll
                for (int ai = 0; ai < 2; ++ai)
#pragma unroll
                    for (int m = 0; m < 4; ++m) { const int row = row0 + ai * HALF + m * 16; const float rs = rs1[row];
                        *(f32x4*)(wi + (size_t)row * 4) = acc[ai][0][m][0] * rs; }
            }
            return;
        }
        const int d0 = 8 * fq;
#pragma unroll
        for (int ai = 0; ai < 2; ++ai)
#pragma unroll
            for (int m = 0; m < 4; ++m) { const int row = row0 + ai * HALF + m * 16; const float rs = rs1[row];
                float o1[8], o2[8];
                if (do_rope) {
                    const f32x4* rp = (const f32x4*)(rope + (size_t)(row & (SEQ - 1)) * 32 + d0);
#pragma unroll
                    for (int n = 0; n < 2; ++n)
#pragma unroll
                        for (int e2 = 0; e2 < 2; ++e2) { const f32x4 cs = rp[2 * n + e2];
                            { const float x1 = acc[ai][0][m][n][2 * e2] * rs, x2 = acc[ai][1][m][n][2 * e2] * rs; o1[4 * n + 2 * e2] = x1 * cs.x - x2 * cs.y; o2[4 * n + 2 * e2] = x2 * cs.x + x1 * cs.y; }
                            { const float x1 = acc[ai][0][m][n][2 * e2 + 1] * rs, x2 = acc[ai][1][m][n][2 * e2 + 1] * rs; o1[4 * n + 2 * e2 + 1] = x1 * cs.z - x2 * cs.w; o2[4 * n + 2 * e2 + 1] = x2 * cs.z + x1 * cs.w; } }
                } else {
#pragma unroll
                    for (int n = 0; n < 2; ++n)
#pragma unroll
                        for (int e = 0; e < 4; ++e) { o1[4 * n + e] = acc[ai][0][m][n][e] * rs; o2[4 * n + e] = acc[ai][1][m][n][e] * rs; }
                }
                u32x4 w1, w2; w1.x = cvt_pk_bf16(o1[0], o1[1]); w1.y = cvt_pk_bf16(o1[2], o1[3]); w1.z = cvt_pk_bf16(o1[4], o1[5]); w1.w = cvt_pk_bf16(o1[6], o1[7]);
                w2.x = cvt_pk_bf16(o2[0], o2[1]); w2.y = cvt_pk_bf16(o2[2], o2[3]); w2.z = cvt_pk_bf16(o2[4], o2[5]); w2.w = cvt_pk_bf16(o2[6], o2[7]);
                if (u.pn == 3 && wc == 1) {
                    bf16_t* tp = ki + ((size_t)(row >> 5) * 256 + (row & 31) + 32 * (fq & 1)) * 8;
                    *(u32x4*)(tp + (size_t)(fq >> 1) * 512) = w1; *(u32x4*)(tp + (size_t)(2 + (fq >> 1)) * 512) = w2;
                } else {
                    bf16_t* rp2 = dst + (size_t)row * ld + col + d0;
                    *(u32x4*)(rp2) = w1; *(u32x4*)(rp2 + 32) = w2; } }
    }
};

struct EpiBf16Plain {
    static constexpr bool PERM = true;
    bf16_t* O; int ldc; float scale;
    __device__ __forceinline__ void pre(AccRef acc, const Unit&, int, int, int, int, const LAS unsigned char*) const {
#pragma unroll
        for (int ai = 0; ai < 2; ++ai)
#pragma unroll
            for (int bj = 0; bj < 2; ++bj)
#pragma unroll
                for (int m = 0; m < 4; ++m) { acc[ai][bj][m][0] = acc[ai][bj][m][0] * scale; acc[ai][bj][m][1] = acc[ai][bj][m][1] * scale; pack8_bf16(acc[ai][bj][m][0], acc[ai][bj][m][1]); }
    }
    __device__ __forceinline__ void post(AccRef acc, const Unit& u, int wr, int wc, int fr, int fq, const LAS unsigned char* mt) const {
        const int row0 = u.pm * BM + wr * 64 + fr, col0 = u.pn * BM + wc * 32 + 8 * fq;
#pragma unroll
        for (int ai = 0; ai < 2; ++ai)
#pragma unroll
            for (int m = 0; m < 4; ++m) { bf16_t* rowp = O + (size_t)(row0 + ai * HALF + m * 16) * ldc + col0;
#pragma unroll
                for (int bj = 0; bj < 2; ++bj) *(u32x4*)(rowp + bj * HALF) = AS_U4(acc[ai][bj][m][0]); }
    }
    __device__ __forceinline__ void run(const f32x4 (&acc)[2][2][4][2], const Unit& u, int wr, int wc, int fr, int fq, const LAS unsigned char* mt) const {
        const int row0 = u.pm * BM + wr * 64 + fr, col0 = u.pn * BM + wc * 32 + 8 * fq;
#pragma unroll
        for (int ai = 0; ai < 2; ++ai)
#pragma unroll
            for (int m = 0; m < 4; ++m) { bf16_t* rowp = O + (size_t)(row0 + ai * HALF + m * 16) * ldc + col0;
#pragma unroll
                for (int bj = 0; bj < 2; ++bj) { const f32x4 v0 = acc[ai][bj][m][0] * scale, v1 = acc[ai][bj][m][1] * scale;
                    u32x4 w; w.x = cvt_pk_bf16(v0[0], v0[1]); w.y = cvt_pk_bf16(v0[2], v0[3]); w.z = cvt_pk_bf16(v1[0], v1[1]); w.w = cvt_pk_bf16(v1[2], v1[3]);
                    *(u32x4*)(rowp + bj * HALF) = w; } }
    }
};

struct EpiF8Plain {
    static constexpr bool PERM = true;
    unsigned char* O; int ldc; float scale;
    __device__ __forceinline__ void pre(AccRef acc, const Unit&, int, int, int, int, const LAS unsigned char*) const {}
    __device__ __forceinline__ void post(AccRef acc, const Unit& u, int wr, int wc, int fr, int fq, const LAS unsigned char* mt) const {
        const int row0 = u.pm * BM + wr * 64 + fr, col0 = u.pn * BM + wc * 32 + 8 * fq;
#pragma unroll
        for (int ai = 0; ai < 2; ++ai)
#pragma unroll
            for (int m = 0; m < 4; ++m) { unsigned char* rowp = O + (size_t)(row0 + ai * HALF + m * 16) * ldc + col0;
#pragma unroll
                for (int bj = 0; bj < 2; ++bj) { const f32x4 v0 = acc[ai][bj][m][0] * scale, v1 = acc[ai][bj][m][1] * scale;
                    u32x2 w; w.x = pk4_fp8(v0[0], v0[1], v0[2], v0[3]); w.y = pk4_fp8(v1[0], v1[1], v1[2], v1[3]);
                    *(u32x2*)(rowp + bj * HALF) = w; } }
    }
    __device__ __forceinline__ void run(AccRef acc, const Unit& u, int wr, int wc, int fr, int fq, const LAS unsigned char* mt) const { post(acc, u, wr, wc, fr, fq, mt); }
};

struct EpiOutProj {
    static constexpr bool PERM = false;
    const float* x; float* h1; unsigned char* h1f8;
    __device__ __forceinline__ void pre(AccRef acc, const Unit& u, int wr, int wc, int fr, int fq, const LAS unsigned char* mt) const {
        const int row0 = u.pm * BM + wr * 64 + fr, col0 = u.pn * BM + wc * 32 + 4 * fq;
#pragma unroll
        for (int ai = 0; ai < 2; ++ai)
#pragma unroll
            for (int m = 0; m < 4; ++m) { const size_t off = (size_t)(row0 + ai * HALF + m * 16) * DM + col0;
#pragma unroll
                for (int bj = 0; bj < 2; ++bj)
#pragma unroll
                    for (int n = 0; n < 2; ++n) acc[ai][bj][m][n] += NT_LD((const f32x4*)(x + off + bj * HALF + n * 16));
                if (m & 1) __builtin_amdgcn_sched_barrier(0); }
    }
    __device__ __forceinline__ void post(AccRef acc, const Unit& u, int wr, int wc, int fr, int fq, const LAS unsigned char* mt) const {
        const int row0 = u.pm * BM + wr * 64 + fr, col0 = u.pn * BM + wc * 32 + 4 * fq;
#pragma unroll
        for (int ai = 0; ai < 2; ++ai)
#pragma unroll
            for (int m = 0; m < 4; ++m) { const size_t off = (size_t)(row0 + ai * HALF + m * 16) * DM + col0;
#pragma unroll
                for (int bj = 0; bj < 2; ++bj)
#pragma unroll
                    for (int n = 0; n < 2; ++n) { const size_t o = off + bj * HALF + n * 16; const f32x4 r = acc[ai][bj][m][n];
                        *(f32x4*)(h1 + o) = r; *(unsigned*)(h1f8 + o) = pk4_fp8(r[0], r[1], r[2], r[3]); } }
    }
    __device__ __forceinline__ void run(AccRef acc, const Unit& u, int wr, int wc, int fr, int fq, const LAS unsigned char* mt) const { pre(acc, u, wr, wc, fr, fq, mt); post(acc, u, wr, wc, fr, fq, mt); }
};

struct EpiUp {
    static constexpr bool PERM = true;
    unsigned char* act;
    __device__ __forceinline__ void pre(AccRef acc, const Unit& u, int wr, int wc, int fr, int fq, const LAS unsigned char* mt) const {
        const int r0 = wr * 64 + fr, cl = 32 * wc + 8 * fq;
        const LAS float* rowA = (const LAS float*)mt; const LAS float* bias = (const LAS float*)(mt + 2048);
        f32x4 bg[2], bl[2];
#pragma unroll
        for (int n = 0; n < 2; ++n) { bg[n] = *(const LAS f32x4*)(bias + cl + 4 * n); bl[n] = *(const LAS f32x4*)(bias + 128 + cl + 4 * n); }
#pragma unroll
        for (int ai = 0; ai < 2; ++ai)
#pragma unroll
            for (int m = 0; m < 4; ++m) { const int r = r0 + ai * HALF + m * 16;
                const float rs = (r < u.rows) ? rowA[r] * 0.03125f : 0.f;
#pragma unroll
                for (int n = 0; n < 2; ++n)
#pragma unroll
                    for (int e = 0; e < 4; ++e) { float g = acc[ai][0][m][n][e] * rs + bg[n][e], l = acc[ai][1][m][n][e] * rs + bl[n][e];
                        g = fminf(g, 7.0f); l = fminf(fmaxf(l, -7.0f), 7.0f); acc[ai][0][m][n][e] = g * sigmoidf_(1.702f * g) * (l + 1.0f); } }
    }
    __device__ __forceinline__ void post(AccRef acc, const Unit& u, int wr, int wc, int fr, int fq, const LAS unsigned char* mt) const {
        const int r0 = wr * 64 + fr, ch = 128 * u.pn + 32 * wc + 8 * fq;
#pragma unroll
        for (int ai = 0; ai < 2; ++ai)
#pragma unroll
            for (int m = 0; m < 4; ++m) { const int r = r0 + ai * HALF + m * 16;
                const f32x4 v0 = acc[ai][0][m][0], v1 = acc[ai][0][m][1];
                u32x2 w; w.x = pk4_fp8(v0[0], v0[1], v0[2], v0[3]); w.y = pk4_fp8(v1[0], v1[1], v1[2], v1[3]);
                *(u32x2*)(act + (size_t)(u.pm * BM + r) * 1024 + ch) = w; }
    }
    __device__ __forceinline__ void run(const f32x4 (&acc)[2][2][4][2], const Unit& u, int wr, int wc, int fr, int fq, const LAS unsigned char* mt) const {
        const int r0 = wr * 64 + fr, cl = 32 * wc + 8 * fq, ch = 128 * u.pn + cl;
        const LAS float* rowA = (const LAS float*)mt; const LAS float* bias = (const LAS float*)(mt + 2048);
        f32x4 bg[2], bl[2];
#pragma unroll
        for (int n = 0; n < 2; ++n) { bg[n] = *(const LAS f32x4*)(bias + cl + 4 * n); bl[n] = *(const LAS f32x4*)(bias + 128 + cl + 4 * n); }
#pragma unroll
        for (int ai = 0; ai < 2; ++ai)
#pragma unroll
            for (int m = 0; m < 4; ++m) { const int r = r0 + ai * HALF + m * 16;
                const float rs = (r < u.rows) ? rowA[r] * 0.03125f : 0.f;
                float o[8];
#pragma unroll
                for (int n = 0; n < 2; ++n)
#pragma unroll
                    for (int e = 0; e < 4; ++e) { float g = acc[ai][0][m][n][e] * rs + bg[n][e], l = acc[ai][1][m][n][e] * rs + bl[n][e];
                        g = fminf(g, 7.0f); l = fminf(fmaxf(l, -7.0f), 7.0f); o[4 * n + e] = g * sigmoidf_(1.702f * g) * (l + 1.0f); }
                u32x2 w; w.x = pk4_fp8(o[0], o[1], o[2], o[3]); w.y = pk4_fp8(o[4], o[5], o[6], o[7]);
                *(u32x2*)(act + (size_t)(u.pm * BM + r) * 1024 + ch) = w; }
    }
};

struct EpiDown {
    static constexpr bool PERM = true;
    unsigned char* y;
    __device__ __forceinline__ void pre(AccRef acc, const Unit& u, int wr, int wc, int fr, int fq, const LAS unsigned char* mt) const {
        const int r0 = wr * 64 + fr, cl = wc * 32 + 8 * fq;
        const LAS float* gateT = (const LAS float*)(mt + 1024); const LAS float* bias = (const LAS float*)(mt + 2048);
        float gt[2][4];
#pragma unroll
        for (int ai = 0; ai < 2; ++ai)
#pragma unroll
            for (int m = 0; m < 4; ++m) gt[ai][m] = gateT[r0 + ai * HALF + m * 16] * 16.0f;
#pragma unroll
        for (int bj = 0; bj < 2; ++bj) { const f32x4 bv0 = *(const LAS f32x4*)(bias + cl + bj * HALF), bv1 = *(const LAS f32x4*)(bias + cl + bj * HALF + 4);
#pragma unroll
            for (int ai = 0; ai < 2; ++ai)
#pragma unroll
                for (int m = 0; m < 4; ++m) { acc[ai][bj][m][0] = (acc[ai][bj][m][0] * 0.03125f + bv0) * gt[ai][m]; acc[ai][bj][m][1] = (acc[ai][bj][m][1] * 0.03125f + bv1) * gt[ai][m]; } }
    }
    __device__ __forceinline__ void post(AccRef acc, const Unit& u, int wr, int wc, int fr, int fq, const LAS unsigned char* mt) const {
        const int r0 = wr * 64 + fr, col0 = u.pn * BM + wc * 32 + 8 * fq;
        const LAS int* slotT = (const LAS int*)mt;
#pragma unroll
        for (int ai = 0; ai < 2; ++ai)
#pragma unroll
            for (int m = 0; m < 4; ++m) { const int r = r0 + ai * HALF + m * 16;
                if (r < u.rows) { unsigned char* rowp = y + (size_t)slotT[r] * 1024 + col0;
#pragma unroll
                    for (int bj = 0; bj < 2; ++bj) { const f32x4 v0 = acc[ai][bj][m][0], v1 = acc[ai][bj][m][1];
                        u32x2 w; w.x = pk4_fp8(v0[0], v0[1], v0[2], v0[3]); w.y = pk4_fp8(v1[0], v1[1], v1[2], v1[3]);
                        *(u32x2*)(rowp + bj * HALF) = w; } } }
    }
    __device__ __forceinline__ void run(AccRef acc, const Unit& u, int wr, int wc, int fr, int fq, const LAS unsigned char* mt) const { pre(acc, u, wr, wc, fr, fq, mt); post(acc, u, wr, wc, fr, fq, mt); }
};

template <bool F8>
__device__ __forceinline__ void p0_transpose_item(const float* W, int ldw, void* WTv, int Kdim, const float* gain, LAS float* scr, int kb, int n0, int src0, int nvalid, int lane) {
    bf16_t* WT = (bf16_t*)WTv;
    const int k0 = 64 * kb;
    f32x4 ld4[8];
#pragma unroll
    for (int i = 0; i < 8; ++i) { const int kk = 8 * i + (lane >> 3), j = (lane & 7) * 4;
        ld4[i] = (f32x4){0.f, 0.f, 0.f, 0.f}; if (j < nvalid) ld4[i] = NT_LD((const f32x4*)(W + (size_t)(k0 + kk) * ldw + src0 + j)); }
#pragma unroll
    for (int i = 0; i < 8; ++i) { const int kk = 8 * i + (lane >> 3), j = (lane & 7) * 4; const float gk = (gain ? gain[k0 + kk] : 1.0f) * (F8 ? 32.0f : 1.0f);
        LAS float* d = scr + kk * 33 + j; d[0] = ld4[i].x * gk; d[1] = ld4[i].y * gk; d[2] = ld4[i].z * gk; d[3] = ld4[i].w * gk; }
    LDS_WAIT(); asm volatile("" ::: "memory");
    const int c = lane & 7;
#pragma unroll
    for (int j = 0; j < 4; ++j) { const int n = (lane >> 3) + 8 * j; const LAS float* s = scr + (8 * c) * 33 + n;
        if constexpr (F8) { u32x2 o; o.x = pk4_fp8(s[0 * 33], s[1 * 33], s[2 * 33], s[3 * 33]); o.y = pk4_fp8(s[4 * 33], s[5 * 33], s[6 * 33], s[7 * 33]);
            *(u32x2*)((unsigned char*)WTv + (size_t)(n0 + n) * Kdim + k0 + 8 * c) = o; }
        else { u32x4 o; o.x = pk2(s[0 * 33], s[1 * 33]); o.y = pk2(s[2 * 33], s[3 * 33]); o.z = pk2(s[4 * 33], s[5 * 33]); o.w = pk2(s[6 * 33], s[7 * 33]);
            *(u32x4*)(WT + (size_t)(n0 + n) * Kdim + k0 + 8 * c) = o; } }
    LDS_WAIT(); asm volatile("" ::: "memory");
}
__device__ __forceinline__ void win_colmap(int nb, int& src0, int& nvalid) {
    const int pn = nb >> 3, j = (nb & 7) * 32, bj = j >> 7, slot = (j & 127) >> 5;
    nvalid = 32;
    if (pn < 2) src0 = (4 * pn + slot) * 64 + 32 * bj;
    else if (pn == 2) src0 = 640 + slot * 64 + 32 * bj;
    else if (pn == 3) { if (slot == 0) src0 = 512 + 32 * bj; else if (slot == 1) src0 = 896 + 32 * bj; else if (slot == 2) src0 = 576 + 32 * bj; else { src0 = 960; nvalid = bj == 0 ? 4 : 0; } }
    else src0 = 964 + 512 * bj + 128 * (pn - 4) + 32 * slot;
}
__device__ __forceinline__ void p0_prologue(const Params& P, LAS unsigned char* lds, int vcu, int G, int wave, int lane) {
    unsigned char* ws = P.ws;
    LAS float* scr = (LAS float*)(lds + wave * 16384);
    const int gw = vcu * NWAVES + wave, NGW = G * NWAVES;
    constexpr int I_IN = 16 * 64, I_OUT = 16 * 32, I_G = 16 * 32, I_P = 4 * 32;
    constexpr int NITEMS = I_IN + I_OUT + I_G + I_P;
    for (int it = gw; it < NITEMS; it += NGW) {
        int r = it;
        if (r < I_IN) { const int kb = r / 64, nb = r % 64; int s0, nv; win_colmap(nb, s0, nv); p0_transpose_item<false>(P.w_in, INW, (bf16_t*)(ws + WS_WIN), 1024, P.g_mix, scr, kb, nb * 32, s0, nv, lane); continue; } r -= I_IN;
        if (r < I_OUT) { const int kb = r / 32, nb = r % 32; p0_transpose_item<false>(P.w_out, 1024, (bf16_t*)(ws + WS_WOUT), 1024, nullptr, scr, kb, nb * 32, nb * 32, 32, lane); continue; } r -= I_OUT;
        if (r < I_G) { const int kb = r / 32, nb = r % 32; p0_transpose_item<true>(P.w_ple_gate, 1024, (unsigned char*)(ws + WS_WG), 1024, P.g_ple, scr, kb, nb * 32, nb * 32, 32, lane); continue; } r -= I_G;
        { const int kb = r / 32, nb = r % 32; p0_transpose_item<false>(P.w_ple_proj, 1024, (bf16_t*)(ws + WS_WP), 256, nullptr, scr, kb, nb * 32, nb * 32, 32, lane); }
    }
    float* rs1 = (float*)(ws + WS_RS1); bf16_t* xb = (bf16_t*)(ws + WS_XB);
    for (int m = gw; m < NTOK; m += NGW) {
        const f32x4* xr = (const f32x4*)(P.x + (size_t)m * DM) + lane; f32x4 v[4]; float s = 0.f;
#pragma unroll
        for (int j = 0; j < 4; ++j) { v[j] = NT_LD(xr + 64 * j); s += (v[j].x * v[j].x + v[j].y * v[j].y) + (v[j].z * v[j].z + v[j].w * v[j].w); }
        s = wave_sum(s);
        u32x2* o8 = (u32x2*)(xb + (size_t)m * DM) + lane;
#pragma unroll
        for (int j = 0; j < 4; ++j) { u32x2 w; w.x = pk2(v[j].x, v[j].y); w.y = pk2(v[j].z, v[j].w); o8[64 * j] = w; }
        if (lane == 0) rs1[m] = 1.0f / sqrtf(s * (1.0f / DM) + EPS);
    }
    bf16_t* pb = (bf16_t*)(ws + WS_PB);
    for (int m = gw; m < NTOK; m += NGW) { const f32x4 v = NT_LD((const f32x4*)(P.p + (size_t)m * 256) + lane); u32x2 w; w.x = pk2(v.x, v.y); w.y = pk2(v.z, v.w); *((u32x2*)(pb + (size_t)m * 256) + lane) = w; }
    f32x2* rope = (f32x2*)(ws + WS_ROPE);
    for (int idx = gw * 64 + lane; idx < SEQ * 32; idx += NGW * 64) { const int t = idx >> 5, i = idx & 31;
        const float inv = exp2f(-(float)i * (13.287712379549449f / 32.0f));
        const float ang = (float)t * inv;
        const double rev = (double)ang * 0.15915494309189535; const float fr = (float)(rev - __builtin_floor(rev));
        rope[idx] = (f32x2){__builtin_amdgcn_cosf(fr), __builtin_amdgcn_sinf(fr)}; }
    float* wrg = (float*)(ws + WS_WRG);
    for (int idx = gw * 64 + lane; idx < 1024 * 32; idx += NGW * 64) wrg[idx] = P.w_router[idx] * P.g_ffn[idx >> 5];
}

__device__ __forceinline__ unsigned fkey(float f) { unsigned u = __builtin_bit_cast(unsigned, f); if (u == 0x80000000u) u = 0u; return u ^ ((unsigned)((int)u >> 31) | 0x80000000u); }
__device__ __forceinline__ int mbcnt64(unsigned long long m) { return __builtin_amdgcn_mbcnt_hi((unsigned)(m >> 32), __builtin_amdgcn_mbcnt_lo((unsigned)m, 0u)); }

template <int NR>
__device__ __forceinline__ unsigned bisect_thr(const unsigned (&v)[NR], unsigned prefix, int startbit) {
    bool exact = false;
#pragma unroll 1
    for (int bit = startbit; bit >= 0; --bit) {
        const unsigned cand = prefix | (1u << bit); int cnt = 0;
#pragma unroll
        for (int r = 0; r < NR; ++r) { cnt += __builtin_popcountll(__ballot(v[r] >= cand)); if ((r & 7) == 7) __builtin_amdgcn_sched_barrier(0); }
        if (cnt >= NSEL) prefix = cand;
        if (cnt == NSEL) { exact = true; break; }
    }
    return exact ? prefix - 1u : prefix;
}
template <int NR, bool EXPL>
__device__ __forceinline__ void compact_sel(const unsigned (&v)[NR], const unsigned (&ci)[NR], unsigned T, LAS unsigned* list, int lane) {
    int cgt = 0;
#pragma unroll
    for (int r = 0; r < NR; ++r) { cgt += __builtin_popcountll(__ballot(v[r] > T)); if ((r & 7) == 7) __builtin_amdgcn_sched_barrier(0); }
    const int need = NSEL - cgt; int base = 0, ties = 0;
#pragma unroll
    for (int r = 0; r < NR; ++r) { const bool gt = v[r] > T, eq = v[r] == T; const unsigned long long em = __ballot(eq);
        const bool sel = gt || (eq && (ties + mbcnt64(em)) < need); const unsigned long long sm = __ballot(sel);
        list[sel ? base + mbcnt64(sm) : NSEL + lane] = EXPL ? ci[r] : (unsigned)(r * 64 + lane);
        base += __builtin_popcountll(sm); ties += __builtin_popcountll(em);
        if ((r & 3) == 3) __builtin_amdgcn_sched_barrier(0); }
}
constexpr int SEL_CAP = 1024;
template <int NR>
__device__ __forceinline__ void select_topk(LAS float* row, LAS unsigned* H, LAS unsigned* list, int lane, bool zero_h) {
    unsigned v[NR];
#pragma unroll
    for (int r = 0; r < NR; ++r) v[r] = fkey(row[r * 64 + lane]);
    LAS u32x4* H4 = (LAS u32x4*)H;
    const u32x4 h0 = H4[2 * lane], h1 = H4[2 * lane + 1];
    if (zero_h) { H4[2 * lane] = (u32x4){0u, 0u, 0u, 0u}; H4[2 * lane + 1] = (u32x4){0u, 0u, 0u, 0u}; }
    const unsigned hw[8] = {h0.x, h0.y, h0.z, h0.w, h1.x, h1.y, h1.z, h1.w};
    unsigned c[16];
#pragma unroll
    for (int i = 0; i < 8; ++i) { c[2 * i] = hw[i] & 0xffffu; c[2 * i + 1] = hw[i] >> 16; }
    unsigned s = 0u;
#pragma unroll
    for (int i = 0; i < 16; ++i) s += c[i];
    unsigned S = s;
#pragma unroll
    for (int off = 1; off < 64; off <<= 1) { const unsigned o = __shfl_down(S, off); if (lane + off < 64) S += o; }
    const unsigned long long okm = __ballot(S >= (unsigned)NSEL);
    bool fast = okm != 0ull; unsigned floorkey = 0u; int C = 0;
    if (fast) {
        const int Ls = 63 - __builtin_clzll(okm);
        unsigned acc = S - s; int bl = -1; unsigned accb = 0u;
#pragma unroll
        for (int b = 15; b >= 0; --b) { acc += c[b]; if (bl < 0 && acc >= (unsigned)NSEL) { bl = b; accb = acc; } }
        const int bstar = __shfl(bl, Ls) + 16 * Ls; C = (int)__shfl(accb, Ls);
        floorkey = (unsigned)bstar << 22;
        fast = (bstar > 1) && (C <= SEL_CAP);
    }
    if (!fast) {
        const unsigned T = bisect_thr<NR>(v, 0u, 31);
        compact_sel<NR, false>(v, v, T, list, lane);
        return;
    }
    LAS unsigned* ckl = (LAS unsigned*)row; LAS unsigned* cil = ckl + 1152;
    { int base = 0;
#pragma unroll
      for (int r = 0; r < NR; ++r) { const bool cnd = v[r] >= floorkey; const unsigned long long m = __ballot(cnd);
          const int pos = cnd ? base + mbcnt64(m) : SEL_CAP + lane;
          ckl[pos] = v[r]; cil[pos] = (unsigned)(r * 64 + lane); base += __builtin_popcountll(m);
          if ((r & 3) == 3) __builtin_amdgcn_sched_barrier(0); } }
    if (C <= 512) {
        unsigned ck[8], ci[8];
#pragma unroll
        for (int j = 0; j < 8; ++j) { const int i = j * 64 + lane; ck[j] = i < C ? ckl[i] : 0u; ci[j] = cil[i]; }
        const unsigned T = (C == NSEL) ? floorkey - 1u : bisect_thr<8>(ck, floorkey, 21);
        compact_sel<8, true>(ck, ci, T, list, lane);
    } else {
        unsigned ck[16], ci[16];
#pragma unroll
        for (int j = 0; j < 16; ++j) { const int i = j * 64 + lane; ck[j] = i < C ? ckl[i] : 0u; ci[j] = cil[i]; }
        const unsigned T = bisect_thr<16>(ck, floorkey, 21);
        compact_sel<16, true>(ck, ci, T, list, lane);
    }
}

typedef short v4i16 __attribute__((ext_vector_type(4)));
constexpr int VROW = 144;

__device__ __forceinline__ void attn_tile(const Params& P, LAS unsigned char* lds, int b, int t0, int wave, int lane) {
    unsigned char* ws = P.ws;
    const bf16_t* QI = (const bf16_t*)(ws + WS_QI); const bf16_t* KI = (const bf16_t*)(ws + WS_KI);
    const bf16_t* Q = (const bf16_t*)(ws + WS_Q); const bf16_t* Kp = (const bf16_t*)(ws + WS_K); const bf16_t* Vp = (const bf16_t*)(ws + WS_V);
    const float* WI = (const float*)(ws + WS_WI); bf16_t* MIX = (bf16_t*)(ws + WS_MIX);
    LAS float* SC = (LAS float*)lds;
    LAS unsigned* list = (LAS unsigned*)(lds + wave * 16384 + 14336);
    LAS unsigned* HIST = (LAS unsigned*)(lds + LDS_MISC);
    const int tokbase = b * SEQ;
    const bool need_sel = t0 >= 256;
    if (need_sel) {
        const int nkt = (t0 + 8 + 31) >> 5;
        bf16x8 a[4]; f32x4 w[4];
        { const bf16_t* src = QI + (size_t)(tokbase + t0 + ((lane & 31) >> 2)) * 256 + (lane & 3) * 64 + 8 * (lane >> 5);
#pragma unroll
          for (int ks = 0; ks < 4; ++ks) a[ks] = *(const bf16x8*)(src + 16 * ks); }
#pragma unroll
        for (int g = 0; g < 4; ++g) w[g] = *(const f32x4*)(WI + (size_t)(tokbase + t0 + 2 * g + (lane >> 5)) * 4);
        for (int kt0 = wave; kt0 < nkt; kt0 += 4 * NWAVES) {
            bf16x8 bf[4][4];
#pragma unroll
            for (int u = 0; u < 4; ++u) { const int kt = kt0 + u * NWAVES;
                if (kt < nkt) { const bf16_t* ksrc = KI + ((size_t)((tokbase >> 5) + kt) * 256 + lane) * 8;
#pragma unroll
                    for (int ks = 0; ks < 4; ++ks) bf[u][ks] = *(const bf16x8*)(ksrc + 512 * ks); } }
#pragma unroll
            for (int u = 0; u < 4; ++u) { const int kt = kt0 + u * NWAVES;
                if (kt < nkt) {
                    const int key = kt * 32 + (lane & 31);
                    f32x16 acc;
#pragma unroll
                    for (int i = 0; i < 16; ++i) acc[i] = 0.f;
#pragma unroll
                    for (int ks = 0; ks < 4; ++ks) acc = __builtin_amdgcn_mfma_f32_32x32x16_bf16(a[ks], bf[u][ks], acc, 0, 0, 0);
#pragma unroll
                    for (int g = 0; g < 4; ++g) { float sc = 0.f;
#pragma unroll
                        for (int h = 0; h < 4; ++h) sc = fmaf(fmaxf(acc[4 * g + h], 0.f), w[g][h], sc);
                        const int ql = 2 * g + (lane >> 5);
                        if (key > t0 + ql) sc = -INFINITY;
                        SC[ql * 4096 + key] = sc;
                        if (key <= t0 + ql) { const unsigned ub = __builtin_bit_cast(unsigned, sc);
                            const unsigned bin = (ub >> 22) ^ (((unsigned)((int)ub >> 31) & 0x1ffu) | 0x200u);
                            __hip_atomic_fetch_add(HIST + ql * 512 + (bin >> 1), 1u << ((bin & 1u) << 4), __ATOMIC_RELAXED, __HIP_MEMORY_SCOPE_WORKGROUP); } }
                } }
        }
        { const int npad = ((t0 + 8 + 1023) >> 10) << 10;
          for (int i = nkt * 32 + (int)threadIdx.x; i < npad; i += NTHR) {
#pragma unroll
              for (int q = 0; q < 8; ++q) SC[q * 4096 + i] = -INFINITY; } }
    }
    __syncthreads();
    const int t = t0 + wave, tok = tokbase + t;
    if (need_sel) {
        LAS float* row = SC + wave * 4096; LAS unsigned* H = HIST + wave * 512; const int n = t + 1;
        if (n <= 1024) select_topk<16>(row, H, list, lane, true);
        else if (n <= 2048) select_topk<32>(row, H, list, lane, true);
        else if (n <= 3072) select_topk<48>(row, H, list, lane, true);
        else select_topk<64>(row, H, list, lane, true);
    } else {
#pragma unroll
        for (int i = 0; i < 4; ++i) list[i * 64 + lane] = (unsigned)(i * 64 + lane);
    }
    const int nvalid = need_sel ? NSEL : (t + 1);
    const int hd = lane & 15, g = lane >> 4;
    bf16x8 qf0, qf1;
#pragma unroll
    for (int i = 0; i < 8; ++i) { qf0[i] = 0; qf1[i] = 0; }
    if (hd < 8) { const bf16_t* qs = Q + (size_t)tok * 512 + hd * 64 + 8 * g; qf0 = *(const bf16x8*)qs; qf1 = *(const bf16x8*)(qs + 32); }
    LAS unsigned char* vreg = lds + wave * 16384;
    u32x4 rA[4], rB[4];
#define ATT_ROWS(R, SRC, G_) do { const int nb_ = (G_) * 32; \
        _Pragma("unroll") for (int i_ = 0; i_ < 4; ++i_) { const unsigned idx_ = list[nb_ + (lane >> 3) + 8 * i_]; R[i_] = *(const u32x4*)((SRC) + (size_t)(tokbase + idx_) * 64 + 8 * (lane & 7)); } } while (0)
#define ATT_STAGE(R, BUF) do { _Pragma("unroll") for (int i_ = 0; i_ < 4; ++i_) *(LAS u32x4*)((BUF) + ((lane >> 3) + 8 * i_) * VROW + (lane & 7) * 16) = R[i_]; } while (0)
    float lg[8][8];
#define ATT_QK(R, G_, BUF) do { LAS unsigned char* kb_ = (BUF); ATT_STAGE(R, kb_); \
        if constexpr ((G_) + 2 < 8) { ATT_ROWS(R, Kp, (G_) + 2); } \
        const LAS unsigned char* kr_ = kb_ + hd * VROW + 16 * g; \
        const bf16x8 ka0_ = *(const LAS bf16x8*)kr_, ka1_ = *(const LAS bf16x8*)(kr_ + 64), kb0_ = *(const LAS bf16x8*)(kr_ + 16 * VROW), kb1_ = *(const LAS bf16x8*)(kr_ + 16 * VROW + 64); \
        f32x4 sa_ = {0.f, 0.f, 0.f, 0.f}, sb_ = {0.f, 0.f, 0.f, 0.f}; \
        sa_ = __builtin_amdgcn_mfma_f32_16x16x32_bf16(ka0_, qf0, sa_, 0, 0, 0); sa_ = __builtin_amdgcn_mfma_f32_16x16x32_bf16(ka1_, qf1, sa_, 0, 0, 0); \
        sb_ = __builtin_amdgcn_mfma_f32_16x16x32_bf16(kb0_, qf0, sb_, 0, 0, 0); sb_ = __builtin_amdgcn_mfma_f32_16x16x32_bf16(kb1_, qf1, sb_, 0, 0, 0); \
        _Pragma("unroll") for (int r_ = 0; r_ < 4; ++r_) { const int sl_ = (G_) * 32 + 4 * g + r_; \
            lg[G_][r_] = sl_ < nvalid ? sa_[r_] * 0.125f : -INFINITY; lg[G_][4 + r_] = (sl_ + 16) < nvalid ? sb_[r_] * 0.125f : -INFINITY; } } while (0)
    ATT_ROWS(rA, Kp, 0); ATT_ROWS(rB, Kp, 1);
    ATT_QK(rA, 0, vreg); ATT_QK(rB, 1, vreg + 4608); ATT_QK(rA, 2, vreg); ATT_QK(rB, 3, vreg + 4608);
    ATT_QK(rA, 4, vreg); ATT_QK(rB, 5, vreg + 4608); ATT_QK(rA, 6, vreg); ATT_QK(rB, 7, vreg + 4608);
    ATT_ROWS(rA, Vp, 0); ATT_ROWS(rB, Vp, 1);
    float mx = -INFINITY;
#pragma unroll
    for (int q = 0; q < 8; ++q)
#pragma unroll
        for (int r = 0; r < 8; ++r) mx = fmaxf(mx, lg[q][r]);
    mx = fmaxf(mx, __shfl_xor(mx, 16)); mx = fmaxf(mx, __shfl_xor(mx, 32));
    float ssum = 0.f;
#pragma unroll
    for (int q = 0; q < 8; ++q)
#pragma unroll
        for (int r = 0; r < 8; ++r) { lg[q][r] = __expf(lg[q][r] - mx); ssum += lg[q][r]; }
    f32x4 o[4];
#pragma unroll
    for (int dt = 0; dt < 4; ++dt) o[dt] = (f32x4){0.f, 0.f, 0.f, 0.f};
#define ATT_PV(R, G_, BUF) do { LAS unsigned char* vb_ = (BUF); ATT_STAGE(R, vb_); \
        if constexpr ((G_) + 2 < 8) { ATT_ROWS(R, Vp, (G_) + 2); } \
        bf16x8 pf_; \
        { const u32x4 pw_ = {cvt_pk_bf16(lg[G_][0], lg[G_][1]), cvt_pk_bf16(lg[G_][2], lg[G_][3]), cvt_pk_bf16(lg[G_][4], lg[G_][5]), cvt_pk_bf16(lg[G_][6], lg[G_][7])}; pf_ = __builtin_bit_cast(bf16x8, pw_); } \
        LAS unsigned char* ta_ = vb_ + (4 * g + (hd >> 2)) * VROW + (hd & 3) * 8; \
        _Pragma("unroll") for (int dt_ = 0; dt_ < 4; ++dt_) { \
            const v4i16 lo_ = __builtin_amdgcn_ds_read_tr16_b64_v4i16((LAS v4i16*)(ta_ + dt_ * 32)); \
            const v4i16 hi_ = __builtin_amdgcn_ds_read_tr16_b64_v4i16((LAS v4i16*)(ta_ + 16 * VROW + dt_ * 32)); \
            bf16x8 vf_; vf_[0] = lo_[0]; vf_[1] = lo_[1]; vf_[2] = lo_[2]; vf_[3] = lo_[3]; vf_[4] = hi_[0]; vf_[5] = hi_[1]; vf_[6] = hi_[2]; vf_[7] = hi_[3]; \
            o[dt_] = __builtin_amdgcn_mfma_f32_16x16x32_bf16(vf_, pf_, o[dt_], 0, 0, 0); } } while (0)
    ATT_PV(rA, 0, vreg); ATT_PV(rB, 1, vreg + 4608); ATT_PV(rA, 2, vreg); ATT_PV(rB, 3, vreg + 4608);
    ATT_PV(rA, 4, vreg); ATT_PV(rB, 5, vreg + 4608); ATT_PV(rA, 6, vreg); ATT_PV(rB, 7, vreg + 4608);
#undef ATT_ROWS
#undef ATT_STAGE
#undef ATT_QK
#undef ATT_PV
    ssum += __shfl_xor(ssum, 16); ssum += __shfl_xor(ssum, 32);
    const float inv = 1.0f / ssum;
    if (hd < 8) {
        bf16_t* op = MIX + (size_t)tok * 1024 + hd * 64 + 4 * g;
#pragma unroll
        for (int dt = 0; dt < 4; ++dt) { u32x2 w; w.x = cvt_pk_bf16(o[dt][0] * inv, o[dt][1] * inv); w.y = cvt_pk_bf16(o[dt][2] * inv, o[dt][3] * inv); *(u32x2*)(op + 16 * dt) = w; }
    }
    __syncthreads();
}

__device__ __forceinline__ void conv_tile(const Params& P, LAS unsigned char* lds, int tile, int tid, int wave, int lane) {
    unsigned char* ws = P.ws;
    const bf16_t* HG = (const bf16_t*)(ws + WS_HGLU); bf16_t* MIX = (bf16_t*)(ws + WS_MIX);
    LAS f32x2* part = (LAS f32x2*)(lds + LDS_MISC + 1024);
    LAS f32x2* stat = part + 256;
    LAS bf16_t* Lin = (LAS bf16_t*)lds;
    LAS bf16_t* Lout = (LAS bf16_t*)(lds + 65536);
    const int tok0 = tile * 32, t0 = tok0 & (SEQ - 1), c = tid;
    for (int ch = tid; ch < 62 * 64; ch += NTHR) { const int r = ch >> 6, cc = ch & 63; const int tt = t0 - 30 + r;
        u32x4 v = {0u, 0u, 0u, 0u}; if (tt >= 0) v = *(const u32x4*)(HG + (size_t)(tok0 - 30 + r) * 512 + cc * 8);
        *(LAS u32x4*)(Lin + r * 512 + cc * 8) = v; }
    __syncthreads();
    float in[62];
#pragma unroll
    for (int r = 0; r < 62; ++r) in[r] = __builtin_bit_cast(float, (unsigned)Lin[r * 512 + c] << 16);
    float out[32];
    const float bias = P.dw_b[c];
#pragma unroll
    for (int i = 0; i < 32; ++i) out[i] = bias;
#pragma unroll
    for (int j = 0; j < 31; ++j) { const float wj = P.dw_w[j * 512 + c];
#pragma unroll
        for (int i = 0; i < 32; ++i) out[i] = fmaf(in[i + j], wj, out[i]); }
#pragma unroll
    for (int i = 0; i < 32; ++i) { const float s1 = wave_sum(out[i]), s2 = wave_sum(out[i] * out[i]); if (lane == 0) part[i * 8 + wave] = (f32x2){s1, s2}; }
    __syncthreads();
    if (tid < 32) { float s1 = 0.f, s2 = 0.f;
#pragma unroll
        for (int w = 0; w < 8; ++w) { const f32x2 pp = part[tid * 8 + w]; s1 += pp.x; s2 += pp.y; }
        const float mean = s1 * (1.0f / 512.0f), var = fmaxf(s2 * (1.0f / 512.0f) - mean * mean, 0.f);
        stat[tid] = (f32x2){mean, 1.0f / sqrtf(var + EPS)}; }
    __syncthreads();
    const float lgc = P.ln_g[c], lbc = P.ln_b[c];
#pragma unroll
    for (int i = 0; i < 32; ++i) { const f32x2 st = stat[i]; const float y = (out[i] - st.x) * st.y * lgc + lbc; const float sl = y * sigmoidf_(y);
        Lout[i * 512 + c] = (bf16_t)f2bf(sl); }
    __syncthreads();
    for (int ch = tid; ch < 32 * 64; ch += NTHR) { const int r = ch >> 6, cc = ch & 63;
        *(u32x4*)(MIX + (size_t)(tok0 + r) * 1024 + 512 + cc * 8) = *(const LAS u32x4*)(Lout + r * 512 + cc * 8); }
    __syncthreads();
}

constexpr int MW_UP = 32 * 16 * 64, MW_DN = 32 * 16 * 32, MW_ITEMS = MW_UP + MW_DN;
__device__ __forceinline__ void mw_decode(const Params& P, int it, const float*& src, int& ldw, unsigned char*& dst, const float*& gain) {
    unsigned char* ws = P.ws;
    if (it < MW_UP) { const int e = it >> 10, rr = it & 1023, kb = rr >> 6, nb = rr & 63, pn = nb >> 3, j = (nb & 7) * 32, bj = j >> 7, jj = j & 127;
        src = P.w_up + (size_t)e * 1024 * 2048 + (size_t)(kb * 64) * 2048 + 1024 * bj + 128 * pn + jj; ldw = 2048;
        dst = ws + WS_WUP + (size_t)e * 2048 * 1024 + (size_t)(nb * 32) * 1024 + kb * 64; gain = P.g_ffn + kb * 64; }
    else { const int r = it - MW_UP, e = r >> 9, rr = r & 511, kb = rr >> 5, nb = rr & 31;
        src = P.w_down + (size_t)e * 1024 * 1024 + (size_t)(kb * 64) * 1024 + nb * 32; ldw = 1024;
        dst = ws + WS_WDOWN + (size_t)e * 1024 * 1024 + (size_t)(nb * 32) * 1024 + kb * 64; gain = nullptr; }
}
#define MW_LOAD(LD, it_) do { if ((it_) < MW_ITEMS) { const float* src_; int ldw_; unsigned char* dst_; const float* gain_; mw_decode(P, (it_), src_, ldw_, dst_, gain_); \
        _Pragma("unroll") for (int i_ = 0; i_ < 8; ++i_) LD[i_] = NT_LD((const f32x4*)(src_ + (size_t)(8 * i_ + (lane >> 3)) * ldw_ + (lane & 7) * 4)); } } while (0)
#define MW_FINISH(LD, it_) do { if ((it_) < MW_ITEMS) { const float* src_; int ldw_; unsigned char* dst_; const float* gain_; mw_decode(P, (it_), src_, ldw_, dst_, gain_); \
        _Pragma("unroll") for (int i_ = 0; i_ < 8; ++i_) { const int kk_ = 8 * i_ + (lane >> 3), j_ = (lane & 7) * 4; const float gk_ = (gain_ ? gain_[kk_] : 1.0f) * 32.0f; \
            LAS float* d_ = scr + kk_ * 33 + j_; d_[0] = LD[i_].x * gk_; d_[1] = LD[i_].y * gk_; d_[2] = LD[i_].z * gk_; d_[3] = LD[i_].w * gk_; } \
        LDS_WAIT(); asm volatile("" ::: "memory"); \
        const int c_ = lane & 7; \
        _Pragma("unroll") for (int j_ = 0; j_ < 4; ++j_) { const int n_ = (lane >> 3) + 8 * j_; const LAS float* sp_ = scr + (8 * c_) * 33 + n_; \
            u32x2 o_; o_.x = pk4_fp8(sp_[0 * 33], sp_[1 * 33], sp_[2 * 33], sp_[3 * 33]); o_.y = pk4_fp8(sp_[4 * 33], sp_[5 * 33], sp_[6 * 33], sp_[7 * 33]); \
            *(u32x2*)(dst_ + (size_t)n_ * 1024 + 8 * c_) = o_; } \
        LDS_WAIT(); asm volatile("" ::: "memory"); } } while (0)
__device__ __forceinline__ void moe_weight_convert(const Params& P, LAS float* scr, int cw, int ncw, int lane) {
    f32x4 l0[8], l1[8], l2[8], l3[8];
    MW_LOAD(l0, cw); MW_LOAD(l1, cw + ncw); MW_LOAD(l2, cw + 2 * ncw);
    for (int base = cw; base < MW_ITEMS; base += 4 * ncw) {
        MW_LOAD(l3, base + 3 * ncw); MW_FINISH(l0, base);
        MW_LOAD(l0, base + 4 * ncw); MW_FINISH(l1, base + ncw);
        MW_LOAD(l1, base + 5 * ncw); MW_FINISH(l2, base + 2 * ncw);
        MW_LOAD(l2, base + 6 * ncw); MW_FINISH(l3, base + 3 * ncw);
    }
}
#undef MW_LOAD
#undef MW_FINISH

__device__ __forceinline__ void router_phase(const Params& P, LAS unsigned char* lds, int blk, int G, int tid, int wave, int lane) {
    unsigned char* ws = P.ws;
    const float* h1 = (const float*)(ws + WS_H1); const float* wrg = (const float*)(ws + WS_WRG);
    int* list = (int*)(ws + WS_LIST); float* lscale = (float*)(ws + WS_LSCALE); float* lgate = (float*)(ws + WS_LGATE);
    unsigned* cntg = (unsigned*)(ws + WS_CTL) + CW_CNT;
    LAS float* WL = (LAS float*)lds;
    LAS int* lcnt = (LAS int*)(lds + LDS_MISC + 1024);
    LAS int* gbase = lcnt + 32;
    LAS int* rec_e = gbase + 32;
    LAS int* rec_p = rec_e + 512;
    LAS float* rec_g = (LAS float*)(rec_p + 512);
    LAS float* rec_s = rec_g + 512;
    for (int i = tid; i < 8192; i += NTHR) ((LAS f32x4*)WL)[i] = ((const f32x4*)wrg)[i];
    __syncthreads();
    const int tl = lane & 31, half = lane >> 5;
    for (int chunk = blk; chunk < NTOK / 128; chunk += G) {
        if (tid < 32) lcnt[tid] = 0;
        __syncthreads();
        if (wave < 4) {
            const int tloc = wave * 32 + tl, tok = chunk * 128 + tloc;
            const float* hrow = h1 + (size_t)tok * DM + 4 * half;
            f32x16 acc;
#pragma unroll
            for (int i = 0; i < 16; ++i) acc[i] = 0.f;
            float ss = 0.f;
#pragma unroll 1
            for (int k0 = 0; k0 < DM; k0 += 32) {
                f32x4 hv[4];
#pragma unroll
                for (int i = 0; i < 4; ++i) hv[i] = *(const f32x4*)(hrow + k0 + 8 * i);
#pragma unroll
                for (int i = 0; i < 4; ++i) {
                    ss = fmaf(hv[i].x, hv[i].x, fmaf(hv[i].y, hv[i].y, fmaf(hv[i].z, hv[i].z, fmaf(hv[i].w, hv[i].w, ss))));
#pragma unroll
                    for (int j = 0; j < 4; ++j) { const float wv = WL[(k0 + 8 * i + 4 * half + j) * 32 + tl];
                        acc = __builtin_amdgcn_mfma_f32_32x32x2f32(wv, hv[i][j], acc, 0, 0, 0); }
                }
            }
            ss += __shfl_xor(ss, 32);
            const float rs = 1.0f / sqrtf(ss * (1.0f / DM) + EPS);
            float v[16];
#pragma unroll
            for (int r = 0; r < 16; ++r) v[r] = acc[r] * rs + P.b_router[(r & 3) + 8 * (r >> 2) + 4 * half];
            float tv[4]; int te[4];
#pragma unroll
            for (int q = 0; q < 4; ++q) { float bv = -INFINITY; int be = 64;
#pragma unroll
                for (int r = 0; r < 16; ++r) { const int e = (r & 3) + 8 * (r >> 2) + 4 * half; if (v[r] > bv || (v[r] == bv && e < be)) { bv = v[r]; be = e; } }
#pragma unroll
                for (int r = 0; r < 16; ++r) { const int e = (r & 3) + 8 * (r >> 2) + 4 * half; if (e == be) v[r] = -INFINITY; }
                tv[q] = bv; te[q] = be; }
            float cv[8]; int ce[8];
#pragma unroll
            for (int q = 0; q < 4; ++q) { cv[q] = tv[q]; ce[q] = te[q]; cv[4 + q] = __shfl_xor(tv[q], 32); ce[4 + q] = __shfl_xor(te[q], 32); }
#pragma unroll
            for (int q = 0; q < 4; ++q) { float bv = -INFINITY; int be = 64;
#pragma unroll
                for (int r = 0; r < 8; ++r) if (cv[r] > bv || (cv[r] == bv && ce[r] < be)) { bv = cv[r]; be = ce[r]; }
#pragma unroll
                for (int r = 0; r < 8; ++r) if (ce[r] == be) cv[r] = -INFINITY;
                tv[q] = bv; te[q] = be; }
            const float e1 = __expf(tv[1] - tv[0]), e2 = __expf(tv[2] - tv[0]), e3 = __expf(tv[3] - tv[0]);
            const float is = 1.0f / (1.0f + e1 + e2 + e3);
            if (half == 0) {
                const float gq[4] = {is, e1 * is, e2 * is, e3 * is};
#pragma unroll
                for (int q = 0; q < 4; ++q) { const int lp = atomicAdd((int*)&lcnt[te[q]], 1); const int si = tloc * 4 + q; rec_e[si] = te[q]; rec_p[si] = lp; rec_g[si] = gq[q]; }
                rec_s[tloc] = rs;
            }
        }
        __syncthreads();
        if (tid < 32) gbase[tid] = (int)atomicAdd(cntg + 64 * tid, (unsigned)lcnt[tid]);
        __syncthreads();
        { const int si = tid, ee = rec_e[si], pos = gbase[ee] + rec_p[si], li = ee * NTOK + pos;
          list[li] = (chunk * 128) * 4 + si; lscale[li] = rec_s[si >> 2]; lgate[li] = rec_g[si]; }
        __syncthreads();
    }
}

__device__ __forceinline__ void combine_phase(const Params& P, int gw, int NGW, int lane) {
    unsigned char* ws = P.ws;
    float* h1 = (float*)(ws + WS_H1); bf16_t* h1b = (bf16_t*)(ws + WS_H1B); const unsigned char* y = ws + WS_Y; float* rs3 = (float*)(ws + WS_RS3);
    for (int m = gw; m < NTOK; m += NGW) {
        const f32x4* hr = (const f32x4*)(h1 + (size_t)m * DM) + lane; f32x4 v[4]; float s = 0.f;
#pragma unroll
        for (int j = 0; j < 4; ++j) v[j] = NT_LD(hr + 64 * j);
#pragma unroll
        for (int k = 0; k < 4; ++k) { const unsigned* yr = (const unsigned*)(y + (size_t)(m * 4 + k) * DM) + lane;
#pragma unroll
            for (int j = 0; j < 4; ++j) { const unsigned w = NT_LD(yr + 64 * j); const f32x2 lo = __builtin_amdgcn_cvt_pk_f32_fp8((int)w, false), hi = __builtin_amdgcn_cvt_pk_f32_fp8((int)w, true);
                v[j].x += lo.x * 0.0625f; v[j].y += lo.y * 0.0625f; v[j].z += hi.x * 0.0625f; v[j].w += hi.y * 0.0625f; } }
        u32x2* o8 = (u32x2*)(h1b + (size_t)m * DM) + lane; unsigned* o4 = (unsigned*)(ws + WS_H1F8 + (size_t)m * DM) + lane;
#pragma unroll
        for (int j = 0; j < 4; ++j) { u32x2 w; w.x = pk2(v[j].x, v[j].y); w.y = pk2(v[j].z, v[j].w); NT_ST(w, o8 + 64 * j); NT_ST(pk4_fp8(v[j].x, v[j].y, v[j].z, v[j].w), o4 + 64 * j);
            s += (v[j].x * v[j].x + v[j].y * v[j].y) + (v[j].z * v[j].z + v[j].w * v[j].w); }
        s = wave_sum(s);
        if (lane == 0) rs3[m] = 1.0f / sqrtf(s * (1.0f / DM) + EPS);
    }
}

__device__ __forceinline__ void final_phase(const Params& P, int gw, int NGW, int lane) {
    unsigned char* ws = P.ws;
    const bf16_t* h2b = (const bf16_t*)(ws + WS_H1B); const bf16_t* pj = (const bf16_t*)(ws + WS_PJ); const unsigned char* G = ws + WS_G; const float* rs3 = (const float*)(ws + WS_RS3);
    f32x4 gv[4];
#pragma unroll
    for (int j = 0; j < 4; ++j) gv[j] = *((const f32x4*)P.g_final + lane + 64 * j);
    for (int m = gw; m < NTOK; m += NGW) {
        const u32x2* hr = (const u32x2*)(h2b + (size_t)m * DM) + lane; const u32x2* pr = (const u32x2*)(pj + (size_t)m * DM) + lane; const unsigned* gr = (const unsigned*)(G + (size_t)m * DM) + lane;
        const float r3 = rs3[m]; f32x4 v[4]; float s = 0.f;
#pragma unroll
        for (int j = 0; j < 4; ++j) { const u32x2 hw = NT_LD(hr + 64 * j), pw = NT_LD(pr + 64 * j); const unsigned gw2 = NT_LD(gr + 64 * j);
            const f32x2 glo = __builtin_amdgcn_cvt_pk_f32_fp8((int)gw2, false), ghi = __builtin_amdgcn_cvt_pk_f32_fp8((int)gw2, true);
            v[j].x = bf_lo(hw.x) + bf_lo(pw.x) * sigmoidf_(glo.x * r3); v[j].y = bf_hi(hw.x) + bf_hi(pw.x) * sigmoidf_(glo.y * r3);
            v[j].z = bf_lo(hw.y) + bf_lo(pw.y) * sigmoidf_(ghi.x * r3); v[j].w = bf_hi(hw.y) + bf_hi(pw.y) * sigmoidf_(ghi.y * r3);
            s += (v[j].x * v[j].x + v[j].y * v[j].y) + (v[j].z * v[j].z + v[j].w * v[j].w); }
        s = wave_sum(s); const float rs = 1.0f / sqrtf(s * (1.0f / DM) + EPS);
        f32x4* orow = (f32x4*)(P.out + (size_t)m * DM) + lane;
#pragma unroll
        for (int j = 0; j < 4; ++j) NT_ST(v[j] * rs * gv[j], orow + 64 * j);
    }
}

#define XB_TMO      128
#define XB_XCNT(j)  (256  + 64 * (j))
#define XB_XSUB(j)  (1280 + 64 * (j))
#define XB_XGEN(j)  (2304 + 64 * (j))
#define XB_TOP      3328
#define XB_TOPGEN   3392
#define XCD_BAR_WORDS 3456
#define XB_SPIN_CAP (1u << 18)
__device__ __forceinline__ unsigned xb_ld(unsigned* p)              { return __hip_atomic_load(p, __ATOMIC_RELAXED, __HIP_MEMORY_SCOPE_AGENT); }
__device__ __forceinline__ unsigned xb_add(unsigned* p, unsigned v) { return __hip_atomic_fetch_add(p, v, __ATOMIC_RELAXED, __HIP_MEMORY_SCOPE_AGENT); }
__device__ __forceinline__ unsigned xb_xcc_id() { return (unsigned)__builtin_amdgcn_s_getreg((3 << 11) | 20) & 0xFu; }
#define XB_SPIN(cond, bar) do { unsigned _sp = 0; while (cond) { __builtin_amdgcn_s_sleep(1); \
    if ((++_sp & 255u) == 0u) { if (xb_ld(&(bar)[XB_TMO])) break; if (_sp > XB_SPIN_CAP) { atomicAdd(&(bar)[XB_TMO], 1u); break; } } } } while (0)
struct XcdBarrier { unsigned* bar; unsigned x; volatile LAS unsigned* st; };
__device__ __forceinline__ XcdBarrier xcd_barrier_post(unsigned* bar, volatile LAS unsigned* st) {
    XcdBarrier b; b.bar = bar; b.x = xb_xcc_id(); b.st = st;
    if (threadIdx.x == 0) (void)xb_add(&bar[XB_XCNT(b.x)], 1u);
    return b;
}
__device__ __forceinline__ void xcd_barrier_complete(unsigned* bar, unsigned x, unsigned& nloc, unsigned& nx) {
    const unsigned G = gridDim.x * gridDim.y * gridDim.z;
    unsigned sum, cnt, mine, sp = 0u;
    for (;;) {
        sum = 0u; cnt = 0u; mine = 0u;
#pragma unroll
        for (unsigned j = 0; j < 16; ++j) { const unsigned c = xb_ld(&bar[XB_XCNT(j)]); sum += c; cnt += (c > 0u) ? 1u : 0u; mine = (j == x) ? c : mine; }
        if (sum == G) break;
        __builtin_amdgcn_s_sleep(1);
        if ((++sp & 255u) == 0u) { if (xb_ld(&bar[XB_TMO])) break; if (sp > XB_SPIN_CAP) { atomicAdd(&bar[XB_TMO], 1u); break; } }
    }
    nloc = mine > 0u ? mine : 1u; nx = cnt > 0u ? cnt : 1u;
}
__device__ __forceinline__ void xcd_barrier(const XcdBarrier& b) {
    asm volatile("s_waitcnt vmcnt(0)" ::: "memory");
    __syncthreads();
    if (threadIdx.x == 0) {
        unsigned* bar = b.bar;
        __builtin_amdgcn_s_waitcnt(0);
        unsigned nloc = b.st[0], nx = b.st[1];
        if (nloc == 0u) { xcd_barrier_complete(bar, b.x, nloc, nx); b.st[0] = nloc; b.st[1] = nx; }
        const unsigned old = xb_add(&bar[XB_XSUB(b.x)], 1u);
        const unsigned gen = old / nloc;
        if (old + 1u == (gen + 1u) * nloc) {
            __builtin_amdgcn_fence(__ATOMIC_RELEASE, "agent");
            asm volatile("s_waitcnt vmcnt(0)" ::: "memory");
            const unsigned og = xb_add(&bar[XB_TOP], 1u);
            const unsigned tg = og / nx;
            if (og + 1u == (tg + 1u) * nx) xb_add(&bar[XB_TOPGEN], 1u);
            else XB_SPIN(xb_ld(&bar[XB_TOPGEN]) == tg, bar);
            __builtin_amdgcn_fence(__ATOMIC_ACQUIRE, "agent");
            xb_add(&bar[XB_XGEN(b.x)], 1u);
            asm volatile("s_waitcnt vmcnt(0)" ::: "memory");
        } else {
            XB_SPIN(xb_ld(&bar[XB_XGEN(b.x)]) == gen, bar);
            __builtin_amdgcn_fence(__ATOMIC_ACQUIRE, "agent");
            asm volatile("s_waitcnt vmcnt(0)" ::: "memory");
        }
    }
    __syncthreads();
}

constexpr int NPHASE = 10;
__global__ void __launch_bounds__(NTHR, 2) fwd_kernel(Params P) {
    extern __shared__ __attribute__((aligned(16))) unsigned char lds_raw[];
    LAS unsigned char* lds = (LAS unsigned char*)lds_raw;
    cg::grid_group grid = cg::this_grid();
    const int tid = threadIdx.x, wave = __builtin_amdgcn_readfirstlane(tid >> 6);
    const int G = gridDim.x, bx = blockIdx.x;
#define FRESH_LANE(name) int name = (int)__builtin_amdgcn_mbcnt_hi(~0u, __builtin_amdgcn_mbcnt_lo(~0u, 0u)); asm volatile("" : "+v"(name))
    const int vcu = (G % 8 == 0) ? (bx % 8) * (G / 8) + bx / 8 : bx;
    const int NGW = G * NWAVES;
    unsigned char* ws = P.ws;
    const int lo = P.ph_lo, hi = P.ph_hi;
#define IN(k) (lo <= (k) && (k) < hi)
    volatile LAS unsigned* xst = (volatile LAS unsigned*)(lds + LDS_XB);
    if (tid < 2) xst[tid] = 0u;
    __syncthreads();
    const XcdBarrier xbar = xcd_barrier_post((unsigned*)(ws + WS_CTL) + CW_BAR, xst);
    if (P.ph_lo > P.ph_hi) grid.sync();
#define SYNC(k) do { if (IN(k) && IN((k) + 1)) xcd_barrier(xbar); } while (0)

    if (IN(0)) { FRESH_LANE(lane); p0_prologue(P, lds, vcu, G, wave, lane); }
    SYNC(0);
    if (IN(1)) {
        { pg8::DenseSched S; S.init((const bf16_t*)(ws + WS_XB), (const bf16_t*)(ws + WS_WIN), NTOK, 2048, 1024, G, bx);
          EpiInProj E{(const float*)(ws + WS_RS1), (const f32x2*)(ws + WS_ROPE), P.glu_b, (bf16_t*)(ws + WS_Q), (bf16_t*)(ws + WS_K), (bf16_t*)(ws + WS_V), (bf16_t*)(ws + WS_QI), (bf16_t*)(ws + WS_KI), (bf16_t*)(ws + WS_HGLU), (float*)(ws + WS_WI)};
          pg8::gemm_phase<EpiInProj, pg8::DenseSched, false>(lds, S, E); }
        { pg8::DenseSched S; S.init((const bf16_t*)(ws + WS_PB), (const bf16_t*)(ws + WS_WP), NTOK, 1024, 256, G, bx);
          EpiBf16Plain E{(bf16_t*)(ws + WS_PJ), 1024, 1.0f};
          pg8::gemm_phase<EpiBf16Plain, pg8::DenseSched, false>(lds, S, E); }
    }
    SYNC(1);
    if (IN(2)) {
        FRESH_LANE(lane);
        for (int i = tid; i < 4096; i += NTHR) ((LAS unsigned*)(lds + LDS_MISC))[i] = 0u;
        __syncthreads();
        unsigned* ctl = (unsigned*)(ws + WS_CTL);
        volatile LAS int* qw = (volatile LAS int*)(lds + LDS_XB + 32);
        if (G % 8 == 0 && G >= 128) { const int ncv = 8; if ((bx >> 3) < ncv) moe_weight_convert(P, (LAS float*)(lds + wave * 16384), (bx * NWAVES) + wave, ncv * 8 * NWAVES, lane); }
        else { moe_weight_convert(P, (LAS float*)(lds + wave * 16384), bx * NWAVES + wave, G * NWAVES, lane); }
        __syncthreads();
        for (int db = 0; db < NB; ++db) { const int b = (bx + db) & 7;
            for (;;) {
                if (tid == 0) qw[0] = (int)atomicAdd(ctl + CW_AQ + 64 * b, 1u);
                __syncthreads();
                const int k = qw[0];
                if (k >= 512) break;
                attn_tile(P, lds, b, (511 - k) * 8, wave, lane);
            }
            __syncthreads(); }
        for (;;) {
            if (tid == 0) qw[0] = (int)atomicAdd(ctl + CW_CQ, 1u);
            __syncthreads();
            const int tl = qw[0];
            if (tl >= NTOK / 32) break;
            conv_tile(P, lds, tl, tid, wave, lane);
        }
    }
    SYNC(2);
    if (IN(3)) {
        pg8::DenseSched S; S.init((const bf16_t*)(ws + WS_MIX), (const bf16_t*)(ws + WS_WOUT), NTOK, 1024, 1024, G, bx);
        EpiOutProj E{P.x, (float*)(ws + WS_H1), (unsigned char*)(ws + WS_H1F8)};
        pg8::gemm_phase<EpiOutProj, pg8::DenseSched, false, false, true>(lds, S, E);
    }
    SYNC(3);
    if (IN(4)) { FRESH_LANE(lane); router_phase(P, lds, vcu, G, tid, wave, lane); }
    SYNC(4);
    if (IN(5) || IN(6)) {
        LAS int* tb = (LAS int*)(lds + LDS_MISC); LAS int* cn = tb + 64;
        if (tid < NE) cn[tid] = (int)__hip_atomic_load((const unsigned*)(ws + WS_CTL) + CW_CNT + 64 * tid, __ATOMIC_RELAXED, __HIP_MEMORY_SCOPE_AGENT);
        __syncthreads();
        if (tid == 0) { int acc = 0;
            for (int e = 0; e < NE; ++e) { tb[e] = acc; acc += (cn[e] + BM - 1) / BM; }
            tb[NE] = acc; }
        __syncthreads();
        if (IN(5)) {
            pg8::MoeSched S; S.A = ws + WS_H1F8; S.Bt = ws + WS_WUP; S.rp = 1024; S.b_estride = (size_t)2048 * 1024; S.tb = tb; S.cnt = cn; S.list = (const int*)(ws + WS_LIST);
            S.nN = 8; S.nwg = tb[NE] * 8; S.G = G; S.c = bx; S.gather = true;
            { LAS int* ut = (LAS int*)(lds + LDS_MISC + 512); S.utab = ut; S.build_table(ut, tid); __syncthreads(); }
            S.m_scale = (const float*)(ws + WS_LSCALE); S.m_gate = nullptr; S.m_bias = P.b_up;
            EpiUp E{(unsigned char*)(ws + WS_ACT)};
            pg8::gemm_phase<EpiUp, pg8::MoeSched, true, true, true>(lds, S, E);
        }
        SYNC(5);
        if (IN(6)) {
            pg8::MoeSched S; S.A = ws + WS_ACT; S.Bt = ws + WS_WDOWN; S.rp = 1024; S.b_estride = (size_t)1024 * 1024; S.tb = tb; S.cnt = cn; S.list = (const int*)(ws + WS_LIST);
            S.nN = 4; S.nwg = tb[NE] * 4; S.G = G; S.c = bx; S.gather = false;
            { LAS int* ut = (LAS int*)(lds + LDS_MISC + 512); S.utab = ut; S.build_table(ut, tid); __syncthreads(); }
            S.m_scale = nullptr; S.m_gate = (const float*)(ws + WS_LGATE); S.m_bias = P.b_down;
            EpiDown E{(unsigned char*)(ws + WS_Y)};
            pg8::gemm_phase<EpiDown, pg8::MoeSched, true, true, true>(lds, S, E);
        }
    }
    SYNC(6);
    if (IN(7)) { FRESH_LANE(l7); const int g7 = vcu * NWAVES + wave;
        combine_phase(P, g7, NGW, l7); }
    SYNC(7);
    if (IN(8)) {
        pg8::DenseSched S; S.init(ws + WS_H1F8, ws + WS_WG, NTOK, 1024, 1024, G, bx); S.rp = 1024; S.idg = true;
        EpiF8Plain E{(unsigned char*)(ws + WS_G), 1024, 0.03125f};
        pg8::gemm_phase<EpiF8Plain, pg8::DenseSched, true, true>(lds, S, E);
    }
    SYNC(8);
    if (IN(9)) { FRESH_LANE(l9); const int g9 = vcu * NWAVES + wave;
        final_phase(P, g9, NGW, l9); }
#undef IN
#undef SYNC
}

#ifndef N_LAUNCH_MODE
#define N_LAUNCH_MODE 1
#endif
extern "C" void kernel_launch(void* const* d_in, const int* in_sizes, int n_in, void* d_out, int out_size, void* d_ws, size_t ws_size, hipStream_t stream) {
    static int grid = 0;
    if (grid == 0) {
        if (n_in != 21 || out_size != NTOK * DM || ws_size < WS_END) { fprintf(stderr, "kernel_launch: unexpected shapes (n_in %d out %d ws %zu)\n", n_in, out_size, ws_size); grid = -1; return; }
        int dev = 0, cus = 0, per_cu = 0;
        (void)hipGetDevice(&dev); (void)hipDeviceGetAttribute(&cus, hipDeviceAttributeMultiprocessorCount, dev);
        (void)hipFuncSetAttribute((const void*)fwd_kernel, hipFuncAttributeMaxDynamicSharedMemorySize, LDS_BYTES);
        if (hipOccupancyMaxActiveBlocksPerMultiprocessor(&per_cu, (const void*)fwd_kernel, NTHR, LDS_BYTES) != hipSuccess || per_cu < 1) { fprintf(stderr, "kernel_launch: occupancy query failed (%d)\n", per_cu); (void)hipGetLastError(); grid = -1; return; }
        grid = cus;
    }
    if (grid < 0) return;
    (void)hipMemsetAsync((char*)d_ws + WS_CTL, 0, CTL_BYTES, stream);
    Params p{};
    p.x = (const float*)d_in[0]; p.p = (const float*)d_in[1]; p.w_in = (const float*)d_in[2]; p.w_out = (const float*)d_in[3]; p.g_mix = (const float*)d_in[4]; p.g_ffn = (const float*)d_in[5];
    p.glu_b = (const float*)d_in[6]; p.dw_w = (const float*)d_in[7]; p.dw_b = (const float*)d_in[8]; p.ln_g = (const float*)d_in[9]; p.ln_b = (const float*)d_in[10];
    p.w_router = (const float*)d_in[11]; p.b_router = (const float*)d_in[12]; p.w_up = (const float*)d_in[13]; p.b_up = (const float*)d_in[14]; p.w_down = (const float*)d_in[15]; p.b_down = (const float*)d_in[16];
    p.w_ple_proj = (const float*)d_in[17]; p.w_ple_gate = (const float*)d_in[18]; p.g_ple = (const float*)d_in[19]; p.g_final = (const float*)d_in[20];
    p.out = (float*)d_out; p.ws = (unsigned char*)d_ws;
#if N_LAUNCH_MODE == 1
    p.ph_lo = 0; p.ph_hi = NPHASE;
    void* args[] = {&p};
    hipError_t e = hipLaunchCooperativeKernel((const void*)fwd_kernel, dim3(grid), dim3(NTHR), args, LDS_BYTES, stream);
    if (e != hipSuccess) fprintf(stderr, "cooperative launch failed: %s (grid %d)\n", hipGetErrorString(e), grid);
#else
    for (int ph = 0; ph < NPHASE; ++ph) {
        p.ph_lo = ph; p.ph_hi = ph + 1;
        void* args[] = {&p};
        hipError_t e = hipLaunchCooperativeKernel((const void*)fwd_kernel, dim3(grid), dim3(NTHR), args, LDS_BYTES, stream);
        if (e != hipSuccess) { fprintf(stderr, "launch %d failed: %s (grid %d)\n", ph, hipGetErrorString(e), grid); break; }
    }
#endif
}
```

```cpp
#include <hip/hip_runtime.h>
#include <hip/hip_cooperative_groups.h>
#include <cstdio>
#include <cstdint>
namespace cg = cooperative_groups;

#define LAS __attribute__((address_space(3)))
#define GAS __attribute__((address_space(1)))
typedef unsigned short bf16_t;
typedef short bf16x8 __attribute__((ext_vector_type(8)));
typedef short s16x4 __attribute__((ext_vector_type(4)));
typedef float f32x4 __attribute__((ext_vector_type(4)));
typedef float f32x2 __attribute__((ext_vector_type(2)));
typedef float f32x16 __attribute__((ext_vector_type(16)));
typedef unsigned u32x4 __attribute__((ext_vector_type(4)));
typedef unsigned u32x2 __attribute__((ext_vector_type(2)));

constexpr int NB = 8, SEQ = 4096, DM = 1024, NTOK = NB * SEQ;
constexpr int NE = 32, TOPK = 4, NSLOT = NTOK * TOPK;
constexpr int INW = 1988;
constexpr int NSEL = 256;
constexpr float EPS = 1e-6f;
constexpr int NWAVES = 8, NTHR = 512;

constexpr size_t MiB = 1u << 20;
constexpr size_t WS_CTL = 0, CTL_BYTES = 64 * 1024;
constexpr size_t WS_ROPE = 1 * MiB;
constexpr size_t WS_WIN = 2 * MiB;
constexpr size_t WS_WOUT = 6 * MiB;
constexpr size_t WS_WG = 8 * MiB;
constexpr size_t WS_WP = 10 * MiB;
constexpr size_t WS_WRG = 10 * MiB + 512 * 1024;
constexpr size_t WS_RS1 = 11 * MiB;
constexpr size_t WS_RS3 = 11 * MiB + 512 * 1024;
constexpr size_t WS_WI = 12 * MiB;
constexpr size_t WS_LIST = 13 * MiB;
constexpr size_t WS_LSCALE = 17 * MiB;
constexpr size_t WS_LGATE = 21 * MiB;
constexpr size_t WS_PB = 25 * MiB;
constexpr size_t WS_WUP = 42 * MiB;
constexpr size_t WS_WDOWN = 170 * MiB;
constexpr size_t WS_H1 = 234 * MiB;
constexpr size_t WS_H1B = 362 * MiB;
constexpr size_t WS_PJ = 426 * MiB;
constexpr size_t WS_XB = 490 * MiB;
constexpr size_t WS_Q = 554 * MiB;
constexpr size_t WS_K = 586 * MiB;
constexpr size_t WS_V = 590 * MiB;
constexpr size_t WS_QI = 594 * MiB;
constexpr size_t WS_KI = 610 * MiB;
constexpr size_t WS_HGLU = 614 * MiB;
constexpr size_t WS_MIX = 646 * MiB;
constexpr size_t WS_H1F8 = 490 * MiB;
constexpr size_t WS_ACT = 522 * MiB;
constexpr size_t WS_Y = 762 * MiB;
constexpr size_t WS_G = 762 * MiB;
constexpr size_t WS_END = 1018 * MiB;
static_assert(WS_H1F8 + (size_t)NTOK * 1024 <= WS_ACT && WS_ACT + (size_t)139264 * 1024 <= WS_Y, "ws map");
constexpr int CW_CNT = 1024;
constexpr int CW_AQ = 4096;
constexpr int CW_CQ = 4096 + 64 * 8;
constexpr int CW_BAR = 8192;
constexpr int CW_XCC = 7168;
constexpr int CW_PAIR = 12288;

constexpr int LDS_STAGE = 131072;
constexpr int LDS_MISC = LDS_STAGE;
constexpr int LDS_META = LDS_MISC + 4096;
constexpr int LDS_XB = 147456;
constexpr int LDS_BYTES = 147456 + 256;

__device__ __forceinline__ unsigned f2bf(float f) { unsigned u = __builtin_bit_cast(unsigned, f); return (u + 0x7fffu + ((u >> 16) & 1u)) >> 16; }
__device__ __forceinline__ unsigned pk2(float lo, float hi) { return f2bf(lo) | (f2bf(hi) << 16); }
__device__ __forceinline__ float bf_lo(unsigned w) { return __builtin_bit_cast(float, w << 16); }
__device__ __forceinline__ float bf_hi(unsigned w) { return __builtin_bit_cast(float, w & 0xffff0000u); }
__device__ __forceinline__ float wave_sum(float v) {
    v += __builtin_bit_cast(float, __builtin_amdgcn_update_dpp(0, __builtin_bit_cast(int, v), 0xB1, 0xF, 0xF, true));
    v += __builtin_bit_cast(float, __builtin_amdgcn_update_dpp(0, __builtin_bit_cast(int, v), 0x4E, 0xF, 0xF, true));
    v += __builtin_bit_cast(float, __builtin_amdgcn_update_dpp(0, __builtin_bit_cast(int, v), 0x141, 0xF, 0xF, true));
    v += __builtin_bit_cast(float, __builtin_amdgcn_update_dpp(0, __builtin_bit_cast(int, v), 0x140, 0xF, 0xF, true));
    const int vi = __builtin_bit_cast(int, v);
    const float r0 = __builtin_bit_cast(float, __builtin_amdgcn_readlane(vi, 0)), r1 = __builtin_bit_cast(float, __builtin_amdgcn_readlane(vi, 16));
    const float r2 = __builtin_bit_cast(float, __builtin_amdgcn_readlane(vi, 32)), r3 = __builtin_bit_cast(float, __builtin_amdgcn_readlane(vi, 48));
    return (r0 + r1) + (r2 + r3);
}
__device__ __forceinline__ unsigned pk4_fp8(float a, float b, float c, float d) { int r = __builtin_amdgcn_cvt_pk_fp8_f32(a, b, 0, false); r = __builtin_amdgcn_cvt_pk_fp8_f32(c, d, r, true); return (unsigned)r; }
__device__ __forceinline__ float sigmoidf_(float x) { return __builtin_amdgcn_rcpf(1.0f + __builtin_amdgcn_exp2f(x * -1.4426950408889634f)); }
#define LDS_WAIT() asm volatile("s_waitcnt lgkmcnt(0)" ::: "memory")
#define NT_LD(p) __builtin_nontemporal_load(p)
#define NT_ST(v, p) __builtin_nontemporal_store(v, p)

struct Params {
    const float* x; const float* p; const float* w_in; const float* w_out; const float* g_mix; const float* g_ffn;
    const float* glu_b; const float* dw_w; const float* dw_b; const float* ln_g; const float* ln_b;
    const float* w_router; const float* b_router; const float* w_up; const float* b_up; const float* w_down; const float* b_down;
    const float* w_ple_proj; const float* w_ple_gate; const float* g_ple; const float* g_final;
    float* out; unsigned char* ws;
    int ph_lo, ph_hi;
};

namespace pg8 {
constexpr int BM = 256, BK = 64, HALF = 128, HTB = HALF * BK * 2, STAGE_BYTES = 8 * HTB, NXCD = 8, WGM = 8;
__host__ __device__ __forceinline__ int lds_byte(int r, int c) { const int st = (r >> 4) * 2 + (c >> 5), rr = r & 15, cc = c & 31, ob = rr * 64 + cc * 2; return st * 1024 + (ob ^ (((ob >> 9) & 1) << 5)); }
__host__ __device__ __forceinline__ void stage_rc(int b, int& R, int& C) { const int st = b / 1024, sb = b % 1024, swz = sb ^ (((sb >> 9) & 1) << 5); R = (st >> 1) * 16 + swz / 64; C = (st & 1) * 32 + (swz % 64) / 2; }
__host__ __device__ __forceinline__ int perm32(int rho) { const int n = rho >> 4, i = rho & 15; return 8 * (i >> 2) + 4 * n + (i & 3); }

struct Unit { int pm, pn, e, rows; };

__device__ __forceinline__ unsigned cvt_pk_bf16(float lo, float hi) { unsigned r; asm volatile("v_cvt_pk_bf16_f32 %0, %1, %2" : "=v"(r) : "v"(lo), "v"(hi)); return r; }

struct DenseSched {
    const void* A; const void* Bt; int rp;
    int nM, nN, nwg, G, c;
    __device__ void init(const void* A_, const void* Bt_, int M, int N, int K_, int G_, int c_) { A = A_; Bt = Bt_; rp = K_ * 2; nM = M / BM; nN = N / BM; nwg = nM * nN; G = G_; c = c_; }
    int pair_pm = -1, pair_pn0 = 0;
    __device__ bool next(int i, Unit& u) const {
        if (pair_pm >= 0) { if (i >= 2) return false; u.pm = pair_pm; u.pn = pair_pn0 + i; u.e = 0; u.rows = BM; return true; }
        const long L = (long)i * G + c; if (L >= nwg) return false;
        int wgid = (int)L; { const int q = nwg / NXCD, r = nwg % NXCD, xcd = wgid % NXCD, off = wgid / NXCD; wgid = (xcd < r ? xcd * (q + 1) : r * (q + 1) + (xcd - r) * q) + off; }
        const int nig = WGM * nN, gid = wgid / nig, fm = gid * WGM, gsz = (nM - fm) < WGM ? (nM - fm) : WGM;
        u.pm = fm + ((wgid % nig) % gsz); u.pn = (wgid % nig) / gsz; u.e = 0; u.rows = BM; return true;
    }
    bool idg = false;
    __device__ __forceinline__ const char* a_ptr(const Unit& u) const { return idg ? (const char*)A : (const char*)A + (size_t)u.pm * BM * rp; }
    __device__ __forceinline__ const char* b_ptr(const Unit& u) const { return (const char*)Bt + (size_t)u.pn * BM * rp; }
    __device__ __forceinline__ int a_row(const Unit& u, int r) const { return u.pm * BM + r; }
    __device__ __forceinline__ void meta(const Unit&, LAS unsigned char*, int, int) const {}
};

struct MoeSched {
    const void* A; const void* Bt; int rp; size_t b_estride;
    const LAS int* tb;
    const LAS int* cnt;
    const int* list;
    int nN, nwg, G, c; bool gather;
    const LAS int* utab;
    __device__ __forceinline__ bool next(int i, Unit& u) const {
        if (i >= 32) return false;
        const LAS int* p = utab + 4 * i; const int rows = p[3]; if (rows < 0) return false;
        u.pm = p[0]; u.pn = p[1]; u.e = p[2]; u.rows = rows; return true;
    }
    __device__ __forceinline__ void build_table(LAS int* tab, int tid) const {
        if (tid < 32) { Unit u; const bool ok = decode(tid, u); tab[4 * tid] = u.pm; tab[4 * tid + 1] = u.pn; tab[4 * tid + 2] = u.e; tab[4 * tid + 3] = ok ? u.rows : -1; }
    }
    __device__ __forceinline__ bool decode(int i, Unit& u) const {
        u.pm = 0; u.pn = 0; u.e = 0; u.rows = 0;
        const long L = (long)i * G + c; if (L >= nwg) return false;
        int wgid = (int)L; { const int q = nwg / NXCD, r = nwg % NXCD, xcd = wgid % NXCD, off = wgid / NXCD; wgid = (xcd < r ? xcd * (q + 1) : r * (q + 1) + (xcd - r) * q) + off; }
        int e = 0;
#pragma unroll 1
        for (; e < NE - 1; ++e) { if (wgid < tb[e + 1] * nN) break; }
        const int local = wgid - tb[e] * nN, nM = tb[e + 1] - tb[e];
        const int nig = WGM * nN, gid = local / nig, fm = gid * WGM, gsz = (nM - fm) < WGM ? (nM - fm) : WGM;
        const int rt = fm + ((local % nig) % gsz);
        u.pm = tb[e] + rt; u.pn = (local % nig) / gsz; u.e = e;
        const int left = cnt[e] - rt * BM; u.rows = left < BM ? left : BM; return true;
    }
    __device__ __forceinline__ const char* a_ptr(const Unit& u) const { return (const char*)A; }
    __device__ __forceinline__ const char* b_ptr(const Unit& u) const { return (const char*)Bt + (size_t)u.e * b_estride + (size_t)u.pn * BM * rp; }
    __device__ __forceinline__ int a_row(const Unit& u, int r) const {
        if (!gather) return u.pm * BM + r;
        const int rt = u.pm - tb[u.e];
        return r < u.rows ? (list[u.e * NTOK + rt * BM + r] >> 2) : 0;
    }
    const float* m_scale; const float* m_gate; const float* m_bias;
    __device__ __forceinline__ void meta(const Unit& u, LAS unsigned char* tbl, int wid, int lane) const {
        const int rt = u.pm - tb[u.e]; const size_t li = (size_t)u.e * NTOK + rt * BM + (wid & 3) * 64 + lane;
        if (gather) {
            if (wid < 4) __builtin_amdgcn_global_load_lds((const unsigned*)(m_scale + li), (LAS unsigned*)(tbl + (wid & 3) * 256), 4, 0, 0);
            else { const int j = (wid & 3) * 64 + lane; const float* src = m_bias + (size_t)u.e * 2048 + (j < 128 ? 128 * u.pn + j : 1024 + 128 * u.pn + (j - 128));
                __builtin_amdgcn_global_load_lds((const unsigned*)src, (LAS unsigned*)(tbl + 2048 + (wid & 3) * 256), 4, 0, 0); }
        } else {
            if (wid < 4) { __builtin_amdgcn_global_load_lds((const unsigned*)(list + li), (LAS unsigned*)(tbl + (wid & 3) * 256), 4, 0, 0);
                __builtin_amdgcn_global_load_lds((const unsigned*)(m_bias + (size_t)u.e * 1024 + u.pn * BM + (wid & 3) * 64 + lane), (LAS unsigned*)(tbl + 2048 + (wid & 3) * 256), 4, 0, 0); }
            else __builtin_amdgcn_global_load_lds((const unsigned*)(m_gate + li), (LAS unsigned*)(tbl + 1024 + (wid & 3) * 256), 4, 0, 0);
        }
    }
};

typedef int v8i32 __attribute__((ext_vector_type(8)));
template <class Epi, class Sched, bool GATHER, bool F8 = false, bool WARMTRIP = false>
__device__ __forceinline__ void gemm_phase(LAS unsigned char* lds, const Sched& S, const Epi& E) {
    const int tid = threadIdx.x, wid = __builtin_amdgcn_readfirstlane(tid >> 6), lane = tid & 63, wr = wid >> 2, wc = wid & 3, fr = lane & 15, fq = lane >> 4;
    const int RP = S.rp, nt = RP / (BK * 2);
    unsigned voffA[2], voffB[2]; int RA[2], CA[2];
#pragma unroll
    for (int i = 0; i < 2; ++i) { int R, C; stage_rc(tid * 16 + i * 8192, R, C); const int Rb = Epi::PERM ? ((R & ~31) + perm32(R & 31)) : R;
        voffA[i] = (unsigned)(R * RP + C * 2); voffB[i] = (unsigned)(Rb * RP + C * 2); RA[i] = R; CA[i] = C; }
    const size_t kstep = (size_t)(BK * 2);
    const size_t hstep = (size_t)HALF * RP;
    const unsigned ldsw = (unsigned)wid * 1024u;
    const int aoff = lds_byte(wr * 64 + fr, fq * 8), boff = lds_byte(wc * 32 + fr, fq * 8);
    unsigned gC[2][2], gN[2][2];
#define PG8_SA(b, h) (((b) * 2 + (h)) * HTB)
#define PG8_SB(b, h) ((4 + (b) * 2 + (h)) * HTB)
#define PG8_STAGE(bufoff, gbase, voff) do { _Pragma("unroll") for (int _i = 0; _i < 2; ++_i) \
        __builtin_amdgcn_global_load_lds((const unsigned*)((const char*)(gbase) + (voff)[_i]), (LAS unsigned*)(lds + (bufoff) + ldsw + _i * 8192), 16, 0, 0); } while (0)
#define PG8_STAGE_A(bufoff, kp, h) do { if constexpr (GATHER) { PG8_STAGE(bufoff, kp, gC[h]); } else { PG8_STAGE(bufoff, (kp) + (h) * hstep, voffA); } } while (0)
#define PG8_LD16(p) (*(const LAS bf16x8*)(p))
#define PG8_CAT(lo, hi) __builtin_bit_cast(v8i32, __builtin_shufflevector(lo, hi, 0, 1, 2, 3, 4, 5, 6, 7, 8, 9, 10, 11, 12, 13, 14, 15))
#define PG8_LDA(dst, b, h) do { _Pragma("unroll") for (int m = 0; m < 4; ++m) { if constexpr (F8) { dst##8[m] = PG8_CAT(PG8_LD16(lds + PG8_SA(b, h) + aoff + m * 2048), PG8_LD16(lds + PG8_SA(b, h) + aoff + m * 2048 + 1024)); } \
        else { _Pragma("unroll") for (int k = 0; k < 2; ++k) dst[m][k] = PG8_LD16(lds + PG8_SA(b, h) + aoff + m * 2048 + k * 1024); } } } while (0)
#define PG8_LDB(dst, b, h) do { _Pragma("unroll") for (int n = 0; n < 2; ++n) { if constexpr (F8) { dst##8[n] = PG8_CAT(PG8_LD16(lds + PG8_SB(b, h) + boff + n * 2048), PG8_LD16(lds + PG8_SB(b, h) + boff + n * 2048 + 1024)); } \
        else { _Pragma("unroll") for (int k = 0; k < 2; ++k) dst[n][k] = PG8_LD16(lds + PG8_SB(b, h) + boff + n * 2048 + k * 1024); } } } while (0)
#define PG8_MMA(ai, bj, At, Bt) do { __builtin_amdgcn_s_setprio(1); _Pragma("unroll") for (int m = 0; m < 4; ++m) _Pragma("unroll") for (int n = 0; n < 2; ++n) { \
        if constexpr (F8) { acc[ai][bj][m][n] = __builtin_amdgcn_mfma_scale_f32_16x16x128_f8f6f4(Bt##8[n], At##8[m], acc[ai][bj][m][n], 0, 0, 0, 0x7f7f7f7f, 0, 0x7f7f7f7f); } \
        else { _Pragma("unroll") for (int k = 0; k < 2; ++k) acc[ai][bj][m][n] = __builtin_amdgcn_mfma_f32_16x16x32_bf16(Bt[n][k], At[m][k], acc[ai][bj][m][n], 0, 0, 0); } } \
        __builtin_amdgcn_s_setprio(0); } while (0)
#define PG8_WAIT_V(n) asm volatile("s_waitcnt vmcnt(" #n ")" ::: "memory")
#define PG8_WAIT_L(n) asm volatile("s_waitcnt lgkmcnt(" #n ")" ::: "memory")
#define PG8_BAR __builtin_amdgcn_s_barrier()
#define PG8_SCHED __builtin_amdgcn_sched_barrier(0)
#define PG8_GOFF(dst, u) do { _Pragma("unroll") for (int _h = 0; _h < 2; ++_h) _Pragma("unroll") for (int _i = 0; _i < 2; ++_i) \
        dst[_h][_i] = (unsigned)(S.a_row(u, _h * HALF + RA[_i]) * RP + CA[_i] * 2); } while (0)
    Unit cur, nxt, nn; int ui = 0;
    if (!S.next(0, cur)) return;
    bool has_next = S.next(1, nxt);
    if constexpr (GATHER) { PG8_GOFF(gC, cur); if (has_next) { PG8_GOFF(gN, nxt); } else { PG8_GOFF(gN, cur); } }
    f32x4 acc[2][2][4][2];
#pragma unroll
    for (int a = 0; a < 2; ++a)
#pragma unroll
        for (int b = 0; b < 2; ++b)
#pragma unroll
            for (int m = 0; m < 4; ++m)
#pragma unroll
                for (int n = 0; n < 2; ++n) acc[a][b][m][n] = (f32x4){0.f, 0.f, 0.f, 0.f};
    bf16x8 At[4][2], B0[2][2], B1[2][2]; v8i32 At8[4], B08[2], B18[2];
    const char* cA = S.a_ptr(cur); const char* cB = S.b_ptr(cur);
    PG8_STAGE(PG8_SB(0, 0), cB, voffB); PG8_STAGE(PG8_SB(0, 1), cB + hstep, voffB); PG8_STAGE_A(PG8_SA(0, 0), cA, 0); PG8_STAGE_A(PG8_SA(0, 1), cA, 1);
    if (wr == 1) PG8_BAR;
    PG8_WAIT_V(2); PG8_BAR;
    PG8_STAGE(PG8_SB(1, 0), cB + kstep, voffB); PG8_STAGE_A(PG8_SA(1, 0), cA + kstep, 0); PG8_STAGE(PG8_SB(1, 1), cB + hstep + kstep, voffB);
    PG8_WAIT_V(6); PG8_BAR;
    for (;;) {
        const char* nA = has_next ? S.a_ptr(nxt) : cA; const char* nB = has_next ? S.b_ptr(nxt) : cB;
        S.meta(cur, lds + (LDS_META - 0) + (ui & 1) * 4096, wid, lane);
#define PG8_TRIP(WARM, t) do { \
            const bool last = ((t) == nt - 2); \
            const char* a1 = cA + (size_t)((t) + 1) * kstep; \
            const char* a2 = last ? nA : cA + (size_t)((t) + 2) * kstep; const char* b2 = last ? nB : cB + (size_t)((t) + 2) * kstep; \
            const char* a3 = a2 + kstep; const char* b3 = b2 + kstep; \
              \
            PG8_LDB(B0, 0, 0); PG8_LDB(B1, 0, 1); PG8_SCHED; PG8_LDA(At, 0, 0); if constexpr (!(WARM)) { PG8_STAGE_A(PG8_SA(1, 1), a1, 1); } \
            if constexpr (GATHER) { if (last) { _Pragma("unroll") for (int h = 0; h < 2; ++h) _Pragma("unroll") for (int i = 0; i < 2; ++i) gC[h][i] = gN[h][i]; } } \
            if constexpr (!(WARM)) { PG8_WAIT_V(8); } PG8_WAIT_L(0); PG8_BAR; PG8_MMA(0, 0, At, B0); PG8_MMA(0, 1, At, B1); PG8_BAR; PG8_SCHED; \
              \
            PG8_LDA(At, 0, 1); PG8_STAGE(PG8_SB(0, 0), b2, voffB); PG8_STAGE(PG8_SB(0, 1), b2 + hstep, voffB); PG8_STAGE_A(PG8_SA(0, 0), a2, 0); \
            if constexpr (!(WARM)) { PG8_WAIT_V(8); } PG8_WAIT_L(0); PG8_BAR; PG8_MMA(1, 0, At, B0); PG8_MMA(1, 1, At, B1); PG8_BAR; PG8_SCHED; \
              \
            PG8_LDB(B0, 1, 0); PG8_LDB(B1, 1, 1); PG8_SCHED; PG8_LDA(At, 1, 0); PG8_STAGE_A(PG8_SA(0, 1), a2, 1); \
            if constexpr (!(WARM)) { PG8_WAIT_V(8); } PG8_WAIT_L(0); PG8_BAR; PG8_MMA(0, 0, At, B0); PG8_MMA(0, 1, At, B1); PG8_BAR; PG8_SCHED; \
              \
            PG8_LDA(At, 1, 1); PG8_STAGE(PG8_SB(1, 0), b3, voffB); PG8_STAGE(PG8_SB(1, 1), b3 + hstep, voffB); PG8_STAGE_A(PG8_SA(1, 0), a3, 0); \
            PG8_WAIT_V(8); PG8_WAIT_L(0); PG8_BAR; PG8_MMA(1, 0, At, B0); PG8_MMA(1, 1, At, B1); PG8_BAR; PG8_SCHED; \
        } while (0)
        int t0_ = 0;
        if constexpr (WARMTRIP) { if (ui > 0) { PG8_TRIP(true, 0); t0_ = 2; } }
        for (int t = t0_; t < nt; t += 2) { PG8_TRIP(false, t); }
#undef PG8_TRIP
        if (wr == 0) PG8_BAR;
        if constexpr (WARMTRIP) { PG8_STAGE_A(PG8_SA(1, 1), nA + kstep, 1); }
        bool has_nn = false;
        if constexpr (GATHER) { if (has_next) { has_nn = S.next(ui + 2, nn); if (has_nn) { PG8_GOFF(gN, nn); } } }
        else { if (has_next) has_nn = S.next(ui + 2, nn); }
        { int fr_ = fr, fq_ = fq; asm volatile("" : "+v"(fr_), "+v"(fq_));
          const LAS unsigned char* mt = lds + LDS_META + (ui & 1) * 4096;
          if constexpr (WARMTRIP) {
              E.pre(acc, cur, wr, wc, fr_, fq_, mt);
              if constexpr (GATHER) asm volatile("" : "+v"(gN[0][0]), "+v"(gN[0][1]), "+v"(gN[1][0]), "+v"(gN[1][1]));
              PG8_WAIT_V(0);
              E.post(acc, cur, wr, wc, fr_, fq_, mt);
          } else { E.run(acc, cur, wr, wc, fr_, fq_, mt); } }
        if (!has_next) break;
#pragma unroll
        for (int a = 0; a < 2; ++a)
#pragma unroll
            for (int b = 0; b < 2; ++b)
#pragma unroll
                for (int m = 0; m < 4; ++m)
#pragma unroll
                    for (int n = 0; n < 2; ++n) acc[a][b][m][n] = (f32x4){0.f, 0.f, 0.f, 0.f};
        cur = nxt; cA = nA; cB = nB; ++ui; nxt = nn; has_next = has_nn;
        if (wr == 1) PG8_BAR;
    }
    PG8_WAIT_V(0);
    PG8_BAR;
#undef PG8_SA
#undef PG8_SB
#undef PG8_STAGE
#undef PG8_STAGE_A
#undef PG8_LDA
#undef PG8_LDB
#undef PG8_MMA
#undef PG8_LD16
#undef PG8_CAT
#undef PG8_WAIT_V
#undef PG8_WAIT_L
#undef PG8_BAR
#undef PG8_SCHED
#undef PG8_GOFF
}
}

using pg8::Unit; using pg8::cvt_pk_bf16;
constexpr int BM = 256, HALF = 128;

typedef f32x4 (&AccRef)[2][2][4][2];
__device__ __forceinline__ void pack8_bf16(f32x4& lo, const f32x4& hi) {
    const unsigned w0 = cvt_pk_bf16(lo[0], lo[1]), w1 = cvt_pk_bf16(lo[2], lo[3]), w2 = cvt_pk_bf16(hi[0], hi[1]), w3 = cvt_pk_bf16(hi[2], hi[3]);
    lo[0] = __builtin_bit_cast(float, w0); lo[1] = __builtin_bit_cast(float, w1); lo[2] = __builtin_bit_cast(float, w2); lo[3] = __builtin_bit_cast(float, w3);
}
#define AS_U4(v) __builtin_bit_cast(u32x4, v)

struct EpiInProj {
    static constexpr bool PERM = true;
    const float* rs1; const f32x2* rope; const float* glu_b;
    bf16_t *q, *k, *v, *qi, *ki, *hglu; float* wi;
    __device__ __forceinline__ void pre(AccRef acc, const Unit& u, int wr, int wc, int fr, int fq, const LAS unsigned char* mt) const {
        const int row0 = u.pm * BM + wr * 64 + fr;
        if (u.pn >= 4) {
            const int ch = 128 * (u.pn - 4) + 32 * wc + 8 * fq;
            f32x4 ba[2], bg[2];
#pragma unroll
            for (int n = 0; n < 2; ++n) { ba[n] = *(const f32x4*)(glu_b + ch + 4 * n); bg[n] = *(const f32x4*)(glu_b + 512 + ch + 4 * n); }
#pragma unroll
            for (int ai = 0; ai < 2; ++ai)
#pragma unroll
                for (int m = 0; m < 4; ++m) { const float rs = rs1[row0 + ai * HALF + m * 16];
#pragma unroll
                    for (int n = 0; n < 2; ++n)
#pragma unroll
                        for (int e = 0; e < 4; ++e) { const float a = acc[ai][0][m][n][e] * rs + ba[n][e], g = acc[ai][1][m][n][e] * rs + bg[n][e]; acc[ai][0][m][n][e] = a * sigmoidf_(g); }
                    pack8_bf16(acc[ai][0][m][0], acc[ai][0][m][1]); }
            return;
        }
        const bool do_rope = !(u.pn == 3 && wc >= 2), is_wi = (u.pn == 3 && wc == 3);
        const int d0 = 8 * fq;
#pragma unroll
        for (int ai = 0; ai < 2; ++ai)
#pragma unroll
            for (int m = 0; m < 4; ++m) { const int row = row0 + ai * HALF + m * 16; const float rs = rs1[row];
                if (do_rope) {
                    const f32x2* rp = rope + (size_t)(row & (SEQ - 1)) * 32 + d0;
#pragma unroll
                    for (int n = 0; n < 2; ++n)
#pragma unroll
                        for (int e = 0; e < 4; ++e) { const f32x2 cs = rp[4 * n + e]; const float x1 = acc[ai][0][m][n][e] * rs, x2 = acc[ai][1][m][n][e] * rs;
                            acc[ai][0][m][n][e] = x1 * cs.x - x2 * cs.y; acc[ai][1][m][n][e] = x2 * cs.x + x1 * cs.y; }
                } else {
#pragma unroll
                    for (int n = 0; n < 2; ++n) { acc[ai][0][m][n] = acc[ai][0][m][n] * rs; acc[ai][1][m][n] = acc[ai][1][m][n] * rs; }
                }
                if (!is_wi) { pack8_bf16(acc[ai][0][m][0], acc[ai][0][m][1]); pack8_bf16(acc[ai][1][m][0], acc[ai][1][m][1]); }
                if (m & 1) __builtin_amdgcn_sched_barrier(0); }
    }
    __device__ __forceinline__ void post(AccRef acc, const Unit& u, int wr, int wc, int fr, int fq, const LAS unsigned char* mt) const {
        const int row0 = u.pm * BM + wr * 64 + fr;
        if (u.pn >= 4) {
            const int ch = 128 * (u.pn - 4) + 32 * wc + 8 * fq;
#pragma unroll
            for (int ai = 0; ai < 2; ++ai)
#pragma unroll
                for (int m = 0; m < 4; ++m) *(u32x4*)(hglu + (size_t)(row0 + ai * HALF + m * 16) * 512 + ch) = AS_U4(acc[ai][0][m][0]);
            return;
        }
        bf16_t* dst; int ld, col; bool is_wi = false;
        if (u.pn < 2) { dst = q; ld = 512; col = (4 * u.pn + wc) * 64; }
        else if (u.pn == 2) { dst = qi; ld = 256; col = wc * 64; }
        else { ld = 64; col = 0; if (wc == 0) dst = k; else if (wc == 1) dst = ki; else if (wc == 2) dst = v; else { dst = v; is_wi = true; } }
        if (is_wi) {
            if (fq == 0) {
#pragma unroll
                for (int ai = 0; ai < 2; ++ai)
#pragma unroll
                    for (int m = 0; m < 4; ++m) *(f32x4*)(wi + (size_t)(row0 + ai * HALF + m * 16) * 4) = acc[ai][0][m][0];
            }
            return;
        }
#pragma unroll
        for (int ai = 0; ai < 2; ++ai)
#pragma unroll
            for (int m = 0; m < 4; ++m) { bf16_t* rp2 = dst + (size_t)(row0 + ai * HALF + m * 16) * ld + col + 8 * fq;
                *(u32x4*)(rp2) = AS_U4(acc[ai][0][m][0]); *(u32x4*)(rp2 + 32) = AS_U4(acc[ai][1][m][0]); }
    }
    __device__ __forceinline__ void run(const f32x4 (&acc)[2][2][4][2], const Unit& u, int wr, int wc, int fr, int fq, const LAS unsigned char* mt) const {
        const int row0 = u.pm * BM + wr * 64 + fr;
        if (u.pn >= 4) {
            const int ch = 128 * (u.pn - 4) + 32 * wc + 8 * fq;
            f32x4 ba[2], bg[2];
#pragma unroll
            for (int n = 0; n < 2; ++n) { ba[n] = *(const f32x4*)(glu_b + ch + 4 * n); bg[n] = *(const f32x4*)(glu_b + 512 + ch + 4 * n); }
#pragma unroll
            for (int ai = 0; ai < 2; ++ai)
#pragma unroll
                for (int m = 0; m < 4; ++m) { const int row = row0 + ai * HALF + m * 16; const float rs = rs1[row];
                    float o[8];
#pragma unroll
                    for (int n = 0; n < 2; ++n)
#pragma unroll
                        for (int e = 0; e < 4; ++e) { const float a = acc[ai][0][m][n][e] * rs + ba[n][e], g = acc[ai][1][m][n][e] * rs + bg[n][e]; o[4 * n + e] = a * sigmoidf_(g); }
                    u32x4 w; w.x = cvt_pk_bf16(o[0], o[1]); w.y = cvt_pk_bf16(o[2], o[3]); w.z = cvt_pk_bf16(o[4], o[5]); w.w = cvt_pk_bf16(o[6], o[7]);
                    *(u32x4*)(hglu + (size_t)row * 512 + ch) = w; }
            return;
        }
        bf16_t* dst; int ld, col; bool do_rope = true, is_wi = false;
        if (u.pn < 2) { dst = q; ld = 512; col = (4 * u.pn + wc) * 64; }
        else if (u.pn == 2) { dst = qi; ld = 256; col = wc * 64; }
        else { ld = 64; col = 0; if (wc == 0) dst = k; else if (wc == 1) dst = ki; else if (wc == 2) { dst = v; do_rope = false; } else { dst = v; is_wi = true; do_rope = false; } }
        if (is_wi) {
            if (fq == 0) {
#pragma unroll
                for (int ai = 0; ai < 2; ++ai)
#pragma unroll
                    for (int m = 0; m < 4; ++m) { const int row = row0 + ai * HALF + m * 16; const float rs = rs1[row];
                        *(f32x4*)(wi + (size_t)row * 4) = acc[ai][0][m][0] * rs; }
            }
            return;
        }
        const int d0 = 8 * fq;
#pragma unroll
        for (int ai = 0; ai < 2; ++ai)
#pragma unroll
            for (int m = 0; m < 4; ++m) { const int row = row0 + ai * HALF + m * 16; const float rs = rs1[row];
                float o1[8], o2[8];
                if (do_rope) {
                    const f32x4* rp = (const f32x4*)(rope + (size_t)(row & (SEQ - 1)) * 32 + d0);
#pragma unroll
                    for (int n = 0; n < 2; ++n)
#pragma unroll
                        for (int e2 = 0; e2 < 2; ++e2) { const f32x4 cs = rp[2 * n + e2];
                            { const float x1 = acc[ai][0][m][n][2 * e2] * rs, x2 = acc[ai][1][m][n][2 * e2] * rs; o1[4 * n + 2 * e2] = x1 * cs.x - x2 * cs.y; o2[4 * n + 2 * e2] = x2 * cs.x + x1 * cs.y; }
                            { const float x1 = acc[ai][0][m][n][2 * e2 + 1] * rs, x2 = acc[ai][1][m][n][2 * e2 + 1] * rs; o1[4 * n + 2 * e2 + 1] = x1 * cs.z - x2 * cs.w; o2[4 * n + 2 * e2 + 1] = x2 * cs.z + x1 * cs.w; } }
                } else {
#pragma unroll
                    for (int n = 0; n < 2; ++n)
#pragma unroll
                        for (int e = 0; e < 4; ++e) { o1[4 * n + e] = acc[ai][0][m][n][e] * rs; o2[4 * n + e] = acc[ai][1][m][n][e] * rs; }
                }
                u32x4 w1, w2; w1.x = cvt_pk_bf16(o1[0], o1[1]); w1.y = cvt_pk_bf16(o1[2], o1[3]); w1.z = cvt_pk_bf16(o1[4], o1[5]); w1.w = cvt_pk_bf16(o1[6], o1[7]);
                w2.x = cvt_pk_bf16(o2[0], o2[1]); w2.y = cvt_pk_bf16(o2[2], o2[3]); w2.z = cvt_pk_bf16(o2[4], o2[5]); w2.w = cvt_pk_bf16(o2[6], o2[7]);
                if (u.pn == 3 && wc == 1) {
                    bf16_t* tp = ki + ((size_t)(row >> 5) * 256 + (row & 31) + 32 * (fq & 1)) * 8;
                    *(u32x4*)(tp + (size_t)(fq >> 1) * 512) = w1; *(u32x4*)(tp + (size_t)(2 + (fq >> 1)) * 512) = w2;
                } else {
                    bf16_t* rp2 = dst + (size_t)row * ld + col + d0;
                    *(u32x4*)(rp2) = w1; *(u32x4*)(rp2 + 32) = w2; } }
    }
};

struct EpiBf16Plain {
    static constexpr bool PERM = true;
    bf16_t* O; int ldc; float scale;
    __device__ __forceinline__ void pre(AccRef acc, const Unit&, int, int, int, int, const LAS unsigned char*) const {
#pragma unroll
        for (int ai = 0; ai < 2; ++ai)
#pragma unroll
            for (int bj = 0; bj < 2; ++bj)
#pragma unroll
                for (int m = 0; m < 4; ++m) { acc[ai][bj][m][0] = acc[ai][bj][m][0] * scale; acc[ai][bj][m][1] = acc[ai][bj][m][1] * scale; pack8_bf16(acc[ai][bj][m][0], acc[ai][bj][m][1]); }
    }
    __device__ __forceinline__ void post(AccRef acc, const Unit& u, int wr, int wc, int fr, int fq, const LAS unsigned char* mt) const {
        const int row0 = u.pm * BM + wr * 64 + fr, col0 = u.pn * BM + wc * 32 + 8 * fq;
#pragma unroll
        for (int ai = 0; ai < 2; ++ai)
#pragma unroll
            for (int m = 0; m < 4; ++m) { bf16_t* rowp = O + (size_t)(row0 + ai * HALF + m * 16) * ldc + col0;
#pragma unroll
                for (int bj = 0; bj < 2; ++bj) *(u32x4*)(rowp + bj * HALF) = AS_U4(acc[ai][bj][m][0]); }
    }
    __device__ __forceinline__ void run(const f32x4 (&acc)[2][2][4][2], const Unit& u, int wr, int wc, int fr, int fq, const LAS unsigned char* mt) const {
        const int row0 = u.pm * BM + wr * 64 + fr, col0 = u.pn * BM + wc * 32 + 8 * fq;
#pragma unroll
        for (int ai = 0; ai < 2; ++ai)
#pragma unroll
            for (int m = 0; m < 4; ++m) { bf16_t* rowp = O + (size_t)(row0 + ai * HALF + m * 16) * ldc + col0;
#pragma unroll
                for (int bj = 0; bj < 2; ++bj) { const f32x4 v0 = acc[ai][bj][m][0] * scale, v1 = acc[ai][bj][m][1] * scale;
                    u32x4 w; w.x = cvt_pk_bf16(v0[0], v0[1]); w.y = cvt_pk_bf16(v0[2], v0[3]); w.z = cvt_pk_bf16(v1[0], v1[1]); w.w = cvt_pk_bf16(v1[2], v1[3]);
                    *(u32x4*)(rowp + bj * HALF) = w; } }
    }
};

struct EpiF8Plain {
    static constexpr bool PERM = true;
    unsigned char* O; int ldc; float scale;
    __device__ __forceinline__ void pre(AccRef acc, const Unit&, int, int, int, int, const LAS unsigned char*) const {}
    __device__ __forceinline__ void post(AccRef acc, const Unit& u, int wr, int wc, int fr, int fq, const LAS unsigned char* mt) const {
        const int row0 = u.pm * BM + wr * 64 + fr, col0 = u.pn * BM + wc * 32 + 8 * fq;
#pragma unroll
        for (int ai = 0; ai < 2; ++ai)
#pragma unroll
            for (int m = 0; m < 4; ++m) { unsigned char* rowp = O + (size_t)(row0 + ai * HALF + m * 16) * ldc + col0;
#pragma unroll
                for (int bj = 0; bj < 2; ++bj) { const f32x4 v0 = acc[ai][bj][m][0] * scale, v1 = acc[ai][bj][m][1] * scale;
                    u32x2 w; w.x = pk4_fp8(v0[0], v0[1], v0[2], v0[3]); w.y = pk4_fp8(v1[0], v1[1], v1[2], v1[3]);
                    *(u32x2*)(rowp + bj * HALF) = w; } }
    }
    __device__ __forceinline__ void run(AccRef acc, const Unit& u, int wr, int wc, int fr, int fq, const LAS unsigned char* mt) const { post(acc, u, wr, wc, fr, fq, mt); }
};

struct EpiOutProj {
    static constexpr bool PERM = false;
    const float* x; float* h1; unsigned char* h1f8;
    __device__ __forceinline__ void pre(AccRef acc, const Unit& u, int wr, int wc, int fr, int fq, const LAS unsigned char* mt) const {
        const int row0 = u.pm * BM + wr * 64 + fr, col0 = u.pn * BM + wc * 32 + 4 * fq;
#pragma unroll
        for (int ai = 0; ai < 2; ++ai)
#pragma unroll
            for (int m = 0; m < 4; ++m) { const size_t off = (size_t)(row0 + ai * HALF + m * 16) * DM + col0;
#pragma unroll
                for (int bj = 0; bj < 2; ++bj)
#pragma unroll
                    for (int n = 0; n < 2; ++n) acc[ai][bj][m][n] += NT_LD((const f32x4*)(x + off + bj * HALF + n * 16));
                if (m & 1) __builtin_amdgcn_sched_barrier(0); }
    }
    __device__ __forceinline__ void post(AccRef acc, const Unit& u, int wr, int wc, int fr, int fq, const LAS unsigned char* mt) const {
        const int row0 = u.pm * BM + wr * 64 + fr, col0 = u.pn * BM + wc * 32 + 4 * fq;
#pragma unroll
        for (int ai = 0; ai < 2; ++ai)
#pragma unroll
            for (int m = 0; m < 4; ++m) { const size_t off = (size_t)(row0 + ai * HALF + m * 16) * DM + col0;
#pragma unroll
                for (int bj = 0; bj < 2; ++bj)
#pragma unroll
                    for (int n = 0; n < 2; ++n) { const size_t o = off + bj * HALF + n * 16; const f32x4 r = acc[ai][bj][m][n];
                        *(f32x4*)(h1 + o) = r; *(unsigned*)(h1f8 + o) = pk4_fp8(r[0], r[1], r[2], r[3]); } }
    }
    __device__ __forceinline__ void run(AccRef acc, const Unit& u, int wr, int wc, int fr, int fq, const LAS unsigned char* mt) const { pre(acc, u, wr, wc, fr, fq, mt); post(acc, u, wr, wc, fr, fq, mt); }
};

struct EpiUp {
    static constexpr bool PERM = true;
    unsigned char* act;
    __device__ __forceinline__ void pre(AccRef acc, const Unit& u, int wr, int wc, int fr, int fq, const LAS unsigned char* mt) const {
        const int r0 = wr * 64 + fr, cl = 32 * wc + 8 * fq;
        const LAS float* rowA = (const LAS float*)mt; const LAS float* bias = (const LAS float*)(mt + 2048);
        f32x4 bg[2], bl[2];
#pragma unroll
        for (int n = 0; n < 2; ++n) { bg[n] = *(const LAS f32x4*)(bias + cl + 4 * n); bl[n] = *(const LAS f32x4*)(bias + 128 + cl + 4 * n); }
#pragma unroll
        for (int ai = 0; ai < 2; ++ai)
#pragma unroll
            for (int m = 0; m < 4; ++m) { const int r = r0 + ai * HALF + m * 16;
                const float rs = (r < u.rows) ? rowA[r] * 0.03125f : 0.f;
#pragma unroll
                for (int n = 0; n < 2; ++n)
#pragma unroll
                    for (int e = 0; e < 4; ++e) { float g = acc[ai][0][m][n][e] * rs + bg[n][e], l = acc[ai][1][m][n][e] * rs + bl[n][e];
                        g = fminf(g, 7.0f); l = fminf(fmaxf(l, -7.0f), 7.0f); acc[ai][0][m][n][e] = g * sigmoidf_(1.702f * g) * (l + 1.0f); } }
    }
    __device__ __forceinline__ void post(AccRef acc, const Unit& u, int wr, int wc, int fr, int fq, const LAS unsigned char* mt) const {
        const int r0 = wr * 64 + fr, ch = 128 * u.pn + 32 * wc + 8 * fq;
#pragma unroll
        for (int ai = 0; ai < 2; ++ai)
#pragma unroll
            for (int m = 0; m < 4; ++m) { const int r = r0 + ai * HALF + m * 16;
                const f32x4 v0 = acc[ai][0][m][0], v1 = acc[ai][0][m][1];
                u32x2 w; w.x = pk4_fp8(v0[0], v0[1], v0[2], v0[3]); w.y = pk4_fp8(v1[0], v1[1], v1[2], v1[3]);
                *(u32x2*)(act + (size_t)(u.pm * BM + r) * 1024 + ch) = w; }
    }
    __device__ __forceinline__ void run(const f32x4 (&acc)[2][2][4][2], const Unit& u, int wr, int wc, int fr, int fq, const LAS unsigned char* mt) const {
        const int r0 = wr * 64 + fr, cl = 32 * wc + 8 * fq, ch = 128 * u.pn + cl;
        const LAS float* rowA = (const LAS float*)mt; const LAS float* bias = (const LAS float*)(mt + 2048);
        f32x4 bg[2], bl[2];
#pragma unroll
        for (int n = 0; n < 2; ++n) { bg[n] = *(const LAS f32x4*)(bias + cl + 4 * n); bl[n] = *(const LAS f32x4*)(bias + 128 + cl + 4 * n); }
#pragma unroll
        for (int ai = 0; ai < 2; ++ai)
#pragma unroll
            for (int m = 0; m < 4; ++m) { const int r = r0 + ai * HALF + m * 16;
                const float rs = (r < u.rows) ? rowA[r] * 0.03125f : 0.f;
                float o[8];
#pragma unroll
                for (int n = 0; n < 2; ++n)
#pragma unroll
                    for (int e = 0; e < 4; ++e) { float g = acc[ai][0][m][n][e] * rs + bg[n][e], l = acc[ai][1][m][n][e] * rs + bl[n][e];
                        g = fminf(g, 7.0f); l = fminf(fmaxf(l, -7.0f), 7.0f); o[4 * n + e] = g * sigmoidf_(1.702f * g) * (l + 1.0f); }
                u32x2 w; w.x = pk4_fp8(o[0], o[1], o[2], o[3]); w.y = pk4_fp8(o[4], o[5], o[6], o[7]);
                *(u32x2*)(act + (size_t)(u.pm * BM + r) * 1024 + ch) = w; }
    }
};

struct EpiDown {
    static constexpr bool PERM = true;
    unsigned char* y;
    __device__ __forceinline__ void pre(AccRef acc, const Unit& u, int wr, int wc, int fr, int fq, const LAS unsigned char* mt) const {
        const int r0 = wr * 64 + fr, cl = wc * 32 + 8 * fq;
        const LAS float* gateT = (const LAS float*)(mt + 1024); const LAS float* bias = (const LAS float*)(mt + 2048);
        float gt[2][4];
#pragma unroll
        for (int ai = 0; ai < 2; ++ai)
#pragma unroll
            for (int m = 0; m < 4; ++m) gt[ai][m] = gateT[r0 + ai * HALF + m * 16] * 16.0f;
#pragma unroll
        for (int bj = 0; bj < 2; ++bj) { const f32x4 bv0 = *(const LAS f32x4*)(bias + cl + bj * HALF), bv1 = *(const LAS f32x4*)(bias + cl + bj * HALF + 4);
#pragma unroll
            for (int ai = 0; ai < 2; ++ai)
#pragma unroll
                for (int m = 0; m < 4; ++m) { acc[ai][bj][m][0] = (acc[ai][bj][m][0] * 0.03125f + bv0) * gt[ai][m]; acc[ai][bj][m][1] = (acc[ai][bj][m][1] * 0.03125f + bv1) * gt[ai][m]; } }
    }
    __device__ __forceinline__ void post(AccRef acc, const Unit& u, int wr, int wc, int fr, int fq, const LAS unsigned char* mt) const {
        const int r0 = wr * 64 + fr, col0 = u.pn * BM + wc * 32 + 8 * fq;
        const LAS int* slotT = (const LAS int*)mt;
#pragma unroll
        for (int ai = 0; ai < 2; ++ai)
#pragma unroll
            for (int m = 0; m < 4; ++m) { const int r = r0 + ai * HALF + m * 16;
                if (r < u.rows) { unsigned char* rowp = y + (size_t)slotT[r] * 1024 + col0;
#pragma unroll
                    for (int bj = 0; bj < 2; ++bj) { const f32x4 v0 = acc[ai][bj][m][0], v1 = acc[ai][bj][m][1];
                        u32x2 w; w.x = pk4_fp8(v0[0], v0[1], v0[2], v0[3]); w.y = pk4_fp8(v1[0], v1[1], v1[2], v1[3]);
                        *(u32x2*)(rowp + bj * HALF) = w; } } }
    }
    __device__ __forceinline__ void run(AccRef acc, const Unit& u, int wr, int wc, int fr, int fq, const LAS unsigned char* mt) const { pre(acc, u, wr, wc, fr, fq, mt); post(acc, u, wr, wc, fr, fq, mt); }
};

template <bool F8>
__device__ __forceinline__ void p0_transpose_item(const float* W, int ldw, void* WTv, int Kdim, const float* gain, LAS float* scr, int kb, int n0, int src0, int nvalid, int lane) {
    bf16_t* WT = (bf16_t*)WTv;
    const int k0 = 64 * kb;
    f32x4 ld4[8];
#pragma unroll
    for (int i = 0; i < 8; ++i) { const int kk = 8 * i + (lane >> 3), j = (lane & 7) * 4;
        ld4[i] = (f32x4){0.f, 0.f, 0.f, 0.f}; if (j < nvalid) ld4[i] = NT_LD((const f32x4*)(W + (size_t)(k0 + kk) * ldw + src0 + j)); }
#pragma unroll
    for (int i = 0; i < 8; ++i) { const int kk = 8 * i + (lane >> 3), j = (lane & 7) * 4; const float gk = (gain ? gain[k0 + kk] : 1.0f) * (F8 ? 32.0f : 1.0f);
        LAS float* d = scr + kk * 33 + j; d[0] = ld4[i].x * gk; d[1] = ld4[i].y * gk; d[2] = ld4[i].z * gk; d[3] = ld4[i].w * gk; }
    LDS_WAIT(); asm volatile("" ::: "memory");
    const int c = lane & 7;
#pragma unroll
    for (int j = 0; j < 4; ++j) { const int n = (lane >> 3) + 8 * j; const LAS float* s = scr + (8 * c) * 33 + n;
        if constexpr (F8) { u32x2 o; o.x = pk4_fp8(s[0 * 33], s[1 * 33], s[2 * 33], s[3 * 33]); o.y = pk4_fp8(s[4 * 33], s[5 * 33], s[6 * 33], s[7 * 33]);
            *(u32x2*)((unsigned char*)WTv + (size_t)(n0 + n) * Kdim + k0 + 8 * c) = o; }
        else { u32x4 o; o.x = pk2(s[0 * 33], s[1 * 33]); o.y = pk2(s[2 * 33], s[3 * 33]); o.z = pk2(s[4 * 33], s[5 * 33]); o.w = pk2(s[6 * 33], s[7 * 33]);
            *(u32x4*)(WT + (size_t)(n0 + n) * Kdim + k0 + 8 * c) = o; } }
    LDS_WAIT(); asm volatile("" ::: "memory");
}
__device__ __forceinline__ void win_colmap(int nb, int& src0, int& nvalid) {
    const int pn = nb >> 3, j = (nb & 7) * 32, bj = j >> 7, slot = (j & 127) >> 5;
    nvalid = 32;
    if (pn < 2) src0 = (4 * pn + slot) * 64 + 32 * bj;
    else if (pn == 2) src0 = 640 + slot * 64 + 32 * bj;
    else if (pn == 3) { if (slot == 0) src0 = 512 + 32 * bj; else if (slot == 1) src0 = 896 + 32 * bj; else if (slot == 2) src0 = 576 + 32 * bj; else { src0 = 960; nvalid = bj == 0 ? 4 : 0; } }
    else src0 = 964 + 512 * bj + 128 * (pn - 4) + 32 * slot;
}
__device__ __forceinline__ void p0_prologue(const Params& P, LAS unsigned char* lds, int vcu, int G, int wave, int lane) {
    unsigned char* ws = P.ws;
    LAS float* scr = (LAS float*)(lds + wave * 16384);
    const int gw = vcu * NWAVES + wave, NGW = G * NWAVES;
    constexpr int I_IN = 16 * 64, I_OUT = 16 * 32, I_G = 16 * 32, I_P = 4 * 32;
    constexpr int NITEMS = I_IN + I_OUT + I_G + I_P;
    for (int it = gw; it < NITEMS; it += NGW) {
        int r = it;
        if (r < I_IN) { const int kb = r / 64, nb = r % 64; int s0, nv; win_colmap(nb, s0, nv); p0_transpose_item<false>(P.w_in, INW, (bf16_t*)(ws + WS_WIN), 1024, P.g_mix, scr, kb, nb * 32, s0, nv, lane); continue; } r -= I_IN;
        if (r < I_OUT) { const int kb = r / 32, nb = r % 32; p0_transpose_item<false>(P.w_out, 1024, (bf16_t*)(ws + WS_WOUT), 1024, nullptr, scr, kb, nb * 32, nb * 32, 32, lane); continue; } r -= I_OUT;
        if (r < I_G) { const int kb = r / 32, nb = r % 32; p0_transpose_item<true>(P.w_ple_gate, 1024, (unsigned char*)(ws + WS_WG), 1024, P.g_ple, scr, kb, nb * 32, nb * 32, 32, lane); continue; } r -= I_G;
        { const int kb = r / 32, nb = r % 32; p0_transpose_item<false>(P.w_ple_proj, 1024, (bf16_t*)(ws + WS_WP), 256, nullptr, scr, kb, nb * 32, nb * 32, 32, lane); }
    }
    float* rs1 = (float*)(ws + WS_RS1); bf16_t* xb = (bf16_t*)(ws + WS_XB);
    for (int m = gw; m < NTOK; m += NGW) {
        const f32x4* xr = (const f32x4*)(P.x + (size_t)m * DM) + lane; f32x4 v[4]; float s = 0.f;
#pragma unroll
        for (int j = 0; j < 4; ++j) { v[j] = NT_LD(xr + 64 * j); s += (v[j].x * v[j].x + v[j].y * v[j].y) + (v[j].z * v[j].z + v[j].w * v[j].w); }
        s = wave_sum(s);
        u32x2* o8 = (u32x2*)(xb + (size_t)m * DM) + lane;
#pragma unroll
        for (int j = 0; j < 4; ++j) { u32x2 w; w.x = pk2(v[j].x, v[j].y); w.y = pk2(v[j].z, v[j].w); o8[64 * j] = w; }
        if (lane == 0) rs1[m] = 1.0f / sqrtf(s * (1.0f / DM) + EPS);
    }
    bf16_t* pb = (bf16_t*)(ws + WS_PB);
    for (int m = gw; m < NTOK; m += NGW) { const f32x4 v = NT_LD((const f32x4*)(P.p + (size_t)m * 256) + lane); u32x2 w; w.x = pk2(v.x, v.y); w.y = pk2(v.z, v.w); *((u32x2*)(pb + (size_t)m * 256) + lane) = w; }
    f32x2* rope = (f32x2*)(ws + WS_ROPE);
    for (int idx = gw * 64 + lane; idx < SEQ * 32; idx += NGW * 64) { const int t = idx >> 5, i = idx & 31;
        const float inv = exp2f(-(float)i * (13.287712379549449f / 32.0f));
        const float ang = (float)t * inv;
        const double rev = (double)ang * 0.15915494309189535; const float fr = (float)(rev - __builtin_floor(rev));
        rope[idx] = (f32x2){__builtin_amdgcn_cosf(fr), __builtin_amdgcn_sinf(fr)}; }
    float* wrg = (float*)(ws + WS_WRG);
    for (int idx = gw * 64 + lane; idx < 1024 * 32; idx += NGW * 64) wrg[idx] = P.w_router[idx] * P.g_ffn[idx >> 5];
}

__device__ __forceinline__ unsigned fkey(float f) { unsigned u = __builtin_bit_cast(unsigned, f); if (u == 0x80000000u) u = 0u; return u ^ ((unsigned)((int)u >> 31) | 0x80000000u); }
__device__ __forceinline__ int mbcnt64(unsigned long long m) { return __builtin_amdgcn_mbcnt_hi((unsigned)(m >> 32), __builtin_amdgcn_mbcnt_lo((unsigned)m, 0u)); }

template <int NR>
__device__ __forceinline__ unsigned bisect_thr(const unsigned (&v)[NR], unsigned prefix, int startbit) {
    bool exact = false;
#pragma unroll 1
    for (int bit = startbit; bit >= 0; --bit) {
        const unsigned cand = prefix | (1u << bit); int cnt = 0;
#pragma unroll
        for (int r = 0; r < NR; ++r) { cnt += __builtin_popcountll(__ballot(v[r] >= cand)); if ((r & 7) == 7) __builtin_amdgcn_sched_barrier(0); }
        if (cnt >= NSEL) prefix = cand;
        if (cnt == NSEL) { exact = true; break; }
    }
    return exact ? prefix - 1u : prefix;
}
template <int NR, bool EXPL>
__device__ __forceinline__ void compact_sel(const unsigned (&v)[NR], const unsigned (&ci)[NR], unsigned T, LAS unsigned* list, int lane) {
    int cgt = 0;
#pragma unroll
    for (int r = 0; r < NR; ++r) { cgt += __builtin_popcountll(__ballot(v[r] > T)); if ((r & 7) == 7) __builtin_amdgcn_sched_barrier(0); }
    const int need = NSEL - cgt; int base = 0, ties = 0;
#pragma unroll
    for (int r = 0; r < NR; ++r) { const bool gt = v[r] > T, eq = v[r] == T; const unsigned long long em = __ballot(eq);
        const bool sel = gt || (eq && (ties + mbcnt64(em)) < need); const unsigned long long sm = __ballot(sel);
        list[sel ? base + mbcnt64(sm) : NSEL + lane] = EXPL ? ci[r] : (unsigned)(r * 64 + lane);
        base += __builtin_popcountll(sm); ties += __builtin_popcountll(em);
        if ((r & 3) == 3) __builtin_amdgcn_sched_barrier(0); }
}
constexpr int SEL_CAP = 1024;
template <int NR>
__device__ __forceinline__ void select_topk(LAS float* row, LAS unsigned* H, LAS unsigned* list, int lane, bool zero_h) {
    unsigned v[NR];
#pragma unroll
    for (int r = 0; r < NR; ++r) v[r] = fkey(row[r * 64 + lane]);
    LAS u32x4* H4 = (LAS u32x4*)H;
    const u32x4 h0 = H4[2 * lane], h1 = H4[2 * lane + 1];
    if (zero_h) { H4[2 * lane] = (u32x4){0u, 0u, 0u, 0u}; H4[2 * lane + 1] = (u32x4){0u, 0u, 0u, 0u}; }
    const unsigned hw[8] = {h0.x, h0.y, h0.z, h0.w, h1.x, h1.y, h1.z, h1.w};
    unsigned c[16];
#pragma unroll
    for (int i = 0; i < 8; ++i) { c[2 * i] = hw[i] & 0xffffu; c[2 * i + 1] = hw[i] >> 16; }
    unsigned s = 0u;
#pragma unroll
    for (int i = 0; i < 16; ++i) s += c[i];
    unsigned S = s;
#pragma unroll
    for (int off = 1; off < 64; off <<= 1) { const unsigned o = __shfl_down(S, off); if (lane + off < 64) S += o; }
    const unsigned long long okm = __ballot(S >= (unsigned)NSEL);
    bool fast = okm != 0ull; unsigned floorkey = 0u; int C = 0;
    if (fast) {
        const int Ls = 63 - __builtin_clzll(okm);
        unsigned acc = S - s; int bl = -1; unsigned accb = 0u;
#pragma unroll
        for (int b = 15; b >= 0; --b) { acc += c[b]; if (bl < 0 && acc >= (unsigned)NSEL) { bl = b; accb = acc; } }
        const int bstar = __shfl(bl, Ls) + 16 * Ls; C = (int)__shfl(accb, Ls);
        floorkey = (unsigned)bstar << 22;
        fast = (bstar > 1) && (C <= SEL_CAP);
    }
    if (!fast) {
        const unsigned T = bisect_thr<NR>(v, 0u, 31);
        compact_sel<NR, false>(v, v, T, list, lane);
        return;
    }
    LAS unsigned* ckl = (LAS unsigned*)row; LAS unsigned* cil = ckl + 1152;
    { int base = 0;
#pragma unroll
      for (int r = 0; r < NR; ++r) { const bool cnd = v[r] >= floorkey; const unsigned long long m = __ballot(cnd);
          const int pos = cnd ? base + mbcnt64(m) : SEL_CAP + lane;
          ckl[pos] = v[r]; cil[pos] = (unsigned)(r * 64 + lane); base += __builtin_popcountll(m);
          if ((r & 3) == 3) __builtin_amdgcn_sched_barrier(0); } }
    if (C <= 512) {
        unsigned ck[8], ci[8];
#pragma unroll
        for (int j = 0; j < 8; ++j) { const int i = j * 64 + lane; ck[j] = i < C ? ckl[i] : 0u; ci[j] = cil[i]; }
        const unsigned T = (C == NSEL) ? floorkey - 1u : bisect_thr<8>(ck, floorkey, 21);
        compact_sel<8, true>(ck, ci, T, list, lane);
    } else {
        unsigned ck[16], ci[16];
#pragma unroll
        for (int j = 0; j < 16; ++j) { const int i = j * 64 + lane; ck[j] = i < C ? ckl[i] : 0u; ci[j] = cil[i]; }
        const unsigned T = bisect_thr<16>(ck, floorkey, 21);
        compact_sel<16, true>(ck, ci, T, list, lane);
    }
}

typedef short v4i16 __attribute__((ext_vector_type(4)));
constexpr int VROW = 144;

__device__ __forceinline__ void attn_tile(const Params& P, LAS unsigned char* lds, int b, int t0, int wave, int lane) {
    unsigned char* ws = P.ws;
    const bf16_t* QI = (const bf16_t*)(ws + WS_QI); const bf16_t* KI = (const bf16_t*)(ws + WS_KI);
    const bf16_t* Q = (const bf16_t*)(ws + WS_Q); const bf16_t* Kp = (const bf16_t*)(ws + WS_K); const bf16_t* Vp = (const bf16_t*)(ws + WS_V);
    const float* WI = (const float*)(ws + WS_WI); bf16_t* MIX = (bf16_t*)(ws + WS_MIX);
    LAS float* SC = (LAS float*)lds;
    LAS unsigned* list = (LAS unsigned*)(lds + wave * 16384 + 14336);
    LAS unsigned* HIST = (LAS unsigned*)(lds + LDS_MISC);
    const int tokbase = b * SEQ;
    const bool need_sel = t0 >= 256;
    if (need_sel) {
        const int nkt = (t0 + 8 + 31) >> 5;
        bf16x8 a[4]; f32x4 w[4];
        { const bf16_t* src = QI + (size_t)(tokbase + t0 + ((lane & 31) >> 2)) * 256 + (lane & 3) * 64 + 8 * (lane >> 5);
#pragma unroll
          for (int ks = 0; ks < 4; ++ks) a[ks] = *(const bf16x8*)(src + 16 * ks); }
#pragma unroll
        for (int g = 0; g < 4; ++g) w[g] = *(const f32x4*)(WI + (size_t)(tokbase + t0 + 2 * g + (lane >> 5)) * 4);
        for (int kt0 = wave; kt0 < nkt; kt0 += 4 * NWAVES) {
            bf16x8 bf[4][4];
#pragma unroll
            for (int u = 0; u < 4; ++u) { const int kt = kt0 + u * NWAVES;
                if (kt < nkt) { const bf16_t* ksrc = KI + ((size_t)((tokbase >> 5) + kt) * 256 + lane) * 8;
#pragma unroll
                    for (int ks = 0; ks < 4; ++ks) bf[u][ks] = *(const bf16x8*)(ksrc + 512 * ks); } }
#pragma unroll
            for (int u = 0; u < 4; ++u) { const int kt = kt0 + u * NWAVES;
                if (kt < nkt) {
                    const int key = kt * 32 + (lane & 31);
                    f32x16 acc;
#pragma unroll
                    for (int i = 0; i < 16; ++i) acc[i] = 0.f;
#pragma unroll
                    for (int ks = 0; ks < 4; ++ks) acc = __builtin_amdgcn_mfma_f32_32x32x16_bf16(a[ks], bf[u][ks], acc, 0, 0, 0);
#pragma unroll
                    for (int g = 0; g < 4; ++g) { float sc = 0.f;
#pragma unroll
                        for (int h = 0; h < 4; ++h) sc = fmaf(fmaxf(acc[4 * g + h], 0.f), w[g][h], sc);
                        const int ql = 2 * g + (lane >> 5);
                        if (key > t0 + ql) sc = -INFINITY;
                        SC[ql * 4096 + key] = sc;
                        if (key <= t0 + ql) { const unsigned ub = __builtin_bit_cast(unsigned, sc);
                            const unsigned bin = (ub >> 22) ^ (((unsigned)((int)ub >> 31) & 0x1ffu) | 0x200u);
                            __hip_atomic_fetch_add(HIST + ql * 512 + (bin >> 1), 1u << ((bin & 1u) << 4), __ATOMIC_RELAXED, __HIP_MEMORY_SCOPE_WORKGROUP); } }
                } }
        }
        { const int npad = ((t0 + 8 + 1023) >> 10) << 10;
          for (int i = nkt * 32 + (int)threadIdx.x; i < npad; i += NTHR) {
#pragma unroll
              for (int q = 0; q < 8; ++q) SC[q * 4096 + i] = -INFINITY; } }
    }
    __syncthreads();
    const int t = t0 + wave, tok = tokbase + t;
    if (need_sel) {
        LAS float* row = SC + wave * 4096; LAS unsigned* H = HIST + wave * 512; const int n = t + 1;
        if (n <= 1024) select_topk<16>(row, H, list, lane, true);
        else if (n <= 2048) select_topk<32>(row, H, list, lane, true);
        else if (n <= 3072) select_topk<48>(row, H, list, lane, true);
        else select_topk<64>(row, H, list, lane, true);
    } else {
#pragma unroll
        for (int i = 0; i < 4; ++i) list[i * 64 + lane] = (unsigned)(i * 64 + lane);
    }
    const int nvalid = need_sel ? NSEL : (t + 1);
    const int hd = lane & 15, g = lane >> 4;
    bf16x8 qf0, qf1;
#pragma unroll
    for (int i = 0; i < 8; ++i) { qf0[i] = 0; qf1[i] = 0; }
    if (hd < 8) { const bf16_t* qs = Q + (size_t)tok * 512 + hd * 64 + 8 * g; qf0 = *(const bf16x8*)qs; qf1 = *(const bf16x8*)(qs + 32); }
    LAS unsigned char* vreg = lds + wave * 16384;
    u32x4 rA[4], rB[4];
#define ATT_ROWS(R, SRC, G_) do { const int nb_ = (G_) * 32; \
        _Pragma("unroll") for (int i_ = 0; i_ < 4; ++i_) { const unsigned idx_ = list[nb_ + (lane >> 3) + 8 * i_]; R[i_] = *(const u32x4*)((SRC) + (size_t)(tokbase + idx_) * 64 + 8 * (lane & 7)); } } while (0)
#define ATT_STAGE(R, BUF) do { _Pragma("unroll") for (int i_ = 0; i_ < 4; ++i_) *(LAS u32x4*)((BUF) + ((lane >> 3) + 8 * i_) * VROW + (lane & 7) * 16) = R[i_]; } while (0)
    float lg[8][8];
#define ATT_QK(R, G_, BUF) do { LAS unsigned char* kb_ = (BUF); ATT_STAGE(R, kb_); \
        if constexpr ((G_) + 2 < 8) { ATT_ROWS(R, Kp, (G_) + 2); } \
        const LAS unsigned char* kr_ = kb_ + hd * VROW + 16 * g; \
        const bf16x8 ka0_ = *(const LAS bf16x8*)kr_, ka1_ = *(const LAS bf16x8*)(kr_ + 64), kb0_ = *(const LAS bf16x8*)(kr_ + 16 * VROW), kb1_ = *(const LAS bf16x8*)(kr_ + 16 * VROW + 64); \
        f32x4 sa_ = {0.f, 0.f, 0.f, 0.f}, sb_ = {0.f, 0.f, 0.f, 0.f}; \
        sa_ = __builtin_amdgcn_mfma_f32_16x16x32_bf16(ka0_, qf0, sa_, 0, 0, 0); sa_ = __builtin_amdgcn_mfma_f32_16x16x32_bf16(ka1_, qf1, sa_, 0, 0, 0); \
        sb_ = __builtin_amdgcn_mfma_f32_16x16x32_bf16(kb0_, qf0, sb_, 0, 0, 0); sb_ = __builtin_amdgcn_mfma_f32_16x16x32_bf16(kb1_, qf1, sb_, 0, 0, 0); \
        _Pragma("unroll") for (int r_ = 0; r_ < 4; ++r_) { const int sl_ = (G_) * 32 + 4 * g + r_; \
            lg[G_][r_] = sl_ < nvalid ? sa_[r_] * 0.125f : -INFINITY; lg[G_][4 + r_] = (sl_ + 16) < nvalid ? sb_[r_] * 0.125f : -INFINITY; } } while (0)
    ATT_ROWS(rA, Kp, 0); ATT_ROWS(rB, Kp, 1);
    ATT_QK(rA, 0, vreg); ATT_QK(rB, 1, vreg + 4608); ATT_QK(rA, 2, vreg); ATT_QK(rB, 3, vreg + 4608);
    ATT_QK(rA, 4, vreg); ATT_QK(rB, 5, vreg + 4608); ATT_QK(rA, 6, vreg); ATT_QK(rB, 7, vreg + 4608);
    ATT_ROWS(rA, Vp, 0); ATT_ROWS(rB, Vp, 1);
    float mx = -INFINITY;
#pragma unroll
    for (int q = 0; q < 8; ++q)
#pragma unroll
        for (int r = 0; r < 8; ++r) mx = fmaxf(mx, lg[q][r]);
    mx = fmaxf(mx, __shfl_xor(mx, 16)); mx = fmaxf(mx, __shfl_xor(mx, 32));
    float ssum = 0.f;
#pragma unroll
    for (int q = 0; q < 8; ++q)
#pragma unroll
        for (int r = 0; r < 8; ++r) { lg[q][r] = __expf(lg[q][r] - mx); ssum += lg[q][r]; }
    f32x4 o[4];
#pragma unroll
    for (int dt = 0; dt < 4; ++dt) o[dt] = (f32x4){0.f, 0.f, 0.f, 0.f};
#define ATT_PV(R, G_, BUF) do { LAS unsigned char* vb_ = (BUF); ATT_STAGE(R, vb_); \
        if constexpr ((G_) + 2 < 8) { ATT_ROWS(R, Vp, (G_) + 2); } \
        bf16x8 pf_; \
        { const u32x4 pw_ = {cvt_pk_bf16(lg[G_][0], lg[G_][1]), cvt_pk_bf16(lg[G_][2], lg[G_][3]), cvt_pk_bf16(lg[G_][4], lg[G_][5]), cvt_pk_bf16(lg[G_][6], lg[G_][7])}; pf_ = __builtin_bit_cast(bf16x8, pw_); } \
        LAS unsigned char* ta_ = vb_ + (4 * g + (hd >> 2)) * VROW + (hd & 3) * 8; \
        _Pragma("unroll") for (int dt_ = 0; dt_ < 4; ++dt_) { \
            const v4i16 lo_ = __builtin_amdgcn_ds_read_tr16_b64_v4i16((LAS v4i16*)(ta_ + dt_ * 32)); \
            const v4i16 hi_ = __builtin_amdgcn_ds_read_tr16_b64_v4i16((LAS v4i16*)(ta_ + 16 * VROW + dt_ * 32)); \
            bf16x8 vf_; vf_[0] = lo_[0]; vf_[1] = lo_[1]; vf_[2] = lo_[2]; vf_[3] = lo_[3]; vf_[4] = hi_[0]; vf_[5] = hi_[1]; vf_[6] = hi_[2]; vf_[7] = hi_[3]; \
            o[dt_] = __builtin_amdgcn_mfma_f32_16x16x32_bf16(vf_, pf_, o[dt_], 0, 0, 0); } } while (0)
    ATT_PV(rA, 0, vreg); ATT_PV(rB, 1, vreg + 4608); ATT_PV(rA, 2, vreg); ATT_PV(rB, 3, vreg + 4608);
    ATT_PV(rA, 4, vreg); ATT_PV(rB, 5, vreg + 4608); ATT_PV(rA, 6, vreg); ATT_PV(rB, 7, vreg + 4608);
#undef ATT_ROWS
#undef ATT_STAGE
#undef ATT_QK
#undef ATT_PV
    ssum += __shfl_xor(ssum, 16); ssum += __shfl_xor(ssum, 32);
    const float inv = 1.0f / ssum;
    if (hd < 8) {
        bf16_t* op = MIX + (size_t)tok * 1024 + hd * 64 + 4 * g;
#pragma unroll
        for (int dt = 0; dt < 4; ++dt) { u32x2 w; w.x = cvt_pk_bf16(o[dt][0] * inv, o[dt][1] * inv); w.y = cvt_pk_bf16(o[dt][2] * inv, o[dt][3] * inv); *(u32x2*)(op + 16 * dt) = w; }
    }
    __syncthreads();
}

__device__ __forceinline__ void conv_tile(const Params& P, LAS unsigned char* lds, int tile, int tid, int wave, int lane) {
    unsigned char* ws = P.ws;
    const bf16_t* HG = (const bf16_t*)(ws + WS_HGLU); bf16_t* MIX = (bf16_t*)(ws + WS_MIX);
    LAS f32x2* part = (LAS f32x2*)(lds + LDS_MISC + 1024);
    LAS f32x2* stat = part + 256;
    LAS bf16_t* Lin = (LAS bf16_t*)lds;
    LAS bf16_t* Lout = (LAS bf16_t*)(lds + 65536);
    const int tok0 = tile * 32, t0 = tok0 & (SEQ - 1), c = tid;
    for (int ch = tid; ch < 62 * 64; ch += NTHR) { const int r = ch >> 6, cc = ch & 63; const int tt = t0 - 30 + r;
        u32x4 v = {0u, 0u, 0u, 0u}; if (tt >= 0) v = *(const u32x4*)(HG + (size_t)(tok0 - 30 + r) * 512 + cc * 8);
        *(LAS u32x4*)(Lin + r * 512 + cc * 8) = v; }
    __syncthreads();
    float in[62];
#pragma unroll
    for (int r = 0; r < 62; ++r) in[r] = __builtin_bit_cast(float, (unsigned)Lin[r * 512 + c] << 16);
    float out[32];
    const float bias = P.dw_b[c];
#pragma unroll
    for (int i = 0; i < 32; ++i) out[i] = bias;
#pragma unroll
    for (int j = 0; j < 31; ++j) { const float wj = P.dw_w[j * 512 + c];
#pragma unroll
        for (int i = 0; i < 32; ++i) out[i] = fmaf(in[i + j], wj, out[i]); }
#pragma unroll
    for (int i = 0; i < 32; ++i) { const float s1 = wave_sum(out[i]), s2 = wave_sum(out[i] * out[i]); if (lane == 0) part[i * 8 + wave] = (f32x2){s1, s2}; }
    __syncthreads();
    if (tid < 32) { float s1 = 0.f, s2 = 0.f;
#pragma unroll
        for (int w = 0; w < 8; ++w) { const f32x2 pp = part[tid * 8 + w]; s1 += pp.x; s2 += pp.y; }
        const float mean = s1 * (1.0f / 512.0f), var = fmaxf(s2 * (1.0f / 512.0f) - mean * mean, 0.f);
        stat[tid] = (f32x2){mean, 1.0f / sqrtf(var + EPS)}; }
    __syncthreads();
    const float lgc = P.ln_g[c], lbc = P.ln_b[c];
#pragma unroll
    for (int i = 0; i < 32; ++i) { const f32x2 st = stat[i]; const float y = (out[i] - st.x) * st.y * lgc + lbc; const float sl = y * sigmoidf_(y);
        Lout[i * 512 + c] = (bf16_t)f2bf(sl); }
    __syncthreads();
    for (int ch = tid; ch < 32 * 64; ch += NTHR) { const int r = ch >> 6, cc = ch & 63;
        *(u32x4*)(MIX + (size_t)(tok0 + r) * 1024 + 512 + cc * 8) = *(const LAS u32x4*)(Lout + r * 512 + cc * 8); }
    __syncthreads();
}

constexpr int MW_UP = 32 * 16 * 64, MW_DN = 32 * 16 * 32, MW_ITEMS = MW_UP + MW_DN;
__device__ __forceinline__ void mw_decode(const Params& P, int it, const float*& src, int& ldw, unsigned char*& dst, const float*& gain) {
    unsigned char* ws = P.ws;
    if (it < MW_UP) { const int e = it >> 10, rr = it & 1023, kb = rr >> 6, nb = rr & 63, pn = nb >> 3, j = (nb & 7) * 32, bj = j >> 7, jj = j & 127;
        src = P.w_up + (size_t)e * 1024 * 2048 + (size_t)(kb * 64) * 2048 + 1024 * bj + 128 * pn + jj; ldw = 2048;
        dst = ws + WS_WUP + (size_t)e * 2048 * 1024 + (size_t)(nb * 32) * 1024 + kb * 64; gain = P.g_ffn + kb * 64; }
    else { const int r = it - MW_UP, e = r >> 9, rr = r & 511, kb = rr >> 5, nb = rr & 31;
        src = P.w_down + (size_t)e * 1024 * 1024 + (size_t)(kb * 64) * 1024 + nb * 32; ldw = 1024;
        dst = ws + WS_WDOWN + (size_t)e * 1024 * 1024 + (size_t)(nb * 32) * 1024 + kb * 64; gain = nullptr; }
}
#define MW_LOAD(LD, it_) do { if ((it_) < MW_ITEMS) { const float* src_; int ldw_; unsigned char* dst_; const float* gain_; mw_decode(P, (it_), src_, ldw_, dst_, gain_); \
        _Pragma("unroll") for (int i_ = 0; i_ < 8; ++i_) LD[i_] = NT_LD((const f32x4*)(src_ + (size_t)(8 * i_ + (lane >> 3)) * ldw_ + (lane & 7) * 4)); } } while (0)
#define MW_FINISH(LD, it_) do { if ((it_) < MW_ITEMS) { const float* src_; int ldw_; unsigned char* dst_; const float* gain_; mw_decode(P, (it_), src_, ldw_, dst_, gain_); \
        _Pragma("unroll") for (int i_ = 0; i_ < 8; ++i_) { const int kk_ = 8 * i_ + (lane >> 3), j_ = (lane & 7) * 4; const float gk_ = (gain_ ? gain_[kk_] : 1.0f) * 32.0f; \
            LAS float* d_ = scr + kk_ * 33 + j_; d_[0] = LD[i_].x * gk_; d_[1] = LD[i_].y * gk_; d_[2] = LD[i_].z * gk_; d_[3] = LD[i_].w * gk_; } \
        LDS_WAIT(); asm volatile("" ::: "memory"); \
        const int c_ = lane & 7; \
        _Pragma("unroll") for (int j_ = 0; j_ < 4; ++j_) { const int n_ = (lane >> 3) + 8 * j_; const LAS float* sp_ = scr + (8 * c_) * 33 + n_; \
            u32x2 o_; o_.x = pk4_fp8(sp_[0 * 33], sp_[1 * 33], sp_[2 * 33], sp_[3 * 33]); o_.y = pk4_fp8(sp_[4 * 33], sp_[5 * 33], sp_[6 * 33], sp_[7 * 33]); \
            *(u32x2*)(dst_ + (size_t)n_ * 1024 + 8 * c_) = o_; } \
        LDS_WAIT(); asm volatile("" ::: "memory"); } } while (0)
__device__ __forceinline__ void moe_weight_convert(const Params& P, LAS float* scr, int cw, int ncw, int lane) {
    f32x4 l0[8], l1[8], l2[8], l3[8];
    MW_LOAD(l0, cw); MW_LOAD(l1, cw + ncw); MW_LOAD(l2, cw + 2 * ncw);
    for (int base = cw; base < MW_ITEMS; base += 4 * ncw) {
        MW_LOAD(l3, base + 3 * ncw); MW_FINISH(l0, base);
        MW_LOAD(l0, base + 4 * ncw); MW_FINISH(l1, base + ncw);
        MW_LOAD(l1, base + 5 * ncw); MW_FINISH(l2, base + 2 * ncw);
        MW_LOAD(l2, base + 6 * ncw); MW_FINISH(l3, base + 3 * ncw);
    }
}
#undef MW_LOAD
#undef MW_FINISH

__device__ __forceinline__ void router_phase(const Params& P, LAS unsigned char* lds, int blk, int G, int tid, int wave, int lane) {
    unsigned char* ws = P.ws;
    const float* h1 = (const float*)(ws + WS_H1); const float* wrg = (const float*)(ws + WS_WRG);
    int* list = (int*)(ws + WS_LIST); float* lscale = (float*)(ws + WS_LSCALE); float* lgate = (float*)(ws + WS_LGATE);
    unsigned* cntg = (unsigned*)(ws + WS_CTL) + CW_CNT;
    LAS float* WL = (LAS float*)lds;
    LAS int* lcnt = (LAS int*)(lds + LDS_MISC + 1024);
    LAS int* gbase = lcnt + 32;
    LAS int* rec_e = gbase + 32;
    LAS int* rec_p = rec_e + 512;
    LAS float* rec_g = (LAS float*)(rec_p + 512);
    LAS float* rec_s = rec_g + 512;
    for (int i = tid; i < 8192; i += NTHR) ((LAS f32x4*)WL)[i] = ((const f32x4*)wrg)[i];
    __syncthreads();
    const int tl = lane & 31, half = lane >> 5;
    for (int chunk = blk; chunk < NTOK / 128; chunk += G) {
        if (tid < 32) lcnt[tid] = 0;
        __syncthreads();
        if (wave < 4) {
            const int tloc = wave * 32 + tl, tok = chunk * 128 + tloc;
            const float* hrow = h1 + (size_t)tok * DM + 4 * half;
            f32x16 acc;
#pragma unroll
            for (int i = 0; i < 16; ++i) acc[i] = 0.f;
            float ss = 0.f;
#pragma unroll 1
            for (int k0 = 0; k0 < DM; k0 += 32) {
                f32x4 hv[4];
#pragma unroll
                for (int i = 0; i < 4; ++i) hv[i] = *(const f32x4*)(hrow + k0 + 8 * i);
#pragma unroll
                for (int i = 0; i < 4; ++i) {
                    ss = fmaf(hv[i].x, hv[i].x, fmaf(hv[i].y, hv[i].y, fmaf(hv[i].z, hv[i].z, fmaf(hv[i].w, hv[i].w, ss))));
#pragma unroll
                    for (int j = 0; j < 4; ++j) { const float wv = WL[(k0 + 8 * i + 4 * half + j) * 32 + tl];
                        acc = __builtin_amdgcn_mfma_f32_32x32x2f32(wv, hv[i][j], acc, 0, 0, 0); }
                }
            }
            ss += __shfl_xor(ss, 32);
            const float rs = 1.0f / sqrtf(ss * (1.0f / DM) + EPS);
            float v[16];
#pragma unroll
            for (int r = 0; r < 16; ++r) v[r] = acc[r] * rs + P.b_router[(r & 3) + 8 * (r >> 2) + 4 * half];
            float tv[4]; int te[4];
#pragma unroll
            for (int q = 0; q < 4; ++q) { float bv = -INFINITY; int be = 64;
#pragma unroll
                for (int r = 0; r < 16; ++r) { const int e = (r & 3) + 8 * (r >> 2) + 4 * half; if (v[r] > bv || (v[r] == bv && e < be)) { bv = v[r]; be = e; } }
#pragma unroll
                for (int r = 0; r < 16; ++r) { const int e = (r & 3) + 8 * (r >> 2) + 4 * half; if (e == be) v[r] = -INFINITY; }
                tv[q] = bv; te[q] = be; }
            float cv[8]; int ce[8];
#pragma unroll
            for (int q = 0; q < 4; ++q) { cv[q] = tv[q]; ce[q] = te[q]; cv[4 + q] = __shfl_xor(tv[q], 32); ce[4 + q] = __shfl_xor(te[q], 32); }
#pragma unroll
            for (int q = 0; q < 4; ++q) { float bv = -INFINITY; int be = 64;
#pragma unroll
                for (int r = 0; r < 8; ++r) if (cv[r] > bv || (cv[r] == bv && ce[r] < be)) { bv = cv[r]; be = ce[r]; }
#pragma unroll
                for (int r = 0; r < 8; ++r) if (ce[r] == be) cv[r] = -INFINITY;
                tv[q] = bv; te[q] = be; }
            const float e1 = __expf(tv[1] - tv[0]), e2 = __expf(tv[2] - tv[0]), e3 = __expf(tv[3] - tv[0]);
            const float is = 1.0f / (1.0f + e1 + e2 + e3);
            if (half == 0) {
                const float gq[4] = {is, e1 * is, e2 * is, e3 * is};
#pragma unroll
                for (int q = 0; q < 4; ++q) { const int lp = atomicAdd((int*)&lcnt[te[q]], 1); const int si = tloc * 4 + q; rec_e[si] = te[q]; rec_p[si] = lp; rec_g[si] = gq[q]; }
                rec_s[tloc] = rs;
            }
        }
        __syncthreads();
        if (tid < 32) gbase[tid] = (int)atomicAdd(cntg + 64 * tid, (unsigned)lcnt[tid]);
        __syncthreads();
        { const int si = tid, ee = rec_e[si], pos = gbase[ee] + rec_p[si], li = ee * NTOK + pos;
          list[li] = (chunk * 128) * 4 + si; lscale[li] = rec_s[si >> 2]; lgate[li] = rec_g[si]; }
        __syncthreads();
    }
}

__device__ __forceinline__ void combine_phase(const Params& P, int mbeg, int mend, int mstep, int lane) {
    unsigned char* ws = P.ws;
    float* h1 = (float*)(ws + WS_H1); bf16_t* h1b = (bf16_t*)(ws + WS_H1B); const unsigned char* y = ws + WS_Y; float* rs3 = (float*)(ws + WS_RS3);
    for (int m = mbeg; m < mend; m += mstep) {
        const f32x4* hr = (const f32x4*)(h1 + (size_t)m * DM) + lane; f32x4 v[4]; float s = 0.f;
#pragma unroll
        for (int j = 0; j < 4; ++j) v[j] = NT_LD(hr + 64 * j);
#pragma unroll
        for (int k = 0; k < 4; ++k) { const unsigned* yr = (const unsigned*)(y + (size_t)(m * 4 + k) * DM) + lane;
#pragma unroll
            for (int j = 0; j < 4; ++j) { const unsigned w = NT_LD(yr + 64 * j); const f32x2 lo = __builtin_amdgcn_cvt_pk_f32_fp8((int)w, false), hi = __builtin_amdgcn_cvt_pk_f32_fp8((int)w, true);
                v[j].x += lo.x * 0.0625f; v[j].y += lo.y * 0.0625f; v[j].z += hi.x * 0.0625f; v[j].w += hi.y * 0.0625f; } }
        u32x2* o8 = (u32x2*)(h1b + (size_t)m * DM) + lane; unsigned* o4 = (unsigned*)(ws + WS_H1F8 + (size_t)m * DM) + lane;
#pragma unroll
        for (int j = 0; j < 4; ++j) { u32x2 w; w.x = pk2(v[j].x, v[j].y); w.y = pk2(v[j].z, v[j].w); NT_ST(w, o8 + 64 * j); NT_ST(pk4_fp8(v[j].x, v[j].y, v[j].z, v[j].w), o4 + 64 * j);
            s += (v[j].x * v[j].x + v[j].y * v[j].y) + (v[j].z * v[j].z + v[j].w * v[j].w); }
        s = wave_sum(s);
        if (lane == 0) rs3[m] = 1.0f / sqrtf(s * (1.0f / DM) + EPS);
    }
}

__device__ __forceinline__ void final_phase(const Params& P, int mbeg, int mend, int mstep, int lane) {
    unsigned char* ws = P.ws;
    const bf16_t* h2b = (const bf16_t*)(ws + WS_H1B); const bf16_t* pj = (const bf16_t*)(ws + WS_PJ); const unsigned char* G = ws + WS_G; const float* rs3 = (const float*)(ws + WS_RS3);
    f32x4 gv[4];
#pragma unroll
    for (int j = 0; j < 4; ++j) gv[j] = *((const f32x4*)P.g_final + lane + 64 * j);
    for (int m = mbeg; m < mend; m += mstep) {
        const u32x2* hr = (const u32x2*)(h2b + (size_t)m * DM) + lane; const u32x2* pr = (const u32x2*)(pj + (size_t)m * DM) + lane; const unsigned* gr = (const unsigned*)(G + (size_t)m * DM) + lane;
        const float r3 = rs3[m]; f32x4 v[4]; float s = 0.f;
#pragma unroll
        for (int j = 0; j < 4; ++j) { const u32x2 hw = NT_LD(hr + 64 * j), pw = NT_LD(pr + 64 * j); const unsigned gw2 = NT_LD(gr + 64 * j);
            const f32x2 glo = __builtin_amdgcn_cvt_pk_f32_fp8((int)gw2, false), ghi = __builtin_amdgcn_cvt_pk_f32_fp8((int)gw2, true);
            v[j].x = bf_lo(hw.x) + bf_lo(pw.x) * sigmoidf_(glo.x * r3); v[j].y = bf_hi(hw.x) + bf_hi(pw.x) * sigmoidf_(glo.y * r3);
            v[j].z = bf_lo(hw.y) + bf_lo(pw.y) * sigmoidf_(ghi.x * r3); v[j].w = bf_hi(hw.y) + bf_hi(pw.y) * sigmoidf_(ghi.y * r3);
            s += (v[j].x * v[j].x + v[j].y * v[j].y) + (v[j].z * v[j].z + v[j].w * v[j].w); }
        s = wave_sum(s); const float rs = 1.0f / sqrtf(s * (1.0f / DM) + EPS);
        f32x4* orow = (f32x4*)(P.out + (size_t)m * DM) + lane;
#pragma unroll
        for (int j = 0; j < 4; ++j) NT_ST(v[j] * rs * gv[j], orow + 64 * j);
    }
}

#define XB_TMO      128
#define XB_XCNT(j)  (256  + 64 * (j))
#define XB_XSUB(j)  (1280 + 64 * (j))
#define XB_XGEN(j)  (2304 + 64 * (j))
#define XB_TOP      3328
#define XB_TOPGEN   3392
#define XCD_BAR_WORDS 3456
#define XB_SPIN_CAP (1u << 18)
__device__ __forceinline__ unsigned xb_ld(unsigned* p)              { return __hip_atomic_load(p, __ATOMIC_RELAXED, __HIP_MEMORY_SCOPE_AGENT); }
__device__ __forceinline__ unsigned xb_add(unsigned* p, unsigned v) { return __hip_atomic_fetch_add(p, v, __ATOMIC_RELAXED, __HIP_MEMORY_SCOPE_AGENT); }
__device__ __forceinline__ unsigned xb_xcc_id() { return (unsigned)__builtin_amdgcn_s_getreg((3 << 11) | 20) & 0xFu; }
#define XB_SPIN(cond, bar) do { unsigned _sp = 0; while (cond) { __builtin_amdgcn_s_sleep(1); \
    if ((++_sp & 255u) == 0u) { if (xb_ld(&(bar)[XB_TMO])) break; if (_sp > XB_SPIN_CAP) { atomicAdd(&(bar)[XB_TMO], 1u); break; } } } } while (0)
struct XcdBarrier { unsigned* bar; unsigned x; volatile LAS unsigned* st; };
__device__ __forceinline__ XcdBarrier xcd_barrier_post(unsigned* bar, volatile LAS unsigned* st) {
    XcdBarrier b; b.bar = bar; b.x = xb_xcc_id(); b.st = st;
    if (threadIdx.x == 0) (void)xb_add(&bar[XB_XCNT(b.x)], 1u);
    return b;
}
__device__ __forceinline__ void xcd_barrier_complete(unsigned* bar, unsigned x, unsigned& nloc, unsigned& nx) {
    const unsigned G = gridDim.x * gridDim.y * gridDim.z;
    unsigned sum, cnt, mine, sp = 0u;
    for (;;) {
        sum = 0u; cnt = 0u; mine = 0u;
#pragma unroll
        for (unsigned j = 0; j < 16; ++j) { const unsigned c = xb_ld(&bar[XB_XCNT(j)]); sum += c; cnt += (c > 0u) ? 1u : 0u; mine = (j == x) ? c : mine; }
        if (sum == G) break;
        __builtin_amdgcn_s_sleep(1);
        if ((++sp & 255u) == 0u) { if (xb_ld(&bar[XB_TMO])) break; if (sp > XB_SPIN_CAP) { atomicAdd(&bar[XB_TMO], 1u); break; } }
    }
    nloc = mine > 0u ? mine : 1u; nx = cnt > 0u ? cnt : 1u;
}
__device__ __forceinline__ void xcd_barrier(const XcdBarrier& b) {
    asm volatile("s_waitcnt vmcnt(0)" ::: "memory");
    __syncthreads();
    if (threadIdx.x == 0) {
        unsigned* bar = b.bar;
        __builtin_amdgcn_s_waitcnt(0);
        unsigned nloc = b.st[0], nx = b.st[1];
        if (nloc == 0u) { xcd_barrier_complete(bar, b.x, nloc, nx); b.st[0] = nloc; b.st[1] = nx; }
        const unsigned old = xb_add(&bar[XB_XSUB(b.x)], 1u);
        const unsigned gen = old / nloc;
        if (old + 1u == (gen + 1u) * nloc) {
            __builtin_amdgcn_fence(__ATOMIC_RELEASE, "agent");
            asm volatile("s_waitcnt vmcnt(0)" ::: "memory");
            const unsigned og = xb_add(&bar[XB_TOP], 1u);
            const unsigned tg = og / nx;
            if (og + 1u == (tg + 1u) * nx) xb_add(&bar[XB_TOPGEN], 1u);
            else XB_SPIN(xb_ld(&bar[XB_TOPGEN]) == tg, bar);
            __builtin_amdgcn_fence(__ATOMIC_ACQUIRE, "agent");
            xb_add(&bar[XB_XGEN(b.x)], 1u);
            asm volatile("s_waitcnt vmcnt(0)" ::: "memory");
        } else {
            XB_SPIN(xb_ld(&bar[XB_XGEN(b.x)]) == gen, bar);
            __builtin_amdgcn_fence(__ATOMIC_ACQUIRE, "agent");
            asm volatile("s_waitcnt vmcnt(0)" ::: "memory");
        }
    }
    __syncthreads();
}

__device__ __forceinline__ void pair_sync(unsigned* flag, unsigned* tmo, bool same_xcd) {
    asm volatile("s_waitcnt vmcnt(0)" ::: "memory");
    __syncthreads();
    if (threadIdx.x == 0) {
        if (!same_xcd) { __builtin_amdgcn_fence(__ATOMIC_RELEASE, "agent"); asm volatile("s_waitcnt vmcnt(0)" ::: "memory"); }
        xb_add(flag, 1u);
        unsigned sp = 0u;
        while (xb_ld(flag) < 2u) { __builtin_amdgcn_s_sleep(1); if ((++sp & 255u) == 0u) { if (xb_ld(tmo)) break; if (sp > XB_SPIN_CAP) { atomicAdd(tmo, 1u); break; } } }
        __builtin_amdgcn_fence(__ATOMIC_ACQUIRE, "agent");
        asm volatile("s_waitcnt vmcnt(0)" ::: "memory");
    }
    __syncthreads();
}

constexpr int NPHASE = 10;
__global__ void __launch_bounds__(NTHR, 2) fwd_kernel(Params P) {
    extern __shared__ __attribute__((aligned(16))) unsigned char lds_raw[];
    LAS unsigned char* lds = (LAS unsigned char*)lds_raw;
    cg::grid_group grid = cg::this_grid();
    const int tid = threadIdx.x, wave = __builtin_amdgcn_readfirstlane(tid >> 6);
    const int G = gridDim.x, bx = blockIdx.x;
#define FRESH_LANE(name) int name = (int)__builtin_amdgcn_mbcnt_hi(~0u, __builtin_amdgcn_mbcnt_lo(~0u, 0u)); asm volatile("" : "+v"(name))
    const int vcu = (G % 8 == 0) ? (bx % 8) * (G / 8) + bx / 8 : bx;
    const int NGW = G * NWAVES;
    unsigned char* ws = P.ws;
    const int lo = P.ph_lo, hi = P.ph_hi;
#define IN(k) (lo <= (k) && (k) < hi)
    volatile LAS unsigned* xst = (volatile LAS unsigned*)(lds + LDS_XB);
    if (tid < 2) xst[tid] = 0u;
    __syncthreads();
    const XcdBarrier xbar = xcd_barrier_post((unsigned*)(ws + WS_CTL) + CW_BAR, xst);
    if (tid == 0) __hip_atomic_store((unsigned*)(ws + WS_CTL) + CW_XCC + bx, xbar.x + 1u, __ATOMIC_RELAXED, __HIP_MEMORY_SCOPE_AGENT);
    if (P.ph_lo > P.ph_hi) grid.sync();
#define SYNC(k) do { if (IN(k) && IN((k) + 1)) xcd_barrier(xbar); } while (0)

    if (IN(0)) { FRESH_LANE(lane); p0_prologue(P, lds, vcu, G, wave, lane); }
    SYNC(0);
    if (IN(1)) {
        { pg8::DenseSched S; S.init((const bf16_t*)(ws + WS_XB), (const bf16_t*)(ws + WS_WIN), NTOK, 2048, 1024, G, bx);
          EpiInProj E{(const float*)(ws + WS_RS1), (const f32x2*)(ws + WS_ROPE), P.glu_b, (bf16_t*)(ws + WS_Q), (bf16_t*)(ws + WS_K), (bf16_t*)(ws + WS_V), (bf16_t*)(ws + WS_QI), (bf16_t*)(ws + WS_KI), (bf16_t*)(ws + WS_HGLU), (float*)(ws + WS_WI)};
          pg8::gemm_phase<EpiInProj, pg8::DenseSched, false>(lds, S, E); }
        { pg8::DenseSched S; S.init((const bf16_t*)(ws + WS_PB), (const bf16_t*)(ws + WS_WP), NTOK, 1024, 256, G, bx);
          EpiBf16Plain E{(bf16_t*)(ws + WS_PJ), 1024, 1.0f};
          pg8::gemm_phase<EpiBf16Plain, pg8::DenseSched, false>(lds, S, E); }
    }
    SYNC(1);
    if (IN(2)) {
        FRESH_LANE(lane);
        for (int i = tid; i < 4096; i += NTHR) ((LAS unsigned*)(lds + LDS_MISC))[i] = 0u;
        __syncthreads();
        unsigned* ctl = (unsigned*)(ws + WS_CTL);
        volatile LAS int* qw = (volatile LAS int*)(lds + LDS_XB + 32);
        if (G % 8 == 0 && G >= 128) { const int ncv = 8; if ((bx >> 3) < ncv) moe_weight_convert(P, (LAS float*)(lds + wave * 16384), (bx * NWAVES) + wave, ncv * 8 * NWAVES, lane); }
        else { moe_weight_convert(P, (LAS float*)(lds + wave * 16384), bx * NWAVES + wave, G * NWAVES, lane); }
        __syncthreads();
        for (int db = 0; db < NB; ++db) { const int b = (bx + db) & 7;
            for (;;) {
                if (tid == 0) qw[0] = (int)atomicAdd(ctl + CW_AQ + 64 * b, 1u);
                __syncthreads();
                const int k = qw[0];
                if (k >= 512) break;
                attn_tile(P, lds, b, (511 - k) * 8, wave, lane);
            }
            __syncthreads(); }
        for (;;) {
            if (tid == 0) qw[0] = (int)atomicAdd(ctl + CW_CQ, 1u);
            __syncthreads();
            const int tl = qw[0];
            if (tl >= NTOK / 32) break;
            conv_tile(P, lds, tl, tid, wave, lane);
        }
    }
    SYNC(2);
    if (IN(3)) {
        pg8::DenseSched S; S.init((const bf16_t*)(ws + WS_MIX), (const bf16_t*)(ws + WS_WOUT), NTOK, 1024, 1024, G, bx);
        EpiOutProj E{P.x, (float*)(ws + WS_H1), (unsigned char*)(ws + WS_H1F8)};
        pg8::gemm_phase<EpiOutProj, pg8::DenseSched, false, false, true>(lds, S, E);
    }
    SYNC(3);
    if (IN(4)) { FRESH_LANE(lane); router_phase(P, lds, vcu, G, tid, wave, lane); }
    SYNC(4);
    if (IN(5) || IN(6)) {
        LAS int* tb = (LAS int*)(lds + LDS_MISC); LAS int* cn = tb + 64;
        if (tid < NE) cn[tid] = (int)__hip_atomic_load((const unsigned*)(ws + WS_CTL) + CW_CNT + 64 * tid, __ATOMIC_RELAXED, __HIP_MEMORY_SCOPE_AGENT);
        __syncthreads();
        if (tid == 0) { int acc = 0;
            for (int e = 0; e < NE; ++e) { tb[e] = acc; acc += (cn[e] + BM - 1) / BM; }
            tb[NE] = acc; }
        __syncthreads();
        if (IN(5)) {
            pg8::MoeSched S; S.A = ws + WS_H1F8; S.Bt = ws + WS_WUP; S.rp = 1024; S.b_estride = (size_t)2048 * 1024; S.tb = tb; S.cnt = cn; S.list = (const int*)(ws + WS_LIST);
            S.nN = 8; S.nwg = tb[NE] * 8; S.G = G; S.c = bx; S.gather = true;
            { LAS int* ut = (LAS int*)(lds + LDS_MISC + 512); S.utab = ut; S.build_table(ut, tid); __syncthreads(); }
            S.m_scale = (const float*)(ws + WS_LSCALE); S.m_gate = nullptr; S.m_bias = P.b_up;
            EpiUp E{(unsigned char*)(ws + WS_ACT)};
            pg8::gemm_phase<EpiUp, pg8::MoeSched, true, true, true>(lds, S, E);
        }
        SYNC(5);
        if (IN(6)) {
            pg8::MoeSched S; S.A = ws + WS_ACT; S.Bt = ws + WS_WDOWN; S.rp = 1024; S.b_estride = (size_t)1024 * 1024; S.tb = tb; S.cnt = cn; S.list = (const int*)(ws + WS_LIST);
            S.nN = 4; S.nwg = tb[NE] * 4; S.G = G; S.c = bx; S.gather = false;
            { LAS int* ut = (LAS int*)(lds + LDS_MISC + 512); S.utab = ut; S.build_table(ut, tid); __syncthreads(); }
            S.m_scale = nullptr; S.m_gate = (const float*)(ws + WS_LGATE); S.m_bias = P.b_down;
            EpiDown E{(unsigned char*)(ws + WS_Y)};
            pg8::gemm_phase<EpiDown, pg8::MoeSched, true, true, true>(lds, S, E);
        }
    }
    SYNC(6);
    {
        const bool fused = (G == 256) && IN(7) && IN(8) && IN(9);
        const int j8 = bx >> 3, pm = (bx & 7) * 16 + (j8 >> 1), half = j8 & 1, r0 = pm * BM + half * 128;
        unsigned* ctl = (unsigned*)(ws + WS_CTL); unsigned* tmo = ctl + CW_BAR + XB_TMO;
        const bool same_xcd = fused && (xb_ld(ctl + CW_XCC + (bx ^ 8)) == xbar.x + 1u);
        if (IN(7)) { FRESH_LANE(l7);
            if (fused) combine_phase(P, r0 + wave, r0 + 128, NWAVES, l7); else combine_phase(P, vcu * NWAVES + wave, NTOK, NGW, l7); }
        if (fused) pair_sync(ctl + CW_PAIR + 16 * (2 * pm), tmo, same_xcd); else SYNC(7);
        if (IN(8)) {
            pg8::DenseSched S; S.init(ws + WS_H1F8, ws + WS_WG, NTOK, 1024, 1024, G, bx); S.rp = 1024; S.idg = true;
            if (fused) { S.pair_pm = pm; S.pair_pn0 = 2 * half; }
            EpiF8Plain E{(unsigned char*)(ws + WS_G), 1024, 0.03125f};
            pg8::gemm_phase<EpiF8Plain, pg8::DenseSched, true, true>(lds, S, E);
        }
        if (fused) pair_sync(ctl + CW_PAIR + 16 * (2 * pm + 1), tmo, same_xcd); else SYNC(8);
        if (IN(9)) { FRESH_LANE(l9);
            if (fused) final_phase(P, r0 + wave, r0 + 128, NWAVES, l9); else final_phase(P, vcu * NWAVES + wave, NTOK, NGW, l9); }
    }
#undef IN
#undef SYNC
}

#ifndef N_LAUNCH_MODE
#define N_LAUNCH_MODE 1
#endif
extern "C" void kernel_launch(void* const* d_in, const int* in_sizes, int n_in, void* d_out, int out_size, void* d_ws, size_t ws_size, hipStream_t stream) {
    static int grid = 0;
    if (grid == 0) {
        if (n_in != 21 || out_size != NTOK * DM || ws_size < WS_END) { fprintf(stderr, "kernel_launch: unexpected shapes (n_in %d out %d ws %zu)\n", n_in, out_size, ws_size); grid = -1; return; }
        int dev = 0, cus = 0, per_cu = 0;
        (void)hipGetDevice(&dev); (void)hipDeviceGetAttribute(&cus, hipDeviceAttributeMultiprocessorCount, dev);
        (void)hipFuncSetAttribute((const void*)fwd_kernel, hipFuncAttributeMaxDynamicSharedMemorySize, LDS_BYTES);
        if (hipOccupancyMaxActiveBlocksPerMultiprocessor(&per_cu, (const void*)fwd_kernel, NTHR, LDS_BYTES) != hipSuccess || per_cu < 1) { fprintf(stderr, "kernel_launch: occupancy query failed (%d)\n", per_cu); (void)hipGetLastError(); grid = -1; return; }
        grid = cus;
    }
    if (grid < 0) return;
    (void)hipMemsetAsync((char*)d_ws + WS_CTL, 0, CTL_BYTES, stream);
    Params p{};
    p.x = (const float*)d_in[0]; p.p = (const float*)d_in[1]; p.w_in = (const float*)d_in[2]; p.w_out = (const float*)d_in[3]; p.g_mix = (const float*)d_in[4]; p.g_ffn = (const float*)d_in[5];
    p.glu_b = (const float*)d_in[6]; p.dw_w = (const float*)d_in[7]; p.dw_b = (const float*)d_in[8]; p.ln_g = (const float*)d_in[9]; p.ln_b = (const float*)d_in[10];
    p.w_router = (const float*)d_in[11]; p.b_router = (const float*)d_in[12]; p.w_up = (const float*)d_in[13]; p.b_up = (const float*)d_in[14]; p.w_down = (const float*)d_in[15]; p.b_down = (const float*)d_in[16];
    p.w_ple_proj = (const float*)d_in[17]; p.w_ple_gate = (const float*)d_in[18]; p.g_ple = (const float*)d_in[19]; p.g_final = (const float*)d_in[20];
    p.out = (float*)d_out; p.ws = (unsigned char*)d_ws;
#if N_LAUNCH_MODE == 1
    p.ph_lo = 0; p.ph_hi = NPHASE;
    void* args[] = {&p};
    hipError_t e = hipLaunchCooperativeKernel((const void*)fwd_kernel, dim3(grid), dim3(NTHR), args, LDS_BYTES, stream);
    if (e != hipSuccess) fprintf(stderr, "cooperative launch failed: %s (grid %d)\n", hipGetErrorString(e), grid);
#else
    for (int ph = 0; ph < NPHASE; ++ph) {
        p.ph_lo = ph; p.ph_hi = ph + 1;
        void* args[] = {&p};
        hipError_t e = hipLaunchCooperativeKernel((const void*)fwd_kernel, dim3(grid), dim3(NTHR), args, LDS_BYTES, stream);
        if (e != hipSuccess) { fprintf(stderr, "launch %d failed: %s (grid %d)\n", ph, hipGetErrorString(e), grid); break; }
    }
#endif
}
```

```cpp
#include <hip/hip_runtime.h>
#include <hip/hip_cooperative_groups.h>
#include <cstdio>
#include <cstdint>
namespace cg = cooperative_groups;

#define LAS __attribute__((address_space(3)))
#define GAS __attribute__((address_space(1)))
typedef unsigned short bf16_t;
typedef short bf16x8 __attribute__((ext_vector_type(8)));
typedef short s16x4 __attribute__((ext_vector_type(4)));
typedef float f32x4 __attribute__((ext_vector_type(4)));
typedef float f32x2 __attribute__((ext_vector_type(2)));
typedef float f32x16 __attribute__((ext_vector_type(16)));
typedef unsigned u32x4 __attribute__((ext_vector_type(4)));
typedef unsigned u32x2 __attribute__((ext_vector_type(2)));

constexpr int NB = 8, SEQ = 4096, DM = 1024, NTOK = NB * SEQ;
constexpr int NE = 32, TOPK = 4, NSLOT = NTOK * TOPK;
constexpr int INW = 1988;
constexpr int NSEL = 256;
constexpr float EPS = 1e-6f;
constexpr int NWAVES = 8, NTHR = 512;

constexpr size_t MiB = 1u << 20;
constexpr size_t WS_CTL = 0, CTL_BYTES = 64 * 1024;
constexpr size_t WS_ROPE = 1 * MiB;
constexpr size_t WS_WIN = 2 * MiB;
constexpr size_t WS_WOUT = 6 * MiB;
constexpr size_t WS_WG = 8 * MiB;
constexpr size_t WS_WP = 10 * MiB;
constexpr size_t WS_WRG = 10 * MiB + 512 * 1024;
constexpr size_t WS_RS1 = 11 * MiB;
constexpr size_t WS_RS3 = 11 * MiB + 512 * 1024;
constexpr size_t WS_WI = 12 * MiB;
constexpr size_t WS_LIST = 13 * MiB;
constexpr size_t WS_LSCALE = 17 * MiB;
constexpr size_t WS_LGATE = 21 * MiB;
constexpr size_t WS_PB = 25 * MiB;
constexpr size_t WS_WUP = 42 * MiB;
constexpr size_t WS_WDOWN = 170 * MiB;
constexpr size_t WS_H1 = 234 * MiB;
constexpr size_t WS_H1B = 362 * MiB;
constexpr size_t WS_PJ = 426 * MiB;
constexpr size_t WS_XB = 490 * MiB;
constexpr size_t WS_Q = 554 * MiB;
constexpr size_t WS_K = 586 * MiB;
constexpr size_t WS_V = 590 * MiB;
constexpr size_t WS_QI = 594 * MiB;
constexpr size_t WS_KI = 610 * MiB;
constexpr size_t WS_HGLU = 614 * MiB;
constexpr size_t WS_MIX = 646 * MiB;
constexpr size_t WS_H1F8 = 298 * MiB;
constexpr size_t WS_ACT = 522 * MiB;
constexpr size_t WS_Y = 762 * MiB;
constexpr size_t WS_G = 762 * MiB;
constexpr size_t WS_END = 1018 * MiB;
static_assert(WS_H1F8 + (size_t)NTOK * 1024 <= WS_ACT && WS_ACT + (size_t)139264 * 1024 <= WS_Y, "ws map");
constexpr int CW_CNT = 1024;
constexpr int CW_AQ = 4096;
constexpr int CW_CQ = 4096 + 64 * 8;
constexpr int CW_BAR = 8192;
constexpr int CW_XCC = 7168;
constexpr int CW_PAIR = 12288;

constexpr int LDS_STAGE = 131072;
constexpr int LDS_MISC = LDS_STAGE;
constexpr int LDS_META = LDS_MISC + 4096;
constexpr int LDS_XB = 147456;
constexpr int LDS_BYTES = 147456 + 256;

__device__ __forceinline__ unsigned f2bf(float f) { unsigned u = __builtin_bit_cast(unsigned, f); return (u + 0x7fffu + ((u >> 16) & 1u)) >> 16; }
__device__ __forceinline__ unsigned pk2(float lo, float hi) { return f2bf(lo) | (f2bf(hi) << 16); }
__device__ __forceinline__ float bf_lo(unsigned w) { return __builtin_bit_cast(float, w << 16); }
__device__ __forceinline__ float bf_hi(unsigned w) { return __builtin_bit_cast(float, w & 0xffff0000u); }
__device__ __forceinline__ float wave_sum(float v) {
    v += __builtin_bit_cast(float, __builtin_amdgcn_update_dpp(0, __builtin_bit_cast(int, v), 0xB1, 0xF, 0xF, true));
    v += __builtin_bit_cast(float, __builtin_amdgcn_update_dpp(0, __builtin_bit_cast(int, v), 0x4E, 0xF, 0xF, true));
    v += __builtin_bit_cast(float, __builtin_amdgcn_update_dpp(0, __builtin_bit_cast(int, v), 0x141, 0xF, 0xF, true));
    v += __builtin_bit_cast(float, __builtin_amdgcn_update_dpp(0, __builtin_bit_cast(int, v), 0x140, 0xF, 0xF, true));
    const int vi = __builtin_bit_cast(int, v);
    const float r0 = __builtin_bit_cast(float, __builtin_amdgcn_readlane(vi, 0)), r1 = __builtin_bit_cast(float, __builtin_amdgcn_readlane(vi, 16));
    const float r2 = __builtin_bit_cast(float, __builtin_amdgcn_readlane(vi, 32)), r3 = __builtin_bit_cast(float, __builtin_amdgcn_readlane(vi, 48));
    return (r0 + r1) + (r2 + r3);
}
__device__ __forceinline__ unsigned pk4_fp8(float a, float b, float c, float d) { int r = __builtin_amdgcn_cvt_pk_fp8_f32(a, b, 0, false); r = __builtin_amdgcn_cvt_pk_fp8_f32(c, d, r, true); return (unsigned)r; }
__device__ __forceinline__ float sigmoidf_(float x) { return __builtin_amdgcn_rcpf(1.0f + __builtin_amdgcn_exp2f(x * -1.4426950408889634f)); }
#define LDS_WAIT() asm volatile("s_waitcnt lgkmcnt(0)" ::: "memory")
#define NT_LD(p) __builtin_nontemporal_load(p)
#define NT_ST(v, p) __builtin_nontemporal_store(v, p)

struct Params {
    const float* x; const float* p; const float* w_in; const float* w_out; const float* g_mix; const float* g_ffn;
    const float* glu_b; const float* dw_w; const float* dw_b; const float* ln_g; const float* ln_b;
    const float* w_router; const float* b_router; const float* w_up; const float* b_up; const float* w_down; const float* b_down;
    const float* w_ple_proj; const float* w_ple_gate; const float* g_ple; const float* g_final;
    float* out; unsigned char* ws;
    int ph_lo, ph_hi;
};

namespace pg8 {
constexpr int BM = 256, BK = 64, HALF = 128, HTB = HALF * BK * 2, STAGE_BYTES = 8 * HTB, NXCD = 8, WGM = 8;
__host__ __device__ __forceinline__ int lds_byte(int r, int c) { const int st = (r >> 4) * 2 + (c >> 5), rr = r & 15, cc = c & 31, ob = rr * 64 + cc * 2; return st * 1024 + (ob ^ (((ob >> 9) & 1) << 5)); }
__host__ __device__ __forceinline__ void stage_rc(int b, int& R, int& C) { const int st = b / 1024, sb = b % 1024, swz = sb ^ (((sb >> 9) & 1) << 5); R = (st >> 1) * 16 + swz / 64; C = (st & 1) * 32 + (swz % 64) / 2; }
__host__ __device__ __forceinline__ int perm32(int rho) { const int n = rho >> 4, i = rho & 15; return 8 * (i >> 2) + 4 * n + (i & 3); }

struct Unit { int pm, pn, e, rows; };

__device__ __forceinline__ unsigned cvt_pk_bf16(float lo, float hi) { unsigned r; asm volatile("v_cvt_pk_bf16_f32 %0, %1, %2" : "=v"(r) : "v"(lo), "v"(hi)); return r; }

struct DenseSched {
    const void* A; const void* Bt; int rp;
    int nM, nN, nwg, G, c;
    __device__ void init(const void* A_, const void* Bt_, int M, int N, int K_, int G_, int c_) { A = A_; Bt = Bt_; rp = K_ * 2; nM = M / BM; nN = N / BM; nwg = nM * nN; G = G_; c = c_; }
    int pair_pm = -1, pair_pn0 = 0;
    __device__ bool next(int i, Unit& u) const {
        if (pair_pm >= 0) { if (i >= 2) return false; u.pm = pair_pm; u.pn = pair_pn0 + i; u.e = 0; u.rows = BM; return true; }
        const long L = (long)i * G + c; if (L >= nwg) return false;
        int wgid = (int)L; { const int q = nwg / NXCD, r = nwg % NXCD, xcd = wgid % NXCD, off = wgid / NXCD; wgid = (xcd < r ? xcd * (q + 1) : r * (q + 1) + (xcd - r) * q) + off; }
        const int nig = WGM * nN, gid = wgid / nig, fm = gid * WGM, gsz = (nM - fm) < WGM ? (nM - fm) : WGM;
        u.pm = fm + ((wgid % nig) % gsz); u.pn = (wgid % nig) / gsz; u.e = 0; u.rows = BM; return true;
    }
    bool idg = false;
    __device__ __forceinline__ const char* a_ptr(const Unit& u) const { return idg ? (const char*)A : (const char*)A + (size_t)u.pm * BM * rp; }
    __device__ __forceinline__ const char* b_ptr(const Unit& u) const { return (const char*)Bt + (size_t)u.pn * BM * rp; }
    __device__ __forceinline__ int a_row(const Unit& u, int r) const { return u.pm * BM + r; }
    __device__ __forceinline__ void meta(const Unit&, LAS unsigned char*, int, int) const {}
};

struct MoeSched {
    const void* A; const void* Bt; int rp; size_t b_estride;
    const LAS int* tb;
    const LAS int* cnt;
    const int* list;
    int nN, nwg, G, c; bool gather;
    const LAS int* utab;
    __device__ __forceinline__ bool next(int i, Unit& u) const {
        if (i >= 32) return false;
        const LAS int* p = utab + 4 * i; const int rows = p[3]; if (rows < 0) return false;
        u.pm = p[0]; u.pn = p[1]; u.e = p[2]; u.rows = rows; return true;
    }
    __device__ __forceinline__ void build_table(LAS int* tab, int tid) const {
        if (tid < 32) { Unit u; const bool ok = decode(tid, u); tab[4 * tid] = u.pm; tab[4 * tid + 1] = u.pn; tab[4 * tid + 2] = u.e; tab[4 * tid + 3] = ok ? u.rows : -1; }
    }
    __device__ __forceinline__ bool decode(int i, Unit& u) const {
        u.pm = 0; u.pn = 0; u.e = 0; u.rows = 0;
        const long L = (long)i * G + c; if (L >= nwg) return false;
        int wgid = (int)L; { const int q = nwg / NXCD, r = nwg % NXCD, xcd = wgid % NXCD, off = wgid / NXCD; wgid = (xcd < r ? xcd * (q + 1) : r * (q + 1) + (xcd - r) * q) + off; }
        int e = 0;
#pragma unroll 1
        for (; e < NE - 1; ++e) { if (wgid < tb[e + 1] * nN) break; }
        const int local = wgid - tb[e] * nN, nM = tb[e + 1] - tb[e];
        const int nig = WGM * nN, gid = local / nig, fm = gid * WGM, gsz = (nM - fm) < WGM ? (nM - fm) : WGM;
        const int rt = fm + ((local % nig) % gsz);
        u.pm = tb[e] + rt; u.pn = (local % nig) / gsz; u.e = e;
        const int left = cnt[e] - rt * BM; u.rows = left < BM ? left : BM; return true;
    }
    __device__ __forceinline__ const char* a_ptr(const Unit& u) const { return (const char*)A; }
    __device__ __forceinline__ const char* b_ptr(const Unit& u) const { return (const char*)Bt + (size_t)u.e * b_estride + (size_t)u.pn * BM * rp; }
    __device__ __forceinline__ int a_row(const Unit& u, int r) const {
        if (!gather) return u.pm * BM + r;
        const int rt = u.pm - tb[u.e];
        return r < u.rows ? (list[u.e * NTOK + rt * BM + r] >> 2) : 0;
    }
    const float* m_scale; const float* m_gate; const float* m_bias;
    __device__ __forceinline__ void meta(const Unit& u, LAS unsigned char* tbl, int wid, int lane) const {
        const int rt = u.pm - tb[u.e]; const size_t li = (size_t)u.e * NTOK + rt * BM + (wid & 3) * 64 + lane;
        if (gather) {
            if (wid < 4) __builtin_amdgcn_global_load_lds((const unsigned*)(m_scale + li), (LAS unsigned*)(tbl + (wid & 3) * 256), 4, 0, 0);
            else { const int j = (wid & 3) * 64 + lane; const float* src = m_bias + (size_t)u.e * 2048 + (j < 128 ? 128 * u.pn + j : 1024 + 128 * u.pn + (j - 128));
                __builtin_amdgcn_global_load_lds((const unsigned*)src, (LAS unsigned*)(tbl + 2048 + (wid & 3) * 256), 4, 0, 0); }
        } else {
            if (wid < 4) { __builtin_amdgcn_global_load_lds((const unsigned*)(list + li), (LAS unsigned*)(tbl + (wid & 3) * 256), 4, 0, 0);
                __builtin_amdgcn_global_load_lds((const unsigned*)(m_bias + (size_t)u.e * 1024 + u.pn * BM + (wid & 3) * 64 + lane), (LAS unsigned*)(tbl + 2048 + (wid & 3) * 256), 4, 0, 0); }
            else __builtin_amdgcn_global_load_lds((const unsigned*)(m_gate + li), (LAS unsigned*)(tbl + 1024 + (wid & 3) * 256), 4, 0, 0);
        }
    }
};

typedef int v8i32 __attribute__((ext_vector_type(8)));
template <class Epi, class Sched, bool GATHER, bool F8 = false, bool WARMTRIP = false>
__device__ __forceinline__ void gemm_phase(LAS unsigned char* lds, const Sched& S, const Epi& E) {
    const int tid = threadIdx.x, wid = __builtin_amdgcn_readfirstlane(tid >> 6), lane = tid & 63, wr = wid >> 2, wc = wid & 3, fr = lane & 15, fq = lane >> 4;
    const int RP = S.rp, nt = RP / (BK * 2);
    unsigned voffA[2], voffB[2]; int RA[2], CA[2];
#pragma unroll
    for (int i = 0; i < 2; ++i) { int R, C; stage_rc(tid * 16 + i * 8192, R, C); const int Rb = Epi::PERM ? ((R & ~31) + perm32(R & 31)) : R;
        voffA[i] = (unsigned)(R * RP + C * 2); voffB[i] = (unsigned)(Rb * RP + C * 2); RA[i] = R; CA[i] = C; }
    const size_t kstep = (size_t)(BK * 2);
    const size_t hstep = (size_t)HALF * RP;
    const unsigned ldsw = (unsigned)wid * 1024u;
    const int aoff = lds_byte(wr * 64 + fr, fq * 8), boff = lds_byte(wc * 32 + fr, fq * 8);
    unsigned gC[2][2], gN[2][2];
#define PG8_SA(b, h) (((b) * 2 + (h)) * HTB)
#define PG8_SB(b, h) ((4 + (b) * 2 + (h)) * HTB)
#define PG8_STAGE(bufoff, gbase, voff) do { _Pragma("unroll") for (int _i = 0; _i < 2; ++_i) \
        __builtin_amdgcn_global_load_lds((const unsigned*)((const char*)(gbase) + (voff)[_i]), (LAS unsigned*)(lds + (bufoff) + ldsw + _i * 8192), 16, 0, 0); } while (0)
#define PG8_STAGE_A(bufoff, kp, h) do { if constexpr (GATHER) { PG8_STAGE(bufoff, kp, gC[h]); } else { PG8_STAGE(bufoff, (kp) + (h) * hstep, voffA); } } while (0)
#define PG8_LD16(p) (*(const LAS bf16x8*)(p))
#define PG8_CAT(lo, hi) __builtin_bit_cast(v8i32, __builtin_shufflevector(lo, hi, 0, 1, 2, 3, 4, 5, 6, 7, 8, 9, 10, 11, 12, 13, 14, 15))
#define PG8_LDA(dst, b, h) do { _Pragma("unroll") for (int m = 0; m < 4; ++m) { if constexpr (F8) { dst##8[m] = PG8_CAT(PG8_LD16(lds + PG8_SA(b, h) + aoff + m * 2048), PG8_LD16(lds + PG8_SA(b, h) + aoff + m * 2048 + 1024)); } \
        else { _Pragma("unroll") for (int k = 0; k < 2; ++k) dst[m][k] = PG8_LD16(lds + PG8_SA(b, h) + aoff + m * 2048 + k * 1024); } } } while (0)
#define PG8_LDB(dst, b, h) do { _Pragma("unroll") for (int n = 0; n < 2; ++n) { if constexpr (F8) { dst##8[n] = PG8_CAT(PG8_LD16(lds + PG8_SB(b, h) + boff + n * 2048), PG8_LD16(lds + PG8_SB(b, h) + boff + n * 2048 + 1024)); } \
        else { _Pragma("unroll") for (int k = 0; k < 2; ++k) dst[n][k] = PG8_LD16(lds + PG8_SB(b, h) + boff + n * 2048 + k * 1024); } } } while (0)
#define PG8_MMA(ai, bj, At, Bt) do { __builtin_amdgcn_s_setprio(1); _Pragma("unroll") for (int m = 0; m < 4; ++m) _Pragma("unroll") for (int n = 0; n < 2; ++n) { \
        if constexpr (F8) { acc[ai][bj][m][n] = __builtin_amdgcn_mfma_scale_f32_16x16x128_f8f6f4(Bt##8[n], At##8[m], acc[ai][bj][m][n], 0, 0, 0, 0x7f7f7f7f, 0, 0x7f7f7f7f); } \
        else { _Pragma("unroll") for (int k = 0; k < 2; ++k) acc[ai][bj][m][n] = __builtin_amdgcn_mfma_f32_16x16x32_bf16(Bt[n][k], At[m][k], acc[ai][bj][m][n], 0, 0, 0); } } \
        __builtin_amdgcn_s_setprio(0); } while (0)
#define PG8_WAIT_V(n) asm volatile("s_waitcnt vmcnt(" #n ")" ::: "memory")
#define PG8_WAIT_L(n) asm volatile("s_waitcnt lgkmcnt(" #n ")" ::: "memory")
#define PG8_BAR __builtin_amdgcn_s_barrier()
#define PG8_SCHED __builtin_amdgcn_sched_barrier(0)
#define PG8_GOFF(dst, u) do { _Pragma("unroll") for (int _h = 0; _h < 2; ++_h) _Pragma("unroll") for (int _i = 0; _i < 2; ++_i) \
        dst[_h][_i] = (unsigned)(S.a_row(u, _h * HALF + RA[_i]) * RP + CA[_i] * 2); } while (0)
    Unit cur, nxt, nn; int ui = 0;
    if (!S.next(0, cur)) return;
    bool has_next = S.next(1, nxt);
    if constexpr (GATHER) { PG8_GOFF(gC, cur); if (has_next) { PG8_GOFF(gN, nxt); } else { PG8_GOFF(gN, cur); } }
    f32x4 acc[2][2][4][2];
#pragma unroll
    for (int a = 0; a < 2; ++a)
#pragma unroll
        for (int b = 0; b < 2; ++b)
#pragma unroll
            for (int m = 0; m < 4; ++m)
#pragma unroll
                for (int n = 0; n < 2; ++n) acc[a][b][m][n] = (f32x4){0.f, 0.f, 0.f, 0.f};
    bf16x8 At[4][2], B0[2][2], B1[2][2]; v8i32 At8[4], B08[2], B18[2];
    const char* cA = S.a_ptr(cur); const char* cB = S.b_ptr(cur);
    PG8_STAGE(PG8_SB(0, 0), cB, voffB); PG8_STAGE(PG8_SB(0, 1), cB + hstep, voffB); PG8_STAGE_A(PG8_SA(0, 0), cA, 0); PG8_STAGE_A(PG8_SA(0, 1), cA, 1);
    if (wr == 1) PG8_BAR;
    PG8_WAIT_V(2); PG8_BAR;
    PG8_STAGE(PG8_SB(1, 0), cB + kstep, voffB); PG8_STAGE_A(PG8_SA(1, 0), cA + kstep, 0); PG8_STAGE(PG8_SB(1, 1), cB + hstep + kstep, voffB);
    PG8_WAIT_V(6); PG8_BAR;
    for (;;) {
        const char* nA = has_next ? S.a_ptr(nxt) : cA; const char* nB = has_next ? S.b_ptr(nxt) : cB;
        S.meta(cur, lds + (LDS_META - 0) + (ui & 1) * 4096, wid, lane);
#define PG8_TRIP(WARM, t) do { \
            const bool last = ((t) == nt - 2); \
            const char* a1 = cA + (size_t)((t) + 1) * kstep; \
            const char* a2 = last ? nA : cA + (size_t)((t) + 2) * kstep; const char* b2 = last ? nB : cB + (size_t)((t) + 2) * kstep; \
            const char* a3 = a2 + kstep; const char* b3 = b2 + kstep; \
              \
            PG8_LDB(B0, 0, 0); PG8_LDB(B1, 0, 1); PG8_SCHED; PG8_LDA(At, 0, 0); if constexpr (!(WARM)) { PG8_STAGE_A(PG8_SA(1, 1), a1, 1); } \
            if constexpr (GATHER) { if (last) { _Pragma("unroll") for (int h = 0; h < 2; ++h) _Pragma("unroll") for (int i = 0; i < 2; ++i) gC[h][i] = gN[h][i]; } } \
            if constexpr (!(WARM)) { PG8_WAIT_V(8); } PG8_WAIT_L(0); PG8_BAR; PG8_MMA(0, 0, At, B0); PG8_MMA(0, 1, At, B1); PG8_BAR; PG8_SCHED; \
              \
            PG8_LDA(At, 0, 1); PG8_STAGE(PG8_SB(0, 0), b2, voffB); PG8_STAGE(PG8_SB(0, 1), b2 + hstep, voffB); PG8_STAGE_A(PG8_SA(0, 0), a2, 0); \
            if constexpr (!(WARM)) { PG8_WAIT_V(8); } PG8_WAIT_L(0); PG8_BAR; PG8_MMA(1, 0, At, B0); PG8_MMA(1, 1, At, B1); PG8_BAR; PG8_SCHED; \
              \
            PG8_LDB(B0, 1, 0); PG8_LDB(B1, 1, 1); PG8_SCHED; PG8_LDA(At, 1, 0); PG8_STAGE_A(PG8_SA(0, 1), a2, 1); \
            if constexpr (!(WARM)) { PG8_WAIT_V(8); } PG8_WAIT_L(0); PG8_BAR; PG8_MMA(0, 0, At, B0); PG8_MMA(0, 1, At, B1); PG8_BAR; PG8_SCHED; \
              \
            PG8_LDA(At, 1, 1); PG8_STAGE(PG8_SB(1, 0), b3, voffB); PG8_STAGE(PG8_SB(1, 1), b3 + hstep, voffB); PG8_STAGE_A(PG8_SA(1, 0), a3, 0); \
            PG8_WAIT_V(8); PG8_WAIT_L(0); PG8_BAR; PG8_MMA(1, 0, At, B0); PG8_MMA(1, 1, At, B1); PG8_BAR; PG8_SCHED; \
        } while (0)
        int t0_ = 0;
        if constexpr (WARMTRIP) { if (ui > 0) { PG8_TRIP(true, 0); t0_ = 2; } }
        for (int t = t0_; t < nt; t += 2) { PG8_TRIP(false, t); }
#undef PG8_TRIP
        if (wr == 0) PG8_BAR;
        if constexpr (WARMTRIP) { PG8_STAGE_A(PG8_SA(1, 1), nA + kstep, 1); }
        bool has_nn = false;
        if constexpr (GATHER) { if (has_next) { has_nn = S.next(ui + 2, nn); if (has_nn) { PG8_GOFF(gN, nn); } } }
        else { if (has_next) has_nn = S.next(ui + 2, nn); }
        { int ln_; asm volatile("v_mbcnt_lo_u32_b32 %0, -1, 0\n\tv_mbcnt_hi_u32_b32 %0, -1, %0" : "=v"(ln_)); const int fr_ = ln_ & 15, fq_ = ln_ >> 4;
          const LAS unsigned char* mt = lds + LDS_META + (ui & 1) * 4096;
          if constexpr (WARMTRIP) {
              E.pre(acc, cur, wr, wc, fr_, fq_, mt);
              if constexpr (GATHER) asm volatile("" : "+v"(gN[0][0]), "+v"(gN[0][1]), "+v"(gN[1][0]), "+v"(gN[1][1]));
              PG8_WAIT_V(0);
              E.post(acc, cur, wr, wc, fr_, fq_, mt);
          } else { E.run(acc, cur, wr, wc, fr_, fq_, mt); } }
        if (!has_next) break;
#pragma unroll
        for (int a = 0; a < 2; ++a)
#pragma unroll
            for (int b = 0; b < 2; ++b)
#pragma unroll
                for (int m = 0; m < 4; ++m)
#pragma unroll
                    for (int n = 0; n < 2; ++n) acc[a][b][m][n] = (f32x4){0.f, 0.f, 0.f, 0.f};
        cur = nxt; cA = nA; cB = nB; ++ui; nxt = nn; has_next = has_nn;
        if (wr == 1) PG8_BAR;
    }
    PG8_WAIT_V(0);
    PG8_BAR;
#undef PG8_SA
#undef PG8_SB
#undef PG8_STAGE
#undef PG8_STAGE_A
#undef PG8_LDA
#undef PG8_LDB
#undef PG8_MMA
#undef PG8_LD16
#undef PG8_CAT
#undef PG8_WAIT_V
#undef PG8_WAIT_L
#undef PG8_BAR
#undef PG8_SCHED
#undef PG8_GOFF
}
}

using pg8::Unit; using pg8::cvt_pk_bf16;
constexpr int BM = 256, HALF = 128;

typedef f32x4 (&AccRef)[2][2][4][2];
__device__ __forceinline__ void pack8_bf16(f32x4& lo, const f32x4& hi) {
    const unsigned w0 = cvt_pk_bf16(lo[0], lo[1]), w1 = cvt_pk_bf16(lo[2], lo[3]), w2 = cvt_pk_bf16(hi[0], hi[1]), w3 = cvt_pk_bf16(hi[2], hi[3]);
    lo[0] = __builtin_bit_cast(float, w0); lo[1] = __builtin_bit_cast(float, w1); lo[2] = __builtin_bit_cast(float, w2); lo[3] = __builtin_bit_cast(float, w3);
}
#define AS_U4(v) __builtin_bit_cast(u32x4, v)

struct EpiInProj {
    static constexpr bool PERM = true;
    const float* rs1; const f32x2* rope; const float* glu_b;
    bf16_t *q, *k, *v, *qi, *ki, *hglu; float* wi;
    __device__ __forceinline__ void pre(AccRef acc, const Unit& u, int wr, int wc, int fr, int fq, const LAS unsigned char* mt) const {
        const int row0 = u.pm * BM + wr * 64 + fr;
        if (u.pn >= 4) {
            const int ch = 128 * (u.pn - 4) + 32 * wc + 8 * fq;
            f32x4 ba[2], bg[2];
#pragma unroll
            for (int n = 0; n < 2; ++n) { ba[n] = *(const f32x4*)(glu_b + ch + 4 * n); bg[n] = *(const f32x4*)(glu_b + 512 + ch + 4 * n); }
#pragma unroll
            for (int ai = 0; ai < 2; ++ai)
#pragma unroll
                for (int m = 0; m < 4; ++m) { const float rs = rs1[row0 + ai * HALF + m * 16];
#pragma unroll
                    for (int n = 0; n < 2; ++n)
#pragma unroll
                        for (int e = 0; e < 4; ++e) { const float a = acc[ai][0][m][n][e] * rs + ba[n][e], g = acc[ai][1][m][n][e] * rs + bg[n][e]; acc[ai][0][m][n][e] = a * sigmoidf_(g); }
                    pack8_bf16(acc[ai][0][m][0], acc[ai][0][m][1]); }
            return;
        }
        const bool do_rope = !(u.pn == 3 && wc >= 2), is_wi = (u.pn == 3 && wc == 3);
        const int d0 = 8 * fq;
#pragma unroll
        for (int ai = 0; ai < 2; ++ai)
#pragma unroll
            for (int m = 0; m < 4; ++m) { const int row = row0 + ai * HALF + m * 16; const float rs = rs1[row];
                if (do_rope) {
                    const f32x2* rp = rope + (size_t)(row & (SEQ - 1)) * 32 + d0;
#pragma unroll
                    for (int n = 0; n < 2; ++n)
#pragma unroll
                        for (int e = 0; e < 4; ++e) { const f32x2 cs = rp[4 * n + e]; const float x1 = acc[ai][0][m][n][e] * rs, x2 = acc[ai][1][m][n][e] * rs;
                            acc[ai][0][m][n][e] = x1 * cs.x - x2 * cs.y; acc[ai][1][m][n][e] = x2 * cs.x + x1 * cs.y; }
                } else {
#pragma unroll
                    for (int n = 0; n < 2; ++n) { acc[ai][0][m][n] = acc[ai][0][m][n] * rs; acc[ai][1][m][n] = acc[ai][1][m][n] * rs; }
                }
                if (!is_wi) { pack8_bf16(acc[ai][0][m][0], acc[ai][0][m][1]); pack8_bf16(acc[ai][1][m][0], acc[ai][1][m][1]); }
                if (m & 1) __builtin_amdgcn_sched_barrier(0); }
    }
    __device__ __forceinline__ void post(AccRef acc, const Unit& u, int wr, int wc, int fr, int fq, const LAS unsigned char* mt) const {
        const int row0 = u.pm * BM + wr * 64 + fr;
        if (u.pn >= 4) {
            const int ch = 128 * (u.pn - 4) + 32 * wc + 8 * fq;
#pragma unroll
            for (int ai = 0; ai < 2; ++ai)
#pragma unroll
                for (int m = 0; m < 4; ++m) *(u32x4*)(hglu + (size_t)(row0 + ai * HALF + m * 16) * 512 + ch) = AS_U4(acc[ai][0][m][0]);
            return;
        }
        bf16_t* dst; int ld, col; bool is_wi = false;
        if (u.pn < 2) { dst = q; ld = 512; col = (4 * u.pn + wc) * 64; }
        else if (u.pn == 2) { dst = qi; ld = 256; col = wc * 64; }
        else { ld = 64; col = 0; if (wc == 0) dst = k; else if (wc == 1) dst = ki; else if (wc == 2) dst = v; else { dst = v; is_wi = true; } }
        if (is_wi) {
            if (fq == 0) {
#pragma unroll
                for (int ai = 0; ai < 2; ++ai)
#pragma unroll
                    for (int m = 0; m < 4; ++m) *(f32x4*)(wi + (size_t)(row0 + ai * HALF + m * 16) * 4) = acc[ai][0][m][0];
            }
            return;
        }
#pragma unroll
        for (int ai = 0; ai < 2; ++ai)
#pragma unroll
            for (int m = 0; m < 4; ++m) { bf16_t* rp2 = dst + (size_t)(row0 + ai * HALF + m * 16) * ld + col + 8 * fq;
                *(u32x4*)(rp2) = AS_U4(acc[ai][0][m][0]); *(u32x4*)(rp2 + 32) = AS_U4(acc[ai][1][m][0]); }
    }
    __device__ __forceinline__ void run(const f32x4 (&acc)[2][2][4][2], const Unit& u, int wr, int wc, int fr, int fq, const LAS unsigned char* mt) const {
        const int row0 = u.pm * BM + wr * 64 + fr;
        if (u.pn >= 4) {
            const int ch = 128 * (u.pn - 4) + 32 * wc + 8 * fq;
            f32x4 ba[2], bg[2];
#pragma unroll
            for (int n = 0; n < 2; ++n) { ba[n] = *(const f32x4*)(glu_b + ch + 4 * n); bg[n] = *(const f32x4*)(glu_b + 512 + ch + 4 * n); }
#pragma unroll
            for (int ai = 0; ai < 2; ++ai)
#pragma unroll
                for (int m = 0; m < 4; ++m) { const int row = row0 + ai * HALF + m * 16; const float rs = rs1[row];
                    float o[8];
#pragma unroll
                    for (int n = 0; n < 2; ++n)
#pragma unroll
                        for (int e = 0; e < 4; ++e) { const float a = acc[ai][0][m][n][e] * rs + ba[n][e], g = acc[ai][1][m][n][e] * rs + bg[n][e]; o[4 * n + e] = a * sigmoidf_(g); }
                    u32x4 w; w.x = cvt_pk_bf16(o[0], o[1]); w.y = cvt_pk_bf16(o[2], o[3]); w.z = cvt_pk_bf16(o[4], o[5]); w.w = cvt_pk_bf16(o[6], o[7]);
                    *(u32x4*)(hglu + (size_t)row * 512 + ch) = w; }
            return;
        }
        bf16_t* dst; int ld, col; bool do_rope = true, is_wi = false;
        if (u.pn < 2) { dst = q; ld = 512; col = (4 * u.pn + wc) * 64; }
        else if (u.pn == 2) { dst = qi; ld = 256; col = wc * 64; }
        else { ld = 64; col = 0; if (wc == 0) dst = k; else if (wc == 1) dst = ki; else if (wc == 2) { dst = v; do_rope = false; } else { dst = v; is_wi = true; do_rope = false; } }
        if (is_wi) {
            if (fq == 0) {
#pragma unroll
                for (int ai = 0; ai < 2; ++ai)
#pragma unroll
                    for (int m = 0; m < 4; ++m) { const int row = row0 + ai * HALF + m * 16; const float rs = rs1[row];
                        *(f32x4*)(wi + (size_t)row * 4) = acc[ai][0][m][0] * rs; }
            }
            return;
        }
        const int d0 = 8 * fq;
#pragma unroll
        for (int ai = 0; ai < 2; ++ai)
#pragma unroll
            for (int m = 0; m < 4; ++m) { const int row = row0 + ai * HALF + m * 16; const float rs = rs1[row];
                float o1[8], o2[8];
                if (do_rope) {
                    const f32x4* rp = (const f32x4*)(rope + (size_t)(row & (SEQ - 1)) * 32 + d0);
#pragma unroll
                    for (int n = 0; n < 2; ++n)
#pragma unroll
                        for (int e2 = 0; e2 < 2; ++e2) { const f32x4 cs = rp[2 * n + e2];
                            { const float x1 = acc[ai][0][m][n][2 * e2] * rs, x2 = acc[ai][1][m][n][2 * e2] * rs; o1[4 * n + 2 * e2] = x1 * cs.x - x2 * cs.y; o2[4 * n + 2 * e2] = x2 * cs.x + x1 * cs.y; }
                            { const float x1 = acc[ai][0][m][n][2 * e2 + 1] * rs, x2 = acc[ai][1][m][n][2 * e2 + 1] * rs; o1[4 * n + 2 * e2 + 1] = x1 * cs.z - x2 * cs.w; o2[4 * n + 2 * e2 + 1] = x2 * cs.z + x1 * cs.w; } }
                } else {
#pragma unroll
                    for (int n = 0; n < 2; ++n)
#pragma unroll
                        for (int e = 0; e < 4; ++e) { o1[4 * n + e] = acc[ai][0][m][n][e] * rs; o2[4 * n + e] = acc[ai][1][m][n][e] * rs; }
                }
                u32x4 w1, w2; w1.x = cvt_pk_bf16(o1[0], o1[1]); w1.y = cvt_pk_bf16(o1[2], o1[3]); w1.z = cvt_pk_bf16(o1[4], o1[5]); w1.w = cvt_pk_bf16(o1[6], o1[7]);
                w2.x = cvt_pk_bf16(o2[0], o2[1]); w2.y = cvt_pk_bf16(o2[2], o2[3]); w2.z = cvt_pk_bf16(o2[4], o2[5]); w2.w = cvt_pk_bf16(o2[6], o2[7]);
                if (u.pn == 3 && wc == 1) {
                    bf16_t* tp = ki + ((size_t)(row >> 5) * 256 + (row & 31) + 32 * (fq & 1)) * 8;
                    *(u32x4*)(tp + (size_t)(fq >> 1) * 512) = w1; *(u32x4*)(tp + (size_t)(2 + (fq >> 1)) * 512) = w2;
                } else {
                    bf16_t* rp2 = dst + (size_t)row * ld + col + d0;
                    *(u32x4*)(rp2) = w1; *(u32x4*)(rp2 + 32) = w2; } }
    }
};

struct EpiBf16Plain {
    static constexpr bool PERM = true;
    bf16_t* O; int ldc; float scale;
    __device__ __forceinline__ void pre(AccRef acc, const Unit&, int, int, int, int, const LAS unsigned char*) const {
#pragma unroll
        for (int ai = 0; ai < 2; ++ai)
#pragma unroll
            for (int bj = 0; bj < 2; ++bj)
#pragma unroll
                for (int m = 0; m < 4; ++m) { acc[ai][bj][m][0] = acc[ai][bj][m][0] * scale; acc[ai][bj][m][1] = acc[ai][bj][m][1] * scale; pack8_bf16(acc[ai][bj][m][0], acc[ai][bj][m][1]); }
    }
    __device__ __forceinline__ void post(AccRef acc, const Unit& u, int wr, int wc, int fr, int fq, const LAS unsigned char* mt) const {
        const int row0 = u.pm * BM + wr * 64 + fr, col0 = u.pn * BM + wc * 32 + 8 * fq;
#pragma unroll
        for (int ai = 0; ai < 2; ++ai)
#pragma unroll
            for (int m = 0; m < 4; ++m) { bf16_t* rowp = O + (size_t)(row0 + ai * HALF + m * 16) * ldc + col0;
#pragma unroll
                for (int bj = 0; bj < 2; ++bj) *(u32x4*)(rowp + bj * HALF) = AS_U4(acc[ai][bj][m][0]); }
    }
    __device__ __forceinline__ void run(const f32x4 (&acc)[2][2][4][2], const Unit& u, int wr, int wc, int fr, int fq, const LAS unsigned char* mt) const {
        const int row0 = u.pm * BM + wr * 64 + fr, col0 = u.pn * BM + wc * 32 + 8 * fq;
#pragma unroll
        for (int ai = 0; ai < 2; ++ai)
#pragma unroll
            for (int m = 0; m < 4; ++m) { bf16_t* rowp = O + (size_t)(row0 + ai * HALF + m * 16) * ldc + col0;
#pragma unroll
                for (int bj = 0; bj < 2; ++bj) { const f32x4 v0 = acc[ai][bj][m][0] * scale, v1 = acc[ai][bj][m][1] * scale;
                    u32x4 w; w.x = cvt_pk_bf16(v0[0], v0[1]); w.y = cvt_pk_bf16(v0[2], v0[3]); w.z = cvt_pk_bf16(v1[0], v1[1]); w.w = cvt_pk_bf16(v1[2], v1[3]);
                    *(u32x4*)(rowp + bj * HALF) = w; } }
    }
};

struct EpiF8Plain {
    static constexpr bool PERM = true;
    unsigned char* O; int ldc; float scale;
    __device__ __forceinline__ void pre(AccRef acc, const Unit&, int, int, int, int, const LAS unsigned char*) const {}
    __device__ __forceinline__ void post(AccRef acc, const Unit& u, int wr, int wc, int fr, int fq, const LAS unsigned char* mt) const {
        const int row0 = u.pm * BM + wr * 64 + fr, col0 = u.pn * BM + wc * 32 + 8 * fq;
#pragma unroll
        for (int ai = 0; ai < 2; ++ai)
#pragma unroll
            for (int m = 0; m < 4; ++m) { unsigned char* rowp = O + (size_t)(row0 + ai * HALF + m * 16) * ldc + col0;
#pragma unroll
                for (int bj = 0; bj < 2; ++bj) { const f32x4 v0 = acc[ai][bj][m][0] * scale, v1 = acc[ai][bj][m][1] * scale;
                    u32x2 w; w.x = pk4_fp8(v0[0], v0[1], v0[2], v0[3]); w.y = pk4_fp8(v1[0], v1[1], v1[2], v1[3]);
                    *(u32x2*)(rowp + bj * HALF) = w; } }
    }
    __device__ __forceinline__ void run(AccRef acc, const Unit& u, int wr, int wc, int fr, int fq, const LAS unsigned char* mt) const { post(acc, u, wr, wc, fr, fq, mt); }
};

struct EpiOutProj {
    static constexpr bool PERM = false;
    const bf16_t* xb; bf16_t* h1; unsigned char* h1f8;
    __device__ __forceinline__ void pre(AccRef acc, const Unit& u, int wr, int wc, int fr, int fq, const LAS unsigned char* mt) const {
        const unsigned off0 = (unsigned)((u.pm * BM + wr * 64 + fr) * DM + u.pn * BM + wc * 32 + 8 * fq) * 2u;
        const unsigned char* xbb = (const unsigned char*)xb;
#pragma unroll
        for (int ai = 0; ai < 2; ++ai)
#pragma unroll
            for (int m = 0; m < 4; ++m) {
#pragma unroll
                for (int bj = 0; bj < 2; ++bj) { const u32x4 w = NT_LD((const u32x4*)(xbb + (off0 + (unsigned)(((ai * HALF + m * 16) * DM + bj * HALF) * 2))));
                    f32x4& v0 = acc[ai][bj][m][0]; f32x4& v1 = acc[ai][bj][m][1];
                    v0[0] += bf_lo(w.x); v0[1] += bf_hi(w.x); v0[2] += bf_lo(w.y); v0[3] += bf_hi(w.y);
                    v1[0] += bf_lo(w.z); v1[1] += bf_hi(w.z); v1[2] += bf_lo(w.w); v1[3] += bf_hi(w.w); }
                if (m & 1) __builtin_amdgcn_sched_barrier(0); }
    }
    __device__ __forceinline__ void post(AccRef acc, const Unit& u, int wr, int wc, int fr, int fq, const LAS unsigned char* mt) const {
        const unsigned off0 = (unsigned)((u.pm * BM + wr * 64 + fr) * DM + u.pn * BM + wc * 32 + 8 * fq);
        unsigned char* h1bb = (unsigned char*)h1;
#pragma unroll
        for (int ai = 0; ai < 2; ++ai)
#pragma unroll
            for (int m = 0; m < 4; ++m)
#pragma unroll
                for (int bj = 0; bj < 2; ++bj) { const unsigned o = off0 + (unsigned)((ai * HALF + m * 16) * DM + bj * HALF); const f32x4 v0 = acc[ai][bj][m][0], v1 = acc[ai][bj][m][1];
                    u32x4 w; w.x = cvt_pk_bf16(v0[0], v0[1]); w.y = cvt_pk_bf16(v0[2], v0[3]); w.z = cvt_pk_bf16(v1[0], v1[1]); w.w = cvt_pk_bf16(v1[2], v1[3]);
                    u32x2 q; q.x = pk4_fp8(v0[0], v0[1], v0[2], v0[3]); q.y = pk4_fp8(v1[0], v1[1], v1[2], v1[3]);
                    *(u32x4*)(h1bb + 2u * o) = w; *(u32x2*)(h1f8 + o) = q;
                    if (bj) __builtin_amdgcn_sched_barrier(0); }
    }
    __device__ __forceinline__ void run(AccRef acc, const Unit& u, int wr, int wc, int fr, int fq, const LAS unsigned char* mt) const { pre(acc, u, wr, wc, fr, fq, mt); post(acc, u, wr, wc, fr, fq, mt); }
};

struct EpiUp {
    static constexpr bool PERM = true;
    unsigned char* act;
    __device__ __forceinline__ void pre(AccRef acc, const Unit& u, int wr, int wc, int fr, int fq, const LAS unsigned char* mt) const {
        const int r0 = wr * 64 + fr, cl = 32 * wc + 8 * fq;
        const LAS float* rowA = (const LAS float*)mt; const LAS float* bias = (const LAS float*)(mt + 2048);
        f32x4 bg[2], bl[2];
#pragma unroll
        for (int n = 0; n < 2; ++n) { bg[n] = *(const LAS f32x4*)(bias + cl + 4 * n); bl[n] = *(const LAS f32x4*)(bias + 128 + cl + 4 * n); }
#pragma unroll
        for (int ai = 0; ai < 2; ++ai)
#pragma unroll
            for (int m = 0; m < 4; ++m) { const int r = r0 + ai * HALF + m * 16;
                const float rs = (r < u.rows) ? rowA[r] * 0.03125f : 0.f;
#pragma unroll
                for (int n = 0; n < 2; ++n)
#pragma unroll
                    for (int e = 0; e < 4; ++e) { float g = acc[ai][0][m][n][e] * rs + bg[n][e], l = acc[ai][1][m][n][e] * rs + bl[n][e];
                        g = fminf(g, 7.0f); l = fminf(fmaxf(l, -7.0f), 7.0f); acc[ai][0][m][n][e] = g * sigmoidf_(1.702f * g) * (l + 1.0f); } }
    }
    __device__ __forceinline__ void post(AccRef acc, const Unit& u, int wr, int wc, int fr, int fq, const LAS unsigned char* mt) const {
        const int r0 = wr * 64 + fr, ch = 128 * u.pn + 32 * wc + 8 * fq;
#pragma unroll
        for (int ai = 0; ai < 2; ++ai)
#pragma unroll
            for (int m = 0; m < 4; ++m) { const int r = r0 + ai * HALF + m * 16;
                const f32x4 v0 = acc[ai][0][m][0], v1 = acc[ai][0][m][1];
                u32x2 w; w.x = pk4_fp8(v0[0], v0[1], v0[2], v0[3]); w.y = pk4_fp8(v1[0], v1[1], v1[2], v1[3]);
                *(u32x2*)(act + (size_t)(u.pm * BM + r) * 1024 + ch) = w; }
    }
    __device__ __forceinline__ void run(const f32x4 (&acc)[2][2][4][2], const Unit& u, int wr, int wc, int fr, int fq, const LAS unsigned char* mt) const {
        const int r0 = wr * 64 + fr, cl = 32 * wc + 8 * fq, ch = 128 * u.pn + cl;
        const LAS float* rowA = (const LAS float*)mt; const LAS float* bias = (const LAS float*)(mt + 2048);
        f32x4 bg[2], bl[2];
#pragma unroll
        for (int n = 0; n < 2; ++n) { bg[n] = *(const LAS f32x4*)(bias + cl + 4 * n); bl[n] = *(const LAS f32x4*)(bias + 128 + cl + 4 * n); }
#pragma unroll
        for (int ai = 0; ai < 2; ++ai)
#pragma unroll
            for (int m = 0; m < 4; ++m) { const int r = r0 + ai * HALF + m * 16;
                const float rs = (r < u.rows) ? rowA[r] * 0.03125f : 0.f;
                float o[8];
#pragma unroll
                for (int n = 0; n < 2; ++n)
#pragma unroll
                    for (int e = 0; e < 4; ++e) { float g = acc[ai][0][m][n][e] * rs + bg[n][e], l = acc[ai][1][m][n][e] * rs + bl[n][e];
                        g = fminf(g, 7.0f); l = fminf(fmaxf(l, -7.0f), 7.0f); o[4 * n + e] = g * sigmoidf_(1.702f * g) * (l + 1.0f); }
                u32x2 w; w.x = pk4_fp8(o[0], o[1], o[2], o[3]); w.y = pk4_fp8(o[4], o[5], o[6], o[7]);
                *(u32x2*)(act + (size_t)(u.pm * BM + r) * 1024 + ch) = w; }
    }
};

struct EpiDown {
    static constexpr bool PERM = true;
    unsigned char* y;
    __device__ __forceinline__ void pre(AccRef acc, const Unit& u, int wr, int wc, int fr, int fq, const LAS unsigned char* mt) const {
        const int r0 = wr * 64 + fr, cl = wc * 32 + 8 * fq;
        const LAS float* gateT = (const LAS float*)(mt + 1024); const LAS float* bias = (const LAS float*)(mt + 2048);
        float gt[2][4];
#pragma unroll
        for (int ai = 0; ai < 2; ++ai)
#pragma unroll
            for (int m = 0; m < 4; ++m) gt[ai][m] = gateT[r0 + ai * HALF + m * 16] * 16.0f;
#pragma unroll
        for (int bj = 0; bj < 2; ++bj) { const f32x4 bv0 = *(const LAS f32x4*)(bias + cl + bj * HALF), bv1 = *(const LAS f32x4*)(bias + cl + bj * HALF + 4);
#pragma unroll
            for (int ai = 0; ai < 2; ++ai)
#pragma unroll
                for (int m = 0; m < 4; ++m) { acc[ai][bj][m][0] = (acc[ai][bj][m][0] * 0.03125f + bv0) * gt[ai][m]; acc[ai][bj][m][1] = (acc[ai][bj][m][1] * 0.03125f + bv1) * gt[ai][m]; } }
    }
    __device__ __forceinline__ void post(AccRef acc, const Unit& u, int wr, int wc, int fr, int fq, const LAS unsigned char* mt) const {
        const int r0 = wr * 64 + fr, col0 = u.pn * BM + wc * 32 + 8 * fq;
        const LAS int* slotT = (const LAS int*)mt;
#pragma unroll
        for (int ai = 0; ai < 2; ++ai)
#pragma unroll
            for (int m = 0; m < 4; ++m) { const int r = r0 + ai * HALF + m * 16;
                if (r < u.rows) { unsigned char* rowp = y + (size_t)slotT[r] * 1024 + col0;
#pragma unroll
                    for (int bj = 0; bj < 2; ++bj) { const f32x4 v0 = acc[ai][bj][m][0], v1 = acc[ai][bj][m][1];
                        u32x2 w; w.x = pk4_fp8(v0[0], v0[1], v0[2], v0[3]); w.y = pk4_fp8(v1[0], v1[1], v1[2], v1[3]);
                        *(u32x2*)(rowp + bj * HALF) = w; } } }
    }
    __device__ __forceinline__ void run(AccRef acc, const Unit& u, int wr, int wc, int fr, int fq, const LAS unsigned char* mt) const { pre(acc, u, wr, wc, fr, fq, mt); post(acc, u, wr, wc, fr, fq, mt); }
};

template <bool F8>
__device__ __forceinline__ void p0_transpose_item(const float* W, int ldw, void* WTv, int Kdim, const float* gain, LAS float* scr, int kb, int n0, int src0, int nvalid, int lane, bool prow = false) {
    bf16_t* WT = (bf16_t*)WTv;
    const int k0 = 64 * kb;
    f32x4 ld4[8];
#pragma unroll
    for (int i = 0; i < 8; ++i) { const int kk = 8 * i + (lane >> 3), j = (lane & 7) * 4;
        ld4[i] = (f32x4){0.f, 0.f, 0.f, 0.f}; if (j < nvalid) ld4[i] = NT_LD((const f32x4*)(W + (size_t)(k0 + kk) * ldw + src0 + j)); }
#pragma unroll
    for (int i = 0; i < 8; ++i) { const int kk = 8 * i + (lane >> 3), j = (lane & 7) * 4; const float gk = (gain ? gain[k0 + kk] : 1.0f) * (F8 ? 32.0f : 1.0f);
        LAS float* d = scr + kk * 33 + j; d[0] = ld4[i].x * gk; d[1] = ld4[i].y * gk; d[2] = ld4[i].z * gk; d[3] = ld4[i].w * gk; }
    LDS_WAIT(); asm volatile("" ::: "memory");
    const int c = lane & 7;
#pragma unroll
    for (int j = 0; j < 4; ++j) { const int nl = (lane >> 3) + 8 * j; const LAS float* s = scr + (8 * c) * 33 + nl;
        const int n = prow ? 16 * ((nl >> 2) & 1) + 4 * (nl >> 3) + (nl & 3) : nl;
        if constexpr (F8) { u32x2 o; o.x = pk4_fp8(s[0 * 33], s[1 * 33], s[2 * 33], s[3 * 33]); o.y = pk4_fp8(s[4 * 33], s[5 * 33], s[6 * 33], s[7 * 33]);
            *(u32x2*)((unsigned char*)WTv + (size_t)(n0 + n) * Kdim + k0 + 8 * c) = o; }
        else { u32x4 o; o.x = pk2(s[0 * 33], s[1 * 33]); o.y = pk2(s[2 * 33], s[3 * 33]); o.z = pk2(s[4 * 33], s[5 * 33]); o.w = pk2(s[6 * 33], s[7 * 33]);
            *(u32x4*)(WT + (size_t)(n0 + n) * Kdim + k0 + 8 * c) = o; } }
    LDS_WAIT(); asm volatile("" ::: "memory");
}
__device__ __forceinline__ void win_colmap(int nb, int& src0, int& nvalid) {
    const int pn = nb >> 3, j = (nb & 7) * 32, bj = j >> 7, slot = (j & 127) >> 5;
    nvalid = 32;
    if (pn < 2) src0 = (4 * pn + slot) * 64 + 32 * bj;
    else if (pn == 2) src0 = 640 + slot * 64 + 32 * bj;
    else if (pn == 3) { if (slot == 0) src0 = 512 + 32 * bj; else if (slot == 1) src0 = 896 + 32 * bj; else if (slot == 2) src0 = 576 + 32 * bj; else { src0 = 960; nvalid = bj == 0 ? 4 : 0; } }
    else src0 = 964 + 512 * bj + 128 * (pn - 4) + 32 * slot;
}
__device__ __forceinline__ void p0_prologue(const Params& P, LAS unsigned char* lds, int vcu, int G, int wave, int lane) {
    unsigned char* ws = P.ws;
    LAS float* scr = (LAS float*)(lds + wave * 16384);
    const int gw = vcu * NWAVES + wave, NGW = G * NWAVES;
    constexpr int I_IN = 16 * 64, I_OUT = 16 * 32, I_G = 16 * 32, I_P = 4 * 32;
    constexpr int NITEMS = I_IN + I_OUT + I_G + I_P;
    for (int it = gw; it < NITEMS; it += NGW) {
        int r = it;
        if (r < I_IN) { const int kb = r / 64, nb = r % 64; int s0, nv; win_colmap(nb, s0, nv); p0_transpose_item<false>(P.w_in, INW, (bf16_t*)(ws + WS_WIN), 1024, P.g_mix, scr, kb, nb * 32, s0, nv, lane); continue; } r -= I_IN;
        if (r < I_OUT) { const int kb = r / 32, nb = r % 32; p0_transpose_item<false>(P.w_out, 1024, (bf16_t*)(ws + WS_WOUT), 1024, nullptr, scr, kb, nb * 32, nb * 32, 32, lane, true); continue; } r -= I_OUT;
        if (r < I_G) { const int kb = r / 32, nb = r % 32; p0_transpose_item<true>(P.w_ple_gate, 1024, (unsigned char*)(ws + WS_WG), 1024, P.g_ple, scr, kb, nb * 32, nb * 32, 32, lane); continue; } r -= I_G;
        { const int kb = r / 32, nb = r % 32; p0_transpose_item<false>(P.w_ple_proj, 1024, (bf16_t*)(ws + WS_WP), 256, nullptr, scr, kb, nb * 32, nb * 32, 32, lane); }
    }
    float* rs1 = (float*)(ws + WS_RS1); bf16_t* xb = (bf16_t*)(ws + WS_XB);
    for (int m = gw; m < NTOK; m += NGW) {
        const f32x4* xr = (const f32x4*)(P.x + (size_t)m * DM) + lane; f32x4 v[4]; float s = 0.f;
#pragma unroll
        for (int j = 0; j < 4; ++j) { v[j] = NT_LD(xr + 64 * j); s += (v[j].x * v[j].x + v[j].y * v[j].y) + (v[j].z * v[j].z + v[j].w * v[j].w); }
        s = wave_sum(s);
        u32x2* o8 = (u32x2*)(xb + (size_t)m * DM) + lane;
#pragma unroll
        for (int j = 0; j < 4; ++j) { u32x2 w; w.x = pk2(v[j].x, v[j].y); w.y = pk2(v[j].z, v[j].w); o8[64 * j] = w; }
        if (lane == 0) rs1[m] = 1.0f / sqrtf(s * (1.0f / DM) + EPS);
    }
    bf16_t* pb = (bf16_t*)(ws + WS_PB);
    for (int m = gw; m < NTOK; m += NGW) { const f32x4 v = NT_LD((const f32x4*)(P.p + (size_t)m * 256) + lane); u32x2 w; w.x = pk2(v.x, v.y); w.y = pk2(v.z, v.w); *((u32x2*)(pb + (size_t)m * 256) + lane) = w; }
    f32x2* rope = (f32x2*)(ws + WS_ROPE);
    for (int idx = gw * 64 + lane; idx < SEQ * 32; idx += NGW * 64) { const int t = idx >> 5, i = idx & 31;
        const float inv = exp2f(-(float)i * (13.287712379549449f / 32.0f));
        const float ang = (float)t * inv;
        const double rev = (double)ang * 0.15915494309189535; const float fr = (float)(rev - __builtin_floor(rev));
        rope[idx] = (f32x2){__builtin_amdgcn_cosf(fr), __builtin_amdgcn_sinf(fr)}; }
    bf16_t* wrg = (bf16_t*)(ws + WS_WRG);
    for (int idx = gw * 64 + lane; idx < 1024 * 32; idx += NGW * 64) { const int k = idx >> 5, e = idx & 31; const float w = P.w_router[idx] * P.g_ffn[k];
        const unsigned short hi = f2bf(w); const float whi = __uint_as_float((unsigned)hi << 16); const size_t o = ((size_t)(k >> 3) * 32 + e) * 8 + (k & 7);
        wrg[o] = hi; wrg[32768 + o] = f2bf(w - whi); }
}

__device__ __forceinline__ unsigned fkey(float f) { unsigned u = __builtin_bit_cast(unsigned, f); if (u == 0x80000000u) u = 0u; return u ^ ((unsigned)((int)u >> 31) | 0x80000000u); }
__device__ __forceinline__ int mbcnt64(unsigned long long m) { return __builtin_amdgcn_mbcnt_hi((unsigned)(m >> 32), __builtin_amdgcn_mbcnt_lo((unsigned)m, 0u)); }

template <int NR>
__device__ __forceinline__ unsigned bisect_thr(const unsigned (&v)[NR], unsigned prefix, int startbit) {
    bool exact = false;
#pragma unroll 1
    for (int bit = startbit; bit >= 0; --bit) {
        const unsigned cand = prefix | (1u << bit); int cnt = 0;
#pragma unroll
        for (int r = 0; r < NR; ++r) { cnt += __builtin_popcountll(__ballot(v[r] >= cand)); if ((r & 7) == 7) __builtin_amdgcn_sched_barrier(0); }
        if (cnt >= NSEL) prefix = cand;
        if (cnt == NSEL) { exact = true; break; }
    }
    return exact ? prefix - 1u : prefix;
}
template <int NR, bool EXPL>
__device__ __forceinline__ void compact_sel(const unsigned (&v)[NR], const unsigned (&ci)[NR], unsigned T, LAS unsigned* list, int lane) {
    int cgt = 0;
#pragma unroll
    for (int r = 0; r < NR; ++r) { cgt += __builtin_popcountll(__ballot(v[r] > T)); if ((r & 7) == 7) __builtin_amdgcn_sched_barrier(0); }
    const int need = NSEL - cgt; int base = 0, ties = 0;
#pragma unroll
    for (int r = 0; r < NR; ++r) { const bool gt = v[r] > T, eq = v[r] == T; const unsigned long long em = __ballot(eq);
        const bool sel = gt || (eq && (ties + mbcnt64(em)) < need); const unsigned long long sm = __ballot(sel);
        list[sel ? base + mbcnt64(sm) : NSEL + lane] = EXPL ? ci[r] : (unsigned)(r * 64 + lane);
        base += __builtin_popcountll(sm); ties += __builtin_popcountll(em);
        if ((r & 3) == 3) __builtin_amdgcn_sched_barrier(0); }
}
constexpr int SEL_CAP = 1024;
template <int NR>
__device__ __forceinline__ void select_topk(LAS float* row, LAS unsigned* H, LAS unsigned* list, int lane, bool zero_h) {
    unsigned v[NR];
#pragma unroll
    for (int r = 0; r < NR; ++r) v[r] = fkey(row[r * 64 + lane]);
    LAS u32x4* H4 = (LAS u32x4*)H;
    const u32x4 h0 = H4[2 * lane], h1 = H4[2 * lane + 1];
    if (zero_h) { H4[2 * lane] = (u32x4){0u, 0u, 0u, 0u}; H4[2 * lane + 1] = (u32x4){0u, 0u, 0u, 0u}; }
    const unsigned hw[8] = {h0.x, h0.y, h0.z, h0.w, h1.x, h1.y, h1.z, h1.w};
    unsigned c[16];
#pragma unroll
    for (int i = 0; i < 8; ++i) { c[2 * i] = hw[i] & 0xffffu; c[2 * i + 1] = hw[i] >> 16; }
    unsigned s = 0u;
#pragma unroll
    for (int i = 0; i < 16; ++i) s += c[i];
    unsigned S = s;
#pragma unroll
    for (int off = 1; off < 64; off <<= 1) { const unsigned o = __shfl_down(S, off); if (lane + off < 64) S += o; }
    const unsigned long long okm = __ballot(S >= (unsigned)NSEL);
    bool fast = okm != 0ull; unsigned floorkey = 0u; int C = 0;
    if (fast) {
        const int Ls = 63 - __builtin_clzll(okm);
        unsigned acc = S - s; int bl = -1; unsigned accb = 0u;
#pragma unroll
        for (int b = 15; b >= 0; --b) { acc += c[b]; if (bl < 0 && acc >= (unsigned)NSEL) { bl = b; accb = acc; } }
        const int bstar = __shfl(bl, Ls) + 16 * Ls; C = (int)__shfl(accb, Ls);
        floorkey = (unsigned)bstar << 22;
        fast = (bstar > 1) && (C <= SEL_CAP);
    }
    if (!fast) {
        const unsigned T = bisect_thr<NR>(v, 0u, 31);
        compact_sel<NR, false>(v, v, T, list, lane);
        return;
    }
    LAS unsigned* ckl = (LAS unsigned*)row; LAS unsigned* cil = ckl + 1152;
    { int base = 0;
#pragma unroll
      for (int r = 0; r < NR; ++r) { const bool cnd = v[r] >= floorkey; const unsigned long long m = __ballot(cnd);
          const int pos = cnd ? base + mbcnt64(m) : SEL_CAP + lane;
          ckl[pos] = v[r]; cil[pos] = (unsigned)(r * 64 + lane); base += __builtin_popcountll(m);
          if ((r & 3) == 3) __builtin_amdgcn_sched_barrier(0); } }
    if (C <= 512) {
        unsigned ck[8], ci[8];
#pragma unroll
        for (int j = 0; j < 8; ++j) { const int i = j * 64 + lane; ck[j] = i < C ? ckl[i] : 0u; ci[j] = cil[i]; }
        const unsigned T = (C == NSEL) ? floorkey - 1u : bisect_thr<8>(ck, floorkey, 21);
        compact_sel<8, true>(ck, ci, T, list, lane);
    } else {
        unsigned ck[16], ci[16];
#pragma unroll
        for (int j = 0; j < 16; ++j) { const int i = j * 64 + lane; ck[j] = i < C ? ckl[i] : 0u; ci[j] = cil[i]; }
        const unsigned T = bisect_thr<16>(ck, floorkey, 21);
        compact_sel<16, true>(ck, ci, T, list, lane);
    }
}

typedef short v4i16 __attribute__((ext_vector_type(4)));
constexpr int VROW = 144;

__device__ __forceinline__ void attn_tile(const Params& P, LAS unsigned char* lds, int b, int t0, int wave, int lane) {
    unsigned char* ws = P.ws;
    const bf16_t* QI = (const bf16_t*)(ws + WS_QI); const bf16_t* KI = (const bf16_t*)(ws + WS_KI);
    const bf16_t* Q = (const bf16_t*)(ws + WS_Q); const bf16_t* Kp = (const bf16_t*)(ws + WS_K); const bf16_t* Vp = (const bf16_t*)(ws + WS_V);
    const float* WI = (const float*)(ws + WS_WI); bf16_t* MIX = (bf16_t*)(ws + WS_MIX);
    LAS float* SC = (LAS float*)lds;
    LAS unsigned* list = (LAS unsigned*)(lds + wave * 16384 + 14336);
    LAS unsigned* HIST = (LAS unsigned*)(lds + LDS_MISC);
    const int tokbase = b * SEQ;
    const bool need_sel = t0 >= 256;
    if (need_sel) {
        const int nkt = (t0 + 8 + 31) >> 5;
        bf16x8 a[4]; f32x4 w[4];
        { const bf16_t* src = QI + (size_t)(tokbase + t0 + ((lane & 31) >> 2)) * 256 + (lane & 3) * 64 + 8 * (lane >> 5);
#pragma unroll
          for (int ks = 0; ks < 4; ++ks) a[ks] = *(const bf16x8*)(src + 16 * ks); }
#pragma unroll
        for (int g = 0; g < 4; ++g) w[g] = *(const f32x4*)(WI + (size_t)(tokbase + t0 + 2 * g + (lane >> 5)) * 4);
        for (int kt0 = wave; kt0 < nkt; kt0 += 4 * NWAVES) {
            bf16x8 bf[4][4];
#pragma unroll
            for (int u = 0; u < 4; ++u) { const int kt = kt0 + u * NWAVES;
                if (kt < nkt) { const bf16_t* ksrc = KI + ((size_t)((tokbase >> 5) + kt) * 256 + lane) * 8;
#pragma unroll
                    for (int ks = 0; ks < 4; ++ks) bf[u][ks] = *(const bf16x8*)(ksrc + 512 * ks); } }
#pragma unroll
            for (int u = 0; u < 4; ++u) { const int kt = kt0 + u * NWAVES;
                if (kt < nkt) {
                    const int key = kt * 32 + (lane & 31);
                    f32x16 acc;
#pragma unroll
                    for (int i = 0; i < 16; ++i) acc[i] = 0.f;
#pragma unroll
                    for (int ks = 0; ks < 4; ++ks) acc = __builtin_amdgcn_mfma_f32_32x32x16_bf16(a[ks], bf[u][ks], acc, 0, 0, 0);
#pragma unroll
                    for (int g = 0; g < 4; ++g) { float sc = 0.f;
#pragma unroll
                        for (int h = 0; h < 4; ++h) sc = fmaf(fmaxf(acc[4 * g + h], 0.f), w[g][h], sc);
                        const int ql = 2 * g + (lane >> 5);
                        if (key > t0 + ql) sc = -INFINITY;
                        SC[ql * 4096 + key] = sc;
                        if (key <= t0 + ql) { const unsigned ub = __builtin_bit_cast(unsigned, sc);
                            const unsigned bin = (ub >> 22) ^ (((unsigned)((int)ub >> 31) & 0x1ffu) | 0x200u);
                            __hip_atomic_fetch_add(HIST + ql * 512 + (bin >> 1), 1u << ((bin & 1u) << 4), __ATOMIC_RELAXED, __HIP_MEMORY_SCOPE_WORKGROUP); } }
                } }
        }
        { const int npad = ((t0 + 8 + 1023) >> 10) << 10;
          for (int i = nkt * 32 + (int)threadIdx.x; i < npad; i += NTHR) {
#pragma unroll
              for (int q = 0; q < 8; ++q) SC[q * 4096 + i] = -INFINITY; } }
    }
    __syncthreads();
    const int t = t0 + wave, tok = tokbase + t;
    if (need_sel) {
        LAS float* row = SC + wave * 4096; LAS unsigned* H = HIST + wave * 512; const int n = t + 1;
        if (n <= 1024) select_topk<16>(row, H, list, lane, true);
        else if (n <= 2048) select_topk<32>(row, H, list, lane, true);
        else if (n <= 3072) select_topk<48>(row, H, list, lane, true);
        else select_topk<64>(row, H, list, lane, true);
    } else {
#pragma unroll
        for (int i = 0; i < 4; ++i) list[i * 64 + lane] = (unsigned)(i * 64 + lane);
    }
    const int nvalid = need_sel ? NSEL : (t + 1);
    const int hd = lane & 15, g = lane >> 4;
    bf16x8 qf0, qf1;
#pragma unroll
    for (int i = 0; i < 8; ++i) { qf0[i] = 0; qf1[i] = 0; }
    if (hd < 8) { const bf16_t* qs = Q + (size_t)tok * 512 + hd * 64 + 8 * g; qf0 = *(const bf16x8*)qs; qf1 = *(const bf16x8*)(qs + 32); }
    LAS unsigned char* vreg = lds + wave * 16384;
    u32x4 rA[4], rB[4];
#define ATT_ROWS(R, SRC, G_) do { const int nb_ = (G_) * 32; \
        _Pragma("unroll") for (int i_ = 0; i_ < 4; ++i_) { const unsigned idx_ = list[nb_ + (lane >> 3) + 8 * i_]; R[i_] = *(const u32x4*)((SRC) + (size_t)(tokbase + idx_) * 64 + 8 * (lane & 7)); } } while (0)
#define ATT_STAGE(R, BUF) do { _Pragma("unroll") for (int i_ = 0; i_ < 4; ++i_) *(LAS u32x4*)((BUF) + ((lane >> 3) + 8 * i_) * VROW + (lane & 7) * 16) = R[i_]; } while (0)
    float lg[8][8];
#define ATT_QK(R, G_, BUF) do { LAS unsigned char* kb_ = (BUF); ATT_STAGE(R, kb_); \
        if constexpr ((G_) + 2 < 8) { ATT_ROWS(R, Kp, (G_) + 2); } \
        const LAS unsigned char* kr_ = kb_ + hd * VROW + 16 * g; \
        const bf16x8 ka0_ = *(const LAS bf16x8*)kr_, ka1_ = *(const LAS bf16x8*)(kr_ + 64), kb0_ = *(const LAS bf16x8*)(kr_ + 16 * VROW), kb1_ = *(const LAS bf16x8*)(kr_ + 16 * VROW + 64); \
        f32x4 sa_ = {0.f, 0.f, 0.f, 0.f}, sb_ = {0.f, 0.f, 0.f, 0.f}; \
        sa_ = __builtin_amdgcn_mfma_f32_16x16x32_bf16(ka0_, qf0, sa_, 0, 0, 0); sa_ = __builtin_amdgcn_mfma_f32_16x16x32_bf16(ka1_, qf1, sa_, 0, 0, 0); \
        sb_ = __builtin_amdgcn_mfma_f32_16x16x32_bf16(kb0_, qf0, sb_, 0, 0, 0); sb_ = __builtin_amdgcn_mfma_f32_16x16x32_bf16(kb1_, qf1, sb_, 0, 0, 0); \
        _Pragma("unroll") for (int r_ = 0; r_ < 4; ++r_) { const int sl_ = (G_) * 32 + 4 * g + r_; \
            lg[G_][r_] = sl_ < nvalid ? sa_[r_] * 0.125f : -INFINITY; lg[G_][4 + r_] = (sl_ + 16) < nvalid ? sb_[r_] * 0.125f : -INFINITY; } } while (0)
    ATT_ROWS(rA, Kp, 0); ATT_ROWS(rB, Kp, 1);
    ATT_QK(rA, 0, vreg); ATT_QK(rB, 1, vreg + 4608); ATT_QK(rA, 2, vreg); ATT_QK(rB, 3, vreg + 4608);
    ATT_QK(rA, 4, vreg); ATT_QK(rB, 5, vreg + 4608); ATT_QK(rA, 6, vreg); ATT_QK(rB, 7, vreg + 4608);
    ATT_ROWS(rA, Vp, 0); ATT_ROWS(rB, Vp, 1);
    float mx = -INFINITY;
#pragma unroll
    for (int q = 0; q < 8; ++q)
#pragma unroll
        for (int r = 0; r < 8; ++r) mx = fmaxf(mx, lg[q][r]);
    mx = fmaxf(mx, __shfl_xor(mx, 16)); mx = fmaxf(mx, __shfl_xor(mx, 32));
    float ssum = 0.f;
#pragma unroll
    for (int q = 0; q < 8; ++q)
#pragma unroll
        for (int r = 0; r < 8; ++r) { lg[q][r] = __expf(lg[q][r] - mx); ssum += lg[q][r]; }
    f32x4 o[4];
#pragma unroll
    for (int dt = 0; dt < 4; ++dt) o[dt] = (f32x4){0.f, 0.f, 0.f, 0.f};
#define ATT_PV(R, G_, BUF) do { LAS unsigned char* vb_ = (BUF); ATT_STAGE(R, vb_); \
        if constexpr ((G_) + 2 < 8) { ATT_ROWS(R, Vp, (G_) + 2); } \
        bf16x8 pf_; \
        { const u32x4 pw_ = {cvt_pk_bf16(lg[G_][0], lg[G_][1]), cvt_pk_bf16(lg[G_][2], lg[G_][3]), cvt_pk_bf16(lg[G_][4], lg[G_][5]), cvt_pk_bf16(lg[G_][6], lg[G_][7])}; pf_ = __builtin_bit_cast(bf16x8, pw_); } \
        LAS unsigned char* ta_ = vb_ + (4 * g + (hd >> 2)) * VROW + (hd & 3) * 8; \
        _Pragma("unroll") for (int dt_ = 0; dt_ < 4; ++dt_) { \
            const v4i16 lo_ = __builtin_amdgcn_ds_read_tr16_b64_v4i16((LAS v4i16*)(ta_ + dt_ * 32)); \
            const v4i16 hi_ = __builtin_amdgcn_ds_read_tr16_b64_v4i16((LAS v4i16*)(ta_ + 16 * VROW + dt_ * 32)); \
            bf16x8 vf_; vf_[0] = lo_[0]; vf_[1] = lo_[1]; vf_[2] = lo_[2]; vf_[3] = lo_[3]; vf_[4] = hi_[0]; vf_[5] = hi_[1]; vf_[6] = hi_[2]; vf_[7] = hi_[3]; \
            o[dt_] = __builtin_amdgcn_mfma_f32_16x16x32_bf16(vf_, pf_, o[dt_], 0, 0, 0); } } while (0)
    ATT_PV(rA, 0, vreg); ATT_PV(rB, 1, vreg + 4608); ATT_PV(rA, 2, vreg); ATT_PV(rB, 3, vreg + 4608);
    ATT_PV(rA, 4, vreg); ATT_PV(rB, 5, vreg + 4608); ATT_PV(rA, 6, vreg); ATT_PV(rB, 7, vreg + 4608);
#undef ATT_ROWS
#undef ATT_STAGE
#undef ATT_QK
#undef ATT_PV
    ssum += __shfl_xor(ssum, 16); ssum += __shfl_xor(ssum, 32);
    const float inv = 1.0f / ssum;
    if (hd < 8) {
        bf16_t* op = MIX + (size_t)tok * 1024 + hd * 64 + 4 * g;
#pragma unroll
        for (int dt = 0; dt < 4; ++dt) { u32x2 w; w.x = cvt_pk_bf16(o[dt][0] * inv, o[dt][1] * inv); w.y = cvt_pk_bf16(o[dt][2] * inv, o[dt][3] * inv); *(u32x2*)(op + 16 * dt) = w; }
    }
    __syncthreads();
}

__device__ __forceinline__ void conv_tile(const Params& P, LAS unsigned char* lds, int tile, int tid, int wave, int lane) {
    unsigned char* ws = P.ws;
    const bf16_t* HG = (const bf16_t*)(ws + WS_HGLU); bf16_t* MIX = (bf16_t*)(ws + WS_MIX);
    LAS f32x2* part = (LAS f32x2*)(lds + LDS_MISC + 1024);
    LAS f32x2* stat = part + 256;
    LAS bf16_t* Lin = (LAS bf16_t*)lds;
    LAS bf16_t* Lout = (LAS bf16_t*)(lds + 65536);
    const int tok0 = tile * 32, t0 = tok0 & (SEQ - 1), c = tid;
    for (int ch = tid; ch < 62 * 64; ch += NTHR) { const int r = ch >> 6, cc = ch & 63; const int tt = t0 - 30 + r;
        u32x4 v = {0u, 0u, 0u, 0u}; if (tt >= 0) v = *(const u32x4*)(HG + (size_t)(tok0 - 30 + r) * 512 + cc * 8);
        *(LAS u32x4*)(Lin + r * 512 + cc * 8) = v; }
    __syncthreads();
    float in[62];
#pragma unroll
    for (int r = 0; r < 62; ++r) in[r] = __builtin_bit_cast(float, (unsigned)Lin[r * 512 + c] << 16);
    float out[32];
    const float bias = P.dw_b[c];
#pragma unroll
    for (int i = 0; i < 32; ++i) out[i] = bias;
#pragma unroll
    for (int j = 0; j < 31; ++j) { const float wj = P.dw_w[j * 512 + c];
#pragma unroll
        for (int i = 0; i < 32; ++i) out[i] = fmaf(in[i + j], wj, out[i]); }
#pragma unroll
    for (int i = 0; i < 32; ++i) { const float s1 = wave_sum(out[i]), s2 = wave_sum(out[i] * out[i]); if (lane == 0) part[i * 8 + wave] = (f32x2){s1, s2}; }
    __syncthreads();
    if (tid < 32) { float s1 = 0.f, s2 = 0.f;
#pragma unroll
        for (int w = 0; w < 8; ++w) { const f32x2 pp = part[tid * 8 + w]; s1 += pp.x; s2 += pp.y; }
        const float mean = s1 * (1.0f / 512.0f), var = fmaxf(s2 * (1.0f / 512.0f) - mean * mean, 0.f);
        stat[tid] = (f32x2){mean, 1.0f / sqrtf(var + EPS)}; }
    __syncthreads();
    const float lgc = P.ln_g[c], lbc = P.ln_b[c];
#pragma unroll
    for (int i = 0; i < 32; ++i) { const f32x2 st = stat[i]; const float y = (out[i] - st.x) * st.y * lgc + lbc; const float sl = y * sigmoidf_(y);
        Lout[i * 512 + c] = (bf16_t)f2bf(sl); }
    __syncthreads();
    for (int ch = tid; ch < 32 * 64; ch += NTHR) { const int r = ch >> 6, cc = ch & 63;
        *(u32x4*)(MIX + (size_t)(tok0 + r) * 1024 + 512 + cc * 8) = *(const LAS u32x4*)(Lout + r * 512 + cc * 8); }
    __syncthreads();
}

constexpr int MW_UP = 32 * 16 * 64, MW_DN = 32 * 16 * 32, MW_ITEMS = MW_UP + MW_DN;
__device__ __forceinline__ void mw_decode(const Params& P, int it, const float*& src, int& ldw, unsigned char*& dst, const float*& gain) {
    unsigned char* ws = P.ws;
    if (it < MW_UP) { const int e = it >> 10, rr = it & 1023, kb = rr >> 6, nb = rr & 63, pn = nb >> 3, j = (nb & 7) * 32, bj = j >> 7, jj = j & 127;
        src = P.w_up + (size_t)e * 1024 * 2048 + (size_t)(kb * 64) * 2048 + 1024 * bj + 128 * pn + jj; ldw = 2048;
        dst = ws + WS_WUP + (size_t)e * 2048 * 1024 + (size_t)(nb * 32) * 1024 + kb * 64; gain = P.g_ffn + kb * 64; }
    else { const int r = it - MW_UP, e = r >> 9, rr = r & 511, kb = rr >> 5, nb = rr & 31;
        src = P.w_down + (size_t)e * 1024 * 1024 + (size_t)(kb * 64) * 1024 + nb * 32; ldw = 1024;
        dst = ws + WS_WDOWN + (size_t)e * 1024 * 1024 + (size_t)(nb * 32) * 1024 + kb * 64; gain = nullptr; }
}
#define MW_LOAD(LD, it_) do { if ((it_) < MW_ITEMS) { const float* src_; int ldw_; unsigned char* dst_; const float* gain_; mw_decode(P, (it_), src_, ldw_, dst_, gain_); \
        _Pragma("unroll") for (int i_ = 0; i_ < 8; ++i_) LD[i_] = NT_LD((const f32x4*)(src_ + (size_t)(8 * i_ + (lane >> 3)) * ldw_ + (lane & 7) * 4)); } } while (0)
#define MW_FINISH(LD, it_) do { if ((it_) < MW_ITEMS) { const float* src_; int ldw_; unsigned char* dst_; const float* gain_; mw_decode(P, (it_), src_, ldw_, dst_, gain_); \
        _Pragma("unroll") for (int i_ = 0; i_ < 8; ++i_) { const int kk_ = 8 * i_ + (lane >> 3), j_ = (lane & 7) * 4; const float gk_ = (gain_ ? gain_[kk_] : 1.0f) * 32.0f; \
            LAS float* d_ = scr + kk_ * 33 + j_; d_[0] = LD[i_].x * gk_; d_[1] = LD[i_].y * gk_; d_[2] = LD[i_].z * gk_; d_[3] = LD[i_].w * gk_; } \
        LDS_WAIT(); asm volatile("" ::: "memory"); \
        const int c_ = lane & 7; \
        _Pragma("unroll") for (int j_ = 0; j_ < 4; ++j_) { const int n_ = (lane >> 3) + 8 * j_; const LAS float* sp_ = scr + (8 * c_) * 33 + n_; \
            u32x2 o_; o_.x = pk4_fp8(sp_[0 * 33], sp_[1 * 33], sp_[2 * 33], sp_[3 * 33]); o_.y = pk4_fp8(sp_[4 * 33], sp_[5 * 33], sp_[6 * 33], sp_[7 * 33]); \
            *(u32x2*)(dst_ + (size_t)n_ * 1024 + 8 * c_) = o_; } \
        LDS_WAIT(); asm volatile("" ::: "memory"); } } while (0)
__device__ __forceinline__ void moe_weight_convert(const Params& P, LAS float* scr, int cw, int ncw, int lane) {
    f32x4 l0[8], l1[8], l2[8], l3[8];
    MW_LOAD(l0, cw); MW_LOAD(l1, cw + ncw); MW_LOAD(l2, cw + 2 * ncw);
    for (int base = cw; base < MW_ITEMS; base += 4 * ncw) {
        MW_LOAD(l3, base + 3 * ncw); MW_FINISH(l0, base);
        MW_LOAD(l0, base + 4 * ncw); MW_FINISH(l1, base + ncw);
        MW_LOAD(l1, base + 5 * ncw); MW_FINISH(l2, base + 2 * ncw);
        MW_LOAD(l2, base + 6 * ncw); MW_FINISH(l3, base + 3 * ncw);
    }
}
#undef MW_LOAD
#undef MW_FINISH

__device__ __forceinline__ void router_phase(const Params& P, LAS unsigned char* lds, int blk, int G, int tid, int wave, int lane) {
    unsigned char* ws = P.ws;
    const bf16_t* h1 = (const bf16_t*)(ws + WS_H1); const u32x4* wrg = (const u32x4*)(ws + WS_WRG);
    int* list = (int*)(ws + WS_LIST); float* lscale = (float*)(ws + WS_LSCALE); float* lgate = (float*)(ws + WS_LGATE);
    unsigned* cntg = (unsigned*)(ws + WS_CTL) + CW_CNT;
    LAS u32x4* WH = (LAS u32x4*)lds;
    LAS float* part = (LAS float*)lds;
    LAS int* lcnt = (LAS int*)(lds + LDS_MISC + 1024);
    LAS int* gbase = lcnt + 32;
    LAS int* rec_e = gbase + 32;
    LAS int* rec_p = rec_e + 512;
    LAS float* rec_g = (LAS float*)(rec_p + 512);
    LAS float* rec_s = rec_g + 512;
    const int tl = lane & 31, half = lane >> 5;
    for (int chunk = blk; chunk < NTOK / 128; chunk += G) {
        for (int i = tid; i < 8192; i += NTHR) WH[i] = wrg[i];
        if (tid < 32) lcnt[tid] = 0;
        __syncthreads();
        const int tloc = (wave & 3) * 32 + tl, tok = chunk * 128 + tloc, kb0 = (wave >> 2) * 512;
        f32x16 acc;
#pragma unroll
        for (int i = 0; i < 16; ++i) acc[i] = 0.f;
        float ss = 0.f;
        {
            const bf16_t* hrow = h1 + (size_t)tok * DM + kb0 + 8 * half;
            const LAS u32x4* wa = WH + (size_t)((kb0 >> 3) + half) * 32 + tl;
#pragma unroll 2
            for (int k0 = 0; k0 < 512; k0 += 64) {
                u32x4 hv[4];
#pragma unroll
                for (int i = 0; i < 4; ++i) hv[i] = NT_LD((const u32x4*)(hrow + k0 + 16 * i));
#pragma unroll
                for (int i = 0; i < 4; ++i) {
                    const u32x4 ah = wa[(size_t)((k0 >> 3) + 2 * i) * 32], al = wa[(size_t)((k0 >> 3) + 2 * i) * 32 + 4096];
                    const float x0 = bf_lo(hv[i].x), x1 = bf_hi(hv[i].x), x2 = bf_lo(hv[i].y), x3 = bf_hi(hv[i].y), x4 = bf_lo(hv[i].z), x5 = bf_hi(hv[i].z), x6 = bf_lo(hv[i].w), x7 = bf_hi(hv[i].w);
                    ss = fmaf(x0, x0, fmaf(x1, x1, fmaf(x2, x2, fmaf(x3, x3, fmaf(x4, x4, fmaf(x5, x5, fmaf(x6, x6, fmaf(x7, x7, ss))))))));
                    acc = __builtin_amdgcn_mfma_f32_32x32x16_bf16(__builtin_bit_cast(bf16x8, ah), __builtin_bit_cast(bf16x8, hv[i]), acc, 0, 0, 0);
                    acc = __builtin_amdgcn_mfma_f32_32x32x16_bf16(__builtin_bit_cast(bf16x8, al), __builtin_bit_cast(bf16x8, hv[i]), acc, 0, 0, 0);
                }
            }
        }
        __syncthreads();
        if (wave >= 4) { const int pl = (wave - 4) * 64 + lane;
#pragma unroll
            for (int r = 0; r < 16; ++r) part[r * 256 + pl] = acc[r];
            part[16 * 256 + pl] = ss; }
        __syncthreads();
        if (wave < 4) {
            { const int pl = wave * 64 + lane;
#pragma unroll
              for (int r = 0; r < 16; ++r) acc[r] += part[r * 256 + pl];
              ss += part[16 * 256 + pl]; }
            ss += __shfl_xor(ss, 32);
            const float rs = 1.0f / sqrtf(ss * (1.0f / DM) + EPS);
            float v[16];
#pragma unroll
            for (int r = 0; r < 16; ++r) v[r] = acc[r] * rs + P.b_router[(r & 3) + 8 * (r >> 2) + 4 * half];
            float tv[4]; int te[4];
#pragma unroll
            for (int q = 0; q < 4; ++q) { float bv = -INFINITY; int be = 64;
#pragma unroll
                for (int r = 0; r < 16; ++r) { const int e = (r & 3) + 8 * (r >> 2) + 4 * half; if (v[r] > bv || (v[r] == bv && e < be)) { bv = v[r]; be = e; } }
#pragma unroll
                for (int r = 0; r < 16; ++r) { const int e = (r & 3) + 8 * (r >> 2) + 4 * half; if (e == be) v[r] = -INFINITY; }
                tv[q] = bv; te[q] = be; }
            float cv[8]; int ce[8];
#pragma unroll
            for (int q = 0; q < 4; ++q) { cv[q] = tv[q]; ce[q] = te[q]; cv[4 + q] = __shfl_xor(tv[q], 32); ce[4 + q] = __shfl_xor(te[q], 32); }
#pragma unroll
            for (int q = 0; q < 4; ++q) { float bv = -INFINITY; int be = 64;
#pragma unroll
                for (int r = 0; r < 8; ++r) if (cv[r] > bv || (cv[r] == bv && ce[r] < be)) { bv = cv[r]; be = ce[r]; }
#pragma unroll
                for (int r = 0; r < 8; ++r) if (ce[r] == be) cv[r] = -INFINITY;
                tv[q] = bv; te[q] = be; }
            const float e1 = __expf(tv[1] - tv[0]), e2 = __expf(tv[2] - tv[0]), e3 = __expf(tv[3] - tv[0]);
            const float is = 1.0f / (1.0f + e1 + e2 + e3);
            if (half == 0) {
                const float gq[4] = {is, e1 * is, e2 * is, e3 * is};
#pragma unroll
                for (int q = 0; q < 4; ++q) { const int lp = atomicAdd((int*)&lcnt[te[q]], 1); const int si = tloc * 4 + q; rec_e[si] = te[q]; rec_p[si] = lp; rec_g[si] = gq[q]; }
                rec_s[tloc] = rs;
            }
        }
        __syncthreads();
        if (tid < 32) gbase[tid] = (int)atomicAdd(cntg + 64 * tid, (unsigned)lcnt[tid]);
        __syncthreads();
        { const int si = tid, ee = rec_e[si], pos = gbase[ee] + rec_p[si], li = ee * NTOK + pos;
          list[li] = (chunk * 128) * 4 + si; lscale[li] = rec_s[si >> 2]; lgate[li] = rec_g[si]; }
        __syncthreads();
    }
}

__device__ __forceinline__ void combine_phase(const Params& P, int mbeg, int mend, int mstep, int lane) {
    unsigned char* ws = P.ws;
    const bf16_t* h1 = (const bf16_t*)(ws + WS_H1); bf16_t* h1b = (bf16_t*)(ws + WS_H1B); const unsigned char* y = ws + WS_Y; float* rs3 = (float*)(ws + WS_RS3);
    for (int m = mbeg; m < mend; m += mstep) {
        const u32x2* hr = (const u32x2*)(h1 + (size_t)m * DM) + lane; f32x4 v[4]; float s = 0.f;
#pragma unroll
        for (int j = 0; j < 4; ++j) { const u32x2 hw = NT_LD(hr + 64 * j); v[j].x = bf_lo(hw.x); v[j].y = bf_hi(hw.x); v[j].z = bf_lo(hw.y); v[j].w = bf_hi(hw.y); }
#pragma unroll
        for (int k = 0; k < 4; ++k) { const unsigned* yr = (const unsigned*)(y + (size_t)(m * 4 + k) * DM) + lane;
#pragma unroll
            for (int j = 0; j < 4; ++j) { const unsigned w = NT_LD(yr + 64 * j); const f32x2 lo = __builtin_amdgcn_cvt_pk_f32_fp8((int)w, false), hi = __builtin_amdgcn_cvt_pk_f32_fp8((int)w, true);
                v[j].x += lo.x * 0.0625f; v[j].y += lo.y * 0.0625f; v[j].z += hi.x * 0.0625f; v[j].w += hi.y * 0.0625f; } }
        u32x2* o8 = (u32x2*)(h1b + (size_t)m * DM) + lane; unsigned* o4 = (unsigned*)(ws + WS_H1F8 + (size_t)m * DM) + lane;
#pragma unroll
        for (int j = 0; j < 4; ++j) { u32x2 w; w.x = pk2(v[j].x, v[j].y); w.y = pk2(v[j].z, v[j].w); NT_ST(w, o8 + 64 * j); NT_ST(pk4_fp8(v[j].x, v[j].y, v[j].z, v[j].w), o4 + 64 * j);
            s += (v[j].x * v[j].x + v[j].y * v[j].y) + (v[j].z * v[j].z + v[j].w * v[j].w); }
        s = wave_sum(s);
        if (lane == 0) rs3[m] = 1.0f / sqrtf(s * (1.0f / DM) + EPS);
    }
}

__device__ __forceinline__ void final_phase(const Params& P, int mbeg, int mend, int mstep, int lane) {
    unsigned char* ws = P.ws;
    const bf16_t* h2b = (const bf16_t*)(ws + WS_H1B); const bf16_t* pj = (const bf16_t*)(ws + WS_PJ); const unsigned char* G = ws + WS_G; const float* rs3 = (const float*)(ws + WS_RS3);
    f32x4 gv[4];
#pragma unroll
    for (int j = 0; j < 4; ++j) gv[j] = *((const f32x4*)P.g_final + lane + 64 * j);
    for (int m = mbeg; m < mend; m += mstep) {
        const u32x2* hr = (const u32x2*)(h2b + (size_t)m * DM) + lane; const u32x2* pr = (const u32x2*)(pj + (size_t)m * DM) + lane; const unsigned* gr = (const unsigned*)(G + (size_t)m * DM) + lane;
        const float r3 = rs3[m]; f32x4 v[4]; float s = 0.f;
#pragma unroll
        for (int j = 0; j < 4; ++j) { const u32x2 hw = NT_LD(hr + 64 * j), pw = NT_LD(pr + 64 * j); const unsigned gw2 = NT_LD(gr + 64 * j);
            const f32x2 glo = __builtin_amdgcn_cvt_pk_f32_fp8((int)gw2, false), ghi = __builtin_amdgcn_cvt_pk_f32_fp8((int)gw2, true);
            v[j].x = bf_lo(hw.x) + bf_lo(pw.x) * sigmoidf_(glo.x * r3); v[j].y = bf_hi(hw.x) + bf_hi(pw.x) * sigmoidf_(glo.y * r3);
            v[j].z = bf_lo(hw.y) + bf_lo(pw.y) * sigmoidf_(ghi.x * r3); v[j].w = bf_hi(hw.y) + bf_hi(pw.y) * sigmoidf_(ghi.y * r3);
            s += (v[j].x * v[j].x + v[j].y * v[j].y) + (v[j].z * v[j].z + v[j].w * v[j].w); }
        s = wave_sum(s); const float rs = 1.0f / sqrtf(s * (1.0f / DM) + EPS);
        f32x4* orow = (f32x4*)(P.out + (size_t)m * DM) + lane;
#pragma unroll
        for (int j = 0; j < 4; ++j) NT_ST(v[j] * rs * gv[j], orow + 64 * j);
    }
}

#define XB_TMO      128
#define XB_XCNT(j)  (256  + 64 * (j))
#define XB_XSUB(j)  (1280 + 64 * (j))
#define XB_XGEN(j)  (2304 + 64 * (j))
#define XB_TOP      3328
#define XB_TOPGEN   3392
#define XCD_BAR_WORDS 3456
#define XB_SPIN_CAP (1u << 18)
__device__ __forceinline__ unsigned xb_ld(unsigned* p)              { return __hip_atomic_load(p, __ATOMIC_RELAXED, __HIP_MEMORY_SCOPE_AGENT); }
__device__ __forceinline__ unsigned xb_add(unsigned* p, unsigned v) { return __hip_atomic_fetch_add(p, v, __ATOMIC_RELAXED, __HIP_MEMORY_SCOPE_AGENT); }
__device__ __forceinline__ unsigned xb_xcc_id() { return (unsigned)__builtin_amdgcn_s_getreg((3 << 11) | 20) & 0xFu; }
#define XB_SPIN(cond, bar) do { unsigned _sp = 0; while (cond) { __builtin_amdgcn_s_sleep(1); \
    if ((++_sp & 255u) == 0u) { if (xb_ld(&(bar)[XB_TMO])) break; if (_sp > XB_SPIN_CAP) { atomicAdd(&(bar)[XB_TMO], 1u); break; } } } } while (0)
struct XcdBarrier { unsigned* bar; unsigned x; volatile LAS unsigned* st; };
__device__ __forceinline__ XcdBarrier xcd_barrier_post(unsigned* bar, volatile LAS unsigned* st) {
    XcdBarrier b; b.bar = bar; b.x = xb_xcc_id(); b.st = st;
    if (threadIdx.x == 0) (void)xb_add(&bar[XB_XCNT(b.x)], 1u);
    return b;
}
__device__ __forceinline__ void xcd_barrier_complete(unsigned* bar, unsigned x, unsigned& nloc, unsigned& nx) {
    const unsigned G = gridDim.x * gridDim.y * gridDim.z;
    unsigned sum, cnt, mine, sp = 0u;
    for (;;) {
        sum = 0u; cnt = 0u; mine = 0u;
#pragma unroll
        for (unsigned j = 0; j < 16; ++j) { const unsigned c = xb_ld(&bar[XB_XCNT(j)]); sum += c; cnt += (c > 0u) ? 1u : 0u; mine = (j == x) ? c : mine; }
        if (sum == G) break;
        __builtin_amdgcn_s_sleep(1);
        if ((++sp & 255u) == 0u) { if (xb_ld(&bar[XB_TMO])) break; if (sp > XB_SPIN_CAP) { atomicAdd(&bar[XB_TMO], 1u); break; } }
    }
    nloc = mine > 0u ? mine : 1u; nx = cnt > 0u ? cnt : 1u;
}
__device__ __forceinline__ void xcd_barrier(const XcdBarrier& b) {
    asm volatile("s_waitcnt vmcnt(0)" ::: "memory");
    __syncthreads();
    if (threadIdx.x == 0) {
        unsigned* bar = b.bar;
        __builtin_amdgcn_s_waitcnt(0);
        unsigned nloc = b.st[0], nx = b.st[1];
        if (nloc == 0u) { xcd_barrier_complete(bar, b.x, nloc, nx); b.st[0] = nloc; b.st[1] = nx; }
        const unsigned old = xb_add(&bar[XB_XSUB(b.x)], 1u);
        const unsigned gen = old / nloc;
        if (old + 1u == (gen + 1u) * nloc) {
            __builtin_amdgcn_fence(__ATOMIC_RELEASE, "agent");
            asm volatile("s_waitcnt vmcnt(0)" ::: "memory");
            const unsigned og = xb_add(&bar[XB_TOP], 1u);
            const unsigned tg = og / nx;
            if (og + 1u == (tg + 1u) * nx) xb_add(&bar[XB_TOPGEN], 1u);
            else XB_SPIN(xb_ld(&bar[XB_TOPGEN]) == tg, bar);
            __builtin_amdgcn_fence(__ATOMIC_ACQUIRE, "agent");
            xb_add(&bar[XB_XGEN(b.x)], 1u);
            asm volatile("s_waitcnt vmcnt(0)" ::: "memory");
        } else {
            XB_SPIN(xb_ld(&bar[XB_XGEN(b.x)]) == gen, bar);
            __builtin_amdgcn_fence(__ATOMIC_ACQUIRE, "agent");
            asm volatile("s_waitcnt vmcnt(0)" ::: "memory");
        }
    }
    __syncthreads();
}

__device__ __forceinline__ void pair_sync(unsigned* flag, unsigned* tmo, bool same_xcd) {
    asm volatile("s_waitcnt vmcnt(0)" ::: "memory");
    __syncthreads();
    if (threadIdx.x == 0) {
        if (!same_xcd) { __builtin_amdgcn_fence(__ATOMIC_RELEASE, "agent"); asm volatile("s_waitcnt vmcnt(0)" ::: "memory"); }
        xb_add(flag, 1u);
        unsigned sp = 0u;
        while (xb_ld(flag) < 2u) { __builtin_amdgcn_s_sleep(1); if ((++sp & 255u) == 0u) { if (xb_ld(tmo)) break; if (sp > XB_SPIN_CAP) { atomicAdd(tmo, 1u); break; } } }
        __builtin_amdgcn_fence(__ATOMIC_ACQUIRE, "agent");
        asm volatile("s_waitcnt vmcnt(0)" ::: "memory");
    }
    __syncthreads();
}

constexpr int NPHASE = 10;
__global__ void __launch_bounds__(NTHR, 2) fwd_kernel(Params P) {
    extern __shared__ __attribute__((aligned(16))) unsigned char lds_raw[];
    LAS unsigned char* lds = (LAS unsigned char*)lds_raw;
    cg::grid_group grid = cg::this_grid();
    const int tid = threadIdx.x, wave = __builtin_amdgcn_readfirstlane(tid >> 6);
    const int G = gridDim.x, bx = blockIdx.x;
#define FRESH_LANE(name) int name = (int)__builtin_amdgcn_mbcnt_hi(~0u, __builtin_amdgcn_mbcnt_lo(~0u, 0u)); asm volatile("" : "+v"(name))
    const int vcu = (G % 8 == 0) ? (bx % 8) * (G / 8) + bx / 8 : bx;
    const int NGW = G * NWAVES;
    unsigned char* ws = P.ws;
    const int lo = P.ph_lo, hi = P.ph_hi;
#define IN(k) (lo <= (k) && (k) < hi)
    volatile LAS unsigned* xst = (volatile LAS unsigned*)(lds + LDS_XB);
    if (tid < 2) xst[tid] = 0u;
    __syncthreads();
    const XcdBarrier xbar = xcd_barrier_post((unsigned*)(ws + WS_CTL) + CW_BAR, xst);
    if (tid == 0) __hip_atomic_store((unsigned*)(ws + WS_CTL) + CW_XCC + bx, xbar.x + 1u, __ATOMIC_RELAXED, __HIP_MEMORY_SCOPE_AGENT);
    if (P.ph_lo > P.ph_hi) grid.sync();
#define SYNC(k) do { if (IN(k) && IN((k) + 1)) xcd_barrier(xbar); } while (0)

    if (IN(0)) { FRESH_LANE(lane); p0_prologue(P, lds, vcu, G, wave, lane); }
    SYNC(0);
    if (IN(1)) {
        { pg8::DenseSched S; S.init((const bf16_t*)(ws + WS_XB), (const bf16_t*)(ws + WS_WIN), NTOK, 2048, 1024, G, bx);
          EpiInProj E{(const float*)(ws + WS_RS1), (const f32x2*)(ws + WS_ROPE), P.glu_b, (bf16_t*)(ws + WS_Q), (bf16_t*)(ws + WS_K), (bf16_t*)(ws + WS_V), (bf16_t*)(ws + WS_QI), (bf16_t*)(ws + WS_KI), (bf16_t*)(ws + WS_HGLU), (float*)(ws + WS_WI)};
          pg8::gemm_phase<EpiInProj, pg8::DenseSched, false>(lds, S, E); }
        { pg8::DenseSched S; S.init((const bf16_t*)(ws + WS_PB), (const bf16_t*)(ws + WS_WP), NTOK, 1024, 256, G, bx);
          EpiBf16Plain E{(bf16_t*)(ws + WS_PJ), 1024, 1.0f};
          pg8::gemm_phase<EpiBf16Plain, pg8::DenseSched, false>(lds, S, E); }
    }
    SYNC(1);
    if (IN(2)) {
        FRESH_LANE(lane);
        for (int i = tid; i < 4096; i += NTHR) ((LAS unsigned*)(lds + LDS_MISC))[i] = 0u;
        __syncthreads();
        unsigned* ctl = (unsigned*)(ws + WS_CTL);
        volatile LAS int* qw = (volatile LAS int*)(lds + LDS_XB + 32);
        if (G % 8 == 0 && G >= 128) { const int ncv = 8; if ((bx >> 3) < ncv) moe_weight_convert(P, (LAS float*)(lds + wave * 16384), (bx * NWAVES) + wave, ncv * 8 * NWAVES, lane); }
        else { moe_weight_convert(P, (LAS float*)(lds + wave * 16384), bx * NWAVES + wave, G * NWAVES, lane); }
        __syncthreads();
        for (int db = 0; db < NB; ++db) { const int b = (bx + db) & 7;
            for (;;) {
                if (tid == 0) qw[0] = (int)atomicAdd(ctl + CW_AQ + 64 * b, 1u);
                __syncthreads();
                const int k = qw[0];
                if (k >= 512) break;
                attn_tile(P, lds, b, (511 - k) * 8, wave, lane);
            }
            __syncthreads(); }
        for (;;) {
            if (tid == 0) qw[0] = (int)atomicAdd(ctl + CW_CQ, 1u);
            __syncthreads();
            const int tl = qw[0];
            if (tl >= NTOK / 32) break;
            conv_tile(P, lds, tl, tid, wave, lane);
        }
    }
    SYNC(2);
    if (IN(3)) {
        pg8::DenseSched S; S.init((const bf16_t*)(ws + WS_MIX), (const bf16_t*)(ws + WS_WOUT), NTOK, 1024, 1024, G, bx);
        EpiOutProj E{(const bf16_t*)(ws + WS_XB), (bf16_t*)(ws + WS_H1), (unsigned char*)(ws + WS_H1F8)};
        S.idg = true;
        pg8::gemm_phase<EpiOutProj, pg8::DenseSched, true, false, true>(lds, S, E);
    }
    SYNC(3);
    if (IN(4)) { FRESH_LANE(lane); router_phase(P, lds, vcu, G, tid, wave, lane); }
    SYNC(4);
    if (IN(5) || IN(6)) {
        LAS int* tb = (LAS int*)(lds + LDS_MISC); LAS int* cn = tb + 64;
        if (tid < NE) cn[tid] = (int)__hip_atomic_load((const unsigned*)(ws + WS_CTL) + CW_CNT + 64 * tid, __ATOMIC_RELAXED, __HIP_MEMORY_SCOPE_AGENT);
        __syncthreads();
        if (tid == 0) { int acc = 0;
            for (int e = 0; e < NE; ++e) { tb[e] = acc; acc += (cn[e] + BM - 1) / BM; }
            tb[NE] = acc; }
        __syncthreads();
        if (IN(5)) {
            pg8::MoeSched S; S.A = ws + WS_H1F8; S.Bt = ws + WS_WUP; S.rp = 1024; S.b_estride = (size_t)2048 * 1024; S.tb = tb; S.cnt = cn; S.list = (const int*)(ws + WS_LIST);
            S.nN = 8; S.nwg = tb[NE] * 8; S.G = G; S.c = bx; S.gather = true;
            { LAS int* ut = (LAS int*)(lds + LDS_MISC + 512); S.utab = ut; S.build_table(ut, tid); __syncthreads(); }
            S.m_scale = (const float*)(ws + WS_LSCALE); S.m_gate = nullptr; S.m_bias = P.b_up;
            EpiUp E{(unsigned char*)(ws + WS_ACT)};
            pg8::gemm_phase<EpiUp, pg8::MoeSched, true, true, true>(lds, S, E);
        }
        SYNC(5);
        if (IN(6)) {
            pg8::MoeSched S; S.A = ws + WS_ACT; S.Bt = ws + WS_WDOWN; S.rp = 1024; S.b_estride = (size_t)1024 * 1024; S.tb = tb; S.cnt = cn; S.list = (const int*)(ws + WS_LIST);
            S.nN = 4; S.nwg = tb[NE] * 4; S.G = G; S.c = bx; S.gather = false;
            { LAS int* ut = (LAS int*)(lds + LDS_MISC + 512); S.utab = ut; S.build_table(ut, tid); __syncthreads(); }
            S.m_scale = nullptr; S.m_gate = (const float*)(ws + WS_LGATE); S.m_bias = P.b_down;
            EpiDown E{(unsigned char*)(ws + WS_Y)};
            pg8::gemm_phase<EpiDown, pg8::MoeSched, true, true, true>(lds, S, E);
        }
    }
    SYNC(6);
    {
        const bool fused = (G == 256) && IN(7) && IN(8) && IN(9);
        const int j8 = bx >> 3, pm = (bx & 7) * 16 + (j8 >> 1), half = j8 & 1, r0 = pm * BM + half * 128;
        unsigned* ctl = (unsigned*)(ws + WS_CTL); unsigned* tmo = ctl + CW_BAR + XB_TMO;
        const bool same_xcd = fused && (xb_ld(ctl + CW_XCC + (bx ^ 8)) == xbar.x + 1u);
        if (IN(7)) { FRESH_LANE(l7);
            if (fused) combine_phase(P, r0 + wave, r0 + 128, NWAVES, l7); else combine_phase(P, vcu * NWAVES + wave, NTOK, NGW, l7); }
        if (fused) pair_sync(ctl + CW_PAIR + 16 * (2 * pm), tmo, same_xcd); else SYNC(7);
        if (IN(8)) {
            pg8::DenseSched S; S.init(ws + WS_H1F8, ws + WS_WG, NTOK, 1024, 1024, G, bx); S.rp = 1024; S.idg = true;
            if (fused) { S.pair_pm = pm; S.pair_pn0 = 2 * half; }
            EpiF8Plain E{(unsigned char*)(ws + WS_G), 1024, 0.03125f};
            pg8::gemm_phase<EpiF8Plain, pg8::DenseSched, true, true>(lds, S, E);
        }
        if (fused) pair_sync(ctl + CW_PAIR + 16 * (2 * pm + 1), tmo, same_xcd); else SYNC(8);
        if (IN(9)) { FRESH_LANE(l9);
            if (fused) final_phase(P, r0 + wave, r0 + 128, NWAVES, l9); else final_phase(P, vcu * NWAVES + wave, NTOK, NGW, l9); }
    }
#undef IN
#undef SYNC
}

#ifndef N_LAUNCH_MODE
#define N_LAUNCH_MODE 1
#endif
extern "C" void kernel_launch(void* const* d_in, const int* in_sizes, int n_in, void* d_out, int out_size, void* d_ws, size_t ws_size, hipStream_t stream) {
    static int grid = 0;
    if (grid == 0) {
        if (n_in != 21 || out_size != NTOK * DM || ws_size < WS_END) { fprintf(stderr, "kernel_launch: unexpected shapes (n_in %d out %d ws %zu)\n", n_in, out_size, ws_size); grid = -1; return; }
        int dev = 0, cus = 0, per_cu = 0;
        (void)hipGetDevice(&dev); (void)hipDeviceGetAttribute(&cus, hipDeviceAttributeMultiprocessorCount, dev);
        (void)hipFuncSetAttribute((const void*)fwd_kernel, hipFuncAttributeMaxDynamicSharedMemorySize, LDS_BYTES);
        if (hipOccupancyMaxActiveBlocksPerMultiprocessor(&per_cu, (const void*)fwd_kernel, NTHR, LDS_BYTES) != hipSuccess || per_cu < 1) { fprintf(stderr, "kernel_launch: occupancy query failed (%d)\n", per_cu); (void)hipGetLastError(); grid = -1; return; }
        grid = cus;
    }
    if (grid < 0) return;
    (void)hipMemsetAsync((char*)d_ws + WS_CTL, 0, CTL_BYTES, stream);
    Params p{};
    p.x = (const float*)d_in[0]; p.p = (const float*)d_in[1]; p.w_in = (const float*)d_in[2]; p.w_out = (const float*)d_in[3]; p.g_mix = (const float*)d_in[4]; p.g_ffn = (const float*)d_in[5];
    p.glu_b = (const float*)d_in[6]; p.dw_w = (const float*)d_in[7]; p.dw_b = (const float*)d_in[8]; p.ln_g = (const float*)d_in[9]; p.ln_b = (const float*)d_in[10];
    p.w_router = (const float*)d_in[11]; p.b_router = (const float*)d_in[12]; p.w_up = (const float*)d_in[13]; p.b_up = (const float*)d_in[14]; p.w_down = (const float*)d_in[15]; p.b_down = (const float*)d_in[16];
    p.w_ple_proj = (const float*)d_in[17]; p.w_ple_gate = (const float*)d_in[18]; p.g_ple = (const float*)d_in[19]; p.g_final = (const float*)d_in[20];
    p.out = (float*)d_out; p.ws = (unsigned char*)d_ws;
#if N_LAUNCH_MODE == 1
    p.ph_lo = 0; p.ph_hi = NPHASE;
    void* args[] = {&p};
    hipError_t e = hipLaunchCooperativeKernel((const void*)fwd_kernel, dim3(grid), dim3(NTHR), args, LDS_BYTES, stream);
    if (e != hipSuccess) fprintf(stderr, "cooperative launch failed: %s (grid %d)\n", hipGetErrorString(e), grid);
#else
    for (int ph = 0; ph < NPHASE; ++ph) {
        p.ph_lo = ph; p.ph_hi = ph + 1;
        void* args[] = {&p};
        hipError_t e = hipLaunchCooperativeKernel((const void*)fwd_kernel, dim3(grid), dim3(NTHR), args, LDS_BYTES, stream);
        if (e != hipSuccess) { fprintf(stderr, "launch %d failed: %s (grid %d)\n", ph, hipGetErrorString(e), grid); break; }
    }
#endif
}
```

```cpp
#include <hip/hip_runtime.h>
#include <hip/hip_cooperative_groups.h>
#include <cstdio>
#include <cstdint>
namespace cg = cooperative_groups;

#define LAS __attribute__((address_space(3)))
#define GAS __attribute__((address_space(1)))
typedef unsigned short bf16_t;
typedef short bf16x8 __attribute__((ext_vector_type(8)));
typedef short s16x4 __attribute__((ext_vector_type(4)));
typedef float f32x4 __attribute__((ext_vector_type(4)));
typedef float f32x2 __attribute__((ext_vector_type(2)));
typedef float f32x16 __attribute__((ext_vector_type(16)));
typedef unsigned u32x4 __attribute__((ext_vector_type(4)));
typedef unsigned u32x2 __attribute__((ext_vector_type(2)));

constexpr int NB = 8, SEQ = 4096, DM = 1024, NTOK = NB * SEQ;
constexpr int NE = 32, TOPK = 4, NSLOT = NTOK * TOPK;
constexpr int INW = 1988;
constexpr int NSEL = 256;
constexpr float EPS = 1e-6f;
constexpr int NWAVES = 8, NTHR = 512;

constexpr size_t MiB = 1u << 20;
constexpr size_t WS_CTL = 0, CTL_BYTES = 64 * 1024;
constexpr size_t WS_ROPE = 1 * MiB;
constexpr size_t WS_WIN = 2 * MiB;
constexpr size_t WS_WOUT = 6 * MiB;
constexpr size_t WS_WG = 8 * MiB;
constexpr size_t WS_WP = 10 * MiB;
constexpr size_t WS_WRG = 10 * MiB + 512 * 1024;
constexpr size_t WS_RS1 = 11 * MiB;
constexpr size_t WS_RS3 = 11 * MiB + 512 * 1024;
constexpr size_t WS_WI = 12 * MiB;
constexpr size_t WS_LIST = 13 * MiB;
constexpr size_t WS_LSCALE = 17 * MiB;
constexpr size_t WS_LGATE = 21 * MiB;
constexpr size_t WS_PB = 25 * MiB;
constexpr size_t WS_WUP = 42 * MiB;
constexpr size_t WS_WDOWN = 170 * MiB;
constexpr size_t WS_H1 = 234 * MiB;
constexpr size_t WS_H1B = 362 * MiB;
constexpr size_t WS_PJ = 426 * MiB;
constexpr size_t WS_XB = 490 * MiB;
constexpr size_t WS_Q = 554 * MiB;
constexpr size_t WS_K = 586 * MiB;
constexpr size_t WS_V = 590 * MiB;
constexpr size_t WS_QI = 594 * MiB;
constexpr size_t WS_KI = 610 * MiB;
constexpr size_t WS_HGLU = 614 * MiB;
constexpr size_t WS_MIX = 646 * MiB;
constexpr size_t WS_H1F8 = 298 * MiB;
constexpr size_t WS_ACT = 522 * MiB;
constexpr size_t WS_Y = 762 * MiB;
constexpr size_t WS_G = 762 * MiB;
constexpr size_t WS_END = 1018 * MiB;
static_assert(WS_H1F8 + (size_t)NTOK * 1024 <= WS_ACT && WS_ACT + (size_t)139264 * 1024 <= WS_Y, "ws map");
constexpr int CW_CNT = 1024;
constexpr int CW_AQ = 4096;
constexpr int CW_CQ = 4096 + 64 * 8;
constexpr int CW_BAR = 8192;
constexpr int CW_XCC = 7168;
constexpr int CW_PAIR = 12288;

constexpr int LDS_STAGE = 131072;
constexpr int LDS_MISC = LDS_STAGE;
constexpr int LDS_META = LDS_MISC + 4096;
constexpr int LDS_XB = 147456;
constexpr int LDS_BYTES = 147456 + 256;

__device__ __forceinline__ unsigned f2bf(float f) { unsigned u = __builtin_bit_cast(unsigned, f); return (u + 0x7fffu + ((u >> 16) & 1u)) >> 16; }
__device__ __forceinline__ unsigned pk2(float lo, float hi) { return f2bf(lo) | (f2bf(hi) << 16); }
__device__ __forceinline__ float bf_lo(unsigned w) { return __builtin_bit_cast(float, w << 16); }
__device__ __forceinline__ float bf_hi(unsigned w) { return __builtin_bit_cast(float, w & 0xffff0000u); }
__device__ __forceinline__ float wave_sum(float v) {
    v += __builtin_bit_cast(float, __builtin_amdgcn_update_dpp(0, __builtin_bit_cast(int, v), 0xB1, 0xF, 0xF, true));
    v += __builtin_bit_cast(float, __builtin_amdgcn_update_dpp(0, __builtin_bit_cast(int, v), 0x4E, 0xF, 0xF, true));
    v += __builtin_bit_cast(float, __builtin_amdgcn_update_dpp(0, __builtin_bit_cast(int, v), 0x141, 0xF, 0xF, true));
    v += __builtin_bit_cast(float, __builtin_amdgcn_update_dpp(0, __builtin_bit_cast(int, v), 0x140, 0xF, 0xF, true));
    const int vi = __builtin_bit_cast(int, v);
    const float r0 = __builtin_bit_cast(float, __builtin_amdgcn_readlane(vi, 0)), r1 = __builtin_bit_cast(float, __builtin_amdgcn_readlane(vi, 16));
    const float r2 = __builtin_bit_cast(float, __builtin_amdgcn_readlane(vi, 32)), r3 = __builtin_bit_cast(float, __builtin_amdgcn_readlane(vi, 48));
    return (r0 + r1) + (r2 + r3);
}
__device__ __forceinline__ unsigned pk4_fp8(float a, float b, float c, float d) { int r = __builtin_amdgcn_cvt_pk_fp8_f32(a, b, 0, false); r = __builtin_amdgcn_cvt_pk_fp8_f32(c, d, r, true); return (unsigned)r; }
__device__ __forceinline__ float sigmoidf_(float x) { return __builtin_amdgcn_rcpf(1.0f + __builtin_amdgcn_exp2f(x * -1.4426950408889634f)); }
#define LDS_WAIT() asm volatile("s_waitcnt lgkmcnt(0)" ::: "memory")
#define NT_LD(p) __builtin_nontemporal_load(p)
#define NT_ST(v, p) __builtin_nontemporal_store(v, p)

struct Params {
    const float* x; const float* p; const float* w_in; const float* w_out; const float* g_mix; const float* g_ffn;
    const float* glu_b; const float* dw_w; const float* dw_b; const float* ln_g; const float* ln_b;
    const float* w_router; const float* b_router; const float* w_up; const float* b_up; const float* w_down; const float* b_down;
    const float* w_ple_proj; const float* w_ple_gate; const float* g_ple; const float* g_final;
    float* out; unsigned char* ws;
    int ph_lo, ph_hi;
};

namespace pg8 {
constexpr int BM = 256, BK = 64, HALF = 128, HTB = HALF * BK * 2, STAGE_BYTES = 8 * HTB, NXCD = 8, WGM = 8;
__host__ __device__ __forceinline__ int lds_byte(int r, int c) { const int st = (r >> 4) * 2 + (c >> 5), rr = r & 15, cc = c & 31, ob = rr * 64 + cc * 2; return st * 1024 + (ob ^ (((ob >> 9) & 1) << 5)); }
__host__ __device__ __forceinline__ void stage_rc(int b, int& R, int& C) { const int st = b / 1024, sb = b % 1024, swz = sb ^ (((sb >> 9) & 1) << 5); R = (st >> 1) * 16 + swz / 64; C = (st & 1) * 32 + (swz % 64) / 2; }
__host__ __device__ __forceinline__ int perm32(int rho) { const int n = rho >> 4, i = rho & 15; return 8 * (i >> 2) + 4 * n + (i & 3); }

struct Unit { int pm, pn, e, rows; };

__device__ __forceinline__ unsigned cvt_pk_bf16(float lo, float hi) { unsigned r; asm volatile("v_cvt_pk_bf16_f32 %0, %1, %2" : "=v"(r) : "v"(lo), "v"(hi)); return r; }

struct DenseSched {
    const void* A; const void* Bt; int rp;
    int nM, nN, nwg, G, c;
    __device__ void init(const void* A_, const void* Bt_, int M, int N, int K_, int G_, int c_) { A = A_; Bt = Bt_; rp = K_ * 2; nM = M / BM; nN = N / BM; nwg = nM * nN; G = G_; c = c_; }
    int pair_pm = -1, pair_pn0 = 0;
    __device__ bool next(int i, Unit& u) const {
        if (pair_pm >= 0) { if (i >= 2) return false; u.pm = pair_pm; u.pn = pair_pn0 + i; u.e = 0; u.rows = BM; return true; }
        const long L = (long)i * G + c; if (L >= nwg) return false;
        int wgid = (int)L; { const int q = nwg / NXCD, r = nwg % NXCD, xcd = wgid % NXCD, off = wgid / NXCD; wgid = (xcd < r ? xcd * (q + 1) : r * (q + 1) + (xcd - r) * q) + off; }
        const int nig = WGM * nN, gid = wgid / nig, fm = gid * WGM, gsz = (nM - fm) < WGM ? (nM - fm) : WGM;
        u.pm = fm + ((wgid % nig) % gsz); u.pn = (wgid % nig) / gsz; u.e = 0; u.rows = BM; return true;
    }
    bool idg = false;
    __device__ __forceinline__ const char* a_ptr(const Unit& u) const { return idg ? (const char*)A : (const char*)A + (size_t)u.pm * BM * rp; }
    __device__ __forceinline__ const char* b_ptr(const Unit& u) const { return (const char*)Bt + (size_t)u.pn * BM * rp; }
    __device__ __forceinline__ int a_row(const Unit& u, int r) const { return u.pm * BM + r; }
    __device__ __forceinline__ void meta(const Unit&, LAS unsigned char*, int, int) const {}
};

struct MoeSched {
    const void* A; const void* Bt; int rp; size_t b_estride;
    const LAS int* tb;
    const LAS int* cnt;
    const int* list;
    int nN, nwg, G, c; bool gather;
    const LAS int* utab;
    __device__ __forceinline__ bool next(int i, Unit& u) const {
        if (i >= 32) return false;
        const LAS int* p = utab + 4 * i; const int rows = p[3]; if (rows < 0) return false;
        u.pm = p[0]; u.pn = p[1]; u.e = p[2]; u.rows = rows; return true;
    }
    __device__ __forceinline__ void build_table(LAS int* tab, int tid) const {
        if (tid < 32) { Unit u; const bool ok = decode(tid, u); tab[4 * tid] = u.pm; tab[4 * tid + 1] = u.pn; tab[4 * tid + 2] = u.e; tab[4 * tid + 3] = ok ? u.rows : -1; }
    }
    __device__ __forceinline__ bool decode(int i, Unit& u) const {
        u.pm = 0; u.pn = 0; u.e = 0; u.rows = 0;
        const long L = (long)i * G + c; if (L >= nwg) return false;
        int wgid = (int)L; { const int q = nwg / NXCD, r = nwg % NXCD, xcd = wgid % NXCD, off = wgid / NXCD; wgid = (xcd < r ? xcd * (q + 1) : r * (q + 1) + (xcd - r) * q) + off; }
        int e = 0;
#pragma unroll 1
        for (; e < NE - 1; ++e) { if (wgid < tb[e + 1] * nN) break; }
        const int local = wgid - tb[e] * nN, nM = tb[e + 1] - tb[e];
        const int nig = WGM * nN, gid = local / nig, fm = gid * WGM, gsz = (nM - fm) < WGM ? (nM - fm) : WGM;
        const int rt = fm + ((local % nig) % gsz);
        u.pm = tb[e] + rt; u.pn = (local % nig) / gsz; u.e = e;
        const int left = cnt[e] - rt * BM; u.rows = left < BM ? left : BM; return true;
    }
    __device__ __forceinline__ const char* a_ptr(const Unit& u) const { return (const char*)A; }
    __device__ __forceinline__ const char* b_ptr(const Unit& u) const { return (const char*)Bt + (size_t)u.e * b_estride + (size_t)u.pn * BM * rp; }
    __device__ __forceinline__ int a_row(const Unit& u, int r) const {
        if (!gather) return u.pm * BM + r;
        const int rt = u.pm - tb[u.e];
        return r < u.rows ? (list[u.e * NTOK + rt * BM + r] >> 2) : 0;
    }
    const float* m_scale; const float* m_gate; const float* m_bias;
    __device__ __forceinline__ void meta(const Unit& u, LAS unsigned char* tbl, int wid, int lane) const {
        const int rt = u.pm - tb[u.e]; const size_t li = (size_t)u.e * NTOK + rt * BM + (wid & 3) * 64 + lane;
        if (gather) {
            if (wid < 4) __builtin_amdgcn_global_load_lds((const unsigned*)(m_scale + li), (LAS unsigned*)(tbl + (wid & 3) * 256), 4, 0, 0);
            else { const int j = (wid & 3) * 64 + lane; const float* src = m_bias + (size_t)u.e * 2048 + (j < 128 ? 128 * u.pn + j : 1024 + 128 * u.pn + (j - 128));
                __builtin_amdgcn_global_load_lds((const unsigned*)src, (LAS unsigned*)(tbl + 2048 + (wid & 3) * 256), 4, 0, 0); }
        } else {
            if (wid < 4) { __builtin_amdgcn_global_load_lds((const unsigned*)(list + li), (LAS unsigned*)(tbl + (wid & 3) * 256), 4, 0, 0);
                __builtin_amdgcn_global_load_lds((const unsigned*)(m_bias + (size_t)u.e * 1024 + u.pn * BM + (wid & 3) * 64 + lane), (LAS unsigned*)(tbl + 2048 + (wid & 3) * 256), 4, 0, 0); }
            else __builtin_amdgcn_global_load_lds((const unsigned*)(m_gate + li), (LAS unsigned*)(tbl + 1024 + (wid & 3) * 256), 4, 0, 0);
        }
    }
};

typedef int v8i32 __attribute__((ext_vector_type(8)));
template <class Epi, class Sched, bool GATHER, bool F8 = false, bool WARMTRIP = false>
__device__ __forceinline__ void gemm_phase(LAS unsigned char* lds, const Sched& S, const Epi& E) {
    const int tid = threadIdx.x, wid = __builtin_amdgcn_readfirstlane(tid >> 6), lane = tid & 63, wr = wid >> 2, wc = wid & 3, fr = lane & 15, fq = lane >> 4;
    const int RP = S.rp, nt = RP / (BK * 2);
    unsigned voffA[2], voffB[2]; int RA[2], CA[2];
#pragma unroll
    for (int i = 0; i < 2; ++i) { int R, C; stage_rc(tid * 16 + i * 8192, R, C); const int Rb = Epi::PERM ? ((R & ~31) + perm32(R & 31)) : R;
        voffA[i] = (unsigned)(R * RP + C * 2); voffB[i] = (unsigned)(Rb * RP + C * 2); RA[i] = R; CA[i] = C; }
    const size_t kstep = (size_t)(BK * 2);
    const size_t hstep = (size_t)HALF * RP;
    const unsigned ldsw = (unsigned)wid * 1024u;
    const int aoff = lds_byte(wr * 64 + fr, fq * 8), boff = lds_byte(wc * 32 + fr, fq * 8);
    unsigned gC[2][2], gN[2][2];
#define PG8_SA(b, h) (((b) * 2 + (h)) * HTB)
#define PG8_SB(b, h) ((4 + (b) * 2 + (h)) * HTB)
#define PG8_STAGE(bufoff, gbase, voff) do { _Pragma("unroll") for (int _i = 0; _i < 2; ++_i) \
        __builtin_amdgcn_global_load_lds((const unsigned*)((const char*)(gbase) + (voff)[_i]), (LAS unsigned*)(lds + (bufoff) + ldsw + _i * 8192), 16, 0, 0); } while (0)
#define PG8_STAGE_A(bufoff, kp, h) do { if constexpr (GATHER) { PG8_STAGE(bufoff, kp, gC[h]); } else { PG8_STAGE(bufoff, (kp) + (h) * hstep, voffA); } } while (0)
#define PG8_LD16(p) (*(const LAS bf16x8*)(p))
#define PG8_CAT(lo, hi) __builtin_bit_cast(v8i32, __builtin_shufflevector(lo, hi, 0, 1, 2, 3, 4, 5, 6, 7, 8, 9, 10, 11, 12, 13, 14, 15))
#define PG8_LDA(dst, b, h) do { _Pragma("unroll") for (int m = 0; m < 4; ++m) { if constexpr (F8) { dst##8[m] = PG8_CAT(PG8_LD16(lds + PG8_SA(b, h) + aoff + m * 2048), PG8_LD16(lds + PG8_SA(b, h) + aoff + m * 2048 + 1024)); } \
        else { _Pragma("unroll") for (int k = 0; k < 2; ++k) dst[m][k] = PG8_LD16(lds + PG8_SA(b, h) + aoff + m * 2048 + k * 1024); } } } while (0)
#define PG8_LDB(dst, b, h) do { _Pragma("unroll") for (int n = 0; n < 2; ++n) { if constexpr (F8) { dst##8[n] = PG8_CAT(PG8_LD16(lds + PG8_SB(b, h) + boff + n * 2048), PG8_LD16(lds + PG8_SB(b, h) + boff + n * 2048 + 1024)); } \
        else { _Pragma("unroll") for (int k = 0; k < 2; ++k) dst[n][k] = PG8_LD16(lds + PG8_SB(b, h) + boff + n * 2048 + k * 1024); } } } while (0)
#define PG8_MMA(ai, bj, At, Bt) do { __builtin_amdgcn_s_setprio(1); _Pragma("unroll") for (int m = 0; m < 4; ++m) _Pragma("unroll") for (int n = 0; n < 2; ++n) { \
        if constexpr (F8) { acc[ai][bj][m][n] = __builtin_amdgcn_mfma_scale_f32_16x16x128_f8f6f4(Bt##8[n], At##8[m], acc[ai][bj][m][n], 0, 0, 0, 0x7f7f7f7f, 0, 0x7f7f7f7f); } \
        else { _Pragma("unroll") for (int k = 0; k < 2; ++k) acc[ai][bj][m][n] = __builtin_amdgcn_mfma_f32_16x16x32_bf16(Bt[n][k], At[m][k], acc[ai][bj][m][n], 0, 0, 0); } } \
        __builtin_amdgcn_s_setprio(0); } while (0)
#define PG8_WAIT_V(n) asm volatile("s_waitcnt vmcnt(" #n ")" ::: "memory")
#define PG8_WAIT_L(n) asm volatile("s_waitcnt lgkmcnt(" #n ")" ::: "memory")
#define PG8_BAR __builtin_amdgcn_s_barrier()
#define PG8_SCHED __builtin_amdgcn_sched_barrier(0)
#define PG8_GOFF(dst, u) do { _Pragma("unroll") for (int _h = 0; _h < 2; ++_h) _Pragma("unroll") for (int _i = 0; _i < 2; ++_i) \
        dst[_h][_i] = (unsigned)(S.a_row(u, _h * HALF + RA[_i]) * RP + CA[_i] * 2); } while (0)
    Unit cur, nxt, nn; int ui = 0;
    if (!S.next(0, cur)) return;
    bool has_next = S.next(1, nxt);
    if constexpr (GATHER) { PG8_GOFF(gC, cur); if (has_next) { PG8_GOFF(gN, nxt); } else { PG8_GOFF(gN, cur); } }
    f32x4 acc[2][2][4][2];
#pragma unroll
    for (int a = 0; a < 2; ++a)
#pragma unroll
        for (int b = 0; b < 2; ++b)
#pragma unroll
            for (int m = 0; m < 4; ++m)
#pragma unroll
                for (int n = 0; n < 2; ++n) acc[a][b][m][n] = (f32x4){0.f, 0.f, 0.f, 0.f};
    bf16x8 At[4][2], B0[2][2], B1[2][2]; v8i32 At8[4], B08[2], B18[2];
    const char* cA = S.a_ptr(cur); const char* cB = S.b_ptr(cur);
    PG8_STAGE(PG8_SB(0, 0), cB, voffB); PG8_STAGE(PG8_SB(0, 1), cB + hstep, voffB); PG8_STAGE_A(PG8_SA(0, 0), cA, 0); PG8_STAGE_A(PG8_SA(0, 1), cA, 1);
    if (wr == 1) PG8_BAR;
    PG8_WAIT_V(2); PG8_BAR;
    PG8_STAGE(PG8_SB(1, 0), cB + kstep, voffB); PG8_STAGE_A(PG8_SA(1, 0), cA + kstep, 0); PG8_STAGE(PG8_SB(1, 1), cB + hstep + kstep, voffB);
    PG8_WAIT_V(6); PG8_BAR;
    for (;;) {
        const char* nA = has_next ? S.a_ptr(nxt) : cA; const char* nB = has_next ? S.b_ptr(nxt) : cB;
        S.meta(cur, lds + (LDS_META - 0) + (ui & 1) * 4096, wid, lane);
#define PG8_TRIP(WARM, t) do { \
            const bool last = ((t) == nt - 2); \
            const char* a1 = cA + (size_t)((t) + 1) * kstep; \
            const char* a2 = last ? nA : cA + (size_t)((t) + 2) * kstep; const char* b2 = last ? nB : cB + (size_t)((t) + 2) * kstep; \
            const char* a3 = a2 + kstep; const char* b3 = b2 + kstep; \
              \
            PG8_LDB(B0, 0, 0); PG8_LDB(B1, 0, 1); PG8_SCHED; PG8_LDA(At, 0, 0); if constexpr (!(WARM)) { PG8_STAGE_A(PG8_SA(1, 1), a1, 1); } \
            if constexpr (GATHER) { if (last) { _Pragma("unroll") for (int h = 0; h < 2; ++h) _Pragma("unroll") for (int i = 0; i < 2; ++i) gC[h][i] = gN[h][i]; } } \
            if constexpr (!(WARM)) { PG8_WAIT_V(8); } PG8_WAIT_L(0); PG8_BAR; PG8_MMA(0, 0, At, B0); PG8_MMA(0, 1, At, B1); PG8_BAR; PG8_SCHED; \
              \
            PG8_LDA(At, 0, 1); PG8_STAGE(PG8_SB(0, 0), b2, voffB); PG8_STAGE(PG8_SB(0, 1), b2 + hstep, voffB); PG8_STAGE_A(PG8_SA(0, 0), a2, 0); \
            if constexpr (!(WARM)) { PG8_WAIT_V(8); } PG8_WAIT_L(0); PG8_BAR; PG8_MMA(1, 0, At, B0); PG8_MMA(1, 1, At, B1); PG8_BAR; PG8_SCHED; \
              \
            PG8_LDB(B0, 1, 0); PG8_LDB(B1, 1, 1); PG8_SCHED; PG8_LDA(At, 1, 0); PG8_STAGE_A(PG8_SA(0, 1), a2, 1); \
            if constexpr (!(WARM)) { PG8_WAIT_V(8); } PG8_WAIT_L(0); PG8_BAR; PG8_MMA(0, 0, At, B0); PG8_MMA(0, 1, At, B1); PG8_BAR; PG8_SCHED; \
              \
            PG8_LDA(At, 1, 1); PG8_STAGE(PG8_SB(1, 0), b3, voffB); PG8_STAGE(PG8_SB(1, 1), b3 + hstep, voffB); PG8_STAGE_A(PG8_SA(1, 0), a3, 0); \
            PG8_WAIT_V(8); PG8_WAIT_L(0); PG8_BAR; PG8_MMA(1, 0, At, B0); PG8_MMA(1, 1, At, B1); PG8_BAR; PG8_SCHED; \
        } while (0)
        int t0_ = 0;
        if constexpr (WARMTRIP) { if (ui > 0) { PG8_TRIP(true, 0); t0_ = 2; } }
        for (int t = t0_; t < nt; t += 2) { PG8_TRIP(false, t); }
#undef PG8_TRIP
        if (wr == 0) PG8_BAR;
        if constexpr (WARMTRIP) { PG8_STAGE_A(PG8_SA(1, 1), nA + kstep, 1); }
        bool has_nn = false;
        if constexpr (GATHER) { if (has_next) { has_nn = S.next(ui + 2, nn); if (has_nn) { PG8_GOFF(gN, nn); } } }
        else { if (has_next) has_nn = S.next(ui + 2, nn); }
        { int ln_; asm volatile("v_mbcnt_lo_u32_b32 %0, -1, 0\n\tv_mbcnt_hi_u32_b32 %0, -1, %0" : "=v"(ln_)); const int fr_ = ln_ & 15, fq_ = ln_ >> 4;
          const LAS unsigned char* mt = lds + LDS_META + (ui & 1) * 4096;
          if constexpr (WARMTRIP) {
              E.pre(acc, cur, wr, wc, fr_, fq_, mt);
              if constexpr (GATHER) asm volatile("" : "+v"(gN[0][0]), "+v"(gN[0][1]), "+v"(gN[1][0]), "+v"(gN[1][1]));
              PG8_WAIT_V(0);
              E.post(acc, cur, wr, wc, fr_, fq_, mt);
          } else { E.run(acc, cur, wr, wc, fr_, fq_, mt); } }
        if (!has_next) break;
#pragma unroll
        for (int a = 0; a < 2; ++a)
#pragma unroll
            for (int b = 0; b < 2; ++b)
#pragma unroll
                for (int m = 0; m < 4; ++m)
#pragma unroll
                    for (int n = 0; n < 2; ++n) acc[a][b][m][n] = (f32x4){0.f, 0.f, 0.f, 0.f};
        cur = nxt; cA = nA; cB = nB; ++ui; nxt = nn; has_next = has_nn;
        if (wr == 1) PG8_BAR;
    }
    PG8_WAIT_V(0);
    PG8_BAR;
#undef PG8_SA
#undef PG8_SB
#undef PG8_STAGE
#undef PG8_STAGE_A
#undef PG8_LDA
#undef PG8_LDB
#undef PG8_MMA
#undef PG8_LD16
#undef PG8_CAT
#undef PG8_WAIT_V
#undef PG8_WAIT_L
#undef PG8_BAR
#undef PG8_SCHED
#undef PG8_GOFF
}
}

using pg8::Unit; using pg8::cvt_pk_bf16;
constexpr int BM = 256, HALF = 128;

typedef f32x4 (&AccRef)[2][2][4][2];
__device__ __forceinline__ void pack8_bf16(f32x4& lo, const f32x4& hi) {
    const unsigned w0 = cvt_pk_bf16(lo[0], lo[1]), w1 = cvt_pk_bf16(lo[2], lo[3]), w2 = cvt_pk_bf16(hi[0], hi[1]), w3 = cvt_pk_bf16(hi[2], hi[3]);
    lo[0] = __builtin_bit_cast(float, w0); lo[1] = __builtin_bit_cast(float, w1); lo[2] = __builtin_bit_cast(float, w2); lo[3] = __builtin_bit_cast(float, w3);
}
#define AS_U4(v) __builtin_bit_cast(u32x4, v)

struct EpiInProj {
    static constexpr bool PERM = true;
    const float* rs1; const f32x2* rope; const float* glu_b;
    bf16_t *q, *k, *v, *qi, *ki, *hglu; float* wi;
    __device__ __forceinline__ void pre(AccRef acc, const Unit& u, int wr, int wc, int fr, int fq, const LAS unsigned char* mt) const {
        const int row0 = u.pm * BM + wr * 64 + fr;
        if (u.pn >= 4) {
            const int ch = 128 * (u.pn - 4) + 32 * wc + 8 * fq;
            f32x4 ba[2], bg[2];
#pragma unroll
            for (int n = 0; n < 2; ++n) { ba[n] = *(const f32x4*)(glu_b + ch + 4 * n); bg[n] = *(const f32x4*)(glu_b + 512 + ch + 4 * n); }
#pragma unroll
            for (int ai = 0; ai < 2; ++ai)
#pragma unroll
                for (int m = 0; m < 4; ++m) { const float rs = rs1[row0 + ai * HALF + m * 16];
#pragma unroll
                    for (int n = 0; n < 2; ++n)
#pragma unroll
                        for (int e = 0; e < 4; ++e) { const float a = acc[ai][0][m][n][e] * rs + ba[n][e], g = acc[ai][1][m][n][e] * rs + bg[n][e]; acc[ai][0][m][n][e] = a * sigmoidf_(g); }
                    pack8_bf16(acc[ai][0][m][0], acc[ai][0][m][1]); }
            return;
        }
        const bool do_rope = !(u.pn == 3 && wc >= 2), is_wi = (u.pn == 3 && wc == 3);
        const int d0 = 8 * fq;
#pragma unroll
        for (int ai = 0; ai < 2; ++ai)
#pragma unroll
            for (int m = 0; m < 4; ++m) { const int row = row0 + ai * HALF + m * 16; const float rs = rs1[row];
                if (do_rope) {
                    const f32x2* rp = rope + (size_t)(row & (SEQ - 1)) * 32 + d0;
#pragma unroll
                    for (int n = 0; n < 2; ++n)
#pragma unroll
                        for (int e = 0; e < 4; ++e) { const f32x2 cs = rp[4 * n + e]; const float x1 = acc[ai][0][m][n][e] * rs, x2 = acc[ai][1][m][n][e] * rs;
                            acc[ai][0][m][n][e] = x1 * cs.x - x2 * cs.y; acc[ai][1][m][n][e] = x2 * cs.x + x1 * cs.y; }
                } else {
#pragma unroll
                    for (int n = 0; n < 2; ++n) { acc[ai][0][m][n] = acc[ai][0][m][n] * rs; acc[ai][1][m][n] = acc[ai][1][m][n] * rs; }
                }
                if (!is_wi) { pack8_bf16(acc[ai][0][m][0], acc[ai][0][m][1]); pack8_bf16(acc[ai][1][m][0], acc[ai][1][m][1]); }
                if (m & 1) __builtin_amdgcn_sched_barrier(0); }
    }
    __device__ __forceinline__ void post(AccRef acc, const Unit& u, int wr, int wc, int fr, int fq, const LAS unsigned char* mt) const {
        const int row0 = u.pm * BM + wr * 64 + fr;
        if (u.pn >= 4) {
            const int ch = 128 * (u.pn - 4) + 32 * wc + 8 * fq;
#pragma unroll
            for (int ai = 0; ai < 2; ++ai)
#pragma unroll
                for (int m = 0; m < 4; ++m) *(u32x4*)(hglu + (size_t)(row0 + ai * HALF + m * 16) * 512 + ch) = AS_U4(acc[ai][0][m][0]);
            return;
        }
        bf16_t* dst; int ld, col; bool is_wi = false;
        if (u.pn < 2) { dst = q; ld = 512; col = (4 * u.pn + wc) * 64; }
        else if (u.pn == 2) { dst = qi; ld = 256; col = wc * 64; }
        else { ld = 64; col = 0; if (wc == 0) dst = k; else if (wc == 1) dst = ki; else if (wc == 2) dst = v; else { dst = v; is_wi = true; } }
        if (is_wi) {
            if (fq == 0) {
#pragma unroll
                for (int ai = 0; ai < 2; ++ai)
#pragma unroll
                    for (int m = 0; m < 4; ++m) *(f32x4*)(wi + (size_t)(row0 + ai * HALF + m * 16) * 4) = acc[ai][0][m][0];
            }
            return;
        }
#pragma unroll
        for (int ai = 0; ai < 2; ++ai)
#pragma unroll
            for (int m = 0; m < 4; ++m) { bf16_t* rp2 = dst + (size_t)(row0 + ai * HALF + m * 16) * ld + col + 8 * fq;
                *(u32x4*)(rp2) = AS_U4(acc[ai][0][m][0]); *(u32x4*)(rp2 + 32) = AS_U4(acc[ai][1][m][0]); }
    }
    __device__ __forceinline__ void run(const f32x4 (&acc)[2][2][4][2], const Unit& u, int wr, int wc, int fr, int fq, const LAS unsigned char* mt) const {
        const int row0 = u.pm * BM + wr * 64 + fr;
        if (u.pn >= 4) {
            const int ch = 128 * (u.pn - 4) + 32 * wc + 8 * fq;
            f32x4 ba[2], bg[2];
#pragma unroll
            for (int n = 0; n < 2; ++n) { ba[n] = *(const f32x4*)(glu_b + ch + 4 * n); bg[n] = *(const f32x4*)(glu_b + 512 + ch + 4 * n); }
#pragma unroll
            for (int ai = 0; ai < 2; ++ai)
#pragma unroll
                for (int m = 0; m < 4; ++m) { const int row = row0 + ai * HALF + m * 16; const float rs = rs1[row];
                    float o[8];
#pragma unroll
                    for (int n = 0; n < 2; ++n)
#pragma unroll
                        for (int e = 0; e < 4; ++e) { const float a = acc[ai][0][m][n][e] * rs + ba[n][e], g = acc[ai][1][m][n][e] * rs + bg[n][e]; o[4 * n + e] = a * sigmoidf_(g); }
                    u32x4 w; w.x = cvt_pk_bf16(o[0], o[1]); w.y = cvt_pk_bf16(o[2], o[3]); w.z = cvt_pk_bf16(o[4], o[5]); w.w = cvt_pk_bf16(o[6], o[7]);
                    *(u32x4*)(hglu + (size_t)row * 512 + ch) = w; }
            return;
        }
        bf16_t* dst; int ld, col; bool do_rope = true, is_wi = false;
        if (u.pn < 2) { dst = q; ld = 512; col = (4 * u.pn + wc) * 64; }
        else if (u.pn == 2) { dst = qi; ld = 256; col = wc * 64; }
        else { ld = 64; col = 0; if (wc == 0) dst = k; else if (wc == 1) dst = ki; else if (wc == 2) { dst = v; do_rope = false; } else { dst = v; is_wi = true; do_rope = false; } }
        if (is_wi) {
            if (fq == 0) {
#pragma unroll
                for (int ai = 0; ai < 2; ++ai)
#pragma unroll
                    for (int m = 0; m < 4; ++m) { const int row = row0 + ai * HALF + m * 16; const float rs = rs1[row];
                        *(f32x4*)(wi + (size_t)row * 4) = acc[ai][0][m][0] * rs; }
            }
            return;
        }
        const int d0 = 8 * fq;
#pragma unroll
        for (int ai = 0; ai < 2; ++ai)
#pragma unroll
            for (int m = 0; m < 4; ++m) { const int row = row0 + ai * HALF + m * 16; const float rs = rs1[row];
                float o1[8], o2[8];
                if (do_rope) {
                    const f32x4* rp = (const f32x4*)(rope + (size_t)(row & (SEQ - 1)) * 32 + d0);
#pragma unroll
                    for (int n = 0; n < 2; ++n)
#pragma unroll
                        for (int e2 = 0; e2 < 2; ++e2) { const f32x4 cs = rp[2 * n + e2];
                            { const float x1 = acc[ai][0][m][n][2 * e2] * rs, x2 = acc[ai][1][m][n][2 * e2] * rs; o1[4 * n + 2 * e2] = x1 * cs.x - x2 * cs.y; o2[4 * n + 2 * e2] = x2 * cs.x + x1 * cs.y; }
                            { const float x1 = acc[ai][0][m][n][2 * e2 + 1] * rs, x2 = acc[ai][1][m][n][2 * e2 + 1] * rs; o1[4 * n + 2 * e2 + 1] = x1 * cs.z - x2 * cs.w; o2[4 * n + 2 * e2 + 1] = x2 * cs.z + x1 * cs.w; } }
                } else {
#pragma unroll
                    for (int n = 0; n < 2; ++n)
#pragma unroll
                        for (int e = 0; e < 4; ++e) { o1[4 * n + e] = acc[ai][0][m][n][e] * rs; o2[4 * n + e] = acc[ai][1][m][n][e] * rs; }
                }
                u32x4 w1, w2; w1.x = cvt_pk_bf16(o1[0], o1[1]); w1.y = cvt_pk_bf16(o1[2], o1[3]); w1.z = cvt_pk_bf16(o1[4], o1[5]); w1.w = cvt_pk_bf16(o1[6], o1[7]);
                w2.x = cvt_pk_bf16(o2[0], o2[1]); w2.y = cvt_pk_bf16(o2[2], o2[3]); w2.z = cvt_pk_bf16(o2[4], o2[5]); w2.w = cvt_pk_bf16(o2[6], o2[7]);
                if (u.pn == 3 && wc == 1) {
                    bf16_t* tp = ki + ((size_t)(row >> 5) * 256 + (row & 31) + 32 * (fq & 1)) * 8;
                    *(u32x4*)(tp + (size_t)(fq >> 1) * 512) = w1; *(u32x4*)(tp + (size_t)(2 + (fq >> 1)) * 512) = w2;
                } else {
                    bf16_t* rp2 = dst + (size_t)row * ld + col + d0;
                    *(u32x4*)(rp2) = w1; *(u32x4*)(rp2 + 32) = w2; } }
    }
};

struct EpiBf16Plain {
    static constexpr bool PERM = true;
    bf16_t* O; int ldc; float scale;
    __device__ __forceinline__ void pre(AccRef acc, const Unit&, int, int, int, int, const LAS unsigned char*) const {
#pragma unroll
        for (int ai = 0; ai < 2; ++ai)
#pragma unroll
            for (int bj = 0; bj < 2; ++bj)
#pragma unroll
                for (int m = 0; m < 4; ++m) { acc[ai][bj][m][0] = acc[ai][bj][m][0] * scale; acc[ai][bj][m][1] = acc[ai][bj][m][1] * scale; pack8_bf16(acc[ai][bj][m][0], acc[ai][bj][m][1]); }
    }
    __device__ __forceinline__ void post(AccRef acc, const Unit& u, int wr, int wc, int fr, int fq, const LAS unsigned char* mt) const {
        const int row0 = u.pm * BM + wr * 64 + fr, col0 = u.pn * BM + wc * 32 + 8 * fq;
#pragma unroll
        for (int ai = 0; ai < 2; ++ai)
#pragma unroll
            for (int m = 0; m < 4; ++m) { bf16_t* rowp = O + (size_t)(row0 + ai * HALF + m * 16) * ldc + col0;
#pragma unroll
                for (int bj = 0; bj < 2; ++bj) *(u32x4*)(rowp + bj * HALF) = AS_U4(acc[ai][bj][m][0]); }
    }
    __device__ __forceinline__ void run(const f32x4 (&acc)[2][2][4][2], const Unit& u, int wr, int wc, int fr, int fq, const LAS unsigned char* mt) const {
        const int row0 = u.pm * BM + wr * 64 + fr, col0 = u.pn * BM + wc * 32 + 8 * fq;
#pragma unroll
        for (int ai = 0; ai < 2; ++ai)
#pragma unroll
            for (int m = 0; m < 4; ++m) { bf16_t* rowp = O + (size_t)(row0 + ai * HALF + m * 16) * ldc + col0;
#pragma unroll
                for (int bj = 0; bj < 2; ++bj) { const f32x4 v0 = acc[ai][bj][m][0] * scale, v1 = acc[ai][bj][m][1] * scale;
                    u32x4 w; w.x = cvt_pk_bf16(v0[0], v0[1]); w.y = cvt_pk_bf16(v0[2], v0[3]); w.z = cvt_pk_bf16(v1[0], v1[1]); w.w = cvt_pk_bf16(v1[2], v1[3]);
                    *(u32x4*)(rowp + bj * HALF) = w; } }
    }
};

struct EpiF8Plain {
    static constexpr bool PERM = true;
    unsigned char* O; int ldc; float scale;
    __device__ __forceinline__ void pre(AccRef acc, const Unit&, int, int, int, int, const LAS unsigned char*) const {}
    __device__ __forceinline__ void post(AccRef acc, const Unit& u, int wr, int wc, int fr, int fq, const LAS unsigned char* mt) const {
        const int row0 = u.pm * BM + wr * 64 + fr, col0 = u.pn * BM + wc * 32 + 8 * fq;
#pragma unroll
        for (int ai = 0; ai < 2; ++ai)
#pragma unroll
            for (int m = 0; m < 4; ++m) { unsigned char* rowp = O + (size_t)(row0 + ai * HALF + m * 16) * ldc + col0;
#pragma unroll
                for (int bj = 0; bj < 2; ++bj) { const f32x4 v0 = acc[ai][bj][m][0] * scale, v1 = acc[ai][bj][m][1] * scale;
                    u32x2 w; w.x = pk4_fp8(v0[0], v0[1], v0[2], v0[3]); w.y = pk4_fp8(v1[0], v1[1], v1[2], v1[3]);
                    *(u32x2*)(rowp + bj * HALF) = w; } }
    }
    __device__ __forceinline__ void run(AccRef acc, const Unit& u, int wr, int wc, int fr, int fq, const LAS unsigned char* mt) const { post(acc, u, wr, wc, fr, fq, mt); }
};

struct EpiOutProj {
    static constexpr bool PERM = false;
    const bf16_t* xb; bf16_t* h1; unsigned char* h1f8;
    __device__ __forceinline__ void pre(AccRef acc, const Unit& u, int wr, int wc, int fr, int fq, const LAS unsigned char* mt) const {
        const unsigned off0 = (unsigned)((u.pm * BM + wr * 64 + fr) * DM + u.pn * BM + wc * 32 + 8 * fq) * 2u;
        const unsigned char* xbb = (const unsigned char*)xb;
#pragma unroll
        for (int ai = 0; ai < 2; ++ai)
#pragma unroll
            for (int m = 0; m < 4; ++m) {
#pragma unroll
                for (int bj = 0; bj < 2; ++bj) { const u32x4 w = NT_LD((const u32x4*)(xbb + (off0 + (unsigned)(((ai * HALF + m * 16) * DM + bj * HALF) * 2))));
                    f32x4& v0 = acc[ai][bj][m][0]; f32x4& v1 = acc[ai][bj][m][1]; constexpr float SC = 1.0f / 512.0f;
                    v0[0] = fmaf(v0[0], SC, bf_lo(w.x)); v0[1] = fmaf(v0[1], SC, bf_hi(w.x)); v0[2] = fmaf(v0[2], SC, bf_lo(w.y)); v0[3] = fmaf(v0[3], SC, bf_hi(w.y));
                    v1[0] = fmaf(v1[0], SC, bf_lo(w.z)); v1[1] = fmaf(v1[1], SC, bf_hi(w.z)); v1[2] = fmaf(v1[2], SC, bf_lo(w.w)); v1[3] = fmaf(v1[3], SC, bf_hi(w.w)); }
                if (m & 1) __builtin_amdgcn_sched_barrier(0); }
    }
    __device__ __forceinline__ void post(AccRef acc, const Unit& u, int wr, int wc, int fr, int fq, const LAS unsigned char* mt) const {
        const unsigned off0 = (unsigned)((u.pm * BM + wr * 64 + fr) * DM + u.pn * BM + wc * 32 + 8 * fq);
        unsigned char* h1bb = (unsigned char*)h1;
#pragma unroll
        for (int ai = 0; ai < 2; ++ai)
#pragma unroll
            for (int m = 0; m < 4; ++m)
#pragma unroll
                for (int bj = 0; bj < 2; ++bj) { const unsigned o = off0 + (unsigned)((ai * HALF + m * 16) * DM + bj * HALF); const f32x4 v0 = acc[ai][bj][m][0], v1 = acc[ai][bj][m][1];
                    u32x4 w; w.x = cvt_pk_bf16(v0[0], v0[1]); w.y = cvt_pk_bf16(v0[2], v0[3]); w.z = cvt_pk_bf16(v1[0], v1[1]); w.w = cvt_pk_bf16(v1[2], v1[3]);
                    u32x2 q; q.x = pk4_fp8(v0[0], v0[1], v0[2], v0[3]); q.y = pk4_fp8(v1[0], v1[1], v1[2], v1[3]);
                    *(u32x4*)(h1bb + 2u * o) = w; *(u32x2*)(h1f8 + o) = q;
                    if (bj) __builtin_amdgcn_sched_barrier(0); }
    }
    __device__ __forceinline__ void run(AccRef acc, const Unit& u, int wr, int wc, int fr, int fq, const LAS unsigned char* mt) const { pre(acc, u, wr, wc, fr, fq, mt); post(acc, u, wr, wc, fr, fq, mt); }
};

struct EpiUp {
    static constexpr bool PERM = true;
    unsigned char* act;
    __device__ __forceinline__ void pre(AccRef acc, const Unit& u, int wr, int wc, int fr, int fq, const LAS unsigned char* mt) const {
        const int r0 = wr * 64 + fr, cl = 32 * wc + 8 * fq;
        const LAS float* rowA = (const LAS float*)mt; const LAS float* bias = (const LAS float*)(mt + 2048);
        f32x4 bg[2], bl[2];
#pragma unroll
        for (int n = 0; n < 2; ++n) { bg[n] = *(const LAS f32x4*)(bias + cl + 4 * n); bl[n] = *(const LAS f32x4*)(bias + 128 + cl + 4 * n); }
#pragma unroll
        for (int ai = 0; ai < 2; ++ai)
#pragma unroll
            for (int m = 0; m < 4; ++m) { const int r = r0 + ai * HALF + m * 16;
                const float rs = (r < u.rows) ? rowA[r] * 0.03125f : 0.f;
#pragma unroll
                for (int n = 0; n < 2; ++n)
#pragma unroll
                    for (int e = 0; e < 4; ++e) { float g = acc[ai][0][m][n][e] * rs + bg[n][e], l = acc[ai][1][m][n][e] * rs + bl[n][e];
                        g = fminf(g, 7.0f); l = fminf(fmaxf(l, -7.0f), 7.0f); acc[ai][0][m][n][e] = g * sigmoidf_(1.702f * g) * (l + 1.0f); } }
    }
    __device__ __forceinline__ void post(AccRef acc, const Unit& u, int wr, int wc, int fr, int fq, const LAS unsigned char* mt) const {
        const int r0 = wr * 64 + fr, ch = 128 * u.pn + 32 * wc + 8 * fq;
#pragma unroll
        for (int ai = 0; ai < 2; ++ai)
#pragma unroll
            for (int m = 0; m < 4; ++m) { const int r = r0 + ai * HALF + m * 16;
                const f32x4 v0 = acc[ai][0][m][0], v1 = acc[ai][0][m][1];
                u32x2 w; w.x = pk4_fp8(v0[0], v0[1], v0[2], v0[3]); w.y = pk4_fp8(v1[0], v1[1], v1[2], v1[3]);
                *(u32x2*)(act + (size_t)(u.pm * BM + r) * 1024 + ch) = w; }
    }
    __device__ __forceinline__ void run(const f32x4 (&acc)[2][2][4][2], const Unit& u, int wr, int wc, int fr, int fq, const LAS unsigned char* mt) const {
        const int r0 = wr * 64 + fr, cl = 32 * wc + 8 * fq, ch = 128 * u.pn + cl;
        const LAS float* rowA = (const LAS float*)mt; const LAS float* bias = (const LAS float*)(mt + 2048);
        f32x4 bg[2], bl[2];
#pragma unroll
        for (int n = 0; n < 2; ++n) { bg[n] = *(const LAS f32x4*)(bias + cl + 4 * n); bl[n] = *(const LAS f32x4*)(bias + 128 + cl + 4 * n); }
#pragma unroll
        for (int ai = 0; ai < 2; ++ai)
#pragma unroll
            for (int m = 0; m < 4; ++m) { const int r = r0 + ai * HALF + m * 16;
                const float rs = (r < u.rows) ? rowA[r] * 0.03125f : 0.f;
                float o[8];
#pragma unroll
                for (int n = 0; n < 2; ++n)
#pragma unroll
                    for (int e = 0; e < 4; ++e) { float g = acc[ai][0][m][n][e] * rs + bg[n][e], l = acc[ai][1][m][n][e] * rs + bl[n][e];
                        g = fminf(g, 7.0f); l = fminf(fmaxf(l, -7.0f), 7.0f); o[4 * n + e] = g * sigmoidf_(1.702f * g) * (l + 1.0f); }
                u32x2 w; w.x = pk4_fp8(o[0], o[1], o[2], o[3]); w.y = pk4_fp8(o[4], o[5], o[6], o[7]);
                *(u32x2*)(act + (size_t)(u.pm * BM + r) * 1024 + ch) = w; }
    }
};

struct EpiDown {
    static constexpr bool PERM = true;
    unsigned char* y;
    __device__ __forceinline__ void pre(AccRef acc, const Unit& u, int wr, int wc, int fr, int fq, const LAS unsigned char* mt) const {
        const int r0 = wr * 64 + fr, cl = wc * 32 + 8 * fq;
        const LAS float* gateT = (const LAS float*)(mt + 1024); const LAS float* bias = (const LAS float*)(mt + 2048);
        float gt[2][4];
#pragma unroll
        for (int ai = 0; ai < 2; ++ai)
#pragma unroll
            for (int m = 0; m < 4; ++m) gt[ai][m] = gateT[r0 + ai * HALF + m * 16] * 16.0f;
#pragma unroll
        for (int bj = 0; bj < 2; ++bj) { const f32x4 bv0 = *(const LAS f32x4*)(bias + cl + bj * HALF), bv1 = *(const LAS f32x4*)(bias + cl + bj * HALF + 4);
#pragma unroll
            for (int ai = 0; ai < 2; ++ai)
#pragma unroll
                for (int m = 0; m < 4; ++m) { acc[ai][bj][m][0] = (acc[ai][bj][m][0] * 0.03125f + bv0) * gt[ai][m]; acc[ai][bj][m][1] = (acc[ai][bj][m][1] * 0.03125f + bv1) * gt[ai][m]; } }
    }
    __device__ __forceinline__ void post(AccRef acc, const Unit& u, int wr, int wc, int fr, int fq, const LAS unsigned char* mt) const {
        const int r0 = wr * 64 + fr, col0 = u.pn * BM + wc * 32 + 8 * fq;
        const LAS int* slotT = (const LAS int*)mt;
#pragma unroll
        for (int ai = 0; ai < 2; ++ai)
#pragma unroll
            for (int m = 0; m < 4; ++m) { const int r = r0 + ai * HALF + m * 16;
                if (r < u.rows) { unsigned char* rowp = y + (size_t)slotT[r] * 1024 + col0;
#pragma unroll
                    for (int bj = 0; bj < 2; ++bj) { const f32x4 v0 = acc[ai][bj][m][0], v1 = acc[ai][bj][m][1];
                        u32x2 w; w.x = pk4_fp8(v0[0], v0[1], v0[2], v0[3]); w.y = pk4_fp8(v1[0], v1[1], v1[2], v1[3]);
                        *(u32x2*)(rowp + bj * HALF) = w; } } }
    }
    __device__ __forceinline__ void run(AccRef acc, const Unit& u, int wr, int wc, int fr, int fq, const LAS unsigned char* mt) const { pre(acc, u, wr, wc, fr, fq, mt); post(acc, u, wr, wc, fr, fq, mt); }
};

template <bool F8>
__device__ __forceinline__ void p0_transpose_item(const float* W, int ldw, void* WTv, int Kdim, const float* gain, LAS float* scr, int kb, int n0, int src0, int nvalid, int lane, bool prow = false) {
    bf16_t* WT = (bf16_t*)WTv;
    const int k0 = 64 * kb;
    f32x4 ld4[8];
#pragma unroll
    for (int i = 0; i < 8; ++i) { const int kk = 8 * i + (lane >> 3), j = (lane & 7) * 4;
        ld4[i] = (f32x4){0.f, 0.f, 0.f, 0.f}; if (j < nvalid) ld4[i] = NT_LD((const f32x4*)(W + (size_t)(k0 + kk) * ldw + src0 + j)); }
#pragma unroll
    for (int i = 0; i < 8; ++i) { const int kk = 8 * i + (lane >> 3), j = (lane & 7) * 4; const float gk = (gain ? gain[k0 + kk] : 1.0f) * (F8 ? 32.0f : 1.0f);
        LAS float* d = scr + kk * 33 + j; d[0] = ld4[i].x * gk; d[1] = ld4[i].y * gk; d[2] = ld4[i].z * gk; d[3] = ld4[i].w * gk; }
    LDS_WAIT(); asm volatile("" ::: "memory");
    const int c = lane & 7;
#pragma unroll
    for (int j = 0; j < 4; ++j) { const int nl = (lane >> 3) + 8 * j; const LAS float* s = scr + (8 * c) * 33 + nl;
        const int n = prow ? 16 * ((nl >> 2) & 1) + 4 * (nl >> 3) + (nl & 3) : nl;
        if constexpr (F8) { u32x2 o; o.x = pk4_fp8(s[0 * 33], s[1 * 33], s[2 * 33], s[3 * 33]); o.y = pk4_fp8(s[4 * 33], s[5 * 33], s[6 * 33], s[7 * 33]);
            *(u32x2*)((unsigned char*)WTv + (size_t)(n0 + n) * Kdim + k0 + 8 * c) = o; }
        else { u32x4 o; o.x = pk2(s[0 * 33], s[1 * 33]); o.y = pk2(s[2 * 33], s[3 * 33]); o.z = pk2(s[4 * 33], s[5 * 33]); o.w = pk2(s[6 * 33], s[7 * 33]);
            *(u32x4*)(WT + (size_t)(n0 + n) * Kdim + k0 + 8 * c) = o; } }
    LDS_WAIT(); asm volatile("" ::: "memory");
}
__device__ __forceinline__ void win_colmap(int nb, int& src0, int& nvalid) {
    const int pn = nb >> 3, j = (nb & 7) * 32, bj = j >> 7, slot = (j & 127) >> 5;
    nvalid = 32;
    if (pn < 2) src0 = (4 * pn + slot) * 64 + 32 * bj;
    else if (pn == 2) src0 = 640 + slot * 64 + 32 * bj;
    else if (pn == 3) { if (slot == 0) src0 = 512 + 32 * bj; else if (slot == 1) src0 = 896 + 32 * bj; else if (slot == 2) src0 = 576 + 32 * bj; else { src0 = 960; nvalid = bj == 0 ? 4 : 0; } }
    else src0 = 964 + 512 * bj + 128 * (pn - 4) + 32 * slot;
}
__device__ __forceinline__ void p0_prologue(const Params& P, LAS unsigned char* lds, int vcu, int G, int wave, int lane) {
    unsigned char* ws = P.ws;
    LAS float* scr = (LAS float*)(lds + wave * 16384);
    const int gw = vcu * NWAVES + wave, NGW = G * NWAVES;
    constexpr int I_IN = 16 * 64, I_OUT = 16 * 32, I_G = 16 * 32, I_P = 4 * 32;
    constexpr int NITEMS = I_IN + I_OUT + I_G + I_P;
    for (int it = gw; it < NITEMS; it += NGW) {
        int r = it;
        if (r < I_IN) { const int kb = r / 64, nb = r % 64; int s0, nv; win_colmap(nb, s0, nv); p0_transpose_item<false>(P.w_in, INW, (bf16_t*)(ws + WS_WIN), 1024, P.g_mix, scr, kb, nb * 32, s0, nv, lane); continue; } r -= I_IN;
        if (r < I_OUT) { const int kb = r / 32, nb = r % 32; p0_transpose_item<true>(P.w_out, 1024, (unsigned char*)(ws + WS_WOUT), 1024, nullptr, scr, kb, nb * 32, nb * 32, 32, lane, true); continue; } r -= I_OUT;
        if (r < I_G) { const int kb = r / 32, nb = r % 32; p0_transpose_item<true>(P.w_ple_gate, 1024, (unsigned char*)(ws + WS_WG), 1024, P.g_ple, scr, kb, nb * 32, nb * 32, 32, lane); continue; } r -= I_G;
        { const int kb = r / 32, nb = r % 32; p0_transpose_item<false>(P.w_ple_proj, 1024, (bf16_t*)(ws + WS_WP), 256, nullptr, scr, kb, nb * 32, nb * 32, 32, lane); }
    }
    float* rs1 = (float*)(ws + WS_RS1); bf16_t* xb = (bf16_t*)(ws + WS_XB);
    for (int m = gw; m < NTOK; m += NGW) {
        const f32x4* xr = (const f32x4*)(P.x + (size_t)m * DM) + lane; f32x4 v[4]; float s = 0.f;
#pragma unroll
        for (int j = 0; j < 4; ++j) { v[j] = NT_LD(xr + 64 * j); s += (v[j].x * v[j].x + v[j].y * v[j].y) + (v[j].z * v[j].z + v[j].w * v[j].w); }
        s = wave_sum(s);
        u32x2* o8 = (u32x2*)(xb + (size_t)m * DM) + lane;
#pragma unroll
        for (int j = 0; j < 4; ++j) { u32x2 w; w.x = pk2(v[j].x, v[j].y); w.y = pk2(v[j].z, v[j].w); o8[64 * j] = w; }
        if (lane == 0) rs1[m] = 1.0f / sqrtf(s * (1.0f / DM) + EPS);
    }
    bf16_t* pb = (bf16_t*)(ws + WS_PB);
    for (int m = gw; m < NTOK; m += NGW) { const f32x4 v = NT_LD((const f32x4*)(P.p + (size_t)m * 256) + lane); u32x2 w; w.x = pk2(v.x, v.y); w.y = pk2(v.z, v.w); *((u32x2*)(pb + (size_t)m * 256) + lane) = w; }
    f32x2* rope = (f32x2*)(ws + WS_ROPE);
    for (int idx = gw * 64 + lane; idx < SEQ * 32; idx += NGW * 64) { const int t = idx >> 5, i = idx & 31;
        const float inv = exp2f(-(float)i * (13.287712379549449f / 32.0f));
        const float ang = (float)t * inv;
        const double rev = (double)ang * 0.15915494309189535; const float fr = (float)(rev - __builtin_floor(rev));
        rope[idx] = (f32x2){__builtin_amdgcn_cosf(fr), __builtin_amdgcn_sinf(fr)}; }
    bf16_t* wrg = (bf16_t*)(ws + WS_WRG);
    for (int idx = gw * 64 + lane; idx < 1024 * 32; idx += NGW * 64) { const int k = idx >> 5, e = idx & 31; const float w = P.w_router[idx] * P.g_ffn[k];
        const unsigned short hi = f2bf(w); const float whi = __uint_as_float((unsigned)hi << 16); const size_t o = ((size_t)(k >> 3) * 32 + e) * 8 + (k & 7);
        wrg[o] = hi; wrg[32768 + o] = f2bf(w - whi); }
}

__device__ __forceinline__ unsigned fkey(float f) { unsigned u = __builtin_bit_cast(unsigned, f); if (u == 0x80000000u) u = 0u; return u ^ ((unsigned)((int)u >> 31) | 0x80000000u); }
__device__ __forceinline__ int mbcnt64(unsigned long long m) { return __builtin_amdgcn_mbcnt_hi((unsigned)(m >> 32), __builtin_amdgcn_mbcnt_lo((unsigned)m, 0u)); }

template <int NR>
__device__ __forceinline__ unsigned bisect_thr(const unsigned (&v)[NR], unsigned prefix, int startbit) {
    bool exact = false;
#pragma unroll 1
    for (int bit = startbit; bit >= 0; --bit) {
        const unsigned cand = prefix | (1u << bit); int cnt = 0;
#pragma unroll
        for (int r = 0; r < NR; ++r) { cnt += __builtin_popcountll(__ballot(v[r] >= cand)); if ((r & 7) == 7) __builtin_amdgcn_sched_barrier(0); }
        if (cnt >= NSEL) prefix = cand;
        if (cnt == NSEL) { exact = true; break; }
    }
    return exact ? prefix - 1u : prefix;
}
template <int NR, bool EXPL>
__device__ __forceinline__ void compact_sel(const unsigned (&v)[NR], const unsigned (&ci)[NR], unsigned T, LAS unsigned* list, int lane) {
    int cgt = 0;
#pragma unroll
    for (int r = 0; r < NR; ++r) { cgt += __builtin_popcountll(__ballot(v[r] > T)); if ((r & 7) == 7) __builtin_amdgcn_sched_barrier(0); }
    const int need = NSEL - cgt; int base = 0, ties = 0;
#pragma unroll
    for (int r = 0; r < NR; ++r) { const bool gt = v[r] > T, eq = v[r] == T; const unsigned long long em = __ballot(eq);
        const bool sel = gt || (eq && (ties + mbcnt64(em)) < need); const unsigned long long sm = __ballot(sel);
        list[sel ? base + mbcnt64(sm) : NSEL + lane] = EXPL ? ci[r] : (unsigned)(r * 64 + lane);
        base += __builtin_popcountll(sm); ties += __builtin_popcountll(em);
        if ((r & 3) == 3) __builtin_amdgcn_sched_barrier(0); }
}
constexpr int SEL_CAP = 1024;
template <int NR>
__device__ __forceinline__ void select_topk(LAS float* row, LAS unsigned* H, LAS unsigned* list, int lane, bool zero_h) {
    unsigned v[NR];
#pragma unroll
    for (int r = 0; r < NR; ++r) v[r] = fkey(row[r * 64 + lane]);
    LAS u32x4* H4 = (LAS u32x4*)H;
    const u32x4 h0 = H4[2 * lane], h1 = H4[2 * lane + 1];
    if (zero_h) { H4[2 * lane] = (u32x4){0u, 0u, 0u, 0u}; H4[2 * lane + 1] = (u32x4){0u, 0u, 0u, 0u}; }
    const unsigned hw[8] = {h0.x, h0.y, h0.z, h0.w, h1.x, h1.y, h1.z, h1.w};
    unsigned c[16];
#pragma unroll
    for (int i = 0; i < 8; ++i) { c[2 * i] = hw[i] & 0xffffu; c[2 * i + 1] = hw[i] >> 16; }
    unsigned s = 0u;
#pragma unroll
    for (int i = 0; i < 16; ++i) s += c[i];
    unsigned S = s;
#pragma unroll
    for (int off = 1; off < 64; off <<= 1) { const unsigned o = __shfl_down(S, off); if (lane + off < 64) S += o; }
    const unsigned long long okm = __ballot(S >= (unsigned)NSEL);
    bool fast = okm != 0ull; unsigned floorkey = 0u; int C = 0;
    if (fast) {
        const int Ls = 63 - __builtin_clzll(okm);
        unsigned acc = S - s; int bl = -1; unsigned accb = 0u;
#pragma unroll
        for (int b = 15; b >= 0; --b) { acc += c[b]; if (bl < 0 && acc >= (unsigned)NSEL) { bl = b; accb = acc; } }
        const int bstar = __shfl(bl, Ls) + 16 * Ls; C = (int)__shfl(accb, Ls);
        floorkey = (unsigned)bstar << 22;
        fast = (bstar > 1) && (C <= SEL_CAP);
    }
    if (!fast) {
        const unsigned T = bisect_thr<NR>(v, 0u, 31);
        compact_sel<NR, false>(v, v, T, list, lane);
        return;
    }
    LAS unsigned* ckl = (LAS unsigned*)row; LAS unsigned* cil = ckl + 1152;
    { int base = 0;
#pragma unroll
      for (int r = 0; r < NR; ++r) { const bool cnd = v[r] >= floorkey; const unsigned long long m = __ballot(cnd);
          const int pos = cnd ? base + mbcnt64(m) : SEL_CAP + lane;
          ckl[pos] = v[r]; cil[pos] = (unsigned)(r * 64 + lane); base += __builtin_popcountll(m);
          if ((r & 3) == 3) __builtin_amdgcn_sched_barrier(0); } }
    if (C <= 512) {
        unsigned ck[8], ci[8];
#pragma unroll
        for (int j = 0; j < 8; ++j) { const int i = j * 64 + lane; ck[j] = i < C ? ckl[i] : 0u; ci[j] = cil[i]; }
        const unsigned T = (C == NSEL) ? floorkey - 1u : bisect_thr<8>(ck, floorkey, 21);
        compact_sel<8, true>(ck, ci, T, list, lane);
    } else {
        unsigned ck[16], ci[16];
#pragma unroll
        for (int j = 0; j < 16; ++j) { const int i = j * 64 + lane; ck[j] = i < C ? ckl[i] : 0u; ci[j] = cil[i]; }
        const unsigned T = bisect_thr<16>(ck, floorkey, 21);
        compact_sel<16, true>(ck, ci, T, list, lane);
    }
}

typedef short v4i16 __attribute__((ext_vector_type(4)));
constexpr int VROW = 144;

__device__ __forceinline__ void attn_tile(const Params& P, LAS unsigned char* lds, int b, int t0, int wave, int lane) {
    unsigned char* ws = P.ws;
    const bf16_t* QI = (const bf16_t*)(ws + WS_QI); const bf16_t* KI = (const bf16_t*)(ws + WS_KI);
    const bf16_t* Q = (const bf16_t*)(ws + WS_Q); const bf16_t* Kp = (const bf16_t*)(ws + WS_K); const bf16_t* Vp = (const bf16_t*)(ws + WS_V);
    const float* WI = (const float*)(ws + WS_WI); unsigned char* MIX = ws + WS_MIX;
    LAS float* SC = (LAS float*)lds;
    LAS unsigned* list = (LAS unsigned*)(lds + wave * 16384 + 14336);
    LAS unsigned* HIST = (LAS unsigned*)(lds + LDS_MISC);
    const int tokbase = b * SEQ;
    const bool need_sel = t0 >= 256;
    if (need_sel) {
        const int nkt = (t0 + 8 + 31) >> 5;
        bf16x8 a[4]; f32x4 w[4];
        { const bf16_t* src = QI + (size_t)(tokbase + t0 + ((lane & 31) >> 2)) * 256 + (lane & 3) * 64 + 8 * (lane >> 5);
#pragma unroll
          for (int ks = 0; ks < 4; ++ks) a[ks] = *(const bf16x8*)(src + 16 * ks); }
#pragma unroll
        for (int g = 0; g < 4; ++g) w[g] = *(const f32x4*)(WI + (size_t)(tokbase + t0 + 2 * g + (lane >> 5)) * 4);
        for (int kt0 = wave; kt0 < nkt; kt0 += 4 * NWAVES) {
            bf16x8 bf[4][4];
#pragma unroll
            for (int u = 0; u < 4; ++u) { const int kt = kt0 + u * NWAVES;
                if (kt < nkt) { const bf16_t* ksrc = KI + ((size_t)((tokbase >> 5) + kt) * 256 + lane) * 8;
#pragma unroll
                    for (int ks = 0; ks < 4; ++ks) bf[u][ks] = *(const bf16x8*)(ksrc + 512 * ks); } }
#pragma unroll
            for (int u = 0; u < 4; ++u) { const int kt = kt0 + u * NWAVES;
                if (kt < nkt) {
                    const int key = kt * 32 + (lane & 31);
                    f32x16 acc;
#pragma unroll
                    for (int i = 0; i < 16; ++i) acc[i] = 0.f;
#pragma unroll
                    for (int ks = 0; ks < 4; ++ks) acc = __builtin_amdgcn_mfma_f32_32x32x16_bf16(a[ks], bf[u][ks], acc, 0, 0, 0);
#pragma unroll
                    for (int g = 0; g < 4; ++g) { float sc = 0.f;
#pragma unroll
                        for (int h = 0; h < 4; ++h) sc = fmaf(fmaxf(acc[4 * g + h], 0.f), w[g][h], sc);
                        const int ql = 2 * g + (lane >> 5);
                        if (key > t0 + ql) sc = -INFINITY;
                        SC[ql * 4096 + key] = sc;
                        if (key <= t0 + ql) { const unsigned ub = __builtin_bit_cast(unsigned, sc);
                            const unsigned bin = (ub >> 22) ^ (((unsigned)((int)ub >> 31) & 0x1ffu) | 0x200u);
                            __hip_atomic_fetch_add(HIST + ql * 512 + (bin >> 1), 1u << ((bin & 1u) << 4), __ATOMIC_RELAXED, __HIP_MEMORY_SCOPE_WORKGROUP); } }
                } }
        }
        { const int npad = ((t0 + 8 + 1023) >> 10) << 10;
          for (int i = nkt * 32 + (int)threadIdx.x; i < npad; i += NTHR) {
#pragma unroll
              for (int q = 0; q < 8; ++q) SC[q * 4096 + i] = -INFINITY; } }
    }
    __syncthreads();
    const int t = t0 + wave, tok = tokbase + t;
    if (need_sel) {
        LAS float* row = SC + wave * 4096; LAS unsigned* H = HIST + wave * 512; const int n = t + 1;
        if (n <= 1024) select_topk<16>(row, H, list, lane, true);
        else if (n <= 2048) select_topk<32>(row, H, list, lane, true);
        else if (n <= 3072) select_topk<48>(row, H, list, lane, true);
        else select_topk<64>(row, H, list, lane, true);
    } else {
#pragma unroll
        for (int i = 0; i < 4; ++i) list[i * 64 + lane] = (unsigned)(i * 64 + lane);
    }
    const int nvalid = need_sel ? NSEL : (t + 1);
    const int hd = lane & 15, g = lane >> 4;
    bf16x8 qf0, qf1;
#pragma unroll
    for (int i = 0; i < 8; ++i) { qf0[i] = 0; qf1[i] = 0; }
    if (hd < 8) { const bf16_t* qs = Q + (size_t)tok * 512 + hd * 64 + 8 * g; qf0 = *(const bf16x8*)qs; qf1 = *(const bf16x8*)(qs + 32); }
    LAS unsigned char* vreg = lds + wave * 16384;
    u32x4 rA[4], rB[4];
#define ATT_ROWS(R, SRC, G_) do { const int nb_ = (G_) * 32; \
        _Pragma("unroll") for (int i_ = 0; i_ < 4; ++i_) { const unsigned idx_ = list[nb_ + (lane >> 3) + 8 * i_]; R[i_] = *(const u32x4*)((SRC) + (size_t)(tokbase + idx_) * 64 + 8 * (lane & 7)); } } while (0)
#define ATT_STAGE(R, BUF) do { _Pragma("unroll") for (int i_ = 0; i_ < 4; ++i_) *(LAS u32x4*)((BUF) + ((lane >> 3) + 8 * i_) * VROW + (lane & 7) * 16) = R[i_]; } while (0)
    float lg[8][8];
#define ATT_QK(R, G_, BUF) do { LAS unsigned char* kb_ = (BUF); ATT_STAGE(R, kb_); \
        if constexpr ((G_) + 2 < 8) { ATT_ROWS(R, Kp, (G_) + 2); } \
        const LAS unsigned char* kr_ = kb_ + hd * VROW + 16 * g; \
        const bf16x8 ka0_ = *(const LAS bf16x8*)kr_, ka1_ = *(const LAS bf16x8*)(kr_ + 64), kb0_ = *(const LAS bf16x8*)(kr_ + 16 * VROW), kb1_ = *(const LAS bf16x8*)(kr_ + 16 * VROW + 64); \
        f32x4 sa_ = {0.f, 0.f, 0.f, 0.f}, sb_ = {0.f, 0.f, 0.f, 0.f}; \
        sa_ = __builtin_amdgcn_mfma_f32_16x16x32_bf16(ka0_, qf0, sa_, 0, 0, 0); sa_ = __builtin_amdgcn_mfma_f32_16x16x32_bf16(ka1_, qf1, sa_, 0, 0, 0); \
        sb_ = __builtin_amdgcn_mfma_f32_16x16x32_bf16(kb0_, qf0, sb_, 0, 0, 0); sb_ = __builtin_amdgcn_mfma_f32_16x16x32_bf16(kb1_, qf1, sb_, 0, 0, 0); \
        _Pragma("unroll") for (int r_ = 0; r_ < 4; ++r_) { const int sl_ = (G_) * 32 + 4 * g + r_; \
            lg[G_][r_] = sl_ < nvalid ? sa_[r_] * 0.125f : -INFINITY; lg[G_][4 + r_] = (sl_ + 16) < nvalid ? sb_[r_] * 0.125f : -INFINITY; } } while (0)
    ATT_ROWS(rA, Kp, 0); ATT_ROWS(rB, Kp, 1);
    ATT_QK(rA, 0, vreg); ATT_QK(rB, 1, vreg + 4608); ATT_QK(rA, 2, vreg); ATT_QK(rB, 3, vreg + 4608);
    ATT_QK(rA, 4, vreg); ATT_QK(rB, 5, vreg + 4608); ATT_QK(rA, 6, vreg); ATT_QK(rB, 7, vreg + 4608);
    ATT_ROWS(rA, Vp, 0); ATT_ROWS(rB, Vp, 1);
    float mx = -INFINITY;
#pragma unroll
    for (int q = 0; q < 8; ++q)
#pragma unroll
        for (int r = 0; r < 8; ++r) mx = fmaxf(mx, lg[q][r]);
    mx = fmaxf(mx, __shfl_xor(mx, 16)); mx = fmaxf(mx, __shfl_xor(mx, 32));
    float ssum = 0.f;
#pragma unroll
    for (int q = 0; q < 8; ++q)
#pragma unroll
        for (int r = 0; r < 8; ++r) { lg[q][r] = __expf(lg[q][r] - mx); ssum += lg[q][r]; }
    f32x4 o[4];
#pragma unroll
    for (int dt = 0; dt < 4; ++dt) o[dt] = (f32x4){0.f, 0.f, 0.f, 0.f};
#define ATT_PV(R, G_, BUF) do { LAS unsigned char* vb_ = (BUF); ATT_STAGE(R, vb_); \
        if constexpr ((G_) + 2 < 8) { ATT_ROWS(R, Vp, (G_) + 2); } \
        bf16x8 pf_; \
        { const u32x4 pw_ = {cvt_pk_bf16(lg[G_][0], lg[G_][1]), cvt_pk_bf16(lg[G_][2], lg[G_][3]), cvt_pk_bf16(lg[G_][4], lg[G_][5]), cvt_pk_bf16(lg[G_][6], lg[G_][7])}; pf_ = __builtin_bit_cast(bf16x8, pw_); } \
        LAS unsigned char* ta_ = vb_ + (4 * g + (hd >> 2)) * VROW + (hd & 3) * 8; \
        _Pragma("unroll") for (int dt_ = 0; dt_ < 4; ++dt_) { \
            const v4i16 lo_ = __builtin_amdgcn_ds_read_tr16_b64_v4i16((LAS v4i16*)(ta_ + dt_ * 32)); \
            const v4i16 hi_ = __builtin_amdgcn_ds_read_tr16_b64_v4i16((LAS v4i16*)(ta_ + 16 * VROW + dt_ * 32)); \
            bf16x8 vf_; vf_[0] = lo_[0]; vf_[1] = lo_[1]; vf_[2] = lo_[2]; vf_[3] = lo_[3]; vf_[4] = hi_[0]; vf_[5] = hi_[1]; vf_[6] = hi_[2]; vf_[7] = hi_[3]; \
            o[dt_] = __builtin_amdgcn_mfma_f32_16x16x32_bf16(vf_, pf_, o[dt_], 0, 0, 0); } } while (0)
    ATT_PV(rA, 0, vreg); ATT_PV(rB, 1, vreg + 4608); ATT_PV(rA, 2, vreg); ATT_PV(rB, 3, vreg + 4608);
    ATT_PV(rA, 4, vreg); ATT_PV(rB, 5, vreg + 4608); ATT_PV(rA, 6, vreg); ATT_PV(rB, 7, vreg + 4608);
#undef ATT_ROWS
#undef ATT_STAGE
#undef ATT_QK
#undef ATT_PV
    ssum += __shfl_xor(ssum, 16); ssum += __shfl_xor(ssum, 32);
    const float inv = 1.0f / ssum;
    if (hd < 8) {
        unsigned char* op = MIX + (size_t)tok * 1024 + hd * 64 + 4 * g; const float inv16 = inv * 16.0f;
#pragma unroll
        for (int dt = 0; dt < 4; ++dt) *(unsigned*)(op + 16 * dt) = pk4_fp8(o[dt][0] * inv16, o[dt][1] * inv16, o[dt][2] * inv16, o[dt][3] * inv16);
    }
    __syncthreads();
}

__device__ __forceinline__ void conv_tile(const Params& P, LAS unsigned char* lds, int tile, int tid, int wave, int lane) {
    unsigned char* ws = P.ws;
    const bf16_t* HG = (const bf16_t*)(ws + WS_HGLU); unsigned char* MIX = ws + WS_MIX;
    LAS f32x2* part = (LAS f32x2*)(lds + LDS_MISC + 1024);
    LAS f32x2* stat = part + 256;
    LAS bf16_t* Lin = (LAS bf16_t*)lds;
    LAS unsigned char* Lout = lds + 65536;
    const int tok0 = tile * 32, t0 = tok0 & (SEQ - 1), c = tid;
    for (int ch = tid; ch < 62 * 64; ch += NTHR) { const int r = ch >> 6, cc = ch & 63; const int tt = t0 - 30 + r;
        u32x4 v = {0u, 0u, 0u, 0u}; if (tt >= 0) v = *(const u32x4*)(HG + (size_t)(tok0 - 30 + r) * 512 + cc * 8);
        *(LAS u32x4*)(Lin + r * 512 + cc * 8) = v; }
    __syncthreads();
    float in[62];
#pragma unroll
    for (int r = 0; r < 62; ++r) in[r] = __builtin_bit_cast(float, (unsigned)Lin[r * 512 + c] << 16);
    float out[32];
    const float bias = P.dw_b[c];
#pragma unroll
    for (int i = 0; i < 32; ++i) out[i] = bias;
#pragma unroll
    for (int j = 0; j < 31; ++j) { const float wj = P.dw_w[j * 512 + c];
#pragma unroll
        for (int i = 0; i < 32; ++i) out[i] = fmaf(in[i + j], wj, out[i]); }
#pragma unroll
    for (int i = 0; i < 32; ++i) { const float s1 = wave_sum(out[i]), s2 = wave_sum(out[i] * out[i]); if (lane == 0) part[i * 8 + wave] = (f32x2){s1, s2}; }
    __syncthreads();
    if (tid < 32) { float s1 = 0.f, s2 = 0.f;
#pragma unroll
        for (int w = 0; w < 8; ++w) { const f32x2 pp = part[tid * 8 + w]; s1 += pp.x; s2 += pp.y; }
        const float mean = s1 * (1.0f / 512.0f), var = fmaxf(s2 * (1.0f / 512.0f) - mean * mean, 0.f);
        stat[tid] = (f32x2){mean, 1.0f / sqrtf(var + EPS)}; }
    __syncthreads();
    const float lgc = P.ln_g[c], lbc = P.ln_b[c];
#pragma unroll
    for (int i = 0; i < 32; ++i) { const f32x2 st = stat[i]; const float y = (out[i] - st.x) * st.y * lgc + lbc; const float sl = y * sigmoidf_(y);
        Lout[i * 512 + c] = (unsigned char)__builtin_amdgcn_cvt_pk_fp8_f32(sl * 16.0f, 0.f, 0, false); }
    __syncthreads();
    for (int ch = tid; ch < 32 * 32; ch += NTHR) { const int r = ch >> 5, cc = ch & 31;
        *(u32x4*)(MIX + (size_t)(tok0 + r) * 1024 + 512 + cc * 16) = *(const LAS u32x4*)(Lout + r * 512 + cc * 16); }
    __syncthreads();
}

constexpr int MW_UP = 32 * 16 * 64, MW_DN = 32 * 16 * 32, MW_ITEMS = MW_UP + MW_DN;
__device__ __forceinline__ void mw_decode(const Params& P, int it, const float*& src, int& ldw, unsigned char*& dst, const float*& gain) {
    unsigned char* ws = P.ws;
    if (it < MW_UP) { const int e = it >> 10, rr = it & 1023, kb = rr >> 6, nb = rr & 63, pn = nb >> 3, j = (nb & 7) * 32, bj = j >> 7, jj = j & 127;
        src = P.w_up + (size_t)e * 1024 * 2048 + (size_t)(kb * 64) * 2048 + 1024 * bj + 128 * pn + jj; ldw = 2048;
        dst = ws + WS_WUP + (size_t)e * 2048 * 1024 + (size_t)(nb * 32) * 1024 + kb * 64; gain = P.g_ffn + kb * 64; }
    else { const int r = it - MW_UP, e = r >> 9, rr = r & 511, kb = rr >> 5, nb = rr & 31;
        src = P.w_down + (size_t)e * 1024 * 1024 + (size_t)(kb * 64) * 1024 + nb * 32; ldw = 1024;
        dst = ws + WS_WDOWN + (size_t)e * 1024 * 1024 + (size_t)(nb * 32) * 1024 + kb * 64; gain = nullptr; }
}
#define MW_LOAD(LD, it_) do { if ((it_) < MW_ITEMS) { const float* src_; int ldw_; unsigned char* dst_; const float* gain_; mw_decode(P, (it_), src_, ldw_, dst_, gain_); \
        _Pragma("unroll") for (int i_ = 0; i_ < 8; ++i_) LD[i_] = NT_LD((const f32x4*)(src_ + (size_t)(8 * i_ + (lane >> 3)) * ldw_ + (lane & 7) * 4)); } } while (0)
#define MW_FINISH(LD, it_) do { if ((it_) < MW_ITEMS) { const float* src_; int ldw_; unsigned char* dst_; const float* gain_; mw_decode(P, (it_), src_, ldw_, dst_, gain_); \
        _Pragma("unroll") for (int i_ = 0; i_ < 8; ++i_) { const int kk_ = 8 * i_ + (lane >> 3), j_ = (lane & 7) * 4; const float gk_ = (gain_ ? gain_[kk_] : 1.0f) * 32.0f; \
            LAS float* d_ = scr + kk_ * 33 + j_; d_[0] = LD[i_].x * gk_; d_[1] = LD[i_].y * gk_; d_[2] = LD[i_].z * gk_; d_[3] = LD[i_].w * gk_; } \
        LDS_WAIT(); asm volatile("" ::: "memory"); \
        const int c_ = lane & 7; \
        _Pragma("unroll") for (int j_ = 0; j_ < 4; ++j_) { const int n_ = (lane >> 3) + 8 * j_; const LAS float* sp_ = scr + (8 * c_) * 33 + n_; \
            u32x2 o_; o_.x = pk4_fp8(sp_[0 * 33], sp_[1 * 33], sp_[2 * 33], sp_[3 * 33]); o_.y = pk4_fp8(sp_[4 * 33], sp_[5 * 33], sp_[6 * 33], sp_[7 * 33]); \
            *(u32x2*)(dst_ + (size_t)n_ * 1024 + 8 * c_) = o_; } \
        LDS_WAIT(); asm volatile("" ::: "memory"); } } while (0)
__device__ __forceinline__ void moe_weight_convert(const Params& P, LAS float* scr, int cw, int ncw, int lane) {
    f32x4 l0[8], l1[8], l2[8], l3[8];
    MW_LOAD(l0, cw); MW_LOAD(l1, cw + ncw); MW_LOAD(l2, cw + 2 * ncw);
    for (int base = cw; base < MW_ITEMS; base += 4 * ncw) {
        MW_LOAD(l3, base + 3 * ncw); MW_FINISH(l0, base);
        MW_LOAD(l0, base + 4 * ncw); MW_FINISH(l1, base + ncw);
        MW_LOAD(l1, base + 5 * ncw); MW_FINISH(l2, base + 2 * ncw);
        MW_LOAD(l2, base + 6 * ncw); MW_FINISH(l3, base + 3 * ncw);
    }
}
#undef MW_LOAD
#undef MW_FINISH

__device__ __forceinline__ void router_phase(const Params& P, LAS unsigned char* lds, int blk, int G, int tid, int wave, int lane) {
    unsigned char* ws = P.ws;
    const bf16_t* h1 = (const bf16_t*)(ws + WS_H1); const u32x4* wrg = (const u32x4*)(ws + WS_WRG);
    int* list = (int*)(ws + WS_LIST); float* lscale = (float*)(ws + WS_LSCALE); float* lgate = (float*)(ws + WS_LGATE);
    unsigned* cntg = (unsigned*)(ws + WS_CTL) + CW_CNT;
    LAS u32x4* WH = (LAS u32x4*)lds;
    LAS float* part = (LAS float*)lds;
    LAS int* lcnt = (LAS int*)(lds + LDS_MISC + 1024);
    LAS int* gbase = lcnt + 32;
    LAS int* rec_e = gbase + 32;
    LAS int* rec_p = rec_e + 512;
    LAS float* rec_g = (LAS float*)(rec_p + 512);
    LAS float* rec_s = rec_g + 512;
    const int tl = lane & 31, half = lane >> 5;
    for (int chunk = blk; chunk < NTOK / 128; chunk += G) {
        for (int i = tid; i < 8192; i += NTHR) WH[i] = wrg[i];
        if (tid < 32) lcnt[tid] = 0;
        __syncthreads();
        const int tloc = (wave & 3) * 32 + tl, tok = chunk * 128 + tloc, kb0 = (wave >> 2) * 512;
        f32x16 acc;
#pragma unroll
        for (int i = 0; i < 16; ++i) acc[i] = 0.f;
        float ss = 0.f;
        {
            const bf16_t* hrow = h1 + (size_t)tok * DM + kb0 + 8 * half;
            const LAS u32x4* wa = WH + (size_t)((kb0 >> 3) + half) * 32 + tl;
#pragma unroll 2
            for (int k0 = 0; k0 < 512; k0 += 64) {
                u32x4 hv[4];
#pragma unroll
                for (int i = 0; i < 4; ++i) hv[i] = NT_LD((const u32x4*)(hrow + k0 + 16 * i));
#pragma unroll
                for (int i = 0; i < 4; ++i) {
                    const u32x4 ah = wa[(size_t)((k0 >> 3) + 2 * i) * 32], al = wa[(size_t)((k0 >> 3) + 2 * i) * 32 + 4096];
                    const float x0 = bf_lo(hv[i].x), x1 = bf_hi(hv[i].x), x2 = bf_lo(hv[i].y), x3 = bf_hi(hv[i].y), x4 = bf_lo(hv[i].z), x5 = bf_hi(hv[i].z), x6 = bf_lo(hv[i].w), x7 = bf_hi(hv[i].w);
                    ss = fmaf(x0, x0, fmaf(x1, x1, fmaf(x2, x2, fmaf(x3, x3, fmaf(x4, x4, fmaf(x5, x5, fmaf(x6, x6, fmaf(x7, x7, ss))))))));
                    acc = __builtin_amdgcn_mfma_f32_32x32x16_bf16(__builtin_bit_cast(bf16x8, ah), __builtin_bit_cast(bf16x8, hv[i]), acc, 0, 0, 0);
                    acc = __builtin_amdgcn_mfma_f32_32x32x16_bf16(__builtin_bit_cast(bf16x8, al), __builtin_bit_cast(bf16x8, hv[i]), acc, 0, 0, 0);
                }
            }
        }
        __syncthreads();
        if (wave >= 4) { const int pl = (wave - 4) * 64 + lane;
#pragma unroll
            for (int r = 0; r < 16; ++r) part[r * 256 + pl] = acc[r];
            part[16 * 256 + pl] = ss; }
        __syncthreads();
        if (wave < 4) {
            { const int pl = wave * 64 + lane;
#pragma unroll
              for (int r = 0; r < 16; ++r) acc[r] += part[r * 256 + pl];
              ss += part[16 * 256 + pl]; }
            ss += __shfl_xor(ss, 32);
            const float rs = 1.0f / sqrtf(ss * (1.0f / DM) + EPS);
            float v[16];
#pragma unroll
            for (int r = 0; r < 16; ++r) v[r] = acc[r] * rs + P.b_router[(r & 3) + 8 * (r >> 2) + 4 * half];
            float tv[4]; int te[4];
#pragma unroll
            for (int q = 0; q < 4; ++q) { float bv = -INFINITY; int be = 64;
#pragma unroll
                for (int r = 0; r < 16; ++r) { const int e = (r & 3) + 8 * (r >> 2) + 4 * half; if (v[r] > bv || (v[r] == bv && e < be)) { bv = v[r]; be = e; } }
#pragma unroll
                for (int r = 0; r < 16; ++r) { const int e = (r & 3) + 8 * (r >> 2) + 4 * half; if (e == be) v[r] = -INFINITY; }
                tv[q] = bv; te[q] = be; }
            float cv[8]; int ce[8];
#pragma unroll
            for (int q = 0; q < 4; ++q) { cv[q] = tv[q]; ce[q] = te[q]; cv[4 + q] = __shfl_xor(tv[q], 32); ce[4 + q] = __shfl_xor(te[q], 32); }
#pragma unroll
            for (int q = 0; q < 4; ++q) { float bv = -INFINITY; int be = 64;
#pragma unroll
                for (int r = 0; r < 8; ++r) if (cv[r] > bv || (cv[r] == bv && ce[r] < be)) { bv = cv[r]; be = ce[r]; }
#pragma unroll
                for (int r = 0; r < 8; ++r) if (ce[r] == be) cv[r] = -INFINITY;
                tv[q] = bv; te[q] = be; }
            const float e1 = __expf(tv[1] - tv[0]), e2 = __expf(tv[2] - tv[0]), e3 = __expf(tv[3] - tv[0]);
            const float is = 1.0f / (1.0f + e1 + e2 + e3);
            if (half == 0) {
                const float gq[4] = {is, e1 * is, e2 * is, e3 * is};
#pragma unroll
                for (int q = 0; q < 4; ++q) { const int lp = atomicAdd((int*)&lcnt[te[q]], 1); const int si = tloc * 4 + q; rec_e[si] = te[q]; rec_p[si] = lp; rec_g[si] = gq[q]; }
                rec_s[tloc] = rs;
            }
        }
        __syncthreads();
        if (tid < 32) gbase[tid] = (int)atomicAdd(cntg + 64 * tid, (unsigned)lcnt[tid]);
        __syncthreads();
        { const int si = tid, ee = rec_e[si], pos = gbase[ee] + rec_p[si], li = ee * NTOK + pos;
          list[li] = (chunk * 128) * 4 + si; lscale[li] = rec_s[si >> 2]; lgate[li] = rec_g[si]; }
        __syncthreads();
    }
}

__device__ __forceinline__ void combine_phase(const Params& P, int mbeg, int mend, int mstep, int lane) {
    unsigned char* ws = P.ws;
    const bf16_t* h1 = (const bf16_t*)(ws + WS_H1); bf16_t* h1b = (bf16_t*)(ws + WS_H1B); const unsigned char* y = ws + WS_Y; float* rs3 = (float*)(ws + WS_RS3);
    for (int m = mbeg; m < mend; m += mstep) {
        const u32x2* hr = (const u32x2*)(h1 + (size_t)m * DM) + lane; f32x4 v[4]; float s = 0.f;
#pragma unroll
        for (int j = 0; j < 4; ++j) { const u32x2 hw = NT_LD(hr + 64 * j); v[j].x = bf_lo(hw.x); v[j].y = bf_hi(hw.x); v[j].z = bf_lo(hw.y); v[j].w = bf_hi(hw.y); }
#pragma unroll
        for (int k = 0; k < 4; ++k) { const unsigned* yr = (const unsigned*)(y + (size_t)(m * 4 + k) * DM) + lane;
#pragma unroll
            for (int j = 0; j < 4; ++j) { const unsigned w = NT_LD(yr + 64 * j); const f32x2 lo = __builtin_amdgcn_cvt_pk_f32_fp8((int)w, false), hi = __builtin_amdgcn_cvt_pk_f32_fp8((int)w, true);
                v[j].x += lo.x * 0.0625f; v[j].y += lo.y * 0.0625f; v[j].z += hi.x * 0.0625f; v[j].w += hi.y * 0.0625f; } }
        u32x2* o8 = (u32x2*)(h1b + (size_t)m * DM) + lane; unsigned* o4 = (unsigned*)(ws + WS_H1F8 + (size_t)m * DM) + lane;
#pragma unroll
        for (int j = 0; j < 4; ++j) { u32x2 w; w.x = pk2(v[j].x, v[j].y); w.y = pk2(v[j].z, v[j].w); NT_ST(w, o8 + 64 * j); NT_ST(pk4_fp8(v[j].x, v[j].y, v[j].z, v[j].w), o4 + 64 * j);
            s += (v[j].x * v[j].x + v[j].y * v[j].y) + (v[j].z * v[j].z + v[j].w * v[j].w); }
        s = wave_sum(s);
        if (lane == 0) rs3[m] = 1.0f / sqrtf(s * (1.0f / DM) + EPS);
    }
}

__device__ __forceinline__ void final_phase(const Params& P, int mbeg, int mend, int mstep, int lane) {
    unsigned char* ws = P.ws;
    const bf16_t* h2b = (const bf16_t*)(ws + WS_H1B); const bf16_t* pj = (const bf16_t*)(ws + WS_PJ); const unsigned char* G = ws + WS_G; const float* rs3 = (const float*)(ws + WS_RS3);
    f32x4 gv[4];
#pragma unroll
    for (int j = 0; j < 4; ++j) gv[j] = *((const f32x4*)P.g_final + lane + 64 * j);
    for (int m = mbeg; m < mend; m += mstep) {
        const u32x2* hr = (const u32x2*)(h2b + (size_t)m * DM) + lane; const u32x2* pr = (const u32x2*)(pj + (size_t)m * DM) + lane; const unsigned* gr = (const unsigned*)(G + (size_t)m * DM) + lane;
        const float r3 = rs3[m]; f32x4 v[4]; float s = 0.f;
#pragma unroll
        for (int j = 0; j < 4; ++j) { const u32x2 hw = NT_LD(hr + 64 * j), pw = NT_LD(pr + 64 * j); const unsigned gw2 = NT_LD(gr + 64 * j);
            const f32x2 glo = __builtin_amdgcn_cvt_pk_f32_fp8((int)gw2, false), ghi = __builtin_amdgcn_cvt_pk_f32_fp8((int)gw2, true);
            v[j].x = bf_lo(hw.x) + bf_lo(pw.x) * sigmoidf_(glo.x * r3); v[j].y = bf_hi(hw.x) + bf_hi(pw.x) * sigmoidf_(glo.y * r3);
            v[j].z = bf_lo(hw.y) + bf_lo(pw.y) * sigmoidf_(ghi.x * r3); v[j].w = bf_hi(hw.y) + bf_hi(pw.y) * sigmoidf_(ghi.y * r3);
            s += (v[j].x * v[j].x + v[j].y * v[j].y) + (v[j].z * v[j].z + v[j].w * v[j].w); }
        s = wave_sum(s); const float rs = 1.0f / sqrtf(s * (1.0f / DM) + EPS);
        f32x4* orow = (f32x4*)(P.out + (size_t)m * DM) + lane;
#pragma unroll
        for (int j = 0; j < 4; ++j) NT_ST(v[j] * rs * gv[j], orow + 64 * j);
    }
}

#define XB_TMO      128
#define XB_XCNT(j)  (256  + 64 * (j))
#define XB_XSUB(j)  (1280 + 64 * (j))
#define XB_XGEN(j)  (2304 + 64 * (j))
#define XB_TOP      3328
#define XB_TOPGEN   3392
#define XCD_BAR_WORDS 3456
#define XB_SPIN_CAP (1u << 18)
__device__ __forceinline__ unsigned xb_ld(unsigned* p)              { return __hip_atomic_load(p, __ATOMIC_RELAXED, __HIP_MEMORY_SCOPE_AGENT); }
__device__ __forceinline__ unsigned xb_add(unsigned* p, unsigned v) { return __hip_atomic_fetch_add(p, v, __ATOMIC_RELAXED, __HIP_MEMORY_SCOPE_AGENT); }
__device__ __forceinline__ unsigned xb_xcc_id() { return (unsigned)__builtin_amdgcn_s_getreg((3 << 11) | 20) & 0xFu; }
#define XB_SPIN(cond, bar) do { unsigned _sp = 0; while (cond) { __builtin_amdgcn_s_sleep(1); \
    if ((++_sp & 255u) == 0u) { if (xb_ld(&(bar)[XB_TMO])) break; if (_sp > XB_SPIN_CAP) { atomicAdd(&(bar)[XB_TMO], 1u); break; } } } } while (0)
struct XcdBarrier { unsigned* bar; unsigned x; volatile LAS unsigned* st; };
__device__ __forceinline__ XcdBarrier xcd_barrier_post(unsigned* bar, volatile LAS unsigned* st) {
    XcdBarrier b; b.bar = bar; b.x = xb_xcc_id(); b.st = st;
    if (threadIdx.x == 0) (void)xb_add(&bar[XB_XCNT(b.x)], 1u);
    return b;
}
__device__ __forceinline__ void xcd_barrier_complete(unsigned* bar, unsigned x, unsigned& nloc, unsigned& nx) {
    const unsigned G = gridDim.x * gridDim.y * gridDim.z;
    unsigned sum, cnt, mine, sp = 0u;
    for (;;) {
        sum = 0u; cnt = 0u; mine = 0u;
#pragma unroll
        for (unsigned j = 0; j < 16; ++j) { const unsigned c = xb_ld(&bar[XB_XCNT(j)]); sum += c; cnt += (c > 0u) ? 1u : 0u; mine = (j == x) ? c : mine; }
        if (sum == G) break;
        __builtin_amdgcn_s_sleep(1);
        if ((++sp & 255u) == 0u) { if (xb_ld(&bar[XB_TMO])) break; if (sp > XB_SPIN_CAP) { atomicAdd(&bar[XB_TMO], 1u); break; } }
    }
    nloc = mine > 0u ? mine : 1u; nx = cnt > 0u ? cnt : 1u;
}
__device__ __forceinline__ void xcd_barrier(const XcdBarrier& b) {
    asm volatile("s_waitcnt vmcnt(0)" ::: "memory");
    __syncthreads();
    if (threadIdx.x == 0) {
        unsigned* bar = b.bar;
        __builtin_amdgcn_s_waitcnt(0);
        unsigned nloc = b.st[0], nx = b.st[1];
        if (nloc == 0u) { xcd_barrier_complete(bar, b.x, nloc, nx); b.st[0] = nloc; b.st[1] = nx; }
        const unsigned old = xb_add(&bar[XB_XSUB(b.x)], 1u);
        const unsigned gen = old / nloc;
        if (old + 1u == (gen + 1u) * nloc) {
            __builtin_amdgcn_fence(__ATOMIC_RELEASE, "agent");
            asm volatile("s_waitcnt vmcnt(0)" ::: "memory");
            const unsigned og = xb_add(&bar[XB_TOP], 1u);
            const unsigned tg = og / nx;
            if (og + 1u == (tg + 1u) * nx) xb_add(&bar[XB_TOPGEN], 1u);
            else XB_SPIN(xb_ld(&bar[XB_TOPGEN]) == tg, bar);
            __builtin_amdgcn_fence(__ATOMIC_ACQUIRE, "agent");
            xb_add(&bar[XB_XGEN(b.x)], 1u);
            asm volatile("s_waitcnt vmcnt(0)" ::: "memory");
        } else {
            XB_SPIN(xb_ld(&bar[XB_XGEN(b.x)]) == gen, bar);
            __builtin_amdgcn_fence(__ATOMIC_ACQUIRE, "agent");
            asm volatile("s_waitcnt vmcnt(0)" ::: "memory");
        }
    }
    __syncthreads();
}

__device__ __forceinline__ void pair_sync(unsigned* flag, unsigned* tmo, bool same_xcd) {
    asm volatile("s_waitcnt vmcnt(0)" ::: "memory");
    __syncthreads();
    if (threadIdx.x == 0) {
        if (!same_xcd) { __builtin_amdgcn_fence(__ATOMIC_RELEASE, "agent"); asm volatile("s_waitcnt vmcnt(0)" ::: "memory"); }
        xb_add(flag, 1u);
        unsigned sp = 0u;
        while (xb_ld(flag) < 2u) { __builtin_amdgcn_s_sleep(1); if ((++sp & 255u) == 0u) { if (xb_ld(tmo)) break; if (sp > XB_SPIN_CAP) { atomicAdd(tmo, 1u); break; } } }
        __builtin_amdgcn_fence(__ATOMIC_ACQUIRE, "agent");
        asm volatile("s_waitcnt vmcnt(0)" ::: "memory");
    }
    __syncthreads();
}

constexpr int NPHASE = 10;
__global__ void __launch_bounds__(NTHR, 2) fwd_kernel(Params P) {
    extern __shared__ __attribute__((aligned(16))) unsigned char lds_raw[];
    LAS unsigned char* lds = (LAS unsigned char*)lds_raw;
    cg::grid_group grid = cg::this_grid();
    const int tid = threadIdx.x, wave = __builtin_amdgcn_readfirstlane(tid >> 6);
    const int G = gridDim.x, bx = blockIdx.x;
#define FRESH_LANE(name) int name = (int)__builtin_amdgcn_mbcnt_hi(~0u, __builtin_amdgcn_mbcnt_lo(~0u, 0u)); asm volatile("" : "+v"(name))
    const int vcu = (G % 8 == 0) ? (bx % 8) * (G / 8) + bx / 8 : bx;
    const int NGW = G * NWAVES;
    unsigned char* ws = P.ws;
    const int lo = P.ph_lo, hi = P.ph_hi;
#define IN(k) (lo <= (k) && (k) < hi)
    volatile LAS unsigned* xst = (volatile LAS unsigned*)(lds + LDS_XB);
    if (tid < 2) xst[tid] = 0u;
    __syncthreads();
    const XcdBarrier xbar = xcd_barrier_post((unsigned*)(ws + WS_CTL) + CW_BAR, xst);
    if (tid == 0) __hip_atomic_store((unsigned*)(ws + WS_CTL) + CW_XCC + bx, xbar.x + 1u, __ATOMIC_RELAXED, __HIP_MEMORY_SCOPE_AGENT);
    if (P.ph_lo > P.ph_hi) grid.sync();
#define SYNC(k) do { if (IN(k) && IN((k) + 1)) xcd_barrier(xbar); } while (0)

    if (IN(0)) { FRESH_LANE(lane); p0_prologue(P, lds, vcu, G, wave, lane); }
    SYNC(0);
    if (IN(1)) {
        { pg8::DenseSched S; S.init((const bf16_t*)(ws + WS_XB), (const bf16_t*)(ws + WS_WIN), NTOK, 2048, 1024, G, bx);
          EpiInProj E{(const float*)(ws + WS_RS1), (const f32x2*)(ws + WS_ROPE), P.glu_b, (bf16_t*)(ws + WS_Q), (bf16_t*)(ws + WS_K), (bf16_t*)(ws + WS_V), (bf16_t*)(ws + WS_QI), (bf16_t*)(ws + WS_KI), (bf16_t*)(ws + WS_HGLU), (float*)(ws + WS_WI)};
          pg8::gemm_phase<EpiInProj, pg8::DenseSched, false>(lds, S, E); }
        { pg8::DenseSched S; S.init((const bf16_t*)(ws + WS_PB), (const bf16_t*)(ws + WS_WP), NTOK, 1024, 256, G, bx);
          EpiBf16Plain E{(bf16_t*)(ws + WS_PJ), 1024, 1.0f};
          pg8::gemm_phase<EpiBf16Plain, pg8::DenseSched, false>(lds, S, E); }
    }
    SYNC(1);
    if (IN(2)) {
        FRESH_LANE(lane);
        for (int i = tid; i < 4096; i += NTHR) ((LAS unsigned*)(lds + LDS_MISC))[i] = 0u;
        __syncthreads();
        unsigned* ctl = (unsigned*)(ws + WS_CTL);
        volatile LAS int* qw = (volatile LAS int*)(lds + LDS_XB + 32);
        if (G % 8 == 0 && G >= 128) { const int ncv = 8; if ((bx >> 3) < ncv) moe_weight_convert(P, (LAS float*)(lds + wave * 16384), (bx * NWAVES) + wave, ncv * 8 * NWAVES, lane); }
        else { moe_weight_convert(P, (LAS float*)(lds + wave * 16384), bx * NWAVES + wave, G * NWAVES, lane); }
        __syncthreads();
        for (int db = 0; db < NB; ++db) { const int b = (bx + db) & 7;
            for (;;) {
                if (tid == 0) qw[0] = (int)atomicAdd(ctl + CW_AQ + 64 * b, 1u);
                __syncthreads();
                const int k = qw[0];
                if (k >= 512) break;
                attn_tile(P, lds, b, (511 - k) * 8, wave, lane);
            }
            __syncthreads(); }
        for (;;) {
            if (tid == 0) qw[0] = (int)atomicAdd(ctl + CW_CQ, 1u);
            __syncthreads();
            const int tl = qw[0];
            if (tl >= NTOK / 32) break;
            conv_tile(P, lds, tl, tid, wave, lane);
        }
    }
    SYNC(2);
    if (IN(3)) {
        pg8::DenseSched S; S.init(ws + WS_MIX, ws + WS_WOUT, NTOK, 1024, 1024, G, bx); S.rp = 1024;
        EpiOutProj E{(const bf16_t*)(ws + WS_XB), (bf16_t*)(ws + WS_H1), (unsigned char*)(ws + WS_H1F8)};
        S.idg = true;
        pg8::gemm_phase<EpiOutProj, pg8::DenseSched, true, true, false>(lds, S, E);
    }
    SYNC(3);
    if (IN(4)) { FRESH_LANE(lane); router_phase(P, lds, vcu, G, tid, wave, lane); }
    SYNC(4);
    if (IN(5) || IN(6)) {
        LAS int* tb = (LAS int*)(lds + LDS_MISC); LAS int* cn = tb + 64;
        if (tid < NE) cn[tid] = (int)__hip_atomic_load((const unsigned*)(ws + WS_CTL) + CW_CNT + 64 * tid, __ATOMIC_RELAXED, __HIP_MEMORY_SCOPE_AGENT);
        __syncthreads();
        if (tid == 0) { int acc = 0;
            for (int e = 0; e < NE; ++e) { tb[e] = acc; acc += (cn[e] + BM - 1) / BM; }
            tb[NE] = acc; }
        __syncthreads();
        if (IN(5)) {
            pg8::MoeSched S; S.A = ws + WS_H1F8; S.Bt = ws + WS_WUP; S.rp = 1024; S.b_estride = (size_t)2048 * 1024; S.tb = tb; S.cnt = cn; S.list = (const int*)(ws + WS_LIST);
            S.nN = 8; S.nwg = tb[NE] * 8; S.G = G; S.c = bx; S.gather = true;
            { LAS int* ut = (LAS int*)(lds + LDS_MISC + 512); S.utab = ut; S.build_table(ut, tid); __syncthreads(); }
            S.m_scale = (const float*)(ws + WS_LSCALE); S.m_gate = nullptr; S.m_bias = P.b_up;
            EpiUp E{(unsigned char*)(ws + WS_ACT)};
            pg8::gemm_phase<EpiUp, pg8::MoeSched, true, true, true>(lds, S, E);
        }
        SYNC(5);
        if (IN(6)) {
            pg8::MoeSched S; S.A = ws + WS_ACT; S.Bt = ws + WS_WDOWN; S.rp = 1024; S.b_estride = (size_t)1024 * 1024; S.tb = tb; S.cnt = cn; S.list = (const int*)(ws + WS_LIST);
            S.nN = 4; S.nwg = tb[NE] * 4; S.G = G; S.c = bx; S.gather = false;
            { LAS int* ut = (LAS int*)(lds + LDS_MISC + 512); S.utab = ut; S.build_table(ut, tid); __syncthreads(); }
            S.m_scale = nullptr; S.m_gate = (const float*)(ws + WS_LGATE); S.m_bias = P.b_down;
            EpiDown E{(unsigned char*)(ws + WS_Y)};
            pg8::gemm_phase<EpiDown, pg8::MoeSched, true, true, true>(lds, S, E);
        }
    }
    SYNC(6);
    {
        const bool fused = (G == 256) && IN(7) && IN(8) && IN(9);
        const int j8 = bx >> 3, pm = (bx & 7) * 16 + (j8 >> 1), half = j8 & 1, r0 = pm * BM + half * 128;
        unsigned* ctl = (unsigned*)(ws + WS_CTL); unsigned* tmo = ctl + CW_BAR + XB_TMO;
        const bool same_xcd = fused && (xb_ld(ctl + CW_XCC + (bx ^ 8)) == xbar.x + 1u);
        if (IN(7)) { FRESH_LANE(l7);
            if (fused) combine_phase(P, r0 + wave, r0 + 128, NWAVES, l7); else combine_phase(P, vcu * NWAVES + wave, NTOK, NGW, l7); }
        if (fused) pair_sync(ctl + CW_PAIR + 16 * (2 * pm), tmo, same_xcd); else SYNC(7);
        if (IN(8)) {
            pg8::DenseSched S; S.init(ws + WS_H1F8, ws + WS_WG, NTOK, 1024, 1024, G, bx); S.rp = 1024; S.idg = true;
            if (fused) { S.pair_pm = pm; S.pair_pn0 = 2 * half; }
            EpiF8Plain E{(unsigned char*)(ws + WS_G), 1024, 0.03125f};
            pg8::gemm_phase<EpiF8Plain, pg8::DenseSched, true, true>(lds, S, E);
        }
        if (fused) pair_sync(ctl + CW_PAIR + 16 * (2 * pm + 1), tmo, same_xcd); else SYNC(8);
        if (IN(9)) { FRESH_LANE(l9);
            if (fused) final_phase(P, r0 + wave, r0 + 128, NWAVES, l9); else final_phase(P, vcu * NWAVES + wave, NTOK, NGW, l9); }
    }
#undef IN
#undef SYNC
}

#ifndef N_LAUNCH_MODE
#define N_LAUNCH_MODE 1
#endif
extern "C" void kernel_launch(void* const* d_in, const int* in_sizes, int n_in, void* d_out, int out_size, void* d_ws, size_t ws_size, hipStream_t stream) {
    static int grid = 0;
    if (grid == 0) {
        if (n_in != 21 || out_size != NTOK * DM || ws_size < WS_END) { fprintf(stderr, "kernel_launch: unexpected shapes (n_in %d out %d ws %zu)\n", n_in, out_size, ws_size); grid = -1; return; }
        int dev = 0, cus = 0, per_cu = 0;
        (void)hipGetDevice(&dev); (void)hipDeviceGetAttribute(&cus, hipDeviceAttributeMultiprocessorCount, dev);
        (void)hipFuncSetAttribute((const void*)fwd_kernel, hipFuncAttributeMaxDynamicSharedMemorySize, LDS_BYTES);
        if (hipOccupancyMaxActiveBlocksPerMultiprocessor(&per_cu, (const void*)fwd_kernel, NTHR, LDS_BYTES) != hipSuccess || per_cu < 1) { fprintf(stderr, "kernel_launch: occupancy query failed (%d)\n", per_cu); (void)hipGetLastError(); grid = -1; return; }
        grid = cus;
    }
    if (grid < 0) return;
    (void)hipMemsetAsync((char*)d_ws + WS_CTL, 0, CTL_BYTES, stream);
    Params p{};
    p.x = (const float*)d_in[0]; p.p = (const float*)d_in[1]; p.w_in = (const float*)d_in[2]; p.w_out = (const float*)d_in[3]; p.g_mix = (const float*)d_in[4]; p.g_ffn = (const float*)d_in[5];
    p.glu_b = (const float*)d_in[6]; p.dw_w = (const float*)d_in[7]; p.dw_b = (const float*)d_in[8]; p.ln_g = (const float*)d_in[9]; p.ln_b = (const float*)d_in[10];
    p.w_router = (const float*)d_in[11]; p.b_router = (const float*)d_in[12]; p.w_up = (const float*)d_in[13]; p.b_up = (const float*)d_in[14]; p.w_down = (const float*)d_in[15]; p.b_down = (const float*)d_in[16];
    p.w_ple_proj = (const float*)d_in[17]; p.w_ple_gate = (const float*)d_in[18]; p.g_ple = (const float*)d_in[19]; p.g_final = (const float*)d_in[20];
    p.out = (float*)d_out; p.ws = (unsigned char*)d_ws;
#if N_LAUNCH_MODE == 1
    p.ph_lo = 0; p.ph_hi = NPHASE;
    void* args[] = {&p};
    hipError_t e = hipLaunchCooperativeKernel((const void*)fwd_kernel, dim3(grid), dim3(NTHR), args, LDS_BYTES, stream);
    if (e != hipSuccess) fprintf(stderr, "cooperative launch failed: %s (grid %d)\n", hipGetErrorString(e), grid);
#else
    for (int ph = 0; ph < NPHASE; ++ph) {
        p.ph_lo = ph; p.ph_hi = ph + 1;
        void* args[] = {&p};
        hipError_t e = hipLaunchCooperativeKernel((const void*)fwd_kernel, dim3(grid), dim3(NTHR), args, LDS_BYTES, stream);
        if (e != hipSuccess) { fprintf(stderr, "launch %d failed: %s (grid %d)\n", ph, hipGetErrorString(e), grid); break; }
    }
#endif
}
```

```cpp
#include <hip/hip_runtime.h>
#include <hip/hip_cooperative_groups.h>
#include <cstdio>
#include <cstdint>
namespace cg = cooperative_groups;

#define LAS __attribute__((address_space(3)))
#define GAS __attribute__((address_space(1)))
typedef unsigned short bf16_t;
typedef short bf16x8 __attribute__((ext_vector_type(8)));
typedef short s16x4 __attribute__((ext_vector_type(4)));
typedef float f32x4 __attribute__((ext_vector_type(4)));
typedef float f32x2 __attribute__((ext_vector_type(2)));
typedef float f32x16 __attribute__((ext_vector_type(16)));
typedef unsigned u32x4 __attribute__((ext_vector_type(4)));
typedef unsigned u32x2 __attribute__((ext_vector_type(2)));

constexpr int NB = 8, SEQ = 4096, DM = 1024, NTOK = NB * SEQ;
constexpr int NE = 32, TOPK = 4, NSLOT = NTOK * TOPK;
constexpr int INW = 1988;
constexpr int NSEL = 256;
constexpr float EPS = 1e-6f;
constexpr int NWAVES = 8, NTHR = 512;

constexpr size_t MiB = 1u << 20;
constexpr size_t WS_CTL = 0, CTL_BYTES = 64 * 1024;
constexpr size_t WS_ROPE = 1 * MiB;
constexpr size_t WS_WIN = 2 * MiB;
constexpr size_t WS_WOUT = 6 * MiB;
constexpr size_t WS_WG = 8 * MiB;
constexpr size_t WS_WP = 10 * MiB;
constexpr size_t WS_WRG = 10 * MiB + 512 * 1024;
constexpr size_t WS_RS1 = 11 * MiB;
constexpr size_t WS_RS3 = 11 * MiB + 512 * 1024;
constexpr size_t WS_WI = 12 * MiB;
constexpr size_t WS_LIST = 13 * MiB;
constexpr size_t WS_LSCALE = 17 * MiB;
constexpr size_t WS_LGATE = 21 * MiB;
constexpr size_t WS_PB = 25 * MiB;
constexpr size_t WS_WUP = 42 * MiB;
constexpr size_t WS_WDOWN = 170 * MiB;
constexpr size_t WS_H1 = 234 * MiB;
constexpr size_t WS_H1B = 362 * MiB;
constexpr size_t WS_PJ = 426 * MiB;
constexpr size_t WS_XB = 490 * MiB;
constexpr size_t WS_Q = 554 * MiB;
constexpr size_t WS_K = 586 * MiB;
constexpr size_t WS_V = 590 * MiB;
constexpr size_t WS_QI = 594 * MiB;
constexpr size_t WS_KI = 610 * MiB;
constexpr size_t WS_HGLU = 614 * MiB;
constexpr size_t WS_MIX = 646 * MiB;
constexpr size_t WS_H1F8 = 298 * MiB;
constexpr size_t WS_ACT = 522 * MiB;
constexpr size_t WS_Y = 762 * MiB;
constexpr size_t WS_G = 762 * MiB;
constexpr size_t WS_END = 1018 * MiB;
static_assert(WS_H1F8 + (size_t)NTOK * 1024 <= WS_ACT && WS_ACT + (size_t)139264 * 1024 <= WS_Y, "ws map");
constexpr int CW_CNT = 1024;
constexpr int CW_AQ = 4096;
constexpr int CW_CQ = 4096 + 64 * 8;
constexpr int CW_BAR = 8192;
constexpr int CW_XCC = 7168;
constexpr int CW_PAIR = 12288;

constexpr int LDS_STAGE = 131072;
constexpr int LDS_MISC = LDS_STAGE;
constexpr int LDS_META = LDS_MISC + 4096;
constexpr int LDS_XB = 147456;
constexpr int LDS_BYTES = 147456 + 256;

__device__ __forceinline__ unsigned f2bf(float f) { unsigned u = __builtin_bit_cast(unsigned, f); return (u + 0x7fffu + ((u >> 16) & 1u)) >> 16; }
__device__ __forceinline__ unsigned pk2(float lo, float hi) { return f2bf(lo) | (f2bf(hi) << 16); }
__device__ __forceinline__ float bf_lo(unsigned w) { return __builtin_bit_cast(float, w << 16); }
__device__ __forceinline__ float bf_hi(unsigned w) { return __builtin_bit_cast(float, w & 0xffff0000u); }
__device__ __forceinline__ float wave_sum(float v) {
    v += __builtin_bit_cast(float, __builtin_amdgcn_update_dpp(0, __builtin_bit_cast(int, v), 0xB1, 0xF, 0xF, true));
    v += __builtin_bit_cast(float, __builtin_amdgcn_update_dpp(0, __builtin_bit_cast(int, v), 0x4E, 0xF, 0xF, true));
    v += __builtin_bit_cast(float, __builtin_amdgcn_update_dpp(0, __builtin_bit_cast(int, v), 0x141, 0xF, 0xF, true));
    v += __builtin_bit_cast(float, __builtin_amdgcn_update_dpp(0, __builtin_bit_cast(int, v), 0x140, 0xF, 0xF, true));
    const int vi = __builtin_bit_cast(int, v);
    const float r0 = __builtin_bit_cast(float, __builtin_amdgcn_readlane(vi, 0)), r1 = __builtin_bit_cast(float, __builtin_amdgcn_readlane(vi, 16));
    const float r2 = __builtin_bit_cast(float, __builtin_amdgcn_readlane(vi, 32)), r3 = __builtin_bit_cast(float, __builtin_amdgcn_readlane(vi, 48));
    return (r0 + r1) + (r2 + r3);
}
__device__ __forceinline__ unsigned pk4_fp8(float a, float b, float c, float d) { int r = __builtin_amdgcn_cvt_pk_fp8_f32(a, b, 0, false); r = __builtin_amdgcn_cvt_pk_fp8_f32(c, d, r, true); return (unsigned)r; }
__device__ __forceinline__ float sigmoidf_(float x) { return __builtin_amdgcn_rcpf(1.0f + __builtin_amdgcn_exp2f(x * -1.4426950408889634f)); }
#define LDS_WAIT() asm volatile("s_waitcnt lgkmcnt(0)" ::: "memory")
#define NT_LD(p) __builtin_nontemporal_load(p)
#define NT_ST(v, p) __builtin_nontemporal_store(v, p)

struct Params {
    const float* x; const float* p; const float* w_in; const float* w_out; const float* g_mix; const float* g_ffn;
    const float* glu_b; const float* dw_w; const float* dw_b; const float* ln_g; const float* ln_b;
    const float* w_router; const float* b_router; const float* w_up; const float* b_up; const float* w_down; const float* b_down;
    const float* w_ple_proj; const float* w_ple_gate; const float* g_ple; const float* g_final;
    float* out; unsigned char* ws;
    int ph_lo, ph_hi;
};

namespace pg8 {
constexpr int BM = 256, BK = 64, HALF = 128, HTB = HALF * BK * 2, STAGE_BYTES = 8 * HTB, NXCD = 8, WGM = 8;
__host__ __device__ __forceinline__ int lds_byte(int r, int c) { const int st = (r >> 4) * 2 + (c >> 5), rr = r & 15, cc = c & 31, ob = rr * 64 + cc * 2; return st * 1024 + (ob ^ (((ob >> 9) & 1) << 5)); }
__host__ __device__ __forceinline__ void stage_rc(int b, int& R, int& C) { const int st = b / 1024, sb = b % 1024, swz = sb ^ (((sb >> 9) & 1) << 5); R = (st >> 1) * 16 + swz / 64; C = (st & 1) * 32 + (swz % 64) / 2; }
__host__ __device__ __forceinline__ int perm32(int rho) { const int n = rho >> 4, i = rho & 15; return 8 * (i >> 2) + 4 * n + (i & 3); }

struct Unit { int pm, pn, e, rows; };

__device__ __forceinline__ unsigned cvt_pk_bf16(float lo, float hi) { unsigned r; asm volatile("v_cvt_pk_bf16_f32 %0, %1, %2" : "=v"(r) : "v"(lo), "v"(hi)); return r; }

struct DenseSched {
    const void* A; const void* Bt; int rp;
    int nM, nN, nwg, G, c;
    __device__ void init(const void* A_, const void* Bt_, int M, int N, int K_, int G_, int c_) { A = A_; Bt = Bt_; rp = K_ * 2; nM = M / BM; nN = N / BM; nwg = nM * nN; G = G_; c = c_; }
    int pair_pm = -1, pair_pn0 = 0;
    __device__ bool next(int i, Unit& u) const {
        if (pair_pm >= 0) { if (i >= 2) return false; u.pm = pair_pm; u.pn = pair_pn0 + i; u.e = 0; u.rows = BM; return true; }
        const long L = (long)i * G + c; if (L >= nwg) return false;
        int wgid = (int)L; { const int q = nwg / NXCD, r = nwg % NXCD, xcd = wgid % NXCD, off = wgid / NXCD; wgid = (xcd < r ? xcd * (q + 1) : r * (q + 1) + (xcd - r) * q) + off; }
        const int nig = WGM * nN, gid = wgid / nig, fm = gid * WGM, gsz = (nM - fm) < WGM ? (nM - fm) : WGM;
        u.pm = fm + ((wgid % nig) % gsz); u.pn = (wgid % nig) / gsz; u.e = 0; u.rows = BM; return true;
    }
    bool idg = false;
    __device__ __forceinline__ const char* a_ptr(const Unit& u) const { return idg ? (const char*)A : (const char*)A + (size_t)u.pm * BM * rp; }
    __device__ __forceinline__ const char* b_ptr(const Unit& u) const { return (const char*)Bt + (size_t)u.pn * BM * rp; }
    __device__ __forceinline__ int a_row(const Unit& u, int r) const { return u.pm * BM + r; }
    __device__ __forceinline__ void meta(const Unit&, LAS unsigned char*, int, int) const {}
};

struct MoeSched {
    const void* A; const void* Bt; int rp; size_t b_estride;
    const LAS int* tb;
    const LAS int* cnt;
    const int* list;
    int nN, nwg, G, c; bool gather;
    const LAS int* utab;
    __device__ __forceinline__ bool next(int i, Unit& u) const {
        if (i >= 32) return false;
        const LAS int* p = utab + 4 * i; const int rows = p[3]; if (rows < 0) return false;
        u.pm = p[0]; u.pn = p[1]; u.e = p[2]; u.rows = rows; return true;
    }
    __device__ __forceinline__ void build_table(LAS int* tab, int tid) const {
        if (tid < 32) { Unit u; const bool ok = decode(tid, u); tab[4 * tid] = u.pm; tab[4 * tid + 1] = u.pn; tab[4 * tid + 2] = u.e; tab[4 * tid + 3] = ok ? u.rows : -1; }
    }
    __device__ __forceinline__ bool decode(int i, Unit& u) const {
        u.pm = 0; u.pn = 0; u.e = 0; u.rows = 0;
        const long L = (long)i * G + c; if (L >= nwg) return false;
        int wgid = (int)L; { const int q = nwg / NXCD, r = nwg % NXCD, xcd = wgid % NXCD, off = wgid / NXCD; wgid = (xcd < r ? xcd * (q + 1) : r * (q + 1) + (xcd - r) * q) + off; }
        int e = 0;
#pragma unroll 1
        for (; e < NE - 1; ++e) { if (wgid < tb[e + 1] * nN) break; }
        const int local = wgid - tb[e] * nN, nM = tb[e + 1] - tb[e];
        const int nig = WGM * nN, gid = local / nig, fm = gid * WGM, gsz = (nM - fm) < WGM ? (nM - fm) : WGM;
        const int rt = fm + ((local % nig) % gsz);
        u.pm = tb[e] + rt; u.pn = (local % nig) / gsz; u.e = e;
        const int left = cnt[e] - rt * BM; u.rows = left < BM ? left : BM; return true;
    }
    __device__ __forceinline__ const char* a_ptr(const Unit& u) const { return (const char*)A; }
    __device__ __forceinline__ const char* b_ptr(const Unit& u) const { return (const char*)Bt + (size_t)u.e * b_estride + (size_t)u.pn * BM * rp; }
    __device__ __forceinline__ int a_row(const Unit& u, int r) const {
        if (!gather) return u.pm * BM + r;
        const int rt = u.pm - tb[u.e];
        return r < u.rows ? (list[u.e * NTOK + rt * BM + r] >> 2) : 0;
    }
    const float* m_scale; const float* m_gate; const float* m_bias;
    __device__ __forceinline__ void meta(const Unit& u, LAS unsigned char* tbl, int wid, int lane) const {
        const int rt = u.pm - tb[u.e]; const size_t li = (size_t)u.e * NTOK + rt * BM + (wid & 3) * 64 + lane;
        if (gather) {
            if (wid < 4) __builtin_amdgcn_global_load_lds((const unsigned*)(m_scale + li), (LAS unsigned*)(tbl + (wid & 3) * 256), 4, 0, 0);
            else { const int j = (wid & 3) * 64 + lane; const float* src = m_bias + (size_t)u.e * 2048 + (j < 128 ? 128 * u.pn + j : 1024 + 128 * u.pn + (j - 128));
                __builtin_amdgcn_global_load_lds((const unsigned*)src, (LAS unsigned*)(tbl + 2048 + (wid & 3) * 256), 4, 0, 0); }
        } else {
            if (wid < 4) { __builtin_amdgcn_global_load_lds((const unsigned*)(list + li), (LAS unsigned*)(tbl + (wid & 3) * 256), 4, 0, 0);
                __builtin_amdgcn_global_load_lds((const unsigned*)(m_bias + (size_t)u.e * 1024 + u.pn * BM + (wid & 3) * 64 + lane), (LAS unsigned*)(tbl + 2048 + (wid & 3) * 256), 4, 0, 0); }
            else __builtin_amdgcn_global_load_lds((const unsigned*)(m_gate + li), (LAS unsigned*)(tbl + 1024 + (wid & 3) * 256), 4, 0, 0);
        }
    }
};

typedef int v8i32 __attribute__((ext_vector_type(8)));
template <class Epi, class Sched, bool GATHER, bool F8 = false, bool WARMTRIP = false>
__device__ __forceinline__ void gemm_phase(LAS unsigned char* lds, const Sched& S, const Epi& E) {
    const int tid = threadIdx.x, wid = __builtin_amdgcn_readfirstlane(tid >> 6), lane = tid & 63, wr = wid >> 2, wc = wid & 3, fr = lane & 15, fq = lane >> 4;
    const int RP = S.rp, nt = RP / (BK * 2);
    unsigned voffA[2], voffB[2]; int RA[2], CA[2];
#pragma unroll
    for (int i = 0; i < 2; ++i) { int R, C; stage_rc(tid * 16 + i * 8192, R, C); const int Rb = Epi::PERM ? ((R & ~31) + perm32(R & 31)) : R;
        voffA[i] = (unsigned)(R * RP + C * 2); voffB[i] = (unsigned)(Rb * RP + C * 2); RA[i] = R; CA[i] = C; }
    const size_t kstep = (size_t)(BK * 2);
    const size_t hstep = (size_t)HALF * RP;
    const unsigned ldsw = (unsigned)wid * 1024u;
    const int aoff = lds_byte(wr * 64 + fr, fq * 8), boff = lds_byte(wc * 32 + fr, fq * 8);
    unsigned gC[2][2], gN[2][2];
#define PG8_SA(b, h) (((b) * 2 + (h)) * HTB)
#define PG8_SB(b, h) ((4 + (b) * 2 + (h)) * HTB)
#define PG8_STAGE(bufoff, gbase, voff) do { _Pragma("unroll") for (int _i = 0; _i < 2; ++_i) \
        __builtin_amdgcn_global_load_lds((const unsigned*)((const char*)(gbase) + (voff)[_i]), (LAS unsigned*)(lds + (bufoff) + ldsw + _i * 8192), 16, 0, 0); } while (0)
#define PG8_STAGE_A(bufoff, kp, h) do { if constexpr (GATHER) { PG8_STAGE(bufoff, kp, gC[h]); } else { PG8_STAGE(bufoff, (kp) + (h) * hstep, voffA); } } while (0)
#define PG8_LD16(p) (*(const LAS bf16x8*)(p))
#define PG8_CAT(lo, hi) __builtin_bit_cast(v8i32, __builtin_shufflevector(lo, hi, 0, 1, 2, 3, 4, 5, 6, 7, 8, 9, 10, 11, 12, 13, 14, 15))
#define PG8_LDA(dst, b, h) do { _Pragma("unroll") for (int m = 0; m < 4; ++m) { if constexpr (F8) { dst##8[m] = PG8_CAT(PG8_LD16(lds + PG8_SA(b, h) + aoff + m * 2048), PG8_LD16(lds + PG8_SA(b, h) + aoff + m * 2048 + 1024)); } \
        else { _Pragma("unroll") for (int k = 0; k < 2; ++k) dst[m][k] = PG8_LD16(lds + PG8_SA(b, h) + aoff + m * 2048 + k * 1024); } } } while (0)
#define PG8_LDB(dst, b, h) do { _Pragma("unroll") for (int n = 0; n < 2; ++n) { if constexpr (F8) { dst##8[n] = PG8_CAT(PG8_LD16(lds + PG8_SB(b, h) + boff + n * 2048), PG8_LD16(lds + PG8_SB(b, h) + boff + n * 2048 + 1024)); } \
        else { _Pragma("unroll") for (int k = 0; k < 2; ++k) dst[n][k] = PG8_LD16(lds + PG8_SB(b, h) + boff + n * 2048 + k * 1024); } } } while (0)
#define PG8_MMA(ai, bj, At, Bt) do { __builtin_amdgcn_s_setprio(1); _Pragma("unroll") for (int m = 0; m < 4; ++m) _Pragma("unroll") for (int n = 0; n < 2; ++n) { \
        if constexpr (F8) { acc[ai][bj][m][n] = __builtin_amdgcn_mfma_scale_f32_16x16x128_f8f6f4(Bt##8[n], At##8[m], acc[ai][bj][m][n], 0, 0, 0, 0x7f7f7f7f, 0, 0x7f7f7f7f); } \
        else { _Pragma("unroll") for (int k = 0; k < 2; ++k) acc[ai][bj][m][n] = __builtin_amdgcn_mfma_f32_16x16x32_bf16(Bt[n][k], At[m][k], acc[ai][bj][m][n], 0, 0, 0); } } \
        __builtin_amdgcn_s_setprio(0); } while (0)
#define PG8_WAIT_V(n) asm volatile("s_waitcnt vmcnt(" #n ")" ::: "memory")
#define PG8_WAIT_L(n) asm volatile("s_waitcnt lgkmcnt(" #n ")" ::: "memory")
#define PG8_BAR __builtin_amdgcn_s_barrier()
#define PG8_SCHED __builtin_amdgcn_sched_barrier(0)
#define PG8_GOFF(dst, u) do { _Pragma("unroll") for (int _h = 0; _h < 2; ++_h) _Pragma("unroll") for (int _i = 0; _i < 2; ++_i) \
        dst[_h][_i] = (unsigned)(S.a_row(u, _h * HALF + RA[_i]) * RP + CA[_i] * 2); } while (0)
    Unit cur, nxt, nn; int ui = 0;
    if (!S.next(0, cur)) return;
    bool has_next = S.next(1, nxt);
    if constexpr (GATHER) { PG8_GOFF(gC, cur); if (has_next) { PG8_GOFF(gN, nxt); } else { PG8_GOFF(gN, cur); } }
    f32x4 acc[2][2][4][2];
#pragma unroll
    for (int a = 0; a < 2; ++a)
#pragma unroll
        for (int b = 0; b < 2; ++b)
#pragma unroll
            for (int m = 0; m < 4; ++m)
#pragma unroll
                for (int n = 0; n < 2; ++n) acc[a][b][m][n] = (f32x4){0.f, 0.f, 0.f, 0.f};
    bf16x8 At[4][2], B0[2][2], B1[2][2]; v8i32 At8[4], B08[2], B18[2];
    const char* cA = S.a_ptr(cur); const char* cB = S.b_ptr(cur);
    PG8_STAGE(PG8_SB(0, 0), cB, voffB); PG8_STAGE(PG8_SB(0, 1), cB + hstep, voffB); PG8_STAGE_A(PG8_SA(0, 0), cA, 0); PG8_STAGE_A(PG8_SA(0, 1), cA, 1);
    if (wr == 1) PG8_BAR;
    PG8_WAIT_V(2); PG8_BAR;
    PG8_STAGE(PG8_SB(1, 0), cB + kstep, voffB); PG8_STAGE_A(PG8_SA(1, 0), cA + kstep, 0); PG8_STAGE(PG8_SB(1, 1), cB + hstep + kstep, voffB);
    PG8_WAIT_V(6); PG8_BAR;
    for (;;) {
        const char* nA = has_next ? S.a_ptr(nxt) : cA; const char* nB = has_next ? S.b_ptr(nxt) : cB;
        S.meta(cur, lds + (LDS_META - 0) + (ui & 1) * 4096, wid, lane);
#define PG8_TRIP(WARM, t) do { \
            const bool last = ((t) == nt - 2); \
            const char* a1 = cA + (size_t)((t) + 1) * kstep; \
            const char* a2 = last ? nA : cA + (size_t)((t) + 2) * kstep; const char* b2 = last ? nB : cB + (size_t)((t) + 2) * kstep; \
            const char* a3 = a2 + kstep; const char* b3 = b2 + kstep; \
              \
            PG8_LDB(B0, 0, 0); PG8_LDB(B1, 0, 1); PG8_SCHED; PG8_LDA(At, 0, 0); if constexpr (!(WARM)) { PG8_STAGE_A(PG8_SA(1, 1), a1, 1); } \
            if constexpr (GATHER) { if (last) { _Pragma("unroll") for (int h = 0; h < 2; ++h) _Pragma("unroll") for (int i = 0; i < 2; ++i) gC[h][i] = gN[h][i]; } } \
            if constexpr (!(WARM)) { PG8_WAIT_V(8); } PG8_WAIT_L(0); PG8_BAR; PG8_MMA(0, 0, At, B0); PG8_MMA(0, 1, At, B1); PG8_BAR; PG8_SCHED; \
              \
            PG8_LDA(At, 0, 1); PG8_STAGE(PG8_SB(0, 0), b2, voffB); PG8_STAGE(PG8_SB(0, 1), b2 + hstep, voffB); PG8_STAGE_A(PG8_SA(0, 0), a2, 0); \
            if constexpr (!(WARM)) { PG8_WAIT_V(8); } PG8_WAIT_L(0); PG8_BAR; PG8_MMA(1, 0, At, B0); PG8_MMA(1, 1, At, B1); PG8_BAR; PG8_SCHED; \
              \
            PG8_LDB(B0, 1, 0); PG8_LDB(B1, 1, 1); PG8_SCHED; PG8_LDA(At, 1, 0); PG8_STAGE_A(PG8_SA(0, 1), a2, 1); \
            if constexpr (!(WARM)) { PG8_WAIT_V(8); } PG8_WAIT_L(0); PG8_BAR; PG8_MMA(0, 0, At, B0); PG8_MMA(0, 1, At, B1); PG8_BAR; PG8_SCHED; \
              \
            PG8_LDA(At, 1, 1); PG8_STAGE(PG8_SB(1, 0), b3, voffB); PG8_STAGE(PG8_SB(1, 1), b3 + hstep, voffB); PG8_STAGE_A(PG8_SA(1, 0), a3, 0); \
            PG8_WAIT_V(8); PG8_WAIT_L(0); PG8_BAR; PG8_MMA(1, 0, At, B0); PG8_MMA(1, 1, At, B1); PG8_BAR; PG8_SCHED; \
        } while (0)
        int t0_ = 0;
        if constexpr (WARMTRIP) { if (ui > 0) { PG8_TRIP(true, 0); t0_ = 2; } }
        for (int t = t0_; t < nt; t += 2) { PG8_TRIP(false, t); }
#undef PG8_TRIP
        if (wr == 0) PG8_BAR;
        if constexpr (WARMTRIP) { PG8_STAGE_A(PG8_SA(1, 1), nA + kstep, 1); }
        bool has_nn = false;
        if constexpr (GATHER) { if (has_next) { has_nn = S.next(ui + 2, nn); if (has_nn) { PG8_GOFF(gN, nn); } } }
        else { if (has_next) has_nn = S.next(ui + 2, nn); }
        { int ln_; asm volatile("v_mbcnt_lo_u32_b32 %0, -1, 0\n\tv_mbcnt_hi_u32_b32 %0, -1, %0" : "=v"(ln_)); const int fr_ = ln_ & 15, fq_ = ln_ >> 4;
          const LAS unsigned char* mt = lds + LDS_META + (ui & 1) * 4096;
          if constexpr (WARMTRIP) {
              E.pre(acc, cur, wr, wc, fr_, fq_, mt);
              if constexpr (GATHER) asm volatile("" : "+v"(gN[0][0]), "+v"(gN[0][1]), "+v"(gN[1][0]), "+v"(gN[1][1]));
              PG8_WAIT_V(0);
              E.post(acc, cur, wr, wc, fr_, fq_, mt);
          } else { E.run(acc, cur, wr, wc, fr_, fq_, mt); } }
        if (!has_next) break;
#pragma unroll
        for (int a = 0; a < 2; ++a)
#pragma unroll
            for (int b = 0; b < 2; ++b)
#pragma unroll
                for (int m = 0; m < 4; ++m)
#pragma unroll
                    for (int n = 0; n < 2; ++n) acc[a][b][m][n] = (f32x4){0.f, 0.f, 0.f, 0.f};
        cur = nxt; cA = nA; cB = nB; ++ui; nxt = nn; has_next = has_nn;
        if (wr == 1) PG8_BAR;
    }
    PG8_WAIT_V(0);
    PG8_BAR;
#undef PG8_SA
#undef PG8_SB
#undef PG8_STAGE
#undef PG8_STAGE_A
#undef PG8_LDA
#undef PG8_LDB
#undef PG8_MMA
#undef PG8_LD16
#undef PG8_CAT
#undef PG8_WAIT_V
#undef PG8_WAIT_L
#undef PG8_BAR
#undef PG8_SCHED
#undef PG8_GOFF
}
}

using pg8::Unit; using pg8::cvt_pk_bf16;
constexpr int BM = 256, HALF = 128;

typedef f32x4 (&AccRef)[2][2][4][2];
__device__ __forceinline__ void pack8_bf16(f32x4& lo, const f32x4& hi) {
    const unsigned w0 = cvt_pk_bf16(lo[0], lo[1]), w1 = cvt_pk_bf16(lo[2], lo[3]), w2 = cvt_pk_bf16(hi[0], hi[1]), w3 = cvt_pk_bf16(hi[2], hi[3]);
    lo[0] = __builtin_bit_cast(float, w0); lo[1] = __builtin_bit_cast(float, w1); lo[2] = __builtin_bit_cast(float, w2); lo[3] = __builtin_bit_cast(float, w3);
}
#define AS_U4(v) __builtin_bit_cast(u32x4, v)

struct EpiInProj {
    static constexpr bool PERM = true;
    const float* rs1; const f32x2* rope; const float* glu_b;
    bf16_t *q, *k, *v, *qi, *ki, *hglu; float* wi;
    __device__ __forceinline__ void pre(AccRef acc, const Unit& u, int wr, int wc, int fr, int fq, const LAS unsigned char* mt) const {
        const int row0 = u.pm * BM + wr * 64 + fr;
        if (u.pn >= 4) {
            const int ch = 128 * (u.pn - 4) + 32 * wc + 8 * fq;
            f32x4 ba[2], bg[2];
#pragma unroll
            for (int n = 0; n < 2; ++n) { ba[n] = *(const f32x4*)(glu_b + ch + 4 * n); bg[n] = *(const f32x4*)(glu_b + 512 + ch + 4 * n); }
#pragma unroll
            for (int ai = 0; ai < 2; ++ai)
#pragma unroll
                for (int m = 0; m < 4; ++m) { const float rs = rs1[row0 + ai * HALF + m * 16];
#pragma unroll
                    for (int n = 0; n < 2; ++n)
#pragma unroll
                        for (int e = 0; e < 4; ++e) { const float a = acc[ai][0][m][n][e] * rs + ba[n][e], g = acc[ai][1][m][n][e] * rs + bg[n][e]; acc[ai][0][m][n][e] = a * sigmoidf_(g); }
                    pack8_bf16(acc[ai][0][m][0], acc[ai][0][m][1]); }
            return;
        }
        const bool do_rope = !(u.pn == 3 && wc >= 2), is_wi = (u.pn == 3 && wc == 3);
        const int d0 = 8 * fq;
#pragma unroll
        for (int ai = 0; ai < 2; ++ai)
#pragma unroll
            for (int m = 0; m < 4; ++m) { const int row = row0 + ai * HALF + m * 16; const float rs = rs1[row];
                if (do_rope) {
                    const f32x2* rp = rope + (size_t)(row & (SEQ - 1)) * 32 + d0;
#pragma unroll
                    for (int n = 0; n < 2; ++n)
#pragma unroll
                        for (int e = 0; e < 4; ++e) { const f32x2 cs = rp[4 * n + e]; const float x1 = acc[ai][0][m][n][e] * rs, x2 = acc[ai][1][m][n][e] * rs;
                            acc[ai][0][m][n][e] = x1 * cs.x - x2 * cs.y; acc[ai][1][m][n][e] = x2 * cs.x + x1 * cs.y; }
                } else {
#pragma unroll
                    for (int n = 0; n < 2; ++n) { acc[ai][0][m][n] = acc[ai][0][m][n] * rs; acc[ai][1][m][n] = acc[ai][1][m][n] * rs; }
                }
                if (!is_wi) { pack8_bf16(acc[ai][0][m][0], acc[ai][0][m][1]); pack8_bf16(acc[ai][1][m][0], acc[ai][1][m][1]); }
                if (m & 1) __builtin_amdgcn_sched_barrier(0); }
    }
    __device__ __forceinline__ void post(AccRef acc, const Unit& u, int wr, int wc, int fr, int fq, const LAS unsigned char* mt) const {
        const int row0 = u.pm * BM + wr * 64 + fr;
        if (u.pn >= 4) {
            const int ch = 128 * (u.pn - 4) + 32 * wc + 8 * fq;
#pragma unroll
            for (int ai = 0; ai < 2; ++ai)
#pragma unroll
                for (int m = 0; m < 4; ++m) *(u32x4*)(hglu + (size_t)(row0 + ai * HALF + m * 16) * 512 + ch) = AS_U4(acc[ai][0][m][0]);
            return;
        }
        bf16_t* dst; int ld, col; bool is_wi = false;
        if (u.pn < 2) { dst = q; ld = 512; col = (4 * u.pn + wc) * 64; }
        else if (u.pn == 2) { dst = qi; ld = 256; col = wc * 64; }
        else { ld = 64; col = 0; if (wc == 0) dst = k; else if (wc == 1) dst = ki; else if (wc == 2) dst = v; else { dst = v; is_wi = true; } }
        if (is_wi) {
            if (fq == 0) {
#pragma unroll
                for (int ai = 0; ai < 2; ++ai)
#pragma unroll
                    for (int m = 0; m < 4; ++m) *(f32x4*)(wi + (size_t)(row0 + ai * HALF + m * 16) * 4) = acc[ai][0][m][0];
            }
            return;
        }
#pragma unroll
        for (int ai = 0; ai < 2; ++ai)
#pragma unroll
            for (int m = 0; m < 4; ++m) { bf16_t* rp2 = dst + (size_t)(row0 + ai * HALF + m * 16) * ld + col + 8 * fq;
                *(u32x4*)(rp2) = AS_U4(acc[ai][0][m][0]); *(u32x4*)(rp2 + 32) = AS_U4(acc[ai][1][m][0]); }
    }
    __device__ __forceinline__ void run(const f32x4 (&acc)[2][2][4][2], const Unit& u, int wr, int wc, int fr, int fq, const LAS unsigned char* mt) const {
        const int row0 = u.pm * BM + wr * 64 + fr;
        if (u.pn >= 4) {
            const int ch = 128 * (u.pn - 4) + 32 * wc + 8 * fq;
            f32x4 ba[2], bg[2];
#pragma unroll
            for (int n = 0; n < 2; ++n) { ba[n] = *(const f32x4*)(glu_b + ch + 4 * n); bg[n] = *(const f32x4*)(glu_b + 512 + ch + 4 * n); }
#pragma unroll
            for (int ai = 0; ai < 2; ++ai)
#pragma unroll
                for (int m = 0; m < 4; ++m) { const int row = row0 + ai * HALF + m * 16; const float rs = rs1[row];
                    float o[8];
#pragma unroll
                    for (int n = 0; n < 2; ++n)
#pragma unroll
                        for (int e = 0; e < 4; ++e) { const float a = acc[ai][0][m][n][e] * rs + ba[n][e], g = acc[ai][1][m][n][e] * rs + bg[n][e]; o[4 * n + e] = a * sigmoidf_(g); }
                    u32x4 w; w.x = cvt_pk_bf16(o[0], o[1]); w.y = cvt_pk_bf16(o[2], o[3]); w.z = cvt_pk_bf16(o[4], o[5]); w.w = cvt_pk_bf16(o[6], o[7]);
                    *(u32x4*)(hglu + (size_t)row * 512 + ch) = w; }
            return;
        }
        bf16_t* dst; int ld, col; bool do_rope = true, is_wi = false;
        if (u.pn < 2) { dst = q; ld = 512; col = (4 * u.pn + wc) * 64; }
        else if (u.pn == 2) { dst = qi; ld = 256; col = wc * 64; }
        else { ld = 64; col = 0; if (wc == 0) dst = k; else if (wc == 1) dst = ki; else if (wc == 2) { dst = v; do_rope = false; } else { dst = v; is_wi = true; do_rope = false; } }
        if (is_wi) {
            if (fq == 0) {
#pragma unroll
                for (int ai = 0; ai < 2; ++ai)
#pragma unroll
                    for (int m = 0; m < 4; ++m) { const int row = row0 + ai * HALF + m * 16; const float rs = rs1[row];
                        *(f32x4*)(wi + (size_t)row * 4) = acc[ai][0][m][0] * rs; }
            }
            return;
        }
        const int d0 = 8 * fq;
#pragma unroll
        for (int ai = 0; ai < 2; ++ai)
#pragma unroll
            for (int m = 0; m < 4; ++m) { const int row = row0 + ai * HALF + m * 16; const float rs = rs1[row];
                float o1[8], o2[8];
                if (do_rope) {
                    const f32x4* rp = (const f32x4*)(rope + (size_t)(row & (SEQ - 1)) * 32 + d0);
#pragma unroll
                    for (int n = 0; n < 2; ++n)
#pragma unroll
                        for (int e2 = 0; e2 < 2; ++e2) { const f32x4 cs = rp[2 * n + e2];
                            { const float x1 = acc[ai][0][m][n][2 * e2] * rs, x2 = acc[ai][1][m][n][2 * e2] * rs; o1[4 * n + 2 * e2] = x1 * cs.x - x2 * cs.y; o2[4 * n + 2 * e2] = x2 * cs.x + x1 * cs.y; }
                            { const float x1 = acc[ai][0][m][n][2 * e2 + 1] * rs, x2 = acc[ai][1][m][n][2 * e2 + 1] * rs; o1[4 * n + 2 * e2 + 1] = x1 * cs.z - x2 * cs.w; o2[4 * n + 2 * e2 + 1] = x2 * cs.z + x1 * cs.w; } }
                } else {
#pragma unroll
                    for (int n = 0; n < 2; ++n)
#pragma unroll
                        for (int e = 0; e < 4; ++e) { o1[4 * n + e] = acc[ai][0][m][n][e] * rs; o2[4 * n + e] = acc[ai][1][m][n][e] * rs; }
                }
                u32x4 w1, w2; w1.x = cvt_pk_bf16(o1[0], o1[1]); w1.y = cvt_pk_bf16(o1[2], o1[3]); w1.z = cvt_pk_bf16(o1[4], o1[5]); w1.w = cvt_pk_bf16(o1[6], o1[7]);
                w2.x = cvt_pk_bf16(o2[0], o2[1]); w2.y = cvt_pk_bf16(o2[2], o2[3]); w2.z = cvt_pk_bf16(o2[4], o2[5]); w2.w = cvt_pk_bf16(o2[6], o2[7]);
                if (u.pn == 3 && wc == 1) {
                    bf16_t* tp = ki + ((size_t)(row >> 5) * 256 + (row & 31) + 32 * (fq & 1)) * 8;
                    *(u32x4*)(tp + (size_t)(fq >> 1) * 512) = w1; *(u32x4*)(tp + (size_t)(2 + (fq >> 1)) * 512) = w2;
                } else {
                    bf16_t* rp2 = dst + (size_t)row * ld + col + d0;
                    *(u32x4*)(rp2) = w1; *(u32x4*)(rp2 + 32) = w2; } }
    }
};

struct EpiBf16Plain {
    static constexpr bool PERM = true;
    bf16_t* O; int ldc; float scale;
    __device__ __forceinline__ void pre(AccRef acc, const Unit&, int, int, int, int, const LAS unsigned char*) const {
#pragma unroll
        for (int ai = 0; ai < 2; ++ai)
#pragma unroll
            for (int bj = 0; bj < 2; ++bj)
#pragma unroll
                for (int m = 0; m < 4; ++m) { acc[ai][bj][m][0] = acc[ai][bj][m][0] * scale; acc[ai][bj][m][1] = acc[ai][bj][m][1] * scale; pack8_bf16(acc[ai][bj][m][0], acc[ai][bj][m][1]); }
    }
    __device__ __forceinline__ void post(AccRef acc, const Unit& u, int wr, int wc, int fr, int fq, const LAS unsigned char* mt) const {
        const int row0 = u.pm * BM + wr * 64 + fr, col0 = u.pn * BM + wc * 32 + 8 * fq;
#pragma unroll
        for (int ai = 0; ai < 2; ++ai)
#pragma unroll
            for (int m = 0; m < 4; ++m) { bf16_t* rowp = O + (size_t)(row0 + ai * HALF + m * 16) * ldc + col0;
#pragma unroll
                for (int bj = 0; bj < 2; ++bj) *(u32x4*)(rowp + bj * HALF) = AS_U4(acc[ai][bj][m][0]); }
    }
    __device__ __forceinline__ void run(const f32x4 (&acc)[2][2][4][2], const Unit& u, int wr, int wc, int fr, int fq, const LAS unsigned char* mt) const {
        const int row0 = u.pm * BM + wr * 64 + fr, col0 = u.pn * BM + wc * 32 + 8 * fq;
#pragma unroll
        for (int ai = 0; ai < 2; ++ai)
#pragma unroll
            for (int m = 0; m < 4; ++m) { bf16_t* rowp = O + (size_t)(row0 + ai * HALF + m * 16) * ldc + col0;
#pragma unroll
                for (int bj = 0; bj < 2; ++bj) { const f32x4 v0 = acc[ai][bj][m][0] * scale, v1 = acc[ai][bj][m][1] * scale;
                    u32x4 w; w.x = cvt_pk_bf16(v0[0], v0[1]); w.y = cvt_pk_bf16(v0[2], v0[3]); w.z = cvt_pk_bf16(v1[0], v1[1]); w.w = cvt_pk_bf16(v1[2], v1[3]);
                    *(u32x4*)(rowp + bj * HALF) = w; } }
    }
};

struct EpiF8Plain {
    static constexpr bool PERM = true;
    unsigned char* O; int ldc; float scale;
    __device__ __forceinline__ void pre(AccRef acc, const Unit&, int, int, int, int, const LAS unsigned char*) const {}
    __device__ __forceinline__ void post(AccRef acc, const Unit& u, int wr, int wc, int fr, int fq, const LAS unsigned char* mt) const {
        const int row0 = u.pm * BM + wr * 64 + fr, col0 = u.pn * BM + wc * 32 + 8 * fq;
#pragma unroll
        for (int ai = 0; ai < 2; ++ai)
#pragma unroll
            for (int m = 0; m < 4; ++m) { unsigned char* rowp = O + (size_t)(row0 + ai * HALF + m * 16) * ldc + col0;
#pragma unroll
                for (int bj = 0; bj < 2; ++bj) { const f32x4 v0 = acc[ai][bj][m][0] * scale, v1 = acc[ai][bj][m][1] * scale;
                    u32x2 w; w.x = pk4_fp8(v0[0], v0[1], v0[2], v0[3]); w.y = pk4_fp8(v1[0], v1[1], v1[2], v1[3]);
                    *(u32x2*)(rowp + bj * HALF) = w; } }
    }
    __device__ __forceinline__ void run(AccRef acc, const Unit& u, int wr, int wc, int fr, int fq, const LAS unsigned char* mt) const { post(acc, u, wr, wc, fr, fq, mt); }
};

struct EpiOutProj {
    static constexpr bool PERM = false;
    const bf16_t* xb; bf16_t* h1; unsigned char* h1f8;
    __device__ __forceinline__ void pre(AccRef acc, const Unit& u, int wr, int wc, int fr, int fq, const LAS unsigned char* mt) const {
        const unsigned off0 = (unsigned)((u.pm * BM + wr * 64 + fr) * DM + u.pn * BM + wc * 32 + 8 * fq) * 2u;
        const unsigned char* xbb = (const unsigned char*)xb;
#pragma unroll
        for (int ai = 0; ai < 2; ++ai)
#pragma unroll
            for (int m = 0; m < 4; ++m) {
#pragma unroll
                for (int bj = 0; bj < 2; ++bj) { const u32x4 w = NT_LD((const u32x4*)(xbb + (off0 + (unsigned)(((ai * HALF + m * 16) * DM + bj * HALF) * 2))));
                    f32x4& v0 = acc[ai][bj][m][0]; f32x4& v1 = acc[ai][bj][m][1]; constexpr float SC = 1.0f / 512.0f;
                    v0[0] = fmaf(v0[0], SC, bf_lo(w.x)); v0[1] = fmaf(v0[1], SC, bf_hi(w.x)); v0[2] = fmaf(v0[2], SC, bf_lo(w.y)); v0[3] = fmaf(v0[3], SC, bf_hi(w.y));
                    v1[0] = fmaf(v1[0], SC, bf_lo(w.z)); v1[1] = fmaf(v1[1], SC, bf_hi(w.z)); v1[2] = fmaf(v1[2], SC, bf_lo(w.w)); v1[3] = fmaf(v1[3], SC, bf_hi(w.w)); }
                if (m & 1) __builtin_amdgcn_sched_barrier(0); }
    }
    __device__ __forceinline__ void post(AccRef acc, const Unit& u, int wr, int wc, int fr, int fq, const LAS unsigned char* mt) const {
        const unsigned off0 = (unsigned)((u.pm * BM + wr * 64 + fr) * DM + u.pn * BM + wc * 32 + 8 * fq);
        unsigned char* h1bb = (unsigned char*)h1;
#pragma unroll
        for (int ai = 0; ai < 2; ++ai)
#pragma unroll
            for (int m = 0; m < 4; ++m)
#pragma unroll
                for (int bj = 0; bj < 2; ++bj) { const unsigned o = off0 + (unsigned)((ai * HALF + m * 16) * DM + bj * HALF); const f32x4 v0 = acc[ai][bj][m][0], v1 = acc[ai][bj][m][1];
                    u32x4 w; w.x = cvt_pk_bf16(v0[0], v0[1]); w.y = cvt_pk_bf16(v0[2], v0[3]); w.z = cvt_pk_bf16(v1[0], v1[1]); w.w = cvt_pk_bf16(v1[2], v1[3]);
                    u32x2 q; q.x = pk4_fp8(v0[0], v0[1], v0[2], v0[3]); q.y = pk4_fp8(v1[0], v1[1], v1[2], v1[3]);
                    *(u32x4*)(h1bb + 2u * o) = w; *(u32x2*)(h1f8 + o) = q;
                    if (bj) __builtin_amdgcn_sched_barrier(0); }
    }
    __device__ __forceinline__ void run(AccRef acc, const Unit& u, int wr, int wc, int fr, int fq, const LAS unsigned char* mt) const { pre(acc, u, wr, wc, fr, fq, mt); post(acc, u, wr, wc, fr, fq, mt); }
};

struct EpiUp {
    static constexpr bool PERM = true;
    unsigned char* act;
    __device__ __forceinline__ void pre(AccRef acc, const Unit& u, int wr, int wc, int fr, int fq, const LAS unsigned char* mt) const {
        const int r0 = wr * 64 + fr, cl = 32 * wc + 8 * fq;
        const LAS float* rowA = (const LAS float*)mt; const LAS float* bias = (const LAS float*)(mt + 2048);
        f32x4 bg[2], bl[2];
#pragma unroll
        for (int n = 0; n < 2; ++n) { bg[n] = *(const LAS f32x4*)(bias + cl + 4 * n); bl[n] = *(const LAS f32x4*)(bias + 128 + cl + 4 * n); }
#pragma unroll
        for (int ai = 0; ai < 2; ++ai)
#pragma unroll
            for (int m = 0; m < 4; ++m) { const int r = r0 + ai * HALF + m * 16;
                const float rs = (r < u.rows) ? rowA[r] * 0.03125f : 0.f;
#pragma unroll
                for (int n = 0; n < 2; ++n)
#pragma unroll
                    for (int e = 0; e < 4; ++e) { float g = acc[ai][0][m][n][e] * rs + bg[n][e], l = acc[ai][1][m][n][e] * rs + bl[n][e];
                        g = fminf(g, 7.0f); l = fminf(fmaxf(l, -7.0f), 7.0f); acc[ai][0][m][n][e] = g * sigmoidf_(1.702f * g) * (l + 1.0f); } }
    }
    __device__ __forceinline__ void post(AccRef acc, const Unit& u, int wr, int wc, int fr, int fq, const LAS unsigned char* mt) const {
        const int r0 = wr * 64 + fr, ch = 128 * u.pn + 32 * wc + 8 * fq;
#pragma unroll
        for (int ai = 0; ai < 2; ++ai)
#pragma unroll
            for (int m = 0; m < 4; ++m) { const int r = r0 + ai * HALF + m * 16;
                const f32x4 v0 = acc[ai][0][m][0], v1 = acc[ai][0][m][1];
                u32x2 w; w.x = pk4_fp8(v0[0], v0[1], v0[2], v0[3]); w.y = pk4_fp8(v1[0], v1[1], v1[2], v1[3]);
                *(u32x2*)(act + (size_t)(u.pm * BM + r) * 1024 + ch) = w; }
    }
    __device__ __forceinline__ void run(const f32x4 (&acc)[2][2][4][2], const Unit& u, int wr, int wc, int fr, int fq, const LAS unsigned char* mt) const {
        const int r0 = wr * 64 + fr, cl = 32 * wc + 8 * fq, ch = 128 * u.pn + cl;
        const LAS float* rowA = (const LAS float*)mt; const LAS float* bias = (const LAS float*)(mt + 2048);
        f32x4 bg[2], bl[2];
#pragma unroll
        for (int n = 0; n < 2; ++n) { bg[n] = *(const LAS f32x4*)(bias + cl + 4 * n); bl[n] = *(const LAS f32x4*)(bias + 128 + cl + 4 * n); }
#pragma unroll
        for (int ai = 0; ai < 2; ++ai)
#pragma unroll
            for (int m = 0; m < 4; ++m) { const int r = r0 + ai * HALF + m * 16;
                const float rs = (r < u.rows) ? rowA[r] * 0.03125f : 0.f;
                float o[8];
#pragma unroll
                for (int n = 0; n < 2; ++n)
#pragma unroll
                    for (int e = 0; e < 4; ++e) { float g = acc[ai][0][m][n][e] * rs + bg[n][e], l = acc[ai][1][m][n][e] * rs + bl[n][e];
                        g = fminf(g, 7.0f); l = fminf(fmaxf(l, -7.0f), 7.0f); o[4 * n + e] = g * sigmoidf_(1.702f * g) * (l + 1.0f); }
                u32x2 w; w.x = pk4_fp8(o[0], o[1], o[2], o[3]); w.y = pk4_fp8(o[4], o[5], o[6], o[7]);
                *(u32x2*)(act + (size_t)(u.pm * BM + r) * 1024 + ch) = w; }
    }
};

struct EpiDown {
    static constexpr bool PERM = true;
    unsigned char* y;
    __device__ __forceinline__ void pre(AccRef acc, const Unit& u, int wr, int wc, int fr, int fq, const LAS unsigned char* mt) const {
        const int r0 = wr * 64 + fr, cl = wc * 32 + 8 * fq;
        const LAS float* gateT = (const LAS float*)(mt + 1024); const LAS float* bias = (const LAS float*)(mt + 2048);
        float gt[2][4];
#pragma unroll
        for (int ai = 0; ai < 2; ++ai)
#pragma unroll
            for (int m = 0; m < 4; ++m) gt[ai][m] = gateT[r0 + ai * HALF + m * 16] * 16.0f;
#pragma unroll
        for (int bj = 0; bj < 2; ++bj) { const f32x4 bv0 = *(const LAS f32x4*)(bias + cl + bj * HALF), bv1 = *(const LAS f32x4*)(bias + cl + bj * HALF + 4);
#pragma unroll
            for (int ai = 0; ai < 2; ++ai)
#pragma unroll
                for (int m = 0; m < 4; ++m) { acc[ai][bj][m][0] = (acc[ai][bj][m][0] * 0.03125f + bv0) * gt[ai][m]; acc[ai][bj][m][1] = (acc[ai][bj][m][1] * 0.03125f + bv1) * gt[ai][m]; } }
    }
    __device__ __forceinline__ void post(AccRef acc, const Unit& u, int wr, int wc, int fr, int fq, const LAS unsigned char* mt) const {
        const int r0 = wr * 64 + fr, col0 = u.pn * BM + wc * 32 + 8 * fq;
        const LAS int* slotT = (const LAS int*)mt;
#pragma unroll
        for (int ai = 0; ai < 2; ++ai)
#pragma unroll
            for (int m = 0; m < 4; ++m) { const int r = r0 + ai * HALF + m * 16;
                if (r < u.rows) { unsigned char* rowp = y + (size_t)slotT[r] * 1024 + col0;
#pragma unroll
                    for (int bj = 0; bj < 2; ++bj) { const f32x4 v0 = acc[ai][bj][m][0], v1 = acc[ai][bj][m][1];
                        u32x2 w; w.x = pk4_fp8(v0[0], v0[1], v0[2], v0[3]); w.y = pk4_fp8(v1[0], v1[1], v1[2], v1[3]);
                        *(u32x2*)(rowp + bj * HALF) = w; } } }
    }
    __device__ __forceinline__ void run(AccRef acc, const Unit& u, int wr, int wc, int fr, int fq, const LAS unsigned char* mt) const { pre(acc, u, wr, wc, fr, fq, mt); post(acc, u, wr, wc, fr, fq, mt); }
};

template <bool F8>
__device__ __forceinline__ void p0_transpose_item(const float* W, int ldw, void* WTv, int Kdim, const float* gain, LAS float* scr, int kb, int n0, int src0, int nvalid, int lane, bool prow = false) {
    bf16_t* WT = (bf16_t*)WTv;
    const int k0 = 64 * kb;
    f32x4 ld4[8];
#pragma unroll
    for (int i = 0; i < 8; ++i) { const int kk = 8 * i + (lane >> 3), j = (lane & 7) * 4;
        ld4[i] = (f32x4){0.f, 0.f, 0.f, 0.f}; if (j < nvalid) ld4[i] = NT_LD((const f32x4*)(W + (size_t)(k0 + kk) * ldw + src0 + j)); }
#pragma unroll
    for (int i = 0; i < 8; ++i) { const int kk = 8 * i + (lane >> 3), j = (lane & 7) * 4; const float gk = (gain ? gain[k0 + kk] : 1.0f) * (F8 ? 32.0f : 1.0f);
        LAS float* d = scr + kk * 33 + j; d[0] = ld4[i].x * gk; d[1] = ld4[i].y * gk; d[2] = ld4[i].z * gk; d[3] = ld4[i].w * gk; }
    LDS_WAIT(); asm volatile("" ::: "memory");
    const int c = lane & 7;
#pragma unroll
    for (int j = 0; j < 4; ++j) { const int nl = (lane >> 3) + 8 * j; const LAS float* s = scr + (8 * c) * 33 + nl;
        const int n = prow ? 16 * ((nl >> 2) & 1) + 4 * (nl >> 3) + (nl & 3) : nl;
        if constexpr (F8) { u32x2 o; o.x = pk4_fp8(s[0 * 33], s[1 * 33], s[2 * 33], s[3 * 33]); o.y = pk4_fp8(s[4 * 33], s[5 * 33], s[6 * 33], s[7 * 33]);
            *(u32x2*)((unsigned char*)WTv + (size_t)(n0 + n) * Kdim + k0 + 8 * c) = o; }
        else { u32x4 o; o.x = pk2(s[0 * 33], s[1 * 33]); o.y = pk2(s[2 * 33], s[3 * 33]); o.z = pk2(s[4 * 33], s[5 * 33]); o.w = pk2(s[6 * 33], s[7 * 33]);
            *(u32x4*)(WT + (size_t)(n0 + n) * Kdim + k0 + 8 * c) = o; } }
    LDS_WAIT(); asm volatile("" ::: "memory");
}
__device__ __forceinline__ void win_colmap(int nb, int& src0, int& nvalid) {
    const int pn = nb >> 3, j = (nb & 7) * 32, bj = j >> 7, slot = (j & 127) >> 5;
    nvalid = 32;
    if (pn < 2) src0 = (4 * pn + slot) * 64 + 32 * bj;
    else if (pn == 2) src0 = 640 + slot * 64 + 32 * bj;
    else if (pn == 3) { if (slot == 0) src0 = 512 + 32 * bj; else if (slot == 1) src0 = 896 + 32 * bj; else if (slot == 2) src0 = 576 + 32 * bj; else { src0 = 960; nvalid = bj == 0 ? 4 : 0; } }
    else src0 = 964 + 512 * bj + 128 * (pn - 4) + 32 * slot;
}
__device__ __forceinline__ void p0_prologue(const Params& P, LAS unsigned char* lds, int vcu, int G, int wave, int lane) {
    unsigned char* ws = P.ws;
    LAS float* scr = (LAS float*)(lds + wave * 16384);
    const int gw = vcu * NWAVES + wave, NGW = G * NWAVES;
    constexpr int I_IN = 16 * 64, I_OUT = 16 * 32, I_G = 16 * 32, I_P = 4 * 32;
    constexpr int NITEMS = I_IN + I_OUT + I_G + I_P;
    for (int it = gw; it < NITEMS; it += NGW) {
        int r = it;
        if (r < I_IN) { const int kb = r / 64, nb = r % 64; int s0, nv; win_colmap(nb, s0, nv); p0_transpose_item<false>(P.w_in, INW, (bf16_t*)(ws + WS_WIN), 1024, P.g_mix, scr, kb, nb * 32, s0, nv, lane); continue; } r -= I_IN;
        if (r < I_OUT) { const int kb = r / 32, nb = r % 32; p0_transpose_item<true>(P.w_out, 1024, (unsigned char*)(ws + WS_WOUT), 1024, nullptr, scr, kb, nb * 32, nb * 32, 32, lane, true); continue; } r -= I_OUT;
        if (r < I_G) { const int kb = r / 32, nb = r % 32; p0_transpose_item<true>(P.w_ple_gate, 1024, (unsigned char*)(ws + WS_WG), 1024, P.g_ple, scr, kb, nb * 32, nb * 32, 32, lane); continue; } r -= I_G;
        { const int kb = r / 32, nb = r % 32; p0_transpose_item<false>(P.w_ple_proj, 1024, (bf16_t*)(ws + WS_WP), 256, nullptr, scr, kb, nb * 32, nb * 32, 32, lane); }
    }
    float* rs1 = (float*)(ws + WS_RS1); bf16_t* xb = (bf16_t*)(ws + WS_XB);
    for (int m = gw; m < NTOK; m += NGW) {
        const f32x4* xr = (const f32x4*)(P.x + (size_t)m * DM) + lane; f32x4 v[4]; float s = 0.f;
#pragma unroll
        for (int j = 0; j < 4; ++j) { v[j] = NT_LD(xr + 64 * j); s += (v[j].x * v[j].x + v[j].y * v[j].y) + (v[j].z * v[j].z + v[j].w * v[j].w); }
        s = wave_sum(s);
        u32x2* o8 = (u32x2*)(xb + (size_t)m * DM) + lane;
#pragma unroll
        for (int j = 0; j < 4; ++j) { u32x2 w; w.x = pk2(v[j].x, v[j].y); w.y = pk2(v[j].z, v[j].w); o8[64 * j] = w; }
        if (lane == 0) rs1[m] = 1.0f / sqrtf(s * (1.0f / DM) + EPS);
    }
    bf16_t* pb = (bf16_t*)(ws + WS_PB);
    for (int m = gw; m < NTOK; m += NGW) { const f32x4 v = NT_LD((const f32x4*)(P.p + (size_t)m * 256) + lane); u32x2 w; w.x = pk2(v.x, v.y); w.y = pk2(v.z, v.w); *((u32x2*)(pb + (size_t)m * 256) + lane) = w; }
    f32x2* rope = (f32x2*)(ws + WS_ROPE);
    for (int idx = gw * 64 + lane; idx < SEQ * 32; idx += NGW * 64) { const int t = idx >> 5, i = idx & 31;
        const float inv = exp2f(-(float)i * (13.287712379549449f / 32.0f));
        const float ang = (float)t * inv;
        const double rev = (double)ang * 0.15915494309189535; const float fr = (float)(rev - __builtin_floor(rev));
        rope[idx] = (f32x2){__builtin_amdgcn_cosf(fr), __builtin_amdgcn_sinf(fr)}; }
    bf16_t* wrg = (bf16_t*)(ws + WS_WRG);
    for (int idx = gw * 64 + lane; idx < 1024 * 32; idx += NGW * 64) { const int k = idx >> 5, e = idx & 31; const float w = P.w_router[idx] * P.g_ffn[k];
        const unsigned short hi = f2bf(w); const float whi = __uint_as_float((unsigned)hi << 16); const size_t o = ((size_t)(k >> 3) * 32 + e) * 8 + (k & 7);
        wrg[o] = hi; wrg[32768 + o] = f2bf(w - whi); }
}

__device__ __forceinline__ unsigned fkey(float f) { unsigned u = __builtin_bit_cast(unsigned, f); if (u == 0x80000000u) u = 0u; return u ^ ((unsigned)((int)u >> 31) | 0x80000000u); }
__device__ __forceinline__ int mbcnt64(unsigned long long m) { return __builtin_amdgcn_mbcnt_hi((unsigned)(m >> 32), __builtin_amdgcn_mbcnt_lo((unsigned)m, 0u)); }

template <int NR>
__device__ __forceinline__ unsigned bisect_thr(const unsigned (&v)[NR], unsigned prefix, int startbit) {
    bool exact = false;
#pragma unroll 1
    for (int bit = startbit; bit >= 0; --bit) {
        const unsigned cand = prefix | (1u << bit); int cnt = 0;
#pragma unroll
        for (int r = 0; r < NR; ++r) { cnt += __builtin_popcountll(__ballot(v[r] >= cand)); if ((r & 7) == 7) __builtin_amdgcn_sched_barrier(0); }
        if (cnt >= NSEL) prefix = cand;
        if (cnt == NSEL) { exact = true; break; }
    }
    return exact ? prefix - 1u : prefix;
}
template <int NR, bool EXPL>
__device__ __forceinline__ void compact_sel(const unsigned (&v)[NR], const unsigned (&ci)[NR], unsigned T, LAS unsigned* list, int lane) {
    int cgt = 0;
#pragma unroll
    for (int r = 0; r < NR; ++r) { cgt += __builtin_popcountll(__ballot(v[r] > T)); if ((r & 7) == 7) __builtin_amdgcn_sched_barrier(0); }
    const int need = NSEL - cgt; int base = 0, ties = 0;
#pragma unroll
    for (int r = 0; r < NR; ++r) { const bool gt = v[r] > T, eq = v[r] == T; const unsigned long long em = __ballot(eq);
        const bool sel = gt || (eq && (ties + mbcnt64(em)) < need); const unsigned long long sm = __ballot(sel);
        list[sel ? base + mbcnt64(sm) : NSEL + lane] = EXPL ? ci[r] : (unsigned)(r * 64 + lane);
        base += __builtin_popcountll(sm); ties += __builtin_popcountll(em);
        if ((r & 3) == 3) __builtin_amdgcn_sched_barrier(0); }
}
constexpr int SEL_CAP = 1024;
template <int NR>
__device__ __forceinline__ void select_topk(LAS float* row, LAS unsigned* H, LAS unsigned* list, int lane, bool zero_h) {
    unsigned v[NR];
#pragma unroll
    for (int r = 0; r < NR; ++r) v[r] = fkey(row[r * 64 + lane]);
    LAS u32x4* H4 = (LAS u32x4*)H;
    const u32x4 h0 = H4[2 * lane], h1 = H4[2 * lane + 1];
    if (zero_h) { H4[2 * lane] = (u32x4){0u, 0u, 0u, 0u}; H4[2 * lane + 1] = (u32x4){0u, 0u, 0u, 0u}; }
    const unsigned hw[8] = {h0.x, h0.y, h0.z, h0.w, h1.x, h1.y, h1.z, h1.w};
    unsigned c[16];
#pragma unroll
    for (int i = 0; i < 8; ++i) { c[2 * i] = hw[i] & 0xffffu; c[2 * i + 1] = hw[i] >> 16; }
    unsigned s = 0u;
#pragma unroll
    for (int i = 0; i < 16; ++i) s += c[i];
    unsigned S = s;
#pragma unroll
    for (int off = 1; off < 64; off <<= 1) { const unsigned o = __shfl_down(S, off); if (lane + off < 64) S += o; }
    const unsigned long long okm = __ballot(S >= (unsigned)NSEL);
    bool fast = okm != 0ull; unsigned floorkey = 0u; int C = 0;
    if (fast) {
        const int Ls = 63 - __builtin_clzll(okm);
        unsigned acc = S - s; int bl = -1; unsigned accb = 0u;
#pragma unroll
        for (int b = 15; b >= 0; --b) { acc += c[b]; if (bl < 0 && acc >= (unsigned)NSEL) { bl = b; accb = acc; } }
        const int bstar = __shfl(bl, Ls) + 16 * Ls; C = (int)__shfl(accb, Ls);
        floorkey = (unsigned)bstar << 22;
        fast = (bstar > 1) && (C <= SEL_CAP);
    }
    if (!fast) {
        const unsigned T = bisect_thr<NR>(v, 0u, 31);
        compact_sel<NR, false>(v, v, T, list, lane);
        return;
    }
    LAS unsigned* ckl = (LAS unsigned*)row; LAS unsigned* cil = ckl + 1152;
    { int base = 0;
#pragma unroll
      for (int r = 0; r < NR; ++r) { const bool cnd = v[r] >= floorkey; const unsigned long long m = __ballot(cnd);
          const int pos = cnd ? base + mbcnt64(m) : SEL_CAP + lane;
          ckl[pos] = v[r]; cil[pos] = (unsigned)(r * 64 + lane); base += __builtin_popcountll(m);
          if ((r & 3) == 3) __builtin_amdgcn_sched_barrier(0); } }
    if (C <= 512) {
        unsigned ck[8], ci[8];
#pragma unroll
        for (int j = 0; j < 8; ++j) { const int i = j * 64 + lane; ck[j] = i < C ? ckl[i] : 0u; ci[j] = cil[i]; }
        const unsigned T = (C == NSEL) ? floorkey - 1u : bisect_thr<8>(ck, floorkey, 21);
        compact_sel<8, true>(ck, ci, T, list, lane);
    } else {
        unsigned ck[16], ci[16];
#pragma unroll
        for (int j = 0; j < 16; ++j) { const int i = j * 64 + lane; ck[j] = i < C ? ckl[i] : 0u; ci[j] = cil[i]; }
        const unsigned T = bisect_thr<16>(ck, floorkey, 21);
        compact_sel<16, true>(ck, ci, T, list, lane);
    }
}

typedef short v4i16 __attribute__((ext_vector_type(4)));
constexpr int VROW = 144;

__device__ __forceinline__ void attn_tile(const Params& P, LAS unsigned char* lds, int b, int t0, int wave, int lane) {
    unsigned char* ws = P.ws;
    const bf16_t* QI = (const bf16_t*)(ws + WS_QI); const bf16_t* KI = (const bf16_t*)(ws + WS_KI);
    const bf16_t* Q = (const bf16_t*)(ws + WS_Q); const bf16_t* Kp = (const bf16_t*)(ws + WS_K); const bf16_t* Vp = (const bf16_t*)(ws + WS_V);
    const float* WI = (const float*)(ws + WS_WI); unsigned char* MIX = ws + WS_MIX;
    LAS float* SC = (LAS float*)lds;
    LAS unsigned* list = (LAS unsigned*)(lds + wave * 16384 + 14336);
    LAS unsigned* HIST = (LAS unsigned*)(lds + LDS_MISC);
    const int tokbase = b * SEQ;
    const bool need_sel = t0 >= 256;
    if (need_sel) {
        const int nkt = (t0 + 8 + 31) >> 5;
        bf16x8 a[4]; f32x4 w[4];
        { const bf16_t* src = QI + (size_t)(tokbase + t0 + ((lane & 31) >> 2)) * 256 + (lane & 3) * 64 + 8 * (lane >> 5);
#pragma unroll
          for (int ks = 0; ks < 4; ++ks) a[ks] = *(const bf16x8*)(src + 16 * ks); }
#pragma unroll
        for (int g = 0; g < 4; ++g) w[g] = *(const f32x4*)(WI + (size_t)(tokbase + t0 + 2 * g + (lane >> 5)) * 4);
        for (int kt0 = wave; kt0 < nkt; kt0 += 4 * NWAVES) {
            bf16x8 bf[4][4];
#pragma unroll
            for (int u = 0; u < 4; ++u) { const int kt = kt0 + u * NWAVES;
                if (kt < nkt) { const bf16_t* ksrc = KI + ((size_t)((tokbase >> 5) + kt) * 256 + lane) * 8;
#pragma unroll
                    for (int ks = 0; ks < 4; ++ks) bf[u][ks] = *(const bf16x8*)(ksrc + 512 * ks); } }
#pragma unroll
            for (int u = 0; u < 4; ++u) { const int kt = kt0 + u * NWAVES;
                if (kt < nkt) {
                    const int key = kt * 32 + (lane & 31);
                    f32x16 acc;
#pragma unroll
                    for (int i = 0; i < 16; ++i) acc[i] = 0.f;
#pragma unroll
                    for (int ks = 0; ks < 4; ++ks) acc = __builtin_amdgcn_mfma_f32_32x32x16_bf16(a[ks], bf[u][ks], acc, 0, 0, 0);
#pragma unroll
                    for (int g = 0; g < 4; ++g) { float sc = 0.f;
#pragma unroll
                        for (int h = 0; h < 4; ++h) sc = fmaf(fmaxf(acc[4 * g + h], 0.f), w[g][h], sc);
                        const int ql = 2 * g + (lane >> 5);
                        if (key > t0 + ql) sc = -INFINITY;
                        SC[ql * 4096 + key] = sc;
                        if (key <= t0 + ql) { const unsigned ub = __builtin_bit_cast(unsigned, sc);
                            const unsigned bin = (ub >> 22) ^ (((unsigned)((int)ub >> 31) & 0x1ffu) | 0x200u);
                            __hip_atomic_fetch_add(HIST + ql * 512 + (bin >> 1), 1u << ((bin & 1u) << 4), __ATOMIC_RELAXED, __HIP_MEMORY_SCOPE_WORKGROUP); } }
                } }
        }
        { const int npad = ((t0 + 8 + 1023) >> 10) << 10;
          for (int i = nkt * 32 + (int)threadIdx.x; i < npad; i += NTHR) {
#pragma unroll
              for (int q = 0; q < 8; ++q) SC[q * 4096 + i] = -INFINITY; } }
    }
    __syncthreads();
    const int t = t0 + wave, tok = tokbase + t;
    if (need_sel) {
        LAS float* row = SC + wave * 4096; LAS unsigned* H = HIST + wave * 512; const int n = t + 1;
        if (n <= 1024) select_topk<16>(row, H, list, lane, true);
        else if (n <= 2048) select_topk<32>(row, H, list, lane, true);
        else if (n <= 3072) select_topk<48>(row, H, list, lane, true);
        else select_topk<64>(row, H, list, lane, true);
    } else {
#pragma unroll
        for (int i = 0; i < 4; ++i) list[i * 64 + lane] = (unsigned)(i * 64 + lane);
    }
    const int nvalid = need_sel ? NSEL : (t + 1);
    const int hd = lane & 15, g = lane >> 4;
    bf16x8 qf0, qf1;
#pragma unroll
    for (int i = 0; i < 8; ++i) { qf0[i] = 0; qf1[i] = 0; }
    if (hd < 8) { const bf16_t* qs = Q + (size_t)tok * 512 + hd * 64 + 8 * g; qf0 = *(const bf16x8*)qs; qf1 = *(const bf16x8*)(qs + 32); }
    LAS unsigned char* vreg = lds + wave * 16384;
    u32x4 rA[4], rB[4];
#define ATT_ROWS(R, SRC, G_) do { const int nb_ = (G_) * 32; \
        _Pragma("unroll") for (int i_ = 0; i_ < 4; ++i_) { const unsigned idx_ = list[nb_ + (lane >> 3) + 8 * i_]; R[i_] = *(const u32x4*)((SRC) + (size_t)(tokbase + idx_) * 64 + 8 * (lane & 7)); } } while (0)
#define ATT_STAGE(R, BUF) do { _Pragma("unroll") for (int i_ = 0; i_ < 4; ++i_) *(LAS u32x4*)((BUF) + ((lane >> 3) + 8 * i_) * VROW + (lane & 7) * 16) = R[i_]; } while (0)
    float lg[8][8];
#define ATT_QK(R, G_, BUF) do { LAS unsigned char* kb_ = (BUF); ATT_STAGE(R, kb_); \
        if constexpr ((G_) + 2 < 8) { ATT_ROWS(R, Kp, (G_) + 2); } \
        const LAS unsigned char* kr_ = kb_ + hd * VROW + 16 * g; \
        const bf16x8 ka0_ = *(const LAS bf16x8*)kr_, ka1_ = *(const LAS bf16x8*)(kr_ + 64), kb0_ = *(const LAS bf16x8*)(kr_ + 16 * VROW), kb1_ = *(const LAS bf16x8*)(kr_ + 16 * VROW + 64); \
        f32x4 sa_ = {0.f, 0.f, 0.f, 0.f}, sb_ = {0.f, 0.f, 0.f, 0.f}; \
        sa_ = __builtin_amdgcn_mfma_f32_16x16x32_bf16(ka0_, qf0, sa_, 0, 0, 0); sa_ = __builtin_amdgcn_mfma_f32_16x16x32_bf16(ka1_, qf1, sa_, 0, 0, 0); \
        sb_ = __builtin_amdgcn_mfma_f32_16x16x32_bf16(kb0_, qf0, sb_, 0, 0, 0); sb_ = __builtin_amdgcn_mfma_f32_16x16x32_bf16(kb1_, qf1, sb_, 0, 0, 0); \
        _Pragma("unroll") for (int r_ = 0; r_ < 4; ++r_) { const int sl_ = (G_) * 32 + 4 * g + r_; \
            lg[G_][r_] = sl_ < nvalid ? sa_[r_] * 0.125f : -INFINITY; lg[G_][4 + r_] = (sl_ + 16) < nvalid ? sb_[r_] * 0.125f : -INFINITY; } } while (0)
    ATT_ROWS(rA, Kp, 0); ATT_ROWS(rB, Kp, 1);
    ATT_QK(rA, 0, vreg); ATT_QK(rB, 1, vreg + 4608); ATT_QK(rA, 2, vreg); ATT_QK(rB, 3, vreg + 4608);
    ATT_QK(rA, 4, vreg); ATT_QK(rB, 5, vreg + 4608); ATT_QK(rA, 6, vreg); ATT_QK(rB, 7, vreg + 4608);
    ATT_ROWS(rA, Vp, 0); ATT_ROWS(rB, Vp, 1);
    float mx = -INFINITY;
#pragma unroll
    for (int q = 0; q < 8; ++q)
#pragma unroll
        for (int r = 0; r < 8; ++r) mx = fmaxf(mx, lg[q][r]);
    mx = fmaxf(mx, __shfl_xor(mx, 16)); mx = fmaxf(mx, __shfl_xor(mx, 32));
    float ssum = 0.f;
#pragma unroll
    for (int q = 0; q < 8; ++q)
#pragma unroll
        for (int r = 0; r < 8; ++r) { lg[q][r] = __expf(lg[q][r] - mx); ssum += lg[q][r]; }
    f32x4 o[4];
#pragma unroll
    for (int dt = 0; dt < 4; ++dt) o[dt] = (f32x4){0.f, 0.f, 0.f, 0.f};
#define ATT_PV(R, G_, BUF) do { LAS unsigned char* vb_ = (BUF); ATT_STAGE(R, vb_); \
        if constexpr ((G_) + 2 < 8) { ATT_ROWS(R, Vp, (G_) + 2); } \
        bf16x8 pf_; \
        { const u32x4 pw_ = {cvt_pk_bf16(lg[G_][0], lg[G_][1]), cvt_pk_bf16(lg[G_][2], lg[G_][3]), cvt_pk_bf16(lg[G_][4], lg[G_][5]), cvt_pk_bf16(lg[G_][6], lg[G_][7])}; pf_ = __builtin_bit_cast(bf16x8, pw_); } \
        LAS unsigned char* ta_ = vb_ + (4 * g + (hd >> 2)) * VROW + (hd & 3) * 8; \
        _Pragma("unroll") for (int dt_ = 0; dt_ < 4; ++dt_) { \
            const v4i16 lo_ = __builtin_amdgcn_ds_read_tr16_b64_v4i16((LAS v4i16*)(ta_ + dt_ * 32)); \
            const v4i16 hi_ = __builtin_amdgcn_ds_read_tr16_b64_v4i16((LAS v4i16*)(ta_ + 16 * VROW + dt_ * 32)); \
            bf16x8 vf_; vf_[0] = lo_[0]; vf_[1] = lo_[1]; vf_[2] = lo_[2]; vf_[3] = lo_[3]; vf_[4] = hi_[0]; vf_[5] = hi_[1]; vf_[6] = hi_[2]; vf_[7] = hi_[3]; \
            o[dt_] = __builtin_amdgcn_mfma_f32_16x16x32_bf16(vf_, pf_, o[dt_], 0, 0, 0); } } while (0)
    ATT_PV(rA, 0, vreg); ATT_PV(rB, 1, vreg + 4608); ATT_PV(rA, 2, vreg); ATT_PV(rB, 3, vreg + 4608);
    ATT_PV(rA, 4, vreg); ATT_PV(rB, 5, vreg + 4608); ATT_PV(rA, 6, vreg); ATT_PV(rB, 7, vreg + 4608);
#undef ATT_ROWS
#undef ATT_STAGE
#undef ATT_QK
#undef ATT_PV
    ssum += __shfl_xor(ssum, 16); ssum += __shfl_xor(ssum, 32);
    const float inv = 1.0f / ssum;
    if (hd < 8) {
        unsigned char* op = MIX + (size_t)tok * 1024 + hd * 64 + 4 * g; const float inv16 = inv * 16.0f;
#pragma unroll
        for (int dt = 0; dt < 4; ++dt) *(unsigned*)(op + 16 * dt) = pk4_fp8(o[dt][0] * inv16, o[dt][1] * inv16, o[dt][2] * inv16, o[dt][3] * inv16);
    }
    __syncthreads();
}

__device__ __forceinline__ void conv_tile(const Params& P, LAS unsigned char* lds, int tile, int tid, int wave, int lane) {
    unsigned char* ws = P.ws;
    const bf16_t* HG = (const bf16_t*)(ws + WS_HGLU); unsigned char* MIX = ws + WS_MIX;
    LAS f32x2* part = (LAS f32x2*)(lds + LDS_MISC + 1024);
    LAS f32x2* stat = part + 256;
    LAS bf16_t* Lin = (LAS bf16_t*)lds;
    LAS unsigned char* Lout = lds + 65536;
    const int tok0 = tile * 32, t0 = tok0 & (SEQ - 1), c = tid;
    for (int ch = tid; ch < 62 * 64; ch += NTHR) { const int r = ch >> 6, cc = ch & 63; const int tt = t0 - 30 + r;
        u32x4 v = {0u, 0u, 0u, 0u}; if (tt >= 0) v = *(const u32x4*)(HG + (size_t)(tok0 - 30 + r) * 512 + cc * 8);
        *(LAS u32x4*)(Lin + r * 512 + cc * 8) = v; }
    __syncthreads();
    float in[62];
#pragma unroll
    for (int r = 0; r < 62; ++r) in[r] = __builtin_bit_cast(float, (unsigned)Lin[r * 512 + c] << 16);
    float out[32];
    const float bias = P.dw_b[c];
#pragma unroll
    for (int i = 0; i < 32; ++i) out[i] = bias;
#pragma unroll
    for (int j = 0; j < 31; ++j) { const float wj = P.dw_w[j * 512 + c];
#pragma unroll
        for (int i = 0; i < 32; ++i) out[i] = fmaf(in[i + j], wj, out[i]); }
#pragma unroll
    for (int i = 0; i < 32; ++i) { const float s1 = wave_sum(out[i]), s2 = wave_sum(out[i] * out[i]); if (lane == 0) part[i * 8 + wave] = (f32x2){s1, s2}; }
    __syncthreads();
    if (tid < 32) { float s1 = 0.f, s2 = 0.f;
#pragma unroll
        for (int w = 0; w < 8; ++w) { const f32x2 pp = part[tid * 8 + w]; s1 += pp.x; s2 += pp.y; }
        const float mean = s1 * (1.0f / 512.0f), var = fmaxf(s2 * (1.0f / 512.0f) - mean * mean, 0.f);
        stat[tid] = (f32x2){mean, 1.0f / sqrtf(var + EPS)}; }
    __syncthreads();
    const float lgc = P.ln_g[c], lbc = P.ln_b[c];
#pragma unroll
    for (int i = 0; i < 32; ++i) { const f32x2 st = stat[i]; const float y = (out[i] - st.x) * st.y * lgc + lbc; const float sl = y * sigmoidf_(y);
        Lout[i * 512 + c] = (unsigned char)__builtin_amdgcn_cvt_pk_fp8_f32(sl * 16.0f, 0.f, 0, false); }
    __syncthreads();
    for (int ch = tid; ch < 32 * 32; ch += NTHR) { const int r = ch >> 5, cc = ch & 31;
        *(u32x4*)(MIX + (size_t)(tok0 + r) * 1024 + 512 + cc * 16) = *(const LAS u32x4*)(Lout + r * 512 + cc * 16); }
    __syncthreads();
}

constexpr int MW_UP = 32 * 16 * 64, MW_DN = 32 * 16 * 32, MW_ITEMS = MW_UP + MW_DN;
__device__ __forceinline__ void mw_decode(const Params& P, int it, const float*& src, int& ldw, unsigned char*& dst, const float*& gain) {
    unsigned char* ws = P.ws;
    if (it < MW_UP) { const int e = it >> 10, rr = it & 1023, kb = rr >> 6, nb = rr & 63, pn = nb >> 3, j = (nb & 7) * 32, bj = j >> 7, jj = j & 127;
        src = P.w_up + (size_t)e * 1024 * 2048 + (size_t)(kb * 64) * 2048 + 1024 * bj + 128 * pn + jj; ldw = 2048;
        dst = ws + WS_WUP + (size_t)e * 2048 * 1024 + (size_t)(nb * 32) * 1024 + kb * 64; gain = P.g_ffn + kb * 64; }
    else { const int r = it - MW_UP, e = r >> 9, rr = r & 511, kb = rr >> 5, nb = rr & 31;
        src = P.w_down + (size_t)e * 1024 * 1024 + (size_t)(kb * 64) * 1024 + nb * 32; ldw = 1024;
        dst = ws + WS_WDOWN + (size_t)e * 1024 * 1024 + (size_t)(nb * 32) * 1024 + kb * 64; gain = nullptr; }
}
#define MW_LOAD(LD, it_) do { if ((it_) < MW_ITEMS) { const float* src_; int ldw_; unsigned char* dst_; const float* gain_; mw_decode(P, (it_), src_, ldw_, dst_, gain_); \
        _Pragma("unroll") for (int i_ = 0; i_ < 8; ++i_) LD[i_] = NT_LD((const f32x4*)(src_ + (size_t)(8 * i_ + (lane >> 3)) * ldw_ + (lane & 7) * 4)); } } while (0)
#define MW_FINISH(LD, it_) do { if ((it_) < MW_ITEMS) { const float* src_; int ldw_; unsigned char* dst_; const float* gain_; mw_decode(P, (it_), src_, ldw_, dst_, gain_); \
        _Pragma("unroll") for (int i_ = 0; i_ < 8; ++i_) { const int kk_ = 8 * i_ + (lane >> 3), j_ = (lane & 7) * 4; const float gk_ = (gain_ ? gain_[kk_] : 1.0f) * 32.0f; \
            LAS float* d_ = scr + kk_ * 33 + j_; d_[0] = LD[i_].x * gk_; d_[1] = LD[i_].y * gk_; d_[2] = LD[i_].z * gk_; d_[3] = LD[i_].w * gk_; } \
        LDS_WAIT(); asm volatile("" ::: "memory"); \
        const int c_ = lane & 7; \
        _Pragma("unroll") for (int j_ = 0; j_ < 4; ++j_) { const int n_ = (lane >> 3) + 8 * j_; const LAS float* sp_ = scr + (8 * c_) * 33 + n_; \
            u32x2 o_; o_.x = pk4_fp8(sp_[0 * 33], sp_[1 * 33], sp_[2 * 33], sp_[3 * 33]); o_.y = pk4_fp8(sp_[4 * 33], sp_[5 * 33], sp_[6 * 33], sp_[7 * 33]); \
            *(u32x2*)(dst_ + (size_t)n_ * 1024 + 8 * c_) = o_; } \
        LDS_WAIT(); asm volatile("" ::: "memory"); } } while (0)
__device__ __forceinline__ void moe_weight_convert(const Params& P, LAS float* scr, int cw, int ncw, int lane) {
    f32x4 l0[8], l1[8], l2[8], l3[8];
    MW_LOAD(l0, cw); MW_LOAD(l1, cw + ncw); MW_LOAD(l2, cw + 2 * ncw);
    for (int base = cw; base < MW_ITEMS; base += 4 * ncw) {
        MW_LOAD(l3, base + 3 * ncw); MW_FINISH(l0, base);
        MW_LOAD(l0, base + 4 * ncw); MW_FINISH(l1, base + ncw);
        MW_LOAD(l1, base + 5 * ncw); MW_FINISH(l2, base + 2 * ncw);
        MW_LOAD(l2, base + 6 * ncw); MW_FINISH(l3, base + 3 * ncw);
    }
}
#undef MW_LOAD
#undef MW_FINISH

__device__ __forceinline__ void router_phase(const Params& P, LAS unsigned char* lds, int blk, int G, int tid, int wave, int lane) {
    unsigned char* ws = P.ws;
    const bf16_t* h1 = (const bf16_t*)(ws + WS_H1); const u32x4* wrg = (const u32x4*)(ws + WS_WRG);
    int* list = (int*)(ws + WS_LIST); float* lscale = (float*)(ws + WS_LSCALE); float* lgate = (float*)(ws + WS_LGATE);
    unsigned* cntg = (unsigned*)(ws + WS_CTL) + CW_CNT;
    LAS u32x4* WH = (LAS u32x4*)lds;
    LAS float* part = (LAS float*)lds;
    LAS int* lcnt = (LAS int*)(lds + LDS_MISC + 1024);
    LAS int* gbase = lcnt + 32;
    LAS int* rec_e = gbase + 32;
    LAS int* rec_p = rec_e + 512;
    LAS float* rec_g = (LAS float*)(rec_p + 512);
    LAS float* rec_s = rec_g + 512;
    const int tl = lane & 31, half = lane >> 5;
    for (int chunk = blk; chunk < NTOK / 128; chunk += G) {
        for (int i = tid; i < 8192; i += NTHR) WH[i] = wrg[i];
        if (tid < 32) lcnt[tid] = 0;
        __syncthreads();
        const int tloc = (wave & 3) * 32 + tl, tok = chunk * 128 + tloc, kb0 = (wave >> 2) * 512;
        f32x16 acc;
#pragma unroll
        for (int i = 0; i < 16; ++i) acc[i] = 0.f;
        float ss = 0.f;
        {
            const bf16_t* hrow = h1 + (size_t)tok * DM + kb0 + 8 * half;
            const LAS u32x4* wa = WH + (size_t)((kb0 >> 3) + half) * 32 + tl;
#pragma unroll 2
            for (int k0 = 0; k0 < 512; k0 += 64) {
                u32x4 hv[4];
#pragma unroll
                for (int i = 0; i < 4; ++i) hv[i] = NT_LD((const u32x4*)(hrow + k0 + 16 * i));
#pragma unroll
                for (int i = 0; i < 4; ++i) {
                    const u32x4 ah = wa[(size_t)((k0 >> 3) + 2 * i) * 32], al = wa[(size_t)((k0 >> 3) + 2 * i) * 32 + 4096];
                    const float x0 = bf_lo(hv[i].x), x1 = bf_hi(hv[i].x), x2 = bf_lo(hv[i].y), x3 = bf_hi(hv[i].y), x4 = bf_lo(hv[i].z), x5 = bf_hi(hv[i].z), x6 = bf_lo(hv[i].w), x7 = bf_hi(hv[i].w);
                    ss = fmaf(x0, x0, fmaf(x1, x1, fmaf(x2, x2, fmaf(x3, x3, fmaf(x4, x4, fmaf(x5, x5, fmaf(x6, x6, fmaf(x7, x7, ss))))))));
                    acc = __builtin_amdgcn_mfma_f32_32x32x16_bf16(__builtin_bit_cast(bf16x8, ah), __builtin_bit_cast(bf16x8, hv[i]), acc, 0, 0, 0);
                    acc = __builtin_amdgcn_mfma_f32_32x32x16_bf16(__builtin_bit_cast(bf16x8, al), __builtin_bit_cast(bf16x8, hv[i]), acc, 0, 0, 0);
                }
            }
        }
        __syncthreads();
        if (wave >= 4) { const int pl = (wave - 4) * 64 + lane;
#pragma unroll
            for (int r = 0; r < 16; ++r) part[r * 256 + pl] = acc[r];
            part[16 * 256 + pl] = ss; }
        __syncthreads();
        if (wave < 4) {
            { const int pl = wave * 64 + lane;
#pragma unroll
              for (int r = 0; r < 16; ++r) acc[r] += part[r * 256 + pl];
              ss += part[16 * 256 + pl]; }
            ss += __shfl_xor(ss, 32);
            const float rs = 1.0f / sqrtf(ss * (1.0f / DM) + EPS);
            float v[16];
#pragma unroll
            for (int r = 0; r < 16; ++r) v[r] = acc[r] * rs + P.b_router[(r & 3) + 8 * (r >> 2) + 4 * half];
            float tv[4]; int te[4];
#pragma unroll
            for (int q = 0; q < 4; ++q) { float bv = -INFINITY; int be = 64;
#pragma unroll
                for (int r = 0; r < 16; ++r) { const int e = (r & 3) + 8 * (r >> 2) + 4 * half; if (v[r] > bv || (v[r] == bv && e < be)) { bv = v[r]; be = e; } }
#pragma unroll
                for (int r = 0; r < 16; ++r) { const int e = (r & 3) + 8 * (r >> 2) + 4 * half; if (e == be) v[r] = -INFINITY; }
                tv[q] = bv; te[q] = be; }
            float cv[8]; int ce[8];
#pragma unroll
            for (int q = 0; q < 4; ++q) { cv[q] = tv[q]; ce[q] = te[q]; cv[4 + q] = __shfl_xor(tv[q], 32); ce[4 + q] = __shfl_xor(te[q], 32); }
#pragma unroll
            for (int q = 0; q < 4; ++q) { float bv = -INFINITY; int be = 64;
#pragma unroll
                for (int r = 0; r < 8; ++r) if (cv[r] > bv || (cv[r] == bv && ce[r] < be)) { bv = cv[r]; be = ce[r]; }
#pragma unroll
                for (int r = 0; r < 8; ++r) if (ce[r] == be) cv[r] = -INFINITY;
                tv[q] = bv; te[q] = be; }
            const float e1 = __expf(tv[1] - tv[0]), e2 = __expf(tv[2] - tv[0]), e3 = __expf(tv[3] - tv[0]);
            const float is = 1.0f / (1.0f + e1 + e2 + e3);
            if (half == 0) {
                const float gq[4] = {is, e1 * is, e2 * is, e3 * is};
#pragma unroll
                for (int q = 0; q < 4; ++q) { const int lp = atomicAdd((int*)&lcnt[te[q]], 1); const int si = tloc * 4 + q; rec_e[si] = te[q]; rec_p[si] = lp; rec_g[si] = gq[q]; }
                rec_s[tloc] = rs;
            }
        }
        __syncthreads();
        if (tid < 32) gbase[tid] = (int)atomicAdd(cntg + 64 * tid, (unsigned)lcnt[tid]);
        __syncthreads();
        { const int si = tid, ee = rec_e[si], pos = gbase[ee] + rec_p[si], li = ee * NTOK + pos;
          list[li] = (chunk * 128) * 4 + si; lscale[li] = rec_s[si >> 2]; lgate[li] = rec_g[si]; }
        __syncthreads();
    }
}

__device__ __forceinline__ void combine_phase(const Params& P, int mbeg, int mend, int mstep, int lane) {
    unsigned char* ws = P.ws;
    const bf16_t* h1 = (const bf16_t*)(ws + WS_H1); bf16_t* h1b = (bf16_t*)(ws + WS_H1B); const unsigned char* y = ws + WS_Y; float* rs3 = (float*)(ws + WS_RS3);
    for (int m = mbeg; m < mend; m += mstep) {
        const u32x2* hr = (const u32x2*)(h1 + (size_t)m * DM) + lane; f32x4 v[4]; float s = 0.f;
#pragma unroll
        for (int j = 0; j < 4; ++j) { const u32x2 hw = NT_LD(hr + 64 * j); v[j].x = bf_lo(hw.x); v[j].y = bf_hi(hw.x); v[j].z = bf_lo(hw.y); v[j].w = bf_hi(hw.y); }
#pragma unroll
        for (int k = 0; k < 4; ++k) { const unsigned* yr = (const unsigned*)(y + (size_t)(m * 4 + k) * DM) + lane;
#pragma unroll
            for (int j = 0; j < 4; ++j) { const unsigned w = NT_LD(yr + 64 * j); const f32x2 lo = __builtin_amdgcn_cvt_pk_f32_fp8((int)w, false), hi = __builtin_amdgcn_cvt_pk_f32_fp8((int)w, true);
                v[j].x += lo.x * 0.0625f; v[j].y += lo.y * 0.0625f; v[j].z += hi.x * 0.0625f; v[j].w += hi.y * 0.0625f; } }
        u32x2* o8 = (u32x2*)(h1b + (size_t)m * DM) + lane; unsigned* o4 = (unsigned*)(ws + WS_H1F8 + (size_t)m * DM) + lane;
#pragma unroll
        for (int j = 0; j < 4; ++j) { u32x2 w; w.x = pk2(v[j].x, v[j].y); w.y = pk2(v[j].z, v[j].w); NT_ST(w, o8 + 64 * j); NT_ST(pk4_fp8(v[j].x, v[j].y, v[j].z, v[j].w), o4 + 64 * j);
            s += (v[j].x * v[j].x + v[j].y * v[j].y) + (v[j].z * v[j].z + v[j].w * v[j].w); }
        s = wave_sum(s);
        if (lane == 0) rs3[m] = 1.0f / sqrtf(s * (1.0f / DM) + EPS);
    }
}

__device__ __forceinline__ void final_phase(const Params& P, int mbeg, int mend, int mstep, int lane) {
    unsigned char* ws = P.ws;
    const bf16_t* h2b = (const bf16_t*)(ws + WS_H1B); const unsigned char* pj = ws + WS_PJ; const unsigned char* G = ws + WS_G; const float* rs3 = (const float*)(ws + WS_RS3);
    f32x4 gv[4];
#pragma unroll
    for (int j = 0; j < 4; ++j) gv[j] = *((const f32x4*)P.g_final + lane + 64 * j);
    for (int m = mbeg; m < mend; m += mstep) {
        const u32x2* hr = (const u32x2*)(h2b + (size_t)m * DM) + lane; const unsigned* pr = (const unsigned*)(pj + (size_t)m * DM) + lane; const unsigned* gr = (const unsigned*)(G + (size_t)m * DM) + lane;
        const float r3 = rs3[m]; f32x4 v[4]; float s = 0.f;
#pragma unroll
        for (int j = 0; j < 4; ++j) { const u32x2 hw = NT_LD(hr + 64 * j); const unsigned pw = NT_LD(pr + 64 * j), gw2 = NT_LD(gr + 64 * j);
            const f32x2 glo = __builtin_amdgcn_cvt_pk_f32_fp8((int)gw2, false), ghi = __builtin_amdgcn_cvt_pk_f32_fp8((int)gw2, true);
            const f32x2 plo = __builtin_amdgcn_cvt_pk_f32_fp8((int)pw, false), phi = __builtin_amdgcn_cvt_pk_f32_fp8((int)pw, true);
            v[j].x = fmaf(plo.x * 0.0625f, sigmoidf_(glo.x * r3), bf_lo(hw.x)); v[j].y = fmaf(plo.y * 0.0625f, sigmoidf_(glo.y * r3), bf_hi(hw.x));
            v[j].z = fmaf(phi.x * 0.0625f, sigmoidf_(ghi.x * r3), bf_lo(hw.y)); v[j].w = fmaf(phi.y * 0.0625f, sigmoidf_(ghi.y * r3), bf_hi(hw.y));
            s += (v[j].x * v[j].x + v[j].y * v[j].y) + (v[j].z * v[j].z + v[j].w * v[j].w); }
        s = wave_sum(s); const float rs = 1.0f / sqrtf(s * (1.0f / DM) + EPS);
        f32x4* orow = (f32x4*)(P.out + (size_t)m * DM) + lane;
#pragma unroll
        for (int j = 0; j < 4; ++j) NT_ST(v[j] * rs * gv[j], orow + 64 * j);
    }
}

#define XB_TMO      128
#define XB_XCNT(j)  (256  + 64 * (j))
#define XB_XSUB(j)  (1280 + 64 * (j))
#define XB_XGEN(j)  (2304 + 64 * (j))
#define XB_TOP      3328
#define XB_TOPGEN   3392
#define XCD_BAR_WORDS 3456
#define XB_SPIN_CAP (1u << 18)
__device__ __forceinline__ unsigned xb_ld(unsigned* p)              { return __hip_atomic_load(p, __ATOMIC_RELAXED, __HIP_MEMORY_SCOPE_AGENT); }
__device__ __forceinline__ unsigned xb_add(unsigned* p, unsigned v) { return __hip_atomic_fetch_add(p, v, __ATOMIC_RELAXED, __HIP_MEMORY_SCOPE_AGENT); }
__device__ __forceinline__ unsigned xb_xcc_id() { return (unsigned)__builtin_amdgcn_s_getreg((3 << 11) | 20) & 0xFu; }
#define XB_SPIN(cond, bar) do { unsigned _sp = 0; while (cond) { __builtin_amdgcn_s_sleep(1); \
    if ((++_sp & 255u) == 0u) { if (xb_ld(&(bar)[XB_TMO])) break; if (_sp > XB_SPIN_CAP) { atomicAdd(&(bar)[XB_TMO], 1u); break; } } } } while (0)
struct XcdBarrier { unsigned* bar; unsigned x; volatile LAS unsigned* st; };
__device__ __forceinline__ XcdBarrier xcd_barrier_post(unsigned* bar, volatile LAS unsigned* st) {
    XcdBarrier b; b.bar = bar; b.x = xb_xcc_id(); b.st = st;
    if (threadIdx.x == 0) (void)xb_add(&bar[XB_XCNT(b.x)], 1u);
    return b;
}
__device__ __forceinline__ void xcd_barrier_complete(unsigned* bar, unsigned x, unsigned& nloc, unsigned& nx) {
    const unsigned G = gridDim.x * gridDim.y * gridDim.z;
    unsigned sum, cnt, mine, sp = 0u;
    for (;;) {
        sum = 0u; cnt = 0u; mine = 0u;
#pragma unroll
        for (unsigned j = 0; j < 16; ++j) { const unsigned c = xb_ld(&bar[XB_XCNT(j)]); sum += c; cnt += (c > 0u) ? 1u : 0u; mine = (j == x) ? c : mine; }
        if (sum == G) break;
        __builtin_amdgcn_s_sleep(1);
        if ((++sp & 255u) == 0u) { if (xb_ld(&bar[XB_TMO])) break; if (sp > XB_SPIN_CAP) { atomicAdd(&bar[XB_TMO], 1u); break; } }
    }
    nloc = mine > 0u ? mine : 1u; nx = cnt > 0u ? cnt : 1u;
}
__device__ __forceinline__ void xcd_barrier(const XcdBarrier& b) {
    asm volatile("s_waitcnt vmcnt(0)" ::: "memory");
    __syncthreads();
    if (threadIdx.x == 0) {
        unsigned* bar = b.bar;
        __builtin_amdgcn_s_waitcnt(0);
        unsigned nloc = b.st[0], nx = b.st[1];
        if (nloc == 0u) { xcd_barrier_complete(bar, b.x, nloc, nx); b.st[0] = nloc; b.st[1] = nx; }
        const unsigned old = xb_add(&bar[XB_XSUB(b.x)], 1u);
        const unsigned gen = old / nloc;
        if (old + 1u == (gen + 1u) * nloc) {
            __builtin_amdgcn_fence(__ATOMIC_RELEASE, "agent");
            asm volatile("s_waitcnt vmcnt(0)" ::: "memory");
            const unsigned og = xb_add(&bar[XB_TOP], 1u);
            const unsigned tg = og / nx;
            if (og + 1u == (tg + 1u) * nx) xb_add(&bar[XB_TOPGEN], 1u);
            else XB_SPIN(xb_ld(&bar[XB_TOPGEN]) == tg, bar);
            __builtin_amdgcn_fence(__ATOMIC_ACQUIRE, "agent");
            xb_add(&bar[XB_XGEN(b.x)], 1u);
            asm volatile("s_waitcnt vmcnt(0)" ::: "memory");
        } else {
            XB_SPIN(xb_ld(&bar[XB_XGEN(b.x)]) == gen, bar);
            __builtin_amdgcn_fence(__ATOMIC_ACQUIRE, "agent");
            asm volatile("s_waitcnt vmcnt(0)" ::: "memory");
        }
    }
    __syncthreads();
}

__device__ __forceinline__ void pair_sync(unsigned* flag, unsigned* tmo, bool same_xcd) {
    asm volatile("s_waitcnt vmcnt(0)" ::: "memory");
    __syncthreads();
    if (threadIdx.x == 0) {
        if (!same_xcd) { __builtin_amdgcn_fence(__ATOMIC_RELEASE, "agent"); asm volatile("s_waitcnt vmcnt(0)" ::: "memory"); }
        xb_add(flag, 1u);
        unsigned sp = 0u;
        while (xb_ld(flag) < 2u) { __builtin_amdgcn_s_sleep(1); if ((++sp & 255u) == 0u) { if (xb_ld(tmo)) break; if (sp > XB_SPIN_CAP) { atomicAdd(tmo, 1u); break; } } }
        __builtin_amdgcn_fence(__ATOMIC_ACQUIRE, "agent");
        asm volatile("s_waitcnt vmcnt(0)" ::: "memory");
    }
    __syncthreads();
}

constexpr int NPHASE = 10;
__global__ void __launch_bounds__(NTHR, 2) fwd_kernel(Params P) {
    extern __shared__ __attribute__((aligned(16))) unsigned char lds_raw[];
    LAS unsigned char* lds = (LAS unsigned char*)lds_raw;
    cg::grid_group grid = cg::this_grid();
    const int tid = threadIdx.x, wave = __builtin_amdgcn_readfirstlane(tid >> 6);
    const int G = gridDim.x, bx = blockIdx.x;
#define FRESH_LANE(name) int name = (int)__builtin_amdgcn_mbcnt_hi(~0u, __builtin_amdgcn_mbcnt_lo(~0u, 0u)); asm volatile("" : "+v"(name))
    const int vcu = (G % 8 == 0) ? (bx % 8) * (G / 8) + bx / 8 : bx;
    const int NGW = G * NWAVES;
    unsigned char* ws = P.ws;
    const int lo = P.ph_lo, hi = P.ph_hi;
#define IN(k) (lo <= (k) && (k) < hi)
    volatile LAS unsigned* xst = (volatile LAS unsigned*)(lds + LDS_XB);
    if (tid < 2) xst[tid] = 0u;
    __syncthreads();
    const XcdBarrier xbar = xcd_barrier_post((unsigned*)(ws + WS_CTL) + CW_BAR, xst);
    if (tid == 0) __hip_atomic_store((unsigned*)(ws + WS_CTL) + CW_XCC + bx, xbar.x + 1u, __ATOMIC_RELAXED, __HIP_MEMORY_SCOPE_AGENT);
    if (P.ph_lo > P.ph_hi) grid.sync();
#define SYNC(k) do { if (IN(k) && IN((k) + 1)) xcd_barrier(xbar); } while (0)

    if (IN(0)) { FRESH_LANE(lane); p0_prologue(P, lds, vcu, G, wave, lane); }
    SYNC(0);
    if (IN(1)) {
        { pg8::DenseSched S; S.init((const bf16_t*)(ws + WS_XB), (const bf16_t*)(ws + WS_WIN), NTOK, 2048, 1024, G, bx);
          EpiInProj E{(const float*)(ws + WS_RS1), (const f32x2*)(ws + WS_ROPE), P.glu_b, (bf16_t*)(ws + WS_Q), (bf16_t*)(ws + WS_K), (bf16_t*)(ws + WS_V), (bf16_t*)(ws + WS_QI), (bf16_t*)(ws + WS_KI), (bf16_t*)(ws + WS_HGLU), (float*)(ws + WS_WI)};
          pg8::gemm_phase<EpiInProj, pg8::DenseSched, false>(lds, S, E); }
        { pg8::DenseSched S; S.init((const bf16_t*)(ws + WS_PB), (const bf16_t*)(ws + WS_WP), NTOK, 1024, 256, G, bx);
          EpiF8Plain E{ws + WS_PJ, 1024, 16.0f};
          pg8::gemm_phase<EpiF8Plain, pg8::DenseSched, false>(lds, S, E); }
    }
    SYNC(1);
    if (IN(2)) {
        FRESH_LANE(lane);
        for (int i = tid; i < 4096; i += NTHR) ((LAS unsigned*)(lds + LDS_MISC))[i] = 0u;
        __syncthreads();
        unsigned* ctl = (unsigned*)(ws + WS_CTL);
        volatile LAS int* qw = (volatile LAS int*)(lds + LDS_XB + 32);
        if (G % 8 == 0 && G >= 128) { const int ncv = 8; if ((bx >> 3) < ncv) moe_weight_convert(P, (LAS float*)(lds + wave * 16384), (bx * NWAVES) + wave, ncv * 8 * NWAVES, lane); }
        else { moe_weight_convert(P, (LAS float*)(lds + wave * 16384), bx * NWAVES + wave, G * NWAVES, lane); }
        __syncthreads();
        for (int db = 0; db < NB; ++db) { const int b = (bx + db) & 7;
            for (;;) {
                if (tid == 0) qw[0] = (int)atomicAdd(ctl + CW_AQ + 64 * b, 1u);
                __syncthreads();
                const int k = qw[0];
                if (k >= 512) break;
                attn_tile(P, lds, b, (511 - k) * 8, wave, lane);
            }
            __syncthreads(); }
        for (;;) {
            if (tid == 0) qw[0] = (int)atomicAdd(ctl + CW_CQ, 1u);
            __syncthreads();
            const int tl = qw[0];
            if (tl >= NTOK / 32) break;
            conv_tile(P, lds, tl, tid, wave, lane);
        }
    }
    SYNC(2);
    if (IN(3)) {
        pg8::DenseSched S; S.init(ws + WS_MIX, ws + WS_WOUT, NTOK, 1024, 1024, G, bx); S.rp = 1024;
        EpiOutProj E{(const bf16_t*)(ws + WS_XB), (bf16_t*)(ws + WS_H1), (unsigned char*)(ws + WS_H1F8)};
        S.idg = true;
        pg8::gemm_phase<EpiOutProj, pg8::DenseSched, true, true, false>(lds, S, E);
    }
    SYNC(3);
    if (IN(4)) { FRESH_LANE(lane); router_phase(P, lds, vcu, G, tid, wave, lane); }
    SYNC(4);
    if (IN(5) || IN(6)) {
        LAS int* tb = (LAS int*)(lds + LDS_MISC); LAS int* cn = tb + 64;
        if (tid < NE) cn[tid] = (int)__hip_atomic_load((const unsigned*)(ws + WS_CTL) + CW_CNT + 64 * tid, __ATOMIC_RELAXED, __HIP_MEMORY_SCOPE_AGENT);
        __syncthreads();
        if (tid == 0) { int acc = 0;
            for (int e = 0; e < NE; ++e) { tb[e] = acc; acc += (cn[e] + BM - 1) / BM; }
            tb[NE] = acc; }
        __syncthreads();
        if (IN(5)) {
            pg8::MoeSched S; S.A = ws + WS_H1F8; S.Bt = ws + WS_WUP; S.rp = 1024; S.b_estride = (size_t)2048 * 1024; S.tb = tb; S.cnt = cn; S.list = (const int*)(ws + WS_LIST);
            S.nN = 8; S.nwg = tb[NE] * 8; S.G = G; S.c = bx; S.gather = true;
            { LAS int* ut = (LAS int*)(lds + LDS_MISC + 512); S.utab = ut; S.build_table(ut, tid); __syncthreads(); }
            S.m_scale = (const float*)(ws + WS_LSCALE); S.m_gate = nullptr; S.m_bias = P.b_up;
            EpiUp E{(unsigned char*)(ws + WS_ACT)};
            pg8::gemm_phase<EpiUp, pg8::MoeSched, true, true, true>(lds, S, E);
        }
        SYNC(5);
        if (IN(6)) {
            pg8::MoeSched S; S.A = ws + WS_ACT; S.Bt = ws + WS_WDOWN; S.rp = 1024; S.b_estride = (size_t)1024 * 1024; S.tb = tb; S.cnt = cn; S.list = (const int*)(ws + WS_LIST);
            S.nN = 4; S.nwg = tb[NE] * 4; S.G = G; S.c = bx; S.gather = false;
            { LAS int* ut = (LAS int*)(lds + LDS_MISC + 512); S.utab = ut; S.build_table(ut, tid); __syncthreads(); }
            S.m_scale = nullptr; S.m_gate = (const float*)(ws + WS_LGATE); S.m_bias = P.b_down;
            EpiDown E{(unsigned char*)(ws + WS_Y)};
            pg8::gemm_phase<EpiDown, pg8::MoeSched, true, true, true>(lds, S, E);
        }
    }
    SYNC(6);
    {
        const bool fused = (G == 256) && IN(7) && IN(8) && IN(9);
        const int j8 = bx >> 3, pm = (bx & 7) * 16 + (j8 >> 1), half = j8 & 1, r0 = pm * BM + half * 128;
        unsigned* ctl = (unsigned*)(ws + WS_CTL); unsigned* tmo = ctl + CW_BAR + XB_TMO;
        const bool same_xcd = fused && (xb_ld(ctl + CW_XCC + (bx ^ 8)) == xbar.x + 1u);
        if (IN(7)) { FRESH_LANE(l7);
            if (fused) combine_phase(P, r0 + wave, r0 + 128, NWAVES, l7); else combine_phase(P, vcu * NWAVES + wave, NTOK, NGW, l7); }
        if (fused) pair_sync(ctl + CW_PAIR + 16 * (2 * pm), tmo, same_xcd); else SYNC(7);
        if (IN(8)) {
            pg8::DenseSched S; S.init(ws + WS_H1F8, ws + WS_WG, NTOK, 1024, 1024, G, bx); S.rp = 1024; S.idg = true;
            if (fused) { S.pair_pm = pm; S.pair_pn0 = 2 * half; }
            EpiF8Plain E{(unsigned char*)(ws + WS_G), 1024, 0.03125f};
            pg8::gemm_phase<EpiF8Plain, pg8::DenseSched, true, true>(lds, S, E);
        }
        if (fused) pair_sync(ctl + CW_PAIR + 16 * (2 * pm + 1), tmo, same_xcd); else SYNC(8);
        if (IN(9)) { FRESH_LANE(l9);
            if (fused) final_phase(P, r0 + wave, r0 + 128, NWAVES, l9); else final_phase(P, vcu * NWAVES + wave, NTOK, NGW, l9); }
    }
#undef IN
#undef SYNC
}

#ifndef N_LAUNCH_MODE
#define N_LAUNCH_MODE 1
#endif
extern "C" void kernel_launch(void* const* d_in, const int* in_sizes, int n_in, void* d_out, int out_size, void* d_ws, size_t ws_size, hipStream_t stream) {
    static int grid = 0;
    if (grid == 0) {
        if (n_in != 21 || out_size != NTOK * DM || ws_size < WS_END) { fprintf(stderr, "kernel_launch: unexpected shapes (n_in %d out %d ws %zu)\n", n_in, out_size, ws_size); grid = -1; return; }
        int dev = 0, cus = 0, per_cu = 0;
        (void)hipGetDevice(&dev); (void)hipDeviceGetAttribute(&cus, hipDeviceAttributeMultiprocessorCount, dev);
        (void)hipFuncSetAttribute((const void*)fwd_kernel, hipFuncAttributeMaxDynamicSharedMemorySize, LDS_BYTES);
        if (hipOccupancyMaxActiveBlocksPerMultiprocessor(&per_cu, (const void*)fwd_kernel, NTHR, LDS_BYTES) != hipSuccess || per_cu < 1) { fprintf(stderr, "kernel_launch: occupancy query failed (%d)\n", per_cu); (void)hipGetLastError(); grid = -1; return; }
        grid = cus;
    }
    if (grid < 0) return;
    (void)hipMemsetAsync((char*)d_ws + WS_CTL, 0, CTL_BYTES, stream);
    Params p{};
    p.x = (const float*)d_in[0]; p.p = (const float*)d_in[1]; p.w_in = (const float*)d_in[2]; p.w_out = (const float*)d_in[3]; p.g_mix = (const float*)d_in[4]; p.g_ffn = (const float*)d_in[5];
    p.glu_b = (const float*)d_in[6]; p.dw_w = (const float*)d_in[7]; p.dw_b = (const float*)d_in[8]; p.ln_g = (const float*)d_in[9]; p.ln_b = (const float*)d_in[10];
    p.w_router = (const float*)d_in[11]; p.b_router = (const float*)d_in[12]; p.w_up = (const float*)d_in[13]; p.b_up = (const float*)d_in[14]; p.w_down = (const float*)d_in[15]; p.b_down = (const float*)d_in[16];
    p.w_ple_proj = (const float*)d_in[17]; p.w_ple_gate = (const float*)d_in[18]; p.g_ple = (const float*)d_in[19]; p.g_final = (const float*)d_in[20];
    p.out = (float*)d_out; p.ws = (unsigned char*)d_ws;
#if N_LAUNCH_MODE == 1
    p.ph_lo = 0; p.ph_hi = NPHASE;
    void* args[] = {&p};
    hipError_t e = hipLaunchCooperativeKernel((const void*)fwd_kernel, dim3(grid), dim3(NTHR), args, LDS_BYTES, stream);
    if (e != hipSuccess) fprintf(stderr, "cooperative launch failed: %s (grid %d)\n", hipGetErrorString(e), grid);
#else
    for (int ph = 0; ph < NPHASE; ++ph) {
        p.ph_lo = ph; p.ph_hi = ph + 1;
        void* args[] = {&p};
        hipError_t e = hipLaunchCooperativeKernel((const void*)fwd_kernel, dim3(grid), dim3(NTHR), args, LDS_BYTES, stream);
        if (e != hipSuccess) { fprintf(stderr, "launch %d failed: %s (grid %d)\n", ph, hipGetErrorString(e), grid); break; }
    }
#endif
}
```

```cpp
#include <hip/hip_runtime.h>
#include <hip/hip_cooperative_groups.h>
#include <cstdio>
#include <cstdint>
namespace cg = cooperative_groups;

#define LAS __attribute__((address_space(3)))
#define GAS __attribute__((address_space(1)))
typedef unsigned short bf16_t;
typedef short bf16x8 __attribute__((ext_vector_type(8)));
typedef short s16x4 __attribute__((ext_vector_type(4)));
typedef float f32x4 __attribute__((ext_vector_type(4)));
typedef float f32x2 __attribute__((ext_vector_type(2)));
typedef float f32x16 __attribute__((ext_vector_type(16)));
typedef unsigned u32x4 __attribute__((ext_vector_type(4)));
typedef unsigned u32x2 __attribute__((ext_vector_type(2)));

constexpr int NB = 8, SEQ = 4096, DM = 1024, NTOK = NB * SEQ;
constexpr int NE = 32, TOPK = 4, NSLOT = NTOK * TOPK;
constexpr int INW = 1988;
constexpr int NSEL = 256;
constexpr float EPS = 1e-6f;
constexpr int NWAVES = 8, NTHR = 512;

constexpr size_t MiB = 1u << 20;
constexpr size_t WS_CTL = 0, CTL_BYTES = 64 * 1024;
constexpr size_t WS_ROPE = 1 * MiB;
constexpr size_t WS_WIN = 2 * MiB;
constexpr size_t WS_WOUT = 6 * MiB;
constexpr size_t WS_WG = 8 * MiB;
constexpr size_t WS_WP = 10 * MiB;
constexpr size_t WS_WRG = 10 * MiB + 512 * 1024;
constexpr size_t WS_RS1 = 11 * MiB;
constexpr size_t WS_RS3 = 11 * MiB + 512 * 1024;
constexpr size_t WS_WI = 12 * MiB;
constexpr size_t WS_LIST = 13 * MiB;
constexpr size_t WS_LSCALE = 17 * MiB;
constexpr size_t WS_LGATE = 21 * MiB;
constexpr size_t WS_PB = 25 * MiB;
constexpr size_t WS_WUP = 42 * MiB;
constexpr size_t WS_WDOWN = 170 * MiB;
constexpr size_t WS_H1 = 234 * MiB;
constexpr size_t WS_H1B = 362 * MiB;
constexpr size_t WS_PJ = 426 * MiB;
constexpr size_t WS_XB = 490 * MiB;
constexpr size_t WS_Q = 554 * MiB;
constexpr size_t WS_K = 586 * MiB;
constexpr size_t WS_V = 590 * MiB;
constexpr size_t WS_QI = 594 * MiB;
constexpr size_t WS_KI = 610 * MiB;
constexpr size_t WS_HGLU = 614 * MiB;
constexpr size_t WS_MIX = 646 * MiB;
constexpr size_t WS_H1F8 = 298 * MiB;
constexpr size_t WS_ACT = 522 * MiB;
constexpr size_t WS_Y = 762 * MiB;
constexpr size_t WS_G = 762 * MiB;
constexpr size_t WS_END = 1018 * MiB;
static_assert(WS_H1F8 + (size_t)NTOK * 1024 <= WS_ACT && WS_ACT + (size_t)139264 * 1024 <= WS_Y, "ws map");
constexpr int CW_CNT = 1024;
constexpr int CW_AQ = 4096;
constexpr int CW_CQ = 4096 + 64 * 8;
constexpr int CW_BAR = 8192;
constexpr int CW_XCC = 7168;
constexpr int CW_PAIR = 12288;

constexpr int LDS_STAGE = 131072;
constexpr int LDS_MISC = LDS_STAGE;
constexpr int LDS_META = LDS_MISC + 4096;
constexpr int LDS_XB = 147456;
constexpr int LDS_BYTES = 147456 + 256;

__device__ __forceinline__ unsigned f2bf(float f) { unsigned u = __builtin_bit_cast(unsigned, f); return (u + 0x7fffu + ((u >> 16) & 1u)) >> 16; }
__device__ __forceinline__ unsigned pk2(float lo, float hi) { return f2bf(lo) | (f2bf(hi) << 16); }
__device__ __forceinline__ float bf_lo(unsigned w) { return __builtin_bit_cast(float, w << 16); }
__device__ __forceinline__ float bf_hi(unsigned w) { return __builtin_bit_cast(float, w & 0xffff0000u); }
__device__ __forceinline__ float wave_sum(float v) {
    v += __builtin_bit_cast(float, __builtin_amdgcn_update_dpp(0, __builtin_bit_cast(int, v), 0xB1, 0xF, 0xF, true));
    v += __builtin_bit_cast(float, __builtin_amdgcn_update_dpp(0, __builtin_bit_cast(int, v), 0x4E, 0xF, 0xF, true));
    v += __builtin_bit_cast(float, __builtin_amdgcn_update_dpp(0, __builtin_bit_cast(int, v), 0x141, 0xF, 0xF, true));
    v += __builtin_bit_cast(float, __builtin_amdgcn_update_dpp(0, __builtin_bit_cast(int, v), 0x140, 0xF, 0xF, true));
    const int vi = __builtin_bit_cast(int, v);
    const float r0 = __builtin_bit_cast(float, __builtin_amdgcn_readlane(vi, 0)), r1 = __builtin_bit_cast(float, __builtin_amdgcn_readlane(vi, 16));
    const float r2 = __builtin_bit_cast(float, __builtin_amdgcn_readlane(vi, 32)), r3 = __builtin_bit_cast(float, __builtin_amdgcn_readlane(vi, 48));
    return (r0 + r1) + (r2 + r3);
}
__device__ __forceinline__ unsigned pk4_fp8(float a, float b, float c, float d) { int r = __builtin_amdgcn_cvt_pk_fp8_f32(a, b, 0, false); r = __builtin_amdgcn_cvt_pk_fp8_f32(c, d, r, true); return (unsigned)r; }
__device__ __forceinline__ float sigmoidf_(float x) { return __builtin_amdgcn_rcpf(1.0f + __builtin_amdgcn_exp2f(x * -1.4426950408889634f)); }
#define LDS_WAIT() asm volatile("s_waitcnt lgkmcnt(0)" ::: "memory")
#define NT_LD(p) __builtin_nontemporal_load(p)
#define NT_ST(v, p) __builtin_nontemporal_store(v, p)

struct Params {
    const float* x; const float* p; const float* w_in; const float* w_out; const float* g_mix; const float* g_ffn;
    const float* glu_b; const float* dw_w; const float* dw_b; const float* ln_g; const float* ln_b;
    const float* w_router; const float* b_router; const float* w_up; const float* b_up; const float* w_down; const float* b_down;
    const float* w_ple_proj; const float* w_ple_gate; const float* g_ple; const float* g_final;
    float* out; unsigned char* ws;
    int ph_lo, ph_hi;
};

namespace pg8 {
constexpr int BM = 256, BK = 64, HALF = 128, HTB = HALF * BK * 2, STAGE_BYTES = 8 * HTB, NXCD = 8, WGM = 8;
__host__ __device__ __forceinline__ int lds_byte(int r, int c) { const int st = (r >> 4) * 2 + (c >> 5), rr = r & 15, cc = c & 31, ob = rr * 64 + cc * 2; return st * 1024 + (ob ^ (((ob >> 9) & 1) << 5)); }
__host__ __device__ __forceinline__ void stage_rc(int b, int& R, int& C) { const int st = b / 1024, sb = b % 1024, swz = sb ^ (((sb >> 9) & 1) << 5); R = (st >> 1) * 16 + swz / 64; C = (st & 1) * 32 + (swz % 64) / 2; }
__host__ __device__ __forceinline__ int perm32(int rho) { const int n = rho >> 4, i = rho & 15; return 8 * (i >> 2) + 4 * n + (i & 3); }

struct Unit { int pm, pn, e, rows; };

__device__ __forceinline__ unsigned cvt_pk_bf16(float lo, float hi) { unsigned r; asm volatile("v_cvt_pk_bf16_f32 %0, %1, %2" : "=v"(r) : "v"(lo), "v"(hi)); return r; }

struct DenseSched {
    const void* A; const void* Bt; int rp;
    int nM, nN, nwg, G, c;
    __device__ void init(const void* A_, const void* Bt_, int M, int N, int K_, int G_, int c_) { A = A_; Bt = Bt_; rp = K_ * 2; nM = M / BM; nN = N / BM; nwg = nM * nN; G = G_; c = c_; }
    int pair_pm = -1, pair_pn0 = 0;
    __device__ bool next(int i, Unit& u) const {
        if (pair_pm >= 0) { if (i >= 2) return false; u.pm = pair_pm; u.pn = pair_pn0 + i; u.e = 0; u.rows = BM; return true; }
        const long L = (long)i * G + c; if (L >= nwg) return false;
        int wgid = (int)L; { const int q = nwg / NXCD, r = nwg % NXCD, xcd = wgid % NXCD, off = wgid / NXCD; wgid = (xcd < r ? xcd * (q + 1) : r * (q + 1) + (xcd - r) * q) + off; }
        const int nig = WGM * nN, gid = wgid / nig, fm = gid * WGM, gsz = (nM - fm) < WGM ? (nM - fm) : WGM;
        u.pm = fm + ((wgid % nig) % gsz); u.pn = (wgid % nig) / gsz; u.e = 0; u.rows = BM; return true;
    }
    bool idg = false;
    __device__ __forceinline__ const char* a_ptr(const Unit& u) const { return idg ? (const char*)A : (const char*)A + (size_t)u.pm * BM * rp; }
    __device__ __forceinline__ const char* b_ptr(const Unit& u) const { return (const char*)Bt + (size_t)u.pn * BM * rp; }
    __device__ __forceinline__ int a_row(const Unit& u, int r) const { return u.pm * BM + r; }
    __device__ __forceinline__ void meta(const Unit&, LAS unsigned char*, int, int) const {}
};

struct MoeSched {
    const void* A; const void* Bt; int rp; size_t b_estride;
    const LAS int* tb;
    const LAS int* cnt;
    const int* list;
    int nN, nwg, G, c; bool gather;
    const LAS int* utab;
    __device__ __forceinline__ bool next(int i, Unit& u) const {
        if (i >= 32) return false;
        const LAS int* p = utab + 4 * i; const int rows = p[3]; if (rows < 0) return false;
        u.pm = p[0]; u.pn = p[1]; u.e = p[2]; u.rows = rows; return true;
    }
    __device__ __forceinline__ void build_table(LAS int* tab, int tid) const {
        if (tid < 32) { Unit u; const bool ok = decode(tid, u); tab[4 * tid] = u.pm; tab[4 * tid + 1] = u.pn; tab[4 * tid + 2] = u.e; tab[4 * tid + 3] = ok ? u.rows : -1; }
    }
    __device__ __forceinline__ bool decode(int i, Unit& u) const {
        u.pm = 0; u.pn = 0; u.e = 0; u.rows = 0;
        const long L = (long)i * G + c; if (L >= nwg) return false;
        int wgid = (int)L; { const int q = nwg / NXCD, r = nwg % NXCD, xcd = wgid % NXCD, off = wgid / NXCD; wgid = (xcd < r ? xcd * (q + 1) : r * (q + 1) + (xcd - r) * q) + off; }
        int e = 0;
#pragma unroll 1
        for (; e < NE - 1; ++e) { if (wgid < tb[e + 1] * nN) break; }
        const int local = wgid - tb[e] * nN, nM = tb[e + 1] - tb[e];
        const int nig = WGM * nN, gid = local / nig, fm = gid * WGM, gsz = (nM - fm) < WGM ? (nM - fm) : WGM;
        const int rt = fm + ((local % nig) % gsz);
        u.pm = tb[e] + rt; u.pn = (local % nig) / gsz; u.e = e;
        const int left = cnt[e] - rt * BM; u.rows = left < BM ? left : BM; return true;
    }
    __device__ __forceinline__ const char* a_ptr(const Unit& u) const { return (const char*)A; }
    __device__ __forceinline__ const char* b_ptr(const Unit& u) const { return (const char*)Bt + (size_t)u.e * b_estride + (size_t)u.pn * BM * rp; }
    __device__ __forceinline__ int a_row(const Unit& u, int r) const {
        if (!gather) return u.pm * BM + r;
        const int rt = u.pm - tb[u.e];
        return r < u.rows ? (list[u.e * NTOK + rt * BM + r] >> 2) : 0;
    }
    const float* m_scale; const float* m_gate; const float* m_bias;
    __device__ __forceinline__ void meta(const Unit& u, LAS unsigned char* tbl, int wid, int lane) const {
        const int rt = u.pm - tb[u.e]; const size_t li = (size_t)u.e * NTOK + rt * BM + (wid & 3) * 64 + lane;
        if (gather) {
            if (wid < 4) __builtin_amdgcn_global_load_lds((const unsigned*)(m_scale + li), (LAS unsigned*)(tbl + (wid & 3) * 256), 4, 0, 0);
            else { const int j = (wid & 3) * 64 + lane; const float* src = m_bias + (size_t)u.e * 2048 + (j < 128 ? 128 * u.pn + j : 1024 + 128 * u.pn + (j - 128));
                __builtin_amdgcn_global_load_lds((const unsigned*)src, (LAS unsigned*)(tbl + 2048 + (wid & 3) * 256), 4, 0, 0); }
        } else {
            if (wid < 4) { __builtin_amdgcn_global_load_lds((const unsigned*)(list + li), (LAS unsigned*)(tbl + (wid & 3) * 256), 4, 0, 0);
                __builtin_amdgcn_global_load_lds((const unsigned*)(m_bias + (size_t)u.e * 1024 + u.pn * BM + (wid & 3) * 64 + lane), (LAS unsigned*)(tbl + 2048 + (wid & 3) * 256), 4, 0, 0); }
            else __builtin_amdgcn_global_load_lds((const unsigned*)(m_gate + li), (LAS unsigned*)(tbl + 1024 + (wid & 3) * 256), 4, 0, 0);
        }
    }
};

typedef int v8i32 __attribute__((ext_vector_type(8)));
template <class Epi, class Sched, bool GATHER, bool F8 = false, bool WARMTRIP = false>
__device__ __forceinline__ void gemm_phase(LAS unsigned char* lds, const Sched& S, const Epi& E) {
    const int tid = threadIdx.x, wid = __builtin_amdgcn_readfirstlane(tid >> 6), lane = tid & 63, wr = wid >> 2, wc = wid & 3, fr = lane & 15, fq = lane >> 4;
    const int RP = S.rp, nt = RP / (BK * 2);
    unsigned voffA[2], voffB[2]; int RA[2], CA[2];
#pragma unroll
    for (int i = 0; i < 2; ++i) { int R, C; stage_rc(tid * 16 + i * 8192, R, C); const int Rb = Epi::PERM ? ((R & ~31) + perm32(R & 31)) : R;
        voffA[i] = (unsigned)(R * RP + C * 2); voffB[i] = (unsigned)(Rb * RP + C * 2); RA[i] = R; CA[i] = C; }
    const size_t kstep = (size_t)(BK * 2);
    const size_t hstep = (size_t)HALF * RP;
    const unsigned ldsw = (unsigned)wid * 1024u;
    const int aoff = lds_byte(wr * 64 + fr, fq * 8), boff = lds_byte(wc * 32 + fr, fq * 8);
    unsigned gC[2][2], gN[2][2];
#define PG8_SA(b, h) (((b) * 2 + (h)) * HTB)
#define PG8_SB(b, h) ((4 + (b) * 2 + (h)) * HTB)
#define PG8_STAGE(bufoff, gbase, voff) do { _Pragma("unroll") for (int _i = 0; _i < 2; ++_i) \
        __builtin_amdgcn_global_load_lds((const unsigned*)((const char*)(gbase) + (voff)[_i]), (LAS unsigned*)(lds + (bufoff) + ldsw + _i * 8192), 16, 0, 0); } while (0)
#define PG8_STAGE_A(bufoff, kp, h) do { if constexpr (GATHER) { PG8_STAGE(bufoff, kp, gC[h]); } else { PG8_STAGE(bufoff, (kp) + (h) * hstep, voffA); } } while (0)
#define PG8_LD16(p) (*(const LAS bf16x8*)(p))
#define PG8_CAT(lo, hi) __builtin_bit_cast(v8i32, __builtin_shufflevector(lo, hi, 0, 1, 2, 3, 4, 5, 6, 7, 8, 9, 10, 11, 12, 13, 14, 15))
#define PG8_LDA(dst, b, h) do { _Pragma("unroll") for (int m = 0; m < 4; ++m) { if constexpr (F8) { dst##8[m] = PG8_CAT(PG8_LD16(lds + PG8_SA(b, h) + aoff + m * 2048), PG8_LD16(lds + PG8_SA(b, h) + aoff + m * 2048 + 1024)); } \
        else { _Pragma("unroll") for (int k = 0; k < 2; ++k) dst[m][k] = PG8_LD16(lds + PG8_SA(b, h) + aoff + m * 2048 + k * 1024); } } } while (0)
#define PG8_LDB(dst, b, h) do { _Pragma("unroll") for (int n = 0; n < 2; ++n) { if constexpr (F8) { dst##8[n] = PG8_CAT(PG8_LD16(lds + PG8_SB(b, h) + boff + n * 2048), PG8_LD16(lds + PG8_SB(b, h) + boff + n * 2048 + 1024)); } \
        else { _Pragma("unroll") for (int k = 0; k < 2; ++k) dst[n][k] = PG8_LD16(lds + PG8_SB(b, h) + boff + n * 2048 + k * 1024); } } } while (0)
#define PG8_MMA(ai, bj, At, Bt) do { __builtin_amdgcn_s_setprio(1); _Pragma("unroll") for (int m = 0; m < 4; ++m) _Pragma("unroll") for (int n = 0; n < 2; ++n) { \
        if constexpr (F8) { acc[ai][bj][m][n] = __builtin_amdgcn_mfma_scale_f32_16x16x128_f8f6f4(Bt##8[n], At##8[m], acc[ai][bj][m][n], 0, 0, 0, 0x7f7f7f7f, 0, 0x7f7f7f7f); } \
        else { _Pragma("unroll") for (int k = 0; k < 2; ++k) acc[ai][bj][m][n] = __builtin_amdgcn_mfma_f32_16x16x32_bf16(Bt[n][k], At[m][k], acc[ai][bj][m][n], 0, 0, 0); } } \
        __builtin_amdgcn_s_setprio(0); } while (0)
#define PG8_WAIT_V(n) asm volatile("s_waitcnt vmcnt(" #n ")" ::: "memory")
#define PG8_WAIT_L(n) asm volatile("s_waitcnt lgkmcnt(" #n ")" ::: "memory")
#define PG8_BAR __builtin_amdgcn_s_barrier()
#define PG8_SCHED __builtin_amdgcn_sched_barrier(0)
#define PG8_GOFF(dst, u) do { _Pragma("unroll") for (int _h = 0; _h < 2; ++_h) _Pragma("unroll") for (int _i = 0; _i < 2; ++_i) \
        dst[_h][_i] = (unsigned)(S.a_row(u, _h * HALF + RA[_i]) * RP + CA[_i] * 2); } while (0)
    Unit cur, nxt, nn; int ui = 0;
    if (!S.next(0, cur)) return;
    bool has_next = S.next(1, nxt);
    if constexpr (GATHER) { PG8_GOFF(gC, cur); if (has_next) { PG8_GOFF(gN, nxt); } else { PG8_GOFF(gN, cur); } }
    f32x4 acc[2][2][4][2];
#pragma unroll
    for (int a = 0; a < 2; ++a)
#pragma unroll
        for (int b = 0; b < 2; ++b)
#pragma unroll
            for (int m = 0; m < 4; ++m)
#pragma unroll
                for (int n = 0; n < 2; ++n) acc[a][b][m][n] = (f32x4){0.f, 0.f, 0.f, 0.f};
    bf16x8 At[4][2], B0[2][2], B1[2][2]; v8i32 At8[4], B08[2], B18[2];
    const char* cA = S.a_ptr(cur); const char* cB = S.b_ptr(cur);
    PG8_STAGE(PG8_SB(0, 0), cB, voffB); PG8_STAGE(PG8_SB(0, 1), cB + hstep, voffB); PG8_STAGE_A(PG8_SA(0, 0), cA, 0); PG8_STAGE_A(PG8_SA(0, 1), cA, 1);
    if (wr == 1) PG8_BAR;
    PG8_WAIT_V(2); PG8_BAR;
    PG8_STAGE(PG8_SB(1, 0), cB + kstep, voffB); PG8_STAGE_A(PG8_SA(1, 0), cA + kstep, 0); PG8_STAGE(PG8_SB(1, 1), cB + hstep + kstep, voffB);
    PG8_WAIT_V(6); PG8_BAR;
    for (;;) {
        const char* nA = has_next ? S.a_ptr(nxt) : cA; const char* nB = has_next ? S.b_ptr(nxt) : cB;
        S.meta(cur, lds + (LDS_META - 0) + (ui & 1) * 4096, wid, lane);
#define PG8_TRIP(WARM, t) do { \
            const bool last = ((t) == nt - 2); \
            const char* a1 = cA + (size_t)((t) + 1) * kstep; \
            const char* a2 = last ? nA : cA + (size_t)((t) + 2) * kstep; const char* b2 = last ? nB : cB + (size_t)((t) + 2) * kstep; \
            const char* a3 = a2 + kstep; const char* b3 = b2 + kstep; \
              \
            PG8_LDB(B0, 0, 0); PG8_LDB(B1, 0, 1); PG8_SCHED; PG8_LDA(At, 0, 0); if constexpr (!(WARM)) { PG8_STAGE_A(PG8_SA(1, 1), a1, 1); } \
            if constexpr (GATHER) { if (last) { _Pragma("unroll") for (int h = 0; h < 2; ++h) _Pragma("unroll") for (int i = 0; i < 2; ++i) gC[h][i] = gN[h][i]; } } \
            if constexpr (!(WARM)) { PG8_WAIT_V(8); } PG8_WAIT_L(0); PG8_BAR; PG8_MMA(0, 0, At, B0); PG8_MMA(0, 1, At, B1); PG8_BAR; PG8_SCHED; \
              \
            PG8_LDA(At, 0, 1); PG8_STAGE(PG8_SB(0, 0), b2, voffB); PG8_STAGE(PG8_SB(0, 1), b2 + hstep, voffB); PG8_STAGE_A(PG8_SA(0, 0), a2, 0); \
            if constexpr (!(WARM)) { PG8_WAIT_V(8); } PG8_WAIT_L(0); PG8_BAR; PG8_MMA(1, 0, At, B0); PG8_MMA(1, 1, At, B1); PG8_BAR; PG8_SCHED; \
              \
            PG8_LDB(B0, 1, 0); PG8_LDB(B1, 1, 1); PG8_SCHED; PG8_LDA(At, 1, 0); PG8_STAGE_A(PG8_SA(0, 1), a2, 1); \
            if constexpr (!(WARM)) { PG8_WAIT_V(8); } PG8_WAIT_L(0); PG8_BAR; PG8_MMA(0, 0, At, B0); PG8_MMA(0, 1, At, B1); PG8_BAR; PG8_SCHED; \
              \
            PG8_LDA(At, 1, 1); PG8_STAGE(PG8_SB(1, 0), b3, voffB); PG8_STAGE(PG8_SB(1, 1), b3 + hstep, voffB); PG8_STAGE_A(PG8_SA(1, 0), a3, 0); \
            PG8_WAIT_V(8); PG8_WAIT_L(0); PG8_BAR; PG8_MMA(1, 0, At, B0); PG8_MMA(1, 1, At, B1); PG8_BAR; PG8_SCHED; \
        } while (0)
        int t0_ = 0;
        if constexpr (WARMTRIP) { if (ui > 0) { PG8_TRIP(true, 0); t0_ = 2; } }
        for (int t = t0_; t < nt; t += 2) { PG8_TRIP(false, t); }
#undef PG8_TRIP
        if (wr == 0) PG8_BAR;
        if constexpr (WARMTRIP) { PG8_STAGE_A(PG8_SA(1, 1), nA + kstep, 1); }
        bool has_nn = false;
        if constexpr (GATHER) { if (has_next) { has_nn = S.next(ui + 2, nn); if (has_nn) { PG8_GOFF(gN, nn); } } }
        else { if (has_next) has_nn = S.next(ui + 2, nn); }
        { int ln_; asm volatile("v_mbcnt_lo_u32_b32 %0, -1, 0\n\tv_mbcnt_hi_u32_b32 %0, -1, %0" : "=v"(ln_)); const int fr_ = ln_ & 15, fq_ = ln_ >> 4;
          const LAS unsigned char* mt = lds + LDS_META + (ui & 1) * 4096;
          if constexpr (WARMTRIP) {
              E.pre(acc, cur, wr, wc, fr_, fq_, mt);
              if constexpr (GATHER) asm volatile("" : "+v"(gN[0][0]), "+v"(gN[0][1]), "+v"(gN[1][0]), "+v"(gN[1][1]));
              PG8_WAIT_V(0);
              E.post(acc, cur, wr, wc, fr_, fq_, mt);
          } else { E.run(acc, cur, wr, wc, fr_, fq_, mt); } }
        if (!has_next) break;
#pragma unroll
        for (int a = 0; a < 2; ++a)
#pragma unroll
            for (int b = 0; b < 2; ++b)
#pragma unroll
                for (int m = 0; m < 4; ++m)
#pragma unroll
                    for (int n = 0; n < 2; ++n) acc[a][b][m][n] = (f32x4){0.f, 0.f, 0.f, 0.f};
        cur = nxt; cA = nA; cB = nB; ++ui; nxt = nn; has_next = has_nn;
        if (wr == 1) PG8_BAR;
    }
    PG8_WAIT_V(0);
    PG8_BAR;
#undef PG8_SA
#undef PG8_SB
#undef PG8_STAGE
#undef PG8_STAGE_A
#undef PG8_LDA
#undef PG8_LDB
#undef PG8_MMA
#undef PG8_LD16
#undef PG8_CAT
#undef PG8_WAIT_V
#undef PG8_WAIT_L
#undef PG8_BAR
#undef PG8_SCHED
#undef PG8_GOFF
}
}

using pg8::Unit; using pg8::cvt_pk_bf16;
constexpr int BM = 256, HALF = 128;

typedef f32x4 (&AccRef)[2][2][4][2];
__device__ __forceinline__ void pack8_bf16(f32x4& lo, const f32x4& hi) {
    const unsigned w0 = cvt_pk_bf16(lo[0], lo[1]), w1 = cvt_pk_bf16(lo[2], lo[3]), w2 = cvt_pk_bf16(hi[0], hi[1]), w3 = cvt_pk_bf16(hi[2], hi[3]);
    lo[0] = __builtin_bit_cast(float, w0); lo[1] = __builtin_bit_cast(float, w1); lo[2] = __builtin_bit_cast(float, w2); lo[3] = __builtin_bit_cast(float, w3);
}
#define AS_U4(v) __builtin_bit_cast(u32x4, v)

struct EpiInProj {
    static constexpr bool PERM = true;
    const float* rs1; const f32x2* rope; const float* glu_b;
    bf16_t *q, *k, *v, *qi, *ki, *hglu; float* wi;
    __device__ __forceinline__ void pre(AccRef acc, const Unit& u, int wr, int wc, int fr, int fq, const LAS unsigned char* mt) const {
        const int row0 = u.pm * BM + wr * 64 + fr;
        if (u.pn >= 4) {
            const int ch = 128 * (u.pn - 4) + 32 * wc + 8 * fq;
            f32x4 ba[2], bg[2];
#pragma unroll
            for (int n = 0; n < 2; ++n) { ba[n] = *(const f32x4*)(glu_b + ch + 4 * n); bg[n] = *(const f32x4*)(glu_b + 512 + ch + 4 * n); }
#pragma unroll
            for (int ai = 0; ai < 2; ++ai)
#pragma unroll
                for (int m = 0; m < 4; ++m) { const float rs = rs1[row0 + ai * HALF + m * 16];
#pragma unroll
                    for (int n = 0; n < 2; ++n)
#pragma unroll
                        for (int e = 0; e < 4; ++e) { const float a = acc[ai][0][m][n][e] * rs + ba[n][e], g = acc[ai][1][m][n][e] * rs + bg[n][e]; acc[ai][0][m][n][e] = a * sigmoidf_(g); }
                    pack8_bf16(acc[ai][0][m][0], acc[ai][0][m][1]); }
            return;
        }
        const bool do_rope = !(u.pn == 3 && wc >= 2), is_wi = (u.pn == 3 && wc == 3);
        const int d0 = 8 * fq;
#pragma unroll
        for (int ai = 0; ai < 2; ++ai)
#pragma unroll
            for (int m = 0; m < 4; ++m) { const int row = row0 + ai * HALF + m * 16; const float rs = rs1[row];
                if (do_rope) {
                    const f32x2* rp = rope + (size_t)(row & (SEQ - 1)) * 32 + d0;
#pragma unroll
                    for (int n = 0; n < 2; ++n)
#pragma unroll
                        for (int e = 0; e < 4; ++e) { const f32x2 cs = rp[4 * n + e]; const float x1 = acc[ai][0][m][n][e] * rs, x2 = acc[ai][1][m][n][e] * rs;
                            acc[ai][0][m][n][e] = x1 * cs.x - x2 * cs.y; acc[ai][1][m][n][e] = x2 * cs.x + x1 * cs.y; }
                } else {
#pragma unroll
                    for (int n = 0; n < 2; ++n) { acc[ai][0][m][n] = acc[ai][0][m][n] * rs; acc[ai][1][m][n] = acc[ai][1][m][n] * rs; }
                }
                if (!is_wi) { pack8_bf16(acc[ai][0][m][0], acc[ai][0][m][1]); pack8_bf16(acc[ai][1][m][0], acc[ai][1][m][1]); }
                if (m & 1) __builtin_amdgcn_sched_barrier(0); }
    }
    __device__ __forceinline__ void post(AccRef acc, const Unit& u, int wr, int wc, int fr, int fq, const LAS unsigned char* mt) const {
        const int row0 = u.pm * BM + wr * 64 + fr;
        if (u.pn >= 4) {
            const int ch = 128 * (u.pn - 4) + 32 * wc + 8 * fq;
#pragma unroll
            for (int ai = 0; ai < 2; ++ai)
#pragma unroll
                for (int m = 0; m < 4; ++m) *(u32x4*)(hglu + (size_t)(row0 + ai * HALF + m * 16) * 512 + ch) = AS_U4(acc[ai][0][m][0]);
            return;
        }
        bf16_t* dst; int ld, col; bool is_wi = false;
        if (u.pn < 2) { dst = q; ld = 512; col = (4 * u.pn + wc) * 64; }
        else if (u.pn == 2) { dst = qi; ld = 256; col = wc * 64; }
        else { ld = 64; col = 0; if (wc == 0) dst = k; else if (wc == 1) dst = ki; else if (wc == 2) dst = v; else { dst = v; is_wi = true; } }
        if (is_wi) {
            if (fq == 0) {
#pragma unroll
                for (int ai = 0; ai < 2; ++ai)
#pragma unroll
                    for (int m = 0; m < 4; ++m) *(f32x4*)(wi + (size_t)(row0 + ai * HALF + m * 16) * 4) = acc[ai][0][m][0];
            }
            return;
        }
#pragma unroll
        for (int ai = 0; ai < 2; ++ai)
#pragma unroll
            for (int m = 0; m < 4; ++m) { bf16_t* rp2 = dst + (size_t)(row0 + ai * HALF + m * 16) * ld + col + 8 * fq;
                *(u32x4*)(rp2) = AS_U4(acc[ai][0][m][0]); *(u32x4*)(rp2 + 32) = AS_U4(acc[ai][1][m][0]); }
    }
    __device__ __forceinline__ void run(const f32x4 (&acc)[2][2][4][2], const Unit& u, int wr, int wc, int fr, int fq, const LAS unsigned char* mt) const {
        const int row0 = u.pm * BM + wr * 64 + fr;
        if (u.pn >= 4) {
            const int ch = 128 * (u.pn - 4) + 32 * wc + 8 * fq;
            f32x4 ba[2], bg[2];
#pragma unroll
            for (int n = 0; n < 2; ++n) { ba[n] = *(const f32x4*)(glu_b + ch + 4 * n); bg[n] = *(const f32x4*)(glu_b + 512 + ch + 4 * n); }
#pragma unroll
            for (int ai = 0; ai < 2; ++ai)
#pragma unroll
                for (int m = 0; m < 4; ++m) { const int row = row0 + ai * HALF + m * 16; const float rs = rs1[row];
                    float o[8];
#pragma unroll
                    for (int n = 0; n < 2; ++n)
#pragma unroll
                        for (int e = 0; e < 4; ++e) { const float a = acc[ai][0][m][n][e] * rs + ba[n][e], g = acc[ai][1][m][n][e] * rs + bg[n][e]; o[4 * n + e] = a * sigmoidf_(g); }
                    u32x4 w; w.x = cvt_pk_bf16(o[0], o[1]); w.y = cvt_pk_bf16(o[2], o[3]); w.z = cvt_pk_bf16(o[4], o[5]); w.w = cvt_pk_bf16(o[6], o[7]);
                    *(u32x4*)(hglu + (size_t)row * 512 + ch) = w; }
            return;
        }
        bf16_t* dst; int ld, col; bool do_rope = true, is_wi = false;
        if (u.pn < 2) { dst = q; ld = 512; col = (4 * u.pn + wc) * 64; }
        else if (u.pn == 2) { dst = qi; ld = 256; col = wc * 64; }
        else { ld = 64; col = 0; if (wc == 0) dst = k; else if (wc == 1) dst = ki; else if (wc == 2) { dst = v; do_rope = false; } else { dst = v; is_wi = true; do_rope = false; } }
        if (is_wi) {
            if (fq == 0) {
#pragma unroll
                for (int ai = 0; ai < 2; ++ai)
#pragma unroll
                    for (int m = 0; m < 4; ++m) { const int row = row0 + ai * HALF + m * 16; const float rs = rs1[row];
                        *(f32x4*)(wi + (size_t)row * 4) = acc[ai][0][m][0] * rs; }
            }
            return;
        }
        const int d0 = 8 * fq;
#pragma unroll
        for (int ai = 0; ai < 2; ++ai)
#pragma unroll
            for (int m = 0; m < 4; ++m) { const int row = row0 + ai * HALF + m * 16; const float rs = rs1[row];
                float o1[8], o2[8];
                if (do_rope) {
                    const f32x4* rp = (const f32x4*)(rope + (size_t)(row & (SEQ - 1)) * 32 + d0);
#pragma unroll
                    for (int n = 0; n < 2; ++n)
#pragma unroll
                        for (int e2 = 0; e2 < 2; ++e2) { const f32x4 cs = rp[2 * n + e2];
                            { const float x1 = acc[ai][0][m][n][2 * e2] * rs, x2 = acc[ai][1][m][n][2 * e2] * rs; o1[4 * n + 2 * e2] = x1 * cs.x - x2 * cs.y; o2[4 * n + 2 * e2] = x2 * cs.x + x1 * cs.y; }
                            { const float x1 = acc[ai][0][m][n][2 * e2 + 1] * rs, x2 = acc[ai][1][m][n][2 * e2 + 1] * rs; o1[4 * n + 2 * e2 + 1] = x1 * cs.z - x2 * cs.w; o2[4 * n + 2 * e2 + 1] = x2 * cs.z + x1 * cs.w; } }
                } else {
#pragma unroll
                    for (int n = 0; n < 2; ++n)
#pragma unroll
                        for (int e = 0; e < 4; ++e) { o1[4 * n + e] = acc[ai][0][m][n][e] * rs; o2[4 * n + e] = acc[ai][1][m][n][e] * rs; }
                }
                u32x4 w1, w2; w1.x = cvt_pk_bf16(o1[0], o1[1]); w1.y = cvt_pk_bf16(o1[2], o1[3]); w1.z = cvt_pk_bf16(o1[4], o1[5]); w1.w = cvt_pk_bf16(o1[6], o1[7]);
                w2.x = cvt_pk_bf16(o2[0], o2[1]); w2.y = cvt_pk_bf16(o2[2], o2[3]); w2.z = cvt_pk_bf16(o2[4], o2[5]); w2.w = cvt_pk_bf16(o2[6], o2[7]);
                if (u.pn == 3 && wc == 1) {
                    bf16_t* tp = ki + ((size_t)(row >> 5) * 256 + (row & 31) + 32 * (fq & 1)) * 8;
                    *(u32x4*)(tp + (size_t)(fq >> 1) * 512) = w1; *(u32x4*)(tp + (size_t)(2 + (fq >> 1)) * 512) = w2;
                } else {
                    bf16_t* rp2 = dst + (size_t)row * ld + col + d0;
                    *(u32x4*)(rp2) = w1; *(u32x4*)(rp2 + 32) = w2; } }
    }
};

struct EpiBf16Plain {
    static constexpr bool PERM = true;
    bf16_t* O; int ldc; float scale;
    __device__ __forceinline__ void pre(AccRef acc, const Unit&, int, int, int, int, const LAS unsigned char*) const {
#pragma unroll
        for (int ai = 0; ai < 2; ++ai)
#pragma unroll
            for (int bj = 0; bj < 2; ++bj)
#pragma unroll
                for (int m = 0; m < 4; ++m) { acc[ai][bj][m][0] = acc[ai][bj][m][0] * scale; acc[ai][bj][m][1] = acc[ai][bj][m][1] * scale; pack8_bf16(acc[ai][bj][m][0], acc[ai][bj][m][1]); }
    }
    __device__ __forceinline__ void post(AccRef acc, const Unit& u, int wr, int wc, int fr, int fq, const LAS unsigned char* mt) const {
        const int row0 = u.pm * BM + wr * 64 + fr, col0 = u.pn * BM + wc * 32 + 8 * fq;
#pragma unroll
        for (int ai = 0; ai < 2; ++ai)
#pragma unroll
            for (int m = 0; m < 4; ++m) { bf16_t* rowp = O + (size_t)(row0 + ai * HALF + m * 16) * ldc + col0;
#pragma unroll
                for (int bj = 0; bj < 2; ++bj) *(u32x4*)(rowp + bj * HALF) = AS_U4(acc[ai][bj][m][0]); }
    }
    __device__ __forceinline__ void run(const f32x4 (&acc)[2][2][4][2], const Unit& u, int wr, int wc, int fr, int fq, const LAS unsigned char* mt) const {
        const int row0 = u.pm * BM + wr * 64 + fr, col0 = u.pn * BM + wc * 32 + 8 * fq;
#pragma unroll
        for (int ai = 0; ai < 2; ++ai)
#pragma unroll
            for (int m = 0; m < 4; ++m) { bf16_t* rowp = O + (size_t)(row0 + ai * HALF + m * 16) * ldc + col0;
#pragma unroll
                for (int bj = 0; bj < 2; ++bj) { const f32x4 v0 = acc[ai][bj][m][0] * scale, v1 = acc[ai][bj][m][1] * scale;
                    u32x4 w; w.x = cvt_pk_bf16(v0[0], v0[1]); w.y = cvt_pk_bf16(v0[2], v0[3]); w.z = cvt_pk_bf16(v1[0], v1[1]); w.w = cvt_pk_bf16(v1[2], v1[3]);
                    *(u32x4*)(rowp + bj * HALF) = w; } }
    }
};

struct EpiF8Plain {
    static constexpr bool PERM = true;
    unsigned char* O; int ldc; float scale;
    __device__ __forceinline__ void pre(AccRef acc, const Unit&, int, int, int, int, const LAS unsigned char*) const {}
    __device__ __forceinline__ void post(AccRef acc, const Unit& u, int wr, int wc, int fr, int fq, const LAS unsigned char* mt) const {
        const int row0 = u.pm * BM + wr * 64 + fr, col0 = u.pn * BM + wc * 32 + 8 * fq;
#pragma unroll
        for (int ai = 0; ai < 2; ++ai)
#pragma unroll
            for (int m = 0; m < 4; ++m) { unsigned char* rowp = O + (size_t)(row0 + ai * HALF + m * 16) * ldc + col0;
#pragma unroll
                for (int bj = 0; bj < 2; ++bj) { const f32x4 v0 = acc[ai][bj][m][0] * scale, v1 = acc[ai][bj][m][1] * scale;
                    u32x2 w; w.x = pk4_fp8(v0[0], v0[1], v0[2], v0[3]); w.y = pk4_fp8(v1[0], v1[1], v1[2], v1[3]);
                    *(u32x2*)(rowp + bj * HALF) = w; } }
    }
    __device__ __forceinline__ void run(AccRef acc, const Unit& u, int wr, int wc, int fr, int fq, const LAS unsigned char* mt) const { post(acc, u, wr, wc, fr, fq, mt); }
};

struct EpiOutProj {
    static constexpr bool PERM = false;
    const bf16_t* xb; bf16_t* h1; unsigned char* h1f8;
    __device__ __forceinline__ void pre(AccRef acc, const Unit& u, int wr, int wc, int fr, int fq, const LAS unsigned char* mt) const {
        const unsigned off0 = (unsigned)((u.pm * BM + wr * 64 + fr) * DM + u.pn * BM + wc * 32 + 8 * fq) * 2u;
        const unsigned char* xbb = (const unsigned char*)xb;
#pragma unroll
        for (int ai = 0; ai < 2; ++ai)
#pragma unroll
            for (int m = 0; m < 4; ++m) {
#pragma unroll
                for (int bj = 0; bj < 2; ++bj) { const u32x4 w = NT_LD((const u32x4*)(xbb + (off0 + (unsigned)(((ai * HALF + m * 16) * DM + bj * HALF) * 2))));
                    f32x4& v0 = acc[ai][bj][m][0]; f32x4& v1 = acc[ai][bj][m][1]; constexpr float SC = 1.0f / 512.0f;
                    v0[0] = fmaf(v0[0], SC, bf_lo(w.x)); v0[1] = fmaf(v0[1], SC, bf_hi(w.x)); v0[2] = fmaf(v0[2], SC, bf_lo(w.y)); v0[3] = fmaf(v0[3], SC, bf_hi(w.y));
                    v1[0] = fmaf(v1[0], SC, bf_lo(w.z)); v1[1] = fmaf(v1[1], SC, bf_hi(w.z)); v1[2] = fmaf(v1[2], SC, bf_lo(w.w)); v1[3] = fmaf(v1[3], SC, bf_hi(w.w)); }
                if (m & 1) __builtin_amdgcn_sched_barrier(0); }
    }
    __device__ __forceinline__ void post(AccRef acc, const Unit& u, int wr, int wc, int fr, int fq, const LAS unsigned char* mt) const {
        const unsigned off0 = (unsigned)((u.pm * BM + wr * 64 + fr) * DM + u.pn * BM + wc * 32 + 8 * fq);
        unsigned char* h1bb = (unsigned char*)h1;
#pragma unroll
        for (int ai = 0; ai < 2; ++ai)
#pragma unroll
            for (int m = 0; m < 4; ++m)
#pragma unroll
                for (int bj = 0; bj < 2; ++bj) { const unsigned o = off0 + (unsigned)((ai * HALF + m * 16) * DM + bj * HALF); const f32x4 v0 = acc[ai][bj][m][0], v1 = acc[ai][bj][m][1];
                    u32x4 w; w.x = cvt_pk_bf16(v0[0], v0[1]); w.y = cvt_pk_bf16(v0[2], v0[3]); w.z = cvt_pk_bf16(v1[0], v1[1]); w.w = cvt_pk_bf16(v1[2], v1[3]);
                    u32x2 q; q.x = pk4_fp8(v0[0], v0[1], v0[2], v0[3]); q.y = pk4_fp8(v1[0], v1[1], v1[2], v1[3]);
                    *(u32x4*)(h1bb + 2u * o) = w; *(u32x2*)(h1f8 + o) = q;
                    if (bj) __builtin_amdgcn_sched_barrier(0); }
    }
    __device__ __forceinline__ void run(AccRef acc, const Unit& u, int wr, int wc, int fr, int fq, const LAS unsigned char* mt) const { pre(acc, u, wr, wc, fr, fq, mt); post(acc, u, wr, wc, fr, fq, mt); }
};

struct EpiUp {
    static constexpr bool PERM = true;
    unsigned char* act;
    __device__ __forceinline__ void pre(AccRef acc, const Unit& u, int wr, int wc, int fr, int fq, const LAS unsigned char* mt) const {
        const int r0 = wr * 64 + fr, cl = 32 * wc + 8 * fq;
        const LAS float* rowA = (const LAS float*)mt; const LAS float* bias = (const LAS float*)(mt + 2048);
        f32x4 bg[2], bl[2];
#pragma unroll
        for (int n = 0; n < 2; ++n) { bg[n] = *(const LAS f32x4*)(bias + cl + 4 * n); bl[n] = *(const LAS f32x4*)(bias + 128 + cl + 4 * n); }
#pragma unroll
        for (int ai = 0; ai < 2; ++ai)
#pragma unroll
            for (int m = 0; m < 4; ++m) { const int r = r0 + ai * HALF + m * 16;
                const float rs = (r < u.rows) ? rowA[r] * 0.03125f : 0.f;
#pragma unroll
                for (int n = 0; n < 2; ++n)
#pragma unroll
                    for (int e = 0; e < 4; ++e) { float g = acc[ai][0][m][n][e] * rs + bg[n][e], l = acc[ai][1][m][n][e] * rs + bl[n][e];
                        g = fminf(g, 7.0f); l = fminf(fmaxf(l, -7.0f), 7.0f); acc[ai][0][m][n][e] = g * sigmoidf_(1.702f * g) * (l + 1.0f); } }
    }
    __device__ __forceinline__ void post(AccRef acc, const Unit& u, int wr, int wc, int fr, int fq, const LAS unsigned char* mt) const {
        const int r0 = wr * 64 + fr, ch = 128 * u.pn + 32 * wc + 8 * fq;
#pragma unroll
        for (int ai = 0; ai < 2; ++ai)
#pragma unroll
            for (int m = 0; m < 4; ++m) { const int r = r0 + ai * HALF + m * 16;
                const f32x4 v0 = acc[ai][0][m][0], v1 = acc[ai][0][m][1];
                u32x2 w; w.x = pk4_fp8(v0[0], v0[1], v0[2], v0[3]); w.y = pk4_fp8(v1[0], v1[1], v1[2], v1[3]);
                *(u32x2*)(act + (size_t)(u.pm * BM + r) * 1024 + ch) = w; }
    }
    __device__ __forceinline__ void run(const f32x4 (&acc)[2][2][4][2], const Unit& u, int wr, int wc, int fr, int fq, const LAS unsigned char* mt) const {
        const int r0 = wr * 64 + fr, cl = 32 * wc + 8 * fq, ch = 128 * u.pn + cl;
        const LAS float* rowA = (const LAS float*)mt; const LAS float* bias = (const LAS float*)(mt + 2048);
        f32x4 bg[2], bl[2];
#pragma unroll
        for (int n = 0; n < 2; ++n) { bg[n] = *(const LAS f32x4*)(bias + cl + 4 * n); bl[n] = *(const LAS f32x4*)(bias + 128 + cl + 4 * n); }
#pragma unroll
        for (int ai = 0; ai < 2; ++ai)
#pragma unroll
            for (int m = 0; m < 4; ++m) { const int r = r0 + ai * HALF + m * 16;
                const float rs = (r < u.rows) ? rowA[r] * 0.03125f : 0.f;
                float o[8];
#pragma unroll
                for (int n = 0; n < 2; ++n)
#pragma unroll
                    for (int e = 0; e < 4; ++e) { float g = acc[ai][0][m][n][e] * rs + bg[n][e], l = acc[ai][1][m][n][e] * rs + bl[n][e];
                        g = fminf(g, 7.0f); l = fminf(fmaxf(l, -7.0f), 7.0f); o[4 * n + e] = g * sigmoidf_(1.702f * g) * (l + 1.0f); }
                u32x2 w; w.x = pk4_fp8(o[0], o[1], o[2], o[3]); w.y = pk4_fp8(o[4], o[5], o[6], o[7]);
                *(u32x2*)(act + (size_t)(u.pm * BM + r) * 1024 + ch) = w; }
    }
};

struct EpiDown {
    static constexpr bool PERM = true;
    unsigned char* y;
    __device__ __forceinline__ void pre(AccRef acc, const Unit& u, int wr, int wc, int fr, int fq, const LAS unsigned char* mt) const {
        const int r0 = wr * 64 + fr, cl = wc * 32 + 8 * fq;
        const LAS float* gateT = (const LAS float*)(mt + 1024); const LAS float* bias = (const LAS float*)(mt + 2048);
        float gt[2][4];
#pragma unroll
        for (int ai = 0; ai < 2; ++ai)
#pragma unroll
            for (int m = 0; m < 4; ++m) gt[ai][m] = gateT[r0 + ai * HALF + m * 16] * 16.0f;
#pragma unroll
        for (int bj = 0; bj < 2; ++bj) { const f32x4 bv0 = *(const LAS f32x4*)(bias + cl + bj * HALF), bv1 = *(const LAS f32x4*)(bias + cl + bj * HALF + 4);
#pragma unroll
            for (int ai = 0; ai < 2; ++ai)
#pragma unroll
                for (int m = 0; m < 4; ++m) { acc[ai][bj][m][0] = (acc[ai][bj][m][0] * 0.03125f + bv0) * gt[ai][m]; acc[ai][bj][m][1] = (acc[ai][bj][m][1] * 0.03125f + bv1) * gt[ai][m]; } }
    }
    __device__ __forceinline__ void post(AccRef acc, const Unit& u, int wr, int wc, int fr, int fq, const LAS unsigned char* mt) const {
        const int r0 = wr * 64 + fr, col0 = u.pn * BM + wc * 32 + 8 * fq;
        const LAS int* slotT = (const LAS int*)mt;
#pragma unroll
        for (int ai = 0; ai < 2; ++ai)
#pragma unroll
            for (int m = 0; m < 4; ++m) { const int r = r0 + ai * HALF + m * 16;
                if (r < u.rows) { unsigned char* rowp = y + (size_t)slotT[r] * 1024 + col0;
#pragma unroll
                    for (int bj = 0; bj < 2; ++bj) { const f32x4 v0 = acc[ai][bj][m][0], v1 = acc[ai][bj][m][1];
                        u32x2 w; w.x = pk4_fp8(v0[0], v0[1], v0[2], v0[3]); w.y = pk4_fp8(v1[0], v1[1], v1[2], v1[3]);
                        *(u32x2*)(rowp + bj * HALF) = w; } } }
    }
    __device__ __forceinline__ void run(AccRef acc, const Unit& u, int wr, int wc, int fr, int fq, const LAS unsigned char* mt) const { pre(acc, u, wr, wc, fr, fq, mt); post(acc, u, wr, wc, fr, fq, mt); }
};

template <bool F8>
__device__ __forceinline__ void p0_transpose_item(const float* W, int ldw, void* WTv, int Kdim, const float* gain, LAS float* scr, int kb, int n0, int src0, int nvalid, int lane, bool prow = false) {
    bf16_t* WT = (bf16_t*)WTv;
    const int k0 = 64 * kb;
    f32x4 ld4[8];
#pragma unroll
    for (int i = 0; i < 8; ++i) { const int kk = 8 * i + (lane >> 3), j = (lane & 7) * 4;
        ld4[i] = (f32x4){0.f, 0.f, 0.f, 0.f}; if (j < nvalid) ld4[i] = NT_LD((const f32x4*)(W + (size_t)(k0 + kk) * ldw + src0 + j)); }
#pragma unroll
    for (int i = 0; i < 8; ++i) { const int kk = 8 * i + (lane >> 3), j = (lane & 7) * 4; const float gk = (gain ? gain[k0 + kk] : 1.0f) * (F8 ? 32.0f : 1.0f);
        LAS float* d = scr + kk * 33 + j; d[0] = ld4[i].x * gk; d[1] = ld4[i].y * gk; d[2] = ld4[i].z * gk; d[3] = ld4[i].w * gk; }
    LDS_WAIT(); asm volatile("" ::: "memory");
    const int c = lane & 7;
#pragma unroll
    for (int j = 0; j < 4; ++j) { const int nl = (lane >> 3) + 8 * j; const LAS float* s = scr + (8 * c) * 33 + nl;
        const int n = prow ? 16 * ((nl >> 2) & 1) + 4 * (nl >> 3) + (nl & 3) : nl;
        if constexpr (F8) { u32x2 o; o.x = pk4_fp8(s[0 * 33], s[1 * 33], s[2 * 33], s[3 * 33]); o.y = pk4_fp8(s[4 * 33], s[5 * 33], s[6 * 33], s[7 * 33]);
            *(u32x2*)((unsigned char*)WTv + (size_t)(n0 + n) * Kdim + k0 + 8 * c) = o; }
        else { u32x4 o; o.x = pk2(s[0 * 33], s[1 * 33]); o.y = pk2(s[2 * 33], s[3 * 33]); o.z = pk2(s[4 * 33], s[5 * 33]); o.w = pk2(s[6 * 33], s[7 * 33]);
            *(u32x4*)(WT + (size_t)(n0 + n) * Kdim + k0 + 8 * c) = o; } }
    LDS_WAIT(); asm volatile("" ::: "memory");
}
__device__ __forceinline__ void win_colmap(int nb, int& src0, int& nvalid) {
    const int pn = nb >> 3, j = (nb & 7) * 32, bj = j >> 7, slot = (j & 127) >> 5;
    nvalid = 32;
    if (pn < 2) src0 = (4 * pn + slot) * 64 + 32 * bj;
    else if (pn == 2) src0 = 640 + slot * 64 + 32 * bj;
    else if (pn == 3) { if (slot == 0) src0 = 512 + 32 * bj; else if (slot == 1) src0 = 896 + 32 * bj; else if (slot == 2) src0 = 576 + 32 * bj; else { src0 = 960; nvalid = bj == 0 ? 4 : 0; } }
    else src0 = 964 + 512 * bj + 128 * (pn - 4) + 32 * slot;
}
__device__ __forceinline__ void p0_prologue(const Params& P, LAS unsigned char* lds, int vcu, int G, int wave, int lane) {
    unsigned char* ws = P.ws;
    LAS float* scr = (LAS float*)(lds + wave * 16384);
    const int gw = vcu * NWAVES + wave, NGW = G * NWAVES;
    constexpr int I_IN = 16 * 64, I_OUT = 16 * 32, I_G = 16 * 32, I_P = 4 * 32;
    constexpr int NITEMS = I_IN + I_OUT + I_G + I_P;
    for (int it = gw; it < NITEMS; it += NGW) {
        int r = it;
        if (r < I_IN) { const int kb = r / 64, nb = r % 64; int s0, nv; win_colmap(nb, s0, nv); p0_transpose_item<false>(P.w_in, INW, (bf16_t*)(ws + WS_WIN), 1024, P.g_mix, scr, kb, nb * 32, s0, nv, lane); continue; } r -= I_IN;
        if (r < I_OUT) { const int kb = r / 32, nb = r % 32; p0_transpose_item<true>(P.w_out, 1024, (unsigned char*)(ws + WS_WOUT), 1024, nullptr, scr, kb, nb * 32, nb * 32, 32, lane, true); continue; } r -= I_OUT;
        if (r < I_G) { const int kb = r / 32, nb = r % 32; p0_transpose_item<true>(P.w_ple_gate, 1024, (unsigned char*)(ws + WS_WG), 1024, P.g_ple, scr, kb, nb * 32, nb * 32, 32, lane); continue; } r -= I_G;
        { const int kb = r / 32, nb = r % 32; p0_transpose_item<false>(P.w_ple_proj, 1024, (bf16_t*)(ws + WS_WP), 256, nullptr, scr, kb, nb * 32, nb * 32, 32, lane); }
    }
    float* rs1 = (float*)(ws + WS_RS1); bf16_t* xb = (bf16_t*)(ws + WS_XB);
    for (int m = gw; m < NTOK; m += NGW) {
        const f32x4* xr = (const f32x4*)(P.x + (size_t)m * DM) + lane; f32x4 v[4]; float s = 0.f;
#pragma unroll
        for (int j = 0; j < 4; ++j) { v[j] = NT_LD(xr + 64 * j); s += (v[j].x * v[j].x + v[j].y * v[j].y) + (v[j].z * v[j].z + v[j].w * v[j].w); }
        s = wave_sum(s);
        u32x2* o8 = (u32x2*)(xb + (size_t)m * DM) + lane;
#pragma unroll
        for (int j = 0; j < 4; ++j) { u32x2 w; w.x = pk2(v[j].x, v[j].y); w.y = pk2(v[j].z, v[j].w); o8[64 * j] = w; }
        if (lane == 0) rs1[m] = 1.0f / sqrtf(s * (1.0f / DM) + EPS);
    }
    bf16_t* pb = (bf16_t*)(ws + WS_PB);
    for (int m = gw; m < NTOK; m += NGW) { const f32x4 v = NT_LD((const f32x4*)(P.p + (size_t)m * 256) + lane); u32x2 w; w.x = pk2(v.x, v.y); w.y = pk2(v.z, v.w); *((u32x2*)(pb + (size_t)m * 256) + lane) = w; }
    f32x2* rope = (f32x2*)(ws + WS_ROPE);
    for (int idx = gw * 64 + lane; idx < SEQ * 32; idx += NGW * 64) { const int t = idx >> 5, i = idx & 31;
        const float inv = exp2f(-(float)i * (13.287712379549449f / 32.0f));
        const float ang = (float)t * inv;
        const double rev = (double)ang * 0.15915494309189535; const float fr = (float)(rev - __builtin_floor(rev));
        rope[idx] = (f32x2){__builtin_amdgcn_cosf(fr), __builtin_amdgcn_sinf(fr)}; }
    bf16_t* wrg = (bf16_t*)(ws + WS_WRG);
    for (int idx = gw * 64 + lane; idx < 1024 * 32; idx += NGW * 64) { const int k = idx >> 5, e = idx & 31; const float w = P.w_router[idx] * P.g_ffn[k];
        const unsigned short hi = f2bf(w); const float whi = __uint_as_float((unsigned)hi << 16); const size_t o = ((size_t)(k >> 3) * 32 + e) * 8 + (k & 7);
        wrg[o] = hi; wrg[32768 + o] = f2bf(w - whi); }
}

__device__ __forceinline__ unsigned fkey(float f) { unsigned u = __builtin_bit_cast(unsigned, f); if (u == 0x80000000u) u = 0u; return u ^ ((unsigned)((int)u >> 31) | 0x80000000u); }
__device__ __forceinline__ int mbcnt64(unsigned long long m) { return __builtin_amdgcn_mbcnt_hi((unsigned)(m >> 32), __builtin_amdgcn_mbcnt_lo((unsigned)m, 0u)); }

template <int NR>
__device__ __forceinline__ unsigned bisect_thr(const unsigned (&v)[NR], unsigned prefix, int startbit) {
    bool exact = false;
#pragma unroll 1
    for (int bit = startbit; bit >= 0; --bit) {
        const unsigned cand = prefix | (1u << bit); int cnt = 0;
#pragma unroll
        for (int r = 0; r < NR; ++r) { cnt += __builtin_popcountll(__ballot(v[r] >= cand)); if ((r & 7) == 7) __builtin_amdgcn_sched_barrier(0); }
        if (cnt >= NSEL) prefix = cand;
        if (cnt == NSEL) { exact = true; break; }
    }
    return exact ? prefix - 1u : prefix;
}
template <int NR, bool EXPL>
__device__ __forceinline__ void compact_sel(const unsigned (&v)[NR], const unsigned (&ci)[NR], unsigned T, LAS unsigned* list, int lane) {
    int cgt = 0;
#pragma unroll
    for (int r = 0; r < NR; ++r) { cgt += __builtin_popcountll(__ballot(v[r] > T)); if ((r & 7) == 7) __builtin_amdgcn_sched_barrier(0); }
    const int need = NSEL - cgt; int base = 0, ties = 0;
#pragma unroll
    for (int r = 0; r < NR; ++r) { const bool gt = v[r] > T, eq = v[r] == T; const unsigned long long em = __ballot(eq);
        const bool sel = gt || (eq && (ties + mbcnt64(em)) < need); const unsigned long long sm = __ballot(sel);
        list[sel ? base + mbcnt64(sm) : NSEL + lane] = EXPL ? ci[r] : (unsigned)(r * 64 + lane);
        base += __builtin_popcountll(sm); ties += __builtin_popcountll(em);
        if ((r & 3) == 3) __builtin_amdgcn_sched_barrier(0); }
}
constexpr int SEL_CAP = 1024;
template <int NR>
__device__ __forceinline__ void select_topk(LAS float* row, LAS unsigned* H, LAS unsigned* list, int lane, bool zero_h) {
    unsigned v[NR];
#pragma unroll
    for (int r = 0; r < NR; ++r) v[r] = fkey(row[r * 64 + lane]);
    LAS u32x4* H4 = (LAS u32x4*)H;
    const u32x4 h0 = H4[2 * lane], h1 = H4[2 * lane + 1];
    if (zero_h) { H4[2 * lane] = (u32x4){0u, 0u, 0u, 0u}; H4[2 * lane + 1] = (u32x4){0u, 0u, 0u, 0u}; }
    const unsigned hw[8] = {h0.x, h0.y, h0.z, h0.w, h1.x, h1.y, h1.z, h1.w};
    unsigned c[16];
#pragma unroll
    for (int i = 0; i < 8; ++i) { c[2 * i] = hw[i] & 0xffffu; c[2 * i + 1] = hw[i] >> 16; }
    unsigned s = 0u;
#pragma unroll
    for (int i = 0; i < 16; ++i) s += c[i];
    unsigned S = s;
#pragma unroll
    for (int off = 1; off < 64; off <<= 1) { const unsigned o = __shfl_down(S, off); if (lane + off < 64) S += o; }
    const unsigned long long okm = __ballot(S >= (unsigned)NSEL);
    bool fast = okm != 0ull; unsigned floorkey = 0u; int C = 0;
    if (fast) {
        const int Ls = 63 - __builtin_clzll(okm);
        unsigned acc = S - s; int bl = -1; unsigned accb = 0u;
#pragma unroll
        for (int b = 15; b >= 0; --b) { acc += c[b]; if (bl < 0 && acc >= (unsigned)NSEL) { bl = b; accb = acc; } }
        const int bstar = __shfl(bl, Ls) + 16 * Ls; C = (int)__shfl(accb, Ls);
        floorkey = (unsigned)bstar << 22;
        fast = (bstar > 1) && (C <= SEL_CAP);
    }
    if (!fast) {
        const unsigned T = bisect_thr<NR>(v, 0u, 31);
        compact_sel<NR, false>(v, v, T, list, lane);
        return;
    }
    LAS unsigned* ckl = (LAS unsigned*)row; LAS unsigned* cil = ckl + 1152;
    { int base = 0;
#pragma unroll
      for (int r = 0; r < NR; ++r) { const bool cnd = v[r] >= floorkey; const unsigned long long m = __ballot(cnd);
          const int pos = cnd ? base + mbcnt64(m) : SEL_CAP + lane;
          ckl[pos] = v[r]; cil[pos] = (unsigned)(r * 64 + lane); base += __builtin_popcountll(m);
          if ((r & 3) == 3) __builtin_amdgcn_sched_barrier(0); } }
    if (C <= 512) {
        unsigned ck[8], ci[8];
#pragma unroll
        for (int j = 0; j < 8; ++j) { const int i = j * 64 + lane; ck[j] = i < C ? ckl[i] : 0u; ci[j] = cil[i]; }
        const unsigned T = (C == NSEL) ? floorkey - 1u : bisect_thr<8>(ck, floorkey, 21);
        compact_sel<8, true>(ck, ci, T, list, lane);
    } else {
        unsigned ck[16], ci[16];
#pragma unroll
        for (int j = 0; j < 16; ++j) { const int i = j * 64 + lane; ck[j] = i < C ? ckl[i] : 0u; ci[j] = cil[i]; }
        const unsigned T = bisect_thr<16>(ck, floorkey, 21);
        compact_sel<16, true>(ck, ci, T, list, lane);
    }
}

typedef short v4i16 __attribute__((ext_vector_type(4)));
constexpr int VROW = 144;

__device__ __forceinline__ void attn_tile(const Params& P, LAS unsigned char* lds, int b, int t0, int wave, int lane) {
    unsigned char* ws = P.ws;
    const bf16_t* QI = (const bf16_t*)(ws + WS_QI); const bf16_t* KI = (const bf16_t*)(ws + WS_KI);
    const bf16_t* Q = (const bf16_t*)(ws + WS_Q); const bf16_t* Kp = (const bf16_t*)(ws + WS_K); const bf16_t* Vp = (const bf16_t*)(ws + WS_V);
    const float* WI = (const float*)(ws + WS_WI); unsigned char* MIX = ws + WS_MIX;
    LAS float* SC = (LAS float*)lds;
    LAS unsigned* list = (LAS unsigned*)(lds + wave * 16384 + 14336);
    LAS unsigned* HIST = (LAS unsigned*)(lds + LDS_MISC);
    const int tokbase = b * SEQ;
    const bool need_sel = t0 >= 256;
    if (need_sel) {
        const int nkt = (t0 + 8 + 31) >> 5;
        bf16x8 a[4]; f32x4 w[4];
        { const bf16_t* src = QI + (size_t)(tokbase + t0 + ((lane & 31) >> 2)) * 256 + (lane & 3) * 64 + 8 * (lane >> 5);
#pragma unroll
          for (int ks = 0; ks < 4; ++ks) a[ks] = *(const bf16x8*)(src + 16 * ks); }
#pragma unroll
        for (int g = 0; g < 4; ++g) w[g] = *(const f32x4*)(WI + (size_t)(tokbase + t0 + 2 * g + (lane >> 5)) * 4);
        for (int kt0 = wave; kt0 < nkt; kt0 += 4 * NWAVES) {
            bf16x8 bf[4][4];
#pragma unroll
            for (int u = 0; u < 4; ++u) { const int kt = kt0 + u * NWAVES;
                if (kt < nkt) { const bf16_t* ksrc = KI + ((size_t)((tokbase >> 5) + kt) * 256 + lane) * 8;
#pragma unroll
                    for (int ks = 0; ks < 4; ++ks) bf[u][ks] = *(const bf16x8*)(ksrc + 512 * ks); } }
#pragma unroll
            for (int u = 0; u < 4; ++u) { const int kt = kt0 + u * NWAVES;
                if (kt < nkt) {
                    const int key = kt * 32 + (lane & 31);
                    f32x16 acc;
#pragma unroll
                    for (int i = 0; i < 16; ++i) acc[i] = 0.f;
#pragma unroll
                    for (int ks = 0; ks < 4; ++ks) acc = __builtin_amdgcn_mfma_f32_32x32x16_bf16(a[ks], bf[u][ks], acc, 0, 0, 0);
#pragma unroll
                    for (int g = 0; g < 4; ++g) { float sc = 0.f;
#pragma unroll
                        for (int h = 0; h < 4; ++h) sc = fmaf(fmaxf(acc[4 * g + h], 0.f), w[g][h], sc);
                        const int ql = 2 * g + (lane >> 5);
                        if (key > t0 + ql) sc = -INFINITY;
                        SC[ql * 4096 + key] = sc;
                        if (key <= t0 + ql) { const unsigned ub = __builtin_bit_cast(unsigned, sc);
                            const unsigned bin = (ub >> 22) ^ (((unsigned)((int)ub >> 31) & 0x1ffu) | 0x200u);
                            __hip_atomic_fetch_add(HIST + ql * 512 + (bin >> 1), 1u << ((bin & 1u) << 4), __ATOMIC_RELAXED, __HIP_MEMORY_SCOPE_WORKGROUP); } }
                } }
        }
        { const int npad = ((t0 + 8 + 1023) >> 10) << 10;
          for (int i = nkt * 32 + (int)threadIdx.x; i < npad; i += NTHR) {
#pragma unroll
              for (int q = 0; q < 8; ++q) SC[q * 4096 + i] = -INFINITY; } }
    }
    __syncthreads();
    const int t = t0 + wave, tok = tokbase + t;
    if (need_sel) {
        LAS float* row = SC + wave * 4096; LAS unsigned* H = HIST + wave * 512; const int n = t + 1;
        if (n <= 1024) select_topk<16>(row, H, list, lane, true);
        else if (n <= 2048) select_topk<32>(row, H, list, lane, true);
        else if (n <= 3072) select_topk<48>(row, H, list, lane, true);
        else select_topk<64>(row, H, list, lane, true);
    } else {
#pragma unroll
        for (int i = 0; i < 4; ++i) list[i * 64 + lane] = (unsigned)(i * 64 + lane);
    }
    const int nvalid = need_sel ? NSEL : (t + 1);
    const int hd = lane & 15, g = lane >> 4;
    bf16x8 qf0, qf1;
#pragma unroll
    for (int i = 0; i < 8; ++i) { qf0[i] = 0; qf1[i] = 0; }
    if (hd < 8) { const bf16_t* qs = Q + (size_t)tok * 512 + hd * 64 + 8 * g; qf0 = *(const bf16x8*)qs; qf1 = *(const bf16x8*)(qs + 32); }
    LAS unsigned char* vreg = lds + wave * 16384;
    u32x4 rA[4], rB[4];
#define ATT_ROWS(R, SRC, G_) do { const int nb_ = (G_) * 32; \
        _Pragma("unroll") for (int i_ = 0; i_ < 4; ++i_) { const unsigned idx_ = list[nb_ + (lane >> 3) + 8 * i_]; R[i_] = *(const u32x4*)((SRC) + (size_t)(tokbase + idx_) * 64 + 8 * (lane & 7)); } } while (0)
#define ATT_STAGE(R, BUF) do { _Pragma("unroll") for (int i_ = 0; i_ < 4; ++i_) *(LAS u32x4*)((BUF) + ((lane >> 3) + 8 * i_) * VROW + (lane & 7) * 16) = R[i_]; } while (0)
    float lg[8][8];
#define ATT_QK(R, G_, BUF) do { LAS unsigned char* kb_ = (BUF); ATT_STAGE(R, kb_); \
        if constexpr ((G_) + 2 < 8) { ATT_ROWS(R, Kp, (G_) + 2); } \
        const LAS unsigned char* kr_ = kb_ + hd * VROW + 16 * g; \
        const bf16x8 ka0_ = *(const LAS bf16x8*)kr_, ka1_ = *(const LAS bf16x8*)(kr_ + 64), kb0_ = *(const LAS bf16x8*)(kr_ + 16 * VROW), kb1_ = *(const LAS bf16x8*)(kr_ + 16 * VROW + 64); \
        f32x4 sa_ = {0.f, 0.f, 0.f, 0.f}, sb_ = {0.f, 0.f, 0.f, 0.f}; \
        sa_ = __builtin_amdgcn_mfma_f32_16x16x32_bf16(ka0_, qf0, sa_, 0, 0, 0); sa_ = __builtin_amdgcn_mfma_f32_16x16x32_bf16(ka1_, qf1, sa_, 0, 0, 0); \
        sb_ = __builtin_amdgcn_mfma_f32_16x16x32_bf16(kb0_, qf0, sb_, 0, 0, 0); sb_ = __builtin_amdgcn_mfma_f32_16x16x32_bf16(kb1_, qf1, sb_, 0, 0, 0); \
        _Pragma("unroll") for (int r_ = 0; r_ < 4; ++r_) { const int sl_ = (G_) * 32 + 4 * g + r_; \
            lg[G_][r_] = sl_ < nvalid ? sa_[r_] * 0.125f : -INFINITY; lg[G_][4 + r_] = (sl_ + 16) < nvalid ? sb_[r_] * 0.125f : -INFINITY; } } while (0)
    ATT_ROWS(rA, Kp, 0); ATT_ROWS(rB, Kp, 1);
    ATT_QK(rA, 0, vreg); ATT_QK(rB, 1, vreg + 4608); ATT_QK(rA, 2, vreg); ATT_QK(rB, 3, vreg + 4608);
    ATT_QK(rA, 4, vreg); ATT_QK(rB, 5, vreg + 4608); ATT_QK(rA, 6, vreg); ATT_QK(rB, 7, vreg + 4608);
    ATT_ROWS(rA, Vp, 0); ATT_ROWS(rB, Vp, 1);
    float mx = -INFINITY;
#pragma unroll
    for (int q = 0; q < 8; ++q)
#pragma unroll
        for (int r = 0; r < 8; ++r) mx = fmaxf(mx, lg[q][r]);
    mx = fmaxf(mx, __shfl_xor(mx, 16)); mx = fmaxf(mx, __shfl_xor(mx, 32));
    float ssum = 0.f;
#pragma unroll
    for (int q = 0; q < 8; ++q)
#pragma unroll
        for (int r = 0; r < 8; ++r) { lg[q][r] = __expf(lg[q][r] - mx); ssum += lg[q][r]; }
    f32x4 o[4];
#pragma unroll
    for (int dt = 0; dt < 4; ++dt) o[dt] = (f32x4){0.f, 0.f, 0.f, 0.f};
#define ATT_PV(R, G_, BUF) do { LAS unsigned char* vb_ = (BUF); ATT_STAGE(R, vb_); \
        if constexpr ((G_) + 2 < 8) { ATT_ROWS(R, Vp, (G_) + 2); } \
        bf16x8 pf_; \
        { const u32x4 pw_ = {cvt_pk_bf16(lg[G_][0], lg[G_][1]), cvt_pk_bf16(lg[G_][2], lg[G_][3]), cvt_pk_bf16(lg[G_][4], lg[G_][5]), cvt_pk_bf16(lg[G_][6], lg[G_][7])}; pf_ = __builtin_bit_cast(bf16x8, pw_); } \
        LAS unsigned char* ta_ = vb_ + (4 * g + (hd >> 2)) * VROW + (hd & 3) * 8; \
        _Pragma("unroll") for (int dt_ = 0; dt_ < 4; ++dt_) { \
            const v4i16 lo_ = __builtin_amdgcn_ds_read_tr16_b64_v4i16((LAS v4i16*)(ta_ + dt_ * 32)); \
            const v4i16 hi_ = __builtin_amdgcn_ds_read_tr16_b64_v4i16((LAS v4i16*)(ta_ + 16 * VROW + dt_ * 32)); \
            bf16x8 vf_; vf_[0] = lo_[0]; vf_[1] = lo_[1]; vf_[2] = lo_[2]; vf_[3] = lo_[3]; vf_[4] = hi_[0]; vf_[5] = hi_[1]; vf_[6] = hi_[2]; vf_[7] = hi_[3]; \
            o[dt_] = __builtin_amdgcn_mfma_f32_16x16x32_bf16(vf_, pf_, o[dt_], 0, 0, 0); } } while (0)
    ATT_PV(rA, 0, vreg); ATT_PV(rB, 1, vreg + 4608); ATT_PV(rA, 2, vreg); ATT_PV(rB, 3, vreg + 4608);
    ATT_PV(rA, 4, vreg); ATT_PV(rB, 5, vreg + 4608); ATT_PV(rA, 6, vreg); ATT_PV(rB, 7, vreg + 4608);
#undef ATT_ROWS
#undef ATT_STAGE
#undef ATT_QK
#undef ATT_PV
    ssum += __shfl_xor(ssum, 16); ssum += __shfl_xor(ssum, 32);
    const float inv = 1.0f / ssum;
    if (hd < 8) {
        unsigned char* op = MIX + (size_t)tok * 1024 + hd * 64 + 4 * g; const float inv16 = inv * 16.0f;
#pragma unroll
        for (int dt = 0; dt < 4; ++dt) *(unsigned*)(op + 16 * dt) = pk4_fp8(o[dt][0] * inv16, o[dt][1] * inv16, o[dt][2] * inv16, o[dt][3] * inv16);
    }
    __syncthreads();
}

__device__ __forceinline__ float row_sum16(float v) {
    v += __builtin_bit_cast(float, __builtin_amdgcn_update_dpp(0, __builtin_bit_cast(int, v), 0xB1, 0xF, 0xF, true));
    v += __builtin_bit_cast(float, __builtin_amdgcn_update_dpp(0, __builtin_bit_cast(int, v), 0x4E, 0xF, 0xF, true));
    v += __builtin_bit_cast(float, __builtin_amdgcn_update_dpp(0, __builtin_bit_cast(int, v), 0x141, 0xF, 0xF, true));
    v += __builtin_bit_cast(float, __builtin_amdgcn_update_dpp(0, __builtin_bit_cast(int, v), 0x140, 0xF, 0xF, true));
    return v;
}
__device__ __forceinline__ void conv_phase(const Params& P, LAS unsigned char* lds, unsigned* queue, volatile LAS int* qw, int wave_) {
    unsigned char* ws = P.ws;
    int lane, wave = wave_; asm volatile("v_mbcnt_lo_u32_b32 %0, -1, 0\n\tv_mbcnt_hi_u32_b32 %0, -1, %0" : "=v"(lane)); asm volatile("" : "+s"(wave));
    const int tid = wave * 64 + lane;
    const bf16_t* HG = (const bf16_t*)(ws + WS_HGLU); unsigned char* MIX = ws + WS_MIX;
    LAS f32x2* part = (LAS f32x2*)(lds + LDS_MISC + 1024);
    LAS f32x2* stat = part + 1024;
    LAS f32x2* dump = (LAS f32x2*)(lds + 81920);
    LAS bf16_t* Lin = (LAS bf16_t*)lds;
    LAS unsigned char* Lout = lds + 65536;
    const int c = tid;
    LAS f32x2* pdst = ((lane & 15) == 0) ? part + wave * 4 + (lane >> 4) : dump + (lane & 31);
    u32x4 R[8];
#define CONV_LOAD(tile_) do { const int tok0_ = (tile_) * 32, t0_ = tok0_ & (SEQ - 1); \
        _Pragma("unroll") for (int i_ = 0; i_ < 8; ++i_) { const int ch_ = tid + i_ * NTHR, r_ = ch_ >> 6, cc_ = ch_ & 63; \
            R[i_] = (u32x4){0u, 0u, 0u, 0u}; if (ch_ < 62 * 64 && t0_ - 30 + r_ >= 0) R[i_] = *(const u32x4*)(HG + (size_t)(tok0_ - 30 + r_) * 512 + cc_ * 8); } } while (0)
    if (tid == 0) qw[0] = (int)atomicAdd(queue, 1u);
    __syncthreads();
    int tile = qw[0];
    if (tile >= NTOK / 32) return;
    CONV_LOAD(tile);
    const float bias = P.dw_b[c], lgc = P.ln_g[c], lbc = P.ln_b[c];
    for (;;) {
#pragma unroll
        for (int i = 0; i < 8; ++i) { const int ch = tid + i * NTHR; if (ch < 62 * 64) *(LAS u32x4*)(Lin + (ch >> 6) * 512 + (ch & 63) * 8) = R[i]; }
        if (tid == 0) qw[1] = (int)atomicAdd(queue, 1u);
        __syncthreads();
        const int nxt = qw[1];
        float in[62];
#pragma unroll
        for (int r = 0; r < 62; ++r) in[r] = __builtin_bit_cast(float, (unsigned)Lin[r * 512 + c] << 16);
        if (nxt < NTOK / 32) CONV_LOAD(nxt);
        float out[32];
#pragma unroll
        for (int i = 0; i < 32; ++i) out[i] = bias;
#pragma unroll
        for (int j = 0; j < 31; ++j) { const float wj = P.dw_w[j * 512 + c];
#pragma unroll
            for (int i = 0; i < 32; ++i) out[i] = fmaf(in[i + j], wj, out[i]); }
#pragma unroll
        for (int i = 0; i < 32; ++i) { const float s1 = row_sum16(out[i]), s2 = row_sum16(out[i] * out[i]); pdst[32 * i] = (f32x2){s1, s2}; }
        __syncthreads();
        if (tid < 32) { float s1 = 0.f, s2 = 0.f;
#pragma unroll
            for (int w = 0; w < 32; ++w) { const f32x2 pp = part[tid * 32 + w]; s1 += pp.x; s2 += pp.y; }
            const float mean = s1 * (1.0f / 512.0f), var = fmaxf(s2 * (1.0f / 512.0f) - mean * mean, 0.f);
            stat[tid] = (f32x2){mean, 1.0f / sqrtf(var + EPS)}; }
        __syncthreads();
#pragma unroll
        for (int i = 0; i < 32; ++i) { const f32x2 st = stat[i]; const float y = (out[i] - st.x) * st.y * lgc + lbc; const float sl = y * sigmoidf_(y);
            Lout[i * 512 + c] = (unsigned char)__builtin_amdgcn_cvt_pk_fp8_f32(sl * 16.0f, 0.f, 0, false); }
        __syncthreads();
        { const int tok0 = tile * 32;
          for (int ch = tid; ch < 32 * 32; ch += NTHR) { const int r = ch >> 5, cc = ch & 31;
              *(u32x4*)(MIX + (size_t)(tok0 + r) * 1024 + 512 + cc * 16) = *(const LAS u32x4*)(Lout + r * 512 + cc * 16); } }
        if (nxt >= NTOK / 32) break;
        tile = nxt;
    }
#undef CONV_LOAD
}

constexpr int MW_UP = 32 * 16 * 64, MW_DN = 32 * 16 * 32, MW_ITEMS = MW_UP + MW_DN;
__device__ __forceinline__ void mw_decode(const Params& P, int it, const float*& src, int& ldw, unsigned char*& dst, const float*& gain) {
    unsigned char* ws = P.ws;
    if (it < MW_UP) { const int e = it >> 10, rr = it & 1023, kb = rr >> 6, nb = rr & 63, pn = nb >> 3, j = (nb & 7) * 32, bj = j >> 7, jj = j & 127;
        src = P.w_up + (size_t)e * 1024 * 2048 + (size_t)(kb * 64) * 2048 + 1024 * bj + 128 * pn + jj; ldw = 2048;
        dst = ws + WS_WUP + (size_t)e * 2048 * 1024 + (size_t)(nb * 32) * 1024 + kb * 64; gain = P.g_ffn + kb * 64; }
    else { const int r = it - MW_UP, e = r >> 9, rr = r & 511, kb = rr >> 5, nb = rr & 31;
        src = P.w_down + (size_t)e * 1024 * 1024 + (size_t)(kb * 64) * 1024 + nb * 32; ldw = 1024;
        dst = ws + WS_WDOWN + (size_t)e * 1024 * 1024 + (size_t)(nb * 32) * 1024 + kb * 64; gain = nullptr; }
}
#define MW_LOAD(LD, it_) do { if ((it_) < MW_ITEMS) { const float* src_; int ldw_; unsigned char* dst_; const float* gain_; mw_decode(P, (it_), src_, ldw_, dst_, gain_); \
        _Pragma("unroll") for (int i_ = 0; i_ < 8; ++i_) LD[i_] = NT_LD((const f32x4*)(src_ + (size_t)(8 * i_ + (lane >> 3)) * ldw_ + (lane & 7) * 4)); } } while (0)
#define MW_FINISH(LD, it_) do { if ((it_) < MW_ITEMS) { const float* src_; int ldw_; unsigned char* dst_; const float* gain_; mw_decode(P, (it_), src_, ldw_, dst_, gain_); \
        _Pragma("unroll") for (int i_ = 0; i_ < 8; ++i_) { const int kk_ = 8 * i_ + (lane >> 3), j_ = (lane & 7) * 4; const float gk_ = (gain_ ? gain_[kk_] : 1.0f) * 32.0f; \
            LAS float* d_ = scr + kk_ * 33 + j_; d_[0] = LD[i_].x * gk_; d_[1] = LD[i_].y * gk_; d_[2] = LD[i_].z * gk_; d_[3] = LD[i_].w * gk_; } \
        LDS_WAIT(); asm volatile("" ::: "memory"); \
        const int c_ = lane & 7; \
        _Pragma("unroll") for (int j_ = 0; j_ < 4; ++j_) { const int n_ = (lane >> 3) + 8 * j_; const LAS float* sp_ = scr + (8 * c_) * 33 + n_; \
            u32x2 o_; o_.x = pk4_fp8(sp_[0 * 33], sp_[1 * 33], sp_[2 * 33], sp_[3 * 33]); o_.y = pk4_fp8(sp_[4 * 33], sp_[5 * 33], sp_[6 * 33], sp_[7 * 33]); \
            *(u32x2*)(dst_ + (size_t)n_ * 1024 + 8 * c_) = o_; } \
        LDS_WAIT(); asm volatile("" ::: "memory"); } } while (0)
__device__ __forceinline__ void moe_weight_convert(const Params& P, LAS float* scr, int cw, int ncw, int lane) {
    f32x4 l0[8], l1[8], l2[8], l3[8];
    MW_LOAD(l0, cw); MW_LOAD(l1, cw + ncw); MW_LOAD(l2, cw + 2 * ncw);
    for (int base = cw; base < MW_ITEMS; base += 4 * ncw) {
        MW_LOAD(l3, base + 3 * ncw); MW_FINISH(l0, base);
        MW_LOAD(l0, base + 4 * ncw); MW_FINISH(l1, base + ncw);
        MW_LOAD(l1, base + 5 * ncw); MW_FINISH(l2, base + 2 * ncw);
        MW_LOAD(l2, base + 6 * ncw); MW_FINISH(l3, base + 3 * ncw);
    }
}
#undef MW_LOAD
#undef MW_FINISH

__device__ __forceinline__ void router_phase(const Params& P, LAS unsigned char* lds, int blk, int G, int tid, int wave, int lane) {
    unsigned char* ws = P.ws;
    const bf16_t* h1 = (const bf16_t*)(ws + WS_H1); const u32x4* wrg = (const u32x4*)(ws + WS_WRG);
    int* list = (int*)(ws + WS_LIST); float* lscale = (float*)(ws + WS_LSCALE); float* lgate = (float*)(ws + WS_LGATE);
    unsigned* cntg = (unsigned*)(ws + WS_CTL) + CW_CNT;
    LAS u32x4* WH = (LAS u32x4*)lds;
    LAS float* part = (LAS float*)lds;
    LAS int* lcnt = (LAS int*)(lds + LDS_MISC + 1024);
    LAS int* gbase = lcnt + 32;
    LAS int* rec_e = gbase + 32;
    LAS int* rec_p = rec_e + 512;
    LAS float* rec_g = (LAS float*)(rec_p + 512);
    LAS float* rec_s = rec_g + 512;
    const int tl = lane & 31, half = lane >> 5;
    for (int chunk = blk; chunk < NTOK / 128; chunk += G) {
        for (int i = tid; i < 8192; i += NTHR) WH[i] = wrg[i];
        if (tid < 32) lcnt[tid] = 0;
        __syncthreads();
        const int tloc = (wave & 3) * 32 + tl, tok = chunk * 128 + tloc, kb0 = (wave >> 2) * 512;
        f32x16 acc;
#pragma unroll
        for (int i = 0; i < 16; ++i) acc[i] = 0.f;
        float ss = 0.f;
        {
            const bf16_t* hrow = h1 + (size_t)tok * DM + kb0 + 8 * half;
            const LAS u32x4* wa = WH + (size_t)((kb0 >> 3) + half) * 32 + tl;
#pragma unroll 2
            for (int k0 = 0; k0 < 512; k0 += 64) {
                u32x4 hv[4];
#pragma unroll
                for (int i = 0; i < 4; ++i) hv[i] = NT_LD((const u32x4*)(hrow + k0 + 16 * i));
#pragma unroll
                for (int i = 0; i < 4; ++i) {
                    const u32x4 ah = wa[(size_t)((k0 >> 3) + 2 * i) * 32], al = wa[(size_t)((k0 >> 3) + 2 * i) * 32 + 4096];
                    const float x0 = bf_lo(hv[i].x), x1 = bf_hi(hv[i].x), x2 = bf_lo(hv[i].y), x3 = bf_hi(hv[i].y), x4 = bf_lo(hv[i].z), x5 = bf_hi(hv[i].z), x6 = bf_lo(hv[i].w), x7 = bf_hi(hv[i].w);
                    ss = fmaf(x0, x0, fmaf(x1, x1, fmaf(x2, x2, fmaf(x3, x3, fmaf(x4, x4, fmaf(x5, x5, fmaf(x6, x6, fmaf(x7, x7, ss))))))));
                    acc = __builtin_amdgcn_mfma_f32_32x32x16_bf16(__builtin_bit_cast(bf16x8, ah), __builtin_bit_cast(bf16x8, hv[i]), acc, 0, 0, 0);
                    acc = __builtin_amdgcn_mfma_f32_32x32x16_bf16(__builtin_bit_cast(bf16x8, al), __builtin_bit_cast(bf16x8, hv[i]), acc, 0, 0, 0);
                }
            }
        }
        __syncthreads();
        if (wave >= 4) { const int pl = (wave - 4) * 64 + lane;
#pragma unroll
            for (int r = 0; r < 16; ++r) part[r * 256 + pl] = acc[r];
            part[16 * 256 + pl] = ss; }
        __syncthreads();
        if (wave < 4) {
            { const int pl = wave * 64 + lane;
#pragma unroll
              for (int r = 0; r < 16; ++r) acc[r] += part[r * 256 + pl];
              ss += part[16 * 256 + pl]; }
            ss += __shfl_xor(ss, 32);
            const float rs = 1.0f / sqrtf(ss * (1.0f / DM) + EPS);
            float v[16];
#pragma unroll
            for (int r = 0; r < 16; ++r) v[r] = acc[r] * rs + P.b_router[(r & 3) + 8 * (r >> 2) + 4 * half];
            float tv[4]; int te[4];
#pragma unroll
            for (int q = 0; q < 4; ++q) { float bv = -INFINITY; int be = 64;
#pragma unroll
                for (int r = 0; r < 16; ++r) { const int e = (r & 3) + 8 * (r >> 2) + 4 * half; if (v[r] > bv || (v[r] == bv && e < be)) { bv = v[r]; be = e; } }
#pragma unroll
                for (int r = 0; r < 16; ++r) { const int e = (r & 3) + 8 * (r >> 2) + 4 * half; if (e == be) v[r] = -INFINITY; }
                tv[q] = bv; te[q] = be; }
            float cv[8]; int ce[8];
#pragma unroll
            for (int q = 0; q < 4; ++q) { cv[q] = tv[q]; ce[q] = te[q]; cv[4 + q] = __shfl_xor(tv[q], 32); ce[4 + q] = __shfl_xor(te[q], 32); }
#pragma unroll
            for (int q = 0; q < 4; ++q) { float bv = -INFINITY; int be = 64;
#pragma unroll
                for (int r = 0; r < 8; ++r) if (cv[r] > bv || (cv[r] == bv && ce[r] < be)) { bv = cv[r]; be = ce[r]; }
#pragma unroll
                for (int r = 0; r < 8; ++r) if (ce[r] == be) cv[r] = -INFINITY;
                tv[q] = bv; te[q] = be; }
            const float e1 = __expf(tv[1] - tv[0]), e2 = __expf(tv[2] - tv[0]), e3 = __expf(tv[3] - tv[0]);
            const float is = 1.0f / (1.0f + e1 + e2 + e3);
            if (half == 0) {
                const float gq[4] = {is, e1 * is, e2 * is, e3 * is};
#pragma unroll
                for (int q = 0; q < 4; ++q) { const int lp = atomicAdd((int*)&lcnt[te[q]], 1); const int si = tloc * 4 + q; rec_e[si] = te[q]; rec_p[si] = lp; rec_g[si] = gq[q]; }
                rec_s[tloc] = rs;
            }
        }
        __syncthreads();
        if (tid < 32) gbase[tid] = (int)atomicAdd(cntg + 64 * tid, (unsigned)lcnt[tid]);
        __syncthreads();
        { const int si = tid, ee = rec_e[si], pos = gbase[ee] + rec_p[si], li = ee * NTOK + pos;
          list[li] = (chunk * 128) * 4 + si; lscale[li] = rec_s[si >> 2]; lgate[li] = rec_g[si]; }
        __syncthreads();
    }
}

__device__ __forceinline__ void combine_phase(const Params& P, int mbeg, int mend, int mstep, int lane) {
    unsigned char* ws = P.ws;
    const bf16_t* h1 = (const bf16_t*)(ws + WS_H1); bf16_t* h1b = (bf16_t*)(ws + WS_H1B); const unsigned char* y = ws + WS_Y; float* rs3 = (float*)(ws + WS_RS3);
    for (int m = mbeg; m < mend; m += mstep) {
        const u32x2* hr = (const u32x2*)(h1 + (size_t)m * DM) + lane; f32x4 v[4]; float s = 0.f;
#pragma unroll
        for (int j = 0; j < 4; ++j) { const u32x2 hw = NT_LD(hr + 64 * j); v[j].x = bf_lo(hw.x); v[j].y = bf_hi(hw.x); v[j].z = bf_lo(hw.y); v[j].w = bf_hi(hw.y); }
#pragma unroll
        for (int k = 0; k < 4; ++k) { const unsigned* yr = (const unsigned*)(y + (size_t)(m * 4 + k) * DM) + lane;
#pragma unroll
            for (int j = 0; j < 4; ++j) { const unsigned w = NT_LD(yr + 64 * j); const f32x2 lo = __builtin_amdgcn_cvt_pk_f32_fp8((int)w, false), hi = __builtin_amdgcn_cvt_pk_f32_fp8((int)w, true);
                v[j].x += lo.x * 0.0625f; v[j].y += lo.y * 0.0625f; v[j].z += hi.x * 0.0625f; v[j].w += hi.y * 0.0625f; } }
        u32x2* o8 = (u32x2*)(h1b + (size_t)m * DM) + lane; unsigned* o4 = (unsigned*)(ws + WS_H1F8 + (size_t)m * DM) + lane;
#pragma unroll
        for (int j = 0; j < 4; ++j) { u32x2 w; w.x = pk2(v[j].x, v[j].y); w.y = pk2(v[j].z, v[j].w); NT_ST(w, o8 + 64 * j); NT_ST(pk4_fp8(v[j].x, v[j].y, v[j].z, v[j].w), o4 + 64 * j);
            s += (v[j].x * v[j].x + v[j].y * v[j].y) + (v[j].z * v[j].z + v[j].w * v[j].w); }
        s = wave_sum(s);
        if (lane == 0) rs3[m] = 1.0f / sqrtf(s * (1.0f / DM) + EPS);
    }
}

__device__ __forceinline__ void final_phase(const Params& P, int mbeg, int mend, int mstep, int lane) {
    unsigned char* ws = P.ws;
    const bf16_t* h2b = (const bf16_t*)(ws + WS_H1B); const unsigned char* pj = ws + WS_PJ; const unsigned char* G = ws + WS_G; const float* rs3 = (const float*)(ws + WS_RS3);
    f32x4 gv[4];
#pragma unroll
    for (int j = 0; j < 4; ++j) gv[j] = *((const f32x4*)P.g_final + lane + 64 * j);
    for (int m = mbeg; m < mend; m += mstep) {
        const u32x2* hr = (const u32x2*)(h2b + (size_t)m * DM) + lane; const unsigned* pr = (const unsigned*)(pj + (size_t)m * DM) + lane; const unsigned* gr = (const unsigned*)(G + (size_t)m * DM) + lane;
        const float r3 = rs3[m]; f32x4 v[4]; float s = 0.f;
#pragma unroll
        for (int j = 0; j < 4; ++j) { const u32x2 hw = NT_LD(hr + 64 * j); const unsigned pw = NT_LD(pr + 64 * j), gw2 = NT_LD(gr + 64 * j);
            const f32x2 glo = __builtin_amdgcn_cvt_pk_f32_fp8((int)gw2, false), ghi = __builtin_amdgcn_cvt_pk_f32_fp8((int)gw2, true);
            const f32x2 plo = __builtin_amdgcn_cvt_pk_f32_fp8((int)pw, false), phi = __builtin_amdgcn_cvt_pk_f32_fp8((int)pw, true);
            v[j].x = fmaf(plo.x * 0.0625f, sigmoidf_(glo.x * r3), bf_lo(hw.x)); v[j].y = fmaf(plo.y * 0.0625f, sigmoidf_(glo.y * r3), bf_hi(hw.x));
            v[j].z = fmaf(phi.x * 0.0625f, sigmoidf_(ghi.x * r3), bf_lo(hw.y)); v[j].w = fmaf(phi.y * 0.0625f, sigmoidf_(ghi.y * r3), bf_hi(hw.y));
            s += (v[j].x * v[j].x + v[j].y * v[j].y) + (v[j].z * v[j].z + v[j].w * v[j].w); }
        s = wave_sum(s); const float rs = 1.0f / sqrtf(s * (1.0f / DM) + EPS);
        f32x4* orow = (f32x4*)(P.out + (size_t)m * DM) + lane;
#pragma unroll
        for (int j = 0; j < 4; ++j) NT_ST(v[j] * rs * gv[j], orow + 64 * j);
    }
}

#define XB_TMO      128
#define XB_XCNT(j)  (256  + 64 * (j))
#define XB_XSUB(j)  (1280 + 64 * (j))
#define XB_XGEN(j)  (2304 + 64 * (j))
#define XB_TOP      3328
#define XB_TOPGEN   3392
#define XCD_BAR_WORDS 3456
#define XB_SPIN_CAP (1u << 18)
__device__ __forceinline__ unsigned xb_ld(unsigned* p)              { return __hip_atomic_load(p, __ATOMIC_RELAXED, __HIP_MEMORY_SCOPE_AGENT); }
__device__ __forceinline__ unsigned xb_add(unsigned* p, unsigned v) { return __hip_atomic_fetch_add(p, v, __ATOMIC_RELAXED, __HIP_MEMORY_SCOPE_AGENT); }
__device__ __forceinline__ unsigned xb_xcc_id() { return (unsigned)__builtin_amdgcn_s_getreg((3 << 11) | 20) & 0xFu; }
#define XB_SPIN(cond, bar) do { unsigned _sp = 0; while (cond) { __builtin_amdgcn_s_sleep(1); \
    if ((++_sp & 255u) == 0u) { if (xb_ld(&(bar)[XB_TMO])) break; if (_sp > XB_SPIN_CAP) { atomicAdd(&(bar)[XB_TMO], 1u); break; } } } } while (0)
struct XcdBarrier { unsigned* bar; unsigned x; volatile LAS unsigned* st; };
__device__ __forceinline__ XcdBarrier xcd_barrier_post(unsigned* bar, volatile LAS unsigned* st) {
    XcdBarrier b; b.bar = bar; b.x = xb_xcc_id(); b.st = st;
    if (threadIdx.x == 0) (void)xb_add(&bar[XB_XCNT(b.x)], 1u);
    return b;
}
__device__ __forceinline__ void xcd_barrier_complete(unsigned* bar, unsigned x, unsigned& nloc, unsigned& nx) {
    const unsigned G = gridDim.x * gridDim.y * gridDim.z;
    unsigned sum, cnt, mine, sp = 0u;
    for (;;) {
        sum = 0u; cnt = 0u; mine = 0u;
#pragma unroll
        for (unsigned j = 0; j < 16; ++j) { const unsigned c = xb_ld(&bar[XB_XCNT(j)]); sum += c; cnt += (c > 0u) ? 1u : 0u; mine = (j == x) ? c : mine; }
        if (sum == G) break;
        __builtin_amdgcn_s_sleep(1);
        if ((++sp & 255u) == 0u) { if (xb_ld(&bar[XB_TMO])) break; if (sp > XB_SPIN_CAP) { atomicAdd(&bar[XB_TMO], 1u); break; } }
    }
    nloc = mine > 0u ? mine : 1u; nx = cnt > 0u ? cnt : 1u;
}
__device__ __forceinline__ void xcd_barrier(const XcdBarrier& b) {
    asm volatile("s_waitcnt vmcnt(0)" ::: "memory");
    __syncthreads();
    if (threadIdx.x == 0) {
        unsigned* bar = b.bar;
        __builtin_amdgcn_s_waitcnt(0);
        unsigned nloc = b.st[0], nx = b.st[1];
        if (nloc == 0u) { xcd_barrier_complete(bar, b.x, nloc, nx); b.st[0] = nloc; b.st[1] = nx; }
        const unsigned old = xb_add(&bar[XB_XSUB(b.x)], 1u);
        const unsigned gen = old / nloc;
        if (old + 1u == (gen + 1u) * nloc) {
            __builtin_amdgcn_fence(__ATOMIC_RELEASE, "agent");
            asm volatile("s_waitcnt vmcnt(0)" ::: "memory");
            const unsigned og = xb_add(&bar[XB_TOP], 1u);
            const unsigned tg = og / nx;
            if (og + 1u == (tg + 1u) * nx) xb_add(&bar[XB_TOPGEN], 1u);
            else XB_SPIN(xb_ld(&bar[XB_TOPGEN]) == tg, bar);
            __builtin_amdgcn_fence(__ATOMIC_ACQUIRE, "agent");
            xb_add(&bar[XB_XGEN(b.x)], 1u);
            asm volatile("s_waitcnt vmcnt(0)" ::: "memory");
        } else {
            XB_SPIN(xb_ld(&bar[XB_XGEN(b.x)]) == gen, bar);
            __builtin_amdgcn_fence(__ATOMIC_ACQUIRE, "agent");
            asm volatile("s_waitcnt vmcnt(0)" ::: "memory");
        }
    }
    __syncthreads();
}

__device__ __forceinline__ void pair_sync(unsigned* flag, unsigned* tmo, bool same_xcd) {
    asm volatile("s_waitcnt vmcnt(0)" ::: "memory");
    __syncthreads();
    if (threadIdx.x == 0) {
        if (!same_xcd) { __builtin_amdgcn_fence(__ATOMIC_RELEASE, "agent"); asm volatile("s_waitcnt vmcnt(0)" ::: "memory"); }
        xb_add(flag, 1u);
        unsigned sp = 0u;
        while (xb_ld(flag) < 2u) { __builtin_amdgcn_s_sleep(1); if ((++sp & 255u) == 0u) { if (xb_ld(tmo)) break; if (sp > XB_SPIN_CAP) { atomicAdd(tmo, 1u); break; } } }
        __builtin_amdgcn_fence(__ATOMIC_ACQUIRE, "agent");
        asm volatile("s_waitcnt vmcnt(0)" ::: "memory");
    }
    __syncthreads();
}

constexpr int NPHASE = 10;
__global__ void __launch_bounds__(NTHR, 2) fwd_kernel(Params P) {
    extern __shared__ __attribute__((aligned(16))) unsigned char lds_raw[];
    LAS unsigned char* lds = (LAS unsigned char*)lds_raw;
    cg::grid_group grid = cg::this_grid();
    const int tid = threadIdx.x, wave = __builtin_amdgcn_readfirstlane(tid >> 6);
    const int G = gridDim.x, bx = blockIdx.x;
#define FRESH_LANE(name) int name = (int)__builtin_amdgcn_mbcnt_hi(~0u, __builtin_amdgcn_mbcnt_lo(~0u, 0u)); asm volatile("" : "+v"(name))
    const int vcu = (G % 8 == 0) ? (bx % 8) * (G / 8) + bx / 8 : bx;
    const int NGW = G * NWAVES;
    unsigned char* ws = P.ws;
    const int lo = P.ph_lo, hi = P.ph_hi;
#define IN(k) (lo <= (k) && (k) < hi)
    volatile LAS unsigned* xst = (volatile LAS unsigned*)(lds + LDS_XB);
    if (tid < 2) xst[tid] = 0u;
    __syncthreads();
    const XcdBarrier xbar = xcd_barrier_post((unsigned*)(ws + WS_CTL) + CW_BAR, xst);
    if (tid == 0) __hip_atomic_store((unsigned*)(ws + WS_CTL) + CW_XCC + bx, xbar.x + 1u, __ATOMIC_RELAXED, __HIP_MEMORY_SCOPE_AGENT);
    if (P.ph_lo > P.ph_hi) grid.sync();
#define SYNC(k) do { if (IN(k) && IN((k) + 1)) xcd_barrier(xbar); } while (0)

    if (IN(0)) { FRESH_LANE(lane); p0_prologue(P, lds, vcu, G, wave, lane); }
    SYNC(0);
    if (IN(1)) {
        { pg8::DenseSched S; S.init((const bf16_t*)(ws + WS_XB), (const bf16_t*)(ws + WS_WIN), NTOK, 2048, 1024, G, bx);
          EpiInProj E{(const float*)(ws + WS_RS1), (const f32x2*)(ws + WS_ROPE), P.glu_b, (bf16_t*)(ws + WS_Q), (bf16_t*)(ws + WS_K), (bf16_t*)(ws + WS_V), (bf16_t*)(ws + WS_QI), (bf16_t*)(ws + WS_KI), (bf16_t*)(ws + WS_HGLU), (float*)(ws + WS_WI)};
          pg8::gemm_phase<EpiInProj, pg8::DenseSched, false>(lds, S, E); }
        { pg8::DenseSched S; S.init((const bf16_t*)(ws + WS_PB), (const bf16_t*)(ws + WS_WP), NTOK, 1024, 256, G, bx);
          EpiF8Plain E{ws + WS_PJ, 1024, 16.0f};
          pg8::gemm_phase<EpiF8Plain, pg8::DenseSched, false>(lds, S, E); }
    }
    SYNC(1);
    if (IN(2)) {
        FRESH_LANE(lane);
        for (int i = tid; i < 4096; i += NTHR) ((LAS unsigned*)(lds + LDS_MISC))[i] = 0u;
        __syncthreads();
        unsigned* ctl = (unsigned*)(ws + WS_CTL);
        volatile LAS int* qw = (volatile LAS int*)(lds + LDS_XB + 32);
        if (G % 8 == 0 && G >= 128) { const int ncv = 8; if ((bx >> 3) < ncv) moe_weight_convert(P, (LAS float*)(lds + wave * 16384), (bx * NWAVES) + wave, ncv * 8 * NWAVES, lane); }
        else { moe_weight_convert(P, (LAS float*)(lds + wave * 16384), bx * NWAVES + wave, G * NWAVES, lane); }
        __syncthreads();
        for (int db = 0; db < NB; ++db) { const int b = (bx + db) & 7;
            for (;;) {
                if (tid == 0) qw[0] = (int)atomicAdd(ctl + CW_AQ + 64 * b, 1u);
                __syncthreads();
                const int k = qw[0];
                if (k >= 512) break;
                attn_tile(P, lds, b, (511 - k) * 8, wave, lane);
            }
            __syncthreads(); }
        conv_phase(P, lds, ctl + CW_CQ, qw, wave);
    }
    SYNC(2);
    if (IN(3)) {
        pg8::DenseSched S; S.init(ws + WS_MIX, ws + WS_WOUT, NTOK, 1024, 1024, G, bx); S.rp = 1024;
        EpiOutProj E{(const bf16_t*)(ws + WS_XB), (bf16_t*)(ws + WS_H1), (unsigned char*)(ws + WS_H1F8)};
        S.idg = true;
        pg8::gemm_phase<EpiOutProj, pg8::DenseSched, true, true, false>(lds, S, E);
    }
    SYNC(3);
    if (IN(4)) { FRESH_LANE(lane); router_phase(P, lds, vcu, G, tid, wave, lane); }
    SYNC(4);
    if (IN(5) || IN(6)) {
        LAS int* tb = (LAS int*)(lds + LDS_MISC); LAS int* cn = tb + 64;
        if (tid < NE) cn[tid] = (int)__hip_atomic_load((const unsigned*)(ws + WS_CTL) + CW_CNT + 64 * tid, __ATOMIC_RELAXED, __HIP_MEMORY_SCOPE_AGENT);
        __syncthreads();
        if (tid == 0) { int acc = 0;
            for (int e = 0; e < NE; ++e) { tb[e] = acc; acc += (cn[e] + BM - 1) / BM; }
            tb[NE] = acc; }
        __syncthreads();
        if (IN(5)) {
            pg8::MoeSched S; S.A = ws + WS_H1F8; S.Bt = ws + WS_WUP; S.rp = 1024; S.b_estride = (size_t)2048 * 1024; S.tb = tb; S.cnt = cn; S.list = (const int*)(ws + WS_LIST);
            S.nN = 8; S.nwg = tb[NE] * 8; S.G = G; S.c = bx; S.gather = true;
            { LAS int* ut = (LAS int*)(lds + LDS_MISC + 512); S.utab = ut; S.build_table(ut, tid); __syncthreads(); }
            S.m_scale = (const float*)(ws + WS_LSCALE); S.m_gate = nullptr; S.m_bias = P.b_up;
            EpiUp E{(unsigned char*)(ws + WS_ACT)};
            pg8::gemm_phase<EpiUp, pg8::MoeSched, true, true, true>(lds, S, E);
        }
        SYNC(5);
        if (IN(6)) {
            pg8::MoeSched S; S.A = ws + WS_ACT; S.Bt = ws + WS_WDOWN; S.rp = 1024; S.b_estride = (size_t)1024 * 1024; S.tb = tb; S.cnt = cn; S.list = (const int*)(ws + WS_LIST);
            S.nN = 4; S.nwg = tb[NE] * 4; S.G = G; S.c = bx; S.gather = false;
            { LAS int* ut = (LAS int*)(lds + LDS_MISC + 512); S.utab = ut; S.build_table(ut, tid); __syncthreads(); }
            S.m_scale = nullptr; S.m_gate = (const float*)(ws + WS_LGATE); S.m_bias = P.b_down;
            EpiDown E{(unsigned char*)(ws + WS_Y)};
            pg8::gemm_phase<EpiDown, pg8::MoeSched, true, true, true>(lds, S, E);
        }
    }
    SYNC(6);
    {
        const bool fused = (G == 256) && IN(7) && IN(8) && IN(9);
        const int j8 = bx >> 3, pm = (bx & 7) * 16 + (j8 >> 1), half = j8 & 1, r0 = pm * BM + half * 128;
        unsigned* ctl = (unsigned*)(ws + WS_CTL); unsigned* tmo = ctl + CW_BAR + XB_TMO;
        const bool same_xcd = fused && (xb_ld(ctl + CW_XCC + (bx ^ 8)) == xbar.x + 1u);
        if (IN(7)) { FRESH_LANE(l7);
            if (fused) combine_phase(P, r0 + wave, r0 + 128, NWAVES, l7); else combine_phase(P, vcu * NWAVES + wave, NTOK, NGW, l7); }
        if (fused) pair_sync(ctl + CW_PAIR + 16 * (2 * pm), tmo, same_xcd); else SYNC(7);
        if (IN(8)) {
            pg8::DenseSched S; S.init(ws + WS_H1F8, ws + WS_WG, NTOK, 1024, 1024, G, bx); S.rp = 1024; S.idg = true;
            if (fused) { S.pair_pm = pm; S.pair_pn0 = 2 * half; }
            EpiF8Plain E{(unsigned char*)(ws + WS_G), 1024, 0.03125f};
            pg8::gemm_phase<EpiF8Plain, pg8::DenseSched, true, true>(lds, S, E);
        }
        if (fused) pair_sync(ctl + CW_PAIR + 16 * (2 * pm + 1), tmo, same_xcd); else SYNC(8);
        if (IN(9)) { FRESH_LANE(l9);
            if (fused) final_phase(P, r0 + wave, r0 + 128, NWAVES, l9); else final_phase(P, vcu * NWAVES + wave, NTOK, NGW, l9); }
    }
#undef IN
#undef SYNC
}

#ifndef N_LAUNCH_MODE
#define N_LAUNCH_MODE 1
#endif
extern "C" void kernel_launch(void* const* d_in, const int* in_sizes, int n_in, void* d_out, int out_size, void* d_ws, size_t ws_size, hipStream_t stream) {
    static int grid = 0;
    if (grid == 0) {
        if (n_in != 21 || out_size != NTOK * DM || ws_size < WS_END) { fprintf(stderr, "kernel_launch: unexpected shapes (n_in %d out %d ws %zu)\n", n_in, out_size, ws_size); grid = -1; return; }
        int dev = 0, cus = 0, per_cu = 0;
        (void)hipGetDevice(&dev); (void)hipDeviceGetAttribute(&cus, hipDeviceAttributeMultiprocessorCount, dev);
        (void)hipFuncSetAttribute((const void*)fwd_kernel, hipFuncAttributeMaxDynamicSharedMemorySize, LDS_BYTES);
        if (hipOccupancyMaxActiveBlocksPerMultiprocessor(&per_cu, (const void*)fwd_kernel, NTHR, LDS_BYTES) != hipSuccess || per_cu < 1) { fprintf(stderr, "kernel_launch: occupancy query failed (%d)\n", per_cu); (void)hipGetLastError(); grid = -1; return; }
        grid = cus;
    }
    if (grid < 0) return;
    (void)hipMemsetAsync((char*)d_ws + WS_CTL, 0, CTL_BYTES, stream);
    Params p{};
    p.x = (const float*)d_in[0]; p.p = (const float*)d_in[1]; p.w_in = (const float*)d_in[2]; p.w_out = (const float*)d_in[3]; p.g_mix = (const float*)d_in[4]; p.g_ffn = (const float*)d_in[5];
    p.glu_b = (const float*)d_in[6]; p.dw_w = (const float*)d_in[7]; p.dw_b = (const float*)d_in[8]; p.ln_g = (const float*)d_in[9]; p.ln_b = (const float*)d_in[10];
    p.w_router = (const float*)d_in[11]; p.b_router = (const float*)d_in[12]; p.w_up = (const float*)d_in[13]; p.b_up = (const float*)d_in[14]; p.w_down = (const float*)d_in[15]; p.b_down = (const float*)d_in[16];
    p.w_ple_proj = (const float*)d_in[17]; p.w_ple_gate = (const float*)d_in[18]; p.g_ple = (const float*)d_in[19]; p.g_final = (const float*)d_in[20];
    p.out = (float*)d_out; p.ws = (unsigned char*)d_ws;
#if N_LAUNCH_MODE == 1
    p.ph_lo = 0; p.ph_hi = NPHASE;
    void* args[] = {&p};
    hipError_t e = hipLaunchCooperativeKernel((const void*)fwd_kernel, dim3(grid), dim3(NTHR), args, LDS_BYTES, stream);
    if (e != hipSuccess) fprintf(stderr, "cooperative launch failed: %s (grid %d)\n", hipGetErrorString(e), grid);
#else
    for (int ph = 0; ph < NPHASE; ++ph) {
        p.ph_lo = ph; p.ph_hi = ph + 1;
        void* args[] = {&p};
        hipError_t e = hipLaunchCooperativeKernel((const void*)fwd_kernel, dim3(grid), dim3(NTHR), args, LDS_BYTES, stream);
        if (e != hipSuccess) { fprintf(stderr, "launch %d failed: %s (grid %d)\n", ph, hipGetErrorString(e), grid); break; }
    }
#endif
}
```
